# Optimizing an MI355X kernel written in HIP

```python
import math
import jax, jax.numpy as jnp
from jax import lax
import numpy as np

D_MODEL = 1024
BATCH = 8
SEQ = 8192
DEPTH = 4

GRID_W = 64
CTX_LEN = 256
N_MIXERS = 3
EPS = 1e-6
HEAD_DIM = 128
N_HEADS = D_MODEL // HEAD_DIM
N_KV_HEADS = N_HEADS // 4
Q_GROUP = N_HEADS // N_KV_HEADS
ATTN_Q_W = N_HEADS * HEAD_DIM
ATTN_KV_W = N_KV_HEADS * HEAD_DIM
AXIS_DIM = HEAD_DIM // 2
ROPE_THETA = 10000.0
Q_BLOCK = 128
CHUNK = 128
GMLP_WIDTH = D_MODEL
GMLP_GROUPS = 8
GMLP_GROUP_DIM = GMLP_WIDTH // GMLP_GROUPS
HYENA_WIDTH = D_MODEL
HYENA_ORDER = 2
FILTER_EMB = 33
N_BANDS = (FILTER_EMB - 1) // 2
FILTER_HIDDEN = 64
DECAY_TARGET = 1e-2
FAST_DECAY_PCT = 0.3
SLOW_DECAY_PCT = 1.5
MAX_DECAY = math.log(DECAY_TARGET) / FAST_DECAY_PCT
MIN_DECAY = math.log(DECAY_TARGET) / SLOW_DECAY_PCT
N_EXPERTS = 32
TOP_K = 4
D_FF = D_MODEL
SWIGLU_ALPHA = 1.702
SWIGLU_LIMIT = 7.0
EXPERT_BLOCK = 256

kernel_name = 'hybrid_gqa_gmlp_hyena_moe_dit'


def rmsnorm(x, g):
    xf = x.astype(jnp.float32)
    y = xf * lax.rsqrt(jnp.mean(xf * xf, axis=-1, keepdims=True) + EPS)
    return y.astype(x.dtype) * g


def axial_rope(n_tok):
    rows = n_tok // GRID_W
    row = jnp.repeat(jnp.arange(rows, dtype=jnp.float32), GRID_W)
    col = jnp.tile(jnp.arange(GRID_W, dtype=jnp.float32), rows)
    inv = ROPE_THETA ** (-jnp.arange(0, AXIS_DIM, 2, dtype=jnp.float32) / AXIS_DIM)
    ang_r = row[:, None] * inv
    ang_c = col[:, None] * inv
    ang = jnp.concatenate([ang_r, ang_r, ang_c, ang_c], axis=-1)
    return jnp.cos(ang), jnp.sin(ang)


def apply_rope(x, cos, sin):
    xr = x.reshape(*x.shape[:-1], 2, 2, AXIS_DIM // 2)
    rot = jnp.stack([-xr[..., 1, :], xr[..., 0, :]], axis=-2).reshape(x.shape)
    return x * cos[None, :, None, :].astype(x.dtype) + rot * sin[None, :, None, :].astype(x.dtype)


def gqa_attend(q, k, v):
    s = jnp.einsum('bqhgd,bkhd->bhgqk', q, k).astype(jnp.float32) * (HEAD_DIM ** -0.5)
    p = jax.nn.softmax(s, axis=-1).astype(v.dtype)
    return jnp.einsum('bhgqk,bkhd->bqhgd', p, v)


def attention_mixer(h_lat, h_ctx, w_in, q_gain, k_gain, cos, sin, ctx_queries):
    B, S, _ = h_lat.shape
    C = h_ctx.shape[1]

    def heads_kv(p_kv):
        b, l, _ = p_kv.shape
        k = rmsnorm(p_kv[..., :ATTN_KV_W].reshape(b, l, N_KV_HEADS, HEAD_DIM), k_gain)
        v = p_kv[..., ATTN_KV_W:].reshape(b, l, N_KV_HEADS, HEAD_DIM)
        return k, v

    def heads_q(p_q):
        b, l, _ = p_q.shape
        return rmsnorm(p_q.reshape(b, l, N_HEADS, HEAD_DIM), q_gain)

    p_lat = h_lat @ w_in
    q_lat = apply_rope(heads_q(p_lat[..., :ATTN_Q_W]), cos, sin)
    k_lat, v_lat = heads_kv(p_lat[..., ATTN_Q_W:])
    k_lat = apply_rope(k_lat, cos, sin)
    if ctx_queries:
        p_ctx = h_ctx @ w_in
        q_ctx = heads_q(p_ctx[..., :ATTN_Q_W])
        k_ctx, v_ctx = heads_kv(p_ctx[..., ATTN_Q_W:])
    else:
        k_ctx, v_ctx = heads_kv(h_ctx @ w_in[:, ATTN_Q_W:])
    k_all = jnp.concatenate([k_lat, k_ctx], axis=1)
    v_all = jnp.concatenate([v_lat, v_ctx], axis=1)
    n_blk = S // Q_BLOCK
    q_blocks = q_lat.reshape(B, n_blk, Q_BLOCK, N_KV_HEADS, Q_GROUP, HEAD_DIM).transpose(1, 0, 2, 3, 4, 5)
    o = lax.map(lambda qb: gqa_attend(qb, k_all, v_all), q_blocks)
    y_lat = o.transpose(1, 0, 2, 3, 4, 5).reshape(B, S, ATTN_Q_W)
    y_ctx = None
    if ctx_queries:
        y_ctx = gqa_attend(q_ctx.reshape(B, C, N_KV_HEADS, Q_GROUP, HEAD_DIM), k_ctx, v_ctx).reshape(B, C, ATTN_Q_W)
    return y_lat, y_ctx


def gmlp_mixer(h, w_in, v_gain, w_s, b_s):
    B, L, _ = h.shape
    z = jax.nn.gelu(h @ w_in, approximate=False)
    u, v = jnp.split(z, 2, axis=-1)
    v = rmsnorm(v, v_gain).reshape(B, L // CHUNK, CHUNK, GMLP_GROUPS, GMLP_GROUP_DIM)
    mixed = jnp.einsum('gpq,bnqgc->bnpgc', w_s, v) + b_s.T[None, None, :, :, None]
    return u * mixed.reshape(B, L, GMLP_WIDTH)


def short_conv(p, w, b):
    pp = jnp.pad(p, ((0, 0), (1, 1), (0, 0)))
    return pp[:, :-2] * w[0] + pp[:, 1:-1] * w[1] + pp[:, 2:] * w[2] + b


def hyena_filter(L, w1, b1, w2, b2, w3, b3, w4, b4, freq):
    t = jnp.linspace(0.0, 1.0, L, dtype=jnp.float32)[:, None]
    w = 2.0 * math.pi * jnp.arange(L, dtype=jnp.float32)[:, None] / L
    f = jnp.linspace(1e-4, N_BANDS - 1, N_BANDS, dtype=jnp.float32)[None, :]
    z = jnp.concatenate([t, jnp.cos(f * w), -jnp.sin(f * w)], axis=-1)
    a = jnp.sin(freq * (z @ w1 + b1))
    a = jnp.sin(freq * (a @ w2 + b2))
    a = jnp.sin(freq * (a @ w3 + b3))
    k = (a @ w4 + b4).astype(jnp.float32)
    deltas = jnp.abs(jnp.linspace(MIN_DECAY, MAX_DECAY, HYENA_WIDTH, dtype=jnp.float32))
    window = jnp.exp(-t * deltas[None, :])
    k_fwd = k[:, :HYENA_WIDTH] * window
    k_bwd = k[:, HYENA_WIDTH:] * window
    zero = jnp.zeros((1, HYENA_WIDTH), jnp.float32)
    return jnp.concatenate([k_fwd, zero, k_bwd[:0:-1]], axis=0)


def hyena_mixer(h, w_in, conv_w, conv_b, f_w1, f_b1, f_w2, f_b2, f_w3, f_b3, f_w4, f_b4, freq, d_skip):
    B, L, _ = h.shape
    p = short_conv(h @ w_in, conv_w, conv_b)
    x0, x1, v = jnp.split(p, HYENA_ORDER + 1, axis=-1)
    v = v * x1
    filt = hyena_filter(L, f_w1, f_b1, f_w2, f_b2, f_w3, f_b3, f_w4, f_b4, freq)
    vf = jnp.fft.rfft(v.astype(jnp.float32), n=2 * L, axis=1)
    kf = jnp.fft.rfft(filt, n=2 * L, axis=0)
    y = jnp.fft.irfft(vf * kf[None], n=2 * L, axis=1)[:, :L].astype(v.dtype)
    y = y + v * d_skip
    return y * x0


def expert_ffn(xb, w1, b1, w2, b2):
    hh = xb @ w1 + b1
    glu, lin = jnp.split(hh, 2, axis=-1)
    glu = jnp.minimum(glu, SWIGLU_LIMIT)
    lin = jnp.clip(lin, -SWIGLU_LIMIT, SWIGLU_LIMIT)
    return (glu * jax.nn.sigmoid(SWIGLU_ALPHA * glu) * (lin + 1.0)) @ w2 + b2


def moe(h, router_w, router_b, w1, b1, w2, b2):
    n_tok, d = h.shape
    logits = (h @ router_w + router_b).astype(jnp.float32)
    top_val, top_idx = lax.top_k(logits, TOP_K)
    gates = jax.nn.softmax(top_val, axis=-1).astype(h.dtype)
    n_assign = n_tok * TOP_K
    flat_e = top_idx.reshape(-1)
    order = jnp.argsort(flat_e)
    sorted_e = flat_e[order]
    counts = jnp.bincount(flat_e, length=N_EXPERTS)
    padded = (counts + EXPERT_BLOCK - 1) // EXPERT_BLOCK * EXPERT_BLOCK
    pad_end = jnp.cumsum(padded)
    pad_start = pad_end - padded
    start = jnp.cumsum(counts) - counts
    dest = pad_start[sorted_e] + (jnp.arange(n_assign) - start[sorted_e])
    n_blocks = -(-n_assign // EXPERT_BLOCK) + N_EXPERTS
    rows = n_blocks * EXPERT_BLOCK
    x_disp = jnp.zeros((rows, d), h.dtype).at[dest].set(h[order // TOP_K])
    block_e = jnp.minimum(jnp.searchsorted(pad_end, jnp.arange(n_blocks) * EXPERT_BLOCK, side='right'), N_EXPERTS - 1)

    def run_block(args):
        xb, e = args
        return expert_ffn(xb, w1[e], b1[e], w2[e], b2[e])

    y_disp = lax.map(run_block, (x_disp.reshape(n_blocks, EXPERT_BLOCK, d), block_e)).reshape(rows, d)
    y_assign = jnp.zeros((n_assign, d), h.dtype).at[order].set(y_disp[dest])
    return jnp.einsum('nkd,nk->nd', y_assign.reshape(n_tok, TOP_K, d), gates)


def setup_inputs(seed: int = 0) -> dict:
    key = jax.random.key(seed)
    ks = iter(jax.random.split(key, 40))

    def nrm(shape, scale):
        return jax.random.normal(next(ks), shape, jnp.float32) * scale

    n_a = len(range(0, DEPTH, N_MIXERS))
    n_b = len(range(1, DEPTH, N_MIXERS))
    n_c = len(range(2, DEPTH, N_MIXERS))
    D = D_MODEL
    return {
        'x': nrm((BATCH, SEQ, D), 1.0),
        'c': nrm((BATCH, D), 1.0),
        'ctx': nrm((BATCH, CTX_LEN, D), 1.0),
        'c_ctx': nrm((D,), 1.0),
        'ada_w': nrm((DEPTH, D, 6 * D), 0.5 * D ** -0.5),
        'ada_b': nrm((DEPTH, 6 * D), 0.02),
        'norm1_g': 1.0 + nrm((DEPTH, D), 0.02),
        'norm2_g': 1.0 + nrm((DEPTH, D), 0.02),
        'mix_w_out': nrm((DEPTH, D, D), D ** -0.5),
        'router_w': nrm((DEPTH, D, N_EXPERTS), D ** -0.5),
        'router_b': nrm((DEPTH, N_EXPERTS), 0.01),
        'exp_w1': nrm((DEPTH, N_EXPERTS, D, 2 * D_FF), D ** -0.5),
        'exp_b1': nrm((DEPTH, N_EXPERTS, 2 * D_FF), 0.01),
        'exp_w2': nrm((DEPTH, N_EXPERTS, D_FF, D), D_FF ** -0.5),
        'exp_b2': nrm((DEPTH, N_EXPERTS, D), 0.01),
        'attn_w_in': nrm((n_a, D, ATTN_Q_W + 2 * ATTN_KV_W), D ** -0.5),
        'attn_q_gain': 1.0 + nrm((n_a, HEAD_DIM), 0.02),
        'attn_k_gain': 1.0 + nrm((n_a, HEAD_DIM), 0.02),
        'gmlp_w_in': nrm((n_b, D, 2 * GMLP_WIDTH), D ** -0.5),
        'gmlp_v_gain': 1.0 + nrm((n_b, GMLP_WIDTH), 0.02),
        'gmlp_w_s': nrm((n_b, GMLP_GROUPS, CHUNK, CHUNK), CHUNK ** -0.5),
        'gmlp_b_s': 1.0 + nrm((n_b, GMLP_GROUPS, CHUNK), 0.02),
        'hyena_w_in': nrm((n_c, D, (HYENA_ORDER + 1) * HYENA_WIDTH), D ** -0.5),
        'hyena_conv_w': nrm((n_c, 3, (HYENA_ORDER + 1) * HYENA_WIDTH), 0.5),
        'hyena_conv_b': nrm((n_c, (HYENA_ORDER + 1) * HYENA_WIDTH), 0.01),
        'hyena_f_w1': nrm((n_c, FILTER_EMB, FILTER_HIDDEN), FILTER_EMB ** -0.5),
        'hyena_f_b1': nrm((n_c, FILTER_HIDDEN), 0.02),
        'hyena_f_w2': nrm((n_c, FILTER_HIDDEN, FILTER_HIDDEN), FILTER_HIDDEN ** -0.5),
        'hyena_f_b2': nrm((n_c, FILTER_HIDDEN), 0.02),
        'hyena_f_w3': nrm((n_c, FILTER_HIDDEN, FILTER_HIDDEN), FILTER_HIDDEN ** -0.5),
        'hyena_f_b3': nrm((n_c, FILTER_HIDDEN), 0.02),
        'hyena_f_w4': nrm((n_c, FILTER_HIDDEN, 2 * HYENA_WIDTH), 0.02 * FILTER_HIDDEN ** -0.5),
        'hyena_f_b4': nrm((n_c, 2 * HYENA_WIDTH), 0.002),
        'hyena_freq': 1.0 + nrm((n_c, FILTER_HIDDEN), 0.02),
        'hyena_d': nrm((n_c, HYENA_WIDTH), 0.5),
        'final_g': 1.0 + nrm((D,), 0.02),
    }


def reference(x, c, ctx, c_ctx, ada_w, ada_b, norm1_g, norm2_g, mix_w_out, router_w, router_b,
              exp_w1, exp_b1, exp_w2, exp_b2, attn_w_in, attn_q_gain, attn_k_gain,
              gmlp_w_in, gmlp_v_gain, gmlp_w_s, gmlp_b_s,
              hyena_w_in, hyena_conv_w, hyena_conv_b, hyena_f_w1, hyena_f_b1, hyena_f_w2, hyena_f_b2,
              hyena_f_w3, hyena_f_b3, hyena_f_w4, hyena_f_b4, hyena_freq, hyena_d, final_g):
    B, S, D = x.shape
    C = ctx.shape[1]
    cos, sin = axial_rope(S)
    x_lat, x_ctx = x, ctx
    for i in range(DEPTH):
        kind = i % N_MIXERS
        j = i // N_MIXERS
        last = i == DEPTH - 1
        mod_lat = jax.nn.silu(c) @ ada_w[i] + ada_b[i]
        mod_ctx = jax.nn.silu(c_ctx) @ ada_w[i] + ada_b[i]
        sh1, sc1, g1, sh2, sc2, g2 = jnp.split(mod_lat[:, None, :], 6, axis=-1)
        csh1, csc1, cg1, csh2, csc2, cg2 = jnp.split(mod_ctx, 6, axis=-1)
        h_lat = rmsnorm(x_lat, norm1_g[i]) * (1.0 + sc1) + sh1
        h_ctx = rmsnorm(x_ctx, norm1_g[i]) * (1.0 + csc1) + csh1
        if kind == 0:
            y_lat, y_ctx = attention_mixer(h_lat, h_ctx, attn_w_in[j], attn_q_gain[j], attn_k_gain[j],
                                           cos, sin, not last)
        elif kind == 1:
            y_lat = gmlp_mixer(h_lat, gmlp_w_in[j], gmlp_v_gain[j], gmlp_w_s[j], gmlp_b_s[j])
            y_ctx = None if last else gmlp_mixer(h_ctx, gmlp_w_in[j], gmlp_v_gain[j], gmlp_w_s[j], gmlp_b_s[j])
        else:
            hy = (hyena_w_in[j], hyena_conv_w[j], hyena_conv_b[j], hyena_f_w1[j], hyena_f_b1[j],
                  hyena_f_w2[j], hyena_f_b2[j], hyena_f_w3[j], hyena_f_b3[j], hyena_f_w4[j], hyena_f_b4[j],
                  hyena_freq[j], hyena_d[j])
            y_lat = hyena_mixer(h_lat, *hy)
            y_ctx = None if last else hyena_mixer(h_ctx, *hy)
        x_lat = x_lat + g1 * (y_lat @ mix_w_out[i])
        h2_lat = rmsnorm(x_lat, norm2_g[i]) * (1.0 + sc2) + sh2
        if last:
            out = moe(h2_lat.reshape(B * S, D), router_w[i], router_b[i], exp_w1[i], exp_b1[i], exp_w2[i], exp_b2[i])
            x_lat = x_lat + g2 * out.reshape(B, S, D)
        else:
            x_ctx = x_ctx + cg1 * (y_ctx @ mix_w_out[i])
            h2_ctx = rmsnorm(x_ctx, norm2_g[i]) * (1.0 + csc2) + csh2
            tokens = jnp.concatenate([h2_lat.reshape(B * S, D), h2_ctx.reshape(B * C, D)], axis=0)
            out = moe(tokens, router_w[i], router_b[i], exp_w1[i], exp_b1[i], exp_w2[i], exp_b2[i])
            x_lat = x_lat + g2 * out[:B * S].reshape(B, S, D)
            x_ctx = x_ctx + cg2 * out[B * S:].reshape(B, C, D)
    return rmsnorm(x_lat, final_g)
```

```cpp
#include <hip/hip_runtime.h>
#include <cstdio>
#include <cstdint>
#include <cmath>

#ifndef MK_MULTI
#define MK_MULTI 1
#endif
#ifndef MK_DBG
#define MK_DBG 0
#endif

constexpr int D = 1024, NB = 8, SEQ = 8192, CL = 256, ML = NB * SEQ, MC = NB * CL, MT = ML + MC;
constexpr int NLAYER = 4, NE = 32, TOPK = 4, SKV = SEQ + CL;
constexpr int MOE_MAXBLK = (MT * TOPK) / 256 + NE;
constexpr float EPS = 1e-6f;
constexpr int FH = 64, FEMB = 33, NFFT = 16384;

constexpr size_t MiB = 1u << 20;
constexpr size_t WS_CTL = 0, CTL_ZERO_BYTES = 1 * MiB;
constexpr size_t WS_MOD = 1 * MiB;
constexpr size_t WS_A3 = 2 * MiB;
constexpr size_t WS_A3C = 4 * MiB;
constexpr size_t WS_FCT = 5 * MiB;
constexpr size_t WS_WATT = 8 * MiB;
constexpr size_t WS_WGM = 14 * MiB;
constexpr size_t WS_WHY = 18 * MiB;
constexpr size_t WS_WOUT = 24 * MiB;
constexpr size_t WS_XC = 32 * MiB;
constexpr size_t WS_TE = 40 * MiB;
constexpr size_t WS_TR = 42 * MiB;
constexpr size_t WS_TG = 44 * MiB;
constexpr size_t WS_SS = 46 * MiB;
constexpr size_t WS_ROWTOK = 52 * MiB;
constexpr size_t WS_KF = 64 * MiB;
constexpr size_t WS_WE1 = 192 * MiB;
constexpr size_t WS_WE2 = 704 * MiB;
constexpr size_t WS_H = 960 * MiB;
constexpr size_t WS_P = 1092 * MiB;
constexpr size_t WS_Y = 1488 * MiB;
constexpr size_t WS_QB = 1620 * MiB;
constexpr size_t WS_KVB = 1752 * MiB;
constexpr size_t WS_X0 = 1818 * MiB;
constexpr size_t WS_VG = 1950 * MiB;
constexpr size_t WS_VT = 2082 * MiB;
constexpr size_t WS_VTC = 2338 * MiB;
constexpr size_t WS_ACT = 2346 * MiB;
constexpr size_t WS_YM = 2890 * MiB;
constexpr size_t WS_END = 3434 * MiB;
constexpr int CW_BAR = 4096;
constexpr int CW_CNT = 16384;
constexpr int CW_DBG = 32768;

constexpr int RING_BYTES = 131072;
constexpr int AUX_OFF = RING_BYTES;
constexpr int AUX_BYTES = 16384;
constexpr int MISC_OFF = AUX_OFF + AUX_BYTES;
constexpr int MISC_BYTES = 4096;
constexpr int LDS_BYTES = MISC_OFF + MISC_BYTES;

#define GAS __attribute__((address_space(1)))
#define LAS __attribute__((address_space(3)))
typedef unsigned short bf16;
typedef unsigned v4u __attribute__((ext_vector_type(4)));
typedef unsigned v2u __attribute__((ext_vector_type(2)));
typedef float f32x4 __attribute__((ext_vector_type(4)));
typedef float f32x2 __attribute__((ext_vector_type(2)));
typedef float f32x16 __attribute__((ext_vector_type(16)));
typedef short bf16x8 __attribute__((ext_vector_type(8)));
typedef short s16x4 __attribute__((ext_vector_type(4)));
typedef int i32x4 __attribute__((ext_vector_type(4)));
typedef GAS unsigned gu32;
#define RLX_AGENT __ATOMIC_RELAXED, __HIP_MEMORY_SCOPE_AGENT
#define LDS_WAIT() asm volatile("s_waitcnt lgkmcnt(0)" ::: "memory")
#define VM_WAIT() asm volatile("s_waitcnt vmcnt(0)" ::: "memory")
__device__ __forceinline__ unsigned f2bf(float f) { unsigned u = __builtin_bit_cast(unsigned, f); return (u + 0x7fffu + ((u >> 16) & 1u)) >> 16; }
__device__ __forceinline__ unsigned pk2(float lo, float hi) { return f2bf(lo) | (f2bf(hi) << 16); }
__device__ __forceinline__ float bf2f(unsigned short b) { return __builtin_bit_cast(float, ((unsigned)b) << 16); }
__device__ __forceinline__ float bflo(unsigned w) { return __builtin_bit_cast(float, w << 16); }
__device__ __forceinline__ float bfhi(unsigned w) { return __builtin_bit_cast(float, w & 0xffff0000u); }
__device__ __forceinline__ unsigned cvt_pk_bf16(float lo, float hi) { unsigned r; asm volatile("v_cvt_pk_bf16_f32 %0, %1, %2" : "=v"(r) : "v"(lo), "v"(hi)); return r; }
__device__ __forceinline__ int opaque_tid() { int t = (int)threadIdx.x; asm volatile("" : "+v"(t)); return t; }
__device__ __forceinline__ float wave_sum(float v) {
#pragma unroll
    for (int o = 1; o < 64; o <<= 1) v += __shfl_xor(v, o);
    return v;
}

#define XB_TMO      128
#define XB_XCNT(j)  (256  + 64 * (j))
#define XB_XSUB(j)  (1280 + 64 * (j))
#define XB_XGEN(j)  (2304 + 64 * (j))
#define XB_TOP      3328
#define XB_TOPGEN   3392
#define XCD_BAR_WORDS 3456
#define XB_SPIN_CAP (1u << 22)
__device__ __forceinline__ unsigned xb_ld(unsigned* p)              { return __hip_atomic_load(p, __ATOMIC_RELAXED, __HIP_MEMORY_SCOPE_AGENT); }
__device__ __forceinline__ unsigned xb_add(unsigned* p, unsigned v) { return __hip_atomic_fetch_add(p, v, __ATOMIC_RELAXED, __HIP_MEMORY_SCOPE_AGENT); }
__device__ __forceinline__ unsigned xb_xcc_id() { return (unsigned)__builtin_amdgcn_s_getreg((3 << 11) | 20) & 0xFu; }
#define XB_SPIN(cond, bar) do { unsigned _sp = 0; while (cond) { __builtin_amdgcn_s_sleep(1); \
    if ((++_sp & 255u) == 0u) { if (xb_ld(&(bar)[XB_TMO])) break; if (_sp > XB_SPIN_CAP) { atomicAdd(&(bar)[XB_TMO], 1u); break; } } } } while (0)
struct XcdBarrier { unsigned* bar; unsigned x; volatile LAS unsigned* st; };
__device__ __forceinline__ XcdBarrier xcd_barrier_post(unsigned* bar, volatile LAS unsigned* st) {
    XcdBarrier b; b.bar = bar; b.x = xb_xcc_id(); b.st = st;
    if (threadIdx.x == 0) (void)xb_add(&bar[XB_XCNT(b.x)], 1u);
    return b;
}
__device__ __forceinline__ void xcd_barrier_complete(unsigned* bar, unsigned x, unsigned& nloc, unsigned& nx) {
    const unsigned G = gridDim.x * gridDim.y * gridDim.z;
    unsigned sum, cnt, mine, sp = 0u;
    for (;;) {
        sum = 0u; cnt = 0u; mine = 0u;
#pragma unroll
        for (unsigned j = 0; j < 16; ++j) { const unsigned c = xb_ld(&bar[XB_XCNT(j)]); sum += c; cnt += (c > 0u) ? 1u : 0u; mine = (j == x) ? c : mine; }
        if (sum == G) break;
        __builtin_amdgcn_s_sleep(1);
        if ((++sp & 255u) == 0u) { if (xb_ld(&bar[XB_TMO])) break; if (sp > XB_SPIN_CAP) { atomicAdd(&bar[XB_TMO], 1u); break; } }
    }
    nloc = mine > 0u ? mine : 1u; nx = cnt > 0u ? cnt : 1u;
}
__device__ __forceinline__ void xcd_barrier(const XcdBarrier& b) {
    asm volatile("s_waitcnt vmcnt(0)" ::: "memory");
    __syncthreads();
    if (threadIdx.x == 0) {
        unsigned* bar = b.bar;
        __builtin_amdgcn_s_waitcnt(0);
        unsigned nloc = b.st[0], nx = b.st[1];
        if (nloc == 0u) { xcd_barrier_complete(bar, b.x, nloc, nx); b.st[0] = nloc; b.st[1] = nx; }
        const unsigned old = xb_add(&bar[XB_XSUB(b.x)], 1u);
        const unsigned gen = old / nloc;
        if (old + 1u == (gen + 1u) * nloc) {
            __builtin_amdgcn_fence(__ATOMIC_RELEASE, "agent");
            asm volatile("s_waitcnt vmcnt(0)" ::: "memory");
            const unsigned og = xb_add(&bar[XB_TOP], 1u);
            const unsigned tg = og / nx;
            if (og + 1u == (tg + 1u) * nx) xb_add(&bar[XB_TOPGEN], 1u);
            else XB_SPIN(xb_ld(&bar[XB_TOPGEN]) == tg, bar);
            __builtin_amdgcn_fence(__ATOMIC_ACQUIRE, "agent");
            xb_add(&bar[XB_XGEN(b.x)], 1u);
            asm volatile("s_waitcnt vmcnt(0)" ::: "memory");
        } else {
            XB_SPIN(xb_ld(&bar[XB_XGEN(b.x)]) == gen, bar);
            __builtin_amdgcn_fence(__ATOMIC_ACQUIRE, "agent");
            asm volatile("s_waitcnt vmcnt(0)" ::: "memory");
        }
    }
    __syncthreads();
}

namespace pg8 {
constexpr int BM = 256, BK = 64, HALF = 128, HTB = HALF * BK * 2, STAGE_BYTES = 8 * HTB, NXCD = 8, WGM = 8;
constexpr int GK = 1024;
__device__ __forceinline__ int lds_byte(int r, int c) { const int st = (r >> 4) * 2 + (c >> 5), rr = r & 15, cc = c & 31, ob = rr * 64 + cc * 2; return st * 1024 + (ob ^ (((ob >> 9) & 1) << 5)); }
__device__ __forceinline__ void stage_rc(int b, int& R, int& C) { const int st = b / 1024, sb = b % 1024, swz = sb ^ (((sb >> 9) & 1) << 5); R = (st >> 1) * 16 + swz / 64; C = (st & 1) * 32 + (swz % 64) / 2; }
__device__ __forceinline__ int perm32(int rho) { const int n = rho >> 4, i = rho & 15; return 8 * (i >> 2) + 4 * n + (i & 3); }
struct Unit { int pm, pn, e; };

struct DenseSched {
    const char* A; const char* Bt; int nM, nN, nwg, G, c;
    __device__ __forceinline__ void init(const void* A_, const void* Bt_, int M, int N, int G_, int c_) { A = (const char*)A_; Bt = (const char*)Bt_; nM = M / BM; nN = N / BM; nwg = nM * nN; G = G_; c = c_; }
    __device__ __forceinline__ bool next(int i, Unit& u) const {
        const long L = (long)i * G + c; if (L >= nwg) return false;
        int wgid = (int)L; { const int q = nwg / NXCD, r = nwg % NXCD, xcd = wgid % NXCD, off = wgid / NXCD; wgid = (xcd < r ? xcd * (q + 1) : r * (q + 1) + (xcd - r) * q) + off; }
        const int nig = WGM * nN, gid = wgid / nig, fm = gid * WGM, gsz = (nM - fm) < WGM ? (nM - fm) : WGM;
        u.pm = fm + ((wgid % nig) % gsz); u.pn = (wgid % nig) / gsz; u.e = 0; return true;
    }
    __device__ __forceinline__ const char* a_ptr(const Unit& u) const { return A + (size_t)u.pm * (BM * GK * 2); }
    __device__ __forceinline__ const char* b_ptr(const Unit& u) const { return Bt + (size_t)u.pn * (BM * GK * 2); }
    __device__ __forceinline__ void a_offs(const Unit&, const int (&)[2], const int (&)[2], unsigned (&)[2][2]) const {}
};
struct MoeSched {
    const char* A; const char* Bt; size_t b_estride; const int* rowtok; const volatile LAS int* cumblk; const volatile LAS int* cnt; int ncol_log2, G, c;
    __device__ __forceinline__ bool next(int i, Unit& u) const {
        int gb, pn; const int ncol = 1 << ncol_log2;
        if (G == 256) { const int xcd = c & 7, j = c >> 3, rpb = 256 >> ncol_log2; gb = i * rpb + xcd + 8 * (j >> ncol_log2); pn = j & (ncol - 1); }
        else { const long L = (long)i * G + c; gb = (int)(L >> ncol_log2); pn = (int)(L & (ncol - 1)); }
        const int tot = cumblk[NE]; if (gb >= tot) return false;
        int e = 0;
#pragma unroll 1
        for (int s = 16; s >= 1; s >>= 1) { if (cumblk[e + s] <= gb) e += s; }
        u.pm = gb; u.pn = pn; u.e = e; return true;
    }
    __device__ __forceinline__ const char* a_ptr(const Unit& u) const { return rowtok ? A : A + (size_t)u.pm * (BM * GK * 2); }
    __device__ __forceinline__ const char* b_ptr(const Unit& u) const { return Bt + (size_t)u.e * b_estride + (size_t)u.pn * (BM * GK * 2); }
    __device__ __forceinline__ void a_offs(const Unit& u, const int (&R)[2], const int (&C)[2], unsigned (&voff)[2][2]) const {
        const int rb = u.pm - cumblk[u.e], n = cnt[u.e]; const int* rt = rowtok + (size_t)u.e * MT;
#pragma unroll
        for (int h = 0; h < 2; ++h)
#pragma unroll
            for (int i = 0; i < 2; ++i) { const int rank = rb * 256 + h * HALF + R[i]; const int tok = rank < n ? rt[rank] : 0; voff[h][i] = (unsigned)tok * (unsigned)(GK * 2) + (unsigned)C[i] * 2u; }
    }
};

template <class Epi, class Sched, bool GATHER>
__device__ __forceinline__ void gemm_phase(LAS unsigned char* lds, const Sched& S, const Epi& E) {
    const int tid = opaque_tid(), wid = __builtin_amdgcn_readfirstlane(tid >> 6), lane = tid & 63, wr = wid >> 2, wc = wid & 3, fr = lane & 15, fq = lane >> 4;
    constexpr int K = GK, nt = K / BK;
    unsigned voffA[2][2], voffB[2]; int Rr[2], Cc[2];
#pragma unroll
    for (int i = 0; i < 2; ++i) { int R, C; stage_rc(tid * 16 + i * 8192, R, C); Rr[i] = R; Cc[i] = C; const int Rb = Epi::PERM ? ((R & ~31) + perm32(R & 31)) : R;
        voffA[0][i] = (unsigned)(R * K + C) * 2u; voffA[1][i] = (unsigned)((R + HALF) * K + C) * 2u; voffB[i] = (unsigned)(Rb * K + C) * 2u; }
    constexpr size_t kstep = (size_t)(BK * 2);
    constexpr size_t hstep = (size_t)HALF * K * 2;
    const unsigned ldsw = (unsigned)wid * 1024u;
    const int aoff = lds_byte(wr * 64 + fr, fq * 8), boff = lds_byte(wc * 32 + fr, fq * 8);
#define PG8_SA(b, h) (((b) * 2 + (h)) * HTB)
#define PG8_SB(b, h) ((4 + (b) * 2 + (h)) * HTB)
#define PG8_STAGE(bufoff, gbase, voff) do { _Pragma("unroll") for (int _i = 0; _i < 2; ++_i) \
        __builtin_amdgcn_global_load_lds((const unsigned*)((const char*)(gbase) + (voff)[_i]), (LAS unsigned*)(lds + (bufoff) + ldsw + _i * 8192), 16, 0, 0); } while (0)
#define PG8_STAGE_A(bufoff, gbase, h) PG8_STAGE(bufoff, gbase, voffA[h])
#define PG8_LDA(dst, b, h) do { _Pragma("unroll") for (int m = 0; m < 4; ++m) _Pragma("unroll") for (int k = 0; k < 2; ++k) dst[m][k] = *(const LAS bf16x8*)(lds + PG8_SA(b, h) + aoff + m * 2048 + k * 1024); } while (0)
#define PG8_LDB(dst, b, h) do { _Pragma("unroll") for (int n = 0; n < 2; ++n) _Pragma("unroll") for (int k = 0; k < 2; ++k) dst[n][k] = *(const LAS bf16x8*)(lds + PG8_SB(b, h) + boff + n * 2048 + k * 1024); } while (0)
#define PG8_MMA(ai, bj, At, Bt) do { __builtin_amdgcn_s_setprio(1); _Pragma("unroll") for (int m = 0; m < 4; ++m) _Pragma("unroll") for (int n = 0; n < 2; ++n) _Pragma("unroll") for (int k = 0; k < 2; ++k) \
        acc[ai][bj][m][n] = __builtin_amdgcn_mfma_f32_16x16x32_bf16(Bt[n][k], At[m][k], acc[ai][bj][m][n], 0, 0, 0); __builtin_amdgcn_s_setprio(0); } while (0)
#define PG8_WAIT_V(n) asm volatile("s_waitcnt vmcnt(" #n ")" ::: "memory")
#define PG8_WAIT_L(n) asm volatile("s_waitcnt lgkmcnt(" #n ")" ::: "memory")
#define PG8_BAR __builtin_amdgcn_s_barrier()
#define PG8_SCHED __builtin_amdgcn_sched_barrier(0)
    Unit cur, nxt; int ui = 0;
    if (!S.next(0, cur)) return;
    f32x4 acc[2][2][4][2];
#pragma unroll
    for (int a = 0; a < 2; ++a)
#pragma unroll
        for (int b = 0; b < 2; ++b)
#pragma unroll
            for (int m = 0; m < 4; ++m)
#pragma unroll
                for (int n = 0; n < 2; ++n) acc[a][b][m][n] = (f32x4){0.f, 0.f, 0.f, 0.f};
    bf16x8 At[4][2], B0[2][2], B1[2][2];
    const char* cA = S.a_ptr(cur); const char* cB = S.b_ptr(cur);
    if constexpr (GATHER) S.a_offs(cur, Rr, Cc, voffA);
    PG8_STAGE(PG8_SB(0, 0), cB, voffB); PG8_STAGE(PG8_SB(0, 1), cB + hstep, voffB); PG8_STAGE_A(PG8_SA(0, 0), cA, 0); PG8_STAGE_A(PG8_SA(0, 1), cA, 1);
    if (wr == 1) PG8_BAR;
    PG8_WAIT_V(2); PG8_BAR;
    PG8_STAGE(PG8_SB(1, 0), cB + kstep, voffB); PG8_STAGE_A(PG8_SA(1, 0), cA + kstep, 0); PG8_STAGE(PG8_SB(1, 1), cB + hstep + kstep, voffB);
    PG8_WAIT_V(6); PG8_BAR;
    for (;;) {
        const bool has_next = S.next(ui + 1, nxt);
        const char* nA = has_next ? S.a_ptr(nxt) : cA; const char* nB = has_next ? S.b_ptr(nxt) : cB;
        for (int t = 0; t < nt; t += 2) {
            const bool last = (t == nt - 2);
            const char* a1 = cA + (size_t)(t + 1) * kstep;
            const char* a2 = last ? nA : cA + (size_t)(t + 2) * kstep; const char* b2 = last ? nB : cB + (size_t)(t + 2) * kstep;
            const char* a3 = a2 + kstep; const char* b3 = b2 + kstep;
            PG8_LDB(B0, 0, 0); PG8_LDB(B1, 0, 1); PG8_SCHED; PG8_LDA(At, 0, 0); PG8_STAGE_A(PG8_SA(1, 1), a1, 1);
            if constexpr (GATHER) { if (last && has_next) S.a_offs(nxt, Rr, Cc, voffA); }
            PG8_WAIT_V(8); PG8_WAIT_L(0); PG8_BAR; PG8_MMA(0, 0, At, B0); PG8_MMA(0, 1, At, B1); PG8_BAR; PG8_SCHED;
            PG8_LDA(At, 0, 1); PG8_STAGE(PG8_SB(0, 0), b2, voffB); PG8_STAGE(PG8_SB(0, 1), b2 + hstep, voffB); PG8_STAGE_A(PG8_SA(0, 0), a2, 0);
            PG8_WAIT_V(8); PG8_WAIT_L(0); PG8_BAR; PG8_MMA(1, 0, At, B0); PG8_MMA(1, 1, At, B1); PG8_BAR; PG8_SCHED;
            PG8_LDB(B0, 1, 0); PG8_LDB(B1, 1, 1); PG8_SCHED; PG8_LDA(At, 1, 0); PG8_STAGE_A(PG8_SA(0, 1), a2, 1);
            PG8_WAIT_V(8); PG8_WAIT_L(0); PG8_BAR; PG8_MMA(0, 0, At, B0); PG8_MMA(0, 1, At, B1); PG8_BAR; PG8_SCHED;
            PG8_LDA(At, 1, 1); PG8_STAGE(PG8_SB(1, 0), b3, voffB); PG8_STAGE(PG8_SB(1, 1), b3 + hstep, voffB); PG8_STAGE_A(PG8_SA(1, 0), a3, 0);
            PG8_WAIT_V(8); PG8_WAIT_L(0); PG8_BAR; PG8_MMA(1, 0, At, B0); PG8_MMA(1, 1, At, B1); PG8_BAR; PG8_SCHED;
        }
        if (wr == 0) PG8_BAR;
        E(acc, cur, wr, wc, fr, fq);
        if (!has_next) break;
#pragma unroll
        for (int a = 0; a < 2; ++a)
#pragma unroll
            for (int b = 0; b < 2; ++b)
#pragma unroll
                for (int m = 0; m < 4; ++m)
#pragma unroll
                    for (int n = 0; n < 2; ++n) acc[a][b][m][n] = (f32x4){0.f, 0.f, 0.f, 0.f};
        cur = nxt; cA = nA; cB = nB; ++ui;
        if (wr == 1) PG8_BAR;
    }
    PG8_WAIT_V(0);
    PG8_BAR;
#undef PG8_SA
#undef PG8_SB
#undef PG8_STAGE
#undef PG8_STAGE_A
#undef PG8_LDA
#undef PG8_LDB
#undef PG8_MMA
#undef PG8_WAIT_V
#undef PG8_WAIT_L
#undef PG8_BAR
#undef PG8_SCHED
}
}
namespace pg8 {
__device__ __forceinline__ f32x2 gelu_pk(f32x2 v) {
    const f32x2 av = __builtin_elementwise_abs(v), d = av * 0.2316418882f + 1.0f;
    f32x2 t; t.x = __builtin_amdgcn_rcpf(d.x); t.y = __builtin_amdgcn_rcpf(d.y);
    f32x2 q = t * 0.5307027145f + (-0.7265760135f); q = q * t + 0.7107068705f; q = q * t + (-0.142248368f); q = q * t + 0.127414796f; q = q * t;
    const f32x2 s = (v * v) * (-0.72134752044f);
    f32x2 e; e.x = __builtin_amdgcn_exp2f(s.x); e.y = __builtin_amdgcn_exp2f(s.y);
    const f32x2 m = v * (q * e), r = v - m;
    f32x2 o; o.x = v.x < 0.f ? m.x : r.x; o.y = v.y < 0.f ? m.y : r.y; return o;
}
struct EpiBf16 {
    static constexpr bool PERM = true;
    bf16* O; int ldc; float* ss; int ACT;
    __device__ __forceinline__ void operator()(const f32x4 (&acc)[2][2][4][2], const Unit& u, int wr, int wc, int fr, int fq) const {
        const int row0 = u.pm * BM + wr * 64 + fr, col0 = u.pn * BM + wc * 32 + 8 * fq;
#pragma unroll
        for (int ai = 0; ai < 2; ++ai)
#pragma unroll
            for (int m = 0; m < 4; ++m) { const int row = row0 + ai * HALF + m * 16; bf16* rowp = O + (size_t)row * ldc + col0; float sq = 0.f;
#pragma unroll
                for (int bj = 0; bj < 2; ++bj) { f32x4 v0 = acc[ai][bj][m][0], v1 = acc[ai][bj][m][1];
                    if (ACT == 1) { f32x2 a = gelu_pk((f32x2){v0[0], v0[1]}), b = gelu_pk((f32x2){v0[2], v0[3]}), c = gelu_pk((f32x2){v1[0], v1[1]}), d = gelu_pk((f32x2){v1[2], v1[3]});
                        v0 = (f32x4){a.x, a.y, b.x, b.y}; v1 = (f32x4){c.x, c.y, d.x, d.y};
                        sq += (v0[0] * v0[0] + v0[1] * v0[1]) + (v0[2] * v0[2] + v0[3] * v0[3]) + (v1[0] * v1[0] + v1[1] * v1[1]) + (v1[2] * v1[2] + v1[3] * v1[3]); }
                    v4u w; w.x = cvt_pk_bf16(v0[0], v0[1]); w.y = cvt_pk_bf16(v0[2], v0[3]); w.z = cvt_pk_bf16(v1[0], v1[1]); w.w = cvt_pk_bf16(v1[2], v1[3]);
                    *(v4u*)(rowp + bj * HALF) = w; }
                if (ACT == 1) { sq += __shfl_xor(sq, 16); sq += __shfl_xor(sq, 32);
                    if (u.pn >= 4 && fq == 0) ss[(size_t)row * 16 + (u.pn - 4) * 4 + wc] = sq; }
            }
    }
};
struct EpiResid {
    static constexpr bool PERM = false;
    const float* baseL; const float* baseC; float* outL; float* outC; const float* modl;
    __device__ __forceinline__ void operator()(const f32x4 (&acc)[2][2][4][2], const Unit& u, int wr, int wc, int fr, int fq) const {
        const bool lat = u.pm < ML / BM; const int rb = lat ? u.pm : u.pm - ML / BM, bidx = lat ? (u.pm >> 5) : 8;
        const float* base = (lat ? baseL : baseC) + (size_t)rb * BM * D; float* out = (lat ? outL : outC) + (size_t)rb * BM * D;
        const float* g = modl + bidx * 6144 + 2 * 1024;
        const int r0 = wr * 64 + fr, col0 = u.pn * BM + wc * 32 + 4 * fq;
        f32x4 gv[2][2];
#pragma unroll
        for (int bj = 0; bj < 2; ++bj)
#pragma unroll
            for (int n = 0; n < 2; ++n) gv[bj][n] = *(const f32x4*)(g + col0 + bj * HALF + n * 16);
#pragma unroll
        for (int ai = 0; ai < 2; ++ai)
#pragma unroll
            for (int m = 0; m < 4; ++m) { const size_t off = (size_t)(r0 + ai * HALF + m * 16) * D + col0;
#pragma unroll
                for (int bj = 0; bj < 2; ++bj)
#pragma unroll
                    for (int n = 0; n < 2; ++n) { const f32x4 bs = *(const f32x4*)(base + off + bj * HALF + n * 16); *(f32x4*)(out + off + bj * HALF + n * 16) = bs + gv[bj][n] * acc[ai][bj][m][n]; }
                asm volatile("" ::: "memory"); }
    }
};
struct EpiSwiglu {
    static constexpr bool PERM = true;
    bf16* O; const float* b1;
    __device__ __forceinline__ void operator()(const f32x4 (&acc)[2][2][4][2], const Unit& u, int wr, int wc, int fr, int fq) const {
        const int row0 = u.pm * BM + wr * 64 + fr, c0 = u.pn * HALF + wc * 32 + 8 * fq; const float* be = b1 + (size_t)u.e * 2048;
        f32x4 bg[2], bl[2];
#pragma unroll
        for (int n = 0; n < 2; ++n) { bg[n] = *(const f32x4*)(be + c0 + 4 * n); bl[n] = *(const f32x4*)(be + 1024 + c0 + 4 * n); }
#pragma unroll
        for (int ai = 0; ai < 2; ++ai)
#pragma unroll
            for (int m = 0; m < 4; ++m) { float o[8];
#pragma unroll
                for (int n = 0; n < 2; ++n)
#pragma unroll
                    for (int j = 0; j < 4; ++j) { float gl = acc[ai][0][m][n][j] + bg[n][j], li = acc[ai][1][m][n][j] + bl[n][j];
                        gl = fminf(gl, 7.0f); li = fminf(fmaxf(li, -7.0f), 7.0f);
                        const float sg = __builtin_amdgcn_rcpf(1.0f + __builtin_amdgcn_exp2f(gl * (-1.702f * 1.4426950408889634f)));
                        o[n * 4 + j] = gl * sg * (li + 1.0f); }
                v4u w; w.x = cvt_pk_bf16(o[0], o[1]); w.y = cvt_pk_bf16(o[2], o[3]); w.z = cvt_pk_bf16(o[4], o[5]); w.w = cvt_pk_bf16(o[6], o[7]);
                *(v4u*)(O + (size_t)(row0 + ai * HALF + m * 16) * D + c0) = w; }
    }
};
struct EpiBias {
    static constexpr bool PERM = true;
    bf16* O; const float* b2;
    __device__ __forceinline__ void operator()(const f32x4 (&acc)[2][2][4][2], const Unit& u, int wr, int wc, int fr, int fq) const {
        const int row0 = u.pm * BM + wr * 64 + fr, col0 = u.pn * BM + wc * 32 + 8 * fq; const float* be = b2 + (size_t)u.e * 1024;
        f32x4 bv[2][2];
#pragma unroll
        for (int bj = 0; bj < 2; ++bj)
#pragma unroll
            for (int n = 0; n < 2; ++n) bv[bj][n] = *(const f32x4*)(be + col0 + bj * HALF + 4 * n);
#pragma unroll
        for (int ai = 0; ai < 2; ++ai)
#pragma unroll
            for (int m = 0; m < 4; ++m) { bf16* rowp = O + (size_t)(row0 + ai * HALF + m * 16) * D + col0;
#pragma unroll
                for (int bj = 0; bj < 2; ++bj) { const f32x4 v0 = acc[ai][bj][m][0] + bv[bj][0], v1 = acc[ai][bj][m][1] + bv[bj][1];
                    v4u w; w.x = cvt_pk_bf16(v0[0], v0[1]); w.y = cvt_pk_bf16(v0[2], v0[3]); w.z = cvt_pk_bf16(v1[0], v1[1]); w.w = cvt_pk_bf16(v1[2], v1[3]);
                    *(v4u*)(rowp + bj * HALF) = w; } }
    }
};
}

namespace att {
constexpr int AD = 128, NW = 8, QBLK = 32, KVBLK = 64;
constexpr float SCALE = 0.088388347648318440f;
constexpr float THR = 8.f;
constexpr int LDQ = 1024, LDK = 512, LDO = 1024;
constexpr int SHM_V = KVBLK * AD * 2, SHM_K = KVBLK * AD * 2, SHM_ATTN = 2 * SHM_V + 2 * SHM_K + NW * 64 * 4;
#define KSWZ(row, colB) ((row) * 256 + ((colB) ^ (((row) & 7) << 4)))
#define SBAR() __builtin_amdgcn_sched_barrier(0)
__device__ __forceinline__ int crow(int r, int hi) { return (r & 3) + 8 * (r >> 2) + 4 * hi; }
__device__ __forceinline__ void partialSM(f32x16& p0, f32x16& p1, float& m_reg, float& mn, float& alpha) {
  constexpr float C = SCALE * 1.4426950408889634f;
  float pmax = p0[0]; for (int r = 1; r < 16; ++r) pmax = fmaxf(pmax, p0[r]); for (int r = 0; r < 16; ++r) pmax = fmaxf(pmax, p1[r]);
  { auto rr = __builtin_amdgcn_permlane32_swap(__float_as_uint(pmax), __float_as_uint(pmax), false, false);
    pmax = fmaxf(__uint_as_float(rr[0]), __uint_as_float(rr[1])); }
  if (__builtin_expect(__all(pmax - m_reg <= THR / SCALE), 1)) { mn = m_reg; alpha = 1.f; }
  else { mn = fmaxf(m_reg, pmax); alpha = __builtin_amdgcn_exp2f((m_reg - mn) * C); m_reg = mn; }
  float mnC = -mn * C;
  for (int r = 0; r < 16; ++r) p0[r] = fmaf(p0[r], C, mnC); for (int r = 0; r < 16; ++r) p1[r] = fmaf(p1[r], C, mnC);
  for (int r = 0; r < 16; ++r) p0[r] = __builtin_amdgcn_exp2f(p0[r]);
}
__device__ __forceinline__ void finishSM(f32x16& p0, f32x16& p1, float alpha, float& l_reg, bf16x8& pa0, bf16x8& pa1, bf16x8& pa2, bf16x8& pa3) {
  for (int r = 0; r < 16; ++r) p1[r] = __builtin_amdgcn_exp2f(p1[r]);
  float ps = 0; for (int r = 0; r < 16; ++r) ps += p0[r]; for (int r = 0; r < 16; ++r) ps += p1[r];
  { auto rr = __builtin_amdgcn_permlane32_swap(__float_as_uint(ps), __float_as_uint(ps), false, false);
    ps = __uint_as_float(rr[0]) + __uint_as_float(rr[1]); }
  l_reg = l_reg * alpha + ps;
#define PK4(P, BASE, OUT) do { unsigned a0 = cvt_pk_bf16(P[BASE + 0], P[BASE + 1]), a1 = cvt_pk_bf16(P[BASE + 2], P[BASE + 3]);   \
    unsigned b0 = cvt_pk_bf16(P[BASE + 4], P[BASE + 5]), b1 = cvt_pk_bf16(P[BASE + 6], P[BASE + 7]);                              \
    auto r0 = __builtin_amdgcn_permlane32_swap(a0, b0, false, false); auto r1 = __builtin_amdgcn_permlane32_swap(a1, b1, false, false); \
    v4u w = {r0[0], r1[0], r0[1], r1[1]}; OUT = *reinterpret_cast<bf16x8*>(&w); } while (0)
  PK4(p0, 0, pa0); PK4(p0, 8, pa1); PK4(p1, 0, pa2); PK4(p1, 8, pa3);
#undef PK4
}
__device__ __forceinline__ void qkt(f32x16& p0, f32x16& p1, const bf16* Ks, const bf16x8* qr, int r32, int hi) {
  p0 = f32x16{}; p1 = f32x16{};
  for (int d0 = 0; d0 < 8; ++d0) { int cb = (d0 * 16 + hi * 8) * 2;
    bf16x8 b0 = *reinterpret_cast<const bf16x8*>((const char*)Ks + KSWZ(r32, cb));
    bf16x8 b1 = *reinterpret_cast<const bf16x8*>((const char*)Ks + KSWZ(32 + r32, cb));
    p0 = __builtin_amdgcn_mfma_f32_32x32x16_bf16(b0, qr[d0], p0, 0, 0, 0);
    p1 = __builtin_amdgcn_mfma_f32_32x32x16_bf16(b1, qr[d0], p1, 0, 0, 0); }
}
__device__ __forceinline__ int v_st(int k, int c) { const int kk = (k & ~0xC) | ((k & 4) << 1) | ((k & 8) >> 1); return ((kk >> 3) * 4 + (c >> 5)) * 512 + ((kk & 7) * 32 + (c & 31)) * 2; }
__device__ __forceinline__ int v_rd_base(int lane) { return ((lane & 3) << 3) | (((lane >> 2) & 3) << 6) | (((lane >> 4) & 1) << 5) | (((lane >> 5) & 1) << 8); }
constexpr int v_rd_off(int d0, int ks, int half) { return d0 * 512 + ks * 4096 + half * 2048; }
template <int OFF> __device__ __forceinline__ s16x4 tr_read(int vb) {
  s16x4 r; asm volatile("ds_read_b64_tr_b16 %0, %1 offset:%2" : "=&v"(r) : "v"(vb), "i"(OFF) : "memory"); return r;
}
template <int D0> __device__ __forceinline__ void pv_one(f32x16& od, int vb, bf16x8 pa0, bf16x8 pa1, bf16x8 pa2, bf16x8 pa3) {
  const s16x4 l0 = tr_read<v_rd_off(D0, 0, 0)>(vb), h0 = tr_read<v_rd_off(D0, 0, 1)>(vb), l1 = tr_read<v_rd_off(D0, 1, 0)>(vb), h1 = tr_read<v_rd_off(D0, 1, 1)>(vb);
  const s16x4 l2 = tr_read<v_rd_off(D0, 2, 0)>(vb), h2 = tr_read<v_rd_off(D0, 2, 1)>(vb), l3 = tr_read<v_rd_off(D0, 3, 0)>(vb), h3 = tr_read<v_rd_off(D0, 3, 1)>(vb);
  asm volatile("s_waitcnt lgkmcnt(0)" ::: "memory"); SBAR();
#define PK(L, H) (bf16x8){L[0], L[1], L[2], L[3], H[0], H[1], H[2], H[3]}
  od = __builtin_amdgcn_mfma_f32_32x32x16_bf16(pa0, PK(l0, h0), od, 0, 0, 0);
  od = __builtin_amdgcn_mfma_f32_32x32x16_bf16(pa1, PK(l1, h1), od, 0, 0, 0);
  od = __builtin_amdgcn_mfma_f32_32x32x16_bf16(pa2, PK(l2, h2), od, 0, 0, 0);
  od = __builtin_amdgcn_mfma_f32_32x32x16_bf16(pa3, PK(l3, h3), od, 0, 0, 0);
#undef PK
}
__device__ __forceinline__ void pv_d0(f32x16* o, int vb, bf16x8 pa0, bf16x8 pa1, bf16x8 pa2, bf16x8 pa3) {
  pv_one<0>(o[0], vb, pa0, pa1, pa2, pa3); pv_one<1>(o[1], vb, pa0, pa1, pa2, pa3); pv_one<2>(o[2], vb, pa0, pa1, pa2, pa3); pv_one<3>(o[3], vb, pa0, pa1, pa2, pa3);
}
__device__ __forceinline__ void attn_dense_body(const bf16* __restrict__ Qb, const bf16* __restrict__ Kh, const bf16* __restrict__ Vh, bf16* __restrict__ Ob, int seq, char* lds) {
  const int tid = opaque_tid(), wid = tid >> 6, lane = tid & 63, r32 = lane & 31, hi = lane >> 5;
  bf16* V_lds = (bf16*)lds; bf16* K_lds = (bf16*)(lds + 2 * SHM_V);
  float* ws = (float*)(lds + 2 * SHM_V + 2 * SHM_K) + wid * 64; float* li_l = ws; float* al_l = ws + 32;
  float m_reg = -1e30f, l_reg = 0; f32x16 o[4] = {}; bf16x8 qr[8];
  const bf16* Qw = Qb + (long)(wid * QBLK + r32) * LDQ + hi * 8;
#pragma unroll
  for (int d0 = 0; d0 < 8; ++d0) qr[d0] = *reinterpret_cast<const bf16x8*>(Qw + d0 * 16);
  const int sr = tid >> 4, sc = (tid & 15) * 8, vst0 = v_st(sr, sc), vst1 = v_st(32 + sr, sc);
  const int vb0 = (int)(uintptr_t)V_lds + v_rd_base(lane);
  struct { bf16x8 vs0, vs1, ks0, ks1; } sr_[2];
#define SLOAD(i, k0) do { sr_[i].vs0 = *reinterpret_cast<const bf16x8*>(&Vh[(long)((k0) + sr) * LDK + sc]); sr_[i].vs1 = *reinterpret_cast<const bf16x8*>(&Vh[(long)((k0) + 32 + sr) * LDK + sc]); \
    sr_[i].ks0 = *reinterpret_cast<const bf16x8*>(&Kh[(long)((k0) + sr) * LDK + sc]); sr_[i].ks1 = *reinterpret_cast<const bf16x8*>(&Kh[(long)((k0) + 32 + sr) * LDK + sc]); } while (0)
#define SWRITE(b, i) do { *(bf16x8*)((char*)V_lds + (b) * SHM_V + vst0) = sr_[i].vs0;          \
    *(bf16x8*)((char*)V_lds + (b) * SHM_V + vst1) = sr_[i].vs1; int kc = sc * 2;               \
    *(bf16x8*)((char*)K_lds + (b) * SHM_K + KSWZ(sr, kc)) = sr_[i].ks0;                       \
    *(bf16x8*)((char*)K_lds + (b) * SHM_K + KSWZ(32 + sr, kc)) = sr_[i].ks1; } while (0)
#define SWAIT() asm volatile("s_waitcnt vmcnt(4)" ::: "memory")
#define RESC(a) do { if (__any((a) < 1.f)) { if (hi == 0) al_l[r32] = (a); asm volatile("s_waitcnt lgkmcnt(0)" ::: "memory"); \
    for (int d = 0; d < 4; ++d) for (int r = 0; r < 16; ++r) o[d][r] *= al_l[crow(r, hi)]; } } while (0)
  f32x16 pA0, pA1, pB0, pB1; float mnA, mnB, alA, alB; bf16x8 pa0, pa1, pa2, pa3; const int NT = seq / KVBLK;
  constexpr int SE = 0, SO = 1;
  SLOAD(SE, 0); asm volatile("s_waitcnt vmcnt(0)" ::: "memory"); SWRITE(0, SE); __syncthreads();
  qkt(pA0, pA1, K_lds, qr, r32, hi); partialSM(pA0, pA1, m_reg, mnA, alA);
  SLOAD(SO, KVBLK); if (2 < NT) SLOAD(SE, 2 * KVBLK);
  SWAIT(); SWRITE(1, SO); __syncthreads();
  for (int j = 1; j + 1 < NT; j += 2) {
    SBAR(); qkt(pB0, pB1, (bf16*)((char*)K_lds + SHM_K), qr, r32, hi);
    finishSM(pA0, pA1, alA, l_reg, pa0, pa1, pa2, pa3); SBAR();
    SLOAD(SO, (j + 2) * KVBLK); SBAR();
    pv_d0(o, vb0, pa0, pa1, pa2, pa3); partialSM(pB0, pB1, m_reg, mnB, alB);
    __syncthreads(); SWAIT(); SWRITE(0, SE);
    RESC(alB); __syncthreads();
    SBAR(); qkt(pA0, pA1, K_lds, qr, r32, hi);
    finishSM(pB0, pB1, alB, l_reg, pa0, pa1, pa2, pa3); SBAR();
    if (j + 3 < NT) SLOAD(SE, (j + 3) * KVBLK); SBAR();
    pv_d0(o, vb0 + (int)SHM_V, pa0, pa1, pa2, pa3); partialSM(pA0, pA1, m_reg, mnA, alA);
    __syncthreads(); SWAIT(); SWRITE(1, SO);
    RESC(alA); __syncthreads();
  }
  SBAR(); qkt(pB0, pB1, (bf16*)((char*)K_lds + SHM_K), qr, r32, hi);
  finishSM(pA0, pA1, alA, l_reg, pa0, pa1, pa2, pa3); SBAR();
  pv_d0(o, vb0, pa0, pa1, pa2, pa3); partialSM(pB0, pB1, m_reg, mnB, alB);
  __syncthreads(); RESC(alB);
  finishSM(pB0, pB1, alB, l_reg, pa0, pa1, pa2, pa3); SBAR();
  pv_d0(o, vb0 + (int)SHM_V, pa0, pa1, pa2, pa3);
  if (hi == 0) li_l[r32] = l_reg; asm volatile("s_waitcnt lgkmcnt(0)" ::: "memory");
  float rli[16];
#pragma unroll
  for (int r = 0; r < 16; ++r) rli[r] = __builtin_amdgcn_rcpf(li_l[crow(r, hi)]);
  bf16* Ow = Ob + (long)(wid * QBLK) * LDO;
#pragma unroll
  for (int r = 0; r < 16; ++r) { int orow = crow(r, hi);
    for (int d0 = 0; d0 < 4; ++d0) Ow[(long)orow * LDO + d0 * 32 + r32] = (bf16)f2bf(o[d0][r] * rli[r]); }
  __syncthreads();
#undef SLOAD
#undef SWRITE
#undef SWAIT
#undef RESC
}
#undef KSWZ
}
constexpr int NWAVES = 8, NTHREADS = 512;
struct Args { const float* in[36]; float* out; unsigned char* ws; int ph_lo, ph_hi; };
enum InIdx { I_X = 0, I_C, I_CTX, I_CCTX, I_ADAW, I_ADAB, I_N1G, I_N2G, I_WOUT, I_RW, I_RB, I_EW1, I_EB1, I_EW2, I_EB2, I_AWIN, I_AQG, I_AKG,
             I_GWIN, I_GVG, I_GWS, I_GBS, I_HWIN, I_HCW, I_HCB, I_FW1, I_FB1, I_FW2, I_FB2, I_FW3, I_FB3, I_FW4, I_FB4, I_FREQ, I_HD, I_FG };
struct Frame {
    LAS unsigned char* lds; volatile LAS unsigned* MISC; gu32* ctl;
    int tid, lane, wave, G, bx;
    float* out; unsigned char* ws;
};
template <class T> __device__ __forceinline__ T* launder(T* p) { unsigned long long v = (unsigned long long)p; asm volatile("" : "+s"(v)); return (T*)v; }
constexpr int MW_PTRS = 640;
__device__ __forceinline__ const float* pin_load(const Frame& F, int i) {
    const unsigned lo = __builtin_amdgcn_readfirstlane(F.MISC[MW_PTRS + 2 * i]), hi = __builtin_amdgcn_readfirstlane(F.MISC[MW_PTRS + 2 * i + 1]);
    return (const float*)(((unsigned long long)hi << 32) | lo);
}
#define PIN(F, i) pin_load(F, i)
__device__ __forceinline__ Frame phase_frame(const Frame& F0) {
    Frame F = F0; F.tid = opaque_tid(); F.lane = F.tid & 63; F.wave = __builtin_amdgcn_readfirstlane(F.tid >> 6);
    F.ws = launder(F0.ws); F.out = launder(F0.out); F.ctl = (gu32*)(F.ws + WS_CTL); return F;
}
constexpr int PH_PRO0 = 0, PH_PRO1 = 1, PH_L0 = 2, PH_PER_LAYER = 9, PH_FINAL = PH_L0 + NLAYER * PH_PER_LAYER, PH_COUNT = PH_FINAL + 1;
enum LPhase { LP_NORM1 = 0, LP_INPROJ, LP_MIX1, LP_MIX2, LP_MIX3, LP_OUTPROJ, LP_NORM2, LP_MOE1, LP_MOE2 };

__device__ __forceinline__ void transpose_item(const float* W, int K, int N, bf16* WT, int k0, int n0, int drow0, LAS float* scr, int lane) {
#pragma unroll 8
    for (int i = 0; i < 32; ++i) { const int kk = 2 * i + (lane >> 5); scr[kk * 33 + (lane & 31)] = W[(size_t)(k0 + kk) * N + n0 + (lane & 31)]; }
    LDS_WAIT(); asm volatile("" ::: "memory");
    const int c = lane & 7;
#pragma unroll
    for (int j = 0; j < 4; ++j) { const int n = (lane >> 3) + 8 * j; const LAS float* s = scr + (8 * c) * 33 + n;
        v4u o; o.x = pk2(s[0 * 33], s[1 * 33]); o.y = pk2(s[2 * 33], s[3 * 33]); o.z = pk2(s[4 * 33], s[5 * 33]); o.w = pk2(s[6 * 33], s[7 * 33]);
        *(GAS v4u*)(WT + (size_t)(drow0 + n) * K + k0 + 8 * c) = o; }
    LDS_WAIT(); asm volatile("" ::: "memory");
}
__device__ __forceinline__ void pro0_transposes(Frame& F) {
    LAS float* scr = (LAS float*)(F.lds + F.wave * 16384);
    const int gw = F.bx * NWAVES + F.wave, NGW = F.G * NWAVES;
    constexpr int R0 = 128 * 1024, R1 = 128 * 512, R2 = 2 * 768, R3 = 1024, R4 = 1536, R5 = 4 * 512, NITEMS = R0 + R1 + R2 + R3 + R4 + R5;
    for (int it = gw; it < NITEMS; it += NGW) {
        int r = it;
        if (r < R0) { const int mi = r >> 10, q = r & 1023, kb = q >> 6, nb = q & 63, n0 = nb * 32;
            const int d0 = n0 < 1024 ? 256 * (n0 >> 7) + (n0 & 127) : 256 * ((n0 - 1024) >> 7) + 128 + (n0 & 127);
            transpose_item(PIN(F, I_EW1) + (size_t)mi * 1024 * 2048, 1024, 2048, (bf16*)(F.ws + WS_WE1) + (size_t)mi * 2048 * 1024, kb * 64, n0, d0, scr, F.lane); continue; } r -= R0;
        if (r < R1) { const int mi = r >> 9, q = r & 511, kb = q >> 5, nb = q & 31;
            transpose_item(PIN(F, I_EW2) + (size_t)mi * 1024 * 1024, 1024, 1024, (bf16*)(F.ws + WS_WE2) + (size_t)mi * 1024 * 1024, kb * 64, nb * 32, nb * 32, scr, F.lane); continue; } r -= R1;
        if (r < R2) { const int mi = r / 768, q = r % 768, kb = q / 48, nb = q % 48;
            transpose_item(PIN(F, I_AWIN) + (size_t)mi * 1024 * 1536, 1024, 1536, (bf16*)(F.ws + WS_WATT) + (size_t)mi * 1536 * 1024, kb * 64, nb * 32, nb * 32, scr, F.lane); continue; } r -= R2;
        if (r < R3) { const int kb = r >> 6, nb = r & 63;
            transpose_item(PIN(F, I_GWIN), 1024, 2048, (bf16*)(F.ws + WS_WGM), kb * 64, nb * 32, nb * 32, scr, F.lane); continue; } r -= R3;
        if (r < R4) { const int kb = r / 96, nb = r % 96;
            transpose_item(PIN(F, I_HWIN), 1024, 3072, (bf16*)(F.ws + WS_WHY), kb * 64, nb * 32, nb * 32, scr, F.lane); continue; } r -= R4;
        { const int mi = r >> 9, q = r & 511, kb = q >> 5, nb = q & 31;
            transpose_item(PIN(F, I_WOUT) + (size_t)mi * 1024 * 1024, 1024, 1024, (bf16*)(F.ws + WS_WOUT) + (size_t)mi * 1024 * 1024, kb * 64, nb * 32, nb * 32, scr, F.lane); }
    }
}
__device__ __forceinline__ void pro0_mod(Frame& F) {
    LAS float* sl = (LAS float*)F.lds;
    LAS float* red = (LAS float*)(F.lds + 65536);
    __syncthreads();
    for (int i = F.tid; i < 9 * 1024; i += NTHREADS) { const int r = i >> 10, k = i & 1023; const float v = r < 8 ? PIN(F, I_C)[r * 1024 + k] : PIN(F, I_CCTX)[k]; sl[i] = v / (1.0f + __expf(-v)); }
    __syncthreads();
    float* MOD = (float*)(F.ws + WS_MOD);
    for (int item = F.bx; item < NLAYER * 96; item += F.G) {
        const int l = item / 96, n0 = (item % 96) * 64;
        const float* W = PIN(F, I_ADAW) + (size_t)l * 1024 * 6144 + n0 + F.lane;
        float acc[9];
#pragma unroll
        for (int r = 0; r < 9; ++r) acc[r] = 0.f;
        const int kb = F.wave * 128;
#pragma unroll 4
        for (int k = 0; k < 128; ++k) { const float wv = W[(size_t)(kb + k) * 6144];
#pragma unroll
            for (int r = 0; r < 9; ++r) acc[r] += sl[r * 1024 + kb + k] * wv; }
#pragma unroll
        for (int r = 0; r < 9; ++r) red[(F.wave * 9 + r) * 64 + F.lane] = acc[r];
        __syncthreads();
        for (int i = F.tid; i < 9 * 64; i += NTHREADS) { const int r = i >> 6, n = i & 63; float s = 0.f;
#pragma unroll
            for (int w = 0; w < 8; ++w) s += red[(w * 9 + r) * 64 + n];
            MOD[((size_t)l * 9 + r) * 6144 + n0 + n] = s + PIN(F, I_ADAB)[l * 6144 + n0 + n]; }
        __syncthreads();
    }
}
__device__ __forceinline__ void pro0_filter_mlp(Frame& F) {
    const int j = F.lane, gw = F.bx * NWAVES + F.wave, NGW = F.G * NWAVES;
    LAS float* W1 = (LAS float*)F.lds; LAS float* W2 = W1 + FEMB * FH; LAS float* W3 = W2 + FH * FH;
    __syncthreads();
    for (int i = F.tid; i < FEMB * FH; i += NTHREADS) W1[i] = PIN(F, I_FW1)[i];
    for (int i = F.tid; i < FH * FH; i += NTHREADS) { W2[i] = PIN(F, I_FW2)[i]; W3[i] = PIN(F, I_FW3)[i]; }
    __syncthreads();
    const float b1 = PIN(F, I_FB1)[j], b2 = PIN(F, I_FB2)[j], b3 = PIN(F, I_FB3)[j], fr = PIN(F, I_FREQ)[j];
    for (int it = gw; it < SEQ + CL; it += NGW) {
        const bool lat = it < SEQ; const int t = lat ? it : it - SEQ; const float L = lat ? (float)SEQ : (float)CL;
        const float tl = (float)t / (L - 1.0f), w = (6.283185307179586f * (float)t) / L;
        float z;
        { const int band = (j - 1) & 15; const float f = 1e-4f + (float)band * ((15.0f - 1e-4f) / 15.0f); const float a = f * w;
          z = (j == 0) ? tl : (j <= 16 ? cosf(a) : -sinf(a)); }
        float s = b1;
#pragma unroll
        for (int i = 0; i < FEMB; ++i) s += __shfl(z, i) * W1[i * FH + j];
        const float a1 = sinf(fr * s);
        s = b2;
#pragma unroll 16
        for (int i = 0; i < FH; ++i) s += __shfl(a1, i) * W2[i * FH + j];
        const float a2 = sinf(fr * s);
        s = b3;
#pragma unroll 16
        for (int i = 0; i < FH; ++i) s += __shfl(a2, i) * W3[i * FH + j];
        const float a3 = sinf(fr * s);
        float* dst = lat ? (float*)(F.ws + WS_A3) + (size_t)t * FH : (float*)(F.ws + WS_A3C) + (size_t)t * FH;
        dst[j] = a3;
    }
    __syncthreads();
}

__device__ __forceinline__ f32x2 cmul(f32x2 a, f32x2 b) { return (f32x2){a.x * b.x - a.y * b.y, a.x * b.y + a.y * b.x}; }
__device__ __forceinline__ f32x2 cconj(f32x2 a) { return (f32x2){a.x, -a.y}; }
__device__ __forceinline__ void fft16k_dif(LAS f32x2* z, int tid) {
#pragma unroll 1
    for (int lq = 12; lq >= 0; lq -= 2) {
        const int q = 1 << lq; const float inv_lb = 1.0f / (float)(4 * q);
#pragma unroll 2
        for (int bf = tid; bf < 4096; bf += NTHREADS) {
            const int j = bf & (q - 1), base = ((bf >> lq) << (lq + 2)) + j;
            const f32x2 x0 = z[base], x1 = z[base + q], x2 = z[base + 2 * q], x3 = z[base + 3 * q];
            const f32x2 t0 = x0 + x2, t1 = x0 - x2, t2 = x1 + x3, d = x1 - x3, t3 = (f32x2){d.y, -d.x};
            const f32x2 y0 = t0 + t2, y2 = t0 - t2, y1 = t1 + t3, y3 = t1 - t3;
            const float fr = (float)j * inv_lb;
            const f32x2 w1 = (f32x2){__builtin_amdgcn_cosf(fr), -__builtin_amdgcn_sinf(fr)}, w2 = cmul(w1, w1), w3 = cmul(w1, w2);
            z[base] = y0; z[base + q] = cmul(y2, w2); z[base + 2 * q] = cmul(y1, w1); z[base + 3 * q] = cmul(y3, w3);
        }
        __syncthreads();
    }
}
__device__ __forceinline__ void fft16k_dit_inv(LAS f32x2* z, int tid) {
#pragma unroll 1
    for (int lq = 0; lq <= 12; lq += 2) {
        const int q = 1 << lq; const float inv_lb = 1.0f / (float)(4 * q);
#pragma unroll 2
        for (int bf = tid; bf < 4096; bf += NTHREADS) {
            const int j = bf & (q - 1), base = ((bf >> lq) << (lq + 2)) + j;
            const float fr = (float)j * inv_lb;
            const f32x2 w1 = (f32x2){__builtin_amdgcn_cosf(fr), __builtin_amdgcn_sinf(fr)}, w2 = cmul(w1, w1), w3 = cmul(w1, w2);
            const f32x2 A0 = z[base], A1 = cmul(z[base + q], w2), A2 = cmul(z[base + 2 * q], w1), A3 = cmul(z[base + 3 * q], w3);
            const f32x2 u0 = A0 + A1, u1 = A0 - A1, u2 = A2 + A3, u3 = A2 - A3, iu3 = (f32x2){-u3.y, u3.x};
            z[base] = u0 + u2; z[base + q] = u1 + iu3; z[base + 2 * q] = u0 - u2; z[base + 3 * q] = u1 - iu3;
        }
        __syncthreads();
    }
}
__device__ __forceinline__ int rev14(int p) { return (int)(__brev((unsigned)p) >> 18); }
__device__ __forceinline__ float hy_delta(int c) { const float mn = -3.0701134573253945f, mx = -15.350567286626973f; return fabsf(mn + (mx - mn) * ((float)c / 1023.0f)); }

__device__ __forceinline__ void pro1_filters(Frame& F) {
    LAS f32x2* z = (LAS f32x2*)F.lds;
    LAS float* wl = (LAS float*)(F.lds + AUX_OFF);
    const float* a3 = (const float*)(F.ws + WS_A3); const float* a3c = (const float*)(F.ws + WS_A3C);
    f32x2* KF = (f32x2*)(F.ws + WS_KF); float* FCT = (float*)(F.ws + WS_FCT);
    for (int u = F.bx; u < 512; u += F.G) {
        const int ca = 2 * u, cb = 2 * u + 1;
        __syncthreads();
        if (F.tid < 256) { const int which = F.tid >> 6, m = F.tid & 63; const int col = (which & 1 ? cb : ca) + (which >> 1) * 1024; wl[which * 64 + m] = PIN(F, I_FW4)[m * 2048 + col]; }
        if (F.tid < 4) { const int col = (F.tid & 1 ? cb : ca) + (F.tid >> 1) * 1024; wl[256 + F.tid] = PIN(F, I_FB4)[col]; }
        __syncthreads();
        const float da = hy_delta(ca), db = hy_delta(cb);
        for (int t = F.tid; t < SEQ; t += NTHREADS) {
            const f32x4* ar = (const f32x4*)(a3 + (size_t)t * FH); float s0 = wl[256], s1 = wl[257], s2 = wl[258], s3 = wl[259];
#pragma unroll 4
            for (int m4 = 0; m4 < 16; ++m4) { const f32x4 a = ar[m4];
#pragma unroll
                for (int i = 0; i < 4; ++i) { const int m = m4 * 4 + i; s0 += a[i] * wl[m]; s1 += a[i] * wl[64 + m]; s2 += a[i] * wl[128 + m]; s3 += a[i] * wl[192 + m]; } }
            const float tl = (float)t / (float)(SEQ - 1); const float wa = __expf(-tl * da), wb = __expf(-tl * db);
            z[t] = (f32x2){s0 * wa, s1 * wb};
            if (t == 0) z[SEQ] = (f32x2){0.f, 0.f}; else z[NFFT - t] = (f32x2){s2 * wa, s3 * wb};
        }
        for (int i = F.tid; i < 511; i += NTHREADS) {
            const int d = i - 255, t = d < 0 ? -d : d; const int o = d < 0 ? 2 : 0;
            const float* ar = a3c + (size_t)t * FH; float sa = wl[256 + o], sb = wl[257 + o];
            for (int m = 0; m < FH; ++m) { const float a = ar[m]; sa += a * wl[o * 64 + m]; sb += a * wl[(o + 1) * 64 + m]; }
            const float tl = (float)t / (float)(CL - 1);
            FCT[(size_t)ca * 512 + d + 256] = sa * __expf(-tl * da); FCT[(size_t)cb * 512 + d + 256] = sb * __expf(-tl * db);
        }
        __syncthreads();
        fft16k_dif(z, F.tid);
        for (int p = F.tid; p < NFFT; p += NTHREADS) {
            const int k = rev14(p), p2 = rev14((NFFT - k) & (NFFT - 1));
            if (p <= p2) { const f32x2 a = z[p], b = z[p2];
                const f32x2 Ka = (f32x2){0.5f * (a.x + b.x), 0.5f * (a.y - b.y)};
                const f32x2 Kb = (f32x2){0.5f * (a.y + b.y), -0.5f * (a.x - b.x)};
                KF[(size_t)ca * NFFT + p] = Ka; KF[(size_t)cb * NFFT + p] = Kb; KF[(size_t)ca * NFFT + p2] = cconj(Ka); KF[(size_t)cb * NFFT + p2] = cconj(Kb); }
        }
    }
    __syncthreads();
}

__device__ __forceinline__ void hyena_conv_phase(Frame& F) {
    LAS f32x2* z = (LAS f32x2*)F.lds;
    LAS float* aux = (LAS float*)(F.lds + AUX_OFF);
    float* VT = (float*)(F.ws + WS_VT); float* VTC = (float*)(F.ws + WS_VTC);
    const f32x2* KF = (const f32x2*)(F.ws + WS_KF); const float* FCT = (const float*)(F.ws + WS_FCT);
    for (int u = F.bx; u < NB * 512; u += F.G) {
        const int b = u >> 9, cp = u & 511, ca = 2 * cp, cb = ca + 1;
        float* va = VT + ((size_t)b * 1024 + ca) * SEQ; float* vb = va + SEQ;
        __syncthreads();
        for (int n = F.tid; n < SEQ; n += NTHREADS) { z[n] = (f32x2){va[n], vb[n]}; z[SEQ + n] = (f32x2){0.f, 0.f}; }
        { const int h = F.tid >> 8, t = F.tid & 255; float* vc = VTC + ((size_t)b * 1024 + ca + h) * CL;
          aux[h * 256 + t] = vc[t]; aux[512 + h * 512 + t] = FCT[(size_t)(ca + h) * 512 + t]; aux[512 + h * 512 + 256 + t] = FCT[(size_t)(ca + h) * 512 + 256 + t];
          __syncthreads();
          float y = 0.f;
#pragma unroll 8
          for (int s = 0; s < CL; ++s) y += aux[h * 256 + s] * aux[512 + h * 512 + (t - s) + 256];
          vc[t] = y; }
        fft16k_dif(z, F.tid);
        const f32x2* Ka = KF + (size_t)ca * NFFT; const f32x2* Kb = KF + (size_t)cb * NFFT;
        for (int p = F.tid; p < NFFT; p += NTHREADS) {
            const int k = rev14(p), p2 = rev14((NFFT - k) & (NFFT - 1));
            if (p <= p2) { const f32x2 a = z[p], b2 = z[p2];
                const f32x2 Va = (f32x2){0.5f * (a.x + b2.x), 0.5f * (a.y - b2.y)}, Vb = (f32x2){0.5f * (a.y + b2.y), -0.5f * (a.x - b2.x)};
                const f32x2 ya = cmul(Va, Ka[p]), yb = cmul(Vb, Kb[p]);
                z[p] = (f32x2){ya.x - yb.y, ya.y + yb.x};
                z[p2] = (f32x2){ya.x + yb.y, -ya.y + yb.x}; }
        }
        __syncthreads();
        fft16k_dit_inv(z, F.tid);
        const float sc = 1.0f / (float)NFFT;
        for (int n = F.tid; n < SEQ; n += NTHREADS) { const f32x2 w = z[n]; va[n] = w.x * sc; vb[n] = w.y * sc; }
    }
    __syncthreads();
}
constexpr int MW_CUMBLK = 16, MW_CNT = 64, MW_SELE = 128, MW_SELV = 256, MW_LRANK = 384, MW_LBASE = 512;
__device__ __forceinline__ void moe_tables(Frame& F, int layer) {
    __syncthreads();
    if (F.tid < NE) F.MISC[MW_CNT + F.tid] = __hip_atomic_load(F.ctl + CW_CNT + layer * NE + F.tid, RLX_AGENT);
    __syncthreads();
    if (F.tid == 0) { unsigned c = 0; for (int e = 0; e < NE; ++e) { F.MISC[MW_CUMBLK + e] = c; c += (F.MISC[MW_CNT + e] + 255u) >> 8; } F.MISC[MW_CUMBLK + NE] = c; }
    __syncthreads();
}

template <int MODE> __device__ __forceinline__ void rowpass(Frame& F, int layer) {
    const bool last = layer == NLAYER - 1;
    const int nrows = (MODE == 2 || (MODE == 1 && last)) ? ML : MT;
    const bool combine = (MODE == 0 && layer > 0) || MODE == 2;
    const int cl = MODE == 2 ? NLAYER - 1 : layer - 1;
    const bool from_input = (MODE == 0 && layer == 0);
    const float* XLs = from_input ? PIN(F, I_X) : F.out; const float* XCs = from_input ? PIN(F, I_CTX) : (const float*)(F.ws + WS_XC);
    float* XLd = F.out; float* XCd = (float*)(F.ws + WS_XC);
    const float* MOD = (const float*)(F.ws + WS_MOD);
    bf16* H = (bf16*)(F.ws + WS_H); const bf16* YM = (const bf16*)(F.ws + WS_YM);
    int* TE = (int*)(F.ws + WS_TE); int* TR = (int*)(F.ws + WS_TR); float* TG = (float*)(F.ws + WS_TG); int* ROWTOK = (int*)(F.ws + WS_ROWTOK);
    const float* gnorm = MODE == 0 ? PIN(F, I_N1G) + layer * D : (MODE == 1 ? PIN(F, I_N2G) + layer * D : PIN(F, I_FG));
    LAS float* RW = (LAS float*)F.lds;
    LAS float* hst = (LAS float*)(F.lds + AUX_OFF) + F.wave * 512;
    if (combine) moe_tables(F, cl);
    if (MODE == 1) { __syncthreads(); const f32x4* src = (const f32x4*)(PIN(F, I_RW) + (size_t)layer * D * NE); for (int i = F.tid; i < D * NE / 4; i += NTHREADS) ((LAS f32x4*)RW)[i] = src[i]; __syncthreads(); }
    f32x4 gn[4];
#pragma unroll
    for (int j = 0; j < 4; ++j) gn[j] = ((const f32x4*)gnorm)[F.lane + 64 * j];
    const int ntiles = nrows / 32;
    for (int tile = F.bx; tile < ntiles; tile += F.G) {
#pragma unroll 1
        for (int rr = 0; rr < 4; ++rr) {
            const int r = tile * 32 + F.wave * 4 + rr; const bool lat = r < ML; const int bidx = lat ? (r >> 13) : 8;
            const size_t xo = lat ? (size_t)r * D : (size_t)(r - ML) * D;
            const f32x4* xs = (const f32x4*)((lat ? XLs : XCs) + xo);
            f32x4 v[4];
#pragma unroll
            for (int j = 0; j < 4; ++j) v[j] = xs[F.lane + 64 * j];
            if (combine) {
                const i32x4 te = *(const i32x4*)(TE + (size_t)r * 4), tr = *(const i32x4*)(TR + (size_t)r * 4); const f32x4 tg = *(const f32x4*)(TG + (size_t)r * 4);
                const float* g2 = MOD + ((size_t)cl * 9 + bidx) * 6144 + 5 * 1024;
                f32x4 a[4];
#pragma unroll
                for (int j = 0; j < 4; ++j) a[j] = (f32x4){0.f, 0.f, 0.f, 0.f};
#pragma unroll
                for (int k = 0; k < 4; ++k) { const int rowid = 256 * (int)F.MISC[MW_CUMBLK + te[k]] + tr[k]; const v2u* yr = (const v2u*)(YM + (size_t)rowid * D); const float gk = tg[k];
#pragma unroll
                    for (int j = 0; j < 4; ++j) { const v2u w = yr[F.lane + 64 * j]; a[j] += gk * (f32x4){bflo(w.x), bfhi(w.x), bflo(w.y), bfhi(w.y)}; } }
#pragma unroll
                for (int j = 0; j < 4; ++j) v[j] += ((const f32x4*)g2)[F.lane + 64 * j] * a[j];
                if (MODE == 0) { f32x4* xd = (f32x4*)((lat ? XLd : XCd) + xo);
#pragma unroll
                    for (int j = 0; j < 4; ++j) xd[F.lane + 64 * j] = v[j]; }
            }
            float ss = 0.f;
#pragma unroll
            for (int j = 0; j < 4; ++j) ss += (v[j].x * v[j].x + v[j].y * v[j].y) + (v[j].z * v[j].z + v[j].w * v[j].w);
            const float rstd = 1.0f / sqrtf(wave_sum(ss) * (1.0f / D) + EPS);
            if (MODE == 2) { f32x4* od = (f32x4*)(F.out + xo);
#pragma unroll
                for (int j = 0; j < 4; ++j) od[F.lane + 64 * j] = v[j] * rstd * gn[j];
                continue; }
            const float* mb = MOD + ((size_t)layer * 9 + bidx) * 6144 + (MODE == 0 ? 0 : 3 * 1024);
            f32x4 hv[4];
#pragma unroll
            for (int j = 0; j < 4; ++j) { const f32x4 sh = ((const f32x4*)mb)[F.lane + 64 * j], sc = ((const f32x4*)(mb + 1024))[F.lane + 64 * j]; hv[j] = v[j] * rstd * gn[j] * (sc + 1.0f) + sh; }
            v2u* hd = (v2u*)(H + (size_t)r * D);
#pragma unroll
            for (int j = 0; j < 4; ++j) { v2u w; w.x = cvt_pk_bf16(hv[j].x, hv[j].y); w.y = cvt_pk_bf16(hv[j].z, hv[j].w); hd[F.lane + 64 * j] = w; }
            if (MODE == 1) {
                const int e = F.lane & 31, par = F.lane >> 5; float acc = 0.f;
#pragma unroll
                for (int ph = 0; ph < 2; ++ph) {
                    LDS_WAIT(); asm volatile("" ::: "memory");
                    *(LAS f32x4*)(hst + 4 * F.lane) = hv[2 * ph]; *(LAS f32x4*)(hst + 256 + 4 * F.lane) = hv[2 * ph + 1];
                    LDS_WAIT(); asm volatile("" ::: "memory");
                    const LAS float* rwp = RW + (size_t)(512 * ph + par) * NE + e; const LAS float* hp = hst + par;
#pragma unroll 8
                    for (int m = 0; m < 256; ++m) acc += hp[2 * m] * rwp[2 * m * NE];
                }
                acc += __shfl_xor(acc, 32);
                const float logit = acc + PIN(F, I_RB)[layer * NE + e];
                int rank = 0;
#pragma unroll
                for (int i = 0; i < NE; ++i) { const float o = __shfl(logit, i); rank += (o > logit || (o == logit && i < e)) ? 1 : 0; }
                const int slot = F.wave * 4 + rr;
                if (F.lane < 32 && rank < 4) { F.MISC[MW_SELE + slot * 4 + rank] = (unsigned)e; F.MISC[MW_SELV + slot * 4 + rank] = __float_as_uint(logit); }
                LDS_WAIT(); asm volatile("" ::: "memory");
                { const int k = F.lane & 3; const float vk = __uint_as_float(F.MISC[MW_SELV + slot * 4 + k]); const float v0 = __shfl(vk, 0);
                  float ex = __expf(vk - v0); float sm = ex; sm += __shfl_xor(sm, 1); sm += __shfl_xor(sm, 2);
                  if (F.lane < 4) { TG[(size_t)r * 4 + k] = ex / sm; TE[(size_t)r * 4 + k] = (int)F.MISC[MW_SELE + slot * 4 + k]; } }
            }
        }
        if (MODE == 1) {
            __syncthreads();
            if (F.tid < NE) { unsigned cnt = 0;
                for (int a = 0; a < 128; ++a) { if (F.MISC[MW_SELE + a] == (unsigned)F.tid) { F.MISC[MW_LRANK + a] = cnt; ++cnt; } }
                unsigned base = 0; if (cnt) base = __hip_atomic_fetch_add(F.ctl + CW_CNT + layer * NE + F.tid, cnt, RLX_AGENT);
                F.MISC[MW_LBASE + F.tid] = base; }
            __syncthreads();
            if (F.tid < 128) { const int a = F.tid; const int e = (int)F.MISC[MW_SELE + a]; const int rank = (int)(F.MISC[MW_LBASE + e] + F.MISC[MW_LRANK + a]); const int tok = tile * 32 + (a >> 2);
                TR[(size_t)tok * 4 + (a & 3)] = rank; ROWTOK[(size_t)e * MT + rank] = tok; }
            __syncthreads();
        }
    }
}

__device__ __forceinline__ void normrope16(float (&x)[16], const float* gain, bool lat, int prow, int pcol, const LAS f32x2* T, int L) {
    float ss = 0.f;
#pragma unroll
    for (int i = 0; i < 16; ++i) ss += x[i] * x[i];
    ss += __shfl_xor(ss, 1); ss += __shfl_xor(ss, 2); ss += __shfl_xor(ss, 4);
    const float rstd = 1.0f / sqrtf(ss * (1.0f / 128.0f) + EPS);
    const int o = (L & 7) * 16;
#pragma unroll
    for (int i = 0; i < 16; ++i) x[i] = x[i] * rstd * gain[o + i];
    float p[16];
#pragma unroll
    for (int i = 0; i < 16; ++i) p[i] = __shfl_xor(x[i], 2);
    if (lat) {
        const int pos = (L & 4) ? pcol : prow; const float sgn = (L & 2) ? 1.0f : -1.0f; const LAS f32x2* t = T + pos * 32 + (L & 1) * 16;
#pragma unroll
        for (int i = 0; i < 16; ++i) { const f32x2 cs = t[i]; x[i] = x[i] * cs.x + sgn * p[i] * cs.y; }
    }
}
__device__ __forceinline__ void qkprep_phase(Frame& F, int j) {
    LAS f32x2* T = (LAS f32x2*)F.lds;
    __syncthreads();
    for (int i = F.tid; i < 128 * 32; i += NTHREADS) { const int pos = i >> 5, f = i & 31; const float inv = powf(10000.0f, -(float)f / 32.0f); const float ang = (float)pos * inv; float s, c; sincosf(ang, &s, &c); T[i] = (f32x2){c, s}; }
    __syncthreads();
    const bf16* P = (const bf16*)(F.ws + WS_P); bf16* QB = (bf16*)(F.ws + WS_QB); bf16* KVB = (bf16*)(F.ws + WS_KVB);
    const float* qg = PIN(F, I_AQG) + j * 128; const float* kg = PIN(F, I_AKG) + j * 128;
    const int gw = F.bx * NWAVES + F.wave, NGW = F.G * NWAVES, L = F.lane;
    for (int r = gw; r < MT; r += NGW) {
        const bool lat = r < ML; const int b = lat ? (r >> 13) : ((r - ML) >> 8); const int s = lat ? (r & (SEQ - 1)) : ((r - ML) & (CL - 1));
        const int prow = s >> 6, pcol = s & 63; const size_t kvrow = (size_t)b * SKV + (lat ? s : SEQ + s);
        const bf16* pr = P + (size_t)r * 1536;
        { const v4u a = *(const v4u*)(pr + 16 * L), c = *(const v4u*)(pr + 16 * L + 8); float x[16];
          x[0] = bflo(a.x); x[1] = bfhi(a.x); x[2] = bflo(a.y); x[3] = bfhi(a.y); x[4] = bflo(a.z); x[5] = bfhi(a.z); x[6] = bflo(a.w); x[7] = bfhi(a.w);
          x[8] = bflo(c.x); x[9] = bfhi(c.x); x[10] = bflo(c.y); x[11] = bfhi(c.y); x[12] = bflo(c.z); x[13] = bfhi(c.z); x[14] = bflo(c.w); x[15] = bfhi(c.w);
          normrope16(x, qg, lat, prow, pcol, T, L);
          v4u o0, o1; o0.x = cvt_pk_bf16(x[0], x[1]); o0.y = cvt_pk_bf16(x[2], x[3]); o0.z = cvt_pk_bf16(x[4], x[5]); o0.w = cvt_pk_bf16(x[6], x[7]);
          o1.x = cvt_pk_bf16(x[8], x[9]); o1.y = cvt_pk_bf16(x[10], x[11]); o1.z = cvt_pk_bf16(x[12], x[13]); o1.w = cvt_pk_bf16(x[14], x[15]);
          *(v4u*)(QB + (size_t)r * D + 16 * L) = o0; *(v4u*)(QB + (size_t)r * D + 16 * L + 8) = o1; }
        { const int Lk = L & 15; const v4u a = *(const v4u*)(pr + 1024 + 16 * Lk), c = *(const v4u*)(pr + 1024 + 16 * Lk + 8); float x[16];
          x[0] = bflo(a.x); x[1] = bfhi(a.x); x[2] = bflo(a.y); x[3] = bfhi(a.y); x[4] = bflo(a.z); x[5] = bfhi(a.z); x[6] = bflo(a.w); x[7] = bfhi(a.w);
          x[8] = bflo(c.x); x[9] = bfhi(c.x); x[10] = bflo(c.y); x[11] = bfhi(c.y); x[12] = bflo(c.z); x[13] = bfhi(c.z); x[14] = bflo(c.w); x[15] = bfhi(c.w);
          normrope16(x, kg, lat, prow, pcol, T, Lk);
          if (L < 16) { v4u o0, o1; o0.x = cvt_pk_bf16(x[0], x[1]); o0.y = cvt_pk_bf16(x[2], x[3]); o0.z = cvt_pk_bf16(x[4], x[5]); o0.w = cvt_pk_bf16(x[6], x[7]);
            o1.x = cvt_pk_bf16(x[8], x[9]); o1.y = cvt_pk_bf16(x[10], x[11]); o1.z = cvt_pk_bf16(x[12], x[13]); o1.w = cvt_pk_bf16(x[14], x[15]);
            *(v4u*)(KVB + kvrow * 512 + 16 * L) = o0; *(v4u*)(KVB + kvrow * 512 + 16 * L + 8) = o1; }
          else if (L < 48) { const int q = L - 16; *(v4u*)(KVB + kvrow * 512 + 256 + 8 * q) = *(const v4u*)(pr + 1280 + 8 * q); } }
    }
}
__device__ __forceinline__ void attention_phase(Frame& F, char* lds_generic, bool ctx_queries) {
    const bf16* QB = (const bf16*)(F.ws + WS_QB); const bf16* KVB = (const bf16*)(F.ws + WS_KVB); bf16* Y = (bf16*)(F.ws + WS_Y);
    const int nunits = 2048 + (ctx_queries ? 64 : 0);
    for (int u = F.bx; u < nunits; u += F.G) {
        if (u < 2048) { const int b = u >> 8, w = u & 255, h = w & 7, qb = w >> 3; const size_t qo = ((size_t)b * SEQ + (size_t)qb * 256) * D + h * 128; const bf16* kh = KVB + (size_t)b * SKV * 512 + (h >> 2) * 128;
            att::attn_dense_body(QB + qo, kh, kh + 256, Y + qo, SKV, lds_generic); }
        else { const int w = u - 2048, b = w >> 3, h = w & 7; const size_t qo = ((size_t)ML + (size_t)b * CL) * D + h * 128; const bf16* kh = KVB + ((size_t)b * SKV + SEQ) * 512 + (h >> 2) * 128;
            att::attn_dense_body(QB + qo, kh, kh + 256, Y + qo, CL, lds_generic); }
    }
}

__device__ __forceinline__ void gmlp_mix_phase(Frame& F) {
    constexpr int LDA = 136;
    LAS bf16* As = (LAS bf16*)F.lds;
    LAS bf16* Vt = (LAS bf16*)(F.lds + 128 * LDA * 2);
    LAS float* rs = (LAS float*)(F.lds + 2 * 128 * LDA * 2);
    const bf16* P = (const bf16*)(F.ws + WS_P); bf16* Y = (bf16*)(F.ws + WS_Y); const float* SS = (const float*)(F.ws + WS_SS);
    const float* ws = PIN(F, I_GWS); const float* bs = PIN(F, I_GBS); const float* vg = PIN(F, I_GVG);
    const int r32 = F.lane & 31, hi = F.lane >> 5;
    for (int u = F.bx; u < (MT / 128) * 8; u += F.G) {
        const int chunk = u >> 3, g = u & 7; const size_t row0 = (size_t)chunk * 128;
        __syncthreads();
        if (F.tid < 128) { const f32x4* sp = (const f32x4*)(SS + (row0 + F.tid) * 16); const f32x4 a = sp[0], b = sp[1], c = sp[2], d = sp[3];
            const float s = ((a.x + a.y) + (a.z + a.w)) + ((b.x + b.y) + (b.z + b.w)) + ((c.x + c.y) + (c.z + c.w)) + ((d.x + d.y) + (d.z + d.w)); rs[F.tid] = 1.0f / sqrtf(s * (1.0f / 1024.0f) + EPS); }
        __syncthreads();
        for (int i = F.tid; i < 128 * 32; i += NTHREADS) { const int p = i >> 5, q4 = (i & 31) * 4; const f32x4 w = *(const f32x4*)(ws + ((size_t)g * 128 + p) * 128 + q4);
            v2u o; o.x = pk2(w.x * rs[q4], w.y * rs[q4 + 1]); o.y = pk2(w.z * rs[q4 + 2], w.w * rs[q4 + 3]); *(LAS v2u*)(As + p * LDA + q4) = o; }
        for (int i = F.tid; i < 128 * 16; i += NTHREADS) { const int q = i >> 4, c8 = (i & 15) * 8; const v4u w = *(const v4u*)(P + (row0 + q) * 2048 + 1024 + g * 128 + c8);
            Vt[(c8 + 0) * LDA + q] = (bf16)(w.x & 0xffff); Vt[(c8 + 1) * LDA + q] = (bf16)(w.x >> 16); Vt[(c8 + 2) * LDA + q] = (bf16)(w.y & 0xffff); Vt[(c8 + 3) * LDA + q] = (bf16)(w.y >> 16);
            Vt[(c8 + 4) * LDA + q] = (bf16)(w.z & 0xffff); Vt[(c8 + 5) * LDA + q] = (bf16)(w.z >> 16); Vt[(c8 + 6) * LDA + q] = (bf16)(w.w & 0xffff); Vt[(c8 + 7) * LDA + q] = (bf16)(w.w >> 16); }
        __syncthreads();
        const int p0 = (F.wave >> 1) * 32, cbase = (F.wave & 1) * 64;
        f32x16 acc0 = {}, acc1 = {};
#pragma unroll
        for (int ks = 0; ks < 8; ++ks) { const int k0 = ks * 16 + hi * 8;
            const bf16x8 a = *(const LAS bf16x8*)(As + (p0 + r32) * LDA + k0);
            const bf16x8 b0 = *(const LAS bf16x8*)(Vt + (cbase + r32) * LDA + k0), b1 = *(const LAS bf16x8*)(Vt + (cbase + 32 + r32) * LDA + k0);
            acc0 = __builtin_amdgcn_mfma_f32_32x32x16_bf16(a, b0, acc0, 0, 0, 0); acc1 = __builtin_amdgcn_mfma_f32_32x32x16_bf16(a, b1, acc1, 0, 0, 0); }
#pragma unroll
        for (int t = 0; t < 2; ++t) { const int c = g * 128 + cbase + t * 32 + r32; const float gain = vg[c];
#pragma unroll
            for (int reg = 0; reg < 16; ++reg) { const int p = p0 + (reg & 3) + 8 * (reg >> 2) + 4 * hi; const float a = t == 0 ? acc0[reg] : acc1[reg];
                const float uu = bf2f(P[(row0 + p) * 2048 + c]); const float mixed = gain * a + bs[g * 128 + p];
                Y[(row0 + p) * D + c] = (bf16)f2bf(uu * mixed); } }
    }
    __syncthreads();
}

__device__ __forceinline__ void hyena_prep_phase(Frame& F) {
    LAS float* tl = (LAS float*)F.lds;
    const bf16* P = (const bf16*)(F.ws + WS_P); bf16* X0 = (bf16*)(F.ws + WS_X0); bf16* VG = (bf16*)(F.ws + WS_VG);
    float* VT = (float*)(F.ws + WS_VT); float* VTC = (float*)(F.ws + WS_VTC);
    const float* cw = PIN(F, I_HCW); const float* cb = PIN(F, I_HCB);
    const int tt = F.tid >> 3, cg = F.tid & 7;
    for (int u = F.bx; u < (MT / 64) * 16; u += F.G) {
        const int tb = u >> 4, c0 = (u & 15) * 64; const int r0 = tb * 64; const bool lat = r0 < ML;
        const int b = lat ? (r0 >> 13) : ((r0 - ML) >> 8), s0 = lat ? (r0 & (SEQ - 1)) : ((r0 - ML) & (CL - 1)), L = lat ? SEQ : CL;
        const int r = r0 + tt, s = s0 + tt, c = c0 + cg * 8;
        float o[3][8];
#pragma unroll
        for (int seg = 0; seg < 3; ++seg) { const int col = seg * 1024 + c;
            const v4u z0 = {0u, 0u, 0u, 0u};
            const v4u pm = s > 0 ? *(const v4u*)(P + (size_t)(r - 1) * 3072 + col) : z0, pc = *(const v4u*)(P + (size_t)r * 3072 + col), pn = s < L - 1 ? *(const v4u*)(P + (size_t)(r + 1) * 3072 + col) : z0;
            const f32x4 w0a = *(const f32x4*)(cw + col), w0b = *(const f32x4*)(cw + col + 4), w1a = *(const f32x4*)(cw + 3072 + col), w1b = *(const f32x4*)(cw + 3072 + col + 4);
            const f32x4 w2a = *(const f32x4*)(cw + 6144 + col), w2b = *(const f32x4*)(cw + 6144 + col + 4), ba = *(const f32x4*)(cb + col), bb = *(const f32x4*)(cb + col + 4);
            const unsigned pmw[4] = {pm.x, pm.y, pm.z, pm.w}, pcw[4] = {pc.x, pc.y, pc.z, pc.w}, pnw[4] = {pn.x, pn.y, pn.z, pn.w};
#pragma unroll
            for (int i = 0; i < 8; ++i) { const float xm = (i & 1) ? bfhi(pmw[i >> 1]) : bflo(pmw[i >> 1]), xc = (i & 1) ? bfhi(pcw[i >> 1]) : bflo(pcw[i >> 1]), xn = (i & 1) ? bfhi(pnw[i >> 1]) : bflo(pnw[i >> 1]);
                const float w0 = i < 4 ? w0a[i & 3] : w0b[i & 3], w1 = i < 4 ? w1a[i & 3] : w1b[i & 3], w2 = i < 4 ? w2a[i & 3] : w2b[i & 3], bi = i < 4 ? ba[i & 3] : bb[i & 3];
                o[seg][i] = xm * w0 + xc * w1 + xn * w2 + bi; } }
        float vgv[8];
#pragma unroll
        for (int i = 0; i < 8; ++i) vgv[i] = o[2][i] * o[1][i];
        v4u w; w.x = cvt_pk_bf16(o[0][0], o[0][1]); w.y = cvt_pk_bf16(o[0][2], o[0][3]); w.z = cvt_pk_bf16(o[0][4], o[0][5]); w.w = cvt_pk_bf16(o[0][6], o[0][7]);
        *(v4u*)(X0 + (size_t)r * D + c) = w;
        w.x = cvt_pk_bf16(vgv[0], vgv[1]); w.y = cvt_pk_bf16(vgv[2], vgv[3]); w.z = cvt_pk_bf16(vgv[4], vgv[5]); w.w = cvt_pk_bf16(vgv[6], vgv[7]);
        *(v4u*)(VG + (size_t)r * D + c) = w;
        __syncthreads();
#pragma unroll
        for (int i = 0; i < 8; ++i) tl[(cg * 8 + i) * 65 + tt] = vgv[i];
        __syncthreads();
        { const int cc = F.tid >> 3, ts = (F.tid & 7) * 8; float* dst = lat ? VT + ((size_t)b * 1024 + c0 + cc) * SEQ + s0 + ts : VTC + ((size_t)b * 1024 + c0 + cc) * CL + s0 + ts;
          const LAS float* sp = tl + cc * 65 + ts;
          *(f32x4*)dst = (f32x4){sp[0], sp[1], sp[2], sp[3]}; *(f32x4*)(dst + 4) = (f32x4){sp[4], sp[5], sp[6], sp[7]}; }
    }
    __syncthreads();
}
__device__ __forceinline__ void hyena_post_phase(Frame& F) {
    LAS float* tl = (LAS float*)F.lds;
    const bf16* X0 = (const bf16*)(F.ws + WS_X0); const bf16* VG = (const bf16*)(F.ws + WS_VG); bf16* Y = (bf16*)(F.ws + WS_Y);
    const float* VT = (const float*)(F.ws + WS_VT); const float* VTC = (const float*)(F.ws + WS_VTC); const float* dsk = PIN(F, I_HD);
    const int tt = F.tid >> 3, cg = F.tid & 7;
    for (int u = F.bx; u < (MT / 64) * 16; u += F.G) {
        const int tb = u >> 4, c0 = (u & 15) * 64; const int r0 = tb * 64; const bool lat = r0 < ML;
        const int b = lat ? (r0 >> 13) : ((r0 - ML) >> 8), s0 = lat ? (r0 & (SEQ - 1)) : ((r0 - ML) & (CL - 1));
        __syncthreads();
        { const int cc = F.tid >> 3, ts = (F.tid & 7) * 8; const float* src = lat ? VT + ((size_t)b * 1024 + c0 + cc) * SEQ + s0 + ts : VTC + ((size_t)b * 1024 + c0 + cc) * CL + s0 + ts;
          const f32x4 a = *(const f32x4*)src, bq = *(const f32x4*)(src + 4); LAS float* dp = tl + cc * 65 + ts;
          dp[0] = a.x; dp[1] = a.y; dp[2] = a.z; dp[3] = a.w; dp[4] = bq.x; dp[5] = bq.y; dp[6] = bq.z; dp[7] = bq.w; }
        __syncthreads();
        const int r = r0 + tt, c = c0 + cg * 8;
        const v4u x0 = *(const v4u*)(X0 + (size_t)r * D + c), vv = *(const v4u*)(VG + (size_t)r * D + c);
        const f32x4 da = *(const f32x4*)(dsk + c), db = *(const f32x4*)(dsk + c + 4);
        const unsigned x0w[4] = {x0.x, x0.y, x0.z, x0.w}, vw[4] = {vv.x, vv.y, vv.z, vv.w}; float y[8];
#pragma unroll
        for (int i = 0; i < 8; ++i) { const float xx = (i & 1) ? bfhi(x0w[i >> 1]) : bflo(x0w[i >> 1]), vx = (i & 1) ? bfhi(vw[i >> 1]) : bflo(vw[i >> 1]); const float di = i < 4 ? da[i & 3] : db[i & 3];
            y[i] = (tl[(cg * 8 + i) * 65 + tt] + vx * di) * xx; }
        v4u w; w.x = cvt_pk_bf16(y[0], y[1]); w.y = cvt_pk_bf16(y[2], y[3]); w.z = cvt_pk_bf16(y[4], y[5]); w.w = cvt_pk_bf16(y[6], y[7]);
        *(v4u*)(Y + (size_t)r * D + c) = w;
    }
    __syncthreads();
}
__device__ __forceinline__ bool phase_nonempty(int ph) {
    if (ph < PH_L0 || ph >= PH_FINAL) return true;
    const int layer = (ph - PH_L0) / PH_PER_LAYER, lp = (ph - PH_L0) % PH_PER_LAYER, kind = layer % 3;
    if (lp == LP_MIX2) return kind != 1;
    if (lp == LP_MIX3) return kind == 2;
    return true;
}
__global__ void __launch_bounds__(NTHREADS, 2) mk_fwd(Args args) {
    extern __shared__ __attribute__((aligned(16))) unsigned char lds[];
    Frame F0;
    F0.lds = (LAS unsigned char*)lds; F0.MISC = (volatile LAS unsigned*)(F0.lds + MISC_OFF);
    F0.tid = threadIdx.x; F0.lane = F0.tid & 63; F0.wave = __builtin_amdgcn_readfirstlane(F0.tid >> 6);
    F0.G = gridDim.x; F0.bx = blockIdx.x; F0.out = args.out; F0.ws = args.ws; F0.ctl = (gu32*)(args.ws + WS_CTL);
    for (int u = F0.tid; u < MISC_BYTES / 4; u += NTHREADS) F0.MISC[u] = 0u;
    __syncthreads();
    if (F0.tid < 36) { const unsigned long long p = (unsigned long long)args.in[F0.tid]; F0.MISC[MW_PTRS + 2 * F0.tid] = (unsigned)p; F0.MISC[MW_PTRS + 2 * F0.tid + 1] = (unsigned)(p >> 32); }
    __syncthreads();
    const int lo = args.ph_lo, hi = args.ph_hi;
    const bool multi = (hi - lo) > 1;
    XcdBarrier bar; bar.bar = (unsigned*)(F0.ctl + CW_BAR); bar.x = 0; bar.st = nullptr;
    if (multi) bar = xcd_barrier_post((unsigned*)(F0.ctl + CW_BAR), F0.MISC + 8);
#ifndef PHMASK
#define PHMASK 0xFFFF
#endif
#define EN(b) ((PHMASK >> (b)) & 1)
#ifndef KMASK
#define KMASK 7
#endif
#define KEN(b) ((KMASK >> (b)) & 1)
#define IN(k) (lo <= (k) && (k) < hi)
#define SEAM(k) do { if ((k) + 1 < hi) xcd_barrier(bar); } while (0)

    if (EN(0) && IN(PH_PRO0)) { Frame F = phase_frame(F0); pro0_mod(F); __syncthreads(); pro0_transposes(F); pro0_filter_mlp(F); SEAM(PH_PRO0); }
    if (EN(1) && IN(PH_PRO1)) { Frame F = phase_frame(F0); pro1_filters(F); SEAM(PH_PRO1); }

#pragma unroll 1
    for (int layer = 0; layer < NLAYER; ++layer) {
        const int kind = layer % 3, jj = layer / 3, pb = PH_L0 + layer * PH_PER_LAYER; const bool last = layer == NLAYER - 1;
        if (EN(2) && IN(pb + LP_NORM1)) { Frame F = phase_frame(F0); rowpass<0>(F, layer); SEAM(pb + LP_NORM1); }
        if (EN(3) && IN(pb + LP_INPROJ)) {
            Frame F = phase_frame(F0);
            const int N = kind == 0 ? 1536 : (kind == 1 ? 2048 : 3072);
            const size_t woff = kind == 0 ? WS_WATT + (size_t)jj * 1536 * 1024 * 2 : (kind == 1 ? WS_WGM : WS_WHY);
            pg8::DenseSched S; S.init(F.ws + WS_H, F.ws + woff, MT, N, F.G, F.bx);
            pg8::EpiBf16 E{(bf16*)(F.ws + WS_P), N, (float*)(F.ws + WS_SS), kind == 1 ? 1 : 0};
            pg8::gemm_phase<pg8::EpiBf16, pg8::DenseSched, false>(F.lds, S, E);
            SEAM(pb + LP_INPROJ);
        }
        if (IN(pb + LP_MIX1)) {
            Frame F = phase_frame(F0);
            if (EN(4) && kind == 0) qkprep_phase(F, jj); else if (EN(5) && kind == 1) gmlp_mix_phase(F); else if (EN(6)) hyena_prep_phase(F);
            SEAM(pb + LP_MIX1);
        }
        if (IN(pb + LP_MIX2) && kind != 1) {
            Frame F = phase_frame(F0);
            if (EN(7) && kind == 0) attention_phase(F, (char*)lds, !last); else if (EN(8)) hyena_conv_phase(F);
            SEAM(pb + LP_MIX2);
        }
        if (EN(9) && IN(pb + LP_MIX3) && kind == 2) { Frame F = phase_frame(F0); hyena_post_phase(F); SEAM(pb + LP_MIX3); }
        if (EN(10) && IN(pb + LP_OUTPROJ)) {
            Frame F = phase_frame(F0); const float* modl = (const float*)(F.ws + WS_MOD) + (size_t)layer * 9 * 6144;
            pg8::DenseSched S; S.init(F.ws + WS_Y, F.ws + WS_WOUT + (size_t)layer * 1024 * 1024 * 2, last ? ML : MT, 1024, F.G, F.bx);
            const bool first = layer == 0;
            pg8::EpiResid E{first ? PIN(F, I_X) : F.out, first ? PIN(F, I_CTX) : (const float*)(F.ws + WS_XC), F.out, (float*)(F.ws + WS_XC), modl};
            pg8::gemm_phase<pg8::EpiResid, pg8::DenseSched, false>(F.lds, S, E);
            SEAM(pb + LP_OUTPROJ);
        }
        if (EN(11) && IN(pb + LP_NORM2)) { Frame F = phase_frame(F0); rowpass<1>(F, layer); SEAM(pb + LP_NORM2); }
        if (EN(12) && IN(pb + LP_MOE1)) {
            Frame F = phase_frame(F0);
            moe_tables(F, layer);
            pg8::MoeSched S{(const char*)(F.ws + WS_H), (const char*)(F.ws + WS_WE1) + (size_t)layer * NE * 2048 * 1024 * 2, (size_t)2048 * 1024 * 2, (const int*)(F.ws + WS_ROWTOK),
                            (const volatile LAS int*)(F.MISC + MW_CUMBLK), (const volatile LAS int*)(F.MISC + MW_CNT), 3, F.G, F.bx};
            pg8::EpiSwiglu E{(bf16*)(F.ws + WS_ACT), PIN(F, I_EB1) + (size_t)layer * NE * 2048};
            pg8::gemm_phase<pg8::EpiSwiglu, pg8::MoeSched, true>(F.lds, S, E);
            SEAM(pb + LP_MOE1);
        }
        if (EN(13) && IN(pb + LP_MOE2)) {
            Frame F = phase_frame(F0);
            moe_tables(F, layer);
            pg8::MoeSched S{(const char*)(F.ws + WS_ACT), (const char*)(F.ws + WS_WE2) + (size_t)layer * NE * 1024 * 1024 * 2, (size_t)1024 * 1024 * 2, nullptr,
                            (const volatile LAS int*)(F.MISC + MW_CUMBLK), (const volatile LAS int*)(F.MISC + MW_CNT), 2, F.G, F.bx};
            pg8::EpiBias E{(bf16*)(F.ws + WS_YM), PIN(F, I_EB2) + (size_t)layer * NE * 1024};
            pg8::gemm_phase<pg8::EpiBias, pg8::MoeSched, false>(F.lds, S, E);
            SEAM(pb + LP_MOE2);
        }
    }
    if (EN(14) && IN(PH_FINAL)) { Frame F = phase_frame(F0); rowpass<2>(F, NLAYER - 1); }
#undef IN
#undef SEAM
}

static bool host_phase_nonempty(int ph) {
    if (ph < PH_L0 || ph >= PH_FINAL) return true;
    const int layer = (ph - PH_L0) / PH_PER_LAYER, lp = (ph - PH_L0) % PH_PER_LAYER, kind = layer % 3;
    if (lp == LP_MIX2) return kind != 1;
    if (lp == LP_MIX3) return kind == 2;
    return true;
}
extern "C" void kernel_launch(void* const* d_in, const int* in_sizes, int n_in, void* d_out, int out_size, void* d_ws, size_t ws_size, hipStream_t stream) {
    static int grid = 0;
    if (grid == 0) {
        if (n_in != 36 || in_sizes[0] != ML * D || out_size != ML * D || ws_size < WS_END) {
            fprintf(stderr, "kernel_launch: built for 36 inputs, x/out of %d floats, >= %zu bytes of workspace; got n_in %d in0 %d out %d ws %zu; nothing launched\n", ML * D, (size_t)WS_END, n_in, n_in > 0 ? in_sizes[0] : -1, out_size, ws_size);
            grid = -1; return; }
        int dev = 0, cus = 0, per_cu = 0;
        if (hipGetDevice(&dev) != hipSuccess || hipDeviceGetAttribute(&cus, hipDeviceAttributeMultiprocessorCount, dev) != hipSuccess) { fprintf(stderr, "kernel_launch: device query failed\n"); grid = -1; return; }
        if (hipFuncSetAttribute((const void*)mk_fwd, hipFuncAttributeMaxDynamicSharedMemorySize, LDS_BYTES) != hipSuccess) { fprintf(stderr, "kernel_launch: hipFuncSetAttribute(%d B LDS) failed\n", LDS_BYTES); grid = -1; return; }
        if (hipOccupancyMaxActiveBlocksPerMultiprocessor(&per_cu, (const void*)mk_fwd, NTHREADS, LDS_BYTES) != hipSuccess || per_cu < 1)
            fprintf(stderr, "kernel_launch: note: occupancy query reports %d workgroups per CU\n", per_cu);
        (void)hipGetLastError();
        grid = cus;
    }
    if (grid < 0) return;
    if (hipMemsetAsync((char*)d_ws + WS_CTL, 0, CTL_ZERO_BYTES, stream) != hipSuccess) { fprintf(stderr, "kernel_launch: memset failed\n"); return; }
    Args a{};
    for (int i = 0; i < 36; ++i) a.in[i] = (const float*)d_in[i];
    a.out = (float*)d_out; a.ws = (unsigned char*)d_ws;
#if MK_MULTI || MK_DBG
    for (int ph = 0; ph < PH_COUNT; ++ph) {
        if (!host_phase_nonempty(ph)) continue;
        a.ph_lo = ph; a.ph_hi = ph + 1;
        hipLaunchKernelGGL(mk_fwd, dim3(grid), dim3(NTHREADS), LDS_BYTES, stream, a);
#if MK_DBG
        dbg_after_phase(ph, a, stream);
#endif
    }
#if MK_DBG
    dbg_report(a, stream);
#endif
#else
    a.ph_lo = 0; a.ph_hi = PH_COUNT;
    hipLaunchKernelGGL(mk_fwd, dim3(grid), dim3(NTHREADS), LDS_BYTES, stream, a);
#endif
    const hipError_t le = hipPeekAtLastError();
    if (le != hipSuccess) fprintf(stderr, "kernel_launch: launch failed: %s\n", hipGetErrorName(le));
}
```

```cpp
#include <hip/hip_runtime.h>
#include <cstdio>
#include <cstdint>
#include <cmath>

#ifndef MK_MULTI
#define MK_MULTI 0
#endif
#ifndef MK_DBG
#define MK_DBG 0
#endif

constexpr int D = 1024, NB = 8, SEQ = 8192, CL = 256, ML = NB * SEQ, MC = NB * CL, MT = ML + MC;
constexpr int NLAYER = 4, NE = 32, TOPK = 4, SKV = SEQ + CL;
constexpr int MOE_MAXBLK = (MT * TOPK) / 256 + NE;
constexpr float EPS = 1e-6f;
constexpr int FH = 64, FEMB = 33, NFFT = 16384;

constexpr size_t MiB = 1u << 20;
constexpr size_t WS_CTL = 0, CTL_ZERO_BYTES = 1 * MiB;
constexpr size_t WS_MOD = 1 * MiB;
constexpr size_t WS_A3 = 2 * MiB;
constexpr size_t WS_A3C = 4 * MiB;
constexpr size_t WS_FCT = 5 * MiB;
constexpr size_t WS_WATT = 8 * MiB;
constexpr size_t WS_WGM = 14 * MiB;
constexpr size_t WS_WHY = 18 * MiB;
constexpr size_t WS_WOUT = 24 * MiB;
constexpr size_t WS_XC = 32 * MiB;
constexpr size_t WS_TE = 40 * MiB;
constexpr size_t WS_TR = 42 * MiB;
constexpr size_t WS_TG = 44 * MiB;
constexpr size_t WS_SS = 46 * MiB;
constexpr size_t WS_ROWTOK = 52 * MiB;
constexpr size_t WS_KF = 64 * MiB;
constexpr size_t WS_WE1 = 192 * MiB;
constexpr size_t WS_WE2 = 704 * MiB;
constexpr size_t WS_H = 960 * MiB;
constexpr size_t WS_P = 1092 * MiB;
constexpr size_t WS_Y = 1488 * MiB;
constexpr size_t WS_QB = 1620 * MiB;
constexpr size_t WS_KVB = 1752 * MiB;
constexpr size_t WS_X0 = 1818 * MiB;
constexpr size_t WS_VG = 1950 * MiB;
constexpr size_t WS_VT = 2082 * MiB;
constexpr size_t WS_VTC = 2338 * MiB;
constexpr size_t WS_ACT = 2346 * MiB;
constexpr size_t WS_YM = 2890 * MiB;
constexpr size_t WS_END = 3434 * MiB;
constexpr int CW_BAR = 4096;
constexpr int CW_CNT = 16384;
constexpr int CW_DBG = 32768;

constexpr int RING_BYTES = 131072;
constexpr int AUX_OFF = RING_BYTES;
constexpr int AUX_BYTES = 16384;
constexpr int MISC_OFF = AUX_OFF + AUX_BYTES;
constexpr int MISC_BYTES = 4096;
constexpr int LDS_BYTES = MISC_OFF + MISC_BYTES;

#define GAS __attribute__((address_space(1)))
#define LAS __attribute__((address_space(3)))
typedef unsigned short bf16;
typedef unsigned v4u __attribute__((ext_vector_type(4)));
typedef unsigned v2u __attribute__((ext_vector_type(2)));
typedef float f32x4 __attribute__((ext_vector_type(4)));
typedef float f32x2 __attribute__((ext_vector_type(2)));
typedef float f32x16 __attribute__((ext_vector_type(16)));
typedef short bf16x8 __attribute__((ext_vector_type(8)));
typedef short s16x4 __attribute__((ext_vector_type(4)));
typedef int i32x4 __attribute__((ext_vector_type(4)));
typedef GAS unsigned gu32;
#define RLX_AGENT __ATOMIC_RELAXED, __HIP_MEMORY_SCOPE_AGENT
#define LDS_WAIT() asm volatile("s_waitcnt lgkmcnt(0)" ::: "memory")
#define VM_WAIT() asm volatile("s_waitcnt vmcnt(0)" ::: "memory")
__device__ __forceinline__ unsigned f2bf(float f) { unsigned u = __builtin_bit_cast(unsigned, f); return (u + 0x7fffu + ((u >> 16) & 1u)) >> 16; }
__device__ __forceinline__ unsigned pk2(float lo, float hi) { return f2bf(lo) | (f2bf(hi) << 16); }
__device__ __forceinline__ float bf2f(unsigned short b) { return __builtin_bit_cast(float, ((unsigned)b) << 16); }
__device__ __forceinline__ float bflo(unsigned w) { return __builtin_bit_cast(float, w << 16); }
__device__ __forceinline__ float bfhi(unsigned w) { return __builtin_bit_cast(float, w & 0xffff0000u); }
__device__ __forceinline__ unsigned cvt_pk_bf16(float lo, float hi) { unsigned r; asm volatile("v_cvt_pk_bf16_f32 %0, %1, %2" : "=v"(r) : "v"(lo), "v"(hi)); return r; }
__device__ __forceinline__ int opaque_tid() { int t = (int)threadIdx.x; asm volatile("" : "+v"(t)); return t; }
__device__ __forceinline__ float wave_sum(float v) {
#pragma unroll
    for (int o = 1; o < 64; o <<= 1) v += __shfl_xor(v, o);
    return v;
}

#define XB_TMO      128
#define XB_XCNT(j)  (256  + 64 * (j))
#define XB_XSUB(j)  (1280 + 64 * (j))
#define XB_XGEN(j)  (2304 + 64 * (j))
#define XB_TOP      3328
#define XB_TOPGEN   3392
#define XCD_BAR_WORDS 3456
#define XB_SPIN_CAP (1u << 22)
__device__ __forceinline__ unsigned xb_ld(unsigned* p)              { return __hip_atomic_load(p, __ATOMIC_RELAXED, __HIP_MEMORY_SCOPE_AGENT); }
__device__ __forceinline__ unsigned xb_add(unsigned* p, unsigned v) { return __hip_atomic_fetch_add(p, v, __ATOMIC_RELAXED, __HIP_MEMORY_SCOPE_AGENT); }
__device__ __forceinline__ unsigned xb_xcc_id() { return (unsigned)__builtin_amdgcn_s_getreg((3 << 11) | 20) & 0xFu; }
#define XB_SPIN(cond, bar) do { unsigned _sp = 0; while (cond) { __builtin_amdgcn_s_sleep(1); \
    if ((++_sp & 255u) == 0u) { if (xb_ld(&(bar)[XB_TMO])) break; if (_sp > XB_SPIN_CAP) { atomicAdd(&(bar)[XB_TMO], 1u); break; } } } } while (0)
struct XcdBarrier { unsigned* bar; unsigned x; volatile LAS unsigned* st; };
__device__ __forceinline__ XcdBarrier xcd_barrier_post(unsigned* bar, volatile LAS unsigned* st) {
    XcdBarrier b; b.bar = bar; b.x = xb_xcc_id(); b.st = st;
    if (threadIdx.x == 0) (void)xb_add(&bar[XB_XCNT(b.x)], 1u);
    return b;
}
__device__ __forceinline__ void xcd_barrier_complete(unsigned* bar, unsigned x, unsigned& nloc, unsigned& nx) {
    const unsigned G = gridDim.x * gridDim.y * gridDim.z;
    unsigned sum, cnt, mine, sp = 0u;
    for (;;) {
        sum = 0u; cnt = 0u; mine = 0u;
#pragma unroll
        for (unsigned j = 0; j < 16; ++j) { const unsigned c = xb_ld(&bar[XB_XCNT(j)]); sum += c; cnt += (c > 0u) ? 1u : 0u; mine = (j == x) ? c : mine; }
        if (sum == G) break;
        __builtin_amdgcn_s_sleep(1);
        if ((++sp & 255u) == 0u) { if (xb_ld(&bar[XB_TMO])) break; if (sp > XB_SPIN_CAP) { atomicAdd(&bar[XB_TMO], 1u); break; } }
    }
    nloc = mine > 0u ? mine : 1u; nx = cnt > 0u ? cnt : 1u;
}
__device__ __forceinline__ void xcd_barrier(const XcdBarrier& b) {
    asm volatile("s_waitcnt vmcnt(0)" ::: "memory");
    __syncthreads();
    if (threadIdx.x == 0) {
        unsigned* bar = b.bar;
        __builtin_amdgcn_s_waitcnt(0);
        unsigned nloc = b.st[0], nx = b.st[1];
        if (nloc == 0u) { xcd_barrier_complete(bar, b.x, nloc, nx); b.st[0] = nloc; b.st[1] = nx; }
        const unsigned old = xb_add(&bar[XB_XSUB(b.x)], 1u);
        const unsigned gen = old / nloc;
        if (old + 1u == (gen + 1u) * nloc) {
            __builtin_amdgcn_fence(__ATOMIC_RELEASE, "agent");
            asm volatile("s_waitcnt vmcnt(0)" ::: "memory");
            const unsigned og = xb_add(&bar[XB_TOP], 1u);
            const unsigned tg = og / nx;
            if (og + 1u == (tg + 1u) * nx) xb_add(&bar[XB_TOPGEN], 1u);
            else XB_SPIN(xb_ld(&bar[XB_TOPGEN]) == tg, bar);
            __builtin_amdgcn_fence(__ATOMIC_ACQUIRE, "agent");
            xb_add(&bar[XB_XGEN(b.x)], 1u);
            asm volatile("s_waitcnt vmcnt(0)" ::: "memory");
        } else {
            XB_SPIN(xb_ld(&bar[XB_XGEN(b.x)]) == gen, bar);
            __builtin_amdgcn_fence(__ATOMIC_ACQUIRE, "agent");
            asm volatile("s_waitcnt vmcnt(0)" ::: "memory");
        }
    }
    __syncthreads();
}

namespace pg8 {
constexpr int BM = 256, BK = 64, HALF = 128, HTB = HALF * BK * 2, STAGE_BYTES = 8 * HTB, NXCD = 8, WGM = 8;
constexpr int GK = 1024;
__device__ __forceinline__ int lds_byte(int r, int c) { const int st = (r >> 4) * 2 + (c >> 5), rr = r & 15, cc = c & 31, ob = rr * 64 + cc * 2; return st * 1024 + (ob ^ (((ob >> 9) & 1) << 5)); }
__device__ __forceinline__ void stage_rc(int b, int& R, int& C) { const int st = b / 1024, sb = b % 1024, swz = sb ^ (((sb >> 9) & 1) << 5); R = (st >> 1) * 16 + swz / 64; C = (st & 1) * 32 + (swz % 64) / 2; }
__device__ __forceinline__ int perm32(int rho) { const int n = rho >> 4, i = rho & 15; return 8 * (i >> 2) + 4 * n + (i & 3); }
struct Unit { int pm, pn, e; };

struct DenseSched {
    const char* A; const char* Bt; int nM, nN, nwg, G, c;
    __device__ __forceinline__ void init(const void* A_, const void* Bt_, int M, int N, int G_, int c_) { A = (const char*)A_; Bt = (const char*)Bt_; nM = M / BM; nN = N / BM; nwg = nM * nN; G = G_; c = c_; }
    __device__ __forceinline__ bool next(int i, Unit& u) const {
        const long L = (long)i * G + c; if (L >= nwg) return false;
        int wgid = (int)L; { const int q = nwg / NXCD, r = nwg % NXCD, xcd = wgid % NXCD, off = wgid / NXCD; wgid = (xcd < r ? xcd * (q + 1) : r * (q + 1) + (xcd - r) * q) + off; }
        const int nig = WGM * nN, gid = wgid / nig, fm = gid * WGM, gsz = (nM - fm) < WGM ? (nM - fm) : WGM;
        u.pm = fm + ((wgid % nig) % gsz); u.pn = (wgid % nig) / gsz; u.e = 0; return true;
    }
    __device__ __forceinline__ const char* a_ptr(const Unit& u) const { return A + (size_t)u.pm * (BM * GK * 2); }
    __device__ __forceinline__ const char* b_ptr(const Unit& u) const { return Bt + (size_t)u.pn * (BM * GK * 2); }
    __device__ __forceinline__ void a_offs(const Unit&, const int (&)[2], const int (&)[2], unsigned (&)[2][2]) const {}
};
struct MoeSched {
    const char* A; const char* Bt; size_t b_estride; const int* rowtok; const volatile LAS int* cumblk; const volatile LAS int* cnt; int ncol_log2, G, c;
    __device__ __forceinline__ bool next(int i, Unit& u) const {
        int gb, pn; const int ncol = 1 << ncol_log2;
        if (G == 256) { const int xcd = c & 7, j = c >> 3, rpb = 256 >> ncol_log2; gb = i * rpb + xcd + 8 * (j >> ncol_log2); pn = j & (ncol - 1); }
        else { const long L = (long)i * G + c; gb = (int)(L >> ncol_log2); pn = (int)(L & (ncol - 1)); }
        const int tot = cumblk[NE]; if (gb >= tot) return false;
        int e = 0;
#pragma unroll 1
        for (int s = 16; s >= 1; s >>= 1) { if (cumblk[e + s] <= gb) e += s; }
        u.pm = gb; u.pn = pn; u.e = e; return true;
    }
    __device__ __forceinline__ const char* a_ptr(const Unit& u) const { return rowtok ? A : A + (size_t)u.pm * (BM * GK * 2); }
    __device__ __forceinline__ const char* b_ptr(const Unit& u) const { return Bt + (size_t)u.e * b_estride + (size_t)u.pn * (BM * GK * 2); }
    __device__ __forceinline__ void a_offs(const Unit& u, const int (&R)[2], const int (&C)[2], unsigned (&voff)[2][2]) const {
        const int rb = u.pm - cumblk[u.e], n = cnt[u.e]; const int* rt = rowtok + (size_t)u.e * MT;
#pragma unroll
        for (int h = 0; h < 2; ++h)
#pragma unroll
            for (int i = 0; i < 2; ++i) { const int rank = rb * 256 + h * HALF + R[i]; const int tok = rank < n ? rt[rank] : 0; voff[h][i] = (unsigned)tok * (unsigned)(GK * 2) + (unsigned)C[i] * 2u; }
    }
};

template <class Epi, class Sched, bool GATHER>
__device__ __forceinline__ void gemm_phase(LAS unsigned char* lds, const Sched& S, const Epi& E) {
    const int tid = opaque_tid(), wid = __builtin_amdgcn_readfirstlane(tid >> 6), lane = tid & 63, wr = wid >> 2, wc = wid & 3, fr = lane & 15, fq = lane >> 4;
    constexpr int K = GK, nt = K / BK;
    unsigned voffA[2][2], voffB[2]; int Rr[2], Cc[2];
#pragma unroll
    for (int i = 0; i < 2; ++i) { int R, C; stage_rc(tid * 16 + i * 8192, R, C); Rr[i] = R; Cc[i] = C; const int Rb = Epi::PERM ? ((R & ~31) + perm32(R & 31)) : R;
        voffA[0][i] = (unsigned)(R * K + C) * 2u; voffA[1][i] = (unsigned)((R + HALF) * K + C) * 2u; voffB[i] = (unsigned)(Rb * K + C) * 2u; }
    constexpr size_t kstep = (size_t)(BK * 2);
    constexpr size_t hstep = (size_t)HALF * K * 2;
    const unsigned ldsw = (unsigned)wid * 1024u;
    const int aoff = lds_byte(wr * 64 + fr, fq * 8), boff = lds_byte(wc * 32 + fr, fq * 8);
#define PG8_SA(b, h) (((b) * 2 + (h)) * HTB)
#define PG8_SB(b, h) ((4 + (b) * 2 + (h)) * HTB)
#define PG8_STAGE(bufoff, gbase, voff) do { _Pragma("unroll") for (int _i = 0; _i < 2; ++_i) \
        __builtin_amdgcn_global_load_lds((const unsigned*)((const char*)(gbase) + (voff)[_i]), (LAS unsigned*)(lds + (bufoff) + ldsw + _i * 8192), 16, 0, 0); } while (0)
#define PG8_STAGE_A(bufoff, gbase, h) PG8_STAGE(bufoff, gbase, voffA[h])
#define PG8_LDA(dst, b, h) do { _Pragma("unroll") for (int m = 0; m < 4; ++m) _Pragma("unroll") for (int k = 0; k < 2; ++k) dst[m][k] = *(const LAS bf16x8*)(lds + PG8_SA(b, h) + aoff + m * 2048 + k * 1024); } while (0)
#define PG8_LDB(dst, b, h) do { _Pragma("unroll") for (int n = 0; n < 2; ++n) _Pragma("unroll") for (int k = 0; k < 2; ++k) dst[n][k] = *(const LAS bf16x8*)(lds + PG8_SB(b, h) + boff + n * 2048 + k * 1024); } while (0)
#define PG8_MMA(ai, bj, At, Bt) do { __builtin_amdgcn_s_setprio(1); _Pragma("unroll") for (int m = 0; m < 4; ++m) _Pragma("unroll") for (int n = 0; n < 2; ++n) _Pragma("unroll") for (int k = 0; k < 2; ++k) \
        acc[ai][bj][m][n] = __builtin_amdgcn_mfma_f32_16x16x32_bf16(Bt[n][k], At[m][k], acc[ai][bj][m][n], 0, 0, 0); __builtin_amdgcn_s_setprio(0); } while (0)
#define PG8_WAIT_V(n) asm volatile("s_waitcnt vmcnt(" #n ")" ::: "memory")
#define PG8_WAIT_L(n) asm volatile("s_waitcnt lgkmcnt(" #n ")" ::: "memory")
#define PG8_BAR __builtin_amdgcn_s_barrier()
#define PG8_SCHED __builtin_amdgcn_sched_barrier(0)
    Unit cur, nxt; int ui = 0;
    if (!S.next(0, cur)) return;
    f32x4 acc[2][2][4][2];
#pragma unroll
    for (int a = 0; a < 2; ++a)
#pragma unroll
        for (int b = 0; b < 2; ++b)
#pragma unroll
            for (int m = 0; m < 4; ++m)
#pragma unroll
                for (int n = 0; n < 2; ++n) acc[a][b][m][n] = (f32x4){0.f, 0.f, 0.f, 0.f};
    bf16x8 At[4][2], B0[2][2], B1[2][2];
    const char* cA = S.a_ptr(cur); const char* cB = S.b_ptr(cur);
    if constexpr (GATHER) S.a_offs(cur, Rr, Cc, voffA);
    PG8_STAGE(PG8_SB(0, 0), cB, voffB); PG8_STAGE(PG8_SB(0, 1), cB + hstep, voffB); PG8_STAGE_A(PG8_SA(0, 0), cA, 0); PG8_STAGE_A(PG8_SA(0, 1), cA, 1);
    if (wr == 1) PG8_BAR;
    PG8_WAIT_V(2); PG8_BAR;
    PG8_STAGE(PG8_SB(1, 0), cB + kstep, voffB); PG8_STAGE_A(PG8_SA(1, 0), cA + kstep, 0); PG8_STAGE(PG8_SB(1, 1), cB + hstep + kstep, voffB);
    PG8_WAIT_V(6); PG8_BAR;
    for (;;) {
        const bool has_next = S.next(ui + 1, nxt);
        const char* nA = has_next ? S.a_ptr(nxt) : cA; const char* nB = has_next ? S.b_ptr(nxt) : cB;
        for (int t = 0; t < nt; t += 2) {
            const bool last = (t == nt - 2);
            const char* a1 = cA + (size_t)(t + 1) * kstep;
            const char* a2 = last ? nA : cA + (size_t)(t + 2) * kstep; const char* b2 = last ? nB : cB + (size_t)(t + 2) * kstep;
            const char* a3 = a2 + kstep; const char* b3 = b2 + kstep;
            PG8_LDB(B0, 0, 0); PG8_LDB(B1, 0, 1); PG8_SCHED; PG8_LDA(At, 0, 0); PG8_STAGE_A(PG8_SA(1, 1), a1, 1);
            if constexpr (GATHER) { if (last && has_next) S.a_offs(nxt, Rr, Cc, voffA); }
            PG8_WAIT_V(8); PG8_WAIT_L(0); PG8_BAR; PG8_MMA(0, 0, At, B0); PG8_MMA(0, 1, At, B1); PG8_BAR; PG8_SCHED;
            PG8_LDA(At, 0, 1); PG8_STAGE(PG8_SB(0, 0), b2, voffB); PG8_STAGE(PG8_SB(0, 1), b2 + hstep, voffB); PG8_STAGE_A(PG8_SA(0, 0), a2, 0);
            PG8_WAIT_V(8); PG8_WAIT_L(0); PG8_BAR; PG8_MMA(1, 0, At, B0); PG8_MMA(1, 1, At, B1); PG8_BAR; PG8_SCHED;
            PG8_LDB(B0, 1, 0); PG8_LDB(B1, 1, 1); PG8_SCHED; PG8_LDA(At, 1, 0); PG8_STAGE_A(PG8_SA(0, 1), a2, 1);
            PG8_WAIT_V(8); PG8_WAIT_L(0); PG8_BAR; PG8_MMA(0, 0, At, B0); PG8_MMA(0, 1, At, B1); PG8_BAR; PG8_SCHED;
            PG8_LDA(At, 1, 1); PG8_STAGE(PG8_SB(1, 0), b3, voffB); PG8_STAGE(PG8_SB(1, 1), b3 + hstep, voffB); PG8_STAGE_A(PG8_SA(1, 0), a3, 0);
            PG8_WAIT_V(8); PG8_WAIT_L(0); PG8_BAR; PG8_MMA(1, 0, At, B0); PG8_MMA(1, 1, At, B1); PG8_BAR; PG8_SCHED;
        }
        if (wr == 0) PG8_BAR;
        E(acc, cur, wr, wc, fr, fq);
        if (!has_next) break;
#pragma unroll
        for (int a = 0; a < 2; ++a)
#pragma unroll
            for (int b = 0; b < 2; ++b)
#pragma unroll
                for (int m = 0; m < 4; ++m)
#pragma unroll
                    for (int n = 0; n < 2; ++n) acc[a][b][m][n] = (f32x4){0.f, 0.f, 0.f, 0.f};
        cur = nxt; cA = nA; cB = nB; ++ui;
        if (wr == 1) PG8_BAR;
    }
    PG8_WAIT_V(0);
    PG8_BAR;
#undef PG8_SA
#undef PG8_SB
#undef PG8_STAGE
#undef PG8_STAGE_A
#undef PG8_LDA
#undef PG8_LDB
#undef PG8_MMA
#undef PG8_WAIT_V
#undef PG8_WAIT_L
#undef PG8_BAR
#undef PG8_SCHED
}
}
namespace pg8 {
__device__ __forceinline__ f32x2 gelu_pk(f32x2 v) {
    const f32x2 av = __builtin_elementwise_abs(v), d = av * 0.2316418882f + 1.0f;
    f32x2 t; t.x = __builtin_amdgcn_rcpf(d.x); t.y = __builtin_amdgcn_rcpf(d.y);
    f32x2 q = t * 0.5307027145f + (-0.7265760135f); q = q * t + 0.7107068705f; q = q * t + (-0.142248368f); q = q * t + 0.127414796f; q = q * t;
    const f32x2 s = (v * v) * (-0.72134752044f);
    f32x2 e; e.x = __builtin_amdgcn_exp2f(s.x); e.y = __builtin_amdgcn_exp2f(s.y);
    const f32x2 m = v * (q * e), r = v - m;
    f32x2 o; o.x = v.x < 0.f ? m.x : r.x; o.y = v.y < 0.f ? m.y : r.y; return o;
}
struct EpiBf16 {
    static constexpr bool PERM = true;
    bf16* O; int ldc; float* ss; int ACT;
    __device__ __forceinline__ void operator()(const f32x4 (&acc)[2][2][4][2], const Unit& u, int wr, int wc, int fr, int fq) const {
        const int row0 = u.pm * BM + wr * 64 + fr, col0 = u.pn * BM + wc * 32 + 8 * fq;
#pragma unroll
        for (int ai = 0; ai < 2; ++ai)
#pragma unroll
            for (int m = 0; m < 4; ++m) { const int row = row0 + ai * HALF + m * 16; bf16* rowp = O + (size_t)row * ldc + col0; float sq = 0.f;
#pragma unroll
                for (int bj = 0; bj < 2; ++bj) { f32x4 v0 = acc[ai][bj][m][0], v1 = acc[ai][bj][m][1];
                    if (ACT == 1) { f32x2 a = gelu_pk((f32x2){v0[0], v0[1]}), b = gelu_pk((f32x2){v0[2], v0[3]}), c = gelu_pk((f32x2){v1[0], v1[1]}), d = gelu_pk((f32x2){v1[2], v1[3]});
                        v0 = (f32x4){a.x, a.y, b.x, b.y}; v1 = (f32x4){c.x, c.y, d.x, d.y};
                        sq += (v0[0] * v0[0] + v0[1] * v0[1]) + (v0[2] * v0[2] + v0[3] * v0[3]) + (v1[0] * v1[0] + v1[1] * v1[1]) + (v1[2] * v1[2] + v1[3] * v1[3]); }
                    v4u w; w.x = cvt_pk_bf16(v0[0], v0[1]); w.y = cvt_pk_bf16(v0[2], v0[3]); w.z = cvt_pk_bf16(v1[0], v1[1]); w.w = cvt_pk_bf16(v1[2], v1[3]);
                    *(v4u*)(rowp + bj * HALF) = w; }
                if (ACT == 1) { sq += __shfl_xor(sq, 16); sq += __shfl_xor(sq, 32);
                    if (u.pn >= 4 && fq == 0) ss[(size_t)row * 16 + (u.pn - 4) * 4 + wc] = sq; }
            }
    }
};
struct EpiResid {
    static constexpr bool PERM = false;
    const float* baseL; const float* baseC; float* outL; float* outC; const float* modl;
    __device__ __forceinline__ void operator()(const f32x4 (&acc)[2][2][4][2], const Unit& u, int wr, int wc, int fr, int fq) const {
        const bool lat = u.pm < ML / BM; const int rb = lat ? u.pm : u.pm - ML / BM, bidx = lat ? (u.pm >> 5) : 8;
        const float* base = (lat ? baseL : baseC) + (size_t)rb * BM * D; float* out = (lat ? outL : outC) + (size_t)rb * BM * D;
        const float* g = modl + bidx * 6144 + 2 * 1024;
        const int r0 = wr * 64 + fr, col0 = u.pn * BM + wc * 32 + 4 * fq;
        f32x4 gv[2][2];
#pragma unroll
        for (int bj = 0; bj < 2; ++bj)
#pragma unroll
            for (int n = 0; n < 2; ++n) gv[bj][n] = *(const f32x4*)(g + col0 + bj * HALF + n * 16);
#pragma unroll
        for (int ai = 0; ai < 2; ++ai)
#pragma unroll
            for (int m = 0; m < 4; ++m) { const size_t off = (size_t)(r0 + ai * HALF + m * 16) * D + col0;
#pragma unroll
                for (int bj = 0; bj < 2; ++bj)
#pragma unroll
                    for (int n = 0; n < 2; ++n) { const f32x4 bs = *(const f32x4*)(base + off + bj * HALF + n * 16); *(f32x4*)(out + off + bj * HALF + n * 16) = bs + gv[bj][n] * acc[ai][bj][m][n]; }
                asm volatile("" ::: "memory"); }
    }
};
struct EpiSwiglu {
    static constexpr bool PERM = true;
    bf16* O; const float* b1;
    __device__ __forceinline__ void operator()(const f32x4 (&acc)[2][2][4][2], const Unit& u, int wr, int wc, int fr, int fq) const {
        const int row0 = u.pm * BM + wr * 64 + fr, c0 = u.pn * HALF + wc * 32 + 8 * fq; const float* be = b1 + (size_t)u.e * 2048;
        f32x4 bg[2], bl[2];
#pragma unroll
        for (int n = 0; n < 2; ++n) { bg[n] = *(const f32x4*)(be + c0 + 4 * n); bl[n] = *(const f32x4*)(be + 1024 + c0 + 4 * n); }
#pragma unroll
        for (int ai = 0; ai < 2; ++ai)
#pragma unroll
            for (int m = 0; m < 4; ++m) { float o[8];
#pragma unroll
                for (int n = 0; n < 2; ++n)
#pragma unroll
                    for (int j = 0; j < 4; ++j) { float gl = acc[ai][0][m][n][j] + bg[n][j], li = acc[ai][1][m][n][j] + bl[n][j];
                        gl = fminf(gl, 7.0f); li = fminf(fmaxf(li, -7.0f), 7.0f);
                        const float sg = __builtin_amdgcn_rcpf(1.0f + __builtin_amdgcn_exp2f(gl * (-1.702f * 1.4426950408889634f)));
                        o[n * 4 + j] = gl * sg * (li + 1.0f); }
                v4u w; w.x = cvt_pk_bf16(o[0], o[1]); w.y = cvt_pk_bf16(o[2], o[3]); w.z = cvt_pk_bf16(o[4], o[5]); w.w = cvt_pk_bf16(o[6], o[7]);
                *(v4u*)(O + (size_t)(row0 + ai * HALF + m * 16) * D + c0) = w; }
    }
};
struct EpiBias {
    static constexpr bool PERM = true;
    bf16* O; const float* b2;
    __device__ __forceinline__ void operator()(const f32x4 (&acc)[2][2][4][2], const Unit& u, int wr, int wc, int fr, int fq) const {
        const int row0 = u.pm * BM + wr * 64 + fr, col0 = u.pn * BM + wc * 32 + 8 * fq; const float* be = b2 + (size_t)u.e * 1024;
        f32x4 bv[2][2];
#pragma unroll
        for (int bj = 0; bj < 2; ++bj)
#pragma unroll
            for (int n = 0; n < 2; ++n) bv[bj][n] = *(const f32x4*)(be + col0 + bj * HALF + 4 * n);
#pragma unroll
        for (int ai = 0; ai < 2; ++ai)
#pragma unroll
            for (int m = 0; m < 4; ++m) { bf16* rowp = O + (size_t)(row0 + ai * HALF + m * 16) * D + col0;
#pragma unroll
                for (int bj = 0; bj < 2; ++bj) { const f32x4 v0 = acc[ai][bj][m][0] + bv[bj][0], v1 = acc[ai][bj][m][1] + bv[bj][1];
                    v4u w; w.x = cvt_pk_bf16(v0[0], v0[1]); w.y = cvt_pk_bf16(v0[2], v0[3]); w.z = cvt_pk_bf16(v1[0], v1[1]); w.w = cvt_pk_bf16(v1[2], v1[3]);
                    *(v4u*)(rowp + bj * HALF) = w; } }
    }
};
}

namespace att {
constexpr int AD = 128, NW = 8, QBLK = 32, KVBLK = 64;
constexpr float SCALE = 0.088388347648318440f;
constexpr float THR = 8.f;
constexpr int LDQ = 1024, LDK = 512, LDO = 1024;
constexpr int SHM_V = KVBLK * AD * 2, SHM_K = KVBLK * AD * 2, SHM_ATTN = 2 * SHM_V + 2 * SHM_K + NW * 64 * 4;
#define KSWZ(row, colB) ((row) * 256 + ((colB) ^ (((row) & 7) << 4)))
#define SBAR() __builtin_amdgcn_sched_barrier(0)
__device__ __forceinline__ int crow(int r, int hi) { return (r & 3) + 8 * (r >> 2) + 4 * hi; }
__device__ __forceinline__ void partialSM(f32x16& p0, f32x16& p1, float& m_reg, float& mn, float& alpha) {
  constexpr float C = SCALE * 1.4426950408889634f;
  float pmax = p0[0]; for (int r = 1; r < 16; ++r) pmax = fmaxf(pmax, p0[r]); for (int r = 0; r < 16; ++r) pmax = fmaxf(pmax, p1[r]);
  { auto rr = __builtin_amdgcn_permlane32_swap(__float_as_uint(pmax), __float_as_uint(pmax), false, false);
    pmax = fmaxf(__uint_as_float(rr[0]), __uint_as_float(rr[1])); }
  if (__builtin_expect(__all(pmax - m_reg <= THR / SCALE), 1)) { mn = m_reg; alpha = 1.f; }
  else { mn = fmaxf(m_reg, pmax); alpha = __builtin_amdgcn_exp2f((m_reg - mn) * C); m_reg = mn; }
  float mnC = -mn * C;
  for (int r = 0; r < 16; ++r) p0[r] = fmaf(p0[r], C, mnC); for (int r = 0; r < 16; ++r) p1[r] = fmaf(p1[r], C, mnC);
  for (int r = 0; r < 16; ++r) p0[r] = __builtin_amdgcn_exp2f(p0[r]);
}
__device__ __forceinline__ void finishSM(f32x16& p0, f32x16& p1, float alpha, float& l_reg, bf16x8& pa0, bf16x8& pa1, bf16x8& pa2, bf16x8& pa3) {
  for (int r = 0; r < 16; ++r) p1[r] = __builtin_amdgcn_exp2f(p1[r]);
  float ps = 0; for (int r = 0; r < 16; ++r) ps += p0[r]; for (int r = 0; r < 16; ++r) ps += p1[r];
  { auto rr = __builtin_amdgcn_permlane32_swap(__float_as_uint(ps), __float_as_uint(ps), false, false);
    ps = __uint_as_float(rr[0]) + __uint_as_float(rr[1]); }
  l_reg = l_reg * alpha + ps;
#define PK4(P, BASE, OUT) do { unsigned a0 = cvt_pk_bf16(P[BASE + 0], P[BASE + 1]), a1 = cvt_pk_bf16(P[BASE + 2], P[BASE + 3]);   \
    unsigned b0 = cvt_pk_bf16(P[BASE + 4], P[BASE + 5]), b1 = cvt_pk_bf16(P[BASE + 6], P[BASE + 7]);                              \
    auto r0 = __builtin_amdgcn_permlane32_swap(a0, b0, false, false); auto r1 = __builtin_amdgcn_permlane32_swap(a1, b1, false, false); \
    v4u w = {r0[0], r1[0], r0[1], r1[1]}; OUT = *reinterpret_cast<bf16x8*>(&w); } while (0)
  PK4(p0, 0, pa0); PK4(p0, 8, pa1); PK4(p1, 0, pa2); PK4(p1, 8, pa3);
#undef PK4
}
__device__ __forceinline__ void qkt(f32x16& p0, f32x16& p1, const bf16* Ks, const bf16x8* qr, int r32, int hi) {
  p0 = f32x16{}; p1 = f32x16{};
  for (int d0 = 0; d0 < 8; ++d0) { int cb = (d0 * 16 + hi * 8) * 2;
    bf16x8 b0 = *reinterpret_cast<const bf16x8*>((const char*)Ks + KSWZ(r32, cb));
    bf16x8 b1 = *reinterpret_cast<const bf16x8*>((const char*)Ks + KSWZ(32 + r32, cb));
    p0 = __builtin_amdgcn_mfma_f32_32x32x16_bf16(b0, qr[d0], p0, 0, 0, 0);
    p1 = __builtin_amdgcn_mfma_f32_32x32x16_bf16(b1, qr[d0], p1, 0, 0, 0); }
}
__device__ __forceinline__ int v_st(int k, int c) { const int kk = (k & ~0xC) | ((k & 4) << 1) | ((k & 8) >> 1); return ((kk >> 3) * 4 + (c >> 5)) * 512 + ((kk & 7) * 32 + (c & 31)) * 2; }
__device__ __forceinline__ int v_rd_base(int lane) { return ((lane & 3) << 3) | (((lane >> 2) & 3) << 6) | (((lane >> 4) & 1) << 5) | (((lane >> 5) & 1) << 8); }
constexpr int v_rd_off(int d0, int ks, int half) { return d0 * 512 + ks * 4096 + half * 2048; }
template <int OFF> __device__ __forceinline__ s16x4 tr_read(int vb) {
  s16x4 r; asm volatile("ds_read_b64_tr_b16 %0, %1 offset:%2" : "=&v"(r) : "v"(vb), "i"(OFF) : "memory"); return r;
}
template <int D0> __device__ __forceinline__ void pv_one(f32x16& od, int vb, bf16x8 pa0, bf16x8 pa1, bf16x8 pa2, bf16x8 pa3) {
  const s16x4 l0 = tr_read<v_rd_off(D0, 0, 0)>(vb), h0 = tr_read<v_rd_off(D0, 0, 1)>(vb), l1 = tr_read<v_rd_off(D0, 1, 0)>(vb), h1 = tr_read<v_rd_off(D0, 1, 1)>(vb);
  const s16x4 l2 = tr_read<v_rd_off(D0, 2, 0)>(vb), h2 = tr_read<v_rd_off(D0, 2, 1)>(vb), l3 = tr_read<v_rd_off(D0, 3, 0)>(vb), h3 = tr_read<v_rd_off(D0, 3, 1)>(vb);
  asm volatile("s_waitcnt lgkmcnt(0)" ::: "memory"); SBAR();
#define PK(L, H) (bf16x8){L[0], L[1], L[2], L[3], H[0], H[1], H[2], H[3]}
  od = __builtin_amdgcn_mfma_f32_32x32x16_bf16(pa0, PK(l0, h0), od, 0, 0, 0);
  od = __builtin_amdgcn_mfma_f32_32x32x16_bf16(pa1, PK(l1, h1), od, 0, 0, 0);
  od = __builtin_amdgcn_mfma_f32_32x32x16_bf16(pa2, PK(l2, h2), od, 0, 0, 0);
  od = __builtin_amdgcn_mfma_f32_32x32x16_bf16(pa3, PK(l3, h3), od, 0, 0, 0);
#undef PK
}
__device__ __forceinline__ void pv_d0(f32x16* o, int vb, bf16x8 pa0, bf16x8 pa1, bf16x8 pa2, bf16x8 pa3) {
  pv_one<0>(o[0], vb, pa0, pa1, pa2, pa3); pv_one<1>(o[1], vb, pa0, pa1, pa2, pa3); pv_one<2>(o[2], vb, pa0, pa1, pa2, pa3); pv_one<3>(o[3], vb, pa0, pa1, pa2, pa3);
}
__device__ __forceinline__ void attn_dense_body(const bf16* __restrict__ Qb, const bf16* __restrict__ Kh, const bf16* __restrict__ Vh, bf16* __restrict__ Ob, int seq, char* lds) {
  const int tid = opaque_tid(), wid = tid >> 6, lane = tid & 63, r32 = lane & 31, hi = lane >> 5;
  bf16* V_lds = (bf16*)lds; bf16* K_lds = (bf16*)(lds + 2 * SHM_V);
  float* ws = (float*)(lds + 2 * SHM_V + 2 * SHM_K) + wid * 64; float* li_l = ws; float* al_l = ws + 32;
  float m_reg = -1e30f, l_reg = 0; f32x16 o[4] = {}; bf16x8 qr[8];
  const bf16* Qw = Qb + (long)(wid * QBLK + r32) * LDQ + hi * 8;
#pragma unroll
  for (int d0 = 0; d0 < 8; ++d0) qr[d0] = *reinterpret_cast<const bf16x8*>(Qw + d0 * 16);
  const int sr = tid >> 4, sc = (tid & 15) * 8, vst0 = v_st(sr, sc), vst1 = v_st(32 + sr, sc);
  const int vb0 = (int)(uintptr_t)V_lds + v_rd_base(lane);
  struct { bf16x8 vs0, vs1, ks0, ks1; } sr_[2];
#define SLOAD(i, k0) do { sr_[i].vs0 = *reinterpret_cast<const bf16x8*>(&Vh[(long)((k0) + sr) * LDK + sc]); sr_[i].vs1 = *reinterpret_cast<const bf16x8*>(&Vh[(long)((k0) + 32 + sr) * LDK + sc]); \
    sr_[i].ks0 = *reinterpret_cast<const bf16x8*>(&Kh[(long)((k0) + sr) * LDK + sc]); sr_[i].ks1 = *reinterpret_cast<const bf16x8*>(&Kh[(long)((k0) + 32 + sr) * LDK + sc]); } while (0)
#define SWRITE(b, i) do { *(bf16x8*)((char*)V_lds + (b) * SHM_V + vst0) = sr_[i].vs0;          \
    *(bf16x8*)((char*)V_lds + (b) * SHM_V + vst1) = sr_[i].vs1; int kc = sc * 2;               \
    *(bf16x8*)((char*)K_lds + (b) * SHM_K + KSWZ(sr, kc)) = sr_[i].ks0;                       \
    *(bf16x8*)((char*)K_lds + (b) * SHM_K + KSWZ(32 + sr, kc)) = sr_[i].ks1; } while (0)
#define SWAIT() asm volatile("s_waitcnt vmcnt(4)" ::: "memory")
#define RESC(a) do { if (__any((a) < 1.f)) { if (hi == 0) al_l[r32] = (a); asm volatile("s_waitcnt lgkmcnt(0)" ::: "memory"); \
    for (int d = 0; d < 4; ++d) for (int r = 0; r < 16; ++r) o[d][r] *= al_l[crow(r, hi)]; } } while (0)
  f32x16 pA0, pA1, pB0, pB1; float mnA, mnB, alA, alB; bf16x8 pa0, pa1, pa2, pa3; const int NT = seq / KVBLK;
  constexpr int SE = 0, SO = 1;
  SLOAD(SE, 0); asm volatile("s_waitcnt vmcnt(0)" ::: "memory"); SWRITE(0, SE); __syncthreads();
  qkt(pA0, pA1, K_lds, qr, r32, hi); partialSM(pA0, pA1, m_reg, mnA, alA);
  SLOAD(SO, KVBLK); if (2 < NT) SLOAD(SE, 2 * KVBLK);
  SWAIT(); SWRITE(1, SO); __syncthreads();
  for (int j = 1; j + 1 < NT; j += 2) {
    SBAR(); qkt(pB0, pB1, (bf16*)((char*)K_lds + SHM_K), qr, r32, hi);
    finishSM(pA0, pA1, alA, l_reg, pa0, pa1, pa2, pa3); SBAR();
    SLOAD(SO, (j + 2) * KVBLK); SBAR();
    pv_d0(o, vb0, pa0, pa1, pa2, pa3); partialSM(pB0, pB1, m_reg, mnB, alB);
    __syncthreads(); SWAIT(); SWRITE(0, SE);
    RESC(alB); __syncthreads();
    SBAR(); qkt(pA0, pA1, K_lds, qr, r32, hi);
    finishSM(pB0, pB1, alB, l_reg, pa0, pa1, pa2, pa3); SBAR();
    if (j + 3 < NT) SLOAD(SE, (j + 3) * KVBLK); SBAR();
    pv_d0(o, vb0 + (int)SHM_V, pa0, pa1, pa2, pa3); partialSM(pA0, pA1, m_reg, mnA, alA);
    __syncthreads(); SWAIT(); SWRITE(1, SO);
    RESC(alA); __syncthreads();
  }
  SBAR(); qkt(pB0, pB1, (bf16*)((char*)K_lds + SHM_K), qr, r32, hi);
  finishSM(pA0, pA1, alA, l_reg, pa0, pa1, pa2, pa3); SBAR();
  pv_d0(o, vb0, pa0, pa1, pa2, pa3); partialSM(pB0, pB1, m_reg, mnB, alB);
  __syncthreads(); RESC(alB);
  finishSM(pB0, pB1, alB, l_reg, pa0, pa1, pa2, pa3); SBAR();
  pv_d0(o, vb0 + (int)SHM_V, pa0, pa1, pa2, pa3);
  if (hi == 0) li_l[r32] = l_reg; asm volatile("s_waitcnt lgkmcnt(0)" ::: "memory");
  float rli[16];
#pragma unroll
  for (int r = 0; r < 16; ++r) rli[r] = __builtin_amdgcn_rcpf(li_l[crow(r, hi)]);
  bf16* Ow = Ob + (long)(wid * QBLK) * LDO;
#pragma unroll
  for (int r = 0; r < 16; ++r) { int orow = crow(r, hi);
    for (int d0 = 0; d0 < 4; ++d0) Ow[(long)orow * LDO + d0 * 32 + r32] = (bf16)f2bf(o[d0][r] * rli[r]); }
  __syncthreads();
#undef SLOAD
#undef SWRITE
#undef SWAIT
#undef RESC
}
#undef KSWZ
}
constexpr int NWAVES = 8, NTHREADS = 512;
struct Args { const float* in[36]; float* out; unsigned char* ws; int ph_lo, ph_hi; };
enum InIdx { I_X = 0, I_C, I_CTX, I_CCTX, I_ADAW, I_ADAB, I_N1G, I_N2G, I_WOUT, I_RW, I_RB, I_EW1, I_EB1, I_EW2, I_EB2, I_AWIN, I_AQG, I_AKG,
             I_GWIN, I_GVG, I_GWS, I_GBS, I_HWIN, I_HCW, I_HCB, I_FW1, I_FB1, I_FW2, I_FB2, I_FW3, I_FB3, I_FW4, I_FB4, I_FREQ, I_HD, I_FG };
struct Frame {
    LAS unsigned char* lds; volatile LAS unsigned* MISC; gu32* ctl;
    int tid, lane, wave, G, bx;
    float* out; unsigned char* ws;
};
template <class T> __device__ __forceinline__ T* launder(T* p) { unsigned long long v = (unsigned long long)p; asm volatile("" : "+s"(v)); return (T*)v; }
constexpr int MW_PTRS = 640;
__device__ __forceinline__ const float* pin_load(const Frame& F, int i) {
    const unsigned lo = __builtin_amdgcn_readfirstlane(F.MISC[MW_PTRS + 2 * i]), hi = __builtin_amdgcn_readfirstlane(F.MISC[MW_PTRS + 2 * i + 1]);
    return (const float*)(((unsigned long long)hi << 32) | lo);
}
#define PIN(F, i) pin_load(F, i)
__device__ __forceinline__ Frame phase_frame(const Frame& F0) {
    Frame F = F0; F.tid = opaque_tid(); F.lane = F.tid & 63; F.wave = __builtin_amdgcn_readfirstlane(F.tid >> 6);
    F.ws = launder(F0.ws); F.out = launder(F0.out); F.ctl = (gu32*)(F.ws + WS_CTL); return F;
}
constexpr int PH_PRO0 = 0, PH_PRO1 = 1, PH_L0 = 2, PH_PER_LAYER = 9, PH_FINAL = PH_L0 + NLAYER * PH_PER_LAYER, PH_COUNT = PH_FINAL + 1;
enum LPhase { LP_NORM1 = 0, LP_INPROJ, LP_MIX1, LP_MIX2, LP_MIX3, LP_OUTPROJ, LP_NORM2, LP_MOE1, LP_MOE2 };

__device__ __forceinline__ void transpose_item(const float* W, int K, int N, bf16* WT, int k0, int n0, int drow0, LAS float* scr, int lane) {
#pragma unroll 8
    for (int i = 0; i < 32; ++i) { const int kk = 2 * i + (lane >> 5); scr[kk * 33 + (lane & 31)] = W[(size_t)(k0 + kk) * N + n0 + (lane & 31)]; }
    LDS_WAIT(); asm volatile("" ::: "memory");
    const int c = lane & 7;
#pragma unroll
    for (int j = 0; j < 4; ++j) { const int n = (lane >> 3) + 8 * j; const LAS float* s = scr + (8 * c) * 33 + n;
        v4u o; o.x = pk2(s[0 * 33], s[1 * 33]); o.y = pk2(s[2 * 33], s[3 * 33]); o.z = pk2(s[4 * 33], s[5 * 33]); o.w = pk2(s[6 * 33], s[7 * 33]);
        *(GAS v4u*)(WT + (size_t)(drow0 + n) * K + k0 + 8 * c) = o; }
    LDS_WAIT(); asm volatile("" ::: "memory");
}
__device__ __forceinline__ void pro0_transposes(Frame& F) {
    LAS float* scr = (LAS float*)(F.lds + F.wave * 16384);
    const int gw = F.bx * NWAVES + F.wave, NGW = F.G * NWAVES;
    constexpr int R0 = 128 * 1024, R1 = 128 * 512, R2 = 2 * 768, R3 = 1024, R4 = 1536, R5 = 4 * 512, NITEMS = R0 + R1 + R2 + R3 + R4 + R5;
    for (int it = gw; it < NITEMS; it += NGW) {
        int r = it;
        if (r < R0) { const int mi = r >> 10, q = r & 1023, kb = q >> 6, nb = q & 63, n0 = nb * 32;
            const int d0 = n0 < 1024 ? 256 * (n0 >> 7) + (n0 & 127) : 256 * ((n0 - 1024) >> 7) + 128 + (n0 & 127);
            transpose_item(PIN(F, I_EW1) + (size_t)mi * 1024 * 2048, 1024, 2048, (bf16*)(F.ws + WS_WE1) + (size_t)mi * 2048 * 1024, kb * 64, n0, d0, scr, F.lane); continue; } r -= R0;
        if (r < R1) { const int mi = r >> 9, q = r & 511, kb = q >> 5, nb = q & 31;
            transpose_item(PIN(F, I_EW2) + (size_t)mi * 1024 * 1024, 1024, 1024, (bf16*)(F.ws + WS_WE2) + (size_t)mi * 1024 * 1024, kb * 64, nb * 32, nb * 32, scr, F.lane); continue; } r -= R1;
        if (r < R2) { const int mi = r / 768, q = r % 768, kb = q / 48, nb = q % 48;
            transpose_item(PIN(F, I_AWIN) + (size_t)mi * 1024 * 1536, 1024, 1536, (bf16*)(F.ws + WS_WATT) + (size_t)mi * 1536 * 1024, kb * 64, nb * 32, nb * 32, scr, F.lane); continue; } r -= R2;
        if (r < R3) { const int kb = r >> 6, nb = r & 63;
            transpose_item(PIN(F, I_GWIN), 1024, 2048, (bf16*)(F.ws + WS_WGM), kb * 64, nb * 32, nb * 32, scr, F.lane); continue; } r -= R3;
        if (r < R4) { const int kb = r / 96, nb = r % 96;
            transpose_item(PIN(F, I_HWIN), 1024, 3072, (bf16*)(F.ws + WS_WHY), kb * 64, nb * 32, nb * 32, scr, F.lane); continue; } r -= R4;
        { const int mi = r >> 9, q = r & 511, kb = q >> 5, nb = q & 31;
            transpose_item(PIN(F, I_WOUT) + (size_t)mi * 1024 * 1024, 1024, 1024, (bf16*)(F.ws + WS_WOUT) + (size_t)mi * 1024 * 1024, kb * 64, nb * 32, nb * 32, scr, F.lane); }
    }
}
__device__ __forceinline__ void pro0_mod(Frame& F) {
    LAS float* sl = (LAS float*)F.lds;
    LAS float* red = (LAS float*)(F.lds + 65536);
    __syncthreads();
    for (int i = F.tid; i < 9 * 1024; i += NTHREADS) { const int r = i >> 10, k = i & 1023; const float v = r < 8 ? PIN(F, I_C)[r * 1024 + k] : PIN(F, I_CCTX)[k]; sl[i] = v / (1.0f + __expf(-v)); }
    __syncthreads();
    float* MOD = (float*)(F.ws + WS_MOD);
    for (int item = F.bx; item < NLAYER * 96; item += F.G) {
        const int l = item / 96, n0 = (item % 96) * 64;
        const float* W = PIN(F, I_ADAW) + (size_t)l * 1024 * 6144 + n0 + F.lane;
        float acc[9];
#pragma unroll
        for (int r = 0; r < 9; ++r) acc[r] = 0.f;
        const int kb = F.wave * 128;
#pragma unroll 4
        for (int k = 0; k < 128; ++k) { const float wv = W[(size_t)(kb + k) * 6144];
#pragma unroll
            for (int r = 0; r < 9; ++r) acc[r] += sl[r * 1024 + kb + k] * wv; }
#pragma unroll
        for (int r = 0; r < 9; ++r) red[(F.wave * 9 + r) * 64 + F.lane] = acc[r];
        __syncthreads();
        for (int i = F.tid; i < 9 * 64; i += NTHREADS) { const int r = i >> 6, n = i & 63; float s = 0.f;
#pragma unroll
            for (int w = 0; w < 8; ++w) s += red[(w * 9 + r) * 64 + n];
            MOD[((size_t)l * 9 + r) * 6144 + n0 + n] = s + PIN(F, I_ADAB)[l * 6144 + n0 + n]; }
        __syncthreads();
    }
}
__device__ __forceinline__ void pro0_filter_mlp(Frame& F) {
    const int j = F.lane, gw = F.bx * NWAVES + F.wave, NGW = F.G * NWAVES;
    LAS float* W1 = (LAS float*)F.lds; LAS float* W2 = W1 + FEMB * FH; LAS float* W3 = W2 + FH * FH;
    __syncthreads();
    for (int i = F.tid; i < FEMB * FH; i += NTHREADS) W1[i] = PIN(F, I_FW1)[i];
    for (int i = F.tid; i < FH * FH; i += NTHREADS) { W2[i] = PIN(F, I_FW2)[i]; W3[i] = PIN(F, I_FW3)[i]; }
    __syncthreads();
    const float b1 = PIN(F, I_FB1)[j], b2 = PIN(F, I_FB2)[j], b3 = PIN(F, I_FB3)[j], fr = PIN(F, I_FREQ)[j];
    for (int it = gw; it < SEQ + CL; it += NGW) {
        const bool lat = it < SEQ; const int t = lat ? it : it - SEQ; const float L = lat ? (float)SEQ : (float)CL;
        const float tl = (float)t / (L - 1.0f), w = (6.283185307179586f * (float)t) / L;
        float z;
        { const int band = (j - 1) & 15; const float f = 1e-4f + (float)band * ((15.0f - 1e-4f) / 15.0f); const float a = f * w;
          z = (j == 0) ? tl : (j <= 16 ? cosf(a) : -sinf(a)); }
        float s = b1;
#pragma unroll
        for (int i = 0; i < FEMB; ++i) s += __shfl(z, i) * W1[i * FH + j];
        const float a1 = sinf(fr * s);
        s = b2;
#pragma unroll 16
        for (int i = 0; i < FH; ++i) s += __shfl(a1, i) * W2[i * FH + j];
        const float a2 = sinf(fr * s);
        s = b3;
#pragma unroll 16
        for (int i = 0; i < FH; ++i) s += __shfl(a2, i) * W3[i * FH + j];
        const float a3 = sinf(fr * s);
        float* dst = lat ? (float*)(F.ws + WS_A3) + (size_t)t * FH : (float*)(F.ws + WS_A3C) + (size_t)t * FH;
        dst[j] = a3;
    }
    __syncthreads();
}

__device__ __forceinline__ f32x2 cmul(f32x2 a, f32x2 b) { return (f32x2){a.x * b.x - a.y * b.y, a.x * b.y + a.y * b.x}; }
__device__ __forceinline__ f32x2 cconj(f32x2 a) { return (f32x2){a.x, -a.y}; }
__device__ __forceinline__ void fft16k_dif(LAS f32x2* z, int tid) {
#pragma unroll 1
    for (int lq = 12; lq >= 0; lq -= 2) {
        const int q = 1 << lq; const float inv_lb = 1.0f / (float)(4 * q);
#pragma unroll 2
        for (int bf = tid; bf < 4096; bf += NTHREADS) {
            const int j = bf & (q - 1), base = ((bf >> lq) << (lq + 2)) + j;
            const f32x2 x0 = z[base], x1 = z[base + q], x2 = z[base + 2 * q], x3 = z[base + 3 * q];
            const f32x2 t0 = x0 + x2, t1 = x0 - x2, t2 = x1 + x3, d = x1 - x3, t3 = (f32x2){d.y, -d.x};
            const f32x2 y0 = t0 + t2, y2 = t0 - t2, y1 = t1 + t3, y3 = t1 - t3;
            const float fr = (float)j * inv_lb;
            const f32x2 w1 = (f32x2){__builtin_amdgcn_cosf(fr), -__builtin_amdgcn_sinf(fr)}, w2 = cmul(w1, w1), w3 = cmul(w1, w2);
            z[base] = y0; z[base + q] = cmul(y2, w2); z[base + 2 * q] = cmul(y1, w1); z[base + 3 * q] = cmul(y3, w3);
        }
        __syncthreads();
    }
}
__device__ __forceinline__ void fft16k_dit_inv(LAS f32x2* z, int tid) {
#pragma unroll 1
    for (int lq = 0; lq <= 12; lq += 2) {
        const int q = 1 << lq; const float inv_lb = 1.0f / (float)(4 * q);
#pragma unroll 2
        for (int bf = tid; bf < 4096; bf += NTHREADS) {
            const int j = bf & (q - 1), base = ((bf >> lq) << (lq + 2)) + j;
            const float fr = (float)j * inv_lb;
            const f32x2 w1 = (f32x2){__builtin_amdgcn_cosf(fr), __builtin_amdgcn_sinf(fr)}, w2 = cmul(w1, w1), w3 = cmul(w1, w2);
            const f32x2 A0 = z[base], A1 = cmul(z[base + q], w2), A2 = cmul(z[base + 2 * q], w1), A3 = cmul(z[base + 3 * q], w3);
            const f32x2 u0 = A0 + A1, u1 = A0 - A1, u2 = A2 + A3, u3 = A2 - A3, iu3 = (f32x2){-u3.y, u3.x};
            z[base] = u0 + u2; z[base + q] = u1 + iu3; z[base + 2 * q] = u0 - u2; z[base + 3 * q] = u1 - iu3;
        }
        __syncthreads();
    }
}
__device__ __forceinline__ int rev14(int p) { return (int)(__brev((unsigned)p) >> 18); }
__device__ __forceinline__ float hy_delta(int c) { const float mn = -3.0701134573253945f, mx = -15.350567286626973f; return fabsf(mn + (mx - mn) * ((float)c / 1023.0f)); }

__device__ __forceinline__ void pro1_filters(Frame& F) {
    LAS f32x2* z = (LAS f32x2*)F.lds;
    LAS float* wl = (LAS float*)(F.lds + AUX_OFF);
    const float* a3 = (const float*)(F.ws + WS_A3); const float* a3c = (const float*)(F.ws + WS_A3C);
    f32x2* KF = (f32x2*)(F.ws + WS_KF); float* FCT = (float*)(F.ws + WS_FCT);
    for (int u = F.bx; u < 512; u += F.G) {
        const int ca = 2 * u, cb = 2 * u + 1;
        __syncthreads();
        if (F.tid < 256) { const int which = F.tid >> 6, m = F.tid & 63; const int col = (which & 1 ? cb : ca) + (which >> 1) * 1024; wl[which * 64 + m] = PIN(F, I_FW4)[m * 2048 + col]; }
        if (F.tid < 4) { const int col = (F.tid & 1 ? cb : ca) + (F.tid >> 1) * 1024; wl[256 + F.tid] = PIN(F, I_FB4)[col]; }
        __syncthreads();
        const float da = hy_delta(ca), db = hy_delta(cb);
        for (int t = F.tid; t < SEQ; t += NTHREADS) {
            const f32x4* ar = (const f32x4*)(a3 + (size_t)t * FH); float s0 = wl[256], s1 = wl[257], s2 = wl[258], s3 = wl[259];
#pragma unroll 4
            for (int m4 = 0; m4 < 16; ++m4) { const f32x4 a = ar[m4];
#pragma unroll
                for (int i = 0; i < 4; ++i) { const int m = m4 * 4 + i; s0 += a[i] * wl[m]; s1 += a[i] * wl[64 + m]; s2 += a[i] * wl[128 + m]; s3 += a[i] * wl[192 + m]; } }
            const float tl = (float)t / (float)(SEQ - 1); const float wa = __expf(-tl * da), wb = __expf(-tl * db);
            z[t] = (f32x2){s0 * wa, s1 * wb};
            if (t == 0) z[SEQ] = (f32x2){0.f, 0.f}; else z[NFFT - t] = (f32x2){s2 * wa, s3 * wb};
        }
        for (int i = F.tid; i < 511; i += NTHREADS) {
            const int d = i - 255, t = d < 0 ? -d : d; const int o = d < 0 ? 2 : 0;
            const float* ar = a3c + (size_t)t * FH; float sa = wl[256 + o], sb = wl[257 + o];
            for (int m = 0; m < FH; ++m) { const float a = ar[m]; sa += a * wl[o * 64 + m]; sb += a * wl[(o + 1) * 64 + m]; }
            const float tl = (float)t / (float)(CL - 1);
            FCT[(size_t)ca * 512 + d + 256] = sa * __expf(-tl * da); FCT[(size_t)cb * 512 + d + 256] = sb * __expf(-tl * db);
        }
        __syncthreads();
        fft16k_dif(z, F.tid);
        for (int p = F.tid; p < NFFT; p += NTHREADS) {
            const int k = rev14(p), p2 = rev14((NFFT - k) & (NFFT - 1));
            if (p <= p2) { const f32x2 a = z[p], b = z[p2];
                const f32x2 Ka = (f32x2){0.5f * (a.x + b.x), 0.5f * (a.y - b.y)};
                const f32x2 Kb = (f32x2){0.5f * (a.y + b.y), -0.5f * (a.x - b.x)};
                KF[(size_t)ca * NFFT + p] = Ka; KF[(size_t)cb * NFFT + p] = Kb; KF[(size_t)ca * NFFT + p2] = cconj(Ka); KF[(size_t)cb * NFFT + p2] = cconj(Kb); }
        }
    }
    __syncthreads();
}

__device__ __forceinline__ void hyena_conv_phase(Frame& F) {
    LAS f32x2* z = (LAS f32x2*)F.lds;
    LAS float* aux = (LAS float*)(F.lds + AUX_OFF);
    float* VT = (float*)(F.ws + WS_VT); float* VTC = (float*)(F.ws + WS_VTC);
    const f32x2* KF = (const f32x2*)(F.ws + WS_KF); const float* FCT = (const float*)(F.ws + WS_FCT);
    for (int u = F.bx; u < NB * 512; u += F.G) {
        const int b = u >> 9, cp = u & 511, ca = 2 * cp, cb = ca + 1;
        float* va = VT + ((size_t)b * 1024 + ca) * SEQ; float* vb = va + SEQ;
        __syncthreads();
        for (int n = F.tid; n < SEQ; n += NTHREADS) { z[n] = (f32x2){va[n], vb[n]}; z[SEQ + n] = (f32x2){0.f, 0.f}; }
        { const int h = F.tid >> 8, t = F.tid & 255; float* vc = VTC + ((size_t)b * 1024 + ca + h) * CL;
          aux[h * 256 + t] = vc[t]; aux[512 + h * 512 + t] = FCT[(size_t)(ca + h) * 512 + t]; aux[512 + h * 512 + 256 + t] = FCT[(size_t)(ca + h) * 512 + 256 + t];
          __syncthreads();
          float y = 0.f;
#pragma unroll 8
          for (int s = 0; s < CL; ++s) y += aux[h * 256 + s] * aux[512 + h * 512 + (t - s) + 256];
          vc[t] = y; }
        fft16k_dif(z, F.tid);
        const f32x2* Ka = KF + (size_t)ca * NFFT; const f32x2* Kb = KF + (size_t)cb * NFFT;
        for (int p = F.tid; p < NFFT; p += NTHREADS) {
            const int k = rev14(p), p2 = rev14((NFFT - k) & (NFFT - 1));
            if (p <= p2) { const f32x2 a = z[p], b2 = z[p2];
                const f32x2 Va = (f32x2){0.5f * (a.x + b2.x), 0.5f * (a.y - b2.y)}, Vb = (f32x2){0.5f * (a.y + b2.y), -0.5f * (a.x - b2.x)};
                const f32x2 ya = cmul(Va, Ka[p]), yb = cmul(Vb, Kb[p]);
                z[p] = (f32x2){ya.x - yb.y, ya.y + yb.x};
                z[p2] = (f32x2){ya.x + yb.y, -ya.y + yb.x}; }
        }
        __syncthreads();
        fft16k_dit_inv(z, F.tid);
        const float sc = 1.0f / (float)NFFT;
        for (int n = F.tid; n < SEQ; n += NTHREADS) { const f32x2 w = z[n]; va[n] = w.x * sc; vb[n] = w.y * sc; }
    }
    __syncthreads();
}
constexpr int MW_CUMBLK = 16, MW_CNT = 64, MW_SELE = 128, MW_SELV = 256, MW_LRANK = 384, MW_LBASE = 512;
__device__ __forceinline__ void moe_tables(Frame& F, int layer) {
    __syncthreads();
    if (F.tid < NE) F.MISC[MW_CNT + F.tid] = __hip_atomic_load(F.ctl + CW_CNT + layer * NE + F.tid, RLX_AGENT);
    __syncthreads();
    if (F.tid == 0) { unsigned c = 0; for (int e = 0; e < NE; ++e) { F.MISC[MW_CUMBLK + e] = c; c += (F.MISC[MW_CNT + e] + 255u) >> 8; } F.MISC[MW_CUMBLK + NE] = c; }
    __syncthreads();
}

template <int MODE> __device__ __forceinline__ void rowpass(Frame& F, int layer) {
    const bool last = layer == NLAYER - 1;
    const int nrows = (MODE == 2 || (MODE == 1 && last)) ? ML : MT;
    const bool combine = (MODE == 0 && layer > 0) || MODE == 2;
    const int cl = MODE == 2 ? NLAYER - 1 : layer - 1;
    const bool from_input = (MODE == 0 && layer == 0);
    const float* XLs = from_input ? PIN(F, I_X) : F.out; const float* XCs = from_input ? PIN(F, I_CTX) : (const float*)(F.ws + WS_XC);
    float* XLd = F.out; float* XCd = (float*)(F.ws + WS_XC);
    const float* MOD = (const float*)(F.ws + WS_MOD);
    bf16* H = (bf16*)(F.ws + WS_H); const bf16* YM = (const bf16*)(F.ws + WS_YM);
    int* TE = (int*)(F.ws + WS_TE); int* TR = (int*)(F.ws + WS_TR); float* TG = (float*)(F.ws + WS_TG); int* ROWTOK = (int*)(F.ws + WS_ROWTOK);
    const float* gnorm = MODE == 0 ? PIN(F, I_N1G) + layer * D : (MODE == 1 ? PIN(F, I_N2G) + layer * D : PIN(F, I_FG));
    LAS float* RW = (LAS float*)F.lds;
    LAS float* hst = (LAS float*)(F.lds + AUX_OFF) + F.wave * 512;
    if (combine) moe_tables(F, cl);
    if (MODE == 1) { __syncthreads(); const f32x4* src = (const f32x4*)(PIN(F, I_RW) + (size_t)layer * D * NE); for (int i = F.tid; i < D * NE / 4; i += NTHREADS) ((LAS f32x4*)RW)[i] = src[i]; __syncthreads(); }
    f32x4 gn[4];
#pragma unroll
    for (int j = 0; j < 4; ++j) gn[j] = ((const f32x4*)gnorm)[F.lane + 64 * j];
    const int ntiles = nrows / 32;
    for (int tile = F.bx; tile < ntiles; tile += F.G) {
#pragma unroll 1
        for (int rr = 0; rr < 4; ++rr) {
            const int r = tile * 32 + F.wave * 4 + rr; const bool lat = r < ML; const int bidx = lat ? (r >> 13) : 8;
            const size_t xo = lat ? (size_t)r * D : (size_t)(r - ML) * D;
            const f32x4* xs = (const f32x4*)((lat ? XLs : XCs) + xo);
            f32x4 v[4];
#pragma unroll
            for (int j = 0; j < 4; ++j) v[j] = xs[F.lane + 64 * j];
            if (combine) {
                const i32x4 te = *(const i32x4*)(TE + (size_t)r * 4), tr = *(const i32x4*)(TR + (size_t)r * 4); const f32x4 tg = *(const f32x4*)(TG + (size_t)r * 4);
                const float* g2 = MOD + ((size_t)cl * 9 + bidx) * 6144 + 5 * 1024;
                f32x4 a[4];
#pragma unroll
                for (int j = 0; j < 4; ++j) a[j] = (f32x4){0.f, 0.f, 0.f, 0.f};
#pragma unroll
                for (int k = 0; k < 4; ++k) { const int rowid = 256 * (int)F.MISC[MW_CUMBLK + te[k]] + tr[k]; const v2u* yr = (const v2u*)(YM + (size_t)rowid * D); const float gk = tg[k];
#pragma unroll
                    for (int j = 0; j < 4; ++j) { const v2u w = yr[F.lane + 64 * j]; a[j] += gk * (f32x4){bflo(w.x), bfhi(w.x), bflo(w.y), bfhi(w.y)}; } }
#pragma unroll
                for (int j = 0; j < 4; ++j) v[j] += ((const f32x4*)g2)[F.lane + 64 * j] * a[j];
                if (MODE == 0) { f32x4* xd = (f32x4*)((lat ? XLd : XCd) + xo);
#pragma unroll
                    for (int j = 0; j < 4; ++j) xd[F.lane + 64 * j] = v[j]; }
            }
            float ss = 0.f;
#pragma unroll
            for (int j = 0; j < 4; ++j) ss += (v[j].x * v[j].x + v[j].y * v[j].y) + (v[j].z * v[j].z + v[j].w * v[j].w);
            const float rstd = 1.0f / sqrtf(wave_sum(ss) * (1.0f / D) + EPS);
            if (MODE == 2) { f32x4* od = (f32x4*)(F.out + xo);
#pragma unroll
                for (int j = 0; j < 4; ++j) od[F.lane + 64 * j] = v[j] * rstd * gn[j];
                continue; }
            const float* mb = MOD + ((size_t)layer * 9 + bidx) * 6144 + (MODE == 0 ? 0 : 3 * 1024);
            f32x4 hv[4];
#pragma unroll
            for (int j = 0; j < 4; ++j) { const f32x4 sh = ((const f32x4*)mb)[F.lane + 64 * j], sc = ((const f32x4*)(mb + 1024))[F.lane + 64 * j]; hv[j] = v[j] * rstd * gn[j] * (sc + 1.0f) + sh; }
            v2u* hd = (v2u*)(H + (size_t)r * D);
#pragma unroll
            for (int j = 0; j < 4; ++j) { v2u w; w.x = cvt_pk_bf16(hv[j].x, hv[j].y); w.y = cvt_pk_bf16(hv[j].z, hv[j].w); hd[F.lane + 64 * j] = w; }
            if (MODE == 1) {
                const int e = F.lane & 31, par = F.lane >> 5; float acc = 0.f;
#pragma unroll
                for (int ph = 0; ph < 2; ++ph) {
                    LDS_WAIT(); asm volatile("" ::: "memory");
                    *(LAS f32x4*)(hst + 4 * F.lane) = hv[2 * ph]; *(LAS f32x4*)(hst + 256 + 4 * F.lane) = hv[2 * ph + 1];
                    LDS_WAIT(); asm volatile("" ::: "memory");
                    const LAS float* rwp = RW + (size_t)(512 * ph + par) * NE + e; const LAS float* hp = hst + par;
#pragma unroll 8
                    for (int m = 0; m < 256; ++m) acc += hp[2 * m] * rwp[2 * m * NE];
                }
                acc += __shfl_xor(acc, 32);
                const float logit = acc + PIN(F, I_RB)[layer * NE + e];
                int rank = 0;
#pragma unroll
                for (int i = 0; i < NE; ++i) { const float o = __shfl(logit, i); rank += (o > logit || (o == logit && i < e)) ? 1 : 0; }
                const int slot = F.wave * 4 + rr;
                if (F.lane < 32 && rank < 4) { F.MISC[MW_SELE + slot * 4 + rank] = (unsigned)e; F.MISC[MW_SELV + slot * 4 + rank] = __float_as_uint(logit); }
                LDS_WAIT(); asm volatile("" ::: "memory");
                { const int k = F.lane & 3; const float vk = __uint_as_float(F.MISC[MW_SELV + slot * 4 + k]); const float v0 = __shfl(vk, 0);
                  float ex = __expf(vk - v0); float sm = ex; sm += __shfl_xor(sm, 1); sm += __shfl_xor(sm, 2);
                  if (F.lane < 4) { TG[(size_t)r * 4 + k] = ex / sm; TE[(size_t)r * 4 + k] = (int)F.MISC[MW_SELE + slot * 4 + k]; } }
            }
        }
        if (MODE == 1) {
            __syncthreads();
            if (F.tid < NE) { unsigned cnt = 0;
                for (int a = 0; a < 128; ++a) { if (F.MISC[MW_SELE + a] == (unsigned)F.tid) { F.MISC[MW_LRANK + a] = cnt; ++cnt; } }
                unsigned base = 0; if (cnt) base = __hip_atomic_fetch_add(F.ctl + CW_CNT + layer * NE + F.tid, cnt, RLX_AGENT);
                F.MISC[MW_LBASE + F.tid] = base; }
            __syncthreads();
            if (F.tid < 128) { const int a = F.tid; const int e = (int)F.MISC[MW_SELE + a]; const int rank = (int)(F.MISC[MW_LBASE + e] + F.MISC[MW_LRANK + a]); const int tok = tile * 32 + (a >> 2);
                TR[(size_t)tok * 4 + (a & 3)] = rank; ROWTOK[(size_t)e * MT + rank] = tok; }
            __syncthreads();
        }
    }
}

__device__ __forceinline__ void normrope16(float (&x)[16], const float* gain, bool lat, int prow, int pcol, const LAS f32x2* T, int L) {
    float ss = 0.f;
#pragma unroll
    for (int i = 0; i < 16; ++i) ss += x[i] * x[i];
    ss += __shfl_xor(ss, 1); ss += __shfl_xor(ss, 2); ss += __shfl_xor(ss, 4);
    const float rstd = 1.0f / sqrtf(ss * (1.0f / 128.0f) + EPS);
    const int o = (L & 7) * 16;
#pragma unroll
    for (int i = 0; i < 16; ++i) x[i] = x[i] * rstd * gain[o + i];
    float p[16];
#pragma unroll
    for (int i = 0; i < 16; ++i) p[i] = __shfl_xor(x[i], 2);
    if (lat) {
        const int pos = (L & 4) ? pcol : prow; const float sgn = (L & 2) ? 1.0f : -1.0f; const LAS f32x2* t = T + pos * 32 + (L & 1) * 16;
#pragma unroll
        for (int i = 0; i < 16; ++i) { const f32x2 cs = t[i]; x[i] = x[i] * cs.x + sgn * p[i] * cs.y; }
    }
}
__device__ __forceinline__ void qkprep_phase(Frame& F, int j) {
    LAS f32x2* T = (LAS f32x2*)F.lds;
    __syncthreads();
    for (int i = F.tid; i < 128 * 32; i += NTHREADS) { const int pos = i >> 5, f = i & 31; const float inv = powf(10000.0f, -(float)f / 32.0f); const float ang = (float)pos * inv; float s, c; sincosf(ang, &s, &c); T[i] = (f32x2){c, s}; }
    __syncthreads();
    const bf16* P = (const bf16*)(F.ws + WS_P); bf16* QB = (bf16*)(F.ws + WS_QB); bf16* KVB = (bf16*)(F.ws + WS_KVB);
    const float* qg = PIN(F, I_AQG) + j * 128; const float* kg = PIN(F, I_AKG) + j * 128;
    const int gw = F.bx * NWAVES + F.wave, NGW = F.G * NWAVES, L = F.lane;
    for (int r = gw; r < MT; r += NGW) {
        const bool lat = r < ML; const int b = lat ? (r >> 13) : ((r - ML) >> 8); const int s = lat ? (r & (SEQ - 1)) : ((r - ML) & (CL - 1));
        const int prow = s >> 6, pcol = s & 63; const size_t kvrow = (size_t)b * SKV + (lat ? s : SEQ + s);
        const bf16* pr = P + (size_t)r * 1536;
        { const v4u a = *(const v4u*)(pr + 16 * L), c = *(const v4u*)(pr + 16 * L + 8); float x[16];
          x[0] = bflo(a.x); x[1] = bfhi(a.x); x[2] = bflo(a.y); x[3] = bfhi(a.y); x[4] = bflo(a.z); x[5] = bfhi(a.z); x[6] = bflo(a.w); x[7] = bfhi(a.w);
          x[8] = bflo(c.x); x[9] = bfhi(c.x); x[10] = bflo(c.y); x[11] = bfhi(c.y); x[12] = bflo(c.z); x[13] = bfhi(c.z); x[14] = bflo(c.w); x[15] = bfhi(c.w);
          normrope16(x, qg, lat, prow, pcol, T, L);
          v4u o0, o1; o0.x = cvt_pk_bf16(x[0], x[1]); o0.y = cvt_pk_bf16(x[2], x[3]); o0.z = cvt_pk_bf16(x[4], x[5]); o0.w = cvt_pk_bf16(x[6], x[7]);
          o1.x = cvt_pk_bf16(x[8], x[9]); o1.y = cvt_pk_bf16(x[10], x[11]); o1.z = cvt_pk_bf16(x[12], x[13]); o1.w = cvt_pk_bf16(x[14], x[15]);
          *(v4u*)(QB + (size_t)r * D + 16 * L) = o0; *(v4u*)(QB + (size_t)r * D + 16 * L + 8) = o1; }
        { const int Lk = L & 15; const v4u a = *(const v4u*)(pr + 1024 + 16 * Lk), c = *(const v4u*)(pr + 1024 + 16 * Lk + 8); float x[16];
          x[0] = bflo(a.x); x[1] = bfhi(a.x); x[2] = bflo(a.y); x[3] = bfhi(a.y); x[4] = bflo(a.z); x[5] = bfhi(a.z); x[6] = bflo(a.w); x[7] = bfhi(a.w);
          x[8] = bflo(c.x); x[9] = bfhi(c.x); x[10] = bflo(c.y); x[11] = bfhi(c.y); x[12] = bflo(c.z); x[13] = bfhi(c.z); x[14] = bflo(c.w); x[15] = bfhi(c.w);
          normrope16(x, kg, lat, prow, pcol, T, Lk);
          if (L < 16) { v4u o0, o1; o0.x = cvt_pk_bf16(x[0], x[1]); o0.y = cvt_pk_bf16(x[2], x[3]); o0.z = cvt_pk_bf16(x[4], x[5]); o0.w = cvt_pk_bf16(x[6], x[7]);
            o1.x = cvt_pk_bf16(x[8], x[9]); o1.y = cvt_pk_bf16(x[10], x[11]); o1.z = cvt_pk_bf16(x[12], x[13]); o1.w = cvt_pk_bf16(x[14], x[15]);
            *(v4u*)(KVB + kvrow * 512 + 16 * L) = o0; *(v4u*)(KVB + kvrow * 512 + 16 * L + 8) = o1; }
          else if (L < 48) { const int q = L - 16; *(v4u*)(KVB + kvrow * 512 + 256 + 8 * q) = *(const v4u*)(pr + 1280 + 8 * q); } }
    }
}
__device__ __forceinline__ void attention_phase(Frame& F, char* lds_generic, bool ctx_queries) {
    const bf16* QB = (const bf16*)(F.ws + WS_QB); const bf16* KVB = (const bf16*)(F.ws + WS_KVB); bf16* Y = (bf16*)(F.ws + WS_Y);
    const int nunits = 2048 + (ctx_queries ? 64 : 0);
    for (int u = F.bx; u < nunits; u += F.G) {
        if (u < 2048) { const int b = u >> 8, w = u & 255, h = w & 7, qb = w >> 3; const size_t qo = ((size_t)b * SEQ + (size_t)qb * 256) * D + h * 128; const bf16* kh = KVB + (size_t)b * SKV * 512 + (h >> 2) * 128;
            att::attn_dense_body(QB + qo, kh, kh + 256, Y + qo, SKV, lds_generic); }
        else { const int w = u - 2048, b = w >> 3, h = w & 7; const size_t qo = ((size_t)ML + (size_t)b * CL) * D + h * 128; const bf16* kh = KVB + ((size_t)b * SKV + SEQ) * 512 + (h >> 2) * 128;
            att::attn_dense_body(QB + qo, kh, kh + 256, Y + qo, CL, lds_generic); }
    }
}

__device__ __forceinline__ void gmlp_mix_phase(Frame& F) {
    constexpr int LDA = 136;
    LAS bf16* As = (LAS bf16*)F.lds;
    LAS bf16* Vt = (LAS bf16*)(F.lds + 128 * LDA * 2);
    LAS float* rs = (LAS float*)(F.lds + 2 * 128 * LDA * 2);
    const bf16* P = (const bf16*)(F.ws + WS_P); bf16* Y = (bf16*)(F.ws + WS_Y); const float* SS = (const float*)(F.ws + WS_SS);
    const float* ws = PIN(F, I_GWS); const float* bs = PIN(F, I_GBS); const float* vg = PIN(F, I_GVG);
    const int r32 = F.lane & 31, hi = F.lane >> 5;
    for (int u = F.bx; u < (MT / 128) * 8; u += F.G) {
        const int chunk = u >> 3, g = u & 7; const size_t row0 = (size_t)chunk * 128;
        __syncthreads();
        if (F.tid < 128) { const f32x4* sp = (const f32x4*)(SS + (row0 + F.tid) * 16); const f32x4 a = sp[0], b = sp[1], c = sp[2], d = sp[3];
            const float s = ((a.x + a.y) + (a.z + a.w)) + ((b.x + b.y) + (b.z + b.w)) + ((c.x + c.y) + (c.z + c.w)) + ((d.x + d.y) + (d.z + d.w)); rs[F.tid] = 1.0f / sqrtf(s * (1.0f / 1024.0f) + EPS); }
        __syncthreads();
        for (int i = F.tid; i < 128 * 32; i += NTHREADS) { const int p = i >> 5, q4 = (i & 31) * 4; const f32x4 w = *(const f32x4*)(ws + ((size_t)g * 128 + p) * 128 + q4);
            v2u o; o.x = pk2(w.x * rs[q4], w.y * rs[q4 + 1]); o.y = pk2(w.z * rs[q4 + 2], w.w * rs[q4 + 3]); *(LAS v2u*)(As + p * LDA + q4) = o; }
        for (int i = F.tid; i < 128 * 16; i += NTHREADS) { const int q = i >> 4, c8 = (i & 15) * 8; const v4u w = *(const v4u*)(P + (row0 + q) * 2048 + 1024 + g * 128 + c8);
            Vt[(c8 + 0) * LDA + q] = (bf16)(w.x & 0xffff); Vt[(c8 + 1) * LDA + q] = (bf16)(w.x >> 16); Vt[(c8 + 2) * LDA + q] = (bf16)(w.y & 0xffff); Vt[(c8 + 3) * LDA + q] = (bf16)(w.y >> 16);
            Vt[(c8 + 4) * LDA + q] = (bf16)(w.z & 0xffff); Vt[(c8 + 5) * LDA + q] = (bf16)(w.z >> 16); Vt[(c8 + 6) * LDA + q] = (bf16)(w.w & 0xffff); Vt[(c8 + 7) * LDA + q] = (bf16)(w.w >> 16); }
        __syncthreads();
        const int p0 = (F.wave >> 1) * 32, cbase = (F.wave & 1) * 64;
        f32x16 acc0 = {}, acc1 = {};
#pragma unroll
        for (int ks = 0; ks < 8; ++ks) { const int k0 = ks * 16 + hi * 8;
            const bf16x8 a = *(const LAS bf16x8*)(As + (p0 + r32) * LDA + k0);
            const bf16x8 b0 = *(const LAS bf16x8*)(Vt + (cbase + r32) * LDA + k0), b1 = *(const LAS bf16x8*)(Vt + (cbase + 32 + r32) * LDA + k0);
            acc0 = __builtin_amdgcn_mfma_f32_32x32x16_bf16(a, b0, acc0, 0, 0, 0); acc1 = __builtin_amdgcn_mfma_f32_32x32x16_bf16(a, b1, acc1, 0, 0, 0); }
#pragma unroll
        for (int t = 0; t < 2; ++t) { const int c = g * 128 + cbase + t * 32 + r32; const float gain = vg[c];
#pragma unroll
            for (int reg = 0; reg < 16; ++reg) { const int p = p0 + (reg & 3) + 8 * (reg >> 2) + 4 * hi; const float a = t == 0 ? acc0[reg] : acc1[reg];
                const float uu = bf2f(P[(row0 + p) * 2048 + c]); const float mixed = gain * a + bs[g * 128 + p];
                Y[(row0 + p) * D + c] = (bf16)f2bf(uu * mixed); } }
    }
    __syncthreads();
}

__device__ __forceinline__ void hyena_prep_phase(Frame& F) {
    LAS float* tl = (LAS float*)F.lds;
    const bf16* P = (const bf16*)(F.ws + WS_P); bf16* X0 = (bf16*)(F.ws + WS_X0); bf16* VG = (bf16*)(F.ws + WS_VG);
    float* VT = (float*)(F.ws + WS_VT); float* VTC = (float*)(F.ws + WS_VTC);
    const float* cw = PIN(F, I_HCW); const float* cb = PIN(F, I_HCB);
    const int tt = F.tid >> 3, cg = F.tid & 7;
    for (int u = F.bx; u < (MT / 64) * 16; u += F.G) {
        const int tb = u >> 4, c0 = (u & 15) * 64; const int r0 = tb * 64; const bool lat = r0 < ML;
        const int b = lat ? (r0 >> 13) : ((r0 - ML) >> 8), s0 = lat ? (r0 & (SEQ - 1)) : ((r0 - ML) & (CL - 1)), L = lat ? SEQ : CL;
        const int r = r0 + tt, s = s0 + tt, c = c0 + cg * 8;
        float o[3][8];
#pragma unroll
        for (int seg = 0; seg < 3; ++seg) { const int col = seg * 1024 + c;
            const v4u z0 = {0u, 0u, 0u, 0u};
            const v4u pm = s > 0 ? *(const v4u*)(P + (size_t)(r - 1) * 3072 + col) : z0, pc = *(const v4u*)(P + (size_t)r * 3072 + col), pn = s < L - 1 ? *(const v4u*)(P + (size_t)(r + 1) * 3072 + col) : z0;
            const f32x4 w0a = *(const f32x4*)(cw + col), w0b = *(const f32x4*)(cw + col + 4), w1a = *(const f32x4*)(cw + 3072 + col), w1b = *(const f32x4*)(cw + 3072 + col + 4);
            const f32x4 w2a = *(const f32x4*)(cw + 6144 + col), w2b = *(const f32x4*)(cw + 6144 + col + 4), ba = *(const f32x4*)(cb + col), bb = *(const f32x4*)(cb + col + 4);
            const unsigned pmw[4] = {pm.x, pm.y, pm.z, pm.w}, pcw[4] = {pc.x, pc.y, pc.z, pc.w}, pnw[4] = {pn.x, pn.y, pn.z, pn.w};
#pragma unroll
            for (int i = 0; i < 8; ++i) { const float xm = (i & 1) ? bfhi(pmw[i >> 1]) : bflo(pmw[i >> 1]), xc = (i & 1) ? bfhi(pcw[i >> 1]) : bflo(pcw[i >> 1]), xn = (i & 1) ? bfhi(pnw[i >> 1]) : bflo(pnw[i >> 1]);
                const float w0 = i < 4 ? w0a[i & 3] : w0b[i & 3], w1 = i < 4 ? w1a[i & 3] : w1b[i & 3], w2 = i < 4 ? w2a[i & 3] : w2b[i & 3], bi = i < 4 ? ba[i & 3] : bb[i & 3];
                o[seg][i] = xm * w0 + xc * w1 + xn * w2 + bi; } }
        float vgv[8];
#pragma unroll
        for (int i = 0; i < 8; ++i) vgv[i] = o[2][i] * o[1][i];
        v4u w; w.x = cvt_pk_bf16(o[0][0], o[0][1]); w.y = cvt_pk_bf16(o[0][2], o[0][3]); w.z = cvt_pk_bf16(o[0][4], o[0][5]); w.w = cvt_pk_bf16(o[0][6], o[0][7]);
        *(v4u*)(X0 + (size_t)r * D + c) = w;
        w.x = cvt_pk_bf16(vgv[0], vgv[1]); w.y = cvt_pk_bf16(vgv[2], vgv[3]); w.z = cvt_pk_bf16(vgv[4], vgv[5]); w.w = cvt_pk_bf16(vgv[6], vgv[7]);
        *(v4u*)(VG + (size_t)r * D + c) = w;
        __syncthreads();
#pragma unroll
        for (int i = 0; i < 8; ++i) tl[(cg * 8 + i) * 65 + tt] = vgv[i];
        __syncthreads();
        { const int cc = F.tid >> 3, ts = (F.tid & 7) * 8; float* dst = lat ? VT + ((size_t)b * 1024 + c0 + cc) * SEQ + s0 + ts : VTC + ((size_t)b * 1024 + c0 + cc) * CL + s0 + ts;
          const LAS float* sp = tl + cc * 65 + ts;
          *(f32x4*)dst = (f32x4){sp[0], sp[1], sp[2], sp[3]}; *(f32x4*)(dst + 4) = (f32x4){sp[4], sp[5], sp[6], sp[7]}; }
    }
    __syncthreads();
}
__device__ __forceinline__ void hyena_post_phase(Frame& F) {
    LAS float* tl = (LAS float*)F.lds;
    const bf16* X0 = (const bf16*)(F.ws + WS_X0); const bf16* VG = (const bf16*)(F.ws + WS_VG); bf16* Y = (bf16*)(F.ws + WS_Y);
    const float* VT = (const float*)(F.ws + WS_VT); const float* VTC = (const float*)(F.ws + WS_VTC); const float* dsk = PIN(F, I_HD);
    const int tt = F.tid >> 3, cg = F.tid & 7;
    for (int u = F.bx; u < (MT / 64) * 16; u += F.G) {
        const int tb = u >> 4, c0 = (u & 15) * 64; const int r0 = tb * 64; const bool lat = r0 < ML;
        const int b = lat ? (r0 >> 13) : ((r0 - ML) >> 8), s0 = lat ? (r0 & (SEQ - 1)) : ((r0 - ML) & (CL - 1));
        __syncthreads();
        { const int cc = F.tid >> 3, ts = (F.tid & 7) * 8; const float* src = lat ? VT + ((size_t)b * 1024 + c0 + cc) * SEQ + s0 + ts : VTC + ((size_t)b * 1024 + c0 + cc) * CL + s0 + ts;
          const f32x4 a = *(const f32x4*)src, bq = *(const f32x4*)(src + 4); LAS float* dp = tl + cc * 65 + ts;
          dp[0] = a.x; dp[1] = a.y; dp[2] = a.z; dp[3] = a.w; dp[4] = bq.x; dp[5] = bq.y; dp[6] = bq.z; dp[7] = bq.w; }
        __syncthreads();
        const int r = r0 + tt, c = c0 + cg * 8;
        const v4u x0 = *(const v4u*)(X0 + (size_t)r * D + c), vv = *(const v4u*)(VG + (size_t)r * D + c);
        const f32x4 da = *(const f32x4*)(dsk + c), db = *(const f32x4*)(dsk + c + 4);
        const unsigned x0w[4] = {x0.x, x0.y, x0.z, x0.w}, vw[4] = {vv.x, vv.y, vv.z, vv.w}; float y[8];
#pragma unroll
        for (int i = 0; i < 8; ++i) { const float xx = (i & 1) ? bfhi(x0w[i >> 1]) : bflo(x0w[i >> 1]), vx = (i & 1) ? bfhi(vw[i >> 1]) : bflo(vw[i >> 1]); const float di = i < 4 ? da[i & 3] : db[i & 3];
            y[i] = (tl[(cg * 8 + i) * 65 + tt] + vx * di) * xx; }
        v4u w; w.x = cvt_pk_bf16(y[0], y[1]); w.y = cvt_pk_bf16(y[2], y[3]); w.z = cvt_pk_bf16(y[4], y[5]); w.w = cvt_pk_bf16(y[6], y[7]);
        *(v4u*)(Y + (size_t)r * D + c) = w;
    }
    __syncthreads();
}
__device__ __forceinline__ bool phase_nonempty(int ph) {
    if (ph < PH_L0 || ph >= PH_FINAL) return true;
    const int layer = (ph - PH_L0) / PH_PER_LAYER, lp = (ph - PH_L0) % PH_PER_LAYER, kind = layer % 3;
    if (lp == LP_MIX2) return kind != 1;
    if (lp == LP_MIX3) return kind == 2;
    return true;
}
__global__ void __launch_bounds__(NTHREADS, 2) mk_fwd(Args args) {
    extern __shared__ __attribute__((aligned(16))) unsigned char lds[];
    Frame F0;
    F0.lds = (LAS unsigned char*)lds; F0.MISC = (volatile LAS unsigned*)(F0.lds + MISC_OFF);
    F0.tid = threadIdx.x; F0.lane = F0.tid & 63; F0.wave = __builtin_amdgcn_readfirstlane(F0.tid >> 6);
    F0.G = gridDim.x; F0.bx = blockIdx.x; F0.out = args.out; F0.ws = args.ws; F0.ctl = (gu32*)(args.ws + WS_CTL);
    for (int u = F0.tid; u < MISC_BYTES / 4; u += NTHREADS) F0.MISC[u] = 0u;
    __syncthreads();
    if (F0.tid < 36) { const unsigned long long p = (unsigned long long)args.in[F0.tid]; F0.MISC[MW_PTRS + 2 * F0.tid] = (unsigned)p; F0.MISC[MW_PTRS + 2 * F0.tid + 1] = (unsigned)(p >> 32); }
    __syncthreads();
    const int lo = args.ph_lo, hi = args.ph_hi;
    const bool multi = (hi - lo) > 1;
    XcdBarrier bar; bar.bar = (unsigned*)(F0.ctl + CW_BAR); bar.x = 0; bar.st = nullptr;
    if (multi) bar = xcd_barrier_post((unsigned*)(F0.ctl + CW_BAR), F0.MISC + 8);
#ifndef PHMASK
#define PHMASK 0xFFFF
#endif
#define EN(b) ((PHMASK >> (b)) & 1)
#ifndef KMASK
#define KMASK 7
#endif
#define KEN(b) ((KMASK >> (b)) & 1)
#define IN(k) (lo <= (k) && (k) < hi)
#define SEAM(k) do { if ((k) + 1 < hi) xcd_barrier(bar); } while (0)

    if (EN(0) && IN(PH_PRO0)) { Frame F = phase_frame(F0); pro0_mod(F); __syncthreads(); pro0_transposes(F); pro0_filter_mlp(F); SEAM(PH_PRO0); }
    if (EN(1) && IN(PH_PRO1)) { Frame F = phase_frame(F0); pro1_filters(F); SEAM(PH_PRO1); }

#pragma unroll 1
    for (int layer = 0; layer < NLAYER; ++layer) {
        const int kind = layer % 3, jj = layer / 3, pb = PH_L0 + layer * PH_PER_LAYER; const bool last = layer == NLAYER - 1;
        if (EN(2) && IN(pb + LP_NORM1)) { Frame F = phase_frame(F0); rowpass<0>(F, layer); SEAM(pb + LP_NORM1); }
        if (EN(3) && IN(pb + LP_INPROJ)) {
            Frame F = phase_frame(F0);
            const int N = kind == 0 ? 1536 : (kind == 1 ? 2048 : 3072);
            const size_t woff = kind == 0 ? WS_WATT + (size_t)jj * 1536 * 1024 * 2 : (kind == 1 ? WS_WGM : WS_WHY);
            pg8::DenseSched S; S.init(F.ws + WS_H, F.ws + woff, MT, N, F.G, F.bx);
            pg8::EpiBf16 E{(bf16*)(F.ws + WS_P), N, (float*)(F.ws + WS_SS), kind == 1 ? 1 : 0};
            pg8::gemm_phase<pg8::EpiBf16, pg8::DenseSched, false>(F.lds, S, E);
            SEAM(pb + LP_INPROJ);
        }
        if (IN(pb + LP_MIX1)) {
            Frame F = phase_frame(F0);
            if (EN(4) && kind == 0) qkprep_phase(F, jj); else if (EN(5) && kind == 1) gmlp_mix_phase(F); else if (EN(6)) hyena_prep_phase(F);
            SEAM(pb + LP_MIX1);
        }
        if (IN(pb + LP_MIX2) && kind != 1) {
            Frame F = phase_frame(F0);
            if (EN(7) && kind == 0) attention_phase(F, (char*)lds, !last); else if (EN(8)) hyena_conv_phase(F);
            SEAM(pb + LP_MIX2);
        }
        if (EN(9) && IN(pb + LP_MIX3) && kind == 2) { Frame F = phase_frame(F0); hyena_post_phase(F); SEAM(pb + LP_MIX3); }
        if (EN(10) && IN(pb + LP_OUTPROJ)) {
            Frame F = phase_frame(F0); const float* modl = (const float*)(F.ws + WS_MOD) + (size_t)layer * 9 * 6144;
            pg8::DenseSched S; S.init(F.ws + WS_Y, F.ws + WS_WOUT + (size_t)layer * 1024 * 1024 * 2, last ? ML : MT, 1024, F.G, F.bx);
            const bool first = layer == 0;
            pg8::EpiResid E{first ? PIN(F, I_X) : F.out, first ? PIN(F, I_CTX) : (const float*)(F.ws + WS_XC), F.out, (float*)(F.ws + WS_XC), modl};
            pg8::gemm_phase<pg8::EpiResid, pg8::DenseSched, false>(F.lds, S, E);
            SEAM(pb + LP_OUTPROJ);
        }
        if (EN(11) && IN(pb + LP_NORM2)) { Frame F = phase_frame(F0); rowpass<1>(F, layer); SEAM(pb + LP_NORM2); }
        if (EN(12) && IN(pb + LP_MOE1)) {
            Frame F = phase_frame(F0);
            moe_tables(F, layer);
            pg8::MoeSched S{(const char*)(F.ws + WS_H), (const char*)(F.ws + WS_WE1) + (size_t)layer * NE * 2048 * 1024 * 2, (size_t)2048 * 1024 * 2, (const int*)(F.ws + WS_ROWTOK),
                            (const volatile LAS int*)(F.MISC + MW_CUMBLK), (const volatile LAS int*)(F.MISC + MW_CNT), 3, F.G, F.bx};
            pg8::EpiSwiglu E{(bf16*)(F.ws + WS_ACT), PIN(F, I_EB1) + (size_t)layer * NE * 2048};
            pg8::gemm_phase<pg8::EpiSwiglu, pg8::MoeSched, true>(F.lds, S, E);
            SEAM(pb + LP_MOE1);
        }
        if (EN(13) && IN(pb + LP_MOE2)) {
            Frame F = phase_frame(F0);
            moe_tables(F, layer);
            pg8::MoeSched S{(const char*)(F.ws + WS_ACT), (const char*)(F.ws + WS_WE2) + (size_t)layer * NE * 1024 * 1024 * 2, (size_t)1024 * 1024 * 2, nullptr,
                            (const volatile LAS int*)(F.MISC + MW_CUMBLK), (const volatile LAS int*)(F.MISC + MW_CNT), 2, F.G, F.bx};
            pg8::EpiBias E{(bf16*)(F.ws + WS_YM), PIN(F, I_EB2) + (size_t)layer * NE * 1024};
            pg8::gemm_phase<pg8::EpiBias, pg8::MoeSched, false>(F.lds, S, E);
            SEAM(pb + LP_MOE2);
        }
    }
    if (EN(14) && IN(PH_FINAL)) { Frame F = phase_frame(F0); rowpass<2>(F, NLAYER - 1); }
#undef IN
#undef SEAM
}

static bool host_phase_nonempty(int ph) {
    if (ph < PH_L0 || ph >= PH_FINAL) return true;
    const int layer = (ph - PH_L0) / PH_PER_LAYER, lp = (ph - PH_L0) % PH_PER_LAYER, kind = layer % 3;
    if (lp == LP_MIX2) return kind != 1;
    if (lp == LP_MIX3) return kind == 2;
    return true;
}
extern "C" void kernel_launch(void* const* d_in, const int* in_sizes, int n_in, void* d_out, int out_size, void* d_ws, size_t ws_size, hipStream_t stream) {
    static int grid = 0;
    if (grid == 0) {
        if (n_in != 36 || in_sizes[0] != ML * D || out_size != ML * D || ws_size < WS_END) {
            fprintf(stderr, "kernel_launch: built for 36 inputs, x/out of %d floats, >= %zu bytes of workspace; got n_in %d in0 %d out %d ws %zu; nothing launched\n", ML * D, (size_t)WS_END, n_in, n_in > 0 ? in_sizes[0] : -1, out_size, ws_size);
            grid = -1; return; }
        int dev = 0, cus = 0, per_cu = 0;
        if (hipGetDevice(&dev) != hipSuccess || hipDeviceGetAttribute(&cus, hipDeviceAttributeMultiprocessorCount, dev) != hipSuccess) { fprintf(stderr, "kernel_launch: device query failed\n"); grid = -1; return; }
        if (hipFuncSetAttribute((const void*)mk_fwd, hipFuncAttributeMaxDynamicSharedMemorySize, LDS_BYTES) != hipSuccess) { fprintf(stderr, "kernel_launch: hipFuncSetAttribute(%d B LDS) failed\n", LDS_BYTES); grid = -1; return; }
        if (hipOccupancyMaxActiveBlocksPerMultiprocessor(&per_cu, (const void*)mk_fwd, NTHREADS, LDS_BYTES) != hipSuccess || per_cu < 1)
            fprintf(stderr, "kernel_launch: note: occupancy query reports %d workgroups per CU\n", per_cu);
        (void)hipGetLastError();
        grid = cus;
    }
    if (grid < 0) return;
    if (hipMemsetAsync((char*)d_ws + WS_CTL, 0, CTL_ZERO_BYTES, stream) != hipSuccess) { fprintf(stderr, "kernel_launch: memset failed\n"); return; }
    Args a{};
    for (int i = 0; i < 36; ++i) a.in[i] = (const float*)d_in[i];
    a.out = (float*)d_out; a.ws = (unsigned char*)d_ws;
#if MK_MULTI || MK_DBG
    for (int ph = 0; ph < PH_COUNT; ++ph) {
        if (!host_phase_nonempty(ph)) continue;
        a.ph_lo = ph; a.ph_hi = ph + 1;
        hipLaunchKernelGGL(mk_fwd, dim3(grid), dim3(NTHREADS), LDS_BYTES, stream, a);
#if MK_DBG
        dbg_after_phase(ph, a, stream);
#endif
    }
#if MK_DBG
    dbg_report(a, stream);
#endif
#else
    a.ph_lo = 0; a.ph_hi = PH_COUNT;
    hipLaunchKernelGGL(mk_fwd, dim3(grid), dim3(NTHREADS), LDS_BYTES, stream, a);
#endif
    const hipError_t le = hipPeekAtLastError();
    if (le != hipSuccess) fprintf(stderr, "kernel_launch: launch failed: %s\n", hipGetErrorName(le));
}
```

```cpp
#include <hip/hip_runtime.h>
#include <cstdio>
#include <cstdint>
#include <cmath>

#ifndef MK_MULTI
#define MK_MULTI 0
#endif
#ifndef MK_REPEAT
#define MK_REPEAT -1
#endif
#ifndef MK_NREP
#define MK_NREP 1
#endif
#ifndef MK_DBG
#define MK_DBG 0
#endif

constexpr int D = 1024, NB = 8, SEQ = 8192, CL = 256, ML = NB * SEQ, MC = NB * CL, MT = ML + MC;
constexpr int NLAYER = 4, NE = 32, TOPK = 4, SKV = SEQ + CL;
constexpr int MOE_MAXBLK = (MT * TOPK) / 256 + NE;
constexpr float EPS = 1e-6f;
constexpr int FH = 64, FEMB = 33, NFFT = 16384;

constexpr size_t MiB = 1u << 20;
constexpr size_t WS_CTL = 0, CTL_ZERO_BYTES = 1 * MiB;
constexpr size_t WS_MOD = 1 * MiB;
constexpr size_t WS_A3 = 2 * MiB;
constexpr size_t WS_A3C = 4 * MiB;
constexpr size_t WS_RC = 4 * MiB + 512 * 1024;
constexpr size_t WS_FCT = 5 * MiB;
constexpr size_t WS_WATT = 8 * MiB;
constexpr size_t WS_WGM = 14 * MiB;
constexpr size_t WS_WHY = 18 * MiB;
constexpr size_t WS_WOUT = 24 * MiB;
constexpr size_t WS_XC = 32 * MiB;
constexpr size_t WS_TE = 40 * MiB;
constexpr size_t WS_TR = 42 * MiB;
constexpr size_t WS_TG = 44 * MiB;
constexpr size_t WS_SS = 46 * MiB;
constexpr size_t WS_ROWTOK = 52 * MiB;
constexpr size_t WS_KF = 64 * MiB;
constexpr size_t WS_WE1 = 192 * MiB;
constexpr size_t WS_WE2 = 704 * MiB;
constexpr size_t WS_H = 960 * MiB;
constexpr size_t WS_P = 1092 * MiB;
constexpr size_t WS_Y = 1488 * MiB;
constexpr size_t WS_QB = 1620 * MiB;
constexpr size_t WS_KVB = 1752 * MiB;
constexpr size_t WS_X0 = 1818 * MiB;
constexpr size_t WS_VG = 1950 * MiB;
constexpr size_t WS_VT = 2082 * MiB;
constexpr size_t WS_VTC = 2338 * MiB;
constexpr size_t WS_ACT = 2346 * MiB;
constexpr size_t WS_YM = 2890 * MiB;
constexpr size_t WS_CT = 3434 * MiB;
constexpr size_t WS_CTC = 3690 * MiB;
constexpr size_t WS_H8 = 3698 * MiB;
constexpr size_t WS_END = 3764 * MiB;
constexpr int CW_BAR = 4096;
constexpr int CW_CNT = 16384;
constexpr int CW_DBG = 32768;

constexpr int RING_BYTES = 131072;
constexpr int AUX_OFF = RING_BYTES;
constexpr int AUX_BYTES = 16384;
constexpr int MISC_OFF = AUX_OFF + AUX_BYTES;
constexpr int MISC_BYTES = 4096;
constexpr int LDS_BYTES = MISC_OFF + MISC_BYTES;

#define GAS __attribute__((address_space(1)))
#define LAS __attribute__((address_space(3)))
typedef unsigned short bf16;
typedef unsigned v4u __attribute__((ext_vector_type(4)));
typedef unsigned v2u __attribute__((ext_vector_type(2)));
typedef float f32x4 __attribute__((ext_vector_type(4)));
typedef float f32x2 __attribute__((ext_vector_type(2)));
typedef float f32x16 __attribute__((ext_vector_type(16)));
typedef short bf16x8 __attribute__((ext_vector_type(8)));
typedef short s16x4 __attribute__((ext_vector_type(4)));
typedef int i32x4 __attribute__((ext_vector_type(4)));
typedef GAS unsigned gu32;
#define RLX_AGENT __ATOMIC_RELAXED, __HIP_MEMORY_SCOPE_AGENT
#define LDS_WAIT() asm volatile("s_waitcnt lgkmcnt(0)" ::: "memory")
#define VM_WAIT() asm volatile("s_waitcnt vmcnt(0)" ::: "memory")
__device__ __forceinline__ unsigned f2bf(float f) { unsigned u = __builtin_bit_cast(unsigned, f); return (u + 0x7fffu + ((u >> 16) & 1u)) >> 16; }
__device__ __forceinline__ unsigned pk2(float lo, float hi) { return f2bf(lo) | (f2bf(hi) << 16); }
__device__ __forceinline__ float bf2f(unsigned short b) { return __builtin_bit_cast(float, ((unsigned)b) << 16); }
__device__ __forceinline__ float bflo(unsigned w) { return __builtin_bit_cast(float, w << 16); }
__device__ __forceinline__ float bfhi(unsigned w) { return __builtin_bit_cast(float, w & 0xffff0000u); }
__device__ __forceinline__ unsigned cvt_pk_bf16(float lo, float hi) { unsigned r; asm volatile("v_cvt_pk_bf16_f32 %0, %1, %2" : "=v"(r) : "v"(lo), "v"(hi)); return r; }
__device__ __forceinline__ int opaque_tid() { int t = (int)threadIdx.x; asm volatile("" : "+v"(t)); return t; }
__device__ __forceinline__ float wave_sum(float v) {
#pragma unroll
    for (int o = 1; o < 64; o <<= 1) v += __shfl_xor(v, o);
    return v;
}

#define XB_TMO      128
#define XB_XCNT(j)  (256  + 64 * (j))
#define XB_XSUB(j)  (1280 + 64 * (j))
#define XB_XGEN(j)  (2304 + 64 * (j))
#define XB_TOP      3328
#define XB_TOPGEN   3392
#define XCD_BAR_WORDS 3456
#define XB_SPIN_CAP (1u << 22)
__device__ __forceinline__ unsigned xb_ld(unsigned* p)              { return __hip_atomic_load(p, __ATOMIC_RELAXED, __HIP_MEMORY_SCOPE_AGENT); }
__device__ __forceinline__ unsigned xb_add(unsigned* p, unsigned v) { return __hip_atomic_fetch_add(p, v, __ATOMIC_RELAXED, __HIP_MEMORY_SCOPE_AGENT); }
__device__ __forceinline__ unsigned xb_xcc_id() { return (unsigned)__builtin_amdgcn_s_getreg((3 << 11) | 20) & 0xFu; }
#define XB_SPIN(cond, bar) do { unsigned _sp = 0; while (cond) { __builtin_amdgcn_s_sleep(1); \
    if ((++_sp & 255u) == 0u) { if (xb_ld(&(bar)[XB_TMO])) break; if (_sp > XB_SPIN_CAP) { atomicAdd(&(bar)[XB_TMO], 1u); break; } } } } while (0)
struct XcdBarrier { unsigned* bar; unsigned x; volatile LAS unsigned* st; };
__device__ __forceinline__ XcdBarrier xcd_barrier_post(unsigned* bar, volatile LAS unsigned* st) {
    XcdBarrier b; b.bar = bar; b.x = xb_xcc_id(); b.st = st;
    if (threadIdx.x == 0) (void)xb_add(&bar[XB_XCNT(b.x)], 1u);
    return b;
}
__device__ __forceinline__ void xcd_barrier_complete(unsigned* bar, unsigned x, unsigned& nloc, unsigned& nx) {
    const unsigned G = gridDim.x * gridDim.y * gridDim.z;
    unsigned sum, cnt, mine, sp = 0u;
    for (;;) {
        sum = 0u; cnt = 0u; mine = 0u;
#pragma unroll
        for (unsigned j = 0; j < 16; ++j) { const unsigned c = xb_ld(&bar[XB_XCNT(j)]); sum += c; cnt += (c > 0u) ? 1u : 0u; mine = (j == x) ? c : mine; }
        if (sum == G) break;
        __builtin_amdgcn_s_sleep(1);
        if ((++sp & 255u) == 0u) { if (xb_ld(&bar[XB_TMO])) break; if (sp > XB_SPIN_CAP) { atomicAdd(&bar[XB_TMO], 1u); break; } }
    }
    nloc = mine > 0u ? mine : 1u; nx = cnt > 0u ? cnt : 1u;
}
__device__ __forceinline__ void xcd_barrier(const XcdBarrier& b) {
    asm volatile("s_waitcnt vmcnt(0)" ::: "memory");
    __syncthreads();
    if (threadIdx.x == 0) {
        unsigned* bar = b.bar;
        __builtin_amdgcn_s_waitcnt(0);
        unsigned nloc = b.st[0], nx = b.st[1];
        if (nloc == 0u) { xcd_barrier_complete(bar, b.x, nloc, nx); b.st[0] = nloc; b.st[1] = nx; }
        const unsigned old = xb_add(&bar[XB_XSUB(b.x)], 1u);
        const unsigned gen = old / nloc;
        if (old + 1u == (gen + 1u) * nloc) {
            __builtin_amdgcn_fence(__ATOMIC_RELEASE, "agent");
            asm volatile("s_waitcnt vmcnt(0)" ::: "memory");
            const unsigned og = xb_add(&bar[XB_TOP], 1u);
            const unsigned tg = og / nx;
            if (og + 1u == (tg + 1u) * nx) xb_add(&bar[XB_TOPGEN], 1u);
            else XB_SPIN(xb_ld(&bar[XB_TOPGEN]) == tg, bar);
            __builtin_amdgcn_fence(__ATOMIC_ACQUIRE, "agent");
            xb_add(&bar[XB_XGEN(b.x)], 1u);
            asm volatile("s_waitcnt vmcnt(0)" ::: "memory");
        } else {
            XB_SPIN(xb_ld(&bar[XB_XGEN(b.x)]) == gen, bar);
            __builtin_amdgcn_fence(__ATOMIC_ACQUIRE, "agent");
            asm volatile("s_waitcnt vmcnt(0)" ::: "memory");
        }
    }
    __syncthreads();
}

namespace pg8 {
constexpr int BM = 256, BK = 64, HALF = 128, HTB = HALF * BK * 2, STAGE_BYTES = 8 * HTB, NXCD = 8, WGM = 8;
constexpr int GK = 1024;
__device__ __forceinline__ int lds_byte(int r, int c) { const int st = (r >> 4) * 2 + (c >> 5), rr = r & 15, cc = c & 31, ob = rr * 64 + cc * 2; return st * 1024 + (ob ^ (((ob >> 9) & 1) << 5)); }
__device__ __forceinline__ void stage_rc(int b, int& R, int& C) { const int st = b / 1024, sb = b % 1024, swz = sb ^ (((sb >> 9) & 1) << 5); R = (st >> 1) * 16 + swz / 64; C = (st & 1) * 32 + (swz % 64) / 2; }
__device__ __forceinline__ int perm32(int rho) { const int n = rho >> 4, i = rho & 15; return 8 * (i >> 2) + 4 * n + (i & 3); }
struct Unit { int pm, pn, e; };

struct DenseSched {
    const char* A; const char* Bt; int nM, nN, nwg, G, c;
    __device__ __forceinline__ void init(const void* A_, const void* Bt_, int M, int N, int G_, int c_) { A = (const char*)A_; Bt = (const char*)Bt_; nM = M / BM; nN = N / BM; nwg = nM * nN; G = G_; c = c_; }
    __device__ __forceinline__ bool next(int i, Unit& u) const {
        const long L = (long)i * G + c; if (L >= nwg) return false;
        int wgid = (int)L; { const int q = nwg / NXCD, r = nwg % NXCD, xcd = wgid % NXCD, off = wgid / NXCD; wgid = (xcd < r ? xcd * (q + 1) : r * (q + 1) + (xcd - r) * q) + off; }
        const int nig = WGM * nN, gid = wgid / nig, fm = gid * WGM, gsz = (nM - fm) < WGM ? (nM - fm) : WGM;
        u.pm = fm + ((wgid % nig) % gsz); u.pn = (wgid % nig) / gsz; u.e = 0; return true;
    }
    __device__ __forceinline__ const char* a_ptr(const Unit& u) const { return A + (size_t)u.pm * (BM * GK * 2); }
    __device__ __forceinline__ const char* b_ptr(const Unit& u) const { return Bt + (size_t)u.pn * (BM * GK * 2); }
    __device__ __forceinline__ void a_offs(const Unit&, const int (&)[2], const int (&)[2], unsigned (&)[2][2]) const {}
};
struct MoeSched {
    const char* A; const char* Bt; size_t b_estride; const int* rowtok; const volatile LAS int* cumblk; const volatile LAS int* cnt; int ncol_log2, G, c, kb;
    __device__ __forceinline__ bool next(int i, Unit& u) const {
        int gb, pn; const int ncol = 1 << ncol_log2;
        if (G == 256) { const int xcd = c & 7, j = c >> 3, rpb = 256 >> ncol_log2; gb = i * rpb + xcd + 8 * (j >> ncol_log2); pn = j & (ncol - 1); }
        else { const long L = (long)i * G + c; gb = (int)(L >> ncol_log2); pn = (int)(L & (ncol - 1)); }
        const int tot = cumblk[NE]; if (gb >= tot) return false;
        int e = 0;
#pragma unroll 1
        for (int s = 16; s >= 1; s >>= 1) { if (cumblk[e + s] <= gb) e += s; }
        u.pm = gb; u.pn = pn; u.e = e; return true;
    }
    __device__ __forceinline__ const char* a_ptr(const Unit&) const { return A; }
    __device__ __forceinline__ const char* b_ptr(const Unit& u) const { return Bt + (size_t)u.e * b_estride + (size_t)u.pn * (size_t)(BM * kb); }
    __device__ __forceinline__ void a_offs(const Unit& u, const int (&R)[2], const int (&C)[2], unsigned (&voff)[2][2]) const {
        const int rb = u.pm - cumblk[u.e], n = cnt[u.e]; const int* rt = rowtok + (size_t)u.e * MT;
#pragma unroll
        for (int h = 0; h < 2; ++h)
#pragma unroll
            for (int i = 0; i < 2; ++i) { const int rank = rb * 256 + h * HALF + R[i]; const int tok = rowtok ? (rank < n ? rt[rank] : 0) : u.pm * BM + h * HALF + R[i]; voff[h][i] = (unsigned)tok * (unsigned)kb + (unsigned)C[i] * 2u; }
    }
};

typedef int v8i __attribute__((ext_vector_type(8)));
__device__ __forceinline__ v8i cat8(bf16x8 lo, bf16x8 hi) { const v4u a = __builtin_bit_cast(v4u, lo), b = __builtin_bit_cast(v4u, hi); return (v8i){(int)a.x, (int)a.y, (int)a.z, (int)a.w, (int)b.x, (int)b.y, (int)b.z, (int)b.w}; }
template <class Epi, class Sched, bool GATHER, bool FP8 = false>
__device__ __forceinline__ void gemm_phase(LAS unsigned char* lds, const Sched& S, const Epi& E) {
    const int tid = opaque_tid(), wid = __builtin_amdgcn_readfirstlane(tid >> 6), lane = tid & 63, wr = wid >> 2, wc = wid & 3, fr = lane & 15, fq = lane >> 4;
    constexpr int KB = FP8 ? GK : GK * 2, nt = KB / (BK * 2);
    unsigned voffA[2][2], voffB[2]; int Rr[2], Cc[2];
#pragma unroll
    for (int i = 0; i < 2; ++i) { int R, C; stage_rc(tid * 16 + i * 8192, R, C); Rr[i] = R; Cc[i] = C; const int Rb = Epi::PERM ? ((R & ~31) + perm32(R & 31)) : R;
        voffA[0][i] = (unsigned)(R * KB + C * 2); voffA[1][i] = (unsigned)((R + HALF) * KB + C * 2); voffB[i] = (unsigned)(Rb * KB + C * 2); }
    constexpr size_t kstep = (size_t)(BK * 2);
    constexpr size_t hstep = (size_t)HALF * KB;
    const unsigned ldsw = (unsigned)wid * 1024u;
    const int aoff = lds_byte(wr * 64 + fr, fq * 8), boff = lds_byte(wc * 32 + fr, fq * 8);
    LAS unsigned char* abase = lds + aoff; LAS unsigned char* bbase = lds + 4 * HTB + boff; asm volatile("" : "+v"(abase), "+v"(bbase));
#define PG8_SA(b, h) (((b) * 2 + (h)) * HTB)
#define PG8_SB(b, h) ((4 + (b) * 2 + (h)) * HTB)
#define PG8_STAGE(bufoff, gbase, voff) do { _Pragma("unroll") for (int _i = 0; _i < 2; ++_i) \
        __builtin_amdgcn_global_load_lds((const unsigned*)((const char*)(gbase) + (voff)[_i]), (LAS unsigned*)(lds + (bufoff) + ldsw + _i * 8192), 16, 0, 0); } while (0)
#define PG8_STAGE_A(bufoff, gbase, h) PG8_STAGE(bufoff, gbase, voffA[h])
#define PG8_RDA(off) (*(const LAS v4u*)(abase + (off)))
#define PG8_RDB(off) (*(const LAS v4u*)(bbase + (off)))
#define PG8_LDA(dst, b, h) do { _Pragma("unroll") for (int m = 0; m < 4; ++m) { const v4u _l = PG8_RDA(PG8_SA(b, h) + m * 2048), _h = PG8_RDA(PG8_SA(b, h) + m * 2048 + 1024); \
        if constexpr (FP8) dst##8[m] = (v8i){(int)_l.x, (int)_l.y, (int)_l.z, (int)_l.w, (int)_h.x, (int)_h.y, (int)_h.z, (int)_h.w}; \
        else { dst[m][0] = __builtin_bit_cast(bf16x8, _l); dst[m][1] = __builtin_bit_cast(bf16x8, _h); } } } while (0)
#define PG8_LDB(dst, b, h) do { _Pragma("unroll") for (int n = 0; n < 2; ++n) { const v4u _l = PG8_RDB(PG8_SA(b, h) + n * 2048), _h = PG8_RDB(PG8_SA(b, h) + n * 2048 + 1024); \
        if constexpr (FP8) dst##8[n] = (v8i){(int)_l.x, (int)_l.y, (int)_l.z, (int)_l.w, (int)_h.x, (int)_h.y, (int)_h.z, (int)_h.w}; \
        else { dst[n][0] = __builtin_bit_cast(bf16x8, _l); dst[n][1] = __builtin_bit_cast(bf16x8, _h); } } } while (0)
#define PG8_MMA(ai, bj, At, Bt) do { __builtin_amdgcn_s_setprio(1); _Pragma("unroll") for (int m = 0; m < 4; ++m) _Pragma("unroll") for (int n = 0; n < 2; ++n) { \
        if constexpr (FP8) acc[ai][bj][m][n] = __builtin_amdgcn_mfma_scale_f32_16x16x128_f8f6f4(Bt##8[n], At##8[m], acc[ai][bj][m][n], 0, 0, 0, 0x7A7A7A7A, 0, 0x7F7F7F7F); \
        else { _Pragma("unroll") for (int k = 0; k < 2; ++k) acc[ai][bj][m][n] = __builtin_amdgcn_mfma_f32_16x16x32_bf16(Bt[n][k], At[m][k], acc[ai][bj][m][n], 0, 0, 0); } } \
        __builtin_amdgcn_s_setprio(0); } while (0)
#define PG8_WAIT_V(n) asm volatile("s_waitcnt vmcnt(" #n ")" ::: "memory")
#define PG8_WAIT_L(n) asm volatile("s_waitcnt lgkmcnt(" #n ")" ::: "memory")
#define PG8_BAR __builtin_amdgcn_s_barrier()
#define PG8_SCHED __builtin_amdgcn_sched_barrier(0)
    Unit cur, nxt; int ui = 0;
    if (!S.next(0, cur)) return;
    f32x4 acc[2][2][4][2];
#pragma unroll
    for (int a = 0; a < 2; ++a)
#pragma unroll
        for (int b = 0; b < 2; ++b)
#pragma unroll
            for (int m = 0; m < 4; ++m)
#pragma unroll
                for (int n = 0; n < 2; ++n) acc[a][b][m][n] = (f32x4){0.f, 0.f, 0.f, 0.f};
    bf16x8 At[4][2], B0[2][2], B1[2][2]; v8i At8[4], B08[2], B18[2];
    const char* cA = S.a_ptr(cur); const char* cB = S.b_ptr(cur);
    if constexpr (GATHER) S.a_offs(cur, Rr, Cc, voffA);
    PG8_STAGE(PG8_SB(0, 0), cB, voffB); PG8_STAGE(PG8_SB(0, 1), cB + hstep, voffB); PG8_STAGE_A(PG8_SA(0, 0), cA, 0); PG8_STAGE_A(PG8_SA(0, 1), cA, 1);
    if (wr == 1) PG8_BAR;
    PG8_WAIT_V(2); PG8_BAR;
    PG8_STAGE(PG8_SB(1, 0), cB + kstep, voffB); PG8_STAGE_A(PG8_SA(1, 0), cA + kstep, 0); PG8_STAGE(PG8_SB(1, 1), cB + hstep + kstep, voffB);
    PG8_WAIT_V(6); PG8_BAR;
    for (;;) {
        const bool has_next = S.next(ui + 1, nxt);
        const char* nA = has_next ? S.a_ptr(nxt) : cA; const char* nB = has_next ? S.b_ptr(nxt) : cB;
#pragma unroll 1
        for (int t = 0; t < nt; t += 2) {
            const bool last = (t == nt - 2);
            const char* a1 = cA + (size_t)(t + 1) * kstep;
            const char* a2 = last ? nA : cA + (size_t)(t + 2) * kstep; const char* b2 = last ? nB : cB + (size_t)(t + 2) * kstep;
            const char* a3 = a2 + kstep; const char* b3 = b2 + kstep;
            PG8_LDB(B0, 0, 0); PG8_LDB(B1, 0, 1); PG8_SCHED; PG8_LDA(At, 0, 0); PG8_STAGE_A(PG8_SA(1, 1), a1, 1);
            if constexpr (GATHER) { if (last && has_next) S.a_offs(nxt, Rr, Cc, voffA); }
            PG8_WAIT_V(8); PG8_WAIT_L(0); PG8_BAR; PG8_MMA(0, 0, At, B0); PG8_MMA(0, 1, At, B1); PG8_BAR; PG8_SCHED;
            PG8_LDA(At, 0, 1); PG8_STAGE(PG8_SB(0, 0), b2, voffB); PG8_STAGE(PG8_SB(0, 1), b2 + hstep, voffB); PG8_STAGE_A(PG8_SA(0, 0), a2, 0);
            PG8_WAIT_V(8); PG8_WAIT_L(0); PG8_BAR; PG8_MMA(1, 0, At, B0); PG8_MMA(1, 1, At, B1); PG8_BAR; PG8_SCHED;
            PG8_LDB(B0, 1, 0); PG8_LDB(B1, 1, 1); PG8_SCHED; PG8_LDA(At, 1, 0); PG8_STAGE_A(PG8_SA(0, 1), a2, 1);
            PG8_WAIT_V(8); PG8_WAIT_L(0); PG8_BAR; PG8_MMA(0, 0, At, B0); PG8_MMA(0, 1, At, B1); PG8_BAR; PG8_SCHED;
            PG8_LDA(At, 1, 1); PG8_STAGE(PG8_SB(1, 0), b3, voffB); PG8_STAGE(PG8_SB(1, 1), b3 + hstep, voffB); PG8_STAGE_A(PG8_SA(1, 0), a3, 0);
            PG8_WAIT_V(8); PG8_WAIT_L(0); PG8_BAR; PG8_MMA(1, 0, At, B0); PG8_MMA(1, 1, At, B1); PG8_BAR; PG8_SCHED;
        }
        if (wr == 0) PG8_BAR;
        E(acc, cur, wr, wc, fr, fq);
        if (!has_next) break;
#pragma unroll
        for (int a = 0; a < 2; ++a)
#pragma unroll
            for (int b = 0; b < 2; ++b)
#pragma unroll
                for (int m = 0; m < 4; ++m)
#pragma unroll
                    for (int n = 0; n < 2; ++n) acc[a][b][m][n] = (f32x4){0.f, 0.f, 0.f, 0.f};
        cur = nxt; cA = nA; cB = nB; ++ui;
        if (wr == 1) PG8_BAR;
    }
    PG8_WAIT_V(0);
    PG8_BAR;
#undef PG8_SA
#undef PG8_SB
#undef PG8_STAGE
#undef PG8_STAGE_A
#undef PG8_LDA
#undef PG8_RDA
#undef PG8_RDB
#undef PG8_LDB
#undef PG8_MMA
#undef PG8_WAIT_V
#undef PG8_WAIT_L
#undef PG8_BAR
#undef PG8_SCHED
}
}
namespace pg8 {
__device__ __forceinline__ f32x2 gelu_pk(f32x2 v) {
    const f32x2 av = __builtin_elementwise_abs(v), d = av * 0.2316418882f + 1.0f;
    f32x2 t; t.x = __builtin_amdgcn_rcpf(d.x); t.y = __builtin_amdgcn_rcpf(d.y);
    f32x2 q = t * 0.5307027145f + (-0.7265760135f); q = q * t + 0.7107068705f; q = q * t + (-0.142248368f); q = q * t + 0.127414796f; q = q * t;
    const f32x2 s = (v * v) * (-0.72134752044f);
    f32x2 e; e.x = __builtin_amdgcn_exp2f(s.x); e.y = __builtin_amdgcn_exp2f(s.y);
    const f32x2 m = v * (q * e), r = v - m;
    f32x2 o; o.x = v.x < 0.f ? m.x : r.x; o.y = v.y < 0.f ? m.y : r.y; return o;
}
struct EpiBf16 {
    static constexpr bool PERM = true;
    bf16* O; int ldc; float* ss; int ACT;
    __device__ __forceinline__ void operator()(const f32x4 (&acc)[2][2][4][2], const Unit& u, int wr, int wc, int fr, int fq) const {
        const int row0 = u.pm * BM + wr * 64 + fr, col0 = u.pn * BM + wc * 32 + 8 * fq;
#pragma unroll
        for (int ai = 0; ai < 2; ++ai)
#pragma unroll
            for (int m = 0; m < 4; ++m) { const int row = row0 + ai * HALF + m * 16; bf16* rowp = O + (size_t)row * ldc + col0; float sq = 0.f;
#pragma unroll
                for (int bj = 0; bj < 2; ++bj) { f32x4 v0 = acc[ai][bj][m][0], v1 = acc[ai][bj][m][1];
                    if (ACT == 1) { f32x2 a = gelu_pk((f32x2){v0[0], v0[1]}), b = gelu_pk((f32x2){v0[2], v0[3]}), c = gelu_pk((f32x2){v1[0], v1[1]}), d = gelu_pk((f32x2){v1[2], v1[3]});
                        v0 = (f32x4){a.x, a.y, b.x, b.y}; v1 = (f32x4){c.x, c.y, d.x, d.y};
                        sq += (v0[0] * v0[0] + v0[1] * v0[1]) + (v0[2] * v0[2] + v0[3] * v0[3]) + (v1[0] * v1[0] + v1[1] * v1[1]) + (v1[2] * v1[2] + v1[3] * v1[3]); }
                    v4u w; w.x = cvt_pk_bf16(v0[0], v0[1]); w.y = cvt_pk_bf16(v0[2], v0[3]); w.z = cvt_pk_bf16(v1[0], v1[1]); w.w = cvt_pk_bf16(v1[2], v1[3]);
                    *(v4u*)(rowp + bj * HALF) = w; }
                if (ACT == 1) { sq += __shfl_xor(sq, 16); sq += __shfl_xor(sq, 32);
                    if (u.pn >= 4 && fq == 0) ss[(size_t)row * 16 + (u.pn - 4) * 4 + wc] = sq; }
            }
    }
};
struct EpiResid {
    static constexpr bool PERM = false;
    const float* baseL; const float* baseC; float* outL; float* outC; const float* modl;
    __device__ __forceinline__ void operator()(const f32x4 (&acc)[2][2][4][2], const Unit& u, int wr, int wc, int fr, int fq) const {
        const bool lat = u.pm < ML / BM; const int rb = lat ? u.pm : u.pm - ML / BM, bidx = lat ? (u.pm >> 5) : 8;
        const float* base = (lat ? baseL : baseC) + (size_t)rb * BM * D; float* out = (lat ? outL : outC) + (size_t)rb * BM * D;
        const float* g = modl + bidx * 6144 + 2 * 1024;
        const int r0 = wr * 64 + fr, col0 = u.pn * BM + wc * 32 + 4 * fq;
        f32x4 gv[2][2];
#pragma unroll
        for (int bj = 0; bj < 2; ++bj)
#pragma unroll
            for (int n = 0; n < 2; ++n) gv[bj][n] = *(const f32x4*)(g + col0 + bj * HALF + n * 16);
#pragma unroll
        for (int ai = 0; ai < 2; ++ai)
#pragma unroll
            for (int m = 0; m < 4; ++m) { const size_t off = (size_t)(r0 + ai * HALF + m * 16) * D + col0;
#pragma unroll
                for (int bj = 0; bj < 2; ++bj)
#pragma unroll
                    for (int n = 0; n < 2; ++n) { const f32x4 bs = *(const f32x4*)(base + off + bj * HALF + n * 16); *(f32x4*)(out + off + bj * HALF + n * 16) = bs + gv[bj][n] * acc[ai][bj][m][n]; }
                asm volatile("" ::: "memory"); }
    }
};
struct EpiSwiglu {
    static constexpr bool PERM = true;
    unsigned char* O; const float* b1;
    __device__ __forceinline__ void operator()(const f32x4 (&acc)[2][2][4][2], const Unit& u, int wr, int wc, int fr, int fq) const {
        const int row0 = u.pm * BM + wr * 64 + fr, c0 = u.pn * HALF + wc * 32 + 8 * fq; const float* be = b1 + (size_t)u.e * 2048;
        f32x4 bg[2], bl[2];
#pragma unroll
        for (int n = 0; n < 2; ++n) { bg[n] = *(const f32x4*)(be + c0 + 4 * n); bl[n] = *(const f32x4*)(be + 1024 + c0 + 4 * n); }
#pragma unroll
        for (int ai = 0; ai < 2; ++ai)
#pragma unroll
            for (int m = 0; m < 4; ++m) { float o[8];
#pragma unroll
                for (int n = 0; n < 2; ++n)
#pragma unroll
                    for (int j = 0; j < 4; ++j) { float gl = acc[ai][0][m][n][j] + bg[n][j], li = acc[ai][1][m][n][j] + bl[n][j];
                        gl = fminf(gl, 7.0f); li = fminf(fmaxf(li, -7.0f), 7.0f);
                        const float sg = __builtin_amdgcn_rcpf(1.0f + __builtin_amdgcn_exp2f(gl * (-1.702f * 1.4426950408889634f)));
                        o[n * 4 + j] = gl * sg * (li + 1.0f); }
                v2u w; w.x = 0; w.y = 0;
                w.x = __builtin_amdgcn_cvt_pk_fp8_f32(o[0], o[1], w.x, false); w.x = __builtin_amdgcn_cvt_pk_fp8_f32(o[2], o[3], w.x, true);
                w.y = __builtin_amdgcn_cvt_pk_fp8_f32(o[4], o[5], w.y, false); w.y = __builtin_amdgcn_cvt_pk_fp8_f32(o[6], o[7], w.y, true);
                *(v2u*)(O + (size_t)(row0 + ai * HALF + m * 16) * D + c0) = w; }
    }
};
struct EpiBias {
    static constexpr bool PERM = true;
    bf16* O; const float* b2;
    __device__ __forceinline__ void operator()(const f32x4 (&acc)[2][2][4][2], const Unit& u, int wr, int wc, int fr, int fq) const {
        const int row0 = u.pm * BM + wr * 64 + fr, col0 = u.pn * BM + wc * 32 + 8 * fq; const float* be = b2 + (size_t)u.e * 1024 + col0;
#pragma unroll
        for (int bj = 0; bj < 2; ++bj) { const f32x4 bv0 = *(const f32x4*)(be + bj * HALF), bv1 = *(const f32x4*)(be + bj * HALF + 4);
#pragma unroll
            for (int ai = 0; ai < 2; ++ai)
#pragma unroll
                for (int m = 0; m < 4; ++m) { const f32x4 v0 = acc[ai][bj][m][0] + bv0, v1 = acc[ai][bj][m][1] + bv1;
                    v4u w; w.x = cvt_pk_bf16(v0[0], v0[1]); w.y = cvt_pk_bf16(v0[2], v0[3]); w.z = cvt_pk_bf16(v1[0], v1[1]); w.w = cvt_pk_bf16(v1[2], v1[3]);
                    *(v4u*)(O + (size_t)(row0 + ai * HALF + m * 16) * D + col0 + bj * HALF) = w; }
            asm volatile("" ::: "memory"); }
    }
};
}

namespace att {
constexpr int AD = 128, NW = 8, QBLK = 32, KVBLK = 64;
constexpr float SCALE = 0.088388347648318440f;
constexpr float THR = 8.f;
constexpr int LDQ = 1024, LDK = 512, LDO = 1024;
constexpr int SHM_V = KVBLK * AD * 2, SHM_K = KVBLK * AD * 2, SHM_ATTN = 2 * SHM_V + 2 * SHM_K + NW * 64 * 4;
#define KSWZ(row, colB) ((row) * 256 + ((colB) ^ (((row) & 7) << 4)))
#define SBAR() __builtin_amdgcn_sched_barrier(0)
__device__ __forceinline__ int crow(int r, int hi) { return (r & 3) + 8 * (r >> 2) + 4 * hi; }
__device__ __forceinline__ void partialSM(f32x16& p0, f32x16& p1, float& m_reg, float& mn, float& alpha) {
  constexpr float C = SCALE * 1.4426950408889634f;
  float pmax = p0[0]; for (int r = 1; r < 16; ++r) pmax = fmaxf(pmax, p0[r]); for (int r = 0; r < 16; ++r) pmax = fmaxf(pmax, p1[r]);
  { auto rr = __builtin_amdgcn_permlane32_swap(__float_as_uint(pmax), __float_as_uint(pmax), false, false);
    pmax = fmaxf(__uint_as_float(rr[0]), __uint_as_float(rr[1])); }
  if (__builtin_expect(__all(pmax - m_reg <= THR / SCALE), 1)) { mn = m_reg; alpha = 1.f; }
  else { mn = fmaxf(m_reg, pmax); alpha = __builtin_amdgcn_exp2f((m_reg - mn) * C); m_reg = mn; }
  float mnC = -mn * C;
  for (int r = 0; r < 16; ++r) p0[r] = fmaf(p0[r], C, mnC); for (int r = 0; r < 16; ++r) p1[r] = fmaf(p1[r], C, mnC);
  for (int r = 0; r < 16; ++r) p0[r] = __builtin_amdgcn_exp2f(p0[r]);
}
__device__ __forceinline__ void finishSM(f32x16& p0, f32x16& p1, float alpha, float& l_reg, bf16x8& pa0, bf16x8& pa1, bf16x8& pa2, bf16x8& pa3) {
  for (int r = 0; r < 16; ++r) p1[r] = __builtin_amdgcn_exp2f(p1[r]);
  float ps = 0; for (int r = 0; r < 16; ++r) ps += p0[r]; for (int r = 0; r < 16; ++r) ps += p1[r];
  { auto rr = __builtin_amdgcn_permlane32_swap(__float_as_uint(ps), __float_as_uint(ps), false, false);
    ps = __uint_as_float(rr[0]) + __uint_as_float(rr[1]); }
  l_reg = l_reg * alpha + ps;
#define PK4(P, BASE, OUT) do { unsigned a0 = cvt_pk_bf16(P[BASE + 0], P[BASE + 1]), a1 = cvt_pk_bf16(P[BASE + 2], P[BASE + 3]);   \
    unsigned b0 = cvt_pk_bf16(P[BASE + 4], P[BASE + 5]), b1 = cvt_pk_bf16(P[BASE + 6], P[BASE + 7]);                              \
    auto r0 = __builtin_amdgcn_permlane32_swap(a0, b0, false, false); auto r1 = __builtin_amdgcn_permlane32_swap(a1, b1, false, false); \
    v4u w = {r0[0], r1[0], r0[1], r1[1]}; OUT = *reinterpret_cast<bf16x8*>(&w); } while (0)
  PK4(p0, 0, pa0); PK4(p0, 8, pa1); PK4(p1, 0, pa2); PK4(p1, 8, pa3);
#undef PK4
}
__device__ __forceinline__ void qkt(f32x16& p0, f32x16& p1, const bf16* Ks, const bf16x8* qr, int r32, int hi) {
  p0 = f32x16{}; p1 = f32x16{};
  for (int d0 = 0; d0 < 8; ++d0) { int cb = (d0 * 16 + hi * 8) * 2;
    bf16x8 b0 = *reinterpret_cast<const bf16x8*>((const char*)Ks + KSWZ(r32, cb));
    bf16x8 b1 = *reinterpret_cast<const bf16x8*>((const char*)Ks + KSWZ(32 + r32, cb));
    p0 = __builtin_amdgcn_mfma_f32_32x32x16_bf16(b0, qr[d0], p0, 0, 0, 0);
    p1 = __builtin_amdgcn_mfma_f32_32x32x16_bf16(b1, qr[d0], p1, 0, 0, 0); }
}
__device__ __forceinline__ int v_st(int k, int c) { const int kk = (k & ~0xC) | ((k & 4) << 1) | ((k & 8) >> 1); return ((kk >> 3) * 4 + (c >> 5)) * 512 + ((kk & 7) * 32 + (c & 31)) * 2; }
__device__ __forceinline__ int v_rd_base(int lane) { return ((lane & 3) << 3) | (((lane >> 2) & 3) << 6) | (((lane >> 4) & 1) << 5) | (((lane >> 5) & 1) << 8); }
constexpr int v_rd_off(int d0, int ks, int half) { return d0 * 512 + ks * 4096 + half * 2048; }
template <int OFF> __device__ __forceinline__ s16x4 tr_read(int vb) {
  s16x4 r; asm volatile("ds_read_b64_tr_b16 %0, %1 offset:%2" : "=&v"(r) : "v"(vb), "i"(OFF) : "memory"); return r;
}
template <int D0> __device__ __forceinline__ void pv_one(f32x16& od, int vb, bf16x8 pa0, bf16x8 pa1, bf16x8 pa2, bf16x8 pa3) {
  const s16x4 l0 = tr_read<v_rd_off(D0, 0, 0)>(vb), h0 = tr_read<v_rd_off(D0, 0, 1)>(vb), l1 = tr_read<v_rd_off(D0, 1, 0)>(vb), h1 = tr_read<v_rd_off(D0, 1, 1)>(vb);
  const s16x4 l2 = tr_read<v_rd_off(D0, 2, 0)>(vb), h2 = tr_read<v_rd_off(D0, 2, 1)>(vb), l3 = tr_read<v_rd_off(D0, 3, 0)>(vb), h3 = tr_read<v_rd_off(D0, 3, 1)>(vb);
  asm volatile("s_waitcnt lgkmcnt(0)" ::: "memory"); SBAR();
#define PK(L, H) (bf16x8){L[0], L[1], L[2], L[3], H[0], H[1], H[2], H[3]}
  od = __builtin_amdgcn_mfma_f32_32x32x16_bf16(pa0, PK(l0, h0), od, 0, 0, 0);
  od = __builtin_amdgcn_mfma_f32_32x32x16_bf16(pa1, PK(l1, h1), od, 0, 0, 0);
  od = __builtin_amdgcn_mfma_f32_32x32x16_bf16(pa2, PK(l2, h2), od, 0, 0, 0);
  od = __builtin_amdgcn_mfma_f32_32x32x16_bf16(pa3, PK(l3, h3), od, 0, 0, 0);
#undef PK
}
__device__ __forceinline__ void pv_d0(f32x16* o, int vb, bf16x8 pa0, bf16x8 pa1, bf16x8 pa2, bf16x8 pa3) {
  pv_one<0>(o[0], vb, pa0, pa1, pa2, pa3); pv_one<1>(o[1], vb, pa0, pa1, pa2, pa3); pv_one<2>(o[2], vb, pa0, pa1, pa2, pa3); pv_one<3>(o[3], vb, pa0, pa1, pa2, pa3);
}
__device__ __forceinline__ void attn_dense_body(const bf16* __restrict__ Qb, const bf16* __restrict__ Kh, const bf16* __restrict__ Vh, bf16* __restrict__ Ob, int seq, char* lds) {
  const int tid = opaque_tid(), wid = tid >> 6, lane = tid & 63, r32 = lane & 31, hi = lane >> 5;
  bf16* V_lds = (bf16*)lds; bf16* K_lds = (bf16*)(lds + 2 * SHM_V);
  float* ws = (float*)(lds + 2 * SHM_V + 2 * SHM_K) + wid * 64; float* li_l = ws; float* al_l = ws + 32;
  float m_reg = -1e30f, l_reg = 0; f32x16 o[4] = {}; bf16x8 qr[8];
  const bf16* Qw = Qb + (long)(wid * QBLK + r32) * LDQ + hi * 8;
#pragma unroll
  for (int d0 = 0; d0 < 8; ++d0) qr[d0] = *reinterpret_cast<const bf16x8*>(Qw + d0 * 16);
  const int sr = tid >> 4, sc = (tid & 15) * 8, vst0 = v_st(sr, sc), vst1 = v_st(32 + sr, sc);
  const int vb0 = (int)(uintptr_t)V_lds + v_rd_base(lane);
  struct { bf16x8 vs0, vs1, ks0, ks1; } sr_[2];
#define SLOAD(i, k0) do { sr_[i].vs0 = *reinterpret_cast<const bf16x8*>(&Vh[(long)((k0) + sr) * LDK + sc]); sr_[i].vs1 = *reinterpret_cast<const bf16x8*>(&Vh[(long)((k0) + 32 + sr) * LDK + sc]); \
    sr_[i].ks0 = *reinterpret_cast<const bf16x8*>(&Kh[(long)((k0) + sr) * LDK + sc]); sr_[i].ks1 = *reinterpret_cast<const bf16x8*>(&Kh[(long)((k0) + 32 + sr) * LDK + sc]); } while (0)
#define SWRITE(b, i) do { *(bf16x8*)((char*)V_lds + (b) * SHM_V + vst0) = sr_[i].vs0;          \
    *(bf16x8*)((char*)V_lds + (b) * SHM_V + vst1) = sr_[i].vs1; int kc = sc * 2;               \
    *(bf16x8*)((char*)K_lds + (b) * SHM_K + KSWZ(sr, kc)) = sr_[i].ks0;                       \
    *(bf16x8*)((char*)K_lds + (b) * SHM_K + KSWZ(32 + sr, kc)) = sr_[i].ks1; } while (0)
#define SWAIT() asm volatile("s_waitcnt vmcnt(4)" ::: "memory")
#define RESC(a) do { if (__any((a) < 1.f)) { if (hi == 0) al_l[r32] = (a); asm volatile("s_waitcnt lgkmcnt(0)" ::: "memory"); \
    for (int d = 0; d < 4; ++d) for (int r = 0; r < 16; ++r) o[d][r] *= al_l[crow(r, hi)]; } } while (0)
  f32x16 pA0, pA1, pB0, pB1; float mnA, mnB, alA, alB; bf16x8 pa0, pa1, pa2, pa3; const int NT = seq / KVBLK;
  constexpr int SE = 0, SO = 1;
  SLOAD(SE, 0); asm volatile("s_waitcnt vmcnt(0)" ::: "memory"); SWRITE(0, SE); __syncthreads();
  qkt(pA0, pA1, K_lds, qr, r32, hi); partialSM(pA0, pA1, m_reg, mnA, alA);
  SLOAD(SO, KVBLK); if (2 < NT) SLOAD(SE, 2 * KVBLK);
  SWAIT(); SWRITE(1, SO); __syncthreads();
  for (int j = 1; j + 1 < NT; j += 2) {
    SBAR(); qkt(pB0, pB1, (bf16*)((char*)K_lds + SHM_K), qr, r32, hi);
    finishSM(pA0, pA1, alA, l_reg, pa0, pa1, pa2, pa3); SBAR();
    SLOAD(SO, (j + 2) * KVBLK); SBAR();
    pv_d0(o, vb0, pa0, pa1, pa2, pa3); partialSM(pB0, pB1, m_reg, mnB, alB);
    __syncthreads(); SWAIT(); SWRITE(0, SE);
    RESC(alB); __syncthreads();
    SBAR(); qkt(pA0, pA1, K_lds, qr, r32, hi);
    finishSM(pB0, pB1, alB, l_reg, pa0, pa1, pa2, pa3); SBAR();
    if (j + 3 < NT) SLOAD(SE, (j + 3) * KVBLK); SBAR();
    pv_d0(o, vb0 + (int)SHM_V, pa0, pa1, pa2, pa3); partialSM(pA0, pA1, m_reg, mnA, alA);
    __syncthreads(); SWAIT(); SWRITE(1, SO);
    RESC(alA); __syncthreads();
  }
  SBAR(); qkt(pB0, pB1, (bf16*)((char*)K_lds + SHM_K), qr, r32, hi);
  finishSM(pA0, pA1, alA, l_reg, pa0, pa1, pa2, pa3); SBAR();
  pv_d0(o, vb0, pa0, pa1, pa2, pa3); partialSM(pB0, pB1, m_reg, mnB, alB);
  __syncthreads(); RESC(alB);
  finishSM(pB0, pB1, alB, l_reg, pa0, pa1, pa2, pa3); SBAR();
  pv_d0(o, vb0 + (int)SHM_V, pa0, pa1, pa2, pa3);
  if (hi == 0) li_l[r32] = l_reg; asm volatile("s_waitcnt lgkmcnt(0)" ::: "memory");
  float rli[16];
#pragma unroll
  for (int r = 0; r < 16; ++r) rli[r] = __builtin_amdgcn_rcpf(li_l[crow(r, hi)]);
  bf16* Ow = Ob + (long)(wid * QBLK) * LDO;
#pragma unroll
  for (int r = 0; r < 16; ++r) { int orow = crow(r, hi);
    for (int d0 = 0; d0 < 4; ++d0) Ow[(long)orow * LDO + d0 * 32 + r32] = (bf16)f2bf(o[d0][r] * rli[r]); }
  __syncthreads();
#undef SLOAD
#undef SWRITE
#undef SWAIT
#undef RESC
}
#undef KSWZ
}
constexpr int NWAVES = 8, NTHREADS = 512;
struct Args { const float* in[36]; float* out; unsigned char* ws; int ph_lo, ph_hi; };
enum InIdx { I_X = 0, I_C, I_CTX, I_CCTX, I_ADAW, I_ADAB, I_N1G, I_N2G, I_WOUT, I_RW, I_RB, I_EW1, I_EB1, I_EW2, I_EB2, I_AWIN, I_AQG, I_AKG,
             I_GWIN, I_GVG, I_GWS, I_GBS, I_HWIN, I_HCW, I_HCB, I_FW1, I_FB1, I_FW2, I_FB2, I_FW3, I_FB3, I_FW4, I_FB4, I_FREQ, I_HD, I_FG };
struct Frame {
    LAS unsigned char* lds; volatile LAS unsigned* MISC; gu32* ctl;
    int tid, lane, wave, G, bx;
    float* out; unsigned char* ws;
};
template <class T> __device__ __forceinline__ T* launder(T* p) { unsigned long long v = (unsigned long long)p; asm volatile("" : "+s"(v)); return (T*)v; }
constexpr int MW_PTRS = 640;
__device__ __forceinline__ const float* pin_load(const Frame& F, int i) {
    const unsigned lo = __builtin_amdgcn_readfirstlane(F.MISC[MW_PTRS + 2 * i]), hi = __builtin_amdgcn_readfirstlane(F.MISC[MW_PTRS + 2 * i + 1]);
    return (const float*)(((unsigned long long)hi << 32) | lo);
}
#define PIN(F, i) pin_load(F, i)
__device__ __forceinline__ Frame phase_frame(const Frame& F0) {
    Frame F = F0; F.tid = opaque_tid(); F.lane = F.tid & 63; F.wave = __builtin_amdgcn_readfirstlane(F.tid >> 6);
    F.ws = launder(F0.ws); F.out = launder(F0.out); F.ctl = (gu32*)(F.ws + WS_CTL); return F;
}
constexpr int PH_PRO0 = 0, PH_PRO1 = 1, PH_L0 = 2, PH_PER_LAYER = 9, PH_FINAL = PH_L0 + NLAYER * PH_PER_LAYER, PH_COUNT = PH_FINAL + 1;
enum LPhase { LP_NORM1 = 0, LP_INPROJ, LP_MIX1, LP_MIX2, LP_MIX3, LP_OUTPROJ, LP_NORM2, LP_MOE1, LP_MOE2 };

template <bool FP8> __device__ __forceinline__ void transpose_item(const float* W, int N, void* WT, int k0, int n0, int drow0, LAS float* scr, int lane) {
    constexpr int K = 1024;
    float v[64];
    const float* src = W + (size_t)k0 * N + n0 + lane;
#pragma unroll
    for (int kk = 0; kk < 64; ++kk) v[kk] = src[(size_t)kk * N];
#pragma unroll
    for (int kk = 0; kk < 64; ++kk) scr[kk * 65 + lane] = v[kk];
    LDS_WAIT(); asm volatile("" ::: "memory");
    if constexpr (!FP8) {
        const int c = lane & 7;
#pragma unroll
        for (int j = 0; j < 8; ++j) { const int n = (lane >> 3) + 8 * j; const LAS float* s = scr + (8 * c) * 65 + n;
            v4u o; o.x = pk2(s[0 * 65], s[1 * 65]); o.y = pk2(s[2 * 65], s[3 * 65]); o.z = pk2(s[4 * 65], s[5 * 65]); o.w = pk2(s[6 * 65], s[7 * 65]);
            *(GAS v4u*)((bf16*)WT + (size_t)(drow0 + n) * K + k0 + 8 * c) = o; }
    } else {
        const int c = lane & 3;
#pragma unroll
        for (int j = 0; j < 4; ++j) { const int n = (lane >> 2) + 16 * j; const LAS float* s = scr + (16 * c) * 65 + n; unsigned w[4];
#pragma unroll
            for (int q = 0; q < 4; ++q) { unsigned x = 0; x = __builtin_amdgcn_cvt_pk_fp8_f32(32.0f * s[(4 * q) * 65], 32.0f * s[(4 * q + 1) * 65], x, false);
                x = __builtin_amdgcn_cvt_pk_fp8_f32(32.0f * s[(4 * q + 2) * 65], 32.0f * s[(4 * q + 3) * 65], x, true); w[q] = x; }
            *(GAS v4u*)((unsigned char*)WT + (size_t)(drow0 + n) * K + k0 + 16 * c) = (v4u){w[0], w[1], w[2], w[3]}; }
    }
    LDS_WAIT(); asm volatile("" ::: "memory");
}
__device__ __forceinline__ void pro0_transposes(Frame& F) {
    LAS float* scr = (LAS float*)(F.lds + F.wave * 16640);
    const int gw = F.bx * NWAVES + F.wave, NGW = F.G * NWAVES;
    constexpr int R0 = 128 * 512, R1 = 128 * 256, R2 = 2 * 384, R3 = 512, R4 = 768, R5 = 4 * 256, NITEMS = R0 + R1 + R2 + R3 + R4 + R5;
    for (int it = gw; it < NITEMS; it += NGW) {
        int r = it;
        if (r < R0) { const int mi = r >> 9, q = r & 511, kb = q >> 5, nb = q & 31, n0 = nb * 64;
            const int d0 = n0 < 1024 ? 256 * (n0 >> 7) + (n0 & 127) : 256 * ((n0 - 1024) >> 7) + 128 + (n0 & 127);
            transpose_item<true>(PIN(F, I_EW1) + (size_t)mi * 1024 * 2048, 2048, F.ws + WS_WE1 + (size_t)mi * 2048 * 1024, kb * 64, n0, d0, scr, F.lane); continue; } r -= R0;
        if (r < R1) { const int mi = r >> 8, q = r & 255, kb = q >> 4, nb = q & 15;
            transpose_item<true>(PIN(F, I_EW2) + (size_t)mi * 1024 * 1024, 1024, F.ws + WS_WE2 + (size_t)mi * 1024 * 1024, kb * 64, nb * 64, nb * 64, scr, F.lane); continue; } r -= R1;
        if (r < R2) { const int mi = r / 384, q = r % 384, kb = q / 24, nb = q % 24;
            transpose_item<false>(PIN(F, I_AWIN) + (size_t)mi * 1024 * 1536, 1536, F.ws + WS_WATT + (size_t)mi * 1536 * 1024 * 2, kb * 64, nb * 64, nb * 64, scr, F.lane); continue; } r -= R2;
        if (r < R3) { const int kb = r >> 5, nb = r & 31;
            transpose_item<false>(PIN(F, I_GWIN), 2048, F.ws + WS_WGM, kb * 64, nb * 64, nb * 64, scr, F.lane); continue; } r -= R3;
        if (r < R4) { const int kb = r / 48, nb = r % 48;
            transpose_item<false>(PIN(F, I_HWIN), 3072, F.ws + WS_WHY, kb * 64, nb * 64, nb * 64, scr, F.lane); continue; } r -= R4;
        { const int mi = r >> 8, q = r & 255, kb = q >> 4, nb = q & 15;
            transpose_item<false>(PIN(F, I_WOUT) + (size_t)mi * 1024 * 1024, 1024, F.ws + WS_WOUT + (size_t)mi * 1024 * 1024 * 2, kb * 64, nb * 64, nb * 64, scr, F.lane); }
    }
}
__device__ __forceinline__ void pro0_mod(Frame& F) {
    LAS float* sl = (LAS float*)F.lds;
    LAS float* red = (LAS float*)(F.lds + 65536);
    __syncthreads();
    for (int i = F.tid; i < 9 * 1024; i += NTHREADS) { const int r = i >> 10, k = i & 1023; const float v = r < 8 ? PIN(F, I_C)[r * 1024 + k] : PIN(F, I_CCTX)[k]; sl[i] = v / (1.0f + __expf(-v)); }
    __syncthreads();
    float* MOD = (float*)(F.ws + WS_MOD);
    for (int item = F.bx; item < NLAYER * 96; item += F.G) {
        const int l = item / 96, n0 = (item % 96) * 64;
        const float* W = PIN(F, I_ADAW) + (size_t)l * 1024 * 6144 + n0 + F.lane;
        float acc[9];
#pragma unroll
        for (int r = 0; r < 9; ++r) acc[r] = 0.f;
        const int kb = F.wave * 128;
#pragma unroll 4
        for (int k = 0; k < 128; ++k) { const float wv = W[(size_t)(kb + k) * 6144];
#pragma unroll
            for (int r = 0; r < 9; ++r) acc[r] += sl[r * 1024 + kb + k] * wv; }
#pragma unroll
        for (int r = 0; r < 9; ++r) red[(F.wave * 9 + r) * 64 + F.lane] = acc[r];
        __syncthreads();
        for (int i = F.tid; i < 9 * 64; i += NTHREADS) { const int r = i >> 6, n = i & 63; float s = 0.f;
#pragma unroll
            for (int w = 0; w < 8; ++w) s += red[(w * 9 + r) * 64 + n];
            MOD[((size_t)l * 9 + r) * 6144 + n0 + n] = s + PIN(F, I_ADAB)[l * 6144 + n0 + n]; }
        __syncthreads();
    }
}
__device__ __forceinline__ void pro0_filter_mlp(Frame& F) {
    const int j = F.lane, gw = F.bx * NWAVES + F.wave, NGW = F.G * NWAVES;
    LAS float* W1 = (LAS float*)F.lds; LAS float* W2 = W1 + FEMB * FH; LAS float* W3 = W2 + FH * FH;
    __syncthreads();
    for (int i = F.tid; i < FEMB * FH; i += NTHREADS) W1[i] = PIN(F, I_FW1)[i];
    for (int i = F.tid; i < FH * FH; i += NTHREADS) { W2[i] = PIN(F, I_FW2)[i]; W3[i] = PIN(F, I_FW3)[i]; }
    __syncthreads();
    const float b1 = PIN(F, I_FB1)[j], b2 = PIN(F, I_FB2)[j], b3 = PIN(F, I_FB3)[j], fr = PIN(F, I_FREQ)[j];
    for (int it = gw; it < SEQ + CL; it += NGW) {
        const bool lat = it < SEQ; const int t = lat ? it : it - SEQ; const float L = lat ? (float)SEQ : (float)CL;
        const float tl = (float)t / (L - 1.0f), w = (6.283185307179586f * (float)t) / L;
        float z;
        { const int band = (j - 1) & 15; const float f = 1e-4f + (float)band * ((15.0f - 1e-4f) / 15.0f); const float a = f * w;
          z = (j == 0) ? tl : (j <= 16 ? cosf(a) : -sinf(a)); }
        float s = b1;
#pragma unroll
        for (int i = 0; i < FEMB; ++i) s += __shfl(z, i) * W1[i * FH + j];
        const float a1 = sinf(fr * s);
        s = b2;
#pragma unroll 16
        for (int i = 0; i < FH; ++i) s += __shfl(a1, i) * W2[i * FH + j];
        const float a2 = sinf(fr * s);
        s = b3;
#pragma unroll 16
        for (int i = 0; i < FH; ++i) s += __shfl(a2, i) * W3[i * FH + j];
        const float a3 = sinf(fr * s);
        float* dst = lat ? (float*)(F.ws + WS_A3) + (size_t)t * FH : (float*)(F.ws + WS_A3C) + (size_t)t * FH;
        dst[j] = a3;
    }
    __syncthreads();
}

__device__ __forceinline__ f32x2 cmul(f32x2 a, f32x2 b) { return (f32x2){a.x * b.x - a.y * b.y, a.x * b.y + a.y * b.x}; }
__device__ __forceinline__ f32x2 cconj(f32x2 a) { return (f32x2){a.x, -a.y}; }
__device__ __forceinline__ void fft16k_dif(LAS f32x2* z, int tid) {
#pragma unroll 1
    for (int lq = 12; lq >= 0; lq -= 2) {
        const int q = 1 << lq; const float inv_lb = 1.0f / (float)(4 * q);
#pragma unroll 2
        for (int bf = tid; bf < 4096; bf += NTHREADS) {
            const int j = bf & (q - 1), base = ((bf >> lq) << (lq + 2)) + j;
            const f32x2 x0 = z[base], x1 = z[base + q], x2 = z[base + 2 * q], x3 = z[base + 3 * q];
            const f32x2 t0 = x0 + x2, t1 = x0 - x2, t2 = x1 + x3, d = x1 - x3, t3 = (f32x2){d.y, -d.x};
            const f32x2 y0 = t0 + t2, y2 = t0 - t2, y1 = t1 + t3, y3 = t1 - t3;
            const float fr = (float)j * inv_lb;
            const f32x2 w1 = (f32x2){__builtin_amdgcn_cosf(fr), -__builtin_amdgcn_sinf(fr)}, w2 = cmul(w1, w1), w3 = cmul(w1, w2);
            z[base] = y0; z[base + q] = cmul(y2, w2); z[base + 2 * q] = cmul(y1, w1); z[base + 3 * q] = cmul(y3, w3);
        }
        __syncthreads();
    }
}
__device__ __forceinline__ void fft16k_dit_inv(LAS f32x2* z, int tid) {
#pragma unroll 1
    for (int lq = 0; lq <= 12; lq += 2) {
        const int q = 1 << lq; const float inv_lb = 1.0f / (float)(4 * q);
#pragma unroll 2
        for (int bf = tid; bf < 4096; bf += NTHREADS) {
            const int j = bf & (q - 1), base = ((bf >> lq) << (lq + 2)) + j;
            const float fr = (float)j * inv_lb;
            const f32x2 w1 = (f32x2){__builtin_amdgcn_cosf(fr), __builtin_amdgcn_sinf(fr)}, w2 = cmul(w1, w1), w3 = cmul(w1, w2);
            const f32x2 A0 = z[base], A1 = cmul(z[base + q], w2), A2 = cmul(z[base + 2 * q], w1), A3 = cmul(z[base + 3 * q], w3);
            const f32x2 u0 = A0 + A1, u1 = A0 - A1, u2 = A2 + A3, u3 = A2 - A3, iu3 = (f32x2){-u3.y, u3.x};
            z[base] = u0 + u2; z[base + q] = u1 + iu3; z[base + 2 * q] = u0 - u2; z[base + 3 * q] = u1 - iu3;
        }
        __syncthreads();
    }
}
__device__ __forceinline__ int rev14(int p) { return (int)(__brev((unsigned)p) >> 18); }
__device__ __forceinline__ float hy_delta(int c) { const float mn = -3.0701134573253945f, mx = -15.350567286626973f; return fabsf(mn + (mx - mn) * ((float)c / 1023.0f)); }

__device__ __forceinline__ void pro1_filters(Frame& F) {
    { const int gw = F.bx * NWAVES + F.wave;
      if (gw < NLAYER * 9) { const int l = gw / 9, e = F.lane & 31, hf = F.lane >> 5; const float* sh = (const float*)(F.ws + WS_MOD) + (size_t)gw * 6144 + 3 * 1024; const float* rw = PIN(F, I_RW) + (size_t)l * D * NE;
          float acc = 0.f; for (int k = hf * 512; k < hf * 512 + 512; ++k) acc += sh[k] * rw[(size_t)k * NE + e];
          acc += __shfl_xor(acc, 32); if (F.lane < 32) ((float*)(F.ws + WS_RC))[gw * NE + e] = acc + PIN(F, I_RB)[l * NE + e]; } }
    LAS f32x2* z = (LAS f32x2*)F.lds;
    LAS float* wl = (LAS float*)(F.lds + AUX_OFF);
    const float* a3 = (const float*)(F.ws + WS_A3); const float* a3c = (const float*)(F.ws + WS_A3C);
    f32x2* KF = (f32x2*)(F.ws + WS_KF); float* FCT = (float*)(F.ws + WS_FCT);
    for (int u = F.bx; u < 512; u += F.G) {
        const int ca = 2 * u, cb = 2 * u + 1;
        __syncthreads();
        if (F.tid < 256) { const int which = F.tid >> 6, m = F.tid & 63; const int col = (which & 1 ? cb : ca) + (which >> 1) * 1024; wl[which * 64 + m] = PIN(F, I_FW4)[m * 2048 + col]; }
        if (F.tid < 4) { const int col = (F.tid & 1 ? cb : ca) + (F.tid >> 1) * 1024; wl[256 + F.tid] = PIN(F, I_FB4)[col]; }
        __syncthreads();
        const float da = hy_delta(ca), db = hy_delta(cb);
        for (int t = F.tid; t < SEQ; t += NTHREADS) {
            const f32x4* ar = (const f32x4*)(a3 + (size_t)t * FH); float s0 = wl[256], s1 = wl[257], s2 = wl[258], s3 = wl[259];
#pragma unroll 4
            for (int m4 = 0; m4 < 16; ++m4) { const f32x4 a = ar[m4];
#pragma unroll
                for (int i = 0; i < 4; ++i) { const int m = m4 * 4 + i; s0 += a[i] * wl[m]; s1 += a[i] * wl[64 + m]; s2 += a[i] * wl[128 + m]; s3 += a[i] * wl[192 + m]; } }
            const float tl = (float)t / (float)(SEQ - 1); const float wa = __expf(-tl * da), wb = __expf(-tl * db);
            z[t] = (f32x2){s0 * wa, s1 * wb};
            if (t == 0) z[SEQ] = (f32x2){0.f, 0.f}; else z[NFFT - t] = (f32x2){s2 * wa, s3 * wb};
        }
        for (int i = F.tid; i < 511; i += NTHREADS) {
            const int d = i - 255, t = d < 0 ? -d : d; const int o = d < 0 ? 2 : 0;
            const float* ar = a3c + (size_t)t * FH; float sa = wl[256 + o], sb = wl[257 + o];
            for (int m = 0; m < FH; ++m) { const float a = ar[m]; sa += a * wl[o * 64 + m]; sb += a * wl[(o + 1) * 64 + m]; }
            const float tl = (float)t / (float)(CL - 1);
            FCT[(size_t)ca * 512 + d + 256] = sa * __expf(-tl * da); FCT[(size_t)cb * 512 + d + 256] = sb * __expf(-tl * db);
        }
        __syncthreads();
        fft16k_dif(z, F.tid);
        for (int p = F.tid; p < NFFT; p += NTHREADS) {
            const int k = rev14(p), p2 = rev14((NFFT - k) & (NFFT - 1));
            if (p <= p2) { const f32x2 a = z[p], b = z[p2];
                const f32x2 Ka = (f32x2){0.5f * (a.x + b.x), 0.5f * (a.y - b.y)};
                const f32x2 Kb = (f32x2){0.5f * (a.y + b.y), -0.5f * (a.x - b.x)};
                KF[(size_t)ca * NFFT + p] = Ka; KF[(size_t)cb * NFFT + p] = Kb; KF[(size_t)ca * NFFT + p2] = cconj(Ka); KF[(size_t)cb * NFFT + p2] = cconj(Kb); }
        }
    }
    __syncthreads();
}

__device__ __forceinline__ void hyena_conv_phase(Frame& F) {
    LAS f32x2* z = (LAS f32x2*)F.lds;
    LAS float* aux = (LAS float*)(F.lds + AUX_OFF);
    const float* VT = (const float*)(F.ws + WS_VT); const float* VTC = (const float*)(F.ws + WS_VTC); float* CT = (float*)(F.ws + WS_CT); float* CTC = (float*)(F.ws + WS_CTC);
    const f32x2* KF = (const f32x2*)(F.ws + WS_KF); const float* FCT = (const float*)(F.ws + WS_FCT);
    for (int u = F.bx; u < NB * 512; u += F.G) {
        const int b = u >> 9, cp = u & 511, ca = 2 * cp, cb = ca + 1;
        const float* va = VT + ((size_t)b * 1024 + ca) * SEQ; const float* vb = va + SEQ; float* oa = CT + ((size_t)b * 1024 + ca) * SEQ; float* ob = oa + SEQ;
        __syncthreads();
        for (int n = F.tid; n < SEQ; n += NTHREADS) { z[n] = (f32x2){va[n], vb[n]}; z[SEQ + n] = (f32x2){0.f, 0.f}; }
        { const int h = F.tid >> 8, t = F.tid & 255; const float* vc = VTC + ((size_t)b * 1024 + ca + h) * CL;
          aux[h * 256 + t] = vc[t]; aux[512 + h * 512 + t] = FCT[(size_t)(ca + h) * 512 + t]; aux[512 + h * 512 + 256 + t] = FCT[(size_t)(ca + h) * 512 + 256 + t];
          __syncthreads();
          float y = 0.f;
#pragma unroll 8
          for (int s = 0; s < CL; ++s) y += aux[h * 256 + s] * aux[512 + h * 512 + (t - s) + 256];
          CTC[((size_t)b * 1024 + ca + h) * CL + t] = y; }
        fft16k_dif(z, F.tid);
        const f32x2* Ka = KF + (size_t)ca * NFFT; const f32x2* Kb = KF + (size_t)cb * NFFT;
        for (int p = F.tid; p < NFFT; p += NTHREADS) {
            const int k = rev14(p), p2 = rev14((NFFT - k) & (NFFT - 1));
            if (p <= p2) { const f32x2 a = z[p], b2 = z[p2];
                const f32x2 Va = (f32x2){0.5f * (a.x + b2.x), 0.5f * (a.y - b2.y)}, Vb = (f32x2){0.5f * (a.y + b2.y), -0.5f * (a.x - b2.x)};
                const f32x2 ya = cmul(Va, Ka[p]), yb = cmul(Vb, Kb[p]);
                z[p] = (f32x2){ya.x - yb.y, ya.y + yb.x};
                z[p2] = (f32x2){ya.x + yb.y, -ya.y + yb.x}; }
        }
        __syncthreads();
        fft16k_dit_inv(z, F.tid);
        const float sc = 1.0f / (float)NFFT;
        for (int n = F.tid; n < SEQ; n += NTHREADS) { const f32x2 w = z[n]; oa[n] = w.x * sc; ob[n] = w.y * sc; }
    }
    __syncthreads();
}
constexpr int MW_CUMBLK = 16, MW_CNT = 64, MW_SELE = 128, MW_SELV = 256, MW_LRANK = 384, MW_LBASE = 512;
__device__ __forceinline__ void moe_tables(Frame& F, int layer) {
    __syncthreads();
    if (F.tid < NE) F.MISC[MW_CNT + F.tid] = __hip_atomic_load(F.ctl + CW_CNT + layer * NE + F.tid, RLX_AGENT);
    __syncthreads();
    if (F.tid == 0) { unsigned c = 0; for (int e = 0; e < NE; ++e) { F.MISC[MW_CUMBLK + e] = c; c += (F.MISC[MW_CNT + e] + 255u) >> 8; } F.MISC[MW_CUMBLK + NE] = c; }
    __syncthreads();
}

template <int MODE> __device__ __forceinline__ void rowpass(Frame& F, int layer) {
    const bool last = layer == NLAYER - 1;
    const int nrows = (MODE == 2 || (MODE == 1 && last)) ? ML : MT;
    const bool combine = (MODE == 0 && layer > 0) || MODE == 2;
    const int cl = MODE == 2 ? NLAYER - 1 : layer - 1;
    const bool from_input = (MODE == 0 && layer == 0);
    const float* XLs = from_input ? PIN(F, I_X) : F.out; const float* XCs = from_input ? PIN(F, I_CTX) : (const float*)(F.ws + WS_XC);
    float* XLd = F.out; float* XCd = (float*)(F.ws + WS_XC);
    const float* MOD = (const float*)(F.ws + WS_MOD);
    bf16* H = (bf16*)(F.ws + WS_H); const bf16* YM = (const bf16*)(F.ws + WS_YM);
    int* TE = (int*)(F.ws + WS_TE); int* TR = (int*)(F.ws + WS_TR); float* TG = (float*)(F.ws + WS_TG); int* ROWTOK = (int*)(F.ws + WS_ROWTOK);
    const float* gnorm = MODE == 0 ? PIN(F, I_N1G) + layer * D : (MODE == 1 ? PIN(F, I_N2G) + layer * D : PIN(F, I_FG));
    LAS float* RW = (LAS float*)F.lds;
    LAS float* hst = (LAS float*)(F.lds + AUX_OFF) + F.wave * 512;
    if (combine) moe_tables(F, cl);
    if (MODE == 1) { __syncthreads(); const f32x4* src = (const f32x4*)(PIN(F, I_RW) + (size_t)layer * D * NE); for (int i = F.tid; i < D * NE / 4; i += NTHREADS) ((LAS f32x4*)RW)[i] = src[i]; __syncthreads(); }
    f32x4 gn[4];
#pragma unroll
    for (int j = 0; j < 4; ++j) gn[j] = ((const f32x4*)gnorm)[F.lane + 64 * j];
    const int ntiles = nrows / 32;
    for (int tile = F.bx; tile < ntiles; tile += F.G) {
#pragma unroll 1
        for (int rr = 0; rr < 4; ++rr) {
            const int r = tile * 32 + F.wave * 4 + rr; const bool lat = r < ML; const int bidx = lat ? (r >> 13) : 8;
            const size_t xo = lat ? (size_t)r * D : (size_t)(r - ML) * D;
            const f32x4* xs = (const f32x4*)((lat ? XLs : XCs) + xo);
            f32x4 v[4];
#pragma unroll
            for (int j = 0; j < 4; ++j) v[j] = xs[F.lane + 64 * j];
            if (combine) {
                const i32x4 te = *(const i32x4*)(TE + (size_t)r * 4), tr = *(const i32x4*)(TR + (size_t)r * 4); const f32x4 tg = *(const f32x4*)(TG + (size_t)r * 4);
                const float* g2 = MOD + ((size_t)cl * 9 + bidx) * 6144 + 5 * 1024;
                f32x4 a[4];
#pragma unroll
                for (int j = 0; j < 4; ++j) a[j] = (f32x4){0.f, 0.f, 0.f, 0.f};
#pragma unroll
                for (int k = 0; k < 4; ++k) { const int rowid = 256 * (int)F.MISC[MW_CUMBLK + te[k]] + tr[k]; const v2u* yr = (const v2u*)(YM + (size_t)rowid * D); const float gk = tg[k];
#pragma unroll
                    for (int j = 0; j < 4; ++j) { const v2u w = yr[F.lane + 64 * j]; a[j] += gk * (f32x4){bflo(w.x), bfhi(w.x), bflo(w.y), bfhi(w.y)}; } }
#pragma unroll
                for (int j = 0; j < 4; ++j) v[j] += ((const f32x4*)g2)[F.lane + 64 * j] * a[j];
                if (MODE == 0) { f32x4* xd = (f32x4*)((lat ? XLd : XCd) + xo);
#pragma unroll
                    for (int j = 0; j < 4; ++j) xd[F.lane + 64 * j] = v[j]; }
            }
            float ss = 0.f;
#pragma unroll
            for (int j = 0; j < 4; ++j) ss += (v[j].x * v[j].x + v[j].y * v[j].y) + (v[j].z * v[j].z + v[j].w * v[j].w);
            const float rstd = 1.0f / sqrtf(wave_sum(ss) * (1.0f / D) + EPS);
            if (MODE == 2) { f32x4* od = (f32x4*)(F.out + xo);
#pragma unroll
                for (int j = 0; j < 4; ++j) od[F.lane + 64 * j] = v[j] * rstd * gn[j];
                continue; }
            const float* mb = MOD + ((size_t)layer * 9 + bidx) * 6144 + (MODE == 0 ? 0 : 3 * 1024);
            f32x4 hv[4];
#pragma unroll
            for (int j = 0; j < 4; ++j) { const f32x4 sh = ((const f32x4*)mb)[F.lane + 64 * j], sc = ((const f32x4*)(mb + 1024))[F.lane + 64 * j]; hv[j] = v[j] * rstd * gn[j] * (sc + 1.0f) + sh; }
            v2u* hd = (v2u*)(H + (size_t)r * D);
#pragma unroll
            for (int j = 0; j < 4; ++j) { v2u w; w.x = cvt_pk_bf16(hv[j].x, hv[j].y); w.y = cvt_pk_bf16(hv[j].z, hv[j].w); hd[F.lane + 64 * j] = w; }
            if (MODE == 1) {
                const int e = F.lane & 31, par = F.lane >> 5; float acc = 0.f;
#pragma unroll
                for (int ph = 0; ph < 2; ++ph) {
                    LDS_WAIT(); asm volatile("" ::: "memory");
                    *(LAS f32x4*)(hst + 4 * F.lane) = hv[2 * ph]; *(LAS f32x4*)(hst + 256 + 4 * F.lane) = hv[2 * ph + 1];
                    LDS_WAIT(); asm volatile("" ::: "memory");
                    const LAS float* rwp = RW + (size_t)(512 * ph + par) * NE + e; const LAS float* hp = hst + par;
#pragma unroll 8
                    for (int m = 0; m < 256; ++m) acc += hp[2 * m] * rwp[2 * m * NE];
                }
                acc += __shfl_xor(acc, 32);
                const float logit = acc + PIN(F, I_RB)[layer * NE + e];
                int rank = 0;
#pragma unroll
                for (int i = 0; i < NE; ++i) { const float o = __shfl(logit, i); rank += (o > logit || (o == logit && i < e)) ? 1 : 0; }
                const int slot = F.wave * 4 + rr;
                if (F.lane < 32 && rank < 4) { F.MISC[MW_SELE + slot * 4 + rank] = (unsigned)e; F.MISC[MW_SELV + slot * 4 + rank] = __float_as_uint(logit); }
                LDS_WAIT(); asm volatile("" ::: "memory");
                { const int k = F.lane & 3; const float vk = __uint_as_float(F.MISC[MW_SELV + slot * 4 + k]); const float v0 = __shfl(vk, 0);
                  float ex = __expf(vk - v0); float sm = ex; sm += __shfl_xor(sm, 1); sm += __shfl_xor(sm, 2);
                  if (F.lane < 4) { TG[(size_t)r * 4 + k] = ex / sm; TE[(size_t)r * 4 + k] = (int)F.MISC[MW_SELE + slot * 4 + k]; } }
            }
        }
        if (MODE == 1) {
            __syncthreads();
            if (F.tid < NE) { unsigned cnt = 0;
                for (int a = 0; a < 128; ++a) { if (F.MISC[MW_SELE + a] == (unsigned)F.tid) { F.MISC[MW_LRANK + a] = cnt; ++cnt; } }
                unsigned base = 0; if (cnt) base = __hip_atomic_fetch_add(F.ctl + CW_CNT + layer * NE + F.tid, cnt, RLX_AGENT);
                F.MISC[MW_LBASE + F.tid] = base; }
            __syncthreads();
            if (F.tid < 128) { const int a = F.tid; const int e = (int)F.MISC[MW_SELE + a]; const int rank = (int)(F.MISC[MW_LBASE + e] + F.MISC[MW_LRANK + a]); const int tok = tile * 32 + (a >> 2);
                TR[(size_t)tok * 4 + (a & 3)] = rank; ROWTOK[(size_t)e * MT + rank] = tok; }
            __syncthreads();
        }
    }
}


typedef float f32x16r __attribute__((ext_vector_type(16)));
__device__ __forceinline__ void router_phase(Frame& F, int layer) {
    const bool last = layer == NLAYER - 1;
    const int ntiles = (last ? ML : MT) / 32;
    LAS float* PART = (LAS float*)F.lds;
    LAS float* SSQ = PART + 8 * 32 * 33;
    LAS float* LG = SSQ + 8 * 32;
    LAS float* RSTD = LG + 32 * 33;
    const float* XL = F.out; const float* XC = (const float*)(F.ws + WS_XC);
    const float* MOD = (const float*)(F.ws + WS_MOD); const float* RC = (const float*)(F.ws + WS_RC);
    unsigned char* H8 = (unsigned char*)(F.ws + WS_H8);
    int* TE = (int*)(F.ws + WS_TE); int* TR = (int*)(F.ws + WS_TR); float* TG = (float*)(F.ws + WS_TG); int* ROWTOK = (int*)(F.ws + WS_ROWTOK);
    const float* gn = PIN(F, I_N2G) + layer * D; const float* rw = PIN(F, I_RW) + (size_t)layer * D * NE;
    const int i = F.lane & 31, hf = F.lane >> 5, kb = F.wave * 128 + 64 * hf;
    for (int tile = F.bx; tile < ntiles; tile += F.G) {
        const int r0 = tile * 32; const bool lat = r0 < ML; const int bidx = lat ? (r0 >> 13) : 8; const int r = r0 + i;
        const float* xrow = (lat ? XL + (size_t)r * D : XC + (size_t)(r - ML) * D) + kb;
        const float* mb = MOD + ((size_t)layer * 9 + bidx) * 6144 + 3 * 1024;
        float xs[64];
#pragma unroll
        for (int q = 0; q < 16; ++q) { const f32x4 v = ((const f32x4*)xrow)[q]; xs[4 * q] = v.x; xs[4 * q + 1] = v.y; xs[4 * q + 2] = v.z; xs[4 * q + 3] = v.w; }
        float ssq = 0.f;
#pragma unroll
        for (int s = 0; s < 64; ++s) ssq += xs[s] * xs[s];
        ssq += __shfl_xor(ssq, 32);
        if (hf == 0) SSQ[F.wave * 32 + i] = ssq;
#pragma unroll
        for (int q = 0; q < 16; ++q) { const f32x4 g = ((const f32x4*)(gn + kb))[q], sc = ((const f32x4*)(mb + 1024 + kb))[q];
            xs[4 * q] *= g.x * (1.0f + sc.x); xs[4 * q + 1] *= g.y * (1.0f + sc.y); xs[4 * q + 2] *= g.z * (1.0f + sc.z); xs[4 * q + 3] *= g.w * (1.0f + sc.w); }
        f32x16r acc = {};
        const float* rwp = rw + (size_t)kb * NE + i;
#pragma unroll
        for (int s0 = 0; s0 < 64; s0 += 16) { float bv[16];
#pragma unroll
            for (int s = 0; s < 16; ++s) bv[s] = rwp[(size_t)(s0 + s) * NE];
#pragma unroll
            for (int s = 0; s < 16; ++s) acc = __builtin_amdgcn_mfma_f32_32x32x2f32(xs[s0 + s], bv[s], acc, 0, 0, 0); }
#pragma unroll
        for (int rg = 0; rg < 16; ++rg) PART[(F.wave * 32 + ((rg & 3) + 8 * (rg >> 2) + 4 * hf)) * 33 + i] = acc[rg];
        __syncthreads();
        { const int tk = F.tid >> 4, e0 = (F.tid & 15) * 2; float q = 0.f, s0 = 0.f, s1 = 0.f;
#pragma unroll
          for (int w = 0; w < 8; ++w) { q += SSQ[w * 32 + tk]; s0 += PART[(w * 32 + tk) * 33 + e0]; s1 += PART[(w * 32 + tk) * 33 + e0 + 1]; }
          const float rstd = 1.0f / sqrtf(q * (1.0f / D) + EPS); const float* rc = RC + ((size_t)layer * 9 + bidx) * NE;
          LG[tk * 33 + e0] = rstd * s0 + rc[e0]; LG[tk * 33 + e0 + 1] = rstd * s1 + rc[e0 + 1]; if ((F.tid & 15) == 0) RSTD[tk] = rstd; }
        __syncthreads();
        { const float rstd = RSTD[i]; unsigned w8[16];
#pragma unroll
          for (int q = 0; q < 16; ++q) { const f32x4 sh = ((const f32x4*)(mb + kb))[q]; unsigned w = 0;
              w = __builtin_amdgcn_cvt_pk_fp8_f32(xs[4 * q] * rstd + sh.x, xs[4 * q + 1] * rstd + sh.y, w, false);
              w = __builtin_amdgcn_cvt_pk_fp8_f32(xs[4 * q + 2] * rstd + sh.z, xs[4 * q + 3] * rstd + sh.w, w, true); w8[q] = w; }
          v4u* hd = (v4u*)(H8 + (size_t)r * D + kb);
#pragma unroll
          for (int q = 0; q < 4; ++q) hd[q] = (v4u){w8[4 * q], w8[4 * q + 1], w8[4 * q + 2], w8[4 * q + 3]}; }
#pragma unroll 1
        for (int rr = 0; rr < 4; ++rr) {
            const int slot = F.wave * 4 + rr, e = i; const float logit = LG[slot * 33 + e]; int rank = 0;
#pragma unroll
            for (int j = 0; j < NE; ++j) { const float o = __shfl(logit, j); rank += (o > logit || (o == logit && j < e)) ? 1 : 0; }
            if (F.lane < 32 && rank < 4) { F.MISC[MW_SELE + slot * 4 + rank] = (unsigned)e; F.MISC[MW_SELV + slot * 4 + rank] = __float_as_uint(logit); }
            LDS_WAIT(); asm volatile("" ::: "memory");
            { const int k = F.lane & 3; const float vk = __uint_as_float(F.MISC[MW_SELV + slot * 4 + k]); const float v0 = __shfl(vk, 0);
              float ex = __expf(vk - v0); float sm = ex; sm += __shfl_xor(sm, 1); sm += __shfl_xor(sm, 2);
              if (F.lane < 4) { const size_t tok = (size_t)r0 + slot; TG[tok * 4 + k] = ex / sm; TE[tok * 4 + k] = (int)F.MISC[MW_SELE + slot * 4 + k]; } }
        }
        __syncthreads();
        if (F.tid < NE) { unsigned cnt = 0;
            for (int a = 0; a < 128; ++a) { if (F.MISC[MW_SELE + a] == (unsigned)F.tid) { F.MISC[MW_LRANK + a] = cnt; ++cnt; } }
            unsigned base = 0; if (cnt) base = __hip_atomic_fetch_add(F.ctl + CW_CNT + layer * NE + F.tid, cnt, RLX_AGENT);
            F.MISC[MW_LBASE + F.tid] = base; }
        __syncthreads();
        if (F.tid < 128) { const int a = F.tid; const int e = (int)F.MISC[MW_SELE + a]; const int rank = (int)(F.MISC[MW_LBASE + e] + F.MISC[MW_LRANK + a]); const int tok = r0 + (a >> 2);
            TR[(size_t)tok * 4 + (a & 3)] = rank; ROWTOK[(size_t)e * MT + rank] = tok; }
        __syncthreads();
    }
}

__device__ __forceinline__ void normrope16(float (&x)[16], const float* gain, bool lat, int prow, int pcol, const LAS f32x2* T, int L) {
    float ss = 0.f;
#pragma unroll
    for (int i = 0; i < 16; ++i) ss += x[i] * x[i];
    ss += __shfl_xor(ss, 1); ss += __shfl_xor(ss, 2); ss += __shfl_xor(ss, 4);
    const float rstd = 1.0f / sqrtf(ss * (1.0f / 128.0f) + EPS);
    const int o = (L & 7) * 16;
#pragma unroll
    for (int i = 0; i < 16; ++i) x[i] = x[i] * rstd * gain[o + i];
    float p[16];
#pragma unroll
    for (int i = 0; i < 16; ++i) p[i] = __shfl_xor(x[i], 2);
    if (lat) {
        const int pos = (L & 4) ? pcol : prow; const float sgn = (L & 2) ? 1.0f : -1.0f; const LAS f32x2* t = T + pos * 32 + (L & 1) * 16;
#pragma unroll
        for (int i = 0; i < 16; ++i) { const f32x2 cs = t[i]; x[i] = x[i] * cs.x + sgn * p[i] * cs.y; }
    }
}
__device__ __forceinline__ void qkprep_phase(Frame& F, int j) {
    LAS f32x2* T = (LAS f32x2*)F.lds;
    __syncthreads();
    for (int i = F.tid; i < 128 * 32; i += NTHREADS) { const int pos = i >> 5, f = i & 31; const float inv = powf(10000.0f, -(float)f / 32.0f); const float ang = (float)pos * inv; float s, c; sincosf(ang, &s, &c); T[i] = (f32x2){c, s}; }
    __syncthreads();
    const bf16* P = (const bf16*)(F.ws + WS_P); bf16* QB = (bf16*)(F.ws + WS_QB); bf16* KVB = (bf16*)(F.ws + WS_KVB);
    const float* qg = PIN(F, I_AQG) + j * 128; const float* kg = PIN(F, I_AKG) + j * 128;
    const int gw = F.bx * NWAVES + F.wave, NGW = F.G * NWAVES, L = F.lane;
    for (int r = gw; r < MT; r += NGW) {
        const bool lat = r < ML; const int b = lat ? (r >> 13) : ((r - ML) >> 8); const int s = lat ? (r & (SEQ - 1)) : ((r - ML) & (CL - 1));
        const int prow = s >> 6, pcol = s & 63; const size_t kvrow = (size_t)b * SKV + (lat ? s : SEQ + s);
        const bf16* pr = P + (size_t)r * 1536;
        { const v4u a = *(const v4u*)(pr + 16 * L), c = *(const v4u*)(pr + 16 * L + 8); float x[16];
          x[0] = bflo(a.x); x[1] = bfhi(a.x); x[2] = bflo(a.y); x[3] = bfhi(a.y); x[4] = bflo(a.z); x[5] = bfhi(a.z); x[6] = bflo(a.w); x[7] = bfhi(a.w);
          x[8] = bflo(c.x); x[9] = bfhi(c.x); x[10] = bflo(c.y); x[11] = bfhi(c.y); x[12] = bflo(c.z); x[13] = bfhi(c.z); x[14] = bflo(c.w); x[15] = bfhi(c.w);
          normrope16(x, qg, lat, prow, pcol, T, L);
          v4u o0, o1; o0.x = cvt_pk_bf16(x[0], x[1]); o0.y = cvt_pk_bf16(x[2], x[3]); o0.z = cvt_pk_bf16(x[4], x[5]); o0.w = cvt_pk_bf16(x[6], x[7]);
          o1.x = cvt_pk_bf16(x[8], x[9]); o1.y = cvt_pk_bf16(x[10], x[11]); o1.z = cvt_pk_bf16(x[12], x[13]); o1.w = cvt_pk_bf16(x[14], x[15]);
          *(v4u*)(QB + (size_t)r * D + 16 * L) = o0; *(v4u*)(QB + (size_t)r * D + 16 * L + 8) = o1; }
        { const int Lk = L & 15; const v4u a = *(const v4u*)(pr + 1024 + 16 * Lk), c = *(const v4u*)(pr + 1024 + 16 * Lk + 8); float x[16];
          x[0] = bflo(a.x); x[1] = bfhi(a.x); x[2] = bflo(a.y); x[3] = bfhi(a.y); x[4] = bflo(a.z); x[5] = bfhi(a.z); x[6] = bflo(a.w); x[7] = bfhi(a.w);
          x[8] = bflo(c.x); x[9] = bfhi(c.x); x[10] = bflo(c.y); x[11] = bfhi(c.y); x[12] = bflo(c.z); x[13] = bfhi(c.z); x[14] = bflo(c.w); x[15] = bfhi(c.w);
          normrope16(x, kg, lat, prow, pcol, T, Lk);
          if (L < 16) { v4u o0, o1; o0.x = cvt_pk_bf16(x[0], x[1]); o0.y = cvt_pk_bf16(x[2], x[3]); o0.z = cvt_pk_bf16(x[4], x[5]); o0.w = cvt_pk_bf16(x[6], x[7]);
            o1.x = cvt_pk_bf16(x[8], x[9]); o1.y = cvt_pk_bf16(x[10], x[11]); o1.z = cvt_pk_bf16(x[12], x[13]); o1.w = cvt_pk_bf16(x[14], x[15]);
            *(v4u*)(KVB + kvrow * 512 + 16 * L) = o0; *(v4u*)(KVB + kvrow * 512 + 16 * L + 8) = o1; }
          else if (L < 48) { const int q = L - 16; *(v4u*)(KVB + kvrow * 512 + 256 + 8 * q) = *(const v4u*)(pr + 1280 + 8 * q); } }
    }
}
__device__ __forceinline__ void attention_phase(Frame& F, char* lds_generic, bool ctx_queries) {
    const bf16* QB = (const bf16*)(F.ws + WS_QB); const bf16* KVB = (const bf16*)(F.ws + WS_KVB); bf16* Y = (bf16*)(F.ws + WS_Y);
    const int nunits = 2048 + (ctx_queries ? 64 : 0);
    for (int u = F.bx; u < nunits; u += F.G) {
        if (u < 2048) { const int b = u >> 8, w = u & 255, h = w & 7, qb = w >> 3; const size_t qo = ((size_t)b * SEQ + (size_t)qb * 256) * D + h * 128; const bf16* kh = KVB + (size_t)b * SKV * 512 + (h >> 2) * 128;
            att::attn_dense_body(QB + qo, kh, kh + 256, Y + qo, SKV, lds_generic); }
        else { const int w = u - 2048, b = w >> 3, h = w & 7; const size_t qo = ((size_t)ML + (size_t)b * CL) * D + h * 128; const bf16* kh = KVB + ((size_t)b * SKV + SEQ) * 512 + (h >> 2) * 128;
            att::attn_dense_body(QB + qo, kh, kh + 256, Y + qo, CL, lds_generic); }
    }
}

__device__ __forceinline__ void gmlp_mix_phase(Frame& F) {
    constexpr int LDA = 136;
    LAS bf16* As = (LAS bf16*)F.lds;
    LAS bf16* Vt = (LAS bf16*)(F.lds + 128 * LDA * 2);
    LAS float* rs = (LAS float*)(F.lds + 2 * 128 * LDA * 2);
    const bf16* P = (const bf16*)(F.ws + WS_P); bf16* Y = (bf16*)(F.ws + WS_Y); const float* SS = (const float*)(F.ws + WS_SS);
    const float* ws = PIN(F, I_GWS); const float* bs = PIN(F, I_GBS); const float* vg = PIN(F, I_GVG);
    const int r32 = F.lane & 31, hi = F.lane >> 5;
    for (int u = F.bx; u < (MT / 128) * 8; u += F.G) {
        const int chunk = u >> 3, g = u & 7; const size_t row0 = (size_t)chunk * 128;
        __syncthreads();
        if (F.tid < 128) { const f32x4* sp = (const f32x4*)(SS + (row0 + F.tid) * 16); const f32x4 a = sp[0], b = sp[1], c = sp[2], d = sp[3];
            const float s = ((a.x + a.y) + (a.z + a.w)) + ((b.x + b.y) + (b.z + b.w)) + ((c.x + c.y) + (c.z + c.w)) + ((d.x + d.y) + (d.z + d.w)); rs[F.tid] = 1.0f / sqrtf(s * (1.0f / 1024.0f) + EPS); }
        __syncthreads();
        for (int i = F.tid; i < 128 * 32; i += NTHREADS) { const int p = i >> 5, q4 = (i & 31) * 4; const f32x4 w = *(const f32x4*)(ws + ((size_t)g * 128 + p) * 128 + q4);
            v2u o; o.x = pk2(w.x * rs[q4], w.y * rs[q4 + 1]); o.y = pk2(w.z * rs[q4 + 2], w.w * rs[q4 + 3]); *(LAS v2u*)(As + p * LDA + q4) = o; }
        for (int i = F.tid; i < 128 * 16; i += NTHREADS) { const int q = i >> 4, c8 = (i & 15) * 8; const v4u w = *(const v4u*)(P + (row0 + q) * 2048 + 1024 + g * 128 + c8);
            Vt[(c8 + 0) * LDA + q] = (bf16)(w.x & 0xffff); Vt[(c8 + 1) * LDA + q] = (bf16)(w.x >> 16); Vt[(c8 + 2) * LDA + q] = (bf16)(w.y & 0xffff); Vt[(c8 + 3) * LDA + q] = (bf16)(w.y >> 16);
            Vt[(c8 + 4) * LDA + q] = (bf16)(w.z & 0xffff); Vt[(c8 + 5) * LDA + q] = (bf16)(w.z >> 16); Vt[(c8 + 6) * LDA + q] = (bf16)(w.w & 0xffff); Vt[(c8 + 7) * LDA + q] = (bf16)(w.w >> 16); }
        __syncthreads();
        const int p0 = (F.wave >> 1) * 32, cbase = (F.wave & 1) * 64;
        f32x16 acc0 = {}, acc1 = {};
#pragma unroll
        for (int ks = 0; ks < 8; ++ks) { const int k0 = ks * 16 + hi * 8;
            const bf16x8 a = *(const LAS bf16x8*)(As + (p0 + r32) * LDA + k0);
            const bf16x8 b0 = *(const LAS bf16x8*)(Vt + (cbase + r32) * LDA + k0), b1 = *(const LAS bf16x8*)(Vt + (cbase + 32 + r32) * LDA + k0);
            acc0 = __builtin_amdgcn_mfma_f32_32x32x16_bf16(a, b0, acc0, 0, 0, 0); acc1 = __builtin_amdgcn_mfma_f32_32x32x16_bf16(a, b1, acc1, 0, 0, 0); }
#pragma unroll
        for (int t = 0; t < 2; ++t) { const int c = g * 128 + cbase + t * 32 + r32; const float gain = vg[c];
#pragma unroll
            for (int reg = 0; reg < 16; ++reg) { const int p = p0 + (reg & 3) + 8 * (reg >> 2) + 4 * hi; const float a = t == 0 ? acc0[reg] : acc1[reg];
                const float uu = bf2f(P[(row0 + p) * 2048 + c]); const float mixed = gain * a + bs[g * 128 + p];
                Y[(row0 + p) * D + c] = (bf16)f2bf(uu * mixed); } }
    }
    __syncthreads();
}

__device__ __forceinline__ void hyena_prep_phase(Frame& F) {
    LAS float* tl = (LAS float*)F.lds;
    const bf16* P = (const bf16*)(F.ws + WS_P); bf16* X0 = (bf16*)(F.ws + WS_X0); bf16* VG = (bf16*)(F.ws + WS_VG);
    float* VT = (float*)(F.ws + WS_VT); float* VTC = (float*)(F.ws + WS_VTC);
    const float* cw = PIN(F, I_HCW); const float* cb = PIN(F, I_HCB);
    const int tt = F.tid >> 3, cg = F.tid & 7;
    for (int u = F.bx; u < (MT / 64) * 16; u += F.G) {
        const int tb = u >> 4, c0 = (u & 15) * 64; const int r0 = tb * 64; const bool lat = r0 < ML;
        const int b = lat ? (r0 >> 13) : ((r0 - ML) >> 8), s0 = lat ? (r0 & (SEQ - 1)) : ((r0 - ML) & (CL - 1)), L = lat ? SEQ : CL;
        const int r = r0 + tt, s = s0 + tt, c = c0 + cg * 8;
        float o[3][8];
#pragma unroll
        for (int seg = 0; seg < 3; ++seg) { const int col = seg * 1024 + c;
            const v4u z0 = {0u, 0u, 0u, 0u};
            const v4u pm = s > 0 ? *(const v4u*)(P + (size_t)(r - 1) * 3072 + col) : z0, pc = *(const v4u*)(P + (size_t)r * 3072 + col), pn = s < L - 1 ? *(const v4u*)(P + (size_t)(r + 1) * 3072 + col) : z0;
            const f32x4 w0a = *(const f32x4*)(cw + col), w0b = *(const f32x4*)(cw + col + 4), w1a = *(const f32x4*)(cw + 3072 + col), w1b = *(const f32x4*)(cw + 3072 + col + 4);
            const f32x4 w2a = *(const f32x4*)(cw + 6144 + col), w2b = *(const f32x4*)(cw + 6144 + col + 4), ba = *(const f32x4*)(cb + col), bb = *(const f32x4*)(cb + col + 4);
            const unsigned pmw[4] = {pm.x, pm.y, pm.z, pm.w}, pcw[4] = {pc.x, pc.y, pc.z, pc.w}, pnw[4] = {pn.x, pn.y, pn.z, pn.w};
#pragma unroll
            for (int i = 0; i < 8; ++i) { const float xm = (i & 1) ? bfhi(pmw[i >> 1]) : bflo(pmw[i >> 1]), xc = (i & 1) ? bfhi(pcw[i >> 1]) : bflo(pcw[i >> 1]), xn = (i & 1) ? bfhi(pnw[i >> 1]) : bflo(pnw[i >> 1]);
                const float w0 = i < 4 ? w0a[i & 3] : w0b[i & 3], w1 = i < 4 ? w1a[i & 3] : w1b[i & 3], w2 = i < 4 ? w2a[i & 3] : w2b[i & 3], bi = i < 4 ? ba[i & 3] : bb[i & 3];
                o[seg][i] = xm * w0 + xc * w1 + xn * w2 + bi; } }
        float vgv[8];
#pragma unroll
        for (int i = 0; i < 8; ++i) vgv[i] = o[2][i] * o[1][i];
        v4u w; w.x = cvt_pk_bf16(o[0][0], o[0][1]); w.y = cvt_pk_bf16(o[0][2], o[0][3]); w.z = cvt_pk_bf16(o[0][4], o[0][5]); w.w = cvt_pk_bf16(o[0][6], o[0][7]);
        *(v4u*)(X0 + (size_t)r * D + c) = w;
        w.x = cvt_pk_bf16(vgv[0], vgv[1]); w.y = cvt_pk_bf16(vgv[2], vgv[3]); w.z = cvt_pk_bf16(vgv[4], vgv[5]); w.w = cvt_pk_bf16(vgv[6], vgv[7]);
        *(v4u*)(VG + (size_t)r * D + c) = w;
        __syncthreads();
#pragma unroll
        for (int i = 0; i < 8; ++i) tl[(cg * 8 + i) * 65 + tt] = vgv[i];
        __syncthreads();
        { const int cc = F.tid >> 3, ts = (F.tid & 7) * 8; float* dst = lat ? VT + ((size_t)b * 1024 + c0 + cc) * SEQ + s0 + ts : VTC + ((size_t)b * 1024 + c0 + cc) * CL + s0 + ts;
          const LAS float* sp = tl + cc * 65 + ts;
          *(f32x4*)dst = (f32x4){sp[0], sp[1], sp[2], sp[3]}; *(f32x4*)(dst + 4) = (f32x4){sp[4], sp[5], sp[6], sp[7]}; }
    }
    __syncthreads();
}
__device__ __forceinline__ void hyena_post_phase(Frame& F) {
    LAS float* tl = (LAS float*)F.lds;
    const bf16* X0 = (const bf16*)(F.ws + WS_X0); const bf16* VG = (const bf16*)(F.ws + WS_VG); bf16* Y = (bf16*)(F.ws + WS_Y);
    const float* VT = (const float*)(F.ws + WS_CT); const float* VTC = (const float*)(F.ws + WS_CTC); const float* dsk = PIN(F, I_HD);
    const int tt = F.tid >> 3, cg = F.tid & 7;
    for (int u = F.bx; u < (MT / 64) * 16; u += F.G) {
        const int tb = u >> 4, c0 = (u & 15) * 64; const int r0 = tb * 64; const bool lat = r0 < ML;
        const int b = lat ? (r0 >> 13) : ((r0 - ML) >> 8), s0 = lat ? (r0 & (SEQ - 1)) : ((r0 - ML) & (CL - 1));
        __syncthreads();
        { const int cc = F.tid >> 3, ts = (F.tid & 7) * 8; const float* src = lat ? VT + ((size_t)b * 1024 + c0 + cc) * SEQ + s0 + ts : VTC + ((size_t)b * 1024 + c0 + cc) * CL + s0 + ts;
          const f32x4 a = *(const f32x4*)src, bq = *(const f32x4*)(src + 4); LAS float* dp = tl + cc * 65 + ts;
          dp[0] = a.x; dp[1] = a.y; dp[2] = a.z; dp[3] = a.w; dp[4] = bq.x; dp[5] = bq.y; dp[6] = bq.z; dp[7] = bq.w; }
        __syncthreads();
        const int r = r0 + tt, c = c0 + cg * 8;
        const v4u x0 = *(const v4u*)(X0 + (size_t)r * D + c), vv = *(const v4u*)(VG + (size_t)r * D + c);
        const f32x4 da = *(const f32x4*)(dsk + c), db = *(const f32x4*)(dsk + c + 4);
        const unsigned x0w[4] = {x0.x, x0.y, x0.z, x0.w}, vw[4] = {vv.x, vv.y, vv.z, vv.w}; float y[8];
#pragma unroll
        for (int i = 0; i < 8; ++i) { const float xx = (i & 1) ? bfhi(x0w[i >> 1]) : bflo(x0w[i >> 1]), vx = (i & 1) ? bfhi(vw[i >> 1]) : bflo(vw[i >> 1]); const float di = i < 4 ? da[i & 3] : db[i & 3];
            y[i] = (tl[(cg * 8 + i) * 65 + tt] + vx * di) * xx; }
        v4u w; w.x = cvt_pk_bf16(y[0], y[1]); w.y = cvt_pk_bf16(y[2], y[3]); w.z = cvt_pk_bf16(y[4], y[5]); w.w = cvt_pk_bf16(y[6], y[7]);
        *(v4u*)(Y + (size_t)r * D + c) = w;
    }
    __syncthreads();
}
__device__ __forceinline__ bool phase_nonempty(int ph) {
    if (ph < PH_L0 || ph >= PH_FINAL) return true;
    const int layer = (ph - PH_L0) / PH_PER_LAYER, lp = (ph - PH_L0) % PH_PER_LAYER, kind = layer % 3;
    if (lp == LP_MIX2) return kind != 1;
    if (lp == LP_MIX3) return kind == 2;
    return true;
}
__global__ void __launch_bounds__(NTHREADS, 2) mk_fwd(Args args) {
    extern __shared__ __attribute__((aligned(16))) unsigned char lds[];
    Frame F0;
    F0.lds = (LAS unsigned char*)lds; F0.MISC = (volatile LAS unsigned*)(F0.lds + MISC_OFF);
    F0.tid = threadIdx.x; F0.lane = F0.tid & 63; F0.wave = __builtin_amdgcn_readfirstlane(F0.tid >> 6);
    F0.G = gridDim.x; F0.bx = blockIdx.x; F0.out = args.out; F0.ws = args.ws; F0.ctl = (gu32*)(args.ws + WS_CTL);
    for (int u = F0.tid; u < MISC_BYTES / 4; u += NTHREADS) F0.MISC[u] = 0u;
    __syncthreads();
    if (F0.tid < 36) { const unsigned long long p = (unsigned long long)args.in[F0.tid]; F0.MISC[MW_PTRS + 2 * F0.tid] = (unsigned)p; F0.MISC[MW_PTRS + 2 * F0.tid + 1] = (unsigned)(p >> 32); }
    __syncthreads();
    const int lo = args.ph_lo, hi = args.ph_hi;
    const bool multi = (hi - lo) > 1;
    XcdBarrier bar; bar.bar = (unsigned*)(F0.ctl + CW_BAR); bar.x = 0; bar.st = nullptr;
    if (multi) bar = xcd_barrier_post((unsigned*)(F0.ctl + CW_BAR), F0.MISC + 8);
#ifndef PHMASK
#define PHMASK 0xFFFF
#endif
#define EN(b) ((PHMASK >> (b)) & 1)
#ifndef KMASK
#define KMASK 7
#endif
#define KEN(b) ((KMASK >> (b)) & 1)
#define IN(k) (lo <= (k) && (k) < hi)
#define SEAM(k) do { if ((k) + 1 < hi) xcd_barrier(bar); } while (0)
#define PB(id) for (int _rep = 0, _n = ((id) == MK_REPEAT ? MK_NREP : 1); _rep < _n; ++_rep) {
#define PE(id) if (_rep + 1 < _n) xcd_barrier(bar); } SEAM(id);

    if (EN(0) && IN(PH_PRO0)) { PB(PH_PRO0) Frame F = phase_frame(F0); pro0_mod(F); __syncthreads(); pro0_transposes(F); pro0_filter_mlp(F); PE(PH_PRO0) }
    if (EN(1) && IN(PH_PRO1)) { PB(PH_PRO1) Frame F = phase_frame(F0); pro1_filters(F); PE(PH_PRO1) }

#pragma unroll 1
    for (int layer = 0; layer < NLAYER; ++layer) {
        const int kind = layer % 3, jj = layer / 3, pb = PH_L0 + layer * PH_PER_LAYER; const bool last = layer == NLAYER - 1;
        if (EN(2) && IN(pb + LP_NORM1)) { PB(pb + LP_NORM1) Frame F = phase_frame(F0); rowpass<0>(F, layer); PE(pb + LP_NORM1) }
        if (EN(3) && IN(pb + LP_INPROJ)) { PB(pb + LP_INPROJ)
            Frame F = phase_frame(F0);
            const int N = kind == 0 ? 1536 : (kind == 1 ? 2048 : 3072);
            const size_t woff = kind == 0 ? WS_WATT + (size_t)jj * 1536 * 1024 * 2 : (kind == 1 ? WS_WGM : WS_WHY);
            pg8::DenseSched S; S.init(F.ws + WS_H, F.ws + woff, MT, N, F.G, F.bx);
            pg8::EpiBf16 E{(bf16*)(F.ws + WS_P), N, (float*)(F.ws + WS_SS), kind == 1 ? 1 : 0};
            pg8::gemm_phase<pg8::EpiBf16, pg8::DenseSched, false>(F.lds, S, E);
            PE(pb + LP_INPROJ)
        }
        if (IN(pb + LP_MIX1)) { PB(pb + LP_MIX1)
            Frame F = phase_frame(F0);
            if (EN(4) && kind == 0) qkprep_phase(F, jj); else if (EN(5) && kind == 1) gmlp_mix_phase(F); else if (EN(6)) hyena_prep_phase(F);
            PE(pb + LP_MIX1)
        }
        if (IN(pb + LP_MIX2) && kind != 1) { PB(pb + LP_MIX2)
            Frame F = phase_frame(F0);
            if (EN(7) && kind == 0) attention_phase(F, (char*)lds, !last); else if (EN(8)) hyena_conv_phase(F);
            PE(pb + LP_MIX2)
        }
        if (EN(9) && IN(pb + LP_MIX3) && kind == 2) { PB(pb + LP_MIX3) Frame F = phase_frame(F0); hyena_post_phase(F); PE(pb + LP_MIX3) }
        if (EN(10) && IN(pb + LP_OUTPROJ)) { PB(pb + LP_OUTPROJ)
            Frame F = phase_frame(F0); const float* modl = (const float*)(F.ws + WS_MOD) + (size_t)layer * 9 * 6144;
            pg8::DenseSched S; S.init(F.ws + WS_Y, F.ws + WS_WOUT + (size_t)layer * 1024 * 1024 * 2, last ? ML : MT, 1024, F.G, F.bx);
            const bool first = layer == 0;
            pg8::EpiResid E{first ? PIN(F, I_X) : F.out, first ? PIN(F, I_CTX) : (const float*)(F.ws + WS_XC), F.out, (float*)(F.ws + WS_XC), modl};
            pg8::gemm_phase<pg8::EpiResid, pg8::DenseSched, false>(F.lds, S, E);
            PE(pb + LP_OUTPROJ)
        }
        if (EN(11) && IN(pb + LP_NORM2)) { PB(pb + LP_NORM2) Frame F = phase_frame(F0); router_phase(F, layer); PE(pb + LP_NORM2) }
        if (EN(12) && IN(pb + LP_MOE1)) { PB(pb + LP_MOE1)
            Frame F = phase_frame(F0);
            moe_tables(F, layer);
            pg8::MoeSched S{(const char*)(F.ws + WS_H8), (const char*)(F.ws + WS_WE1) + (size_t)layer * NE * 2048 * 1024, (size_t)2048 * 1024, (const int*)(F.ws + WS_ROWTOK),
                            (const volatile LAS int*)(F.MISC + MW_CUMBLK), (const volatile LAS int*)(F.MISC + MW_CNT), 3, F.G, F.bx, 1024};
            pg8::EpiSwiglu E{(unsigned char*)(F.ws + WS_ACT), PIN(F, I_EB1) + (size_t)layer * NE * 2048};
            pg8::gemm_phase<pg8::EpiSwiglu, pg8::MoeSched, true, true>(F.lds, S, E);
            PE(pb + LP_MOE1)
        }
        if (EN(13) && IN(pb + LP_MOE2)) { PB(pb + LP_MOE2)
            Frame F = phase_frame(F0);
            moe_tables(F, layer);
            pg8::MoeSched S{(const char*)(F.ws + WS_ACT), (const char*)(F.ws + WS_WE2) + (size_t)layer * NE * 1024 * 1024, (size_t)1024 * 1024, nullptr,
                            (const volatile LAS int*)(F.MISC + MW_CUMBLK), (const volatile LAS int*)(F.MISC + MW_CNT), 2, F.G, F.bx, 1024};
            pg8::EpiBias E{(bf16*)(F.ws + WS_YM), PIN(F, I_EB2) + (size_t)layer * NE * 1024};
            pg8::gemm_phase<pg8::EpiBias, pg8::MoeSched, true, true>(F.lds, S, E);
            PE(pb + LP_MOE2)
        }
    }
    if (EN(14) && IN(PH_FINAL)) { Frame F = phase_frame(F0); rowpass<2>(F, NLAYER - 1); }
#undef IN
#undef SEAM
}

static bool host_phase_nonempty(int ph) {
    if (ph < PH_L0 || ph >= PH_FINAL) return true;
    const int layer = (ph - PH_L0) / PH_PER_LAYER, lp = (ph - PH_L0) % PH_PER_LAYER, kind = layer % 3;
    if (lp == LP_MIX2) return kind != 1;
    if (lp == LP_MIX3) return kind == 2;
    return true;
}
extern "C" void kernel_launch(void* const* d_in, const int* in_sizes, int n_in, void* d_out, int out_size, void* d_ws, size_t ws_size, hipStream_t stream) {
    static int grid = 0;
    if (grid == 0) {
        if (n_in != 36 || in_sizes[0] != ML * D || out_size != ML * D || ws_size < WS_END) {
            fprintf(stderr, "kernel_launch: built for 36 inputs, x/out of %d floats, >= %zu bytes of workspace; got n_in %d in0 %d out %d ws %zu; nothing launched\n", ML * D, (size_t)WS_END, n_in, n_in > 0 ? in_sizes[0] : -1, out_size, ws_size);
            grid = -1; return; }
        int dev = 0, cus = 0, per_cu = 0;
        if (hipGetDevice(&dev) != hipSuccess || hipDeviceGetAttribute(&cus, hipDeviceAttributeMultiprocessorCount, dev) != hipSuccess) { fprintf(stderr, "kernel_launch: device query failed\n"); grid = -1; return; }
        if (hipFuncSetAttribute((const void*)mk_fwd, hipFuncAttributeMaxDynamicSharedMemorySize, LDS_BYTES) != hipSuccess) { fprintf(stderr, "kernel_launch: hipFuncSetAttribute(%d B LDS) failed\n", LDS_BYTES); grid = -1; return; }
        if (hipOccupancyMaxActiveBlocksPerMultiprocessor(&per_cu, (const void*)mk_fwd, NTHREADS, LDS_BYTES) != hipSuccess || per_cu < 1)
            fprintf(stderr, "kernel_launch: note: occupancy query reports %d workgroups per CU\n", per_cu);
        (void)hipGetLastError();
        grid = cus;
    }
    if (grid < 0) return;
    if (hipMemsetAsync((char*)d_ws + WS_CTL, 0, CTL_ZERO_BYTES, stream) != hipSuccess) { fprintf(stderr, "kernel_launch: memset failed\n"); return; }
    Args a{};
    for (int i = 0; i < 36; ++i) a.in[i] = (const float*)d_in[i];
    a.out = (float*)d_out; a.ws = (unsigned char*)d_ws;
#if MK_MULTI || MK_DBG
    for (int ph = 0; ph < PH_COUNT; ++ph) {
        if (!host_phase_nonempty(ph)) continue;
        a.ph_lo = ph; a.ph_hi = ph + 1;
        hipLaunchKernelGGL(mk_fwd, dim3(grid), dim3(NTHREADS), LDS_BYTES, stream, a);
#if MK_DBG
        dbg_after_phase(ph, a, stream);
#endif
    }
#if MK_DBG
    dbg_report(a, stream);
#endif
#else
    a.ph_lo = 0; a.ph_hi = PH_COUNT;
    hipLaunchKernelGGL(mk_fwd, dim3(grid), dim3(NTHREADS), LDS_BYTES, stream, a);
#endif
    const hipError_t le = hipPeekAtLastError();
    if (le != hipSuccess) fprintf(stderr, "kernel_launch: launch failed: %s\n", hipGetErrorName(le));
}
```

```cpp
#include <hip/hip_runtime.h>
#include <cstdio>
#include <cstdint>
#include <cmath>

#ifndef MK_MULTI
#define MK_MULTI 0
#endif
#ifndef MK_REPEAT
#define MK_REPEAT -1
#endif
#ifndef MK_NREP
#define MK_NREP 1
#endif
#ifndef MK_DBG
#define MK_DBG 0
#endif

constexpr int D = 1024, NB = 8, SEQ = 8192, CL = 256, ML = NB * SEQ, MC = NB * CL, MT = ML + MC;
constexpr int NLAYER = 4, NE = 32, TOPK = 4, SKV = SEQ + CL;
constexpr int MOE_MAXBLK = (MT * TOPK) / 256 + NE;
constexpr float EPS = 1e-6f;
constexpr int FH = 64, FEMB = 33, NFFT = 16384;

constexpr size_t MiB = 1u << 20;
constexpr size_t WS_CTL = 0, CTL_ZERO_BYTES = 1 * MiB;
constexpr size_t WS_MOD = 1 * MiB;
constexpr size_t WS_A3 = 2 * MiB;
constexpr size_t WS_A3C = 4 * MiB;
constexpr size_t WS_RC = 4 * MiB + 512 * 1024;
constexpr size_t WS_FCT = 5 * MiB;
constexpr size_t WS_WATT = 8 * MiB;
constexpr size_t WS_WGM = 14 * MiB;
constexpr size_t WS_WHY = 18 * MiB;
constexpr size_t WS_WOUT = 24 * MiB;
constexpr size_t WS_XC = 32 * MiB;
constexpr size_t WS_TE = 40 * MiB;
constexpr size_t WS_TR = 42 * MiB;
constexpr size_t WS_TG = 44 * MiB;
constexpr size_t WS_SS = 46 * MiB;
constexpr size_t WS_ROWTOK = 52 * MiB;
constexpr size_t WS_KF = 64 * MiB;
constexpr size_t WS_WE1 = 192 * MiB;
constexpr size_t WS_WE2 = 704 * MiB;
constexpr size_t WS_H = 960 * MiB;
constexpr size_t WS_P = 1092 * MiB;
constexpr size_t WS_Y = 1488 * MiB;
constexpr size_t WS_QB = 1620 * MiB;
constexpr size_t WS_KVB = 1752 * MiB;
constexpr size_t WS_X0 = 1818 * MiB;
constexpr size_t WS_VG = 1950 * MiB;
constexpr size_t WS_VT = 2082 * MiB;
constexpr size_t WS_VTC = 2338 * MiB;
constexpr size_t WS_ACT = 2346 * MiB;
constexpr size_t WS_YM = 2890 * MiB;
constexpr size_t WS_CT = 3434 * MiB;
constexpr size_t WS_CTC = 3690 * MiB;
constexpr size_t WS_H8 = 3698 * MiB;
constexpr size_t WS_END = 3764 * MiB;
constexpr int CW_BAR = 4096;
constexpr int CW_CNT = 16384;
constexpr int CW_DBG = 32768;

constexpr int RING_BYTES = 131072;
constexpr int AUX_OFF = RING_BYTES;
constexpr int AUX_BYTES = 16384;
constexpr int MISC_OFF = AUX_OFF + AUX_BYTES;
constexpr int MISC_BYTES = 4096;
constexpr int LDS_BYTES = MISC_OFF + MISC_BYTES;

#define GAS __attribute__((address_space(1)))
#define LAS __attribute__((address_space(3)))
typedef unsigned short bf16;
typedef unsigned v4u __attribute__((ext_vector_type(4)));
typedef unsigned v2u __attribute__((ext_vector_type(2)));
typedef float f32x4 __attribute__((ext_vector_type(4)));
typedef float f32x2 __attribute__((ext_vector_type(2)));
typedef float f32x16 __attribute__((ext_vector_type(16)));
typedef short bf16x8 __attribute__((ext_vector_type(8)));
typedef short s16x4 __attribute__((ext_vector_type(4)));
typedef int i32x4 __attribute__((ext_vector_type(4)));
typedef GAS unsigned gu32;
#define RLX_AGENT __ATOMIC_RELAXED, __HIP_MEMORY_SCOPE_AGENT
#define LDS_WAIT() asm volatile("s_waitcnt lgkmcnt(0)" ::: "memory")
#define VM_WAIT() asm volatile("s_waitcnt vmcnt(0)" ::: "memory")
__device__ __forceinline__ unsigned f2bf(float f) { unsigned u = __builtin_bit_cast(unsigned, f); return (u + 0x7fffu + ((u >> 16) & 1u)) >> 16; }
__device__ __forceinline__ unsigned pk2(float lo, float hi) { return f2bf(lo) | (f2bf(hi) << 16); }
__device__ __forceinline__ float bf2f(unsigned short b) { return __builtin_bit_cast(float, ((unsigned)b) << 16); }
__device__ __forceinline__ float bflo(unsigned w) { return __builtin_bit_cast(float, w << 16); }
__device__ __forceinline__ float bfhi(unsigned w) { return __builtin_bit_cast(float, w & 0xffff0000u); }
__device__ __forceinline__ unsigned cvt_pk_bf16(float lo, float hi) { unsigned r; asm volatile("v_cvt_pk_bf16_f32 %0, %1, %2" : "=v"(r) : "v"(lo), "v"(hi)); return r; }
__device__ __forceinline__ int opaque_tid() { int t = (int)threadIdx.x; asm volatile("" : "+v"(t)); return t; }
__device__ __forceinline__ float wave_sum(float v) {
#pragma unroll
    for (int o = 1; o < 64; o <<= 1) v += __shfl_xor(v, o);
    return v;
}

#define XB_TMO      128
#define XB_XCNT(j)  (256  + 64 * (j))
#define XB_XSUB(j)  (1280 + 64 * (j))
#define XB_XGEN(j)  (2304 + 64 * (j))
#define XB_TOP      3328
#define XB_TOPGEN   3392
#define XCD_BAR_WORDS 3456
#define XB_SPIN_CAP (1u << 22)
__device__ __forceinline__ unsigned xb_ld(unsigned* p)              { return __hip_atomic_load(p, __ATOMIC_RELAXED, __HIP_MEMORY_SCOPE_AGENT); }
__device__ __forceinline__ unsigned xb_add(unsigned* p, unsigned v) { return __hip_atomic_fetch_add(p, v, __ATOMIC_RELAXED, __HIP_MEMORY_SCOPE_AGENT); }
__device__ __forceinline__ unsigned xb_xcc_id() { return (unsigned)__builtin_amdgcn_s_getreg((3 << 11) | 20) & 0xFu; }
#define XB_SPIN(cond, bar) do { unsigned _sp = 0; while (cond) { __builtin_amdgcn_s_sleep(1); \
    if ((++_sp & 255u) == 0u) { if (xb_ld(&(bar)[XB_TMO])) break; if (_sp > XB_SPIN_CAP) { atomicAdd(&(bar)[XB_TMO], 1u); break; } } } } while (0)
struct XcdBarrier { unsigned* bar; unsigned x; volatile LAS unsigned* st; };
__device__ __forceinline__ XcdBarrier xcd_barrier_post(unsigned* bar, volatile LAS unsigned* st) {
    XcdBarrier b; b.bar = bar; b.x = xb_xcc_id(); b.st = st;
    if (threadIdx.x == 0) (void)xb_add(&bar[XB_XCNT(b.x)], 1u);
    return b;
}
__device__ __forceinline__ void xcd_barrier_complete(unsigned* bar, unsigned x, unsigned& nloc, unsigned& nx) {
    const unsigned G = gridDim.x * gridDim.y * gridDim.z;
    unsigned sum, cnt, mine, sp = 0u;
    for (;;) {
        sum = 0u; cnt = 0u; mine = 0u;
#pragma unroll
        for (unsigned j = 0; j < 16; ++j) { const unsigned c = xb_ld(&bar[XB_XCNT(j)]); sum += c; cnt += (c > 0u) ? 1u : 0u; mine = (j == x) ? c : mine; }
        if (sum == G) break;
        __builtin_amdgcn_s_sleep(1);
        if ((++sp & 255u) == 0u) { if (xb_ld(&bar[XB_TMO])) break; if (sp > XB_SPIN_CAP) { atomicAdd(&bar[XB_TMO], 1u); break; } }
    }
    nloc = mine > 0u ? mine : 1u; nx = cnt > 0u ? cnt : 1u;
}
__device__ __forceinline__ void xcd_barrier(const XcdBarrier& b) {
    asm volatile("s_waitcnt vmcnt(0)" ::: "memory");
    __syncthreads();
    if (threadIdx.x == 0) {
        unsigned* bar = b.bar;
        __builtin_amdgcn_s_waitcnt(0);
        unsigned nloc = b.st[0], nx = b.st[1];
        if (nloc == 0u) { xcd_barrier_complete(bar, b.x, nloc, nx); b.st[0] = nloc; b.st[1] = nx; }
        const unsigned old = xb_add(&bar[XB_XSUB(b.x)], 1u);
        const unsigned gen = old / nloc;
        if (old + 1u == (gen + 1u) * nloc) {
            __builtin_amdgcn_fence(__ATOMIC_RELEASE, "agent");
            asm volatile("s_waitcnt vmcnt(0)" ::: "memory");
            const unsigned og = xb_add(&bar[XB_TOP], 1u);
            const unsigned tg = og / nx;
            if (og + 1u == (tg + 1u) * nx) xb_add(&bar[XB_TOPGEN], 1u);
            else XB_SPIN(xb_ld(&bar[XB_TOPGEN]) == tg, bar);
            __builtin_amdgcn_fence(__ATOMIC_ACQUIRE, "agent");
            xb_add(&bar[XB_XGEN(b.x)], 1u);
            asm volatile("s_waitcnt vmcnt(0)" ::: "memory");
        } else {
            XB_SPIN(xb_ld(&bar[XB_XGEN(b.x)]) == gen, bar);
            __builtin_amdgcn_fence(__ATOMIC_ACQUIRE, "agent");
            asm volatile("s_waitcnt vmcnt(0)" ::: "memory");
        }
    }
    __syncthreads();
}

namespace pg8 {
constexpr int BM = 256, BK = 64, HALF = 128, HTB = HALF * BK * 2, STAGE_BYTES = 8 * HTB, NXCD = 8, WGM = 8;
constexpr int GK = 1024;
__device__ __forceinline__ int lds_byte(int r, int c) { const int st = (r >> 4) * 2 + (c >> 5), rr = r & 15, cc = c & 31, ob = rr * 64 + cc * 2; return st * 1024 + (ob ^ (((ob >> 9) & 1) << 5)); }
__device__ __forceinline__ void stage_rc(int b, int& R, int& C) { const int st = b / 1024, sb = b % 1024, swz = sb ^ (((sb >> 9) & 1) << 5); R = (st >> 1) * 16 + swz / 64; C = (st & 1) * 32 + (swz % 64) / 2; }
__device__ __forceinline__ int perm32(int rho) { const int n = rho >> 4, i = rho & 15; return 8 * (i >> 2) + 4 * n + (i & 3); }
struct Unit { int pm, pn, e; };

struct DenseSched {
    const char* A; const char* Bt; int nM, nN, nwg, G, c;
    __device__ __forceinline__ void init(const void* A_, const void* Bt_, int M, int N, int G_, int c_) { A = (const char*)A_; Bt = (const char*)Bt_; nM = M / BM; nN = N / BM; nwg = nM * nN; G = G_; c = c_; }
    __device__ __forceinline__ bool next(int i, Unit& u) const {
        const long L = (long)i * G + c; if (L >= nwg) return false;
        int wgid = (int)L; { const int q = nwg / NXCD, r = nwg % NXCD, xcd = wgid % NXCD, off = wgid / NXCD; wgid = (xcd < r ? xcd * (q + 1) : r * (q + 1) + (xcd - r) * q) + off; }
        const int nig = WGM * nN, gid = wgid / nig, fm = gid * WGM, gsz = (nM - fm) < WGM ? (nM - fm) : WGM;
        u.pm = fm + ((wgid % nig) % gsz); u.pn = (wgid % nig) / gsz; u.e = 0; return true;
    }
    __device__ __forceinline__ const char* a_ptr(const Unit& u) const { return A + (size_t)u.pm * (BM * GK * 2); }
    __device__ __forceinline__ const char* b_ptr(const Unit& u) const { return Bt + (size_t)u.pn * (BM * GK * 2); }
    __device__ __forceinline__ void a_offs(const Unit&, const int (&)[2], const int (&)[2], unsigned (&)[2][2]) const {}
};
struct MoeSched {
    const char* A; const char* Bt; size_t b_estride; const int* rowtok; const volatile LAS int* cumblk; const volatile LAS int* cnt; int ncol_log2, G, c, kb;
    __device__ __forceinline__ bool next(int i, Unit& u) const {
        int gb, pn; const int ncol = 1 << ncol_log2;
        if (G == 256) { const int xcd = c & 7, j = c >> 3, rpb = 256 >> ncol_log2; gb = i * rpb + xcd + 8 * (j >> ncol_log2); pn = j & (ncol - 1); }
        else { const long L = (long)i * G + c; gb = (int)(L >> ncol_log2); pn = (int)(L & (ncol - 1)); }
        const int tot = cumblk[NE]; if (gb >= tot) return false;
        int e = 0;
#pragma unroll 1
        for (int s = 16; s >= 1; s >>= 1) { if (cumblk[e + s] <= gb) e += s; }
        u.pm = gb; u.pn = pn; u.e = e; return true;
    }
    __device__ __forceinline__ const char* a_ptr(const Unit&) const { return A; }
    __device__ __forceinline__ const char* b_ptr(const Unit& u) const { return Bt + (size_t)u.e * b_estride + (size_t)u.pn * (size_t)(BM * kb); }
    __device__ __forceinline__ void a_offs(const Unit& u, const int (&R)[2], const int (&C)[2], unsigned (&voff)[2][2]) const {
        const int rb = u.pm - cumblk[u.e], n = cnt[u.e]; const int* rt = rowtok + (size_t)u.e * MT;
#pragma unroll
        for (int h = 0; h < 2; ++h)
#pragma unroll
            for (int i = 0; i < 2; ++i) { const int rank = rb * 256 + h * HALF + R[i]; const int tok = rowtok ? (rank < n ? rt[rank] : 0) : u.pm * BM + h * HALF + R[i]; voff[h][i] = (unsigned)tok * (unsigned)kb + (unsigned)C[i] * 2u; }
    }
};

typedef int v8i __attribute__((ext_vector_type(8)));
__device__ __forceinline__ v8i cat8(bf16x8 lo, bf16x8 hi) { const v4u a = __builtin_bit_cast(v4u, lo), b = __builtin_bit_cast(v4u, hi); return (v8i){(int)a.x, (int)a.y, (int)a.z, (int)a.w, (int)b.x, (int)b.y, (int)b.z, (int)b.w}; }
template <class Epi, class Sched, bool GATHER, bool FP8 = false>
__device__ __forceinline__ void gemm_phase(LAS unsigned char* lds, const Sched& S, const Epi& E) {
    const int tid = opaque_tid(), wid = __builtin_amdgcn_readfirstlane(tid >> 6), lane = tid & 63, wr = wid >> 2, wc = wid & 3, fr = lane & 15, fq = lane >> 4;
    constexpr int KB = FP8 ? GK : GK * 2, nt = KB / (BK * 2);
    unsigned voffA[2][2], voffB[2]; int Rr[2], Cc[2];
#pragma unroll
    for (int i = 0; i < 2; ++i) { int R, C; stage_rc(tid * 16 + i * 8192, R, C); Rr[i] = R; Cc[i] = C; const int Rb = Epi::PERM ? ((R & ~31) + perm32(R & 31)) : R;
        voffA[0][i] = (unsigned)(R * KB + C * 2); voffA[1][i] = (unsigned)((R + HALF) * KB + C * 2); voffB[i] = (unsigned)(Rb * KB + C * 2); }
    constexpr size_t kstep = (size_t)(BK * 2);
    constexpr size_t hstep = (size_t)HALF * KB;
    const unsigned ldsw = (unsigned)wid * 1024u;
    const int aoff = lds_byte(wr * 64 + fr, fq * 8), boff = lds_byte(wc * 32 + fr, fq * 8);
    LAS unsigned char* abase = lds + aoff; LAS unsigned char* bbase = lds + 4 * HTB + boff; asm volatile("" : "+v"(abase), "+v"(bbase));
#define PG8_SA(b, h) (((b) * 2 + (h)) * HTB)
#define PG8_SB(b, h) ((4 + (b) * 2 + (h)) * HTB)
#define PG8_STAGE(bufoff, gbase, voff) do { _Pragma("unroll") for (int _i = 0; _i < 2; ++_i) \
        __builtin_amdgcn_global_load_lds((const unsigned*)((const char*)(gbase) + (voff)[_i]), (LAS unsigned*)(lds + (bufoff) + ldsw + _i * 8192), 16, 0, 0); } while (0)
#define PG8_STAGE_A(bufoff, gbase, h) PG8_STAGE(bufoff, gbase, voffA[h])
#define PG8_RDA(off) (*(const LAS v4u*)(abase + (off)))
#define PG8_RDB(off) (*(const LAS v4u*)(bbase + (off)))
#define PG8_LDA(dst, b, h) do { _Pragma("unroll") for (int m = 0; m < 4; ++m) { const v4u _l = PG8_RDA(PG8_SA(b, h) + m * 2048), _h = PG8_RDA(PG8_SA(b, h) + m * 2048 + 1024); \
        if constexpr (FP8) dst##8[m] = (v8i){(int)_l.x, (int)_l.y, (int)_l.z, (int)_l.w, (int)_h.x, (int)_h.y, (int)_h.z, (int)_h.w}; \
        else { dst[m][0] = __builtin_bit_cast(bf16x8, _l); dst[m][1] = __builtin_bit_cast(bf16x8, _h); } } } while (0)
#define PG8_LDB(dst, b, h) do { _Pragma("unroll") for (int n = 0; n < 2; ++n) { const v4u _l = PG8_RDB(PG8_SA(b, h) + n * 2048), _h = PG8_RDB(PG8_SA(b, h) + n * 2048 + 1024); \
        if constexpr (FP8) dst##8[n] = (v8i){(int)_l.x, (int)_l.y, (int)_l.z, (int)_l.w, (int)_h.x, (int)_h.y, (int)_h.z, (int)_h.w}; \
        else { dst[n][0] = __builtin_bit_cast(bf16x8, _l); dst[n][1] = __builtin_bit_cast(bf16x8, _h); } } } while (0)
#define PG8_MMA(ai, bj, At, Bt) do { __builtin_amdgcn_s_setprio(1); _Pragma("unroll") for (int m = 0; m < 4; ++m) _Pragma("unroll") for (int n = 0; n < 2; ++n) { \
        if constexpr (FP8) acc[ai][bj][m][n] = __builtin_amdgcn_mfma_scale_f32_16x16x128_f8f6f4(Bt##8[n], At##8[m], acc[ai][bj][m][n], 0, 0, 0, 0x7A7A7A7A, 0, 0x7F7F7F7F); \
        else { _Pragma("unroll") for (int k = 0; k < 2; ++k) acc[ai][bj][m][n] = __builtin_amdgcn_mfma_f32_16x16x32_bf16(Bt[n][k], At[m][k], acc[ai][bj][m][n], 0, 0, 0); } } \
        __builtin_amdgcn_s_setprio(0); } while (0)
#define PG8_WAIT_V(n) asm volatile("s_waitcnt vmcnt(" #n ")" ::: "memory")
#define PG8_WAIT_L(n) asm volatile("s_waitcnt lgkmcnt(" #n ")" ::: "memory")
#define PG8_BAR __builtin_amdgcn_s_barrier()
#define PG8_SCHED __builtin_amdgcn_sched_barrier(0)
    Unit cur, nxt; int ui = 0;
    if (!S.next(0, cur)) return;
    f32x4 acc[2][2][4][2];
#pragma unroll
    for (int a = 0; a < 2; ++a)
#pragma unroll
        for (int b = 0; b < 2; ++b)
#pragma unroll
            for (int m = 0; m < 4; ++m)
#pragma unroll
                for (int n = 0; n < 2; ++n) acc[a][b][m][n] = (f32x4){0.f, 0.f, 0.f, 0.f};
    bf16x8 At[4][2], B0[2][2], B1[2][2]; v8i At8[4], B08[2], B18[2];
    const char* cA = S.a_ptr(cur); const char* cB = S.b_ptr(cur);
    if constexpr (GATHER) S.a_offs(cur, Rr, Cc, voffA);
    PG8_STAGE(PG8_SB(0, 0), cB, voffB); PG8_STAGE(PG8_SB(0, 1), cB + hstep, voffB); PG8_STAGE_A(PG8_SA(0, 0), cA, 0); PG8_STAGE_A(PG8_SA(0, 1), cA, 1);
    if (wr == 1) PG8_BAR;
    PG8_WAIT_V(2); PG8_BAR;
    PG8_STAGE(PG8_SB(1, 0), cB + kstep, voffB); PG8_STAGE_A(PG8_SA(1, 0), cA + kstep, 0); PG8_STAGE(PG8_SB(1, 1), cB + hstep + kstep, voffB);
    PG8_WAIT_V(6); PG8_BAR;
    for (;;) {
        const bool has_next = S.next(ui + 1, nxt);
        const char* nA = has_next ? S.a_ptr(nxt) : cA; const char* nB = has_next ? S.b_ptr(nxt) : cB;
#pragma unroll 1
        for (int t = 0; t < nt; t += 2) {
            const bool last = (t == nt - 2);
            const char* a1 = cA + (size_t)(t + 1) * kstep;
            const char* a2 = last ? nA : cA + (size_t)(t + 2) * kstep; const char* b2 = last ? nB : cB + (size_t)(t + 2) * kstep;
            const char* a3 = a2 + kstep; const char* b3 = b2 + kstep;
            PG8_LDB(B0, 0, 0); PG8_LDB(B1, 0, 1); PG8_SCHED; PG8_LDA(At, 0, 0); PG8_STAGE_A(PG8_SA(1, 1), a1, 1);
            if constexpr (GATHER) { if (last && has_next) S.a_offs(nxt, Rr, Cc, voffA); }
            PG8_WAIT_V(8); PG8_WAIT_L(0); PG8_BAR; PG8_MMA(0, 0, At, B0); PG8_MMA(0, 1, At, B1); PG8_BAR; PG8_SCHED;
            PG8_LDA(At, 0, 1); PG8_STAGE(PG8_SB(0, 0), b2, voffB); PG8_STAGE(PG8_SB(0, 1), b2 + hstep, voffB); PG8_STAGE_A(PG8_SA(0, 0), a2, 0);
            PG8_WAIT_V(8); PG8_WAIT_L(0); PG8_BAR; PG8_MMA(1, 0, At, B0); PG8_MMA(1, 1, At, B1); PG8_BAR; PG8_SCHED;
            PG8_LDB(B0, 1, 0); PG8_LDB(B1, 1, 1); PG8_SCHED; PG8_LDA(At, 1, 0); PG8_STAGE_A(PG8_SA(0, 1), a2, 1);
            PG8_WAIT_V(8); PG8_WAIT_L(0); PG8_BAR; PG8_MMA(0, 0, At, B0); PG8_MMA(0, 1, At, B1); PG8_BAR; PG8_SCHED;
            PG8_LDA(At, 1, 1); PG8_STAGE(PG8_SB(1, 0), b3, voffB); PG8_STAGE(PG8_SB(1, 1), b3 + hstep, voffB); PG8_STAGE_A(PG8_SA(1, 0), a3, 0);
            PG8_WAIT_V(8); PG8_WAIT_L(0); PG8_BAR; PG8_MMA(1, 0, At, B0); PG8_MMA(1, 1, At, B1); PG8_BAR; PG8_SCHED;
        }
        if (wr == 0) PG8_BAR;
        E(acc, cur, wr, wc, fr, fq);
        if (!has_next) break;
#pragma unroll
        for (int a = 0; a < 2; ++a)
#pragma unroll
            for (int b = 0; b < 2; ++b)
#pragma unroll
                for (int m = 0; m < 4; ++m)
#pragma unroll
                    for (int n = 0; n < 2; ++n) acc[a][b][m][n] = (f32x4){0.f, 0.f, 0.f, 0.f};
        cur = nxt; cA = nA; cB = nB; ++ui;
        if (wr == 1) PG8_BAR;
    }
    PG8_WAIT_V(0);
    PG8_BAR;
#undef PG8_SA
#undef PG8_SB
#undef PG8_STAGE
#undef PG8_STAGE_A
#undef PG8_LDA
#undef PG8_RDA
#undef PG8_RDB
#undef PG8_LDB
#undef PG8_MMA
#undef PG8_WAIT_V
#undef PG8_WAIT_L
#undef PG8_BAR
#undef PG8_SCHED
}
}
namespace pg8 {
__device__ __forceinline__ f32x2 gelu_pk(f32x2 v) {
    const f32x2 av = __builtin_elementwise_abs(v), d = av * 0.2316418882f + 1.0f;
    f32x2 t; t.x = __builtin_amdgcn_rcpf(d.x); t.y = __builtin_amdgcn_rcpf(d.y);
    f32x2 q = t * 0.5307027145f + (-0.7265760135f); q = q * t + 0.7107068705f; q = q * t + (-0.142248368f); q = q * t + 0.127414796f; q = q * t;
    const f32x2 s = (v * v) * (-0.72134752044f);
    f32x2 e; e.x = __builtin_amdgcn_exp2f(s.x); e.y = __builtin_amdgcn_exp2f(s.y);
    const f32x2 m = v * (q * e), r = v - m;
    f32x2 o; o.x = v.x < 0.f ? m.x : r.x; o.y = v.y < 0.f ? m.y : r.y; return o;
}
struct EpiBf16 {
    static constexpr bool PERM = true;
    bf16* O; int ldc; float* ss; int ACT;
    __device__ __forceinline__ void operator()(const f32x4 (&acc)[2][2][4][2], const Unit& u, int wr, int wc, int fr, int fq) const {
        const int row0 = u.pm * BM + wr * 64 + fr, col0 = u.pn * BM + wc * 32 + 8 * fq;
#pragma unroll
        for (int ai = 0; ai < 2; ++ai)
#pragma unroll
            for (int m = 0; m < 4; ++m) { const int row = row0 + ai * HALF + m * 16; bf16* rowp = O + (size_t)row * ldc + col0; float sq = 0.f;
#pragma unroll
                for (int bj = 0; bj < 2; ++bj) { f32x4 v0 = acc[ai][bj][m][0], v1 = acc[ai][bj][m][1];
                    if (ACT == 1) { f32x2 a = gelu_pk((f32x2){v0[0], v0[1]}), b = gelu_pk((f32x2){v0[2], v0[3]}), c = gelu_pk((f32x2){v1[0], v1[1]}), d = gelu_pk((f32x2){v1[2], v1[3]});
                        v0 = (f32x4){a.x, a.y, b.x, b.y}; v1 = (f32x4){c.x, c.y, d.x, d.y};
                        sq += (v0[0] * v0[0] + v0[1] * v0[1]) + (v0[2] * v0[2] + v0[3] * v0[3]) + (v1[0] * v1[0] + v1[1] * v1[1]) + (v1[2] * v1[2] + v1[3] * v1[3]); }
                    v4u w; w.x = cvt_pk_bf16(v0[0], v0[1]); w.y = cvt_pk_bf16(v0[2], v0[3]); w.z = cvt_pk_bf16(v1[0], v1[1]); w.w = cvt_pk_bf16(v1[2], v1[3]);
                    *(v4u*)(rowp + bj * HALF) = w; }
                if (ACT == 1) { sq += __shfl_xor(sq, 16); sq += __shfl_xor(sq, 32);
                    if (u.pn >= 4 && fq == 0) ss[(size_t)row * 16 + (u.pn - 4) * 4 + wc] = sq; }
            }
    }
};
struct EpiResid {
    static constexpr bool PERM = false;
    const float* baseL; const float* baseC; float* outL; float* outC; const float* modl;
    __device__ __forceinline__ void operator()(const f32x4 (&acc)[2][2][4][2], const Unit& u, int wr, int wc, int fr, int fq) const {
        const bool lat = u.pm < ML / BM; const int rb = lat ? u.pm : u.pm - ML / BM, bidx = lat ? (u.pm >> 5) : 8;
        const float* base = (lat ? baseL : baseC) + (size_t)rb * BM * D; float* out = (lat ? outL : outC) + (size_t)rb * BM * D;
        const float* g = modl + bidx * 6144 + 2 * 1024;
        const int r0 = wr * 64 + fr, col0 = u.pn * BM + wc * 32 + 4 * fq;
        f32x4 gv[2][2];
#pragma unroll
        for (int bj = 0; bj < 2; ++bj)
#pragma unroll
            for (int n = 0; n < 2; ++n) gv[bj][n] = *(const f32x4*)(g + col0 + bj * HALF + n * 16);
#pragma unroll
        for (int ai = 0; ai < 2; ++ai)
#pragma unroll
            for (int m = 0; m < 4; ++m) { const size_t off = (size_t)(r0 + ai * HALF + m * 16) * D + col0;
#pragma unroll
                for (int bj = 0; bj < 2; ++bj)
#pragma unroll
                    for (int n = 0; n < 2; ++n) { const f32x4 bs = *(const f32x4*)(base + off + bj * HALF + n * 16); *(f32x4*)(out + off + bj * HALF + n * 16) = bs + gv[bj][n] * acc[ai][bj][m][n]; }
                asm volatile("" ::: "memory"); }
    }
};
struct EpiSwiglu {
    static constexpr bool PERM = true;
    unsigned char* O; const float* b1;
    __device__ __forceinline__ void operator()(const f32x4 (&acc)[2][2][4][2], const Unit& u, int wr, int wc, int fr, int fq) const {
        const int row0 = u.pm * BM + wr * 64 + fr, c0 = u.pn * HALF + wc * 32 + 8 * fq; const float* be = b1 + (size_t)u.e * 2048;
        f32x4 bg[2], bl[2];
#pragma unroll
        for (int n = 0; n < 2; ++n) { bg[n] = *(const f32x4*)(be + c0 + 4 * n); bl[n] = *(const f32x4*)(be + 1024 + c0 + 4 * n); }
#pragma unroll
        for (int ai = 0; ai < 2; ++ai)
#pragma unroll
            for (int m = 0; m < 4; ++m) { float o[8];
#pragma unroll
                for (int n = 0; n < 2; ++n)
#pragma unroll
                    for (int j = 0; j < 4; ++j) { float gl = acc[ai][0][m][n][j] + bg[n][j], li = acc[ai][1][m][n][j] + bl[n][j];
                        gl = fminf(gl, 7.0f); li = fminf(fmaxf(li, -7.0f), 7.0f);
                        const float sg = __builtin_amdgcn_rcpf(1.0f + __builtin_amdgcn_exp2f(gl * (-1.702f * 1.4426950408889634f)));
                        o[n * 4 + j] = gl * sg * (li + 1.0f); }
                v2u w; w.x = 0; w.y = 0;
                w.x = __builtin_amdgcn_cvt_pk_fp8_f32(o[0], o[1], w.x, false); w.x = __builtin_amdgcn_cvt_pk_fp8_f32(o[2], o[3], w.x, true);
                w.y = __builtin_amdgcn_cvt_pk_fp8_f32(o[4], o[5], w.y, false); w.y = __builtin_amdgcn_cvt_pk_fp8_f32(o[6], o[7], w.y, true);
                *(v2u*)(O + (size_t)(row0 + ai * HALF + m * 16) * D + c0) = w; }
    }
};
struct EpiBias {
    static constexpr bool PERM = true;
    bf16* O; const float* b2;
    __device__ __forceinline__ void operator()(const f32x4 (&acc)[2][2][4][2], const Unit& u, int wr, int wc, int fr, int fq) const {
        const int row0 = u.pm * BM + wr * 64 + fr, col0 = u.pn * BM + wc * 32 + 8 * fq; const float* be = b2 + (size_t)u.e * 1024 + col0;
#pragma unroll
        for (int bj = 0; bj < 2; ++bj) { const f32x4 bv0 = *(const f32x4*)(be + bj * HALF), bv1 = *(const f32x4*)(be + bj * HALF + 4);
#pragma unroll
            for (int ai = 0; ai < 2; ++ai)
#pragma unroll
                for (int m = 0; m < 4; ++m) { const f32x4 v0 = acc[ai][bj][m][0] + bv0, v1 = acc[ai][bj][m][1] + bv1;
                    v4u w; w.x = cvt_pk_bf16(v0[0], v0[1]); w.y = cvt_pk_bf16(v0[2], v0[3]); w.z = cvt_pk_bf16(v1[0], v1[1]); w.w = cvt_pk_bf16(v1[2], v1[3]);
                    *(v4u*)(O + (size_t)(row0 + ai * HALF + m * 16) * D + col0 + bj * HALF) = w; }
            asm volatile("" ::: "memory"); }
    }
};
}

namespace att {
constexpr int AD = 128, NW = 8, QBLK = 32, KVBLK = 64;
constexpr float SCALE = 0.088388347648318440f;
constexpr float THR = 8.f;
constexpr int LDQ = 1024, LDK = 512, LDO = 1024;
constexpr int SHM_V = KVBLK * AD * 2, SHM_K = KVBLK * AD * 2, SHM_ATTN = 2 * SHM_V + 2 * SHM_K + NW * 64 * 4;
#define KSWZ(row, colB) ((row) * 256 + ((colB) ^ (((row) & 7) << 4)))
#define SBAR() __builtin_amdgcn_sched_barrier(0)
__device__ __forceinline__ int crow(int r, int hi) { return (r & 3) + 8 * (r >> 2) + 4 * hi; }
__device__ __forceinline__ void partialSM(f32x16& p0, f32x16& p1, float& m_reg, float& mn, float& alpha) {
  constexpr float C = SCALE * 1.4426950408889634f;
  float pmax = p0[0]; for (int r = 1; r < 16; ++r) pmax = fmaxf(pmax, p0[r]); for (int r = 0; r < 16; ++r) pmax = fmaxf(pmax, p1[r]);
  { auto rr = __builtin_amdgcn_permlane32_swap(__float_as_uint(pmax), __float_as_uint(pmax), false, false);
    pmax = fmaxf(__uint_as_float(rr[0]), __uint_as_float(rr[1])); }
  if (__builtin_expect(__all(pmax - m_reg <= THR / SCALE), 1)) { mn = m_reg; alpha = 1.f; }
  else { mn = fmaxf(m_reg, pmax); alpha = __builtin_amdgcn_exp2f((m_reg - mn) * C); m_reg = mn; }
  float mnC = -mn * C;
  for (int r = 0; r < 16; ++r) p0[r] = fmaf(p0[r], C, mnC); for (int r = 0; r < 16; ++r) p1[r] = fmaf(p1[r], C, mnC);
  for (int r = 0; r < 16; ++r) p0[r] = __builtin_amdgcn_exp2f(p0[r]);
}
__device__ __forceinline__ void finishSM(f32x16& p0, f32x16& p1, float alpha, float& l_reg, bf16x8& pa0, bf16x8& pa1, bf16x8& pa2, bf16x8& pa3) {
  for (int r = 0; r < 16; ++r) p1[r] = __builtin_amdgcn_exp2f(p1[r]);
  float ps = 0; for (int r = 0; r < 16; ++r) ps += p0[r]; for (int r = 0; r < 16; ++r) ps += p1[r];
  { auto rr = __builtin_amdgcn_permlane32_swap(__float_as_uint(ps), __float_as_uint(ps), false, false);
    ps = __uint_as_float(rr[0]) + __uint_as_float(rr[1]); }
  l_reg = l_reg * alpha + ps;
#define PK4(P, BASE, OUT) do { unsigned a0 = cvt_pk_bf16(P[BASE + 0], P[BASE + 1]), a1 = cvt_pk_bf16(P[BASE + 2], P[BASE + 3]);   \
    unsigned b0 = cvt_pk_bf16(P[BASE + 4], P[BASE + 5]), b1 = cvt_pk_bf16(P[BASE + 6], P[BASE + 7]);                              \
    auto r0 = __builtin_amdgcn_permlane32_swap(a0, b0, false, false); auto r1 = __builtin_amdgcn_permlane32_swap(a1, b1, false, false); \
    v4u w = {r0[0], r1[0], r0[1], r1[1]}; OUT = *reinterpret_cast<bf16x8*>(&w); } while (0)
  PK4(p0, 0, pa0); PK4(p0, 8, pa1); PK4(p1, 0, pa2); PK4(p1, 8, pa3);
#undef PK4
}
__device__ __forceinline__ void qkt(f32x16& p0, f32x16& p1, const bf16* Ks, const bf16x8* qr, int r32, int hi) {
  p0 = f32x16{}; p1 = f32x16{};
  for (int d0 = 0; d0 < 8; ++d0) { int cb = (d0 * 16 + hi * 8) * 2;
    bf16x8 b0 = *reinterpret_cast<const bf16x8*>((const char*)Ks + KSWZ(r32, cb));
    bf16x8 b1 = *reinterpret_cast<const bf16x8*>((const char*)Ks + KSWZ(32 + r32, cb));
    p0 = __builtin_amdgcn_mfma_f32_32x32x16_bf16(b0, qr[d0], p0, 0, 0, 0);
    p1 = __builtin_amdgcn_mfma_f32_32x32x16_bf16(b1, qr[d0], p1, 0, 0, 0); }
}
__device__ __forceinline__ int v_st(int k, int c) { const int kk = (k & ~0xC) | ((k & 4) << 1) | ((k & 8) >> 1); return ((kk >> 3) * 4 + (c >> 5)) * 512 + ((kk & 7) * 32 + (c & 31)) * 2; }
__device__ __forceinline__ int v_rd_base(int lane) { return ((lane & 3) << 3) | (((lane >> 2) & 3) << 6) | (((lane >> 4) & 1) << 5) | (((lane >> 5) & 1) << 8); }
constexpr int v_rd_off(int d0, int ks, int half) { return d0 * 512 + ks * 4096 + half * 2048; }
template <int OFF> __device__ __forceinline__ s16x4 tr_read(int vb) {
  s16x4 r; asm volatile("ds_read_b64_tr_b16 %0, %1 offset:%2" : "=&v"(r) : "v"(vb), "i"(OFF) : "memory"); return r;
}
template <int D0> __device__ __forceinline__ void pv_one(f32x16& od, int vb, bf16x8 pa0, bf16x8 pa1, bf16x8 pa2, bf16x8 pa3) {
  const s16x4 l0 = tr_read<v_rd_off(D0, 0, 0)>(vb), h0 = tr_read<v_rd_off(D0, 0, 1)>(vb), l1 = tr_read<v_rd_off(D0, 1, 0)>(vb), h1 = tr_read<v_rd_off(D0, 1, 1)>(vb);
  const s16x4 l2 = tr_read<v_rd_off(D0, 2, 0)>(vb), h2 = tr_read<v_rd_off(D0, 2, 1)>(vb), l3 = tr_read<v_rd_off(D0, 3, 0)>(vb), h3 = tr_read<v_rd_off(D0, 3, 1)>(vb);
  asm volatile("s_waitcnt lgkmcnt(0)" ::: "memory"); SBAR();
#define PK(L, H) (bf16x8){L[0], L[1], L[2], L[3], H[0], H[1], H[2], H[3]}
  od = __builtin_amdgcn_mfma_f32_32x32x16_bf16(pa0, PK(l0, h0), od, 0, 0, 0);
  od = __builtin_amdgcn_mfma_f32_32x32x16_bf16(pa1, PK(l1, h1), od, 0, 0, 0);
  od = __builtin_amdgcn_mfma_f32_32x32x16_bf16(pa2, PK(l2, h2), od, 0, 0, 0);
  od = __builtin_amdgcn_mfma_f32_32x32x16_bf16(pa3, PK(l3, h3), od, 0, 0, 0);
#undef PK
}
__device__ __forceinline__ void pv_d0(f32x16* o, int vb, bf16x8 pa0, bf16x8 pa1, bf16x8 pa2, bf16x8 pa3) {
  pv_one<0>(o[0], vb, pa0, pa1, pa2, pa3); pv_one<1>(o[1], vb, pa0, pa1, pa2, pa3); pv_one<2>(o[2], vb, pa0, pa1, pa2, pa3); pv_one<3>(o[3], vb, pa0, pa1, pa2, pa3);
}
__device__ __forceinline__ void attn_dense_body(const bf16* __restrict__ Qb, const bf16* __restrict__ Kh, const bf16* __restrict__ Vh, bf16* __restrict__ Ob, int seq, char* lds) {
  const int tid = opaque_tid(), wid = tid >> 6, lane = tid & 63, r32 = lane & 31, hi = lane >> 5;
  bf16* V_lds = (bf16*)lds; bf16* K_lds = (bf16*)(lds + 2 * SHM_V);
  float* ws = (float*)(lds + 2 * SHM_V + 2 * SHM_K) + wid * 64; float* li_l = ws; float* al_l = ws + 32;
  float m_reg = -1e30f, l_reg = 0; f32x16 o[4] = {}; bf16x8 qr[8];
  const bf16* Qw = Qb + (long)(wid * QBLK + r32) * LDQ + hi * 8;
#pragma unroll
  for (int d0 = 0; d0 < 8; ++d0) qr[d0] = *reinterpret_cast<const bf16x8*>(Qw + d0 * 16);
  const int sr = tid >> 4, sc = (tid & 15) * 8, vst0 = v_st(sr, sc), vst1 = v_st(32 + sr, sc);
  const int vb0 = (int)(uintptr_t)V_lds + v_rd_base(lane);
  struct { bf16x8 vs0, vs1, ks0, ks1; } sr_[2];
#define SLOAD(i, k0) do { sr_[i].vs0 = *reinterpret_cast<const bf16x8*>(&Vh[(long)((k0) + sr) * LDK + sc]); sr_[i].vs1 = *reinterpret_cast<const bf16x8*>(&Vh[(long)((k0) + 32 + sr) * LDK + sc]); \
    sr_[i].ks0 = *reinterpret_cast<const bf16x8*>(&Kh[(long)((k0) + sr) * LDK + sc]); sr_[i].ks1 = *reinterpret_cast<const bf16x8*>(&Kh[(long)((k0) + 32 + sr) * LDK + sc]); } while (0)
#define SWRITE(b, i) do { *(bf16x8*)((char*)V_lds + (b) * SHM_V + vst0) = sr_[i].vs0;          \
    *(bf16x8*)((char*)V_lds + (b) * SHM_V + vst1) = sr_[i].vs1; int kc = sc * 2;               \
    *(bf16x8*)((char*)K_lds + (b) * SHM_K + KSWZ(sr, kc)) = sr_[i].ks0;                       \
    *(bf16x8*)((char*)K_lds + (b) * SHM_K + KSWZ(32 + sr, kc)) = sr_[i].ks1; } while (0)
#define SWAIT() asm volatile("s_waitcnt vmcnt(4)" ::: "memory")
#define RESC(a) do { if (__any((a) < 1.f)) { if (hi == 0) al_l[r32] = (a); asm volatile("s_waitcnt lgkmcnt(0)" ::: "memory"); \
    for (int d = 0; d < 4; ++d) for (int r = 0; r < 16; ++r) o[d][r] *= al_l[crow(r, hi)]; } } while (0)
  f32x16 pA0, pA1, pB0, pB1; float mnA, mnB, alA, alB; bf16x8 pa0, pa1, pa2, pa3; const int NT = seq / KVBLK;
  constexpr int SE = 0, SO = 1;
  SLOAD(SE, 0); asm volatile("s_waitcnt vmcnt(0)" ::: "memory"); SWRITE(0, SE); __syncthreads();
  qkt(pA0, pA1, K_lds, qr, r32, hi); partialSM(pA0, pA1, m_reg, mnA, alA);
  SLOAD(SO, KVBLK); if (2 < NT) SLOAD(SE, 2 * KVBLK);
  SWAIT(); SWRITE(1, SO); __syncthreads();
  for (int j = 1; j + 1 < NT; j += 2) {
    SBAR(); qkt(pB0, pB1, (bf16*)((char*)K_lds + SHM_K), qr, r32, hi);
    finishSM(pA0, pA1, alA, l_reg, pa0, pa1, pa2, pa3); SBAR();
    SLOAD(SO, (j + 2) * KVBLK); SBAR();
    pv_d0(o, vb0, pa0, pa1, pa2, pa3); partialSM(pB0, pB1, m_reg, mnB, alB);
    __syncthreads(); SWAIT(); SWRITE(0, SE);
    RESC(alB); __syncthreads();
    SBAR(); qkt(pA0, pA1, K_lds, qr, r32, hi);
    finishSM(pB0, pB1, alB, l_reg, pa0, pa1, pa2, pa3); SBAR();
    if (j + 3 < NT) SLOAD(SE, (j + 3) * KVBLK); SBAR();
    pv_d0(o, vb0 + (int)SHM_V, pa0, pa1, pa2, pa3); partialSM(pA0, pA1, m_reg, mnA, alA);
    __syncthreads(); SWAIT(); SWRITE(1, SO);
    RESC(alA); __syncthreads();
  }
  SBAR(); qkt(pB0, pB1, (bf16*)((char*)K_lds + SHM_K), qr, r32, hi);
  finishSM(pA0, pA1, alA, l_reg, pa0, pa1, pa2, pa3); SBAR();
  pv_d0(o, vb0, pa0, pa1, pa2, pa3); partialSM(pB0, pB1, m_reg, mnB, alB);
  __syncthreads(); RESC(alB);
  finishSM(pB0, pB1, alB, l_reg, pa0, pa1, pa2, pa3); SBAR();
  pv_d0(o, vb0 + (int)SHM_V, pa0, pa1, pa2, pa3);
  if (hi == 0) li_l[r32] = l_reg; asm volatile("s_waitcnt lgkmcnt(0)" ::: "memory");
  float rli[16];
#pragma unroll
  for (int r = 0; r < 16; ++r) rli[r] = __builtin_amdgcn_rcpf(li_l[crow(r, hi)]);
  bf16* Ow = Ob + (long)(wid * QBLK) * LDO;
#pragma unroll
  for (int r = 0; r < 16; ++r) { int orow = crow(r, hi);
    for (int d0 = 0; d0 < 4; ++d0) Ow[(long)orow * LDO + d0 * 32 + r32] = (bf16)f2bf(o[d0][r] * rli[r]); }
  __syncthreads();
#undef SLOAD
#undef SWRITE
#undef SWAIT
#undef RESC
}
#undef KSWZ
}
constexpr int NWAVES = 8, NTHREADS = 512;
struct Args { const float* in[36]; float* out; unsigned char* ws; int ph_lo, ph_hi; };
enum InIdx { I_X = 0, I_C, I_CTX, I_CCTX, I_ADAW, I_ADAB, I_N1G, I_N2G, I_WOUT, I_RW, I_RB, I_EW1, I_EB1, I_EW2, I_EB2, I_AWIN, I_AQG, I_AKG,
             I_GWIN, I_GVG, I_GWS, I_GBS, I_HWIN, I_HCW, I_HCB, I_FW1, I_FB1, I_FW2, I_FB2, I_FW3, I_FB3, I_FW4, I_FB4, I_FREQ, I_HD, I_FG };
struct Frame {
    LAS unsigned char* lds; volatile LAS unsigned* MISC; gu32* ctl;
    int tid, lane, wave, G, bx;
    float* out; unsigned char* ws;
};
template <class T> __device__ __forceinline__ T* launder(T* p) { unsigned long long v = (unsigned long long)p; asm volatile("" : "+s"(v)); return (T*)v; }
constexpr int MW_PTRS = 640;
__device__ __forceinline__ const float* pin_load(const Frame& F, int i) {
    const unsigned lo = __builtin_amdgcn_readfirstlane(F.MISC[MW_PTRS + 2 * i]), hi = __builtin_amdgcn_readfirstlane(F.MISC[MW_PTRS + 2 * i + 1]);
    return (const float*)(((unsigned long long)hi << 32) | lo);
}
#define PIN(F, i) pin_load(F, i)
__device__ __forceinline__ Frame phase_frame(const Frame& F0) {
    Frame F = F0; F.tid = opaque_tid(); F.lane = F.tid & 63; F.wave = __builtin_amdgcn_readfirstlane(F.tid >> 6);
    F.ws = launder(F0.ws); F.out = launder(F0.out); F.ctl = (gu32*)(F.ws + WS_CTL); return F;
}
constexpr int PH_PRO0 = 0, PH_PRO1 = 1, PH_L0 = 2, PH_PER_LAYER = 9, PH_FINAL = PH_L0 + NLAYER * PH_PER_LAYER, PH_COUNT = PH_FINAL + 1;
enum LPhase { LP_NORM1 = 0, LP_INPROJ, LP_MIX1, LP_MIX2, LP_MIX3, LP_OUTPROJ, LP_NORM2, LP_MOE1, LP_MOE2 };

template <bool FP8> __device__ __forceinline__ void transpose_item(const float* W, int N, void* WT, int k0, int n0, int drow0, LAS float* scr, int lane) {
    constexpr int K = 1024;
    float v[64];
    const float* src = W + (size_t)k0 * N + n0 + lane;
#pragma unroll
    for (int kk = 0; kk < 64; ++kk) v[kk] = src[(size_t)kk * N];
#pragma unroll
    for (int kk = 0; kk < 64; ++kk) scr[kk * 65 + lane] = v[kk];
    LDS_WAIT(); asm volatile("" ::: "memory");
    if constexpr (!FP8) {
        const int c = lane & 7;
#pragma unroll
        for (int j = 0; j < 8; ++j) { const int n = (lane >> 3) + 8 * j; const LAS float* s = scr + (8 * c) * 65 + n;
            v4u o; o.x = pk2(s[0 * 65], s[1 * 65]); o.y = pk2(s[2 * 65], s[3 * 65]); o.z = pk2(s[4 * 65], s[5 * 65]); o.w = pk2(s[6 * 65], s[7 * 65]);
            *(GAS v4u*)((bf16*)WT + (size_t)(drow0 + n) * K + k0 + 8 * c) = o; }
    } else {
        const int c = lane & 3;
#pragma unroll
        for (int j = 0; j < 4; ++j) { const int n = (lane >> 2) + 16 * j; const LAS float* s = scr + (16 * c) * 65 + n; unsigned w[4];
#pragma unroll
            for (int q = 0; q < 4; ++q) { unsigned x = 0; x = __builtin_amdgcn_cvt_pk_fp8_f32(32.0f * s[(4 * q) * 65], 32.0f * s[(4 * q + 1) * 65], x, false);
                x = __builtin_amdgcn_cvt_pk_fp8_f32(32.0f * s[(4 * q + 2) * 65], 32.0f * s[(4 * q + 3) * 65], x, true); w[q] = x; }
            *(GAS v4u*)((unsigned char*)WT + (size_t)(drow0 + n) * K + k0 + 16 * c) = (v4u){w[0], w[1], w[2], w[3]}; }
    }
    LDS_WAIT(); asm volatile("" ::: "memory");
}
__device__ __forceinline__ void pro0_transposes(Frame& F) {
    LAS float* scr = (LAS float*)(F.lds + F.wave * 16640);
    const int gw = F.bx * NWAVES + F.wave, NGW = F.G * NWAVES;
    constexpr int R0 = 128 * 512, R1 = 128 * 256, R2 = 2 * 384, R3 = 512, R4 = 768, R5 = 4 * 256, NITEMS = R0 + R1 + R2 + R3 + R4 + R5;
    for (int it = gw; it < NITEMS; it += NGW) {
        int r = it;
        if (r < R0) { const int mi = r >> 9, q = r & 511, kb = q >> 5, nb = q & 31, n0 = nb * 64;
            const int d0 = n0 < 1024 ? 256 * (n0 >> 7) + (n0 & 127) : 256 * ((n0 - 1024) >> 7) + 128 + (n0 & 127);
            transpose_item<true>(PIN(F, I_EW1) + (size_t)mi * 1024 * 2048, 2048, F.ws + WS_WE1 + (size_t)mi * 2048 * 1024, kb * 64, n0, d0, scr, F.lane); continue; } r -= R0;
        if (r < R1) { const int mi = r >> 8, q = r & 255, kb = q >> 4, nb = q & 15;
            transpose_item<true>(PIN(F, I_EW2) + (size_t)mi * 1024 * 1024, 1024, F.ws + WS_WE2 + (size_t)mi * 1024 * 1024, kb * 64, nb * 64, nb * 64, scr, F.lane); continue; } r -= R1;
        if (r < R2) { const int mi = r / 384, q = r % 384, kb = q / 24, nb = q % 24;
            transpose_item<false>(PIN(F, I_AWIN) + (size_t)mi * 1024 * 1536, 1536, F.ws + WS_WATT + (size_t)mi * 1536 * 1024 * 2, kb * 64, nb * 64, nb * 64, scr, F.lane); continue; } r -= R2;
        if (r < R3) { const int kb = r >> 5, nb = r & 31;
            transpose_item<false>(PIN(F, I_GWIN), 2048, F.ws + WS_WGM, kb * 64, nb * 64, nb * 64, scr, F.lane); continue; } r -= R3;
        if (r < R4) { const int kb = r / 48, nb = r % 48;
            transpose_item<false>(PIN(F, I_HWIN), 3072, F.ws + WS_WHY, kb * 64, nb * 64, nb * 64, scr, F.lane); continue; } r -= R4;
        { const int mi = r >> 8, q = r & 255, kb = q >> 4, nb = q & 15;
            transpose_item<false>(PIN(F, I_WOUT) + (size_t)mi * 1024 * 1024, 1024, F.ws + WS_WOUT + (size_t)mi * 1024 * 1024 * 2, kb * 64, nb * 64, nb * 64, scr, F.lane); }
    }
}
__device__ __forceinline__ void pro0_mod(Frame& F) {
    LAS float* sl = (LAS float*)F.lds;
    LAS float* red = (LAS float*)(F.lds + 65536);
    __syncthreads();
    for (int i = F.tid; i < 9 * 1024; i += NTHREADS) { const int r = i >> 10, k = i & 1023; const float v = r < 8 ? PIN(F, I_C)[r * 1024 + k] : PIN(F, I_CCTX)[k]; sl[i] = v / (1.0f + __expf(-v)); }
    __syncthreads();
    float* MOD = (float*)(F.ws + WS_MOD);
    for (int item = F.bx; item < NLAYER * 96; item += F.G) {
        const int l = item / 96, n0 = (item % 96) * 64;
        const float* W = PIN(F, I_ADAW) + (size_t)l * 1024 * 6144 + n0 + F.lane;
        float acc[9];
#pragma unroll
        for (int r = 0; r < 9; ++r) acc[r] = 0.f;
        const int kb = F.wave * 128;
#pragma unroll 4
        for (int k = 0; k < 128; ++k) { const float wv = W[(size_t)(kb + k) * 6144];
#pragma unroll
            for (int r = 0; r < 9; ++r) acc[r] += sl[r * 1024 + kb + k] * wv; }
#pragma unroll
        for (int r = 0; r < 9; ++r) red[(F.wave * 9 + r) * 64 + F.lane] = acc[r];
        __syncthreads();
        for (int i = F.tid; i < 9 * 64; i += NTHREADS) { const int r = i >> 6, n = i & 63; float s = 0.f;
#pragma unroll
            for (int w = 0; w < 8; ++w) s += red[(w * 9 + r) * 64 + n];
            MOD[((size_t)l * 9 + r) * 6144 + n0 + n] = s + PIN(F, I_ADAB)[l * 6144 + n0 + n]; }
        __syncthreads();
    }
}
__device__ __forceinline__ void pro0_filter_mlp(Frame& F) {
    const int j = F.lane, gw = F.bx * NWAVES + F.wave, NGW = F.G * NWAVES;
    LAS float* W1 = (LAS float*)F.lds; LAS float* W2 = W1 + FEMB * FH; LAS float* W3 = W2 + FH * FH;
    __syncthreads();
    for (int i = F.tid; i < FEMB * FH; i += NTHREADS) W1[i] = PIN(F, I_FW1)[i];
    for (int i = F.tid; i < FH * FH; i += NTHREADS) { W2[i] = PIN(F, I_FW2)[i]; W3[i] = PIN(F, I_FW3)[i]; }
    __syncthreads();
    const float b1 = PIN(F, I_FB1)[j], b2 = PIN(F, I_FB2)[j], b3 = PIN(F, I_FB3)[j], fr = PIN(F, I_FREQ)[j];
    for (int it = gw; it < SEQ + CL; it += NGW) {
        const bool lat = it < SEQ; const int t = lat ? it : it - SEQ; const float L = lat ? (float)SEQ : (float)CL;
        const float tl = (float)t / (L - 1.0f), w = (6.283185307179586f * (float)t) / L;
        float z;
        { const int band = (j - 1) & 15; const float f = 1e-4f + (float)band * ((15.0f - 1e-4f) / 15.0f); const float a = f * w;
          z = (j == 0) ? tl : (j <= 16 ? cosf(a) : -sinf(a)); }
        float s = b1;
#pragma unroll
        for (int i = 0; i < FEMB; ++i) s += __shfl(z, i) * W1[i * FH + j];
        const float a1 = sinf(fr * s);
        s = b2;
#pragma unroll 16
        for (int i = 0; i < FH; ++i) s += __shfl(a1, i) * W2[i * FH + j];
        const float a2 = sinf(fr * s);
        s = b3;
#pragma unroll 16
        for (int i = 0; i < FH; ++i) s += __shfl(a2, i) * W3[i * FH + j];
        const float a3 = sinf(fr * s);
        float* dst = lat ? (float*)(F.ws + WS_A3) + (size_t)t * FH : (float*)(F.ws + WS_A3C) + (size_t)t * FH;
        dst[j] = a3;
    }
    __syncthreads();
}

__device__ __forceinline__ f32x2 cmul(f32x2 a, f32x2 b) { return (f32x2){a.x * b.x - a.y * b.y, a.x * b.y + a.y * b.x}; }
__device__ __forceinline__ f32x2 cconj(f32x2 a) { return (f32x2){a.x, -a.y}; }
__device__ __forceinline__ void fft16k_dif(LAS f32x2* z, int tid) {
#pragma unroll 1
    for (int lq = 12; lq >= 0; lq -= 2) {
        const int q = 1 << lq; const float inv_lb = 1.0f / (float)(4 * q);
#pragma unroll 2
        for (int bf = tid; bf < 4096; bf += NTHREADS) {
            const int j = bf & (q - 1), base = ((bf >> lq) << (lq + 2)) + j;
            const f32x2 x0 = z[base], x1 = z[base + q], x2 = z[base + 2 * q], x3 = z[base + 3 * q];
            const f32x2 t0 = x0 + x2, t1 = x0 - x2, t2 = x1 + x3, d = x1 - x3, t3 = (f32x2){d.y, -d.x};
            const f32x2 y0 = t0 + t2, y2 = t0 - t2, y1 = t1 + t3, y3 = t1 - t3;
            const float fr = (float)j * inv_lb;
            const f32x2 w1 = (f32x2){__builtin_amdgcn_cosf(fr), -__builtin_amdgcn_sinf(fr)}, w2 = cmul(w1, w1), w3 = cmul(w1, w2);
            z[base] = y0; z[base + q] = cmul(y2, w2); z[base + 2 * q] = cmul(y1, w1); z[base + 3 * q] = cmul(y3, w3);
        }
        __syncthreads();
    }
}
__device__ __forceinline__ void fft16k_dit_inv(LAS f32x2* z, int tid) {
#pragma unroll 1
    for (int lq = 0; lq <= 12; lq += 2) {
        const int q = 1 << lq; const float inv_lb = 1.0f / (float)(4 * q);
#pragma unroll 2
        for (int bf = tid; bf < 4096; bf += NTHREADS) {
            const int j = bf & (q - 1), base = ((bf >> lq) << (lq + 2)) + j;
            const float fr = (float)j * inv_lb;
            const f32x2 w1 = (f32x2){__builtin_amdgcn_cosf(fr), __builtin_amdgcn_sinf(fr)}, w2 = cmul(w1, w1), w3 = cmul(w1, w2);
            const f32x2 A0 = z[base], A1 = cmul(z[base + q], w2), A2 = cmul(z[base + 2 * q], w1), A3 = cmul(z[base + 3 * q], w3);
            const f32x2 u0 = A0 + A1, u1 = A0 - A1, u2 = A2 + A3, u3 = A2 - A3, iu3 = (f32x2){-u3.y, u3.x};
            z[base] = u0 + u2; z[base + q] = u1 + iu3; z[base + 2 * q] = u0 - u2; z[base + 3 * q] = u1 - iu3;
        }
        __syncthreads();
    }
}
__device__ __forceinline__ int rev14(int p) { return (int)(__brev((unsigned)p) >> 18); }
__device__ __forceinline__ float hy_delta(int c) { const float mn = -3.0701134573253945f, mx = -15.350567286626973f; return fabsf(mn + (mx - mn) * ((float)c / 1023.0f)); }

__device__ __forceinline__ void pro1_filters(Frame& F) {
    { const int gw = F.bx * NWAVES + F.wave;
      if (gw < NLAYER * 9) { const int l = gw / 9, e = F.lane & 31, hf = F.lane >> 5; const float* sh = (const float*)(F.ws + WS_MOD) + (size_t)gw * 6144 + 3 * 1024; const float* rw = PIN(F, I_RW) + (size_t)l * D * NE;
          float acc = 0.f; for (int k = hf * 512; k < hf * 512 + 512; ++k) acc += sh[k] * rw[(size_t)k * NE + e];
          acc += __shfl_xor(acc, 32); if (F.lane < 32) ((float*)(F.ws + WS_RC))[gw * NE + e] = acc + PIN(F, I_RB)[l * NE + e]; } }
    LAS f32x2* z = (LAS f32x2*)F.lds;
    LAS float* wl = (LAS float*)(F.lds + AUX_OFF);
    const float* a3 = (const float*)(F.ws + WS_A3); const float* a3c = (const float*)(F.ws + WS_A3C);
    f32x2* KF = (f32x2*)(F.ws + WS_KF); float* FCT = (float*)(F.ws + WS_FCT);
    for (int u = F.bx; u < 512; u += F.G) {
        const int ca = 2 * u, cb = 2 * u + 1;
        __syncthreads();
        if (F.tid < 256) { const int which = F.tid >> 6, m = F.tid & 63; const int col = (which & 1 ? cb : ca) + (which >> 1) * 1024; wl[which * 64 + m] = PIN(F, I_FW4)[m * 2048 + col]; }
        if (F.tid < 4) { const int col = (F.tid & 1 ? cb : ca) + (F.tid >> 1) * 1024; wl[256 + F.tid] = PIN(F, I_FB4)[col]; }
        __syncthreads();
        const float da = hy_delta(ca), db = hy_delta(cb);
        for (int t = F.tid; t < SEQ; t += NTHREADS) {
            const f32x4* ar = (const f32x4*)(a3 + (size_t)t * FH); float s0 = wl[256], s1 = wl[257], s2 = wl[258], s3 = wl[259];
#pragma unroll 4
            for (int m4 = 0; m4 < 16; ++m4) { const f32x4 a = ar[m4];
#pragma unroll
                for (int i = 0; i < 4; ++i) { const int m = m4 * 4 + i; s0 += a[i] * wl[m]; s1 += a[i] * wl[64 + m]; s2 += a[i] * wl[128 + m]; s3 += a[i] * wl[192 + m]; } }
            const float tl = (float)t / (float)(SEQ - 1); const float wa = __expf(-tl * da), wb = __expf(-tl * db);
            z[t] = (f32x2){s0 * wa, s1 * wb};
            if (t == 0) z[SEQ] = (f32x2){0.f, 0.f}; else z[NFFT - t] = (f32x2){s2 * wa, s3 * wb};
        }
        for (int i = F.tid; i < 511; i += NTHREADS) {
            const int d = i - 255, t = d < 0 ? -d : d; const int o = d < 0 ? 2 : 0;
            const float* ar = a3c + (size_t)t * FH; float sa = wl[256 + o], sb = wl[257 + o];
            for (int m = 0; m < FH; ++m) { const float a = ar[m]; sa += a * wl[o * 64 + m]; sb += a * wl[(o + 1) * 64 + m]; }
            const float tl = (float)t / (float)(CL - 1);
            FCT[(size_t)ca * 512 + d + 256] = sa * __expf(-tl * da); FCT[(size_t)cb * 512 + d + 256] = sb * __expf(-tl * db);
        }
        __syncthreads();
        fft16k_dif(z, F.tid);
        for (int p = F.tid; p < NFFT; p += NTHREADS) {
            const int k = rev14(p), p2 = rev14((NFFT - k) & (NFFT - 1));
            if (p <= p2) { const f32x2 a = z[p], b = z[p2];
                const f32x2 Ka = (f32x2){0.5f * (a.x + b.x), 0.5f * (a.y - b.y)};
                const f32x2 Kb = (f32x2){0.5f * (a.y + b.y), -0.5f * (a.x - b.x)};
                KF[(size_t)ca * NFFT + p] = Ka; KF[(size_t)cb * NFFT + p] = Kb; KF[(size_t)ca * NFFT + p2] = cconj(Ka); KF[(size_t)cb * NFFT + p2] = cconj(Kb); }
        }
    }
    __syncthreads();
}

__device__ __forceinline__ void hyena_conv_phase(Frame& F) {
    LAS f32x2* z = (LAS f32x2*)F.lds;
    LAS float* aux = (LAS float*)(F.lds + AUX_OFF);
    const float* VT = (const float*)(F.ws + WS_VT); const float* VTC = (const float*)(F.ws + WS_VTC); float* CT = (float*)(F.ws + WS_CT); float* CTC = (float*)(F.ws + WS_CTC);
    const f32x2* KF = (const f32x2*)(F.ws + WS_KF); const float* FCT = (const float*)(F.ws + WS_FCT);
    for (int u = F.bx; u < NB * 512; u += F.G) {
        const int b = u >> 9, cp = u & 511, ca = 2 * cp, cb = ca + 1;
        const float* va = VT + ((size_t)b * 1024 + ca) * SEQ; const float* vb = va + SEQ; float* oa = CT + ((size_t)b * 1024 + ca) * SEQ; float* ob = oa + SEQ;
        __syncthreads();
        for (int n = F.tid; n < SEQ; n += NTHREADS) { z[n] = (f32x2){va[n], vb[n]}; z[SEQ + n] = (f32x2){0.f, 0.f}; }
        { const int h = F.tid >> 8, t = F.tid & 255; const float* vc = VTC + ((size_t)b * 1024 + ca + h) * CL;
          aux[h * 256 + t] = vc[t]; aux[512 + h * 512 + t] = FCT[(size_t)(ca + h) * 512 + t]; aux[512 + h * 512 + 256 + t] = FCT[(size_t)(ca + h) * 512 + 256 + t];
          __syncthreads();
          float y = 0.f;
#pragma unroll 8
          for (int s = 0; s < CL; ++s) y += aux[h * 256 + s] * aux[512 + h * 512 + (t - s) + 256];
          CTC[((size_t)b * 1024 + ca + h) * CL + t] = y; }
        fft16k_dif(z, F.tid);
        const f32x2* Ka = KF + (size_t)ca * NFFT; const f32x2* Kb = KF + (size_t)cb * NFFT;
        for (int p = F.tid; p < NFFT; p += NTHREADS) {
            const int k = rev14(p), p2 = rev14((NFFT - k) & (NFFT - 1));
            if (p <= p2) { const f32x2 a = z[p], b2 = z[p2];
                const f32x2 Va = (f32x2){0.5f * (a.x + b2.x), 0.5f * (a.y - b2.y)}, Vb = (f32x2){0.5f * (a.y + b2.y), -0.5f * (a.x - b2.x)};
                const f32x2 ya = cmul(Va, Ka[p]), yb = cmul(Vb, Kb[p]);
                z[p] = (f32x2){ya.x - yb.y, ya.y + yb.x};
                z[p2] = (f32x2){ya.x + yb.y, -ya.y + yb.x}; }
        }
        __syncthreads();
        fft16k_dit_inv(z, F.tid);
        const float sc = 1.0f / (float)NFFT;
        for (int n = F.tid; n < SEQ; n += NTHREADS) { const f32x2 w = z[n]; oa[n] = w.x * sc; ob[n] = w.y * sc; }
    }
    __syncthreads();
}
constexpr int MW_CUMBLK = 16, MW_CNT = 64, MW_SELE = 128, MW_SELV = 256, MW_LRANK = 384, MW_LBASE = 512;
__device__ __forceinline__ void moe_tables(Frame& F, int layer) {
    __syncthreads();
    if (F.tid < NE) F.MISC[MW_CNT + F.tid] = __hip_atomic_load(F.ctl + CW_CNT + layer * NE + F.tid, RLX_AGENT);
    __syncthreads();
    if (F.tid == 0) { unsigned c = 0; for (int e = 0; e < NE; ++e) { F.MISC[MW_CUMBLK + e] = c; c += (F.MISC[MW_CNT + e] + 255u) >> 8; } F.MISC[MW_CUMBLK + NE] = c; }
    __syncthreads();
}

template <int MODE> __device__ __forceinline__ void rowpass(Frame& F, int layer, bool real = true) {
    const bool combine = (MODE == 0 && layer > 0) || MODE == 2;
    const int nrows = MODE == 2 ? ML : MT;
    const int cl = MODE == 2 ? NLAYER - 1 : layer - 1;
    const bool from_input = (MODE == 0 && layer == 0);
    const float* XLs = from_input ? PIN(F, I_X) : F.out; const float* XCs = from_input ? PIN(F, I_CTX) : (const float*)(F.ws + WS_XC);
    float* XLd = real ? F.out : (float*)(F.ws + WS_P); float* XCd = real ? (float*)(F.ws + WS_XC) : (float*)(F.ws + WS_P) + (size_t)ML * D;
    const float* MOD = (const float*)(F.ws + WS_MOD);
    bf16* H = (bf16*)(F.ws + WS_H); const bf16* YM = (const bf16*)(F.ws + WS_YM);
    const int* TE = (const int*)(F.ws + WS_TE); const int* TR = (const int*)(F.ws + WS_TR); const float* TG = (const float*)(F.ws + WS_TG);
    const float* gnorm = MODE == 0 ? PIN(F, I_N1G) + layer * D : PIN(F, I_FG);
    if (combine) moe_tables(F, cl);
    f32x4 gn[4];
#pragma unroll
    for (int j = 0; j < 4; ++j) gn[j] = ((const f32x4*)gnorm)[F.lane + 64 * j];
    const int ntiles = nrows / 32;
    for (int tile = F.bx; tile < ntiles; tile += F.G) {
        const int rbase = tile * 32 + F.wave * 4; const bool lat = rbase < ML; const int bidx = lat ? (rbase >> 13) : 8;
        const float* g2 = MOD + ((size_t)(combine ? cl : 0) * 9 + bidx) * 6144 + 5 * 1024;
        const float* mb = MOD + ((size_t)layer * 9 + bidx) * 6144;
#pragma unroll 1
        for (int pr = 0; pr < 2; ++pr) {
            size_t xo[2]; f32x4 v[2][4]; int rowid[2][4]; float gk[2][4];
#pragma unroll
            for (int u = 0; u < 2; ++u) { const int r = rbase + 2 * pr + u; xo[u] = lat ? (size_t)r * D : (size_t)(r - ML) * D;
                if (combine) { const i32x4 te = *(const i32x4*)(TE + (size_t)r * 4), tr = *(const i32x4*)(TR + (size_t)r * 4); const f32x4 tg = *(const f32x4*)(TG + (size_t)r * 4);
#pragma unroll
                    for (int k = 0; k < 4; ++k) { rowid[u][k] = 256 * (int)F.MISC[MW_CUMBLK + te[k]] + tr[k]; gk[u][k] = tg[k]; } }
                const f32x4* xs = (const f32x4*)((lat ? XLs : XCs) + xo[u]);
#pragma unroll
                for (int j = 0; j < 4; ++j) v[u][j] = xs[F.lane + 64 * j]; }
            if (combine) {
                v2u w[2][4][4];
#pragma unroll
                for (int u = 0; u < 2; ++u)
#pragma unroll
                    for (int k = 0; k < 4; ++k) { const v2u* yr = (const v2u*)(YM + (size_t)rowid[u][k] * D);
#pragma unroll
                        for (int j = 0; j < 4; ++j) w[u][k][j] = yr[F.lane + 64 * j]; }
#pragma unroll
                for (int u = 0; u < 2; ++u) {
#pragma unroll
                    for (int j = 0; j < 4; ++j) { f32x4 a = (f32x4){0.f, 0.f, 0.f, 0.f};
#pragma unroll
                        for (int k = 0; k < 4; ++k) a += gk[u][k] * (f32x4){bflo(w[u][k][j].x), bfhi(w[u][k][j].x), bflo(w[u][k][j].y), bfhi(w[u][k][j].y)};
                        v[u][j] += ((const f32x4*)g2)[F.lane + 64 * j] * a; }
                    if (MODE == 0) { f32x4* xd = (f32x4*)((lat ? XLd : XCd) + xo[u]);
#pragma unroll
                        for (int j = 0; j < 4; ++j) xd[F.lane + 64 * j] = v[u][j]; } }
            }
#pragma unroll
            for (int u = 0; u < 2; ++u) { const int r = rbase + 2 * pr + u;
                float ss = 0.f;
#pragma unroll
                for (int j = 0; j < 4; ++j) ss += (v[u][j].x * v[u][j].x + v[u][j].y * v[u][j].y) + (v[u][j].z * v[u][j].z + v[u][j].w * v[u][j].w);
                const float rstd = 1.0f / sqrtf(wave_sum(ss) * (1.0f / D) + EPS);
                if (MODE == 2) { f32x4* od = (f32x4*)(XLd + xo[u]);
#pragma unroll
                    for (int j = 0; j < 4; ++j) od[F.lane + 64 * j] = v[u][j] * rstd * gn[j]; }
                else { v2u* hd = (v2u*)(H + (size_t)r * D);
#pragma unroll
                    for (int j = 0; j < 4; ++j) { const f32x4 sh = ((const f32x4*)mb)[F.lane + 64 * j], sc = ((const f32x4*)(mb + 1024))[F.lane + 64 * j]; const f32x4 hv = v[u][j] * rstd * gn[j] * (sc + 1.0f) + sh;
                        v2u o; o.x = cvt_pk_bf16(hv.x, hv.y); o.y = cvt_pk_bf16(hv.z, hv.w); hd[F.lane + 64 * j] = o; } }
            }
        }
    }
}

typedef float f32x16r __attribute__((ext_vector_type(16)));
__device__ __forceinline__ void router_phase(Frame& F, int layer, bool real = true) {
    const bool last = layer == NLAYER - 1;
    const int ntiles = (last ? ML : MT) / 32;
    LAS float* PART = (LAS float*)F.lds;
    LAS float* SSQ = PART + 8 * 32 * 33;
    LAS float* LG = SSQ + 8 * 32;
    LAS float* RSTD = LG + 32 * 33;
    LAS unsigned* CW = (LAS unsigned*)(RSTD + 32);
    LAS unsigned* RUN = CW + 64;
    LAS float* AV = (LAS float*)(RUN + 32);
    LAS float* SHV = AV + 1024;
    const float* XL = F.out; const float* XC = (const float*)(F.ws + WS_XC);
    const float* MOD = (const float*)(F.ws + WS_MOD); const float* RC = (const float*)(F.ws + WS_RC);
    unsigned char* H8 = (unsigned char*)(F.ws + WS_H8);
    int* TE = (int*)(F.ws + WS_TE); int* TR = (int*)(F.ws + WS_TR); float* TG = (float*)(F.ws + WS_TG); int* ROWTOK = (int*)(F.ws + WS_ROWTOK);
    const float* gn = PIN(F, I_N2G) + layer * D; const float* rw = PIN(F, I_RW) + (size_t)layer * D * NE;
    const int i = F.lane & 31, hf = F.lane >> 5, kb = F.wave * 128 + 64 * hf;
    const int per = 2048 / F.G;
    const int nmine = (2048 % F.G == 0) ? per + ((2048 + F.bx < ntiles) ? 1 : 0) : 0;
#define RT_TILE(n_) ((2048 % F.G == 0) ? ((n_) < per ? F.bx * per + (n_) : 2048 + F.bx) : F.bx + (n_) * F.G)
    const int ncnt = (2048 % F.G == 0) ? nmine : (F.bx < ntiles ? (ntiles - 1 - F.bx) / F.G + 1 : 0);
    __syncthreads();
    if (F.tid < NE) RUN[F.tid] = 0u;
    float bv[64];
    { const float* rwp = rw + (size_t)kb * NE + i;
#pragma unroll
      for (int s = 0; s < 64; ++s) bv[s] = rwp[(size_t)s * NE]; }
    float xs[64];
#define RT_LOADX(tile_) do { const int r_ = (tile_) * 32 + i; const float* xr_ = (r_ < ML ? XL + (size_t)r_ * D : XC + (size_t)(r_ - ML) * D) + kb; \
        _Pragma("unroll") for (int q = 0; q < 16; ++q) { const f32x4 v = ((const f32x4*)xr_)[q]; xs[4 * q] = v.x; xs[4 * q + 1] = v.y; xs[4 * q + 2] = v.z; xs[4 * q + 3] = v.w; } } while (0)
    if (ncnt > 0) RT_LOADX(RT_TILE(0));
    int cur_b = -1;
    for (int n = 0; n < ncnt; ++n) {
        const int tile = RT_TILE(n);
        const int r0 = tile * 32; const bool lat = r0 < ML; const int bidx = lat ? (r0 >> 13) : 8; const int r = r0 + i;
        if (bidx != cur_b) {
            cur_b = bidx; const float* mb = MOD + ((size_t)layer * 9 + bidx) * 6144 + 3 * 1024;
            __syncthreads();
            for (int k = F.tid; k < 1024; k += NTHREADS) { AV[k] = gn[k] * (1.0f + mb[1024 + k]); SHV[k] = mb[k]; }
            __syncthreads();
        }
        float ssq = 0.f;
#pragma unroll
        for (int s = 0; s < 64; ++s) ssq += xs[s] * xs[s];
        ssq += __shfl_xor(ssq, 32);
        if (hf == 0) SSQ[F.wave * 32 + i] = ssq;
#pragma unroll
        for (int q = 0; q < 16; ++q) { const f32x4 a = ((const LAS f32x4*)(AV + kb))[q]; xs[4 * q] *= a.x; xs[4 * q + 1] *= a.y; xs[4 * q + 2] *= a.z; xs[4 * q + 3] *= a.w; }
        f32x16r acc = {};
#pragma unroll
        for (int s = 0; s < 64; ++s) acc = __builtin_amdgcn_mfma_f32_32x32x2f32(xs[s], bv[s], acc, 0, 0, 0);
#pragma unroll
        for (int rg = 0; rg < 16; ++rg) PART[(F.wave * 32 + ((rg & 3) + 8 * (rg >> 2) + 4 * hf)) * 33 + i] = acc[rg];
        __syncthreads();
        { const int tk = F.tid >> 4, e0 = (F.tid & 15) * 2; float q = 0.f, s0 = 0.f, s1 = 0.f;
#pragma unroll
          for (int w = 0; w < 8; ++w) { q += SSQ[w * 32 + tk]; s0 += PART[(w * 32 + tk) * 33 + e0]; s1 += PART[(w * 32 + tk) * 33 + e0 + 1]; }
          const float rstd = 1.0f / sqrtf(q * (1.0f / D) + EPS); const float* rc = RC + ((size_t)layer * 9 + bidx) * NE;
          LG[tk * 33 + e0] = rstd * s0 + rc[e0]; LG[tk * 33 + e0 + 1] = rstd * s1 + rc[e0 + 1]; if ((F.tid & 15) == 0) RSTD[tk] = rstd; }
        __syncthreads();
        { const float rstd = RSTD[i]; unsigned w8[16];
#pragma unroll
          for (int q = 0; q < 16; ++q) { const f32x4 sh = ((const LAS f32x4*)(SHV + kb))[q]; unsigned w = 0;
              w = __builtin_amdgcn_cvt_pk_fp8_f32(xs[4 * q] * rstd + sh.x, xs[4 * q + 1] * rstd + sh.y, w, false);
              w = __builtin_amdgcn_cvt_pk_fp8_f32(xs[4 * q + 2] * rstd + sh.z, xs[4 * q + 3] * rstd + sh.w, w, true); w8[q] = w; }
          v4u* hd = (v4u*)(H8 + (size_t)r * D + kb);
#pragma unroll
          for (int q = 0; q < 4; ++q) hd[q] = (v4u){w8[4 * q], w8[4 * q + 1], w8[4 * q + 2], w8[4 * q + 3]}; }
        if (n + 1 < ncnt) RT_LOADX(RT_TILE(n + 1));
#pragma unroll 1
        for (int rr = 0; rr < 4; ++rr) {
            const int slot = F.wave * 4 + rr, e = i; const float logit = LG[slot * 33 + e]; int rank = 0;
#pragma unroll
            for (int j = 0; j < NE; ++j) { const float o = __shfl(logit, j); rank += (o > logit || (o == logit && j < e)) ? 1 : 0; }
            if (F.lane < 32 && rank < 4) { F.MISC[MW_SELE + slot * 4 + rank] = (unsigned)e; F.MISC[MW_SELV + slot * 4 + rank] = __float_as_uint(logit); }
            LDS_WAIT(); asm volatile("" ::: "memory");
            { const int k = F.lane & 3; const float vk = __uint_as_float(F.MISC[MW_SELV + slot * 4 + k]); const float v0 = __shfl(vk, 0);
              float ex = __expf(vk - v0); float sm = ex; sm += __shfl_xor(sm, 1); sm += __shfl_xor(sm, 2);
              if (F.lane < 4) { const size_t tok = (size_t)r0 + slot; TG[tok * 4 + k] = ex / sm; TE[tok * 4 + k] = (int)F.MISC[MW_SELE + slot * 4 + k]; } }
        }
        __syncthreads();
        int my = 0, lr = 0;
        if (F.wave < 2) { my = (int)F.MISC[MW_SELE + F.tid]; unsigned cm = 0;
#pragma unroll
            for (int e = 0; e < NE; ++e) { const unsigned long long m = __ballot(my == e); const unsigned pc = (unsigned)__popcll(m);
                if (my == e) lr = (int)__builtin_amdgcn_mbcnt_hi((unsigned)(m >> 32), __builtin_amdgcn_mbcnt_lo((unsigned)m, 0u)); if (F.lane == e) cm = pc; }
            if (F.lane < NE) CW[F.wave * 32 + F.lane] = cm; }
        __syncthreads();
        if (F.wave < 2) { const int a = F.tid; const int brank = (int)RUN[my] + lr + (F.wave == 1 ? (int)CW[my] : 0); TR[((size_t)r0 + (a >> 2)) * 4 + (a & 3)] = brank; }
        __syncthreads();
        if (F.tid < NE) RUN[F.tid] += CW[F.tid] + CW[32 + F.tid];
    }
    VM_WAIT(); __syncthreads();
    if (F.tid < NE) { const unsigned cnt = RUN[F.tid]; unsigned base = 0;
        if (cnt) base = __hip_atomic_fetch_add(F.ctl + CW_CNT + (real ? layer : NLAYER) * NE + F.tid, cnt, RLX_AGENT);
        F.MISC[MW_LBASE + F.tid] = base; }
    __syncthreads();
    if (real) for (int n = 0; n < ncnt; ++n) { const int r0 = RT_TILE(n) * 32;
        if (F.tid < 128) { const size_t idx = ((size_t)r0 + (F.tid >> 2)) * 4 + (F.tid & 3); const int e = TE[idx]; const int rank = TR[idx] + (int)F.MISC[MW_LBASE + e]; TR[idx] = rank; ROWTOK[(size_t)e * MT + rank] = r0 + (F.tid >> 2); } }
    __syncthreads();
#undef RT_LOADX
#undef RT_TILE
}

__device__ __forceinline__ void normrope16(float (&x)[16], const float* gain, bool lat, int prow, int pcol, const LAS f32x2* T, int L) {
    float ss = 0.f;
#pragma unroll
    for (int i = 0; i < 16; ++i) ss += x[i] * x[i];
    ss += __shfl_xor(ss, 1); ss += __shfl_xor(ss, 2); ss += __shfl_xor(ss, 4);
    const float rstd = 1.0f / sqrtf(ss * (1.0f / 128.0f) + EPS);
    const int o = (L & 7) * 16;
#pragma unroll
    for (int i = 0; i < 16; ++i) x[i] = x[i] * rstd * gain[o + i];
    float p[16];
#pragma unroll
    for (int i = 0; i < 16; ++i) p[i] = __shfl_xor(x[i], 2);
    if (lat) {
        const int pos = (L & 4) ? pcol : prow; const float sgn = (L & 2) ? 1.0f : -1.0f; const LAS f32x2* t = T + pos * 32 + (L & 1) * 16;
#pragma unroll
        for (int i = 0; i < 16; ++i) { const f32x2 cs = t[i]; x[i] = x[i] * cs.x + sgn * p[i] * cs.y; }
    }
}
__device__ __forceinline__ void qkprep_phase(Frame& F, int j) {
    LAS f32x2* T = (LAS f32x2*)F.lds;
    __syncthreads();
    for (int i = F.tid; i < 128 * 32; i += NTHREADS) { const int pos = i >> 5, f = i & 31; const float inv = powf(10000.0f, -(float)f / 32.0f); const float ang = (float)pos * inv; float s, c; sincosf(ang, &s, &c); T[i] = (f32x2){c, s}; }
    __syncthreads();
    const bf16* P = (const bf16*)(F.ws + WS_P); bf16* QB = (bf16*)(F.ws + WS_QB); bf16* KVB = (bf16*)(F.ws + WS_KVB);
    const float* qg = PIN(F, I_AQG) + j * 128; const float* kg = PIN(F, I_AKG) + j * 128;
    const int gw = F.bx * NWAVES + F.wave, NGW = F.G * NWAVES, L = F.lane;
    for (int r = gw; r < MT; r += NGW) {
        const bool lat = r < ML; const int b = lat ? (r >> 13) : ((r - ML) >> 8); const int s = lat ? (r & (SEQ - 1)) : ((r - ML) & (CL - 1));
        const int prow = s >> 6, pcol = s & 63; const size_t kvrow = (size_t)b * SKV + (lat ? s : SEQ + s);
        const bf16* pr = P + (size_t)r * 1536;
        { const v4u a = *(const v4u*)(pr + 16 * L), c = *(const v4u*)(pr + 16 * L + 8); float x[16];
          x[0] = bflo(a.x); x[1] = bfhi(a.x); x[2] = bflo(a.y); x[3] = bfhi(a.y); x[4] = bflo(a.z); x[5] = bfhi(a.z); x[6] = bflo(a.w); x[7] = bfhi(a.w);
          x[8] = bflo(c.x); x[9] = bfhi(c.x); x[10] = bflo(c.y); x[11] = bfhi(c.y); x[12] = bflo(c.z); x[13] = bfhi(c.z); x[14] = bflo(c.w); x[15] = bfhi(c.w);
          normrope16(x, qg, lat, prow, pcol, T, L);
          v4u o0, o1; o0.x = cvt_pk_bf16(x[0], x[1]); o0.y = cvt_pk_bf16(x[2], x[3]); o0.z = cvt_pk_bf16(x[4], x[5]); o0.w = cvt_pk_bf16(x[6], x[7]);
          o1.x = cvt_pk_bf16(x[8], x[9]); o1.y = cvt_pk_bf16(x[10], x[11]); o1.z = cvt_pk_bf16(x[12], x[13]); o1.w = cvt_pk_bf16(x[14], x[15]);
          *(v4u*)(QB + (size_t)r * D + 16 * L) = o0; *(v4u*)(QB + (size_t)r * D + 16 * L + 8) = o1; }
        { const int Lk = L & 15; const v4u a = *(const v4u*)(pr + 1024 + 16 * Lk), c = *(const v4u*)(pr + 1024 + 16 * Lk + 8); float x[16];
          x[0] = bflo(a.x); x[1] = bfhi(a.x); x[2] = bflo(a.y); x[3] = bfhi(a.y); x[4] = bflo(a.z); x[5] = bfhi(a.z); x[6] = bflo(a.w); x[7] = bfhi(a.w);
          x[8] = bflo(c.x); x[9] = bfhi(c.x); x[10] = bflo(c.y); x[11] = bfhi(c.y); x[12] = bflo(c.z); x[13] = bfhi(c.z); x[14] = bflo(c.w); x[15] = bfhi(c.w);
          normrope16(x, kg, lat, prow, pcol, T, Lk);
          if (L < 16) { v4u o0, o1; o0.x = cvt_pk_bf16(x[0], x[1]); o0.y = cvt_pk_bf16(x[2], x[3]); o0.z = cvt_pk_bf16(x[4], x[5]); o0.w = cvt_pk_bf16(x[6], x[7]);
            o1.x = cvt_pk_bf16(x[8], x[9]); o1.y = cvt_pk_bf16(x[10], x[11]); o1.z = cvt_pk_bf16(x[12], x[13]); o1.w = cvt_pk_bf16(x[14], x[15]);
            *(v4u*)(KVB + kvrow * 512 + 16 * L) = o0; *(v4u*)(KVB + kvrow * 512 + 16 * L + 8) = o1; }
          else if (L < 48) { const int q = L - 16; *(v4u*)(KVB + kvrow * 512 + 256 + 8 * q) = *(const v4u*)(pr + 1280 + 8 * q); } }
    }
}
__device__ __forceinline__ void attention_phase(Frame& F, char* lds_generic, bool ctx_queries) {
    const bf16* QB = (const bf16*)(F.ws + WS_QB); const bf16* KVB = (const bf16*)(F.ws + WS_KVB); bf16* Y = (bf16*)(F.ws + WS_Y);
    const int nunits = 2048 + (ctx_queries ? 64 : 0);
    for (int u = F.bx; u < nunits; u += F.G) {
        if (u < 2048) { const int b = u >> 8, w = u & 255, h = w & 7, qb = w >> 3; const size_t qo = ((size_t)b * SEQ + (size_t)qb * 256) * D + h * 128; const bf16* kh = KVB + (size_t)b * SKV * 512 + (h >> 2) * 128;
            att::attn_dense_body(QB + qo, kh, kh + 256, Y + qo, SKV, lds_generic); }
        else { const int w = u - 2048, b = w >> 3, h = w & 7; const size_t qo = ((size_t)ML + (size_t)b * CL) * D + h * 128; const bf16* kh = KVB + ((size_t)b * SKV + SEQ) * 512 + (h >> 2) * 128;
            att::attn_dense_body(QB + qo, kh, kh + 256, Y + qo, CL, lds_generic); }
    }
}

__device__ __forceinline__ void gmlp_mix_phase(Frame& F) {
    constexpr int LDA = 136;
    LAS bf16* As = (LAS bf16*)F.lds;
    LAS bf16* Vt = (LAS bf16*)(F.lds + 128 * LDA * 2);
    LAS float* rs = (LAS float*)(F.lds + 2 * 128 * LDA * 2);
    const bf16* P = (const bf16*)(F.ws + WS_P); bf16* Y = (bf16*)(F.ws + WS_Y); const float* SS = (const float*)(F.ws + WS_SS);
    const float* ws = PIN(F, I_GWS); const float* bs = PIN(F, I_GBS); const float* vg = PIN(F, I_GVG);
    const int r32 = F.lane & 31, hi = F.lane >> 5;
    for (int u = F.bx; u < (MT / 128) * 8; u += F.G) {
        const int chunk = u >> 3, g = u & 7; const size_t row0 = (size_t)chunk * 128;
        __syncthreads();
        if (F.tid < 128) { const f32x4* sp = (const f32x4*)(SS + (row0 + F.tid) * 16); const f32x4 a = sp[0], b = sp[1], c = sp[2], d = sp[3];
            const float s = ((a.x + a.y) + (a.z + a.w)) + ((b.x + b.y) + (b.z + b.w)) + ((c.x + c.y) + (c.z + c.w)) + ((d.x + d.y) + (d.z + d.w)); rs[F.tid] = 1.0f / sqrtf(s * (1.0f / 1024.0f) + EPS); }
        __syncthreads();
        for (int i = F.tid; i < 128 * 32; i += NTHREADS) { const int p = i >> 5, q4 = (i & 31) * 4; const f32x4 w = *(const f32x4*)(ws + ((size_t)g * 128 + p) * 128 + q4);
            v2u o; o.x = pk2(w.x * rs[q4], w.y * rs[q4 + 1]); o.y = pk2(w.z * rs[q4 + 2], w.w * rs[q4 + 3]); *(LAS v2u*)(As + p * LDA + q4) = o; }
        for (int i = F.tid; i < 128 * 16; i += NTHREADS) { const int q = i >> 4, c8 = (i & 15) * 8; const v4u w = *(const v4u*)(P + (row0 + q) * 2048 + 1024 + g * 128 + c8);
            Vt[(c8 + 0) * LDA + q] = (bf16)(w.x & 0xffff); Vt[(c8 + 1) * LDA + q] = (bf16)(w.x >> 16); Vt[(c8 + 2) * LDA + q] = (bf16)(w.y & 0xffff); Vt[(c8 + 3) * LDA + q] = (bf16)(w.y >> 16);
            Vt[(c8 + 4) * LDA + q] = (bf16)(w.z & 0xffff); Vt[(c8 + 5) * LDA + q] = (bf16)(w.z >> 16); Vt[(c8 + 6) * LDA + q] = (bf16)(w.w & 0xffff); Vt[(c8 + 7) * LDA + q] = (bf16)(w.w >> 16); }
        __syncthreads();
        const int p0 = (F.wave >> 1) * 32, cbase = (F.wave & 1) * 64;
        f32x16 acc0 = {}, acc1 = {};
#pragma unroll
        for (int ks = 0; ks < 8; ++ks) { const int k0 = ks * 16 + hi * 8;
            const bf16x8 a = *(const LAS bf16x8*)(As + (p0 + r32) * LDA + k0);
            const bf16x8 b0 = *(const LAS bf16x8*)(Vt + (cbase + r32) * LDA + k0), b1 = *(const LAS bf16x8*)(Vt + (cbase + 32 + r32) * LDA + k0);
            acc0 = __builtin_amdgcn_mfma_f32_32x32x16_bf16(a, b0, acc0, 0, 0, 0); acc1 = __builtin_amdgcn_mfma_f32_32x32x16_bf16(a, b1, acc1, 0, 0, 0); }
#pragma unroll
        for (int t = 0; t < 2; ++t) { const int c = g * 128 + cbase + t * 32 + r32; const float gain = vg[c];
#pragma unroll
            for (int reg = 0; reg < 16; ++reg) { const int p = p0 + (reg & 3) + 8 * (reg >> 2) + 4 * hi; const float a = t == 0 ? acc0[reg] : acc1[reg];
                const float uu = bf2f(P[(row0 + p) * 2048 + c]); const float mixed = gain * a + bs[g * 128 + p];
                Y[(row0 + p) * D + c] = (bf16)f2bf(uu * mixed); } }
    }
    __syncthreads();
}

__device__ __forceinline__ void hyena_prep_phase(Frame& F) {
    LAS float* tl = (LAS float*)F.lds;
    const bf16* P = (const bf16*)(F.ws + WS_P); bf16* X0 = (bf16*)(F.ws + WS_X0); bf16* VG = (bf16*)(F.ws + WS_VG);
    float* VT = (float*)(F.ws + WS_VT); float* VTC = (float*)(F.ws + WS_VTC);
    const float* cw = PIN(F, I_HCW); const float* cb = PIN(F, I_HCB);
    const int tt = F.tid >> 3, cg = F.tid & 7;
    for (int u = F.bx; u < (MT / 64) * 16; u += F.G) {
        const int tb = u >> 4, c0 = (u & 15) * 64; const int r0 = tb * 64; const bool lat = r0 < ML;
        const int b = lat ? (r0 >> 13) : ((r0 - ML) >> 8), s0 = lat ? (r0 & (SEQ - 1)) : ((r0 - ML) & (CL - 1)), L = lat ? SEQ : CL;
        const int r = r0 + tt, s = s0 + tt, c = c0 + cg * 8;
        float o[3][8];
#pragma unroll
        for (int seg = 0; seg < 3; ++seg) { const int col = seg * 1024 + c;
            const v4u z0 = {0u, 0u, 0u, 0u};
            const v4u pm = s > 0 ? *(const v4u*)(P + (size_t)(r - 1) * 3072 + col) : z0, pc = *(const v4u*)(P + (size_t)r * 3072 + col), pn = s < L - 1 ? *(const v4u*)(P + (size_t)(r + 1) * 3072 + col) : z0;
            const f32x4 w0a = *(const f32x4*)(cw + col), w0b = *(const f32x4*)(cw + col + 4), w1a = *(const f32x4*)(cw + 3072 + col), w1b = *(const f32x4*)(cw + 3072 + col + 4);
            const f32x4 w2a = *(const f32x4*)(cw + 6144 + col), w2b = *(const f32x4*)(cw + 6144 + col + 4), ba = *(const f32x4*)(cb + col), bb = *(const f32x4*)(cb + col + 4);
            const unsigned pmw[4] = {pm.x, pm.y, pm.z, pm.w}, pcw[4] = {pc.x, pc.y, pc.z, pc.w}, pnw[4] = {pn.x, pn.y, pn.z, pn.w};
#pragma unroll
            for (int i = 0; i < 8; ++i) { const float xm = (i & 1) ? bfhi(pmw[i >> 1]) : bflo(pmw[i >> 1]), xc = (i & 1) ? bfhi(pcw[i >> 1]) : bflo(pcw[i >> 1]), xn = (i & 1) ? bfhi(pnw[i >> 1]) : bflo(pnw[i >> 1]);
                const float w0 = i < 4 ? w0a[i & 3] : w0b[i & 3], w1 = i < 4 ? w1a[i & 3] : w1b[i & 3], w2 = i < 4 ? w2a[i & 3] : w2b[i & 3], bi = i < 4 ? ba[i & 3] : bb[i & 3];
                o[seg][i] = xm * w0 + xc * w1 + xn * w2 + bi; } }
        float vgv[8];
#pragma unroll
        for (int i = 0; i < 8; ++i) vgv[i] = o[2][i] * o[1][i];
        v4u w; w.x = cvt_pk_bf16(o[0][0], o[0][1]); w.y = cvt_pk_bf16(o[0][2], o[0][3]); w.z = cvt_pk_bf16(o[0][4], o[0][5]); w.w = cvt_pk_bf16(o[0][6], o[0][7]);
        *(v4u*)(X0 + (size_t)r * D + c) = w;
        w.x = cvt_pk_bf16(vgv[0], vgv[1]); w.y = cvt_pk_bf16(vgv[2], vgv[3]); w.z = cvt_pk_bf16(vgv[4], vgv[5]); w.w = cvt_pk_bf16(vgv[6], vgv[7]);
        *(v4u*)(VG + (size_t)r * D + c) = w;
        __syncthreads();
#pragma unroll
        for (int i = 0; i < 8; ++i) tl[(cg * 8 + i) * 65 + tt] = vgv[i];
        __syncthreads();
        { const int cc = F.tid >> 3, ts = (F.tid & 7) * 8; float* dst = lat ? VT + ((size_t)b * 1024 + c0 + cc) * SEQ + s0 + ts : VTC + ((size_t)b * 1024 + c0 + cc) * CL + s0 + ts;
          const LAS float* sp = tl + cc * 65 + ts;
          *(f32x4*)dst = (f32x4){sp[0], sp[1], sp[2], sp[3]}; *(f32x4*)(dst + 4) = (f32x4){sp[4], sp[5], sp[6], sp[7]}; }
    }
    __syncthreads();
}
__device__ __forceinline__ void hyena_post_phase(Frame& F) {
    LAS float* tl = (LAS float*)F.lds;
    const bf16* X0 = (const bf16*)(F.ws + WS_X0); const bf16* VG = (const bf16*)(F.ws + WS_VG); bf16* Y = (bf16*)(F.ws + WS_Y);
    const float* VT = (const float*)(F.ws + WS_CT); const float* VTC = (const float*)(F.ws + WS_CTC); const float* dsk = PIN(F, I_HD);
    const int tt = F.tid >> 3, cg = F.tid & 7;
    for (int u = F.bx; u < (MT / 64) * 16; u += F.G) {
        const int tb = u >> 4, c0 = (u & 15) * 64; const int r0 = tb * 64; const bool lat = r0 < ML;
        const int b = lat ? (r0 >> 13) : ((r0 - ML) >> 8), s0 = lat ? (r0 & (SEQ - 1)) : ((r0 - ML) & (CL - 1));
        __syncthreads();
        { const int cc = F.tid >> 3, ts = (F.tid & 7) * 8; const float* src = lat ? VT + ((size_t)b * 1024 + c0 + cc) * SEQ + s0 + ts : VTC + ((size_t)b * 1024 + c0 + cc) * CL + s0 + ts;
          const f32x4 a = *(const f32x4*)src, bq = *(const f32x4*)(src + 4); LAS float* dp = tl + cc * 65 + ts;
          dp[0] = a.x; dp[1] = a.y; dp[2] = a.z; dp[3] = a.w; dp[4] = bq.x; dp[5] = bq.y; dp[6] = bq.z; dp[7] = bq.w; }
        __syncthreads();
        const int r = r0 + tt, c = c0 + cg * 8;
        const v4u x0 = *(const v4u*)(X0 + (size_t)r * D + c), vv = *(const v4u*)(VG + (size_t)r * D + c);
        const f32x4 da = *(const f32x4*)(dsk + c), db = *(const f32x4*)(dsk + c + 4);
        const unsigned x0w[4] = {x0.x, x0.y, x0.z, x0.w}, vw[4] = {vv.x, vv.y, vv.z, vv.w}; float y[8];
#pragma unroll
        for (int i = 0; i < 8; ++i) { const float xx = (i & 1) ? bfhi(x0w[i >> 1]) : bflo(x0w[i >> 1]), vx = (i & 1) ? bfhi(vw[i >> 1]) : bflo(vw[i >> 1]); const float di = i < 4 ? da[i & 3] : db[i & 3];
            y[i] = (tl[(cg * 8 + i) * 65 + tt] + vx * di) * xx; }
        v4u w; w.x = cvt_pk_bf16(y[0], y[1]); w.y = cvt_pk_bf16(y[2], y[3]); w.z = cvt_pk_bf16(y[4], y[5]); w.w = cvt_pk_bf16(y[6], y[7]);
        *(v4u*)(Y + (size_t)r * D + c) = w;
    }
    __syncthreads();
}
__device__ __forceinline__ bool phase_nonempty(int ph) {
    if (ph < PH_L0 || ph >= PH_FINAL) return true;
    const int layer = (ph - PH_L0) / PH_PER_LAYER, lp = (ph - PH_L0) % PH_PER_LAYER, kind = layer % 3;
    if (lp == LP_MIX2) return kind != 1;
    if (lp == LP_MIX3) return kind == 2;
    return true;
}
__global__ void __launch_bounds__(NTHREADS, 2) mk_fwd(Args args) {
    extern __shared__ __attribute__((aligned(16))) unsigned char lds[];
    Frame F0;
    F0.lds = (LAS unsigned char*)lds; F0.MISC = (volatile LAS unsigned*)(F0.lds + MISC_OFF);
    F0.tid = threadIdx.x; F0.lane = F0.tid & 63; F0.wave = __builtin_amdgcn_readfirstlane(F0.tid >> 6);
    F0.G = gridDim.x; F0.bx = blockIdx.x; F0.out = args.out; F0.ws = args.ws; F0.ctl = (gu32*)(args.ws + WS_CTL);
    for (int u = F0.tid; u < MISC_BYTES / 4; u += NTHREADS) F0.MISC[u] = 0u;
    __syncthreads();
    if (F0.tid < 36) { const unsigned long long p = (unsigned long long)args.in[F0.tid]; F0.MISC[MW_PTRS + 2 * F0.tid] = (unsigned)p; F0.MISC[MW_PTRS + 2 * F0.tid + 1] = (unsigned)(p >> 32); }
    __syncthreads();
    const int lo = args.ph_lo, hi = args.ph_hi;
    const bool multi = (hi - lo) > 1;
    XcdBarrier bar; bar.bar = (unsigned*)(F0.ctl + CW_BAR); bar.x = 0; bar.st = nullptr;
    if (multi) bar = xcd_barrier_post((unsigned*)(F0.ctl + CW_BAR), F0.MISC + 8);
#ifndef PHMASK
#define PHMASK 0xFFFF
#endif
#define EN(b) ((PHMASK >> (b)) & 1)
#ifndef KMASK
#define KMASK 7
#endif
#define KEN(b) ((KMASK >> (b)) & 1)
#define IN(k) (lo <= (k) && (k) < hi)
#define SEAM(k) do { if ((k) + 1 < hi) xcd_barrier(bar); } while (0)
#define PB(id) for (int _rep = 0, _n = ((id) == MK_REPEAT ? MK_NREP : 1); _rep < _n; ++_rep) {
#define PE(id) if (_rep + 1 < _n) xcd_barrier(bar); } SEAM(id);

    if (EN(0) && IN(PH_PRO0)) { PB(PH_PRO0) Frame F = phase_frame(F0); pro0_mod(F); __syncthreads(); pro0_transposes(F); pro0_filter_mlp(F); PE(PH_PRO0) }
    if (EN(1) && IN(PH_PRO1)) { PB(PH_PRO1) Frame F = phase_frame(F0); pro1_filters(F); PE(PH_PRO1) }

#pragma unroll 1
    for (int layer = 0; layer < NLAYER; ++layer) {
        const int kind = layer % 3, jj = layer / 3, pb = PH_L0 + layer * PH_PER_LAYER; const bool last = layer == NLAYER - 1;
        if (EN(2) && IN(pb + LP_NORM1)) { PB(pb + LP_NORM1) Frame F = phase_frame(F0); rowpass<0>(F, layer, _rep + 1 == _n); PE(pb + LP_NORM1) }
        if (EN(3) && IN(pb + LP_INPROJ)) { PB(pb + LP_INPROJ)
            Frame F = phase_frame(F0);
            const int N = kind == 0 ? 1536 : (kind == 1 ? 2048 : 3072);
            const size_t woff = kind == 0 ? WS_WATT + (size_t)jj * 1536 * 1024 * 2 : (kind == 1 ? WS_WGM : WS_WHY);
            pg8::DenseSched S; S.init(F.ws + WS_H, F.ws + woff, MT, N, F.G, F.bx);
            pg8::EpiBf16 E{(bf16*)(F.ws + WS_P), N, (float*)(F.ws + WS_SS), kind == 1 ? 1 : 0};
            pg8::gemm_phase<pg8::EpiBf16, pg8::DenseSched, false>(F.lds, S, E);
            PE(pb + LP_INPROJ)
        }
        if (IN(pb + LP_MIX1)) { PB(pb + LP_MIX1)
            Frame F = phase_frame(F0);
            if (EN(4) && kind == 0) qkprep_phase(F, jj); else if (EN(5) && kind == 1) gmlp_mix_phase(F); else if (EN(6)) hyena_prep_phase(F);
            PE(pb + LP_MIX1)
        }
        if (IN(pb + LP_MIX2) && kind != 1) { PB(pb + LP_MIX2)
            Frame F = phase_frame(F0);
            if (EN(7) && kind == 0) attention_phase(F, (char*)lds, !last); else if (EN(8)) hyena_conv_phase(F);
            PE(pb + LP_MIX2)
        }
        if (EN(9) && IN(pb + LP_MIX3) && kind == 2) { PB(pb + LP_MIX3) Frame F = phase_frame(F0); hyena_post_phase(F); PE(pb + LP_MIX3) }
        if (EN(10) && IN(pb + LP_OUTPROJ)) { PB(pb + LP_OUTPROJ)
            Frame F = phase_frame(F0); const float* modl = (const float*)(F.ws + WS_MOD) + (size_t)layer * 9 * 6144;
            pg8::DenseSched S; S.init(F.ws + WS_Y, F.ws + WS_WOUT + (size_t)layer * 1024 * 1024 * 2, last ? ML : MT, 1024, F.G, F.bx);
            const bool first = layer == 0;
            pg8::EpiResid E{first ? PIN(F, I_X) : F.out, first ? PIN(F, I_CTX) : (const float*)(F.ws + WS_XC), F.out, (float*)(F.ws + WS_XC), modl};
            pg8::gemm_phase<pg8::EpiResid, pg8::DenseSched, false>(F.lds, S, E);
            PE(pb + LP_OUTPROJ)
        }
        if (EN(11) && IN(pb + LP_NORM2)) { PB(pb + LP_NORM2) Frame F = phase_frame(F0); router_phase(F, layer, _rep + 1 == _n); PE(pb + LP_NORM2) }
        if (EN(12) && IN(pb + LP_MOE1)) { PB(pb + LP_MOE1)
            Frame F = phase_frame(F0);
            moe_tables(F, layer);
            pg8::MoeSched S{(const char*)(F.ws + WS_H8), (const char*)(F.ws + WS_WE1) + (size_t)layer * NE * 2048 * 1024, (size_t)2048 * 1024, (const int*)(F.ws + WS_ROWTOK),
                            (const volatile LAS int*)(F.MISC + MW_CUMBLK), (const volatile LAS int*)(F.MISC + MW_CNT), 3, F.G, F.bx, 1024};
            pg8::EpiSwiglu E{(unsigned char*)(F.ws + WS_ACT), PIN(F, I_EB1) + (size_t)layer * NE * 2048};
            pg8::gemm_phase<pg8::EpiSwiglu, pg8::MoeSched, true, true>(F.lds, S, E);
            PE(pb + LP_MOE1)
        }
        if (EN(13) && IN(pb + LP_MOE2)) { PB(pb + LP_MOE2)
            Frame F = phase_frame(F0);
            moe_tables(F, layer);
            pg8::MoeSched S{(const char*)(F.ws + WS_ACT), (const char*)(F.ws + WS_WE2) + (size_t)layer * NE * 1024 * 1024, (size_t)1024 * 1024, nullptr,
                            (const volatile LAS int*)(F.MISC + MW_CUMBLK), (const volatile LAS int*)(F.MISC + MW_CNT), 2, F.G, F.bx, 1024};
            pg8::EpiBias E{(bf16*)(F.ws + WS_YM), PIN(F, I_EB2) + (size_t)layer * NE * 1024};
            pg8::gemm_phase<pg8::EpiBias, pg8::MoeSched, true, true>(F.lds, S, E);
            PE(pb + LP_MOE2)
        }
    }
    if (EN(14) && IN(PH_FINAL)) { PB(PH_FINAL) Frame F = phase_frame(F0); rowpass<2>(F, NLAYER - 1, _rep + 1 == _n); PE(PH_FINAL) }
#undef IN
#undef SEAM
}

static bool host_phase_nonempty(int ph) {
    if (ph < PH_L0 || ph >= PH_FINAL) return true;
    const int layer = (ph - PH_L0) / PH_PER_LAYER, lp = (ph - PH_L0) % PH_PER_LAYER, kind = layer % 3;
    if (lp == LP_MIX2) return kind != 1;
    if (lp == LP_MIX3) return kind == 2;
    return true;
}
extern "C" void kernel_launch(void* const* d_in, const int* in_sizes, int n_in, void* d_out, int out_size, void* d_ws, size_t ws_size, hipStream_t stream) {
    static int grid = 0;
    if (grid == 0) {
        if (n_in != 36 || in_sizes[0] != ML * D || out_size != ML * D || ws_size < WS_END) {
            fprintf(stderr, "kernel_launch: built for 36 inputs, x/out of %d floats, >= %zu bytes of workspace; got n_in %d in0 %d out %d ws %zu; nothing launched\n", ML * D, (size_t)WS_END, n_in, n_in > 0 ? in_sizes[0] : -1, out_size, ws_size);
            grid = -1; return; }
        int dev = 0, cus = 0, per_cu = 0;
        if (hipGetDevice(&dev) != hipSuccess || hipDeviceGetAttribute(&cus, hipDeviceAttributeMultiprocessorCount, dev) != hipSuccess) { fprintf(stderr, "kernel_launch: device query failed\n"); grid = -1; return; }
        if (hipFuncSetAttribute((const void*)mk_fwd, hipFuncAttributeMaxDynamicSharedMemorySize, LDS_BYTES) != hipSuccess) { fprintf(stderr, "kernel_launch: hipFuncSetAttribute(%d B LDS) failed\n", LDS_BYTES); grid = -1; return; }
        if (hipOccupancyMaxActiveBlocksPerMultiprocessor(&per_cu, (const void*)mk_fwd, NTHREADS, LDS_BYTES) != hipSuccess || per_cu < 1)
            fprintf(stderr, "kernel_launch: note: occupancy query reports %d workgroups per CU\n", per_cu);
        (void)hipGetLastError();
        grid = cus;
    }
    if (grid < 0) return;
    if (hipMemsetAsync((char*)d_ws + WS_CTL, 0, CTL_ZERO_BYTES, stream) != hipSuccess) { fprintf(stderr, "kernel_launch: memset failed\n"); return; }
    Args a{};
    for (int i = 0; i < 36; ++i) a.in[i] = (const float*)d_in[i];
    a.out = (float*)d_out; a.ws = (unsigned char*)d_ws;
#if MK_MULTI || MK_DBG
    for (int ph = 0; ph < PH_COUNT; ++ph) {
        if (!host_phase_nonempty(ph)) continue;
        a.ph_lo = ph; a.ph_hi = ph + 1;
        hipLaunchKernelGGL(mk_fwd, dim3(grid), dim3(NTHREADS), LDS_BYTES, stream, a);
#if MK_DBG
        dbg_after_phase(ph, a, stream);
#endif
    }
#if MK_DBG
    dbg_report(a, stream);
#endif
#else
    a.ph_lo = 0; a.ph_hi = PH_COUNT;
    hipLaunchKernelGGL(mk_fwd, dim3(grid), dim3(NTHREADS), LDS_BYTES, stream, a);
#endif
    const hipError_t le = hipPeekAtLastError();
    if (le != hipSuccess) fprintf(stderr, "kernel_launch: launch failed: %s\n", hipGetErrorName(le));
}
```

```cpp
#include <hip/hip_runtime.h>
#include <cstdio>
#include <cstdint>
#include <cmath>

#ifndef MK_MULTI
#define MK_MULTI 0
#endif
#ifndef MK_REPEAT
#define MK_REPEAT -1
#endif
#ifndef MK_NREP
#define MK_NREP 1
#endif
#ifndef MK_DBG
#define MK_DBG 0
#endif

constexpr int D = 1024, NB = 8, SEQ = 8192, CL = 256, ML = NB * SEQ, MC = NB * CL, MT = ML + MC;
constexpr int NLAYER = 4, NE = 32, TOPK = 4, SKV = SEQ + CL;
constexpr int MOE_MAXBLK = (MT * TOPK) / 256 + NE;
constexpr float EPS = 1e-6f;
constexpr int FH = 64, FEMB = 33, NFFT = 16384;

constexpr size_t MiB = 1u << 20;
constexpr size_t WS_CTL = 0, CTL_ZERO_BYTES = 1 * MiB;
constexpr size_t WS_MOD = 1 * MiB;
constexpr size_t WS_A3 = 2 * MiB;
constexpr size_t WS_A3C = 4 * MiB;
constexpr size_t WS_RC = 4 * MiB + 512 * 1024;
constexpr size_t WS_FCT = 5 * MiB;
constexpr size_t WS_WATT = 8 * MiB;
constexpr size_t WS_WGM = 14 * MiB;
constexpr size_t WS_WHY = 18 * MiB;
constexpr size_t WS_WOUT = 24 * MiB;
constexpr size_t WS_XC = 32 * MiB;
constexpr size_t WS_TE = 40 * MiB;
constexpr size_t WS_TR = 42 * MiB;
constexpr size_t WS_TG = 44 * MiB;
constexpr size_t WS_SS = 46 * MiB;
constexpr size_t WS_ROWTOK = 52 * MiB;
constexpr size_t WS_KF = 64 * MiB;
constexpr size_t WS_WE1 = 192 * MiB;
constexpr size_t WS_WE2 = 704 * MiB;
constexpr size_t WS_H = 960 * MiB;
constexpr size_t WS_P = 1092 * MiB;
constexpr size_t WS_Y = 1488 * MiB;
constexpr size_t WS_QB = 1620 * MiB;
constexpr size_t WS_KVB = 1752 * MiB;
constexpr size_t WS_X0 = 1818 * MiB;
constexpr size_t WS_VG = 1950 * MiB;
constexpr size_t WS_VT = 2082 * MiB;
constexpr size_t WS_VTC = 2338 * MiB;
constexpr size_t WS_ACT = 2346 * MiB;
constexpr size_t WS_YM = 2890 * MiB;
constexpr size_t WS_CT = 3434 * MiB;
constexpr size_t WS_CTC = 3690 * MiB;
constexpr size_t WS_H8 = 3698 * MiB;
constexpr size_t WS_END = 3764 * MiB;
constexpr int CW_BAR = 4096;
constexpr int CW_CNT = 16384;
constexpr int CW_DBG = 32768;

constexpr int RING_BYTES = 131072;
constexpr int AUX_OFF = RING_BYTES;
constexpr int AUX_BYTES = 16384;
constexpr int MISC_OFF = AUX_OFF + AUX_BYTES;
constexpr int MISC_BYTES = 4096;
constexpr int LDS_BYTES = MISC_OFF + MISC_BYTES;

#define GAS __attribute__((address_space(1)))
#define LAS __attribute__((address_space(3)))
typedef unsigned short bf16;
typedef unsigned v4u __attribute__((ext_vector_type(4)));
typedef unsigned v2u __attribute__((ext_vector_type(2)));
typedef float f32x4 __attribute__((ext_vector_type(4)));
typedef float f32x2 __attribute__((ext_vector_type(2)));
typedef float f32x16 __attribute__((ext_vector_type(16)));
typedef short bf16x8 __attribute__((ext_vector_type(8)));
typedef short s16x4 __attribute__((ext_vector_type(4)));
typedef int i32x4 __attribute__((ext_vector_type(4)));
typedef GAS unsigned gu32;
#define RLX_AGENT __ATOMIC_RELAXED, __HIP_MEMORY_SCOPE_AGENT
#define LDS_WAIT() asm volatile("s_waitcnt lgkmcnt(0)" ::: "memory")
#define VM_WAIT() asm volatile("s_waitcnt vmcnt(0)" ::: "memory")
__device__ __forceinline__ unsigned f2bf(float f) { unsigned u = __builtin_bit_cast(unsigned, f); return (u + 0x7fffu + ((u >> 16) & 1u)) >> 16; }
__device__ __forceinline__ unsigned pk2(float lo, float hi) { return f2bf(lo) | (f2bf(hi) << 16); }
__device__ __forceinline__ float bf2f(unsigned short b) { return __builtin_bit_cast(float, ((unsigned)b) << 16); }
__device__ __forceinline__ float bflo(unsigned w) { return __builtin_bit_cast(float, w << 16); }
__device__ __forceinline__ float bfhi(unsigned w) { return __builtin_bit_cast(float, w & 0xffff0000u); }
__device__ __forceinline__ unsigned cvt_pk_bf16(float lo, float hi) { unsigned r; asm volatile("v_cvt_pk_bf16_f32 %0, %1, %2" : "=v"(r) : "v"(lo), "v"(hi)); return r; }
__device__ __forceinline__ int opaque_tid() { int t = (int)threadIdx.x; asm volatile("" : "+v"(t)); return t; }
__device__ __forceinline__ float wave_sum(float v) {
#pragma unroll
    for (int o = 1; o < 64; o <<= 1) v += __shfl_xor(v, o);
    return v;
}

#define XB_TMO      128
#define XB_XCNT(j)  (256  + 64 * (j))
#define XB_XSUB(j)  (1280 + 64 * (j))
#define XB_XGEN(j)  (2304 + 64 * (j))
#define XB_TOP      3328
#define XB_TOPGEN   3392
#define XCD_BAR_WORDS 3456
#define XB_SPIN_CAP (1u << 22)
__device__ __forceinline__ unsigned xb_ld(unsigned* p)              { return __hip_atomic_load(p, __ATOMIC_RELAXED, __HIP_MEMORY_SCOPE_AGENT); }
__device__ __forceinline__ unsigned xb_add(unsigned* p, unsigned v) { return __hip_atomic_fetch_add(p, v, __ATOMIC_RELAXED, __HIP_MEMORY_SCOPE_AGENT); }
__device__ __forceinline__ unsigned xb_xcc_id() { return (unsigned)__builtin_amdgcn_s_getreg((3 << 11) | 20) & 0xFu; }
#define XB_SPIN(cond, bar) do { unsigned _sp = 0; while (cond) { __builtin_amdgcn_s_sleep(1); \
    if ((++_sp & 255u) == 0u) { if (xb_ld(&(bar)[XB_TMO])) break; if (_sp > XB_SPIN_CAP) { atomicAdd(&(bar)[XB_TMO], 1u); break; } } } } while (0)
struct XcdBarrier { unsigned* bar; unsigned x; volatile LAS unsigned* st; };
__device__ __forceinline__ XcdBarrier xcd_barrier_post(unsigned* bar, volatile LAS unsigned* st) {
    XcdBarrier b; b.bar = bar; b.x = xb_xcc_id(); b.st = st;
    if (threadIdx.x == 0) (void)xb_add(&bar[XB_XCNT(b.x)], 1u);
    return b;
}
__device__ __forceinline__ void xcd_barrier_complete(unsigned* bar, unsigned x, unsigned& nloc, unsigned& nx) {
    const unsigned G = gridDim.x * gridDim.y * gridDim.z;
    unsigned sum, cnt, mine, sp = 0u;
    for (;;) {
        sum = 0u; cnt = 0u; mine = 0u;
#pragma unroll
        for (unsigned j = 0; j < 16; ++j) { const unsigned c = xb_ld(&bar[XB_XCNT(j)]); sum += c; cnt += (c > 0u) ? 1u : 0u; mine = (j == x) ? c : mine; }
        if (sum == G) break;
        __builtin_amdgcn_s_sleep(1);
        if ((++sp & 255u) == 0u) { if (xb_ld(&bar[XB_TMO])) break; if (sp > XB_SPIN_CAP) { atomicAdd(&bar[XB_TMO], 1u); break; } }
    }
    nloc = mine > 0u ? mine : 1u; nx = cnt > 0u ? cnt : 1u;
}
__device__ __forceinline__ void xcd_barrier(const XcdBarrier& b) {
    asm volatile("s_waitcnt vmcnt(0)" ::: "memory");
    __syncthreads();
    if (threadIdx.x == 0) {
        unsigned* bar = b.bar;
        __builtin_amdgcn_s_waitcnt(0);
        unsigned nloc = b.st[0], nx = b.st[1];
        if (nloc == 0u) { xcd_barrier_complete(bar, b.x, nloc, nx); b.st[0] = nloc; b.st[1] = nx; }
        const unsigned old = xb_add(&bar[XB_XSUB(b.x)], 1u);
        const unsigned gen = old / nloc;
        if (old + 1u == (gen + 1u) * nloc) {
            __builtin_amdgcn_fence(__ATOMIC_RELEASE, "agent");
            asm volatile("s_waitcnt vmcnt(0)" ::: "memory");
            const unsigned og = xb_add(&bar[XB_TOP], 1u);
            const unsigned tg = og / nx;
            if (og + 1u == (tg + 1u) * nx) xb_add(&bar[XB_TOPGEN], 1u);
            else XB_SPIN(xb_ld(&bar[XB_TOPGEN]) == tg, bar);
            __builtin_amdgcn_fence(__ATOMIC_ACQUIRE, "agent");
            xb_add(&bar[XB_XGEN(b.x)], 1u);
            asm volatile("s_waitcnt vmcnt(0)" ::: "memory");
        } else {
            XB_SPIN(xb_ld(&bar[XB_XGEN(b.x)]) == gen, bar);
            __builtin_amdgcn_fence(__ATOMIC_ACQUIRE, "agent");
            asm volatile("s_waitcnt vmcnt(0)" ::: "memory");
        }
    }
    __syncthreads();
}

namespace pg8 {
constexpr int BM = 256, BK = 64, HALF = 128, HTB = HALF * BK * 2, STAGE_BYTES = 8 * HTB, NXCD = 8, WGM = 8;
constexpr int GK = 1024;
__device__ __forceinline__ int lds_byte(int r, int c) { const int st = (r >> 4) * 2 + (c >> 5), rr = r & 15, cc = c & 31, ob = rr * 64 + cc * 2; return st * 1024 + (ob ^ (((ob >> 9) & 1) << 5)); }
__device__ __forceinline__ void stage_rc(int b, int& R, int& C) { const int st = b / 1024, sb = b % 1024, swz = sb ^ (((sb >> 9) & 1) << 5); R = (st >> 1) * 16 + swz / 64; C = (st & 1) * 32 + (swz % 64) / 2; }
__device__ __forceinline__ int perm32(int rho) { const int n = rho >> 4, i = rho & 15; return 8 * (i >> 2) + 4 * n + (i & 3); }
struct Unit { int pm, pn, e; };

struct DenseSched {
    const char* A; const char* Bt; int nM, nN, nwg, G, c;
    __device__ __forceinline__ void init(const void* A_, const void* Bt_, int M, int N, int G_, int c_) { A = (const char*)A_; Bt = (const char*)Bt_; nM = M / BM; nN = N / BM; nwg = nM * nN; G = G_; c = c_; }
    __device__ __forceinline__ bool next(int i, Unit& u) const {
        const long L = (long)i * G + c; if (L >= nwg) return false;
        int wgid = (int)L; { const int q = nwg / NXCD, r = nwg % NXCD, xcd = wgid % NXCD, off = wgid / NXCD; wgid = (xcd < r ? xcd * (q + 1) : r * (q + 1) + (xcd - r) * q) + off; }
        const int nig = WGM * nN, gid = wgid / nig, fm = gid * WGM, gsz = (nM - fm) < WGM ? (nM - fm) : WGM;
        u.pm = fm + ((wgid % nig) % gsz); u.pn = (wgid % nig) / gsz; u.e = 0; return true;
    }
    __device__ __forceinline__ const char* a_ptr(const Unit& u) const { return A + (size_t)u.pm * (BM * GK * 2); }
    __device__ __forceinline__ const char* b_ptr(const Unit& u) const { return Bt + (size_t)u.pn * (BM * GK * 2); }
    __device__ __forceinline__ void a_offs(const Unit&, const int (&)[2], const int (&)[2], unsigned (&)[2][2]) const {}
};
struct MoeSched {
    const char* A; const char* Bt; size_t b_estride; const int* rowtok; const volatile LAS int* cumblk; const volatile LAS int* cnt; int ncol_log2, G, c, kb;
    __device__ __forceinline__ bool next(int i, Unit& u) const {
        int gb, pn; const int ncol = 1 << ncol_log2;
        if (G == 256) { const int xcd = c & 7, j = c >> 3, rpb = 256 >> ncol_log2; gb = i * rpb + xcd + 8 * (j >> ncol_log2); pn = j & (ncol - 1); }
        else { const long L = (long)i * G + c; gb = (int)(L >> ncol_log2); pn = (int)(L & (ncol - 1)); }
        const int tot = cumblk[NE]; if (gb >= tot) return false;
        int e = 0;
#pragma unroll 1
        for (int s = 16; s >= 1; s >>= 1) { if (cumblk[e + s] <= gb) e += s; }
        u.pm = gb; u.pn = pn; u.e = e; return true;
    }
    __device__ __forceinline__ const char* a_ptr(const Unit&) const { return A; }
    __device__ __forceinline__ const char* b_ptr(const Unit& u) const { return Bt + (size_t)u.e * b_estride + (size_t)u.pn * (size_t)(BM * kb); }
    __device__ __forceinline__ void a_offs(const Unit& u, const int (&R)[2], const int (&C)[2], unsigned (&voff)[2][2]) const {
        const int rb = u.pm - cumblk[u.e], n = cnt[u.e]; const int* rt = rowtok + (size_t)u.e * MT;
#pragma unroll
        for (int h = 0; h < 2; ++h)
#pragma unroll
            for (int i = 0; i < 2; ++i) { const int rank = rb * 256 + h * HALF + R[i]; const int tok = rowtok ? (rank < n ? rt[rank] : 0) : u.pm * BM + h * HALF + R[i]; voff[h][i] = (unsigned)tok * (unsigned)kb + (unsigned)C[i] * 2u; }
    }
};

typedef int v8i __attribute__((ext_vector_type(8)));
__device__ __forceinline__ v8i cat8(bf16x8 lo, bf16x8 hi) { const v4u a = __builtin_bit_cast(v4u, lo), b = __builtin_bit_cast(v4u, hi); return (v8i){(int)a.x, (int)a.y, (int)a.z, (int)a.w, (int)b.x, (int)b.y, (int)b.z, (int)b.w}; }
template <class Epi, class Sched, bool GATHER, bool FP8 = false>
__device__ __forceinline__ void gemm_phase(LAS unsigned char* lds, const Sched& S, const Epi& E) {
    const int tid = opaque_tid(), wid = __builtin_amdgcn_readfirstlane(tid >> 6), lane = tid & 63, wr = wid >> 2, wc = wid & 3, fr = lane & 15, fq = lane >> 4;
    constexpr int KB = FP8 ? GK : GK * 2, nt = KB / (BK * 2);
    unsigned voffA[2][2], voffB[2]; int Rr[2], Cc[2];
#pragma unroll
    for (int i = 0; i < 2; ++i) { int R, C; stage_rc(tid * 16 + i * 8192, R, C); Rr[i] = R; Cc[i] = C; const int Rb = Epi::PERM ? ((R & ~31) + perm32(R & 31)) : R;
        voffA[0][i] = (unsigned)(R * KB + C * 2); voffA[1][i] = (unsigned)((R + HALF) * KB + C * 2); voffB[i] = (unsigned)(Rb * KB + C * 2); }
    constexpr size_t kstep = (size_t)(BK * 2);
    constexpr size_t hstep = (size_t)HALF * KB;
    const unsigned ldsw = (unsigned)wid * 1024u;
    const int aoff = lds_byte(wr * 64 + fr, fq * 8), boff = lds_byte(wc * 32 + fr, fq * 8);
    LAS unsigned char* abase = lds + aoff; LAS unsigned char* bbase = lds + 4 * HTB + boff; asm volatile("" : "+v"(abase), "+v"(bbase));
#define PG8_SA(b, h) (((b) * 2 + (h)) * HTB)
#define PG8_SB(b, h) ((4 + (b) * 2 + (h)) * HTB)
#define PG8_STAGE(bufoff, gbase, voff) do { _Pragma("unroll") for (int _i = 0; _i < 2; ++_i) \
        __builtin_amdgcn_global_load_lds((const unsigned*)((const char*)(gbase) + (voff)[_i]), (LAS unsigned*)(lds + (bufoff) + ldsw + _i * 8192), 16, 0, 0); } while (0)
#define PG8_STAGE_A(bufoff, gbase, h) PG8_STAGE(bufoff, gbase, voffA[h])
#define PG8_RDA(off) (*(const LAS v4u*)(abase + (off)))
#define PG8_RDB(off) (*(const LAS v4u*)(bbase + (off)))
#define PG8_LDA(dst, b, h) do { _Pragma("unroll") for (int m = 0; m < 4; ++m) { const v4u _l = PG8_RDA(PG8_SA(b, h) + m * 2048), _h = PG8_RDA(PG8_SA(b, h) + m * 2048 + 1024); \
        if constexpr (FP8) dst##8[m] = (v8i){(int)_l.x, (int)_l.y, (int)_l.z, (int)_l.w, (int)_h.x, (int)_h.y, (int)_h.z, (int)_h.w}; \
        else { dst[m][0] = __builtin_bit_cast(bf16x8, _l); dst[m][1] = __builtin_bit_cast(bf16x8, _h); } } } while (0)
#define PG8_LDB(dst, b, h) do { _Pragma("unroll") for (int n = 0; n < 2; ++n) { const v4u _l = PG8_RDB(PG8_SA(b, h) + n * 2048), _h = PG8_RDB(PG8_SA(b, h) + n * 2048 + 1024); \
        if constexpr (FP8) dst##8[n] = (v8i){(int)_l.x, (int)_l.y, (int)_l.z, (int)_l.w, (int)_h.x, (int)_h.y, (int)_h.z, (int)_h.w}; \
        else { dst[n][0] = __builtin_bit_cast(bf16x8, _l); dst[n][1] = __builtin_bit_cast(bf16x8, _h); } } } while (0)
#define PG8_MMA(ai, bj, At, Bt) do { __builtin_amdgcn_s_setprio(1); _Pragma("unroll") for (int m = 0; m < 4; ++m) _Pragma("unroll") for (int n = 0; n < 2; ++n) { \
        if constexpr (FP8) acc[ai][bj][m][n] = __builtin_amdgcn_mfma_scale_f32_16x16x128_f8f6f4(Bt##8[n], At##8[m], acc[ai][bj][m][n], 0, 0, 0, 0x7A7A7A7A, 0, 0x7F7F7F7F); \
        else { _Pragma("unroll") for (int k = 0; k < 2; ++k) acc[ai][bj][m][n] = __builtin_amdgcn_mfma_f32_16x16x32_bf16(Bt[n][k], At[m][k], acc[ai][bj][m][n], 0, 0, 0); } } \
        __builtin_amdgcn_s_setprio(0); } while (0)
#define PG8_WAIT_V(n) asm volatile("s_waitcnt vmcnt(" #n ")" ::: "memory")
#define PG8_WAIT_L(n) asm volatile("s_waitcnt lgkmcnt(" #n ")" ::: "memory")
#define PG8_BAR __builtin_amdgcn_s_barrier()
#define PG8_SCHED __builtin_amdgcn_sched_barrier(0)
    Unit cur, nxt; int ui = 0;
    if (!S.next(0, cur)) return;
    f32x4 acc[2][2][4][2];
#pragma unroll
    for (int a = 0; a < 2; ++a)
#pragma unroll
        for (int b = 0; b < 2; ++b)
#pragma unroll
            for (int m = 0; m < 4; ++m)
#pragma unroll
                for (int n = 0; n < 2; ++n) acc[a][b][m][n] = (f32x4){0.f, 0.f, 0.f, 0.f};
    bf16x8 At[4][2], B0[2][2], B1[2][2]; v8i At8[4], B08[2], B18[2];
    const char* cA = S.a_ptr(cur); const char* cB = S.b_ptr(cur);
    if constexpr (GATHER) S.a_offs(cur, Rr, Cc, voffA);
    PG8_STAGE(PG8_SB(0, 0), cB, voffB); PG8_STAGE(PG8_SB(0, 1), cB + hstep, voffB); PG8_STAGE_A(PG8_SA(0, 0), cA, 0); PG8_STAGE_A(PG8_SA(0, 1), cA, 1);
    if (wr == 1) PG8_BAR;
    PG8_WAIT_V(2); PG8_BAR;
    PG8_STAGE(PG8_SB(1, 0), cB + kstep, voffB); PG8_STAGE_A(PG8_SA(1, 0), cA + kstep, 0); PG8_STAGE(PG8_SB(1, 1), cB + hstep + kstep, voffB);
    PG8_WAIT_V(6); PG8_BAR;
    for (;;) {
        const bool has_next = S.next(ui + 1, nxt);
        const char* nA = has_next ? S.a_ptr(nxt) : cA; const char* nB = has_next ? S.b_ptr(nxt) : cB;
#pragma unroll 1
        for (int t = 0; t < nt; t += 2) {
            const bool last = (t == nt - 2);
            const char* a1 = cA + (size_t)(t + 1) * kstep;
            const char* a2 = last ? nA : cA + (size_t)(t + 2) * kstep; const char* b2 = last ? nB : cB + (size_t)(t + 2) * kstep;
            const char* a3 = a2 + kstep; const char* b3 = b2 + kstep;
            PG8_LDB(B0, 0, 0); PG8_LDB(B1, 0, 1); PG8_SCHED; PG8_LDA(At, 0, 0); PG8_STAGE_A(PG8_SA(1, 1), a1, 1);
            if constexpr (GATHER) { if (last && has_next) S.a_offs(nxt, Rr, Cc, voffA); }
            PG8_WAIT_V(8); PG8_WAIT_L(0); PG8_BAR; PG8_MMA(0, 0, At, B0); PG8_MMA(0, 1, At, B1); PG8_BAR; PG8_SCHED;
            PG8_LDA(At, 0, 1); PG8_STAGE(PG8_SB(0, 0), b2, voffB); PG8_STAGE(PG8_SB(0, 1), b2 + hstep, voffB); PG8_STAGE_A(PG8_SA(0, 0), a2, 0);
            PG8_WAIT_V(8); PG8_WAIT_L(0); PG8_BAR; PG8_MMA(1, 0, At, B0); PG8_MMA(1, 1, At, B1); PG8_BAR; PG8_SCHED;
            PG8_LDB(B0, 1, 0); PG8_LDB(B1, 1, 1); PG8_SCHED; PG8_LDA(At, 1, 0); PG8_STAGE_A(PG8_SA(0, 1), a2, 1);
            PG8_WAIT_V(8); PG8_WAIT_L(0); PG8_BAR; PG8_MMA(0, 0, At, B0); PG8_MMA(0, 1, At, B1); PG8_BAR; PG8_SCHED;
            PG8_LDA(At, 1, 1); PG8_STAGE(PG8_SB(1, 0), b3, voffB); PG8_STAGE(PG8_SB(1, 1), b3 + hstep, voffB); PG8_STAGE_A(PG8_SA(1, 0), a3, 0);
            PG8_WAIT_V(8); PG8_WAIT_L(0); PG8_BAR; PG8_MMA(1, 0, At, B0); PG8_MMA(1, 1, At, B1); PG8_BAR; PG8_SCHED;
        }
        if (wr == 0) PG8_BAR;
        E(acc, cur, wr, wc, fr, fq);
        if (!has_next) break;
#pragma unroll
        for (int a = 0; a < 2; ++a)
#pragma unroll
            for (int b = 0; b < 2; ++b)
#pragma unroll
                for (int m = 0; m < 4; ++m)
#pragma unroll
                    for (int n = 0; n < 2; ++n) acc[a][b][m][n] = (f32x4){0.f, 0.f, 0.f, 0.f};
        cur = nxt; cA = nA; cB = nB; ++ui;
        if (wr == 1) PG8_BAR;
    }
    PG8_WAIT_V(0);
    PG8_BAR;
#undef PG8_SA
#undef PG8_SB
#undef PG8_STAGE
#undef PG8_STAGE_A
#undef PG8_LDA
#undef PG8_RDA
#undef PG8_RDB
#undef PG8_LDB
#undef PG8_MMA
#undef PG8_WAIT_V
#undef PG8_WAIT_L
#undef PG8_BAR
#undef PG8_SCHED
}
}
namespace pg8 {
__device__ __forceinline__ f32x2 gelu_pk(f32x2 v) {
    const f32x2 av = __builtin_elementwise_abs(v), d = av * 0.2316418882f + 1.0f;
    f32x2 t; t.x = __builtin_amdgcn_rcpf(d.x); t.y = __builtin_amdgcn_rcpf(d.y);
    f32x2 q = t * 0.5307027145f + (-0.7265760135f); q = q * t + 0.7107068705f; q = q * t + (-0.142248368f); q = q * t + 0.127414796f; q = q * t;
    const f32x2 s = (v * v) * (-0.72134752044f);
    f32x2 e; e.x = __builtin_amdgcn_exp2f(s.x); e.y = __builtin_amdgcn_exp2f(s.y);
    const f32x2 m = v * (q * e), r = v - m;
    f32x2 o; o.x = v.x < 0.f ? m.x : r.x; o.y = v.y < 0.f ? m.y : r.y; return o;
}
struct EpiBf16 {
    static constexpr bool PERM = true;
    bf16* O; int ldc; float* ss; int ACT;
    __device__ __forceinline__ void operator()(const f32x4 (&acc)[2][2][4][2], const Unit& u, int wr, int wc, int fr, int fq) const {
        const int row0 = u.pm * BM + wr * 64 + fr, col0 = u.pn * BM + wc * 32 + 8 * fq;
#pragma unroll
        for (int ai = 0; ai < 2; ++ai)
#pragma unroll
            for (int m = 0; m < 4; ++m) { const int row = row0 + ai * HALF + m * 16; bf16* rowp = O + (size_t)row * ldc + col0; float sq = 0.f;
#pragma unroll
                for (int bj = 0; bj < 2; ++bj) { f32x4 v0 = acc[ai][bj][m][0], v1 = acc[ai][bj][m][1];
                    if (ACT == 1) { f32x2 a = gelu_pk((f32x2){v0[0], v0[1]}), b = gelu_pk((f32x2){v0[2], v0[3]}), c = gelu_pk((f32x2){v1[0], v1[1]}), d = gelu_pk((f32x2){v1[2], v1[3]});
                        v0 = (f32x4){a.x, a.y, b.x, b.y}; v1 = (f32x4){c.x, c.y, d.x, d.y};
                        sq += (v0[0] * v0[0] + v0[1] * v0[1]) + (v0[2] * v0[2] + v0[3] * v0[3]) + (v1[0] * v1[0] + v1[1] * v1[1]) + (v1[2] * v1[2] + v1[3] * v1[3]); }
                    v4u w; w.x = cvt_pk_bf16(v0[0], v0[1]); w.y = cvt_pk_bf16(v0[2], v0[3]); w.z = cvt_pk_bf16(v1[0], v1[1]); w.w = cvt_pk_bf16(v1[2], v1[3]);
                    *(v4u*)(rowp + bj * HALF) = w; }
                if (ACT == 1) { sq += __shfl_xor(sq, 16); sq += __shfl_xor(sq, 32);
                    if (u.pn >= 4 && fq == 0) ss[(size_t)row * 16 + (u.pn - 4) * 4 + wc] = sq; }
            }
    }
};
struct EpiResid {
    static constexpr bool PERM = false;
    const float* baseL; const float* baseC; float* outL; float* outC; const float* modl;
    __device__ __forceinline__ void operator()(const f32x4 (&acc)[2][2][4][2], const Unit& u, int wr, int wc, int fr, int fq) const {
        const bool lat = u.pm < ML / BM; const int rb = lat ? u.pm : u.pm - ML / BM, bidx = lat ? (u.pm >> 5) : 8;
        const float* base = (lat ? baseL : baseC) + (size_t)rb * BM * D; float* out = (lat ? outL : outC) + (size_t)rb * BM * D;
        const float* g = modl + bidx * 6144 + 2 * 1024;
        const int r0 = wr * 64 + fr, col0 = u.pn * BM + wc * 32 + 4 * fq;
        f32x4 gv[2][2];
#pragma unroll
        for (int bj = 0; bj < 2; ++bj)
#pragma unroll
            for (int n = 0; n < 2; ++n) gv[bj][n] = *(const f32x4*)(g + col0 + bj * HALF + n * 16);
#pragma unroll
        for (int ai = 0; ai < 2; ++ai)
#pragma unroll
          for (int mp = 0; mp < 2; ++mp) { f32x4 bs[2][2][2];
#pragma unroll
            for (int m2 = 0; m2 < 2; ++m2) { const size_t off = (size_t)(r0 + ai * HALF + (mp * 2 + m2) * 16) * D + col0;
#pragma unroll
                for (int bj = 0; bj < 2; ++bj)
#pragma unroll
                    for (int n = 0; n < 2; ++n) bs[m2][bj][n] = *(const f32x4*)(base + off + bj * HALF + n * 16); }
#pragma unroll
            for (int m2 = 0; m2 < 2; ++m2) { const size_t off = (size_t)(r0 + ai * HALF + (mp * 2 + m2) * 16) * D + col0;
#pragma unroll
                for (int bj = 0; bj < 2; ++bj)
#pragma unroll
                    for (int n = 0; n < 2; ++n) *(f32x4*)(out + off + bj * HALF + n * 16) = bs[m2][bj][n] + gv[bj][n] * acc[ai][bj][mp * 2 + m2][n]; }
            asm volatile("" ::: "memory"); }
    }
};
struct EpiSwiglu {
    static constexpr bool PERM = true;
    unsigned char* O; const float* b1;
    __device__ __forceinline__ void operator()(const f32x4 (&acc)[2][2][4][2], const Unit& u, int wr, int wc, int fr, int fq) const {
        const int row0 = u.pm * BM + wr * 64 + fr, c0 = u.pn * HALF + wc * 32 + 8 * fq; const float* be = b1 + (size_t)u.e * 2048;
        f32x4 bg[2], bl[2];
#pragma unroll
        for (int n = 0; n < 2; ++n) { bg[n] = *(const f32x4*)(be + c0 + 4 * n); bl[n] = *(const f32x4*)(be + 1024 + c0 + 4 * n); }
#pragma unroll
        for (int ai = 0; ai < 2; ++ai)
#pragma unroll
            for (int m = 0; m < 4; ++m) { float o[8];
#pragma unroll
                for (int n = 0; n < 2; ++n)
#pragma unroll
                    for (int j = 0; j < 4; ++j) { float gl = acc[ai][0][m][n][j] + bg[n][j], li = acc[ai][1][m][n][j] + bl[n][j];
                        gl = fminf(gl, 7.0f); li = fminf(fmaxf(li, -7.0f), 7.0f);
                        const float sg = __builtin_amdgcn_rcpf(1.0f + __builtin_amdgcn_exp2f(gl * (-1.702f * 1.4426950408889634f)));
                        o[n * 4 + j] = gl * sg * (li + 1.0f); }
                v2u w; w.x = 0; w.y = 0;
                w.x = __builtin_amdgcn_cvt_pk_fp8_f32(o[0], o[1], w.x, false); w.x = __builtin_amdgcn_cvt_pk_fp8_f32(o[2], o[3], w.x, true);
                w.y = __builtin_amdgcn_cvt_pk_fp8_f32(o[4], o[5], w.y, false); w.y = __builtin_amdgcn_cvt_pk_fp8_f32(o[6], o[7], w.y, true);
                *(v2u*)(O + (size_t)(row0 + ai * HALF + m * 16) * D + c0) = w; }
    }
};
struct EpiBias {
    static constexpr bool PERM = true;
    bf16* O; const float* b2;
    __device__ __forceinline__ void operator()(const f32x4 (&acc)[2][2][4][2], const Unit& u, int wr, int wc, int fr, int fq) const {
        const int row0 = u.pm * BM + wr * 64 + fr, col0 = u.pn * BM + wc * 32 + 8 * fq; const float* be = b2 + (size_t)u.e * 1024 + col0;
#pragma unroll
        for (int bj = 0; bj < 2; ++bj) { const f32x4 bv0 = *(const f32x4*)(be + bj * HALF), bv1 = *(const f32x4*)(be + bj * HALF + 4);
#pragma unroll
            for (int ai = 0; ai < 2; ++ai)
#pragma unroll
                for (int m = 0; m < 4; ++m) { const f32x4 v0 = acc[ai][bj][m][0] + bv0, v1 = acc[ai][bj][m][1] + bv1;
                    v4u w; w.x = cvt_pk_bf16(v0[0], v0[1]); w.y = cvt_pk_bf16(v0[2], v0[3]); w.z = cvt_pk_bf16(v1[0], v1[1]); w.w = cvt_pk_bf16(v1[2], v1[3]);
                    *(v4u*)(O + (size_t)(row0 + ai * HALF + m * 16) * D + col0 + bj * HALF) = w; }
            asm volatile("" ::: "memory"); }
    }
};
}

namespace att {
constexpr int AD = 128, NW = 8, QBLK = 32, KVBLK = 64;
constexpr float SCALE = 0.088388347648318440f;
constexpr float THR = 8.f;
constexpr int LDQ = 1024, LDK = 512, LDO = 1024;
constexpr int SHM_V = KVBLK * AD * 2, SHM_K = KVBLK * AD * 2, SHM_ATTN = 2 * SHM_V + 2 * SHM_K + NW * 64 * 4;
#define KSWZ(row, colB) ((row) * 256 + ((colB) ^ (((row) & 7) << 4)))
#define SBAR() __builtin_amdgcn_sched_barrier(0)
__device__ __forceinline__ int crow(int r, int hi) { return (r & 3) + 8 * (r >> 2) + 4 * hi; }
__device__ __forceinline__ void partialSM(f32x16& p0, f32x16& p1, float& m_reg, float& mn, float& alpha) {
  constexpr float C = SCALE * 1.4426950408889634f;
  float pmax = p0[0]; for (int r = 1; r < 16; ++r) pmax = fmaxf(pmax, p0[r]); for (int r = 0; r < 16; ++r) pmax = fmaxf(pmax, p1[r]);
  { auto rr = __builtin_amdgcn_permlane32_swap(__float_as_uint(pmax), __float_as_uint(pmax), false, false);
    pmax = fmaxf(__uint_as_float(rr[0]), __uint_as_float(rr[1])); }
  if (__builtin_expect(__all(pmax - m_reg <= THR / SCALE), 1)) { mn = m_reg; alpha = 1.f; }
  else { mn = fmaxf(m_reg, pmax); alpha = __builtin_amdgcn_exp2f((m_reg - mn) * C); m_reg = mn; }
  float mnC = -mn * C;
  for (int r = 0; r < 16; ++r) p0[r] = fmaf(p0[r], C, mnC); for (int r = 0; r < 16; ++r) p1[r] = fmaf(p1[r], C, mnC);
  for (int r = 0; r < 16; ++r) p0[r] = __builtin_amdgcn_exp2f(p0[r]);
}
__device__ __forceinline__ void finishSM(f32x16& p0, f32x16& p1, float alpha, float& l_reg, bf16x8& pa0, bf16x8& pa1, bf16x8& pa2, bf16x8& pa3) {
  for (int r = 0; r < 16; ++r) p1[r] = __builtin_amdgcn_exp2f(p1[r]);
  float ps = 0; for (int r = 0; r < 16; ++r) ps += p0[r]; for (int r = 0; r < 16; ++r) ps += p1[r];
  { auto rr = __builtin_amdgcn_permlane32_swap(__float_as_uint(ps), __float_as_uint(ps), false, false);
    ps = __uint_as_float(rr[0]) + __uint_as_float(rr[1]); }
  l_reg = l_reg * alpha + ps;
#define PK4(P, BASE, OUT) do { unsigned a0 = cvt_pk_bf16(P[BASE + 0], P[BASE + 1]), a1 = cvt_pk_bf16(P[BASE + 2], P[BASE + 3]);   \
    unsigned b0 = cvt_pk_bf16(P[BASE + 4], P[BASE + 5]), b1 = cvt_pk_bf16(P[BASE + 6], P[BASE + 7]);                              \
    auto r0 = __builtin_amdgcn_permlane32_swap(a0, b0, false, false); auto r1 = __builtin_amdgcn_permlane32_swap(a1, b1, false, false); \
    v4u w = {r0[0], r1[0], r0[1], r1[1]}; OUT = *reinterpret_cast<bf16x8*>(&w); } while (0)
  PK4(p0, 0, pa0); PK4(p0, 8, pa1); PK4(p1, 0, pa2); PK4(p1, 8, pa3);
#undef PK4
}
__device__ __forceinline__ void qkt(f32x16& p0, f32x16& p1, const bf16* Ks, const bf16x8* qr, int r32, int hi) {
  p0 = f32x16{}; p1 = f32x16{};
  for (int d0 = 0; d0 < 8; ++d0) { int cb = (d0 * 16 + hi * 8) * 2;
    bf16x8 b0 = *reinterpret_cast<const bf16x8*>((const char*)Ks + KSWZ(r32, cb));
    bf16x8 b1 = *reinterpret_cast<const bf16x8*>((const char*)Ks + KSWZ(32 + r32, cb));
    p0 = __builtin_amdgcn_mfma_f32_32x32x16_bf16(b0, qr[d0], p0, 0, 0, 0);
    p1 = __builtin_amdgcn_mfma_f32_32x32x16_bf16(b1, qr[d0], p1, 0, 0, 0); }
}
__device__ __forceinline__ int v_st(int k, int c) { const int kk = (k & ~0xC) | ((k & 4) << 1) | ((k & 8) >> 1); return ((kk >> 3) * 4 + (c >> 5)) * 512 + ((kk & 7) * 32 + (c & 31)) * 2; }
__device__ __forceinline__ int v_rd_base(int lane) { return ((lane & 3) << 3) | (((lane >> 2) & 3) << 6) | (((lane >> 4) & 1) << 5) | (((lane >> 5) & 1) << 8); }
constexpr int v_rd_off(int d0, int ks, int half) { return d0 * 512 + ks * 4096 + half * 2048; }
template <int OFF> __device__ __forceinline__ s16x4 tr_read(int vb) {
  s16x4 r; asm volatile("ds_read_b64_tr_b16 %0, %1 offset:%2" : "=&v"(r) : "v"(vb), "i"(OFF) : "memory"); return r;
}
template <int D0> __device__ __forceinline__ void pv_one(f32x16& od, int vb, bf16x8 pa0, bf16x8 pa1, bf16x8 pa2, bf16x8 pa3) {
  const s16x4 l0 = tr_read<v_rd_off(D0, 0, 0)>(vb), h0 = tr_read<v_rd_off(D0, 0, 1)>(vb), l1 = tr_read<v_rd_off(D0, 1, 0)>(vb), h1 = tr_read<v_rd_off(D0, 1, 1)>(vb);
  const s16x4 l2 = tr_read<v_rd_off(D0, 2, 0)>(vb), h2 = tr_read<v_rd_off(D0, 2, 1)>(vb), l3 = tr_read<v_rd_off(D0, 3, 0)>(vb), h3 = tr_read<v_rd_off(D0, 3, 1)>(vb);
  asm volatile("s_waitcnt lgkmcnt(0)" ::: "memory"); SBAR();
#define PK(L, H) (bf16x8){L[0], L[1], L[2], L[3], H[0], H[1], H[2], H[3]}
  od = __builtin_amdgcn_mfma_f32_32x32x16_bf16(pa0, PK(l0, h0), od, 0, 0, 0);
  od = __builtin_amdgcn_mfma_f32_32x32x16_bf16(pa1, PK(l1, h1), od, 0, 0, 0);
  od = __builtin_amdgcn_mfma_f32_32x32x16_bf16(pa2, PK(l2, h2), od, 0, 0, 0);
  od = __builtin_amdgcn_mfma_f32_32x32x16_bf16(pa3, PK(l3, h3), od, 0, 0, 0);
#undef PK
}
__device__ __forceinline__ void pv_d0(f32x16* o, int vb, bf16x8 pa0, bf16x8 pa1, bf16x8 pa2, bf16x8 pa3) {
  pv_one<0>(o[0], vb, pa0, pa1, pa2, pa3); pv_one<1>(o[1], vb, pa0, pa1, pa2, pa3); pv_one<2>(o[2], vb, pa0, pa1, pa2, pa3); pv_one<3>(o[3], vb, pa0, pa1, pa2, pa3);
}
__device__ __forceinline__ void attn_dense_body(const bf16* __restrict__ Qb, const bf16* __restrict__ Kh, const bf16* __restrict__ Vh, bf16* __restrict__ Ob, int seq, char* lds) {
  const int tid = opaque_tid(), wid = tid >> 6, lane = tid & 63, r32 = lane & 31, hi = lane >> 5;
  bf16* V_lds = (bf16*)lds; bf16* K_lds = (bf16*)(lds + 2 * SHM_V);
  float* ws = (float*)(lds + 2 * SHM_V + 2 * SHM_K) + wid * 64; float* li_l = ws; float* al_l = ws + 32;
  float m_reg = -1e30f, l_reg = 0; f32x16 o[4] = {}; bf16x8 qr[8];
  const bf16* Qw = Qb + (long)(wid * QBLK + r32) * LDQ + hi * 8;
#pragma unroll
  for (int d0 = 0; d0 < 8; ++d0) qr[d0] = *reinterpret_cast<const bf16x8*>(Qw + d0 * 16);
  const int sr = tid >> 4, sc = (tid & 15) * 8, vst0 = v_st(sr, sc), vst1 = v_st(32 + sr, sc);
  const int vb0 = (int)(uintptr_t)V_lds + v_rd_base(lane);
  struct { bf16x8 vs0, vs1, ks0, ks1; } sr_[2];
#define SLOAD(i, k0) do { sr_[i].vs0 = *reinterpret_cast<const bf16x8*>(&Vh[(long)((k0) + sr) * LDK + sc]); sr_[i].vs1 = *reinterpret_cast<const bf16x8*>(&Vh[(long)((k0) + 32 + sr) * LDK + sc]); \
    sr_[i].ks0 = *reinterpret_cast<const bf16x8*>(&Kh[(long)((k0) + sr) * LDK + sc]); sr_[i].ks1 = *reinterpret_cast<const bf16x8*>(&Kh[(long)((k0) + 32 + sr) * LDK + sc]); } while (0)
#define SWRITE(b, i) do { *(bf16x8*)((char*)V_lds + (b) * SHM_V + vst0) = sr_[i].vs0;          \
    *(bf16x8*)((char*)V_lds + (b) * SHM_V + vst1) = sr_[i].vs1; int kc = sc * 2;               \
    *(bf16x8*)((char*)K_lds + (b) * SHM_K + KSWZ(sr, kc)) = sr_[i].ks0;                       \
    *(bf16x8*)((char*)K_lds + (b) * SHM_K + KSWZ(32 + sr, kc)) = sr_[i].ks1; } while (0)
#define SWAIT() asm volatile("s_waitcnt vmcnt(4)" ::: "memory")
#define RESC(a) do { if (__any((a) < 1.f)) { if (hi == 0) al_l[r32] = (a); asm volatile("s_waitcnt lgkmcnt(0)" ::: "memory"); \
    for (int d = 0; d < 4; ++d) for (int r = 0; r < 16; ++r) o[d][r] *= al_l[crow(r, hi)]; } } while (0)
  f32x16 pA0, pA1, pB0, pB1; float mnA, mnB, alA, alB; bf16x8 pa0, pa1, pa2, pa3; const int NT = seq / KVBLK;
  constexpr int SE = 0, SO = 1;
  SLOAD(SE, 0); asm volatile("s_waitcnt vmcnt(0)" ::: "memory"); SWRITE(0, SE); __syncthreads();
  qkt(pA0, pA1, K_lds, qr, r32, hi); partialSM(pA0, pA1, m_reg, mnA, alA);
  SLOAD(SO, KVBLK); if (2 < NT) SLOAD(SE, 2 * KVBLK);
  SWAIT(); SWRITE(1, SO); __syncthreads();
  for (int j = 1; j + 1 < NT; j += 2) {
    SBAR(); qkt(pB0, pB1, (bf16*)((char*)K_lds + SHM_K), qr, r32, hi);
    finishSM(pA0, pA1, alA, l_reg, pa0, pa1, pa2, pa3); SBAR();
    SLOAD(SO, (j + 2) * KVBLK); SBAR();
    pv_d0(o, vb0, pa0, pa1, pa2, pa3); partialSM(pB0, pB1, m_reg, mnB, alB);
    __syncthreads(); SWAIT(); SWRITE(0, SE);
    RESC(alB); __syncthreads();
    SBAR(); qkt(pA0, pA1, K_lds, qr, r32, hi);
    finishSM(pB0, pB1, alB, l_reg, pa0, pa1, pa2, pa3); SBAR();
    if (j + 3 < NT) SLOAD(SE, (j + 3) * KVBLK); SBAR();
    pv_d0(o, vb0 + (int)SHM_V, pa0, pa1, pa2, pa3); partialSM(pA0, pA1, m_reg, mnA, alA);
    __syncthreads(); SWAIT(); SWRITE(1, SO);
    RESC(alA); __syncthreads();
  }
  SBAR(); qkt(pB0, pB1, (bf16*)((char*)K_lds + SHM_K), qr, r32, hi);
  finishSM(pA0, pA1, alA, l_reg, pa0, pa1, pa2, pa3); SBAR();
  pv_d0(o, vb0, pa0, pa1, pa2, pa3); partialSM(pB0, pB1, m_reg, mnB, alB);
  __syncthreads(); RESC(alB);
  finishSM(pB0, pB1, alB, l_reg, pa0, pa1, pa2, pa3); SBAR();
  pv_d0(o, vb0 + (int)SHM_V, pa0, pa1, pa2, pa3);
  if (hi == 0) li_l[r32] = l_reg; asm volatile("s_waitcnt lgkmcnt(0)" ::: "memory");
  float rli[16];
#pragma unroll
  for (int r = 0; r < 16; ++r) rli[r] = __builtin_amdgcn_rcpf(li_l[crow(r, hi)]);
  bf16* Ow = Ob + (long)(wid * QBLK) * LDO;
#pragma unroll
  for (int r = 0; r < 16; ++r) { int orow = crow(r, hi);
    for (int d0 = 0; d0 < 4; ++d0) Ow[(long)orow * LDO + d0 * 32 + r32] = (bf16)f2bf(o[d0][r] * rli[r]); }
  __syncthreads();
#undef SLOAD
#undef SWRITE
#undef SWAIT
#undef RESC
}
#undef KSWZ
}
constexpr int NWAVES = 8, NTHREADS = 512;
struct Args { const float* in[36]; float* out; unsigned char* ws; int ph_lo, ph_hi; };
enum InIdx { I_X = 0, I_C, I_CTX, I_CCTX, I_ADAW, I_ADAB, I_N1G, I_N2G, I_WOUT, I_RW, I_RB, I_EW1, I_EB1, I_EW2, I_EB2, I_AWIN, I_AQG, I_AKG,
             I_GWIN, I_GVG, I_GWS, I_GBS, I_HWIN, I_HCW, I_HCB, I_FW1, I_FB1, I_FW2, I_FB2, I_FW3, I_FB3, I_FW4, I_FB4, I_FREQ, I_HD, I_FG };
struct Frame {
    LAS unsigned char* lds; volatile LAS unsigned* MISC; gu32* ctl;
    int tid, lane, wave, G, bx;
    float* out; unsigned char* ws;
};
template <class T> __device__ __forceinline__ T* launder(T* p) { unsigned long long v = (unsigned long long)p; asm volatile("" : "+s"(v)); return (T*)v; }
constexpr int MW_PTRS = 640;
__device__ __forceinline__ const float* pin_load(const Frame& F, int i) {
    const unsigned lo = __builtin_amdgcn_readfirstlane(F.MISC[MW_PTRS + 2 * i]), hi = __builtin_amdgcn_readfirstlane(F.MISC[MW_PTRS + 2 * i + 1]);
    return (const float*)(((unsigned long long)hi << 32) | lo);
}
#define PIN(F, i) pin_load(F, i)
__device__ __forceinline__ Frame phase_frame(const Frame& F0) {
    Frame F = F0; F.tid = opaque_tid(); F.lane = F.tid & 63; F.wave = __builtin_amdgcn_readfirstlane(F.tid >> 6);
    F.ws = launder(F0.ws); F.out = launder(F0.out); F.ctl = (gu32*)(F.ws + WS_CTL); return F;
}
constexpr int PH_PRO0 = 0, PH_PRO1 = 1, PH_L0 = 2, PH_PER_LAYER = 9, PH_FINAL = PH_L0 + NLAYER * PH_PER_LAYER, PH_COUNT = PH_FINAL + 1;
enum LPhase { LP_NORM1 = 0, LP_INPROJ, LP_MIX1, LP_MIX2, LP_MIX3, LP_OUTPROJ, LP_NORM2, LP_MOE1, LP_MOE2 };

template <bool FP8> __device__ __forceinline__ void transpose_item(const float* W, int N, void* WT, int k0, int n0, int drow0, LAS float* scr, int lane) {
    constexpr int K = 1024;
    float v[64];
    const float* src = W + (size_t)k0 * N + n0 + lane;
#pragma unroll
    for (int kk = 0; kk < 64; ++kk) v[kk] = src[(size_t)kk * N];
#pragma unroll
    for (int kk = 0; kk < 64; ++kk) scr[kk * 65 + lane] = v[kk];
    LDS_WAIT(); asm volatile("" ::: "memory");
    if constexpr (!FP8) {
        const int c = lane & 7;
#pragma unroll
        for (int j = 0; j < 8; ++j) { const int n = (lane >> 3) + 8 * j; const LAS float* s = scr + (8 * c) * 65 + n;
            v4u o; o.x = pk2(s[0 * 65], s[1 * 65]); o.y = pk2(s[2 * 65], s[3 * 65]); o.z = pk2(s[4 * 65], s[5 * 65]); o.w = pk2(s[6 * 65], s[7 * 65]);
            *(GAS v4u*)((bf16*)WT + (size_t)(drow0 + n) * K + k0 + 8 * c) = o; }
    } else {
        const int c = lane & 3;
#pragma unroll
        for (int j = 0; j < 4; ++j) { const int n = (lane >> 2) + 16 * j; const LAS float* s = scr + (16 * c) * 65 + n; unsigned w[4];
#pragma unroll
            for (int q = 0; q < 4; ++q) { unsigned x = 0; x = __builtin_amdgcn_cvt_pk_fp8_f32(32.0f * s[(4 * q) * 65], 32.0f * s[(4 * q + 1) * 65], x, false);
                x = __builtin_amdgcn_cvt_pk_fp8_f32(32.0f * s[(4 * q + 2) * 65], 32.0f * s[(4 * q + 3) * 65], x, true); w[q] = x; }
            *(GAS v4u*)((unsigned char*)WT + (size_t)(drow0 + n) * K + k0 + 16 * c) = (v4u){w[0], w[1], w[2], w[3]}; }
    }
    LDS_WAIT(); asm volatile("" ::: "memory");
}
__device__ __forceinline__ void pro0_transposes(Frame& F) {
    LAS float* scr = (LAS float*)(F.lds + F.wave * 16640);
    const int gw = F.bx * NWAVES + F.wave, NGW = F.G * NWAVES;
    constexpr int R0 = 128 * 512, R1 = 128 * 256, R2 = 2 * 384, R3 = 512, R4 = 768, R5 = 4 * 256, NITEMS = R0 + R1 + R2 + R3 + R4 + R5;
    for (int it = gw; it < NITEMS; it += NGW) {
        int r = it;
        if (r < R0) { const int mi = r >> 9, q = r & 511, kb = q >> 5, nb = q & 31, n0 = nb * 64;
            const int d0 = n0 < 1024 ? 256 * (n0 >> 7) + (n0 & 127) : 256 * ((n0 - 1024) >> 7) + 128 + (n0 & 127);
            transpose_item<true>(PIN(F, I_EW1) + (size_t)mi * 1024 * 2048, 2048, F.ws + WS_WE1 + (size_t)mi * 2048 * 1024, kb * 64, n0, d0, scr, F.lane); continue; } r -= R0;
        if (r < R1) { const int mi = r >> 8, q = r & 255, kb = q >> 4, nb = q & 15;
            transpose_item<true>(PIN(F, I_EW2) + (size_t)mi * 1024 * 1024, 1024, F.ws + WS_WE2 + (size_t)mi * 1024 * 1024, kb * 64, nb * 64, nb * 64, scr, F.lane); continue; } r -= R1;
        if (r < R2) { const int mi = r / 384, q = r % 384, kb = q / 24, nb = q % 24;
            transpose_item<false>(PIN(F, I_AWIN) + (size_t)mi * 1024 * 1536, 1536, F.ws + WS_WATT + (size_t)mi * 1536 * 1024 * 2, kb * 64, nb * 64, nb * 64, scr, F.lane); continue; } r -= R2;
        if (r < R3) { const int kb = r >> 5, nb = r & 31;
            transpose_item<false>(PIN(F, I_GWIN), 2048, F.ws + WS_WGM, kb * 64, nb * 64, nb * 64, scr, F.lane); continue; } r -= R3;
        if (r < R4) { const int kb = r / 48, nb = r % 48;
            transpose_item<false>(PIN(F, I_HWIN), 3072, F.ws + WS_WHY, kb * 64, nb * 64, nb * 64, scr, F.lane); continue; } r -= R4;
        { const int mi = r >> 8, q = r & 255, kb = q >> 4, nb = q & 15;
            transpose_item<false>(PIN(F, I_WOUT) + (size_t)mi * 1024 * 1024, 1024, F.ws + WS_WOUT + (size_t)mi * 1024 * 1024 * 2, kb * 64, nb * 64, nb * 64, scr, F.lane); }
    }
}
__device__ __forceinline__ void pro0_mod(Frame& F) {
    LAS float* sl = (LAS float*)F.lds;
    LAS float* red = (LAS float*)(F.lds + 65536);
    __syncthreads();
    for (int i = F.tid; i < 9 * 1024; i += NTHREADS) { const int r = i >> 10, k = i & 1023; const float v = r < 8 ? PIN(F, I_C)[r * 1024 + k] : PIN(F, I_CCTX)[k]; sl[i] = v / (1.0f + __expf(-v)); }
    __syncthreads();
    float* MOD = (float*)(F.ws + WS_MOD);
    for (int item = F.bx; item < NLAYER * 96; item += F.G) {
        const int l = item / 96, n0 = (item % 96) * 64;
        const float* W = PIN(F, I_ADAW) + (size_t)l * 1024 * 6144 + n0 + F.lane;
        float acc[9];
#pragma unroll
        for (int r = 0; r < 9; ++r) acc[r] = 0.f;
        const int kb = F.wave * 128;
#pragma unroll 4
        for (int k = 0; k < 128; ++k) { const float wv = W[(size_t)(kb + k) * 6144];
#pragma unroll
            for (int r = 0; r < 9; ++r) acc[r] += sl[r * 1024 + kb + k] * wv; }
#pragma unroll
        for (int r = 0; r < 9; ++r) red[(F.wave * 9 + r) * 64 + F.lane] = acc[r];
        __syncthreads();
        for (int i = F.tid; i < 9 * 64; i += NTHREADS) { const int r = i >> 6, n = i & 63; float s = 0.f;
#pragma unroll
            for (int w = 0; w < 8; ++w) s += red[(w * 9 + r) * 64 + n];
            MOD[((size_t)l * 9 + r) * 6144 + n0 + n] = s + PIN(F, I_ADAB)[l * 6144 + n0 + n]; }
        __syncthreads();
    }
}
__device__ __forceinline__ void pro0_filter_mlp(Frame& F) {
    const int j = F.lane, gw = F.bx * NWAVES + F.wave, NGW = F.G * NWAVES;
    LAS float* W1 = (LAS float*)F.lds; LAS float* W2 = W1 + FEMB * FH; LAS float* W3 = W2 + FH * FH;
    __syncthreads();
    for (int i = F.tid; i < FEMB * FH; i += NTHREADS) W1[i] = PIN(F, I_FW1)[i];
    for (int i = F.tid; i < FH * FH; i += NTHREADS) { W2[i] = PIN(F, I_FW2)[i]; W3[i] = PIN(F, I_FW3)[i]; }
    __syncthreads();
    const float b1 = PIN(F, I_FB1)[j], b2 = PIN(F, I_FB2)[j], b3 = PIN(F, I_FB3)[j], fr = PIN(F, I_FREQ)[j];
    for (int it = gw; it < SEQ + CL; it += NGW) {
        const bool lat = it < SEQ; const int t = lat ? it : it - SEQ; const float L = lat ? (float)SEQ : (float)CL;
        const float tl = (float)t / (L - 1.0f), w = (6.283185307179586f * (float)t) / L;
        float z;
        { const int band = (j - 1) & 15; const float f = 1e-4f + (float)band * ((15.0f - 1e-4f) / 15.0f); const float a = f * w;
          z = (j == 0) ? tl : (j <= 16 ? cosf(a) : -sinf(a)); }
        float s = b1;
#pragma unroll
        for (int i = 0; i < FEMB; ++i) s += __shfl(z, i) * W1[i * FH + j];
        const float a1 = sinf(fr * s);
        s = b2;
#pragma unroll 16
        for (int i = 0; i < FH; ++i) s += __shfl(a1, i) * W2[i * FH + j];
        const float a2 = sinf(fr * s);
        s = b3;
#pragma unroll 16
        for (int i = 0; i < FH; ++i) s += __shfl(a2, i) * W3[i * FH + j];
        const float a3 = sinf(fr * s);
        float* dst = lat ? (float*)(F.ws + WS_A3) + (size_t)t * FH : (float*)(F.ws + WS_A3C) + (size_t)t * FH;
        dst[j] = a3;
    }
    __syncthreads();
}

__device__ __forceinline__ f32x2 cmul(f32x2 a, f32x2 b) { return (f32x2){a.x * b.x - a.y * b.y, a.x * b.y + a.y * b.x}; }
__device__ __forceinline__ f32x2 cconj(f32x2 a) { return (f32x2){a.x, -a.y}; }
__device__ __forceinline__ void fft16k_dif(LAS f32x2* z, int tid) {
#pragma unroll 1
    for (int lq = 12; lq >= 0; lq -= 2) {
        const int q = 1 << lq; const float inv_lb = 1.0f / (float)(4 * q);
#pragma unroll 2
        for (int bf = tid; bf < 4096; bf += NTHREADS) {
            const int j = bf & (q - 1), base = ((bf >> lq) << (lq + 2)) + j;
            const f32x2 x0 = z[base], x1 = z[base + q], x2 = z[base + 2 * q], x3 = z[base + 3 * q];
            const f32x2 t0 = x0 + x2, t1 = x0 - x2, t2 = x1 + x3, d = x1 - x3, t3 = (f32x2){d.y, -d.x};
            const f32x2 y0 = t0 + t2, y2 = t0 - t2, y1 = t1 + t3, y3 = t1 - t3;
            const float fr = (float)j * inv_lb;
            const f32x2 w1 = (f32x2){__builtin_amdgcn_cosf(fr), -__builtin_amdgcn_sinf(fr)}, w2 = cmul(w1, w1), w3 = cmul(w1, w2);
            z[base] = y0; z[base + q] = cmul(y2, w2); z[base + 2 * q] = cmul(y1, w1); z[base + 3 * q] = cmul(y3, w3);
        }
        __syncthreads();
    }
}
__device__ __forceinline__ void fft16k_dit_inv(LAS f32x2* z, int tid) {
#pragma unroll 1
    for (int lq = 0; lq <= 12; lq += 2) {
        const int q = 1 << lq; const float inv_lb = 1.0f / (float)(4 * q);
#pragma unroll 2
        for (int bf = tid; bf < 4096; bf += NTHREADS) {
            const int j = bf & (q - 1), base = ((bf >> lq) << (lq + 2)) + j;
            const float fr = (float)j * inv_lb;
            const f32x2 w1 = (f32x2){__builtin_amdgcn_cosf(fr), __builtin_amdgcn_sinf(fr)}, w2 = cmul(w1, w1), w3 = cmul(w1, w2);
            const f32x2 A0 = z[base], A1 = cmul(z[base + q], w2), A2 = cmul(z[base + 2 * q], w1), A3 = cmul(z[base + 3 * q], w3);
            const f32x2 u0 = A0 + A1, u1 = A0 - A1, u2 = A2 + A3, u3 = A2 - A3, iu3 = (f32x2){-u3.y, u3.x};
            z[base] = u0 + u2; z[base + q] = u1 + iu3; z[base + 2 * q] = u0 - u2; z[base + 3 * q] = u1 - iu3;
        }
        __syncthreads();
    }
}
__device__ __forceinline__ int rev14(int p) { return (int)(__brev((unsigned)p) >> 18); }
__device__ __forceinline__ float hy_delta(int c) { const float mn = -3.0701134573253945f, mx = -15.350567286626973f; return fabsf(mn + (mx - mn) * ((float)c / 1023.0f)); }

__device__ __forceinline__ void pro1_filters(Frame& F) {
    { const int gw = F.bx * NWAVES + F.wave;
      if (gw < NLAYER * 9) { const int l = gw / 9, e = F.lane & 31, hf = F.lane >> 5; const float* sh = (const float*)(F.ws + WS_MOD) + (size_t)gw * 6144 + 3 * 1024; const float* rw = PIN(F, I_RW) + (size_t)l * D * NE;
          float acc = 0.f; for (int k = hf * 512; k < hf * 512 + 512; ++k) acc += sh[k] * rw[(size_t)k * NE + e];
          acc += __shfl_xor(acc, 32); if (F.lane < 32) ((float*)(F.ws + WS_RC))[gw * NE + e] = acc + PIN(F, I_RB)[l * NE + e]; } }
    LAS f32x2* z = (LAS f32x2*)F.lds;
    LAS float* wl = (LAS float*)(F.lds + AUX_OFF);
    const float* a3 = (const float*)(F.ws + WS_A3); const float* a3c = (const float*)(F.ws + WS_A3C);
    f32x2* KF = (f32x2*)(F.ws + WS_KF); float* FCT = (float*)(F.ws + WS_FCT);
    for (int u = F.bx; u < 512; u += F.G) {
        const int ca = 2 * u, cb = 2 * u + 1;
        __syncthreads();
        if (F.tid < 256) { const int which = F.tid >> 6, m = F.tid & 63; const int col = (which & 1 ? cb : ca) + (which >> 1) * 1024; wl[which * 64 + m] = PIN(F, I_FW4)[m * 2048 + col]; }
        if (F.tid < 4) { const int col = (F.tid & 1 ? cb : ca) + (F.tid >> 1) * 1024; wl[256 + F.tid] = PIN(F, I_FB4)[col]; }
        __syncthreads();
        const float da = hy_delta(ca), db = hy_delta(cb);
        for (int t = F.tid; t < SEQ; t += NTHREADS) {
            const f32x4* ar = (const f32x4*)(a3 + (size_t)t * FH); float s0 = wl[256], s1 = wl[257], s2 = wl[258], s3 = wl[259];
#pragma unroll 4
            for (int m4 = 0; m4 < 16; ++m4) { const f32x4 a = ar[m4];
#pragma unroll
                for (int i = 0; i < 4; ++i) { const int m = m4 * 4 + i; s0 += a[i] * wl[m]; s1 += a[i] * wl[64 + m]; s2 += a[i] * wl[128 + m]; s3 += a[i] * wl[192 + m]; } }
            const float tl = (float)t / (float)(SEQ - 1); const float wa = __expf(-tl * da), wb = __expf(-tl * db);
            z[t] = (f32x2){s0 * wa, s1 * wb};
            if (t == 0) z[SEQ] = (f32x2){0.f, 0.f}; else z[NFFT - t] = (f32x2){s2 * wa, s3 * wb};
        }
        for (int i = F.tid; i < 511; i += NTHREADS) {
            const int d = i - 255, t = d < 0 ? -d : d; const int o = d < 0 ? 2 : 0;
            const float* ar = a3c + (size_t)t * FH; float sa = wl[256 + o], sb = wl[257 + o];
            for (int m = 0; m < FH; ++m) { const float a = ar[m]; sa += a * wl[o * 64 + m]; sb += a * wl[(o + 1) * 64 + m]; }
            const float tl = (float)t / (float)(CL - 1);
            FCT[(size_t)ca * 512 + d + 256] = sa * __expf(-tl * da); FCT[(size_t)cb * 512 + d + 256] = sb * __expf(-tl * db);
        }
        __syncthreads();
        fft16k_dif(z, F.tid);
        for (int p = F.tid; p < NFFT; p += NTHREADS) {
            const int k = rev14(p), p2 = rev14((NFFT - k) & (NFFT - 1));
            if (p <= p2) { const f32x2 a = z[p], b = z[p2];
                const f32x2 Ka = (f32x2){0.5f * (a.x + b.x), 0.5f * (a.y - b.y)};
                const f32x2 Kb = (f32x2){0.5f * (a.y + b.y), -0.5f * (a.x - b.x)};
                KF[(size_t)ca * NFFT + p] = Ka; KF[(size_t)cb * NFFT + p] = Kb; KF[(size_t)ca * NFFT + p2] = cconj(Ka); KF[(size_t)cb * NFFT + p2] = cconj(Kb); }
        }
    }
    __syncthreads();
}

__device__ __forceinline__ void hyena_conv_phase(Frame& F) {
    LAS f32x2* z = (LAS f32x2*)F.lds;
    LAS float* aux = (LAS float*)(F.lds + AUX_OFF);
    const float* VT = (const float*)(F.ws + WS_VT); const float* VTC = (const float*)(F.ws + WS_VTC); float* CT = (float*)(F.ws + WS_CT); float* CTC = (float*)(F.ws + WS_CTC);
    const f32x2* KF = (const f32x2*)(F.ws + WS_KF); const float* FCT = (const float*)(F.ws + WS_FCT);
    for (int u = F.bx; u < NB * 512; u += F.G) {
        const int b = u >> 9, cp = u & 511, ca = 2 * cp, cb = ca + 1;
        const float* va = VT + ((size_t)b * 1024 + ca) * SEQ; const float* vb = va + SEQ; float* oa = CT + ((size_t)b * 1024 + ca) * SEQ; float* ob = oa + SEQ;
        __syncthreads();
        for (int n = F.tid; n < SEQ; n += NTHREADS) { z[n] = (f32x2){va[n], vb[n]}; z[SEQ + n] = (f32x2){0.f, 0.f}; }
        { const int h = F.tid >> 8, t = F.tid & 255; const float* vc = VTC + ((size_t)b * 1024 + ca + h) * CL;
          aux[h * 256 + t] = vc[t]; aux[512 + h * 512 + t] = FCT[(size_t)(ca + h) * 512 + t]; aux[512 + h * 512 + 256 + t] = FCT[(size_t)(ca + h) * 512 + 256 + t];
          __syncthreads();
          float y = 0.f;
#pragma unroll 8
          for (int s = 0; s < CL; ++s) y += aux[h * 256 + s] * aux[512 + h * 512 + (t - s) + 256];
          CTC[((size_t)b * 1024 + ca + h) * CL + t] = y; }
        fft16k_dif(z, F.tid);
        const f32x2* Ka = KF + (size_t)ca * NFFT; const f32x2* Kb = KF + (size_t)cb * NFFT;
        for (int p = F.tid; p < NFFT; p += NTHREADS) {
            const int k = rev14(p), p2 = rev14((NFFT - k) & (NFFT - 1));
            if (p <= p2) { const f32x2 a = z[p], b2 = z[p2];
                const f32x2 Va = (f32x2){0.5f * (a.x + b2.x), 0.5f * (a.y - b2.y)}, Vb = (f32x2){0.5f * (a.y + b2.y), -0.5f * (a.x - b2.x)};
                const f32x2 ya = cmul(Va, Ka[p]), yb = cmul(Vb, Kb[p]);
                z[p] = (f32x2){ya.x - yb.y, ya.y + yb.x};
                z[p2] = (f32x2){ya.x + yb.y, -ya.y + yb.x}; }
        }
        __syncthreads();
        fft16k_dit_inv(z, F.tid);
        const float sc = 1.0f / (float)NFFT;
        for (int n = F.tid; n < SEQ; n += NTHREADS) { const f32x2 w = z[n]; oa[n] = w.x * sc; ob[n] = w.y * sc; }
    }
    __syncthreads();
}
constexpr int MW_CUMBLK = 16, MW_CNT = 64, MW_SELE = 128, MW_SELV = 256, MW_LRANK = 384, MW_LBASE = 512;
__device__ __forceinline__ void moe_tables(Frame& F, int layer) {
    __syncthreads();
    if (F.tid < NE) F.MISC[MW_CNT + F.tid] = __hip_atomic_load(F.ctl + CW_CNT + layer * NE + F.tid, RLX_AGENT);
    __syncthreads();
    if (F.tid == 0) { unsigned c = 0; for (int e = 0; e < NE; ++e) { F.MISC[MW_CUMBLK + e] = c; c += (F.MISC[MW_CNT + e] + 255u) >> 8; } F.MISC[MW_CUMBLK + NE] = c; }
    __syncthreads();
}

template <int MODE> __device__ __forceinline__ void rowpass(Frame& F, int layer, bool real = true) {
    const bool combine = (MODE == 0 && layer > 0) || MODE == 2;
    const int nrows = MODE == 2 ? ML : MT;
    const int cl = MODE == 2 ? NLAYER - 1 : layer - 1;
    const bool from_input = (MODE == 0 && layer == 0);
    const float* XLs = from_input ? PIN(F, I_X) : F.out; const float* XCs = from_input ? PIN(F, I_CTX) : (const float*)(F.ws + WS_XC);
    float* XLd = real ? F.out : (float*)(F.ws + WS_P); float* XCd = real ? (float*)(F.ws + WS_XC) : (float*)(F.ws + WS_P) + (size_t)ML * D;
    const float* MOD = (const float*)(F.ws + WS_MOD);
    bf16* H = (bf16*)(F.ws + WS_H); const bf16* YM = (const bf16*)(F.ws + WS_YM);
    const int* TE = (const int*)(F.ws + WS_TE); const int* TR = (const int*)(F.ws + WS_TR); const float* TG = (const float*)(F.ws + WS_TG);
    const float* gnorm = MODE == 0 ? PIN(F, I_N1G) + layer * D : PIN(F, I_FG);
    if (combine) moe_tables(F, cl);
    f32x4 gn[4];
#pragma unroll
    for (int j = 0; j < 4; ++j) gn[j] = ((const f32x4*)gnorm)[F.lane + 64 * j];
    const int ntiles = nrows / 32;
    for (int tile = F.bx; tile < ntiles; tile += F.G) {
        const int rbase = tile * 32 + F.wave * 4; const bool lat = rbase < ML; const int bidx = lat ? (rbase >> 13) : 8;
        const float* g2 = MOD + ((size_t)(combine ? cl : 0) * 9 + bidx) * 6144 + 5 * 1024;
        const float* mb = MOD + ((size_t)layer * 9 + bidx) * 6144;
#pragma unroll 1
        for (int pr = 0; pr < 2; ++pr) {
            size_t xo[2]; f32x4 v[2][4]; int rowid[2][4]; float gk[2][4];
#pragma unroll
            for (int u = 0; u < 2; ++u) { const int r = rbase + 2 * pr + u; xo[u] = lat ? (size_t)r * D : (size_t)(r - ML) * D;
                if (combine) { const i32x4 te = *(const i32x4*)(TE + (size_t)r * 4), tr = *(const i32x4*)(TR + (size_t)r * 4); const f32x4 tg = *(const f32x4*)(TG + (size_t)r * 4);
#pragma unroll
                    for (int k = 0; k < 4; ++k) { rowid[u][k] = 256 * (int)F.MISC[MW_CUMBLK + te[k]] + tr[k]; gk[u][k] = tg[k]; } }
                const f32x4* xs = (const f32x4*)((lat ? XLs : XCs) + xo[u]);
#pragma unroll
                for (int j = 0; j < 4; ++j) v[u][j] = xs[F.lane + 64 * j]; }
            if (combine) {
                v2u w[2][4][4];
#pragma unroll
                for (int u = 0; u < 2; ++u)
#pragma unroll
                    for (int k = 0; k < 4; ++k) { const v2u* yr = (const v2u*)(YM + (size_t)rowid[u][k] * D);
#pragma unroll
                        for (int j = 0; j < 4; ++j) w[u][k][j] = yr[F.lane + 64 * j]; }
#pragma unroll
                for (int u = 0; u < 2; ++u) {
#pragma unroll
                    for (int j = 0; j < 4; ++j) { f32x4 a = (f32x4){0.f, 0.f, 0.f, 0.f};
#pragma unroll
                        for (int k = 0; k < 4; ++k) a += gk[u][k] * (f32x4){bflo(w[u][k][j].x), bfhi(w[u][k][j].x), bflo(w[u][k][j].y), bfhi(w[u][k][j].y)};
                        v[u][j] += ((const f32x4*)g2)[F.lane + 64 * j] * a; }
                    if (MODE == 0) { f32x4* xd = (f32x4*)((lat ? XLd : XCd) + xo[u]);
#pragma unroll
                        for (int j = 0; j < 4; ++j) xd[F.lane + 64 * j] = v[u][j]; } }
            }
#pragma unroll
            for (int u = 0; u < 2; ++u) { const int r = rbase + 2 * pr + u;
                float ss = 0.f;
#pragma unroll
                for (int j = 0; j < 4; ++j) ss += (v[u][j].x * v[u][j].x + v[u][j].y * v[u][j].y) + (v[u][j].z * v[u][j].z + v[u][j].w * v[u][j].w);
                const float rstd = 1.0f / sqrtf(wave_sum(ss) * (1.0f / D) + EPS);
                if (MODE == 2) { f32x4* od = (f32x4*)(XLd + xo[u]);
#pragma unroll
                    for (int j = 0; j < 4; ++j) od[F.lane + 64 * j] = v[u][j] * rstd * gn[j]; }
                else { v2u* hd = (v2u*)(H + (size_t)r * D);
#pragma unroll
                    for (int j = 0; j < 4; ++j) { const f32x4 sh = ((const f32x4*)mb)[F.lane + 64 * j], sc = ((const f32x4*)(mb + 1024))[F.lane + 64 * j]; const f32x4 hv = v[u][j] * rstd * gn[j] * (sc + 1.0f) + sh;
                        v2u o; o.x = cvt_pk_bf16(hv.x, hv.y); o.y = cvt_pk_bf16(hv.z, hv.w); hd[F.lane + 64 * j] = o; } }
            }
        }
    }
}

typedef float f32x16r __attribute__((ext_vector_type(16)));
__device__ __forceinline__ void router_phase(Frame& F, int layer, bool real = true) {
    const bool last = layer == NLAYER - 1;
    const int ntiles = (last ? ML : MT) / 32;
    LAS float* PART = (LAS float*)F.lds;
    LAS float* SSQ = PART + 8 * 32 * 33;
    LAS float* LG = SSQ + 8 * 32;
    LAS float* RSTD = LG + 32 * 33;
    LAS unsigned* CW = (LAS unsigned*)(RSTD + 32);
    LAS unsigned* RUN = CW + 64;
    LAS float* AV = (LAS float*)(RUN + 32);
    LAS float* SHV = AV + 1024;
    const float* XL = F.out; const float* XC = (const float*)(F.ws + WS_XC);
    const float* MOD = (const float*)(F.ws + WS_MOD); const float* RC = (const float*)(F.ws + WS_RC);
    unsigned char* H8 = (unsigned char*)(F.ws + WS_H8);
    int* TE = (int*)(F.ws + WS_TE); int* TR = (int*)(F.ws + WS_TR); float* TG = (float*)(F.ws + WS_TG); int* ROWTOK = (int*)(F.ws + WS_ROWTOK);
    const float* gn = PIN(F, I_N2G) + layer * D; const float* rw = PIN(F, I_RW) + (size_t)layer * D * NE;
    const int i = F.lane & 31, hf = F.lane >> 5, kb = F.wave * 128 + 64 * hf;
    const int per = 2048 / F.G;
    const int nmine = (2048 % F.G == 0) ? per + ((2048 + F.bx < ntiles) ? 1 : 0) : 0;
#define RT_TILE(n_) ((2048 % F.G == 0) ? ((n_) < per ? F.bx * per + (n_) : 2048 + F.bx) : F.bx + (n_) * F.G)
    const int ncnt = (2048 % F.G == 0) ? nmine : (F.bx < ntiles ? (ntiles - 1 - F.bx) / F.G + 1 : 0);
    __syncthreads();
    if (F.tid < NE) RUN[F.tid] = 0u;
    float bv[64];
    { const float* rwp = rw + (size_t)kb * NE + i;
#pragma unroll
      for (int s = 0; s < 64; ++s) bv[s] = rwp[(size_t)s * NE]; }
    float xs[64];
#define RT_LOADX(tile_) do { const int r_ = (tile_) * 32 + i; const float* xr_ = (r_ < ML ? XL + (size_t)r_ * D : XC + (size_t)(r_ - ML) * D) + kb; \
        _Pragma("unroll") for (int q = 0; q < 16; ++q) { const f32x4 v = ((const f32x4*)xr_)[q]; xs[4 * q] = v.x; xs[4 * q + 1] = v.y; xs[4 * q + 2] = v.z; xs[4 * q + 3] = v.w; } } while (0)
    if (ncnt > 0) RT_LOADX(RT_TILE(0));
    int cur_b = -1;
    for (int n = 0; n < ncnt; ++n) {
        const int tile = RT_TILE(n);
        const int r0 = tile * 32; const bool lat = r0 < ML; const int bidx = lat ? (r0 >> 13) : 8; const int r = r0 + i;
        if (bidx != cur_b) {
            cur_b = bidx; const float* mb = MOD + ((size_t)layer * 9 + bidx) * 6144 + 3 * 1024;
            __syncthreads();
            for (int k = F.tid; k < 1024; k += NTHREADS) { AV[k] = gn[k] * (1.0f + mb[1024 + k]); SHV[k] = mb[k]; }
            __syncthreads();
        }
        float ssq = 0.f;
#pragma unroll
        for (int s = 0; s < 64; ++s) ssq += xs[s] * xs[s];
        ssq += __shfl_xor(ssq, 32);
        if (hf == 0) SSQ[F.wave * 32 + i] = ssq;
#pragma unroll
        for (int q = 0; q < 16; ++q) { const f32x4 a = ((const LAS f32x4*)(AV + kb))[q]; xs[4 * q] *= a.x; xs[4 * q + 1] *= a.y; xs[4 * q + 2] *= a.z; xs[4 * q + 3] *= a.w; }
        f32x16r acc = {};
#pragma unroll
        for (int s = 0; s < 64; ++s) acc = __builtin_amdgcn_mfma_f32_32x32x2f32(xs[s], bv[s], acc, 0, 0, 0);
#pragma unroll
        for (int rg = 0; rg < 16; ++rg) PART[(F.wave * 32 + ((rg & 3) + 8 * (rg >> 2) + 4 * hf)) * 33 + i] = acc[rg];
        __syncthreads();
        { const int tk = F.tid >> 4, e0 = (F.tid & 15) * 2; float q = 0.f, s0 = 0.f, s1 = 0.f;
#pragma unroll
          for (int w = 0; w < 8; ++w) { q += SSQ[w * 32 + tk]; s0 += PART[(w * 32 + tk) * 33 + e0]; s1 += PART[(w * 32 + tk) * 33 + e0 + 1]; }
          const float rstd = 1.0f / sqrtf(q * (1.0f / D) + EPS); const float* rc = RC + ((size_t)layer * 9 + bidx) * NE;
          LG[tk * 33 + e0] = rstd * s0 + rc[e0]; LG[tk * 33 + e0 + 1] = rstd * s1 + rc[e0 + 1]; if ((F.tid & 15) == 0) RSTD[tk] = rstd; }
        __syncthreads();
        { const float rstd = RSTD[i]; unsigned w8[16];
#pragma unroll
          for (int q = 0; q < 16; ++q) { const f32x4 sh = ((const LAS f32x4*)(SHV + kb))[q]; unsigned w = 0;
              w = __builtin_amdgcn_cvt_pk_fp8_f32(xs[4 * q] * rstd + sh.x, xs[4 * q + 1] * rstd + sh.y, w, false);
              w = __builtin_amdgcn_cvt_pk_fp8_f32(xs[4 * q + 2] * rstd + sh.z, xs[4 * q + 3] * rstd + sh.w, w, true); w8[q] = w; }
          v4u* hd = (v4u*)(H8 + (size_t)r * D + kb);
#pragma unroll
          for (int q = 0; q < 4; ++q) hd[q] = (v4u){w8[4 * q], w8[4 * q + 1], w8[4 * q + 2], w8[4 * q + 3]}; }
        if (n + 1 < ncnt) RT_LOADX(RT_TILE(n + 1));
#pragma unroll 1
        for (int rr = 0; rr < 4; ++rr) {
            const int slot = F.wave * 4 + rr, e = i; const float logit = LG[slot * 33 + e]; int rank = 0;
#pragma unroll
            for (int j = 0; j < NE; ++j) { const float o = __shfl(logit, j); rank += (o > logit || (o == logit && j < e)) ? 1 : 0; }
            if (F.lane < 32 && rank < 4) { F.MISC[MW_SELE + slot * 4 + rank] = (unsigned)e; F.MISC[MW_SELV + slot * 4 + rank] = __float_as_uint(logit); }
            LDS_WAIT(); asm volatile("" ::: "memory");
            { const int k = F.lane & 3; const float vk = __uint_as_float(F.MISC[MW_SELV + slot * 4 + k]); const float v0 = __shfl(vk, 0);
              float ex = __expf(vk - v0); float sm = ex; sm += __shfl_xor(sm, 1); sm += __shfl_xor(sm, 2);
              if (F.lane < 4) { const size_t tok = (size_t)r0 + slot; TG[tok * 4 + k] = ex / sm; TE[tok * 4 + k] = (int)F.MISC[MW_SELE + slot * 4 + k]; } }
        }
        __syncthreads();
        int my = 0, lr = 0;
        if (F.wave < 2) { my = (int)F.MISC[MW_SELE + F.tid]; unsigned cm = 0;
#pragma unroll
            for (int e = 0; e < NE; ++e) { const unsigned long long m = __ballot(my == e); const unsigned pc = (unsigned)__popcll(m);
                if (my == e) lr = (int)__builtin_amdgcn_mbcnt_hi((unsigned)(m >> 32), __builtin_amdgcn_mbcnt_lo((unsigned)m, 0u)); if (F.lane == e) cm = pc; }
            if (F.lane < NE) CW[F.wave * 32 + F.lane] = cm; }
        __syncthreads();
        if (F.wave < 2) { const int a = F.tid; const int brank = (int)RUN[my] + lr + (F.wave == 1 ? (int)CW[my] : 0); TR[((size_t)r0 + (a >> 2)) * 4 + (a & 3)] = brank; }
        __syncthreads();
        if (F.tid < NE) RUN[F.tid] += CW[F.tid] + CW[32 + F.tid];
    }
    VM_WAIT(); __syncthreads();
    if (F.tid < NE) { const unsigned cnt = RUN[F.tid]; unsigned base = 0;
        if (cnt) base = __hip_atomic_fetch_add(F.ctl + CW_CNT + (real ? layer : NLAYER) * NE + F.tid, cnt, RLX_AGENT);
        F.MISC[MW_LBASE + F.tid] = base; }
    __syncthreads();
    if (real) for (int n = 0; n < ncnt; ++n) { const int r0 = RT_TILE(n) * 32;
        if (F.tid < 128) { const size_t idx = ((size_t)r0 + (F.tid >> 2)) * 4 + (F.tid & 3); const int e = TE[idx]; const int rank = TR[idx] + (int)F.MISC[MW_LBASE + e]; TR[idx] = rank; ROWTOK[(size_t)e * MT + rank] = r0 + (F.tid >> 2); } }
    __syncthreads();
#undef RT_LOADX
#undef RT_TILE
}

__device__ __forceinline__ void normrope16(float (&x)[16], const float* gain, bool lat, int prow, int pcol, const LAS f32x2* T, int L) {
    float ss = 0.f;
#pragma unroll
    for (int i = 0; i < 16; ++i) ss += x[i] * x[i];
    ss += __shfl_xor(ss, 1); ss += __shfl_xor(ss, 2); ss += __shfl_xor(ss, 4);
    const float rstd = 1.0f / sqrtf(ss * (1.0f / 128.0f) + EPS);
    const int o = (L & 7) * 16;
#pragma unroll
    for (int i = 0; i < 16; ++i) x[i] = x[i] * rstd * gain[o + i];
    float p[16];
#pragma unroll
    for (int i = 0; i < 16; ++i) p[i] = __shfl_xor(x[i], 2);
    if (lat) {
        const int pos = (L & 4) ? pcol : prow; const float sgn = (L & 2) ? 1.0f : -1.0f; const LAS f32x2* t = T + pos * 32 + (L & 1) * 16;
#pragma unroll
        for (int i = 0; i < 16; ++i) { const f32x2 cs = t[i]; x[i] = x[i] * cs.x + sgn * p[i] * cs.y; }
    }
}
__device__ __forceinline__ void qkprep_phase(Frame& F, int j) {
    LAS f32x2* T = (LAS f32x2*)F.lds;
    __syncthreads();
    for (int i = F.tid; i < 128 * 32; i += NTHREADS) { const int pos = i >> 5, f = i & 31; const float inv = powf(10000.0f, -(float)f / 32.0f); const float ang = (float)pos * inv; float s, c; sincosf(ang, &s, &c); T[i] = (f32x2){c, s}; }
    __syncthreads();
    const bf16* P = (const bf16*)(F.ws + WS_P); bf16* QB = (bf16*)(F.ws + WS_QB); bf16* KVB = (bf16*)(F.ws + WS_KVB);
    const float* qg = PIN(F, I_AQG) + j * 128; const float* kg = PIN(F, I_AKG) + j * 128;
    const int gw = F.bx * NWAVES + F.wave, NGW = F.G * NWAVES, L = F.lane;
    for (int r = gw; r < MT; r += NGW) {
        const bool lat = r < ML; const int b = lat ? (r >> 13) : ((r - ML) >> 8); const int s = lat ? (r & (SEQ - 1)) : ((r - ML) & (CL - 1));
        const int prow = s >> 6, pcol = s & 63; const size_t kvrow = (size_t)b * SKV + (lat ? s : SEQ + s);
        const bf16* pr = P + (size_t)r * 1536;
        { const v4u a = *(const v4u*)(pr + 16 * L), c = *(const v4u*)(pr + 16 * L + 8); float x[16];
          x[0] = bflo(a.x); x[1] = bfhi(a.x); x[2] = bflo(a.y); x[3] = bfhi(a.y); x[4] = bflo(a.z); x[5] = bfhi(a.z); x[6] = bflo(a.w); x[7] = bfhi(a.w);
          x[8] = bflo(c.x); x[9] = bfhi(c.x); x[10] = bflo(c.y); x[11] = bfhi(c.y); x[12] = bflo(c.z); x[13] = bfhi(c.z); x[14] = bflo(c.w); x[15] = bfhi(c.w);
          normrope16(x, qg, lat, prow, pcol, T, L);
          v4u o0, o1; o0.x = cvt_pk_bf16(x[0], x[1]); o0.y = cvt_pk_bf16(x[2], x[3]); o0.z = cvt_pk_bf16(x[4], x[5]); o0.w = cvt_pk_bf16(x[6], x[7]);
          o1.x = cvt_pk_bf16(x[8], x[9]); o1.y = cvt_pk_bf16(x[10], x[11]); o1.z = cvt_pk_bf16(x[12], x[13]); o1.w = cvt_pk_bf16(x[14], x[15]);
          *(v4u*)(QB + (size_t)r * D + 16 * L) = o0; *(v4u*)(QB + (size_t)r * D + 16 * L + 8) = o1; }
        { const int Lk = L & 15; const v4u a = *(const v4u*)(pr + 1024 + 16 * Lk), c = *(const v4u*)(pr + 1024 + 16 * Lk + 8); float x[16];
          x[0] = bflo(a.x); x[1] = bfhi(a.x); x[2] = bflo(a.y); x[3] = bfhi(a.y); x[4] = bflo(a.z); x[5] = bfhi(a.z); x[6] = bflo(a.w); x[7] = bfhi(a.w);
          x[8] = bflo(c.x); x[9] = bfhi(c.x); x[10] = bflo(c.y); x[11] = bfhi(c.y); x[12] = bflo(c.z); x[13] = bfhi(c.z); x[14] = bflo(c.w); x[15] = bfhi(c.w);
          normrope16(x, kg, lat, prow, pcol, T, Lk);
          if (L < 16) { v4u o0, o1; o0.x = cvt_pk_bf16(x[0], x[1]); o0.y = cvt_pk_bf16(x[2], x[3]); o0.z = cvt_pk_bf16(x[4], x[5]); o0.w = cvt_pk_bf16(x[6], x[7]);
            o1.x = cvt_pk_bf16(x[8], x[9]); o1.y = cvt_pk_bf16(x[10], x[11]); o1.z = cvt_pk_bf16(x[12], x[13]); o1.w = cvt_pk_bf16(x[14], x[15]);
            *(v4u*)(KVB + kvrow * 512 + 16 * L) = o0; *(v4u*)(KVB + kvrow * 512 + 16 * L + 8) = o1; }
          else if (L < 48) { const int q = L - 16; *(v4u*)(KVB + kvrow * 512 + 256 + 8 * q) = *(const v4u*)(pr + 1280 + 8 * q); } }
    }
}
__device__ __forceinline__ void attention_phase(Frame& F, char* lds_generic, bool ctx_queries) {
    const bf16* QB = (const bf16*)(F.ws + WS_QB); const bf16* KVB = (const bf16*)(F.ws + WS_KVB); bf16* Y = (bf16*)(F.ws + WS_Y);
    const int nunits = 2048 + (ctx_queries ? 64 : 0);
    for (int u = F.bx; u < nunits; u += F.G) {
        if (u < 2048) { const int b = u >> 8, w = u & 255, h = w & 7, qb = w >> 3; const size_t qo = ((size_t)b * SEQ + (size_t)qb * 256) * D + h * 128; const bf16* kh = KVB + (size_t)b * SKV * 512 + (h >> 2) * 128;
            att::attn_dense_body(QB + qo, kh, kh + 256, Y + qo, SKV, lds_generic); }
        else { const int w = u - 2048, b = w >> 3, h = w & 7; const size_t qo = ((size_t)ML + (size_t)b * CL) * D + h * 128; const bf16* kh = KVB + ((size_t)b * SKV + SEQ) * 512 + (h >> 2) * 128;
            att::attn_dense_body(QB + qo, kh, kh + 256, Y + qo, CL, lds_generic); }
    }
}

__device__ __forceinline__ void gmlp_mix_phase(Frame& F) {
    constexpr int LDA = 136, LDO = 132;
    LAS bf16* As = (LAS bf16*)F.lds;
    LAS bf16* Vt = (LAS bf16*)(F.lds + 128 * LDA * 2);
    LAS float* rs = (LAS float*)(F.lds + 2 * 128 * LDA * 2);
    LAS float* Ot = (LAS float*)(F.lds + 2 * 128 * LDA * 2 + 512);
    const bf16* P = (const bf16*)(F.ws + WS_P); bf16* Y = (bf16*)(F.ws + WS_Y); const float* SS = (const float*)(F.ws + WS_SS);
    const float* ws = PIN(F, I_GWS); const float* bs = PIN(F, I_GBS); const float* vg = PIN(F, I_GVG);
    const int r32 = F.lane & 31, hi = F.lane >> 5;
    for (int u = F.bx; u < (MT / 128) * 8; u += F.G) {
        const int chunk = u >> 3, g = u & 7; const size_t row0 = (size_t)chunk * 128;
        __syncthreads();
        if (F.tid < 128) { const f32x4* sp = (const f32x4*)(SS + (row0 + F.tid) * 16); const f32x4 a = sp[0], b = sp[1], c = sp[2], d = sp[3];
            const float s = ((a.x + a.y) + (a.z + a.w)) + ((b.x + b.y) + (b.z + b.w)) + ((c.x + c.y) + (c.z + c.w)) + ((d.x + d.y) + (d.z + d.w)); rs[F.tid] = 1.0f / sqrtf(s * (1.0f / 1024.0f) + EPS); }
        __syncthreads();
        for (int i = F.tid; i < 128 * 32; i += NTHREADS) { const int p = i >> 5, q4 = (i & 31) * 4; const f32x4 w = *(const f32x4*)(ws + ((size_t)g * 128 + p) * 128 + q4);
            v2u o; o.x = pk2(w.x * rs[q4], w.y * rs[q4 + 1]); o.y = pk2(w.z * rs[q4 + 2], w.w * rs[q4 + 3]); *(LAS v2u*)(As + p * LDA + q4) = o; }
        for (int i = F.tid; i < 128 * 16; i += NTHREADS) { const int q = i >> 4, c8 = (i & 15) * 8; const v4u w = *(const v4u*)(P + (row0 + q) * 2048 + 1024 + g * 128 + c8);
            Vt[(c8 + 0) * LDA + q] = (bf16)(w.x & 0xffff); Vt[(c8 + 1) * LDA + q] = (bf16)(w.x >> 16); Vt[(c8 + 2) * LDA + q] = (bf16)(w.y & 0xffff); Vt[(c8 + 3) * LDA + q] = (bf16)(w.y >> 16);
            Vt[(c8 + 4) * LDA + q] = (bf16)(w.z & 0xffff); Vt[(c8 + 5) * LDA + q] = (bf16)(w.z >> 16); Vt[(c8 + 6) * LDA + q] = (bf16)(w.w & 0xffff); Vt[(c8 + 7) * LDA + q] = (bf16)(w.w >> 16); }
        __syncthreads();
        const int p0 = (F.wave >> 1) * 32, cbase = (F.wave & 1) * 64;
        f32x16 acc0 = {}, acc1 = {};
#pragma unroll
        for (int ks = 0; ks < 8; ++ks) { const int k0 = ks * 16 + hi * 8;
            const bf16x8 a = *(const LAS bf16x8*)(As + (p0 + r32) * LDA + k0);
            const bf16x8 b0 = *(const LAS bf16x8*)(Vt + (cbase + r32) * LDA + k0), b1 = *(const LAS bf16x8*)(Vt + (cbase + 32 + r32) * LDA + k0);
            acc0 = __builtin_amdgcn_mfma_f32_32x32x16_bf16(a, b0, acc0, 0, 0, 0); acc1 = __builtin_amdgcn_mfma_f32_32x32x16_bf16(a, b1, acc1, 0, 0, 0); }
#pragma unroll
        for (int t = 0; t < 2; ++t) { const int cl = cbase + t * 32 + r32; const float gain = vg[g * 128 + cl];
#pragma unroll
            for (int reg = 0; reg < 16; ++reg) { const int p = p0 + (reg & 3) + 8 * (reg >> 2) + 4 * hi; Ot[p * LDO + cl] = gain * (t == 0 ? acc0[reg] : acc1[reg]) + bs[g * 128 + p]; } }
        __syncthreads();
        for (int i = F.tid; i < 128 * 16; i += NTHREADS) { const int p = i >> 4, c8 = (i & 15) * 8; const v4u uw = *(const v4u*)(P + (row0 + p) * 2048 + g * 128 + c8);
            const LAS float* o = Ot + p * LDO + c8; const f32x4 m0 = *(const LAS f32x4*)o, m1 = *(const LAS f32x4*)(o + 4);
            v4u w; w.x = cvt_pk_bf16(bflo(uw.x) * m0.x, bfhi(uw.x) * m0.y); w.y = cvt_pk_bf16(bflo(uw.y) * m0.z, bfhi(uw.y) * m0.w);
            w.z = cvt_pk_bf16(bflo(uw.z) * m1.x, bfhi(uw.z) * m1.y); w.w = cvt_pk_bf16(bflo(uw.w) * m1.z, bfhi(uw.w) * m1.w);
            *(v4u*)(Y + (row0 + p) * D + g * 128 + c8) = w; }
    }
    __syncthreads();
}

__device__ __forceinline__ void hyena_prep_phase(Frame& F) {
    LAS float* tl = (LAS float*)F.lds;
    const bf16* P = (const bf16*)(F.ws + WS_P); bf16* X0 = (bf16*)(F.ws + WS_X0); bf16* VG = (bf16*)(F.ws + WS_VG);
    float* VT = (float*)(F.ws + WS_VT); float* VTC = (float*)(F.ws + WS_VTC);
    const float* cw = PIN(F, I_HCW); const float* cb = PIN(F, I_HCB);
    const int tt = F.tid >> 3, cg = F.tid & 7;
    for (int u = F.bx; u < (MT / 64) * 16; u += F.G) {
        const int tb = u >> 4, c0 = (u & 15) * 64; const int r0 = tb * 64; const bool lat = r0 < ML;
        const int b = lat ? (r0 >> 13) : ((r0 - ML) >> 8), s0 = lat ? (r0 & (SEQ - 1)) : ((r0 - ML) & (CL - 1)), L = lat ? SEQ : CL;
        const int r = r0 + tt, s = s0 + tt, c = c0 + cg * 8;
        float o[3][8];
#pragma unroll
        for (int seg = 0; seg < 3; ++seg) { const int col = seg * 1024 + c;
            const v4u z0 = {0u, 0u, 0u, 0u};
            const v4u pm = s > 0 ? *(const v4u*)(P + (size_t)(r - 1) * 3072 + col) : z0, pc = *(const v4u*)(P + (size_t)r * 3072 + col), pn = s < L - 1 ? *(const v4u*)(P + (size_t)(r + 1) * 3072 + col) : z0;
            const f32x4 w0a = *(const f32x4*)(cw + col), w0b = *(const f32x4*)(cw + col + 4), w1a = *(const f32x4*)(cw + 3072 + col), w1b = *(const f32x4*)(cw + 3072 + col + 4);
            const f32x4 w2a = *(const f32x4*)(cw + 6144 + col), w2b = *(const f32x4*)(cw + 6144 + col + 4), ba = *(const f32x4*)(cb + col), bb = *(const f32x4*)(cb + col + 4);
            const unsigned pmw[4] = {pm.x, pm.y, pm.z, pm.w}, pcw[4] = {pc.x, pc.y, pc.z, pc.w}, pnw[4] = {pn.x, pn.y, pn.z, pn.w};
#pragma unroll
            for (int i = 0; i < 8; ++i) { const float xm = (i & 1) ? bfhi(pmw[i >> 1]) : bflo(pmw[i >> 1]), xc = (i & 1) ? bfhi(pcw[i >> 1]) : bflo(pcw[i >> 1]), xn = (i & 1) ? bfhi(pnw[i >> 1]) : bflo(pnw[i >> 1]);
                const float w0 = i < 4 ? w0a[i & 3] : w0b[i & 3], w1 = i < 4 ? w1a[i & 3] : w1b[i & 3], w2 = i < 4 ? w2a[i & 3] : w2b[i & 3], bi = i < 4 ? ba[i & 3] : bb[i & 3];
                o[seg][i] = xm * w0 + xc * w1 + xn * w2 + bi; } }
        float vgv[8];
#pragma unroll
        for (int i = 0; i < 8; ++i) vgv[i] = o[2][i] * o[1][i];
        v4u w; w.x = cvt_pk_bf16(o[0][0], o[0][1]); w.y = cvt_pk_bf16(o[0][2], o[0][3]); w.z = cvt_pk_bf16(o[0][4], o[0][5]); w.w = cvt_pk_bf16(o[0][6], o[0][7]);
        *(v4u*)(X0 + (size_t)r * D + c) = w;
        w.x = cvt_pk_bf16(vgv[0], vgv[1]); w.y = cvt_pk_bf16(vgv[2], vgv[3]); w.z = cvt_pk_bf16(vgv[4], vgv[5]); w.w = cvt_pk_bf16(vgv[6], vgv[7]);
        *(v4u*)(VG + (size_t)r * D + c) = w;
        __syncthreads();
#pragma unroll
        for (int i = 0; i < 8; ++i) tl[(cg * 8 + i) * 65 + tt] = vgv[i];
        __syncthreads();
        { const int cc = F.tid >> 3, ts = (F.tid & 7) * 8; float* dst = lat ? VT + ((size_t)b * 1024 + c0 + cc) * SEQ + s0 + ts : VTC + ((size_t)b * 1024 + c0 + cc) * CL + s0 + ts;
          const LAS float* sp = tl + cc * 65 + ts;
          *(f32x4*)dst = (f32x4){sp[0], sp[1], sp[2], sp[3]}; *(f32x4*)(dst + 4) = (f32x4){sp[4], sp[5], sp[6], sp[7]}; }
    }
    __syncthreads();
}
__device__ __forceinline__ void hyena_post_phase(Frame& F) {
    LAS float* tl = (LAS float*)F.lds;
    const bf16* X0 = (const bf16*)(F.ws + WS_X0); const bf16* VG = (const bf16*)(F.ws + WS_VG); bf16* Y = (bf16*)(F.ws + WS_Y);
    const float* VT = (const float*)(F.ws + WS_CT); const float* VTC = (const float*)(F.ws + WS_CTC); const float* dsk = PIN(F, I_HD);
    const int tt = F.tid >> 3, cg = F.tid & 7;
    for (int u = F.bx; u < (MT / 64) * 16; u += F.G) {
        const int tb = u >> 4, c0 = (u & 15) * 64; const int r0 = tb * 64; const bool lat = r0 < ML;
        const int b = lat ? (r0 >> 13) : ((r0 - ML) >> 8), s0 = lat ? (r0 & (SEQ - 1)) : ((r0 - ML) & (CL - 1));
        __syncthreads();
        { const int cc = F.tid >> 3, ts = (F.tid & 7) * 8; const float* src = lat ? VT + ((size_t)b * 1024 + c0 + cc) * SEQ + s0 + ts : VTC + ((size_t)b * 1024 + c0 + cc) * CL + s0 + ts;
          const f32x4 a = *(const f32x4*)src, bq = *(const f32x4*)(src + 4); LAS float* dp = tl + cc * 65 + ts;
          dp[0] = a.x; dp[1] = a.y; dp[2] = a.z; dp[3] = a.w; dp[4] = bq.x; dp[5] = bq.y; dp[6] = bq.z; dp[7] = bq.w; }
        __syncthreads();
        const int r = r0 + tt, c = c0 + cg * 8;
        const v4u x0 = *(const v4u*)(X0 + (size_t)r * D + c), vv = *(const v4u*)(VG + (size_t)r * D + c);
        const f32x4 da = *(const f32x4*)(dsk + c), db = *(const f32x4*)(dsk + c + 4);
        const unsigned x0w[4] = {x0.x, x0.y, x0.z, x0.w}, vw[4] = {vv.x, vv.y, vv.z, vv.w}; float y[8];
#pragma unroll
        for (int i = 0; i < 8; ++i) { const float xx = (i & 1) ? bfhi(x0w[i >> 1]) : bflo(x0w[i >> 1]), vx = (i & 1) ? bfhi(vw[i >> 1]) : bflo(vw[i >> 1]); const float di = i < 4 ? da[i & 3] : db[i & 3];
            y[i] = (tl[(cg * 8 + i) * 65 + tt] + vx * di) * xx; }
        v4u w; w.x = cvt_pk_bf16(y[0], y[1]); w.y = cvt_pk_bf16(y[2], y[3]); w.z = cvt_pk_bf16(y[4], y[5]); w.w = cvt_pk_bf16(y[6], y[7]);
        *(v4u*)(Y + (size_t)r * D + c) = w;
    }
    __syncthreads();
}
__device__ __forceinline__ bool phase_nonempty(int ph) {
    if (ph < PH_L0 || ph >= PH_FINAL) return true;
    const int layer = (ph - PH_L0) / PH_PER_LAYER, lp = (ph - PH_L0) % PH_PER_LAYER, kind = layer % 3;
    if (lp == LP_MIX2) return kind != 1;
    if (lp == LP_MIX3) return kind == 2;
    return true;
}
__global__ void __launch_bounds__(NTHREADS, 2) mk_fwd(Args args) {
    extern __shared__ __attribute__((aligned(16))) unsigned char lds[];
    Frame F0;
    F0.lds = (LAS unsigned char*)lds; F0.MISC = (volatile LAS unsigned*)(F0.lds + MISC_OFF);
    F0.tid = threadIdx.x; F0.lane = F0.tid & 63; F0.wave = __builtin_amdgcn_readfirstlane(F0.tid >> 6);
    F0.G = gridDim.x; F0.bx = blockIdx.x; F0.out = args.out; F0.ws = args.ws; F0.ctl = (gu32*)(args.ws + WS_CTL);
    for (int u = F0.tid; u < MISC_BYTES / 4; u += NTHREADS) F0.MISC[u] = 0u;
    __syncthreads();
    if (F0.tid < 36) { const unsigned long long p = (unsigned long long)args.in[F0.tid]; F0.MISC[MW_PTRS + 2 * F0.tid] = (unsigned)p; F0.MISC[MW_PTRS + 2 * F0.tid + 1] = (unsigned)(p >> 32); }
    __syncthreads();
    const int lo = args.ph_lo, hi = args.ph_hi;
    const bool multi = (hi - lo) > 1;
    XcdBarrier bar; bar.bar = (unsigned*)(F0.ctl + CW_BAR); bar.x = 0; bar.st = nullptr;
    if (multi) bar = xcd_barrier_post((unsigned*)(F0.ctl + CW_BAR), F0.MISC + 8);
#ifndef PHMASK
#define PHMASK 0xFFFF
#endif
#define EN(b) ((PHMASK >> (b)) & 1)
#ifndef KMASK
#define KMASK 7
#endif
#define KEN(b) ((KMASK >> (b)) & 1)
#define IN(k) (lo <= (k) && (k) < hi)
#define SEAM(k) do { if ((k) + 1 < hi) xcd_barrier(bar); } while (0)
#define PB(id) for (int _rep = 0, _n = ((id) == MK_REPEAT ? MK_NREP : 1); _rep < _n; ++_rep) {
#define PE(id) if (_rep + 1 < _n) xcd_barrier(bar); } SEAM(id);

    if (EN(0) && IN(PH_PRO0)) { PB(PH_PRO0) Frame F = phase_frame(F0); pro0_mod(F); __syncthreads(); pro0_transposes(F); pro0_filter_mlp(F); PE(PH_PRO0) }
    if (EN(1) && IN(PH_PRO1)) { PB(PH_PRO1) Frame F = phase_frame(F0); pro1_filters(F); PE(PH_PRO1) }

#pragma unroll 1
    for (int layer = 0; layer < NLAYER; ++layer) {
        const int kind = layer % 3, jj = layer / 3, pb = PH_L0 + layer * PH_PER_LAYER; const bool last = layer == NLAYER - 1;
        if (EN(2) && IN(pb + LP_NORM1)) { PB(pb + LP_NORM1) Frame F = phase_frame(F0); rowpass<0>(F, layer, _rep + 1 == _n); PE(pb + LP_NORM1) }
        if (EN(3) && IN(pb + LP_INPROJ)) { PB(pb + LP_INPROJ)
            Frame F = phase_frame(F0);
            const int N = kind == 0 ? 1536 : (kind == 1 ? 2048 : 3072);
            const size_t woff = kind == 0 ? WS_WATT + (size_t)jj * 1536 * 1024 * 2 : (kind == 1 ? WS_WGM : WS_WHY);
            pg8::DenseSched S; S.init(F.ws + WS_H, F.ws + woff, MT, N, F.G, F.bx);
            pg8::EpiBf16 E{(bf16*)(F.ws + WS_P), N, (float*)(F.ws + WS_SS), kind == 1 ? 1 : 0};
            pg8::gemm_phase<pg8::EpiBf16, pg8::DenseSched, false>(F.lds, S, E);
            PE(pb + LP_INPROJ)
        }
        if (IN(pb + LP_MIX1)) { PB(pb + LP_MIX1)
            Frame F = phase_frame(F0);
            if (EN(4) && kind == 0) qkprep_phase(F, jj); else if (EN(5) && kind == 1) gmlp_mix_phase(F); else if (EN(6)) hyena_prep_phase(F);
            PE(pb + LP_MIX1)
        }
        if (IN(pb + LP_MIX2) && kind != 1) { PB(pb + LP_MIX2)
            Frame F = phase_frame(F0);
            if (EN(7) && kind == 0) attention_phase(F, (char*)lds, !last); else if (EN(8)) hyena_conv_phase(F);
            PE(pb + LP_MIX2)
        }
        if (EN(9) && IN(pb + LP_MIX3) && kind == 2) { PB(pb + LP_MIX3) Frame F = phase_frame(F0); hyena_post_phase(F); PE(pb + LP_MIX3) }
        if (EN(10) && IN(pb + LP_OUTPROJ)) { PB(pb + LP_OUTPROJ)
            Frame F = phase_frame(F0); const float* modl = (const float*)(F.ws + WS_MOD) + (size_t)layer * 9 * 6144;
            pg8::DenseSched S; S.init(F.ws + WS_Y, F.ws + WS_WOUT + (size_t)layer * 1024 * 1024 * 2, last ? ML : MT, 1024, F.G, F.bx);
            const bool first = layer == 0;
            pg8::EpiResid E{first ? PIN(F, I_X) : F.out, first ? PIN(F, I_CTX) : (const float*)(F.ws + WS_XC), F.out, (float*)(F.ws + WS_XC), modl};
            pg8::gemm_phase<pg8::EpiResid, pg8::DenseSched, false>(F.lds, S, E);
            PE(pb + LP_OUTPROJ)
        }
        if (EN(11) && IN(pb + LP_NORM2)) { PB(pb + LP_NORM2) Frame F = phase_frame(F0); router_phase(F, layer, _rep + 1 == _n); PE(pb + LP_NORM2) }
        if (EN(12) && IN(pb + LP_MOE1)) { PB(pb + LP_MOE1)
            Frame F = phase_frame(F0);
            moe_tables(F, layer);
            pg8::MoeSched S{(const char*)(F.ws + WS_H8), (const char*)(F.ws + WS_WE1) + (size_t)layer * NE * 2048 * 1024, (size_t)2048 * 1024, (const int*)(F.ws + WS_ROWTOK),
                            (const volatile LAS int*)(F.MISC + MW_CUMBLK), (const volatile LAS int*)(F.MISC + MW_CNT), 3, F.G, F.bx, 1024};
            pg8::EpiSwiglu E{(unsigned char*)(F.ws + WS_ACT), PIN(F, I_EB1) + (size_t)layer * NE * 2048};
            pg8::gemm_phase<pg8::EpiSwiglu, pg8::MoeSched, true, true>(F.lds, S, E);
            PE(pb + LP_MOE1)
        }
        if (EN(13) && IN(pb + LP_MOE2)) { PB(pb + LP_MOE2)
            Frame F = phase_frame(F0);
            moe_tables(F, layer);
            pg8::MoeSched S{(const char*)(F.ws + WS_ACT), (const char*)(F.ws + WS_WE2) + (size_t)layer * NE * 1024 * 1024, (size_t)1024 * 1024, nullptr,
                            (const volatile LAS int*)(F.MISC + MW_CUMBLK), (const volatile LAS int*)(F.MISC + MW_CNT), 2, F.G, F.bx, 1024};
            pg8::EpiBias E{(bf16*)(F.ws + WS_YM), PIN(F, I_EB2) + (size_t)layer * NE * 1024};
            pg8::gemm_phase<pg8::EpiBias, pg8::MoeSched, true, true>(F.lds, S, E);
            PE(pb + LP_MOE2)
        }
    }
    if (EN(14) && IN(PH_FINAL)) { PB(PH_FINAL) Frame F = phase_frame(F0); rowpass<2>(F, NLAYER - 1, _rep + 1 == _n); PE(PH_FINAL) }
#undef IN
#undef SEAM
}

static bool host_phase_nonempty(int ph) {
    if (ph < PH_L0 || ph >= PH_FINAL) return true;
    const int layer = (ph - PH_L0) / PH_PER_LAYER, lp = (ph - PH_L0) % PH_PER_LAYER, kind = layer % 3;
    if (lp == LP_MIX2) return kind != 1;
    if (lp == LP_MIX3) return kind == 2;
    return true;
}
extern "C" void kernel_launch(void* const* d_in, const int* in_sizes, int n_in, void* d_out, int out_size, void* d_ws, size_t ws_size, hipStream_t stream) {
    static int grid = 0;
    if (grid == 0) {
        if (n_in != 36 || in_sizes[0] != ML * D || out_size != ML * D || ws_size < WS_END) {
            fprintf(stderr, "kernel_launch: built for 36 inputs, x/out of %d floats, >= %zu bytes of workspace; got n_in %d in0 %d out %d ws %zu; nothing launched\n", ML * D, (size_t)WS_END, n_in, n_in > 0 ? in_sizes[0] : -1, out_size, ws_size);
            grid = -1; return; }
        int dev = 0, cus = 0, per_cu = 0;
        if (hipGetDevice(&dev) != hipSuccess || hipDeviceGetAttribute(&cus, hipDeviceAttributeMultiprocessorCount, dev) != hipSuccess) { fprintf(stderr, "kernel_launch: device query failed\n"); grid = -1; return; }
        if (hipFuncSetAttribute((const void*)mk_fwd, hipFuncAttributeMaxDynamicSharedMemorySize, LDS_BYTES) != hipSuccess) { fprintf(stderr, "kernel_launch: hipFuncSetAttribute(%d B LDS) failed\n", LDS_BYTES); grid = -1; return; }
        if (hipOccupancyMaxActiveBlocksPerMultiprocessor(&per_cu, (const void*)mk_fwd, NTHREADS, LDS_BYTES) != hipSuccess || per_cu < 1)
            fprintf(stderr, "kernel_launch: note: occupancy query reports %d workgroups per CU\n", per_cu);
        (void)hipGetLastError();
        grid = cus;
    }
    if (grid < 0) return;
    if (hipMemsetAsync((char*)d_ws + WS_CTL, 0, CTL_ZERO_BYTES, stream) != hipSuccess) { fprintf(stderr, "kernel_launch: memset failed\n"); return; }
    Args a{};
    for (int i = 0; i < 36; ++i) a.in[i] = (const float*)d_in[i];
    a.out = (float*)d_out; a.ws = (unsigned char*)d_ws;
#if MK_MULTI || MK_DBG
    for (int ph = 0; ph < PH_COUNT; ++ph) {
        if (!host_phase_nonempty(ph)) continue;
        a.ph_lo = ph; a.ph_hi = ph + 1;
        hipLaunchKernelGGL(mk_fwd, dim3(grid), dim3(NTHREADS), LDS_BYTES, stream, a);
#if MK_DBG
        dbg_after_phase(ph, a, stream);
#endif
    }
#if MK_DBG
    dbg_report(a, stream);
#endif
#else
    a.ph_lo = 0; a.ph_hi = PH_COUNT;
    hipLaunchKernelGGL(mk_fwd, dim3(grid), dim3(NTHREADS), LDS_BYTES, stream, a);
#endif
    const hipError_t le = hipPeekAtLastError();
    if (le != hipSuccess) fprintf(stderr, "kernel_launch: launch failed: %s\n", hipGetErrorName(le));
}
```

```cpp
#include <hip/hip_runtime.h>
#include <cstdio>
#include <cstdint>
#include <cmath>

#ifndef MK_MULTI
#define MK_MULTI 0
#endif
#ifndef MK_REPEAT
#define MK_REPEAT -1
#endif
#ifndef MK_NREP
#define MK_NREP 1
#endif
#ifndef MK_XP
#define MK_XP 0
#endif
#ifndef MK_DBG
#define MK_DBG 0
#endif

constexpr int D = 1024, NB = 8, SEQ = 8192, CL = 256, ML = NB * SEQ, MC = NB * CL, MT = ML + MC;
constexpr int NLAYER = 4, NE = 32, TOPK = 4, SKV = SEQ + CL;
constexpr int MOE_MAXBLK = (MT * TOPK) / 256 + NE;
constexpr float EPS = 1e-6f;
constexpr int FH = 64, FEMB = 33, NFFT = 16384;

constexpr size_t MiB = 1u << 20;
constexpr size_t WS_CTL = 0, CTL_ZERO_BYTES = 1 * MiB;
constexpr size_t WS_MOD = 1 * MiB;
constexpr size_t WS_A3 = 2 * MiB;
constexpr size_t WS_A3C = 4 * MiB;
constexpr size_t WS_RC = 4 * MiB + 512 * 1024;
constexpr size_t WS_FCT = 5 * MiB;
constexpr size_t WS_WATT = 8 * MiB;
constexpr size_t WS_WGM = 14 * MiB;
constexpr size_t WS_WHY = 18 * MiB;
constexpr size_t WS_WOUT = 24 * MiB;
constexpr size_t WS_XC = 32 * MiB;
constexpr size_t WS_TE = 40 * MiB;
constexpr size_t WS_TR = 42 * MiB;
constexpr size_t WS_TG = 44 * MiB;
constexpr size_t WS_SS = 46 * MiB;
constexpr size_t WS_ROWTOK = 52 * MiB;
constexpr size_t WS_KF = 64 * MiB;
constexpr size_t WS_WE1 = 192 * MiB;
constexpr size_t WS_WE2 = 704 * MiB;
constexpr size_t WS_H = 960 * MiB;
constexpr size_t WS_P = 1092 * MiB;
constexpr size_t WS_Y = 1488 * MiB;
constexpr size_t WS_QB = 1620 * MiB;
constexpr size_t WS_KVB = 1752 * MiB;
constexpr size_t WS_X0 = 1818 * MiB;
constexpr size_t WS_VG = 1950 * MiB;
constexpr size_t WS_VT = 2082 * MiB;
constexpr size_t WS_VTC = 2338 * MiB;
constexpr size_t WS_ACT = 2346 * MiB;
constexpr size_t WS_YM = 2890 * MiB;
constexpr size_t WS_CT = 3434 * MiB;
constexpr size_t WS_CTC = 3690 * MiB;
constexpr size_t WS_H8 = 3698 * MiB;
constexpr size_t WS_END = 3764 * MiB;
constexpr int CW_BAR = 4096;
constexpr int CW_CNT = 16384;
constexpr int CW_DBG = 32768;

constexpr int RING_BYTES = 131072;
constexpr int AUX_OFF = RING_BYTES;
constexpr int AUX_BYTES = 16384;
constexpr int MISC_OFF = AUX_OFF + AUX_BYTES;
constexpr int MISC_BYTES = 4096;
constexpr int LDS_BYTES = MISC_OFF + MISC_BYTES;

#define GAS __attribute__((address_space(1)))
#define LAS __attribute__((address_space(3)))
typedef unsigned short bf16;
typedef unsigned v4u __attribute__((ext_vector_type(4)));
typedef unsigned v2u __attribute__((ext_vector_type(2)));
typedef float f32x4 __attribute__((ext_vector_type(4)));
typedef float f32x2 __attribute__((ext_vector_type(2)));
typedef float f32x16 __attribute__((ext_vector_type(16)));
typedef short bf16x8 __attribute__((ext_vector_type(8)));
typedef short s16x4 __attribute__((ext_vector_type(4)));
typedef int i32x4 __attribute__((ext_vector_type(4)));
typedef GAS unsigned gu32;
#define RLX_AGENT __ATOMIC_RELAXED, __HIP_MEMORY_SCOPE_AGENT
#define LDS_WAIT() asm volatile("s_waitcnt lgkmcnt(0)" ::: "memory")
#define VM_WAIT() asm volatile("s_waitcnt vmcnt(0)" ::: "memory")
__device__ __forceinline__ int opaque_tid(int wave) { int l; asm volatile("v_mbcnt_lo_u32_b32 %0, -1, 0\n\tv_mbcnt_hi_u32_b32 %0, -1, %0" : "=v"(l)); return (wave << 6) | l; }
__device__ __forceinline__ unsigned f2bf(float f) { unsigned u = __builtin_bit_cast(unsigned, f); return (u + 0x7fffu + ((u >> 16) & 1u)) >> 16; }
__device__ __forceinline__ unsigned pk2(float lo, float hi) { return f2bf(lo) | (f2bf(hi) << 16); }
__device__ __forceinline__ float bf2f(unsigned short b) { return __builtin_bit_cast(float, ((unsigned)b) << 16); }
__device__ __forceinline__ float bflo(unsigned w) { return __builtin_bit_cast(float, w << 16); }
__device__ __forceinline__ float bfhi(unsigned w) { return __builtin_bit_cast(float, w & 0xffff0000u); }
__device__ __forceinline__ unsigned cvt_pk_bf16(float lo, float hi) { unsigned r; asm volatile("v_cvt_pk_bf16_f32 %0, %1, %2" : "=v"(r) : "v"(lo), "v"(hi)); return r; }
__device__ __forceinline__ float wave_sum(float v) {
#pragma unroll
    for (int o = 1; o < 64; o <<= 1) v += __shfl_xor(v, o);
    return v;
}

#define XB_TMO      128
#define XB_XCNT(j)  (256  + 64 * (j))
#define XB_XSUB(j)  (1280 + 64 * (j))
#define XB_XGEN(j)  (2304 + 64 * (j))
#define XB_TOP      3328
#define XB_TOPGEN   3392
#define XCD_BAR_WORDS 3456
#define XB_SPIN_CAP (1u << 22)
__device__ __forceinline__ unsigned xb_ld(unsigned* p)              { return __hip_atomic_load(p, __ATOMIC_RELAXED, __HIP_MEMORY_SCOPE_AGENT); }
__device__ __forceinline__ unsigned xb_add(unsigned* p, unsigned v) { return __hip_atomic_fetch_add(p, v, __ATOMIC_RELAXED, __HIP_MEMORY_SCOPE_AGENT); }
__device__ __forceinline__ unsigned xb_xcc_id() { return (unsigned)__builtin_amdgcn_s_getreg((3 << 11) | 20) & 0xFu; }
#define XB_SPIN(cond, bar) do { unsigned _sp = 0; while (cond) { __builtin_amdgcn_s_sleep(1); \
    if ((++_sp & 255u) == 0u) { if (xb_ld(&(bar)[XB_TMO])) break; if (_sp > XB_SPIN_CAP) { atomicAdd(&(bar)[XB_TMO], 1u); break; } } } } while (0)
struct XcdBarrier { unsigned* bar; unsigned x; volatile LAS unsigned* st; int w; };
__device__ __forceinline__ bool xb_thread0(int w) { return opaque_tid(w) == 0; }
__device__ __forceinline__ XcdBarrier xcd_barrier_post(unsigned* bar, volatile LAS unsigned* st, int w) {
    XcdBarrier b; b.bar = bar; b.x = xb_xcc_id(); b.st = st; b.w = w;
    if (xb_thread0(w)) (void)xb_add(&bar[XB_XCNT(b.x)], 1u);
    return b;
}
__device__ __forceinline__ void xcd_barrier_complete(unsigned* bar, unsigned x, unsigned& nloc, unsigned& nx) {
    const unsigned G = gridDim.x * gridDim.y * gridDim.z;
    unsigned sum, cnt, mine, sp = 0u;
    for (;;) {
        sum = 0u; cnt = 0u; mine = 0u;
#pragma unroll
        for (unsigned j = 0; j < 16; ++j) { const unsigned c = xb_ld(&bar[XB_XCNT(j)]); sum += c; cnt += (c > 0u) ? 1u : 0u; mine = (j == x) ? c : mine; }
        if (sum == G) break;
        __builtin_amdgcn_s_sleep(1);
        if ((++sp & 255u) == 0u) { if (xb_ld(&bar[XB_TMO])) break; if (sp > XB_SPIN_CAP) { atomicAdd(&bar[XB_TMO], 1u); break; } }
    }
    nloc = mine > 0u ? mine : 1u; nx = cnt > 0u ? cnt : 1u;
}
__device__ __forceinline__ void xcd_barrier(const XcdBarrier& b) {
    asm volatile("s_waitcnt vmcnt(0)" ::: "memory");
    __syncthreads();
    if (xb_thread0(b.w)) {
        unsigned* bar = b.bar;
        __builtin_amdgcn_s_waitcnt(0);
        unsigned nloc = b.st[0], nx = b.st[1];
        if (nloc == 0u) { xcd_barrier_complete(bar, b.x, nloc, nx); b.st[0] = nloc; b.st[1] = nx; }
        const unsigned old = xb_add(&bar[XB_XSUB(b.x)], 1u);
        const unsigned gen = old / nloc;
        if (old + 1u == (gen + 1u) * nloc) {
            __builtin_amdgcn_fence(__ATOMIC_RELEASE, "agent");
            asm volatile("s_waitcnt vmcnt(0)" ::: "memory");
            const unsigned og = xb_add(&bar[XB_TOP], 1u);
            const unsigned tg = og / nx;
            if (og + 1u == (tg + 1u) * nx) xb_add(&bar[XB_TOPGEN], 1u);
            else XB_SPIN(xb_ld(&bar[XB_TOPGEN]) == tg, bar);
            __builtin_amdgcn_fence(__ATOMIC_ACQUIRE, "agent");
            xb_add(&bar[XB_XGEN(b.x)], 1u);
            asm volatile("s_waitcnt vmcnt(0)" ::: "memory");
        } else {
            XB_SPIN(xb_ld(&bar[XB_XGEN(b.x)]) == gen, bar);
            __builtin_amdgcn_fence(__ATOMIC_ACQUIRE, "agent");
            asm volatile("s_waitcnt vmcnt(0)" ::: "memory");
        }
    }
    __syncthreads();
}

namespace pg8 {
constexpr int BM = 256, BK = 64, HALF = 128, HTB = HALF * BK * 2, STAGE_BYTES = 8 * HTB, NXCD = 8, WGM = 8;
constexpr int GK = 1024;
__device__ __forceinline__ int lds_byte(int r, int c) { const int st = (r >> 4) * 2 + (c >> 5), rr = r & 15, cc = c & 31, ob = rr * 64 + cc * 2; return st * 1024 + (ob ^ (((ob >> 9) & 1) << 5)); }
__device__ __forceinline__ void stage_rc(int b, int& R, int& C) { const int st = b / 1024, sb = b % 1024, swz = sb ^ (((sb >> 9) & 1) << 5); R = (st >> 1) * 16 + swz / 64; C = (st & 1) * 32 + (swz % 64) / 2; }
__device__ __forceinline__ int perm32(int rho) { const int n = rho >> 4, i = rho & 15; return 8 * (i >> 2) + 4 * n + (i & 3); }
struct Unit { int pm, pn, e; };

template <bool IDG> struct DenseSchedT {
    const char* A; const char* Bt; int nM, nN, nwg, G, c, kb;
    __device__ __forceinline__ void init(const void* A_, const void* Bt_, int M, int N, int G_, int c_, int kb_ = GK * 2) { A = (const char*)A_; Bt = (const char*)Bt_; nM = M / BM; nN = N / BM; nwg = nM * nN; G = G_; c = c_; kb = kb_; }
    __device__ __forceinline__ bool next(int i, Unit& u) const {
        const long L = (long)i * G + c; if (L >= nwg) return false;
        int wgid = (int)L; { const int q = nwg / NXCD, r = nwg % NXCD, xcd = wgid % NXCD, off = wgid / NXCD; wgid = (xcd < r ? xcd * (q + 1) : r * (q + 1) + (xcd - r) * q) + off; }
        const int nig = WGM * nN, gid = wgid / nig, fm = gid * WGM, gsz = (nM - fm) < WGM ? (nM - fm) : WGM;
        u.pm = fm + ((wgid % nig) % gsz); u.pn = (wgid % nig) / gsz; u.e = 0; return true;
    }
    __device__ __forceinline__ const char* a_ptr(const Unit& u) const { return IDG ? A : A + (size_t)u.pm * (size_t)(BM * kb); }
    __device__ __forceinline__ const char* b_ptr(const Unit& u) const { return Bt + (size_t)u.pn * (size_t)(BM * kb); }
    __device__ __forceinline__ void a_offs(const Unit& u, const int (&R)[2], const int (&C)[2], unsigned (&voff)[2][2]) const {
#pragma unroll
        for (int h = 0; h < 2; ++h)
#pragma unroll
            for (int i = 0; i < 2; ++i) voff[h][i] = (unsigned)(u.pm * BM + h * HALF + R[i]) * (unsigned)kb + (unsigned)C[i] * 2u;
    }
};
typedef DenseSchedT<false> DenseSched;
struct MoeSched {
    const char* A; const char* Bt; size_t b_estride; const int* rowtok; const volatile LAS int* cumblk; const volatile LAS int* cnt; int ncol_log2, G, c, kb;
    __device__ __forceinline__ bool next(int i, Unit& u) const {
        int gb, pn; const int ncol = 1 << ncol_log2;
        if (G == 256) { const int xcd = c & 7, j = c >> 3, rpb = 256 >> ncol_log2; gb = i * rpb + xcd + 8 * (j >> ncol_log2); pn = j & (ncol - 1); }
        else { const long L = (long)i * G + c; gb = (int)(L >> ncol_log2); pn = (int)(L & (ncol - 1)); }
        const int tot = cumblk[NE]; if (gb >= tot) return false;
        int e = 0;
#pragma unroll 1
        for (int s = 16; s >= 1; s >>= 1) { if (cumblk[e + s] <= gb) e += s; }
        u.pm = gb; u.pn = pn; u.e = e; return true;
    }
    __device__ __forceinline__ const char* a_ptr(const Unit&) const { return A; }
    __device__ __forceinline__ const char* b_ptr(const Unit& u) const { return Bt + (size_t)u.e * b_estride + (size_t)u.pn * (size_t)(BM * kb); }
    __device__ __forceinline__ void a_offs(const Unit& u, const int (&R)[2], const int (&C)[2], unsigned (&voff)[2][2]) const {
        const int rb = u.pm - cumblk[u.e], n = cnt[u.e]; const int* rt = rowtok + (size_t)u.e * MT;
#pragma unroll
        for (int h = 0; h < 2; ++h)
#pragma unroll
            for (int i = 0; i < 2; ++i) { const int rank = rb * 256 + h * HALF + R[i]; const int tok = rowtok ? (rank < n ? rt[rank] : 0) : u.pm * BM + h * HALF + R[i]; voff[h][i] = (unsigned)tok * (unsigned)kb + (unsigned)C[i] * 2u; }
    }
};

typedef int v8i __attribute__((ext_vector_type(8)));
__device__ __forceinline__ v8i cat8(bf16x8 lo, bf16x8 hi) { const v4u a = __builtin_bit_cast(v4u, lo), b = __builtin_bit_cast(v4u, hi); return (v8i){(int)a.x, (int)a.y, (int)a.z, (int)a.w, (int)b.x, (int)b.y, (int)b.z, (int)b.w}; }
template <class Epi, class Sched, bool GATHER, bool FP8 = false>
__device__ __forceinline__ void gemm_phase(LAS unsigned char* lds, const Sched& S, const Epi& E, int wave_id, bool skip_epi = false) {
    const int tid = opaque_tid(wave_id), wid = __builtin_amdgcn_readfirstlane(tid >> 6), lane = tid & 63, wr = wid >> 2, wc = wid & 3, fr = lane & 15, fq = lane >> 4;
    constexpr int KB = FP8 ? GK : GK * 2, nt = KB / (BK * 2);
    unsigned voffA[2][2], voffB[2]; int Rr[2], Cc[2];
#pragma unroll
    for (int i = 0; i < 2; ++i) { int R, C; stage_rc(tid * 16 + i * 8192, R, C); Rr[i] = R; Cc[i] = C; const int Rb = Epi::PERM ? ((R & ~31) + perm32(R & 31)) : R;
        voffA[0][i] = (unsigned)(R * KB + C * 2); voffA[1][i] = (unsigned)((R + HALF) * KB + C * 2); voffB[i] = (unsigned)(Rb * KB + C * 2); }
    constexpr size_t kstep = (size_t)(BK * 2);
    constexpr size_t hstep = (size_t)HALF * KB;
    const unsigned ldsw = (unsigned)wid * 1024u;
    const int aoff = lds_byte(wr * 64 + fr, fq * 8), boff = lds_byte(wc * 32 + fr, fq * 8);
    LAS unsigned char* abase = lds + aoff; LAS unsigned char* bbase = lds + 4 * HTB + boff; asm volatile("" : "+v"(abase), "+v"(bbase));
#define PG8_SA(b, h) (((b) * 2 + (h)) * HTB)
#define PG8_SB(b, h) ((4 + (b) * 2 + (h)) * HTB)
#define PG8_STAGE(bufoff, gbase, voff) do { _Pragma("unroll") for (int _i = 0; _i < 2; ++_i) \
        __builtin_amdgcn_global_load_lds((const unsigned*)((const char*)(gbase) + (voff)[_i]), (LAS unsigned*)(lds + (bufoff) + ldsw + _i * 8192), 16, 0, 0); } while (0)
#define PG8_STAGE_A(bufoff, gbase, h) PG8_STAGE(bufoff, gbase, voffA[h])
#define PG8_RDA(off) (*(const LAS v4u*)(abase + (off)))
#define PG8_RDB(off) (*(const LAS v4u*)(bbase + (off)))
#define PG8_LDA(dst, b, h) do { _Pragma("unroll") for (int m = 0; m < 4; ++m) { const v4u _l = PG8_RDA(PG8_SA(b, h) + m * 2048), _h = PG8_RDA(PG8_SA(b, h) + m * 2048 + 1024); \
        if constexpr (FP8) dst##8[m] = (v8i){(int)_l.x, (int)_l.y, (int)_l.z, (int)_l.w, (int)_h.x, (int)_h.y, (int)_h.z, (int)_h.w}; \
        else { dst[m][0] = __builtin_bit_cast(bf16x8, _l); dst[m][1] = __builtin_bit_cast(bf16x8, _h); } } } while (0)
#define PG8_LDB(dst, b, h) do { _Pragma("unroll") for (int n = 0; n < 2; ++n) { const v4u _l = PG8_RDB(PG8_SA(b, h) + n * 2048), _h = PG8_RDB(PG8_SA(b, h) + n * 2048 + 1024); \
        if constexpr (FP8) dst##8[n] = (v8i){(int)_l.x, (int)_l.y, (int)_l.z, (int)_l.w, (int)_h.x, (int)_h.y, (int)_h.z, (int)_h.w}; \
        else { dst[n][0] = __builtin_bit_cast(bf16x8, _l); dst[n][1] = __builtin_bit_cast(bf16x8, _h); } } } while (0)
#define PG8_MMA(ai, bj, At, Bt) do { __builtin_amdgcn_s_setprio(1); _Pragma("unroll") for (int m = 0; m < 4; ++m) _Pragma("unroll") for (int n = 0; n < 2; ++n) { \
        if constexpr (FP8) acc[ai][bj][m][n] = __builtin_amdgcn_mfma_scale_f32_16x16x128_f8f6f4(Bt##8[n], At##8[m], acc[ai][bj][m][n], 0, 0, 0, 0x7A7A7A7A, 0, 0x7F7F7F7F); \
        else { _Pragma("unroll") for (int k = 0; k < 2; ++k) acc[ai][bj][m][n] = __builtin_amdgcn_mfma_f32_16x16x32_bf16(Bt[n][k], At[m][k], acc[ai][bj][m][n], 0, 0, 0); } } \
        __builtin_amdgcn_s_setprio(0); } while (0)
#define PG8_WAIT_V(n) asm volatile("s_waitcnt vmcnt(" #n ")" ::: "memory")
#define PG8_WAIT_L(n) asm volatile("s_waitcnt lgkmcnt(" #n ")" ::: "memory")
#define PG8_BAR __builtin_amdgcn_s_barrier()
#define PG8_SCHED __builtin_amdgcn_sched_barrier(0)
    Unit cur, nxt; int ui = 0;
    if (!S.next(0, cur)) return;
    f32x4 acc[2][2][4][2];
#pragma unroll
    for (int a = 0; a < 2; ++a)
#pragma unroll
        for (int b = 0; b < 2; ++b)
#pragma unroll
            for (int m = 0; m < 4; ++m)
#pragma unroll
                for (int n = 0; n < 2; ++n) acc[a][b][m][n] = (f32x4){0.f, 0.f, 0.f, 0.f};
    bf16x8 At[4][2], B0[2][2], B1[2][2]; v8i At8[4], B08[2], B18[2];
    const char* cA = S.a_ptr(cur); const char* cB = S.b_ptr(cur);
    if constexpr (GATHER) S.a_offs(cur, Rr, Cc, voffA);
    PG8_STAGE(PG8_SB(0, 0), cB, voffB); PG8_STAGE(PG8_SB(0, 1), cB + hstep, voffB); PG8_STAGE_A(PG8_SA(0, 0), cA, 0); PG8_STAGE_A(PG8_SA(0, 1), cA, 1);
    if (wr == 1) PG8_BAR;
    PG8_WAIT_V(2); PG8_BAR;
    PG8_STAGE(PG8_SB(1, 0), cB + kstep, voffB); PG8_STAGE_A(PG8_SA(1, 0), cA + kstep, 0); PG8_STAGE(PG8_SB(1, 1), cB + hstep + kstep, voffB);
    PG8_WAIT_V(6); PG8_BAR;
    for (;;) {
        const bool has_next = S.next(ui + 1, nxt);
        const char* nA = has_next ? S.a_ptr(nxt) : cA; const char* nB = has_next ? S.b_ptr(nxt) : cB;
#pragma unroll 1
        for (int t = 0; t < nt; t += 2) {
            const bool last = (t == nt - 2);
            const char* a1 = cA + (size_t)(t + 1) * kstep;
            const char* a2 = last ? nA : cA + (size_t)(t + 2) * kstep; const char* b2 = last ? nB : cB + (size_t)(t + 2) * kstep;
            const char* a3 = a2 + kstep; const char* b3 = b2 + kstep;
            PG8_LDB(B0, 0, 0); PG8_LDB(B1, 0, 1); PG8_SCHED; PG8_LDA(At, 0, 0); PG8_STAGE_A(PG8_SA(1, 1), a1, 1);
            if constexpr (GATHER) { if (last && has_next) S.a_offs(nxt, Rr, Cc, voffA); }
            PG8_WAIT_V(8); PG8_WAIT_L(0); PG8_BAR; PG8_MMA(0, 0, At, B0); PG8_MMA(0, 1, At, B1); PG8_BAR; PG8_SCHED;
            PG8_LDA(At, 0, 1); PG8_STAGE(PG8_SB(0, 0), b2, voffB); PG8_STAGE(PG8_SB(0, 1), b2 + hstep, voffB); PG8_STAGE_A(PG8_SA(0, 0), a2, 0);
            PG8_WAIT_V(8); PG8_WAIT_L(0); PG8_BAR; PG8_MMA(1, 0, At, B0); PG8_MMA(1, 1, At, B1); PG8_BAR; PG8_SCHED;
            PG8_LDB(B0, 1, 0); PG8_LDB(B1, 1, 1); PG8_SCHED; PG8_LDA(At, 1, 0); PG8_STAGE_A(PG8_SA(0, 1), a2, 1);
            PG8_WAIT_V(8); PG8_WAIT_L(0); PG8_BAR; PG8_MMA(0, 0, At, B0); PG8_MMA(0, 1, At, B1); PG8_BAR; PG8_SCHED;
            PG8_LDA(At, 1, 1); PG8_STAGE(PG8_SB(1, 0), b3, voffB); PG8_STAGE(PG8_SB(1, 1), b3 + hstep, voffB); PG8_STAGE_A(PG8_SA(1, 0), a3, 0);
            PG8_WAIT_V(8); PG8_WAIT_L(0); PG8_BAR; PG8_MMA(1, 0, At, B0); PG8_MMA(1, 1, At, B1); PG8_BAR; PG8_SCHED;
        }
        if (wr == 0) PG8_BAR;
        if (!skip_epi) E(acc, cur, wr, wc, fr, fq);
        if (!has_next) break;
#pragma unroll
        for (int a = 0; a < 2; ++a)
#pragma unroll
            for (int b = 0; b < 2; ++b)
#pragma unroll
                for (int m = 0; m < 4; ++m)
#pragma unroll
                    for (int n = 0; n < 2; ++n) acc[a][b][m][n] = (f32x4){0.f, 0.f, 0.f, 0.f};
        cur = nxt; cA = nA; cB = nB; ++ui;
        if (wr == 1) PG8_BAR;
    }
    PG8_WAIT_V(0);
    PG8_BAR;
#undef PG8_SA
#undef PG8_SB
#undef PG8_STAGE
#undef PG8_STAGE_A
#undef PG8_LDA
#undef PG8_RDA
#undef PG8_RDB
#undef PG8_LDB
#undef PG8_MMA
#undef PG8_WAIT_V
#undef PG8_WAIT_L
#undef PG8_BAR
#undef PG8_SCHED
}
}
namespace pg8 {
__device__ __forceinline__ f32x2 gelu_pk(f32x2 v) {
    const f32x2 av = __builtin_elementwise_abs(v), d = av * 0.2316418882f + 1.0f;
    f32x2 t; t.x = __builtin_amdgcn_rcpf(d.x); t.y = __builtin_amdgcn_rcpf(d.y);
    f32x2 q = t * 0.5307027145f + (-0.7265760135f); q = q * t + 0.7107068705f; q = q * t + (-0.142248368f); q = q * t + 0.127414796f; q = q * t;
    const f32x2 s = (v * v) * (-0.72134752044f);
    f32x2 e; e.x = __builtin_amdgcn_exp2f(s.x); e.y = __builtin_amdgcn_exp2f(s.y);
    const f32x2 m = v * (q * e), r = v - m;
    f32x2 o; o.x = v.x < 0.f ? m.x : r.x; o.y = v.y < 0.f ? m.y : r.y; return o;
}
struct EpiBf16 {
    static constexpr bool PERM = true;
    bf16* O; int ldc; float* ss; int ACT;
    __device__ __forceinline__ void operator()(const f32x4 (&acc)[2][2][4][2], const Unit& u, int wr, int wc, int fr, int fq) const {
        const int row0 = u.pm * BM + wr * 64 + fr, col0 = u.pn * BM + wc * 32 + 8 * fq;
#pragma unroll
        for (int ai = 0; ai < 2; ++ai)
#pragma unroll
            for (int m = 0; m < 4; ++m) { const int row = row0 + ai * HALF + m * 16; bf16* rowp = O + (size_t)row * ldc + col0; float sq = 0.f;
#pragma unroll
                for (int bj = 0; bj < 2; ++bj) { f32x4 v0 = acc[ai][bj][m][0], v1 = acc[ai][bj][m][1];
                    if (ACT == 1) { f32x2 a = gelu_pk((f32x2){v0[0], v0[1]}), b = gelu_pk((f32x2){v0[2], v0[3]}), c = gelu_pk((f32x2){v1[0], v1[1]}), d = gelu_pk((f32x2){v1[2], v1[3]});
                        v0 = (f32x4){a.x, a.y, b.x, b.y}; v1 = (f32x4){c.x, c.y, d.x, d.y};
                        sq += (v0[0] * v0[0] + v0[1] * v0[1]) + (v0[2] * v0[2] + v0[3] * v0[3]) + (v1[0] * v1[0] + v1[1] * v1[1]) + (v1[2] * v1[2] + v1[3] * v1[3]); }
                    v4u w; w.x = cvt_pk_bf16(v0[0], v0[1]); w.y = cvt_pk_bf16(v0[2], v0[3]); w.z = cvt_pk_bf16(v1[0], v1[1]); w.w = cvt_pk_bf16(v1[2], v1[3]);
                    *(v4u*)(rowp + bj * HALF) = w; }
                if (ACT == 1) { sq += __shfl_xor(sq, 16); sq += __shfl_xor(sq, 32);
                    if (u.pn >= 4 && fq == 0) ss[(size_t)row * 16 + (u.pn - 4) * 4 + wc] = sq; }
            }
    }
};
struct EpiResid {
    static constexpr bool PERM = false;
    const float* baseL; const float* baseC; float* outL; float* outC; const float* modl;
    __device__ __forceinline__ void operator()(const f32x4 (&acc)[2][2][4][2], const Unit& u, int wr, int wc, int fr, int fq) const {
        const bool lat = u.pm < ML / BM; const int rb = lat ? u.pm : u.pm - ML / BM, bidx = lat ? (u.pm >> 5) : 8;
        const float* base = (lat ? baseL : baseC) + (size_t)rb * BM * D; float* out = (lat ? outL : outC) + (size_t)rb * BM * D;
        const float* g = modl + bidx * 6144 + 2 * 1024;
        const int r0 = wr * 64 + fr, col0 = u.pn * BM + wc * 32 + 4 * fq;
        f32x4 gv[2][2];
#pragma unroll
        for (int bj = 0; bj < 2; ++bj)
#pragma unroll
            for (int n = 0; n < 2; ++n) gv[bj][n] = *(const f32x4*)(g + col0 + bj * HALF + n * 16);
#pragma unroll
        for (int ai = 0; ai < 2; ++ai)
#pragma unroll
          for (int mp = 0; mp < 2; ++mp) { f32x4 bs[2][2][2];
#pragma unroll
            for (int m2 = 0; m2 < 2; ++m2) { const size_t off = (size_t)(r0 + ai * HALF + (mp * 2 + m2) * 16) * D + col0;
#pragma unroll
                for (int bj = 0; bj < 2; ++bj)
#pragma unroll
                    for (int n = 0; n < 2; ++n) bs[m2][bj][n] = *(const f32x4*)(base + off + bj * HALF + n * 16); }
#pragma unroll
            for (int m2 = 0; m2 < 2; ++m2) { const size_t off = (size_t)(r0 + ai * HALF + (mp * 2 + m2) * 16) * D + col0;
#pragma unroll
                for (int bj = 0; bj < 2; ++bj)
#pragma unroll
                    for (int n = 0; n < 2; ++n) *(f32x4*)(out + off + bj * HALF + n * 16) = bs[m2][bj][n] + gv[bj][n] * acc[ai][bj][mp * 2 + m2][n]; }
            asm volatile("" ::: "memory"); }
    }
};
struct EpiSwiglu {
    static constexpr bool PERM = true;
    unsigned char* O; const float* b1;
    __device__ __forceinline__ void operator()(const f32x4 (&acc)[2][2][4][2], const Unit& u, int wr, int wc, int fr, int fq) const {
        const int row0 = u.pm * BM + wr * 64 + fr, c0 = u.pn * HALF + wc * 32 + 8 * fq; const float* be = b1 + (size_t)u.e * 2048;
        f32x4 bg[2], bl[2];
#pragma unroll
        for (int n = 0; n < 2; ++n) { bg[n] = *(const f32x4*)(be + c0 + 4 * n); bl[n] = *(const f32x4*)(be + 1024 + c0 + 4 * n); }
#pragma unroll
        for (int ai = 0; ai < 2; ++ai)
#pragma unroll
            for (int m = 0; m < 4; ++m) { float o[8];
#pragma unroll
                for (int n = 0; n < 2; ++n)
#pragma unroll
                    for (int j = 0; j < 4; ++j) { float gl = acc[ai][0][m][n][j] + bg[n][j], li = acc[ai][1][m][n][j] + bl[n][j];
                        gl = fminf(gl, 7.0f); li = fminf(fmaxf(li, -7.0f), 7.0f);
                        const float sg = __builtin_amdgcn_rcpf(1.0f + __builtin_amdgcn_exp2f(gl * (-1.702f * 1.4426950408889634f)));
                        o[n * 4 + j] = gl * sg * (li + 1.0f); }
                v2u w; w.x = 0; w.y = 0;
                w.x = __builtin_amdgcn_cvt_pk_fp8_f32(o[0], o[1], w.x, false); w.x = __builtin_amdgcn_cvt_pk_fp8_f32(o[2], o[3], w.x, true);
                w.y = __builtin_amdgcn_cvt_pk_fp8_f32(o[4], o[5], w.y, false); w.y = __builtin_amdgcn_cvt_pk_fp8_f32(o[6], o[7], w.y, true);
                *(v2u*)(O + (size_t)(row0 + ai * HALF + m * 16) * D + c0) = w; }
    }
};
struct EpiBias {
    static constexpr bool PERM = true;
    unsigned char* O; const float* b2;
    __device__ __forceinline__ void operator()(const f32x4 (&acc)[2][2][4][2], const Unit& u, int wr, int wc, int fr, int fq) const {
        const int row0 = u.pm * BM + wr * 64 + fr, col0 = u.pn * BM + wc * 32 + 8 * fq; const float* be = b2 + (size_t)u.e * 1024 + col0;
#pragma unroll
        for (int bj = 0; bj < 2; ++bj) { const f32x4 bv0 = *(const f32x4*)(be + bj * HALF), bv1 = *(const f32x4*)(be + bj * HALF + 4);
#pragma unroll
            for (int ai = 0; ai < 2; ++ai)
#pragma unroll
                for (int m = 0; m < 4; ++m) { const f32x4 v0 = acc[ai][bj][m][0] + bv0, v1 = acc[ai][bj][m][1] + bv1;
                    v2u w; w.x = 0; w.y = 0;
                    w.x = __builtin_amdgcn_cvt_pk_fp8_f32(v0[0], v0[1], w.x, false); w.x = __builtin_amdgcn_cvt_pk_fp8_f32(v0[2], v0[3], w.x, true);
                    w.y = __builtin_amdgcn_cvt_pk_fp8_f32(v1[0], v1[1], w.y, false); w.y = __builtin_amdgcn_cvt_pk_fp8_f32(v1[2], v1[3], w.y, true);
                    *(v2u*)(O + (size_t)(row0 + ai * HALF + m * 16) * D + col0 + bj * HALF) = w; }
            asm volatile("" ::: "memory"); }
    }
};
}

namespace att {
constexpr int AD = 128, NW = 8, QBLK = 32, KVBLK = 64;
constexpr float SCALE = 0.088388347648318440f;
constexpr float THR = 8.f;
constexpr int LDQ = 1024, LDK = 512, LDO = 1024;
constexpr int SHM_V = KVBLK * AD * 2, SHM_K = KVBLK * AD * 2, SHM_ATTN = 2 * SHM_V + 2 * SHM_K + NW * 64 * 4;
#define KSWZ(row, colB) ((row) * 256 + ((colB) ^ (((row) & 7) << 4)))
#define SBAR() __builtin_amdgcn_sched_barrier(0)
__device__ __forceinline__ int crow(int r, int hi) { return (r & 3) + 8 * (r >> 2) + 4 * hi; }
__device__ __forceinline__ void partialSM(f32x16& p0, f32x16& p1, float& m_reg, float& mn, float& alpha) {
  constexpr float C = SCALE * 1.4426950408889634f;
  float pmax = p0[0]; for (int r = 1; r < 16; ++r) pmax = fmaxf(pmax, p0[r]); for (int r = 0; r < 16; ++r) pmax = fmaxf(pmax, p1[r]);
  { auto rr = __builtin_amdgcn_permlane32_swap(__float_as_uint(pmax), __float_as_uint(pmax), false, false);
    pmax = fmaxf(__uint_as_float(rr[0]), __uint_as_float(rr[1])); }
  if (__builtin_expect(__all(pmax - m_reg <= THR / SCALE), 1)) { mn = m_reg; alpha = 1.f; }
  else { mn = fmaxf(m_reg, pmax); alpha = __builtin_amdgcn_exp2f((m_reg - mn) * C); m_reg = mn; }
  float mnC = -mn * C;
  for (int r = 0; r < 16; ++r) p0[r] = fmaf(p0[r], C, mnC); for (int r = 0; r < 16; ++r) p1[r] = fmaf(p1[r], C, mnC);
  for (int r = 0; r < 16; ++r) p0[r] = __builtin_amdgcn_exp2f(p0[r]);
}
__device__ __forceinline__ void finishSM(f32x16& p0, f32x16& p1, float alpha, float& l_reg, bf16x8& pa0, bf16x8& pa1, bf16x8& pa2, bf16x8& pa3) {
  for (int r = 0; r < 16; ++r) p1[r] = __builtin_amdgcn_exp2f(p1[r]);
  float ps = 0; for (int r = 0; r < 16; ++r) ps += p0[r]; for (int r = 0; r < 16; ++r) ps += p1[r];
  { auto rr = __builtin_amdgcn_permlane32_swap(__float_as_uint(ps), __float_as_uint(ps), false, false);
    ps = __uint_as_float(rr[0]) + __uint_as_float(rr[1]); }
  l_reg = l_reg * alpha + ps;
#define PK4(P, BASE, OUT) do { unsigned a0 = cvt_pk_bf16(P[BASE + 0], P[BASE + 1]), a1 = cvt_pk_bf16(P[BASE + 2], P[BASE + 3]);   \
    unsigned b0 = cvt_pk_bf16(P[BASE + 4], P[BASE + 5]), b1 = cvt_pk_bf16(P[BASE + 6], P[BASE + 7]);                              \
    auto r0 = __builtin_amdgcn_permlane32_swap(a0, b0, false, false); auto r1 = __builtin_amdgcn_permlane32_swap(a1, b1, false, false); \
    v4u w = {r0[0], r1[0], r0[1], r1[1]}; OUT = *reinterpret_cast<bf16x8*>(&w); } while (0)
  PK4(p0, 0, pa0); PK4(p0, 8, pa1); PK4(p1, 0, pa2); PK4(p1, 8, pa3);
#undef PK4
}
__device__ __forceinline__ void qkt(f32x16& p0, f32x16& p1, const bf16* Ks, const bf16x8* qr, int r32, int hi) {
  p0 = f32x16{}; p1 = f32x16{};
  for (int d0 = 0; d0 < 8; ++d0) { int cb = (d0 * 16 + hi * 8) * 2;
    bf16x8 b0 = *reinterpret_cast<const bf16x8*>((const char*)Ks + KSWZ(r32, cb));
    bf16x8 b1 = *reinterpret_cast<const bf16x8*>((const char*)Ks + KSWZ(32 + r32, cb));
    p0 = __builtin_amdgcn_mfma_f32_32x32x16_bf16(b0, qr[d0], p0, 0, 0, 0);
    p1 = __builtin_amdgcn_mfma_f32_32x32x16_bf16(b1, qr[d0], p1, 0, 0, 0); }
}
__device__ __forceinline__ int v_st(int k, int c) { const int kk = (k & ~0xC) | ((k & 4) << 1) | ((k & 8) >> 1); return ((kk >> 3) * 4 + (c >> 5)) * 512 + ((kk & 7) * 32 + (c & 31)) * 2; }
__device__ __forceinline__ int v_rd_base(int lane) { return ((lane & 3) << 3) | (((lane >> 2) & 3) << 6) | (((lane >> 4) & 1) << 5) | (((lane >> 5) & 1) << 8); }
constexpr int v_rd_off(int d0, int ks, int half) { return d0 * 512 + ks * 4096 + half * 2048; }
template <int OFF> __device__ __forceinline__ s16x4 tr_read(int vb) {
  s16x4 r; asm volatile("ds_read_b64_tr_b16 %0, %1 offset:%2" : "=&v"(r) : "v"(vb), "i"(OFF) : "memory"); return r;
}
template <int D0> __device__ __forceinline__ void pv_one(f32x16& od, int vb, bf16x8 pa0, bf16x8 pa1, bf16x8 pa2, bf16x8 pa3) {
  const s16x4 l0 = tr_read<v_rd_off(D0, 0, 0)>(vb), h0 = tr_read<v_rd_off(D0, 0, 1)>(vb), l1 = tr_read<v_rd_off(D0, 1, 0)>(vb), h1 = tr_read<v_rd_off(D0, 1, 1)>(vb);
  const s16x4 l2 = tr_read<v_rd_off(D0, 2, 0)>(vb), h2 = tr_read<v_rd_off(D0, 2, 1)>(vb), l3 = tr_read<v_rd_off(D0, 3, 0)>(vb), h3 = tr_read<v_rd_off(D0, 3, 1)>(vb);
  asm volatile("s_waitcnt lgkmcnt(0)" ::: "memory"); SBAR();
#define PK(L, H) (bf16x8){L[0], L[1], L[2], L[3], H[0], H[1], H[2], H[3]}
  od = __builtin_amdgcn_mfma_f32_32x32x16_bf16(pa0, PK(l0, h0), od, 0, 0, 0);
  od = __builtin_amdgcn_mfma_f32_32x32x16_bf16(pa1, PK(l1, h1), od, 0, 0, 0);
  od = __builtin_amdgcn_mfma_f32_32x32x16_bf16(pa2, PK(l2, h2), od, 0, 0, 0);
  od = __builtin_amdgcn_mfma_f32_32x32x16_bf16(pa3, PK(l3, h3), od, 0, 0, 0);
#undef PK
}
__device__ __forceinline__ void pv_d0(f32x16* o, int vb, bf16x8 pa0, bf16x8 pa1, bf16x8 pa2, bf16x8 pa3) {
  pv_one<0>(o[0], vb, pa0, pa1, pa2, pa3); pv_one<1>(o[1], vb, pa0, pa1, pa2, pa3); pv_one<2>(o[2], vb, pa0, pa1, pa2, pa3); pv_one<3>(o[3], vb, pa0, pa1, pa2, pa3);
}
__device__ __forceinline__ void attn_dense_body(const bf16* __restrict__ Qb, const bf16* __restrict__ Kh, const bf16* __restrict__ Vh, bf16* __restrict__ Ob, int seq, char* lds, int wave_id) {
  const int tid = opaque_tid(wave_id), wid = tid >> 6, lane = tid & 63, r32 = lane & 31, hi = lane >> 5;
  bf16* V_lds = (bf16*)lds; bf16* K_lds = (bf16*)(lds + 2 * SHM_V);
  float* ws = (float*)(lds + 2 * SHM_V + 2 * SHM_K) + wid * 64; float* li_l = ws; float* al_l = ws + 32;
  float m_reg = -1e30f, l_reg = 0; f32x16 o[4] = {}; bf16x8 qr[8];
  const bf16* Qw = Qb + (long)(wid * QBLK + r32) * LDQ + hi * 8;
#pragma unroll
  for (int d0 = 0; d0 < 8; ++d0) qr[d0] = *reinterpret_cast<const bf16x8*>(Qw + d0 * 16);
  const int sr = tid >> 4, sc = (tid & 15) * 8, vst0 = v_st(sr, sc), vst1 = v_st(32 + sr, sc);
  const int vb0 = (int)(uintptr_t)V_lds + v_rd_base(lane);
  struct { bf16x8 vs0, vs1, ks0, ks1; } sr_[2];
#define SLOAD(i, k0) do { sr_[i].vs0 = *reinterpret_cast<const bf16x8*>(&Vh[(long)((k0) + sr) * LDK + sc]); sr_[i].vs1 = *reinterpret_cast<const bf16x8*>(&Vh[(long)((k0) + 32 + sr) * LDK + sc]); \
    sr_[i].ks0 = *reinterpret_cast<const bf16x8*>(&Kh[(long)((k0) + sr) * LDK + sc]); sr_[i].ks1 = *reinterpret_cast<const bf16x8*>(&Kh[(long)((k0) + 32 + sr) * LDK + sc]); } while (0)
#define SWRITE(b, i) do { *(bf16x8*)((char*)V_lds + (b) * SHM_V + vst0) = sr_[i].vs0;          \
    *(bf16x8*)((char*)V_lds + (b) * SHM_V + vst1) = sr_[i].vs1; int kc = sc * 2;               \
    *(bf16x8*)((char*)K_lds + (b) * SHM_K + KSWZ(sr, kc)) = sr_[i].ks0;                       \
    *(bf16x8*)((char*)K_lds + (b) * SHM_K + KSWZ(32 + sr, kc)) = sr_[i].ks1; } while (0)
#define SWAIT() asm volatile("s_waitcnt vmcnt(4)" ::: "memory")
#define RESC(a) do { if (__any((a) < 1.f)) { if (hi == 0) al_l[r32] = (a); asm volatile("s_waitcnt lgkmcnt(0)" ::: "memory"); \
    for (int d = 0; d < 4; ++d) for (int r = 0; r < 16; ++r) o[d][r] *= al_l[crow(r, hi)]; } } while (0)
  f32x16 pA0, pA1, pB0, pB1; float mnA, mnB, alA, alB; bf16x8 pa0, pa1, pa2, pa3; const int NT = seq / KVBLK;
  constexpr int SE = 0, SO = 1;
  SLOAD(SE, 0); asm volatile("s_waitcnt vmcnt(0)" ::: "memory"); SWRITE(0, SE); __syncthreads();
  qkt(pA0, pA1, K_lds, qr, r32, hi); partialSM(pA0, pA1, m_reg, mnA, alA);
  SLOAD(SO, KVBLK); if (2 < NT) SLOAD(SE, 2 * KVBLK);
  SWAIT(); SWRITE(1, SO); __syncthreads();
  for (int j = 1; j + 1 < NT; j += 2) {
    SBAR(); qkt(pB0, pB1, (bf16*)((char*)K_lds + SHM_K), qr, r32, hi);
    finishSM(pA0, pA1, alA, l_reg, pa0, pa1, pa2, pa3); SBAR();
    SLOAD(SO, (j + 2) * KVBLK); SBAR();
    pv_d0(o, vb0, pa0, pa1, pa2, pa3); partialSM(pB0, pB1, m_reg, mnB, alB);
    __syncthreads(); SWAIT(); SWRITE(0, SE);
    RESC(alB); __syncthreads();
    SBAR(); qkt(pA0, pA1, K_lds, qr, r32, hi);
    finishSM(pB0, pB1, alB, l_reg, pa0, pa1, pa2, pa3); SBAR();
    if (j + 3 < NT) SLOAD(SE, (j + 3) * KVBLK); SBAR();
    pv_d0(o, vb0 + (int)SHM_V, pa0, pa1, pa2, pa3); partialSM(pA0, pA1, m_reg, mnA, alA);
    __syncthreads(); SWAIT(); SWRITE(1, SO);
    RESC(alA); __syncthreads();
  }
  SBAR(); qkt(pB0, pB1, (bf16*)((char*)K_lds + SHM_K), qr, r32, hi);
  finishSM(pA0, pA1, alA, l_reg, pa0, pa1, pa2, pa3); SBAR();
  pv_d0(o, vb0, pa0, pa1, pa2, pa3); partialSM(pB0, pB1, m_reg, mnB, alB);
  __syncthreads(); RESC(alB);
  finishSM(pB0, pB1, alB, l_reg, pa0, pa1, pa2, pa3); SBAR();
  pv_d0(o, vb0 + (int)SHM_V, pa0, pa1, pa2, pa3);
  if (hi == 0) li_l[r32] = l_reg; asm volatile("s_waitcnt lgkmcnt(0)" ::: "memory");
  float rli[16];
#pragma unroll
  for (int r = 0; r < 16; ++r) rli[r] = __builtin_amdgcn_rcpf(li_l[crow(r, hi)]);
  bf16* Ow = Ob + (long)(wid * QBLK) * LDO;
#pragma unroll
  for (int r = 0; r < 16; ++r) { int orow = crow(r, hi);
    for (int d0 = 0; d0 < 4; ++d0) Ow[(long)orow * LDO + d0 * 32 + r32] = (bf16)f2bf(o[d0][r] * rli[r]); }
  __syncthreads();
#undef SLOAD
#undef SWRITE
#undef SWAIT
#undef RESC
}
#undef KSWZ
}
constexpr int NWAVES = 8, NTHREADS = 512;
struct Args { const float* in[36]; float* out; unsigned char* ws; int ph_lo, ph_hi; };
enum InIdx { I_X = 0, I_C, I_CTX, I_CCTX, I_ADAW, I_ADAB, I_N1G, I_N2G, I_WOUT, I_RW, I_RB, I_EW1, I_EB1, I_EW2, I_EB2, I_AWIN, I_AQG, I_AKG,
             I_GWIN, I_GVG, I_GWS, I_GBS, I_HWIN, I_HCW, I_HCB, I_FW1, I_FB1, I_FW2, I_FB2, I_FW3, I_FB3, I_FW4, I_FB4, I_FREQ, I_HD, I_FG };
struct Frame {
    LAS unsigned char* lds; volatile LAS unsigned* MISC; gu32* ctl;
    int tid, lane, wave, G, bx;
    float* out; unsigned char* ws;
};
template <class T> __device__ __forceinline__ T* launder(T* p) { unsigned long long v = (unsigned long long)p; asm volatile("" : "+s"(v)); return (T*)(GAS T*)v; }
constexpr int MW_PTRS = 640;
__device__ __forceinline__ const float* pin_load(const Frame& F, int i) {
    const unsigned lo = __builtin_amdgcn_readfirstlane(F.MISC[MW_PTRS + 2 * i]), hi = __builtin_amdgcn_readfirstlane(F.MISC[MW_PTRS + 2 * i + 1]);
    return (const float*)(GAS const float*)(((unsigned long long)hi << 32) | lo);
}
#define PIN(F, i) pin_load(F, i)
__device__ __forceinline__ Frame phase_frame(const Frame& F0) {
    Frame F = F0; F.tid = opaque_tid(F0.wave); F.lane = F.tid & 63; F.wave = F0.wave;
    F.ws = launder(F0.ws); F.out = launder(F0.out); F.ctl = (gu32*)(F.ws + WS_CTL);
    { LAS unsigned char* l = F0.lds; asm volatile("" : "+s"(l)); F.lds = l; F.MISC = (volatile LAS unsigned*)(l + MISC_OFF); }
    return F;
}
constexpr int PH_PRO0 = 0, PH_PRO1 = 1, PH_L0 = 2, PH_PER_LAYER = 9, PH_FINAL = PH_L0 + NLAYER * PH_PER_LAYER, PH_COUNT = PH_FINAL + 1;
enum LPhase { LP_NORM1 = 0, LP_INPROJ, LP_MIX1, LP_MIX2, LP_MIX3, LP_OUTPROJ, LP_NORM2, LP_MOE1, LP_MOE2 };

template <bool FP8> __device__ __forceinline__ void transpose_item(const float* W, int N, void* WT, int k0, int n0, int drow0, LAS float* scr, int lane) {
    constexpr int K = 1024;
    float v[64];
    const float* src = W + (size_t)k0 * N + n0 + lane;
#pragma unroll
    for (int kk = 0; kk < 64; ++kk) v[kk] = src[(size_t)kk * N];
#pragma unroll
    for (int kk = 0; kk < 64; ++kk) scr[kk * 65 + lane] = v[kk];
    LDS_WAIT(); asm volatile("" ::: "memory");
    if constexpr (!FP8) {
        const int c = lane & 7;
#pragma unroll
        for (int j = 0; j < 8; ++j) { const int n = (lane >> 3) + 8 * j; const LAS float* s = scr + (8 * c) * 65 + n;
            v4u o; o.x = pk2(s[0 * 65], s[1 * 65]); o.y = pk2(s[2 * 65], s[3 * 65]); o.z = pk2(s[4 * 65], s[5 * 65]); o.w = pk2(s[6 * 65], s[7 * 65]);
            *(GAS v4u*)((bf16*)WT + (size_t)(drow0 + n) * K + k0 + 8 * c) = o; }
    } else {
        const int c = lane & 3;
#pragma unroll
        for (int j = 0; j < 4; ++j) { const int n = (lane >> 2) + 16 * j; const LAS float* s = scr + (16 * c) * 65 + n; unsigned w[4];
#pragma unroll
            for (int q = 0; q < 4; ++q) { unsigned x = 0; x = __builtin_amdgcn_cvt_pk_fp8_f32(32.0f * s[(4 * q) * 65], 32.0f * s[(4 * q + 1) * 65], x, false);
                x = __builtin_amdgcn_cvt_pk_fp8_f32(32.0f * s[(4 * q + 2) * 65], 32.0f * s[(4 * q + 3) * 65], x, true); w[q] = x; }
            *(GAS v4u*)((unsigned char*)WT + (size_t)(drow0 + n) * K + k0 + 16 * c) = (v4u){w[0], w[1], w[2], w[3]}; }
    }
    LDS_WAIT(); asm volatile("" ::: "memory");
}
__device__ __forceinline__ void pro0_transposes(Frame& F) {
    LAS float* scr = (LAS float*)(F.lds + F.wave * 16640);
    const int gw = F.bx * NWAVES + F.wave, NGW = F.G * NWAVES;
    constexpr int R0 = 128 * 512, R1 = 128 * 256, R2 = 2 * 384, R3 = 512, R4 = 768, R5 = 4 * 256, NITEMS = R0 + R1 + R2 + R3 + R4 + R5;
    for (int it = gw; it < NITEMS; it += NGW) {
        int r = it;
        if (r < R0) { const int mi = r >> 9, q = r & 511, kb = q >> 5, nb = q & 31, n0 = nb * 64;
            const int d0 = n0 < 1024 ? 256 * (n0 >> 7) + (n0 & 127) : 256 * ((n0 - 1024) >> 7) + 128 + (n0 & 127);
            transpose_item<true>(PIN(F, I_EW1) + (size_t)mi * 1024 * 2048, 2048, F.ws + WS_WE1 + (size_t)mi * 2048 * 1024, kb * 64, n0, d0, scr, F.lane); continue; } r -= R0;
        if (r < R1) { const int mi = r >> 8, q = r & 255, kb = q >> 4, nb = q & 15;
            transpose_item<true>(PIN(F, I_EW2) + (size_t)mi * 1024 * 1024, 1024, F.ws + WS_WE2 + (size_t)mi * 1024 * 1024, kb * 64, nb * 64, nb * 64, scr, F.lane); continue; } r -= R1;
        if (r < R2) { const int mi = r / 384, q = r % 384, kb = q / 24, nb = q % 24;
            transpose_item<false>(PIN(F, I_AWIN) + (size_t)mi * 1024 * 1536, 1536, F.ws + WS_WATT + (size_t)mi * 1536 * 1024 * 2, kb * 64, nb * 64, nb * 64, scr, F.lane); continue; } r -= R2;
        if (r < R3) { const int kb = r >> 5, nb = r & 31;
            transpose_item<false>(PIN(F, I_GWIN), 2048, F.ws + WS_WGM, kb * 64, nb * 64, nb * 64, scr, F.lane); continue; } r -= R3;
        if (r < R4) { const int kb = r / 48, nb = r % 48;
            transpose_item<false>(PIN(F, I_HWIN), 3072, F.ws + WS_WHY, kb * 64, nb * 64, nb * 64, scr, F.lane); continue; } r -= R4;
        { const int mi = r >> 8, q = r & 255, kb = q >> 4, nb = q & 15;
            transpose_item<false>(PIN(F, I_WOUT) + (size_t)mi * 1024 * 1024, 1024, F.ws + WS_WOUT + (size_t)mi * 1024 * 1024 * 2, kb * 64, nb * 64, nb * 64, scr, F.lane); }
    }
}
__device__ __forceinline__ void pro0_mod(Frame& F) {
    LAS float* sl = (LAS float*)F.lds;
    LAS float* red = (LAS float*)(F.lds + 65536);
    __syncthreads();
    for (int i = F.tid; i < 9 * 1024; i += NTHREADS) { const int r = i >> 10, k = i & 1023; const float v = r < 8 ? PIN(F, I_C)[r * 1024 + k] : PIN(F, I_CCTX)[k]; sl[i] = v / (1.0f + __expf(-v)); }
    __syncthreads();
    float* MOD = (float*)(F.ws + WS_MOD);
    for (int item = F.bx; item < NLAYER * 96; item += F.G) {
        const int l = item / 96, n0 = (item % 96) * 64;
        const float* W = PIN(F, I_ADAW) + (size_t)l * 1024 * 6144 + n0 + F.lane;
        float acc[9];
#pragma unroll
        for (int r = 0; r < 9; ++r) acc[r] = 0.f;
        const int kb = F.wave * 128;
#pragma unroll 4
        for (int k = 0; k < 128; ++k) { const float wv = W[(size_t)(kb + k) * 6144];
#pragma unroll
            for (int r = 0; r < 9; ++r) acc[r] += sl[r * 1024 + kb + k] * wv; }
#pragma unroll
        for (int r = 0; r < 9; ++r) red[(F.wave * 9 + r) * 64 + F.lane] = acc[r];
        __syncthreads();
        for (int i = F.tid; i < 9 * 64; i += NTHREADS) { const int r = i >> 6, n = i & 63; float s = 0.f;
#pragma unroll
            for (int w = 0; w < 8; ++w) s += red[(w * 9 + r) * 64 + n];
            MOD[((size_t)l * 9 + r) * 6144 + n0 + n] = s + PIN(F, I_ADAB)[l * 6144 + n0 + n]; }
        __syncthreads();
    }
}
__device__ __forceinline__ void pro0_filter_mlp(Frame& F) {
    const int j = F.lane, gw = F.bx * NWAVES + F.wave, NGW = F.G * NWAVES;
    LAS float* W1 = (LAS float*)F.lds; LAS float* W2 = W1 + FEMB * FH; LAS float* W3 = W2 + FH * FH;
    __syncthreads();
    for (int i = F.tid; i < FEMB * FH; i += NTHREADS) W1[i] = PIN(F, I_FW1)[i];
    for (int i = F.tid; i < FH * FH; i += NTHREADS) { W2[i] = PIN(F, I_FW2)[i]; W3[i] = PIN(F, I_FW3)[i]; }
    __syncthreads();
    const float b1 = PIN(F, I_FB1)[j], b2 = PIN(F, I_FB2)[j], b3 = PIN(F, I_FB3)[j], fr = PIN(F, I_FREQ)[j];
    for (int it = gw; it < SEQ + CL; it += NGW) {
        const bool lat = it < SEQ; const int t = lat ? it : it - SEQ; const float L = lat ? (float)SEQ : (float)CL;
        const float tl = (float)t / (L - 1.0f), w = (6.283185307179586f * (float)t) / L;
        float z;
        { const int band = (j - 1) & 15; const float f = 1e-4f + (float)band * ((15.0f - 1e-4f) / 15.0f); const float a = f * w;
          z = (j == 0) ? tl : (j <= 16 ? cosf(a) : -sinf(a)); }
        float s = b1;
#pragma unroll
        for (int i = 0; i < FEMB; ++i) s += __shfl(z, i) * W1[i * FH + j];
        const float a1 = sinf(fr * s);
        s = b2;
#pragma unroll 16
        for (int i = 0; i < FH; ++i) s += __shfl(a1, i) * W2[i * FH + j];
        const float a2 = sinf(fr * s);
        s = b3;
#pragma unroll 16
        for (int i = 0; i < FH; ++i) s += __shfl(a2, i) * W3[i * FH + j];
        const float a3 = sinf(fr * s);
        float* dst = lat ? (float*)(F.ws + WS_A3) + (size_t)t * FH : (float*)(F.ws + WS_A3C) + (size_t)t * FH;
        dst[j] = a3;
    }
    __syncthreads();
}

__device__ __forceinline__ f32x2 cmul(f32x2 a, f32x2 b) { return (f32x2){a.x * b.x - a.y * b.y, a.x * b.y + a.y * b.x}; }
__device__ __forceinline__ f32x2 cconj(f32x2 a) { return (f32x2){a.x, -a.y}; }
#define ZP(n) ((n) + ((n) >> 5))
constexpr int FFT_LDS_BYTES = (NFFT + NFFT / 32) * 8;
__device__ __forceinline__ void bfly_dif(f32x2& a0, f32x2& a1, f32x2& a2, f32x2& a3, f32x2 w) {
    const f32x2 t0 = a0 + a2, t1 = a0 - a2, t2 = a1 + a3, d = a1 - a3, t3 = (f32x2){d.y, -d.x};
    const f32x2 y0 = t0 + t2, y2 = t0 - t2, y1 = t1 + t3, y3 = t1 - t3, w2 = cmul(w, w), w3 = cmul(w2, w);
    a0 = y0; a1 = cmul(y2, w2); a2 = cmul(y1, w); a3 = cmul(y3, w3);
}
__device__ __forceinline__ void bfly_dit(f32x2& a0, f32x2& a1, f32x2& a2, f32x2& a3, f32x2 w) {
    const f32x2 w2 = cmul(w, w), w3 = cmul(w2, w), A1 = cmul(a1, w2), A2 = cmul(a2, w), A3 = cmul(a3, w3);
    const f32x2 u0 = a0 + A1, u1 = a0 - A1, u2 = A2 + A3, u3 = A2 - A3, iu3 = (f32x2){-u3.y, u3.x};
    a0 = u0 + u2; a1 = u1 + iu3; a2 = u0 - u2; a3 = u1 - iu3;
}
template <int LQ, bool INV> __device__ __forceinline__ void fft_r16(LAS f32x2* z, int tid) {
    constexpr int q16 = 1 << LQ; constexpr float inv_lb = 1.0f / (float)(16 * q16);
    constexpr float C1 = 0.92387953251128674f, S1 = 0.38268343236508977f, C2 = 0.70710678118654752f;
    asm volatile("" : "+v"(tid));
#pragma unroll 1
    for (int g = tid; g < NFFT / 16; g += NTHREADS) {
        const int j = g & (q16 - 1), base = ((g >> LQ) << (LQ + 4)) + j;
        f32x2 x[16];
#pragma unroll
        for (int m = 0; m < 16; ++m) x[m] = z[ZP(base + (m << LQ))];
        const float fr = (float)j * inv_lb; const float sn = __builtin_amdgcn_sinf(fr);
        const f32x2 w1 = (f32x2){__builtin_amdgcn_cosf(fr), INV ? sn : -sn};
        const float sg = INV ? 1.0f : -1.0f;
        const f32x2 wa0 = w1, wa1 = cmul(w1, (f32x2){C1, sg * S1}), wa2 = cmul(w1, (f32x2){C2, sg * C2}), wa3 = cmul(w1, (f32x2){S1, sg * C1});
        const f32x2 w2 = cmul(w1, w1), wb = cmul(w2, w2);
        if constexpr (!INV) {
            bfly_dif(x[0], x[4], x[8], x[12], wa0); bfly_dif(x[1], x[5], x[9], x[13], wa1); bfly_dif(x[2], x[6], x[10], x[14], wa2); bfly_dif(x[3], x[7], x[11], x[15], wa3);
#pragma unroll
            for (int a = 0; a < 4; ++a) bfly_dif(x[4 * a], x[4 * a + 1], x[4 * a + 2], x[4 * a + 3], wb);
        } else {
#pragma unroll
            for (int a = 0; a < 4; ++a) bfly_dit(x[4 * a], x[4 * a + 1], x[4 * a + 2], x[4 * a + 3], wb);
            bfly_dit(x[0], x[4], x[8], x[12], wa0); bfly_dit(x[1], x[5], x[9], x[13], wa1); bfly_dit(x[2], x[6], x[10], x[14], wa2); bfly_dit(x[3], x[7], x[11], x[15], wa3);
        }
#pragma unroll
        for (int m = 0; m < 16; ++m) z[ZP(base + (m << LQ))] = x[m];
    }
    __syncthreads();
}
template <bool INV> __device__ __forceinline__ void fft_r4_unit(LAS f32x2* z, int tid) {
    asm volatile("" : "+v"(tid));
#pragma unroll 2
    for (int bf = tid; bf < NFFT / 4; bf += NTHREADS) {
        const int base = 4 * bf; f32x2 a0 = z[ZP(base)], a1 = z[ZP(base + 1)], a2 = z[ZP(base + 2)], a3 = z[ZP(base + 3)];
        if constexpr (!INV) { const f32x2 t0 = a0 + a2, t1 = a0 - a2, t2 = a1 + a3, d = a1 - a3, t3 = (f32x2){d.y, -d.x};
            z[ZP(base)] = t0 + t2; z[ZP(base + 1)] = t0 - t2; z[ZP(base + 2)] = t1 + t3; z[ZP(base + 3)] = t1 - t3; }
        else { const f32x2 u0 = a0 + a1, u1 = a0 - a1, u2 = a2 + a3, u3 = a2 - a3, iu3 = (f32x2){-u3.y, u3.x};
            z[ZP(base)] = u0 + u2; z[ZP(base + 1)] = u1 + iu3; z[ZP(base + 2)] = u0 - u2; z[ZP(base + 3)] = u1 - iu3; }
    }
    __syncthreads();
}
__device__ __forceinline__ void fft16k_dif(LAS f32x2* z, int tid) { fft_r16<10, false>(z, tid); fft_r16<6, false>(z, tid); fft_r16<2, false>(z, tid); fft_r4_unit<false>(z, tid); }
__device__ __forceinline__ void fft16k_dit_inv(LAS f32x2* z, int tid) { fft_r4_unit<true>(z, tid); fft_r16<2, true>(z, tid); fft_r16<6, true>(z, tid); fft_r16<10, true>(z, tid); }
constexpr int KF_LD = 8256;
__device__ __forceinline__ int rev14(int p) { return (int)(__brev((unsigned)p) >> 18); }
__device__ __forceinline__ float hy_delta(int c) { const float mn = -3.0701134573253945f, mx = -15.350567286626973f; return fabsf(mn + (mx - mn) * ((float)c / 1023.0f)); }

__device__ __forceinline__ void pro1_filters(Frame& F) {
    { const int gw = F.bx * NWAVES + F.wave;
      if (gw < NLAYER * 9) { const int l = gw / 9, e = F.lane & 31, hf = F.lane >> 5; const float* sh = (const float*)(F.ws + WS_MOD) + (size_t)gw * 6144 + 3 * 1024; const float* rw = PIN(F, I_RW) + (size_t)l * D * NE;
          float acc = 0.f; for (int k = hf * 512; k < hf * 512 + 512; ++k) acc += sh[k] * rw[(size_t)k * NE + e];
          acc += __shfl_xor(acc, 32); if (F.lane < 32) ((float*)(F.ws + WS_RC))[gw * NE + e] = acc + PIN(F, I_RB)[l * NE + e]; } }
    LAS f32x2* z = (LAS f32x2*)F.lds;
    LAS float* wl = (LAS float*)(F.lds + AUX_OFF + 8192);
    const float* a3 = (const float*)(F.ws + WS_A3); const float* a3c = (const float*)(F.ws + WS_A3C);
    f32x2* KF = (f32x2*)(F.ws + WS_KF); float* FCT = (float*)(F.ws + WS_FCT);
    for (int u = F.bx; u < 512; u += F.G) {
        const int ca = 2 * u, cb = 2 * u + 1;
        __syncthreads();
        if (F.tid < 256) { const int which = F.tid >> 6, m = F.tid & 63; const int col = (which & 1 ? cb : ca) + (which >> 1) * 1024; wl[which * 64 + m] = PIN(F, I_FW4)[m * 2048 + col]; }
        if (F.tid < 4) { const int col = (F.tid & 1 ? cb : ca) + (F.tid >> 1) * 1024; wl[256 + F.tid] = PIN(F, I_FB4)[col]; }
        __syncthreads();
        const float da = hy_delta(ca), db = hy_delta(cb);
        for (int t = F.tid; t < SEQ; t += NTHREADS) {
            const f32x4* ar = (const f32x4*)(a3 + (size_t)t * FH); float s0 = wl[256], s1 = wl[257], s2 = wl[258], s3 = wl[259];
#pragma unroll 4
            for (int m4 = 0; m4 < 16; ++m4) { const f32x4 a = ar[m4];
#pragma unroll
                for (int i = 0; i < 4; ++i) { const int m = m4 * 4 + i; s0 += a[i] * wl[m]; s1 += a[i] * wl[64 + m]; s2 += a[i] * wl[128 + m]; s3 += a[i] * wl[192 + m]; } }
            const float tl = (float)t / (float)(SEQ - 1); const float wa = __expf(-tl * da), wb = __expf(-tl * db);
            z[ZP(t)] = (f32x2){s0 * wa, s1 * wb};
            if (t == 0) z[ZP(SEQ)] = (f32x2){0.f, 0.f}; else z[ZP(NFFT - t)] = (f32x2){s2 * wa, s3 * wb};
        }
        for (int i = F.tid; i < 511; i += NTHREADS) {
            const int d = i - 255, t = d < 0 ? -d : d; const int o = d < 0 ? 2 : 0;
            const float* ar = a3c + (size_t)t * FH; float sa = wl[256 + o], sb = wl[257 + o];
            for (int m = 0; m < FH; ++m) { const float a = ar[m]; sa += a * wl[o * 64 + m]; sb += a * wl[(o + 1) * 64 + m]; }
            const float tl = (float)t / (float)(CL - 1);
            FCT[(size_t)ca * 512 + d + 256] = sa * __expf(-tl * da); FCT[(size_t)cb * 512 + d + 256] = sb * __expf(-tl * db);
        }
        __syncthreads();
        fft16k_dif(z, F.tid);
        for (int k = F.tid; k <= NFFT / 2; k += NTHREADS) {
            const int p = rev14(k), p2 = rev14((NFFT - k) & (NFFT - 1)); const f32x2 a = z[ZP(p)], b = z[ZP(p2)];
            KF[(size_t)ca * KF_LD + k] = (f32x2){0.5f * (a.x + b.x), 0.5f * (a.y - b.y)};
            KF[(size_t)cb * KF_LD + k] = (f32x2){0.5f * (a.y + b.y), -0.5f * (a.x - b.x)};
        }
    }
    __syncthreads();
}

__device__ __forceinline__ void hyena_conv_phase(Frame& F) {
    LAS f32x2* z = (LAS f32x2*)F.lds;
    LAS float* aux = (LAS float*)(F.lds + AUX_OFF + 8192);
    const float* VT = (const float*)(F.ws + WS_VT); const float* VTC = (const float*)(F.ws + WS_VTC); float* CT = (float*)(F.ws + WS_CT); float* CTC = (float*)(F.ws + WS_CTC);
    const f32x2* KF = (const f32x2*)(F.ws + WS_KF); const float* FCT = (const float*)(F.ws + WS_FCT);
    f32x4 ina[4], inb[4];
#define HC_LOADIN(u_, t_) do { const int b_ = (u_) >> 9, c_ = 2 * ((u_) & 511); const f32x4* va_ = (const f32x4*)(VT + ((size_t)b_ * 1024 + c_) * SEQ + 16 * (t_)); \
        _Pragma("unroll") for (int i = 0; i < 4; ++i) { ina[i] = va_[i]; inb[i] = va_[SEQ / 4 + i]; } } while (0)
    if (F.bx < NB * 512) HC_LOADIN(F.bx, F.tid);
    for (int u = F.bx; u < NB * 512; u += F.G) {
        const int b = u >> 9, cp = u & 511, ca = 2 * cp, cb = ca + 1;
        int tq = F.tid; asm volatile("" : "+v"(tq));
        __syncthreads();
        { const int n0 = 16 * tq;
#pragma unroll
          for (int i = 0; i < 4; ++i) {
              z[ZP(n0 + 4 * i)] = (f32x2){ina[i].x, inb[i].x}; z[ZP(n0 + 4 * i + 1)] = (f32x2){ina[i].y, inb[i].y}; z[ZP(n0 + 4 * i + 2)] = (f32x2){ina[i].z, inb[i].z}; z[ZP(n0 + 4 * i + 3)] = (f32x2){ina[i].w, inb[i].w};
#pragma unroll
              for (int j = 0; j < 4; ++j) z[ZP(SEQ + n0 + 4 * i + j)] = (f32x2){0.f, 0.f}; } }
        f32x4 ka[8], kb[8]; f32x2 kaN, kbN;
        { const f32x4* pa = (const f32x4*)(KF + (size_t)ca * KF_LD + 16 * tq); const f32x4* pb = (const f32x4*)(KF + (size_t)cb * KF_LD + 16 * tq);
#pragma unroll
          for (int i = 0; i < 8; ++i) { ka[i] = pa[i]; kb[i] = pb[i]; }
          kaN = KF[(size_t)ca * KF_LD + NFFT / 2]; kbN = KF[(size_t)cb * KF_LD + NFFT / 2]; }
        { const int h = tq >> 8, t = tq & 255; const float* vc = VTC + ((size_t)b * 1024 + ca + h) * CL;
          aux[h * 256 + t] = vc[t]; aux[512 + h * 512 + t] = FCT[(size_t)(ca + h) * 512 + t]; aux[512 + h * 512 + 256 + t] = FCT[(size_t)(ca + h) * 512 + 256 + t];
          __syncthreads();
          float y = 0.f;
#pragma unroll 8
          for (int s = 0; s < CL; ++s) y += aux[h * 256 + s] * aux[512 + h * 512 + (t - s) + 256];
          CTC[((size_t)b * 1024 + ca + h) * CL + t] = y; }
        fft16k_dif(z, F.tid);
        int tpw = tq; asm volatile("" : "+v"(tpw));
#define HC_PW(k_, Ka_, Kb_) do { const int p = rev14(k_), p2 = rev14((NFFT - (k_)) & (NFFT - 1)); const f32x2 a = z[ZP(p)], b2 = z[ZP(p2)]; \
            const f32x2 Va = (f32x2){0.5f * (a.x + b2.x), 0.5f * (a.y - b2.y)}, Vb = (f32x2){0.5f * (a.y + b2.y), -0.5f * (a.x - b2.x)}; \
            const f32x2 ya = cmul(Va, Ka_), yb = cmul(Vb, Kb_); \
            z[ZP(p)] = (f32x2){ya.x - yb.y, ya.y + yb.x}; z[ZP(p2)] = (f32x2){ya.x + yb.y, -ya.y + yb.x}; } while (0)
#pragma unroll
        for (int i = 0; i < 8; ++i) { const int k = 16 * tpw + 2 * i;
            HC_PW(k, ((f32x2){ka[i].x, ka[i].y}), ((f32x2){kb[i].x, kb[i].y})); HC_PW(k + 1, ((f32x2){ka[i].z, ka[i].w}), ((f32x2){kb[i].z, kb[i].w}));
            asm volatile("" ::: "memory"); }
        if (tpw == 0) HC_PW(NFFT / 2, kaN, kbN);
#undef HC_PW
        __syncthreads();
        if (u + F.G < NB * 512) HC_LOADIN(u + F.G, tq);
        fft16k_dit_inv(z, F.tid);
        { int to = tq; asm volatile("" : "+v"(to)); const float sc = 1.0f / (float)NFFT; const int n0 = 16 * to;
          f32x4* oa = (f32x4*)(CT + ((size_t)b * 1024 + ca) * SEQ + n0);
#pragma unroll
          for (int i = 0; i < 4; ++i) { const f32x2 w0 = z[ZP(n0 + 4 * i)], w1 = z[ZP(n0 + 4 * i + 1)], w2 = z[ZP(n0 + 4 * i + 2)], w3 = z[ZP(n0 + 4 * i + 3)];
              oa[i] = (f32x4){w0.x * sc, w1.x * sc, w2.x * sc, w3.x * sc}; oa[SEQ / 4 + i] = (f32x4){w0.y * sc, w1.y * sc, w2.y * sc, w3.y * sc}; } }
    }
    __syncthreads();
#undef HC_LOADIN
}
constexpr int MW_CUMBLK = 16, MW_CNT = 64, MW_SELE = 128, MW_SELV = 256, MW_LRANK = 384, MW_LBASE = 512;
__device__ __forceinline__ void moe_tables(Frame& F, int layer) {
    __syncthreads();
    if (F.tid < NE) F.MISC[MW_CNT + F.tid] = __hip_atomic_load(F.ctl + CW_CNT + layer * NE + F.tid, RLX_AGENT);
    __syncthreads();
    if (F.tid == 0) { unsigned c = 0; for (int e = 0; e < NE; ++e) { F.MISC[MW_CUMBLK + e] = c; c += (F.MISC[MW_CNT + e] + 255u) >> 8; } F.MISC[MW_CUMBLK + NE] = c; }
    __syncthreads();
}

template <int MODE> __device__ __forceinline__ void rowpass(Frame& F, int layer, bool real = true, bool h8 = false) {
    const bool combine = (MODE == 0 && layer > 0) || MODE == 2;
    const int nrows = MODE == 2 ? ML : MT;
    const int cl = MODE == 2 ? NLAYER - 1 : layer - 1;
    const bool from_input = (MODE == 0 && layer == 0);
    const float* XLs = from_input ? PIN(F, I_X) : F.out; const float* XCs = from_input ? PIN(F, I_CTX) : (const float*)(F.ws + WS_XC);
    float* XLd = real ? F.out : (float*)(F.ws + WS_P); float* XCd = real ? (float*)(F.ws + WS_XC) : (float*)(F.ws + WS_P) + (size_t)ML * D;
    const float* MOD = (const float*)(F.ws + WS_MOD);
    bf16* H = (bf16*)(F.ws + WS_H); unsigned char* H8 = (unsigned char*)(F.ws + WS_H8); const unsigned char* YM = (const unsigned char*)(F.ws + WS_YM);
    const int* TE = (const int*)(F.ws + WS_TE); const int* TR = (const int*)(F.ws + WS_TR); const float* TG = (const float*)(F.ws + WS_TG);
    const float* gnorm = MODE == 0 ? PIN(F, I_N1G) + layer * D : PIN(F, I_FG);
    if (combine) moe_tables(F, cl);
    f32x4 gn[4];
#pragma unroll
    for (int j = 0; j < 4; ++j) gn[j] = ((const f32x4*)gnorm)[F.lane + 64 * j];
    const int ntiles = nrows / 32;
    for (int tile = F.bx; tile < ntiles; tile += F.G) {
        const int rbase = tile * 32 + F.wave * 4; const bool lat = rbase < ML; const int bidx = lat ? (rbase >> 13) : 8;
        const float* g2 = MOD + ((size_t)(combine ? cl : 0) * 9 + bidx) * 6144 + 5 * 1024;
        const float* mb = MOD + ((size_t)layer * 9 + bidx) * 6144;
#pragma unroll 1
        for (int pr = 0; pr < 2; ++pr) {
            size_t xo[2]; f32x4 v[2][4]; int rowid[2][4]; float gk[2][4];
#pragma unroll
            for (int u = 0; u < 2; ++u) { const int r = rbase + 2 * pr + u; xo[u] = lat ? (size_t)r * D : (size_t)(r - ML) * D;
                if (combine) { const i32x4 te = *(const i32x4*)(TE + (size_t)r * 4), tr = *(const i32x4*)(TR + (size_t)r * 4); const f32x4 tg = *(const f32x4*)(TG + (size_t)r * 4);
#pragma unroll
                    for (int k = 0; k < 4; ++k) { rowid[u][k] = 256 * (int)F.MISC[MW_CUMBLK + te[k]] + tr[k]; gk[u][k] = tg[k]; } }
                const f32x4* xs = (const f32x4*)((lat ? XLs : XCs) + xo[u]);
#pragma unroll
                for (int j = 0; j < 4; ++j) v[u][j] = xs[F.lane + 64 * j]; }
            if (combine) {
                unsigned w[2][4][4];
#pragma unroll
                for (int u = 0; u < 2; ++u)
#pragma unroll
                    for (int k = 0; k < 4; ++k) { const unsigned* yr = (const unsigned*)(YM + (size_t)rowid[u][k] * D);
#pragma unroll
                        for (int j = 0; j < 4; ++j) w[u][k][j] = yr[F.lane + 64 * j]; }
#pragma unroll
                for (int u = 0; u < 2; ++u) {
#pragma unroll
                    for (int j = 0; j < 4; ++j) { f32x4 a = (f32x4){0.f, 0.f, 0.f, 0.f};
#pragma unroll
                        for (int k = 0; k < 4; ++k) { const f32x2 lo = __builtin_amdgcn_cvt_pk_f32_fp8(w[u][k][j], false), hi2 = __builtin_amdgcn_cvt_pk_f32_fp8(w[u][k][j], true); a += gk[u][k] * (f32x4){lo.x, lo.y, hi2.x, hi2.y}; }
                        v[u][j] += ((const f32x4*)g2)[F.lane + 64 * j] * a; }
                    if (MODE == 0) { f32x4* xd = (f32x4*)((lat ? XLd : XCd) + xo[u]);
#pragma unroll
                        for (int j = 0; j < 4; ++j) xd[F.lane + 64 * j] = v[u][j]; } }
            }
#pragma unroll
            for (int u = 0; u < 2; ++u) { const int r = rbase + 2 * pr + u;
                float ss = 0.f;
#pragma unroll
                for (int j = 0; j < 4; ++j) ss += (v[u][j].x * v[u][j].x + v[u][j].y * v[u][j].y) + (v[u][j].z * v[u][j].z + v[u][j].w * v[u][j].w);
                const float rstd = 1.0f / sqrtf(wave_sum(ss) * (1.0f / D) + EPS);
                if (MODE == 2) { f32x4* od = (f32x4*)(XLd + xo[u]);
#pragma unroll
                    for (int j = 0; j < 4; ++j) od[F.lane + 64 * j] = v[u][j] * rstd * gn[j]; }
                else { v2u* hd = (v2u*)(H + (size_t)r * D); unsigned* hd8 = (unsigned*)(H8 + (size_t)r * D);
#pragma unroll
                    for (int j = 0; j < 4; ++j) { const f32x4 sh = ((const f32x4*)mb)[F.lane + 64 * j], sc = ((const f32x4*)(mb + 1024))[F.lane + 64 * j]; const f32x4 hv = v[u][j] * rstd * gn[j] * (sc + 1.0f) + sh;
                        if (h8) { unsigned o = 0; o = __builtin_amdgcn_cvt_pk_fp8_f32(hv.x, hv.y, o, false); o = __builtin_amdgcn_cvt_pk_fp8_f32(hv.z, hv.w, o, true); hd8[F.lane + 64 * j] = o; }
                        else { v2u o; o.x = cvt_pk_bf16(hv.x, hv.y); o.y = cvt_pk_bf16(hv.z, hv.w); hd[F.lane + 64 * j] = o; } } }
            }
        }
    }
}

typedef float f32x16r __attribute__((ext_vector_type(16)));
__device__ __forceinline__ void router_phase(Frame& F, int layer, bool real = true) {
    const bool last = layer == NLAYER - 1;
    const int ntiles = (last ? ML : MT) / 32;
    LAS float* PART = (LAS float*)F.lds;
    LAS float* SSQ = PART + 8 * 32 * 33;
    LAS float* LG = SSQ + 8 * 32;
    LAS float* RSTD = LG + 32 * 33;
    LAS unsigned* CW = (LAS unsigned*)(RSTD + 32);
    LAS unsigned* RUN = CW + 64;
    LAS float* AV = (LAS float*)(RUN + 32);
    LAS float* SHV = AV + 1024;
    const float* XL = F.out; const float* XC = (const float*)(F.ws + WS_XC);
    const float* MOD = (const float*)(F.ws + WS_MOD); const float* RC = (const float*)(F.ws + WS_RC);
    unsigned char* H8 = (unsigned char*)(F.ws + WS_H8);
    int* TE = (int*)(F.ws + WS_TE); int* TR = (int*)(F.ws + WS_TR); float* TG = (float*)(F.ws + WS_TG); int* ROWTOK = (int*)(F.ws + WS_ROWTOK);
    const float* gn = PIN(F, I_N2G) + layer * D; const float* rw = PIN(F, I_RW) + (size_t)layer * D * NE;
    const int i = F.lane & 31, hf = F.lane >> 5, kb = F.wave * 128 + 64 * hf;
    const int per = 2048 / F.G;
    const int nmine = (2048 % F.G == 0) ? per + ((2048 + F.bx < ntiles) ? 1 : 0) : 0;
#define RT_TILE(n_) ((2048 % F.G == 0) ? ((n_) < per ? F.bx * per + (n_) : 2048 + F.bx) : F.bx + (n_) * F.G)
    const int ncnt = (2048 % F.G == 0) ? nmine : (F.bx < ntiles ? (ntiles - 1 - F.bx) / F.G + 1 : 0);
    __syncthreads();
    if (F.tid < NE) RUN[F.tid] = 0u;
    float bv[64];
    { const float* rwp = rw + (size_t)kb * NE + i;
#pragma unroll
      for (int s = 0; s < 64; ++s) bv[s] = rwp[(size_t)s * NE]; }
    float xs[64];
#define RT_LOADX(tile_) do { const int r_ = (tile_) * 32 + i; const float* xr_ = (r_ < ML ? XL + (size_t)r_ * D : XC + (size_t)(r_ - ML) * D) + kb; \
        _Pragma("unroll") for (int q = 0; q < 16; ++q) { const f32x4 v = ((const f32x4*)xr_)[q]; xs[4 * q] = v.x; xs[4 * q + 1] = v.y; xs[4 * q + 2] = v.z; xs[4 * q + 3] = v.w; } } while (0)
    if (ncnt > 0) RT_LOADX(RT_TILE(0));
    int cur_b = -1;
    for (int n = 0; n < ncnt; ++n) {
        const int tile = RT_TILE(n);
        const int r0 = tile * 32; const bool lat = r0 < ML; const int bidx = lat ? (r0 >> 13) : 8; const int r = r0 + i;
        if (bidx != cur_b) {
            cur_b = bidx; const float* mb = MOD + ((size_t)layer * 9 + bidx) * 6144 + 3 * 1024;
            __syncthreads();
            for (int k = F.tid; k < 1024; k += NTHREADS) { AV[k] = gn[k] * (1.0f + mb[1024 + k]); SHV[k] = mb[k]; }
            __syncthreads();
        }
        float ssq = 0.f;
#pragma unroll
        for (int s = 0; s < 64; ++s) ssq += xs[s] * xs[s];
        ssq += __shfl_xor(ssq, 32);
        if (hf == 0) SSQ[F.wave * 32 + i] = ssq;
#pragma unroll
        for (int q = 0; q < 16; ++q) { const f32x4 a = ((const LAS f32x4*)(AV + kb))[q]; xs[4 * q] *= a.x; xs[4 * q + 1] *= a.y; xs[4 * q + 2] *= a.z; xs[4 * q + 3] *= a.w; if ((q & 3) == 3) asm volatile("" ::: "memory"); }
        f32x16r acc = {};
#pragma unroll
        for (int s = 0; s < 64; ++s) acc = __builtin_amdgcn_mfma_f32_32x32x2f32(xs[s], bv[s], acc, 0, 0, 0);
#pragma unroll
        for (int rg = 0; rg < 16; ++rg) PART[(F.wave * 32 + ((rg & 3) + 8 * (rg >> 2) + 4 * hf)) * 33 + i] = acc[rg];
        __syncthreads();
        { const int tk = F.tid >> 4, e0 = (F.tid & 15) * 2; float q = 0.f, s0 = 0.f, s1 = 0.f;
#pragma unroll
          for (int w = 0; w < 8; ++w) { q += SSQ[w * 32 + tk]; s0 += PART[(w * 32 + tk) * 33 + e0]; s1 += PART[(w * 32 + tk) * 33 + e0 + 1]; }
          const float rstd = 1.0f / sqrtf(q * (1.0f / D) + EPS); const float* rc = RC + ((size_t)layer * 9 + bidx) * NE;
          LG[tk * 33 + e0] = rstd * s0 + rc[e0]; LG[tk * 33 + e0 + 1] = rstd * s1 + rc[e0 + 1]; if ((F.tid & 15) == 0) RSTD[tk] = rstd; }
        __syncthreads();
        { const float rstd = RSTD[i]; v4u* hd = (v4u*)(H8 + (size_t)r * D + kb);
#pragma unroll
          for (int q4 = 0; q4 < 4; ++q4) { unsigned w8[4];
#pragma unroll
              for (int qq = 0; qq < 4; ++qq) { const int q = 4 * q4 + qq; const f32x4 sh = ((const LAS f32x4*)(SHV + kb))[q]; unsigned w = 0;
                  w = __builtin_amdgcn_cvt_pk_fp8_f32(xs[4 * q] * rstd + sh.x, xs[4 * q + 1] * rstd + sh.y, w, false);
                  w = __builtin_amdgcn_cvt_pk_fp8_f32(xs[4 * q + 2] * rstd + sh.z, xs[4 * q + 3] * rstd + sh.w, w, true); w8[qq] = w; }
              hd[q4] = (v4u){w8[0], w8[1], w8[2], w8[3]}; asm volatile("" ::: "memory"); } }
        if (n + 1 < ncnt) RT_LOADX(RT_TILE(n + 1));
#pragma unroll 1
        for (int rr = 0; rr < 4; ++rr) {
            const int slot = F.wave * 4 + rr, e = i; const float logit = LG[slot * 33 + e]; int rank = 0;
#pragma unroll 4
            for (int j = 0; j < NE; ++j) { const float o = __shfl(logit, j); rank += (o > logit || (o == logit && j < e)) ? 1 : 0; }
            if (F.lane < 32 && rank < 4) { F.MISC[MW_SELE + slot * 4 + rank] = (unsigned)e; F.MISC[MW_SELV + slot * 4 + rank] = __float_as_uint(logit); }
            LDS_WAIT(); asm volatile("" ::: "memory");
            { const int k = F.lane & 3; const float vk = __uint_as_float(F.MISC[MW_SELV + slot * 4 + k]); const float v0 = __shfl(vk, 0);
              float ex = __expf(vk - v0); float sm = ex; sm += __shfl_xor(sm, 1); sm += __shfl_xor(sm, 2);
              if (F.lane < 4) { const size_t tok = (size_t)r0 + slot; TG[tok * 4 + k] = ex / sm; TE[tok * 4 + k] = (int)F.MISC[MW_SELE + slot * 4 + k]; } }
        }
        __syncthreads();
        int my = 0, lr = 0;
        if (F.wave < 2) { my = (int)F.MISC[MW_SELE + F.tid]; unsigned cm = 0;
#pragma unroll 2
            for (int e = 0; e < NE; ++e) { const unsigned long long m = __ballot(my == e); const unsigned pc = (unsigned)__popcll(m);
                if (my == e) lr = (int)__builtin_amdgcn_mbcnt_hi((unsigned)(m >> 32), __builtin_amdgcn_mbcnt_lo((unsigned)m, 0u)); if (F.lane == e) cm = pc; }
            if (F.lane < NE) CW[F.wave * 32 + F.lane] = cm; }
        __syncthreads();
        if (F.wave < 2) { const int a = F.tid; const int brank = (int)RUN[my] + lr + (F.wave == 1 ? (int)CW[my] : 0); TR[((size_t)r0 + (a >> 2)) * 4 + (a & 3)] = brank; }
        __syncthreads();
        if (F.tid < NE) RUN[F.tid] += CW[F.tid] + CW[32 + F.tid];
    }
    VM_WAIT(); __syncthreads();
    if (F.tid < NE) { const unsigned cnt = RUN[F.tid]; unsigned base = 0;
        if (cnt) base = __hip_atomic_fetch_add(F.ctl + CW_CNT + (real ? layer : NLAYER) * NE + F.tid, cnt, RLX_AGENT);
        F.MISC[MW_LBASE + F.tid] = base; }
    __syncthreads();
    if (real) for (int n = 0; n < ncnt; ++n) { const int r0 = RT_TILE(n) * 32;
        if (F.tid < 128) { const size_t idx = ((size_t)r0 + (F.tid >> 2)) * 4 + (F.tid & 3); const int e = TE[idx]; const int rank = TR[idx] + (int)F.MISC[MW_LBASE + e]; TR[idx] = rank; ROWTOK[(size_t)e * MT + rank] = r0 + (F.tid >> 2); } }
    __syncthreads();
#undef RT_LOADX
#undef RT_TILE
}

__device__ __forceinline__ void normrope16(float (&x)[16], const float* gain, bool lat, int prow, int pcol, const LAS f32x2* T, int L) {
    float ss = 0.f;
#pragma unroll
    for (int i = 0; i < 16; ++i) ss += x[i] * x[i];
    ss += __shfl_xor(ss, 1); ss += __shfl_xor(ss, 2); ss += __shfl_xor(ss, 4);
    const float rstd = 1.0f / sqrtf(ss * (1.0f / 128.0f) + EPS);
    const int o = (L & 7) * 16;
#pragma unroll
    for (int i = 0; i < 16; ++i) x[i] = x[i] * rstd * gain[o + i];
    float p[16];
#pragma unroll
    for (int i = 0; i < 16; ++i) p[i] = __shfl_xor(x[i], 2);
    if (lat) {
        const int pos = (L & 4) ? pcol : prow; const float sgn = (L & 2) ? 1.0f : -1.0f; const LAS f32x2* t = T + pos * 32 + (L & 1) * 16;
#pragma unroll
        for (int i = 0; i < 16; ++i) { const f32x2 cs = t[i]; x[i] = x[i] * cs.x + sgn * p[i] * cs.y; }
    }
}
__device__ __forceinline__ void qkprep_phase(Frame& F, int j) {
    LAS f32x2* T = (LAS f32x2*)F.lds;
    __syncthreads();
    for (int i = F.tid; i < 128 * 32; i += NTHREADS) { const int pos = i >> 5, f = i & 31; const float inv = powf(10000.0f, -(float)f / 32.0f); const float ang = (float)pos * inv; float s, c; sincosf(ang, &s, &c); T[i] = (f32x2){c, s}; }
    __syncthreads();
    const bf16* P = (const bf16*)(F.ws + WS_P); bf16* QB = (bf16*)(F.ws + WS_QB); bf16* KVB = (bf16*)(F.ws + WS_KVB);
    const float* qg = PIN(F, I_AQG) + j * 128; const float* kg = PIN(F, I_AKG) + j * 128;
    const int gw = F.bx * NWAVES + F.wave, NGW = F.G * NWAVES, L = F.lane;
    for (int r = gw; r < MT; r += NGW) {
        const bool lat = r < ML; const int b = lat ? (r >> 13) : ((r - ML) >> 8); const int s = lat ? (r & (SEQ - 1)) : ((r - ML) & (CL - 1));
        const int prow = s >> 6, pcol = s & 63; const size_t kvrow = (size_t)b * SKV + (lat ? s : SEQ + s);
        const bf16* pr = P + (size_t)r * 1536;
        { const v4u a = *(const v4u*)(pr + 16 * L), c = *(const v4u*)(pr + 16 * L + 8); float x[16];
          x[0] = bflo(a.x); x[1] = bfhi(a.x); x[2] = bflo(a.y); x[3] = bfhi(a.y); x[4] = bflo(a.z); x[5] = bfhi(a.z); x[6] = bflo(a.w); x[7] = bfhi(a.w);
          x[8] = bflo(c.x); x[9] = bfhi(c.x); x[10] = bflo(c.y); x[11] = bfhi(c.y); x[12] = bflo(c.z); x[13] = bfhi(c.z); x[14] = bflo(c.w); x[15] = bfhi(c.w);
          normrope16(x, qg, lat, prow, pcol, T, L);
          v4u o0, o1; o0.x = cvt_pk_bf16(x[0], x[1]); o0.y = cvt_pk_bf16(x[2], x[3]); o0.z = cvt_pk_bf16(x[4], x[5]); o0.w = cvt_pk_bf16(x[6], x[7]);
          o1.x = cvt_pk_bf16(x[8], x[9]); o1.y = cvt_pk_bf16(x[10], x[11]); o1.z = cvt_pk_bf16(x[12], x[13]); o1.w = cvt_pk_bf16(x[14], x[15]);
          *(v4u*)(QB + (size_t)r * D + 16 * L) = o0; *(v4u*)(QB + (size_t)r * D + 16 * L + 8) = o1; }
        { const int Lk = L & 15; const v4u a = *(const v4u*)(pr + 1024 + 16 * Lk), c = *(const v4u*)(pr + 1024 + 16 * Lk + 8); float x[16];
          x[0] = bflo(a.x); x[1] = bfhi(a.x); x[2] = bflo(a.y); x[3] = bfhi(a.y); x[4] = bflo(a.z); x[5] = bfhi(a.z); x[6] = bflo(a.w); x[7] = bfhi(a.w);
          x[8] = bflo(c.x); x[9] = bfhi(c.x); x[10] = bflo(c.y); x[11] = bfhi(c.y); x[12] = bflo(c.z); x[13] = bfhi(c.z); x[14] = bflo(c.w); x[15] = bfhi(c.w);
          normrope16(x, kg, lat, prow, pcol, T, Lk);
          if (L < 16) { v4u o0, o1; o0.x = cvt_pk_bf16(x[0], x[1]); o0.y = cvt_pk_bf16(x[2], x[3]); o0.z = cvt_pk_bf16(x[4], x[5]); o0.w = cvt_pk_bf16(x[6], x[7]);
            o1.x = cvt_pk_bf16(x[8], x[9]); o1.y = cvt_pk_bf16(x[10], x[11]); o1.z = cvt_pk_bf16(x[12], x[13]); o1.w = cvt_pk_bf16(x[14], x[15]);
            *(v4u*)(KVB + kvrow * 512 + 16 * L) = o0; *(v4u*)(KVB + kvrow * 512 + 16 * L + 8) = o1; }
          else if (L < 48) { const int q = L - 16; *(v4u*)(KVB + kvrow * 512 + 256 + 8 * q) = *(const v4u*)(pr + 1280 + 8 * q); } }
    }
}
__device__ __forceinline__ void attention_phase(Frame& F, char* lds_generic, bool ctx_queries) {
    const bf16* QB = (const bf16*)(F.ws + WS_QB); const bf16* KVB = (const bf16*)(F.ws + WS_KVB); bf16* Y = (bf16*)(F.ws + WS_Y);
    const int nunits = 2048 + (ctx_queries ? 64 : 0);
    for (int u = F.bx; u < nunits; u += F.G) {
        if (u < 2048) { const int b = u >> 8, w = u & 255, h = w & 7, qb = w >> 3; const size_t qo = ((size_t)b * SEQ + (size_t)qb * 256) * D + h * 128; const bf16* kh = KVB + (size_t)b * SKV * 512 + (h >> 2) * 128;
            att::attn_dense_body(QB + qo, kh, kh + 256, Y + qo, SKV, lds_generic, F.wave); }
        else { const int w = u - 2048, b = w >> 3, h = w & 7; const size_t qo = ((size_t)ML + (size_t)b * CL) * D + h * 128; const bf16* kh = KVB + ((size_t)b * SKV + SEQ) * 512 + (h >> 2) * 128;
            att::attn_dense_body(QB + qo, kh, kh + 256, Y + qo, CL, lds_generic, F.wave); }
    }
}

__device__ __forceinline__ void gmlp_mix_phase(Frame& F) {
    constexpr int LDA = 136, LDO = 132;
    LAS bf16* As = (LAS bf16*)F.lds;
    LAS bf16* Vt = (LAS bf16*)(F.lds + 128 * LDA * 2);
    LAS float* rs = (LAS float*)(F.lds + 2 * 128 * LDA * 2);
    LAS float* Ot = (LAS float*)(F.lds + 2 * 128 * LDA * 2 + 512);
    const bf16* P = (const bf16*)(F.ws + WS_P); bf16* Y = (bf16*)(F.ws + WS_Y); const float* SS = (const float*)(F.ws + WS_SS);
    const float* ws = PIN(F, I_GWS); const float* bs = PIN(F, I_GBS); const float* vg = PIN(F, I_GVG);
    const int r32 = F.lane & 31, hi = F.lane >> 5;
    for (int u = F.bx; u < (MT / 128) * 8; u += F.G) {
        const int chunk = u >> 3, g = u & 7; const size_t row0 = (size_t)chunk * 128;
        __syncthreads();
        if (F.tid < 128) { const f32x4* sp = (const f32x4*)(SS + (row0 + F.tid) * 16); const f32x4 a = sp[0], b = sp[1], c = sp[2], d = sp[3];
            const float s = ((a.x + a.y) + (a.z + a.w)) + ((b.x + b.y) + (b.z + b.w)) + ((c.x + c.y) + (c.z + c.w)) + ((d.x + d.y) + (d.z + d.w)); rs[F.tid] = 1.0f / sqrtf(s * (1.0f / 1024.0f) + EPS); }
        __syncthreads();
        for (int i = F.tid; i < 128 * 32; i += NTHREADS) { const int p = i >> 5, q4 = (i & 31) * 4; const f32x4 w = *(const f32x4*)(ws + ((size_t)g * 128 + p) * 128 + q4);
            v2u o; o.x = pk2(w.x * rs[q4], w.y * rs[q4 + 1]); o.y = pk2(w.z * rs[q4 + 2], w.w * rs[q4 + 3]); *(LAS v2u*)(As + p * LDA + q4) = o; }
        for (int i = F.tid; i < 128 * 16; i += NTHREADS) { const int q = i >> 4, c8 = (i & 15) * 8; const v4u w = *(const v4u*)(P + (row0 + q) * 2048 + 1024 + g * 128 + c8);
            Vt[(c8 + 0) * LDA + q] = (bf16)(w.x & 0xffff); Vt[(c8 + 1) * LDA + q] = (bf16)(w.x >> 16); Vt[(c8 + 2) * LDA + q] = (bf16)(w.y & 0xffff); Vt[(c8 + 3) * LDA + q] = (bf16)(w.y >> 16);
            Vt[(c8 + 4) * LDA + q] = (bf16)(w.z & 0xffff); Vt[(c8 + 5) * LDA + q] = (bf16)(w.z >> 16); Vt[(c8 + 6) * LDA + q] = (bf16)(w.w & 0xffff); Vt[(c8 + 7) * LDA + q] = (bf16)(w.w >> 16); }
        __syncthreads();
        const int p0 = (F.wave >> 1) * 32, cbase = (F.wave & 1) * 64;
        f32x16 acc0 = {}, acc1 = {};
#pragma unroll
        for (int ks = 0; ks < 8; ++ks) { const int k0 = ks * 16 + hi * 8;
            const bf16x8 a = *(const LAS bf16x8*)(As + (p0 + r32) * LDA + k0);
            const bf16x8 b0 = *(const LAS bf16x8*)(Vt + (cbase + r32) * LDA + k0), b1 = *(const LAS bf16x8*)(Vt + (cbase + 32 + r32) * LDA + k0);
            acc0 = __builtin_amdgcn_mfma_f32_32x32x16_bf16(a, b0, acc0, 0, 0, 0); acc1 = __builtin_amdgcn_mfma_f32_32x32x16_bf16(a, b1, acc1, 0, 0, 0); }
#pragma unroll
        for (int t = 0; t < 2; ++t) { const int cl = cbase + t * 32 + r32; const float gain = vg[g * 128 + cl];
#pragma unroll
            for (int reg = 0; reg < 16; ++reg) { const int p = p0 + (reg & 3) + 8 * (reg >> 2) + 4 * hi; Ot[p * LDO + cl] = gain * (t == 0 ? acc0[reg] : acc1[reg]) + bs[g * 128 + p]; } }
        __syncthreads();
        for (int i = F.tid; i < 128 * 16; i += NTHREADS) { const int p = i >> 4, c8 = (i & 15) * 8; const v4u uw = *(const v4u*)(P + (row0 + p) * 2048 + g * 128 + c8);
            const LAS float* o = Ot + p * LDO + c8; const f32x4 m0 = *(const LAS f32x4*)o, m1 = *(const LAS f32x4*)(o + 4);
            v4u w; w.x = cvt_pk_bf16(bflo(uw.x) * m0.x, bfhi(uw.x) * m0.y); w.y = cvt_pk_bf16(bflo(uw.y) * m0.z, bfhi(uw.y) * m0.w);
            w.z = cvt_pk_bf16(bflo(uw.z) * m1.x, bfhi(uw.z) * m1.y); w.w = cvt_pk_bf16(bflo(uw.w) * m1.z, bfhi(uw.w) * m1.w);
            *(v4u*)(Y + (row0 + p) * D + g * 128 + c8) = w; }
    }
    __syncthreads();
}

__device__ __forceinline__ void hyena_prep_phase(Frame& F) {
    LAS float* tl = (LAS float*)F.lds;
    const bf16* P = (const bf16*)(F.ws + WS_P); bf16* X0 = (bf16*)(F.ws + WS_X0); bf16* VG = (bf16*)(F.ws + WS_VG);
    float* VT = (float*)(F.ws + WS_VT); float* VTC = (float*)(F.ws + WS_VTC);
    const float* cw = PIN(F, I_HCW); const float* cb = PIN(F, I_HCB);
    const int tt = F.tid >> 3, cg = F.tid & 7;
    for (int u = F.bx; u < (MT / 64) * 16; u += F.G) {
        const int tb = u >> 4, c0 = (u & 15) * 64; const int r0 = tb * 64; const bool lat = r0 < ML;
        const int b = lat ? (r0 >> 13) : ((r0 - ML) >> 8), s0 = lat ? (r0 & (SEQ - 1)) : ((r0 - ML) & (CL - 1)), L = lat ? SEQ : CL;
        const int r = r0 + tt, s = s0 + tt, c = c0 + cg * 8;
        float o[3][8];
#pragma unroll
        for (int seg = 0; seg < 3; ++seg) { const int col = seg * 1024 + c;
            const v4u z0 = {0u, 0u, 0u, 0u};
            const v4u pm = s > 0 ? *(const v4u*)(P + (size_t)(r - 1) * 3072 + col) : z0, pc = *(const v4u*)(P + (size_t)r * 3072 + col), pn = s < L - 1 ? *(const v4u*)(P + (size_t)(r + 1) * 3072 + col) : z0;
            const f32x4 w0a = *(const f32x4*)(cw + col), w0b = *(const f32x4*)(cw + col + 4), w1a = *(const f32x4*)(cw + 3072 + col), w1b = *(const f32x4*)(cw + 3072 + col + 4);
            const f32x4 w2a = *(const f32x4*)(cw + 6144 + col), w2b = *(const f32x4*)(cw + 6144 + col + 4), ba = *(const f32x4*)(cb + col), bb = *(const f32x4*)(cb + col + 4);
            const unsigned pmw[4] = {pm.x, pm.y, pm.z, pm.w}, pcw[4] = {pc.x, pc.y, pc.z, pc.w}, pnw[4] = {pn.x, pn.y, pn.z, pn.w};
#pragma unroll
            for (int i = 0; i < 8; ++i) { const float xm = (i & 1) ? bfhi(pmw[i >> 1]) : bflo(pmw[i >> 1]), xc = (i & 1) ? bfhi(pcw[i >> 1]) : bflo(pcw[i >> 1]), xn = (i & 1) ? bfhi(pnw[i >> 1]) : bflo(pnw[i >> 1]);
                const float w0 = i < 4 ? w0a[i & 3] : w0b[i & 3], w1 = i < 4 ? w1a[i & 3] : w1b[i & 3], w2 = i < 4 ? w2a[i & 3] : w2b[i & 3], bi = i < 4 ? ba[i & 3] : bb[i & 3];
                o[seg][i] = xm * w0 + xc * w1 + xn * w2 + bi; } }
        float vgv[8];
#pragma unroll
        for (int i = 0; i < 8; ++i) vgv[i] = o[2][i] * o[1][i];
        v4u w; w.x = cvt_pk_bf16(o[0][0], o[0][1]); w.y = cvt_pk_bf16(o[0][2], o[0][3]); w.z = cvt_pk_bf16(o[0][4], o[0][5]); w.w = cvt_pk_bf16(o[0][6], o[0][7]);
        *(v4u*)(X0 + (size_t)r * D + c) = w;
        w.x = cvt_pk_bf16(vgv[0], vgv[1]); w.y = cvt_pk_bf16(vgv[2], vgv[3]); w.z = cvt_pk_bf16(vgv[4], vgv[5]); w.w = cvt_pk_bf16(vgv[6], vgv[7]);
        *(v4u*)(VG + (size_t)r * D + c) = w;
        __syncthreads();
#pragma unroll
        for (int i = 0; i < 8; ++i) tl[(cg * 8 + i) * 65 + tt] = vgv[i];
        __syncthreads();
        { const int cc = F.tid >> 3, ts = (F.tid & 7) * 8; float* dst = lat ? VT + ((size_t)b * 1024 + c0 + cc) * SEQ + s0 + ts : VTC + ((size_t)b * 1024 + c0 + cc) * CL + s0 + ts;
          const LAS float* sp = tl + cc * 65 + ts;
          *(f32x4*)dst = (f32x4){sp[0], sp[1], sp[2], sp[3]}; *(f32x4*)(dst + 4) = (f32x4){sp[4], sp[5], sp[6], sp[7]}; }
    }
    __syncthreads();
}
__device__ __forceinline__ void hyena_post_phase(Frame& F) {
    LAS float* tl = (LAS float*)F.lds;
    const bf16* X0 = (const bf16*)(F.ws + WS_X0); const bf16* VG = (const bf16*)(F.ws + WS_VG); bf16* Y = (bf16*)(F.ws + WS_Y);
    const float* VT = (const float*)(F.ws + WS_CT); const float* VTC = (const float*)(F.ws + WS_CTC); const float* dsk = PIN(F, I_HD);
    const int tt = F.tid >> 3, cg = F.tid & 7;
    for (int u = F.bx; u < (MT / 64) * 16; u += F.G) {
        const int tb = u >> 4, c0 = (u & 15) * 64; const int r0 = tb * 64; const bool lat = r0 < ML;
        const int b = lat ? (r0 >> 13) : ((r0 - ML) >> 8), s0 = lat ? (r0 & (SEQ - 1)) : ((r0 - ML) & (CL - 1));
        __syncthreads();
        { const int cc = F.tid >> 3, ts = (F.tid & 7) * 8; const float* src = lat ? VT + ((size_t)b * 1024 + c0 + cc) * SEQ + s0 + ts : VTC + ((size_t)b * 1024 + c0 + cc) * CL + s0 + ts;
          const f32x4 a = *(const f32x4*)src, bq = *(const f32x4*)(src + 4); LAS float* dp = tl + cc * 65 + ts;
          dp[0] = a.x; dp[1] = a.y; dp[2] = a.z; dp[3] = a.w; dp[4] = bq.x; dp[5] = bq.y; dp[6] = bq.z; dp[7] = bq.w; }
        __syncthreads();
        const int r = r0 + tt, c = c0 + cg * 8;
        const v4u x0 = *(const v4u*)(X0 + (size_t)r * D + c), vv = *(const v4u*)(VG + (size_t)r * D + c);
        const f32x4 da = *(const f32x4*)(dsk + c), db = *(const f32x4*)(dsk + c + 4);
        const unsigned x0w[4] = {x0.x, x0.y, x0.z, x0.w}, vw[4] = {vv.x, vv.y, vv.z, vv.w}; float y[8];
#pragma unroll
        for (int i = 0; i < 8; ++i) { const float xx = (i & 1) ? bfhi(x0w[i >> 1]) : bflo(x0w[i >> 1]), vx = (i & 1) ? bfhi(vw[i >> 1]) : bflo(vw[i >> 1]); const float di = i < 4 ? da[i & 3] : db[i & 3];
            y[i] = (tl[(cg * 8 + i) * 65 + tt] + vx * di) * xx; }
        v4u w; w.x = cvt_pk_bf16(y[0], y[1]); w.y = cvt_pk_bf16(y[2], y[3]); w.z = cvt_pk_bf16(y[4], y[5]); w.w = cvt_pk_bf16(y[6], y[7]);
        *(v4u*)(Y + (size_t)r * D + c) = w;
    }
    __syncthreads();
}
__device__ __forceinline__ bool phase_nonempty(int ph) {
    if (ph < PH_L0 || ph >= PH_FINAL) return true;
    const int layer = (ph - PH_L0) / PH_PER_LAYER, lp = (ph - PH_L0) % PH_PER_LAYER, kind = layer % 3;
    if (lp == LP_MIX2) return kind != 1;
    if (lp == LP_MIX3) return kind == 2;
    return true;
}
__global__ void __launch_bounds__(NTHREADS, 2) mk_fwd(Args args) {
    extern __shared__ __attribute__((aligned(16))) unsigned char lds[];
    Frame F0;
    F0.lds = (LAS unsigned char*)lds; F0.MISC = (volatile LAS unsigned*)(F0.lds + MISC_OFF);
    F0.tid = threadIdx.x; F0.lane = F0.tid & 63; F0.wave = __builtin_amdgcn_readfirstlane(F0.tid >> 6);
    F0.G = gridDim.x; F0.bx = blockIdx.x; F0.out = args.out; F0.ws = args.ws; F0.ctl = (gu32*)(args.ws + WS_CTL);
    for (int u = F0.tid; u < MISC_BYTES / 4; u += NTHREADS) F0.MISC[u] = 0u;
    __syncthreads();
    if (F0.tid < 36) { const unsigned long long p = (unsigned long long)args.in[F0.tid]; F0.MISC[MW_PTRS + 2 * F0.tid] = (unsigned)p; F0.MISC[MW_PTRS + 2 * F0.tid + 1] = (unsigned)(p >> 32); }
    __syncthreads();
    const int lo = args.ph_lo, hi = args.ph_hi;
    const bool multi = (hi - lo) > 1;
    XcdBarrier bar; bar.bar = (unsigned*)(F0.ctl + CW_BAR); bar.x = 0; bar.st = nullptr; bar.w = F0.wave;
    if (multi) bar = xcd_barrier_post((unsigned*)(F0.ctl + CW_BAR), F0.MISC + 8, F0.wave);
#ifndef PHMASK
#define PHMASK 0xFFFF
#endif
#define EN(b) ((PHMASK >> (b)) & 1)
#ifndef KMASK
#define KMASK 7
#endif
#define KEN(b) ((KMASK >> (b)) & 1)
#define IN(k) (lo <= (k) && (k) < hi)
#define SEAM(k) do { if ((k) + 1 < hi) xcd_barrier(bar); } while (0)
#define PB(id) for (int _rep = 0, _n = ((id) == MK_REPEAT ? MK_NREP : 1); _rep < _n; ++_rep) {
#define PE(id) if (_rep + 1 < _n) xcd_barrier(bar); } SEAM(id);

    if (EN(0) && IN(PH_PRO0)) { PB(PH_PRO0) Frame F = phase_frame(F0); pro0_mod(F); __syncthreads(); pro0_transposes(F); pro0_filter_mlp(F); PE(PH_PRO0) }
    if (EN(1) && IN(PH_PRO1)) { PB(PH_PRO1) Frame F = phase_frame(F0); pro1_filters(F); PE(PH_PRO1) }

#pragma unroll 1
    for (int layer = 0; layer < NLAYER; ++layer) {
        const int kind = layer % 3, jj = layer / 3, pb = PH_L0 + layer * PH_PER_LAYER; const bool last = layer == NLAYER - 1;
        if (EN(2) && IN(pb + LP_NORM1)) { PB(pb + LP_NORM1) Frame F = phase_frame(F0); rowpass<0>(F, layer, _rep + 1 == _n, false); PE(pb + LP_NORM1) }
        if (EN(3) && IN(pb + LP_INPROJ)) { PB(pb + LP_INPROJ)
            Frame F = phase_frame(F0);
            const int N = kind == 0 ? 1536 : (kind == 1 ? 2048 : 3072);
            const size_t woff = kind == 0 ? WS_WATT + (size_t)jj * 1536 * 1024 * 2 : (kind == 1 ? WS_WGM : WS_WHY);
            pg8::DenseSched S; S.init(F.ws + WS_H, F.ws + woff, MT, N, F.G, F.bx);
            pg8::EpiBf16 E{(bf16*)(F.ws + WS_P), N, (float*)(F.ws + WS_SS), kind == 1 ? 1 : 0};
            pg8::gemm_phase<pg8::EpiBf16, pg8::DenseSched, false>(F.lds, S, E, F.wave);
            PE(pb + LP_INPROJ)
        }
        if (IN(pb + LP_MIX1)) { PB(pb + LP_MIX1)
            Frame F = phase_frame(F0);
            if (EN(4) && kind == 0) qkprep_phase(F, jj); else if (EN(5) && kind == 1) gmlp_mix_phase(F); else if (EN(6)) hyena_prep_phase(F);
            PE(pb + LP_MIX1)
        }
        if (IN(pb + LP_MIX2) && kind != 1) { PB(pb + LP_MIX2)
            Frame F = phase_frame(F0);
            if (EN(7) && kind == 0) attention_phase(F, (char*)lds, !last); else if (EN(8)) hyena_conv_phase(F);
            PE(pb + LP_MIX2)
        }
        if (EN(9) && IN(pb + LP_MIX3) && kind == 2) { PB(pb + LP_MIX3) Frame F = phase_frame(F0); hyena_post_phase(F); PE(pb + LP_MIX3) }
        if (EN(10) && IN(pb + LP_OUTPROJ)) { PB(pb + LP_OUTPROJ)
            Frame F = phase_frame(F0); const float* modl = (const float*)(F.ws + WS_MOD) + (size_t)layer * 9 * 6144;
            pg8::DenseSched S; S.init(F.ws + WS_Y, F.ws + WS_WOUT + (size_t)layer * 1024 * 1024 * 2, last ? ML : MT, 1024, F.G, F.bx);
            const bool first = layer == 0;
            pg8::EpiResid E{first ? PIN(F, I_X) : F.out, first ? PIN(F, I_CTX) : (const float*)(F.ws + WS_XC), F.out, (float*)(F.ws + WS_XC), modl};
            pg8::gemm_phase<pg8::EpiResid, pg8::DenseSched, false>(F.lds, S, E, F.wave);
            PE(pb + LP_OUTPROJ)
        }
        if (EN(11) && IN(pb + LP_NORM2)) { PB(pb + LP_NORM2) Frame F = phase_frame(F0); router_phase(F, layer, _rep + 1 == _n); PE(pb + LP_NORM2) }
        if (EN(12) && IN(pb + LP_MOE1)) { PB(pb + LP_MOE1)
            Frame F = phase_frame(F0);
            moe_tables(F, layer);
            pg8::MoeSched S{(const char*)(F.ws + WS_H8), (const char*)(F.ws + WS_WE1) + (size_t)layer * NE * 2048 * 1024, (size_t)2048 * 1024, (const int*)(F.ws + WS_ROWTOK),
                            (const volatile LAS int*)(F.MISC + MW_CUMBLK), (const volatile LAS int*)(F.MISC + MW_CNT), 3, F.G, F.bx, 1024};
            pg8::EpiSwiglu E{(unsigned char*)(F.ws + WS_ACT), PIN(F, I_EB1) + (size_t)layer * NE * 2048};
            pg8::gemm_phase<pg8::EpiSwiglu, pg8::MoeSched, true, true>(F.lds, S, E, F.wave, MK_XP == 1 && _rep + 1 < _n);
            PE(pb + LP_MOE1)
        }
        if (EN(13) && IN(pb + LP_MOE2)) { PB(pb + LP_MOE2)
            Frame F = phase_frame(F0);
            moe_tables(F, layer);
            pg8::MoeSched S{(const char*)(F.ws + WS_ACT), (const char*)(F.ws + WS_WE2) + (size_t)layer * NE * 1024 * 1024, (size_t)1024 * 1024, nullptr,
                            (const volatile LAS int*)(F.MISC + MW_CUMBLK), (const volatile LAS int*)(F.MISC + MW_CNT), 2, F.G, F.bx, 1024};
            pg8::EpiBias E{(unsigned char*)(F.ws + WS_YM), PIN(F, I_EB2) + (size_t)layer * NE * 1024};
            pg8::gemm_phase<pg8::EpiBias, pg8::MoeSched, true, true>(F.lds, S, E, F.wave, MK_XP == 1 && _rep + 1 < _n);
            PE(pb + LP_MOE2)
        }
    }
    if (EN(14) && IN(PH_FINAL)) { PB(PH_FINAL) Frame F = phase_frame(F0); rowpass<2>(F, NLAYER - 1, _rep + 1 == _n); PE(PH_FINAL) }
#undef IN
#undef SEAM
}

static bool host_phase_nonempty(int ph) {
    if (ph < PH_L0 || ph >= PH_FINAL) return true;
    const int layer = (ph - PH_L0) / PH_PER_LAYER, lp = (ph - PH_L0) % PH_PER_LAYER, kind = layer % 3;
    if (lp == LP_MIX2) return kind != 1;
    if (lp == LP_MIX3) return kind == 2;
    return true;
}
extern "C" void kernel_launch(void* const* d_in, const int* in_sizes, int n_in, void* d_out, int out_size, void* d_ws, size_t ws_size, hipStream_t stream) {
    static int grid = 0;
    if (grid == 0) {
        if (n_in != 36 || in_sizes[0] != ML * D || out_size != ML * D || ws_size < WS_END) {
            fprintf(stderr, "kernel_launch: built for 36 inputs, x/out of %d floats, >= %zu bytes of workspace; got n_in %d in0 %d out %d ws %zu; nothing launched\n", ML * D, (size_t)WS_END, n_in, n_in > 0 ? in_sizes[0] : -1, out_size, ws_size);
            grid = -1; return; }
        int dev = 0, cus = 0, per_cu = 0;
        if (hipGetDevice(&dev) != hipSuccess || hipDeviceGetAttribute(&cus, hipDeviceAttributeMultiprocessorCount, dev) != hipSuccess) { fprintf(stderr, "kernel_launch: device query failed\n"); grid = -1; return; }
        if (hipFuncSetAttribute((const void*)mk_fwd, hipFuncAttributeMaxDynamicSharedMemorySize, LDS_BYTES) != hipSuccess) { fprintf(stderr, "kernel_launch: hipFuncSetAttribute(%d B LDS) failed\n", LDS_BYTES); grid = -1; return; }
        if (hipOccupancyMaxActiveBlocksPerMultiprocessor(&per_cu, (const void*)mk_fwd, NTHREADS, LDS_BYTES) != hipSuccess || per_cu < 1)
            fprintf(stderr, "kernel_launch: note: occupancy query reports %d workgroups per CU\n", per_cu);
        (void)hipGetLastError();
        grid = cus;
    }
    if (grid < 0) return;
    if (hipMemsetAsync((char*)d_ws + WS_CTL, 0, CTL_ZERO_BYTES, stream) != hipSuccess) { fprintf(stderr, "kernel_launch: memset failed\n"); return; }
    Args a{};
    for (int i = 0; i < 36; ++i) a.in[i] = (const float*)d_in[i];
    a.out = (float*)d_out; a.ws = (unsigned char*)d_ws;
#if MK_MULTI || MK_DBG
    for (int ph = 0; ph < PH_COUNT; ++ph) {
        if (!host_phase_nonempty(ph)) continue;
        a.ph_lo = ph; a.ph_hi = ph + 1;
        hipLaunchKernelGGL(mk_fwd, dim3(grid), dim3(NTHREADS), LDS_BYTES, stream, a);
#if MK_DBG
        dbg_after_phase(ph, a, stream);
#endif
    }
#if MK_DBG
    dbg_report(a, stream);
#endif
#else
    a.ph_lo = 0; a.ph_hi = PH_COUNT;
    hipLaunchKernelGGL(mk_fwd, dim3(grid), dim3(NTHREADS), LDS_BYTES, stream, a);
#endif
    const hipError_t le = hipPeekAtLastError();
    if (le != hipSuccess) fprintf(stderr, "kernel_launch: launch failed: %s\n", hipGetErrorName(le));
}
```

```cpp
#include <hip/hip_runtime.h>
#include <cstdio>
#include <cstdint>
#include <cmath>

#ifndef MK_MULTI
#define MK_MULTI 0
#endif
#ifndef MK_REPEAT
#define MK_REPEAT -1
#endif
#ifndef MK_NREP
#define MK_NREP 1
#endif
#ifndef MK_XP
#define MK_XP 0
#endif
#ifndef MK_MOEMAP
#define MK_MOEMAP 0
#endif
#ifndef MK_DBG
#define MK_DBG 0
#endif

constexpr int D = 1024, NB = 8, SEQ = 8192, CL = 256, ML = NB * SEQ, MC = NB * CL, MT = ML + MC;
constexpr int NLAYER = 4, NE = 32, TOPK = 4, SKV = SEQ + CL;
constexpr int MOE_MAXBLK = (MT * TOPK) / 256 + NE;
constexpr float EPS = 1e-6f;
constexpr int FH = 64, FEMB = 33, NFFT = 16384;

constexpr size_t MiB = 1u << 20;
constexpr size_t WS_CTL = 0, CTL_ZERO_BYTES = 1 * MiB;
constexpr size_t WS_MOD = 1 * MiB;
constexpr size_t WS_A3 = 2 * MiB;
constexpr size_t WS_A3C = 4 * MiB;
constexpr size_t WS_RC = 4 * MiB + 512 * 1024;
constexpr size_t WS_FCT = 5 * MiB;
constexpr size_t WS_WATT = 8 * MiB;
constexpr size_t WS_WGM = 14 * MiB;
constexpr size_t WS_WHY = 18 * MiB;
constexpr size_t WS_WOUT = 24 * MiB;
constexpr size_t WS_RW3 = 32 * MiB;
constexpr size_t WS_TE = 40 * MiB;
constexpr size_t WS_TR = 42 * MiB;
constexpr size_t WS_TG = 44 * MiB;
constexpr size_t WS_SS = 46 * MiB;
constexpr size_t WS_ROWTOK = 52 * MiB;
constexpr size_t WS_KF = 64 * MiB;
constexpr size_t WS_WE1 = 192 * MiB;
constexpr size_t WS_WE2 = 704 * MiB;
constexpr size_t WS_H = 960 * MiB;
constexpr size_t WS_P = 1092 * MiB;
constexpr size_t WS_Y = 1488 * MiB;
constexpr size_t WS_QB = 1620 * MiB;
constexpr size_t WS_K8_OFF = 72 * MiB;
constexpr size_t WS_KVB = 1752 * MiB;
constexpr size_t WS_X0 = 1818 * MiB;
constexpr size_t WS_VG = 1950 * MiB;
constexpr size_t WS_VT = 2082 * MiB;
constexpr size_t WS_VTC = 2338 * MiB;
constexpr size_t WS_ACT = 2346 * MiB;
constexpr size_t WS_YM = 2890 * MiB;
constexpr size_t WS_CT = 3434 * MiB;
constexpr size_t WS_CTC = 3690 * MiB;
constexpr size_t WS_H8 = 3698 * MiB;
constexpr size_t WS_XB = 3764 * MiB;
constexpr size_t WS_END = 3896 * MiB;
constexpr int CW_BAR = 4096;
constexpr int CW_CNT = 16384;
constexpr int CW_DBG = 32768;

constexpr int RING_BYTES = 131072;
constexpr int AUX_OFF = RING_BYTES;
constexpr int AUX_BYTES = 16384;
constexpr int MISC_OFF = AUX_OFF + AUX_BYTES;
constexpr int MISC_BYTES = 4096;
constexpr int LDS_BYTES = MISC_OFF + MISC_BYTES;

#define GAS __attribute__((address_space(1)))
#define LAS __attribute__((address_space(3)))
typedef unsigned short bf16;
typedef unsigned v4u __attribute__((ext_vector_type(4)));
typedef unsigned v2u __attribute__((ext_vector_type(2)));
typedef float f32x4 __attribute__((ext_vector_type(4)));
typedef float f32x2 __attribute__((ext_vector_type(2)));
typedef float f32x16 __attribute__((ext_vector_type(16)));
typedef short bf16x8 __attribute__((ext_vector_type(8)));
typedef short s16x4 __attribute__((ext_vector_type(4)));
typedef int i32x4 __attribute__((ext_vector_type(4)));
typedef GAS unsigned gu32;
#define RLX_AGENT __ATOMIC_RELAXED, __HIP_MEMORY_SCOPE_AGENT
#define LDS_WAIT() asm volatile("s_waitcnt lgkmcnt(0)" ::: "memory")
#define VM_WAIT() asm volatile("s_waitcnt vmcnt(0)" ::: "memory")
__device__ __forceinline__ int opaque_tid(int wave) { int l; asm volatile("v_mbcnt_lo_u32_b32 %0, -1, 0\n\tv_mbcnt_hi_u32_b32 %0, -1, %0" : "=v"(l)); return (wave << 6) | l; }
__device__ __forceinline__ unsigned f2bf(float f) { unsigned u = __builtin_bit_cast(unsigned, f); return (u + 0x7fffu + ((u >> 16) & 1u)) >> 16; }
__device__ __forceinline__ unsigned pk2(float lo, float hi) { return f2bf(lo) | (f2bf(hi) << 16); }
__device__ __forceinline__ float bf2f(unsigned short b) { return __builtin_bit_cast(float, ((unsigned)b) << 16); }
__device__ __forceinline__ float bflo(unsigned w) { return __builtin_bit_cast(float, w << 16); }
__device__ __forceinline__ float bfhi(unsigned w) { return __builtin_bit_cast(float, w & 0xffff0000u); }
__device__ __forceinline__ f32x4 bf4_f32(v2u w) { return (f32x4){__uint_as_float(w.x << 16), __uint_as_float(w.x & 0xffff0000u), __uint_as_float(w.y << 16), __uint_as_float(w.y & 0xffff0000u)}; }
__device__ __forceinline__ unsigned cvt_pk_bf16(float lo, float hi) { unsigned r; asm volatile("v_cvt_pk_bf16_f32 %0, %1, %2" : "=v"(r) : "v"(lo), "v"(hi)); return r; }
__device__ __forceinline__ float shx(float v, int mask, int lane) { return __int_as_float(__builtin_amdgcn_ds_bpermute((lane ^ mask) << 2, __float_as_int(v))); }
__device__ __forceinline__ float wave_sum(float v, int lane) {
#pragma unroll
    for (int o = 1; o < 64; o <<= 1) v += shx(v, o, lane);
    return v;
}

#define XB_TMO      128
#define XB_XCNT(j)  (256  + 64 * (j))
#define XB_XSUB(j)  (1280 + 64 * (j))
#define XB_XGEN(j)  (2304 + 64 * (j))
#define XB_TOP      3328
#define XB_TOPGEN   3392
#define XCD_BAR_WORDS 3456
#define XB_SPIN_CAP (1u << 22)
__device__ __forceinline__ unsigned xb_ld(unsigned* p)              { return __hip_atomic_load(p, __ATOMIC_RELAXED, __HIP_MEMORY_SCOPE_AGENT); }
__device__ __forceinline__ unsigned xb_add(unsigned* p, unsigned v) { return __hip_atomic_fetch_add(p, v, __ATOMIC_RELAXED, __HIP_MEMORY_SCOPE_AGENT); }
__device__ __forceinline__ unsigned xb_xcc_id() { return (unsigned)__builtin_amdgcn_s_getreg((3 << 11) | 20) & 0xFu; }
#define XB_SPIN(cond, bar) do { unsigned _sp = 0; while (cond) { __builtin_amdgcn_s_sleep(1); \
    if ((++_sp & 255u) == 0u) { if (xb_ld(&(bar)[XB_TMO])) break; if (_sp > XB_SPIN_CAP) { atomicAdd(&(bar)[XB_TMO], 1u); break; } } } } while (0)
struct XcdBarrier { unsigned* bar; unsigned x; volatile LAS unsigned* st; int w; };
__device__ __forceinline__ bool xb_thread0(int w) { return opaque_tid(w) == 0; }
__device__ __forceinline__ XcdBarrier xcd_barrier_post(unsigned* bar, volatile LAS unsigned* st, int w) {
    XcdBarrier b; b.bar = bar; b.x = xb_xcc_id(); b.st = st; b.w = w;
    if (xb_thread0(w)) (void)xb_add(&bar[XB_XCNT(b.x)], 1u);
    return b;
}
__device__ __forceinline__ void xcd_barrier_complete(unsigned* bar, unsigned x, unsigned& nloc, unsigned& nx) {
    const unsigned G = gridDim.x * gridDim.y * gridDim.z;
    unsigned sum, cnt, mine, sp = 0u;
    for (;;) {
        sum = 0u; cnt = 0u; mine = 0u;
#pragma unroll
        for (unsigned j = 0; j < 16; ++j) { const unsigned c = xb_ld(&bar[XB_XCNT(j)]); sum += c; cnt += (c > 0u) ? 1u : 0u; mine = (j == x) ? c : mine; }
        if (sum == G) break;
        __builtin_amdgcn_s_sleep(1);
        if ((++sp & 255u) == 0u) { if (xb_ld(&bar[XB_TMO])) break; if (sp > XB_SPIN_CAP) { atomicAdd(&bar[XB_TMO], 1u); break; } }
    }
    nloc = mine > 0u ? mine : 1u; nx = cnt > 0u ? cnt : 1u;
}
__device__ __forceinline__ void xcd_barrier(const XcdBarrier& b) {
    asm volatile("s_waitcnt vmcnt(0)" ::: "memory");
    __syncthreads();
    if (xb_thread0(b.w)) {
        unsigned* bar = b.bar;
        __builtin_amdgcn_s_waitcnt(0);
        unsigned nloc = b.st[0], nx = b.st[1];
        if (nloc == 0u) { xcd_barrier_complete(bar, b.x, nloc, nx); b.st[0] = nloc; b.st[1] = nx; }
        const unsigned old = xb_add(&bar[XB_XSUB(b.x)], 1u);
        const unsigned gen = old / nloc;
        if (old + 1u == (gen + 1u) * nloc) {
            __builtin_amdgcn_fence(__ATOMIC_RELEASE, "agent");
            asm volatile("s_waitcnt vmcnt(0)" ::: "memory");
            const unsigned og = xb_add(&bar[XB_TOP], 1u);
            const unsigned tg = og / nx;
            if (og + 1u == (tg + 1u) * nx) xb_add(&bar[XB_TOPGEN], 1u);
            else XB_SPIN(xb_ld(&bar[XB_TOPGEN]) == tg, bar);
            __builtin_amdgcn_fence(__ATOMIC_ACQUIRE, "agent");
            xb_add(&bar[XB_XGEN(b.x)], 1u);
            asm volatile("s_waitcnt vmcnt(0)" ::: "memory");
        } else {
            XB_SPIN(xb_ld(&bar[XB_XGEN(b.x)]) == gen, bar);
            __builtin_amdgcn_fence(__ATOMIC_ACQUIRE, "agent");
            asm volatile("s_waitcnt vmcnt(0)" ::: "memory");
        }
    }
    __syncthreads();
}

namespace pg8 {
constexpr int BM = 256, BK = 64, HALF = 128, HTB = HALF * BK * 2, STAGE_BYTES = 8 * HTB, NXCD = 8, WGM = 8;
constexpr int GK = 1024;
__device__ __forceinline__ int lds_byte(int r, int c) { const int st = (r >> 4) * 2 + (c >> 5), rr = r & 15, cc = c & 31, ob = rr * 64 + cc * 2; return st * 1024 + (ob ^ (((ob >> 9) & 1) << 5)); }
__device__ __forceinline__ void stage_rc(int b, int& R, int& C) { const int st = b / 1024, sb = b % 1024, swz = sb ^ (((sb >> 9) & 1) << 5); R = (st >> 1) * 16 + swz / 64; C = (st & 1) * 32 + (swz % 64) / 2; }
__device__ __forceinline__ int perm32(int rho) { const int n = rho >> 4, i = rho & 15; return 8 * (i >> 2) + 4 * n + (i & 3); }
struct Unit { int pm, pn, e; };

template <bool IDG> struct DenseSchedT {
    const char* A; const char* Bt; int nM, nN, nwg, G, c, kb;
    __device__ __forceinline__ void init(const void* A_, const void* Bt_, int M, int N, int G_, int c_, int kb_ = GK * 2) { A = (const char*)A_; Bt = (const char*)Bt_; nM = M / BM; nN = N / BM; nwg = nM * nN; G = G_; c = c_; kb = kb_; }
    __device__ __forceinline__ bool next(int i, Unit& u) const {
        const long L = (long)i * G + c; if (L >= nwg) return false;
        int wgid = (int)L; { const int q = nwg / NXCD, r = nwg % NXCD, xcd = wgid % NXCD, off = wgid / NXCD; wgid = (xcd < r ? xcd * (q + 1) : r * (q + 1) + (xcd - r) * q) + off; }
        const int nig = WGM * nN, gid = wgid / nig, fm = gid * WGM, gsz = (nM - fm) < WGM ? (nM - fm) : WGM;
        u.pm = fm + ((wgid % nig) % gsz); u.pn = (wgid % nig) / gsz; u.e = 0; return true;
    }
    __device__ __forceinline__ const char* a_ptr(const Unit& u) const { return IDG ? A : A + (size_t)u.pm * (size_t)(BM * kb); }
    __device__ __forceinline__ const char* b_ptr(const Unit& u) const { return Bt + (size_t)u.pn * (size_t)(BM * kb); }
    __device__ __forceinline__ void a_offs(const Unit& u, const int (&R)[2], const int (&C)[2], unsigned (&voff)[2][2]) const {
#pragma unroll
        for (int h = 0; h < 2; ++h)
#pragma unroll
            for (int i = 0; i < 2; ++i) voff[h][i] = (unsigned)(u.pm * BM + h * HALF + R[i]) * (unsigned)kb + (unsigned)C[i] * 2u;
    }
    __device__ __forceinline__ void a_raw(const Unit&, const int (&)[2], int (&)[2][2]) const {}
    __device__ __forceinline__ void a_fin(const Unit& u, const int (&R)[2], const int (&C)[2], const int (&)[2][2], unsigned (&voff)[2][2]) const { a_offs(u, R, C, voff); }
};
typedef DenseSchedT<false> DenseSched;
struct MoeSched {
    const char* A; const char* Bt; size_t b_estride; const int* rowtok; const volatile LAS int* cumblk; const volatile LAS int* cnt; int ncol_log2, G, c, kb; const volatile LAS int* ulist;
    __device__ __forceinline__ bool next(int i, Unit& u) const {
        const int v = ulist[i & 63]; if (v < 0) return false;
        u.pm = v >> 8; u.e = (v >> 3) & 31; u.pn = v & 7; return true;
    }
    __device__ __forceinline__ void build_list(volatile LAS int* dst, int tid) const {
        if (tid < 64) { Unit u; dst[tid] = search(tid, u) ? ((u.pm << 8) | (u.e << 3) | u.pn) : -1; }
    }
    __device__ __forceinline__ bool search(int i, Unit& u) const {
        int gb, pn; const int ncol = 1 << ncol_log2;
        if (G == 256 && MK_MOEMAP == 0) { const int xcd = c & 7, j = c >> 3, rpb = 256 >> ncol_log2; gb = i * rpb + xcd + 8 * (j >> ncol_log2); pn = j & (ncol - 1); }
        else { const long L = (long)i * G + c; gb = (int)(L >> ncol_log2); pn = (int)(L & (ncol - 1)); }
        const int tot = cumblk[NE]; if (gb >= tot) return false;
        int e = 0;
#pragma unroll 1
        for (int s = 16; s >= 1; s >>= 1) { if (cumblk[e + s] <= gb) e += s; }
        u.pm = gb; u.pn = pn; u.e = e; return true;
    }
    __device__ __forceinline__ const char* a_ptr(const Unit&) const { return A; }
    __device__ __forceinline__ const char* b_ptr(const Unit& u) const { return Bt + (size_t)u.e * b_estride + (size_t)u.pn * (size_t)(BM * kb); }
    __device__ __forceinline__ void a_raw(const Unit& u, const int (&R)[2], int (&raw)[2][2]) const {
        if (!rowtok) return;
        const int rb = u.pm - cumblk[u.e]; const int* rt = rowtok + (size_t)u.e * MT;
#pragma unroll
        for (int h = 0; h < 2; ++h)
#pragma unroll
            for (int i = 0; i < 2; ++i) { const int* ptr = rt + (rb * 256 + h * HALF + R[i]);
                asm volatile("global_load_dword %0, %1, off" : "=v"(raw[h][i]) : "v"(ptr) : "memory"); }
    }
    __device__ __forceinline__ void a_fin(const Unit& u, const int (&R)[2], const int (&C)[2], const int (&raw_)[2][2], unsigned (&voff)[2][2]) const {
        int raw[2][2] = {{raw_[0][0], raw_[0][1]}, {raw_[1][0], raw_[1][1]}};
        asm volatile("" : "+v"(raw[0][0]), "+v"(raw[0][1]), "+v"(raw[1][0]), "+v"(raw[1][1]));
        const int rb = u.pm - cumblk[u.e], n = cnt[u.e];
#pragma unroll
        for (int h = 0; h < 2; ++h)
#pragma unroll
            for (int i = 0; i < 2; ++i) { const int rank = rb * 256 + h * HALF + R[i]; const int tok = rowtok ? (rank < n ? raw[h][i] : 0) : u.pm * BM + h * HALF + R[i];
                voff[h][i] = (unsigned)tok * (unsigned)kb + (unsigned)C[i] * 2u; }
    }
    __device__ __forceinline__ void a_offs(const Unit& u, const int (&R)[2], const int (&C)[2], unsigned (&voff)[2][2]) const { int raw[2][2] = {{0, 0}, {0, 0}}; a_raw(u, R, raw); asm volatile("s_waitcnt vmcnt(0)" : "+v"(raw[0][0]), "+v"(raw[0][1]), "+v"(raw[1][0]), "+v"(raw[1][1]) :: "memory"); a_fin(u, R, C, raw, voff); }
};

typedef int v8i __attribute__((ext_vector_type(8)));
__device__ __forceinline__ v8i cat8(bf16x8 lo, bf16x8 hi) { const v4u a = __builtin_bit_cast(v4u, lo), b = __builtin_bit_cast(v4u, hi); return (v8i){(int)a.x, (int)a.y, (int)a.z, (int)a.w, (int)b.x, (int)b.y, (int)b.z, (int)b.w}; }
template <class Epi, class Sched, bool GATHER, bool FP8 = false, int XG = 0>
__device__ __forceinline__ void gemm_phase(LAS unsigned char* lds, const Sched& S, const Epi& E, int wave_id, bool skip_epi = false, unsigned stagger_ticks = 0u) {
    if (stagger_ticks && ((blockIdx.x >> 3) & 1u)) { const unsigned long long t0 = __builtin_amdgcn_s_memrealtime(); while (__builtin_amdgcn_s_memrealtime() - t0 < (unsigned long long)stagger_ticks) __builtin_amdgcn_s_sleep(8); }
    const int tid = opaque_tid(wave_id), wid = __builtin_amdgcn_readfirstlane(tid >> 6), lane = tid & 63, wr = wid >> 2, wc = wid & 3, fr = lane & 15, fq = lane >> 4;
    constexpr int KB = FP8 ? GK : GK * 2, nt = KB / (BK * 2);
    unsigned voffA[2][2], voffB[2]; int Rr[2], Cc[2];
#pragma unroll
    for (int i = 0; i < 2; ++i) { int R, C; stage_rc(tid * 16 + i * 8192, R, C); Rr[i] = R; Cc[i] = C; const int Rb = Epi::PERM ? ((R & ~31) + perm32(R & 31)) : R;
        voffA[0][i] = (unsigned)(R * KB + C * 2); voffA[1][i] = (unsigned)((R + HALF) * KB + C * 2); voffB[i] = (unsigned)(Rb * KB + C * 2); }
    constexpr size_t kstep = (size_t)(BK * 2);
    constexpr size_t hstep = (size_t)HALF * KB;
    const unsigned ldsw = (unsigned)wid * 1024u;
    const int aoff = lds_byte(wr * 64 + fr, fq * 8), boff = lds_byte(wc * 32 + fr, fq * 8);
    LAS unsigned char* abase = lds + aoff; LAS unsigned char* bbase = lds + 4 * HTB + boff; asm volatile("" : "+v"(abase), "+v"(bbase));
#define PG8_SA(b, h) (((b) * 2 + (h)) * HTB)
#define PG8_SB(b, h) ((4 + (b) * 2 + (h)) * HTB)
#define PG8_STAGE(bufoff, gbase, voff) do { if (XG == 3) break; _Pragma("unroll") for (int _i = 0; _i < 2; ++_i) \
        __builtin_amdgcn_global_load_lds((const unsigned*)((const char*)(gbase) + (voff)[_i]), (LAS unsigned*)(lds + (bufoff) + ldsw + _i * 8192), 16, 0, 0); } while (0)
#define PG8_STAGE_A(bufoff, gbase, h) PG8_STAGE(bufoff, gbase, voffA[h])
#define PG8_RDA(off) (*(const LAS v4u*)(abase + (off)))
#define PG8_RDB(off) (*(const LAS v4u*)(bbase + (off)))
#define PG8_LDA(dst, b, h) do { if (XG == 2) break; _Pragma("unroll") for (int m = 0; m < 4; ++m) { const v4u _l = PG8_RDA(PG8_SA(b, h) + m * 2048), _h = PG8_RDA(PG8_SA(b, h) + m * 2048 + 1024); \
        if constexpr (FP8) dst##8[m] = (v8i){(int)_l.x, (int)_l.y, (int)_l.z, (int)_l.w, (int)_h.x, (int)_h.y, (int)_h.z, (int)_h.w}; \
        else { dst[m][0] = __builtin_bit_cast(bf16x8, _l); dst[m][1] = __builtin_bit_cast(bf16x8, _h); } } } while (0)
#define PG8_LDB(dst, b, h) do { if (XG == 2) break; _Pragma("unroll") for (int n = 0; n < 2; ++n) { const v4u _l = PG8_RDB(PG8_SA(b, h) + n * 2048), _h = PG8_RDB(PG8_SA(b, h) + n * 2048 + 1024); \
        if constexpr (FP8) dst##8[n] = (v8i){(int)_l.x, (int)_l.y, (int)_l.z, (int)_l.w, (int)_h.x, (int)_h.y, (int)_h.z, (int)_h.w}; \
        else { dst[n][0] = __builtin_bit_cast(bf16x8, _l); dst[n][1] = __builtin_bit_cast(bf16x8, _h); } } } while (0)
#define PG8_MMA(ai, bj, At, Bt) do { if (XG == 1) break; __builtin_amdgcn_s_setprio(1); _Pragma("unroll") for (int m = 0; m < 4; ++m) _Pragma("unroll") for (int n = 0; n < 2; ++n) { \
        if constexpr (FP8) acc[ai][bj][m][n] = __builtin_amdgcn_mfma_scale_f32_16x16x128_f8f6f4(Bt##8[n], At##8[m], acc[ai][bj][m][n], 0, 0, 0, 0x7A7A7A7A, 0, 0x7F7F7F7F); \
        else { _Pragma("unroll") for (int k = 0; k < 2; ++k) acc[ai][bj][m][n] = __builtin_amdgcn_mfma_f32_16x16x32_bf16(Bt[n][k], At[m][k], acc[ai][bj][m][n], 0, 0, 0); } } \
        __builtin_amdgcn_s_setprio(0); } while (0)
#define PG8_WAIT_V(n) asm volatile("s_waitcnt vmcnt(" #n ")" ::: "memory")
#define PG8_WAIT_L(n) asm volatile("s_waitcnt lgkmcnt(" #n ")" ::: "memory")
#define PG8_BAR __builtin_amdgcn_s_barrier()
#define PG8_SCHED __builtin_amdgcn_sched_barrier(0)
    Unit cur, nxt; int ui = 0;
    if (!S.next(0, cur)) return;
    f32x4 acc[2][2][4][2];
#pragma unroll
    for (int a = 0; a < 2; ++a)
#pragma unroll
        for (int b = 0; b < 2; ++b)
#pragma unroll
            for (int m = 0; m < 4; ++m)
#pragma unroll
                for (int n = 0; n < 2; ++n) acc[a][b][m][n] = (f32x4){0.f, 0.f, 0.f, 0.f};
    bf16x8 At[4][2], B0[2][2], B1[2][2]; v8i At8[4], B08[2], B18[2];
    if constexpr (XG == 2) { _Pragma("unroll") for (int m = 0; m < 4; ++m) { asm volatile("" : "=v"(At8[m])); } _Pragma("unroll") for (int n = 0; n < 2; ++n) { asm volatile("" : "=v"(B08[n])); asm volatile("" : "=v"(B18[n])); } }
    const char* cA = S.a_ptr(cur); const char* cB = S.b_ptr(cur);
    if constexpr (GATHER) S.a_offs(cur, Rr, Cc, voffA);
    PG8_STAGE(PG8_SB(0, 0), cB, voffB); PG8_STAGE(PG8_SB(0, 1), cB + hstep, voffB); PG8_STAGE_A(PG8_SA(0, 0), cA, 0); PG8_STAGE_A(PG8_SA(0, 1), cA, 1);
    if (wr == 1) PG8_BAR;
    PG8_WAIT_V(2); PG8_BAR;
    PG8_STAGE(PG8_SB(1, 0), cB + kstep, voffB); PG8_STAGE_A(PG8_SA(1, 0), cA + kstep, 0); PG8_STAGE(PG8_SB(1, 1), cB + hstep + kstep, voffB);
    PG8_WAIT_V(6); PG8_BAR;
    for (;;) {
        const bool has_next = S.next(ui + 1, nxt);
        const char* nA = has_next ? S.a_ptr(nxt) : cA; const char* nB = has_next ? S.b_ptr(nxt) : cB;
        int rawN[2][2] = {{0, 0}, {0, 0}};
        if constexpr (GATHER) { if (has_next) S.a_raw(nxt, Rr, rawN); }
#pragma unroll 1
        for (int t = 0; t < nt; t += 2) {
            const bool last = (t == nt - 2);
            if constexpr (Epi::LDSBIAS) { if (last && wid == 0) E.stage_bias(cur, lane); }
            const char* a1 = cA + (size_t)(t + 1) * kstep;
            const char* a2 = last ? nA : cA + (size_t)(t + 2) * kstep; const char* b2 = last ? nB : cB + (size_t)(t + 2) * kstep;
            const char* a3 = a2 + kstep; const char* b3 = b2 + kstep;
            PG8_LDB(B0, 0, 0); PG8_LDB(B1, 0, 1); PG8_SCHED; PG8_LDA(At, 0, 0); PG8_STAGE_A(PG8_SA(1, 1), a1, 1);
            if constexpr (GATHER) { if (last && has_next) S.a_fin(nxt, Rr, Cc, rawN, voffA); }
            PG8_WAIT_V(8); PG8_WAIT_L(0); PG8_BAR; PG8_MMA(0, 0, At, B0); PG8_MMA(0, 1, At, B1); PG8_BAR; PG8_SCHED;
            PG8_LDA(At, 0, 1); PG8_STAGE(PG8_SB(0, 0), b2, voffB); PG8_STAGE(PG8_SB(0, 1), b2 + hstep, voffB); PG8_STAGE_A(PG8_SA(0, 0), a2, 0);
            PG8_WAIT_V(8); PG8_WAIT_L(0); PG8_BAR; PG8_MMA(1, 0, At, B0); PG8_MMA(1, 1, At, B1); PG8_BAR; PG8_SCHED;
            PG8_LDB(B0, 1, 0); PG8_LDB(B1, 1, 1); PG8_SCHED; PG8_LDA(At, 1, 0); PG8_STAGE_A(PG8_SA(0, 1), a2, 1);
            PG8_WAIT_V(8); PG8_WAIT_L(0); PG8_BAR; PG8_MMA(0, 0, At, B0); PG8_MMA(0, 1, At, B1); PG8_BAR; PG8_SCHED;
            PG8_LDA(At, 1, 1); PG8_STAGE(PG8_SB(1, 0), b3, voffB); PG8_STAGE(PG8_SB(1, 1), b3 + hstep, voffB); PG8_STAGE_A(PG8_SA(1, 0), a3, 0);
            PG8_WAIT_V(8); PG8_WAIT_L(0); PG8_BAR; PG8_MMA(1, 0, At, B0); PG8_MMA(1, 1, At, B1); PG8_BAR; PG8_SCHED;
        }
        if (wr == 0) PG8_BAR;
        if (!skip_epi) E(acc, cur, wr, wc, fr, fq);
        if (!has_next) break;
#pragma unroll
        for (int a = 0; a < 2; ++a)
#pragma unroll
            for (int b = 0; b < 2; ++b)
#pragma unroll
                for (int m = 0; m < 4; ++m)
#pragma unroll
                    for (int n = 0; n < 2; ++n) acc[a][b][m][n] = (f32x4){0.f, 0.f, 0.f, 0.f};
        cur = nxt; cA = nA; cB = nB; ++ui;
        if (wr == 1) PG8_BAR;
    }
    PG8_WAIT_V(0);
    PG8_BAR;
#undef PG8_SA
#undef PG8_SB
#undef PG8_STAGE
#undef PG8_STAGE_A
#undef PG8_LDA
#undef PG8_RDA
#undef PG8_RDB
#undef PG8_LDB
#undef PG8_MMA
#undef PG8_WAIT_V
#undef PG8_WAIT_L
#undef PG8_BAR
#undef PG8_SCHED
}
}
namespace pg8 {
__device__ __forceinline__ f32x2 gelu_pk(f32x2 v) {
    const f32x2 av = __builtin_elementwise_abs(v), d = av * 0.2316418882f + 1.0f;
    f32x2 t; t.x = __builtin_amdgcn_rcpf(d.x); t.y = __builtin_amdgcn_rcpf(d.y);
    f32x2 q = t * 0.5307027145f + (-0.7265760135f); q = q * t + 0.7107068705f; q = q * t + (-0.142248368f); q = q * t + 0.127414796f; q = q * t;
    const f32x2 s = (v * v) * (-0.72134752044f);
    f32x2 e; e.x = __builtin_amdgcn_exp2f(s.x); e.y = __builtin_amdgcn_exp2f(s.y);
    const f32x2 m = v * (q * e), r = v - m;
    f32x2 o; o.x = v.x < 0.f ? m.x : r.x; o.y = v.y < 0.f ? m.y : r.y; return o;
}
struct EpiBf16 {
    static constexpr bool PERM = true, LDSBIAS = false;
    bf16* O; int ldc; float* ss; int ACT;
    __device__ __forceinline__ void operator()(const f32x4 (&acc)[2][2][4][2], const Unit& u, int wr, int wc, int fr, int fq) const {
        const int row0 = u.pm * BM + wr * 64 + fr, col0 = u.pn * BM + wc * 32 + 8 * fq;
#pragma unroll
        for (int ai = 0; ai < 2; ++ai)
#pragma unroll
            for (int m = 0; m < 4; ++m) { const int row = row0 + ai * HALF + m * 16; bf16* rowp = O + (size_t)row * ldc + col0; float sq = 0.f;
#pragma unroll
                for (int bj = 0; bj < 2; ++bj) { f32x4 v0 = acc[ai][bj][m][0], v1 = acc[ai][bj][m][1];
                    if (ACT == 1) { f32x2 a = gelu_pk((f32x2){v0[0], v0[1]}), b = gelu_pk((f32x2){v0[2], v0[3]}), c = gelu_pk((f32x2){v1[0], v1[1]}), d = gelu_pk((f32x2){v1[2], v1[3]});
                        v0 = (f32x4){a.x, a.y, b.x, b.y}; v1 = (f32x4){c.x, c.y, d.x, d.y};
                        sq += (v0[0] * v0[0] + v0[1] * v0[1]) + (v0[2] * v0[2] + v0[3] * v0[3]) + (v1[0] * v1[0] + v1[1] * v1[1]) + (v1[2] * v1[2] + v1[3] * v1[3]); }
                    v4u w; w.x = cvt_pk_bf16(v0[0], v0[1]); w.y = cvt_pk_bf16(v0[2], v0[3]); w.z = cvt_pk_bf16(v1[0], v1[1]); w.w = cvt_pk_bf16(v1[2], v1[3]);
                    *(v4u*)(rowp + bj * HALF) = w; }
                if (ACT == 1) { const int ln = (fq << 4) | fr; sq += shx(sq, 16, ln); sq += shx(sq, 32, ln);
                    if (u.pn >= 4 && fq == 0) ss[(size_t)row * 16 + (u.pn - 4) * 4 + wc] = sq; }
            }
    }
};
struct EpiResid {
    static constexpr bool PERM = false, LDSBIAS = false;
    bf16* xb; const float* modl;
    __device__ __forceinline__ void operator()(const f32x4 (&acc)[2][2][4][2], const Unit& u, int wr, int wc, int fr, int fq) const {
        const bool lat = u.pm < ML / BM; const int bidx = lat ? (u.pm >> 5) : 8;
        bf16* base = xb + (size_t)u.pm * BM * D;
        const float* g = modl + bidx * 6144 + 2 * 1024;
        const int r0 = wr * 64 + fr, col0 = u.pn * BM + wc * 32 + 4 * fq;
        f32x4 gv[2][2];
#pragma unroll
        for (int bj = 0; bj < 2; ++bj)
#pragma unroll
            for (int n = 0; n < 2; ++n) gv[bj][n] = *(const f32x4*)(g + col0 + bj * HALF + n * 16);
        const int odd = fq & 1, colp = col0 - 4 * odd;
#pragma unroll
        for (int ai = 0; ai < 2; ++ai) { v4u bs[2][2][2];
#pragma unroll
            for (int mp = 0; mp < 2; ++mp) { const size_t off = (size_t)(r0 + ai * HALF + (2 * mp + odd) * 16) * D + colp;
#pragma unroll
                for (int bj = 0; bj < 2; ++bj)
#pragma unroll
                    for (int n = 0; n < 2; ++n) bs[mp][bj][n] = *(const v4u*)(base + off + bj * HALF + n * 16); }
#pragma unroll
            for (int mp = 0; mp < 2; ++mp) { const size_t off = (size_t)(r0 + ai * HALF + (2 * mp + odd) * 16) * D + colp;
#pragma unroll
                for (int bj = 0; bj < 2; ++bj)
#pragma unroll
                    for (int n = 0; n < 2; ++n) { const v4u L = bs[mp][bj][n];
                        const auto s0 = __builtin_amdgcn_permlane16_swap(L.x, L.z, false, false), s1 = __builtin_amdgcn_permlane16_swap(L.y, L.w, false, false);
                        const f32x4 va = bf4_f32((v2u){s0[0], s1[0]}) + gv[bj][n] * acc[ai][bj][2 * mp][n], vb = bf4_f32((v2u){s0[1], s1[1]}) + gv[bj][n] * acc[ai][bj][2 * mp + 1][n];
                        const auto t0 = __builtin_amdgcn_permlane16_swap(cvt_pk_bf16(va.x, va.y), cvt_pk_bf16(vb.x, vb.y), false, false), t1 = __builtin_amdgcn_permlane16_swap(cvt_pk_bf16(va.z, va.w), cvt_pk_bf16(vb.z, vb.w), false, false);
                        *(v4u*)(base + off + bj * HALF + n * 16) = (v4u){t0[0], t1[0], t0[1], t1[1]}; } }
            asm volatile("" ::: "memory"); }
    }
};
struct EpiSwiglu {
    static constexpr bool PERM = true, LDSBIAS = true;
    unsigned char* O; const float* b1; LAS float* bl;
    __device__ __forceinline__ void stage_bias(const Unit& u, int lane) const { const float* src = b1 + (size_t)u.e * 2048 + (lane < 32 ? u.pn * HALF + 4 * lane : 1024 + u.pn * HALF + 4 * (lane - 32));
        __builtin_amdgcn_global_load_lds((const unsigned*)src, (LAS unsigned*)bl, 16, 0, 0); }
    __device__ __forceinline__ void operator()(const f32x4 (&acc)[2][2][4][2], const Unit& u, int wr, int wc, int fr, int fq) const {
        const int row0 = u.pm * BM + wr * 64 + fr, cl = wc * 32 + 8 * fq, c0 = u.pn * HALF + cl;
        f32x4 bg[2], bli[2];
#pragma unroll
        for (int n = 0; n < 2; ++n) { bg[n] = *(const LAS f32x4*)(bl + cl + 4 * n); bli[n] = *(const LAS f32x4*)(bl + 128 + cl + 4 * n) + 1.0f; }
#pragma unroll
        for (int ai = 0; ai < 2; ++ai)
#pragma unroll
            for (int mp = 0; mp < 4; mp += 2) { v2u wv[2];
#pragma unroll
              for (int mm = 0; mm < 2; ++mm) { const int m = mp + mm; float o[8];
#pragma unroll
                for (int n = 0; n < 2; ++n)
#pragma unroll
                    for (int j = 0; j < 4; ++j) { const float gl = fminf(acc[ai][0][m][n][j] + bg[n][j], 7.0f), lp = __builtin_amdgcn_fmed3f(acc[ai][1][m][n][j] + bli[n][j], -6.0f, 8.0f);
                        const float sg = __builtin_amdgcn_rcpf(1.0f + __builtin_amdgcn_exp2f(gl * (-1.702f * 1.4426950408889634f)));
                        o[n * 4 + j] = gl * sg * lp; }
                v2u w; w.x = 0; w.y = 0;
                w.x = __builtin_amdgcn_cvt_pk_fp8_f32(o[0], o[1], w.x, false); w.x = __builtin_amdgcn_cvt_pk_fp8_f32(o[2], o[3], w.x, true);
                w.y = __builtin_amdgcn_cvt_pk_fp8_f32(o[4], o[5], w.y, false); w.y = __builtin_amdgcn_cvt_pk_fp8_f32(o[6], o[7], w.y, true);
                wv[mm] = w; }
              const auto sx = __builtin_amdgcn_permlane16_swap(wv[0].x, wv[1].x, false, false), sy = __builtin_amdgcn_permlane16_swap(wv[0].y, wv[1].y, false, false);
              *(v4u*)(O + (size_t)(row0 + ai * HALF + (mp + (fq & 1)) * 16) * D + (c0 - 8 * (fq & 1))) = (v4u){sx[0], sy[0], sx[1], sy[1]}; }
    }
};
struct EpiBias {
    static constexpr bool PERM = true, LDSBIAS = true;
    unsigned char* O; const float* b2; LAS float* bl;
    __device__ __forceinline__ void stage_bias(const Unit& u, int lane) const { __builtin_amdgcn_global_load_lds((const unsigned*)(b2 + (size_t)u.e * 1024 + u.pn * BM + 4 * lane), (LAS unsigned*)bl, 16, 0, 0); }
    __device__ __forceinline__ void operator()(const f32x4 (&acc)[2][2][4][2], const Unit& u, int wr, int wc, int fr, int fq) const {
        const int row0 = u.pm * BM + wr * 64 + fr, cl = wc * 32 + 8 * fq, col0 = u.pn * BM + cl;
#pragma unroll
        for (int bj = 0; bj < 2; ++bj) { const f32x4 bv0 = *(const LAS f32x4*)(bl + cl + bj * HALF), bv1 = *(const LAS f32x4*)(bl + cl + bj * HALF + 4);
#pragma unroll
            for (int ai = 0; ai < 2; ++ai)
#pragma unroll
                for (int mp = 0; mp < 4; mp += 2) { v2u wv[2];
#pragma unroll
                    for (int mm = 0; mm < 2; ++mm) { const int m = mp + mm; const f32x4 v0 = acc[ai][bj][m][0] + bv0, v1 = acc[ai][bj][m][1] + bv1;
                        v2u w; w.x = 0; w.y = 0;
                        w.x = __builtin_amdgcn_cvt_pk_fp8_f32(v0[0], v0[1], w.x, false); w.x = __builtin_amdgcn_cvt_pk_fp8_f32(v0[2], v0[3], w.x, true);
                        w.y = __builtin_amdgcn_cvt_pk_fp8_f32(v1[0], v1[1], w.y, false); w.y = __builtin_amdgcn_cvt_pk_fp8_f32(v1[2], v1[3], w.y, true);
                        wv[mm] = w; }
                    const auto sx = __builtin_amdgcn_permlane16_swap(wv[0].x, wv[1].x, false, false), sy = __builtin_amdgcn_permlane16_swap(wv[0].y, wv[1].y, false, false);
                    *(v4u*)(O + (size_t)(row0 + ai * HALF + (mp + (fq & 1)) * 16) * D + (col0 - 8 * (fq & 1)) + bj * HALF) = (v4u){sx[0], sy[0], sx[1], sy[1]}; }
            asm volatile("" ::: "memory"); }
    }
};
}

namespace att {
constexpr int AD = 128, NW = 8, QBLK = 32, KVBLK = 64;
constexpr float SCALE = 0.088388347648318440f;
constexpr int LDO = 1024;
constexpr int SHM_V = AD * KVBLK, SHM_K = KVBLK * AD, SHM_ATTN = 4 * SHM_V + 4 * SHM_K;
typedef int v8i __attribute__((ext_vector_type(8)));
#define K8SW(key, c) ((key) * 128 + ((((c) ^ (((key) >> 1) & 7))) << 4))
#define V8SW(d, c) ((d) * 64 + ((((c) ^ (((d) >> 2) & 3))) << 4))
#define SBAR() __builtin_amdgcn_sched_barrier(0)
__device__ __forceinline__ int crow(int r, int hi) { return (r & 3) + 8 * (r >> 2) + 4 * hi; }
template <int XV = 0>
__device__ __forceinline__ int exp4(float a0, float a1, float a2, float a3) {
  float t0 = fminf(a0 + 8.0f, 8.0f), t1 = fminf(a1 + 8.0f, 8.0f), t2 = fminf(a2 + 8.0f, 8.0f), t3 = fminf(a3 + 8.0f, 8.0f); int w;
  asm volatile("v_exp_f32 %1, %1\n\tv_exp_f32 %2, %2\n\tv_exp_f32 %3, %3\n\tv_exp_f32 %4, %4\n\t"
               "v_cvt_pk_fp8_f32 %0, %1, %2\n\ts_nop 0\n\tv_cvt_pk_fp8_f32 %0, %3, %4 op_sel:[0,0,1]"
               : "=&v"(w), "+v"(t0), "+v"(t1), "+v"(t2), "+v"(t3));
  return w;
}
template <int PAD>
__device__ __forceinline__ int expc4(float a0, float a1, float a2, float a3) {
  int w; float t0, t1, t2, t3;
  if constexpr (PAD != 0)
    asm volatile("s_nop 5\n\tv_exp_f32_e64 %1, %5 clamp\n\tv_exp_f32_e64 %2, %6 clamp\n\tv_exp_f32_e64 %3, %7 clamp\n\tv_exp_f32_e64 %4, %8 clamp\n\t"
                 "v_cvt_scalef32_pk_fp8_f32 %0, %1, %2, %9\n\ts_nop 0\n\tv_cvt_scalef32_pk_fp8_f32 %0, %3, %4, %9 op_sel:[0,0,0,1]"
                 : "=&v"(w), "=&v"(t0), "=&v"(t1), "=&v"(t2), "=&v"(t3) : "v"(a0), "v"(a1), "v"(a2), "v"(a3), "s"(0x3B800000));
  else
    asm volatile("v_exp_f32_e64 %1, %5 clamp\n\tv_exp_f32_e64 %2, %6 clamp\n\tv_exp_f32_e64 %3, %7 clamp\n\tv_exp_f32_e64 %4, %8 clamp\n\t"
                 "v_cvt_scalef32_pk_fp8_f32 %0, %1, %2, %9\n\ts_nop 0\n\tv_cvt_scalef32_pk_fp8_f32 %0, %3, %4, %9 op_sel:[0,0,0,1]"
                 : "=&v"(w), "=&v"(t0), "=&v"(t1), "=&v"(t2), "=&v"(t3) : "v"(a0), "v"(a1), "v"(a2), "v"(a3), "s"(0x3B800000));
  return w;
}
#define EXC4(P, m, PAD) expc4<PAD>(P[4 * (m)], P[4 * (m) + 1], P[4 * (m) + 2], P[4 * (m) + 3])
typedef int v4i __attribute__((ext_vector_type(4)));
__device__ __forceinline__ void partialSM(const f32x16& p0, float nb, v4i& plo) {
#pragma unroll
  for (int m = 0; m < 4; ++m) plo[m] = exp4(p0[4 * m], p0[4 * m + 1], p0[4 * m + 2], p0[4 * m + 3]);
}
__device__ __forceinline__ void finishSM(const f32x16& p1, float nb, const v4i& plo, v8i& pa) {
  v4i phi;
#pragma unroll
  for (int m = 0; m < 4; ++m) phi[m] = exp4(p1[4 * m], p1[4 * m + 1], p1[4 * m + 2], p1[4 * m + 3]);
  pa = (v8i){plo[0], plo[1], plo[2], plo[3], phi[0], phi[1], phi[2], phi[3]};
}
__device__ __forceinline__ void qkt(f32x16& p0, f32x16& p1, const char* Ks, const v8i* q8, int r32, int hi, const f32x16& NBV) {
  p0 = NBV; p1 = NBV;
#pragma unroll
  for (int s = 0; s < 2; ++s) { const int c0 = 4 * s + 2 * hi;
    const v4u a0 = *reinterpret_cast<const v4u*>(Ks + K8SW(r32, c0)), a1 = *reinterpret_cast<const v4u*>(Ks + K8SW(r32, c0 + 1));
    const v4u b0 = *reinterpret_cast<const v4u*>(Ks + K8SW(32 + r32, c0)), b1 = *reinterpret_cast<const v4u*>(Ks + K8SW(32 + r32, c0 + 1));
    const v8i A0 = (v8i){(int)a0.x, (int)a0.y, (int)a0.z, (int)a0.w, (int)a1.x, (int)a1.y, (int)a1.z, (int)a1.w};
    const v8i A1 = (v8i){(int)b0.x, (int)b0.y, (int)b0.z, (int)b0.w, (int)b1.x, (int)b1.y, (int)b1.z, (int)b1.w};
    p0 = __builtin_amdgcn_mfma_scale_f32_32x32x64_f8f6f4(A0, q8[s], p0, 0, 0, 0, 0x7F7F7F7F, 0, 0x7C7C7C7C);
    p1 = __builtin_amdgcn_mfma_scale_f32_32x32x64_f8f6f4(A1, q8[s], p1, 0, 0, 0, 0x7F7F7F7F, 0, 0x7C7C7C7C); }
}
__device__ __forceinline__ void pv_d0(f32x16* o, f32x16& lacc, const char* Vs, v8i pa, int r32, int hi) {
  { const int one = 0x38383838; const v8i ONES = (v8i){one, one, one, one, one, one, one, one};
    lacc = __builtin_amdgcn_mfma_scale_f32_32x32x64_f8f6f4(pa, ONES, lacc, 0, 0, 0, 0x7F7F7F7F, 0, 0x7F7F7F7F); }
#pragma unroll
  for (int d0 = 0; d0 < 4; ++d0) { const int d = 32 * d0 + r32;
    const v4u b0 = *reinterpret_cast<const v4u*>(Vs + V8SW(d, 2 * hi)), b1 = *reinterpret_cast<const v4u*>(Vs + V8SW(d, 2 * hi + 1));
    const v8i B = (v8i){(int)b0.x, (int)b0.y, (int)b0.z, (int)b0.w, (int)b1.x, (int)b1.y, (int)b1.z, (int)b1.w};
    o[d0] = __builtin_amdgcn_mfma_scale_f32_32x32x64_f8f6f4(pa, B, o[d0], 0, 0, 0, 0x7F7F7F7F, 0, 0x7F7F7F7F); }
}
__device__ __forceinline__ v8i lds32(const char* p0, const char* p1) { const v4u a = *reinterpret_cast<const v4u*>(p0), b = *reinterpret_cast<const v4u*>(p1);
  return (v8i){(int)a.x, (int)a.y, (int)a.z, (int)a.w, (int)b.x, (int)b.y, (int)b.z, (int)b.w}; }
#define MF8(A, B, C, SB) ((XV == 3 || XV == 4 || XV == 5 || XV == 9) ? (C) : __builtin_amdgcn_mfma_scale_f32_32x32x64_f8f6f4(A, B, C, 0, 0, 0, 0x7F7F7F7F, 0, SB))
#define EX4(P, m) exp4<XV>(P[4 * (m)], P[4 * (m) + 1], P[4 * (m) + 2], P[4 * (m) + 3])
template <int XV = 0>
__device__ __forceinline__ void tile_step(f32x16& pN0, f32x16& pN1, const f32x16& pP1, const v4i& ploP, v4i& ploN, f32x16* o, f32x16& lacc,
                                          const char* Ks, const char* Vs, const v8i* q8, int r32, int hi, const f32x16& Z) {
  const int one = 0x38383838; const v8i ONES = (v8i){one, one, one, one, one, one, one, one};
  v4i phi;
  const v8i A00 = lds32(Ks + K8SW(r32, 2 * hi), Ks + K8SW(r32, 2 * hi + 1)), A10 = lds32(Ks + K8SW(32 + r32, 2 * hi), Ks + K8SW(32 + r32, 2 * hi + 1));
  const v8i A01 = lds32(Ks + K8SW(r32, 4 + 2 * hi), Ks + K8SW(r32, 4 + 2 * hi + 1)), A11 = lds32(Ks + K8SW(32 + r32, 4 + 2 * hi), Ks + K8SW(32 + r32, 4 + 2 * hi + 1));
  phi[0] = EXC4(pP1, 0, 0); SBAR();
  pN0 = MF8(A00, q8[0], Z, 0x7C7C7C7C);   SBAR(); const v8i V0 = lds32(Vs + V8SW(r32, 2 * hi), Vs + V8SW(r32, 2 * hi + 1));           phi[1] = EXC4(pP1, 1, 0); SBAR();
  pN0 = MF8(A01, q8[1], pN0, 0x7C7C7C7C); SBAR(); const v8i V1 = lds32(Vs + V8SW(32 + r32, 2 * hi), Vs + V8SW(32 + r32, 2 * hi + 1)); phi[2] = EXC4(pP1, 2, 0); SBAR();
  pN1 = MF8(A10, q8[0], Z, 0x7C7C7C7C);   SBAR(); const v8i V2 = lds32(Vs + V8SW(64 + r32, 2 * hi), Vs + V8SW(64 + r32, 2 * hi + 1)); phi[3] = EXC4(pP1, 3, 0); SBAR();
  pN1 = MF8(A11, q8[1], pN1, 0x7C7C7C7C); SBAR(); const v8i V3 = lds32(Vs + V8SW(96 + r32, 2 * hi), Vs + V8SW(96 + r32, 2 * hi + 1)); SBAR();
  const v8i pa = (v8i){ploP[0], ploP[1], ploP[2], ploP[3], phi[0], phi[1], phi[2], phi[3]};
  lacc = MF8(pa, ONES, lacc, 0x7F7F7F7F); SBAR(); ploN[0] = EXC4(pN0, 0, 1); SBAR();
  o[0] = MF8(pa, V0, o[0], 0x7F7F7F7F);   SBAR(); ploN[1] = EXC4(pN0, 1, 0); SBAR();
  o[1] = MF8(pa, V1, o[1], 0x7F7F7F7F);   SBAR(); ploN[2] = EXC4(pN0, 2, 0); SBAR();
  o[2] = MF8(pa, V2, o[2], 0x7F7F7F7F);   SBAR(); ploN[3] = EXC4(pN0, 3, 0); SBAR();
  o[3] = MF8(pa, V3, o[3], 0x7F7F7F7F);   SBAR();
}
template <int XV = 0>
__device__ __forceinline__ void attn_dense_body(const unsigned char* __restrict__ Q8, const unsigned char* __restrict__ K8, const unsigned char* __restrict__ VT, int vt_ld, bf16* __restrict__ Ob, int seq, char* lds, int wave_id, float nb) {
  const int tid = opaque_tid(wave_id), wid = tid >> 6, lane = tid & 63, r32 = lane & 31, hi = lane >> 5;
  char* V_lds = lds; char* K_lds = lds + 4 * SHM_V;
  f32x16 lacc = {}; f32x16 o[4] = {}; v8i qr[2]; f32x16 NBV;
#pragma unroll
  for (int i = 0; i < 16; ++i) NBV[i] = nb;
  { const unsigned char* Qw = Q8 + (long)(wid * QBLK + r32) * 1024 + hi * 32;
#pragma unroll
    for (int s2 = 0; s2 < 2; ++s2) { const v4u a = *reinterpret_cast<const v4u*>(Qw + 64 * s2), b = *reinterpret_cast<const v4u*>(Qw + 64 * s2 + 16);
      qr[s2] = (v8i){(int)a.x, (int)a.y, (int)a.z, (int)a.w, (int)b.x, (int)b.y, (int)b.z, (int)b.w}; } }
  struct { v4u vs, ks; } sr_[1];
  const int kkey = tid >> 3, kch = tid & 7; const unsigned koff = (unsigned)(kkey * 256 + kch * 16); const int kst = K8SW(kkey, kch);
  const int vd = tid >> 2, vc = tid & 3; const unsigned voff = (unsigned)(vd * vt_ld + vc * 16); const int vst = V8SW(vd, vc);
#define SLOAD(i, k0) do { if (XV >= 7) break; sr_[i].vs = *reinterpret_cast<const v4u*>((const char*)VT + (size_t)(k0) + voff); \
    sr_[i].ks = *reinterpret_cast<const v4u*>((const char*)K8 + (size_t)(k0) * 256 + koff); } while (0)
#define SWRITE(b, i) do { *(v4u*)(V_lds + (b) * SHM_V + vst) = sr_[i].vs; *(v4u*)(K_lds + (b) * SHM_K + kst) = sr_[i].ks; } while (0)
#define SWAIT() asm volatile("s_waitcnt vmcnt(0)" ::: "memory")
#define TBAR() asm volatile("s_waitcnt lgkmcnt(0)\n\ts_barrier" ::: "memory")
  f32x16 pA0, pA1, pB0, pB1; v8i pa; v4i plA, plB; const int NT = seq / KVBLK;
  SLOAD(0, 0); SWAIT(); SWRITE(0, 0); SLOAD(0, KVBLK); TBAR();
  qkt(pA0, pA1, K_lds, qr, r32, hi, NBV); partialSM(pA0, nb, plA);
  SWAIT(); SWRITE(1, 0); SLOAD(0, 2 * KVBLK); TBAR();
#define STEP_IO(t, SW) do { SWAIT(); SWRITE(SW, 0); { const int tn = (t) + 2 < NT ? (t) + 2 : NT - 1; SLOAD(0, tn * KVBLK); } SBAR(); } while (0)
#define STEP_B(t, SK, SV, SW) do { STEP_IO(t, SW); tile_step<XV>(pB0, pB1, pA1, plA, plB, o, lacc, K_lds + (SK) * SHM_K, V_lds + (SV) * SHM_V, qr, r32, hi, NBV); TBAR(); } while (0)
#define STEP_A(t, SK, SV, SW) do { STEP_IO(t, SW); tile_step<XV>(pA0, pA1, pB1, plB, plA, o, lacc, K_lds + (SK) * SHM_K, V_lds + (SV) * SHM_V, qr, r32, hi, NBV); TBAR(); } while (0)
  int j = 1;
  for (; j + 5 < NT; j += 4) { STEP_B(j, 1, 0, 2); STEP_A(j + 1, 2, 1, 3); STEP_B(j + 2, 3, 2, 0); STEP_A(j + 3, 0, 3, 1); }
  STEP_B(j, 1, 0, 2); STEP_A(j + 1, 2, 1, 3);
  SBAR(); qkt(pB0, pB1, K_lds + 3 * SHM_K, qr, r32, hi, NBV);
  finishSM(pA1, nb, plA, pa); SBAR();
  pv_d0(o, lacc, V_lds + 2 * SHM_V, pa, r32, hi); partialSM(pB0, nb, plB);
  finishSM(pB1, nb, plB, pa); SBAR();
  pv_d0(o, lacc, V_lds + 3 * SHM_V, pa, r32, hi);
  __syncthreads();
  { const int ln2 = opaque_tid(wave_id) & 63, r32e = ln2 & 31, hie = ln2 >> 5;
    unsigned short* T = (unsigned short*)lds + wid * (32 * 136);
#pragma unroll
    for (int r = 0; r < 16; ++r) { const int orow = crow(r, hie); const float rl = __builtin_amdgcn_rcpf(lacc[r]);
#pragma unroll
      for (int d0 = 0; d0 < 4; ++d0) T[orow * 136 + d0 * 32 + r32e] = f2bf(o[d0][r] * rl); }
    asm volatile("s_waitcnt lgkmcnt(0)" ::: "memory");
    bf16* Ow = Ob + (long)(wid * QBLK) * LDO; const int rr = ln2 >> 4, ch = (ln2 & 15) * 8;
#pragma unroll
    for (int k = 0; k < 8; ++k) { const int row = 4 * k + rr; *(v4u*)(Ow + (long)row * LDO + ch) = *(const v4u*)(T + row * 136 + ch); } }
  __syncthreads();
#undef SLOAD
#undef TBAR
#undef STEP_IO
#undef STEP_A
#undef STEP_B
#undef SWRITE
#undef SWAIT
}
#undef K8SW
#undef V8SW
}
constexpr int NWAVES = 8, NTHREADS = 512;
struct Args { const float* in[36]; float* out; unsigned char* ws; int ph_lo, ph_hi; };
enum InIdx { I_X = 0, I_C, I_CTX, I_CCTX, I_ADAW, I_ADAB, I_N1G, I_N2G, I_WOUT, I_RW, I_RB, I_EW1, I_EB1, I_EW2, I_EB2, I_AWIN, I_AQG, I_AKG,
             I_GWIN, I_GVG, I_GWS, I_GBS, I_HWIN, I_HCW, I_HCB, I_FW1, I_FB1, I_FW2, I_FB2, I_FW3, I_FB3, I_FW4, I_FB4, I_FREQ, I_HD, I_FG };
struct Frame {
    LAS unsigned char* lds; volatile LAS unsigned* MISC; gu32* ctl;
    int tid, lane, wave, G, bx;
    float* out; unsigned char* ws;
};
template <class T> __device__ __forceinline__ T* launder(T* p) { unsigned long long v = (unsigned long long)p; asm volatile("" : "+s"(v)); return (T*)(GAS T*)v; }
constexpr int MW_PTRS = 640;
__device__ __forceinline__ const float* pin_load(const Frame& F, int i) {
    const unsigned lo = __builtin_amdgcn_readfirstlane(F.MISC[MW_PTRS + 2 * i]), hi = __builtin_amdgcn_readfirstlane(F.MISC[MW_PTRS + 2 * i + 1]);
    return (const float*)(GAS const float*)(((unsigned long long)hi << 32) | lo);
}
#define PIN(F, i) pin_load(F, i)
__device__ __forceinline__ Frame phase_frame(const Frame& F0) {
    Frame F = F0; F.tid = opaque_tid(F0.wave); F.lane = F.tid & 63; F.wave = F0.wave;
    F.ws = launder(F0.ws); F.out = launder(F0.out); F.ctl = (gu32*)(F.ws + WS_CTL);
    { LAS unsigned char* l = F0.lds; asm volatile("" : "+s"(l)); F.lds = l; F.MISC = (volatile LAS unsigned*)(l + MISC_OFF); }
    return F;
}
constexpr int PH_PRO0 = 0, PH_PRO1 = 1, PH_L0 = 2, PH_PER_LAYER = 9, PH_FINAL = PH_L0 + NLAYER * PH_PER_LAYER, PH_COUNT = PH_FINAL + 1;
enum LPhase { LP_NORM1 = 0, LP_INPROJ, LP_MIX1, LP_MIX2, LP_MIX3, LP_OUTPROJ, LP_NORM2, LP_MOE1, LP_MOE2 };

struct TItem { const float* src; unsigned char* dst; int N; bool fp8; };
__device__ __forceinline__ TItem titem_decode(Frame& F, int it) {
    constexpr int R0 = 128 * 512, R1 = 128 * 256, R2 = 2 * 384, R3 = 512, R4 = 768;
    int r = it; TItem t;
    if (r < R0) { const int mi = r >> 9, q = r & 511, kb = q >> 5, nb = q & 31, n0 = nb * 64;
        const int d0 = n0 < 1024 ? 256 * (n0 >> 7) + (n0 & 127) : 256 * ((n0 - 1024) >> 7) + 128 + (n0 & 127);
        t.src = PIN(F, I_EW1) + (size_t)mi * 1024 * 2048 + (size_t)(kb * 64) * 2048 + n0; t.N = 2048; t.fp8 = true; t.dst = F.ws + WS_WE1 + (size_t)mi * 2048 * 1024 + (size_t)d0 * 1024 + kb * 64; return t; } r -= R0;
    if (r < R1) { const int mi = r >> 8, q = r & 255, kb = q >> 4, nb = q & 15;
        t.src = PIN(F, I_EW2) + (size_t)mi * 1024 * 1024 + (size_t)(kb * 64) * 1024 + nb * 64; t.N = 1024; t.fp8 = true; t.dst = F.ws + WS_WE2 + (size_t)mi * 1024 * 1024 + (size_t)(nb * 64) * 1024 + kb * 64; return t; } r -= R1;
    if (r < R2) { const int mi = r / 384, q = r % 384, kb = q / 24, nb = q % 24;
        t.src = PIN(F, I_AWIN) + (size_t)mi * 1024 * 1536 + (size_t)(kb * 64) * 1536 + nb * 64; t.N = 1536; t.fp8 = true; t.dst = F.ws + WS_WATT + (size_t)mi * 1536 * 1024 + (size_t)(nb * 64) * 1024 + kb * 64; return t; } r -= R2;
    if (r < R3) { const int kb = r >> 5, nb = r & 31;
        t.src = PIN(F, I_GWIN) + (size_t)(kb * 64) * 2048 + nb * 64; t.N = 2048; t.fp8 = false; t.dst = F.ws + WS_WGM + ((size_t)(nb * 64) * 1024 + kb * 64) * 2; return t; } r -= R3;
    if (r < R4) { const int kb = r / 48, nb = r % 48;
        t.src = PIN(F, I_HWIN) + (size_t)(kb * 64) * 3072 + nb * 64; t.N = 3072; t.fp8 = false; t.dst = F.ws + WS_WHY + ((size_t)(nb * 64) * 1024 + kb * 64) * 2; return t; } r -= R4;
    { const int mi = r >> 8, q = r & 255, kb = q >> 4, nb = q & 15;
        t.src = PIN(F, I_WOUT) + (size_t)mi * 1024 * 1024 + (size_t)(kb * 64) * 1024 + nb * 64; t.N = 1024; t.fp8 = false; t.dst = F.ws + WS_WOUT + ((size_t)mi * 1024 * 1024 + (size_t)(nb * 64) * 1024 + kb * 64) * 2; return t; }
}
__device__ __forceinline__ void titem_load(const TItem& t, float (&v)[64], int lane) {
    const float* src = t.src + lane;
#pragma unroll
    for (int kk = 0; kk < 64; ++kk) v[kk] = src[(size_t)kk * t.N];
}
__device__ __forceinline__ void titem_finish(const TItem& t, const float (&v)[64], LAS float* scr, int lane) {
    constexpr int K = 1024;
#pragma unroll
    for (int kk = 0; kk < 64; ++kk) scr[kk * 65 + lane] = v[kk];
    LDS_WAIT(); asm volatile("" ::: "memory");
    if (!t.fp8) {
        const int c = lane & 7;
#pragma unroll
        for (int j = 0; j < 8; ++j) { const int n = (lane >> 3) + 8 * j; const LAS float* s = scr + (8 * c) * 65 + n;
            v4u o; o.x = pk2(s[0 * 65], s[1 * 65]); o.y = pk2(s[2 * 65], s[3 * 65]); o.z = pk2(s[4 * 65], s[5 * 65]); o.w = pk2(s[6 * 65], s[7 * 65]);
            *(GAS v4u*)(t.dst + ((size_t)n * K + 8 * c) * 2) = o; }
    } else {
        const int c = lane & 3;
#pragma unroll
        for (int j = 0; j < 4; ++j) { const int n = (lane >> 2) + 16 * j; const LAS float* s = scr + (16 * c) * 65 + n; unsigned w[4];
#pragma unroll
            for (int q = 0; q < 4; ++q) { unsigned x = 0; x = __builtin_amdgcn_cvt_pk_fp8_f32(32.0f * s[(4 * q) * 65], 32.0f * s[(4 * q + 1) * 65], x, false);
                x = __builtin_amdgcn_cvt_pk_fp8_f32(32.0f * s[(4 * q + 2) * 65], 32.0f * s[(4 * q + 3) * 65], x, true); w[q] = x; }
            *(GAS v4u*)(t.dst + (size_t)n * K + 16 * c) = (v4u){w[0], w[1], w[2], w[3]}; }
    }
    LDS_WAIT(); asm volatile("" ::: "memory");
}
__device__ __forceinline__ void pro0_transposes(Frame& F) {
    LAS float* scr = (LAS float*)(F.lds + F.wave * 16640);
    const int gw = F.bx * NWAVES + F.wave, NGW = F.G * NWAVES;
    constexpr int NITEMS = 128 * 512 + 128 * 256 + 2 * 384 + 512 + 768 + 4 * 256;
    float va[64], vb[64];
    int it = gw; if (it >= NITEMS) return;
    TItem ta = titem_decode(F, it), tb = ta; titem_load(ta, va, F.lane);
    for (;;) {
        const bool nb_ok = it + NGW < NITEMS; if (nb_ok) { tb = titem_decode(F, it + NGW); titem_load(tb, vb, F.lane); }
        titem_finish(ta, va, scr, F.lane);
        if (!nb_ok) break; it += NGW;
        const bool na_ok = it + NGW < NITEMS; if (na_ok) { ta = titem_decode(F, it + NGW); titem_load(ta, va, F.lane); }
        titem_finish(tb, vb, scr, F.lane);
        if (!na_ok) break; it += NGW;
    }
}
__device__ __forceinline__ void pro0_mod(Frame& F) {
    LAS float* sl = (LAS float*)F.lds;
    LAS float* red = (LAS float*)(F.lds + 65536);
    __syncthreads();
    for (int i = F.tid; i < 9 * 1024; i += NTHREADS) { const int r = i >> 10, k = i & 1023; const float v = r < 8 ? PIN(F, I_C)[r * 1024 + k] : PIN(F, I_CCTX)[k]; sl[i] = v / (1.0f + __expf(-v)); }
    __syncthreads();
    float* MOD = (float*)(F.ws + WS_MOD);
    for (int item = F.bx; item < NLAYER * 96; item += F.G) {
        const int l = item / 96, n0 = (item % 96) * 64;
        const float* W = PIN(F, I_ADAW) + (size_t)l * 1024 * 6144 + n0 + F.lane;
        float acc[9];
#pragma unroll
        for (int r = 0; r < 9; ++r) acc[r] = 0.f;
        const int kb = F.wave * 128;
#pragma unroll 16
        for (int k = 0; k < 128; ++k) { const float wv = W[(size_t)(kb + k) * 6144];
#pragma unroll
            for (int r = 0; r < 9; ++r) acc[r] += sl[r * 1024 + kb + k] * wv; }
#pragma unroll
        for (int r = 0; r < 9; ++r) red[(F.wave * 9 + r) * 64 + F.lane] = acc[r];
        __syncthreads();
        for (int i = F.tid; i < 9 * 64; i += NTHREADS) { const int r = i >> 6, n = i & 63; float s = 0.f;
#pragma unroll
            for (int w = 0; w < 8; ++w) s += red[(w * 9 + r) * 64 + n];
            MOD[((size_t)l * 9 + r) * 6144 + n0 + n] = s + PIN(F, I_ADAB)[l * 6144 + n0 + n]; }
        __syncthreads();
    }
}
__device__ __forceinline__ void pro0_filter_mlp(Frame& F) {
    const int j = F.lane, gw = F.bx * NWAVES + F.wave, NGW = F.G * NWAVES;
    LAS float* W1 = (LAS float*)F.lds; LAS float* W2 = W1 + FEMB * FH; LAS float* W3 = W2 + FH * FH;
    __syncthreads();
    for (int i = F.tid; i < FEMB * FH; i += NTHREADS) W1[i] = PIN(F, I_FW1)[i];
    for (int i = F.tid; i < FH * FH; i += NTHREADS) { W2[i] = PIN(F, I_FW2)[i]; W3[i] = PIN(F, I_FW3)[i]; }
    __syncthreads();
    const float b1 = PIN(F, I_FB1)[j], b2 = PIN(F, I_FB2)[j], b3 = PIN(F, I_FB3)[j], fr = PIN(F, I_FREQ)[j];
    for (int it = gw; it < SEQ + CL; it += NGW) {
        const bool lat = it < SEQ; const int t = lat ? it : it - SEQ; const float L = lat ? (float)SEQ : (float)CL;
        const float tl = (float)t / (L - 1.0f), w = (6.283185307179586f * (float)t) / L;
        float z;
        { const int band = (j - 1) & 15; const float f = 1e-4f + (float)band * ((15.0f - 1e-4f) / 15.0f); const float a = f * w;
          z = (j == 0) ? tl : (j <= 16 ? cosf(a) : -sinf(a)); }
        float s = b1;
#pragma unroll
        for (int i = 0; i < FEMB; ++i) s += __shfl(z, i) * W1[i * FH + j];
        const float a1 = sinf(fr * s);
        s = b2;
#pragma unroll 16
        for (int i = 0; i < FH; ++i) s += __shfl(a1, i) * W2[i * FH + j];
        const float a2 = sinf(fr * s);
        s = b3;
#pragma unroll 16
        for (int i = 0; i < FH; ++i) s += __shfl(a2, i) * W3[i * FH + j];
        const float a3 = sinf(fr * s);
        float* dst = lat ? (float*)(F.ws + WS_A3) + (size_t)t * FH : (float*)(F.ws + WS_A3C) + (size_t)t * FH;
        dst[j] = a3;
    }
    __syncthreads();
}

__device__ __forceinline__ f32x2 cmul(f32x2 a, f32x2 b) { return (f32x2){a.x * b.x - a.y * b.y, a.x * b.y + a.y * b.x}; }
__device__ __forceinline__ f32x2 cconj(f32x2 a) { return (f32x2){a.x, -a.y}; }
#define ZP(n) ((n) + ((n) >> 5))
constexpr int FFT_LDS_BYTES = (NFFT + NFFT / 32) * 8;
__device__ __forceinline__ void bfly_dif(f32x2& a0, f32x2& a1, f32x2& a2, f32x2& a3, f32x2 w) {
    const f32x2 t0 = a0 + a2, t1 = a0 - a2, t2 = a1 + a3, d = a1 - a3, t3 = (f32x2){d.y, -d.x};
    const f32x2 y0 = t0 + t2, y2 = t0 - t2, y1 = t1 + t3, y3 = t1 - t3, w2 = cmul(w, w), w3 = cmul(w2, w);
    a0 = y0; a1 = cmul(y2, w2); a2 = cmul(y1, w); a3 = cmul(y3, w3);
}
__device__ __forceinline__ void bfly_dit(f32x2& a0, f32x2& a1, f32x2& a2, f32x2& a3, f32x2 w) {
    const f32x2 w2 = cmul(w, w), w3 = cmul(w2, w), A1 = cmul(a1, w2), A2 = cmul(a2, w), A3 = cmul(a3, w3);
    const f32x2 u0 = a0 + A1, u1 = a0 - A1, u2 = A2 + A3, u3 = A2 - A3, iu3 = (f32x2){-u3.y, u3.x};
    a0 = u0 + u2; a1 = u1 + iu3; a2 = u0 - u2; a3 = u1 - iu3;
}
template <int LQ, bool INV> __device__ __forceinline__ void fft_r16(LAS f32x2* z, int tid) {
    constexpr int q16 = 1 << LQ; constexpr float inv_lb = 1.0f / (float)(16 * q16);
    constexpr float C1 = 0.92387953251128674f, S1 = 0.38268343236508977f, C2 = 0.70710678118654752f;
    asm volatile("" : "+v"(tid));
#pragma unroll 1
    for (int g = tid; g < NFFT / 16; g += NTHREADS) {
        const int j = g & (q16 - 1), base = ((g >> LQ) << (LQ + 4)) + j;
        f32x2 x[16];
#pragma unroll
        for (int m = 0; m < 16; ++m) x[m] = z[ZP(base + (m << LQ))];
        const float fr = (float)j * inv_lb; const float sn = __builtin_amdgcn_sinf(fr);
        const f32x2 w1 = (f32x2){__builtin_amdgcn_cosf(fr), INV ? sn : -sn};
        const float sg = INV ? 1.0f : -1.0f;
        const f32x2 wa0 = w1, wa1 = cmul(w1, (f32x2){C1, sg * S1}), wa2 = cmul(w1, (f32x2){C2, sg * C2}), wa3 = cmul(w1, (f32x2){S1, sg * C1});
        const f32x2 w2 = cmul(w1, w1), wb = cmul(w2, w2);
        if constexpr (!INV) {
            bfly_dif(x[0], x[4], x[8], x[12], wa0); bfly_dif(x[1], x[5], x[9], x[13], wa1); bfly_dif(x[2], x[6], x[10], x[14], wa2); bfly_dif(x[3], x[7], x[11], x[15], wa3);
#pragma unroll
            for (int a = 0; a < 4; ++a) bfly_dif(x[4 * a], x[4 * a + 1], x[4 * a + 2], x[4 * a + 3], wb);
        } else {
#pragma unroll
            for (int a = 0; a < 4; ++a) bfly_dit(x[4 * a], x[4 * a + 1], x[4 * a + 2], x[4 * a + 3], wb);
            bfly_dit(x[0], x[4], x[8], x[12], wa0); bfly_dit(x[1], x[5], x[9], x[13], wa1); bfly_dit(x[2], x[6], x[10], x[14], wa2); bfly_dit(x[3], x[7], x[11], x[15], wa3);
        }
#pragma unroll
        for (int m = 0; m < 16; ++m) z[ZP(base + (m << LQ))] = x[m];
    }
    __syncthreads();
}
template <bool INV> __device__ __forceinline__ void fft_r4_unit(LAS f32x2* z, int tid) {
    asm volatile("" : "+v"(tid));
#pragma unroll 2
    for (int bf = tid; bf < NFFT / 4; bf += NTHREADS) {
        const int base = 4 * bf; f32x2 a0 = z[ZP(base)], a1 = z[ZP(base + 1)], a2 = z[ZP(base + 2)], a3 = z[ZP(base + 3)];
        if constexpr (!INV) { const f32x2 t0 = a0 + a2, t1 = a0 - a2, t2 = a1 + a3, d = a1 - a3, t3 = (f32x2){d.y, -d.x};
            z[ZP(base)] = t0 + t2; z[ZP(base + 1)] = t0 - t2; z[ZP(base + 2)] = t1 + t3; z[ZP(base + 3)] = t1 - t3; }
        else { const f32x2 u0 = a0 + a1, u1 = a0 - a1, u2 = a2 + a3, u3 = a2 - a3, iu3 = (f32x2){-u3.y, u3.x};
            z[ZP(base)] = u0 + u2; z[ZP(base + 1)] = u1 + iu3; z[ZP(base + 2)] = u0 - u2; z[ZP(base + 3)] = u1 - iu3; }
    }
    __syncthreads();
}
__device__ __forceinline__ void fft16k_dif(LAS f32x2* z, int tid) { fft_r16<10, false>(z, tid); fft_r16<6, false>(z, tid); fft_r16<2, false>(z, tid); fft_r4_unit<false>(z, tid); }
__device__ __forceinline__ void fft16k_dit_inv(LAS f32x2* z, int tid) { fft_r4_unit<true>(z, tid); fft_r16<2, true>(z, tid); fft_r16<6, true>(z, tid); fft_r16<10, true>(z, tid); }
constexpr int KF_LD = 8256;
__device__ __forceinline__ int rev14(int p) { return (int)(__brev((unsigned)p) >> 18); }
__device__ __forceinline__ float hy_delta(int c) { const float mn = -3.0701134573253945f, mx = -15.350567286626973f; return fabsf(mn + (mx - mn) * ((float)c / 1023.0f)); }

__device__ __forceinline__ void pro1_router_split(Frame& F) {
    const float* MOD = (const float*)(F.ws + WS_MOD); unsigned char* RW3 = F.ws + WS_RW3;
    for (int ent = F.bx * NTHREADS + F.tid; ent < NLAYER * 9 * 8 * 8 * 64; ent += F.G * NTHREADS) {
        const int lane = ent & 63, kb = (ent >> 6) & 7, w = (ent >> 9) & 7, lb = ent >> 12, l = lb / 9;
        const int k0 = w * 128 + 16 * kb + 8 * (lane >> 5), e = lane & 31;
        const float* gn = PIN(F, I_N2G) + l * D; const float* sc = MOD + (size_t)lb * 6144 + 4 * 1024; const float* rw = PIN(F, I_RW) + (size_t)l * D * NE;
        unsigned ph[4], pm[4], pl[4];
#pragma unroll
        for (int j2 = 0; j2 < 4; ++j2) { const int k = k0 + 2 * j2; const float v0 = gn[k] * (1.0f + sc[k]) * rw[(size_t)k * NE + e], v1 = gn[k + 1] * (1.0f + sc[k + 1]) * rw[(size_t)(k + 1) * NE + e];
            const unsigned h = cvt_pk_bf16(v0, v1); const float r0 = v0 - __uint_as_float(h << 16), r1 = v1 - __uint_as_float(h & 0xffff0000u);
            const unsigned m = cvt_pk_bf16(r0, r1); const float s0 = r0 - __uint_as_float(m << 16), s1 = r1 - __uint_as_float(m & 0xffff0000u);
            ph[j2] = h; pm[j2] = m; pl[j2] = cvt_pk_bf16(s0, s1); }
        v4u* dst = (v4u*)(RW3 + (size_t)(ent >> 6) * 3 * 1024) + lane;
        dst[0] = (v4u){ph[0], ph[1], ph[2], ph[3]}; dst[64] = (v4u){pm[0], pm[1], pm[2], pm[3]}; dst[128] = (v4u){pl[0], pl[1], pl[2], pl[3]};
    }
}
__device__ __forceinline__ void pro1_filters(Frame& F) {
    if (F.bx < NLAYER * 9) {
        const int lb = F.bx, l = lb / 9, e = F.lane & 31, hf = F.lane >> 5; const float* sh = (const float*)(F.ws + WS_MOD) + (size_t)lb * 6144 + 3 * 1024; const float* rw = PIN(F, I_RW) + (size_t)l * D * NE;
        LAS float* red = (LAS float*)F.lds; const int k0 = F.wave * 128 + hf * 64; float acc = 0.f;
#pragma unroll 8
        for (int k = k0; k < k0 + 64; ++k) acc += sh[k] * rw[(size_t)k * NE + e];
        acc += shx(acc, 32, F.lane); if (F.lane < 32) red[F.wave * 32 + e] = acc;
        __syncthreads();
        if (F.tid < 32) { float s = PIN(F, I_RB)[l * NE + F.tid];
#pragma unroll
            for (int w = 0; w < 8; ++w) s += red[w * 32 + F.tid];
            ((float*)(F.ws + WS_RC))[lb * NE + F.tid] = s; }
    }
    LAS f32x2* z = (LAS f32x2*)F.lds;
    LAS float* wl = (LAS float*)(F.lds + AUX_OFF + 8192);
    const float* a3 = (const float*)(F.ws + WS_A3); const float* a3c = (const float*)(F.ws + WS_A3C);
    f32x2* KF = (f32x2*)(F.ws + WS_KF); float* FCT = (float*)(F.ws + WS_FCT);
    for (int u = F.bx; u < 512; u += F.G) {
        const int ca = 2 * u, cb = 2 * u + 1;
        __syncthreads();
        if (F.tid < 256) { const int which = F.tid >> 6, m = F.tid & 63; const int col = (which & 1 ? cb : ca) + (which >> 1) * 1024; wl[which * 64 + m] = PIN(F, I_FW4)[m * 2048 + col]; }
        if (F.tid < 4) { const int col = (F.tid & 1 ? cb : ca) + (F.tid >> 1) * 1024; wl[256 + F.tid] = PIN(F, I_FB4)[col]; }
        __syncthreads();
        const float da = hy_delta(ca), db = hy_delta(cb);
        for (int t = F.tid; t < SEQ; t += NTHREADS) {
            const f32x4* ar = (const f32x4*)(a3 + (size_t)t * FH); float s0 = wl[256], s1 = wl[257], s2 = wl[258], s3 = wl[259];
#pragma unroll 8
            for (int m4 = 0; m4 < 16; ++m4) { const f32x4 a = ar[m4];
#pragma unroll
                for (int i = 0; i < 4; ++i) { const int m = m4 * 4 + i; s0 += a[i] * wl[m]; s1 += a[i] * wl[64 + m]; s2 += a[i] * wl[128 + m]; s3 += a[i] * wl[192 + m]; } }
            const float tl = (float)t / (float)(SEQ - 1); const float wa = __expf(-tl * da), wb = __expf(-tl * db);
            z[ZP(t)] = (f32x2){s0 * wa, s1 * wb};
            if (t == 0) z[ZP(SEQ)] = (f32x2){0.f, 0.f}; else z[ZP(NFFT - t)] = (f32x2){s2 * wa, s3 * wb};
        }
        for (int i = F.tid; i < 511; i += NTHREADS) {
            const int d = i - 255, t = d < 0 ? -d : d; const int o = d < 0 ? 2 : 0;
            const f32x4* ar = (const f32x4*)(a3c + (size_t)t * FH); float sa = wl[256 + o], sb = wl[257 + o];
            f32x4 av[16];
#pragma unroll
            for (int m4 = 0; m4 < 16; ++m4) av[m4] = ar[m4];
            __builtin_amdgcn_sched_barrier(0);
#pragma unroll
            for (int m4 = 0; m4 < 16; ++m4) {
#pragma unroll
                for (int i2 = 0; i2 < 4; ++i2) { const int m = m4 * 4 + i2; sa += av[m4][i2] * wl[o * 64 + m]; sb += av[m4][i2] * wl[(o + 1) * 64 + m]; }
                if ((m4 & 3) == 3) __builtin_amdgcn_sched_barrier(0); }
            const float tl = (float)t / (float)(CL - 1);
            FCT[(size_t)ca * 512 + d + 256] = sa * __expf(-tl * da); FCT[(size_t)cb * 512 + d + 256] = sb * __expf(-tl * db);
        }
        __syncthreads();
        fft16k_dif(z, F.tid);
        for (int k = F.tid; k <= NFFT / 2; k += NTHREADS) {
            const int p = rev14(k), p2 = rev14((NFFT - k) & (NFFT - 1)); const f32x2 a = z[ZP(p)], b = z[ZP(p2)];
            KF[(size_t)ca * KF_LD + k] = (f32x2){0.5f * (a.x + b.x), 0.5f * (a.y - b.y)};
            KF[(size_t)cb * KF_LD + k] = (f32x2){0.5f * (a.y + b.y), -0.5f * (a.x - b.x)};
        }
    }
    __syncthreads();
}

__device__ __forceinline__ void hyena_conv_phase(Frame& F) {
    LAS f32x2* z = (LAS f32x2*)F.lds;
    LAS float* aux = (LAS float*)(F.lds + AUX_OFF + 8192);
    const float* VT = (const float*)(F.ws + WS_VT); const float* VTC = (const float*)(F.ws + WS_VTC); float* CT = (float*)(F.ws + WS_CT); float* CTC = (float*)(F.ws + WS_CTC);
    const f32x2* KF = (const f32x2*)(F.ws + WS_KF); const float* FCT = (const float*)(F.ws + WS_FCT);
    f32x4 ina[4], inb[4];
#define HC_LOADIN(u_, t_) do { const int b_ = (u_) >> 9, c_ = 2 * ((u_) & 511); const f32x4* va_ = (const f32x4*)(VT + ((size_t)b_ * 1024 + c_) * SEQ + 16 * (t_)); \
        _Pragma("unroll") for (int i = 0; i < 4; ++i) { ina[i] = va_[i]; inb[i] = va_[SEQ / 4 + i]; } } while (0)
    if (F.bx < NB * 512) HC_LOADIN(F.bx, F.tid);
    for (int u = F.bx; u < NB * 512; u += F.G) {
        const int b = u >> 9, cp = u & 511, ca = 2 * cp, cb = ca + 1;
        int tq = F.tid; asm volatile("" : "+v"(tq));
        __syncthreads();
        { const int n0 = 16 * tq;
#pragma unroll
          for (int i = 0; i < 4; ++i) {
              z[ZP(n0 + 4 * i)] = (f32x2){ina[i].x, inb[i].x}; z[ZP(n0 + 4 * i + 1)] = (f32x2){ina[i].y, inb[i].y}; z[ZP(n0 + 4 * i + 2)] = (f32x2){ina[i].z, inb[i].z}; z[ZP(n0 + 4 * i + 3)] = (f32x2){ina[i].w, inb[i].w};
#pragma unroll
              for (int j = 0; j < 4; ++j) z[ZP(SEQ + n0 + 4 * i + j)] = (f32x2){0.f, 0.f}; } }
        f32x4 ka[8], kb[8]; f32x2 kaN, kbN;
        { const f32x4* pa = (const f32x4*)(KF + (size_t)ca * KF_LD + 16 * tq); const f32x4* pb = (const f32x4*)(KF + (size_t)cb * KF_LD + 16 * tq);
#pragma unroll
          for (int i = 0; i < 8; ++i) { ka[i] = pa[i]; kb[i] = pb[i]; }
          kaN = KF[(size_t)ca * KF_LD + NFFT / 2]; kbN = KF[(size_t)cb * KF_LD + NFFT / 2]; }
        { const int h = tq >> 8, t = tq & 255; const float* vc = VTC + ((size_t)b * 1024 + ca + h) * CL;
          aux[h * 256 + t] = vc[t]; aux[512 + h * 512 + t] = FCT[(size_t)(ca + h) * 512 + t]; aux[512 + h * 512 + 256 + t] = FCT[(size_t)(ca + h) * 512 + 256 + t];
          __syncthreads();
          float y = 0.f;
#pragma unroll 8
          for (int s = 0; s < CL; ++s) y += aux[h * 256 + s] * aux[512 + h * 512 + (t - s) + 256];
          CTC[((size_t)b * 1024 + ca + h) * CL + t] = y; }
        fft16k_dif(z, F.tid);
        int tpw = tq; asm volatile("" : "+v"(tpw));
#define HC_PW(k_, Ka_, Kb_) do { const int p = rev14(k_), p2 = rev14((NFFT - (k_)) & (NFFT - 1)); const f32x2 a = z[ZP(p)], b2 = z[ZP(p2)]; \
            const f32x2 Va = (f32x2){0.5f * (a.x + b2.x), 0.5f * (a.y - b2.y)}, Vb = (f32x2){0.5f * (a.y + b2.y), -0.5f * (a.x - b2.x)}; \
            const f32x2 ya = cmul(Va, Ka_), yb = cmul(Vb, Kb_); \
            z[ZP(p)] = (f32x2){ya.x - yb.y, ya.y + yb.x}; z[ZP(p2)] = (f32x2){ya.x + yb.y, -ya.y + yb.x}; } while (0)
#pragma unroll
        for (int i = 0; i < 8; ++i) { const int k = 16 * tpw + 2 * i;
            HC_PW(k, ((f32x2){ka[i].x, ka[i].y}), ((f32x2){kb[i].x, kb[i].y})); HC_PW(k + 1, ((f32x2){ka[i].z, ka[i].w}), ((f32x2){kb[i].z, kb[i].w}));
            asm volatile("" ::: "memory"); }
        if (tpw == 0) HC_PW(NFFT / 2, kaN, kbN);
#undef HC_PW
        __syncthreads();
        if (u + F.G < NB * 512) HC_LOADIN(u + F.G, tq);
        fft16k_dit_inv(z, F.tid);
        { int to = tq; asm volatile("" : "+v"(to)); const float sc = 1.0f / (float)NFFT; const int n0 = 16 * to;
          f32x4* oa = (f32x4*)(CT + ((size_t)b * 1024 + ca) * SEQ + n0);
#pragma unroll
          for (int i = 0; i < 4; ++i) { const f32x2 w0 = z[ZP(n0 + 4 * i)], w1 = z[ZP(n0 + 4 * i + 1)], w2 = z[ZP(n0 + 4 * i + 2)], w3 = z[ZP(n0 + 4 * i + 3)];
              oa[i] = (f32x4){w0.x * sc, w1.x * sc, w2.x * sc, w3.x * sc}; oa[SEQ / 4 + i] = (f32x4){w0.y * sc, w1.y * sc, w2.y * sc, w3.y * sc}; } }
    }
    __syncthreads();
#undef HC_LOADIN
}
constexpr int MW_CUMBLK = 16, MW_CNT = 64, MW_SELE = 128, MW_SELV = 256, MW_LRANK = 384, MW_LBASE = 512;
__device__ __forceinline__ void moe_tables(Frame& F, int layer) {
    __syncthreads();
    if (F.tid < NE) F.MISC[MW_CNT + F.tid] = __hip_atomic_load(F.ctl + CW_CNT + layer * NE + F.tid, RLX_AGENT);
    __syncthreads();
    if (F.tid == 0) { unsigned c = 0; for (int e = 0; e < NE; ++e) { F.MISC[MW_CUMBLK + e] = c; c += (F.MISC[MW_CNT + e] + 255u) >> 8; } F.MISC[MW_CUMBLK + NE] = c; }
    __syncthreads();
}

template <int MODE> __device__ __forceinline__ void rowpass(Frame& F, int layer, bool real = true, bool h8 = false) {
    const bool combine = (MODE == 0 && layer > 0) || MODE == 2;
    const int nrows = MODE == 2 ? ML : MT;
    const int cl = MODE == 2 ? NLAYER - 1 : layer - 1;
    const bool from_input = (MODE == 0 && layer == 0);
    const float* XLs = PIN(F, I_X); const float* XCs = PIN(F, I_CTX);
    bf16* XB = (bf16*)(F.ws + WS_XB); bf16* XBd = real ? XB : (bf16*)(F.ws + WS_P);
    const float* MOD = (const float*)(F.ws + WS_MOD);
    bf16* H = (bf16*)(F.ws + WS_H); unsigned char* H8 = (unsigned char*)(F.ws + WS_H8); const unsigned char* YM = (const unsigned char*)(F.ws + WS_YM);
    const int* TE = (const int*)(F.ws + WS_TE); const int* TR = (const int*)(F.ws + WS_TR); const float* TG = (const float*)(F.ws + WS_TG);
    const float* gnorm = MODE == 0 ? PIN(F, I_N1G) + layer * D : PIN(F, I_FG);
    if (combine) moe_tables(F, cl);
    f32x4 gn[4];
#pragma unroll
    for (int j = 0; j < 4; ++j) gn[j] = ((const f32x4*)gnorm)[F.lane + 64 * j];
    const int ntiles = nrows / 32;
    i32x4 nte[4], ntr[4]; f32x4 ntg[4];
#define RP_TABLES(tile_) do { const size_t rb_ = (size_t)((tile_) * 32 + F.wave * 4) * 4; \
        _Pragma("unroll") for (int q = 0; q < 4; ++q) { nte[q] = *(const i32x4*)(TE + rb_ + 4 * q); ntr[q] = *(const i32x4*)(TR + rb_ + 4 * q); ntg[q] = *(const f32x4*)(TG + rb_ + 4 * q); } } while (0)
    if (combine && F.bx < ntiles) RP_TABLES(F.bx);
    for (int tile = F.bx; tile < ntiles; tile += F.G) {
        const int rbase = tile * 32 + F.wave * 4; const bool lat = rbase < ML; const int bidx = lat ? (rbase >> 13) : 8;
        const float* g2 = MOD + ((size_t)(combine ? cl : 0) * 9 + bidx) * 6144 + 5 * 1024;
        const float* mb = MOD + ((size_t)layer * 9 + bidx) * 6144;
        int rid[4][4]; float gkk[4][4];
        if (combine) {
#pragma unroll
            for (int q = 0; q < 4; ++q)
#pragma unroll
                for (int k = 0; k < 4; ++k) { rid[q][k] = 256 * (int)F.MISC[MW_CUMBLK + nte[q][k]] + ntr[q][k]; gkk[q][k] = ntg[q][k]; }
            if (tile + F.G < ntiles) RP_TABLES(tile + F.G);
        }
#pragma unroll 1
        for (int pr = 0; pr < 2; ++pr) {
            size_t xo[2]; f32x4 v[2][4]; int rowid[2][4]; float gk[2][4];
#pragma unroll
            for (int u = 0; u < 2; ++u) { const int r = rbase + 2 * pr + u; xo[u] = (size_t)r * D;
                if (combine) {
#pragma unroll
                    for (int k = 0; k < 4; ++k) { rowid[u][k] = pr ? rid[2 + u][k] : rid[u][k]; gk[u][k] = pr ? gkk[2 + u][k] : gkk[u][k]; } }
                if (from_input) { const f32x4* xs = (const f32x4*)(lat ? XLs + xo[u] : XCs + (xo[u] - (size_t)ML * D));
#pragma unroll
                    for (int j = 0; j < 4; ++j) v[u][j] = xs[F.lane + 64 * j]; }
                else { const v2u* xs = (const v2u*)(XB + xo[u]);
#pragma unroll
                    for (int j = 0; j < 4; ++j) v[u][j] = bf4_f32(xs[F.lane + 64 * j]); } }
            if (combine) {
                unsigned w[2][4][4];
#pragma unroll
                for (int u = 0; u < 2; ++u)
#pragma unroll
                    for (int k = 0; k < 4; ++k) { const unsigned* yr = (const unsigned*)(YM + (size_t)rowid[u][k] * D);
#pragma unroll
                        for (int j = 0; j < 4; ++j) w[u][k][j] = yr[F.lane + 64 * j]; }
#pragma unroll
                for (int u = 0; u < 2; ++u) {
#pragma unroll
                    for (int j = 0; j < 4; ++j) { f32x4 a = (f32x4){0.f, 0.f, 0.f, 0.f};
#pragma unroll
                        for (int k = 0; k < 4; ++k) { const f32x2 lo = __builtin_amdgcn_cvt_pk_f32_fp8(w[u][k][j], false), hi2 = __builtin_amdgcn_cvt_pk_f32_fp8(w[u][k][j], true); a += gk[u][k] * (f32x4){lo.x, lo.y, hi2.x, hi2.y}; }
                        v[u][j] += ((const f32x4*)g2)[F.lane + 64 * j] * a; }
                    if (MODE == 0) { v2u* xd = (v2u*)(XBd + xo[u]);
#pragma unroll
                        for (int j = 0; j < 4; ++j) { v2u o; o.x = cvt_pk_bf16(v[u][j].x, v[u][j].y); o.y = cvt_pk_bf16(v[u][j].z, v[u][j].w); xd[F.lane + 64 * j] = o; } } }
            }
            if (from_input) {
#pragma unroll
                for (int u = 0; u < 2; ++u) { v2u* xd = (v2u*)(XBd + xo[u]);
#pragma unroll
                    for (int j = 0; j < 4; ++j) { v2u o; o.x = cvt_pk_bf16(v[u][j].x, v[u][j].y); o.y = cvt_pk_bf16(v[u][j].z, v[u][j].w); xd[F.lane + 64 * j] = o; } } }
#pragma unroll
            for (int u = 0; u < 2; ++u) { const int r = rbase + 2 * pr + u;
                float ss = 0.f;
#pragma unroll
                for (int j = 0; j < 4; ++j) ss += (v[u][j].x * v[u][j].x + v[u][j].y * v[u][j].y) + (v[u][j].z * v[u][j].z + v[u][j].w * v[u][j].w);
                const float rstd = 1.0f / sqrtf(wave_sum(ss, F.lane) * (1.0f / D) + EPS);
                if (MODE == 2) { f32x4* od = (f32x4*)((real ? F.out : (float*)(F.ws + WS_P)) + xo[u]);
#pragma unroll
                    for (int j = 0; j < 4; ++j) od[F.lane + 64 * j] = v[u][j] * rstd * gn[j]; }
                else { v2u* hd = (v2u*)(H + (size_t)r * D); unsigned* hd8 = (unsigned*)(H8 + (size_t)r * D);
#pragma unroll
                    for (int j = 0; j < 4; ++j) { const f32x4 sh = ((const f32x4*)mb)[F.lane + 64 * j], sc = ((const f32x4*)(mb + 1024))[F.lane + 64 * j]; const f32x4 hv = v[u][j] * rstd * gn[j] * (sc + 1.0f) + sh;
                        if (h8) { unsigned o = 0; o = __builtin_amdgcn_cvt_pk_fp8_f32(hv.x, hv.y, o, false); o = __builtin_amdgcn_cvt_pk_fp8_f32(hv.z, hv.w, o, true); hd8[F.lane + 64 * j] = o; }
                        else { v2u o; o.x = cvt_pk_bf16(hv.x, hv.y); o.y = cvt_pk_bf16(hv.z, hv.w); hd[F.lane + 64 * j] = o; } } }
            }
        }
    }
}

typedef float f32x16r __attribute__((ext_vector_type(16)));
__device__ __forceinline__ void router_phase(Frame& F, int layer, bool real = true, int xp = 0) {
    const bool last = layer == NLAYER - 1;
    const int ntiles = (last ? ML : MT) / 32;
    LAS float* PART = (LAS float*)F.lds;
    LAS float* SSQ = PART + 8 * 32 * 33;
    LAS float* LG = SSQ + 8 * 32;
    LAS float* RSTD = LG + 32 * 33;
    LAS unsigned* CW = (LAS unsigned*)(RSTD + 32);
    LAS unsigned* RUN = CW + 64;
    LAS float* AV = (LAS float*)(RUN + 32);
    LAS float* SHV = AV + 1024;
    LAS float* RCV = SHV + 1024;
    LAS bf16* STG = (LAS bf16*)((LAS unsigned char*)(RCV + 32) + F.wave * (32 * 272));
    const bf16* XB = (const bf16*)(F.ws + WS_XB);
    const float* MOD = (const float*)(F.ws + WS_MOD); const float* RC = (const float*)(F.ws + WS_RC);
    unsigned char* H8 = (unsigned char*)(F.ws + WS_H8);
    int* TE = (int*)(F.ws + WS_TE); int* TR = (int*)(F.ws + WS_TR); float* TG = (float*)(F.ws + WS_TG); int* ROWTOK = (int*)(F.ws + WS_ROWTOK);
    const float* gn = PIN(F, I_N2G) + layer * D; const float* rw = PIN(F, I_RW) + (size_t)layer * D * NE;
    const int i = F.lane & 31, hf = F.lane >> 5, lr = F.lane >> 4, lc = F.lane & 15, kw = F.wave * 128;
    const int per = 2048 / F.G;
    const int nmine = (2048 % F.G == 0) ? per + ((2048 + F.bx < ntiles) ? 1 : 0) : 0;
#define RT_TILE(n_) ((2048 % F.G == 0) ? ((n_) < per ? F.bx * per + (n_) : 2048 + F.bx) : F.bx + (n_) * F.G)
    const int ncnt = (2048 % F.G == 0) ? nmine : (F.bx < ntiles ? (ntiles - 1 - F.bx) / F.G + 1 : 0);
    __syncthreads();
    if (F.tid < NE) RUN[F.tid] = 0u;
    bf16x8 bw[8][2];
    v2u rawp[16];
#define RT_LOADX(tile_) do { const int rb_ = (tile_) * 32 + lr; const bf16* xb_ = XB + (size_t)rb_ * D + kw + 4 * lc; \
        _Pragma("unroll") for (int q = 0; q < 16; ++q) rawp[q] = *(const v2u*)(xb_ + (size_t)(4 * (q & 7)) * D + 64 * (q >> 3)); } while (0)
    if (ncnt > 0) RT_LOADX(RT_TILE(0));
    int cur_b = -1;
    for (int n = 0; n < ncnt; ++n) {
        const int tile = RT_TILE(n);
        const int r0 = tile * 32; const bool lat = r0 < ML; const int bidx = lat ? (r0 >> 13) : 8; const int r = r0 + i;
        if (bidx != cur_b) {
            cur_b = bidx; const float* mb = MOD + ((size_t)layer * 9 + bidx) * 6144 + 3 * 1024;
            __syncthreads();
            for (int k = F.tid; k < 1024; k += NTHREADS) { AV[k] = gn[k] * (1.0f + mb[1024 + k]); SHV[k] = mb[k]; }
            if (F.tid < NE) RCV[F.tid] = RC[((size_t)layer * 9 + bidx) * NE + F.tid];
            __syncthreads();
            { const v4u* src = (const v4u*)(F.ws + WS_RW3 + ((size_t)(layer * 9 + bidx) * 8 + F.wave) * 8 * 3 * 1024) + F.lane;
#pragma unroll
              for (int kb = 0; kb < 8; ++kb)
#pragma unroll
                  for (int t = 0; t < 2; ++t) bw[kb][t] = __builtin_bit_cast(bf16x8, src[(kb * 3 + t) * 64]); }
        }
        { float s8[8];
#pragma unroll
          for (int q = 0; q < 8; ++q) { const f32x4 a = bf4_f32(rawp[q]), b = bf4_f32(rawp[q + 8]); s8[q] = ((a.x * a.x + a.y * a.y) + (a.z * a.z + a.w * a.w)) + ((b.x * b.x + b.y * b.y) + (b.z * b.z + b.w * b.w)); }
#pragma unroll
          for (int q = 0; q < 8; ++q) { float v = s8[q]; v += shx(v, 1, F.lane); v += shx(v, 2, F.lane); v += shx(v, 4, F.lane); v += shx(v, 8, F.lane); if (lc == 0) SSQ[F.wave * 32 + 4 * q + lr] = v; } }
        __syncthreads();
        const f32x4 av0 = ((const LAS f32x4*)(AV + kw))[lc], av1 = ((const LAS f32x4*)(AV + kw))[lc + 16];
        { const f32x4 sh0 = ((const LAS f32x4*)(SHV + kw))[lc], sh1 = ((const LAS f32x4*)(SHV + kw))[lc + 16];
          unsigned char* hb = H8 + (size_t)(r0 + lr) * D + kw + 4 * lc;
#pragma unroll
          for (int q = 0; q < 8; ++q) { float qs = 0.f;
#pragma unroll
              for (int w = 0; w < 8; ++w) qs += SSQ[w * 32 + 4 * q + lr];
              const float rs = 1.0f / sqrtf(qs * (1.0f / D) + EPS);
#pragma unroll
              for (int hq = 0; hq < 2; ++hq) { const f32x4 h = bf4_f32(rawp[q + 8 * hq]) * (rs * (hq ? av1 : av0)) + (hq ? sh1 : sh0); unsigned w = 0;
                  w = __builtin_amdgcn_cvt_pk_fp8_f32(h.x, h.y, w, false); w = __builtin_amdgcn_cvt_pk_fp8_f32(h.z, h.w, w, true);
                  *(unsigned*)(hb + (size_t)(4 * q) * D + 64 * hq) = w; } } }
        f32x16r acc = {};
        asm volatile("s_waitcnt lgkmcnt(0)" ::: "memory");
#pragma unroll
        for (int q = 0; q < 16; ++q) *(LAS v2u*)(STG + (4 * (q & 7) + lr) * 136 + 4 * lc + 64 * (q >> 3)) = rawp[q];
        asm volatile("s_waitcnt lgkmcnt(0)" ::: "memory");
        if (n + 1 < ncnt) RT_LOADX(RT_TILE(n + 1));
#pragma unroll
        for (int kb = 0; kb < 8; ++kb) { const bf16x8 a = *(const LAS bf16x8*)(STG + i * 136 + 16 * kb + 8 * hf);
#pragma unroll
            for (int t = 0; t < 2; ++t) acc = __builtin_amdgcn_mfma_f32_32x32x16_bf16(a, bw[kb][t], acc, 0, 0, 0); }
#pragma unroll
        for (int rg = 0; rg < 16; ++rg) PART[(F.wave * 32 + ((rg & 3) + 8 * (rg >> 2) + 4 * hf)) * 33 + i] = acc[rg];
        __syncthreads();
        { const int tk = F.tid >> 4, e0 = (F.tid & 15) * 2; float q = 0.f, s0 = 0.f, s1 = 0.f;
#pragma unroll
          for (int w = 0; w < 8; ++w) { q += SSQ[w * 32 + tk]; s0 += PART[(w * 32 + tk) * 33 + e0]; s1 += PART[(w * 32 + tk) * 33 + e0 + 1]; }
          const float rstd = 1.0f / sqrtf(q * (1.0f / D) + EPS);
          LG[tk * 33 + e0] = rstd * s0 + RCV[e0]; LG[tk * 33 + e0 + 1] = rstd * s1 + RCV[e0 + 1]; }
        __syncthreads();
        { const int tk = F.tid >> 4, e0 = (F.tid & 15) * 2; const LAS float* lg = LG + tk * 33; const float l0 = lg[e0], l1 = lg[e0 + 1]; int rk0 = 0, rk1 = 0;
#pragma unroll 8
          for (int j = 0; j < NE; ++j) { const float o = lg[j]; rk0 += (o > l0 || (o == l0 && j < e0)) ? 1 : 0; rk1 += (o > l1 || (o == l1 && j < e0 + 1)) ? 1 : 0; }
          if (rk0 < 4) { F.MISC[MW_SELE + tk * 4 + rk0] = (unsigned)e0; F.MISC[MW_SELV + tk * 4 + rk0] = __float_as_uint(l0); }
          if (rk1 < 4) { F.MISC[MW_SELE + tk * 4 + rk1] = (unsigned)(e0 + 1); F.MISC[MW_SELV + tk * 4 + rk1] = __float_as_uint(l1); } }
        __syncthreads();
        int my = 0, lrk = 0;
        if (F.wave < 2) { const int a = F.tid; my = (int)F.MISC[MW_SELE + a];
            { const float vk = __uint_as_float(F.MISC[MW_SELV + a]), v0 = __uint_as_float(F.MISC[MW_SELV + (a & ~3)]);
              const float ex = __expf(vk - v0); float sm = ex; sm += shx(sm, 1, F.lane); sm += shx(sm, 2, F.lane);
              const size_t idx = ((size_t)r0 + (a >> 2)) * 4 + (a & 3); TG[idx] = ex / sm; TE[idx] = my; }
            unsigned cm = 0;
#pragma unroll 2
            for (int e = 0; e < NE; ++e) { const unsigned long long m = __ballot(my == e); const unsigned pc = (unsigned)__popcll(m);
                if (my == e) lrk = (int)__builtin_amdgcn_mbcnt_hi((unsigned)(m >> 32), __builtin_amdgcn_mbcnt_lo((unsigned)m, 0u)); if (F.lane == e) cm = pc; }
            if (F.lane < NE) CW[F.wave * 32 + F.lane] = cm; }
        __syncthreads();
        if (F.wave < 2) { const int a = F.tid; const int brank = (int)RUN[my] + lrk + (F.wave == 1 ? (int)CW[my] : 0); TR[((size_t)r0 + (a >> 2)) * 4 + (a & 3)] = brank; }
        __syncthreads();
        if (F.tid < NE) RUN[F.tid] += CW[F.tid] + CW[32 + F.tid];
    }
    VM_WAIT(); __syncthreads();
    if (F.tid < NE) { const unsigned cnt = RUN[F.tid]; unsigned base = 0;
        if (cnt) base = __hip_atomic_fetch_add(F.ctl + CW_CNT + (real ? layer : NLAYER) * NE + F.tid, cnt, RLX_AGENT);
        F.MISC[MW_LBASE + F.tid] = base; }
    __syncthreads();
    if (real) for (int n = 0; n < ncnt; ++n) { const int r0 = RT_TILE(n) * 32;
        if (F.tid < 128) { const size_t idx = ((size_t)r0 + (F.tid >> 2)) * 4 + (F.tid & 3); const int e = TE[idx]; const int rank = TR[idx] + (int)F.MISC[MW_LBASE + e]; TR[idx] = rank; ROWTOK[(size_t)e * MT + rank] = r0 + (F.tid >> 2); } }
    __syncthreads();
#undef RT_LOADX
#undef RT_TILE
}

__device__ __forceinline__ void normrope16(float (&x)[16], const float* gain, bool lat, int prow, int pcol, const LAS f32x2* T, int L, float oscale, int lane) {
    float ss = 0.f;
#pragma unroll
    for (int i = 0; i < 16; ++i) ss += x[i] * x[i];
    ss += shx(ss, 1, lane); ss += shx(ss, 2, lane); ss += shx(ss, 4, lane);
    const float rstd = 1.0f / sqrtf(ss * (1.0f / 128.0f) + EPS);
    const int o = (L & 7) * 16;
#pragma unroll
    for (int i = 0; i < 16; ++i) x[i] = x[i] * rstd * gain[o + i];
    float p[16];
#pragma unroll
    for (int i = 0; i < 16; ++i) p[i] = shx(x[i], 2, lane);
    if (lat) {
        const int pos = (L & 4) ? pcol : prow; const float sgn = (L & 2) ? 1.0f : -1.0f; const LAS f32x2* t = T + pos * 32 + (L & 1) * 16;
#pragma unroll
        for (int i = 0; i < 16; ++i) { const f32x2 cs = t[i]; x[i] = x[i] * cs.x + sgn * p[i] * cs.y; }
    }
#pragma unroll
    for (int i = 0; i < 16; ++i) x[i] *= oscale;
}
__device__ __forceinline__ void qkprep_phase(Frame& F, int j) {
    LAS f32x2* T = (LAS f32x2*)F.lds;
    __syncthreads();
    for (int i = F.tid; i < 128 * 32; i += NTHREADS) { const int pos = i >> 5, f = i & 31; const float inv = powf(10000.0f, -(float)f / 32.0f); const float ang = (float)pos * inv; float s, c; sincosf(ang, &s, &c); T[i] = (f32x2){c, s}; }
    __syncthreads();
    const bf16* P = (const bf16*)(F.ws + WS_P); unsigned char* Q8 = (unsigned char*)(F.ws + WS_QB); unsigned char* K8 = (unsigned char*)(F.ws + WS_QB + WS_K8_OFF); unsigned char* VT8 = (unsigned char*)(F.ws + WS_KVB);
    const float* qg = PIN(F, I_AQG) + j * 128; const float* kg = PIN(F, I_AKG) + j * 128;
    if (F.bx == 0 && F.tid == 0) { float qm = 0.f, km = 0.f; for (int i = 0; i < 128; ++i) { qm = fmaxf(qm, fabsf(qg[i])); km = fmaxf(km, fabsf(kg[i])); }
        const float sig = att::SCALE * 1.4426950408889634f * 11.3137085f * qm * km;
        ((float*)(F.ws + WS_RC))[2048 + j] = -fminf(-2.0f, 8.0f - 7.0f * sig); }
    const int gw = F.bx * NWAVES + F.wave, NGW = F.G * NWAVES, L = F.lane;
    v4u nqa, nqc, nka, nkc;
#define QK_LOAD(r_) do { const bf16* pr_ = P + (size_t)(r_) * 1536; nqa = *(const v4u*)(pr_ + 16 * L); nqc = *(const v4u*)(pr_ + 16 * L + 8); nka = *(const v4u*)(pr_ + 1024 + 16 * (L & 15)); nkc = *(const v4u*)(pr_ + 1024 + 16 * (L & 15) + 8); } while (0)
    if (gw < MT) QK_LOAD(gw);
    for (int r = gw; r < MT; r += NGW) {
        const v4u qa_ = nqa, qc_ = nqc, ka_ = nka, kc_ = nkc;
        if (r + NGW < MT) QK_LOAD(r + NGW);
        const bool lat = r < ML; const int b = lat ? (r >> 13) : ((r - ML) >> 8); const int s = lat ? (r & (SEQ - 1)) : ((r - ML) & (CL - 1));
        const int prow = s >> 6, pcol = s & 63; const size_t kvrow = (size_t)b * SKV + (lat ? s : SEQ + s);
        { const v4u a = qa_, c = qc_; float x[16];
          x[0] = bflo(a.x); x[1] = bfhi(a.x); x[2] = bflo(a.y); x[3] = bfhi(a.y); x[4] = bflo(a.z); x[5] = bfhi(a.z); x[6] = bflo(a.w); x[7] = bfhi(a.w);
          x[8] = bflo(c.x); x[9] = bfhi(c.x); x[10] = bflo(c.y); x[11] = bfhi(c.y); x[12] = bflo(c.z); x[13] = bfhi(c.z); x[14] = bflo(c.w); x[15] = bfhi(c.w);
          normrope16(x, qg, lat, prow, pcol, T, L, att::SCALE * 1.4426950408889634f * 8.0f, L);
          v4u o;
#pragma unroll
          for (int w4 = 0; w4 < 4; ++w4) { unsigned w = 0; w = __builtin_amdgcn_cvt_pk_fp8_f32(x[4 * w4], x[4 * w4 + 1], w, false); w = __builtin_amdgcn_cvt_pk_fp8_f32(x[4 * w4 + 2], x[4 * w4 + 3], w, true); o[w4] = w; }
          *(v4u*)(Q8 + (size_t)r * D + 16 * L) = o; }
        { const int Lk = L & 15; const v4u a = ka_, c = kc_; float x[16];
          x[0] = bflo(a.x); x[1] = bfhi(a.x); x[2] = bflo(a.y); x[3] = bfhi(a.y); x[4] = bflo(a.z); x[5] = bfhi(a.z); x[6] = bflo(a.w); x[7] = bfhi(a.w);
          x[8] = bflo(c.x); x[9] = bfhi(c.x); x[10] = bflo(c.y); x[11] = bfhi(c.y); x[12] = bflo(c.z); x[13] = bfhi(c.z); x[14] = bflo(c.w); x[15] = bfhi(c.w);
          normrope16(x, kg, lat, prow, pcol, T, Lk, 1.0f, L);
          if (L < 16) { v4u o;
#pragma unroll
            for (int w4 = 0; w4 < 4; ++w4) { unsigned w = 0; w = __builtin_amdgcn_cvt_pk_fp8_f32(x[4 * w4], x[4 * w4 + 1], w, false); w = __builtin_amdgcn_cvt_pk_fp8_f32(x[4 * w4 + 2], x[4 * w4 + 3], w, true); o[w4] = w; }
            *(v4u*)(K8 + kvrow * 256 + 16 * L) = o; }
        }
    }
#undef QK_LOAD
    LAS unsigned char* Tt = F.lds + 32768;
    for (int tile = F.bx; tile < NB * (SKV / 64); tile += F.G) {
        const int b = tile / (SKV / 64), kb = tile % (SKV / 64), ki = F.tid >> 3, seg = F.tid & 7, pos = kb * 64 + ki;
        const size_t r = pos < SEQ ? (size_t)b * SEQ + pos : (size_t)ML + (size_t)b * CL + (pos - SEQ);
        const int k5 = ki & 31, slot = 32 * ((k5 >> 2) & 1) + ((k5 & 3) | ((k5 >> 3) << 2)) + (ki >= 32 ? 16 : 0);
        const v4u* src = (const v4u*)(P + r * 1536 + 1280 + 32 * seg);
        __syncthreads();
#pragma unroll
        for (int q = 0; q < 4; ++q) { const v4u w = src[q]; const unsigned ww[4] = {w.x, w.y, w.z, w.w};
#pragma unroll
            for (int e2 = 0; e2 < 4; ++e2) { const unsigned pk = __builtin_amdgcn_cvt_pk_fp8_f32(bflo(ww[e2]), bfhi(ww[e2]), 0u, false); const int dd = 32 * seg + 8 * q + 2 * e2;
                Tt[dd * 64 + slot] = (unsigned char)(pk & 0xff); Tt[(dd + 1) * 64 + slot] = (unsigned char)((pk >> 8) & 0xff); } }
        __syncthreads();
        { const int rho = F.tid >> 1, half = F.tid & 1; const v4u a = *(const LAS v4u*)(Tt + rho * 64 + 32 * half), c = *(const LAS v4u*)(Tt + rho * 64 + 32 * half + 16);
          unsigned char* dst = VT8 + ((size_t)(b * 2 + (rho >> 7)) * 128 + (rho & 127)) * SKV + kb * 64 + 32 * half;
          *(v4u*)dst = a; *(v4u*)(dst + 16) = c; }
    }
    __syncthreads();
}
template <int XV = 0>
__device__ __forceinline__ void attention_phase(Frame& F, char* lds_generic, bool ctx_queries, int j) {
    const float nb = -((const float*)(F.ws + WS_RC))[2048 + j] - 8.0f;
    const unsigned char* Q8 = (const unsigned char*)(F.ws + WS_QB); const unsigned char* K8 = (const unsigned char*)(F.ws + WS_QB + WS_K8_OFF); const unsigned char* VT8 = (const unsigned char*)(F.ws + WS_KVB); bf16* Y = (bf16*)(F.ws + WS_Y);
    const int nunits = 2048 + (ctx_queries ? 64 : 0);
    for (int u = F.bx; u < nunits; u += F.G) {
        if (u < 2048) { const int b = u >> 8, w = u & 255, h = w & 7, qb = w >> 3; const size_t qo = ((size_t)b * SEQ + (size_t)qb * 256) * D + h * 128;
            att::attn_dense_body<XV>(Q8 + qo, K8 + (size_t)b * SKV * 256 + (h >> 2) * 128, VT8 + (size_t)(b * 2 + (h >> 2)) * 128 * SKV, SKV, Y + qo, SKV, lds_generic, F.wave, nb); }
        else { const int w = u - 2048, b = w >> 3, h = w & 7; const size_t qo = ((size_t)ML + (size_t)b * CL) * D + h * 128;
            att::attn_dense_body<XV>(Q8 + qo, K8 + ((size_t)b * SKV + SEQ) * 256 + (h >> 2) * 128, VT8 + (size_t)(b * 2 + (h >> 2)) * 128 * SKV + SEQ, SKV, Y + qo, CL, lds_generic, F.wave, nb); }
    }
}

__device__ __forceinline__ void gmlp_mix_phase(Frame& F) {
    constexpr int LDA = 136, LDO = 132;
    LAS bf16* As = (LAS bf16*)F.lds;
    LAS bf16* Vt = (LAS bf16*)(F.lds + 128 * LDA * 2);
    LAS float* rs = (LAS float*)(F.lds + 2 * 128 * LDA * 2);
    LAS float* Ot = (LAS float*)(F.lds + 2 * 128 * LDA * 2 + 512);
    const bf16* P = (const bf16*)(F.ws + WS_P); bf16* Y = (bf16*)(F.ws + WS_Y); const float* SS = (const float*)(F.ws + WS_SS);
    const float* ws = PIN(F, I_GWS); const float* bs = PIN(F, I_GBS); const float* vg = PIN(F, I_GVG);
    const int r32 = F.lane & 31, hi = F.lane >> 5;
    constexpr int NU = (MT / 128) * 8;
    struct GIn { f32x4 s; v4u v[4], uu[4]; } ga, gb; int gcur = -1;
#define GM_LOAD(u_, IN) do { const int g_ = (u_) & 7; const size_t row0_ = (size_t)((u_) >> 3) * 128; \
        IN.s = *(const f32x4*)(SS + (row0_ + (F.tid >> 2)) * 16 + (F.tid & 3) * 4);                                       \
        _Pragma("unroll") for (int k = 0; k < 4; ++k) { const int i_ = F.tid + NTHREADS * k, q_ = i_ >> 4, c8_ = (i_ & 15) * 8; const bf16* pp_ = P + (row0_ + q_) * 2048 + g_ * 128 + c8_; \
            IN.v[k] = *(const v4u*)(pp_ + 1024); IN.uu[k] = *(const v4u*)pp_; } } while (0)
#define GM_UNIT(u_, IN) do { \
        const int chunk = (u_) >> 3, g = (u_) & 7; const size_t row0 = (size_t)chunk * 128; \
        __syncthreads(); \
        if (g != gcur) { gcur = g; \
            for (int i = F.tid; i < 128 * 32; i += NTHREADS) { const int p = i >> 5, q4 = (i & 31) * 4; const f32x4 w = *(const f32x4*)(ws + ((size_t)g * 128 + p) * 128 + q4); \
                v2u o; o.x = pk2(w.x, w.y); o.y = pk2(w.z, w.w); *(LAS v2u*)(As + p * LDA + q4) = o; } } \
        { float s = (IN.s.x + IN.s.y) + (IN.s.z + IN.s.w); s += shx(s, 1, F.lane); s += shx(s, 2, F.lane); if ((F.tid & 3) == 0) rs[F.tid >> 2] = 1.0f / sqrtf(s * (1.0f / 1024.0f) + EPS); } \
        __syncthreads(); \
        _Pragma("unroll") for (int k = 0; k < 4; ++k) { const int i = F.tid + NTHREADS * k, q = i >> 4, c8 = (i & 15) * 8; const float rq = rs[q]; const unsigned ww[4] = {IN.v[k].x, IN.v[k].y, IN.v[k].z, IN.v[k].w}; \
            _Pragma("unroll") for (int e2 = 0; e2 < 4; ++e2) { const unsigned pk = cvt_pk_bf16(bflo(ww[e2]) * rq, bfhi(ww[e2]) * rq); Vt[(c8 + 2 * e2) * LDA + q] = (bf16)(pk & 0xffff); Vt[(c8 + 2 * e2 + 1) * LDA + q] = (bf16)(pk >> 16); } } \
        __syncthreads(); \
        const int p0 = (F.wave >> 1) * 32, cbase = (F.wave & 1) * 64; \
        f32x16 acc0 = {}, acc1 = {}; \
        _Pragma("unroll") for (int ks = 0; ks < 8; ++ks) { const int k0 = ks * 16 + hi * 8; \
            const bf16x8 a = *(const LAS bf16x8*)(As + (p0 + r32) * LDA + k0); \
            const bf16x8 b0 = *(const LAS bf16x8*)(Vt + (cbase + r32) * LDA + k0), b1 = *(const LAS bf16x8*)(Vt + (cbase + 32 + r32) * LDA + k0); \
            acc0 = __builtin_amdgcn_mfma_f32_32x32x16_bf16(a, b0, acc0, 0, 0, 0); acc1 = __builtin_amdgcn_mfma_f32_32x32x16_bf16(a, b1, acc1, 0, 0, 0); } \
        _Pragma("unroll") for (int t = 0; t < 2; ++t) { const int cl = cbase + t * 32 + r32; const float gain = vg[g * 128 + cl]; \
            _Pragma("unroll") for (int reg = 0; reg < 16; ++reg) { const int p = p0 + (reg & 3) + 8 * (reg >> 2) + 4 * hi; Ot[p * LDO + cl] = gain * (t == 0 ? acc0[reg] : acc1[reg]) + bs[g * 128 + p]; } } \
        __syncthreads(); \
        _Pragma("unroll") for (int k = 0; k < 4; ++k) { const int i = F.tid + NTHREADS * k, p = i >> 4, c8 = (i & 15) * 8; const v4u uw = IN.uu[k]; \
            const LAS float* o = Ot + p * LDO + c8; const f32x4 m0 = *(const LAS f32x4*)o, m1 = *(const LAS f32x4*)(o + 4); \
            v4u w; w.x = cvt_pk_bf16(bflo(uw.x) * m0.x, bfhi(uw.x) * m0.y); w.y = cvt_pk_bf16(bflo(uw.y) * m0.z, bfhi(uw.y) * m0.w); \
            w.z = cvt_pk_bf16(bflo(uw.z) * m1.x, bfhi(uw.z) * m1.y); w.w = cvt_pk_bf16(bflo(uw.w) * m1.z, bfhi(uw.w) * m1.w); \
            *(v4u*)(Y + (row0 + p) * D + g * 128 + c8) = w; } } while (0)
    int u = F.bx;
    if (u < NU) GM_LOAD(u, ga);
    for (; u < NU; u += 2 * F.G) {
        if (u + F.G < NU) GM_LOAD(u + F.G, gb);
        GM_UNIT(u, ga);
        if (u + F.G >= NU) break;
        if (u + 2 * F.G < NU) GM_LOAD(u + 2 * F.G, ga);
        GM_UNIT(u + F.G, gb);
    }
    __syncthreads();
#undef GM_LOAD
#undef GM_UNIT
}

__device__ __forceinline__ void hyena_prep_phase(Frame& F) {
    LAS float* tl = (LAS float*)F.lds;
    const bf16* P = (const bf16*)(F.ws + WS_P); bf16* X0 = (bf16*)(F.ws + WS_X0); bf16* VG = (bf16*)(F.ws + WS_VG);
    float* VT = (float*)(F.ws + WS_VT); float* VTC = (float*)(F.ws + WS_VTC);
    const float* cw = PIN(F, I_HCW); const float* cb = PIN(F, I_HCB);
    const int tt = F.tid >> 3, cg = F.tid & 7;
    constexpr int NU = (MT / 64) * 16;
    v4u pa[3][3], pb[3][3];
#define HP_LOAD(u_, IN) do { const int tb_ = (u_) >> 4, c0_ = ((u_) & 15) * 64, r0_ = tb_ * 64; const bool lat_ = r0_ < ML; \
        const int s_ = (lat_ ? (r0_ & (SEQ - 1)) : ((r0_ - ML) & (CL - 1))) + tt, L_ = lat_ ? SEQ : CL; const bf16* pr_ = P + (size_t)(r0_ + tt) * 3072 + c0_ + cg * 8; const v4u z0_ = {0u, 0u, 0u, 0u}; \
        _Pragma("unroll") for (int seg = 0; seg < 3; ++seg) { IN[seg][0] = s_ > 0 ? *(const v4u*)(pr_ + seg * 1024 - 3072) : z0_; IN[seg][1] = *(const v4u*)(pr_ + seg * 1024); \
            IN[seg][2] = s_ < L_ - 1 ? *(const v4u*)(pr_ + seg * 1024 + 3072) : z0_; } } while (0)
    LAS float* wl = tl + 64 * 65; int c0w = -1;
#define HP_UNIT(u_, IN) do { \
        const int tb = (u_) >> 4, c0 = ((u_) & 15) * 64; const int r0 = tb * 64; const bool lat = r0 < ML; \
        const int b = lat ? (r0 >> 13) : ((r0 - ML) >> 8), s0 = lat ? (r0 & (SEQ - 1)) : ((r0 - ML) & (CL - 1)); \
        const int r = r0 + tt, c = c0 + cg * 8; \
        if (c0 != c0w) { c0w = c0; __syncthreads(); \
            for (int i = F.tid; i < 768; i += NTHREADS) { const int seg = i >> 8, k = (i >> 6) & 3, ch = i & 63; wl[i] = k < 3 ? cw[k * 3072 + seg * 1024 + c0 + ch] : cb[seg * 1024 + c0 + ch]; } \
            __syncthreads(); } \
        float o[3][8]; \
        _Pragma("unroll") for (int seg = 0; seg < 3; ++seg) { \
            const unsigned pmw[4] = {IN[seg][0].x, IN[seg][0].y, IN[seg][0].z, IN[seg][0].w}, pcw[4] = {IN[seg][1].x, IN[seg][1].y, IN[seg][1].z, IN[seg][1].w}, pnw[4] = {IN[seg][2].x, IN[seg][2].y, IN[seg][2].z, IN[seg][2].w}; \
            _Pragma("unroll") for (int i = 0; i < 8; ++i) { const float xm = (i & 1) ? bfhi(pmw[i >> 1]) : bflo(pmw[i >> 1]), xc = (i & 1) ? bfhi(pcw[i >> 1]) : bflo(pcw[i >> 1]), xn = (i & 1) ? bfhi(pnw[i >> 1]) : bflo(pnw[i >> 1]); \
                const LAS float* wp = wl + seg * 256 + cg * 8 + i; o[seg][i] = xm * wp[0] + xc * wp[64] + xn * wp[128] + wp[192]; } } \
        float vgv[8]; \
        _Pragma("unroll") for (int i = 0; i < 8; ++i) vgv[i] = o[2][i] * o[1][i]; \
        v4u w; w.x = cvt_pk_bf16(o[0][0], o[0][1]); w.y = cvt_pk_bf16(o[0][2], o[0][3]); w.z = cvt_pk_bf16(o[0][4], o[0][5]); w.w = cvt_pk_bf16(o[0][6], o[0][7]); \
        *(v4u*)(X0 + (size_t)r * D + c) = w; \
        w.x = cvt_pk_bf16(vgv[0], vgv[1]); w.y = cvt_pk_bf16(vgv[2], vgv[3]); w.z = cvt_pk_bf16(vgv[4], vgv[5]); w.w = cvt_pk_bf16(vgv[6], vgv[7]); \
        *(v4u*)(VG + (size_t)r * D + c) = w; \
        __syncthreads(); \
        _Pragma("unroll") for (int i = 0; i < 8; ++i) tl[(cg * 8 + i) * 65 + tt] = vgv[i]; \
        __syncthreads(); \
        { const int cc = F.tid >> 3, ts = (F.tid & 7) * 8; float* dst = lat ? VT + ((size_t)b * 1024 + c0 + cc) * SEQ + s0 + ts : VTC + ((size_t)b * 1024 + c0 + cc) * CL + s0 + ts; \
          const LAS float* sp = tl + cc * 65 + ts; \
          *(f32x4*)dst = (f32x4){sp[0], sp[1], sp[2], sp[3]}; *(f32x4*)(dst + 4) = (f32x4){sp[4], sp[5], sp[6], sp[7]}; } } while (0)
    int u = F.bx;
    if (u < NU) HP_LOAD(u, pa);
    for (; u < NU; u += 2 * F.G) {
        if (u + F.G < NU) HP_LOAD(u + F.G, pb);
        HP_UNIT(u, pa);
        if (u + F.G >= NU) break;
        if (u + 2 * F.G < NU) HP_LOAD(u + 2 * F.G, pa);
        HP_UNIT(u + F.G, pb);
    }
    __syncthreads();
#undef HP_LOAD
#undef HP_UNIT
}
__device__ __forceinline__ void hyena_post_phase(Frame& F) {
    LAS float* tl = (LAS float*)F.lds;
    const bf16* X0 = (const bf16*)(F.ws + WS_X0); const bf16* VG = (const bf16*)(F.ws + WS_VG); bf16* Y = (bf16*)(F.ws + WS_Y);
    const float* VT = (const float*)(F.ws + WS_CT); const float* VTC = (const float*)(F.ws + WS_CTC); const float* dsk = PIN(F, I_HD);
    const int tt = F.tid >> 3, cg = F.tid & 7;
    constexpr int NU = (MT / 64) * 16;
    struct PIn { f32x4 a, bq; v4u x0, vv; } qa, qb;
#define HQ_LOAD(u_, IN) do { const int tb_ = (u_) >> 4, c0_ = ((u_) & 15) * 64, r0_ = tb_ * 64; const bool lat_ = r0_ < ML; \
        const int b_ = lat_ ? (r0_ >> 13) : ((r0_ - ML) >> 8), s0_ = lat_ ? (r0_ & (SEQ - 1)) : ((r0_ - ML) & (CL - 1)); const int cc_ = F.tid >> 3, ts_ = (F.tid & 7) * 8; \
        const float* src_ = lat_ ? VT + ((size_t)b_ * 1024 + c0_ + cc_) * SEQ + s0_ + ts_ : VTC + ((size_t)b_ * 1024 + c0_ + cc_) * CL + s0_ + ts_; \
        IN.a = *(const f32x4*)src_; IN.bq = *(const f32x4*)(src_ + 4); \
        IN.x0 = *(const v4u*)(X0 + (size_t)(r0_ + tt) * D + c0_ + cg * 8); IN.vv = *(const v4u*)(VG + (size_t)(r0_ + tt) * D + c0_ + cg * 8); } while (0)
#define HQ_UNIT(u_, IN) do { \
        const int tb = (u_) >> 4, c0 = ((u_) & 15) * 64; const int r0 = tb * 64; \
        __syncthreads(); \
        { const int cc = F.tid >> 3, ts = (F.tid & 7) * 8; LAS float* dp = tl + cc * 65 + ts; \
          dp[0] = IN.a.x; dp[1] = IN.a.y; dp[2] = IN.a.z; dp[3] = IN.a.w; dp[4] = IN.bq.x; dp[5] = IN.bq.y; dp[6] = IN.bq.z; dp[7] = IN.bq.w; } \
        __syncthreads(); \
        const int r = r0 + tt, c = c0 + cg * 8; \
        const f32x4 da = *(const f32x4*)(dsk + c), db = *(const f32x4*)(dsk + c + 4); \
        const unsigned x0w[4] = {IN.x0.x, IN.x0.y, IN.x0.z, IN.x0.w}, vw[4] = {IN.vv.x, IN.vv.y, IN.vv.z, IN.vv.w}; float y[8]; \
        _Pragma("unroll") for (int i = 0; i < 8; ++i) { const float xx = (i & 1) ? bfhi(x0w[i >> 1]) : bflo(x0w[i >> 1]), vx = (i & 1) ? bfhi(vw[i >> 1]) : bflo(vw[i >> 1]); const float di = i < 4 ? da[i & 3] : db[i & 3]; \
            y[i] = (tl[(cg * 8 + i) * 65 + tt] + vx * di) * xx; } \
        v4u w; w.x = cvt_pk_bf16(y[0], y[1]); w.y = cvt_pk_bf16(y[2], y[3]); w.z = cvt_pk_bf16(y[4], y[5]); w.w = cvt_pk_bf16(y[6], y[7]); \
        *(v4u*)(Y + (size_t)r * D + c) = w; } while (0)
    int u = F.bx;
    if (u < NU) HQ_LOAD(u, qa);
    for (; u < NU; u += 2 * F.G) {
        if (u + F.G < NU) HQ_LOAD(u + F.G, qb);
        HQ_UNIT(u, qa);
        if (u + F.G >= NU) break;
        if (u + 2 * F.G < NU) HQ_LOAD(u + 2 * F.G, qa);
        HQ_UNIT(u + F.G, qb);
    }
    __syncthreads();
#undef HQ_LOAD
#undef HQ_UNIT
}
__device__ __forceinline__ bool phase_nonempty(int ph) {
    if (ph < PH_L0 || ph >= PH_FINAL) return true;
    const int layer = (ph - PH_L0) / PH_PER_LAYER, lp = (ph - PH_L0) % PH_PER_LAYER, kind = layer % 3;
    if (lp == LP_MIX2) return kind != 1;
    if (lp == LP_MIX3) return kind == 2;
    return true;
}
__global__ void __launch_bounds__(NTHREADS, 2) mk_fwd(Args args) {
    extern __shared__ __attribute__((aligned(16))) unsigned char lds[];
    Frame F0;
    F0.lds = (LAS unsigned char*)lds; F0.MISC = (volatile LAS unsigned*)(F0.lds + MISC_OFF);
    F0.tid = threadIdx.x; F0.lane = F0.tid & 63; F0.wave = __builtin_amdgcn_readfirstlane(F0.tid >> 6);
    F0.G = gridDim.x; F0.bx = blockIdx.x; F0.out = args.out; F0.ws = args.ws; F0.ctl = (gu32*)(args.ws + WS_CTL);
    for (int u = F0.tid; u < MISC_BYTES / 4; u += NTHREADS) F0.MISC[u] = 0u;
    __syncthreads();
    if (F0.tid < 36) { const unsigned long long p = (unsigned long long)args.in[F0.tid]; F0.MISC[MW_PTRS + 2 * F0.tid] = (unsigned)p; F0.MISC[MW_PTRS + 2 * F0.tid + 1] = (unsigned)(p >> 32); }
    __syncthreads();
    const int lo = args.ph_lo, hi = args.ph_hi;
    const bool multi = (hi - lo) > 1;
    XcdBarrier bar; bar.bar = (unsigned*)(F0.ctl + CW_BAR); bar.x = 0; bar.st = nullptr; bar.w = F0.wave;
    if (multi) bar = xcd_barrier_post((unsigned*)(F0.ctl + CW_BAR), F0.MISC + 8, F0.wave);
#ifndef PHMASK
#define PHMASK 0xFFFF
#endif
#define EN(b) ((PHMASK >> (b)) & 1)
#ifndef MK_STAG_IN
#define MK_STAG_IN 0u
#define MK_STAG_OUT 0u
#define MK_STAG_M1 0u
#define MK_STAG_M2 0u
#endif
#ifndef KMASK
#define KMASK 7
#endif
#define KEN(b) ((KMASK >> (b)) & 1)
#define IN(k) (lo <= (k) && (k) < hi)
#define SEAM(k) do { if ((k) + 1 < hi) xcd_barrier(bar); } while (0)
#define PB(id) for (int _rep = 0, _n = ((id) == MK_REPEAT ? MK_NREP : 1); _rep < _n; ++_rep) {
#define PE(id) if (_rep + 1 < _n) xcd_barrier(bar); } SEAM(id);

    if (EN(0) && IN(PH_PRO0)) { PB(PH_PRO0) Frame F = phase_frame(F0); pro0_mod(F); __syncthreads(); pro0_transposes(F); pro0_filter_mlp(F); PE(PH_PRO0) }
    if (EN(1) && IN(PH_PRO1)) { PB(PH_PRO1) Frame F = phase_frame(F0); pro1_router_split(F); pro1_filters(F); PE(PH_PRO1) }

#pragma unroll 1
    for (int layer = 0; layer < NLAYER; ++layer) {
        const int kind = layer % 3, jj = layer / 3, pb = PH_L0 + layer * PH_PER_LAYER; const bool last = layer == NLAYER - 1;
        if (EN(2) && IN(pb + LP_NORM1)) { PB(pb + LP_NORM1) Frame F = phase_frame(F0); rowpass<0>(F, layer, _rep + 1 == _n, kind == 0); PE(pb + LP_NORM1) }
        if (EN(3) && IN(pb + LP_INPROJ)) { PB(pb + LP_INPROJ)
            Frame F = phase_frame(F0);
            if (kind == 0) {
                pg8::DenseSchedT<true> S; S.init(F.ws + WS_H8, F.ws + WS_WATT + (size_t)jj * 1536 * 1024, MT, 1536, F.G, F.bx, 1024);
                pg8::EpiBf16 E{(bf16*)(F.ws + WS_P), 1536, (float*)(F.ws + WS_SS), 0};
                pg8::gemm_phase<pg8::EpiBf16, pg8::DenseSchedT<true>, true, true>(F.lds, S, E, F.wave, false, MK_STAG_IN);
            } else {
                const int N = kind == 1 ? 2048 : 3072;
                pg8::DenseSched S; S.init(F.ws + WS_H, F.ws + (kind == 1 ? WS_WGM : WS_WHY), MT, N, F.G, F.bx);
                pg8::EpiBf16 E{(bf16*)(F.ws + WS_P), N, (float*)(F.ws + WS_SS), kind == 1 ? 1 : 0};
                pg8::gemm_phase<pg8::EpiBf16, pg8::DenseSched, false>(F.lds, S, E, F.wave, false, MK_STAG_IN);
            }
            PE(pb + LP_INPROJ)
        }
        if (IN(pb + LP_MIX1)) { PB(pb + LP_MIX1)
            Frame F = phase_frame(F0);
            if (EN(4) && kind == 0) qkprep_phase(F, jj); else if (EN(5) && kind == 1) gmlp_mix_phase(F); else if (EN(6)) hyena_prep_phase(F);
            PE(pb + LP_MIX1)
        }
        if (IN(pb + LP_MIX2) && kind != 1) { PB(pb + LP_MIX2)
            Frame F = phase_frame(F0);
            if (EN(7) && kind == 0) {
#if MK_XP >= 10 && MK_XP < 20
                if (_rep + 1 < _n) attention_phase<MK_XP - 10>(F, (char*)lds, !last, jj); else
#endif
                attention_phase<0>(F, (char*)lds, !last, jj); }
            else if (EN(8)) hyena_conv_phase(F);
            PE(pb + LP_MIX2)
        }
        if (EN(9) && IN(pb + LP_MIX3) && kind == 2) { PB(pb + LP_MIX3) Frame F = phase_frame(F0); hyena_post_phase(F); PE(pb + LP_MIX3) }
        if (EN(10) && IN(pb + LP_OUTPROJ)) { PB(pb + LP_OUTPROJ)
            Frame F = phase_frame(F0); const float* modl = (const float*)(F.ws + WS_MOD) + (size_t)layer * 9 * 6144;
            pg8::DenseSched S; S.init(F.ws + WS_Y, F.ws + WS_WOUT + (size_t)layer * 1024 * 1024 * 2, last ? ML : MT, 1024, F.G, F.bx);
            pg8::EpiResid E{(bf16*)(F.ws + WS_XB), modl};
            pg8::gemm_phase<pg8::EpiResid, pg8::DenseSched, false>(F.lds, S, E, F.wave, false, MK_STAG_OUT);
            PE(pb + LP_OUTPROJ)
        }
        if (EN(11) && IN(pb + LP_NORM2)) { PB(pb + LP_NORM2) Frame F = phase_frame(F0); router_phase(F, layer, _rep + 1 == _n, (_rep + 1 < _n) ? MK_XP : 0); PE(pb + LP_NORM2) }
        if (EN(12) && IN(pb + LP_MOE1)) { PB(pb + LP_MOE1)
            Frame F = phase_frame(F0);
            moe_tables(F, layer);
            pg8::MoeSched S{(const char*)(F.ws + WS_H8), (const char*)(F.ws + WS_WE1) + (size_t)layer * NE * 2048 * 1024, (size_t)2048 * 1024, (const int*)(F.ws + WS_ROWTOK),
                            (const volatile LAS int*)(F.MISC + MW_CUMBLK), (const volatile LAS int*)(F.MISC + MW_CNT), 3, F.G, F.bx, 1024, (const volatile LAS int*)(F.lds + AUX_OFF + 1024)};
            S.build_list((volatile LAS int*)(F.lds + AUX_OFF + 1024), F.tid); __syncthreads();
            pg8::EpiSwiglu E{(unsigned char*)(F.ws + WS_ACT), PIN(F, I_EB1) + (size_t)layer * NE * 2048, (LAS float*)(F.lds + AUX_OFF)};
#if MK_XP >= 20
            if (_rep + 1 < _n) { int one_ = 1; asm volatile("" : "+s"(one_)); pg8::gemm_phase<pg8::EpiSwiglu, pg8::MoeSched, true, true, MK_XP - 20>(F.lds, S, E, F.wave, one_ != 0, MK_STAG_M1); } else
#endif
            pg8::gemm_phase<pg8::EpiSwiglu, pg8::MoeSched, true, true>(F.lds, S, E, F.wave, MK_XP == 1 && _rep + 1 < _n, MK_STAG_M1);
            PE(pb + LP_MOE1)
        }
        if (EN(13) && IN(pb + LP_MOE2)) { PB(pb + LP_MOE2)
            Frame F = phase_frame(F0);
            moe_tables(F, layer);
            pg8::MoeSched S{(const char*)(F.ws + WS_ACT), (const char*)(F.ws + WS_WE2) + (size_t)layer * NE * 1024 * 1024, (size_t)1024 * 1024, nullptr,
                            (const volatile LAS int*)(F.MISC + MW_CUMBLK), (const volatile LAS int*)(F.MISC + MW_CNT), 2, F.G, F.bx, 1024, (const volatile LAS int*)(F.lds + AUX_OFF + 1024)};
            S.build_list((volatile LAS int*)(F.lds + AUX_OFF + 1024), F.tid); __syncthreads();
            pg8::EpiBias E{(unsigned char*)(F.ws + WS_YM), PIN(F, I_EB2) + (size_t)layer * NE * 1024, (LAS float*)(F.lds + AUX_OFF)};
            pg8::gemm_phase<pg8::EpiBias, pg8::MoeSched, true, true>(F.lds, S, E, F.wave, MK_XP == 1 && _rep + 1 < _n, MK_STAG_M2);
            PE(pb + LP_MOE2)
        }
    }
    if (EN(14) && IN(PH_FINAL)) { PB(PH_FINAL) Frame F = phase_frame(F0); rowpass<2>(F, NLAYER - 1, _rep + 1 == _n); PE(PH_FINAL) }
#undef IN
#undef SEAM
}

static bool host_phase_nonempty(int ph) {
    if (ph < PH_L0 || ph >= PH_FINAL) return true;
    const int layer = (ph - PH_L0) / PH_PER_LAYER, lp = (ph - PH_L0) % PH_PER_LAYER, kind = layer % 3;
    if (lp == LP_MIX2) return kind != 1;
    if (lp == LP_MIX3) return kind == 2;
    return true;
}
extern "C" void kernel_launch(void* const* d_in, const int* in_sizes, int n_in, void* d_out, int out_size, void* d_ws, size_t ws_size, hipStream_t stream) {
    static int grid = 0;
    if (grid == 0) {
        if (n_in != 36 || in_sizes[0] != ML * D || out_size != ML * D || ws_size < WS_END) {
            fprintf(stderr, "kernel_launch: built for 36 inputs, x/out of %d floats, >= %zu bytes of workspace; got n_in %d in0 %d out %d ws %zu; nothing launched\n", ML * D, (size_t)WS_END, n_in, n_in > 0 ? in_sizes[0] : -1, out_size, ws_size);
            grid = -1; return; }
        int dev = 0, cus = 0, per_cu = 0;
        if (hipGetDevice(&dev) != hipSuccess || hipDeviceGetAttribute(&cus, hipDeviceAttributeMultiprocessorCount, dev) != hipSuccess) { fprintf(stderr, "kernel_launch: device query failed\n"); grid = -1; return; }
        if (hipFuncSetAttribute((const void*)mk_fwd, hipFuncAttributeMaxDynamicSharedMemorySize, LDS_BYTES) != hipSuccess) { fprintf(stderr, "kernel_launch: hipFuncSetAttribute(%d B LDS) failed\n", LDS_BYTES); grid = -1; return; }
        if (hipOccupancyMaxActiveBlocksPerMultiprocessor(&per_cu, (const void*)mk_fwd, NTHREADS, LDS_BYTES) != hipSuccess || per_cu < 1)
            fprintf(stderr, "kernel_launch: note: occupancy query reports %d workgroups per CU\n", per_cu);
        (void)hipGetLastError();
        grid = cus;
    }
    if (grid < 0) return;
    if (hipMemsetAsync((char*)d_ws + WS_CTL, 0, CTL_ZERO_BYTES, stream) != hipSuccess) { fprintf(stderr, "kernel_launch: memset failed\n"); return; }
    Args a{};
    for (int i = 0; i < 36; ++i) a.in[i] = (const float*)d_in[i];
    a.out = (float*)d_out; a.ws = (unsigned char*)d_ws;
#if MK_MULTI || MK_DBG
    for (int ph = 0; ph < PH_COUNT; ++ph) {
        if (!host_phase_nonempty(ph)) continue;
        a.ph_lo = ph; a.ph_hi = ph + 1;
        hipLaunchKernelGGL(mk_fwd, dim3(grid), dim3(NTHREADS), LDS_BYTES, stream, a);
#if MK_DBG
        dbg_after_phase(ph, a, stream);
#endif
    }
#if MK_DBG
    dbg_report(a, stream);
#endif
#else
    a.ph_lo = 0; a.ph_hi = PH_COUNT;
    hipLaunchKernelGGL(mk_fwd, dim3(grid), dim3(NTHREADS), LDS_BYTES, stream, a);
#endif
    const hipError_t le = hipPeekAtLastError();
    if (le != hipSuccess) fprintf(stderr, "kernel_launch: launch failed: %s\n", hipGetErrorName(le));
}
```

```cpp
#include <hip/hip_runtime.h>
#include <cstdio>
#include <cstdint>
#include <cmath>

#ifndef MK_MULTI
#define MK_MULTI 0
#endif
#ifndef MK_REPEAT
#define MK_REPEAT -1
#endif
#ifndef MK_NREP
#define MK_NREP 1
#endif
#ifndef MK_XP
#define MK_XP 0
#endif
#ifndef MK_MOEMAP
#define MK_MOEMAP 0
#endif
#ifndef MK_DBG
#define MK_DBG 0
#endif

constexpr int D = 1024, NB = 8, SEQ = 8192, CL = 256, ML = NB * SEQ, MC = NB * CL, MT = ML + MC;
constexpr int NLAYER = 4, NE = 32, TOPK = 4, SKV = SEQ + CL;
constexpr int MOE_MAXBLK = (MT * TOPK) / 256 + NE;
constexpr float EPS = 1e-6f;
constexpr int FH = 64, FEMB = 33, NFFT = 16384;

constexpr size_t MiB = 1u << 20;
constexpr size_t WS_CTL = 0, CTL_ZERO_BYTES = 1 * MiB;
constexpr size_t WS_MOD = 1 * MiB;
constexpr size_t WS_A3 = 2 * MiB;
constexpr size_t WS_A3C = 4 * MiB;
constexpr size_t WS_RC = 4 * MiB + 512 * 1024;
constexpr size_t WS_FCT = 5 * MiB;
constexpr size_t WS_WATT = 8 * MiB;
constexpr size_t WS_WGM = 14 * MiB;
constexpr size_t WS_WHY = 18 * MiB;
constexpr size_t WS_WOUT = 24 * MiB;
constexpr size_t WS_RW3 = 32 * MiB;
constexpr size_t WS_TE = 40 * MiB;
constexpr size_t WS_TR = 42 * MiB;
constexpr size_t WS_TG = 44 * MiB;
constexpr size_t WS_SS = 46 * MiB;
constexpr size_t WS_ROWTOK = 52 * MiB;
constexpr size_t WS_KF = 64 * MiB;
constexpr size_t WS_WE1 = 192 * MiB;
constexpr size_t WS_WE2 = 704 * MiB;
constexpr size_t WS_H = 960 * MiB;
constexpr size_t WS_P = 1092 * MiB;
constexpr size_t WS_Y = 1488 * MiB;
constexpr size_t WS_QB = 1620 * MiB;
constexpr size_t WS_K8_OFF = 72 * MiB;
constexpr size_t WS_KVB = 1752 * MiB;
constexpr size_t WS_X0 = 1818 * MiB;
constexpr size_t WS_VG = 1950 * MiB;
constexpr size_t WS_VT = 2082 * MiB;
constexpr size_t WS_VTC = 2338 * MiB;
constexpr size_t WS_ACT = 2346 * MiB;
constexpr size_t WS_YM = 2890 * MiB;
constexpr size_t WS_CT = 3434 * MiB;
constexpr size_t WS_CTC = 3690 * MiB;
constexpr size_t WS_H8 = 3698 * MiB;
constexpr size_t WS_XB = 3764 * MiB;
constexpr size_t WS_END = 3896 * MiB;
constexpr int CW_BAR = 4096;
constexpr int CW_CNT = 16384;
constexpr int CW_DBG = 32768;

constexpr int RING_BYTES = 131072;
constexpr int AUX_OFF = RING_BYTES;
constexpr int AUX_BYTES = 16384;
constexpr int MISC_OFF = AUX_OFF + AUX_BYTES;
constexpr int MISC_BYTES = 4096;
constexpr int LDS_BYTES = MISC_OFF + MISC_BYTES;

#define GAS __attribute__((address_space(1)))
#define LAS __attribute__((address_space(3)))
typedef unsigned short bf16;
typedef unsigned v4u __attribute__((ext_vector_type(4)));
typedef unsigned v2u __attribute__((ext_vector_type(2)));
typedef float f32x4 __attribute__((ext_vector_type(4)));
typedef float f32x2 __attribute__((ext_vector_type(2)));
typedef float f32x16 __attribute__((ext_vector_type(16)));
typedef short bf16x8 __attribute__((ext_vector_type(8)));
typedef short s16x4 __attribute__((ext_vector_type(4)));
typedef int i32x4 __attribute__((ext_vector_type(4)));
typedef GAS unsigned gu32;
#define RLX_AGENT __ATOMIC_RELAXED, __HIP_MEMORY_SCOPE_AGENT
#define LDS_WAIT() asm volatile("s_waitcnt lgkmcnt(0)" ::: "memory")
#define VM_WAIT() asm volatile("s_waitcnt vmcnt(0)" ::: "memory")
__device__ __forceinline__ int opaque_tid(int wave) { int l; asm volatile("v_mbcnt_lo_u32_b32 %0, -1, 0\n\tv_mbcnt_hi_u32_b32 %0, -1, %0" : "=v"(l)); return (wave << 6) | l; }
__device__ __forceinline__ unsigned f2bf(float f) { unsigned u = __builtin_bit_cast(unsigned, f); return (u + 0x7fffu + ((u >> 16) & 1u)) >> 16; }
__device__ __forceinline__ unsigned pk2(float lo, float hi) { return f2bf(lo) | (f2bf(hi) << 16); }
__device__ __forceinline__ float bf2f(unsigned short b) { return __builtin_bit_cast(float, ((unsigned)b) << 16); }
__device__ __forceinline__ float bflo(unsigned w) { return __builtin_bit_cast(float, w << 16); }
__device__ __forceinline__ float bfhi(unsigned w) { return __builtin_bit_cast(float, w & 0xffff0000u); }
__device__ __forceinline__ f32x4 bf4_f32(v2u w) { return (f32x4){__uint_as_float(w.x << 16), __uint_as_float(w.x & 0xffff0000u), __uint_as_float(w.y << 16), __uint_as_float(w.y & 0xffff0000u)}; }
__device__ __forceinline__ unsigned cvt_pk_bf16(float lo, float hi) { unsigned r; asm volatile("v_cvt_pk_bf16_f32 %0, %1, %2" : "=v"(r) : "v"(lo), "v"(hi)); return r; }
__device__ __forceinline__ float shx(float v, int mask, int lane) { return __int_as_float(__builtin_amdgcn_ds_bpermute((lane ^ mask) << 2, __float_as_int(v))); }
__device__ __forceinline__ float wave_sum(float v, int lane) {
#pragma unroll
    for (int o = 1; o < 64; o <<= 1) v += shx(v, o, lane);
    return v;
}

#define XB_TMO      128
#define XB_XCNT(j)  (256  + 64 * (j))
#define XB_XSUB(j)  (1280 + 64 * (j))
#define XB_XGEN(j)  (2304 + 64 * (j))
#define XB_TOP      3328
#define XB_TOPGEN   3392
#define XCD_BAR_WORDS 3456
#define XB_SPIN_CAP (1u << 22)
__device__ __forceinline__ unsigned xb_ld(unsigned* p)              { return __hip_atomic_load(p, __ATOMIC_RELAXED, __HIP_MEMORY_SCOPE_AGENT); }
__device__ __forceinline__ unsigned xb_add(unsigned* p, unsigned v) { return __hip_atomic_fetch_add(p, v, __ATOMIC_RELAXED, __HIP_MEMORY_SCOPE_AGENT); }
__device__ __forceinline__ unsigned xb_xcc_id() { return (unsigned)__builtin_amdgcn_s_getreg((3 << 11) | 20) & 0xFu; }
#define XB_SPIN(cond, bar) do { unsigned _sp = 0; while (cond) { __builtin_amdgcn_s_sleep(1); \
    if ((++_sp & 255u) == 0u) { if (xb_ld(&(bar)[XB_TMO])) break; if (_sp > XB_SPIN_CAP) { atomicAdd(&(bar)[XB_TMO], 1u); break; } } } } while (0)
struct XcdBarrier { unsigned* bar; unsigned x; volatile LAS unsigned* st; int w; };
__device__ __forceinline__ bool xb_thread0(int w) { return opaque_tid(w) == 0; }
__device__ __forceinline__ XcdBarrier xcd_barrier_post(unsigned* bar, volatile LAS unsigned* st, int w) {
    XcdBarrier b; b.bar = bar; b.x = xb_xcc_id(); b.st = st; b.w = w;
    if (xb_thread0(w)) (void)xb_add(&bar[XB_XCNT(b.x)], 1u);
    return b;
}
__device__ __forceinline__ void xcd_barrier_complete(unsigned* bar, unsigned x, unsigned& nloc, unsigned& nx) {
    const unsigned G = gridDim.x * gridDim.y * gridDim.z;
    unsigned sum, cnt, mine, sp = 0u;
    for (;;) {
        sum = 0u; cnt = 0u; mine = 0u;
#pragma unroll
        for (unsigned j = 0; j < 16; ++j) { const unsigned c = xb_ld(&bar[XB_XCNT(j)]); sum += c; cnt += (c > 0u) ? 1u : 0u; mine = (j == x) ? c : mine; }
        if (sum == G) break;
        __builtin_amdgcn_s_sleep(1);
        if ((++sp & 255u) == 0u) { if (xb_ld(&bar[XB_TMO])) break; if (sp > XB_SPIN_CAP) { atomicAdd(&bar[XB_TMO], 1u); break; } }
    }
    nloc = mine > 0u ? mine : 1u; nx = cnt > 0u ? cnt : 1u;
}
__device__ __forceinline__ void xcd_barrier(const XcdBarrier& b) {
    asm volatile("s_waitcnt vmcnt(0)" ::: "memory");
    __syncthreads();
    if (xb_thread0(b.w)) {
        unsigned* bar = b.bar;
        __builtin_amdgcn_s_waitcnt(0);
        unsigned nloc = b.st[0], nx = b.st[1];
        if (nloc == 0u) { xcd_barrier_complete(bar, b.x, nloc, nx); b.st[0] = nloc; b.st[1] = nx; }
        const unsigned old = xb_add(&bar[XB_XSUB(b.x)], 1u);
        const unsigned gen = old / nloc;
        if (old + 1u == (gen + 1u) * nloc) {
            __builtin_amdgcn_fence(__ATOMIC_RELEASE, "agent");
            asm volatile("s_waitcnt vmcnt(0)" ::: "memory");
            const unsigned og = xb_add(&bar[XB_TOP], 1u);
            const unsigned tg = og / nx;
            if (og + 1u == (tg + 1u) * nx) xb_add(&bar[XB_TOPGEN], 1u);
            else XB_SPIN(xb_ld(&bar[XB_TOPGEN]) == tg, bar);
            __builtin_amdgcn_fence(__ATOMIC_ACQUIRE, "agent");
            xb_add(&bar[XB_XGEN(b.x)], 1u);
            asm volatile("s_waitcnt vmcnt(0)" ::: "memory");
        } else {
            XB_SPIN(xb_ld(&bar[XB_XGEN(b.x)]) == gen, bar);
            __builtin_amdgcn_fence(__ATOMIC_ACQUIRE, "agent");
            asm volatile("s_waitcnt vmcnt(0)" ::: "memory");
        }
    }
    __syncthreads();
}

namespace pg8 {
constexpr int BM = 256, BK = 64, HALF = 128, HTB = HALF * BK * 2, STAGE_BYTES = 8 * HTB, NXCD = 8, WGM = 8;
constexpr int GK = 1024;
__device__ __forceinline__ int lds_byte(int r, int c) { const int st = (r >> 4) * 2 + (c >> 5), rr = r & 15, cc = c & 31, ob = rr * 64 + cc * 2; return st * 1024 + (ob ^ (((ob >> 9) & 1) << 5)); }
__device__ __forceinline__ void stage_rc(int b, int& R, int& C) { const int st = b / 1024, sb = b % 1024, swz = sb ^ (((sb >> 9) & 1) << 5); R = (st >> 1) * 16 + swz / 64; C = (st & 1) * 32 + (swz % 64) / 2; }
__device__ __forceinline__ int perm32(int rho) { const int n = rho >> 4, i = rho & 15; return 8 * (i >> 2) + 4 * n + (i & 3); }
struct Unit { int pm, pn, e; };

template <bool IDG> struct DenseSchedT {
    const char* A; const char* Bt; int nM, nN, nwg, G, c, kb;
    __device__ __forceinline__ void init(const void* A_, const void* Bt_, int M, int N, int G_, int c_, int kb_ = GK * 2) { A = (const char*)A_; Bt = (const char*)Bt_; nM = M / BM; nN = N / BM; nwg = nM * nN; G = G_; c = c_; kb = kb_; }
    __device__ __forceinline__ bool next(int i, Unit& u) const {
        const long L = (long)i * G + c; if (L >= nwg) return false;
        int wgid = (int)L; { const int q = nwg / NXCD, r = nwg % NXCD, xcd = wgid % NXCD, off = wgid / NXCD; wgid = (xcd < r ? xcd * (q + 1) : r * (q + 1) + (xcd - r) * q) + off; }
        const int nig = WGM * nN, gid = wgid / nig, fm = gid * WGM, gsz = (nM - fm) < WGM ? (nM - fm) : WGM;
        u.pm = fm + ((wgid % nig) % gsz); u.pn = (wgid % nig) / gsz; u.e = 0; return true;
    }
    __device__ __forceinline__ const char* a_ptr(const Unit& u) const { return IDG ? A : A + (size_t)u.pm * (size_t)(BM * kb); }
    __device__ __forceinline__ const char* b_ptr(const Unit& u) const { return Bt + (size_t)u.pn * (size_t)(BM * kb); }
    __device__ __forceinline__ void a_offs(const Unit& u, const int (&R)[2], const int (&C)[2], unsigned (&voff)[2][2]) const {
#pragma unroll
        for (int h = 0; h < 2; ++h)
#pragma unroll
            for (int i = 0; i < 2; ++i) voff[h][i] = (unsigned)(u.pm * BM + h * HALF + R[i]) * (unsigned)kb + (unsigned)C[i] * 2u;
    }
    __device__ __forceinline__ void a_raw(const Unit&, const int (&)[2], int (&)[2][2]) const {}
    __device__ __forceinline__ void a_fin(const Unit& u, const int (&R)[2], const int (&C)[2], const int (&)[2][2], unsigned (&voff)[2][2]) const { a_offs(u, R, C, voff); }
};
typedef DenseSchedT<false> DenseSched;
struct MoeSched {
    const char* A; const char* Bt; size_t b_estride; const int* rowtok; const volatile LAS int* cumblk; const volatile LAS int* cnt; int ncol_log2, G, c, kb; const volatile LAS int* ulist;
    __device__ __forceinline__ bool next(int i, Unit& u) const {
        const int v = ulist[i & 63]; if (v < 0) return false;
        u.pm = v >> 8; u.e = (v >> 3) & 31; u.pn = v & 7; return true;
    }
    __device__ __forceinline__ void build_list(volatile LAS int* dst, int tid) const {
        if (tid < 64) { Unit u; dst[tid] = search(tid, u) ? ((u.pm << 8) | (u.e << 3) | u.pn) : -1; }
    }
    __device__ __forceinline__ bool search(int i, Unit& u) const {
        int gb, pn; const int ncol = 1 << ncol_log2;
        if (G == 256 && MK_MOEMAP == 0) { const int xcd = c & 7, j = c >> 3, rpb = 256 >> ncol_log2; gb = i * rpb + xcd + 8 * (j >> ncol_log2); pn = j & (ncol - 1); }
        else { const long L = (long)i * G + c; gb = (int)(L >> ncol_log2); pn = (int)(L & (ncol - 1)); }
        const int tot = cumblk[NE]; if (gb >= tot) return false;
        int e = 0;
#pragma unroll 1
        for (int s = 16; s >= 1; s >>= 1) { if (cumblk[e + s] <= gb) e += s; }
        u.pm = gb; u.pn = pn; u.e = e; return true;
    }
    __device__ __forceinline__ const char* a_ptr(const Unit&) const { return A; }
    __device__ __forceinline__ const char* b_ptr(const Unit& u) const { return Bt + (size_t)u.e * b_estride + (size_t)u.pn * (size_t)(BM * kb); }
    __device__ __forceinline__ void a_raw(const Unit& u, const int (&R)[2], int (&raw)[2][2]) const {
        if (!rowtok) return;
        const int rb = u.pm - cumblk[u.e]; const int* rt = rowtok + (size_t)u.e * MT;
#pragma unroll
        for (int h = 0; h < 2; ++h)
#pragma unroll
            for (int i = 0; i < 2; ++i) { const int* ptr = rt + (rb * 256 + h * HALF + R[i]);
                asm volatile("global_load_dword %0, %1, off" : "=v"(raw[h][i]) : "v"(ptr) : "memory"); }
    }
    __device__ __forceinline__ void a_fin(const Unit& u, const int (&R)[2], const int (&C)[2], const int (&raw_)[2][2], unsigned (&voff)[2][2]) const {
        int raw[2][2] = {{raw_[0][0], raw_[0][1]}, {raw_[1][0], raw_[1][1]}};
        asm volatile("" : "+v"(raw[0][0]), "+v"(raw[0][1]), "+v"(raw[1][0]), "+v"(raw[1][1]));
        const int rb = u.pm - cumblk[u.e], n = cnt[u.e];
#pragma unroll
        for (int h = 0; h < 2; ++h)
#pragma unroll
            for (int i = 0; i < 2; ++i) { const int rank = rb * 256 + h * HALF + R[i]; const int tok = rowtok ? (rank < n ? raw[h][i] : 0) : u.pm * BM + h * HALF + R[i];
                voff[h][i] = (unsigned)tok * (unsigned)kb + (unsigned)C[i] * 2u; }
    }
    __device__ __forceinline__ void a_offs(const Unit& u, const int (&R)[2], const int (&C)[2], unsigned (&voff)[2][2]) const { int raw[2][2] = {{0, 0}, {0, 0}}; a_raw(u, R, raw); asm volatile("s_waitcnt vmcnt(0)" : "+v"(raw[0][0]), "+v"(raw[0][1]), "+v"(raw[1][0]), "+v"(raw[1][1]) :: "memory"); a_fin(u, R, C, raw, voff); }
};

typedef int v8i __attribute__((ext_vector_type(8)));
__device__ __forceinline__ v8i cat8(bf16x8 lo, bf16x8 hi) { const v4u a = __builtin_bit_cast(v4u, lo), b = __builtin_bit_cast(v4u, hi); return (v8i){(int)a.x, (int)a.y, (int)a.z, (int)a.w, (int)b.x, (int)b.y, (int)b.z, (int)b.w}; }
template <class Epi, class Sched, bool GATHER, bool FP8 = false, int XG = 0>
__device__ __forceinline__ void gemm_phase(LAS unsigned char* lds, const Sched& S, const Epi& E, int wave_id, bool skip_epi = false, unsigned stagger_ticks = 0u) {
    if (stagger_ticks && ((blockIdx.x >> 3) & 1u)) { const unsigned long long t0 = __builtin_amdgcn_s_memrealtime(); while (__builtin_amdgcn_s_memrealtime() - t0 < (unsigned long long)stagger_ticks) __builtin_amdgcn_s_sleep(8); }
    const int tid = opaque_tid(wave_id), wid = __builtin_amdgcn_readfirstlane(tid >> 6), lane = tid & 63, wr = wid >> 2, wc = wid & 3, fr = lane & 15, fq = lane >> 4;
    constexpr int KB = FP8 ? GK : GK * 2, nt = KB / (BK * 2);
    unsigned voffA[2][2], voffB[2]; int Rr[2], Cc[2];
#pragma unroll
    for (int i = 0; i < 2; ++i) { int R, C; stage_rc(tid * 16 + i * 8192, R, C); Rr[i] = R; Cc[i] = C; const int Rb = Epi::PERM ? ((R & ~31) + perm32(R & 31)) : R;
        voffA[0][i] = (unsigned)(R * KB + C * 2); voffA[1][i] = (unsigned)((R + HALF) * KB + C * 2); voffB[i] = (unsigned)(Rb * KB + C * 2); }
    constexpr size_t kstep = (size_t)(BK * 2);
    constexpr size_t hstep = (size_t)HALF * KB;
    const unsigned ldsw = (unsigned)wid * 1024u;
    const int aoff = lds_byte(wr * 64 + fr, fq * 8), boff = lds_byte(wc * 32 + fr, fq * 8);
    LAS unsigned char* abase = lds + aoff; LAS unsigned char* bbase = lds + 4 * HTB + boff; asm volatile("" : "+v"(abase), "+v"(bbase));
#define PG8_SA(b, h) (((b) * 2 + (h)) * HTB)
#define PG8_SB(b, h) ((4 + (b) * 2 + (h)) * HTB)
#define PG8_STAGE(bufoff, gbase, voff) do { if (XG == 3) break; _Pragma("unroll") for (int _i = 0; _i < 2; ++_i) \
        __builtin_amdgcn_global_load_lds((const unsigned*)((const char*)(gbase) + (voff)[_i]), (LAS unsigned*)(lds + (bufoff) + ldsw + _i * 8192), 16, 0, 0); } while (0)
#define PG8_STAGE_A(bufoff, gbase, h) PG8_STAGE(bufoff, gbase, voffA[h])
#define PG8_RDA(off) (*(const LAS v4u*)(abase + (off)))
#define PG8_RDB(off) (*(const LAS v4u*)(bbase + (off)))
#define PG8_LDA(dst, b, h) do { if (XG == 2) break; _Pragma("unroll") for (int m = 0; m < 4; ++m) { const v4u _l = PG8_RDA(PG8_SA(b, h) + m * 2048), _h = PG8_RDA(PG8_SA(b, h) + m * 2048 + 1024); \
        if constexpr (FP8) dst##8[m] = (v8i){(int)_l.x, (int)_l.y, (int)_l.z, (int)_l.w, (int)_h.x, (int)_h.y, (int)_h.z, (int)_h.w}; \
        else { dst[m][0] = __builtin_bit_cast(bf16x8, _l); dst[m][1] = __builtin_bit_cast(bf16x8, _h); } } } while (0)
#define PG8_LDB(dst, b, h) do { if (XG == 2) break; _Pragma("unroll") for (int n = 0; n < 2; ++n) { const v4u _l = PG8_RDB(PG8_SA(b, h) + n * 2048), _h = PG8_RDB(PG8_SA(b, h) + n * 2048 + 1024); \
        if constexpr (FP8) dst##8[n] = (v8i){(int)_l.x, (int)_l.y, (int)_l.z, (int)_l.w, (int)_h.x, (int)_h.y, (int)_h.z, (int)_h.w}; \
        else { dst[n][0] = __builtin_bit_cast(bf16x8, _l); dst[n][1] = __builtin_bit_cast(bf16x8, _h); } } } while (0)
#define PG8_MMA(ai, bj, At, Bt) do { if (XG == 1) break; __builtin_amdgcn_s_setprio(1); _Pragma("unroll") for (int m = 0; m < 4; ++m) _Pragma("unroll") for (int n = 0; n < 2; ++n) { \
        if constexpr (FP8) acc[ai][bj][m][n] = __builtin_amdgcn_mfma_scale_f32_16x16x128_f8f6f4(Bt##8[n], At##8[m], acc[ai][bj][m][n], 0, 0, 0, 0x7A7A7A7A, 0, 0x7F7F7F7F); \
        else { _Pragma("unroll") for (int k = 0; k < 2; ++k) acc[ai][bj][m][n] = __builtin_amdgcn_mfma_f32_16x16x32_bf16(Bt[n][k], At[m][k], acc[ai][bj][m][n], 0, 0, 0); } } \
        __builtin_amdgcn_s_setprio(0); } while (0)
#define PG8_WAIT_V(n) asm volatile("s_waitcnt vmcnt(" #n ")" ::: "memory")
#define PG8_WAIT_L(n) asm volatile("s_waitcnt lgkmcnt(" #n ")" ::: "memory")
#define PG8_BAR __builtin_amdgcn_s_barrier()
#define PG8_SCHED __builtin_amdgcn_sched_barrier(0)
    Unit cur, nxt; int ui = 0;
    if (!S.next(0, cur)) return;
    f32x4 acc[2][2][4][2];
#pragma unroll
    for (int a = 0; a < 2; ++a)
#pragma unroll
        for (int b = 0; b < 2; ++b)
#pragma unroll
            for (int m = 0; m < 4; ++m)
#pragma unroll
                for (int n = 0; n < 2; ++n) acc[a][b][m][n] = (f32x4){0.f, 0.f, 0.f, 0.f};
    bf16x8 At[4][2], B0[2][2], B1[2][2]; v8i At8[4], B08[2], B18[2];
    if constexpr (XG == 2) { _Pragma("unroll") for (int m = 0; m < 4; ++m) { asm volatile("" : "=v"(At8[m])); } _Pragma("unroll") for (int n = 0; n < 2; ++n) { asm volatile("" : "=v"(B08[n])); asm volatile("" : "=v"(B18[n])); } }
    const char* cA = S.a_ptr(cur); const char* cB = S.b_ptr(cur);
    if constexpr (GATHER) S.a_offs(cur, Rr, Cc, voffA);
    PG8_STAGE(PG8_SB(0, 0), cB, voffB); PG8_STAGE(PG8_SB(0, 1), cB + hstep, voffB); PG8_STAGE_A(PG8_SA(0, 0), cA, 0); PG8_STAGE_A(PG8_SA(0, 1), cA, 1);
    if (wr == 1) PG8_BAR;
    PG8_WAIT_V(2); PG8_BAR;
    PG8_STAGE(PG8_SB(1, 0), cB + kstep, voffB); PG8_STAGE_A(PG8_SA(1, 0), cA + kstep, 0); PG8_STAGE(PG8_SB(1, 1), cB + hstep + kstep, voffB);
    PG8_WAIT_V(6); PG8_BAR;
    for (;;) {
        const bool has_next = S.next(ui + 1, nxt);
        const char* nA = has_next ? S.a_ptr(nxt) : cA; const char* nB = has_next ? S.b_ptr(nxt) : cB;
        int rawN[2][2] = {{0, 0}, {0, 0}};
        if constexpr (GATHER) { if (has_next) S.a_raw(nxt, Rr, rawN); }
#pragma unroll 1
        for (int t = 0; t < nt; t += 2) {
            const bool last = (t == nt - 2);
            if constexpr (Epi::LDSBIAS) { if (last && wid == 0) E.stage_bias(cur, lane); }
            const char* a1 = cA + (size_t)(t + 1) * kstep;
            const char* a2 = last ? nA : cA + (size_t)(t + 2) * kstep; const char* b2 = last ? nB : cB + (size_t)(t + 2) * kstep;
            const char* a3 = a2 + kstep; const char* b3 = b2 + kstep;
            PG8_LDB(B0, 0, 0); PG8_LDB(B1, 0, 1); PG8_SCHED; PG8_LDA(At, 0, 0); PG8_STAGE_A(PG8_SA(1, 1), a1, 1);
            if constexpr (GATHER) { if (last && has_next) S.a_fin(nxt, Rr, Cc, rawN, voffA); }
            PG8_WAIT_V(8); PG8_WAIT_L(0); PG8_BAR; PG8_MMA(0, 0, At, B0); PG8_MMA(0, 1, At, B1); PG8_BAR; PG8_SCHED;
            PG8_LDA(At, 0, 1); PG8_STAGE(PG8_SB(0, 0), b2, voffB); PG8_STAGE(PG8_SB(0, 1), b2 + hstep, voffB); PG8_STAGE_A(PG8_SA(0, 0), a2, 0);
            PG8_WAIT_V(8); PG8_WAIT_L(0); PG8_BAR; PG8_MMA(1, 0, At, B0); PG8_MMA(1, 1, At, B1); PG8_BAR; PG8_SCHED;
            PG8_LDB(B0, 1, 0); PG8_LDB(B1, 1, 1); PG8_SCHED; PG8_LDA(At, 1, 0); PG8_STAGE_A(PG8_SA(0, 1), a2, 1);
            PG8_WAIT_V(8); PG8_WAIT_L(0); PG8_BAR; PG8_MMA(0, 0, At, B0); PG8_MMA(0, 1, At, B1); PG8_BAR; PG8_SCHED;
            PG8_LDA(At, 1, 1); PG8_STAGE(PG8_SB(1, 0), b3, voffB); PG8_STAGE(PG8_SB(1, 1), b3 + hstep, voffB); PG8_STAGE_A(PG8_SA(1, 0), a3, 0);
            PG8_WAIT_V(8); PG8_WAIT_L(0); PG8_BAR; PG8_MMA(1, 0, At, B0); PG8_MMA(1, 1, At, B1); PG8_BAR; PG8_SCHED;
        }
        if (wr == 0) PG8_BAR;
        if (!skip_epi) E(acc, cur, wr, wc, fr, fq);
        if (!has_next) break;
#pragma unroll
        for (int a = 0; a < 2; ++a)
#pragma unroll
            for (int b = 0; b < 2; ++b)
#pragma unroll
                for (int m = 0; m < 4; ++m)
#pragma unroll
                    for (int n = 0; n < 2; ++n) acc[a][b][m][n] = (f32x4){0.f, 0.f, 0.f, 0.f};
        cur = nxt; cA = nA; cB = nB; ++ui;
        if (wr == 1) PG8_BAR;
    }
    PG8_WAIT_V(0);
    PG8_BAR;
#undef PG8_SA
#undef PG8_SB
#undef PG8_STAGE
#undef PG8_STAGE_A
#undef PG8_LDA
#undef PG8_RDA
#undef PG8_RDB
#undef PG8_LDB
#undef PG8_MMA
#undef PG8_WAIT_V
#undef PG8_WAIT_L
#undef PG8_BAR
#undef PG8_SCHED
}
}
namespace pg8 {
__device__ __forceinline__ f32x2 gelu_pk(f32x2 v) {
    const f32x2 av = __builtin_elementwise_abs(v), d = av * 0.2316418882f + 1.0f;
    f32x2 t; t.x = __builtin_amdgcn_rcpf(d.x); t.y = __builtin_amdgcn_rcpf(d.y);
    f32x2 q = t * 0.5307027145f + (-0.7265760135f); q = q * t + 0.7107068705f; q = q * t + (-0.142248368f); q = q * t + 0.127414796f; q = q * t;
    const f32x2 s = (v * v) * (-0.72134752044f);
    f32x2 e; e.x = __builtin_amdgcn_exp2f(s.x); e.y = __builtin_amdgcn_exp2f(s.y);
    const f32x2 m = v * (q * e), r = v - m;
    f32x2 o; o.x = v.x < 0.f ? m.x : r.x; o.y = v.y < 0.f ? m.y : r.y; return o;
}
struct EpiBf16 {
    static constexpr bool PERM = true, LDSBIAS = false;
    bf16* O; int ldc; float* ss; int ACT;
    __device__ __forceinline__ void operator()(const f32x4 (&acc)[2][2][4][2], const Unit& u, int wr, int wc, int fr, int fq) const {
        const int row0 = u.pm * BM + wr * 64 + fr, col0 = u.pn * BM + wc * 32 + 8 * fq;
#pragma unroll
        for (int ai = 0; ai < 2; ++ai)
#pragma unroll
            for (int m = 0; m < 4; ++m) { const int row = row0 + ai * HALF + m * 16; bf16* rowp = O + (size_t)row * ldc + col0; float sq = 0.f;
#pragma unroll
                for (int bj = 0; bj < 2; ++bj) { f32x4 v0 = acc[ai][bj][m][0], v1 = acc[ai][bj][m][1];
                    if (ACT == 1) { f32x2 a = gelu_pk((f32x2){v0[0], v0[1]}), b = gelu_pk((f32x2){v0[2], v0[3]}), c = gelu_pk((f32x2){v1[0], v1[1]}), d = gelu_pk((f32x2){v1[2], v1[3]});
                        v0 = (f32x4){a.x, a.y, b.x, b.y}; v1 = (f32x4){c.x, c.y, d.x, d.y};
                        sq += (v0[0] * v0[0] + v0[1] * v0[1]) + (v0[2] * v0[2] + v0[3] * v0[3]) + (v1[0] * v1[0] + v1[1] * v1[1]) + (v1[2] * v1[2] + v1[3] * v1[3]); }
                    v4u w; w.x = cvt_pk_bf16(v0[0], v0[1]); w.y = cvt_pk_bf16(v0[2], v0[3]); w.z = cvt_pk_bf16(v1[0], v1[1]); w.w = cvt_pk_bf16(v1[2], v1[3]);
                    *(v4u*)(rowp + bj * HALF) = w; }
                if (ACT == 1) { const int ln = (fq << 4) | fr; sq += shx(sq, 16, ln); sq += shx(sq, 32, ln);
                    if (u.pn >= 4 && fq == 0) ss[(size_t)row * 16 + (u.pn - 4) * 4 + wc] = sq; }
            }
    }
};
struct EpiResid {
    static constexpr bool PERM = false, LDSBIAS = false;
    bf16* xb; const float* modl;
    __device__ __forceinline__ void operator()(const f32x4 (&acc)[2][2][4][2], const Unit& u, int wr, int wc, int fr, int fq) const {
        const bool lat = u.pm < ML / BM; const int bidx = lat ? (u.pm >> 5) : 8;
        bf16* base = xb + (size_t)u.pm * BM * D;
        const float* g = modl + bidx * 6144 + 2 * 1024;
        const int r0 = wr * 64 + fr, col0 = u.pn * BM + wc * 32 + 4 * fq;
        f32x4 gv[2][2];
#pragma unroll
        for (int bj = 0; bj < 2; ++bj)
#pragma unroll
            for (int n = 0; n < 2; ++n) gv[bj][n] = *(const f32x4*)(g + col0 + bj * HALF + n * 16);
        const int odd = fq & 1, colp = col0 - 4 * odd;
#pragma unroll
        for (int ai = 0; ai < 2; ++ai) { v4u bs[2][2][2];
#pragma unroll
            for (int mp = 0; mp < 2; ++mp) { const size_t off = (size_t)(r0 + ai * HALF + (2 * mp + odd) * 16) * D + colp;
#pragma unroll
                for (int bj = 0; bj < 2; ++bj)
#pragma unroll
                    for (int n = 0; n < 2; ++n) bs[mp][bj][n] = *(const v4u*)(base + off + bj * HALF + n * 16); }
#pragma unroll
            for (int mp = 0; mp < 2; ++mp) { const size_t off = (size_t)(r0 + ai * HALF + (2 * mp + odd) * 16) * D + colp;
#pragma unroll
                for (int bj = 0; bj < 2; ++bj)
#pragma unroll
                    for (int n = 0; n < 2; ++n) { const v4u L = bs[mp][bj][n];
                        const auto s0 = __builtin_amdgcn_permlane16_swap(L.x, L.z, false, false), s1 = __builtin_amdgcn_permlane16_swap(L.y, L.w, false, false);
                        const f32x4 va = bf4_f32((v2u){s0[0], s1[0]}) + gv[bj][n] * acc[ai][bj][2 * mp][n], vb = bf4_f32((v2u){s0[1], s1[1]}) + gv[bj][n] * acc[ai][bj][2 * mp + 1][n];
                        const auto t0 = __builtin_amdgcn_permlane16_swap(cvt_pk_bf16(va.x, va.y), cvt_pk_bf16(vb.x, vb.y), false, false), t1 = __builtin_amdgcn_permlane16_swap(cvt_pk_bf16(va.z, va.w), cvt_pk_bf16(vb.z, vb.w), false, false);
                        *(v4u*)(base + off + bj * HALF + n * 16) = (v4u){t0[0], t1[0], t0[1], t1[1]}; } }
            asm volatile("" ::: "memory"); }
    }
};
struct EpiSwiglu {
    static constexpr bool PERM = true, LDSBIAS = true;
    unsigned char* O; const float* b1; LAS float* bl;
    __device__ __forceinline__ void stage_bias(const Unit& u, int lane) const { const float* src = b1 + (size_t)u.e * 2048 + (lane < 32 ? u.pn * HALF + 4 * lane : 1024 + u.pn * HALF + 4 * (lane - 32));
        __builtin_amdgcn_global_load_lds((const unsigned*)src, (LAS unsigned*)bl, 16, 0, 0); }
    __device__ __forceinline__ void operator()(const f32x4 (&acc)[2][2][4][2], const Unit& u, int wr, int wc, int fr, int fq) const {
        const int row0 = u.pm * BM + wr * 64 + fr, cl = wc * 32 + 8 * fq, c0 = u.pn * HALF + cl;
        f32x4 bg[2], bli[2];
#pragma unroll
        for (int n = 0; n < 2; ++n) { bg[n] = *(const LAS f32x4*)(bl + cl + 4 * n); bli[n] = *(const LAS f32x4*)(bl + 128 + cl + 4 * n) + 1.0f; }
#pragma unroll
        for (int ai = 0; ai < 2; ++ai)
#pragma unroll
            for (int mp = 0; mp < 4; mp += 2) { v2u wv[2];
#pragma unroll
              for (int mm = 0; mm < 2; ++mm) { const int m = mp + mm; float o[8];
#pragma unroll
                for (int n = 0; n < 2; ++n)
#pragma unroll
                    for (int j = 0; j < 4; ++j) { const float gl = fminf(acc[ai][0][m][n][j] + bg[n][j], 7.0f), lp = __builtin_amdgcn_fmed3f(acc[ai][1][m][n][j] + bli[n][j], -6.0f, 8.0f);
                        const float sg = __builtin_amdgcn_rcpf(1.0f + __builtin_amdgcn_exp2f(gl * (-1.702f * 1.4426950408889634f)));
                        o[n * 4 + j] = gl * sg * lp; }
                v2u w; w.x = 0; w.y = 0;
                w.x = __builtin_amdgcn_cvt_pk_fp8_f32(o[0], o[1], w.x, false); w.x = __builtin_amdgcn_cvt_pk_fp8_f32(o[2], o[3], w.x, true);
                w.y = __builtin_amdgcn_cvt_pk_fp8_f32(o[4], o[5], w.y, false); w.y = __builtin_amdgcn_cvt_pk_fp8_f32(o[6], o[7], w.y, true);
                wv[mm] = w; }
              const auto sx = __builtin_amdgcn_permlane16_swap(wv[0].x, wv[1].x, false, false), sy = __builtin_amdgcn_permlane16_swap(wv[0].y, wv[1].y, false, false);
              *(v4u*)(O + (size_t)(row0 + ai * HALF + (mp + (fq & 1)) * 16) * D + (c0 - 8 * (fq & 1))) = (v4u){sx[0], sy[0], sx[1], sy[1]}; }
    }
};
struct EpiBias {
    static constexpr bool PERM = true, LDSBIAS = true;
    unsigned char* O; const float* b2; LAS float* bl;
    __device__ __forceinline__ void stage_bias(const Unit& u, int lane) const { __builtin_amdgcn_global_load_lds((const unsigned*)(b2 + (size_t)u.e * 1024 + u.pn * BM + 4 * lane), (LAS unsigned*)bl, 16, 0, 0); }
    __device__ __forceinline__ void operator()(const f32x4 (&acc)[2][2][4][2], const Unit& u, int wr, int wc, int fr, int fq) const {
        const int row0 = u.pm * BM + wr * 64 + fr, cl = wc * 32 + 8 * fq, col0 = u.pn * BM + cl;
#pragma unroll
        for (int bj = 0; bj < 2; ++bj) { const f32x4 bv0 = *(const LAS f32x4*)(bl + cl + bj * HALF), bv1 = *(const LAS f32x4*)(bl + cl + bj * HALF + 4);
#pragma unroll
            for (int ai = 0; ai < 2; ++ai)
#pragma unroll
                for (int mp = 0; mp < 4; mp += 2) { v2u wv[2];
#pragma unroll
                    for (int mm = 0; mm < 2; ++mm) { const int m = mp + mm; const f32x4 v0 = acc[ai][bj][m][0] + bv0, v1 = acc[ai][bj][m][1] + bv1;
                        v2u w; w.x = 0; w.y = 0;
                        w.x = __builtin_amdgcn_cvt_pk_fp8_f32(v0[0], v0[1], w.x, false); w.x = __builtin_amdgcn_cvt_pk_fp8_f32(v0[2], v0[3], w.x, true);
                        w.y = __builtin_amdgcn_cvt_pk_fp8_f32(v1[0], v1[1], w.y, false); w.y = __builtin_amdgcn_cvt_pk_fp8_f32(v1[2], v1[3], w.y, true);
                        wv[mm] = w; }
                    const auto sx = __builtin_amdgcn_permlane16_swap(wv[0].x, wv[1].x, false, false), sy = __builtin_amdgcn_permlane16_swap(wv[0].y, wv[1].y, false, false);
                    *(v4u*)(O + (size_t)(row0 + ai * HALF + (mp + (fq & 1)) * 16) * D + (col0 - 8 * (fq & 1)) + bj * HALF) = (v4u){sx[0], sy[0], sx[1], sy[1]}; }
            asm volatile("" ::: "memory"); }
    }
};
}

namespace att {
constexpr int AD = 128, NW = 8, QBLK = 32, KVBLK = 64;
constexpr float SCALE = 0.088388347648318440f;
constexpr int LDO = 1024;
constexpr int SHM_V = AD * KVBLK, SHM_K = KVBLK * AD, SHM_ATTN = 4 * SHM_V + 4 * SHM_K;
typedef int v8i __attribute__((ext_vector_type(8)));
#define K8SW(key, c) ((key) * 128 + ((((c) ^ (((key) >> 1) & 7))) << 4))
#define V8SW(d, c) ((d) * 64 + ((((c) ^ (((d) >> 2) & 3))) << 4))
#define SBAR() __builtin_amdgcn_sched_barrier(0)
__device__ __forceinline__ int crow(int r, int hi) { return (r & 3) + 8 * (r >> 2) + 4 * hi; }
template <int XV = 0>
__device__ __forceinline__ int exp4(float a0, float a1, float a2, float a3) {
  float t0 = fminf(a0 + 8.0f, 8.0f), t1 = fminf(a1 + 8.0f, 8.0f), t2 = fminf(a2 + 8.0f, 8.0f), t3 = fminf(a3 + 8.0f, 8.0f); int w;
  asm volatile("v_exp_f32 %1, %1\n\tv_exp_f32 %2, %2\n\tv_exp_f32 %3, %3\n\tv_exp_f32 %4, %4\n\t"
               "v_cvt_pk_fp8_f32 %0, %1, %2\n\ts_nop 0\n\tv_cvt_pk_fp8_f32 %0, %3, %4 op_sel:[0,0,1]"
               : "=&v"(w), "+v"(t0), "+v"(t1), "+v"(t2), "+v"(t3));
  return w;
}
template <int PAD>
__device__ __forceinline__ int expc4(float a0, float a1, float a2, float a3) {
  int w; float t0, t1, t2, t3;
  if constexpr (PAD != 0)
    asm volatile("s_nop 5\n\tv_exp_f32_e64 %1, %5 clamp\n\tv_exp_f32_e64 %2, %6 clamp\n\tv_exp_f32_e64 %3, %7 clamp\n\tv_exp_f32_e64 %4, %8 clamp\n\t"
                 "v_cvt_scalef32_pk_fp8_f32 %0, %1, %2, %9\n\ts_nop 0\n\tv_cvt_scalef32_pk_fp8_f32 %0, %3, %4, %9 op_sel:[0,0,0,1]"
                 : "=&v"(w), "=&v"(t0), "=&v"(t1), "=&v"(t2), "=&v"(t3) : "v"(a0), "v"(a1), "v"(a2), "v"(a3), "s"(0x3B800000));
  else
    asm volatile("v_exp_f32_e64 %1, %5 clamp\n\tv_exp_f32_e64 %2, %6 clamp\n\tv_exp_f32_e64 %3, %7 clamp\n\tv_exp_f32_e64 %4, %8 clamp\n\t"
                 "v_cvt_scalef32_pk_fp8_f32 %0, %1, %2, %9\n\ts_nop 0\n\tv_cvt_scalef32_pk_fp8_f32 %0, %3, %4, %9 op_sel:[0,0,0,1]"
                 : "=&v"(w), "=&v"(t0), "=&v"(t1), "=&v"(t2), "=&v"(t3) : "v"(a0), "v"(a1), "v"(a2), "v"(a3), "s"(0x3B800000));
  return w;
}
#define EXC4(P, m, PAD) expc4<PAD>(P[4 * (m)], P[4 * (m) + 1], P[4 * (m) + 2], P[4 * (m) + 3])
typedef int v4i __attribute__((ext_vector_type(4)));
__device__ __forceinline__ void partialSM(const f32x16& p0, float nb, v4i& plo) {
#pragma unroll
  for (int m = 0; m < 4; ++m) plo[m] = exp4(p0[4 * m], p0[4 * m + 1], p0[4 * m + 2], p0[4 * m + 3]);
}
__device__ __forceinline__ void finishSM(const f32x16& p1, float nb, const v4i& plo, v8i& pa) {
  v4i phi;
#pragma unroll
  for (int m = 0; m < 4; ++m) phi[m] = exp4(p1[4 * m], p1[4 * m + 1], p1[4 * m + 2], p1[4 * m + 3]);
  pa = (v8i){plo[0], plo[1], plo[2], plo[3], phi[0], phi[1], phi[2], phi[3]};
}
__device__ __forceinline__ void qkt(f32x16& p0, f32x16& p1, const char* Ks, const v8i* q8, int r32, int hi, const f32x16& NBV) {
  p0 = NBV; p1 = NBV;
#pragma unroll
  for (int s = 0; s < 2; ++s) { const int c0 = 4 * s + 2 * hi;
    const v4u a0 = *reinterpret_cast<const v4u*>(Ks + K8SW(r32, c0)), a1 = *reinterpret_cast<const v4u*>(Ks + K8SW(r32, c0 + 1));
    const v4u b0 = *reinterpret_cast<const v4u*>(Ks + K8SW(32 + r32, c0)), b1 = *reinterpret_cast<const v4u*>(Ks + K8SW(32 + r32, c0 + 1));
    const v8i A0 = (v8i){(int)a0.x, (int)a0.y, (int)a0.z, (int)a0.w, (int)a1.x, (int)a1.y, (int)a1.z, (int)a1.w};
    const v8i A1 = (v8i){(int)b0.x, (int)b0.y, (int)b0.z, (int)b0.w, (int)b1.x, (int)b1.y, (int)b1.z, (int)b1.w};
    p0 = __builtin_amdgcn_mfma_scale_f32_32x32x64_f8f6f4(A0, q8[s], p0, 0, 0, 0, 0x7F7F7F7F, 0, 0x7C7C7C7C);
    p1 = __builtin_amdgcn_mfma_scale_f32_32x32x64_f8f6f4(A1, q8[s], p1, 0, 0, 0, 0x7F7F7F7F, 0, 0x7C7C7C7C); }
}
__device__ __forceinline__ void pv_d0(f32x16* o, f32x16& lacc, const char* Vs, v8i pa, int r32, int hi) {
  { const int one = 0x38383838; const v8i ONES = (v8i){one, one, one, one, one, one, one, one};
    lacc = __builtin_amdgcn_mfma_scale_f32_32x32x64_f8f6f4(pa, ONES, lacc, 0, 0, 0, 0x7F7F7F7F, 0, 0x7F7F7F7F); }
#pragma unroll
  for (int d0 = 0; d0 < 4; ++d0) { const int d = 32 * d0 + r32;
    const v4u b0 = *reinterpret_cast<const v4u*>(Vs + V8SW(d, 2 * hi)), b1 = *reinterpret_cast<const v4u*>(Vs + V8SW(d, 2 * hi + 1));
    const v8i B = (v8i){(int)b0.x, (int)b0.y, (int)b0.z, (int)b0.w, (int)b1.x, (int)b1.y, (int)b1.z, (int)b1.w};
    o[d0] = __builtin_amdgcn_mfma_scale_f32_32x32x64_f8f6f4(pa, B, o[d0], 0, 0, 0, 0x7F7F7F7F, 0, 0x7F7F7F7F); }
}
__device__ __forceinline__ v8i lds32(const char* p0, const char* p1) { const v4u a = *reinterpret_cast<const v4u*>(p0), b = *reinterpret_cast<const v4u*>(p1);
  return (v8i){(int)a.x, (int)a.y, (int)a.z, (int)a.w, (int)b.x, (int)b.y, (int)b.z, (int)b.w}; }
#define MF8(A, B, C, SB) ((XV == 3 || XV == 4 || XV == 5 || XV == 9) ? (C) : __builtin_amdgcn_mfma_scale_f32_32x32x64_f8f6f4(A, B, C, 0, 0, 0, 0x7F7F7F7F, 0, SB))
#define EX4(P, m) exp4<XV>(P[4 * (m)], P[4 * (m) + 1], P[4 * (m) + 2], P[4 * (m) + 3])
template <int XV = 0>
__device__ __forceinline__ void tile_step(f32x16& pN0, f32x16& pN1, const f32x16& pP1, const v4i& ploP, v4i& ploN, f32x16* o, f32x16& lacc,
                                          const char* Ks, const char* Vs, const v8i* q8, int r32, int hi, const f32x16& Z) {
  const int one = 0x38383838; const v8i ONES = (v8i){one, one, one, one, one, one, one, one};
  v4i phi;
  const v8i A00 = lds32(Ks + K8SW(r32, 2 * hi), Ks + K8SW(r32, 2 * hi + 1)), A10 = lds32(Ks + K8SW(32 + r32, 2 * hi), Ks + K8SW(32 + r32, 2 * hi + 1));
  const v8i A01 = lds32(Ks + K8SW(r32, 4 + 2 * hi), Ks + K8SW(r32, 4 + 2 * hi + 1)), A11 = lds32(Ks + K8SW(32 + r32, 4 + 2 * hi), Ks + K8SW(32 + r32, 4 + 2 * hi + 1));
  phi[0] = EXC4(pP1, 0, 0); SBAR();
  pN0 = MF8(A00, q8[0], Z, 0x7C7C7C7C);   SBAR(); const v8i V0 = lds32(Vs + V8SW(r32, 2 * hi), Vs + V8SW(r32, 2 * hi + 1));           phi[1] = EXC4(pP1, 1, 0); SBAR();
  pN0 = MF8(A01, q8[1], pN0, 0x7C7C7C7C); SBAR(); const v8i V1 = lds32(Vs + V8SW(32 + r32, 2 * hi), Vs + V8SW(32 + r32, 2 * hi + 1)); phi[2] = EXC4(pP1, 2, 0); SBAR();
  pN1 = MF8(A10, q8[0], Z, 0x7C7C7C7C);   SBAR(); const v8i V2 = lds32(Vs + V8SW(64 + r32, 2 * hi), Vs + V8SW(64 + r32, 2 * hi + 1)); phi[3] = EXC4(pP1, 3, 0); SBAR();
  pN1 = MF8(A11, q8[1], pN1, 0x7C7C7C7C); SBAR(); const v8i V3 = lds32(Vs + V8SW(96 + r32, 2 * hi), Vs + V8SW(96 + r32, 2 * hi + 1)); SBAR();
  const v8i pa = (v8i){ploP[0], ploP[1], ploP[2], ploP[3], phi[0], phi[1], phi[2], phi[3]};
  lacc = MF8(pa, ONES, lacc, 0x7F7F7F7F); SBAR(); ploN[0] = EXC4(pN0, 0, 1); SBAR();
  o[0] = MF8(pa, V0, o[0], 0x7F7F7F7F);   SBAR(); ploN[1] = EXC4(pN0, 1, 0); SBAR();
  o[1] = MF8(pa, V1, o[1], 0x7F7F7F7F);   SBAR(); ploN[2] = EXC4(pN0, 2, 0); SBAR();
  o[2] = MF8(pa, V2, o[2], 0x7F7F7F7F);   SBAR(); ploN[3] = EXC4(pN0, 3, 0); SBAR();
  o[3] = MF8(pa, V3, o[3], 0x7F7F7F7F);   SBAR();
}
template <int XV = 0>
__device__ __forceinline__ void attn_dense_body(const unsigned char* __restrict__ Q8, const unsigned char* __restrict__ K8, const unsigned char* __restrict__ VT, int vt_ld, bf16* __restrict__ Ob, int seq, char* lds, int wave_id, float nb) {
  const int tid = opaque_tid(wave_id), wid = tid >> 6, lane = tid & 63, r32 = lane & 31, hi = lane >> 5;
  char* V_lds = lds; char* K_lds = lds + 4 * SHM_V;
  f32x16 lacc = {}; f32x16 o[4] = {}; v8i qr[2]; f32x16 NBV;
#pragma unroll
  for (int i = 0; i < 16; ++i) NBV[i] = nb;
  { const unsigned char* Qw = Q8 + (long)(wid * QBLK + r32) * 1024 + hi * 32;
#pragma unroll
    for (int s2 = 0; s2 < 2; ++s2) { const v4u a = *reinterpret_cast<const v4u*>(Qw + 64 * s2), b = *reinterpret_cast<const v4u*>(Qw + 64 * s2 + 16);
      qr[s2] = (v8i){(int)a.x, (int)a.y, (int)a.z, (int)a.w, (int)b.x, (int)b.y, (int)b.z, (int)b.w}; } }
  struct { v4u vs, ks; } sr_[1];
  const int kkey = tid >> 3, kch = tid & 7; const unsigned koff = (unsigned)(kkey * 256 + kch * 16); const int kst = K8SW(kkey, kch);
  const int vd = tid >> 2, vc = tid & 3; const unsigned voff = (unsigned)(vd * vt_ld + vc * 16); const int vst = V8SW(vd, vc);
#define SLOAD(i, k0) do { if (XV >= 7) break; sr_[i].vs = *reinterpret_cast<const v4u*>((const char*)VT + (size_t)(k0) + voff); \
    sr_[i].ks = *reinterpret_cast<const v4u*>((const char*)K8 + (size_t)(k0) * 256 + koff); } while (0)
#define SWRITE(b, i) do { *(v4u*)(V_lds + (b) * SHM_V + vst) = sr_[i].vs; *(v4u*)(K_lds + (b) * SHM_K + kst) = sr_[i].ks; } while (0)
#define SWAIT() asm volatile("s_waitcnt vmcnt(0)" ::: "memory")
#define TBAR() asm volatile("s_waitcnt lgkmcnt(0)\n\ts_barrier" ::: "memory")
  f32x16 pA0, pA1, pB0, pB1; v8i pa; v4i plA, plB; const int NT = seq / KVBLK;
  SLOAD(0, 0); SWAIT(); SWRITE(0, 0); SLOAD(0, KVBLK); TBAR();
  qkt(pA0, pA1, K_lds, qr, r32, hi, NBV); partialSM(pA0, nb, plA);
  SWAIT(); SWRITE(1, 0); SLOAD(0, 2 * KVBLK); TBAR();
#define STEP_IO(t, SW) do { SWAIT(); SWRITE(SW, 0); { const int tn = (t) + 2 < NT ? (t) + 2 : NT - 1; SLOAD(0, tn * KVBLK); } SBAR(); } while (0)
#define STEP_B(t, SK, SV, SW) do { STEP_IO(t, SW); tile_step<XV>(pB0, pB1, pA1, plA, plB, o, lacc, K_lds + (SK) * SHM_K, V_lds + (SV) * SHM_V, qr, r32, hi, NBV); TBAR(); } while (0)
#define STEP_A(t, SK, SV, SW) do { STEP_IO(t, SW); tile_step<XV>(pA0, pA1, pB1, plB, plA, o, lacc, K_lds + (SK) * SHM_K, V_lds + (SV) * SHM_V, qr, r32, hi, NBV); TBAR(); } while (0)
  int j = 1;
  for (; j + 5 < NT; j += 4) { STEP_B(j, 1, 0, 2); STEP_A(j + 1, 2, 1, 3); STEP_B(j + 2, 3, 2, 0); STEP_A(j + 3, 0, 3, 1); }
  STEP_B(j, 1, 0, 2); STEP_A(j + 1, 2, 1, 3);
  SBAR(); qkt(pB0, pB1, K_lds + 3 * SHM_K, qr, r32, hi, NBV);
  finishSM(pA1, nb, plA, pa); SBAR();
  pv_d0(o, lacc, V_lds + 2 * SHM_V, pa, r32, hi); partialSM(pB0, nb, plB);
  finishSM(pB1, nb, plB, pa); SBAR();
  pv_d0(o, lacc, V_lds + 3 * SHM_V, pa, r32, hi);
  { const int ln2 = opaque_tid(wave_id) & 63, r32e = ln2 & 31, hie = ln2 >> 5;
    bf16* Ow = Ob + (long)(wid * QBLK) * LDO;
#pragma unroll
    for (int r = 0; r < 16; ++r) { const int orow = crow(r, hie); const float rl = __builtin_amdgcn_rcpf(lacc[r]);
      for (int d0 = 0; d0 < 4; ++d0) Ow[(long)orow * LDO + d0 * 32 + r32e] = (bf16)f2bf(o[d0][r] * rl); } }
  __syncthreads();
#undef SLOAD
#undef TBAR
#undef STEP_IO
#undef STEP_A
#undef STEP_B
#undef SWRITE
#undef SWAIT
}
#undef K8SW
#undef V8SW
}
constexpr int NWAVES = 8, NTHREADS = 512;
struct Args { const float* in[36]; float* out; unsigned char* ws; int ph_lo, ph_hi; };
enum InIdx { I_X = 0, I_C, I_CTX, I_CCTX, I_ADAW, I_ADAB, I_N1G, I_N2G, I_WOUT, I_RW, I_RB, I_EW1, I_EB1, I_EW2, I_EB2, I_AWIN, I_AQG, I_AKG,
             I_GWIN, I_GVG, I_GWS, I_GBS, I_HWIN, I_HCW, I_HCB, I_FW1, I_FB1, I_FW2, I_FB2, I_FW3, I_FB3, I_FW4, I_FB4, I_FREQ, I_HD, I_FG };
struct Frame {
    LAS unsigned char* lds; volatile LAS unsigned* MISC; gu32* ctl;
    int tid, lane, wave, G, bx;
    float* out; unsigned char* ws;
};
template <class T> __device__ __forceinline__ T* launder(T* p) { unsigned long long v = (unsigned long long)p; asm volatile("" : "+s"(v)); return (T*)(GAS T*)v; }
constexpr int MW_PTRS = 640;
__device__ __forceinline__ const float* pin_load(const Frame& F, int i) {
    const unsigned lo = __builtin_amdgcn_readfirstlane(F.MISC[MW_PTRS + 2 * i]), hi = __builtin_amdgcn_readfirstlane(F.MISC[MW_PTRS + 2 * i + 1]);
    return (const float*)(GAS const float*)(((unsigned long long)hi << 32) | lo);
}
#define PIN(F, i) pin_load(F, i)
__device__ __forceinline__ Frame phase_frame(const Frame& F0) {
    Frame F = F0; F.tid = opaque_tid(F0.wave); F.lane = F.tid & 63; F.wave = F0.wave;
    F.ws = launder(F0.ws); F.out = launder(F0.out); F.ctl = (gu32*)(F.ws + WS_CTL);
    { LAS unsigned char* l = F0.lds; asm volatile("" : "+s"(l)); F.lds = l; F.MISC = (volatile LAS unsigned*)(l + MISC_OFF); }
    return F;
}
constexpr int PH_PRO0 = 0, PH_PRO1 = 1, PH_L0 = 2, PH_PER_LAYER = 9, PH_FINAL = PH_L0 + NLAYER * PH_PER_LAYER, PH_COUNT = PH_FINAL + 1;
enum LPhase { LP_NORM1 = 0, LP_INPROJ, LP_MIX1, LP_MIX2, LP_MIX3, LP_OUTPROJ, LP_NORM2, LP_MOE1, LP_MOE2 };

struct TItem { const float* src; unsigned char* dst; int N; bool fp8; };
__device__ __forceinline__ TItem titem_decode(Frame& F, int it) {
    constexpr int R0 = 128 * 512, R1 = 128 * 256, R2 = 2 * 384, R3 = 512, R4 = 768;
    int r = it; TItem t;
    if (r < R0) { const int mi = r >> 9, q = r & 511, kb = q >> 5, nb = q & 31, n0 = nb * 64;
        const int d0 = n0 < 1024 ? 256 * (n0 >> 7) + (n0 & 127) : 256 * ((n0 - 1024) >> 7) + 128 + (n0 & 127);
        t.src = PIN(F, I_EW1) + (size_t)mi * 1024 * 2048 + (size_t)(kb * 64) * 2048 + n0; t.N = 2048; t.fp8 = true; t.dst = F.ws + WS_WE1 + (size_t)mi * 2048 * 1024 + (size_t)d0 * 1024 + kb * 64; return t; } r -= R0;
    if (r < R1) { const int mi = r >> 8, q = r & 255, kb = q >> 4, nb = q & 15;
        t.src = PIN(F, I_EW2) + (size_t)mi * 1024 * 1024 + (size_t)(kb * 64) * 1024 + nb * 64; t.N = 1024; t.fp8 = true; t.dst = F.ws + WS_WE2 + (size_t)mi * 1024 * 1024 + (size_t)(nb * 64) * 1024 + kb * 64; return t; } r -= R1;
    if (r < R2) { const int mi = r / 384, q = r % 384, kb = q / 24, nb = q % 24;
        t.src = PIN(F, I_AWIN) + (size_t)mi * 1024 * 1536 + (size_t)(kb * 64) * 1536 + nb * 64; t.N = 1536; t.fp8 = true; t.dst = F.ws + WS_WATT + (size_t)mi * 1536 * 1024 + (size_t)(nb * 64) * 1024 + kb * 64; return t; } r -= R2;
    if (r < R3) { const int kb = r >> 5, nb = r & 31;
        t.src = PIN(F, I_GWIN) + (size_t)(kb * 64) * 2048 + nb * 64; t.N = 2048; t.fp8 = false; t.dst = F.ws + WS_WGM + ((size_t)(nb * 64) * 1024 + kb * 64) * 2; return t; } r -= R3;
    if (r < R4) { const int kb = r / 48, nb = r % 48;
        t.src = PIN(F, I_HWIN) + (size_t)(kb * 64) * 3072 + nb * 64; t.N = 3072; t.fp8 = false; t.dst = F.ws + WS_WHY + ((size_t)(nb * 64) * 1024 + kb * 64) * 2; return t; } r -= R4;
    { const int mi = r >> 8, q = r & 255, kb = q >> 4, nb = q & 15;
        t.src = PIN(F, I_WOUT) + (size_t)mi * 1024 * 1024 + (size_t)(kb * 64) * 1024 + nb * 64; t.N = 1024; t.fp8 = false; t.dst = F.ws + WS_WOUT + ((size_t)mi * 1024 * 1024 + (size_t)(nb * 64) * 1024 + kb * 64) * 2; return t; }
}
__device__ __forceinline__ void titem_load(const TItem& t, float (&v)[64], int lane) {
    const float* src = t.src + lane;
#pragma unroll
    for (int kk = 0; kk < 64; ++kk) v[kk] = src[(size_t)kk * t.N];
}
__device__ __forceinline__ void titem_finish(const TItem& t, const float (&v)[64], LAS float* scr, int lane) {
    constexpr int K = 1024;
#pragma unroll
    for (int kk = 0; kk < 64; ++kk) scr[kk * 65 + lane] = v[kk];
    LDS_WAIT(); asm volatile("" ::: "memory");
    if (!t.fp8) {
        const int c = lane & 7;
#pragma unroll
        for (int j = 0; j < 8; ++j) { const int n = (lane >> 3) + 8 * j; const LAS float* s = scr + (8 * c) * 65 + n;
            v4u o; o.x = pk2(s[0 * 65], s[1 * 65]); o.y = pk2(s[2 * 65], s[3 * 65]); o.z = pk2(s[4 * 65], s[5 * 65]); o.w = pk2(s[6 * 65], s[7 * 65]);
            *(GAS v4u*)(t.dst + ((size_t)n * K + 8 * c) * 2) = o; }
    } else {
        const int c = lane & 3;
#pragma unroll
        for (int j = 0; j < 4; ++j) { const int n = (lane >> 2) + 16 * j; const LAS float* s = scr + (16 * c) * 65 + n; unsigned w[4];
#pragma unroll
            for (int q = 0; q < 4; ++q) { unsigned x = 0; x = __builtin_amdgcn_cvt_pk_fp8_f32(32.0f * s[(4 * q) * 65], 32.0f * s[(4 * q + 1) * 65], x, false);
                x = __builtin_amdgcn_cvt_pk_fp8_f32(32.0f * s[(4 * q + 2) * 65], 32.0f * s[(4 * q + 3) * 65], x, true); w[q] = x; }
            *(GAS v4u*)(t.dst + (size_t)n * K + 16 * c) = (v4u){w[0], w[1], w[2], w[3]}; }
    }
    LDS_WAIT(); asm volatile("" ::: "memory");
}
__device__ __forceinline__ void pro0_transposes(Frame& F) {
    LAS float* scr = (LAS float*)(F.lds + F.wave * 16640);
    const int gw = F.bx * NWAVES + F.wave, NGW = F.G * NWAVES;
    constexpr int NITEMS = 128 * 512 + 128 * 256 + 2 * 384 + 512 + 768 + 4 * 256;
    float va[64], vb[64];
    int it = gw; if (it >= NITEMS) return;
    TItem ta = titem_decode(F, it), tb = ta; titem_load(ta, va, F.lane);
    for (;;) {
        const bool nb_ok = it + NGW < NITEMS; if (nb_ok) { tb = titem_decode(F, it + NGW); titem_load(tb, vb, F.lane); }
        titem_finish(ta, va, scr, F.lane);
        if (!nb_ok) break; it += NGW;
        const bool na_ok = it + NGW < NITEMS; if (na_ok) { ta = titem_decode(F, it + NGW); titem_load(ta, va, F.lane); }
        titem_finish(tb, vb, scr, F.lane);
        if (!na_ok) break; it += NGW;
    }
}
__device__ __forceinline__ void pro0_mod(Frame& F) {
    LAS float* sl = (LAS float*)F.lds;
    LAS float* red = (LAS float*)(F.lds + 65536);
    __syncthreads();
    for (int i = F.tid; i < 9 * 1024; i += NTHREADS) { const int r = i >> 10, k = i & 1023; const float v = r < 8 ? PIN(F, I_C)[r * 1024 + k] : PIN(F, I_CCTX)[k]; sl[i] = v / (1.0f + __expf(-v)); }
    __syncthreads();
    float* MOD = (float*)(F.ws + WS_MOD);
    for (int item = F.bx; item < NLAYER * 96; item += F.G) {
        const int l = item / 96, n0 = (item % 96) * 64;
        const float* W = PIN(F, I_ADAW) + (size_t)l * 1024 * 6144 + n0 + F.lane;
        float acc[9];
#pragma unroll
        for (int r = 0; r < 9; ++r) acc[r] = 0.f;
        const int kb = F.wave * 128;
#pragma unroll 16
        for (int k = 0; k < 128; ++k) { const float wv = W[(size_t)(kb + k) * 6144];
#pragma unroll
            for (int r = 0; r < 9; ++r) acc[r] += sl[r * 1024 + kb + k] * wv; }
#pragma unroll
        for (int r = 0; r < 9; ++r) red[(F.wave * 9 + r) * 64 + F.lane] = acc[r];
        __syncthreads();
        for (int i = F.tid; i < 9 * 64; i += NTHREADS) { const int r = i >> 6, n = i & 63; float s = 0.f;
#pragma unroll
            for (int w = 0; w < 8; ++w) s += red[(w * 9 + r) * 64 + n];
            MOD[((size_t)l * 9 + r) * 6144 + n0 + n] = s + PIN(F, I_ADAB)[l * 6144 + n0 + n]; }
        __syncthreads();
    }
}
__device__ __forceinline__ void pro0_filter_mlp(Frame& F) {
    const int j = F.lane, gw = F.bx * NWAVES + F.wave, NGW = F.G * NWAVES;
    LAS float* W1 = (LAS float*)F.lds; LAS float* W2 = W1 + FEMB * FH; LAS float* W3 = W2 + FH * FH;
    __syncthreads();
    for (int i = F.tid; i < FEMB * FH; i += NTHREADS) W1[i] = PIN(F, I_FW1)[i];
    for (int i = F.tid; i < FH * FH; i += NTHREADS) { W2[i] = PIN(F, I_FW2)[i]; W3[i] = PIN(F, I_FW3)[i]; }
    __syncthreads();
    const float b1 = PIN(F, I_FB1)[j], b2 = PIN(F, I_FB2)[j], b3 = PIN(F, I_FB3)[j], fr = PIN(F, I_FREQ)[j];
    for (int it = gw; it < SEQ + CL; it += NGW) {
        const bool lat = it < SEQ; const int t = lat ? it : it - SEQ; const float L = lat ? (float)SEQ : (float)CL;
        const float tl = (float)t / (L - 1.0f), w = (6.283185307179586f * (float)t) / L;
        float z;
        { const int band = (j - 1) & 15; const float f = 1e-4f + (float)band * ((15.0f - 1e-4f) / 15.0f); const float a = f * w;
          z = (j == 0) ? tl : (j <= 16 ? cosf(a) : -sinf(a)); }
        float s = b1;
#pragma unroll
        for (int i = 0; i < FEMB; ++i) s += __shfl(z, i) * W1[i * FH + j];
        const float a1 = sinf(fr * s);
        s = b2;
#pragma unroll 16
        for (int i = 0; i < FH; ++i) s += __shfl(a1, i) * W2[i * FH + j];
        const float a2 = sinf(fr * s);
        s = b3;
#pragma unroll 16
        for (int i = 0; i < FH; ++i) s += __shfl(a2, i) * W3[i * FH + j];
        const float a3 = sinf(fr * s);
        float* dst = lat ? (float*)(F.ws + WS_A3) + (size_t)t * FH : (float*)(F.ws + WS_A3C) + (size_t)t * FH;
        dst[j] = a3;
    }
    __syncthreads();
}

__device__ __forceinline__ f32x2 cmul(f32x2 a, f32x2 b) { return (f32x2){a.x * b.x - a.y * b.y, a.x * b.y + a.y * b.x}; }
__device__ __forceinline__ f32x2 cconj(f32x2 a) { return (f32x2){a.x, -a.y}; }
#define ZP(n) ((n) + ((n) >> 5))
constexpr int FFT_LDS_BYTES = (NFFT + NFFT / 32) * 8;
__device__ __forceinline__ void bfly_dif(f32x2& a0, f32x2& a1, f32x2& a2, f32x2& a3, f32x2 w) {
    const f32x2 t0 = a0 + a2, t1 = a0 - a2, t2 = a1 + a3, d = a1 - a3, t3 = (f32x2){d.y, -d.x};
    const f32x2 y0 = t0 + t2, y2 = t0 - t2, y1 = t1 + t3, y3 = t1 - t3, w2 = cmul(w, w), w3 = cmul(w2, w);
    a0 = y0; a1 = cmul(y2, w2); a2 = cmul(y1, w); a3 = cmul(y3, w3);
}
__device__ __forceinline__ void bfly_dit(f32x2& a0, f32x2& a1, f32x2& a2, f32x2& a3, f32x2 w) {
    const f32x2 w2 = cmul(w, w), w3 = cmul(w2, w), A1 = cmul(a1, w2), A2 = cmul(a2, w), A3 = cmul(a3, w3);
    const f32x2 u0 = a0 + A1, u1 = a0 - A1, u2 = A2 + A3, u3 = A2 - A3, iu3 = (f32x2){-u3.y, u3.x};
    a0 = u0 + u2; a1 = u1 + iu3; a2 = u0 - u2; a3 = u1 - iu3;
}
template <int LQ, bool INV> __device__ __forceinline__ void fft_r16(LAS f32x2* z, int tid) {
    constexpr int q16 = 1 << LQ; constexpr float inv_lb = 1.0f / (float)(16 * q16);
    constexpr float C1 = 0.92387953251128674f, S1 = 0.38268343236508977f, C2 = 0.70710678118654752f;
    asm volatile("" : "+v"(tid));
#pragma unroll 1
    for (int g = tid; g < NFFT / 16; g += NTHREADS) {
        const int j = g & (q16 - 1), base = ((g >> LQ) << (LQ + 4)) + j;
        f32x2 x[16];
#pragma unroll
        for (int m = 0; m < 16; ++m) x[m] = z[ZP(base + (m << LQ))];
        const float fr = (float)j * inv_lb; const float sn = __builtin_amdgcn_sinf(fr);
        const f32x2 w1 = (f32x2){__builtin_amdgcn_cosf(fr), INV ? sn : -sn};
        const float sg = INV ? 1.0f : -1.0f;
        const f32x2 wa0 = w1, wa1 = cmul(w1, (f32x2){C1, sg * S1}), wa2 = cmul(w1, (f32x2){C2, sg * C2}), wa3 = cmul(w1, (f32x2){S1, sg * C1});
        const f32x2 w2 = cmul(w1, w1), wb = cmul(w2, w2);
        if constexpr (!INV) {
            bfly_dif(x[0], x[4], x[8], x[12], wa0); bfly_dif(x[1], x[5], x[9], x[13], wa1); bfly_dif(x[2], x[6], x[10], x[14], wa2); bfly_dif(x[3], x[7], x[11], x[15], wa3);
#pragma unroll
            for (int a = 0; a < 4; ++a) bfly_dif(x[4 * a], x[4 * a + 1], x[4 * a + 2], x[4 * a + 3], wb);
        } else {
#pragma unroll
            for (int a = 0; a < 4; ++a) bfly_dit(x[4 * a], x[4 * a + 1], x[4 * a + 2], x[4 * a + 3], wb);
            bfly_dit(x[0], x[4], x[8], x[12], wa0); bfly_dit(x[1], x[5], x[9], x[13], wa1); bfly_dit(x[2], x[6], x[10], x[14], wa2); bfly_dit(x[3], x[7], x[11], x[15], wa3);
        }
#pragma unroll
        for (int m = 0; m < 16; ++m) z[ZP(base + (m << LQ))] = x[m];
    }
    __syncthreads();
}
template <bool INV> __device__ __forceinline__ void fft_r4_unit(LAS f32x2* z, int tid) {
    asm volatile("" : "+v"(tid));
#pragma unroll 2
    for (int bf = tid; bf < NFFT / 4; bf += NTHREADS) {
        const int base = 4 * bf; f32x2 a0 = z[ZP(base)], a1 = z[ZP(base + 1)], a2 = z[ZP(base + 2)], a3 = z[ZP(base + 3)];
        if constexpr (!INV) { const f32x2 t0 = a0 + a2, t1 = a0 - a2, t2 = a1 + a3, d = a1 - a3, t3 = (f32x2){d.y, -d.x};
            z[ZP(base)] = t0 + t2; z[ZP(base + 1)] = t0 - t2; z[ZP(base + 2)] = t1 + t3; z[ZP(base + 3)] = t1 - t3; }
        else { const f32x2 u0 = a0 + a1, u1 = a0 - a1, u2 = a2 + a3, u3 = a2 - a3, iu3 = (f32x2){-u3.y, u3.x};
            z[ZP(base)] = u0 + u2; z[ZP(base + 1)] = u1 + iu3; z[ZP(base + 2)] = u0 - u2; z[ZP(base + 3)] = u1 - iu3; }
    }
    __syncthreads();
}
__device__ __forceinline__ void fft16k_dif(LAS f32x2* z, int tid) { fft_r16<10, false>(z, tid); fft_r16<6, false>(z, tid); fft_r16<2, false>(z, tid); fft_r4_unit<false>(z, tid); }
__device__ __forceinline__ void fft16k_dit_inv(LAS f32x2* z, int tid) { fft_r4_unit<true>(z, tid); fft_r16<2, true>(z, tid); fft_r16<6, true>(z, tid); fft_r16<10, true>(z, tid); }
constexpr int KF_LD = 8256;
__device__ __forceinline__ int rev14(int p) { return (int)(__brev((unsigned)p) >> 18); }
__device__ __forceinline__ float hy_delta(int c) { const float mn = -3.0701134573253945f, mx = -15.350567286626973f; return fabsf(mn + (mx - mn) * ((float)c / 1023.0f)); }

__device__ __forceinline__ void pro1_router_split(Frame& F) {
    const float* MOD = (const float*)(F.ws + WS_MOD); unsigned char* RW3 = F.ws + WS_RW3;
    for (int ent = F.bx * NTHREADS + F.tid; ent < NLAYER * 9 * 8 * 8 * 64; ent += F.G * NTHREADS) {
        const int lane = ent & 63, kb = (ent >> 6) & 7, w = (ent >> 9) & 7, lb = ent >> 12, l = lb / 9;
        const int k0 = w * 128 + 16 * kb + 8 * (lane >> 5), e = lane & 31;
        const float* gn = PIN(F, I_N2G) + l * D; const float* sc = MOD + (size_t)lb * 6144 + 4 * 1024; const float* rw = PIN(F, I_RW) + (size_t)l * D * NE;
        unsigned ph[4], pm[4], pl[4];
#pragma unroll
        for (int j2 = 0; j2 < 4; ++j2) { const int k = k0 + 2 * j2; const float v0 = gn[k] * (1.0f + sc[k]) * rw[(size_t)k * NE + e], v1 = gn[k + 1] * (1.0f + sc[k + 1]) * rw[(size_t)(k + 1) * NE + e];
            const unsigned h = cvt_pk_bf16(v0, v1); const float r0 = v0 - __uint_as_float(h << 16), r1 = v1 - __uint_as_float(h & 0xffff0000u);
            const unsigned m = cvt_pk_bf16(r0, r1); const float s0 = r0 - __uint_as_float(m << 16), s1 = r1 - __uint_as_float(m & 0xffff0000u);
            ph[j2] = h; pm[j2] = m; pl[j2] = cvt_pk_bf16(s0, s1); }
        v4u* dst = (v4u*)(RW3 + (size_t)(ent >> 6) * 3 * 1024) + lane;
        dst[0] = (v4u){ph[0], ph[1], ph[2], ph[3]}; dst[64] = (v4u){pm[0], pm[1], pm[2], pm[3]}; dst[128] = (v4u){pl[0], pl[1], pl[2], pl[3]};
    }
}
__device__ __forceinline__ void pro1_filters(Frame& F) {
    if (F.bx < NLAYER * 9) {
        const int lb = F.bx, l = lb / 9, e = F.lane & 31, hf = F.lane >> 5; const float* sh = (const float*)(F.ws + WS_MOD) + (size_t)lb * 6144 + 3 * 1024; const float* rw = PIN(F, I_RW) + (size_t)l * D * NE;
        LAS float* red = (LAS float*)F.lds; const int k0 = F.wave * 128 + hf * 64; float acc = 0.f;
#pragma unroll 8
        for (int k = k0; k < k0 + 64; ++k) acc += sh[k] * rw[(size_t)k * NE + e];
        acc += shx(acc, 32, F.lane); if (F.lane < 32) red[F.wave * 32 + e] = acc;
        __syncthreads();
        if (F.tid < 32) { float s = PIN(F, I_RB)[l * NE + F.tid];
#pragma unroll
            for (int w = 0; w < 8; ++w) s += red[w * 32 + F.tid];
            ((float*)(F.ws + WS_RC))[lb * NE + F.tid] = s; }
    }
    LAS f32x2* z = (LAS f32x2*)F.lds;
    LAS float* wl = (LAS float*)(F.lds + AUX_OFF + 8192);
    const float* a3 = (const float*)(F.ws + WS_A3); const float* a3c = (const float*)(F.ws + WS_A3C);
    f32x2* KF = (f32x2*)(F.ws + WS_KF); float* FCT = (float*)(F.ws + WS_FCT);
    for (int u = F.bx; u < 512; u += F.G) {
        const int ca = 2 * u, cb = 2 * u + 1;
        __syncthreads();
        if (F.tid < 256) { const int which = F.tid >> 6, m = F.tid & 63; const int col = (which & 1 ? cb : ca) + (which >> 1) * 1024; wl[which * 64 + m] = PIN(F, I_FW4)[m * 2048 + col]; }
        if (F.tid < 4) { const int col = (F.tid & 1 ? cb : ca) + (F.tid >> 1) * 1024; wl[256 + F.tid] = PIN(F, I_FB4)[col]; }
        __syncthreads();
        const float da = hy_delta(ca), db = hy_delta(cb);
        for (int t = F.tid; t < SEQ; t += NTHREADS) {
            const f32x4* ar = (const f32x4*)(a3 + (size_t)t * FH); float s0 = wl[256], s1 = wl[257], s2 = wl[258], s3 = wl[259];
#pragma unroll 8
            for (int m4 = 0; m4 < 16; ++m4) { const f32x4 a = ar[m4];
#pragma unroll
                for (int i = 0; i < 4; ++i) { const int m = m4 * 4 + i; s0 += a[i] * wl[m]; s1 += a[i] * wl[64 + m]; s2 += a[i] * wl[128 + m]; s3 += a[i] * wl[192 + m]; } }
            const float tl = (float)t / (float)(SEQ - 1); const float wa = __expf(-tl * da), wb = __expf(-tl * db);
            z[ZP(t)] = (f32x2){s0 * wa, s1 * wb};
            if (t == 0) z[ZP(SEQ)] = (f32x2){0.f, 0.f}; else z[ZP(NFFT - t)] = (f32x2){s2 * wa, s3 * wb};
        }
        for (int i = F.tid; i < 511; i += NTHREADS) {
            const int d = i - 255, t = d < 0 ? -d : d; const int o = d < 0 ? 2 : 0;
            const f32x4* ar = (const f32x4*)(a3c + (size_t)t * FH); float sa = wl[256 + o], sb = wl[257 + o];
            f32x4 av[16];
#pragma unroll
            for (int m4 = 0; m4 < 16; ++m4) av[m4] = ar[m4];
            __builtin_amdgcn_sched_barrier(0);
#pragma unroll
            for (int m4 = 0; m4 < 16; ++m4) {
#pragma unroll
                for (int i2 = 0; i2 < 4; ++i2) { const int m = m4 * 4 + i2; sa += av[m4][i2] * wl[o * 64 + m]; sb += av[m4][i2] * wl[(o + 1) * 64 + m]; }
                if ((m4 & 3) == 3) __builtin_amdgcn_sched_barrier(0); }
            const float tl = (float)t / (float)(CL - 1);
            FCT[(size_t)ca * 512 + d + 256] = sa * __expf(-tl * da); FCT[(size_t)cb * 512 + d + 256] = sb * __expf(-tl * db);
        }
        __syncthreads();
        fft16k_dif(z, F.tid);
        for (int k = F.tid; k <= NFFT / 2; k += NTHREADS) {
            const int p = rev14(k), p2 = rev14((NFFT - k) & (NFFT - 1)); const f32x2 a = z[ZP(p)], b = z[ZP(p2)];
            KF[(size_t)ca * KF_LD + k] = (f32x2){0.5f * (a.x + b.x), 0.5f * (a.y - b.y)};
            KF[(size_t)cb * KF_LD + k] = (f32x2){0.5f * (a.y + b.y), -0.5f * (a.x - b.x)};
        }
    }
    __syncthreads();
}

__device__ __forceinline__ void hyena_conv_phase(Frame& F) {
    LAS f32x2* z = (LAS f32x2*)F.lds;
    LAS float* aux = (LAS float*)(F.lds + AUX_OFF + 8192);
    const float* VT = (const float*)(F.ws + WS_VT); const float* VTC = (const float*)(F.ws + WS_VTC); float* CT = (float*)(F.ws + WS_CT); float* CTC = (float*)(F.ws + WS_CTC);
    const f32x2* KF = (const f32x2*)(F.ws + WS_KF); const float* FCT = (const float*)(F.ws + WS_FCT);
    v4u ina[2], inb[2];
#define HC_LOADIN(u_, t_) do { const int b_ = (u_) >> 9, c_ = 2 * ((u_) & 511); const v4u* va_ = (const v4u*)((const bf16*)VT + ((size_t)b_ * 1024 + c_) * SEQ + 16 * (t_)); \
        ina[0] = va_[0]; ina[1] = va_[1]; inb[0] = va_[SEQ / 8]; inb[1] = va_[SEQ / 8 + 1]; } while (0)
    if (F.bx < NB * 512) HC_LOADIN(F.bx, F.tid);
    for (int u = F.bx; u < NB * 512; u += F.G) {
        const int b = u >> 9, cp = u & 511, ca = 2 * cp, cb = ca + 1;
        int tq = F.tid; asm volatile("" : "+v"(tq));
        __syncthreads();
        { const int n0 = 16 * tq;
#pragma unroll
          for (int i = 0; i < 4; ++i) { const unsigned a0 = ina[i >> 1][2 * (i & 1)], a1 = ina[i >> 1][2 * (i & 1) + 1], b0 = inb[i >> 1][2 * (i & 1)], b1 = inb[i >> 1][2 * (i & 1) + 1];
              z[ZP(n0 + 4 * i)] = (f32x2){bflo(a0), bflo(b0)}; z[ZP(n0 + 4 * i + 1)] = (f32x2){bfhi(a0), bfhi(b0)}; z[ZP(n0 + 4 * i + 2)] = (f32x2){bflo(a1), bflo(b1)}; z[ZP(n0 + 4 * i + 3)] = (f32x2){bfhi(a1), bfhi(b1)};
#pragma unroll
              for (int j = 0; j < 4; ++j) z[ZP(SEQ + n0 + 4 * i + j)] = (f32x2){0.f, 0.f}; } }
        f32x4 ka[8], kb[8]; f32x2 kaN, kbN;
        { const f32x4* pa = (const f32x4*)(KF + (size_t)ca * KF_LD + 16 * tq); const f32x4* pb = (const f32x4*)(KF + (size_t)cb * KF_LD + 16 * tq);
#pragma unroll
          for (int i = 0; i < 8; ++i) { ka[i] = pa[i]; kb[i] = pb[i]; }
          kaN = KF[(size_t)ca * KF_LD + NFFT / 2]; kbN = KF[(size_t)cb * KF_LD + NFFT / 2]; }
        { const int h = tq >> 8, t = tq & 255; const float* vc = VTC + ((size_t)b * 1024 + ca + h) * CL;
          aux[h * 256 + t] = vc[t]; aux[512 + h * 512 + t] = FCT[(size_t)(ca + h) * 512 + t]; aux[512 + h * 512 + 256 + t] = FCT[(size_t)(ca + h) * 512 + 256 + t];
          __syncthreads();
          float y = 0.f;
#pragma unroll 8
          for (int s = 0; s < CL; ++s) y += aux[h * 256 + s] * aux[512 + h * 512 + (t - s) + 256];
          CTC[((size_t)b * 1024 + ca + h) * CL + t] = y; }
        fft16k_dif(z, F.tid);
        int tpw = tq; asm volatile("" : "+v"(tpw));
#define HC_PW(k_, Ka_, Kb_) do { const int p = rev14(k_), p2 = rev14((NFFT - (k_)) & (NFFT - 1)); const f32x2 a = z[ZP(p)], b2 = z[ZP(p2)]; \
            const f32x2 Va = (f32x2){0.5f * (a.x + b2.x), 0.5f * (a.y - b2.y)}, Vb = (f32x2){0.5f * (a.y + b2.y), -0.5f * (a.x - b2.x)}; \
            const f32x2 ya = cmul(Va, Ka_), yb = cmul(Vb, Kb_); \
            z[ZP(p)] = (f32x2){ya.x - yb.y, ya.y + yb.x}; z[ZP(p2)] = (f32x2){ya.x + yb.y, -ya.y + yb.x}; } while (0)
#pragma unroll
        for (int i = 0; i < 8; ++i) { const int k = 16 * tpw + 2 * i;
            HC_PW(k, ((f32x2){ka[i].x, ka[i].y}), ((f32x2){kb[i].x, kb[i].y})); HC_PW(k + 1, ((f32x2){ka[i].z, ka[i].w}), ((f32x2){kb[i].z, kb[i].w}));
            asm volatile("" ::: "memory"); }
        if (tpw == 0) HC_PW(NFFT / 2, kaN, kbN);
#undef HC_PW
        __syncthreads();
        if (u + F.G < NB * 512) HC_LOADIN(u + F.G, tq);
        fft16k_dit_inv(z, F.tid);
        { int to = tq; asm volatile("" : "+v"(to)); const float sc = 1.0f / (float)NFFT; const int n0 = 16 * to;
          v4u* oa = (v4u*)((bf16*)CT + ((size_t)b * 1024 + ca) * SEQ + n0);
#pragma unroll
          for (int h2 = 0; h2 < 2; ++h2) { f32x2 w[8];
#pragma unroll
              for (int j = 0; j < 8; ++j) w[j] = z[ZP(n0 + 8 * h2 + j)];
              oa[h2] = (v4u){cvt_pk_bf16(w[0].x * sc, w[1].x * sc), cvt_pk_bf16(w[2].x * sc, w[3].x * sc), cvt_pk_bf16(w[4].x * sc, w[5].x * sc), cvt_pk_bf16(w[6].x * sc, w[7].x * sc)};
              oa[SEQ / 8 + h2] = (v4u){cvt_pk_bf16(w[0].y * sc, w[1].y * sc), cvt_pk_bf16(w[2].y * sc, w[3].y * sc), cvt_pk_bf16(w[4].y * sc, w[5].y * sc), cvt_pk_bf16(w[6].y * sc, w[7].y * sc)}; } }
    }
    __syncthreads();
#undef HC_LOADIN
}
constexpr int MW_CUMBLK = 16, MW_CNT = 64, MW_SELE = 128, MW_SELV = 256, MW_LRANK = 384, MW_LBASE = 512;
__device__ __forceinline__ void moe_tables(Frame& F, int layer) {
    __syncthreads();
    if (F.tid < NE) F.MISC[MW_CNT + F.tid] = __hip_atomic_load(F.ctl + CW_CNT + layer * NE + F.tid, RLX_AGENT);
    __syncthreads();
    if (F.tid == 0) { unsigned c = 0; for (int e = 0; e < NE; ++e) { F.MISC[MW_CUMBLK + e] = c; c += (F.MISC[MW_CNT + e] + 255u) >> 8; } F.MISC[MW_CUMBLK + NE] = c; }
    __syncthreads();
}

template <int MODE> __device__ __forceinline__ void rowpass(Frame& F, int layer, bool real = true, bool h8 = false) {
    const bool combine = (MODE == 0 && layer > 0) || MODE == 2;
    const int nrows = MODE == 2 ? ML : MT;
    const int cl = MODE == 2 ? NLAYER - 1 : layer - 1;
    const bool from_input = (MODE == 0 && layer == 0);
    const float* XLs = PIN(F, I_X); const float* XCs = PIN(F, I_CTX);
    bf16* XB = (bf16*)(F.ws + WS_XB); bf16* XBd = real ? XB : (bf16*)(F.ws + WS_P);
    const float* MOD = (const float*)(F.ws + WS_MOD);
    bf16* H = (bf16*)(F.ws + WS_H); unsigned char* H8 = (unsigned char*)(F.ws + WS_H8); const unsigned char* YM = (const unsigned char*)(F.ws + WS_YM);
    const int* TE = (const int*)(F.ws + WS_TE); const int* TR = (const int*)(F.ws + WS_TR); const float* TG = (const float*)(F.ws + WS_TG);
    const float* gnorm = MODE == 0 ? PIN(F, I_N1G) + layer * D : PIN(F, I_FG);
    if (combine) moe_tables(F, cl);
    f32x4 gn[4];
#pragma unroll
    for (int j = 0; j < 4; ++j) gn[j] = ((const f32x4*)gnorm)[F.lane + 64 * j];
    const int ntiles = nrows / 32;
    i32x4 nte[4], ntr[4]; f32x4 ntg[4];
#define RP_TABLES(tile_) do { const size_t rb_ = (size_t)((tile_) * 32 + F.wave * 4) * 4; \
        _Pragma("unroll") for (int q = 0; q < 4; ++q) { nte[q] = *(const i32x4*)(TE + rb_ + 4 * q); ntr[q] = *(const i32x4*)(TR + rb_ + 4 * q); ntg[q] = *(const f32x4*)(TG + rb_ + 4 * q); } } while (0)
    if (combine && F.bx < ntiles) RP_TABLES(F.bx);
    for (int tile = F.bx; tile < ntiles; tile += F.G) {
        const int rbase = tile * 32 + F.wave * 4; const bool lat = rbase < ML; const int bidx = lat ? (rbase >> 13) : 8;
        const float* g2 = MOD + ((size_t)(combine ? cl : 0) * 9 + bidx) * 6144 + 5 * 1024;
        const float* mb = MOD + ((size_t)layer * 9 + bidx) * 6144;
        int rid[4][4]; float gkk[4][4];
        if (combine) {
#pragma unroll
            for (int q = 0; q < 4; ++q)
#pragma unroll
                for (int k = 0; k < 4; ++k) { rid[q][k] = 256 * (int)F.MISC[MW_CUMBLK + nte[q][k]] + ntr[q][k]; gkk[q][k] = ntg[q][k]; }
            if (tile + F.G < ntiles) RP_TABLES(tile + F.G);
        }
#pragma unroll 1
        for (int pr = 0; pr < 2; ++pr) {
            size_t xo[2]; f32x4 v[2][4]; int rowid[2][4]; float gk[2][4];
#pragma unroll
            for (int u = 0; u < 2; ++u) { const int r = rbase + 2 * pr + u; xo[u] = (size_t)r * D;
                if (combine) {
#pragma unroll
                    for (int k = 0; k < 4; ++k) { rowid[u][k] = pr ? rid[2 + u][k] : rid[u][k]; gk[u][k] = pr ? gkk[2 + u][k] : gkk[u][k]; } }
                if (from_input) { const f32x4* xs = (const f32x4*)(lat ? XLs + xo[u] : XCs + (xo[u] - (size_t)ML * D));
#pragma unroll
                    for (int j = 0; j < 4; ++j) v[u][j] = xs[F.lane + 64 * j]; }
                else { const v2u* xs = (const v2u*)(XB + xo[u]);
#pragma unroll
                    for (int j = 0; j < 4; ++j) v[u][j] = bf4_f32(xs[F.lane + 64 * j]); } }
            if (combine) {
                unsigned w[2][4][4];
#pragma unroll
                for (int u = 0; u < 2; ++u)
#pragma unroll
                    for (int k = 0; k < 4; ++k) { const unsigned* yr = (const unsigned*)(YM + (size_t)rowid[u][k] * D);
#pragma unroll
                        for (int j = 0; j < 4; ++j) w[u][k][j] = yr[F.lane + 64 * j]; }
#pragma unroll
                for (int u = 0; u < 2; ++u) {
#pragma unroll
                    for (int j = 0; j < 4; ++j) { f32x4 a = (f32x4){0.f, 0.f, 0.f, 0.f};
#pragma unroll
                        for (int k = 0; k < 4; ++k) { const f32x2 lo = __builtin_amdgcn_cvt_pk_f32_fp8(w[u][k][j], false), hi2 = __builtin_amdgcn_cvt_pk_f32_fp8(w[u][k][j], true); a += gk[u][k] * (f32x4){lo.x, lo.y, hi2.x, hi2.y}; }
                        v[u][j] += ((const f32x4*)g2)[F.lane + 64 * j] * a; }
                    if (MODE == 0) { v2u* xd = (v2u*)(XBd + xo[u]);
#pragma unroll
                        for (int j = 0; j < 4; ++j) { v2u o; o.x = cvt_pk_bf16(v[u][j].x, v[u][j].y); o.y = cvt_pk_bf16(v[u][j].z, v[u][j].w); xd[F.lane + 64 * j] = o; } } }
            }
            if (from_input) {
#pragma unroll
                for (int u = 0; u < 2; ++u) { v2u* xd = (v2u*)(XBd + xo[u]);
#pragma unroll
                    for (int j = 0; j < 4; ++j) { v2u o; o.x = cvt_pk_bf16(v[u][j].x, v[u][j].y); o.y = cvt_pk_bf16(v[u][j].z, v[u][j].w); xd[F.lane + 64 * j] = o; } } }
#pragma unroll
            for (int u = 0; u < 2; ++u) { const int r = rbase + 2 * pr + u;
                float ss = 0.f;
#pragma unroll
                for (int j = 0; j < 4; ++j) ss += (v[u][j].x * v[u][j].x + v[u][j].y * v[u][j].y) + (v[u][j].z * v[u][j].z + v[u][j].w * v[u][j].w);
                const float rstd = 1.0f / sqrtf(wave_sum(ss, F.lane) * (1.0f / D) + EPS);
                if (MODE == 2) { f32x4* od = (f32x4*)((real ? F.out : (float*)(F.ws + WS_P)) + xo[u]);
#pragma unroll
                    for (int j = 0; j < 4; ++j) od[F.lane + 64 * j] = v[u][j] * rstd * gn[j]; }
                else { v2u* hd = (v2u*)(H + (size_t)r * D); unsigned* hd8 = (unsigned*)(H8 + (size_t)r * D);
#pragma unroll
                    for (int j = 0; j < 4; ++j) { const f32x4 sh = ((const f32x4*)mb)[F.lane + 64 * j], sc = ((const f32x4*)(mb + 1024))[F.lane + 64 * j]; const f32x4 hv = v[u][j] * rstd * gn[j] * (sc + 1.0f) + sh;
                        if (h8) { unsigned o = 0; o = __builtin_amdgcn_cvt_pk_fp8_f32(hv.x, hv.y, o, false); o = __builtin_amdgcn_cvt_pk_fp8_f32(hv.z, hv.w, o, true); hd8[F.lane + 64 * j] = o; }
                        else { v2u o; o.x = cvt_pk_bf16(hv.x, hv.y); o.y = cvt_pk_bf16(hv.z, hv.w); hd[F.lane + 64 * j] = o; } } }
            }
        }
    }
}

typedef float f32x16r __attribute__((ext_vector_type(16)));
__device__ __forceinline__ void router_phase(Frame& F, int layer, bool real = true, int xp = 0) {
    const bool last = layer == NLAYER - 1;
    const int ntiles = (last ? ML : MT) / 32;
    LAS float* PART = (LAS float*)F.lds;
    LAS float* SSQ = PART + 8 * 32 * 33;
    LAS float* LG = SSQ + 8 * 32;
    LAS float* RSTD = LG + 32 * 33;
    LAS unsigned* CW = (LAS unsigned*)(RSTD + 32);
    LAS unsigned* RUN = CW + 64;
    LAS float* AV = (LAS float*)(RUN + 32);
    LAS float* SHV = AV + 1024;
    LAS float* RCV = SHV + 1024;
    LAS bf16* STG = (LAS bf16*)((LAS unsigned char*)(RCV + 32) + F.wave * (32 * 272));
    const bf16* XB = (const bf16*)(F.ws + WS_XB);
    const float* MOD = (const float*)(F.ws + WS_MOD); const float* RC = (const float*)(F.ws + WS_RC);
    unsigned char* H8 = (unsigned char*)(F.ws + WS_H8);
    int* TE = (int*)(F.ws + WS_TE); int* TR = (int*)(F.ws + WS_TR); float* TG = (float*)(F.ws + WS_TG); int* ROWTOK = (int*)(F.ws + WS_ROWTOK);
    const float* gn = PIN(F, I_N2G) + layer * D; const float* rw = PIN(F, I_RW) + (size_t)layer * D * NE;
    const int i = F.lane & 31, hf = F.lane >> 5, lr = F.lane >> 4, lc = F.lane & 15, kw = F.wave * 128;
    const int per = 2048 / F.G;
    const int nmine = (2048 % F.G == 0) ? per + ((2048 + F.bx < ntiles) ? 1 : 0) : 0;
#define RT_TILE(n_) ((2048 % F.G == 0) ? ((n_) < per ? F.bx * per + (n_) : 2048 + F.bx) : F.bx + (n_) * F.G)
    const int ncnt = (2048 % F.G == 0) ? nmine : (F.bx < ntiles ? (ntiles - 1 - F.bx) / F.G + 1 : 0);
    __syncthreads();
    if (F.tid < NE) RUN[F.tid] = 0u;
    bf16x8 bw[8][2];
    v2u rawp[16];
#define RT_LOADX(tile_) do { const int rb_ = (tile_) * 32 + lr; const bf16* xb_ = XB + (size_t)rb_ * D + kw + 4 * lc; \
        _Pragma("unroll") for (int q = 0; q < 16; ++q) rawp[q] = *(const v2u*)(xb_ + (size_t)(4 * (q & 7)) * D + 64 * (q >> 3)); } while (0)
    if (ncnt > 0) RT_LOADX(RT_TILE(0));
    int cur_b = -1;
    for (int n = 0; n < ncnt; ++n) {
        const int tile = RT_TILE(n);
        const int r0 = tile * 32; const bool lat = r0 < ML; const int bidx = lat ? (r0 >> 13) : 8; const int r = r0 + i;
        if (bidx != cur_b) {
            cur_b = bidx; const float* mb = MOD + ((size_t)layer * 9 + bidx) * 6144 + 3 * 1024;
            __syncthreads();
            for (int k = F.tid; k < 1024; k += NTHREADS) { AV[k] = gn[k] * (1.0f + mb[1024 + k]); SHV[k] = mb[k]; }
            if (F.tid < NE) RCV[F.tid] = RC[((size_t)layer * 9 + bidx) * NE + F.tid];
            __syncthreads();
            { const v4u* src = (const v4u*)(F.ws + WS_RW3 + ((size_t)(layer * 9 + bidx) * 8 + F.wave) * 8 * 3 * 1024) + F.lane;
#pragma unroll
              for (int kb = 0; kb < 8; ++kb)
#pragma unroll
                  for (int t = 0; t < 2; ++t) bw[kb][t] = __builtin_bit_cast(bf16x8, src[(kb * 3 + t) * 64]); }
        }
        { float s8[8];
#pragma unroll
          for (int q = 0; q < 8; ++q) { const f32x4 a = bf4_f32(rawp[q]), b = bf4_f32(rawp[q + 8]); s8[q] = ((a.x * a.x + a.y * a.y) + (a.z * a.z + a.w * a.w)) + ((b.x * b.x + b.y * b.y) + (b.z * b.z + b.w * b.w)); }
#pragma unroll
          for (int q = 0; q < 8; ++q) { float v = s8[q]; v += shx(v, 1, F.lane); v += shx(v, 2, F.lane); v += shx(v, 4, F.lane); v += shx(v, 8, F.lane); if (lc == 0) SSQ[F.wave * 32 + 4 * q + lr] = v; } }
        __syncthreads();
        const f32x4 av0 = ((const LAS f32x4*)(AV + kw))[lc], av1 = ((const LAS f32x4*)(AV + kw))[lc + 16];
        { const f32x4 sh0 = ((const LAS f32x4*)(SHV + kw))[lc], sh1 = ((const LAS f32x4*)(SHV + kw))[lc + 16];
          unsigned char* hb = H8 + (size_t)(r0 + lr) * D + kw + 4 * lc;
#pragma unroll
          for (int q = 0; q < 8; ++q) { float qs = 0.f;
#pragma unroll
              for (int w = 0; w < 8; ++w) qs += SSQ[w * 32 + 4 * q + lr];
              const float rs = 1.0f / sqrtf(qs * (1.0f / D) + EPS);
#pragma unroll
              for (int hq = 0; hq < 2; ++hq) { const f32x4 h = bf4_f32(rawp[q + 8 * hq]) * (rs * (hq ? av1 : av0)) + (hq ? sh1 : sh0); unsigned w = 0;
                  w = __builtin_amdgcn_cvt_pk_fp8_f32(h.x, h.y, w, false); w = __builtin_amdgcn_cvt_pk_fp8_f32(h.z, h.w, w, true);
                  *(unsigned*)(hb + (size_t)(4 * q) * D + 64 * hq) = w; } } }
        f32x16r acc = {};
        asm volatile("s_waitcnt lgkmcnt(0)" ::: "memory");
#pragma unroll
        for (int q = 0; q < 16; ++q) *(LAS v2u*)(STG + (4 * (q & 7) + lr) * 136 + 4 * lc + 64 * (q >> 3)) = rawp[q];
        asm volatile("s_waitcnt lgkmcnt(0)" ::: "memory");
        if (n + 1 < ncnt) RT_LOADX(RT_TILE(n + 1));
#pragma unroll
        for (int kb = 0; kb < 8; ++kb) { const bf16x8 a = *(const LAS bf16x8*)(STG + i * 136 + 16 * kb + 8 * hf);
#pragma unroll
            for (int t = 0; t < 2; ++t) acc = __builtin_amdgcn_mfma_f32_32x32x16_bf16(a, bw[kb][t], acc, 0, 0, 0); }
#pragma unroll
        for (int rg = 0; rg < 16; ++rg) PART[(F.wave * 32 + ((rg & 3) + 8 * (rg >> 2) + 4 * hf)) * 33 + i] = acc[rg];
        __syncthreads();
        { const int tk = F.tid >> 4, e0 = (F.tid & 15) * 2; float q = 0.f, s0 = 0.f, s1 = 0.f;
#pragma unroll
          for (int w = 0; w < 8; ++w) { q += SSQ[w * 32 + tk]; s0 += PART[(w * 32 + tk) * 33 + e0]; s1 += PART[(w * 32 + tk) * 33 + e0 + 1]; }
          const float rstd = 1.0f / sqrtf(q * (1.0f / D) + EPS);
          LG[tk * 33 + e0] = rstd * s0 + RCV[e0]; LG[tk * 33 + e0 + 1] = rstd * s1 + RCV[e0 + 1]; }
        __syncthreads();
        { const int tk = F.tid >> 4, e0 = (F.tid & 15) * 2; const LAS float* lg = LG + tk * 33; const float l0 = lg[e0], l1 = lg[e0 + 1]; int rk0 = 0, rk1 = 0;
#pragma unroll 8
          for (int j = 0; j < NE; ++j) { const float o = lg[j]; rk0 += (o > l0 || (o == l0 && j < e0)) ? 1 : 0; rk1 += (o > l1 || (o == l1 && j < e0 + 1)) ? 1 : 0; }
          if (rk0 < 4) { F.MISC[MW_SELE + tk * 4 + rk0] = (unsigned)e0; F.MISC[MW_SELV + tk * 4 + rk0] = __float_as_uint(l0); }
          if (rk1 < 4) { F.MISC[MW_SELE + tk * 4 + rk1] = (unsigned)(e0 + 1); F.MISC[MW_SELV + tk * 4 + rk1] = __float_as_uint(l1); } }
        __syncthreads();
        int my = 0, lrk = 0;
        if (F.wave < 2) { const int a = F.tid; my = (int)F.MISC[MW_SELE + a];
            { const float vk = __uint_as_float(F.MISC[MW_SELV + a]), v0 = __uint_as_float(F.MISC[MW_SELV + (a & ~3)]);
              const float ex = __expf(vk - v0); float sm = ex; sm += shx(sm, 1, F.lane); sm += shx(sm, 2, F.lane);
              const size_t idx = ((size_t)r0 + (a >> 2)) * 4 + (a & 3); TG[idx] = ex / sm; TE[idx] = my; }
            unsigned cm = 0;
#pragma unroll 2
            for (int e = 0; e < NE; ++e) { const unsigned long long m = __ballot(my == e); const unsigned pc = (unsigned)__popcll(m);
                if (my == e) lrk = (int)__builtin_amdgcn_mbcnt_hi((unsigned)(m >> 32), __builtin_amdgcn_mbcnt_lo((unsigned)m, 0u)); if (F.lane == e) cm = pc; }
            if (F.lane < NE) CW[F.wave * 32 + F.lane] = cm; }
        __syncthreads();
        if (F.wave < 2) { const int a = F.tid; const int brank = (int)RUN[my] + lrk + (F.wave == 1 ? (int)CW[my] : 0); TR[((size_t)r0 + (a >> 2)) * 4 + (a & 3)] = brank; }
        __syncthreads();
        if (F.tid < NE) RUN[F.tid] += CW[F.tid] + CW[32 + F.tid];
    }
    VM_WAIT(); __syncthreads();
    if (F.tid < NE) { const unsigned cnt = RUN[F.tid]; unsigned base = 0;
        if (cnt) base = __hip_atomic_fetch_add(F.ctl + CW_CNT + (real ? layer : NLAYER) * NE + F.tid, cnt, RLX_AGENT);
        F.MISC[MW_LBASE + F.tid] = base; }
    __syncthreads();
    if (real) for (int n = 0; n < ncnt; ++n) { const int r0 = RT_TILE(n) * 32;
        if (F.tid < 128) { const size_t idx = ((size_t)r0 + (F.tid >> 2)) * 4 + (F.tid & 3); const int e = TE[idx]; const int rank = TR[idx] + (int)F.MISC[MW_LBASE + e]; TR[idx] = rank; ROWTOK[(size_t)e * MT + rank] = r0 + (F.tid >> 2); } }
    __syncthreads();
#undef RT_LOADX
#undef RT_TILE
}

__device__ __forceinline__ void normrope16(float (&x)[16], const float* gain, bool lat, int prow, int pcol, const LAS f32x2* T, int L, float oscale, int lane) {
    float ss = 0.f;
#pragma unroll
    for (int i = 0; i < 16; ++i) ss += x[i] * x[i];
    ss += shx(ss, 1, lane); ss += shx(ss, 2, lane); ss += shx(ss, 4, lane);
    const float rstd = 1.0f / sqrtf(ss * (1.0f / 128.0f) + EPS);
    const int o = (L & 7) * 16;
#pragma unroll
    for (int i = 0; i < 16; ++i) x[i] = x[i] * rstd * gain[o + i];
    float p[16];
#pragma unroll
    for (int i = 0; i < 16; ++i) p[i] = shx(x[i], 2, lane);
    if (lat) {
        const int pos = (L & 4) ? pcol : prow; const float sgn = (L & 2) ? 1.0f : -1.0f; const LAS f32x2* t = T + pos * 32 + (L & 1) * 16;
#pragma unroll
        for (int i = 0; i < 16; ++i) { const f32x2 cs = t[i]; x[i] = x[i] * cs.x + sgn * p[i] * cs.y; }
    }
#pragma unroll
    for (int i = 0; i < 16; ++i) x[i] *= oscale;
}
__device__ __forceinline__ void qkprep_phase(Frame& F, int j) {
    LAS f32x2* T = (LAS f32x2*)F.lds;
    __syncthreads();
    for (int i = F.tid; i < 128 * 32; i += NTHREADS) { const int pos = i >> 5, f = i & 31; const float inv = powf(10000.0f, -(float)f / 32.0f); const float ang = (float)pos * inv; float s, c; sincosf(ang, &s, &c); T[i] = (f32x2){c, s}; }
    __syncthreads();
    const bf16* P = (const bf16*)(F.ws + WS_P); unsigned char* Q8 = (unsigned char*)(F.ws + WS_QB); unsigned char* K8 = (unsigned char*)(F.ws + WS_QB + WS_K8_OFF); unsigned char* VT8 = (unsigned char*)(F.ws + WS_KVB);
    const float* qg = PIN(F, I_AQG) + j * 128; const float* kg = PIN(F, I_AKG) + j * 128;
    if (F.bx == 0 && F.tid == 0) { float qm = 0.f, km = 0.f; for (int i = 0; i < 128; ++i) { qm = fmaxf(qm, fabsf(qg[i])); km = fmaxf(km, fabsf(kg[i])); }
        const float sig = att::SCALE * 1.4426950408889634f * 11.3137085f * qm * km;
        ((float*)(F.ws + WS_RC))[2048 + j] = -fminf(-2.0f, 8.0f - 7.0f * sig); }
    const int gw = F.bx * NWAVES + F.wave, NGW = F.G * NWAVES, L = F.lane;
    v4u nqa, nqc, nka, nkc;
#define QK_LOAD(r_) do { const bf16* pr_ = P + (size_t)(r_) * 1536; nqa = *(const v4u*)(pr_ + 16 * L); nqc = *(const v4u*)(pr_ + 16 * L + 8); nka = *(const v4u*)(pr_ + 1024 + 16 * (L & 15)); nkc = *(const v4u*)(pr_ + 1024 + 16 * (L & 15) + 8); } while (0)
    if (gw < MT) QK_LOAD(gw);
    for (int r = gw; r < MT; r += NGW) {
        const v4u qa_ = nqa, qc_ = nqc, ka_ = nka, kc_ = nkc;
        if (r + NGW < MT) QK_LOAD(r + NGW);
        const bool lat = r < ML; const int b = lat ? (r >> 13) : ((r - ML) >> 8); const int s = lat ? (r & (SEQ - 1)) : ((r - ML) & (CL - 1));
        const int prow = s >> 6, pcol = s & 63; const size_t kvrow = (size_t)b * SKV + (lat ? s : SEQ + s);
        { const v4u a = qa_, c = qc_; float x[16];
          x[0] = bflo(a.x); x[1] = bfhi(a.x); x[2] = bflo(a.y); x[3] = bfhi(a.y); x[4] = bflo(a.z); x[5] = bfhi(a.z); x[6] = bflo(a.w); x[7] = bfhi(a.w);
          x[8] = bflo(c.x); x[9] = bfhi(c.x); x[10] = bflo(c.y); x[11] = bfhi(c.y); x[12] = bflo(c.z); x[13] = bfhi(c.z); x[14] = bflo(c.w); x[15] = bfhi(c.w);
          normrope16(x, qg, lat, prow, pcol, T, L, att::SCALE * 1.4426950408889634f * 8.0f, L);
          v4u o;
#pragma unroll
          for (int w4 = 0; w4 < 4; ++w4) { unsigned w = 0; w = __builtin_amdgcn_cvt_pk_fp8_f32(x[4 * w4], x[4 * w4 + 1], w, false); w = __builtin_amdgcn_cvt_pk_fp8_f32(x[4 * w4 + 2], x[4 * w4 + 3], w, true); o[w4] = w; }
          *(v4u*)(Q8 + (size_t)r * D + 16 * L) = o; }
        { const int Lk = L & 15; const v4u a = ka_, c = kc_; float x[16];
          x[0] = bflo(a.x); x[1] = bfhi(a.x); x[2] = bflo(a.y); x[3] = bfhi(a.y); x[4] = bflo(a.z); x[5] = bfhi(a.z); x[6] = bflo(a.w); x[7] = bfhi(a.w);
          x[8] = bflo(c.x); x[9] = bfhi(c.x); x[10] = bflo(c.y); x[11] = bfhi(c.y); x[12] = bflo(c.z); x[13] = bfhi(c.z); x[14] = bflo(c.w); x[15] = bfhi(c.w);
          normrope16(x, kg, lat, prow, pcol, T, Lk, 1.0f, L);
          if (L < 16) { v4u o;
#pragma unroll
            for (int w4 = 0; w4 < 4; ++w4) { unsigned w = 0; w = __builtin_amdgcn_cvt_pk_fp8_f32(x[4 * w4], x[4 * w4 + 1], w, false); w = __builtin_amdgcn_cvt_pk_fp8_f32(x[4 * w4 + 2], x[4 * w4 + 3], w, true); o[w4] = w; }
            *(v4u*)(K8 + kvrow * 256 + 16 * L) = o; }
        }
    }
#undef QK_LOAD
    LAS unsigned char* Tt = F.lds + 32768;
    for (int tile = F.bx; tile < NB * (SKV / 64); tile += F.G) {
        const int b = tile / (SKV / 64), kb = tile % (SKV / 64), ki = F.tid >> 3, seg = F.tid & 7, pos = kb * 64 + ki;
        const size_t r = pos < SEQ ? (size_t)b * SEQ + pos : (size_t)ML + (size_t)b * CL + (pos - SEQ);
        const int k5 = ki & 31, slot = 32 * ((k5 >> 2) & 1) + ((k5 & 3) | ((k5 >> 3) << 2)) + (ki >= 32 ? 16 : 0);
        const v4u* src = (const v4u*)(P + r * 1536 + 1280 + 32 * seg);
        __syncthreads();
#pragma unroll
        for (int q = 0; q < 4; ++q) { const v4u w = src[q]; const unsigned ww[4] = {w.x, w.y, w.z, w.w};
#pragma unroll
            for (int e2 = 0; e2 < 4; ++e2) { const unsigned pk = __builtin_amdgcn_cvt_pk_fp8_f32(bflo(ww[e2]), bfhi(ww[e2]), 0u, false); const int dd = 32 * seg + 8 * q + 2 * e2;
                Tt[dd * 64 + slot] = (unsigned char)(pk & 0xff); Tt[(dd + 1) * 64 + slot] = (unsigned char)((pk >> 8) & 0xff); } }
        __syncthreads();
        { const int rho = F.tid >> 1, half = F.tid & 1; const v4u a = *(const LAS v4u*)(Tt + rho * 64 + 32 * half), c = *(const LAS v4u*)(Tt + rho * 64 + 32 * half + 16);
          unsigned char* dst = VT8 + ((size_t)(b * 2 + (rho >> 7)) * 128 + (rho & 127)) * SKV + kb * 64 + 32 * half;
          *(v4u*)dst = a; *(v4u*)(dst + 16) = c; }
    }
    __syncthreads();
}
template <int XV = 0>
__device__ __forceinline__ void attention_phase(Frame& F, char* lds_generic, bool ctx_queries, int j) {
    const float nb = -((const float*)(F.ws + WS_RC))[2048 + j] - 8.0f;
    const unsigned char* Q8 = (const unsigned char*)(F.ws + WS_QB); const unsigned char* K8 = (const unsigned char*)(F.ws + WS_QB + WS_K8_OFF); const unsigned char* VT8 = (const unsigned char*)(F.ws + WS_KVB); bf16* Y = (bf16*)(F.ws + WS_Y);
    const int nunits = 2048 + (ctx_queries ? 64 : 0);
    for (int u = F.bx; u < nunits; u += F.G) {
        if (u < 2048) { const int b = u >> 8, w = u & 255, h = w & 7, qb = w >> 3; const size_t qo = ((size_t)b * SEQ + (size_t)qb * 256) * D + h * 128;
            att::attn_dense_body<XV>(Q8 + qo, K8 + (size_t)b * SKV * 256 + (h >> 2) * 128, VT8 + (size_t)(b * 2 + (h >> 2)) * 128 * SKV, SKV, Y + qo, SKV, lds_generic, F.wave, nb); }
        else { const int w = u - 2048, b = w >> 3, h = w & 7; const size_t qo = ((size_t)ML + (size_t)b * CL) * D + h * 128;
            att::attn_dense_body<XV>(Q8 + qo, K8 + ((size_t)b * SKV + SEQ) * 256 + (h >> 2) * 128, VT8 + (size_t)(b * 2 + (h >> 2)) * 128 * SKV + SEQ, SKV, Y + qo, CL, lds_generic, F.wave, nb); }
    }
}

__device__ __forceinline__ void gmlp_mix_phase(Frame& F) {
    constexpr int LDA = 136, LDO = 132;
    LAS bf16* As = (LAS bf16*)F.lds;
    LAS bf16* Vt = (LAS bf16*)(F.lds + 128 * LDA * 2);
    LAS float* rs = (LAS float*)(F.lds + 2 * 128 * LDA * 2);
    LAS float* Ot = (LAS float*)(F.lds + 2 * 128 * LDA * 2 + 512);
    const bf16* P = (const bf16*)(F.ws + WS_P); bf16* Y = (bf16*)(F.ws + WS_Y); const float* SS = (const float*)(F.ws + WS_SS);
    const float* ws = PIN(F, I_GWS); const float* bs = PIN(F, I_GBS); const float* vg = PIN(F, I_GVG);
    const int r32 = F.lane & 31, hi = F.lane >> 5;
    constexpr int NU = (MT / 128) * 8;
    struct GIn { f32x4 s; v4u v[4], uu[4]; } ga, gb; int gcur = -1;
#define GM_LOAD(u_, IN) do { const int g_ = (u_) & 7; const size_t row0_ = (size_t)((u_) >> 3) * 128; \
        IN.s = *(const f32x4*)(SS + (row0_ + (F.tid >> 2)) * 16 + (F.tid & 3) * 4);                                       \
        _Pragma("unroll") for (int k = 0; k < 4; ++k) { const int i_ = F.tid + NTHREADS * k, q_ = i_ >> 4, c8_ = (i_ & 15) * 8; const bf16* pp_ = P + (row0_ + q_) * 2048 + g_ * 128 + c8_; \
            IN.v[k] = *(const v4u*)(pp_ + 1024); IN.uu[k] = *(const v4u*)pp_; } } while (0)
#define GM_UNIT(u_, IN) do { \
        const int chunk = (u_) >> 3, g = (u_) & 7; const size_t row0 = (size_t)chunk * 128; \
        __syncthreads(); \
        if (g != gcur) { gcur = g; \
            for (int i = F.tid; i < 128 * 32; i += NTHREADS) { const int p = i >> 5, q4 = (i & 31) * 4; const f32x4 w = *(const f32x4*)(ws + ((size_t)g * 128 + p) * 128 + q4); \
                v2u o; o.x = pk2(w.x, w.y); o.y = pk2(w.z, w.w); *(LAS v2u*)(As + p * LDA + q4) = o; } } \
        { float s = (IN.s.x + IN.s.y) + (IN.s.z + IN.s.w); s += shx(s, 1, F.lane); s += shx(s, 2, F.lane); if ((F.tid & 3) == 0) rs[F.tid >> 2] = 1.0f / sqrtf(s * (1.0f / 1024.0f) + EPS); } \
        __syncthreads(); \
        _Pragma("unroll") for (int k = 0; k < 4; ++k) { const int i = F.tid + NTHREADS * k, q = i >> 4, c8 = (i & 15) * 8; const float rq = rs[q]; const unsigned ww[4] = {IN.v[k].x, IN.v[k].y, IN.v[k].z, IN.v[k].w}; \
            _Pragma("unroll") for (int e2 = 0; e2 < 4; ++e2) { const unsigned pk = cvt_pk_bf16(bflo(ww[e2]) * rq, bfhi(ww[e2]) * rq); Vt[(c8 + 2 * e2) * LDA + q] = (bf16)(pk & 0xffff); Vt[(c8 + 2 * e2 + 1) * LDA + q] = (bf16)(pk >> 16); } } \
        __syncthreads(); \
        const int p0 = (F.wave >> 1) * 32, cbase = (F.wave & 1) * 64; \
        f32x16 acc0 = {}, acc1 = {}; \
        _Pragma("unroll") for (int ks = 0; ks < 8; ++ks) { const int k0 = ks * 16 + hi * 8; \
            const bf16x8 a = *(const LAS bf16x8*)(As + (p0 + r32) * LDA + k0); \
            const bf16x8 b0 = *(const LAS bf16x8*)(Vt + (cbase + r32) * LDA + k0), b1 = *(const LAS bf16x8*)(Vt + (cbase + 32 + r32) * LDA + k0); \
            acc0 = __builtin_amdgcn_mfma_f32_32x32x16_bf16(a, b0, acc0, 0, 0, 0); acc1 = __builtin_amdgcn_mfma_f32_32x32x16_bf16(a, b1, acc1, 0, 0, 0); } \
        _Pragma("unroll") for (int t = 0; t < 2; ++t) { const int cl = cbase + t * 32 + r32; const float gain = vg[g * 128 + cl]; \
            _Pragma("unroll") for (int reg = 0; reg < 16; ++reg) { const int p = p0 + (reg & 3) + 8 * (reg >> 2) + 4 * hi; Ot[p * LDO + cl] = gain * (t == 0 ? acc0[reg] : acc1[reg]) + bs[g * 128 + p]; } } \
        __syncthreads(); \
        _Pragma("unroll") for (int k = 0; k < 4; ++k) { const int i = F.tid + NTHREADS * k, p = i >> 4, c8 = (i & 15) * 8; const v4u uw = IN.uu[k]; \
            const LAS float* o = Ot + p * LDO + c8; const f32x4 m0 = *(const LAS f32x4*)o, m1 = *(const LAS f32x4*)(o + 4); \
            v4u w; w.x = cvt_pk_bf16(bflo(uw.x) * m0.x, bfhi(uw.x) * m0.y); w.y = cvt_pk_bf16(bflo(uw.y) * m0.z, bfhi(uw.y) * m0.w); \
            w.z = cvt_pk_bf16(bflo(uw.z) * m1.x, bfhi(uw.z) * m1.y); w.w = cvt_pk_bf16(bflo(uw.w) * m1.z, bfhi(uw.w) * m1.w); \
            *(v4u*)(Y + (row0 + p) * D + g * 128 + c8) = w; } } while (0)
    int u = F.bx;
    if (u < NU) GM_LOAD(u, ga);
    for (; u < NU; u += 2 * F.G) {
        if (u + F.G < NU) GM_LOAD(u + F.G, gb);
        GM_UNIT(u, ga);
        if (u + F.G >= NU) break;
        if (u + 2 * F.G < NU) GM_LOAD(u + 2 * F.G, ga);
        GM_UNIT(u + F.G, gb);
    }
    __syncthreads();
#undef GM_LOAD
#undef GM_UNIT
}

__device__ __forceinline__ void hyena_prep_phase(Frame& F) {
    LAS float* tl = (LAS float*)F.lds;
    const bf16* P = (const bf16*)(F.ws + WS_P); bf16* X0 = (bf16*)(F.ws + WS_X0); bf16* VG = (bf16*)(F.ws + WS_VG);
    float* VT = (float*)(F.ws + WS_VT); float* VTC = (float*)(F.ws + WS_VTC);
    const float* cw = PIN(F, I_HCW); const float* cb = PIN(F, I_HCB);
    const int tt = F.tid >> 3, cg = F.tid & 7;
    constexpr int NU = (MT / 64) * 16;
    v4u pa[3][3], pb[3][3];
#define HP_LOAD(u_, IN) do { const int tb_ = (u_) >> 4, c0_ = ((u_) & 15) * 64, r0_ = tb_ * 64; const bool lat_ = r0_ < ML; \
        const int s_ = (lat_ ? (r0_ & (SEQ - 1)) : ((r0_ - ML) & (CL - 1))) + tt, L_ = lat_ ? SEQ : CL; const bf16* pr_ = P + (size_t)(r0_ + tt) * 3072 + c0_ + cg * 8; const v4u z0_ = {0u, 0u, 0u, 0u}; \
        _Pragma("unroll") for (int seg = 0; seg < 3; ++seg) { IN[seg][0] = s_ > 0 ? *(const v4u*)(pr_ + seg * 1024 - 3072) : z0_; IN[seg][1] = *(const v4u*)(pr_ + seg * 1024); \
            IN[seg][2] = s_ < L_ - 1 ? *(const v4u*)(pr_ + seg * 1024 + 3072) : z0_; } } while (0)
    LAS float* wl = tl + 64 * 65; int c0w = -1;
#define HP_UNIT(u_, IN) do { \
        const int tb = (u_) >> 4, c0 = ((u_) & 15) * 64; const int r0 = tb * 64; const bool lat = r0 < ML; \
        const int b = lat ? (r0 >> 13) : ((r0 - ML) >> 8), s0 = lat ? (r0 & (SEQ - 1)) : ((r0 - ML) & (CL - 1)); \
        const int r = r0 + tt, c = c0 + cg * 8; \
        if (c0 != c0w) { c0w = c0; __syncthreads(); \
            for (int i = F.tid; i < 768; i += NTHREADS) { const int seg = i >> 8, k = (i >> 6) & 3, ch = i & 63; wl[i] = k < 3 ? cw[k * 3072 + seg * 1024 + c0 + ch] : cb[seg * 1024 + c0 + ch]; } \
            __syncthreads(); } \
        float o[3][8]; \
        _Pragma("unroll") for (int seg = 0; seg < 3; ++seg) { \
            const unsigned pmw[4] = {IN[seg][0].x, IN[seg][0].y, IN[seg][0].z, IN[seg][0].w}, pcw[4] = {IN[seg][1].x, IN[seg][1].y, IN[seg][1].z, IN[seg][1].w}, pnw[4] = {IN[seg][2].x, IN[seg][2].y, IN[seg][2].z, IN[seg][2].w}; \
            _Pragma("unroll") for (int i = 0; i < 8; ++i) { const float xm = (i & 1) ? bfhi(pmw[i >> 1]) : bflo(pmw[i >> 1]), xc = (i & 1) ? bfhi(pcw[i >> 1]) : bflo(pcw[i >> 1]), xn = (i & 1) ? bfhi(pnw[i >> 1]) : bflo(pnw[i >> 1]); \
                const LAS float* wp = wl + seg * 256 + cg * 8 + i; o[seg][i] = xm * wp[0] + xc * wp[64] + xn * wp[128] + wp[192]; } } \
        float vgv[8]; \
        _Pragma("unroll") for (int i = 0; i < 8; ++i) vgv[i] = o[2][i] * o[1][i]; \
        v4u w; w.x = cvt_pk_bf16(o[0][0], o[0][1]); w.y = cvt_pk_bf16(o[0][2], o[0][3]); w.z = cvt_pk_bf16(o[0][4], o[0][5]); w.w = cvt_pk_bf16(o[0][6], o[0][7]); \
        *(v4u*)(X0 + (size_t)r * D + c) = w; \
        w.x = cvt_pk_bf16(vgv[0], vgv[1]); w.y = cvt_pk_bf16(vgv[2], vgv[3]); w.z = cvt_pk_bf16(vgv[4], vgv[5]); w.w = cvt_pk_bf16(vgv[6], vgv[7]); \
        *(v4u*)(VG + (size_t)r * D + c) = w; \
        __syncthreads(); \
        _Pragma("unroll") for (int i = 0; i < 8; ++i) tl[(cg * 8 + i) * 65 + tt] = vgv[i]; \
        __syncthreads(); \
        { const int cc = F.tid >> 3, ts = (F.tid & 7) * 8; const LAS float* sp = tl + cc * 65 + ts; \
          if (lat) *(v4u*)((bf16*)VT + ((size_t)b * 1024 + c0 + cc) * SEQ + s0 + ts) = (v4u){cvt_pk_bf16(sp[0], sp[1]), cvt_pk_bf16(sp[2], sp[3]), cvt_pk_bf16(sp[4], sp[5]), cvt_pk_bf16(sp[6], sp[7])};        \
          else { float* dst = VTC + ((size_t)b * 1024 + c0 + cc) * CL + s0 + ts; *(f32x4*)dst = (f32x4){sp[0], sp[1], sp[2], sp[3]}; *(f32x4*)(dst + 4) = (f32x4){sp[4], sp[5], sp[6], sp[7]}; } } } while (0)
    int u = F.bx;
    if (u < NU) HP_LOAD(u, pa);
    for (; u < NU; u += 2 * F.G) {
        if (u + F.G < NU) HP_LOAD(u + F.G, pb);
        HP_UNIT(u, pa);
        if (u + F.G >= NU) break;
        if (u + 2 * F.G < NU) HP_LOAD(u + 2 * F.G, pa);
        HP_UNIT(u + F.G, pb);
    }
    __syncthreads();
#undef HP_LOAD
#undef HP_UNIT
}
__device__ __forceinline__ void hyena_post_phase(Frame& F) {
    LAS float* tl = (LAS float*)F.lds;
    const bf16* X0 = (const bf16*)(F.ws + WS_X0); const bf16* VG = (const bf16*)(F.ws + WS_VG); bf16* Y = (bf16*)(F.ws + WS_Y);
    const float* VT = (const float*)(F.ws + WS_CT); const float* VTC = (const float*)(F.ws + WS_CTC); const float* dsk = PIN(F, I_HD);
    const int tt = F.tid >> 3, cg = F.tid & 7;
    constexpr int NU = (MT / 64) * 16;
    struct PIn { f32x4 a, bq; v4u cw, x0, vv; } qa, qb;
#define HQ_LOAD(u_, IN) do { const int tb_ = (u_) >> 4, c0_ = ((u_) & 15) * 64, r0_ = tb_ * 64; const bool lat_ = r0_ < ML; \
        const int b_ = lat_ ? (r0_ >> 13) : ((r0_ - ML) >> 8), s0_ = lat_ ? (r0_ & (SEQ - 1)) : ((r0_ - ML) & (CL - 1)); const int cc_ = F.tid >> 3, ts_ = (F.tid & 7) * 8; \
        if (lat_) IN.cw = *(const v4u*)((const bf16*)VT + ((size_t)b_ * 1024 + c0_ + cc_) * SEQ + s0_ + ts_);        \
        else { const float* src_ = VTC + ((size_t)b_ * 1024 + c0_ + cc_) * CL + s0_ + ts_; IN.a = *(const f32x4*)src_; IN.bq = *(const f32x4*)(src_ + 4); } \
        IN.x0 = *(const v4u*)(X0 + (size_t)(r0_ + tt) * D + c0_ + cg * 8); IN.vv = *(const v4u*)(VG + (size_t)(r0_ + tt) * D + c0_ + cg * 8); } while (0)
#define HQ_UNIT(u_, IN) do { \
        const int tb = (u_) >> 4, c0 = ((u_) & 15) * 64; const int r0 = tb * 64; \
        __syncthreads(); \
        { const int cc = F.tid >> 3, ts = (F.tid & 7) * 8; LAS float* dp = tl + cc * 65 + ts; \
          if (r0 < ML) { dp[0] = bflo(IN.cw.x); dp[1] = bfhi(IN.cw.x); dp[2] = bflo(IN.cw.y); dp[3] = bfhi(IN.cw.y); dp[4] = bflo(IN.cw.z); dp[5] = bfhi(IN.cw.z); dp[6] = bflo(IN.cw.w); dp[7] = bfhi(IN.cw.w); } \
          else { dp[0] = IN.a.x; dp[1] = IN.a.y; dp[2] = IN.a.z; dp[3] = IN.a.w; dp[4] = IN.bq.x; dp[5] = IN.bq.y; dp[6] = IN.bq.z; dp[7] = IN.bq.w; } } \
        __syncthreads(); \
        const int r = r0 + tt, c = c0 + cg * 8; \
        const f32x4 da = *(const f32x4*)(dsk + c), db = *(const f32x4*)(dsk + c + 4); \
        const unsigned x0w[4] = {IN.x0.x, IN.x0.y, IN.x0.z, IN.x0.w}, vw[4] = {IN.vv.x, IN.vv.y, IN.vv.z, IN.vv.w}; float y[8]; \
        _Pragma("unroll") for (int i = 0; i < 8; ++i) { const float xx = (i & 1) ? bfhi(x0w[i >> 1]) : bflo(x0w[i >> 1]), vx = (i & 1) ? bfhi(vw[i >> 1]) : bflo(vw[i >> 1]); const float di = i < 4 ? da[i & 3] : db[i & 3]; \
            y[i] = (tl[(cg * 8 + i) * 65 + tt] + vx * di) * xx; } \
        v4u w; w.x = cvt_pk_bf16(y[0], y[1]); w.y = cvt_pk_bf16(y[2], y[3]); w.z = cvt_pk_bf16(y[4], y[5]); w.w = cvt_pk_bf16(y[6], y[7]); \
        *(v4u*)(Y + (size_t)r * D + c) = w; } while (0)
    int u = F.bx;
    if (u < NU) HQ_LOAD(u, qa);
    for (; u < NU; u += 2 * F.G) {
        if (u + F.G < NU) HQ_LOAD(u + F.G, qb);
        HQ_UNIT(u, qa);
        if (u + F.G >= NU) break;
        if (u + 2 * F.G < NU) HQ_LOAD(u + 2 * F.G, qa);
        HQ_UNIT(u + F.G, qb);
    }
    __syncthreads();
#undef HQ_LOAD
#undef HQ_UNIT
}
__device__ __forceinline__ bool phase_nonempty(int ph) {
    if (ph < PH_L0 || ph >= PH_FINAL) return true;
    const int layer = (ph - PH_L0) / PH_PER_LAYER, lp = (ph - PH_L0) % PH_PER_LAYER, kind = layer % 3;
    if (lp == LP_MIX2) return kind != 1;
    if (lp == LP_MIX3) return kind == 2;
    return true;
}
__global__ void __launch_bounds__(NTHREADS, 2) mk_fwd(Args args) {
    extern __shared__ __attribute__((aligned(16))) unsigned char lds[];
    Frame F0;
    F0.lds = (LAS unsigned char*)lds; F0.MISC = (volatile LAS unsigned*)(F0.lds + MISC_OFF);
    F0.tid = threadIdx.x; F0.lane = F0.tid & 63; F0.wave = __builtin_amdgcn_readfirstlane(F0.tid >> 6);
    F0.G = gridDim.x; F0.bx = blockIdx.x; F0.out = args.out; F0.ws = args.ws; F0.ctl = (gu32*)(args.ws + WS_CTL);
    for (int u = F0.tid; u < MISC_BYTES / 4; u += NTHREADS) F0.MISC[u] = 0u;
    __syncthreads();
    if (F0.tid < 36) { const unsigned long long p = (unsigned long long)args.in[F0.tid]; F0.MISC[MW_PTRS + 2 * F0.tid] = (unsigned)p; F0.MISC[MW_PTRS + 2 * F0.tid + 1] = (unsigned)(p >> 32); }
    __syncthreads();
    const int lo = args.ph_lo, hi = args.ph_hi;
    const bool multi = (hi - lo) > 1;
    XcdBarrier bar; bar.bar = (unsigned*)(F0.ctl + CW_BAR); bar.x = 0; bar.st = nullptr; bar.w = F0.wave;
    if (multi) bar = xcd_barrier_post((unsigned*)(F0.ctl + CW_BAR), F0.MISC + 8, F0.wave);
#ifndef PHMASK
#define PHMASK 0xFFFF
#endif
#define EN(b) ((PHMASK >> (b)) & 1)
#ifndef MK_STAG_IN
#define MK_STAG_IN 0u
#define MK_STAG_OUT 0u
#define MK_STAG_M1 0u
#define MK_STAG_M2 0u
#endif
#ifndef KMASK
#define KMASK 7
#endif
#define KEN(b) ((KMASK >> (b)) & 1)
#define IN(k) (lo <= (k) && (k) < hi)
#define SEAM(k) do { if ((k) + 1 < hi) xcd_barrier(bar); } while (0)
#define PB(id) for (int _rep = 0, _n = ((id) == MK_REPEAT ? MK_NREP : 1); _rep < _n; ++_rep) {
#define PE(id) if (_rep + 1 < _n) xcd_barrier(bar); } SEAM(id);

    if (EN(0) && IN(PH_PRO0)) { PB(PH_PRO0) Frame F = phase_frame(F0); pro0_mod(F); __syncthreads(); pro0_transposes(F); pro0_filter_mlp(F); PE(PH_PRO0) }
    if (EN(1) && IN(PH_PRO1)) { PB(PH_PRO1) Frame F = phase_frame(F0); pro1_router_split(F); pro1_filters(F); PE(PH_PRO1) }

#pragma unroll 1
    for (int layer = 0; layer < NLAYER; ++layer) {
        const int kind = layer % 3, jj = layer / 3, pb = PH_L0 + layer * PH_PER_LAYER; const bool last = layer == NLAYER - 1;
        if (EN(2) && IN(pb + LP_NORM1)) { PB(pb + LP_NORM1) Frame F = phase_frame(F0); rowpass<0>(F, layer, _rep + 1 == _n, kind == 0); PE(pb + LP_NORM1) }
        if (EN(3) && IN(pb + LP_INPROJ)) { PB(pb + LP_INPROJ)
            Frame F = phase_frame(F0);
            if (kind == 0) {
                pg8::DenseSchedT<true> S; S.init(F.ws + WS_H8, F.ws + WS_WATT + (size_t)jj * 1536 * 1024, MT, 1536, F.G, F.bx, 1024);
                pg8::EpiBf16 E{(bf16*)(F.ws + WS_P), 1536, (float*)(F.ws + WS_SS), 0};
                pg8::gemm_phase<pg8::EpiBf16, pg8::DenseSchedT<true>, true, true>(F.lds, S, E, F.wave, false, MK_STAG_IN);
            } else {
                const int N = kind == 1 ? 2048 : 3072;
                pg8::DenseSched S; S.init(F.ws + WS_H, F.ws + (kind == 1 ? WS_WGM : WS_WHY), MT, N, F.G, F.bx);
                pg8::EpiBf16 E{(bf16*)(F.ws + WS_P), N, (float*)(F.ws + WS_SS), kind == 1 ? 1 : 0};
                pg8::gemm_phase<pg8::EpiBf16, pg8::DenseSched, false>(F.lds, S, E, F.wave, false, MK_STAG_IN);
            }
            PE(pb + LP_INPROJ)
        }
        if (IN(pb + LP_MIX1)) { PB(pb + LP_MIX1)
            Frame F = phase_frame(F0);
            if (EN(4) && kind == 0) qkprep_phase(F, jj); else if (EN(5) && kind == 1) gmlp_mix_phase(F); else if (EN(6)) hyena_prep_phase(F);
            PE(pb + LP_MIX1)
        }
        if (IN(pb + LP_MIX2) && kind != 1) { PB(pb + LP_MIX2)
            Frame F = phase_frame(F0);
            if (EN(7) && kind == 0) {
#if MK_XP >= 10 && MK_XP < 20
                if (_rep + 1 < _n) attention_phase<MK_XP - 10>(F, (char*)lds, !last, jj); else
#endif
                attention_phase<0>(F, (char*)lds, !last, jj); }
            else if (EN(8)) hyena_conv_phase(F);
            PE(pb + LP_MIX2)
        }
        if (EN(9) && IN(pb + LP_MIX3) && kind == 2) { PB(pb + LP_MIX3) Frame F = phase_frame(F0); hyena_post_phase(F); PE(pb + LP_MIX3) }
        if (EN(10) && IN(pb + LP_OUTPROJ)) { PB(pb + LP_OUTPROJ)
            Frame F = phase_frame(F0); const float* modl = (const float*)(F.ws + WS_MOD) + (size_t)layer * 9 * 6144;
            pg8::DenseSched S; S.init(F.ws + WS_Y, F.ws + WS_WOUT + (size_t)layer * 1024 * 1024 * 2, last ? ML : MT, 1024, F.G, F.bx);
            pg8::EpiResid E{(bf16*)(F.ws + WS_XB), modl};
            pg8::gemm_phase<pg8::EpiResid, pg8::DenseSched, false>(F.lds, S, E, F.wave, false, MK_STAG_OUT);
            PE(pb + LP_OUTPROJ)
        }
        if (EN(11) && IN(pb + LP_NORM2)) { PB(pb + LP_NORM2) Frame F = phase_frame(F0); router_phase(F, layer, _rep + 1 == _n, (_rep + 1 < _n) ? MK_XP : 0); PE(pb + LP_NORM2) }
        if (EN(12) && IN(pb + LP_MOE1)) { PB(pb + LP_MOE1)
            Frame F = phase_frame(F0);
            moe_tables(F, layer);
            pg8::MoeSched S{(const char*)(F.ws + WS_H8), (const char*)(F.ws + WS_WE1) + (size_t)layer * NE * 2048 * 1024, (size_t)2048 * 1024, (const int*)(F.ws + WS_ROWTOK),
                            (const volatile LAS int*)(F.MISC + MW_CUMBLK), (const volatile LAS int*)(F.MISC + MW_CNT), 3, F.G, F.bx, 1024, (const volatile LAS int*)(F.lds + AUX_OFF + 1024)};
            S.build_list((volatile LAS int*)(F.lds + AUX_OFF + 1024), F.tid); __syncthreads();
            pg8::EpiSwiglu E{(unsigned char*)(F.ws + WS_ACT), PIN(F, I_EB1) + (size_t)layer * NE * 2048, (LAS float*)(F.lds + AUX_OFF)};
#if MK_XP >= 20
            if (_rep + 1 < _n) { int one_ = 1; asm volatile("" : "+s"(one_)); pg8::gemm_phase<pg8::EpiSwiglu, pg8::MoeSched, true, true, MK_XP - 20>(F.lds, S, E, F.wave, one_ != 0, MK_STAG_M1); } else
#endif
            pg8::gemm_phase<pg8::EpiSwiglu, pg8::MoeSched, true, true>(F.lds, S, E, F.wave, MK_XP == 1 && _rep + 1 < _n, MK_STAG_M1);
            PE(pb + LP_MOE1)
        }
        if (EN(13) && IN(pb + LP_MOE2)) { PB(pb + LP_MOE2)
            Frame F = phase_frame(F0);
            moe_tables(F, layer);
            pg8::MoeSched S{(const char*)(F.ws + WS_ACT), (const char*)(F.ws + WS_WE2) + (size_t)layer * NE * 1024 * 1024, (size_t)1024 * 1024, nullptr,
                            (const volatile LAS int*)(F.MISC + MW_CUMBLK), (const volatile LAS int*)(F.MISC + MW_CNT), 2, F.G, F.bx, 1024, (const volatile LAS int*)(F.lds + AUX_OFF + 1024)};
            S.build_list((volatile LAS int*)(F.lds + AUX_OFF + 1024), F.tid); __syncthreads();
            pg8::EpiBias E{(unsigned char*)(F.ws + WS_YM), PIN(F, I_EB2) + (size_t)layer * NE * 1024, (LAS float*)(F.lds + AUX_OFF)};
            pg8::gemm_phase<pg8::EpiBias, pg8::MoeSched, true, true>(F.lds, S, E, F.wave, MK_XP == 1 && _rep + 1 < _n, MK_STAG_M2);
            PE(pb + LP_MOE2)
        }
    }
    if (EN(14) && IN(PH_FINAL)) { PB(PH_FINAL) Frame F = phase_frame(F0); rowpass<2>(F, NLAYER - 1, _rep + 1 == _n); PE(PH_FINAL) }
#undef IN
#undef SEAM
}

static bool host_phase_nonempty(int ph) {
    if (ph < PH_L0 || ph >= PH_FINAL) return true;
    const int layer = (ph - PH_L0) / PH_PER_LAYER, lp = (ph - PH_L0) % PH_PER_LAYER, kind = layer % 3;
    if (lp == LP_MIX2) return kind != 1;
    if (lp == LP_MIX3) return kind == 2;
    return true;
}
extern "C" void kernel_launch(void* const* d_in, const int* in_sizes, int n_in, void* d_out, int out_size, void* d_ws, size_t ws_size, hipStream_t stream) {
    static int grid = 0;
    if (grid == 0) {
        if (n_in != 36 || in_sizes[0] != ML * D || out_size != ML * D || ws_size < WS_END) {
            fprintf(stderr, "kernel_launch: built for 36 inputs, x/out of %d floats, >= %zu bytes of workspace; got n_in %d in0 %d out %d ws %zu; nothing launched\n", ML * D, (size_t)WS_END, n_in, n_in > 0 ? in_sizes[0] : -1, out_size, ws_size);
            grid = -1; return; }
        int dev = 0, cus = 0, per_cu = 0;
        if (hipGetDevice(&dev) != hipSuccess || hipDeviceGetAttribute(&cus, hipDeviceAttributeMultiprocessorCount, dev) != hipSuccess) { fprintf(stderr, "kernel_launch: device query failed\n"); grid = -1; return; }
        if (hipFuncSetAttribute((const void*)mk_fwd, hipFuncAttributeMaxDynamicSharedMemorySize, LDS_BYTES) != hipSuccess) { fprintf(stderr, "kernel_launch: hipFuncSetAttribute(%d B LDS) failed\n", LDS_BYTES); grid = -1; return; }
        if (hipOccupancyMaxActiveBlocksPerMultiprocessor(&per_cu, (const void*)mk_fwd, NTHREADS, LDS_BYTES) != hipSuccess || per_cu < 1)
            fprintf(stderr, "kernel_launch: note: occupancy query reports %d workgroups per CU\n", per_cu);
        (void)hipGetLastError();
        grid = cus;
    }
    if (grid < 0) return;
    if (hipMemsetAsync((char*)d_ws + WS_CTL, 0, CTL_ZERO_BYTES, stream) != hipSuccess) { fprintf(stderr, "kernel_launch: memset failed\n"); return; }
    Args a{};
    for (int i = 0; i < 36; ++i) a.in[i] = (const float*)d_in[i];
    a.out = (float*)d_out; a.ws = (unsigned char*)d_ws;
#if MK_MULTI || MK_DBG
    for (int ph = 0; ph < PH_COUNT; ++ph) {
        if (!host_phase_nonempty(ph)) continue;
        a.ph_lo = ph; a.ph_hi = ph + 1;
        hipLaunchKernelGGL(mk_fwd, dim3(grid), dim3(NTHREADS), LDS_BYTES, stream, a);
#if MK_DBG
        dbg_after_phase(ph, a, stream);
#endif
    }
#if MK_DBG
    dbg_report(a, stream);
#endif
#else
    a.ph_lo = 0; a.ph_hi = PH_COUNT;
    hipLaunchKernelGGL(mk_fwd, dim3(grid), dim3(NTHREADS), LDS_BYTES, stream, a);
#endif
    const hipError_t le = hipPeekAtLastError();
    if (le != hipSuccess) fprintf(stderr, "kernel_launch: launch failed: %s\n", hipGetErrorName(le));
}
```

```cpp
#include <hip/hip_runtime.h>
#include <cstdio>
#include <cstdint>
#include <cmath>

#ifndef MK_MULTI
#define MK_MULTI 0
#endif
#ifndef MK_REPEAT
#define MK_REPEAT -1
#endif
#ifndef MK_NREP
#define MK_NREP 1
#endif
#ifndef MK_XP
#define MK_XP 0
#endif
#ifndef MK_MOEMAP
#define MK_MOEMAP 0
#endif
#ifndef MK_DBG
#define MK_DBG 0
#endif

constexpr int D = 1024, NB = 8, SEQ = 8192, CL = 256, ML = NB * SEQ, MC = NB * CL, MT = ML + MC;
constexpr int NLAYER = 4, NE = 32, TOPK = 4, SKV = SEQ + CL;
constexpr int MOE_MAXBLK = (MT * TOPK) / 256 + NE;
constexpr float EPS = 1e-6f;
constexpr int FH = 64, FEMB = 33, NFFT = 16384;

constexpr size_t MiB = 1u << 20;
constexpr size_t WS_CTL = 0, CTL_ZERO_BYTES = 1 * MiB;
constexpr size_t WS_MOD = 1 * MiB;
constexpr size_t WS_A3 = 2 * MiB;
constexpr size_t WS_A3C = 4 * MiB;
constexpr size_t WS_RC = 4 * MiB + 512 * 1024;
constexpr size_t WS_FCT = 5 * MiB;
constexpr size_t WS_WATT = 8 * MiB;
constexpr size_t WS_WGM = 14 * MiB;
constexpr size_t WS_WHY = 18 * MiB;
constexpr size_t WS_WOUT = 24 * MiB;
constexpr size_t WS_RW3 = 32 * MiB;
constexpr size_t WS_TE = 40 * MiB;
constexpr size_t WS_TR = 42 * MiB;
constexpr size_t WS_TG = 44 * MiB;
constexpr size_t WS_SS = 46 * MiB;
constexpr size_t WS_ROWTOK = 52 * MiB;
constexpr size_t WS_KF = 64 * MiB;
constexpr size_t WS_WE1 = 192 * MiB;
constexpr size_t WS_WE2 = 704 * MiB;
constexpr size_t WS_H = 960 * MiB;
constexpr size_t WS_P = 1092 * MiB;
constexpr size_t WS_Y = 1488 * MiB;
constexpr size_t WS_QB = 1620 * MiB;
constexpr size_t WS_K8_OFF = 72 * MiB;
constexpr size_t WS_KVB = 1752 * MiB;
constexpr size_t WS_X0 = 1818 * MiB;
constexpr size_t WS_VG = 1950 * MiB;
constexpr size_t WS_VT = 2082 * MiB;
constexpr size_t WS_VTC = 2338 * MiB;
constexpr size_t WS_ACT = 2346 * MiB;
constexpr size_t WS_YM = 2890 * MiB;
constexpr size_t WS_CT = 3434 * MiB;
constexpr size_t WS_CTC = 3690 * MiB;
constexpr size_t WS_H8 = 3698 * MiB;
constexpr size_t WS_XB = 3764 * MiB;
constexpr size_t WS_END = 3896 * MiB;
constexpr int CW_BAR = 4096;
constexpr int CW_CNT = 16384;
constexpr int CW_DBG = 32768;

constexpr int RING_BYTES = 131072;
constexpr int AUX_OFF = RING_BYTES;
constexpr int AUX_BYTES = 16384;
constexpr int MISC_OFF = AUX_OFF + AUX_BYTES;
constexpr int MISC_BYTES = 4096;
constexpr int LDS_BYTES = MISC_OFF + MISC_BYTES;

#define GAS __attribute__((address_space(1)))
#define LAS __attribute__((address_space(3)))
typedef unsigned short bf16;
typedef unsigned v4u __attribute__((ext_vector_type(4)));
typedef unsigned v2u __attribute__((ext_vector_type(2)));
typedef float f32x4 __attribute__((ext_vector_type(4)));
typedef float f32x2 __attribute__((ext_vector_type(2)));
typedef float f32x16 __attribute__((ext_vector_type(16)));
typedef short bf16x8 __attribute__((ext_vector_type(8)));
typedef short s16x4 __attribute__((ext_vector_type(4)));
typedef int i32x4 __attribute__((ext_vector_type(4)));
typedef GAS unsigned gu32;
#define RLX_AGENT __ATOMIC_RELAXED, __HIP_MEMORY_SCOPE_AGENT
#define LDS_WAIT() asm volatile("s_waitcnt lgkmcnt(0)" ::: "memory")
#define VM_WAIT() asm volatile("s_waitcnt vmcnt(0)" ::: "memory")
__device__ __forceinline__ int opaque_tid(int wave) { int l; asm volatile("v_mbcnt_lo_u32_b32 %0, -1, 0\n\tv_mbcnt_hi_u32_b32 %0, -1, %0" : "=v"(l)); return (wave << 6) | l; }
__device__ __forceinline__ unsigned f2bf(float f) { unsigned u = __builtin_bit_cast(unsigned, f); return (u + 0x7fffu + ((u >> 16) & 1u)) >> 16; }
__device__ __forceinline__ unsigned pk2(float lo, float hi) { return f2bf(lo) | (f2bf(hi) << 16); }
__device__ __forceinline__ float bf2f(unsigned short b) { return __builtin_bit_cast(float, ((unsigned)b) << 16); }
__device__ __forceinline__ float bflo(unsigned w) { return __builtin_bit_cast(float, w << 16); }
__device__ __forceinline__ float bfhi(unsigned w) { return __builtin_bit_cast(float, w & 0xffff0000u); }
__device__ __forceinline__ f32x4 bf4_f32(v2u w) { return (f32x4){__uint_as_float(w.x << 16), __uint_as_float(w.x & 0xffff0000u), __uint_as_float(w.y << 16), __uint_as_float(w.y & 0xffff0000u)}; }
__device__ __forceinline__ unsigned cvt_pk_bf16(float lo, float hi) { unsigned r; asm volatile("v_cvt_pk_bf16_f32 %0, %1, %2" : "=v"(r) : "v"(lo), "v"(hi)); return r; }
__device__ __forceinline__ float shx(float v, int mask, int lane) { return __int_as_float(__builtin_amdgcn_ds_bpermute((lane ^ mask) << 2, __float_as_int(v))); }
__device__ __forceinline__ float wave_sum(float v, int lane) {
#pragma unroll
    for (int o = 1; o < 64; o <<= 1) v += shx(v, o, lane);
    return v;
}

#define XB_TMO      128
#define XB_XCNT(j)  (256  + 64 * (j))
#define XB_XSUB(j)  (1280 + 64 * (j))
#define XB_XGEN(j)  (2304 + 64 * (j))
#define XB_TOP      3328
#define XB_TOPGEN   3392
#define XCD_BAR_WORDS 3456
#define XB_SPIN_CAP (1u << 22)
__device__ __forceinline__ unsigned xb_ld(unsigned* p)              { return __hip_atomic_load(p, __ATOMIC_RELAXED, __HIP_MEMORY_SCOPE_AGENT); }
__device__ __forceinline__ unsigned xb_add(unsigned* p, unsigned v) { return __hip_atomic_fetch_add(p, v, __ATOMIC_RELAXED, __HIP_MEMORY_SCOPE_AGENT); }
__device__ __forceinline__ unsigned xb_xcc_id() { return (unsigned)__builtin_amdgcn_s_getreg((3 << 11) | 20) & 0xFu; }
#define XB_SPIN(cond, bar) do { unsigned _sp = 0; while (cond) { __builtin_amdgcn_s_sleep(1); \
    if ((++_sp & 255u) == 0u) { if (xb_ld(&(bar)[XB_TMO])) break; if (_sp > XB_SPIN_CAP) { atomicAdd(&(bar)[XB_TMO], 1u); break; } } } } while (0)
struct XcdBarrier { unsigned* bar; unsigned x; volatile LAS unsigned* st; int w; };
__device__ __forceinline__ bool xb_thread0(int w) { return opaque_tid(w) == 0; }
__device__ __forceinline__ XcdBarrier xcd_barrier_post(unsigned* bar, volatile LAS unsigned* st, int w) {
    XcdBarrier b; b.bar = bar; b.x = xb_xcc_id(); b.st = st; b.w = w;
    if (xb_thread0(w)) (void)xb_add(&bar[XB_XCNT(b.x)], 1u);
    return b;
}
__device__ __forceinline__ void xcd_barrier_complete(unsigned* bar, unsigned x, unsigned& nloc, unsigned& nx) {
    const unsigned G = gridDim.x * gridDim.y * gridDim.z;
    unsigned sum, cnt, mine, sp = 0u;
    for (;;) {
        sum = 0u; cnt = 0u; mine = 0u;
#pragma unroll
        for (unsigned j = 0; j < 16; ++j) { const unsigned c = xb_ld(&bar[XB_XCNT(j)]); sum += c; cnt += (c > 0u) ? 1u : 0u; mine = (j == x) ? c : mine; }
        if (sum == G) break;
        __builtin_amdgcn_s_sleep(1);
        if ((++sp & 255u) == 0u) { if (xb_ld(&bar[XB_TMO])) break; if (sp > XB_SPIN_CAP) { atomicAdd(&bar[XB_TMO], 1u); break; } }
    }
    nloc = mine > 0u ? mine : 1u; nx = cnt > 0u ? cnt : 1u;
}
__device__ __forceinline__ void xcd_barrier(const XcdBarrier& b) {
    asm volatile("s_waitcnt vmcnt(0)" ::: "memory");
    __syncthreads();
    if (xb_thread0(b.w)) {
        unsigned* bar = b.bar;
        __builtin_amdgcn_s_waitcnt(0);
        unsigned nloc = b.st[0], nx = b.st[1];
        if (nloc == 0u) { xcd_barrier_complete(bar, b.x, nloc, nx); b.st[0] = nloc; b.st[1] = nx; }
        const unsigned old = xb_add(&bar[XB_XSUB(b.x)], 1u);
        const unsigned gen = old / nloc;
        if (old + 1u == (gen + 1u) * nloc) {
            __builtin_amdgcn_fence(__ATOMIC_RELEASE, "agent");
            asm volatile("s_waitcnt vmcnt(0)" ::: "memory");
            const unsigned og = xb_add(&bar[XB_TOP], 1u);
            const unsigned tg = og / nx;
            if (og + 1u == (tg + 1u) * nx) xb_add(&bar[XB_TOPGEN], 1u);
            else XB_SPIN(xb_ld(&bar[XB_TOPGEN]) == tg, bar);
            __builtin_amdgcn_fence(__ATOMIC_ACQUIRE, "agent");
            xb_add(&bar[XB_XGEN(b.x)], 1u);
            asm volatile("s_waitcnt vmcnt(0)" ::: "memory");
        } else {
            XB_SPIN(xb_ld(&bar[XB_XGEN(b.x)]) == gen, bar);
            __builtin_amdgcn_fence(__ATOMIC_ACQUIRE, "agent");
            asm volatile("s_waitcnt vmcnt(0)" ::: "memory");
        }
    }
    __syncthreads();
}

namespace pg8 {
constexpr int BM = 256, BK = 64, HALF = 128, HTB = HALF * BK * 2, STAGE_BYTES = 8 * HTB, NXCD = 8, WGM = 8;
constexpr int GK = 1024;
__device__ __forceinline__ int lds_byte(int r, int c) { const int st = (r >> 4) * 2 + (c >> 5), rr = r & 15, cc = c & 31, ob = rr * 64 + cc * 2; return st * 1024 + (ob ^ (((ob >> 9) & 1) << 5)); }
__device__ __forceinline__ void stage_rc(int b, int& R, int& C) { const int st = b / 1024, sb = b % 1024, swz = sb ^ (((sb >> 9) & 1) << 5); R = (st >> 1) * 16 + swz / 64; C = (st & 1) * 32 + (swz % 64) / 2; }
__device__ __forceinline__ int perm32(int rho) { const int n = rho >> 4, i = rho & 15; return 8 * (i >> 2) + 4 * n + (i & 3); }
struct Unit { int pm, pn, e; };

template <bool IDG> struct DenseSchedT {
    const char* A; const char* Bt; int nM, nN, nwg, G, c, kb;
    __device__ __forceinline__ void init(const void* A_, const void* Bt_, int M, int N, int G_, int c_, int kb_ = GK * 2) { A = (const char*)A_; Bt = (const char*)Bt_; nM = M / BM; nN = N / BM; nwg = nM * nN; G = G_; c = c_; kb = kb_; }
    __device__ __forceinline__ bool next(int i, Unit& u) const {
        const long L = (long)i * G + c; if (L >= nwg) return false;
        int wgid = (int)L; { const int q = nwg / NXCD, r = nwg % NXCD, xcd = wgid % NXCD, off = wgid / NXCD; wgid = (xcd < r ? xcd * (q + 1) : r * (q + 1) + (xcd - r) * q) + off; }
        const int nig = WGM * nN, gid = wgid / nig, fm = gid * WGM, gsz = (nM - fm) < WGM ? (nM - fm) : WGM;
        u.pm = fm + ((wgid % nig) % gsz); u.pn = (wgid % nig) / gsz; u.e = 0; return true;
    }
    __device__ __forceinline__ const char* a_ptr(const Unit& u) const { return IDG ? A : A + (size_t)u.pm * (size_t)(BM * kb); }
    __device__ __forceinline__ const char* b_ptr(const Unit& u) const { return Bt + (size_t)u.pn * (size_t)(BM * kb); }
    __device__ __forceinline__ void a_offs(const Unit& u, const int (&R)[2], const int (&C)[2], unsigned (&voff)[2][2]) const {
#pragma unroll
        for (int h = 0; h < 2; ++h)
#pragma unroll
            for (int i = 0; i < 2; ++i) voff[h][i] = (unsigned)(u.pm * BM + h * HALF + R[i]) * (unsigned)kb + (unsigned)C[i] * 2u;
    }
    __device__ __forceinline__ void a_raw(const Unit&, const int (&)[2], int (&)[2][2]) const {}
    __device__ __forceinline__ void a_fin(const Unit& u, const int (&R)[2], const int (&C)[2], const int (&)[2][2], unsigned (&voff)[2][2]) const { a_offs(u, R, C, voff); }
};
typedef DenseSchedT<false> DenseSched;
struct MoeSched {
    const char* A; const char* Bt; size_t b_estride; const int* rowtok; const volatile LAS int* cumblk; const volatile LAS int* cnt; int ncol_log2, G, c, kb; const volatile LAS int* ulist;
    __device__ __forceinline__ bool next(int i, Unit& u) const {
        const int v = ulist[i & 63]; if (v < 0) return false;
        u.pm = v >> 8; u.e = (v >> 3) & 31; u.pn = v & 7; return true;
    }
    __device__ __forceinline__ void build_list(volatile LAS int* dst, int tid) const {
        if (tid < 64) { Unit u; dst[tid] = search(tid, u) ? ((u.pm << 8) | (u.e << 3) | u.pn) : -1; }
    }
    __device__ __forceinline__ bool search(int i, Unit& u) const {
        int gb, pn; const int ncol = 1 << ncol_log2;
        if (G == 256 && MK_MOEMAP == 0) { const int xcd = c & 7, j = c >> 3, rpb = 256 >> ncol_log2; gb = i * rpb + xcd + 8 * (j >> ncol_log2); pn = j & (ncol - 1); }
        else { const long L = (long)i * G + c; gb = (int)(L >> ncol_log2); pn = (int)(L & (ncol - 1)); }
        const int tot = cumblk[NE]; if (gb >= tot) return false;
        int e = 0;
#pragma unroll 1
        for (int s = 16; s >= 1; s >>= 1) { if (cumblk[e + s] <= gb) e += s; }
        u.pm = gb; u.pn = pn; u.e = e; return true;
    }
    __device__ __forceinline__ const char* a_ptr(const Unit&) const { return A; }
    __device__ __forceinline__ const char* b_ptr(const Unit& u) const { return Bt + (size_t)u.e * b_estride + (size_t)u.pn * (size_t)(BM * kb); }
    __device__ __forceinline__ void a_raw(const Unit& u, const int (&R)[2], int (&raw)[2][2]) const {
        if (!rowtok) return;
        const int rb = u.pm - cumblk[u.e]; const int* rt = rowtok + (size_t)u.e * MT;
#pragma unroll
        for (int h = 0; h < 2; ++h)
#pragma unroll
            for (int i = 0; i < 2; ++i) { const int* ptr = rt + (rb * 256 + h * HALF + R[i]);
                asm volatile("global_load_dword %0, %1, off" : "=v"(raw[h][i]) : "v"(ptr) : "memory"); }
    }
    __device__ __forceinline__ void a_fin(const Unit& u, const int (&R)[2], const int (&C)[2], const int (&raw_)[2][2], unsigned (&voff)[2][2]) const {
        int raw[2][2] = {{raw_[0][0], raw_[0][1]}, {raw_[1][0], raw_[1][1]}};
        asm volatile("" : "+v"(raw[0][0]), "+v"(raw[0][1]), "+v"(raw[1][0]), "+v"(raw[1][1]));
        const int rb = u.pm - cumblk[u.e], n = cnt[u.e];
#pragma unroll
        for (int h = 0; h < 2; ++h)
#pragma unroll
            for (int i = 0; i < 2; ++i) { const int rank = rb * 256 + h * HALF + R[i]; const int tok = rowtok ? (rank < n ? raw[h][i] : 0) : u.pm * BM + h * HALF + R[i];
                voff[h][i] = (unsigned)tok * (unsigned)kb + (unsigned)C[i] * 2u; }
    }
    __device__ __forceinline__ void a_offs(const Unit& u, const int (&R)[2], const int (&C)[2], unsigned (&voff)[2][2]) const { int raw[2][2] = {{0, 0}, {0, 0}}; a_raw(u, R, raw); asm volatile("s_waitcnt vmcnt(0)" : "+v"(raw[0][0]), "+v"(raw[0][1]), "+v"(raw[1][0]), "+v"(raw[1][1]) :: "memory"); a_fin(u, R, C, raw, voff); }
};

typedef int v8i __attribute__((ext_vector_type(8)));
__device__ __forceinline__ v8i cat8(bf16x8 lo, bf16x8 hi) { const v4u a = __builtin_bit_cast(v4u, lo), b = __builtin_bit_cast(v4u, hi); return (v8i){(int)a.x, (int)a.y, (int)a.z, (int)a.w, (int)b.x, (int)b.y, (int)b.z, (int)b.w}; }
template <class Epi, class Sched, bool GATHER, bool FP8 = false, int XG = 0>
__device__ __forceinline__ void gemm_phase(LAS unsigned char* lds, const Sched& S, const Epi& E, int wave_id, bool skip_epi = false, unsigned stagger_ticks = 0u) {
    if (stagger_ticks && ((blockIdx.x >> 3) & 1u)) { const unsigned long long t0 = __builtin_amdgcn_s_memrealtime(); while (__builtin_amdgcn_s_memrealtime() - t0 < (unsigned long long)stagger_ticks) __builtin_amdgcn_s_sleep(8); }
    const int tid = opaque_tid(wave_id), wid = __builtin_amdgcn_readfirstlane(tid >> 6), lane = tid & 63, wr = wid >> 2, wc = wid & 3, fr = lane & 15, fq = lane >> 4;
    constexpr int KB = FP8 ? GK : GK * 2, nt = KB / (BK * 2);
    unsigned voffA[2][2], voffB[2]; int Rr[2], Cc[2];
#pragma unroll
    for (int i = 0; i < 2; ++i) { int R, C; stage_rc(tid * 16 + i * 8192, R, C); Rr[i] = R; Cc[i] = C; const int Rb = Epi::PERM ? ((R & ~31) + perm32(R & 31)) : R;
        voffA[0][i] = (unsigned)(R * KB + C * 2); voffA[1][i] = (unsigned)((R + HALF) * KB + C * 2); voffB[i] = (unsigned)(Rb * KB + C * 2); }
    constexpr size_t kstep = (size_t)(BK * 2);
    constexpr size_t hstep = (size_t)HALF * KB;
    const unsigned ldsw = (unsigned)wid * 1024u;
    const int aoff = lds_byte(wr * 64 + fr, fq * 8), boff = lds_byte(wc * 32 + fr, fq * 8);
    LAS unsigned char* abase = lds + aoff; LAS unsigned char* bbase = lds + 4 * HTB + boff; asm volatile("" : "+v"(abase), "+v"(bbase));
#define PG8_SA(b, h) (((b) * 2 + (h)) * HTB)
#define PG8_SB(b, h) ((4 + (b) * 2 + (h)) * HTB)
#define PG8_STAGE(bufoff, gbase, voff) do { if (XG == 3) break; _Pragma("unroll") for (int _i = 0; _i < 2; ++_i) \
        __builtin_amdgcn_global_load_lds((const unsigned*)((const char*)(gbase) + (voff)[_i]), (LAS unsigned*)(lds + (bufoff) + ldsw + _i * 8192), 16, 0, 0); } while (0)
#define PG8_STAGE_A(bufoff, gbase, h) PG8_STAGE(bufoff, gbase, voffA[h])
#define PG8_RDA(off) (*(const LAS v4u*)(abase + (off)))
#define PG8_RDB(off) (*(const LAS v4u*)(bbase + (off)))
#define PG8_LDA(dst, b, h) do { if (XG == 2) break; _Pragma("unroll") for (int m = 0; m < 4; ++m) { const v4u _l = PG8_RDA(PG8_SA(b, h) + m * 2048), _h = PG8_RDA(PG8_SA(b, h) + m * 2048 + 1024); \
        if constexpr (FP8) dst##8[m] = (v8i){(int)_l.x, (int)_l.y, (int)_l.z, (int)_l.w, (int)_h.x, (int)_h.y, (int)_h.z, (int)_h.w}; \
        else { dst[m][0] = __builtin_bit_cast(bf16x8, _l); dst[m][1] = __builtin_bit_cast(bf16x8, _h); } } } while (0)
#define PG8_LDB(dst, b, h) do { if (XG == 2) break; _Pragma("unroll") for (int n = 0; n < 2; ++n) { const v4u _l = PG8_RDB(PG8_SA(b, h) + n * 2048), _h = PG8_RDB(PG8_SA(b, h) + n * 2048 + 1024); \
        if constexpr (FP8) dst##8[n] = (v8i){(int)_l.x, (int)_l.y, (int)_l.z, (int)_l.w, (int)_h.x, (int)_h.y, (int)_h.z, (int)_h.w}; \
        else { dst[n][0] = __builtin_bit_cast(bf16x8, _l); dst[n][1] = __builtin_bit_cast(bf16x8, _h); } } } while (0)
#define PG8_MMA(ai, bj, At, Bt) do { if (XG == 1) break; __builtin_amdgcn_s_setprio(1); _Pragma("unroll") for (int m = 0; m < 4; ++m) _Pragma("unroll") for (int n = 0; n < 2; ++n) { \
        if constexpr (FP8) acc[ai][bj][m][n] = __builtin_amdgcn_mfma_scale_f32_16x16x128_f8f6f4(Bt##8[n], At##8[m], acc[ai][bj][m][n], 0, 0, 0, 0x7A7A7A7A, 0, 0x7F7F7F7F); \
        else { _Pragma("unroll") for (int k = 0; k < 2; ++k) acc[ai][bj][m][n] = __builtin_amdgcn_mfma_f32_16x16x32_bf16(Bt[n][k], At[m][k], acc[ai][bj][m][n], 0, 0, 0); } } \
        __builtin_amdgcn_s_setprio(0); } while (0)
#define PG8_WAIT_V(n) asm volatile("s_waitcnt vmcnt(" #n ")" ::: "memory")
#define PG8_WAIT_L(n) asm volatile("s_waitcnt lgkmcnt(" #n ")" ::: "memory")
#define PG8_BAR __builtin_amdgcn_s_barrier()
#define PG8_SCHED __builtin_amdgcn_sched_barrier(0)
    Unit cur, nxt; int ui = 0;
    if (!S.next(0, cur)) return;
    f32x4 acc[2][2][4][2];
#pragma unroll
    for (int a = 0; a < 2; ++a)
#pragma unroll
        for (int b = 0; b < 2; ++b)
#pragma unroll
            for (int m = 0; m < 4; ++m)
#pragma unroll
                for (int n = 0; n < 2; ++n) acc[a][b][m][n] = (f32x4){0.f, 0.f, 0.f, 0.f};
    bf16x8 At[4][2], B0[2][2], B1[2][2]; v8i At8[4], B08[2], B18[2];
    if constexpr (XG == 2) { _Pragma("unroll") for (int m = 0; m < 4; ++m) { asm volatile("" : "=v"(At8[m])); } _Pragma("unroll") for (int n = 0; n < 2; ++n) { asm volatile("" : "=v"(B08[n])); asm volatile("" : "=v"(B18[n])); } }
    const char* cA = S.a_ptr(cur); const char* cB = S.b_ptr(cur);
    if constexpr (GATHER) S.a_offs(cur, Rr, Cc, voffA);
    PG8_STAGE(PG8_SB(0, 0), cB, voffB); PG8_STAGE(PG8_SB(0, 1), cB + hstep, voffB); PG8_STAGE_A(PG8_SA(0, 0), cA, 0); PG8_STAGE_A(PG8_SA(0, 1), cA, 1);
    if (wr == 1) PG8_BAR;
    PG8_WAIT_V(2); PG8_BAR;
    PG8_STAGE(PG8_SB(1, 0), cB + kstep, voffB); PG8_STAGE_A(PG8_SA(1, 0), cA + kstep, 0); PG8_STAGE(PG8_SB(1, 1), cB + hstep + kstep, voffB);
    PG8_WAIT_V(6); PG8_BAR;
    for (;;) {
        const bool has_next = S.next(ui + 1, nxt);
        const char* nA = has_next ? S.a_ptr(nxt) : cA; const char* nB = has_next ? S.b_ptr(nxt) : cB;
        int rawN[2][2] = {{0, 0}, {0, 0}};
        if constexpr (GATHER) { if (has_next) S.a_raw(nxt, Rr, rawN); }
#pragma unroll 1
        for (int t = 0; t < nt; t += 2) {
            const bool last = (t == nt - 2);
            if constexpr (Epi::LDSBIAS) { if (last && wid == 0) E.stage_bias(cur, lane); }
            const char* a1 = cA + (size_t)(t + 1) * kstep;
            const char* a2 = last ? nA : cA + (size_t)(t + 2) * kstep; const char* b2 = last ? nB : cB + (size_t)(t + 2) * kstep;
            const char* a3 = a2 + kstep; const char* b3 = b2 + kstep;
            PG8_LDB(B0, 0, 0); PG8_LDB(B1, 0, 1); PG8_SCHED; PG8_LDA(At, 0, 0); PG8_STAGE_A(PG8_SA(1, 1), a1, 1);
            if constexpr (GATHER) { if (last && has_next) S.a_fin(nxt, Rr, Cc, rawN, voffA); }
            PG8_WAIT_V(8); PG8_WAIT_L(0); PG8_BAR; PG8_MMA(0, 0, At, B0); PG8_MMA(0, 1, At, B1); PG8_BAR; PG8_SCHED;
            PG8_LDA(At, 0, 1); PG8_STAGE(PG8_SB(0, 0), b2, voffB); PG8_STAGE(PG8_SB(0, 1), b2 + hstep, voffB); PG8_STAGE_A(PG8_SA(0, 0), a2, 0);
            PG8_WAIT_V(8); PG8_WAIT_L(0); PG8_BAR; PG8_MMA(1, 0, At, B0); PG8_MMA(1, 1, At, B1); PG8_BAR; PG8_SCHED;
            PG8_LDB(B0, 1, 0); PG8_LDB(B1, 1, 1); PG8_SCHED; PG8_LDA(At, 1, 0); PG8_STAGE_A(PG8_SA(0, 1), a2, 1);
            PG8_WAIT_V(8); PG8_WAIT_L(0); PG8_BAR; PG8_MMA(0, 0, At, B0); PG8_MMA(0, 1, At, B1); PG8_BAR; PG8_SCHED;
            PG8_LDA(At, 1, 1); PG8_STAGE(PG8_SB(1, 0), b3, voffB); PG8_STAGE(PG8_SB(1, 1), b3 + hstep, voffB); PG8_STAGE_A(PG8_SA(1, 0), a3, 0);
            PG8_WAIT_V(8); PG8_WAIT_L(0); PG8_BAR; PG8_MMA(1, 0, At, B0); PG8_MMA(1, 1, At, B1); PG8_BAR; PG8_SCHED;
        }
        if (wr == 0) PG8_BAR;
        if (!skip_epi) E(acc, cur, wr, wc, fr, fq);
        if (!has_next) break;
#pragma unroll
        for (int a = 0; a < 2; ++a)
#pragma unroll
            for (int b = 0; b < 2; ++b)
#pragma unroll
                for (int m = 0; m < 4; ++m)
#pragma unroll
                    for (int n = 0; n < 2; ++n) acc[a][b][m][n] = (f32x4){0.f, 0.f, 0.f, 0.f};
        cur = nxt; cA = nA; cB = nB; ++ui;
        if (wr == 1) PG8_BAR;
    }
    PG8_WAIT_V(0);
    PG8_BAR;
#undef PG8_SA
#undef PG8_SB
#undef PG8_STAGE
#undef PG8_STAGE_A
#undef PG8_LDA
#undef PG8_RDA
#undef PG8_RDB
#undef PG8_LDB
#undef PG8_MMA
#undef PG8_WAIT_V
#undef PG8_WAIT_L
#undef PG8_BAR
#undef PG8_SCHED
}
}
namespace pg8 {
__device__ __forceinline__ f32x2 gelu_pk(f32x2 v) {
    const f32x2 av = __builtin_elementwise_abs(v), d = av * 0.2316418882f + 1.0f;
    f32x2 t; t.x = __builtin_amdgcn_rcpf(d.x); t.y = __builtin_amdgcn_rcpf(d.y);
    f32x2 q = t * 0.5307027145f + (-0.7265760135f); q = q * t + 0.7107068705f; q = q * t + (-0.142248368f); q = q * t + 0.127414796f; q = q * t;
    const f32x2 s = (v * v) * (-0.72134752044f);
    f32x2 e; e.x = __builtin_amdgcn_exp2f(s.x); e.y = __builtin_amdgcn_exp2f(s.y);
    const f32x2 m = v * (q * e), r = v - m;
    f32x2 o; o.x = v.x < 0.f ? m.x : r.x; o.y = v.y < 0.f ? m.y : r.y; return o;
}
struct EpiBf16 {
    static constexpr bool PERM = true, LDSBIAS = false;
    bf16* O; int ldc; float* ss; int ACT;
    __device__ __forceinline__ void operator()(const f32x4 (&acc)[2][2][4][2], const Unit& u, int wr, int wc, int fr, int fq) const {
        const int row0 = u.pm * BM + wr * 64 + fr, col0 = u.pn * BM + wc * 32 + 8 * fq;
#pragma unroll
        for (int ai = 0; ai < 2; ++ai)
#pragma unroll
            for (int m = 0; m < 4; ++m) { const int row = row0 + ai * HALF + m * 16; bf16* rowp = O + (size_t)row * ldc + col0; float sq = 0.f;
#pragma unroll
                for (int bj = 0; bj < 2; ++bj) { f32x4 v0 = acc[ai][bj][m][0], v1 = acc[ai][bj][m][1];
                    if (ACT == 1) { f32x2 a = gelu_pk((f32x2){v0[0], v0[1]}), b = gelu_pk((f32x2){v0[2], v0[3]}), c = gelu_pk((f32x2){v1[0], v1[1]}), d = gelu_pk((f32x2){v1[2], v1[3]});
                        v0 = (f32x4){a.x, a.y, b.x, b.y}; v1 = (f32x4){c.x, c.y, d.x, d.y};
                        sq += (v0[0] * v0[0] + v0[1] * v0[1]) + (v0[2] * v0[2] + v0[3] * v0[3]) + (v1[0] * v1[0] + v1[1] * v1[1]) + (v1[2] * v1[2] + v1[3] * v1[3]); }
                    v4u w; w.x = cvt_pk_bf16(v0[0], v0[1]); w.y = cvt_pk_bf16(v0[2], v0[3]); w.z = cvt_pk_bf16(v1[0], v1[1]); w.w = cvt_pk_bf16(v1[2], v1[3]);
                    *(v4u*)(rowp + bj * HALF) = w; }
                if (ACT == 1) { const int ln = (fq << 4) | fr; sq += shx(sq, 16, ln); sq += shx(sq, 32, ln);
                    if (u.pn >= 4 && fq == 0) ss[(size_t)row * 16 + (u.pn - 4) * 4 + wc] = sq; }
            }
    }
};
struct EpiResid {
    static constexpr bool PERM = false, LDSBIAS = false;
    bf16* xb; const float* modl;
    __device__ __forceinline__ void operator()(const f32x4 (&acc)[2][2][4][2], const Unit& u, int wr, int wc, int fr, int fq) const {
        const bool lat = u.pm < ML / BM; const int bidx = lat ? (u.pm >> 5) : 8;
        bf16* base = xb + (size_t)u.pm * BM * D;
        const float* g = modl + bidx * 6144 + 2 * 1024;
        const int r0 = wr * 64 + fr, col0 = u.pn * BM + wc * 32 + 4 * fq;
        f32x4 gv[2][2];
#pragma unroll
        for (int bj = 0; bj < 2; ++bj)
#pragma unroll
            for (int n = 0; n < 2; ++n) gv[bj][n] = *(const f32x4*)(g + col0 + bj * HALF + n * 16);
        const int odd = fq & 1, colp = col0 - 4 * odd;
#pragma unroll
        for (int ai = 0; ai < 2; ++ai) { v4u bs[2][2][2];
#pragma unroll
            for (int mp = 0; mp < 2; ++mp) { const size_t off = (size_t)(r0 + ai * HALF + (2 * mp + odd) * 16) * D + colp;
#pragma unroll
                for (int bj = 0; bj < 2; ++bj)
#pragma unroll
                    for (int n = 0; n < 2; ++n) bs[mp][bj][n] = *(const v4u*)(base + off + bj * HALF + n * 16); }
#pragma unroll
            for (int mp = 0; mp < 2; ++mp) { const size_t off = (size_t)(r0 + ai * HALF + (2 * mp + odd) * 16) * D + colp;
#pragma unroll
                for (int bj = 0; bj < 2; ++bj)
#pragma unroll
                    for (int n = 0; n < 2; ++n) { const v4u L = bs[mp][bj][n];
                        const auto s0 = __builtin_amdgcn_permlane16_swap(L.x, L.z, false, false), s1 = __builtin_amdgcn_permlane16_swap(L.y, L.w, false, false);
                        const f32x4 va = bf4_f32((v2u){s0[0], s1[0]}) + gv[bj][n] * acc[ai][bj][2 * mp][n], vb = bf4_f32((v2u){s0[1], s1[1]}) + gv[bj][n] * acc[ai][bj][2 * mp + 1][n];
                        const auto t0 = __builtin_amdgcn_permlane16_swap(cvt_pk_bf16(va.x, va.y), cvt_pk_bf16(vb.x, vb.y), false, false), t1 = __builtin_amdgcn_permlane16_swap(cvt_pk_bf16(va.z, va.w), cvt_pk_bf16(vb.z, vb.w), false, false);
                        *(v4u*)(base + off + bj * HALF + n * 16) = (v4u){t0[0], t1[0], t0[1], t1[1]}; } }
            asm volatile("" ::: "memory"); }
    }
};
struct EpiSwiglu {
    static constexpr bool PERM = true, LDSBIAS = true;
    unsigned char* O; const float* b1; LAS float* bl;
    __device__ __forceinline__ void stage_bias(const Unit& u, int lane) const { const float* src = b1 + (size_t)u.e * 2048 + (lane < 32 ? u.pn * HALF + 4 * lane : 1024 + u.pn * HALF + 4 * (lane - 32));
        __builtin_amdgcn_global_load_lds((const unsigned*)src, (LAS unsigned*)bl, 16, 0, 0); }
    __device__ __forceinline__ void operator()(const f32x4 (&acc)[2][2][4][2], const Unit& u, int wr, int wc, int fr, int fq) const {
        const int row0 = u.pm * BM + wr * 64 + fr, cl = wc * 32 + 8 * fq, c0 = u.pn * HALF + cl;
        f32x4 bg[2], bli[2];
#pragma unroll
        for (int n = 0; n < 2; ++n) { bg[n] = *(const LAS f32x4*)(bl + cl + 4 * n); bli[n] = *(const LAS f32x4*)(bl + 128 + cl + 4 * n) + 1.0f; }
#pragma unroll
        for (int ai = 0; ai < 2; ++ai)
#pragma unroll
            for (int mp = 0; mp < 4; mp += 2) { v2u wv[2];
#pragma unroll
              for (int mm = 0; mm < 2; ++mm) { const int m = mp + mm; float o[8];
#pragma unroll
                for (int n = 0; n < 2; ++n)
#pragma unroll
                    for (int j = 0; j < 4; ++j) { const float gl = fminf(acc[ai][0][m][n][j] + bg[n][j], 7.0f), lp = __builtin_amdgcn_fmed3f(acc[ai][1][m][n][j] + bli[n][j], -6.0f, 8.0f);
                        const float sg = __builtin_amdgcn_rcpf(1.0f + __builtin_amdgcn_exp2f(gl * (-1.702f * 1.4426950408889634f)));
                        o[n * 4 + j] = gl * sg * lp; }
                v2u w; w.x = 0; w.y = 0;
                w.x = __builtin_amdgcn_cvt_pk_fp8_f32(o[0], o[1], w.x, false); w.x = __builtin_amdgcn_cvt_pk_fp8_f32(o[2], o[3], w.x, true);
                w.y = __builtin_amdgcn_cvt_pk_fp8_f32(o[4], o[5], w.y, false); w.y = __builtin_amdgcn_cvt_pk_fp8_f32(o[6], o[7], w.y, true);
                wv[mm] = w; }
              const auto sx = __builtin_amdgcn_permlane16_swap(wv[0].x, wv[1].x, false, false), sy = __builtin_amdgcn_permlane16_swap(wv[0].y, wv[1].y, false, false);
              *(v4u*)(O + (size_t)(row0 + ai * HALF + (mp + (fq & 1)) * 16) * D + (c0 - 8 * (fq & 1))) = (v4u){sx[0], sy[0], sx[1], sy[1]}; }
    }
};
struct EpiBias {
    static constexpr bool PERM = true, LDSBIAS = true;
    unsigned char* O; const float* b2; LAS float* bl;
    __device__ __forceinline__ void stage_bias(const Unit& u, int lane) const { __builtin_amdgcn_global_load_lds((const unsigned*)(b2 + (size_t)u.e * 1024 + u.pn * BM + 4 * lane), (LAS unsigned*)bl, 16, 0, 0); }
    __device__ __forceinline__ void operator()(const f32x4 (&acc)[2][2][4][2], const Unit& u, int wr, int wc, int fr, int fq) const {
        const int row0 = u.pm * BM + wr * 64 + fr, cl = wc * 32 + 8 * fq, col0 = u.pn * BM + cl;
#pragma unroll
        for (int bj = 0; bj < 2; ++bj) { const f32x4 bv0 = *(const LAS f32x4*)(bl + cl + bj * HALF), bv1 = *(const LAS f32x4*)(bl + cl + bj * HALF + 4);
#pragma unroll
            for (int ai = 0; ai < 2; ++ai)
#pragma unroll
                for (int mp = 0; mp < 4; mp += 2) { v2u wv[2];
#pragma unroll
                    for (int mm = 0; mm < 2; ++mm) { const int m = mp + mm; const f32x4 v0 = acc[ai][bj][m][0] + bv0, v1 = acc[ai][bj][m][1] + bv1;
                        v2u w; w.x = 0; w.y = 0;
                        w.x = __builtin_amdgcn_cvt_pk_fp8_f32(v0[0], v0[1], w.x, false); w.x = __builtin_amdgcn_cvt_pk_fp8_f32(v0[2], v0[3], w.x, true);
                        w.y = __builtin_amdgcn_cvt_pk_fp8_f32(v1[0], v1[1], w.y, false); w.y = __builtin_amdgcn_cvt_pk_fp8_f32(v1[2], v1[3], w.y, true);
                        wv[mm] = w; }
                    const auto sx = __builtin_amdgcn_permlane16_swap(wv[0].x, wv[1].x, false, false), sy = __builtin_amdgcn_permlane16_swap(wv[0].y, wv[1].y, false, false);
                    *(v4u*)(O + (size_t)(row0 + ai * HALF + (mp + (fq & 1)) * 16) * D + (col0 - 8 * (fq & 1)) + bj * HALF) = (v4u){sx[0], sy[0], sx[1], sy[1]}; }
            asm volatile("" ::: "memory"); }
    }
};
}

namespace att {
constexpr int AD = 128, NW = 8, QBLK = 32, KVBLK = 64;
constexpr float SCALE = 0.088388347648318440f;
constexpr int LDO = 1024;
constexpr int SHM_V = AD * KVBLK, SHM_K = KVBLK * AD, SHM_ATTN = 4 * SHM_V + 4 * SHM_K;
typedef int v8i __attribute__((ext_vector_type(8)));
#define K8SW(key, c) ((key) * 128 + ((((c) ^ (((key) >> 1) & 7))) << 4))
#define V8SW(d, c) ((d) * 64 + ((((c) ^ (((d) >> 2) & 3))) << 4))
#define SBAR() __builtin_amdgcn_sched_barrier(0)
__device__ __forceinline__ int crow(int r, int hi) { return (r & 3) + 8 * (r >> 2) + 4 * hi; }
template <int XV = 0>
__device__ __forceinline__ int exp4(float a0, float a1, float a2, float a3) {
  float t0 = fminf(a0 + 8.0f, 8.0f), t1 = fminf(a1 + 8.0f, 8.0f), t2 = fminf(a2 + 8.0f, 8.0f), t3 = fminf(a3 + 8.0f, 8.0f); int w;
  asm volatile("v_exp_f32 %1, %1\n\tv_exp_f32 %2, %2\n\tv_exp_f32 %3, %3\n\tv_exp_f32 %4, %4\n\t"
               "v_cvt_pk_fp8_f32 %0, %1, %2\n\ts_nop 0\n\tv_cvt_pk_fp8_f32 %0, %3, %4 op_sel:[0,0,1]"
               : "=&v"(w), "+v"(t0), "+v"(t1), "+v"(t2), "+v"(t3));
  return w;
}
template <int PAD>
__device__ __forceinline__ int expc4(float a0, float a1, float a2, float a3) {
  int w; float t0, t1, t2, t3;
  if constexpr (PAD != 0)
    asm volatile("s_nop 5\n\tv_exp_f32_e64 %1, %5 clamp\n\tv_exp_f32_e64 %2, %6 clamp\n\tv_exp_f32_e64 %3, %7 clamp\n\tv_exp_f32_e64 %4, %8 clamp\n\t"
                 "v_cvt_scalef32_pk_fp8_f32 %0, %1, %2, %9\n\ts_nop 0\n\tv_cvt_scalef32_pk_fp8_f32 %0, %3, %4, %9 op_sel:[0,0,0,1]"
                 : "=&v"(w), "=&v"(t0), "=&v"(t1), "=&v"(t2), "=&v"(t3) : "v"(a0), "v"(a1), "v"(a2), "v"(a3), "s"(0x3B800000));
  else
    asm volatile("v_exp_f32_e64 %1, %5 clamp\n\tv_exp_f32_e64 %2, %6 clamp\n\tv_exp_f32_e64 %3, %7 clamp\n\tv_exp_f32_e64 %4, %8 clamp\n\t"
                 "v_cvt_scalef32_pk_fp8_f32 %0, %1, %2, %9\n\ts_nop 0\n\tv_cvt_scalef32_pk_fp8_f32 %0, %3, %4, %9 op_sel:[0,0,0,1]"
                 : "=&v"(w), "=&v"(t0), "=&v"(t1), "=&v"(t2), "=&v"(t3) : "v"(a0), "v"(a1), "v"(a2), "v"(a3), "s"(0x3B800000));
  return w;
}
#define EXC4(P, m, PAD) expc4<PAD>(P[4 * (m)], P[4 * (m) + 1], P[4 * (m) + 2], P[4 * (m) + 3])
typedef int v4i __attribute__((ext_vector_type(4)));
__device__ __forceinline__ void partialSM(const f32x16& p0, float nb, v4i& plo) {
#pragma unroll
  for (int m = 0; m < 4; ++m) plo[m] = exp4(p0[4 * m], p0[4 * m + 1], p0[4 * m + 2], p0[4 * m + 3]);
}
__device__ __forceinline__ void finishSM(const f32x16& p1, float nb, const v4i& plo, v8i& pa) {
  v4i phi;
#pragma unroll
  for (int m = 0; m < 4; ++m) phi[m] = exp4(p1[4 * m], p1[4 * m + 1], p1[4 * m + 2], p1[4 * m + 3]);
  pa = (v8i){plo[0], plo[1], plo[2], plo[3], phi[0], phi[1], phi[2], phi[3]};
}
__device__ __forceinline__ void qkt(f32x16& p0, f32x16& p1, const char* Ks, const v8i* q8, int r32, int hi, const f32x16& NBV) {
  p0 = NBV; p1 = NBV;
#pragma unroll
  for (int s = 0; s < 2; ++s) { const int c0 = 4 * s + 2 * hi;
    const v4u a0 = *reinterpret_cast<const v4u*>(Ks + K8SW(r32, c0)), a1 = *reinterpret_cast<const v4u*>(Ks + K8SW(r32, c0 + 1));
    const v4u b0 = *reinterpret_cast<const v4u*>(Ks + K8SW(32 + r32, c0)), b1 = *reinterpret_cast<const v4u*>(Ks + K8SW(32 + r32, c0 + 1));
    const v8i A0 = (v8i){(int)a0.x, (int)a0.y, (int)a0.z, (int)a0.w, (int)a1.x, (int)a1.y, (int)a1.z, (int)a1.w};
    const v8i A1 = (v8i){(int)b0.x, (int)b0.y, (int)b0.z, (int)b0.w, (int)b1.x, (int)b1.y, (int)b1.z, (int)b1.w};
    p0 = __builtin_amdgcn_mfma_scale_f32_32x32x64_f8f6f4(A0, q8[s], p0, 0, 0, 0, 0x7F7F7F7F, 0, 0x7C7C7C7C);
    p1 = __builtin_amdgcn_mfma_scale_f32_32x32x64_f8f6f4(A1, q8[s], p1, 0, 0, 0, 0x7F7F7F7F, 0, 0x7C7C7C7C); }
}
__device__ __forceinline__ void pv_d0(f32x16* o, f32x16& lacc, const char* Vs, v8i pa, int r32, int hi) {
  { const int one = 0x38383838; const v8i ONES = (v8i){one, one, one, one, one, one, one, one};
    lacc = __builtin_amdgcn_mfma_scale_f32_32x32x64_f8f6f4(pa, ONES, lacc, 0, 0, 0, 0x7F7F7F7F, 0, 0x7F7F7F7F); }
#pragma unroll
  for (int d0 = 0; d0 < 4; ++d0) { const int d = 32 * d0 + r32;
    const v4u b0 = *reinterpret_cast<const v4u*>(Vs + V8SW(d, 2 * hi)), b1 = *reinterpret_cast<const v4u*>(Vs + V8SW(d, 2 * hi + 1));
    const v8i B = (v8i){(int)b0.x, (int)b0.y, (int)b0.z, (int)b0.w, (int)b1.x, (int)b1.y, (int)b1.z, (int)b1.w};
    o[d0] = __builtin_amdgcn_mfma_scale_f32_32x32x64_f8f6f4(pa, B, o[d0], 0, 0, 0, 0x7F7F7F7F, 0, 0x7F7F7F7F); }
}
__device__ __forceinline__ v8i lds32(const char* p0, const char* p1) { const v4u a = *reinterpret_cast<const v4u*>(p0), b = *reinterpret_cast<const v4u*>(p1);
  return (v8i){(int)a.x, (int)a.y, (int)a.z, (int)a.w, (int)b.x, (int)b.y, (int)b.z, (int)b.w}; }
#define MF8(A, B, C, SB) ((XV == 3 || XV == 4 || XV == 5 || XV == 9) ? (C) : __builtin_amdgcn_mfma_scale_f32_32x32x64_f8f6f4(A, B, C, 0, 0, 0, 0x7F7F7F7F, 0, SB))
#define EX4(P, m) exp4<XV>(P[4 * (m)], P[4 * (m) + 1], P[4 * (m) + 2], P[4 * (m) + 3])
template <int XV = 0>
__device__ __forceinline__ void tile_step(f32x16& pN0, f32x16& pN1, const f32x16& pP1, const v4i& ploP, v4i& ploN, f32x16* o, f32x16& lacc,
                                          const char* Ks, const char* Vs, const v8i* q8, int r32, int hi, const f32x16& Z) {
  const int one = 0x38383838; const v8i ONES = (v8i){one, one, one, one, one, one, one, one};
  v4i phi;
  const v8i A00 = lds32(Ks + K8SW(r32, 2 * hi), Ks + K8SW(r32, 2 * hi + 1)), A10 = lds32(Ks + K8SW(32 + r32, 2 * hi), Ks + K8SW(32 + r32, 2 * hi + 1));
  const v8i A01 = lds32(Ks + K8SW(r32, 4 + 2 * hi), Ks + K8SW(r32, 4 + 2 * hi + 1)), A11 = lds32(Ks + K8SW(32 + r32, 4 + 2 * hi), Ks + K8SW(32 + r32, 4 + 2 * hi + 1));
  phi[0] = EXC4(pP1, 0, 0); SBAR();
  pN0 = MF8(A00, q8[0], Z, 0x7C7C7C7C);   SBAR(); const v8i V0 = lds32(Vs + V8SW(r32, 2 * hi), Vs + V8SW(r32, 2 * hi + 1));           phi[1] = EXC4(pP1, 1, 0); SBAR();
  pN0 = MF8(A01, q8[1], pN0, 0x7C7C7C7C); SBAR(); const v8i V1 = lds32(Vs + V8SW(32 + r32, 2 * hi), Vs + V8SW(32 + r32, 2 * hi + 1)); phi[2] = EXC4(pP1, 2, 0); SBAR();
  pN1 = MF8(A10, q8[0], Z, 0x7C7C7C7C);   SBAR(); const v8i V2 = lds32(Vs + V8SW(64 + r32, 2 * hi), Vs + V8SW(64 + r32, 2 * hi + 1)); phi[3] = EXC4(pP1, 3, 0); SBAR();
  pN1 = MF8(A11, q8[1], pN1, 0x7C7C7C7C); SBAR(); const v8i V3 = lds32(Vs + V8SW(96 + r32, 2 * hi), Vs + V8SW(96 + r32, 2 * hi + 1)); SBAR();
  const v8i pa = (v8i){ploP[0], ploP[1], ploP[2], ploP[3], phi[0], phi[1], phi[2], phi[3]};
  lacc = MF8(pa, ONES, lacc, 0x7F7F7F7F); SBAR(); ploN[0] = EXC4(pN0, 0, 1); SBAR();
  o[0] = MF8(pa, V0, o[0], 0x7F7F7F7F);   SBAR(); ploN[1] = EXC4(pN0, 1, 0); SBAR();
  o[1] = MF8(pa, V1, o[1], 0x7F7F7F7F);   SBAR(); ploN[2] = EXC4(pN0, 2, 0); SBAR();
  o[2] = MF8(pa, V2, o[2], 0x7F7F7F7F);   SBAR(); ploN[3] = EXC4(pN0, 3, 0); SBAR();
  o[3] = MF8(pa, V3, o[3], 0x7F7F7F7F);   SBAR();
}
template <int XV = 0>
__device__ __forceinline__ void attn_dense_body(const unsigned char* __restrict__ Q8, const unsigned char* __restrict__ K8, const unsigned char* __restrict__ VT, int vt_ld, bf16* __restrict__ Ob, int seq, char* lds, int wave_id, float nb) {
  const int tid = opaque_tid(wave_id), wid = tid >> 6, lane = tid & 63, r32 = lane & 31, hi = lane >> 5;
  char* V_lds = lds; char* K_lds = lds + 4 * SHM_V;
  f32x16 lacc = {}; f32x16 o[4] = {}; v8i qr[2]; f32x16 NBV;
#pragma unroll
  for (int i = 0; i < 16; ++i) NBV[i] = nb;
  { const unsigned char* Qw = Q8 + (long)(wid * QBLK + r32) * 1024 + hi * 32;
#pragma unroll
    for (int s2 = 0; s2 < 2; ++s2) { const v4u a = *reinterpret_cast<const v4u*>(Qw + 64 * s2), b = *reinterpret_cast<const v4u*>(Qw + 64 * s2 + 16);
      qr[s2] = (v8i){(int)a.x, (int)a.y, (int)a.z, (int)a.w, (int)b.x, (int)b.y, (int)b.z, (int)b.w}; } }
  struct { v4u vs, ks; } sr_[1];
  const int kkey = tid >> 3, kch = tid & 7; const unsigned koff = (unsigned)(kkey * 256 + kch * 16); const int kst = K8SW(kkey, kch);
  const int vd = tid >> 2, vc = tid & 3; const unsigned voff = (unsigned)(vd * vt_ld + vc * 16); const int vst = V8SW(vd, vc);
#define SLOAD(i, k0) do { if (XV >= 7) break; sr_[i].vs = *reinterpret_cast<const v4u*>((const char*)VT + (size_t)(k0) + voff); \
    sr_[i].ks = *reinterpret_cast<const v4u*>((const char*)K8 + (size_t)(k0) * 256 + koff); } while (0)
#define SWRITE(b, i) do { *(v4u*)(V_lds + (b) * SHM_V + vst) = sr_[i].vs; *(v4u*)(K_lds + (b) * SHM_K + kst) = sr_[i].ks; } while (0)
#define SWAIT() asm volatile("s_waitcnt vmcnt(0)" ::: "memory")
#define TBAR() asm volatile("s_waitcnt lgkmcnt(0)\n\ts_barrier" ::: "memory")
  f32x16 pA0, pA1, pB0, pB1; v8i pa; v4i plA, plB; const int NT = seq / KVBLK;
  SLOAD(0, 0); SWAIT(); SWRITE(0, 0); SLOAD(0, KVBLK); TBAR();
  qkt(pA0, pA1, K_lds, qr, r32, hi, NBV); partialSM(pA0, nb, plA);
  SWAIT(); SWRITE(1, 0); SLOAD(0, 2 * KVBLK); TBAR();
#define STEP_IO(t, SW) do { SWAIT(); SWRITE(SW, 0); { const int tn = (t) + 2 < NT ? (t) + 2 : NT - 1; SLOAD(0, tn * KVBLK); } SBAR(); } while (0)
#define STEP_B(t, SK, SV, SW) do { STEP_IO(t, SW); tile_step<XV>(pB0, pB1, pA1, plA, plB, o, lacc, K_lds + (SK) * SHM_K, V_lds + (SV) * SHM_V, qr, r32, hi, NBV); TBAR(); } while (0)
#define STEP_A(t, SK, SV, SW) do { STEP_IO(t, SW); tile_step<XV>(pA0, pA1, pB1, plB, plA, o, lacc, K_lds + (SK) * SHM_K, V_lds + (SV) * SHM_V, qr, r32, hi, NBV); TBAR(); } while (0)
  int j = 1;
  for (; j + 5 < NT; j += 4) { STEP_B(j, 1, 0, 2); STEP_A(j + 1, 2, 1, 3); STEP_B(j + 2, 3, 2, 0); STEP_A(j + 3, 0, 3, 1); }
  STEP_B(j, 1, 0, 2); STEP_A(j + 1, 2, 1, 3);
  SBAR(); qkt(pB0, pB1, K_lds + 3 * SHM_K, qr, r32, hi, NBV);
  finishSM(pA1, nb, plA, pa); SBAR();
  pv_d0(o, lacc, V_lds + 2 * SHM_V, pa, r32, hi); partialSM(pB0, nb, plB);
  finishSM(pB1, nb, plB, pa); SBAR();
  pv_d0(o, lacc, V_lds + 3 * SHM_V, pa, r32, hi);
  { const int ln2 = opaque_tid(wave_id) & 63, r32e = ln2 & 31, hie = ln2 >> 5;
    bf16* Ow = Ob + (long)(wid * QBLK) * LDO;
#pragma unroll
    for (int r = 0; r < 16; ++r) { const int orow = crow(r, hie); const float rl = __builtin_amdgcn_rcpf(lacc[r]);
      for (int d0 = 0; d0 < 4; ++d0) Ow[(long)orow * LDO + d0 * 32 + r32e] = (bf16)f2bf(o[d0][r] * rl); } }
  __syncthreads();
#undef SLOAD
#undef TBAR
#undef STEP_IO
#undef STEP_A
#undef STEP_B
#undef SWRITE
#undef SWAIT
}
#undef K8SW
#undef V8SW
}
constexpr int NWAVES = 8, NTHREADS = 512;
struct Args { const float* in[36]; float* out; unsigned char* ws; int ph_lo, ph_hi; };
enum InIdx { I_X = 0, I_C, I_CTX, I_CCTX, I_ADAW, I_ADAB, I_N1G, I_N2G, I_WOUT, I_RW, I_RB, I_EW1, I_EB1, I_EW2, I_EB2, I_AWIN, I_AQG, I_AKG,
             I_GWIN, I_GVG, I_GWS, I_GBS, I_HWIN, I_HCW, I_HCB, I_FW1, I_FB1, I_FW2, I_FB2, I_FW3, I_FB3, I_FW4, I_FB4, I_FREQ, I_HD, I_FG };
struct Frame {
    LAS unsigned char* lds; volatile LAS unsigned* MISC; gu32* ctl;
    int tid, lane, wave, G, bx;
    float* out; unsigned char* ws;
};
template <class T> __device__ __forceinline__ T* launder(T* p) { unsigned long long v = (unsigned long long)p; asm volatile("" : "+s"(v)); return (T*)(GAS T*)v; }
constexpr int MW_PTRS = 640;
__device__ __forceinline__ const float* pin_load(const Frame& F, int i) {
    const unsigned lo = __builtin_amdgcn_readfirstlane(F.MISC[MW_PTRS + 2 * i]), hi = __builtin_amdgcn_readfirstlane(F.MISC[MW_PTRS + 2 * i + 1]);
    return (const float*)(GAS const float*)(((unsigned long long)hi << 32) | lo);
}
#define PIN(F, i) pin_load(F, i)
__device__ __forceinline__ Frame phase_frame(const Frame& F0) {
    Frame F = F0; F.tid = opaque_tid(F0.wave); F.lane = F.tid & 63; F.wave = F0.wave;
    F.ws = launder(F0.ws); F.out = launder(F0.out); F.ctl = (gu32*)(F.ws + WS_CTL);
    { LAS unsigned char* l = F0.lds; asm volatile("" : "+s"(l)); F.lds = l; F.MISC = (volatile LAS unsigned*)(l + MISC_OFF); }
    return F;
}
constexpr int PH_PRO0 = 0, PH_PRO1 = 1, PH_L0 = 2, PH_PER_LAYER = 9, PH_FINAL = PH_L0 + NLAYER * PH_PER_LAYER, PH_COUNT = PH_FINAL + 1;
enum LPhase { LP_NORM1 = 0, LP_INPROJ, LP_MIX1, LP_MIX2, LP_MIX3, LP_OUTPROJ, LP_NORM2, LP_MOE1, LP_MOE2 };

struct TItem { const float* src; unsigned char* dst; int N; bool fp8; };
__device__ __forceinline__ TItem titem_decode(Frame& F, int it) {
    constexpr int R0 = 128 * 512, R1 = 128 * 256, R2 = 2 * 384, R3 = 512, R4 = 768;
    int r = it; TItem t;
    if (r < R0) { const int mi = r >> 9, q = r & 511, kb = q >> 5, nb = q & 31, n0 = nb * 64;
        const int d0 = n0 < 1024 ? 256 * (n0 >> 7) + (n0 & 127) : 256 * ((n0 - 1024) >> 7) + 128 + (n0 & 127);
        t.src = PIN(F, I_EW1) + (size_t)mi * 1024 * 2048 + (size_t)(kb * 64) * 2048 + n0; t.N = 2048; t.fp8 = true; t.dst = F.ws + WS_WE1 + (size_t)mi * 2048 * 1024 + (size_t)d0 * 1024 + kb * 64; return t; } r -= R0;
    if (r < R1) { const int mi = r >> 8, q = r & 255, kb = q >> 4, nb = q & 15;
        t.src = PIN(F, I_EW2) + (size_t)mi * 1024 * 1024 + (size_t)(kb * 64) * 1024 + nb * 64; t.N = 1024; t.fp8 = true; t.dst = F.ws + WS_WE2 + (size_t)mi * 1024 * 1024 + (size_t)(nb * 64) * 1024 + kb * 64; return t; } r -= R1;
    if (r < R2) { const int mi = r / 384, q = r % 384, kb = q / 24, nb = q % 24;
        t.src = PIN(F, I_AWIN) + (size_t)mi * 1024 * 1536 + (size_t)(kb * 64) * 1536 + nb * 64; t.N = 1536; t.fp8 = true; t.dst = F.ws + WS_WATT + (size_t)mi * 1536 * 1024 + (size_t)(nb * 64) * 1024 + kb * 64; return t; } r -= R2;
    if (r < R3) { const int kb = r >> 5, nb = r & 31;
        t.src = PIN(F, I_GWIN) + (size_t)(kb * 64) * 2048 + nb * 64; t.N = 2048; t.fp8 = false; t.dst = F.ws + WS_WGM + ((size_t)(nb * 64) * 1024 + kb * 64) * 2; return t; } r -= R3;
    if (r < R4) { const int kb = r / 48, nb = r % 48;
        t.src = PIN(F, I_HWIN) + (size_t)(kb * 64) * 3072 + nb * 64; t.N = 3072; t.fp8 = false; t.dst = F.ws + WS_WHY + ((size_t)(nb * 64) * 1024 + kb * 64) * 2; return t; } r -= R4;
    { const int mi = r >> 8, q = r & 255, kb = q >> 4, nb = q & 15;
        t.src = PIN(F, I_WOUT) + (size_t)mi * 1024 * 1024 + (size_t)(kb * 64) * 1024 + nb * 64; t.N = 1024; t.fp8 = false; t.dst = F.ws + WS_WOUT + ((size_t)mi * 1024 * 1024 + (size_t)(nb * 64) * 1024 + kb * 64) * 2; return t; }
}
__device__ __forceinline__ void titem_load(const TItem& t, float (&v)[64], int lane) {
    const float* src = t.src + lane;
#pragma unroll
    for (int kk = 0; kk < 64; ++kk) v[kk] = src[(size_t)kk * t.N];
}
__device__ __forceinline__ void titem_finish(const TItem& t, const float (&v)[64], LAS float* scr, int lane) {
    constexpr int K = 1024;
#pragma unroll
    for (int kk = 0; kk < 64; ++kk) scr[kk * 65 + lane] = v[kk];
    LDS_WAIT(); asm volatile("" ::: "memory");
    if (!t.fp8) {
        const int c = lane & 7;
#pragma unroll
        for (int j = 0; j < 8; ++j) { const int n = (lane >> 3) + 8 * j; const LAS float* s = scr + (8 * c) * 65 + n;
            v4u o; o.x = pk2(s[0 * 65], s[1 * 65]); o.y = pk2(s[2 * 65], s[3 * 65]); o.z = pk2(s[4 * 65], s[5 * 65]); o.w = pk2(s[6 * 65], s[7 * 65]);
            *(GAS v4u*)(t.dst + ((size_t)n * K + 8 * c) * 2) = o; }
    } else {
        const int c = lane & 3;
#pragma unroll
        for (int j = 0; j < 4; ++j) { const int n = (lane >> 2) + 16 * j; const LAS float* s = scr + (16 * c) * 65 + n; unsigned w[4];
#pragma unroll
            for (int q = 0; q < 4; ++q) { unsigned x = 0; x = __builtin_amdgcn_cvt_pk_fp8_f32(32.0f * s[(4 * q) * 65], 32.0f * s[(4 * q + 1) * 65], x, false);
                x = __builtin_amdgcn_cvt_pk_fp8_f32(32.0f * s[(4 * q + 2) * 65], 32.0f * s[(4 * q + 3) * 65], x, true); w[q] = x; }
            *(GAS v4u*)(t.dst + (size_t)n * K + 16 * c) = (v4u){w[0], w[1], w[2], w[3]}; }
    }
    LDS_WAIT(); asm volatile("" ::: "memory");
}
__device__ __forceinline__ void pro0_transposes(Frame& F) {
    LAS float* scr = (LAS float*)(F.lds + F.wave * 16640);
    const int gw = F.bx * NWAVES + F.wave, NGW = F.G * NWAVES;
    constexpr int NITEMS = 128 * 512 + 128 * 256 + 2 * 384 + 512 + 768 + 4 * 256;
    float va[64], vb[64];
    int it = gw; if (it >= NITEMS) return;
    TItem ta = titem_decode(F, it), tb = ta; titem_load(ta, va, F.lane);
    for (;;) {
        const bool nb_ok = it + NGW < NITEMS; if (nb_ok) { tb = titem_decode(F, it + NGW); titem_load(tb, vb, F.lane); }
        titem_finish(ta, va, scr, F.lane);
        if (!nb_ok) break; it += NGW;
        const bool na_ok = it + NGW < NITEMS; if (na_ok) { ta = titem_decode(F, it + NGW); titem_load(ta, va, F.lane); }
        titem_finish(tb, vb, scr, F.lane);
        if (!na_ok) break; it += NGW;
    }
}
__device__ __forceinline__ void pro0_mod(Frame& F) {
    LAS float* sl = (LAS float*)F.lds;
    LAS float* red = (LAS float*)(F.lds + 65536);
    __syncthreads();
    for (int i = F.tid; i < 9 * 1024; i += NTHREADS) { const int r = i >> 10, k = i & 1023; const float v = r < 8 ? PIN(F, I_C)[r * 1024 + k] : PIN(F, I_CCTX)[k]; sl[i] = v / (1.0f + __expf(-v)); }
    __syncthreads();
    float* MOD = (float*)(F.ws + WS_MOD);
    for (int item = F.bx; item < NLAYER * 96; item += F.G) {
        const int l = item / 96, n0 = (item % 96) * 64;
        const float* W = PIN(F, I_ADAW) + (size_t)l * 1024 * 6144 + n0 + F.lane;
        float acc[9];
#pragma unroll
        for (int r = 0; r < 9; ++r) acc[r] = 0.f;
        const int kb = F.wave * 128;
#pragma unroll 16
        for (int k = 0; k < 128; ++k) { const float wv = W[(size_t)(kb + k) * 6144];
#pragma unroll
            for (int r = 0; r < 9; ++r) acc[r] += sl[r * 1024 + kb + k] * wv; }
#pragma unroll
        for (int r = 0; r < 9; ++r) red[(F.wave * 9 + r) * 64 + F.lane] = acc[r];
        __syncthreads();
        for (int i = F.tid; i < 9 * 64; i += NTHREADS) { const int r = i >> 6, n = i & 63; float s = 0.f;
#pragma unroll
            for (int w = 0; w < 8; ++w) s += red[(w * 9 + r) * 64 + n];
            MOD[((size_t)l * 9 + r) * 6144 + n0 + n] = s + PIN(F, I_ADAB)[l * 6144 + n0 + n]; }
        __syncthreads();
    }
}
__device__ __forceinline__ void pro0_filter_mlp(Frame& F) {
    const int j = F.lane, gw = F.bx * NWAVES + F.wave, NGW = F.G * NWAVES;
    LAS float* W1 = (LAS float*)F.lds; LAS float* W2 = W1 + FEMB * FH; LAS float* W3 = W2 + FH * FH;
    __syncthreads();
    for (int i = F.tid; i < FEMB * FH; i += NTHREADS) W1[i] = PIN(F, I_FW1)[i];
    for (int i = F.tid; i < FH * FH; i += NTHREADS) { W2[i] = PIN(F, I_FW2)[i]; W3[i] = PIN(F, I_FW3)[i]; }
    __syncthreads();
    const float b1 = PIN(F, I_FB1)[j], b2 = PIN(F, I_FB2)[j], b3 = PIN(F, I_FB3)[j], fr = PIN(F, I_FREQ)[j];
    for (int it = gw; it < SEQ + CL; it += NGW) {
        const bool lat = it < SEQ; const int t = lat ? it : it - SEQ; const float L = lat ? (float)SEQ : (float)CL;
        const float tl = (float)t / (L - 1.0f), w = (6.283185307179586f * (float)t) / L;
        float z;
        { const int band = (j - 1) & 15; const float f = 1e-4f + (float)band * ((15.0f - 1e-4f) / 15.0f); const float a = f * w;
          z = (j == 0) ? tl : (j <= 16 ? cosf(a) : -sinf(a)); }
        float s = b1;
#pragma unroll
        for (int i = 0; i < FEMB; ++i) s += __shfl(z, i) * W1[i * FH + j];
        const float a1 = sinf(fr * s);
        s = b2;
#pragma unroll 16
        for (int i = 0; i < FH; ++i) s += __shfl(a1, i) * W2[i * FH + j];
        const float a2 = sinf(fr * s);
        s = b3;
#pragma unroll 16
        for (int i = 0; i < FH; ++i) s += __shfl(a2, i) * W3[i * FH + j];
        const float a3 = sinf(fr * s);
        float* dst = lat ? (float*)(F.ws + WS_A3) + (size_t)t * FH : (float*)(F.ws + WS_A3C) + (size_t)t * FH;
        dst[j] = a3;
    }
    __syncthreads();
}

__device__ __forceinline__ f32x2 cmul(f32x2 a, f32x2 b) { return (f32x2){a.x * b.x - a.y * b.y, a.x * b.y + a.y * b.x}; }
__device__ __forceinline__ f32x2 cconj(f32x2 a) { return (f32x2){a.x, -a.y}; }
#define ZP(n) ((n) + ((n) >> 5))
constexpr int FFT_LDS_BYTES = (NFFT + NFFT / 32) * 8;
__device__ __forceinline__ void bfly_dif(f32x2& a0, f32x2& a1, f32x2& a2, f32x2& a3, f32x2 w) {
    const f32x2 t0 = a0 + a2, t1 = a0 - a2, t2 = a1 + a3, d = a1 - a3, t3 = (f32x2){d.y, -d.x};
    const f32x2 y0 = t0 + t2, y2 = t0 - t2, y1 = t1 + t3, y3 = t1 - t3, w2 = cmul(w, w), w3 = cmul(w2, w);
    a0 = y0; a1 = cmul(y2, w2); a2 = cmul(y1, w); a3 = cmul(y3, w3);
}
__device__ __forceinline__ void bfly_dit(f32x2& a0, f32x2& a1, f32x2& a2, f32x2& a3, f32x2 w) {
    const f32x2 w2 = cmul(w, w), w3 = cmul(w2, w), A1 = cmul(a1, w2), A2 = cmul(a2, w), A3 = cmul(a3, w3);
    const f32x2 u0 = a0 + A1, u1 = a0 - A1, u2 = A2 + A3, u3 = A2 - A3, iu3 = (f32x2){-u3.y, u3.x};
    a0 = u0 + u2; a1 = u1 + iu3; a2 = u0 - u2; a3 = u1 - iu3;
}
template <int LQ, bool INV> __device__ __forceinline__ void fft_r16(LAS f32x2* z, int tid) {
    constexpr int q16 = 1 << LQ; constexpr float inv_lb = 1.0f / (float)(16 * q16);
    constexpr float C1 = 0.92387953251128674f, S1 = 0.38268343236508977f, C2 = 0.70710678118654752f;
    asm volatile("" : "+v"(tid));
#pragma unroll 1
    for (int g = tid; g < NFFT / 16; g += NTHREADS) {
        const int j = g & (q16 - 1), base = ((g >> LQ) << (LQ + 4)) + j;
        f32x2 x[16];
#pragma unroll
        for (int m = 0; m < 16; ++m) x[m] = z[ZP(base + (m << LQ))];
        const float fr = (float)j * inv_lb; const float sn = __builtin_amdgcn_sinf(fr);
        const f32x2 w1 = (f32x2){__builtin_amdgcn_cosf(fr), INV ? sn : -sn};
        const float sg = INV ? 1.0f : -1.0f;
        const f32x2 wa0 = w1, wa1 = cmul(w1, (f32x2){C1, sg * S1}), wa2 = cmul(w1, (f32x2){C2, sg * C2}), wa3 = cmul(w1, (f32x2){S1, sg * C1});
        const f32x2 w2 = cmul(w1, w1), wb = cmul(w2, w2);
        if constexpr (!INV) {
            bfly_dif(x[0], x[4], x[8], x[12], wa0); bfly_dif(x[1], x[5], x[9], x[13], wa1); bfly_dif(x[2], x[6], x[10], x[14], wa2); bfly_dif(x[3], x[7], x[11], x[15], wa3);
#pragma unroll
            for (int a = 0; a < 4; ++a) bfly_dif(x[4 * a], x[4 * a + 1], x[4 * a + 2], x[4 * a + 3], wb);
        } else {
#pragma unroll
            for (int a = 0; a < 4; ++a) bfly_dit(x[4 * a], x[4 * a + 1], x[4 * a + 2], x[4 * a + 3], wb);
            bfly_dit(x[0], x[4], x[8], x[12], wa0); bfly_dit(x[1], x[5], x[9], x[13], wa1); bfly_dit(x[2], x[6], x[10], x[14], wa2); bfly_dit(x[3], x[7], x[11], x[15], wa3);
        }
#pragma unroll
        for (int m = 0; m < 16; ++m) z[ZP(base + (m << LQ))] = x[m];
    }
    __syncthreads();
}
template <bool INV> __device__ __forceinline__ void fft_r4_unit(LAS f32x2* z, int tid) {
    asm volatile("" : "+v"(tid));
#pragma unroll 2
    for (int bf = tid; bf < NFFT / 4; bf += NTHREADS) {
        const int base = 4 * bf; f32x2 a0 = z[ZP(base)], a1 = z[ZP(base + 1)], a2 = z[ZP(base + 2)], a3 = z[ZP(base + 3)];
        if constexpr (!INV) { const f32x2 t0 = a0 + a2, t1 = a0 - a2, t2 = a1 + a3, d = a1 - a3, t3 = (f32x2){d.y, -d.x};
            z[ZP(base)] = t0 + t2; z[ZP(base + 1)] = t0 - t2; z[ZP(base + 2)] = t1 + t3; z[ZP(base + 3)] = t1 - t3; }
        else { const f32x2 u0 = a0 + a1, u1 = a0 - a1, u2 = a2 + a3, u3 = a2 - a3, iu3 = (f32x2){-u3.y, u3.x};
            z[ZP(base)] = u0 + u2; z[ZP(base + 1)] = u1 + iu3; z[ZP(base + 2)] = u0 - u2; z[ZP(base + 3)] = u1 - iu3; }
    }
    __syncthreads();
}
__device__ __forceinline__ void fft16k_dif(LAS f32x2* z, int tid) { fft_r16<10, false>(z, tid); fft_r16<6, false>(z, tid); fft_r16<2, false>(z, tid); fft_r4_unit<false>(z, tid); }
__device__ __forceinline__ void fft16k_dit_inv(LAS f32x2* z, int tid) { fft_r4_unit<true>(z, tid); fft_r16<2, true>(z, tid); fft_r16<6, true>(z, tid); fft_r16<10, true>(z, tid); }
constexpr int KF_LD = 8256;
__device__ __forceinline__ int rev14(int p) { return (int)(__brev((unsigned)p) >> 18); }
__device__ __forceinline__ float hy_delta(int c) { const float mn = -3.0701134573253945f, mx = -15.350567286626973f; return fabsf(mn + (mx - mn) * ((float)c / 1023.0f)); }

__device__ __forceinline__ void pro1_router_split(Frame& F) {
    const float* MOD = (const float*)(F.ws + WS_MOD); unsigned char* RW3 = F.ws + WS_RW3;
    for (int ent = F.bx * NTHREADS + F.tid; ent < NLAYER * 9 * 8 * 8 * 64; ent += F.G * NTHREADS) {
        const int lane = ent & 63, kb = (ent >> 6) & 7, w = (ent >> 9) & 7, lb = ent >> 12, l = lb / 9;
        const int k0 = w * 128 + 16 * kb + 8 * (lane >> 5), e = lane & 31;
        const float* gn = PIN(F, I_N2G) + l * D; const float* sc = MOD + (size_t)lb * 6144 + 4 * 1024; const float* rw = PIN(F, I_RW) + (size_t)l * D * NE;
        unsigned ph[4], pm[4], pl[4];
#pragma unroll
        for (int j2 = 0; j2 < 4; ++j2) { const int k = k0 + 2 * j2; const float v0 = gn[k] * (1.0f + sc[k]) * rw[(size_t)k * NE + e], v1 = gn[k + 1] * (1.0f + sc[k + 1]) * rw[(size_t)(k + 1) * NE + e];
            const unsigned h = cvt_pk_bf16(v0, v1); const float r0 = v0 - __uint_as_float(h << 16), r1 = v1 - __uint_as_float(h & 0xffff0000u);
            const unsigned m = cvt_pk_bf16(r0, r1); const float s0 = r0 - __uint_as_float(m << 16), s1 = r1 - __uint_as_float(m & 0xffff0000u);
            ph[j2] = h; pm[j2] = m; pl[j2] = cvt_pk_bf16(s0, s1); }
        v4u* dst = (v4u*)(RW3 + (size_t)(ent >> 6) * 3 * 1024) + lane;
        dst[0] = (v4u){ph[0], ph[1], ph[2], ph[3]}; dst[64] = (v4u){pm[0], pm[1], pm[2], pm[3]}; dst[128] = (v4u){pl[0], pl[1], pl[2], pl[3]};
    }
}
__device__ __forceinline__ void pro1_filters(Frame& F) {
    if (F.bx < NLAYER * 9) {
        const int lb = F.bx, l = lb / 9, e = F.lane & 31, hf = F.lane >> 5; const float* sh = (const float*)(F.ws + WS_MOD) + (size_t)lb * 6144 + 3 * 1024; const float* rw = PIN(F, I_RW) + (size_t)l * D * NE;
        LAS float* red = (LAS float*)F.lds; const int k0 = F.wave * 128 + hf * 64; float acc = 0.f;
#pragma unroll 8
        for (int k = k0; k < k0 + 64; ++k) acc += sh[k] * rw[(size_t)k * NE + e];
        acc += shx(acc, 32, F.lane); if (F.lane < 32) red[F.wave * 32 + e] = acc;
        __syncthreads();
        if (F.tid < 32) { float s = PIN(F, I_RB)[l * NE + F.tid];
#pragma unroll
            for (int w = 0; w < 8; ++w) s += red[w * 32 + F.tid];
            ((float*)(F.ws + WS_RC))[lb * NE + F.tid] = s; }
    }
    LAS f32x2* z = (LAS f32x2*)F.lds;
    LAS float* wl = (LAS float*)(F.lds + AUX_OFF + 8192);
    const float* a3 = (const float*)(F.ws + WS_A3); const float* a3c = (const float*)(F.ws + WS_A3C);
    f32x2* KF = (f32x2*)(F.ws + WS_KF); float* FCT = (float*)(F.ws + WS_FCT);
    for (int u = F.bx; u < 512; u += F.G) {
        const int ca = 2 * u, cb = 2 * u + 1;
        __syncthreads();
        if (F.tid < 256) { const int which = F.tid >> 6, m = F.tid & 63; const int col = (which & 1 ? cb : ca) + (which >> 1) * 1024; wl[which * 64 + m] = PIN(F, I_FW4)[m * 2048 + col]; }
        if (F.tid < 4) { const int col = (F.tid & 1 ? cb : ca) + (F.tid >> 1) * 1024; wl[256 + F.tid] = PIN(F, I_FB4)[col]; }
        __syncthreads();
        const float da = hy_delta(ca), db = hy_delta(cb);
        const float dska = PIN(F, I_HD)[ca], dskb = PIN(F, I_HD)[cb];
        for (int t = F.tid; t < SEQ; t += NTHREADS) {
            const f32x4* ar = (const f32x4*)(a3 + (size_t)t * FH); float s0 = wl[256], s1 = wl[257], s2 = wl[258], s3 = wl[259];
#pragma unroll 8
            for (int m4 = 0; m4 < 16; ++m4) { const f32x4 a = ar[m4];
#pragma unroll
                for (int i = 0; i < 4; ++i) { const int m = m4 * 4 + i; s0 += a[i] * wl[m]; s1 += a[i] * wl[64 + m]; s2 += a[i] * wl[128 + m]; s3 += a[i] * wl[192 + m]; } }
            const float tl = (float)t / (float)(SEQ - 1); const float wa = __expf(-tl * da), wb = __expf(-tl * db);
            z[ZP(t)] = (f32x2){s0 * wa + (t == 0 ? dska : 0.f), s1 * wb + (t == 0 ? dskb : 0.f)};
            if (t == 0) z[ZP(SEQ)] = (f32x2){0.f, 0.f}; else z[ZP(NFFT - t)] = (f32x2){s2 * wa, s3 * wb};
        }
        for (int i = F.tid; i < 511; i += NTHREADS) {
            const int d = i - 255, t = d < 0 ? -d : d; const int o = d < 0 ? 2 : 0;
            const f32x4* ar = (const f32x4*)(a3c + (size_t)t * FH); float sa = wl[256 + o], sb = wl[257 + o];
            f32x4 av[16];
#pragma unroll
            for (int m4 = 0; m4 < 16; ++m4) av[m4] = ar[m4];
            __builtin_amdgcn_sched_barrier(0);
#pragma unroll
            for (int m4 = 0; m4 < 16; ++m4) {
#pragma unroll
                for (int i2 = 0; i2 < 4; ++i2) { const int m = m4 * 4 + i2; sa += av[m4][i2] * wl[o * 64 + m]; sb += av[m4][i2] * wl[(o + 1) * 64 + m]; }
                if ((m4 & 3) == 3) __builtin_amdgcn_sched_barrier(0); }
            const float tl = (float)t / (float)(CL - 1);
            FCT[(size_t)ca * 512 + d + 256] = sa * __expf(-tl * da) + (d == 0 ? dska : 0.f); FCT[(size_t)cb * 512 + d + 256] = sb * __expf(-tl * db) + (d == 0 ? dskb : 0.f);
        }
        __syncthreads();
        fft16k_dif(z, F.tid);
        for (int k = F.tid; k <= NFFT / 2; k += NTHREADS) {
            const int p = rev14(k), p2 = rev14((NFFT - k) & (NFFT - 1)); const f32x2 a = z[ZP(p)], b = z[ZP(p2)];
            KF[(size_t)ca * KF_LD + k] = (f32x2){0.5f * (a.x + b.x), 0.5f * (a.y - b.y)};
            KF[(size_t)cb * KF_LD + k] = (f32x2){0.5f * (a.y + b.y), -0.5f * (a.x - b.x)};
        }
    }
    __syncthreads();
}

__device__ __forceinline__ void hyena_conv_phase(Frame& F) {
    LAS f32x2* z = (LAS f32x2*)F.lds;
    LAS float* aux = (LAS float*)(F.lds + AUX_OFF + 8192);
    const float* VT = (const float*)(F.ws + WS_VT); const float* VTC = (const float*)(F.ws + WS_VTC); float* CT = (float*)(F.ws + WS_CT); float* CTC = (float*)(F.ws + WS_CTC);
    const f32x2* KF = (const f32x2*)(F.ws + WS_KF); const float* FCT = (const float*)(F.ws + WS_FCT);
    v4u ina[2], inb[2];
#define HC_LOADIN(u_, t_) do { const int b_ = (u_) >> 9, c_ = 2 * ((u_) & 511); const v4u* va_ = (const v4u*)((const bf16*)VT + ((size_t)b_ * 1024 + c_) * SEQ + 16 * (t_)); \
        ina[0] = va_[0]; ina[1] = va_[1]; inb[0] = va_[SEQ / 8]; inb[1] = va_[SEQ / 8 + 1]; } while (0)
    if (F.bx < NB * 512) HC_LOADIN(F.bx, F.tid);
    for (int u = F.bx; u < NB * 512; u += F.G) {
        const int b = u >> 9, cp = u & 511, ca = 2 * cp, cb = ca + 1;
        int tq = F.tid; asm volatile("" : "+v"(tq));
        __syncthreads();
        { const int n0 = 16 * tq;
#pragma unroll
          for (int i = 0; i < 4; ++i) { const unsigned a0 = ina[i >> 1][2 * (i & 1)], a1 = ina[i >> 1][2 * (i & 1) + 1], b0 = inb[i >> 1][2 * (i & 1)], b1 = inb[i >> 1][2 * (i & 1) + 1];
              z[ZP(n0 + 4 * i)] = (f32x2){bflo(a0), bflo(b0)}; z[ZP(n0 + 4 * i + 1)] = (f32x2){bfhi(a0), bfhi(b0)}; z[ZP(n0 + 4 * i + 2)] = (f32x2){bflo(a1), bflo(b1)}; z[ZP(n0 + 4 * i + 3)] = (f32x2){bfhi(a1), bfhi(b1)};
#pragma unroll
              for (int j = 0; j < 4; ++j) z[ZP(SEQ + n0 + 4 * i + j)] = (f32x2){0.f, 0.f}; } }
        f32x4 ka[8], kb[8]; f32x2 kaN, kbN;
        { const f32x4* pa = (const f32x4*)(KF + (size_t)ca * KF_LD + 16 * tq); const f32x4* pb = (const f32x4*)(KF + (size_t)cb * KF_LD + 16 * tq);
#pragma unroll
          for (int i = 0; i < 8; ++i) { ka[i] = pa[i]; kb[i] = pb[i]; }
          kaN = KF[(size_t)ca * KF_LD + NFFT / 2]; kbN = KF[(size_t)cb * KF_LD + NFFT / 2]; }
        { const int h = tq >> 8, t = tq & 255; const float* vc = VTC + ((size_t)b * 1024 + ca + h) * CL;
          aux[h * 256 + t] = vc[t]; aux[512 + h * 512 + t] = FCT[(size_t)(ca + h) * 512 + t]; aux[512 + h * 512 + 256 + t] = FCT[(size_t)(ca + h) * 512 + 256 + t];
          __syncthreads();
          float y = 0.f;
#pragma unroll 8
          for (int s = 0; s < CL; ++s) y += aux[h * 256 + s] * aux[512 + h * 512 + (t - s) + 256];
          CTC[((size_t)b * 1024 + ca + h) * CL + t] = y; }
        fft16k_dif(z, F.tid);
        int tpw = tq; asm volatile("" : "+v"(tpw));
#define HC_PW(k_, Ka_, Kb_) do { const int p = rev14(k_), p2 = rev14((NFFT - (k_)) & (NFFT - 1)); const f32x2 a = z[ZP(p)], b2 = z[ZP(p2)]; \
            const f32x2 Va = (f32x2){0.5f * (a.x + b2.x), 0.5f * (a.y - b2.y)}, Vb = (f32x2){0.5f * (a.y + b2.y), -0.5f * (a.x - b2.x)}; \
            const f32x2 ya = cmul(Va, Ka_), yb = cmul(Vb, Kb_); \
            z[ZP(p)] = (f32x2){ya.x - yb.y, ya.y + yb.x}; z[ZP(p2)] = (f32x2){ya.x + yb.y, -ya.y + yb.x}; } while (0)
#pragma unroll
        for (int i = 0; i < 8; ++i) { const int k = 16 * tpw + 2 * i;
            HC_PW(k, ((f32x2){ka[i].x, ka[i].y}), ((f32x2){kb[i].x, kb[i].y})); HC_PW(k + 1, ((f32x2){ka[i].z, ka[i].w}), ((f32x2){kb[i].z, kb[i].w}));
            asm volatile("" ::: "memory"); }
        if (tpw == 0) HC_PW(NFFT / 2, kaN, kbN);
#undef HC_PW
        __syncthreads();
        if (u + F.G < NB * 512) HC_LOADIN(u + F.G, tq);
        fft16k_dit_inv(z, F.tid);
        { int to = tq; asm volatile("" : "+v"(to)); const float sc = 1.0f / (float)NFFT; const int n0 = 16 * to;
          v4u* oa = (v4u*)((bf16*)CT + ((size_t)b * 1024 + ca) * SEQ + n0);
#pragma unroll
          for (int h2 = 0; h2 < 2; ++h2) { f32x2 w[8];
#pragma unroll
              for (int j = 0; j < 8; ++j) w[j] = z[ZP(n0 + 8 * h2 + j)];
              oa[h2] = (v4u){cvt_pk_bf16(w[0].x * sc, w[1].x * sc), cvt_pk_bf16(w[2].x * sc, w[3].x * sc), cvt_pk_bf16(w[4].x * sc, w[5].x * sc), cvt_pk_bf16(w[6].x * sc, w[7].x * sc)};
              oa[SEQ / 8 + h2] = (v4u){cvt_pk_bf16(w[0].y * sc, w[1].y * sc), cvt_pk_bf16(w[2].y * sc, w[3].y * sc), cvt_pk_bf16(w[4].y * sc, w[5].y * sc), cvt_pk_bf16(w[6].y * sc, w[7].y * sc)}; } }
    }
    __syncthreads();
#undef HC_LOADIN
}
constexpr int MW_CUMBLK = 16, MW_CNT = 64, MW_SELE = 128, MW_SELV = 256, MW_LRANK = 384, MW_LBASE = 512;
__device__ __forceinline__ void moe_tables(Frame& F, int layer) {
    __syncthreads();
    if (F.tid < NE) F.MISC[MW_CNT + F.tid] = __hip_atomic_load(F.ctl + CW_CNT + layer * NE + F.tid, RLX_AGENT);
    __syncthreads();
    if (F.tid == 0) { unsigned c = 0; for (int e = 0; e < NE; ++e) { F.MISC[MW_CUMBLK + e] = c; c += (F.MISC[MW_CNT + e] + 255u) >> 8; } F.MISC[MW_CUMBLK + NE] = c; }
    __syncthreads();
}

template <int MODE> __device__ __forceinline__ void rowpass(Frame& F, int layer, bool real = true, bool h8 = false) {
    const bool combine = (MODE == 0 && layer > 0) || MODE == 2;
    const int nrows = MODE == 2 ? ML : MT;
    const int cl = MODE == 2 ? NLAYER - 1 : layer - 1;
    const bool from_input = (MODE == 0 && layer == 0);
    const float* XLs = PIN(F, I_X); const float* XCs = PIN(F, I_CTX);
    bf16* XB = (bf16*)(F.ws + WS_XB); bf16* XBd = real ? XB : (bf16*)(F.ws + WS_P);
    const float* MOD = (const float*)(F.ws + WS_MOD);
    bf16* H = (bf16*)(F.ws + WS_H); unsigned char* H8 = (unsigned char*)(F.ws + WS_H8); const unsigned char* YM = (const unsigned char*)(F.ws + WS_YM);
    const int* TE = (const int*)(F.ws + WS_TE); const int* TR = (const int*)(F.ws + WS_TR); const float* TG = (const float*)(F.ws + WS_TG);
    const float* gnorm = MODE == 0 ? PIN(F, I_N1G) + layer * D : PIN(F, I_FG);
    if (combine) moe_tables(F, cl);
    f32x4 gn[4];
#pragma unroll
    for (int j = 0; j < 4; ++j) gn[j] = ((const f32x4*)gnorm)[F.lane + 64 * j];
    const int ntiles = nrows / 32;
    i32x4 nte[4], ntr[4]; f32x4 ntg[4];
#define RP_TABLES(tile_) do { const size_t rb_ = (size_t)((tile_) * 32 + F.wave * 4) * 4; \
        _Pragma("unroll") for (int q = 0; q < 4; ++q) { nte[q] = *(const i32x4*)(TE + rb_ + 4 * q); ntr[q] = *(const i32x4*)(TR + rb_ + 4 * q); ntg[q] = *(const f32x4*)(TG + rb_ + 4 * q); } } while (0)
    if (combine && F.bx < ntiles) RP_TABLES(F.bx);
    for (int tile = F.bx; tile < ntiles; tile += F.G) {
        const int rbase = tile * 32 + F.wave * 4; const bool lat = rbase < ML; const int bidx = lat ? (rbase >> 13) : 8;
        const float* g2 = MOD + ((size_t)(combine ? cl : 0) * 9 + bidx) * 6144 + 5 * 1024;
        const float* mb = MOD + ((size_t)layer * 9 + bidx) * 6144;
        int rid[4][4]; float gkk[4][4];
        if (combine) {
#pragma unroll
            for (int q = 0; q < 4; ++q)
#pragma unroll
                for (int k = 0; k < 4; ++k) { rid[q][k] = 256 * (int)F.MISC[MW_CUMBLK + nte[q][k]] + ntr[q][k]; gkk[q][k] = ntg[q][k]; }
            if (tile + F.G < ntiles) RP_TABLES(tile + F.G);
        }
#pragma unroll 1
        for (int pr = 0; pr < 2; ++pr) {
            size_t xo[2]; f32x4 v[2][4]; int rowid[2][4]; float gk[2][4];
#pragma unroll
            for (int u = 0; u < 2; ++u) { const int r = rbase + 2 * pr + u; xo[u] = (size_t)r * D;
                if (combine) {
#pragma unroll
                    for (int k = 0; k < 4; ++k) { rowid[u][k] = pr ? rid[2 + u][k] : rid[u][k]; gk[u][k] = pr ? gkk[2 + u][k] : gkk[u][k]; } }
                if (from_input) { const f32x4* xs = (const f32x4*)(lat ? XLs + xo[u] : XCs + (xo[u] - (size_t)ML * D));
#pragma unroll
                    for (int j = 0; j < 4; ++j) v[u][j] = xs[F.lane + 64 * j]; }
                else { const v2u* xs = (const v2u*)(XB + xo[u]);
#pragma unroll
                    for (int j = 0; j < 4; ++j) v[u][j] = bf4_f32(xs[F.lane + 64 * j]); } }
            if (combine) {
                unsigned w[2][4][4];
#pragma unroll
                for (int u = 0; u < 2; ++u)
#pragma unroll
                    for (int k = 0; k < 4; ++k) { const unsigned* yr = (const unsigned*)(YM + (size_t)rowid[u][k] * D);
#pragma unroll
                        for (int j = 0; j < 4; ++j) w[u][k][j] = yr[F.lane + 64 * j]; }
#pragma unroll
                for (int u = 0; u < 2; ++u) {
#pragma unroll
                    for (int j = 0; j < 4; ++j) { f32x4 a = (f32x4){0.f, 0.f, 0.f, 0.f};
#pragma unroll
                        for (int k = 0; k < 4; ++k) { const f32x2 lo = __builtin_amdgcn_cvt_pk_f32_fp8(w[u][k][j], false), hi2 = __builtin_amdgcn_cvt_pk_f32_fp8(w[u][k][j], true); a += gk[u][k] * (f32x4){lo.x, lo.y, hi2.x, hi2.y}; }
                        v[u][j] += ((const f32x4*)g2)[F.lane + 64 * j] * a; }
                    if (MODE == 0) { v2u* xd = (v2u*)(XBd + xo[u]);
#pragma unroll
                        for (int j = 0; j < 4; ++j) { v2u o; o.x = cvt_pk_bf16(v[u][j].x, v[u][j].y); o.y = cvt_pk_bf16(v[u][j].z, v[u][j].w); xd[F.lane + 64 * j] = o; } } }
            }
            if (from_input) {
#pragma unroll
                for (int u = 0; u < 2; ++u) { v2u* xd = (v2u*)(XBd + xo[u]);
#pragma unroll
                    for (int j = 0; j < 4; ++j) { v2u o; o.x = cvt_pk_bf16(v[u][j].x, v[u][j].y); o.y = cvt_pk_bf16(v[u][j].z, v[u][j].w); xd[F.lane + 64 * j] = o; } } }
#pragma unroll
            for (int u = 0; u < 2; ++u) { const int r = rbase + 2 * pr + u;
                float ss = 0.f;
#pragma unroll
                for (int j = 0; j < 4; ++j) ss += (v[u][j].x * v[u][j].x + v[u][j].y * v[u][j].y) + (v[u][j].z * v[u][j].z + v[u][j].w * v[u][j].w);
                const float rstd = 1.0f / sqrtf(wave_sum(ss, F.lane) * (1.0f / D) + EPS);
                if (MODE == 2) { f32x4* od = (f32x4*)((real ? F.out : (float*)(F.ws + WS_P)) + xo[u]);
#pragma unroll
                    for (int j = 0; j < 4; ++j) od[F.lane + 64 * j] = v[u][j] * rstd * gn[j]; }
                else { v2u* hd = (v2u*)(H + (size_t)r * D); unsigned* hd8 = (unsigned*)(H8 + (size_t)r * D);
#pragma unroll
                    for (int j = 0; j < 4; ++j) { const f32x4 sh = ((const f32x4*)mb)[F.lane + 64 * j], sc = ((const f32x4*)(mb + 1024))[F.lane + 64 * j]; const f32x4 hv = v[u][j] * rstd * gn[j] * (sc + 1.0f) + sh;
                        if (h8) { unsigned o = 0; o = __builtin_amdgcn_cvt_pk_fp8_f32(hv.x, hv.y, o, false); o = __builtin_amdgcn_cvt_pk_fp8_f32(hv.z, hv.w, o, true); hd8[F.lane + 64 * j] = o; }
                        else { v2u o; o.x = cvt_pk_bf16(hv.x, hv.y); o.y = cvt_pk_bf16(hv.z, hv.w); hd[F.lane + 64 * j] = o; } } }
            }
        }
    }
}

typedef float f32x16r __attribute__((ext_vector_type(16)));
__device__ __forceinline__ void router_phase(Frame& F, int layer, bool real = true, int xp = 0) {
    const bool last = layer == NLAYER - 1;
    const int ntiles = (last ? ML : MT) / 32;
    LAS float* PART = (LAS float*)F.lds;
    LAS float* SSQ = PART + 8 * 32 * 33;
    LAS float* LG = SSQ + 8 * 32;
    LAS float* RSTD = LG + 32 * 33;
    LAS unsigned* CW = (LAS unsigned*)(RSTD + 32);
    LAS unsigned* RUN = CW + 64;
    LAS float* AV = (LAS float*)(RUN + 32);
    LAS float* SHV = AV + 1024;
    LAS float* RCV = SHV + 1024;
    LAS bf16* STG = (LAS bf16*)((LAS unsigned char*)(RCV + 32) + F.wave * (32 * 272));
    const bf16* XB = (const bf16*)(F.ws + WS_XB);
    const float* MOD = (const float*)(F.ws + WS_MOD); const float* RC = (const float*)(F.ws + WS_RC);
    unsigned char* H8 = (unsigned char*)(F.ws + WS_H8);
    int* TE = (int*)(F.ws + WS_TE); int* TR = (int*)(F.ws + WS_TR); float* TG = (float*)(F.ws + WS_TG); int* ROWTOK = (int*)(F.ws + WS_ROWTOK);
    const float* gn = PIN(F, I_N2G) + layer * D; const float* rw = PIN(F, I_RW) + (size_t)layer * D * NE;
    const int i = F.lane & 31, hf = F.lane >> 5, lr = F.lane >> 4, lc = F.lane & 15, kw = F.wave * 128;
    const int per = 2048 / F.G;
    const int nmine = (2048 % F.G == 0) ? per + ((2048 + F.bx < ntiles) ? 1 : 0) : 0;
#define RT_TILE(n_) ((2048 % F.G == 0) ? ((n_) < per ? F.bx * per + (n_) : 2048 + F.bx) : F.bx + (n_) * F.G)
    const int ncnt = (2048 % F.G == 0) ? nmine : (F.bx < ntiles ? (ntiles - 1 - F.bx) / F.G + 1 : 0);
    __syncthreads();
    if (F.tid < NE) RUN[F.tid] = 0u;
    bf16x8 bw[8][2];
    v2u rawp[16];
#define RT_LOADX(tile_) do { const int rb_ = (tile_) * 32 + lr; const bf16* xb_ = XB + (size_t)rb_ * D + kw + 4 * lc; \
        _Pragma("unroll") for (int q = 0; q < 16; ++q) rawp[q] = *(const v2u*)(xb_ + (size_t)(4 * (q & 7)) * D + 64 * (q >> 3)); } while (0)
    if (ncnt > 0) RT_LOADX(RT_TILE(0));
    int cur_b = -1;
    for (int n = 0; n < ncnt; ++n) {
        const int tile = RT_TILE(n);
        const int r0 = tile * 32; const bool lat = r0 < ML; const int bidx = lat ? (r0 >> 13) : 8; const int r = r0 + i;
        if (bidx != cur_b) {
            cur_b = bidx; const float* mb = MOD + ((size_t)layer * 9 + bidx) * 6144 + 3 * 1024;
            __syncthreads();
            for (int k = F.tid; k < 1024; k += NTHREADS) { AV[k] = gn[k] * (1.0f + mb[1024 + k]); SHV[k] = mb[k]; }
            if (F.tid < NE) RCV[F.tid] = RC[((size_t)layer * 9 + bidx) * NE + F.tid];
            __syncthreads();
            { const v4u* src = (const v4u*)(F.ws + WS_RW3 + ((size_t)(layer * 9 + bidx) * 8 + F.wave) * 8 * 3 * 1024) + F.lane;
#pragma unroll
              for (int kb = 0; kb < 8; ++kb)
#pragma unroll
                  for (int t = 0; t < 2; ++t) bw[kb][t] = __builtin_bit_cast(bf16x8, src[(kb * 3 + t) * 64]); }
        }
        { float s8[8];
#pragma unroll
          for (int q = 0; q < 8; ++q) { const f32x4 a = bf4_f32(rawp[q]), b = bf4_f32(rawp[q + 8]); s8[q] = ((a.x * a.x + a.y * a.y) + (a.z * a.z + a.w * a.w)) + ((b.x * b.x + b.y * b.y) + (b.z * b.z + b.w * b.w)); }
#pragma unroll
          for (int q = 0; q < 8; ++q) { float v = s8[q]; v += shx(v, 1, F.lane); v += shx(v, 2, F.lane); v += shx(v, 4, F.lane); v += shx(v, 8, F.lane); if (lc == 0) SSQ[F.wave * 32 + 4 * q + lr] = v; } }
        __syncthreads();
        const f32x4 av0 = ((const LAS f32x4*)(AV + kw))[lc], av1 = ((const LAS f32x4*)(AV + kw))[lc + 16];
        { const f32x4 sh0 = ((const LAS f32x4*)(SHV + kw))[lc], sh1 = ((const LAS f32x4*)(SHV + kw))[lc + 16];
          unsigned char* hb = H8 + (size_t)(r0 + lr) * D + kw + 4 * lc;
#pragma unroll
          for (int q = 0; q < 8; ++q) { float qs = 0.f;
#pragma unroll
              for (int w = 0; w < 8; ++w) qs += SSQ[w * 32 + 4 * q + lr];
              const float rs = 1.0f / sqrtf(qs * (1.0f / D) + EPS);
#pragma unroll
              for (int hq = 0; hq < 2; ++hq) { const f32x4 h = bf4_f32(rawp[q + 8 * hq]) * (rs * (hq ? av1 : av0)) + (hq ? sh1 : sh0); unsigned w = 0;
                  w = __builtin_amdgcn_cvt_pk_fp8_f32(h.x, h.y, w, false); w = __builtin_amdgcn_cvt_pk_fp8_f32(h.z, h.w, w, true);
                  *(unsigned*)(hb + (size_t)(4 * q) * D + 64 * hq) = w; } } }
        f32x16r acc = {};
        asm volatile("s_waitcnt lgkmcnt(0)" ::: "memory");
#pragma unroll
        for (int q = 0; q < 16; ++q) *(LAS v2u*)(STG + (4 * (q & 7) + lr) * 136 + 4 * lc + 64 * (q >> 3)) = rawp[q];
        asm volatile("s_waitcnt lgkmcnt(0)" ::: "memory");
        if (n + 1 < ncnt) RT_LOADX(RT_TILE(n + 1));
#pragma unroll
        for (int kb = 0; kb < 8; ++kb) { const bf16x8 a = *(const LAS bf16x8*)(STG + i * 136 + 16 * kb + 8 * hf);
#pragma unroll
            for (int t = 0; t < 2; ++t) acc = __builtin_amdgcn_mfma_f32_32x32x16_bf16(a, bw[kb][t], acc, 0, 0, 0); }
#pragma unroll
        for (int rg = 0; rg < 16; ++rg) PART[(F.wave * 32 + ((rg & 3) + 8 * (rg >> 2) + 4 * hf)) * 33 + i] = acc[rg];
        __syncthreads();
        { const int tk = F.tid >> 4, e0 = (F.tid & 15) * 2; float q = 0.f, s0 = 0.f, s1 = 0.f;
#pragma unroll
          for (int w = 0; w < 8; ++w) { q += SSQ[w * 32 + tk]; s0 += PART[(w * 32 + tk) * 33 + e0]; s1 += PART[(w * 32 + tk) * 33 + e0 + 1]; }
          const float rstd = 1.0f / sqrtf(q * (1.0f / D) + EPS);
          LG[tk * 33 + e0] = rstd * s0 + RCV[e0]; LG[tk * 33 + e0 + 1] = rstd * s1 + RCV[e0 + 1]; }
        __syncthreads();
        { const int tk = F.tid >> 4, e0 = (F.tid & 15) * 2; const LAS float* lg = LG + tk * 33; const float l0 = lg[e0], l1 = lg[e0 + 1]; int rk0 = 0, rk1 = 0;
#pragma unroll 8
          for (int j = 0; j < NE; ++j) { const float o = lg[j]; rk0 += (o > l0 || (o == l0 && j < e0)) ? 1 : 0; rk1 += (o > l1 || (o == l1 && j < e0 + 1)) ? 1 : 0; }
          if (rk0 < 4) { F.MISC[MW_SELE + tk * 4 + rk0] = (unsigned)e0; F.MISC[MW_SELV + tk * 4 + rk0] = __float_as_uint(l0); }
          if (rk1 < 4) { F.MISC[MW_SELE + tk * 4 + rk1] = (unsigned)(e0 + 1); F.MISC[MW_SELV + tk * 4 + rk1] = __float_as_uint(l1); } }
        __syncthreads();
        int my = 0, lrk = 0;
        if (F.wave < 2) { const int a = F.tid; my = (int)F.MISC[MW_SELE + a];
            { const float vk = __uint_as_float(F.MISC[MW_SELV + a]), v0 = __uint_as_float(F.MISC[MW_SELV + (a & ~3)]);
              const float ex = __expf(vk - v0); float sm = ex; sm += shx(sm, 1, F.lane); sm += shx(sm, 2, F.lane);
              const size_t idx = ((size_t)r0 + (a >> 2)) * 4 + (a & 3); TG[idx] = ex / sm; TE[idx] = my; }
            unsigned cm = 0;
#pragma unroll 2
            for (int e = 0; e < NE; ++e) { const unsigned long long m = __ballot(my == e); const unsigned pc = (unsigned)__popcll(m);
                if (my == e) lrk = (int)__builtin_amdgcn_mbcnt_hi((unsigned)(m >> 32), __builtin_amdgcn_mbcnt_lo((unsigned)m, 0u)); if (F.lane == e) cm = pc; }
            if (F.lane < NE) CW[F.wave * 32 + F.lane] = cm; }
        __syncthreads();
        if (F.wave < 2) { const int a = F.tid; const int brank = (int)RUN[my] + lrk + (F.wave == 1 ? (int)CW[my] : 0); TR[((size_t)r0 + (a >> 2)) * 4 + (a & 3)] = brank; }
        __syncthreads();
        if (F.tid < NE) RUN[F.tid] += CW[F.tid] + CW[32 + F.tid];
    }
    VM_WAIT(); __syncthreads();
    if (F.tid < NE) { const unsigned cnt = RUN[F.tid]; unsigned base = 0;
        if (cnt) base = __hip_atomic_fetch_add(F.ctl + CW_CNT + (real ? layer : NLAYER) * NE + F.tid, cnt, RLX_AGENT);
        F.MISC[MW_LBASE + F.tid] = base; }
    __syncthreads();
    if (real) for (int n = 0; n < ncnt; ++n) { const int r0 = RT_TILE(n) * 32;
        if (F.tid < 128) { const size_t idx = ((size_t)r0 + (F.tid >> 2)) * 4 + (F.tid & 3); const int e = TE[idx]; const int rank = TR[idx] + (int)F.MISC[MW_LBASE + e]; TR[idx] = rank; ROWTOK[(size_t)e * MT + rank] = r0 + (F.tid >> 2); } }
    __syncthreads();
#undef RT_LOADX
#undef RT_TILE
}

__device__ __forceinline__ void normrope16(float (&x)[16], const float* gain, bool lat, int prow, int pcol, const LAS f32x2* T, int L, float oscale, int lane) {
    float ss = 0.f;
#pragma unroll
    for (int i = 0; i < 16; ++i) ss += x[i] * x[i];
    ss += shx(ss, 1, lane); ss += shx(ss, 2, lane); ss += shx(ss, 4, lane);
    const float rstd = 1.0f / sqrtf(ss * (1.0f / 128.0f) + EPS);
    const int o = (L & 7) * 16;
#pragma unroll
    for (int i = 0; i < 16; ++i) x[i] = x[i] * rstd * gain[o + i];
    float p[16];
#pragma unroll
    for (int i = 0; i < 16; ++i) p[i] = shx(x[i], 2, lane);
    if (lat) {
        const int pos = (L & 4) ? pcol : prow; const float sgn = (L & 2) ? 1.0f : -1.0f; const LAS f32x2* t = T + pos * 32 + (L & 1) * 16;
#pragma unroll
        for (int i = 0; i < 16; ++i) { const f32x2 cs = t[i]; x[i] = x[i] * cs.x + sgn * p[i] * cs.y; }
    }
#pragma unroll
    for (int i = 0; i < 16; ++i) x[i] *= oscale;
}
__device__ __forceinline__ void qkprep_phase(Frame& F, int j) {
    LAS f32x2* T = (LAS f32x2*)F.lds;
    __syncthreads();
    for (int i = F.tid; i < 128 * 32; i += NTHREADS) { const int pos = i >> 5, f = i & 31; const float inv = powf(10000.0f, -(float)f / 32.0f); const float ang = (float)pos * inv; float s, c; sincosf(ang, &s, &c); T[i] = (f32x2){c, s}; }
    __syncthreads();
    const bf16* P = (const bf16*)(F.ws + WS_P); unsigned char* Q8 = (unsigned char*)(F.ws + WS_QB); unsigned char* K8 = (unsigned char*)(F.ws + WS_QB + WS_K8_OFF); unsigned char* VT8 = (unsigned char*)(F.ws + WS_KVB);
    const float* qg = PIN(F, I_AQG) + j * 128; const float* kg = PIN(F, I_AKG) + j * 128;
    if (F.bx == 0 && F.tid == 0) { float qm = 0.f, km = 0.f; for (int i = 0; i < 128; ++i) { qm = fmaxf(qm, fabsf(qg[i])); km = fmaxf(km, fabsf(kg[i])); }
        const float sig = att::SCALE * 1.4426950408889634f * 11.3137085f * qm * km;
        ((float*)(F.ws + WS_RC))[2048 + j] = -fminf(-2.0f, 8.0f - 7.0f * sig); }
    const int gw = F.bx * NWAVES + F.wave, NGW = F.G * NWAVES, L = F.lane;
    v4u nqa, nqc, nka, nkc;
#define QK_LOAD(r_) do { const bf16* pr_ = P + (size_t)(r_) * 1536; nqa = *(const v4u*)(pr_ + 16 * L); nqc = *(const v4u*)(pr_ + 16 * L + 8); nka = *(const v4u*)(pr_ + 1024 + 16 * (L & 15)); nkc = *(const v4u*)(pr_ + 1024 + 16 * (L & 15) + 8); } while (0)
    if (gw < MT) QK_LOAD(gw);
    for (int r = gw; r < MT; r += NGW) {
        const v4u qa_ = nqa, qc_ = nqc, ka_ = nka, kc_ = nkc;
        if (r + NGW < MT) QK_LOAD(r + NGW);
        const bool lat = r < ML; const int b = lat ? (r >> 13) : ((r - ML) >> 8); const int s = lat ? (r & (SEQ - 1)) : ((r - ML) & (CL - 1));
        const int prow = s >> 6, pcol = s & 63; const size_t kvrow = (size_t)b * SKV + (lat ? s : SEQ + s);
        { const v4u a = qa_, c = qc_; float x[16];
          x[0] = bflo(a.x); x[1] = bfhi(a.x); x[2] = bflo(a.y); x[3] = bfhi(a.y); x[4] = bflo(a.z); x[5] = bfhi(a.z); x[6] = bflo(a.w); x[7] = bfhi(a.w);
          x[8] = bflo(c.x); x[9] = bfhi(c.x); x[10] = bflo(c.y); x[11] = bfhi(c.y); x[12] = bflo(c.z); x[13] = bfhi(c.z); x[14] = bflo(c.w); x[15] = bfhi(c.w);
          normrope16(x, qg, lat, prow, pcol, T, L, att::SCALE * 1.4426950408889634f * 8.0f, L);
          v4u o;
#pragma unroll
          for (int w4 = 0; w4 < 4; ++w4) { unsigned w = 0; w = __builtin_amdgcn_cvt_pk_fp8_f32(x[4 * w4], x[4 * w4 + 1], w, false); w = __builtin_amdgcn_cvt_pk_fp8_f32(x[4 * w4 + 2], x[4 * w4 + 3], w, true); o[w4] = w; }
          *(v4u*)(Q8 + (size_t)r * D + 16 * L) = o; }
        { const int Lk = L & 15; const v4u a = ka_, c = kc_; float x[16];
          x[0] = bflo(a.x); x[1] = bfhi(a.x); x[2] = bflo(a.y); x[3] = bfhi(a.y); x[4] = bflo(a.z); x[5] = bfhi(a.z); x[6] = bflo(a.w); x[7] = bfhi(a.w);
          x[8] = bflo(c.x); x[9] = bfhi(c.x); x[10] = bflo(c.y); x[11] = bfhi(c.y); x[12] = bflo(c.z); x[13] = bfhi(c.z); x[14] = bflo(c.w); x[15] = bfhi(c.w);
          normrope16(x, kg, lat, prow, pcol, T, Lk, 1.0f, L);
          if (L < 16) { v4u o;
#pragma unroll
            for (int w4 = 0; w4 < 4; ++w4) { unsigned w = 0; w = __builtin_amdgcn_cvt_pk_fp8_f32(x[4 * w4], x[4 * w4 + 1], w, false); w = __builtin_amdgcn_cvt_pk_fp8_f32(x[4 * w4 + 2], x[4 * w4 + 3], w, true); o[w4] = w; }
            *(v4u*)(K8 + kvrow * 256 + 16 * L) = o; }
        }
    }
#undef QK_LOAD
    LAS unsigned char* Tt = F.lds + 32768;
    for (int tile = F.bx; tile < NB * (SKV / 64); tile += F.G) {
        const int b = tile / (SKV / 64), kb = tile % (SKV / 64), ki = F.tid >> 3, seg = F.tid & 7, pos = kb * 64 + ki;
        const size_t r = pos < SEQ ? (size_t)b * SEQ + pos : (size_t)ML + (size_t)b * CL + (pos - SEQ);
        const int k5 = ki & 31, slot = 32 * ((k5 >> 2) & 1) + ((k5 & 3) | ((k5 >> 3) << 2)) + (ki >= 32 ? 16 : 0);
        const v4u* src = (const v4u*)(P + r * 1536 + 1280 + 32 * seg);
        __syncthreads();
#pragma unroll
        for (int q = 0; q < 4; ++q) { const v4u w = src[q]; const unsigned ww[4] = {w.x, w.y, w.z, w.w};
#pragma unroll
            for (int e2 = 0; e2 < 4; ++e2) { const unsigned pk = __builtin_amdgcn_cvt_pk_fp8_f32(bflo(ww[e2]), bfhi(ww[e2]), 0u, false); const int dd = 32 * seg + 8 * q + 2 * e2;
                Tt[dd * 64 + slot] = (unsigned char)(pk & 0xff); Tt[(dd + 1) * 64 + slot] = (unsigned char)((pk >> 8) & 0xff); } }
        __syncthreads();
        { const int rho = F.tid >> 1, half = F.tid & 1; const v4u a = *(const LAS v4u*)(Tt + rho * 64 + 32 * half), c = *(const LAS v4u*)(Tt + rho * 64 + 32 * half + 16);
          unsigned char* dst = VT8 + ((size_t)(b * 2 + (rho >> 7)) * 128 + (rho & 127)) * SKV + kb * 64 + 32 * half;
          *(v4u*)dst = a; *(v4u*)(dst + 16) = c; }
    }
    __syncthreads();
}
template <int XV = 0>
__device__ __forceinline__ void attention_phase(Frame& F, char* lds_generic, bool ctx_queries, int j) {
    const float nb = -((const float*)(F.ws + WS_RC))[2048 + j] - 8.0f;
    const unsigned char* Q8 = (const unsigned char*)(F.ws + WS_QB); const unsigned char* K8 = (const unsigned char*)(F.ws + WS_QB + WS_K8_OFF); const unsigned char* VT8 = (const unsigned char*)(F.ws + WS_KVB); bf16* Y = (bf16*)(F.ws + WS_Y);
    const int nunits = 2048 + (ctx_queries ? 64 : 0);
    for (int u = F.bx; u < nunits; u += F.G) {
        if (u < 2048) { const int b = u >> 8, w = u & 255, h = w & 7, qb = w >> 3; const size_t qo = ((size_t)b * SEQ + (size_t)qb * 256) * D + h * 128;
            att::attn_dense_body<XV>(Q8 + qo, K8 + (size_t)b * SKV * 256 + (h >> 2) * 128, VT8 + (size_t)(b * 2 + (h >> 2)) * 128 * SKV, SKV, Y + qo, SKV, lds_generic, F.wave, nb); }
        else { const int w = u - 2048, b = w >> 3, h = w & 7; const size_t qo = ((size_t)ML + (size_t)b * CL) * D + h * 128;
            att::attn_dense_body<XV>(Q8 + qo, K8 + ((size_t)b * SKV + SEQ) * 256 + (h >> 2) * 128, VT8 + (size_t)(b * 2 + (h >> 2)) * 128 * SKV + SEQ, SKV, Y + qo, CL, lds_generic, F.wave, nb); }
    }
}

__device__ __forceinline__ void gmlp_mix_phase(Frame& F) {
    constexpr int LDA = 136, LDO = 132;
    LAS bf16* As = (LAS bf16*)F.lds;
    LAS bf16* Vt = (LAS bf16*)(F.lds + 128 * LDA * 2);
    LAS float* rs = (LAS float*)(F.lds + 2 * 128 * LDA * 2);
    LAS float* Ot = (LAS float*)(F.lds + 2 * 128 * LDA * 2 + 512);
    const bf16* P = (const bf16*)(F.ws + WS_P); bf16* Y = (bf16*)(F.ws + WS_Y); const float* SS = (const float*)(F.ws + WS_SS);
    const float* ws = PIN(F, I_GWS); const float* bs = PIN(F, I_GBS); const float* vg = PIN(F, I_GVG);
    const int r32 = F.lane & 31, hi = F.lane >> 5;
    constexpr int NU = (MT / 128) * 8;
    struct GIn { f32x4 s; v4u v[4], uu[4]; } ga, gb; int gcur = -1;
#define GM_LOAD(u_, IN) do { const int g_ = (u_) & 7; const size_t row0_ = (size_t)((u_) >> 3) * 128; \
        IN.s = *(const f32x4*)(SS + (row0_ + (F.tid >> 2)) * 16 + (F.tid & 3) * 4);                                       \
        _Pragma("unroll") for (int k = 0; k < 4; ++k) { const int i_ = F.tid + NTHREADS * k, q_ = i_ >> 4, c8_ = (i_ & 15) * 8; const bf16* pp_ = P + (row0_ + q_) * 2048 + g_ * 128 + c8_; \
            IN.v[k] = *(const v4u*)(pp_ + 1024); IN.uu[k] = *(const v4u*)pp_; } } while (0)
#define GM_UNIT(u_, IN) do { \
        const int chunk = (u_) >> 3, g = (u_) & 7; const size_t row0 = (size_t)chunk * 128; \
        __syncthreads(); \
        if (g != gcur) { gcur = g; \
            for (int i = F.tid; i < 128 * 32; i += NTHREADS) { const int p = i >> 5, q4 = (i & 31) * 4; const f32x4 w = *(const f32x4*)(ws + ((size_t)g * 128 + p) * 128 + q4); \
                v2u o; o.x = pk2(w.x, w.y); o.y = pk2(w.z, w.w); *(LAS v2u*)(As + p * LDA + q4) = o; } } \
        { float s = (IN.s.x + IN.s.y) + (IN.s.z + IN.s.w); s += shx(s, 1, F.lane); s += shx(s, 2, F.lane); if ((F.tid & 3) == 0) rs[F.tid >> 2] = 1.0f / sqrtf(s * (1.0f / 1024.0f) + EPS); } \
        __syncthreads(); \
        _Pragma("unroll") for (int k = 0; k < 4; ++k) { const int i = F.tid + NTHREADS * k, q = i >> 4, c8 = (i & 15) * 8; const float rq = rs[q]; const unsigned ww[4] = {IN.v[k].x, IN.v[k].y, IN.v[k].z, IN.v[k].w}; \
            _Pragma("unroll") for (int e2 = 0; e2 < 4; ++e2) { const unsigned pk = cvt_pk_bf16(bflo(ww[e2]) * rq, bfhi(ww[e2]) * rq); Vt[(c8 + 2 * e2) * LDA + q] = (bf16)(pk & 0xffff); Vt[(c8 + 2 * e2 + 1) * LDA + q] = (bf16)(pk >> 16); } } \
        __syncthreads(); \
        const int p0 = (F.wave >> 1) * 32, cbase = (F.wave & 1) * 64; \
        f32x16 acc0 = {}, acc1 = {}; \
        _Pragma("unroll") for (int ks = 0; ks < 8; ++ks) { const int k0 = ks * 16 + hi * 8; \
            const bf16x8 a = *(const LAS bf16x8*)(As + (p0 + r32) * LDA + k0); \
            const bf16x8 b0 = *(const LAS bf16x8*)(Vt + (cbase + r32) * LDA + k0), b1 = *(const LAS bf16x8*)(Vt + (cbase + 32 + r32) * LDA + k0); \
            acc0 = __builtin_amdgcn_mfma_f32_32x32x16_bf16(a, b0, acc0, 0, 0, 0); acc1 = __builtin_amdgcn_mfma_f32_32x32x16_bf16(a, b1, acc1, 0, 0, 0); } \
        _Pragma("unroll") for (int t = 0; t < 2; ++t) { const int cl = cbase + t * 32 + r32; const float gain = vg[g * 128 + cl]; \
            _Pragma("unroll") for (int reg = 0; reg < 16; ++reg) { const int p = p0 + (reg & 3) + 8 * (reg >> 2) + 4 * hi; Ot[p * LDO + cl] = gain * (t == 0 ? acc0[reg] : acc1[reg]) + bs[g * 128 + p]; } } \
        __syncthreads(); \
        _Pragma("unroll") for (int k = 0; k < 4; ++k) { const int i = F.tid + NTHREADS * k, p = i >> 4, c8 = (i & 15) * 8; const v4u uw = IN.uu[k]; \
            const LAS float* o = Ot + p * LDO + c8; const f32x4 m0 = *(const LAS f32x4*)o, m1 = *(const LAS f32x4*)(o + 4); \
            v4u w; w.x = cvt_pk_bf16(bflo(uw.x) * m0.x, bfhi(uw.x) * m0.y); w.y = cvt_pk_bf16(bflo(uw.y) * m0.z, bfhi(uw.y) * m0.w); \
            w.z = cvt_pk_bf16(bflo(uw.z) * m1.x, bfhi(uw.z) * m1.y); w.w = cvt_pk_bf16(bflo(uw.w) * m1.z, bfhi(uw.w) * m1.w); \
            *(v4u*)(Y + (row0 + p) * D + g * 128 + c8) = w; } } while (0)
    int u = F.bx;
    if (u < NU) GM_LOAD(u, ga);
    for (; u < NU; u += 2 * F.G) {
        if (u + F.G < NU) GM_LOAD(u + F.G, gb);
        GM_UNIT(u, ga);
        if (u + F.G >= NU) break;
        if (u + 2 * F.G < NU) GM_LOAD(u + 2 * F.G, ga);
        GM_UNIT(u + F.G, gb);
    }
    __syncthreads();
#undef GM_LOAD
#undef GM_UNIT
}

__device__ __forceinline__ void hyena_prep_phase(Frame& F) {
    LAS float* tl = (LAS float*)F.lds;
    const bf16* P = (const bf16*)(F.ws + WS_P); bf16* X0 = (bf16*)(F.ws + WS_X0); bf16* VG = (bf16*)(F.ws + WS_VG);
    float* VT = (float*)(F.ws + WS_VT); float* VTC = (float*)(F.ws + WS_VTC);
    const float* cw = PIN(F, I_HCW); const float* cb = PIN(F, I_HCB);
    const int tt = F.tid >> 3, cg = F.tid & 7;
    constexpr int NU = (MT / 64) * 16;
    v4u pa[3][3], pb[3][3];
#define HP_LOAD(u_, IN) do { const int tb_ = (u_) >> 4, c0_ = ((u_) & 15) * 64, r0_ = tb_ * 64; const bool lat_ = r0_ < ML; \
        const int s_ = (lat_ ? (r0_ & (SEQ - 1)) : ((r0_ - ML) & (CL - 1))) + tt, L_ = lat_ ? SEQ : CL; const bf16* pr_ = P + (size_t)(r0_ + tt) * 3072 + c0_ + cg * 8; const v4u z0_ = {0u, 0u, 0u, 0u}; \
        _Pragma("unroll") for (int seg = 0; seg < 3; ++seg) { IN[seg][0] = s_ > 0 ? *(const v4u*)(pr_ + seg * 1024 - 3072) : z0_; IN[seg][1] = *(const v4u*)(pr_ + seg * 1024); \
            IN[seg][2] = s_ < L_ - 1 ? *(const v4u*)(pr_ + seg * 1024 + 3072) : z0_; } } while (0)
    LAS float* wl = tl + 64 * 65; int c0w = -1;
#define HP_UNIT(u_, IN) do { \
        const int tb = (u_) >> 4, c0 = ((u_) & 15) * 64; const int r0 = tb * 64; const bool lat = r0 < ML; \
        const int b = lat ? (r0 >> 13) : ((r0 - ML) >> 8), s0 = lat ? (r0 & (SEQ - 1)) : ((r0 - ML) & (CL - 1)); \
        const int r = r0 + tt, c = c0 + cg * 8; \
        if (c0 != c0w) { c0w = c0; __syncthreads(); \
            for (int i = F.tid; i < 768; i += NTHREADS) { const int seg = i >> 8, k = (i >> 6) & 3, ch = i & 63; wl[i] = k < 3 ? cw[k * 3072 + seg * 1024 + c0 + ch] : cb[seg * 1024 + c0 + ch]; } \
            __syncthreads(); } \
        float o[3][8]; \
        _Pragma("unroll") for (int seg = 0; seg < 3; ++seg) { \
            const unsigned pmw[4] = {IN[seg][0].x, IN[seg][0].y, IN[seg][0].z, IN[seg][0].w}, pcw[4] = {IN[seg][1].x, IN[seg][1].y, IN[seg][1].z, IN[seg][1].w}, pnw[4] = {IN[seg][2].x, IN[seg][2].y, IN[seg][2].z, IN[seg][2].w}; \
            _Pragma("unroll") for (int i = 0; i < 8; ++i) { const float xm = (i & 1) ? bfhi(pmw[i >> 1]) : bflo(pmw[i >> 1]), xc = (i & 1) ? bfhi(pcw[i >> 1]) : bflo(pcw[i >> 1]), xn = (i & 1) ? bfhi(pnw[i >> 1]) : bflo(pnw[i >> 1]); \
                const LAS float* wp = wl + seg * 256 + cg * 8 + i; o[seg][i] = xm * wp[0] + xc * wp[64] + xn * wp[128] + wp[192]; } } \
        float vgv[8]; \
        _Pragma("unroll") for (int i = 0; i < 8; ++i) vgv[i] = o[2][i] * o[1][i]; \
        v4u w; w.x = cvt_pk_bf16(o[0][0], o[0][1]); w.y = cvt_pk_bf16(o[0][2], o[0][3]); w.z = cvt_pk_bf16(o[0][4], o[0][5]); w.w = cvt_pk_bf16(o[0][6], o[0][7]); \
        *(v4u*)(X0 + (size_t)r * D + c) = w; \
        __syncthreads(); \
        _Pragma("unroll") for (int i = 0; i < 8; ++i) tl[(cg * 8 + i) * 65 + tt] = vgv[i]; \
        __syncthreads(); \
        { const int cc = F.tid >> 3, ts = (F.tid & 7) * 8; const LAS float* sp = tl + cc * 65 + ts; \
          if (lat) *(v4u*)((bf16*)VT + ((size_t)b * 1024 + c0 + cc) * SEQ + s0 + ts) = (v4u){cvt_pk_bf16(sp[0], sp[1]), cvt_pk_bf16(sp[2], sp[3]), cvt_pk_bf16(sp[4], sp[5]), cvt_pk_bf16(sp[6], sp[7])};        \
          else { float* dst = VTC + ((size_t)b * 1024 + c0 + cc) * CL + s0 + ts; *(f32x4*)dst = (f32x4){sp[0], sp[1], sp[2], sp[3]}; *(f32x4*)(dst + 4) = (f32x4){sp[4], sp[5], sp[6], sp[7]}; } } } while (0)
    int u = F.bx;
    if (u < NU) HP_LOAD(u, pa);
    for (; u < NU; u += 2 * F.G) {
        if (u + F.G < NU) HP_LOAD(u + F.G, pb);
        HP_UNIT(u, pa);
        if (u + F.G >= NU) break;
        if (u + 2 * F.G < NU) HP_LOAD(u + 2 * F.G, pa);
        HP_UNIT(u + F.G, pb);
    }
    __syncthreads();
#undef HP_LOAD
#undef HP_UNIT
}
__device__ __forceinline__ void hyena_post_phase(Frame& F) {
    LAS float* tl = (LAS float*)F.lds;
    const bf16* X0 = (const bf16*)(F.ws + WS_X0); const bf16* VG = (const bf16*)(F.ws + WS_VG); bf16* Y = (bf16*)(F.ws + WS_Y);
    const float* VT = (const float*)(F.ws + WS_CT); const float* VTC = (const float*)(F.ws + WS_CTC); const float* dsk = PIN(F, I_HD);
    const int tt = F.tid >> 3, cg = F.tid & 7;
    constexpr int NU = (MT / 64) * 16;
    struct PIn { f32x4 a, bq; v4u cw, x0; } qa, qb;
#define HQ_LOAD(u_, IN) do { const int tb_ = (u_) >> 4, c0_ = ((u_) & 15) * 64, r0_ = tb_ * 64; const bool lat_ = r0_ < ML; \
        const int b_ = lat_ ? (r0_ >> 13) : ((r0_ - ML) >> 8), s0_ = lat_ ? (r0_ & (SEQ - 1)) : ((r0_ - ML) & (CL - 1)); const int cc_ = F.tid >> 3, ts_ = (F.tid & 7) * 8; \
        if (lat_) IN.cw = *(const v4u*)((const bf16*)VT + ((size_t)b_ * 1024 + c0_ + cc_) * SEQ + s0_ + ts_);        \
        else { const float* src_ = VTC + ((size_t)b_ * 1024 + c0_ + cc_) * CL + s0_ + ts_; IN.a = *(const f32x4*)src_; IN.bq = *(const f32x4*)(src_ + 4); } \
        IN.x0 = *(const v4u*)(X0 + (size_t)(r0_ + tt) * D + c0_ + cg * 8); } while (0)
#define HQ_UNIT(u_, IN) do { \
        const int tb = (u_) >> 4, c0 = ((u_) & 15) * 64; const int r0 = tb * 64; \
        __syncthreads(); \
        { const int cc = F.tid >> 3, ts = (F.tid & 7) * 8; LAS float* dp = tl + cc * 65 + ts; \
          if (r0 < ML) { dp[0] = bflo(IN.cw.x); dp[1] = bfhi(IN.cw.x); dp[2] = bflo(IN.cw.y); dp[3] = bfhi(IN.cw.y); dp[4] = bflo(IN.cw.z); dp[5] = bfhi(IN.cw.z); dp[6] = bflo(IN.cw.w); dp[7] = bfhi(IN.cw.w); } \
          else { dp[0] = IN.a.x; dp[1] = IN.a.y; dp[2] = IN.a.z; dp[3] = IN.a.w; dp[4] = IN.bq.x; dp[5] = IN.bq.y; dp[6] = IN.bq.z; dp[7] = IN.bq.w; } } \
        __syncthreads(); \
        const int r = r0 + tt, c = c0 + cg * 8; \
        const unsigned x0w[4] = {IN.x0.x, IN.x0.y, IN.x0.z, IN.x0.w}; float y[8]; \
        _Pragma("unroll") for (int i = 0; i < 8; ++i) { const float xx = (i & 1) ? bfhi(x0w[i >> 1]) : bflo(x0w[i >> 1]); y[i] = tl[(cg * 8 + i) * 65 + tt] * xx; }        \
        v4u w; w.x = cvt_pk_bf16(y[0], y[1]); w.y = cvt_pk_bf16(y[2], y[3]); w.z = cvt_pk_bf16(y[4], y[5]); w.w = cvt_pk_bf16(y[6], y[7]); \
        *(v4u*)(Y + (size_t)r * D + c) = w; } while (0)
    int u = F.bx;
    if (u < NU) HQ_LOAD(u, qa);
    for (; u < NU; u += 2 * F.G) {
        if (u + F.G < NU) HQ_LOAD(u + F.G, qb);
        HQ_UNIT(u, qa);
        if (u + F.G >= NU) break;
        if (u + 2 * F.G < NU) HQ_LOAD(u + 2 * F.G, qa);
        HQ_UNIT(u + F.G, qb);
    }
    __syncthreads();
#undef HQ_LOAD
#undef HQ_UNIT
}
__device__ __forceinline__ bool phase_nonempty(int ph) {
    if (ph < PH_L0 || ph >= PH_FINAL) return true;
    const int layer = (ph - PH_L0) / PH_PER_LAYER, lp = (ph - PH_L0) % PH_PER_LAYER, kind = layer % 3;
    if (lp == LP_MIX2) return kind != 1;
    if (lp == LP_MIX3) return kind == 2;
    return true;
}
__global__ void __launch_bounds__(NTHREADS, 2) mk_fwd(Args args) {
    extern __shared__ __attribute__((aligned(16))) unsigned char lds[];
    Frame F0;
    F0.lds = (LAS unsigned char*)lds; F0.MISC = (volatile LAS unsigned*)(F0.lds + MISC_OFF);
    F0.tid = threadIdx.x; F0.lane = F0.tid & 63; F0.wave = __builtin_amdgcn_readfirstlane(F0.tid >> 6);
    F0.G = gridDim.x; F0.bx = blockIdx.x; F0.out = args.out; F0.ws = args.ws; F0.ctl = (gu32*)(args.ws + WS_CTL);
    for (int u = F0.tid; u < MISC_BYTES / 4; u += NTHREADS) F0.MISC[u] = 0u;
    __syncthreads();
    if (F0.tid < 36) { const unsigned long long p = (unsigned long long)args.in[F0.tid]; F0.MISC[MW_PTRS + 2 * F0.tid] = (unsigned)p; F0.MISC[MW_PTRS + 2 * F0.tid + 1] = (unsigned)(p >> 32); }
    __syncthreads();
    const int lo = args.ph_lo, hi = args.ph_hi;
    const bool multi = (hi - lo) > 1;
    XcdBarrier bar; bar.bar = (unsigned*)(F0.ctl + CW_BAR); bar.x = 0; bar.st = nullptr; bar.w = F0.wave;
    if (multi) bar = xcd_barrier_post((unsigned*)(F0.ctl + CW_BAR), F0.MISC + 8, F0.wave);
#ifndef PHMASK
#define PHMASK 0xFFFF
#endif
#define EN(b) ((PHMASK >> (b)) & 1)
#ifndef MK_STAG_IN
#define MK_STAG_IN 0u
#define MK_STAG_OUT 0u
#define MK_STAG_M1 0u
#define MK_STAG_M2 0u
#endif
#ifndef KMASK
#define KMASK 7
#endif
#define KEN(b) ((KMASK >> (b)) & 1)
#define IN(k) (lo <= (k) && (k) < hi)
#define SEAM(k) do { if ((k) + 1 < hi) xcd_barrier(bar); } while (0)
#define PB(id) for (int _rep = 0, _n = ((id) == MK_REPEAT ? MK_NREP : 1); _rep < _n; ++_rep) {
#define PE(id) if (_rep + 1 < _n) xcd_barrier(bar); } SEAM(id);

    if (EN(0) && IN(PH_PRO0)) { PB(PH_PRO0) Frame F = phase_frame(F0); pro0_mod(F); __syncthreads(); pro0_transposes(F); pro0_filter_mlp(F); PE(PH_PRO0) }
    if (EN(1) && IN(PH_PRO1)) { PB(PH_PRO1) Frame F = phase_frame(F0); pro1_router_split(F); pro1_filters(F); PE(PH_PRO1) }

#pragma unroll 1
    for (int layer = 0; layer < NLAYER; ++layer) {
        const int kind = layer % 3, jj = layer / 3, pb = PH_L0 + layer * PH_PER_LAYER; const bool last = layer == NLAYER - 1;
        if (EN(2) && IN(pb + LP_NORM1)) { PB(pb + LP_NORM1) Frame F = phase_frame(F0); rowpass<0>(F, layer, _rep + 1 == _n, kind == 0); PE(pb + LP_NORM1) }
        if (EN(3) && IN(pb + LP_INPROJ)) { PB(pb + LP_INPROJ)
            Frame F = phase_frame(F0);
            if (kind == 0) {
                pg8::DenseSchedT<true> S; S.init(F.ws + WS_H8, F.ws + WS_WATT + (size_t)jj * 1536 * 1024, MT, 1536, F.G, F.bx, 1024);
                pg8::EpiBf16 E{(bf16*)(F.ws + WS_P), 1536, (float*)(F.ws + WS_SS), 0};
                pg8::gemm_phase<pg8::EpiBf16, pg8::DenseSchedT<true>, true, true>(F.lds, S, E, F.wave, false, MK_STAG_IN);
            } else {
                const int N = kind == 1 ? 2048 : 3072;
                pg8::DenseSched S; S.init(F.ws + WS_H, F.ws + (kind == 1 ? WS_WGM : WS_WHY), MT, N, F.G, F.bx);
                pg8::EpiBf16 E{(bf16*)(F.ws + WS_P), N, (float*)(F.ws + WS_SS), kind == 1 ? 1 : 0};
                pg8::gemm_phase<pg8::EpiBf16, pg8::DenseSched, false>(F.lds, S, E, F.wave, false, MK_STAG_IN);
            }
            PE(pb + LP_INPROJ)
        }
        if (IN(pb + LP_MIX1)) { PB(pb + LP_MIX1)
            Frame F = phase_frame(F0);
            if (EN(4) && kind == 0) qkprep_phase(F, jj); else if (EN(5) && kind == 1) gmlp_mix_phase(F); else if (EN(6)) hyena_prep_phase(F);
            PE(pb + LP_MIX1)
        }
        if (IN(pb + LP_MIX2) && kind != 1) { PB(pb + LP_MIX2)
            Frame F = phase_frame(F0);
            if (EN(7) && kind == 0) {
#if MK_XP >= 10 && MK_XP < 20
                if (_rep + 1 < _n) attention_phase<MK_XP - 10>(F, (char*)lds, !last, jj); else
#endif
                attention_phase<0>(F, (char*)lds, !last, jj); }
            else if (EN(8)) hyena_conv_phase(F);
            PE(pb + LP_MIX2)
        }
        if (EN(9) && IN(pb + LP_MIX3) && kind == 2) { PB(pb + LP_MIX3) Frame F = phase_frame(F0); hyena_post_phase(F); PE(pb + LP_MIX3) }
        if (EN(10) && IN(pb + LP_OUTPROJ)) { PB(pb + LP_OUTPROJ)
            Frame F = phase_frame(F0); const float* modl = (const float*)(F.ws + WS_MOD) + (size_t)layer * 9 * 6144;
            pg8::DenseSched S; S.init(F.ws + WS_Y, F.ws + WS_WOUT + (size_t)layer * 1024 * 1024 * 2, last ? ML : MT, 1024, F.G, F.bx);
            pg8::EpiResid E{(bf16*)(F.ws + WS_XB), modl};
            pg8::gemm_phase<pg8::EpiResid, pg8::DenseSched, false>(F.lds, S, E, F.wave, false, MK_STAG_OUT);
            PE(pb + LP_OUTPROJ)
        }
        if (EN(11) && IN(pb + LP_NORM2)) { PB(pb + LP_NORM2) Frame F = phase_frame(F0); router_phase(F, layer, _rep + 1 == _n, (_rep + 1 < _n) ? MK_XP : 0); PE(pb + LP_NORM2) }
        if (EN(12) && IN(pb + LP_MOE1)) { PB(pb + LP_MOE1)
            Frame F = phase_frame(F0);
            moe_tables(F, layer);
            pg8::MoeSched S{(const char*)(F.ws + WS_H8), (const char*)(F.ws + WS_WE1) + (size_t)layer * NE * 2048 * 1024, (size_t)2048 * 1024, (const int*)(F.ws + WS_ROWTOK),
                            (const volatile LAS int*)(F.MISC + MW_CUMBLK), (const volatile LAS int*)(F.MISC + MW_CNT), 3, F.G, F.bx, 1024, (const volatile LAS int*)(F.lds + AUX_OFF + 1024)};
            S.build_list((volatile LAS int*)(F.lds + AUX_OFF + 1024), F.tid); __syncthreads();
            pg8::EpiSwiglu E{(unsigned char*)(F.ws + WS_ACT), PIN(F, I_EB1) + (size_t)layer * NE * 2048, (LAS float*)(F.lds + AUX_OFF)};
#if MK_XP >= 20
            if (_rep + 1 < _n) { int one_ = 1; asm volatile("" : "+s"(one_)); pg8::gemm_phase<pg8::EpiSwiglu, pg8::MoeSched, true, true, MK_XP - 20>(F.lds, S, E, F.wave, one_ != 0, MK_STAG_M1); } else
#endif
            pg8::gemm_phase<pg8::EpiSwiglu, pg8::MoeSched, true, true>(F.lds, S, E, F.wave, MK_XP == 1 && _rep + 1 < _n, MK_STAG_M1);
            PE(pb + LP_MOE1)
        }
        if (EN(13) && IN(pb + LP_MOE2)) { PB(pb + LP_MOE2)
            Frame F = phase_frame(F0);
            moe_tables(F, layer);
            pg8::MoeSched S{(const char*)(F.ws + WS_ACT), (const char*)(F.ws + WS_WE2) + (size_t)layer * NE * 1024 * 1024, (size_t)1024 * 1024, nullptr,
                            (const volatile LAS int*)(F.MISC + MW_CUMBLK), (const volatile LAS int*)(F.MISC + MW_CNT), 2, F.G, F.bx, 1024, (const volatile LAS int*)(F.lds + AUX_OFF + 1024)};
            S.build_list((volatile LAS int*)(F.lds + AUX_OFF + 1024), F.tid); __syncthreads();
            pg8::EpiBias E{(unsigned char*)(F.ws + WS_YM), PIN(F, I_EB2) + (size_t)layer * NE * 1024, (LAS float*)(F.lds + AUX_OFF)};
            pg8::gemm_phase<pg8::EpiBias, pg8::MoeSched, true, true>(F.lds, S, E, F.wave, MK_XP == 1 && _rep + 1 < _n, MK_STAG_M2);
            PE(pb + LP_MOE2)
        }
    }
    if (EN(14) && IN(PH_FINAL)) { PB(PH_FINAL) Frame F = phase_frame(F0); rowpass<2>(F, NLAYER - 1, _rep + 1 == _n); PE(PH_FINAL) }
#undef IN
#undef SEAM
}

static bool host_phase_nonempty(int ph) {
    if (ph < PH_L0 || ph >= PH_FINAL) return true;
    const int layer = (ph - PH_L0) / PH_PER_LAYER, lp = (ph - PH_L0) % PH_PER_LAYER, kind = layer % 3;
    if (lp == LP_MIX2) return kind != 1;
    if (lp == LP_MIX3) return kind == 2;
    return true;
}
extern "C" void kernel_launch(void* const* d_in, const int* in_sizes, int n_in, void* d_out, int out_size, void* d_ws, size_t ws_size, hipStream_t stream) {
    static int grid = 0;
    if (grid == 0) {
        if (n_in != 36 || in_sizes[0] != ML * D || out_size != ML * D || ws_size < WS_END) {
            fprintf(stderr, "kernel_launch: built for 36 inputs, x/out of %d floats, >= %zu bytes of workspace; got n_in %d in0 %d out %d ws %zu; nothing launched\n", ML * D, (size_t)WS_END, n_in, n_in > 0 ? in_sizes[0] : -1, out_size, ws_size);
            grid = -1; return; }
        int dev = 0, cus = 0, per_cu = 0;
        if (hipGetDevice(&dev) != hipSuccess || hipDeviceGetAttribute(&cus, hipDeviceAttributeMultiprocessorCount, dev) != hipSuccess) { fprintf(stderr, "kernel_launch: device query failed\n"); grid = -1; return; }
        if (hipFuncSetAttribute((const void*)mk_fwd, hipFuncAttributeMaxDynamicSharedMemorySize, LDS_BYTES) != hipSuccess) { fprintf(stderr, "kernel_launch: hipFuncSetAttribute(%d B LDS) failed\n", LDS_BYTES); grid = -1; return; }
        if (hipOccupancyMaxActiveBlocksPerMultiprocessor(&per_cu, (const void*)mk_fwd, NTHREADS, LDS_BYTES) != hipSuccess || per_cu < 1)
            fprintf(stderr, "kernel_launch: note: occupancy query reports %d workgroups per CU\n", per_cu);
        (void)hipGetLastError();
        grid = cus;
    }
    if (grid < 0) return;
    if (hipMemsetAsync((char*)d_ws + WS_CTL, 0, CTL_ZERO_BYTES, stream) != hipSuccess) { fprintf(stderr, "kernel_launch: memset failed\n"); return; }
    Args a{};
    for (int i = 0; i < 36; ++i) a.in[i] = (const float*)d_in[i];
    a.out = (float*)d_out; a.ws = (unsigned char*)d_ws;
#if MK_MULTI || MK_DBG
    for (int ph = 0; ph < PH_COUNT; ++ph) {
        if (!host_phase_nonempty(ph)) continue;
        a.ph_lo = ph; a.ph_hi = ph + 1;
        hipLaunchKernelGGL(mk_fwd, dim3(grid), dim3(NTHREADS), LDS_BYTES, stream, a);
#if MK_DBG
        dbg_after_phase(ph, a, stream);
#endif
    }
#if MK_DBG
    dbg_report(a, stream);
#endif
#else
    a.ph_lo = 0; a.ph_hi = PH_COUNT;
    hipLaunchKernelGGL(mk_fwd, dim3(grid), dim3(NTHREADS), LDS_BYTES, stream, a);
#endif
    const hipError_t le = hipPeekAtLastError();
    if (le != hipSuccess) fprintf(stderr, "kernel_launch: launch failed: %s\n", hipGetErrorName(le));
}
```

```cpp
#include <hip/hip_runtime.h>
#include <cstdio>
#include <cstdint>
#include <cmath>

#ifndef MK_MULTI
#define MK_MULTI 0
#endif
#ifndef MK_REPEAT
#define MK_REPEAT -1
#endif
#ifndef MK_NREP
#define MK_NREP 1
#endif
#ifndef MK_XP
#define MK_XP 0
#endif
#ifndef MK_MOEMAP
#define MK_MOEMAP 0
#endif
#ifndef MK_DBG
#define MK_DBG 0
#endif

constexpr int D = 1024, NB = 8, SEQ = 8192, CL = 256, ML = NB * SEQ, MC = NB * CL, MT = ML + MC;
constexpr int NLAYER = 4, NE = 32, TOPK = 4, SKV = SEQ + CL;
constexpr int MOE_MAXBLK = (MT * TOPK) / 256 + NE;
constexpr float EPS = 1e-6f;
constexpr int FH = 64, FEMB = 33, NFFT = 16384;

constexpr size_t MiB = 1u << 20;
constexpr size_t WS_CTL = 0, CTL_ZERO_BYTES = 1 * MiB;
constexpr size_t WS_MOD = 1 * MiB;
constexpr size_t WS_A3 = 2 * MiB;
constexpr size_t WS_A3C = 4 * MiB;
constexpr size_t WS_RC = 4 * MiB + 512 * 1024;
constexpr size_t WS_FCT = 5 * MiB;
constexpr size_t WS_WATT = 8 * MiB;
constexpr size_t WS_WGM = 14 * MiB;
constexpr size_t WS_WHY = 18 * MiB;
constexpr size_t WS_WOUT = 24 * MiB;
constexpr size_t WS_RW3 = 32 * MiB;
constexpr size_t WS_TE = 40 * MiB;
constexpr size_t WS_TR = 42 * MiB;
constexpr size_t WS_TG = 44 * MiB;
constexpr size_t WS_SS = 46 * MiB;
constexpr size_t WS_ROWTOK = 52 * MiB;
constexpr size_t WS_KF = 64 * MiB;
constexpr size_t WS_WE1 = 192 * MiB;
constexpr size_t WS_WE2 = 704 * MiB;
constexpr size_t WS_H = 960 * MiB;
constexpr size_t WS_P = 1092 * MiB;
constexpr size_t WS_Y = 1488 * MiB;
constexpr size_t WS_QB = 1620 * MiB;
constexpr size_t WS_K8_OFF = 72 * MiB;
constexpr size_t WS_KVB = 1752 * MiB;
constexpr size_t WS_X0 = 1818 * MiB;
constexpr size_t WS_VG = 1950 * MiB;
constexpr size_t WS_VT = 2082 * MiB;
constexpr size_t WS_VTC = 2338 * MiB;
constexpr size_t WS_ACT = 2346 * MiB;
constexpr size_t WS_YM = 2890 * MiB;
constexpr size_t WS_CT = 3434 * MiB;
constexpr size_t WS_CTC = 3690 * MiB;
constexpr size_t WS_H8 = 3698 * MiB;
constexpr size_t WS_XB = 3764 * MiB;
constexpr size_t WS_END = 3896 * MiB;
constexpr int CW_BAR = 4096;
constexpr int CW_CNT = 16384;
constexpr int CW_DBG = 32768;

constexpr int RING_BYTES = 131072;
constexpr int AUX_OFF = RING_BYTES;
constexpr int AUX_BYTES = 16384;
constexpr int MISC_OFF = AUX_OFF + AUX_BYTES;
constexpr int MISC_BYTES = 4096;
constexpr int LDS_BYTES = MISC_OFF + MISC_BYTES;

#define GAS __attribute__((address_space(1)))
#define LAS __attribute__((address_space(3)))
typedef unsigned short bf16;
typedef unsigned v4u __attribute__((ext_vector_type(4)));
typedef unsigned v2u __attribute__((ext_vector_type(2)));
typedef float f32x4 __attribute__((ext_vector_type(4)));
typedef float f32x2 __attribute__((ext_vector_type(2)));
typedef float f32x16 __attribute__((ext_vector_type(16)));
typedef short bf16x8 __attribute__((ext_vector_type(8)));
typedef short s16x4 __attribute__((ext_vector_type(4)));
typedef int i32x4 __attribute__((ext_vector_type(4)));
typedef GAS unsigned gu32;
#define RLX_AGENT __ATOMIC_RELAXED, __HIP_MEMORY_SCOPE_AGENT
#define LDS_WAIT() asm volatile("s_waitcnt lgkmcnt(0)" ::: "memory")
#define VM_WAIT() asm volatile("s_waitcnt vmcnt(0)" ::: "memory")
__device__ __forceinline__ int opaque_tid(int wave) { int l; asm volatile("v_mbcnt_lo_u32_b32 %0, -1, 0\n\tv_mbcnt_hi_u32_b32 %0, -1, %0" : "=v"(l)); return (wave << 6) | l; }
__device__ __forceinline__ unsigned f2bf(float f) { unsigned u = __builtin_bit_cast(unsigned, f); return (u + 0x7fffu + ((u >> 16) & 1u)) >> 16; }
__device__ __forceinline__ unsigned pk2(float lo, float hi) { return f2bf(lo) | (f2bf(hi) << 16); }
__device__ __forceinline__ float bf2f(unsigned short b) { return __builtin_bit_cast(float, ((unsigned)b) << 16); }
__device__ __forceinline__ float bflo(unsigned w) { return __builtin_bit_cast(float, w << 16); }
__device__ __forceinline__ float bfhi(unsigned w) { return __builtin_bit_cast(float, w & 0xffff0000u); }
__device__ __forceinline__ f32x4 bf4_f32(v2u w) { return (f32x4){__uint_as_float(w.x << 16), __uint_as_float(w.x & 0xffff0000u), __uint_as_float(w.y << 16), __uint_as_float(w.y & 0xffff0000u)}; }
__device__ __forceinline__ unsigned cvt_pk_bf16(float lo, float hi) { unsigned r; asm volatile("v_cvt_pk_bf16_f32 %0, %1, %2" : "=v"(r) : "v"(lo), "v"(hi)); return r; }
__device__ __forceinline__ float shx(float v, int mask, int lane) { return __int_as_float(__builtin_amdgcn_ds_bpermute((lane ^ mask) << 2, __float_as_int(v))); }
__device__ __forceinline__ float wave_sum(float v, int lane) {
#pragma unroll
    for (int o = 1; o < 64; o <<= 1) v += shx(v, o, lane);
    return v;
}

#define XB_TMO      128
#define XB_XCNT(j)  (256  + 64 * (j))
#define XB_XSUB(j)  (1280 + 64 * (j))
#define XB_XGEN(j)  (2304 + 64 * (j))
#define XB_TOP      3328
#define XB_TOPGEN   3392
#define XCD_BAR_WORDS 3456
#define XB_SPIN_CAP (1u << 22)
__device__ __forceinline__ unsigned xb_ld(unsigned* p)              { return __hip_atomic_load(p, __ATOMIC_RELAXED, __HIP_MEMORY_SCOPE_AGENT); }
__device__ __forceinline__ unsigned xb_add(unsigned* p, unsigned v) { return __hip_atomic_fetch_add(p, v, __ATOMIC_RELAXED, __HIP_MEMORY_SCOPE_AGENT); }
__device__ __forceinline__ unsigned xb_xcc_id() { return (unsigned)__builtin_amdgcn_s_getreg((3 << 11) | 20) & 0xFu; }
#define XB_SPIN(cond, bar) do { unsigned _sp = 0; while (cond) { __builtin_amdgcn_s_sleep(1); \
    if ((++_sp & 255u) == 0u) { if (xb_ld(&(bar)[XB_TMO])) break; if (_sp > XB_SPIN_CAP) { atomicAdd(&(bar)[XB_TMO], 1u); break; } } } } while (0)
struct XcdBarrier { unsigned* bar; unsigned x; volatile LAS unsigned* st; int w; };
__device__ __forceinline__ bool xb_thread0(int w) { return opaque_tid(w) == 0; }
__device__ __forceinline__ XcdBarrier xcd_barrier_post(unsigned* bar, volatile LAS unsigned* st, int w) {
    XcdBarrier b; b.bar = bar; b.x = xb_xcc_id(); b.st = st; b.w = w;
    if (xb_thread0(w)) (void)xb_add(&bar[XB_XCNT(b.x)], 1u);
    return b;
}
__device__ __forceinline__ void xcd_barrier_complete(unsigned* bar, unsigned x, unsigned& nloc, unsigned& nx) {
    const unsigned G = gridDim.x * gridDim.y * gridDim.z;
    unsigned sum, cnt, mine, sp = 0u;
    for (;;) {
        sum = 0u; cnt = 0u; mine = 0u;
#pragma unroll
        for (unsigned j = 0; j < 16; ++j) { const unsigned c = xb_ld(&bar[XB_XCNT(j)]); sum += c; cnt += (c > 0u) ? 1u : 0u; mine = (j == x) ? c : mine; }
        if (sum == G) break;
        __builtin_amdgcn_s_sleep(1);
        if ((++sp & 255u) == 0u) { if (xb_ld(&bar[XB_TMO])) break; if (sp > XB_SPIN_CAP) { atomicAdd(&bar[XB_TMO], 1u); break; } }
    }
    nloc = mine > 0u ? mine : 1u; nx = cnt > 0u ? cnt : 1u;
}
__device__ __forceinline__ void xcd_barrier(const XcdBarrier& b) {
    asm volatile("s_waitcnt vmcnt(0)" ::: "memory");
    __syncthreads();
    if (xb_thread0(b.w)) {
        unsigned* bar = b.bar;
        __builtin_amdgcn_s_waitcnt(0);
        unsigned nloc = b.st[0], nx = b.st[1];
        if (nloc == 0u) { xcd_barrier_complete(bar, b.x, nloc, nx); b.st[0] = nloc; b.st[1] = nx; }
        const unsigned old = xb_add(&bar[XB_XSUB(b.x)], 1u);
        const unsigned gen = old / nloc;
        if (old + 1u == (gen + 1u) * nloc) {
            __builtin_amdgcn_fence(__ATOMIC_RELEASE, "agent");
            asm volatile("s_waitcnt vmcnt(0)" ::: "memory");
            const unsigned og = xb_add(&bar[XB_TOP], 1u);
            const unsigned tg = og / nx;
            if (og + 1u == (tg + 1u) * nx) xb_add(&bar[XB_TOPGEN], 1u);
            else XB_SPIN(xb_ld(&bar[XB_TOPGEN]) == tg, bar);
            __builtin_amdgcn_fence(__ATOMIC_ACQUIRE, "agent");
            xb_add(&bar[XB_XGEN(b.x)], 1u);
            asm volatile("s_waitcnt vmcnt(0)" ::: "memory");
        } else {
            XB_SPIN(xb_ld(&bar[XB_XGEN(b.x)]) == gen, bar);
            __builtin_amdgcn_fence(__ATOMIC_ACQUIRE, "agent");
            asm volatile("s_waitcnt vmcnt(0)" ::: "memory");
        }
    }
    __syncthreads();
}

namespace pg8 {
constexpr int BM = 256, BK = 64, HALF = 128, HTB = HALF * BK * 2, STAGE_BYTES = 8 * HTB, NXCD = 8, WGM = 8;
constexpr int GK = 1024;
__device__ __forceinline__ int lds_byte(int r, int c) { const int st = (r >> 4) * 2 + (c >> 5), rr = r & 15, cc = c & 31, ob = rr * 64 + cc * 2; return st * 1024 + (ob ^ (((ob >> 9) & 1) << 5)); }
__device__ __forceinline__ void stage_rc(int b, int& R, int& C) { const int st = b / 1024, sb = b % 1024, swz = sb ^ (((sb >> 9) & 1) << 5); R = (st >> 1) * 16 + swz / 64; C = (st & 1) * 32 + (swz % 64) / 2; }
__device__ __forceinline__ int perm32(int rho) { const int n = rho >> 4, i = rho & 15; return 8 * (i >> 2) + 4 * n + (i & 3); }
struct Unit { int pm, pn, e; };

template <bool IDG> struct DenseSchedT {
    const char* A; const char* Bt; int nM, nN, nwg, G, c, kb;
    __device__ __forceinline__ void init(const void* A_, const void* Bt_, int M, int N, int G_, int c_, int kb_ = GK * 2) { A = (const char*)A_; Bt = (const char*)Bt_; nM = M / BM; nN = N / BM; nwg = nM * nN; G = G_; c = c_; kb = kb_; }
    __device__ __forceinline__ bool next(int i, Unit& u) const {
        const long L = (long)i * G + c; if (L >= nwg) return false;
        int wgid = (int)L; { const int q = nwg / NXCD, r = nwg % NXCD, xcd = wgid % NXCD, off = wgid / NXCD; wgid = (xcd < r ? xcd * (q + 1) : r * (q + 1) + (xcd - r) * q) + off; }
        const int nig = WGM * nN, gid = wgid / nig, fm = gid * WGM, gsz = (nM - fm) < WGM ? (nM - fm) : WGM;
        u.pm = fm + ((wgid % nig) % gsz); u.pn = (wgid % nig) / gsz; u.e = 0; return true;
    }
    __device__ __forceinline__ const char* a_ptr(const Unit& u) const { return IDG ? A : A + (size_t)u.pm * (size_t)(BM * kb); }
    __device__ __forceinline__ const char* b_ptr(const Unit& u) const { return Bt + (size_t)u.pn * (size_t)(BM * kb); }
    __device__ __forceinline__ void a_offs(const Unit& u, const int (&R)[2], const int (&C)[2], unsigned (&voff)[2][2]) const {
#pragma unroll
        for (int h = 0; h < 2; ++h)
#pragma unroll
            for (int i = 0; i < 2; ++i) voff[h][i] = (unsigned)(u.pm * BM + h * HALF + R[i]) * (unsigned)kb + (unsigned)C[i] * 2u;
    }
    __device__ __forceinline__ void a_raw(const Unit&, const int (&)[2], int (&)[2][2]) const {}
    __device__ __forceinline__ void a_fin(const Unit& u, const int (&R)[2], const int (&C)[2], const int (&)[2][2], unsigned (&voff)[2][2]) const { a_offs(u, R, C, voff); }
};
typedef DenseSchedT<false> DenseSched;
struct MoeSched {
    const char* A; const char* Bt; size_t b_estride; const int* rowtok; const volatile LAS int* cumblk; const volatile LAS int* cnt; int ncol_log2, G, c, kb; const volatile LAS int* ulist;
    __device__ __forceinline__ bool next(int i, Unit& u) const {
        const int v = ulist[i & 63]; if (v < 0) return false;
        u.pm = v >> 8; u.e = (v >> 3) & 31; u.pn = v & 7; return true;
    }
    __device__ __forceinline__ void build_list(volatile LAS int* dst, int tid) const {
        if (tid < 64) { Unit u; dst[tid] = search(tid, u) ? ((u.pm << 8) | (u.e << 3) | u.pn) : -1; }
    }
    __device__ __forceinline__ bool search(int i, Unit& u) const {
        int gb, pn; const int ncol = 1 << ncol_log2;
        if (G == 256 && MK_MOEMAP == 0) { const int xcd = c & 7, j = c >> 3, rpb = 256 >> ncol_log2; gb = i * rpb + xcd + 8 * (j >> ncol_log2); pn = j & (ncol - 1); }
        else { const long L = (long)i * G + c; gb = (int)(L >> ncol_log2); pn = (int)(L & (ncol - 1)); }
        const int tot = cumblk[NE]; if (gb >= tot) return false;
        int e = 0;
#pragma unroll 1
        for (int s = 16; s >= 1; s >>= 1) { if (cumblk[e + s] <= gb) e += s; }
        u.pm = gb; u.pn = pn; u.e = e; return true;
    }
    __device__ __forceinline__ const char* a_ptr(const Unit&) const { return A; }
    __device__ __forceinline__ const char* b_ptr(const Unit& u) const { return Bt + (size_t)u.e * b_estride + (size_t)u.pn * (size_t)(BM * kb); }
    __device__ __forceinline__ void a_raw(const Unit& u, const int (&R)[2], int (&raw)[2][2]) const {
        if (!rowtok) return;
        const int rb = u.pm - cumblk[u.e]; const int* rt = rowtok + (size_t)u.e * MT;
#pragma unroll
        for (int h = 0; h < 2; ++h)
#pragma unroll
            for (int i = 0; i < 2; ++i) { const int* ptr = rt + (rb * 256 + h * HALF + R[i]);
                asm volatile("global_load_dword %0, %1, off" : "=v"(raw[h][i]) : "v"(ptr) : "memory"); }
    }
    __device__ __forceinline__ void a_fin(const Unit& u, const int (&R)[2], const int (&C)[2], const int (&raw_)[2][2], unsigned (&voff)[2][2]) const {
        int raw[2][2] = {{raw_[0][0], raw_[0][1]}, {raw_[1][0], raw_[1][1]}};
        asm volatile("" : "+v"(raw[0][0]), "+v"(raw[0][1]), "+v"(raw[1][0]), "+v"(raw[1][1]));
        const int rb = u.pm - cumblk[u.e], n = cnt[u.e];
#pragma unroll
        for (int h = 0; h < 2; ++h)
#pragma unroll
            for (int i = 0; i < 2; ++i) { const int rank = rb * 256 + h * HALF + R[i]; const int tok = rowtok ? (rank < n ? raw[h][i] : 0) : u.pm * BM + h * HALF + R[i];
                voff[h][i] = (unsigned)tok * (unsigned)kb + (unsigned)C[i] * 2u; }
    }
    __device__ __forceinline__ void a_offs(const Unit& u, const int (&R)[2], const int (&C)[2], unsigned (&voff)[2][2]) const { int raw[2][2] = {{0, 0}, {0, 0}}; a_raw(u, R, raw); asm volatile("s_waitcnt vmcnt(0)" : "+v"(raw[0][0]), "+v"(raw[0][1]), "+v"(raw[1][0]), "+v"(raw[1][1]) :: "memory"); a_fin(u, R, C, raw, voff); }
};

typedef int v8i __attribute__((ext_vector_type(8)));
__device__ __forceinline__ v8i cat8(bf16x8 lo, bf16x8 hi) { const v4u a = __builtin_bit_cast(v4u, lo), b = __builtin_bit_cast(v4u, hi); return (v8i){(int)a.x, (int)a.y, (int)a.z, (int)a.w, (int)b.x, (int)b.y, (int)b.z, (int)b.w}; }
template <class Epi, class Sched, bool GATHER, bool FP8 = false, int XG = 0>
__device__ __forceinline__ void gemm_phase(LAS unsigned char* lds, const Sched& S, const Epi& E, int wave_id, bool skip_epi = false, unsigned stagger_ticks = 0u) {
    if (stagger_ticks && ((blockIdx.x >> 3) & 1u)) { const unsigned long long t0 = __builtin_amdgcn_s_memrealtime(); while (__builtin_amdgcn_s_memrealtime() - t0 < (unsigned long long)stagger_ticks) __builtin_amdgcn_s_sleep(8); }
    const int tid = opaque_tid(wave_id), wid = __builtin_amdgcn_readfirstlane(tid >> 6), lane = tid & 63, wr = wid >> 2, wc = wid & 3, fr = lane & 15, fq = lane >> 4;
    constexpr int KB = FP8 ? GK : GK * 2, nt = KB / (BK * 2);
    unsigned voffA[2][2], voffB[2]; int Rr[2], Cc[2];
#pragma unroll
    for (int i = 0; i < 2; ++i) { int R, C; stage_rc(tid * 16 + i * 8192, R, C); Rr[i] = R; Cc[i] = C; const int Rb = Epi::PERM ? ((R & ~31) + perm32(R & 31)) : R;
        voffA[0][i] = (unsigned)(R * KB + C * 2); voffA[1][i] = (unsigned)((R + HALF) * KB + C * 2); voffB[i] = (unsigned)(Rb * KB + C * 2); }
    constexpr size_t kstep = (size_t)(BK * 2);
    constexpr size_t hstep = (size_t)HALF * KB;
    const unsigned ldsw = (unsigned)wid * 1024u;
    const int aoff = lds_byte(wr * 64 + fr, fq * 8), boff = lds_byte(wc * 32 + fr, fq * 8);
    LAS unsigned char* abase = lds + aoff; LAS unsigned char* bbase = lds + 4 * HTB + boff; asm volatile("" : "+v"(abase), "+v"(bbase));
#define PG8_SA(b, h) (((b) * 2 + (h)) * HTB)
#define PG8_SB(b, h) ((4 + (b) * 2 + (h)) * HTB)
#define PG8_STAGE(bufoff, gbase, voff) do { if (XG == 3) break; _Pragma("unroll") for (int _i = 0; _i < 2; ++_i) \
        __builtin_amdgcn_global_load_lds((const unsigned*)((const char*)(gbase) + (voff)[_i]), (LAS unsigned*)(lds + (bufoff) + ldsw + _i * 8192), 16, 0, 0); } while (0)
#define PG8_STAGE_A(bufoff, gbase, h) PG8_STAGE(bufoff, gbase, voffA[h])
#define PG8_RDA(off) (*(const LAS v4u*)(abase + (off)))
#define PG8_RDB(off) (*(const LAS v4u*)(bbase + (off)))
#define PG8_LDA(dst, b, h) do { if (XG == 2) break; _Pragma("unroll") for (int m = 0; m < 4; ++m) { const v4u _l = PG8_RDA(PG8_SA(b, h) + m * 2048), _h = PG8_RDA(PG8_SA(b, h) + m * 2048 + 1024); \
        if constexpr (FP8) dst##8[m] = (v8i){(int)_l.x, (int)_l.y, (int)_l.z, (int)_l.w, (int)_h.x, (int)_h.y, (int)_h.z, (int)_h.w}; \
        else { dst[m][0] = __builtin_bit_cast(bf16x8, _l); dst[m][1] = __builtin_bit_cast(bf16x8, _h); } } } while (0)
#define PG8_LDB(dst, b, h) do { if (XG == 2) break; _Pragma("unroll") for (int n = 0; n < 2; ++n) { const v4u _l = PG8_RDB(PG8_SA(b, h) + n * 2048), _h = PG8_RDB(PG8_SA(b, h) + n * 2048 + 1024); \
        if constexpr (FP8) dst##8[n] = (v8i){(int)_l.x, (int)_l.y, (int)_l.z, (int)_l.w, (int)_h.x, (int)_h.y, (int)_h.z, (int)_h.w}; \
        else { dst[n][0] = __builtin_bit_cast(bf16x8, _l); dst[n][1] = __builtin_bit_cast(bf16x8, _h); } } } while (0)
#define PG8_MMA(ai, bj, At, Bt) do { if (XG == 1) break; __builtin_amdgcn_s_setprio(1); _Pragma("unroll") for (int m = 0; m < 4; ++m) _Pragma("unroll") for (int n = 0; n < 2; ++n) { \
        if constexpr (FP8) acc[ai][bj][m][n] = __builtin_amdgcn_mfma_scale_f32_16x16x128_f8f6f4(Bt##8[n], At##8[m], acc[ai][bj][m][n], 0, 0, 0, 0x7A7A7A7A, 0, 0x7F7F7F7F); \
        else { _Pragma("unroll") for (int k = 0; k < 2; ++k) acc[ai][bj][m][n] = __builtin_amdgcn_mfma_f32_16x16x32_bf16(Bt[n][k], At[m][k], acc[ai][bj][m][n], 0, 0, 0); } } \
        __builtin_amdgcn_s_setprio(0); } while (0)
#define PG8_WAIT_V(n) asm volatile("s_waitcnt vmcnt(" #n ")" ::: "memory")
#define PG8_WAIT_L(n) asm volatile("s_waitcnt lgkmcnt(" #n ")" ::: "memory")
#define PG8_BAR __builtin_amdgcn_s_barrier()
#define PG8_SCHED __builtin_amdgcn_sched_barrier(0)
    Unit cur, nxt; int ui = 0;
    if (!S.next(0, cur)) return;
    f32x4 acc[2][2][4][2];
#pragma unroll
    for (int a = 0; a < 2; ++a)
#pragma unroll
        for (int b = 0; b < 2; ++b)
#pragma unroll
            for (int m = 0; m < 4; ++m)
#pragma unroll
                for (int n = 0; n < 2; ++n) acc[a][b][m][n] = (f32x4){0.f, 0.f, 0.f, 0.f};
    bf16x8 At[4][2], B0[2][2], B1[2][2]; v8i At8[4], B08[2], B18[2];
    if constexpr (XG == 2) { _Pragma("unroll") for (int m = 0; m < 4; ++m) { asm volatile("" : "=v"(At8[m])); } _Pragma("unroll") for (int n = 0; n < 2; ++n) { asm volatile("" : "=v"(B08[n])); asm volatile("" : "=v"(B18[n])); } }
    const char* cA = S.a_ptr(cur); const char* cB = S.b_ptr(cur);
    if constexpr (GATHER) S.a_offs(cur, Rr, Cc, voffA);
    PG8_STAGE(PG8_SB(0, 0), cB, voffB); PG8_STAGE(PG8_SB(0, 1), cB + hstep, voffB); PG8_STAGE_A(PG8_SA(0, 0), cA, 0); PG8_STAGE_A(PG8_SA(0, 1), cA, 1);
    if (wr == 1) PG8_BAR;
    PG8_WAIT_V(2); PG8_BAR;
    PG8_STAGE(PG8_SB(1, 0), cB + kstep, voffB); PG8_STAGE_A(PG8_SA(1, 0), cA + kstep, 0); PG8_STAGE(PG8_SB(1, 1), cB + hstep + kstep, voffB);
    PG8_WAIT_V(6); PG8_BAR;
    for (;;) {
        const bool has_next = S.next(ui + 1, nxt);
        const char* nA = has_next ? S.a_ptr(nxt) : cA; const char* nB = has_next ? S.b_ptr(nxt) : cB;
        int rawN[2][2] = {{0, 0}, {0, 0}};
        if constexpr (GATHER) { if (has_next) S.a_raw(nxt, Rr, rawN); }
#pragma unroll 1
        for (int t = 0; t < nt; t += 2) {
            const bool last = (t == nt - 2);
            if constexpr (Epi::LDSBIAS) { if (last && wid == 0) E.stage_bias(cur, lane); }
            const char* a1 = cA + (size_t)(t + 1) * kstep;
            const char* a2 = last ? nA : cA + (size_t)(t + 2) * kstep; const char* b2 = last ? nB : cB + (size_t)(t + 2) * kstep;
            const char* a3 = a2 + kstep; const char* b3 = b2 + kstep;
            PG8_LDB(B0, 0, 0); PG8_LDB(B1, 0, 1); PG8_SCHED; PG8_LDA(At, 0, 0); PG8_STAGE_A(PG8_SA(1, 1), a1, 1);
            if constexpr (GATHER) { if (last && has_next) S.a_fin(nxt, Rr, Cc, rawN, voffA); }
            PG8_WAIT_V(8); PG8_WAIT_L(0); PG8_BAR; PG8_MMA(0, 0, At, B0); PG8_MMA(0, 1, At, B1); PG8_BAR; PG8_SCHED;
            PG8_LDA(At, 0, 1); PG8_STAGE(PG8_SB(0, 0), b2, voffB); PG8_STAGE(PG8_SB(0, 1), b2 + hstep, voffB); PG8_STAGE_A(PG8_SA(0, 0), a2, 0);
            PG8_WAIT_V(8); PG8_WAIT_L(0); PG8_BAR; PG8_MMA(1, 0, At, B0); PG8_MMA(1, 1, At, B1); PG8_BAR; PG8_SCHED;
            PG8_LDB(B0, 1, 0); PG8_LDB(B1, 1, 1); PG8_SCHED; PG8_LDA(At, 1, 0); PG8_STAGE_A(PG8_SA(0, 1), a2, 1);
            PG8_WAIT_V(8); PG8_WAIT_L(0); PG8_BAR; PG8_MMA(0, 0, At, B0); PG8_MMA(0, 1, At, B1); PG8_BAR; PG8_SCHED;
            PG8_LDA(At, 1, 1); PG8_STAGE(PG8_SB(1, 0), b3, voffB); PG8_STAGE(PG8_SB(1, 1), b3 + hstep, voffB); PG8_STAGE_A(PG8_SA(1, 0), a3, 0);
            PG8_WAIT_V(8); PG8_WAIT_L(0); PG8_BAR; PG8_MMA(1, 0, At, B0); PG8_MMA(1, 1, At, B1); PG8_BAR; PG8_SCHED;
        }
        if (wr == 0) PG8_BAR;
        if (!skip_epi) E(acc, cur, wr, wc, fr, fq);
        if (!has_next) break;
#pragma unroll
        for (int a = 0; a < 2; ++a)
#pragma unroll
            for (int b = 0; b < 2; ++b)
#pragma unroll
                for (int m = 0; m < 4; ++m)
#pragma unroll
                    for (int n = 0; n < 2; ++n) acc[a][b][m][n] = (f32x4){0.f, 0.f, 0.f, 0.f};
        cur = nxt; cA = nA; cB = nB; ++ui;
        if (wr == 1) PG8_BAR;
    }
    PG8_WAIT_V(0);
    PG8_BAR;
#undef PG8_SA
#undef PG8_SB
#undef PG8_STAGE
#undef PG8_STAGE_A
#undef PG8_LDA
#undef PG8_RDA
#undef PG8_RDB
#undef PG8_LDB
#undef PG8_MMA
#undef PG8_WAIT_V
#undef PG8_WAIT_L
#undef PG8_BAR
#undef PG8_SCHED
}
}
namespace pg8 {
__device__ __forceinline__ f32x2 gelu_pk(f32x2 v) {
    const f32x2 av = __builtin_elementwise_abs(v), d = av * 0.2316418882f + 1.0f;
    f32x2 t; t.x = __builtin_amdgcn_rcpf(d.x); t.y = __builtin_amdgcn_rcpf(d.y);
    f32x2 q = t * 0.5307027145f + (-0.7265760135f); q = q * t + 0.7107068705f; q = q * t + (-0.142248368f); q = q * t + 0.127414796f; q = q * t;
    const f32x2 s = (v * v) * (-0.72134752044f);
    f32x2 e; e.x = __builtin_amdgcn_exp2f(s.x); e.y = __builtin_amdgcn_exp2f(s.y);
    const f32x2 m = v * (q * e), r = v - m;
    f32x2 o; o.x = v.x < 0.f ? m.x : r.x; o.y = v.y < 0.f ? m.y : r.y; return o;
}
struct EpiBf16 {
    static constexpr bool PERM = true, LDSBIAS = false;
    bf16* O; int ldc; float* ss; int ACT;
    __device__ __forceinline__ void operator()(const f32x4 (&acc)[2][2][4][2], const Unit& u, int wr, int wc, int fr, int fq) const {
        const int row0 = u.pm * BM + wr * 64 + fr, col0 = u.pn * BM + wc * 32 + 8 * fq;
#pragma unroll
        for (int ai = 0; ai < 2; ++ai)
#pragma unroll
            for (int m = 0; m < 4; ++m) { const int row = row0 + ai * HALF + m * 16; bf16* rowp = O + (size_t)row * ldc + col0; float sq = 0.f;
#pragma unroll
                for (int bj = 0; bj < 2; ++bj) { f32x4 v0 = acc[ai][bj][m][0], v1 = acc[ai][bj][m][1];
                    if (ACT == 1) { f32x2 a = gelu_pk((f32x2){v0[0], v0[1]}), b = gelu_pk((f32x2){v0[2], v0[3]}), c = gelu_pk((f32x2){v1[0], v1[1]}), d = gelu_pk((f32x2){v1[2], v1[3]});
                        v0 = (f32x4){a.x, a.y, b.x, b.y}; v1 = (f32x4){c.x, c.y, d.x, d.y};
                        sq += (v0[0] * v0[0] + v0[1] * v0[1]) + (v0[2] * v0[2] + v0[3] * v0[3]) + (v1[0] * v1[0] + v1[1] * v1[1]) + (v1[2] * v1[2] + v1[3] * v1[3]); }
                    v4u w; w.x = cvt_pk_bf16(v0[0], v0[1]); w.y = cvt_pk_bf16(v0[2], v0[3]); w.z = cvt_pk_bf16(v1[0], v1[1]); w.w = cvt_pk_bf16(v1[2], v1[3]);
                    *(v4u*)(rowp + bj * HALF) = w; }
                if (ACT == 1) { const int ln = (fq << 4) | fr; sq += shx(sq, 16, ln); sq += shx(sq, 32, ln);
                    if (u.pn >= 4 && fq == 0) ss[(size_t)row * 16 + (u.pn - 4) * 4 + wc] = sq; }
            }
    }
};
struct EpiResid {
    static constexpr bool PERM = false, LDSBIAS = false;
    bf16* xb; const float* modl;
    __device__ __forceinline__ void operator()(const f32x4 (&acc)[2][2][4][2], const Unit& u, int wr, int wc, int fr, int fq) const {
        const bool lat = u.pm < ML / BM; const int bidx = lat ? (u.pm >> 5) : 8;
        bf16* base = xb + (size_t)u.pm * BM * D;
        const float* g = modl + bidx * 6144 + 2 * 1024;
        const int r0 = wr * 64 + fr, col0 = u.pn * BM + wc * 32 + 4 * fq;
        f32x4 gv[2][2];
#pragma unroll
        for (int bj = 0; bj < 2; ++bj)
#pragma unroll
            for (int n = 0; n < 2; ++n) gv[bj][n] = *(const f32x4*)(g + col0 + bj * HALF + n * 16);
        const int odd = fq & 1, colp = col0 - 4 * odd;
#pragma unroll
        for (int ai = 0; ai < 2; ++ai) { v4u bs[2][2][2];
#pragma unroll
            for (int mp = 0; mp < 2; ++mp) { const size_t off = (size_t)(r0 + ai * HALF + (2 * mp + odd) * 16) * D + colp;
#pragma unroll
                for (int bj = 0; bj < 2; ++bj)
#pragma unroll
                    for (int n = 0; n < 2; ++n) bs[mp][bj][n] = *(const v4u*)(base + off + bj * HALF + n * 16); }
#pragma unroll
            for (int mp = 0; mp < 2; ++mp) { const size_t off = (size_t)(r0 + ai * HALF + (2 * mp + odd) * 16) * D + colp;
#pragma unroll
                for (int bj = 0; bj < 2; ++bj)
#pragma unroll
                    for (int n = 0; n < 2; ++n) { const v4u L = bs[mp][bj][n];
                        const auto s0 = __builtin_amdgcn_permlane16_swap(L.x, L.z, false, false), s1 = __builtin_amdgcn_permlane16_swap(L.y, L.w, false, false);
                        const f32x4 va = bf4_f32((v2u){s0[0], s1[0]}) + gv[bj][n] * acc[ai][bj][2 * mp][n], vb = bf4_f32((v2u){s0[1], s1[1]}) + gv[bj][n] * acc[ai][bj][2 * mp + 1][n];
                        const auto t0 = __builtin_amdgcn_permlane16_swap(cvt_pk_bf16(va.x, va.y), cvt_pk_bf16(vb.x, vb.y), false, false), t1 = __builtin_amdgcn_permlane16_swap(cvt_pk_bf16(va.z, va.w), cvt_pk_bf16(vb.z, vb.w), false, false);
                        *(v4u*)(base + off + bj * HALF + n * 16) = (v4u){t0[0], t1[0], t0[1], t1[1]}; } }
            asm volatile("" ::: "memory"); }
    }
};
struct EpiSwiglu {
    static constexpr bool PERM = true, LDSBIAS = true;
    unsigned char* O; const float* b1; LAS float* bl;
    __device__ __forceinline__ void stage_bias(const Unit& u, int lane) const { const float* src = b1 + (size_t)u.e * 2048 + (lane < 32 ? u.pn * HALF + 4 * lane : 1024 + u.pn * HALF + 4 * (lane - 32));
        __builtin_amdgcn_global_load_lds((const unsigned*)src, (LAS unsigned*)bl, 16, 0, 0); }
    __device__ __forceinline__ void operator()(const f32x4 (&acc)[2][2][4][2], const Unit& u, int wr, int wc, int fr, int fq) const {
        const int row0 = u.pm * BM + wr * 64 + fr, cl = wc * 32 + 8 * fq, c0 = u.pn * HALF + cl;
        f32x4 bg[2], bli[2];
#pragma unroll
        for (int n = 0; n < 2; ++n) { bg[n] = *(const LAS f32x4*)(bl + cl + 4 * n); bli[n] = *(const LAS f32x4*)(bl + 128 + cl + 4 * n) + 1.0f; }
#pragma unroll
        for (int ai = 0; ai < 2; ++ai)
#pragma unroll
            for (int mp = 0; mp < 4; mp += 2) { v2u wv[2];
#pragma unroll
              for (int mm = 0; mm < 2; ++mm) { const int m = mp + mm; float o[8];
#pragma unroll
                for (int n = 0; n < 2; ++n)
#pragma unroll
                    for (int j = 0; j < 4; ++j) { const float gl = fminf(acc[ai][0][m][n][j] + bg[n][j], 7.0f), lp = __builtin_amdgcn_fmed3f(acc[ai][1][m][n][j] + bli[n][j], -6.0f, 8.0f);
                        const float sg = __builtin_amdgcn_rcpf(1.0f + __builtin_amdgcn_exp2f(gl * (-1.702f * 1.4426950408889634f)));
                        o[n * 4 + j] = gl * sg * lp; }
                v2u w; w.x = 0; w.y = 0;
                w.x = __builtin_amdgcn_cvt_pk_fp8_f32(o[0], o[1], w.x, false); w.x = __builtin_amdgcn_cvt_pk_fp8_f32(o[2], o[3], w.x, true);
                w.y = __builtin_amdgcn_cvt_pk_fp8_f32(o[4], o[5], w.y, false); w.y = __builtin_amdgcn_cvt_pk_fp8_f32(o[6], o[7], w.y, true);
                wv[mm] = w; }
              const auto sx = __builtin_amdgcn_permlane16_swap(wv[0].x, wv[1].x, false, false), sy = __builtin_amdgcn_permlane16_swap(wv[0].y, wv[1].y, false, false);
              *(v4u*)(O + (size_t)(row0 + ai * HALF + (mp + (fq & 1)) * 16) * D + (c0 - 8 * (fq & 1))) = (v4u){sx[0], sy[0], sx[1], sy[1]}; }
    }
};
struct EpiBias {
    static constexpr bool PERM = true, LDSBIAS = true;
    unsigned char* O; const float* b2; LAS float* bl;
    __device__ __forceinline__ void stage_bias(const Unit& u, int lane) const { __builtin_amdgcn_global_load_lds((const unsigned*)(b2 + (size_t)u.e * 1024 + u.pn * BM + 4 * lane), (LAS unsigned*)bl, 16, 0, 0); }
    __device__ __forceinline__ void operator()(const f32x4 (&acc)[2][2][4][2], const Unit& u, int wr, int wc, int fr, int fq) const {
        const int row0 = u.pm * BM + wr * 64 + fr, cl = wc * 32 + 8 * fq, col0 = u.pn * BM + cl;
#pragma unroll
        for (int bj = 0; bj < 2; ++bj) { const f32x4 bv0 = *(const LAS f32x4*)(bl + cl + bj * HALF), bv1 = *(const LAS f32x4*)(bl + cl + bj * HALF + 4);
#pragma unroll
            for (int ai = 0; ai < 2; ++ai)
#pragma unroll
                for (int mp = 0; mp < 4; mp += 2) { v2u wv[2];
#pragma unroll
                    for (int mm = 0; mm < 2; ++mm) { const int m = mp + mm; const f32x4 v0 = acc[ai][bj][m][0] + bv0, v1 = acc[ai][bj][m][1] + bv1;
                        v2u w; w.x = 0; w.y = 0;
                        w.x = __builtin_amdgcn_cvt_pk_fp8_f32(v0[0], v0[1], w.x, false); w.x = __builtin_amdgcn_cvt_pk_fp8_f32(v0[2], v0[3], w.x, true);
                        w.y = __builtin_amdgcn_cvt_pk_fp8_f32(v1[0], v1[1], w.y, false); w.y = __builtin_amdgcn_cvt_pk_fp8_f32(v1[2], v1[3], w.y, true);
                        wv[mm] = w; }
                    const auto sx = __builtin_amdgcn_permlane16_swap(wv[0].x, wv[1].x, false, false), sy = __builtin_amdgcn_permlane16_swap(wv[0].y, wv[1].y, false, false);
                    *(v4u*)(O + (size_t)(row0 + ai * HALF + (mp + (fq & 1)) * 16) * D + (col0 - 8 * (fq & 1)) + bj * HALF) = (v4u){sx[0], sy[0], sx[1], sy[1]}; }
            asm volatile("" ::: "memory"); }
    }
};
}

namespace att {
constexpr int AD = 128, NW = 8, QBLK = 32, KVBLK = 64;
constexpr float SCALE = 0.088388347648318440f;
constexpr int LDO = 1024;
constexpr int SHM_V = AD * KVBLK, SHM_K = KVBLK * AD, SHM_ATTN = 4 * SHM_V + 4 * SHM_K;
typedef int v8i __attribute__((ext_vector_type(8)));
#define K8SW(key, c) ((key) * 128 + ((((c) ^ (((key) >> 1) & 7))) << 4))
#define V8SW(d, c) ((d) * 64 + ((((c) ^ (((d) >> 2) & 3))) << 4))
#define SBAR() __builtin_amdgcn_sched_barrier(0)
__device__ __forceinline__ int crow(int r, int hi) { return (r & 3) + 8 * (r >> 2) + 4 * hi; }
template <int XV = 0>
__device__ __forceinline__ int exp4(float a0, float a1, float a2, float a3) {
  float t0 = fminf(a0 + 8.0f, 8.0f), t1 = fminf(a1 + 8.0f, 8.0f), t2 = fminf(a2 + 8.0f, 8.0f), t3 = fminf(a3 + 8.0f, 8.0f); int w;
  asm volatile("v_exp_f32 %1, %1\n\tv_exp_f32 %2, %2\n\tv_exp_f32 %3, %3\n\tv_exp_f32 %4, %4\n\t"
               "v_cvt_pk_fp8_f32 %0, %1, %2\n\ts_nop 0\n\tv_cvt_pk_fp8_f32 %0, %3, %4 op_sel:[0,0,1]"
               : "=&v"(w), "+v"(t0), "+v"(t1), "+v"(t2), "+v"(t3));
  return w;
}
template <int PAD>
__device__ __forceinline__ int expc4(float a0, float a1, float a2, float a3) {
  int w; float t0, t1, t2, t3;
  if constexpr (PAD != 0)
    asm volatile("s_nop 5\n\tv_exp_f32_e64 %1, %5 clamp\n\tv_exp_f32_e64 %2, %6 clamp\n\tv_exp_f32_e64 %3, %7 clamp\n\tv_exp_f32_e64 %4, %8 clamp\n\t"
                 "v_cvt_scalef32_pk_fp8_f32 %0, %1, %2, %9\n\ts_nop 0\n\tv_cvt_scalef32_pk_fp8_f32 %0, %3, %4, %9 op_sel:[0,0,0,1]"
                 : "=&v"(w), "=&v"(t0), "=&v"(t1), "=&v"(t2), "=&v"(t3) : "v"(a0), "v"(a1), "v"(a2), "v"(a3), "s"(0x3B800000));
  else
    asm volatile("v_exp_f32_e64 %1, %5 clamp\n\tv_exp_f32_e64 %2, %6 clamp\n\tv_exp_f32_e64 %3, %7 clamp\n\tv_exp_f32_e64 %4, %8 clamp\n\t"
                 "v_cvt_scalef32_pk_fp8_f32 %0, %1, %2, %9\n\ts_nop 0\n\tv_cvt_scalef32_pk_fp8_f32 %0, %3, %4, %9 op_sel:[0,0,0,1]"
                 : "=&v"(w), "=&v"(t0), "=&v"(t1), "=&v"(t2), "=&v"(t3) : "v"(a0), "v"(a1), "v"(a2), "v"(a3), "s"(0x3B800000));
  return w;
}
#define EXC4(P, m, PAD) expc4<PAD>(P[4 * (m)], P[4 * (m) + 1], P[4 * (m) + 2], P[4 * (m) + 3])
typedef int v4i __attribute__((ext_vector_type(4)));
__device__ __forceinline__ void partialSM(const f32x16& p0, float nb, v4i& plo) {
#pragma unroll
  for (int m = 0; m < 4; ++m) plo[m] = exp4(p0[4 * m], p0[4 * m + 1], p0[4 * m + 2], p0[4 * m + 3]);
}
__device__ __forceinline__ void finishSM(const f32x16& p1, float nb, const v4i& plo, v8i& pa) {
  v4i phi;
#pragma unroll
  for (int m = 0; m < 4; ++m) phi[m] = exp4(p1[4 * m], p1[4 * m + 1], p1[4 * m + 2], p1[4 * m + 3]);
  pa = (v8i){plo[0], plo[1], plo[2], plo[3], phi[0], phi[1], phi[2], phi[3]};
}
__device__ __forceinline__ void qkt(f32x16& p0, f32x16& p1, const char* Ks, const v8i* q8, int r32, int hi, const f32x16& NBV) {
  p0 = NBV; p1 = NBV;
#pragma unroll
  for (int s = 0; s < 2; ++s) { const int c0 = 4 * s + 2 * hi;
    const v4u a0 = *reinterpret_cast<const v4u*>(Ks + K8SW(r32, c0)), a1 = *reinterpret_cast<const v4u*>(Ks + K8SW(r32, c0 + 1));
    const v4u b0 = *reinterpret_cast<const v4u*>(Ks + K8SW(32 + r32, c0)), b1 = *reinterpret_cast<const v4u*>(Ks + K8SW(32 + r32, c0 + 1));
    const v8i A0 = (v8i){(int)a0.x, (int)a0.y, (int)a0.z, (int)a0.w, (int)a1.x, (int)a1.y, (int)a1.z, (int)a1.w};
    const v8i A1 = (v8i){(int)b0.x, (int)b0.y, (int)b0.z, (int)b0.w, (int)b1.x, (int)b1.y, (int)b1.z, (int)b1.w};
    p0 = __builtin_amdgcn_mfma_scale_f32_32x32x64_f8f6f4(A0, q8[s], p0, 0, 0, 0, 0x7F7F7F7F, 0, 0x7C7C7C7C);
    p1 = __builtin_amdgcn_mfma_scale_f32_32x32x64_f8f6f4(A1, q8[s], p1, 0, 0, 0, 0x7F7F7F7F, 0, 0x7C7C7C7C); }
}
__device__ __forceinline__ void pv_d0(f32x16* o, f32x16& lacc, const char* Vs, v8i pa, int r32, int hi) {
  { const int one = 0x38383838; const v8i ONES = (v8i){one, one, one, one, one, one, one, one};
    lacc = __builtin_amdgcn_mfma_scale_f32_32x32x64_f8f6f4(pa, ONES, lacc, 0, 0, 0, 0x7F7F7F7F, 0, 0x7F7F7F7F); }
#pragma unroll
  for (int d0 = 0; d0 < 4; ++d0) { const int d = 32 * d0 + r32;
    const v4u b0 = *reinterpret_cast<const v4u*>(Vs + V8SW(d, 2 * hi)), b1 = *reinterpret_cast<const v4u*>(Vs + V8SW(d, 2 * hi + 1));
    const v8i B = (v8i){(int)b0.x, (int)b0.y, (int)b0.z, (int)b0.w, (int)b1.x, (int)b1.y, (int)b1.z, (int)b1.w};
    o[d0] = __builtin_amdgcn_mfma_scale_f32_32x32x64_f8f6f4(pa, B, o[d0], 0, 0, 0, 0x7F7F7F7F, 0, 0x7F7F7F7F); }
}
__device__ __forceinline__ v8i lds32(const char* p0, const char* p1) { const v4u a = *reinterpret_cast<const v4u*>(p0), b = *reinterpret_cast<const v4u*>(p1);
  return (v8i){(int)a.x, (int)a.y, (int)a.z, (int)a.w, (int)b.x, (int)b.y, (int)b.z, (int)b.w}; }
#define MF8(A, B, C, SB) ((XV == 3 || XV == 4 || XV == 5 || XV == 9) ? (C) : __builtin_amdgcn_mfma_scale_f32_32x32x64_f8f6f4(A, B, C, 0, 0, 0, 0x7F7F7F7F, 0, SB))
#define EX4(P, m) exp4<XV>(P[4 * (m)], P[4 * (m) + 1], P[4 * (m) + 2], P[4 * (m) + 3])
template <int XV = 0>
__device__ __forceinline__ void tile_step(f32x16& pN0, f32x16& pN1, const f32x16& pP1, const v4i& ploP, v4i& ploN, f32x16* o, f32x16& lacc,
                                          const char* Ks, const char* Vs, const v8i* q8, int r32, int hi, const f32x16& Z) {
  const int one = 0x38383838; const v8i ONES = (v8i){one, one, one, one, one, one, one, one};
  v4i phi;
  const v8i A00 = lds32(Ks + K8SW(r32, 2 * hi), Ks + K8SW(r32, 2 * hi + 1)), A10 = lds32(Ks + K8SW(32 + r32, 2 * hi), Ks + K8SW(32 + r32, 2 * hi + 1));
  const v8i A01 = lds32(Ks + K8SW(r32, 4 + 2 * hi), Ks + K8SW(r32, 4 + 2 * hi + 1)), A11 = lds32(Ks + K8SW(32 + r32, 4 + 2 * hi), Ks + K8SW(32 + r32, 4 + 2 * hi + 1));
  phi[0] = EXC4(pP1, 0, 0); SBAR();
  pN0 = MF8(A00, q8[0], Z, 0x7C7C7C7C);   SBAR(); const v8i V0 = lds32(Vs + V8SW(r32, 2 * hi), Vs + V8SW(r32, 2 * hi + 1));           phi[1] = EXC4(pP1, 1, 0); SBAR();
  pN0 = MF8(A01, q8[1], pN0, 0x7C7C7C7C); SBAR(); const v8i V1 = lds32(Vs + V8SW(32 + r32, 2 * hi), Vs + V8SW(32 + r32, 2 * hi + 1)); phi[2] = EXC4(pP1, 2, 0); SBAR();
  pN1 = MF8(A10, q8[0], Z, 0x7C7C7C7C);   SBAR(); const v8i V2 = lds32(Vs + V8SW(64 + r32, 2 * hi), Vs + V8SW(64 + r32, 2 * hi + 1)); phi[3] = EXC4(pP1, 3, 0); SBAR();
  pN1 = MF8(A11, q8[1], pN1, 0x7C7C7C7C); SBAR(); const v8i V3 = lds32(Vs + V8SW(96 + r32, 2 * hi), Vs + V8SW(96 + r32, 2 * hi + 1)); SBAR();
  const v8i pa = (v8i){ploP[0], ploP[1], ploP[2], ploP[3], phi[0], phi[1], phi[2], phi[3]};
  lacc = MF8(pa, ONES, lacc, 0x7F7F7F7F); SBAR(); ploN[0] = EXC4(pN0, 0, 1); SBAR();
  o[0] = MF8(pa, V0, o[0], 0x7F7F7F7F);   SBAR(); ploN[1] = EXC4(pN0, 1, 0); SBAR();
  o[1] = MF8(pa, V1, o[1], 0x7F7F7F7F);   SBAR(); ploN[2] = EXC4(pN0, 2, 0); SBAR();
  o[2] = MF8(pa, V2, o[2], 0x7F7F7F7F);   SBAR(); ploN[3] = EXC4(pN0, 3, 0); SBAR();
  o[3] = MF8(pa, V3, o[3], 0x7F7F7F7F);   SBAR();
}
template <int XV = 0>
__device__ __forceinline__ void attn_dense_body(const unsigned char* __restrict__ Q8, const unsigned char* __restrict__ K8, const unsigned char* __restrict__ VT, int vt_ld, bf16* __restrict__ Ob, int seq, char* lds, int wave_id, float nb) {
  const int tid = opaque_tid(wave_id), wid = tid >> 6, lane = tid & 63, r32 = lane & 31, hi = lane >> 5;
  char* V_lds = lds; char* K_lds = lds + 4 * SHM_V;
  f32x16 lacc = {}; f32x16 o[4] = {}; v8i qr[2]; f32x16 NBV;
#pragma unroll
  for (int i = 0; i < 16; ++i) NBV[i] = nb;
  { const unsigned char* Qw = Q8 + (long)(wid * QBLK + r32) * 1024 + hi * 32;
#pragma unroll
    for (int s2 = 0; s2 < 2; ++s2) { const v4u a = *reinterpret_cast<const v4u*>(Qw + 64 * s2), b = *reinterpret_cast<const v4u*>(Qw + 64 * s2 + 16);
      qr[s2] = (v8i){(int)a.x, (int)a.y, (int)a.z, (int)a.w, (int)b.x, (int)b.y, (int)b.z, (int)b.w}; } }
  struct { v4u vs, ks; } sr_[1];
  const int kkey = tid >> 3, kch = tid & 7; const unsigned koff = (unsigned)(kkey * 256 + kch * 16); const int kst = K8SW(kkey, kch);
  const int vd = tid >> 2, vc = tid & 3; const unsigned voff = (unsigned)(vd * vt_ld + vc * 16); const int vst = V8SW(vd, vc);
#define SLOAD(i, k0) do { if (XV >= 7) break; sr_[i].vs = *reinterpret_cast<const v4u*>((const char*)VT + (size_t)(k0) + voff); \
    sr_[i].ks = *reinterpret_cast<const v4u*>((const char*)K8 + (size_t)(k0) * 256 + koff); } while (0)
#define SWRITE(b, i) do { *(v4u*)(V_lds + (b) * SHM_V + vst) = sr_[i].vs; *(v4u*)(K_lds + (b) * SHM_K + kst) = sr_[i].ks; } while (0)
#define SWAIT() asm volatile("s_waitcnt vmcnt(0)" ::: "memory")
#define TBAR() asm volatile("s_waitcnt lgkmcnt(0)\n\ts_barrier" ::: "memory")
  f32x16 pA0, pA1, pB0, pB1; v8i pa; v4i plA, plB; const int NT = seq / KVBLK;
  SLOAD(0, 0); SWAIT(); SWRITE(0, 0); SLOAD(0, KVBLK); TBAR();
  qkt(pA0, pA1, K_lds, qr, r32, hi, NBV); partialSM(pA0, nb, plA);
  SWAIT(); SWRITE(1, 0); SLOAD(0, 2 * KVBLK); TBAR();
#define STEP_IO(t, SW) do { SWAIT(); SWRITE(SW, 0); { const int tn = (t) + 2 < NT ? (t) + 2 : NT - 1; SLOAD(0, tn * KVBLK); } SBAR(); } while (0)
#define STEP_B(t, SK, SV, SW) do { STEP_IO(t, SW); tile_step<XV>(pB0, pB1, pA1, plA, plB, o, lacc, K_lds + (SK) * SHM_K, V_lds + (SV) * SHM_V, qr, r32, hi, NBV); TBAR(); } while (0)
#define STEP_A(t, SK, SV, SW) do { STEP_IO(t, SW); tile_step<XV>(pA0, pA1, pB1, plB, plA, o, lacc, K_lds + (SK) * SHM_K, V_lds + (SV) * SHM_V, qr, r32, hi, NBV); TBAR(); } while (0)
  int j = 1;
  for (; j + 5 < NT; j += 4) { STEP_B(j, 1, 0, 2); STEP_A(j + 1, 2, 1, 3); STEP_B(j + 2, 3, 2, 0); STEP_A(j + 3, 0, 3, 1); }
  STEP_B(j, 1, 0, 2); STEP_A(j + 1, 2, 1, 3);
  SBAR(); qkt(pB0, pB1, K_lds + 3 * SHM_K, qr, r32, hi, NBV);
  finishSM(pA1, nb, plA, pa); SBAR();
  pv_d0(o, lacc, V_lds + 2 * SHM_V, pa, r32, hi); partialSM(pB0, nb, plB);
  finishSM(pB1, nb, plB, pa); SBAR();
  pv_d0(o, lacc, V_lds + 3 * SHM_V, pa, r32, hi);
  { const int ln2 = opaque_tid(wave_id) & 63, r32e = ln2 & 31, hie = ln2 >> 5;
    bf16* Ow = Ob + (long)(wid * QBLK) * LDO;
#pragma unroll
    for (int r = 0; r < 16; ++r) { const int orow = crow(r, hie); const float rl = __builtin_amdgcn_rcpf(lacc[r]);
      for (int d0 = 0; d0 < 4; ++d0) Ow[(long)orow * LDO + d0 * 32 + r32e] = (bf16)f2bf(o[d0][r] * rl); } }
  __syncthreads();
#undef SLOAD
#undef TBAR
#undef STEP_IO
#undef STEP_A
#undef STEP_B
#undef SWRITE
#undef SWAIT
}
#undef K8SW
#undef V8SW
}
constexpr int NWAVES = 8, NTHREADS = 512;
struct Args { const float* in[36]; float* out; unsigned char* ws; int ph_lo, ph_hi; };
enum InIdx { I_X = 0, I_C, I_CTX, I_CCTX, I_ADAW, I_ADAB, I_N1G, I_N2G, I_WOUT, I_RW, I_RB, I_EW1, I_EB1, I_EW2, I_EB2, I_AWIN, I_AQG, I_AKG,
             I_GWIN, I_GVG, I_GWS, I_GBS, I_HWIN, I_HCW, I_HCB, I_FW1, I_FB1, I_FW2, I_FB2, I_FW3, I_FB3, I_FW4, I_FB4, I_FREQ, I_HD, I_FG };
struct Frame {
    LAS unsigned char* lds; volatile LAS unsigned* MISC; gu32* ctl;
    int tid, lane, wave, G, bx;
    float* out; unsigned char* ws;
};
template <class T> __device__ __forceinline__ T* launder(T* p) { unsigned long long v = (unsigned long long)p; asm volatile("" : "+s"(v)); return (T*)(GAS T*)v; }
constexpr int MW_PTRS = 640;
__device__ __forceinline__ const float* pin_load(const Frame& F, int i) {
    const unsigned lo = __builtin_amdgcn_readfirstlane(F.MISC[MW_PTRS + 2 * i]), hi = __builtin_amdgcn_readfirstlane(F.MISC[MW_PTRS + 2 * i + 1]);
    return (const float*)(GAS const float*)(((unsigned long long)hi << 32) | lo);
}
#define PIN(F, i) pin_load(F, i)
__device__ __forceinline__ Frame phase_frame(const Frame& F0) {
    Frame F = F0; F.tid = opaque_tid(F0.wave); F.lane = F.tid & 63; F.wave = F0.wave;
    F.ws = launder(F0.ws); F.out = launder(F0.out); F.ctl = (gu32*)(F.ws + WS_CTL);
    { LAS unsigned char* l = F0.lds; asm volatile("" : "+s"(l)); F.lds = l; F.MISC = (volatile LAS unsigned*)(l + MISC_OFF); }
    return F;
}
constexpr int PH_PRO0 = 0, PH_PRO1 = 1, PH_L0 = 2, PH_PER_LAYER = 9, PH_FINAL = PH_L0 + NLAYER * PH_PER_LAYER, PH_COUNT = PH_FINAL + 1;
enum LPhase { LP_NORM1 = 0, LP_INPROJ, LP_MIX1, LP_MIX2, LP_MIX3, LP_OUTPROJ, LP_NORM2, LP_MOE1, LP_MOE2 };

struct TItem { const float* src; unsigned char* dst; int N; bool fp8; };
__device__ __forceinline__ TItem titem_decode(Frame& F, int it) {
    constexpr int R0 = 128 * 512, R1 = 128 * 256, R2 = 2 * 384, R3 = 512, R4 = 768;
    int r = it; TItem t;
    if (r < R0) { const int mi = r >> 9, q = r & 511, kb = q >> 5, nb = q & 31, n0 = nb * 64;
        const int d0 = n0 < 1024 ? 256 * (n0 >> 7) + (n0 & 127) : 256 * ((n0 - 1024) >> 7) + 128 + (n0 & 127);
        t.src = PIN(F, I_EW1) + (size_t)mi * 1024 * 2048 + (size_t)(kb * 64) * 2048 + n0; t.N = 2048; t.fp8 = true; t.dst = F.ws + WS_WE1 + (size_t)mi * 2048 * 1024 + (size_t)d0 * 1024 + kb * 64; return t; } r -= R0;
    if (r < R1) { const int mi = r >> 8, q = r & 255, kb = q >> 4, nb = q & 15;
        t.src = PIN(F, I_EW2) + (size_t)mi * 1024 * 1024 + (size_t)(kb * 64) * 1024 + nb * 64; t.N = 1024; t.fp8 = true; t.dst = F.ws + WS_WE2 + (size_t)mi * 1024 * 1024 + (size_t)(nb * 64) * 1024 + kb * 64; return t; } r -= R1;
    if (r < R2) { const int mi = r / 384, q = r % 384, kb = q / 24, nb = q % 24;
        t.src = PIN(F, I_AWIN) + (size_t)mi * 1024 * 1536 + (size_t)(kb * 64) * 1536 + nb * 64; t.N = 1536; t.fp8 = true; t.dst = F.ws + WS_WATT + (size_t)mi * 1536 * 1024 + (size_t)(nb * 64) * 1024 + kb * 64; return t; } r -= R2;
    if (r < R3) { const int kb = r >> 5, nb = r & 31;
        t.src = PIN(F, I_GWIN) + (size_t)(kb * 64) * 2048 + nb * 64; t.N = 2048; t.fp8 = false; t.dst = F.ws + WS_WGM + ((size_t)(nb * 64) * 1024 + kb * 64) * 2; return t; } r -= R3;
    if (r < R4) { const int kb = r / 48, nb = r % 48;
        t.src = PIN(F, I_HWIN) + (size_t)(kb * 64) * 3072 + nb * 64; t.N = 3072; t.fp8 = true; t.dst = F.ws + WS_WHY + (size_t)(nb * 64) * 1024 + kb * 64; return t; } r -= R4;
    { const int mi = r >> 8, q = r & 255, kb = q >> 4, nb = q & 15;
        t.src = PIN(F, I_WOUT) + (size_t)mi * 1024 * 1024 + (size_t)(kb * 64) * 1024 + nb * 64; t.N = 1024; t.fp8 = false; t.dst = F.ws + WS_WOUT + ((size_t)mi * 1024 * 1024 + (size_t)(nb * 64) * 1024 + kb * 64) * 2; return t; }
}
__device__ __forceinline__ void titem_load(const TItem& t, float (&v)[64], int lane) {
    const float* src = t.src + lane;
#pragma unroll
    for (int kk = 0; kk < 64; ++kk) v[kk] = src[(size_t)kk * t.N];
}
__device__ __forceinline__ void titem_finish(const TItem& t, const float (&v)[64], LAS float* scr, int lane) {
    constexpr int K = 1024;
#pragma unroll
    for (int kk = 0; kk < 64; ++kk) scr[kk * 65 + lane] = v[kk];
    LDS_WAIT(); asm volatile("" ::: "memory");
    if (!t.fp8) {
        const int c = lane & 7;
#pragma unroll
        for (int j = 0; j < 8; ++j) { const int n = (lane >> 3) + 8 * j; const LAS float* s = scr + (8 * c) * 65 + n;
            v4u o; o.x = pk2(s[0 * 65], s[1 * 65]); o.y = pk2(s[2 * 65], s[3 * 65]); o.z = pk2(s[4 * 65], s[5 * 65]); o.w = pk2(s[6 * 65], s[7 * 65]);
            *(GAS v4u*)(t.dst + ((size_t)n * K + 8 * c) * 2) = o; }
    } else {
        const int c = lane & 3;
#pragma unroll
        for (int j = 0; j < 4; ++j) { const int n = (lane >> 2) + 16 * j; const LAS float* s = scr + (16 * c) * 65 + n; unsigned w[4];
#pragma unroll
            for (int q = 0; q < 4; ++q) { unsigned x = 0; x = __builtin_amdgcn_cvt_pk_fp8_f32(32.0f * s[(4 * q) * 65], 32.0f * s[(4 * q + 1) * 65], x, false);
                x = __builtin_amdgcn_cvt_pk_fp8_f32(32.0f * s[(4 * q + 2) * 65], 32.0f * s[(4 * q + 3) * 65], x, true); w[q] = x; }
            *(GAS v4u*)(t.dst + (size_t)n * K + 16 * c) = (v4u){w[0], w[1], w[2], w[3]}; }
    }
    LDS_WAIT(); asm volatile("" ::: "memory");
}
__device__ __forceinline__ void pro0_transposes(Frame& F) {
    LAS float* scr = (LAS float*)(F.lds + F.wave * 16640);
    const int gw = F.bx * NWAVES + F.wave, NGW = F.G * NWAVES;
    constexpr int NITEMS = 128 * 512 + 128 * 256 + 2 * 384 + 512 + 768 + 4 * 256;
    float va[64], vb[64];
    int it = gw; if (it >= NITEMS) return;
    TItem ta = titem_decode(F, it), tb = ta; titem_load(ta, va, F.lane);
    for (;;) {
        const bool nb_ok = it + NGW < NITEMS; if (nb_ok) { tb = titem_decode(F, it + NGW); titem_load(tb, vb, F.lane); }
        titem_finish(ta, va, scr, F.lane);
        if (!nb_ok) break; it += NGW;
        const bool na_ok = it + NGW < NITEMS; if (na_ok) { ta = titem_decode(F, it + NGW); titem_load(ta, va, F.lane); }
        titem_finish(tb, vb, scr, F.lane);
        if (!na_ok) break; it += NGW;
    }
}
__device__ __forceinline__ void pro0_mod(Frame& F) {
    LAS float* sl = (LAS float*)F.lds;
    LAS float* red = (LAS float*)(F.lds + 65536);
    __syncthreads();
    for (int i = F.tid; i < 9 * 1024; i += NTHREADS) { const int r = i >> 10, k = i & 1023; const float v = r < 8 ? PIN(F, I_C)[r * 1024 + k] : PIN(F, I_CCTX)[k]; sl[i] = v / (1.0f + __expf(-v)); }
    __syncthreads();
    float* MOD = (float*)(F.ws + WS_MOD);
    for (int item = F.bx; item < NLAYER * 96; item += F.G) {
        const int l = item / 96, n0 = (item % 96) * 64;
        const float* W = PIN(F, I_ADAW) + (size_t)l * 1024 * 6144 + n0 + F.lane;
        float acc[9];
#pragma unroll
        for (int r = 0; r < 9; ++r) acc[r] = 0.f;
        const int kb = F.wave * 128;
#pragma unroll 16
        for (int k = 0; k < 128; ++k) { const float wv = W[(size_t)(kb + k) * 6144];
#pragma unroll
            for (int r = 0; r < 9; ++r) acc[r] += sl[r * 1024 + kb + k] * wv; }
#pragma unroll
        for (int r = 0; r < 9; ++r) red[(F.wave * 9 + r) * 64 + F.lane] = acc[r];
        __syncthreads();
        for (int i = F.tid; i < 9 * 64; i += NTHREADS) { const int r = i >> 6, n = i & 63; float s = 0.f;
#pragma unroll
            for (int w = 0; w < 8; ++w) s += red[(w * 9 + r) * 64 + n];
            MOD[((size_t)l * 9 + r) * 6144 + n0 + n] = s + PIN(F, I_ADAB)[l * 6144 + n0 + n]; }
        __syncthreads();
    }
}
__device__ __forceinline__ void pro0_filter_mlp(Frame& F) {
    const int j = F.lane, gw = F.bx * NWAVES + F.wave, NGW = F.G * NWAVES;
    LAS float* W1 = (LAS float*)F.lds; LAS float* W2 = W1 + FEMB * FH; LAS float* W3 = W2 + FH * FH;
    __syncthreads();
    for (int i = F.tid; i < FEMB * FH; i += NTHREADS) W1[i] = PIN(F, I_FW1)[i];
    for (int i = F.tid; i < FH * FH; i += NTHREADS) { W2[i] = PIN(F, I_FW2)[i]; W3[i] = PIN(F, I_FW3)[i]; }
    __syncthreads();
    const float b1 = PIN(F, I_FB1)[j], b2 = PIN(F, I_FB2)[j], b3 = PIN(F, I_FB3)[j], fr = PIN(F, I_FREQ)[j];
    for (int it = gw; it < SEQ + CL; it += NGW) {
        const bool lat = it < SEQ; const int t = lat ? it : it - SEQ; const float L = lat ? (float)SEQ : (float)CL;
        const float tl = (float)t / (L - 1.0f), w = (6.283185307179586f * (float)t) / L;
        float z;
        { const int band = (j - 1) & 15; const float f = 1e-4f + (float)band * ((15.0f - 1e-4f) / 15.0f); const float a = f * w;
          z = (j == 0) ? tl : (j <= 16 ? cosf(a) : -sinf(a)); }
        float s = b1;
#pragma unroll
        for (int i = 0; i < FEMB; ++i) s += __shfl(z, i) * W1[i * FH + j];
        const float a1 = sinf(fr * s);
        s = b2;
#pragma unroll 16
        for (int i = 0; i < FH; ++i) s += __shfl(a1, i) * W2[i * FH + j];
        const float a2 = sinf(fr * s);
        s = b3;
#pragma unroll 16
        for (int i = 0; i < FH; ++i) s += __shfl(a2, i) * W3[i * FH + j];
        const float a3 = sinf(fr * s);
        float* dst = lat ? (float*)(F.ws + WS_A3) + (size_t)t * FH : (float*)(F.ws + WS_A3C) + (size_t)t * FH;
        dst[j] = a3;
    }
    __syncthreads();
}

__device__ __forceinline__ f32x2 cmul(f32x2 a, f32x2 b) { return (f32x2){a.x * b.x - a.y * b.y, a.x * b.y + a.y * b.x}; }
__device__ __forceinline__ f32x2 cconj(f32x2 a) { return (f32x2){a.x, -a.y}; }
#define ZP(n) ((n) + ((n) >> 5))
constexpr int FFT_LDS_BYTES = (NFFT + NFFT / 32) * 8;
__device__ __forceinline__ void bfly_dif(f32x2& a0, f32x2& a1, f32x2& a2, f32x2& a3, f32x2 w) {
    const f32x2 t0 = a0 + a2, t1 = a0 - a2, t2 = a1 + a3, d = a1 - a3, t3 = (f32x2){d.y, -d.x};
    const f32x2 y0 = t0 + t2, y2 = t0 - t2, y1 = t1 + t3, y3 = t1 - t3, w2 = cmul(w, w), w3 = cmul(w2, w);
    a0 = y0; a1 = cmul(y2, w2); a2 = cmul(y1, w); a3 = cmul(y3, w3);
}
__device__ __forceinline__ void bfly_dit(f32x2& a0, f32x2& a1, f32x2& a2, f32x2& a3, f32x2 w) {
    const f32x2 w2 = cmul(w, w), w3 = cmul(w2, w), A1 = cmul(a1, w2), A2 = cmul(a2, w), A3 = cmul(a3, w3);
    const f32x2 u0 = a0 + A1, u1 = a0 - A1, u2 = A2 + A3, u3 = A2 - A3, iu3 = (f32x2){-u3.y, u3.x};
    a0 = u0 + u2; a1 = u1 + iu3; a2 = u0 - u2; a3 = u1 - iu3;
}
template <int LQ, bool INV> __device__ __forceinline__ void fft_r16(LAS f32x2* z, int tid) {
    constexpr int q16 = 1 << LQ; constexpr float inv_lb = 1.0f / (float)(16 * q16);
    constexpr float C1 = 0.92387953251128674f, S1 = 0.38268343236508977f, C2 = 0.70710678118654752f;
    asm volatile("" : "+v"(tid));
#pragma unroll 1
    for (int g = tid; g < NFFT / 16; g += NTHREADS) {
        const int j = g & (q16 - 1), base = ((g >> LQ) << (LQ + 4)) + j;
        f32x2 x[16];
#pragma unroll
        for (int m = 0; m < 16; ++m) x[m] = z[ZP(base + (m << LQ))];
        const float fr = (float)j * inv_lb; const float sn = __builtin_amdgcn_sinf(fr);
        const f32x2 w1 = (f32x2){__builtin_amdgcn_cosf(fr), INV ? sn : -sn};
        const float sg = INV ? 1.0f : -1.0f;
        const f32x2 wa0 = w1, wa1 = cmul(w1, (f32x2){C1, sg * S1}), wa2 = cmul(w1, (f32x2){C2, sg * C2}), wa3 = cmul(w1, (f32x2){S1, sg * C1});
        const f32x2 w2 = cmul(w1, w1), wb = cmul(w2, w2);
        if constexpr (!INV) {
            bfly_dif(x[0], x[4], x[8], x[12], wa0); bfly_dif(x[1], x[5], x[9], x[13], wa1); bfly_dif(x[2], x[6], x[10], x[14], wa2); bfly_dif(x[3], x[7], x[11], x[15], wa3);
#pragma unroll
            for (int a = 0; a < 4; ++a) bfly_dif(x[4 * a], x[4 * a + 1], x[4 * a + 2], x[4 * a + 3], wb);
        } else {
#pragma unroll
            for (int a = 0; a < 4; ++a) bfly_dit(x[4 * a], x[4 * a + 1], x[4 * a + 2], x[4 * a + 3], wb);
            bfly_dit(x[0], x[4], x[8], x[12], wa0); bfly_dit(x[1], x[5], x[9], x[13], wa1); bfly_dit(x[2], x[6], x[10], x[14], wa2); bfly_dit(x[3], x[7], x[11], x[15], wa3);
        }
#pragma unroll
        for (int m = 0; m < 16; ++m) z[ZP(base + (m << LQ))] = x[m];
    }
    __syncthreads();
}
template <bool INV> __device__ __forceinline__ void fft_r4_unit(LAS f32x2* z, int tid) {
    asm volatile("" : "+v"(tid));
#pragma unroll 2
    for (int bf = tid; bf < NFFT / 4; bf += NTHREADS) {
        const int base = 4 * bf; f32x2 a0 = z[ZP(base)], a1 = z[ZP(base + 1)], a2 = z[ZP(base + 2)], a3 = z[ZP(base + 3)];
        if constexpr (!INV) { const f32x2 t0 = a0 + a2, t1 = a0 - a2, t2 = a1 + a3, d = a1 - a3, t3 = (f32x2){d.y, -d.x};
            z[ZP(base)] = t0 + t2; z[ZP(base + 1)] = t0 - t2; z[ZP(base + 2)] = t1 + t3; z[ZP(base + 3)] = t1 - t3; }
        else { const f32x2 u0 = a0 + a1, u1 = a0 - a1, u2 = a2 + a3, u3 = a2 - a3, iu3 = (f32x2){-u3.y, u3.x};
            z[ZP(base)] = u0 + u2; z[ZP(base + 1)] = u1 + iu3; z[ZP(base + 2)] = u0 - u2; z[ZP(base + 3)] = u1 - iu3; }
    }
    __syncthreads();
}
__device__ __forceinline__ void fft16k_dif(LAS f32x2* z, int tid) { fft_r16<10, false>(z, tid); fft_r16<6, false>(z, tid); fft_r16<2, false>(z, tid); fft_r4_unit<false>(z, tid); }
__device__ __forceinline__ void fft16k_dit_inv(LAS f32x2* z, int tid) { fft_r4_unit<true>(z, tid); fft_r16<2, true>(z, tid); fft_r16<6, true>(z, tid); fft_r16<10, true>(z, tid); }
constexpr int KF_LD = 8256;
__device__ __forceinline__ int rev14(int p) { return (int)(__brev((unsigned)p) >> 18); }
__device__ __forceinline__ float hy_delta(int c) { const float mn = -3.0701134573253945f, mx = -15.350567286626973f; return fabsf(mn + (mx - mn) * ((float)c / 1023.0f)); }

__device__ __forceinline__ void pro1_router_split(Frame& F) {
    const float* MOD = (const float*)(F.ws + WS_MOD); unsigned char* RW3 = F.ws + WS_RW3;
    for (int ent = F.bx * NTHREADS + F.tid; ent < NLAYER * 9 * 8 * 8 * 64; ent += F.G * NTHREADS) {
        const int lane = ent & 63, kb = (ent >> 6) & 7, w = (ent >> 9) & 7, lb = ent >> 12, l = lb / 9;
        const int k0 = w * 128 + 16 * kb + 8 * (lane >> 5), e = lane & 31;
        const float* gn = PIN(F, I_N2G) + l * D; const float* sc = MOD + (size_t)lb * 6144 + 4 * 1024; const float* rw = PIN(F, I_RW) + (size_t)l * D * NE;
        unsigned ph[4], pm[4], pl[4];
#pragma unroll
        for (int j2 = 0; j2 < 4; ++j2) { const int k = k0 + 2 * j2; const float v0 = gn[k] * (1.0f + sc[k]) * rw[(size_t)k * NE + e], v1 = gn[k + 1] * (1.0f + sc[k + 1]) * rw[(size_t)(k + 1) * NE + e];
            const unsigned h = cvt_pk_bf16(v0, v1); const float r0 = v0 - __uint_as_float(h << 16), r1 = v1 - __uint_as_float(h & 0xffff0000u);
            const unsigned m = cvt_pk_bf16(r0, r1); const float s0 = r0 - __uint_as_float(m << 16), s1 = r1 - __uint_as_float(m & 0xffff0000u);
            ph[j2] = h; pm[j2] = m; pl[j2] = cvt_pk_bf16(s0, s1); }
        v4u* dst = (v4u*)(RW3 + (size_t)(ent >> 6) * 3 * 1024) + lane;
        dst[0] = (v4u){ph[0], ph[1], ph[2], ph[3]}; dst[64] = (v4u){pm[0], pm[1], pm[2], pm[3]}; dst[128] = (v4u){pl[0], pl[1], pl[2], pl[3]};
    }
}
__device__ __forceinline__ void pro1_filters(Frame& F) {
    if (F.bx < NLAYER * 9) {
        const int lb = F.bx, l = lb / 9, e = F.lane & 31, hf = F.lane >> 5; const float* sh = (const float*)(F.ws + WS_MOD) + (size_t)lb * 6144 + 3 * 1024; const float* rw = PIN(F, I_RW) + (size_t)l * D * NE;
        LAS float* red = (LAS float*)F.lds; const int k0 = F.wave * 128 + hf * 64; float acc = 0.f;
#pragma unroll 8
        for (int k = k0; k < k0 + 64; ++k) acc += sh[k] * rw[(size_t)k * NE + e];
        acc += shx(acc, 32, F.lane); if (F.lane < 32) red[F.wave * 32 + e] = acc;
        __syncthreads();
        if (F.tid < 32) { float s = PIN(F, I_RB)[l * NE + F.tid];
#pragma unroll
            for (int w = 0; w < 8; ++w) s += red[w * 32 + F.tid];
            ((float*)(F.ws + WS_RC))[lb * NE + F.tid] = s; }
    }
    LAS f32x2* z = (LAS f32x2*)F.lds;
    LAS float* wl = (LAS float*)(F.lds + AUX_OFF + 8192);
    const float* a3 = (const float*)(F.ws + WS_A3); const float* a3c = (const float*)(F.ws + WS_A3C);
    f32x2* KF = (f32x2*)(F.ws + WS_KF); float* FCT = (float*)(F.ws + WS_FCT);
    for (int u = F.bx; u < 512; u += F.G) {
        const int ca = 2 * u, cb = 2 * u + 1;
        __syncthreads();
        if (F.tid < 256) { const int which = F.tid >> 6, m = F.tid & 63; const int col = (which & 1 ? cb : ca) + (which >> 1) * 1024; wl[which * 64 + m] = PIN(F, I_FW4)[m * 2048 + col]; }
        if (F.tid < 4) { const int col = (F.tid & 1 ? cb : ca) + (F.tid >> 1) * 1024; wl[256 + F.tid] = PIN(F, I_FB4)[col]; }
        __syncthreads();
        const float da = hy_delta(ca), db = hy_delta(cb);
        const float dska = PIN(F, I_HD)[ca], dskb = PIN(F, I_HD)[cb];
        for (int t = F.tid; t < SEQ; t += NTHREADS) {
            const f32x4* ar = (const f32x4*)(a3 + (size_t)t * FH); float s0 = wl[256], s1 = wl[257], s2 = wl[258], s3 = wl[259];
#pragma unroll 8
            for (int m4 = 0; m4 < 16; ++m4) { const f32x4 a = ar[m4];
#pragma unroll
                for (int i = 0; i < 4; ++i) { const int m = m4 * 4 + i; s0 += a[i] * wl[m]; s1 += a[i] * wl[64 + m]; s2 += a[i] * wl[128 + m]; s3 += a[i] * wl[192 + m]; } }
            const float tl = (float)t / (float)(SEQ - 1); const float wa = __expf(-tl * da), wb = __expf(-tl * db);
            z[ZP(t)] = (f32x2){s0 * wa + (t == 0 ? dska : 0.f), s1 * wb + (t == 0 ? dskb : 0.f)};
            if (t == 0) z[ZP(SEQ)] = (f32x2){0.f, 0.f}; else z[ZP(NFFT - t)] = (f32x2){s2 * wa, s3 * wb};
        }
        for (int i = F.tid; i < 511; i += NTHREADS) {
            const int d = i - 255, t = d < 0 ? -d : d; const int o = d < 0 ? 2 : 0;
            const f32x4* ar = (const f32x4*)(a3c + (size_t)t * FH); float sa = wl[256 + o], sb = wl[257 + o];
            f32x4 av[16];
#pragma unroll
            for (int m4 = 0; m4 < 16; ++m4) av[m4] = ar[m4];
            __builtin_amdgcn_sched_barrier(0);
#pragma unroll
            for (int m4 = 0; m4 < 16; ++m4) {
#pragma unroll
                for (int i2 = 0; i2 < 4; ++i2) { const int m = m4 * 4 + i2; sa += av[m4][i2] * wl[o * 64 + m]; sb += av[m4][i2] * wl[(o + 1) * 64 + m]; }
                if ((m4 & 3) == 3) __builtin_amdgcn_sched_barrier(0); }
            const float tl = (float)t / (float)(CL - 1);
            FCT[(size_t)ca * 512 + d + 256] = sa * __expf(-tl * da) + (d == 0 ? dska : 0.f); FCT[(size_t)cb * 512 + d + 256] = sb * __expf(-tl * db) + (d == 0 ? dskb : 0.f);
        }
        __syncthreads();
        fft16k_dif(z, F.tid);
        for (int k = F.tid; k <= NFFT / 2; k += NTHREADS) {
            const int p = rev14(k), p2 = rev14((NFFT - k) & (NFFT - 1)); const f32x2 a = z[ZP(p)], b = z[ZP(p2)];
            KF[(size_t)ca * KF_LD + k] = (f32x2){0.5f * (a.x + b.x), 0.5f * (a.y - b.y)};
            KF[(size_t)cb * KF_LD + k] = (f32x2){0.5f * (a.y + b.y), -0.5f * (a.x - b.x)};
        }
    }
    __syncthreads();
}

__device__ __forceinline__ void hyena_conv_phase(Frame& F) {
    LAS f32x2* z = (LAS f32x2*)F.lds;
    LAS float* aux = (LAS float*)(F.lds + AUX_OFF + 8192);
    const float* VT = (const float*)(F.ws + WS_VT); const float* VTC = (const float*)(F.ws + WS_VTC); float* CT = (float*)(F.ws + WS_CT); float* CTC = (float*)(F.ws + WS_CTC);
    const f32x2* KF = (const f32x2*)(F.ws + WS_KF); const float* FCT = (const float*)(F.ws + WS_FCT);
    v4u ina[2], inb[2];
#define HC_LOADIN(u_, t_) do { const int b_ = (u_) >> 9, c_ = 2 * ((u_) & 511); const v4u* va_ = (const v4u*)((const bf16*)VT + ((size_t)b_ * 1024 + c_) * SEQ + 16 * (t_)); \
        ina[0] = va_[0]; ina[1] = va_[1]; inb[0] = va_[SEQ / 8]; inb[1] = va_[SEQ / 8 + 1]; } while (0)
    if (F.bx < NB * 512) HC_LOADIN(F.bx, F.tid);
    for (int u = F.bx; u < NB * 512; u += F.G) {
        const int b = u >> 9, cp = u & 511, ca = 2 * cp, cb = ca + 1;
        int tq = F.tid; asm volatile("" : "+v"(tq));
        __syncthreads();
        { const int n0 = 16 * tq;
#pragma unroll
          for (int i = 0; i < 4; ++i) { const unsigned a0 = ina[i >> 1][2 * (i & 1)], a1 = ina[i >> 1][2 * (i & 1) + 1], b0 = inb[i >> 1][2 * (i & 1)], b1 = inb[i >> 1][2 * (i & 1) + 1];
              z[ZP(n0 + 4 * i)] = (f32x2){bflo(a0), bflo(b0)}; z[ZP(n0 + 4 * i + 1)] = (f32x2){bfhi(a0), bfhi(b0)}; z[ZP(n0 + 4 * i + 2)] = (f32x2){bflo(a1), bflo(b1)}; z[ZP(n0 + 4 * i + 3)] = (f32x2){bfhi(a1), bfhi(b1)};
#pragma unroll
              for (int j = 0; j < 4; ++j) z[ZP(SEQ + n0 + 4 * i + j)] = (f32x2){0.f, 0.f}; } }
        f32x4 ka[8], kb[8]; f32x2 kaN, kbN;
        { const f32x4* pa = (const f32x4*)(KF + (size_t)ca * KF_LD + 16 * tq); const f32x4* pb = (const f32x4*)(KF + (size_t)cb * KF_LD + 16 * tq);
#pragma unroll
          for (int i = 0; i < 8; ++i) { ka[i] = pa[i]; kb[i] = pb[i]; }
          kaN = KF[(size_t)ca * KF_LD + NFFT / 2]; kbN = KF[(size_t)cb * KF_LD + NFFT / 2]; }
        { const int h = tq >> 8, t = tq & 255; const float* vc = VTC + ((size_t)b * 1024 + ca + h) * CL;
          aux[h * 256 + t] = vc[t]; aux[512 + h * 512 + t] = FCT[(size_t)(ca + h) * 512 + t]; aux[512 + h * 512 + 256 + t] = FCT[(size_t)(ca + h) * 512 + 256 + t];
          __syncthreads();
          float y = 0.f;
#pragma unroll 8
          for (int s = 0; s < CL; ++s) y += aux[h * 256 + s] * aux[512 + h * 512 + (t - s) + 256];
          CTC[((size_t)b * 1024 + ca + h) * CL + t] = y; }
        fft16k_dif(z, F.tid);
        int tpw = tq; asm volatile("" : "+v"(tpw));
#define HC_PW(k_, Ka_, Kb_) do { const int p = rev14(k_), p2 = rev14((NFFT - (k_)) & (NFFT - 1)); const f32x2 a = z[ZP(p)], b2 = z[ZP(p2)]; \
            const f32x2 Va = (f32x2){0.5f * (a.x + b2.x), 0.5f * (a.y - b2.y)}, Vb = (f32x2){0.5f * (a.y + b2.y), -0.5f * (a.x - b2.x)}; \
            const f32x2 ya = cmul(Va, Ka_), yb = cmul(Vb, Kb_); \
            z[ZP(p)] = (f32x2){ya.x - yb.y, ya.y + yb.x}; z[ZP(p2)] = (f32x2){ya.x + yb.y, -ya.y + yb.x}; } while (0)
#pragma unroll
        for (int i = 0; i < 8; ++i) { const int k = 16 * tpw + 2 * i;
            HC_PW(k, ((f32x2){ka[i].x, ka[i].y}), ((f32x2){kb[i].x, kb[i].y})); HC_PW(k + 1, ((f32x2){ka[i].z, ka[i].w}), ((f32x2){kb[i].z, kb[i].w}));
            asm volatile("" ::: "memory"); }
        if (tpw == 0) HC_PW(NFFT / 2, kaN, kbN);
#undef HC_PW
        __syncthreads();
        if (u + F.G < NB * 512) HC_LOADIN(u + F.G, tq);
        fft16k_dit_inv(z, F.tid);
        { int to = tq; asm volatile("" : "+v"(to)); const float sc = 1.0f / (float)NFFT; const int n0 = 16 * to;
          v4u* oa = (v4u*)((bf16*)CT + ((size_t)b * 1024 + ca) * SEQ + n0);
#pragma unroll
          for (int h2 = 0; h2 < 2; ++h2) { f32x2 w[8];
#pragma unroll
              for (int j = 0; j < 8; ++j) w[j] = z[ZP(n0 + 8 * h2 + j)];
              oa[h2] = (v4u){cvt_pk_bf16(w[0].x * sc, w[1].x * sc), cvt_pk_bf16(w[2].x * sc, w[3].x * sc), cvt_pk_bf16(w[4].x * sc, w[5].x * sc), cvt_pk_bf16(w[6].x * sc, w[7].x * sc)};
              oa[SEQ / 8 + h2] = (v4u){cvt_pk_bf16(w[0].y * sc, w[1].y * sc), cvt_pk_bf16(w[2].y * sc, w[3].y * sc), cvt_pk_bf16(w[4].y * sc, w[5].y * sc), cvt_pk_bf16(w[6].y * sc, w[7].y * sc)}; } }
    }
    __syncthreads();
#undef HC_LOADIN
}
constexpr int MW_CUMBLK = 16, MW_CNT = 64, MW_SELE = 128, MW_SELV = 256, MW_LRANK = 384, MW_LBASE = 512;
__device__ __forceinline__ void moe_tables(Frame& F, int layer) {
    __syncthreads();
    if (F.tid < NE) F.MISC[MW_CNT + F.tid] = __hip_atomic_load(F.ctl + CW_CNT + layer * NE + F.tid, RLX_AGENT);
    __syncthreads();
    if (F.tid == 0) { unsigned c = 0; for (int e = 0; e < NE; ++e) { F.MISC[MW_CUMBLK + e] = c; c += (F.MISC[MW_CNT + e] + 255u) >> 8; } F.MISC[MW_CUMBLK + NE] = c; }
    __syncthreads();
}

template <int MODE> __device__ __forceinline__ void rowpass(Frame& F, int layer, bool real = true, bool h8 = false) {
    const bool combine = (MODE == 0 && layer > 0) || MODE == 2;
    const int nrows = MODE == 2 ? ML : MT;
    const int cl = MODE == 2 ? NLAYER - 1 : layer - 1;
    const bool from_input = (MODE == 0 && layer == 0);
    const float* XLs = PIN(F, I_X); const float* XCs = PIN(F, I_CTX);
    bf16* XB = (bf16*)(F.ws + WS_XB); bf16* XBd = real ? XB : (bf16*)(F.ws + WS_P);
    const float* MOD = (const float*)(F.ws + WS_MOD);
    bf16* H = (bf16*)(F.ws + WS_H); unsigned char* H8 = (unsigned char*)(F.ws + WS_H8); const unsigned char* YM = (const unsigned char*)(F.ws + WS_YM);
    const int* TE = (const int*)(F.ws + WS_TE); const int* TR = (const int*)(F.ws + WS_TR); const float* TG = (const float*)(F.ws + WS_TG);
    const float* gnorm = MODE == 0 ? PIN(F, I_N1G) + layer * D : PIN(F, I_FG);
    if (combine) moe_tables(F, cl);
    f32x4 gn[4];
#pragma unroll
    for (int j = 0; j < 4; ++j) gn[j] = ((const f32x4*)gnorm)[F.lane + 64 * j];
    const int ntiles = nrows / 32;
    i32x4 nte[4], ntr[4]; f32x4 ntg[4];
#define RP_TABLES(tile_) do { const size_t rb_ = (size_t)((tile_) * 32 + F.wave * 4) * 4; \
        _Pragma("unroll") for (int q = 0; q < 4; ++q) { nte[q] = *(const i32x4*)(TE + rb_ + 4 * q); ntr[q] = *(const i32x4*)(TR + rb_ + 4 * q); ntg[q] = *(const f32x4*)(TG + rb_ + 4 * q); } } while (0)
    if (combine && F.bx < ntiles) RP_TABLES(F.bx);
    for (int tile = F.bx; tile < ntiles; tile += F.G) {
        const int rbase = tile * 32 + F.wave * 4; const bool lat = rbase < ML; const int bidx = lat ? (rbase >> 13) : 8;
        const float* g2 = MOD + ((size_t)(combine ? cl : 0) * 9 + bidx) * 6144 + 5 * 1024;
        const float* mb = MOD + ((size_t)layer * 9 + bidx) * 6144;
        int rid[4][4]; float gkk[4][4];
        if (combine) {
#pragma unroll
            for (int q = 0; q < 4; ++q)
#pragma unroll
                for (int k = 0; k < 4; ++k) { rid[q][k] = 256 * (int)F.MISC[MW_CUMBLK + nte[q][k]] + ntr[q][k]; gkk[q][k] = ntg[q][k]; }
            if (tile + F.G < ntiles) RP_TABLES(tile + F.G);
        }
#pragma unroll 1
        for (int pr = 0; pr < 2; ++pr) {
            size_t xo[2]; f32x4 v[2][4]; int rowid[2][4]; float gk[2][4];
#pragma unroll
            for (int u = 0; u < 2; ++u) { const int r = rbase + 2 * pr + u; xo[u] = (size_t)r * D;
                if (combine) {
#pragma unroll
                    for (int k = 0; k < 4; ++k) { rowid[u][k] = pr ? rid[2 + u][k] : rid[u][k]; gk[u][k] = pr ? gkk[2 + u][k] : gkk[u][k]; } }
                if (from_input) { const f32x4* xs = (const f32x4*)(lat ? XLs + xo[u] : XCs + (xo[u] - (size_t)ML * D));
#pragma unroll
                    for (int j = 0; j < 4; ++j) v[u][j] = xs[F.lane + 64 * j]; }
                else { const v2u* xs = (const v2u*)(XB + xo[u]);
#pragma unroll
                    for (int j = 0; j < 4; ++j) v[u][j] = bf4_f32(xs[F.lane + 64 * j]); } }
            if (combine) {
                unsigned w[2][4][4];
#pragma unroll
                for (int u = 0; u < 2; ++u)
#pragma unroll
                    for (int k = 0; k < 4; ++k) { const unsigned* yr = (const unsigned*)(YM + (size_t)rowid[u][k] * D);
#pragma unroll
                        for (int j = 0; j < 4; ++j) w[u][k][j] = yr[F.lane + 64 * j]; }
#pragma unroll
                for (int u = 0; u < 2; ++u) {
#pragma unroll
                    for (int j = 0; j < 4; ++j) { f32x4 a = (f32x4){0.f, 0.f, 0.f, 0.f};
#pragma unroll
                        for (int k = 0; k < 4; ++k) { const f32x2 lo = __builtin_amdgcn_cvt_pk_f32_fp8(w[u][k][j], false), hi2 = __builtin_amdgcn_cvt_pk_f32_fp8(w[u][k][j], true); a += gk[u][k] * (f32x4){lo.x, lo.y, hi2.x, hi2.y}; }
                        v[u][j] += ((const f32x4*)g2)[F.lane + 64 * j] * a; }
                    if (MODE == 0) { v2u* xd = (v2u*)(XBd + xo[u]);
#pragma unroll
                        for (int j = 0; j < 4; ++j) { v2u o; o.x = cvt_pk_bf16(v[u][j].x, v[u][j].y); o.y = cvt_pk_bf16(v[u][j].z, v[u][j].w); xd[F.lane + 64 * j] = o; } } }
            }
            if (from_input) {
#pragma unroll
                for (int u = 0; u < 2; ++u) { v2u* xd = (v2u*)(XBd + xo[u]);
#pragma unroll
                    for (int j = 0; j < 4; ++j) { v2u o; o.x = cvt_pk_bf16(v[u][j].x, v[u][j].y); o.y = cvt_pk_bf16(v[u][j].z, v[u][j].w); xd[F.lane + 64 * j] = o; } } }
#pragma unroll
            for (int u = 0; u < 2; ++u) { const int r = rbase + 2 * pr + u;
                float ss = 0.f;
#pragma unroll
                for (int j = 0; j < 4; ++j) ss += (v[u][j].x * v[u][j].x + v[u][j].y * v[u][j].y) + (v[u][j].z * v[u][j].z + v[u][j].w * v[u][j].w);
                const float rstd = 1.0f / sqrtf(wave_sum(ss, F.lane) * (1.0f / D) + EPS);
                if (MODE == 2) { f32x4* od = (f32x4*)((real ? F.out : (float*)(F.ws + WS_P)) + xo[u]);
#pragma unroll
                    for (int j = 0; j < 4; ++j) od[F.lane + 64 * j] = v[u][j] * rstd * gn[j]; }
                else { v2u* hd = (v2u*)(H + (size_t)r * D); unsigned* hd8 = (unsigned*)(H8 + (size_t)r * D);
#pragma unroll
                    for (int j = 0; j < 4; ++j) { const f32x4 sh = ((const f32x4*)mb)[F.lane + 64 * j], sc = ((const f32x4*)(mb + 1024))[F.lane + 64 * j]; const f32x4 hv = v[u][j] * rstd * gn[j] * (sc + 1.0f) + sh;
                        if (h8) { unsigned o = 0; o = __builtin_amdgcn_cvt_pk_fp8_f32(hv.x, hv.y, o, false); o = __builtin_amdgcn_cvt_pk_fp8_f32(hv.z, hv.w, o, true); hd8[F.lane + 64 * j] = o; }
                        else { v2u o; o.x = cvt_pk_bf16(hv.x, hv.y); o.y = cvt_pk_bf16(hv.z, hv.w); hd[F.lane + 64 * j] = o; } } }
            }
        }
    }
}

typedef float f32x16r __attribute__((ext_vector_type(16)));
__device__ __forceinline__ void router_phase(Frame& F, int layer, bool real = true, int xp = 0) {
    const bool last = layer == NLAYER - 1;
    const int ntiles = (last ? ML : MT) / 32;
    LAS float* PART = (LAS float*)F.lds;
    LAS float* SSQ = PART + 8 * 32 * 33;
    LAS float* LG = SSQ + 8 * 32;
    LAS float* RSTD = LG + 32 * 33;
    LAS unsigned* CW = (LAS unsigned*)(RSTD + 32);
    LAS unsigned* RUN = CW + 64;
    LAS float* AV = (LAS float*)(RUN + 32);
    LAS float* SHV = AV + 1024;
    LAS float* RCV = SHV + 1024;
    LAS bf16* STG = (LAS bf16*)((LAS unsigned char*)(RCV + 32) + F.wave * (32 * 272));
    const bf16* XB = (const bf16*)(F.ws + WS_XB);
    const float* MOD = (const float*)(F.ws + WS_MOD); const float* RC = (const float*)(F.ws + WS_RC);
    unsigned char* H8 = (unsigned char*)(F.ws + WS_H8);
    int* TE = (int*)(F.ws + WS_TE); int* TR = (int*)(F.ws + WS_TR); float* TG = (float*)(F.ws + WS_TG); int* ROWTOK = (int*)(F.ws + WS_ROWTOK);
    const float* gn = PIN(F, I_N2G) + layer * D; const float* rw = PIN(F, I_RW) + (size_t)layer * D * NE;
    const int i = F.lane & 31, hf = F.lane >> 5, lr = F.lane >> 4, lc = F.lane & 15, kw = F.wave * 128;
    const int per = 2048 / F.G;
    const int nmine = (2048 % F.G == 0) ? per + ((2048 + F.bx < ntiles) ? 1 : 0) : 0;
#define RT_TILE(n_) ((2048 % F.G == 0) ? ((n_) < per ? F.bx * per + (n_) : 2048 + F.bx) : F.bx + (n_) * F.G)
    const int ncnt = (2048 % F.G == 0) ? nmine : (F.bx < ntiles ? (ntiles - 1 - F.bx) / F.G + 1 : 0);
    __syncthreads();
    if (F.tid < NE) RUN[F.tid] = 0u;
    bf16x8 bw[8][2];
    v2u rawp[16];
#define RT_LOADX(tile_) do { const int rb_ = (tile_) * 32 + lr; const bf16* xb_ = XB + (size_t)rb_ * D + kw + 4 * lc; \
        _Pragma("unroll") for (int q = 0; q < 16; ++q) rawp[q] = *(const v2u*)(xb_ + (size_t)(4 * (q & 7)) * D + 64 * (q >> 3)); } while (0)
    if (ncnt > 0) RT_LOADX(RT_TILE(0));
    int cur_b = -1;
    for (int n = 0; n < ncnt; ++n) {
        const int tile = RT_TILE(n);
        const int r0 = tile * 32; const bool lat = r0 < ML; const int bidx = lat ? (r0 >> 13) : 8; const int r = r0 + i;
        if (bidx != cur_b) {
            cur_b = bidx; const float* mb = MOD + ((size_t)layer * 9 + bidx) * 6144 + 3 * 1024;
            __syncthreads();
            for (int k = F.tid; k < 1024; k += NTHREADS) { AV[k] = gn[k] * (1.0f + mb[1024 + k]); SHV[k] = mb[k]; }
            if (F.tid < NE) RCV[F.tid] = RC[((size_t)layer * 9 + bidx) * NE + F.tid];
            __syncthreads();
            { const v4u* src = (const v4u*)(F.ws + WS_RW3 + ((size_t)(layer * 9 + bidx) * 8 + F.wave) * 8 * 3 * 1024) + F.lane;
#pragma unroll
              for (int kb = 0; kb < 8; ++kb)
#pragma unroll
                  for (int t = 0; t < 2; ++t) bw[kb][t] = __builtin_bit_cast(bf16x8, src[(kb * 3 + t) * 64]); }
        }
        { float s8[8];
#pragma unroll
          for (int q = 0; q < 8; ++q) { const f32x4 a = bf4_f32(rawp[q]), b = bf4_f32(rawp[q + 8]); s8[q] = ((a.x * a.x + a.y * a.y) + (a.z * a.z + a.w * a.w)) + ((b.x * b.x + b.y * b.y) + (b.z * b.z + b.w * b.w)); }
#pragma unroll
          for (int q = 0; q < 8; ++q) { float v = s8[q]; v += shx(v, 1, F.lane); v += shx(v, 2, F.lane); v += shx(v, 4, F.lane); v += shx(v, 8, F.lane); if (lc == 0) SSQ[F.wave * 32 + 4 * q + lr] = v; } }
        __syncthreads();
        const f32x4 av0 = ((const LAS f32x4*)(AV + kw))[lc], av1 = ((const LAS f32x4*)(AV + kw))[lc + 16];
        { const f32x4 sh0 = ((const LAS f32x4*)(SHV + kw))[lc], sh1 = ((const LAS f32x4*)(SHV + kw))[lc + 16];
          unsigned char* hb = H8 + (size_t)(r0 + lr) * D + kw + 4 * lc;
#pragma unroll
          for (int q = 0; q < 8; ++q) { float qs = 0.f;
#pragma unroll
              for (int w = 0; w < 8; ++w) qs += SSQ[w * 32 + 4 * q + lr];
              const float rs = 1.0f / sqrtf(qs * (1.0f / D) + EPS);
#pragma unroll
              for (int hq = 0; hq < 2; ++hq) { const f32x4 h = bf4_f32(rawp[q + 8 * hq]) * (rs * (hq ? av1 : av0)) + (hq ? sh1 : sh0); unsigned w = 0;
                  w = __builtin_amdgcn_cvt_pk_fp8_f32(h.x, h.y, w, false); w = __builtin_amdgcn_cvt_pk_fp8_f32(h.z, h.w, w, true);
                  *(unsigned*)(hb + (size_t)(4 * q) * D + 64 * hq) = w; } } }
        f32x16r acc = {};
        asm volatile("s_waitcnt lgkmcnt(0)" ::: "memory");
#pragma unroll
        for (int q = 0; q < 16; ++q) *(LAS v2u*)(STG + (4 * (q & 7) + lr) * 136 + 4 * lc + 64 * (q >> 3)) = rawp[q];
        asm volatile("s_waitcnt lgkmcnt(0)" ::: "memory");
        if (n + 1 < ncnt) RT_LOADX(RT_TILE(n + 1));
#pragma unroll
        for (int kb = 0; kb < 8; ++kb) { const bf16x8 a = *(const LAS bf16x8*)(STG + i * 136 + 16 * kb + 8 * hf);
#pragma unroll
            for (int t = 0; t < 2; ++t) acc = __builtin_amdgcn_mfma_f32_32x32x16_bf16(a, bw[kb][t], acc, 0, 0, 0); }
#pragma unroll
        for (int rg = 0; rg < 16; ++rg) PART[(F.wave * 32 + ((rg & 3) + 8 * (rg >> 2) + 4 * hf)) * 33 + i] = acc[rg];
        __syncthreads();
        { const int tk = F.tid >> 4, e0 = (F.tid & 15) * 2; float q = 0.f, s0 = 0.f, s1 = 0.f;
#pragma unroll
          for (int w = 0; w < 8; ++w) { q += SSQ[w * 32 + tk]; s0 += PART[(w * 32 + tk) * 33 + e0]; s1 += PART[(w * 32 + tk) * 33 + e0 + 1]; }
          const float rstd = 1.0f / sqrtf(q * (1.0f / D) + EPS);
          LG[tk * 33 + e0] = rstd * s0 + RCV[e0]; LG[tk * 33 + e0 + 1] = rstd * s1 + RCV[e0 + 1]; }
        __syncthreads();
        { const int tk = F.tid >> 4, e0 = (F.tid & 15) * 2; const LAS float* lg = LG + tk * 33; const float l0 = lg[e0], l1 = lg[e0 + 1]; int rk0 = 0, rk1 = 0;
#pragma unroll 8
          for (int j = 0; j < NE; ++j) { const float o = lg[j]; rk0 += (o > l0 || (o == l0 && j < e0)) ? 1 : 0; rk1 += (o > l1 || (o == l1 && j < e0 + 1)) ? 1 : 0; }
          if (rk0 < 4) { F.MISC[MW_SELE + tk * 4 + rk0] = (unsigned)e0; F.MISC[MW_SELV + tk * 4 + rk0] = __float_as_uint(l0); }
          if (rk1 < 4) { F.MISC[MW_SELE + tk * 4 + rk1] = (unsigned)(e0 + 1); F.MISC[MW_SELV + tk * 4 + rk1] = __float_as_uint(l1); } }
        __syncthreads();
        int my = 0, lrk = 0;
        if (F.wave < 2) { const int a = F.tid; my = (int)F.MISC[MW_SELE + a];
            { const float vk = __uint_as_float(F.MISC[MW_SELV + a]), v0 = __uint_as_float(F.MISC[MW_SELV + (a & ~3)]);
              const float ex = __expf(vk - v0); float sm = ex; sm += shx(sm, 1, F.lane); sm += shx(sm, 2, F.lane);
              const size_t idx = ((size_t)r0 + (a >> 2)) * 4 + (a & 3); TG[idx] = ex / sm; TE[idx] = my; }
            unsigned cm = 0;
#pragma unroll 2
            for (int e = 0; e < NE; ++e) { const unsigned long long m = __ballot(my == e); const unsigned pc = (unsigned)__popcll(m);
                if (my == e) lrk = (int)__builtin_amdgcn_mbcnt_hi((unsigned)(m >> 32), __builtin_amdgcn_mbcnt_lo((unsigned)m, 0u)); if (F.lane == e) cm = pc; }
            if (F.lane < NE) CW[F.wave * 32 + F.lane] = cm; }
        __syncthreads();
        if (F.wave < 2) { const int a = F.tid; const int brank = (int)RUN[my] + lrk + (F.wave == 1 ? (int)CW[my] : 0); TR[((size_t)r0 + (a >> 2)) * 4 + (a & 3)] = brank; }
        __syncthreads();
        if (F.tid < NE) RUN[F.tid] += CW[F.tid] + CW[32 + F.tid];
    }
    VM_WAIT(); __syncthreads();
    if (F.tid < NE) { const unsigned cnt = RUN[F.tid]; unsigned base = 0;
        if (cnt) base = __hip_atomic_fetch_add(F.ctl + CW_CNT + (real ? layer : NLAYER) * NE + F.tid, cnt, RLX_AGENT);
        F.MISC[MW_LBASE + F.tid] = base; }
    __syncthreads();
    if (real) for (int n = 0; n < ncnt; ++n) { const int r0 = RT_TILE(n) * 32;
        if (F.tid < 128) { const size_t idx = ((size_t)r0 + (F.tid >> 2)) * 4 + (F.tid & 3); const int e = TE[idx]; const int rank = TR[idx] + (int)F.MISC[MW_LBASE + e]; TR[idx] = rank; ROWTOK[(size_t)e * MT + rank] = r0 + (F.tid >> 2); } }
    __syncthreads();
#undef RT_LOADX
#undef RT_TILE
}

__device__ __forceinline__ void normrope16(float (&x)[16], const float* gain, bool lat, int prow, int pcol, const LAS f32x2* T, int L, float oscale, int lane) {
    float ss = 0.f;
#pragma unroll
    for (int i = 0; i < 16; ++i) ss += x[i] * x[i];
    ss += shx(ss, 1, lane); ss += shx(ss, 2, lane); ss += shx(ss, 4, lane);
    const float rstd = 1.0f / sqrtf(ss * (1.0f / 128.0f) + EPS);
    const int o = (L & 7) * 16;
#pragma unroll
    for (int i = 0; i < 16; ++i) x[i] = x[i] * rstd * gain[o + i];
    float p[16];
#pragma unroll
    for (int i = 0; i < 16; ++i) p[i] = shx(x[i], 2, lane);
    if (lat) {
        const int pos = (L & 4) ? pcol : prow; const float sgn = (L & 2) ? 1.0f : -1.0f; const LAS f32x2* t = T + pos * 32 + (L & 1) * 16;
#pragma unroll
        for (int i = 0; i < 16; ++i) { const f32x2 cs = t[i]; x[i] = x[i] * cs.x + sgn * p[i] * cs.y; }
    }
#pragma unroll
    for (int i = 0; i < 16; ++i) x[i] *= oscale;
}
__device__ __forceinline__ void qkprep_phase(Frame& F, int j) {
    LAS f32x2* T = (LAS f32x2*)F.lds;
    __syncthreads();
    for (int i = F.tid; i < 128 * 32; i += NTHREADS) { const int pos = i >> 5, f = i & 31; const float inv = powf(10000.0f, -(float)f / 32.0f); const float ang = (float)pos * inv; float s, c; sincosf(ang, &s, &c); T[i] = (f32x2){c, s}; }
    __syncthreads();
    const bf16* P = (const bf16*)(F.ws + WS_P); unsigned char* Q8 = (unsigned char*)(F.ws + WS_QB); unsigned char* K8 = (unsigned char*)(F.ws + WS_QB + WS_K8_OFF); unsigned char* VT8 = (unsigned char*)(F.ws + WS_KVB);
    const float* qg = PIN(F, I_AQG) + j * 128; const float* kg = PIN(F, I_AKG) + j * 128;
    if (F.bx == 0 && F.tid == 0) { float qm = 0.f, km = 0.f; for (int i = 0; i < 128; ++i) { qm = fmaxf(qm, fabsf(qg[i])); km = fmaxf(km, fabsf(kg[i])); }
        const float sig = att::SCALE * 1.4426950408889634f * 11.3137085f * qm * km;
        ((float*)(F.ws + WS_RC))[2048 + j] = -fminf(-2.0f, 8.0f - 7.0f * sig); }
    const int gw = F.bx * NWAVES + F.wave, NGW = F.G * NWAVES, L = F.lane;
    v4u nqa, nqc, nka, nkc;
#define QK_LOAD(r_) do { const bf16* pr_ = P + (size_t)(r_) * 1536; nqa = *(const v4u*)(pr_ + 16 * L); nqc = *(const v4u*)(pr_ + 16 * L + 8); nka = *(const v4u*)(pr_ + 1024 + 16 * (L & 15)); nkc = *(const v4u*)(pr_ + 1024 + 16 * (L & 15) + 8); } while (0)
    if (gw < MT) QK_LOAD(gw);
    for (int r = gw; r < MT; r += NGW) {
        const v4u qa_ = nqa, qc_ = nqc, ka_ = nka, kc_ = nkc;
        if (r + NGW < MT) QK_LOAD(r + NGW);
        const bool lat = r < ML; const int b = lat ? (r >> 13) : ((r - ML) >> 8); const int s = lat ? (r & (SEQ - 1)) : ((r - ML) & (CL - 1));
        const int prow = s >> 6, pcol = s & 63; const size_t kvrow = (size_t)b * SKV + (lat ? s : SEQ + s);
        { const v4u a = qa_, c = qc_; float x[16];
          x[0] = bflo(a.x); x[1] = bfhi(a.x); x[2] = bflo(a.y); x[3] = bfhi(a.y); x[4] = bflo(a.z); x[5] = bfhi(a.z); x[6] = bflo(a.w); x[7] = bfhi(a.w);
          x[8] = bflo(c.x); x[9] = bfhi(c.x); x[10] = bflo(c.y); x[11] = bfhi(c.y); x[12] = bflo(c.z); x[13] = bfhi(c.z); x[14] = bflo(c.w); x[15] = bfhi(c.w);
          normrope16(x, qg, lat, prow, pcol, T, L, att::SCALE * 1.4426950408889634f * 8.0f, L);
          v4u o;
#pragma unroll
          for (int w4 = 0; w4 < 4; ++w4) { unsigned w = 0; w = __builtin_amdgcn_cvt_pk_fp8_f32(x[4 * w4], x[4 * w4 + 1], w, false); w = __builtin_amdgcn_cvt_pk_fp8_f32(x[4 * w4 + 2], x[4 * w4 + 3], w, true); o[w4] = w; }
          *(v4u*)(Q8 + (size_t)r * D + 16 * L) = o; }
        { const int Lk = L & 15; const v4u a = ka_, c = kc_; float x[16];
          x[0] = bflo(a.x); x[1] = bfhi(a.x); x[2] = bflo(a.y); x[3] = bfhi(a.y); x[4] = bflo(a.z); x[5] = bfhi(a.z); x[6] = bflo(a.w); x[7] = bfhi(a.w);
          x[8] = bflo(c.x); x[9] = bfhi(c.x); x[10] = bflo(c.y); x[11] = bfhi(c.y); x[12] = bflo(c.z); x[13] = bfhi(c.z); x[14] = bflo(c.w); x[15] = bfhi(c.w);
          normrope16(x, kg, lat, prow, pcol, T, Lk, 1.0f, L);
          if (L < 16) { v4u o;
#pragma unroll
            for (int w4 = 0; w4 < 4; ++w4) { unsigned w = 0; w = __builtin_amdgcn_cvt_pk_fp8_f32(x[4 * w4], x[4 * w4 + 1], w, false); w = __builtin_amdgcn_cvt_pk_fp8_f32(x[4 * w4 + 2], x[4 * w4 + 3], w, true); o[w4] = w; }
            *(v4u*)(K8 + kvrow * 256 + 16 * L) = o; }
        }
    }
#undef QK_LOAD
    LAS unsigned char* Tt = F.lds + 32768;
    for (int tile = F.bx; tile < NB * (SKV / 64); tile += F.G) {
        const int b = tile / (SKV / 64), kb = tile % (SKV / 64), ki = F.tid >> 3, seg = F.tid & 7, pos = kb * 64 + ki;
        const size_t r = pos < SEQ ? (size_t)b * SEQ + pos : (size_t)ML + (size_t)b * CL + (pos - SEQ);
        const int k5 = ki & 31, slot = 32 * ((k5 >> 2) & 1) + ((k5 & 3) | ((k5 >> 3) << 2)) + (ki >= 32 ? 16 : 0);
        const v4u* src = (const v4u*)(P + r * 1536 + 1280 + 32 * seg);
        __syncthreads();
#pragma unroll
        for (int q = 0; q < 4; ++q) { const v4u w = src[q]; const unsigned ww[4] = {w.x, w.y, w.z, w.w};
#pragma unroll
            for (int e2 = 0; e2 < 4; ++e2) { const unsigned pk = __builtin_amdgcn_cvt_pk_fp8_f32(bflo(ww[e2]), bfhi(ww[e2]), 0u, false); const int dd = 32 * seg + 8 * q + 2 * e2;
                Tt[dd * 64 + slot] = (unsigned char)(pk & 0xff); Tt[(dd + 1) * 64 + slot] = (unsigned char)((pk >> 8) & 0xff); } }
        __syncthreads();
        { const int rho = F.tid >> 1, half = F.tid & 1; const v4u a = *(const LAS v4u*)(Tt + rho * 64 + 32 * half), c = *(const LAS v4u*)(Tt + rho * 64 + 32 * half + 16);
          unsigned char* dst = VT8 + ((size_t)(b * 2 + (rho >> 7)) * 128 + (rho & 127)) * SKV + kb * 64 + 32 * half;
          *(v4u*)dst = a; *(v4u*)(dst + 16) = c; }
    }
    __syncthreads();
}
template <int XV = 0>
__device__ __forceinline__ void attention_phase(Frame& F, char* lds_generic, bool ctx_queries, int j) {
    const float nb = -((const float*)(F.ws + WS_RC))[2048 + j] - 8.0f;
    const unsigned char* Q8 = (const unsigned char*)(F.ws + WS_QB); const unsigned char* K8 = (const unsigned char*)(F.ws + WS_QB + WS_K8_OFF); const unsigned char* VT8 = (const unsigned char*)(F.ws + WS_KVB); bf16* Y = (bf16*)(F.ws + WS_Y);
    const int nunits = 2048 + (ctx_queries ? 64 : 0);
    for (int u = F.bx; u < nunits; u += F.G) {
        if (u < 2048) { const int b = u >> 8, w = u & 255, h = w & 7, qb = w >> 3; const size_t qo = ((size_t)b * SEQ + (size_t)qb * 256) * D + h * 128;
            att::attn_dense_body<XV>(Q8 + qo, K8 + (size_t)b * SKV * 256 + (h >> 2) * 128, VT8 + (size_t)(b * 2 + (h >> 2)) * 128 * SKV, SKV, Y + qo, SKV, lds_generic, F.wave, nb); }
        else { const int w = u - 2048, b = w >> 3, h = w & 7; const size_t qo = ((size_t)ML + (size_t)b * CL) * D + h * 128;
            att::attn_dense_body<XV>(Q8 + qo, K8 + ((size_t)b * SKV + SEQ) * 256 + (h >> 2) * 128, VT8 + (size_t)(b * 2 + (h >> 2)) * 128 * SKV + SEQ, SKV, Y + qo, CL, lds_generic, F.wave, nb); }
    }
}

__device__ __forceinline__ void gmlp_mix_phase(Frame& F) {
    constexpr int LDA = 136, LDO = 132;
    LAS bf16* As = (LAS bf16*)F.lds;
    LAS bf16* Vt = (LAS bf16*)(F.lds + 128 * LDA * 2);
    LAS float* rs = (LAS float*)(F.lds + 2 * 128 * LDA * 2);
    LAS float* Ot = (LAS float*)(F.lds + 2 * 128 * LDA * 2 + 512);
    const bf16* P = (const bf16*)(F.ws + WS_P); bf16* Y = (bf16*)(F.ws + WS_Y); const float* SS = (const float*)(F.ws + WS_SS);
    const float* ws = PIN(F, I_GWS); const float* bs = PIN(F, I_GBS); const float* vg = PIN(F, I_GVG);
    const int r32 = F.lane & 31, hi = F.lane >> 5;
    constexpr int NU = (MT / 128) * 8;
    struct GIn { f32x4 s; v4u v[4], uu[4]; } ga, gb; int gcur = -1;
#define GM_LOAD(u_, IN) do { const int g_ = (u_) & 7; const size_t row0_ = (size_t)((u_) >> 3) * 128; \
        IN.s = *(const f32x4*)(SS + (row0_ + (F.tid >> 2)) * 16 + (F.tid & 3) * 4);                                       \
        _Pragma("unroll") for (int k = 0; k < 4; ++k) { const int i_ = F.tid + NTHREADS * k, q_ = i_ >> 4, c8_ = (i_ & 15) * 8; const bf16* pp_ = P + (row0_ + q_) * 2048 + g_ * 128 + c8_; \
            IN.v[k] = *(const v4u*)(pp_ + 1024); IN.uu[k] = *(const v4u*)pp_; } } while (0)
#define GM_UNIT(u_, IN) do { \
        const int chunk = (u_) >> 3, g = (u_) & 7; const size_t row0 = (size_t)chunk * 128; \
        __syncthreads(); \
        if (g != gcur) { gcur = g; \
            for (int i = F.tid; i < 128 * 32; i += NTHREADS) { const int p = i >> 5, q4 = (i & 31) * 4; const f32x4 w = *(const f32x4*)(ws + ((size_t)g * 128 + p) * 128 + q4); \
                v2u o; o.x = pk2(w.x, w.y); o.y = pk2(w.z, w.w); *(LAS v2u*)(As + p * LDA + q4) = o; } } \
        { float s = (IN.s.x + IN.s.y) + (IN.s.z + IN.s.w); s += shx(s, 1, F.lane); s += shx(s, 2, F.lane); if ((F.tid & 3) == 0) rs[F.tid >> 2] = 1.0f / sqrtf(s * (1.0f / 1024.0f) + EPS); } \
        __syncthreads(); \
        _Pragma("unroll") for (int k = 0; k < 4; ++k) { const int i = F.tid + NTHREADS * k, q = i >> 4, c8 = (i & 15) * 8; const float rq = rs[q]; const unsigned ww[4] = {IN.v[k].x, IN.v[k].y, IN.v[k].z, IN.v[k].w}; \
            _Pragma("unroll") for (int e2 = 0; e2 < 4; ++e2) { const unsigned pk = cvt_pk_bf16(bflo(ww[e2]) * rq, bfhi(ww[e2]) * rq); Vt[(c8 + 2 * e2) * LDA + q] = (bf16)(pk & 0xffff); Vt[(c8 + 2 * e2 + 1) * LDA + q] = (bf16)(pk >> 16); } } \
        __syncthreads(); \
        const int p0 = (F.wave >> 1) * 32, cbase = (F.wave & 1) * 64; \
        f32x16 acc0 = {}, acc1 = {}; \
        _Pragma("unroll") for (int ks = 0; ks < 8; ++ks) { const int k0 = ks * 16 + hi * 8; \
            const bf16x8 a = *(const LAS bf16x8*)(As + (p0 + r32) * LDA + k0); \
            const bf16x8 b0 = *(const LAS bf16x8*)(Vt + (cbase + r32) * LDA + k0), b1 = *(const LAS bf16x8*)(Vt + (cbase + 32 + r32) * LDA + k0); \
            acc0 = __builtin_amdgcn_mfma_f32_32x32x16_bf16(a, b0, acc0, 0, 0, 0); acc1 = __builtin_amdgcn_mfma_f32_32x32x16_bf16(a, b1, acc1, 0, 0, 0); } \
        _Pragma("unroll") for (int t = 0; t < 2; ++t) { const int cl = cbase + t * 32 + r32; const float gain = vg[g * 128 + cl]; \
            _Pragma("unroll") for (int reg = 0; reg < 16; ++reg) { const int p = p0 + (reg & 3) + 8 * (reg >> 2) + 4 * hi; Ot[p * LDO + cl] = gain * (t == 0 ? acc0[reg] : acc1[reg]) + bs[g * 128 + p]; } } \
        __syncthreads(); \
        _Pragma("unroll") for (int k = 0; k < 4; ++k) { const int i = F.tid + NTHREADS * k, p = i >> 4, c8 = (i & 15) * 8; const v4u uw = IN.uu[k]; \
            const LAS float* o = Ot + p * LDO + c8; const f32x4 m0 = *(const LAS f32x4*)o, m1 = *(const LAS f32x4*)(o + 4); \
            v4u w; w.x = cvt_pk_bf16(bflo(uw.x) * m0.x, bfhi(uw.x) * m0.y); w.y = cvt_pk_bf16(bflo(uw.y) * m0.z, bfhi(uw.y) * m0.w); \
            w.z = cvt_pk_bf16(bflo(uw.z) * m1.x, bfhi(uw.z) * m1.y); w.w = cvt_pk_bf16(bflo(uw.w) * m1.z, bfhi(uw.w) * m1.w); \
            *(v4u*)(Y + (row0 + p) * D + g * 128 + c8) = w; } } while (0)
    int u = F.bx;
    if (u < NU) GM_LOAD(u, ga);
    for (; u < NU; u += 2 * F.G) {
        if (u + F.G < NU) GM_LOAD(u + F.G, gb);
        GM_UNIT(u, ga);
        if (u + F.G >= NU) break;
        if (u + 2 * F.G < NU) GM_LOAD(u + 2 * F.G, ga);
        GM_UNIT(u + F.G, gb);
    }
    __syncthreads();
#undef GM_LOAD
#undef GM_UNIT
}

__device__ __forceinline__ void hyena_prep_phase(Frame& F) {
    LAS float* tl = (LAS float*)F.lds;
    const bf16* P = (const bf16*)(F.ws + WS_P); bf16* X0 = (bf16*)(F.ws + WS_X0); bf16* VG = (bf16*)(F.ws + WS_VG);
    float* VT = (float*)(F.ws + WS_VT); float* VTC = (float*)(F.ws + WS_VTC);
    const float* cw = PIN(F, I_HCW); const float* cb = PIN(F, I_HCB);
    const int tt = F.tid >> 3, cg = F.tid & 7;
    constexpr int NU = (MT / 64) * 16;
    v4u pa[3][3], pb[3][3];
#define HP_LOAD(u_, IN) do { const int tb_ = (u_) >> 4, c0_ = ((u_) & 15) * 64, r0_ = tb_ * 64; const bool lat_ = r0_ < ML; \
        const int s_ = (lat_ ? (r0_ & (SEQ - 1)) : ((r0_ - ML) & (CL - 1))) + tt, L_ = lat_ ? SEQ : CL; const bf16* pr_ = P + (size_t)(r0_ + tt) * 3072 + c0_ + cg * 8; const v4u z0_ = {0u, 0u, 0u, 0u}; \
        _Pragma("unroll") for (int seg = 0; seg < 3; ++seg) { IN[seg][0] = s_ > 0 ? *(const v4u*)(pr_ + seg * 1024 - 3072) : z0_; IN[seg][1] = *(const v4u*)(pr_ + seg * 1024); \
            IN[seg][2] = s_ < L_ - 1 ? *(const v4u*)(pr_ + seg * 1024 + 3072) : z0_; } } while (0)
    LAS float* wl = tl + 64 * 65; int c0w = -1;
#define HP_UNIT(u_, IN) do { \
        const int tb = (u_) >> 4, c0 = ((u_) & 15) * 64; const int r0 = tb * 64; const bool lat = r0 < ML; \
        const int b = lat ? (r0 >> 13) : ((r0 - ML) >> 8), s0 = lat ? (r0 & (SEQ - 1)) : ((r0 - ML) & (CL - 1)); \
        const int r = r0 + tt, c = c0 + cg * 8; \
        if (c0 != c0w) { c0w = c0; __syncthreads(); \
            for (int i = F.tid; i < 768; i += NTHREADS) { const int seg = i >> 8, k = (i >> 6) & 3, ch = i & 63; wl[i] = k < 3 ? cw[k * 3072 + seg * 1024 + c0 + ch] : cb[seg * 1024 + c0 + ch]; } \
            __syncthreads(); } \
        float o[3][8]; \
        _Pragma("unroll") for (int seg = 0; seg < 3; ++seg) { \
            const unsigned pmw[4] = {IN[seg][0].x, IN[seg][0].y, IN[seg][0].z, IN[seg][0].w}, pcw[4] = {IN[seg][1].x, IN[seg][1].y, IN[seg][1].z, IN[seg][1].w}, pnw[4] = {IN[seg][2].x, IN[seg][2].y, IN[seg][2].z, IN[seg][2].w}; \
            _Pragma("unroll") for (int i = 0; i < 8; ++i) { const float xm = (i & 1) ? bfhi(pmw[i >> 1]) : bflo(pmw[i >> 1]), xc = (i & 1) ? bfhi(pcw[i >> 1]) : bflo(pcw[i >> 1]), xn = (i & 1) ? bfhi(pnw[i >> 1]) : bflo(pnw[i >> 1]); \
                const LAS float* wp = wl + seg * 256 + cg * 8 + i; o[seg][i] = xm * wp[0] + xc * wp[64] + xn * wp[128] + wp[192]; } } \
        float vgv[8]; \
        _Pragma("unroll") for (int i = 0; i < 8; ++i) vgv[i] = o[2][i] * o[1][i]; \
        v4u w; w.x = cvt_pk_bf16(o[0][0], o[0][1]); w.y = cvt_pk_bf16(o[0][2], o[0][3]); w.z = cvt_pk_bf16(o[0][4], o[0][5]); w.w = cvt_pk_bf16(o[0][6], o[0][7]); \
        *(v4u*)(X0 + (size_t)r * D + c) = w; \
        __syncthreads(); \
        _Pragma("unroll") for (int i = 0; i < 8; ++i) tl[(cg * 8 + i) * 65 + tt] = vgv[i]; \
        __syncthreads(); \
        { const int cc = F.tid >> 3, ts = (F.tid & 7) * 8; const LAS float* sp = tl + cc * 65 + ts; \
          if (lat) *(v4u*)((bf16*)VT + ((size_t)b * 1024 + c0 + cc) * SEQ + s0 + ts) = (v4u){cvt_pk_bf16(sp[0], sp[1]), cvt_pk_bf16(sp[2], sp[3]), cvt_pk_bf16(sp[4], sp[5]), cvt_pk_bf16(sp[6], sp[7])};        \
          else { float* dst = VTC + ((size_t)b * 1024 + c0 + cc) * CL + s0 + ts; *(f32x4*)dst = (f32x4){sp[0], sp[1], sp[2], sp[3]}; *(f32x4*)(dst + 4) = (f32x4){sp[4], sp[5], sp[6], sp[7]}; } } } while (0)
    int u = F.bx;
    if (u < NU) HP_LOAD(u, pa);
    for (; u < NU; u += 2 * F.G) {
        if (u + F.G < NU) HP_LOAD(u + F.G, pb);
        HP_UNIT(u, pa);
        if (u + F.G >= NU) break;
        if (u + 2 * F.G < NU) HP_LOAD(u + 2 * F.G, pa);
        HP_UNIT(u + F.G, pb);
    }
    __syncthreads();
#undef HP_LOAD
#undef HP_UNIT
}
__device__ __forceinline__ void hyena_post_phase(Frame& F) {
    LAS float* tl = (LAS float*)F.lds;
    const bf16* X0 = (const bf16*)(F.ws + WS_X0); const bf16* VG = (const bf16*)(F.ws + WS_VG); bf16* Y = (bf16*)(F.ws + WS_Y);
    const float* VT = (const float*)(F.ws + WS_CT); const float* VTC = (const float*)(F.ws + WS_CTC); const float* dsk = PIN(F, I_HD);
    const int tt = F.tid >> 3, cg = F.tid & 7;
    constexpr int NU = (MT / 64) * 16;
    struct PIn { f32x4 a, bq; v4u cw, x0; } qa, qb;
#define HQ_LOAD(u_, IN) do { const int tb_ = (u_) >> 4, c0_ = ((u_) & 15) * 64, r0_ = tb_ * 64; const bool lat_ = r0_ < ML; \
        const int b_ = lat_ ? (r0_ >> 13) : ((r0_ - ML) >> 8), s0_ = lat_ ? (r0_ & (SEQ - 1)) : ((r0_ - ML) & (CL - 1)); const int cc_ = F.tid >> 3, ts_ = (F.tid & 7) * 8; \
        if (lat_) IN.cw = *(const v4u*)((const bf16*)VT + ((size_t)b_ * 1024 + c0_ + cc_) * SEQ + s0_ + ts_);        \
        else { const float* src_ = VTC + ((size_t)b_ * 1024 + c0_ + cc_) * CL + s0_ + ts_; IN.a = *(const f32x4*)src_; IN.bq = *(const f32x4*)(src_ + 4); } \
        IN.x0 = *(const v4u*)(X0 + (size_t)(r0_ + tt) * D + c0_ + cg * 8); } while (0)
#define HQ_UNIT(u_, IN) do { \
        const int tb = (u_) >> 4, c0 = ((u_) & 15) * 64; const int r0 = tb * 64; \
        __syncthreads(); \
        { const int cc = F.tid >> 3, ts = (F.tid & 7) * 8; LAS float* dp = tl + cc * 65 + ts; \
          if (r0 < ML) { dp[0] = bflo(IN.cw.x); dp[1] = bfhi(IN.cw.x); dp[2] = bflo(IN.cw.y); dp[3] = bfhi(IN.cw.y); dp[4] = bflo(IN.cw.z); dp[5] = bfhi(IN.cw.z); dp[6] = bflo(IN.cw.w); dp[7] = bfhi(IN.cw.w); } \
          else { dp[0] = IN.a.x; dp[1] = IN.a.y; dp[2] = IN.a.z; dp[3] = IN.a.w; dp[4] = IN.bq.x; dp[5] = IN.bq.y; dp[6] = IN.bq.z; dp[7] = IN.bq.w; } } \
        __syncthreads(); \
        const int r = r0 + tt, c = c0 + cg * 8; \
        const unsigned x0w[4] = {IN.x0.x, IN.x0.y, IN.x0.z, IN.x0.w}; float y[8]; \
        _Pragma("unroll") for (int i = 0; i < 8; ++i) { const float xx = (i & 1) ? bfhi(x0w[i >> 1]) : bflo(x0w[i >> 1]); y[i] = tl[(cg * 8 + i) * 65 + tt] * xx; }        \
        v4u w; w.x = cvt_pk_bf16(y[0], y[1]); w.y = cvt_pk_bf16(y[2], y[3]); w.z = cvt_pk_bf16(y[4], y[5]); w.w = cvt_pk_bf16(y[6], y[7]); \
        *(v4u*)(Y + (size_t)r * D + c) = w; } while (0)
    int u = F.bx;
    if (u < NU) HQ_LOAD(u, qa);
    for (; u < NU; u += 2 * F.G) {
        if (u + F.G < NU) HQ_LOAD(u + F.G, qb);
        HQ_UNIT(u, qa);
        if (u + F.G >= NU) break;
        if (u + 2 * F.G < NU) HQ_LOAD(u + 2 * F.G, qa);
        HQ_UNIT(u + F.G, qb);
    }
    __syncthreads();
#undef HQ_LOAD
#undef HQ_UNIT
}
__device__ __forceinline__ bool phase_nonempty(int ph) {
    if (ph < PH_L0 || ph >= PH_FINAL) return true;
    const int layer = (ph - PH_L0) / PH_PER_LAYER, lp = (ph - PH_L0) % PH_PER_LAYER, kind = layer % 3;
    if (lp == LP_MIX2) return kind != 1;
    if (lp == LP_MIX3) return kind == 2;
    return true;
}
__global__ void __launch_bounds__(NTHREADS, 2) mk_fwd(Args args) {
    extern __shared__ __attribute__((aligned(16))) unsigned char lds[];
    Frame F0;
    F0.lds = (LAS unsigned char*)lds; F0.MISC = (volatile LAS unsigned*)(F0.lds + MISC_OFF);
    F0.tid = threadIdx.x; F0.lane = F0.tid & 63; F0.wave = __builtin_amdgcn_readfirstlane(F0.tid >> 6);
    F0.G = gridDim.x; F0.bx = blockIdx.x; F0.out = args.out; F0.ws = args.ws; F0.ctl = (gu32*)(args.ws + WS_CTL);
    for (int u = F0.tid; u < MISC_BYTES / 4; u += NTHREADS) F0.MISC[u] = 0u;
    __syncthreads();
    if (F0.tid < 36) { const unsigned long long p = (unsigned long long)args.in[F0.tid]; F0.MISC[MW_PTRS + 2 * F0.tid] = (unsigned)p; F0.MISC[MW_PTRS + 2 * F0.tid + 1] = (unsigned)(p >> 32); }
    __syncthreads();
    const int lo = args.ph_lo, hi = args.ph_hi;
    const bool multi = (hi - lo) > 1;
    XcdBarrier bar; bar.bar = (unsigned*)(F0.ctl + CW_BAR); bar.x = 0; bar.st = nullptr; bar.w = F0.wave;
    if (multi) bar = xcd_barrier_post((unsigned*)(F0.ctl + CW_BAR), F0.MISC + 8, F0.wave);
#ifndef PHMASK
#define PHMASK 0xFFFF
#endif
#define EN(b) ((PHMASK >> (b)) & 1)
#ifndef MK_STAG_IN
#define MK_STAG_IN 0u
#define MK_STAG_OUT 0u
#define MK_STAG_M1 0u
#define MK_STAG_M2 0u
#endif
#ifndef KMASK
#define KMASK 7
#endif
#define KEN(b) ((KMASK >> (b)) & 1)
#define IN(k) (lo <= (k) && (k) < hi)
#define SEAM(k) do { if ((k) + 1 < hi) xcd_barrier(bar); } while (0)
#define PB(id) for (int _rep = 0, _n = ((id) == MK_REPEAT ? MK_NREP : 1); _rep < _n; ++_rep) {
#define PE(id) if (_rep + 1 < _n) xcd_barrier(bar); } SEAM(id);

    if (EN(0) && IN(PH_PRO0)) { PB(PH_PRO0) Frame F = phase_frame(F0); pro0_mod(F); __syncthreads(); pro0_transposes(F); pro0_filter_mlp(F); PE(PH_PRO0) }
    if (EN(1) && IN(PH_PRO1)) { PB(PH_PRO1) Frame F = phase_frame(F0); pro1_router_split(F); pro1_filters(F); PE(PH_PRO1) }

#pragma unroll 1
    for (int layer = 0; layer < NLAYER; ++layer) {
        const int kind = layer % 3, jj = layer / 3, pb = PH_L0 + layer * PH_PER_LAYER; const bool last = layer == NLAYER - 1;
        if (EN(2) && IN(pb + LP_NORM1)) { PB(pb + LP_NORM1) Frame F = phase_frame(F0); rowpass<0>(F, layer, _rep + 1 == _n, kind != 1); PE(pb + LP_NORM1) }
        if (EN(3) && IN(pb + LP_INPROJ)) { PB(pb + LP_INPROJ)
            Frame F = phase_frame(F0);
            if (kind != 1) {
                const int N = kind == 0 ? 1536 : 3072;
                pg8::DenseSchedT<true> S; S.init(F.ws + WS_H8, kind == 0 ? F.ws + WS_WATT + (size_t)jj * 1536 * 1024 : F.ws + WS_WHY, MT, N, F.G, F.bx, 1024);
                pg8::EpiBf16 E{(bf16*)(F.ws + WS_P), N, (float*)(F.ws + WS_SS), 0};
                pg8::gemm_phase<pg8::EpiBf16, pg8::DenseSchedT<true>, true, true>(F.lds, S, E, F.wave, false, MK_STAG_IN);
            } else {
                const int N = 2048;
                pg8::DenseSched S; S.init(F.ws + WS_H, F.ws + WS_WGM, MT, N, F.G, F.bx);
                pg8::EpiBf16 E{(bf16*)(F.ws + WS_P), N, (float*)(F.ws + WS_SS), 1};
                pg8::gemm_phase<pg8::EpiBf16, pg8::DenseSched, false>(F.lds, S, E, F.wave, false, MK_STAG_IN);
            }
            PE(pb + LP_INPROJ)
        }
        if (IN(pb + LP_MIX1)) { PB(pb + LP_MIX1)
            Frame F = phase_frame(F0);
            if (EN(4) && kind == 0) qkprep_phase(F, jj); else if (EN(5) && kind == 1) gmlp_mix_phase(F); else if (EN(6)) hyena_prep_phase(F);
            PE(pb + LP_MIX1)
        }
        if (IN(pb + LP_MIX2) && kind != 1) { PB(pb + LP_MIX2)
            Frame F = phase_frame(F0);
            if (EN(7) && kind == 0) {
#if MK_XP >= 10 && MK_XP < 20
                if (_rep + 1 < _n) attention_phase<MK_XP - 10>(F, (char*)lds, !last, jj); else
#endif
                attention_phase<0>(F, (char*)lds, !last, jj); }
            else if (EN(8)) hyena_conv_phase(F);
            PE(pb + LP_MIX2)
        }
        if (EN(9) && IN(pb + LP_MIX3) && kind == 2) { PB(pb + LP_MIX3) Frame F = phase_frame(F0); hyena_post_phase(F); PE(pb + LP_MIX3) }
        if (EN(10) && IN(pb + LP_OUTPROJ)) { PB(pb + LP_OUTPROJ)
            Frame F = phase_frame(F0); const float* modl = (const float*)(F.ws + WS_MOD) + (size_t)layer * 9 * 6144;
            pg8::DenseSched S; S.init(F.ws + WS_Y, F.ws + WS_WOUT + (size_t)layer * 1024 * 1024 * 2, last ? ML : MT, 1024, F.G, F.bx);
            pg8::EpiResid E{(bf16*)(F.ws + WS_XB), modl};
            pg8::gemm_phase<pg8::EpiResid, pg8::DenseSched, false>(F.lds, S, E, F.wave, false, MK_STAG_OUT);
            PE(pb + LP_OUTPROJ)
        }
        if (EN(11) && IN(pb + LP_NORM2)) { PB(pb + LP_NORM2) Frame F = phase_frame(F0); router_phase(F, layer, _rep + 1 == _n, (_rep + 1 < _n) ? MK_XP : 0); PE(pb + LP_NORM2) }
        if (EN(12) && IN(pb + LP_MOE1)) { PB(pb + LP_MOE1)
            Frame F = phase_frame(F0);
            moe_tables(F, layer);
            pg8::MoeSched S{(const char*)(F.ws + WS_H8), (const char*)(F.ws + WS_WE1) + (size_t)layer * NE * 2048 * 1024, (size_t)2048 * 1024, (const int*)(F.ws + WS_ROWTOK),
                            (const volatile LAS int*)(F.MISC + MW_CUMBLK), (const volatile LAS int*)(F.MISC + MW_CNT), 3, F.G, F.bx, 1024, (const volatile LAS int*)(F.lds + AUX_OFF + 1024)};
            S.build_list((volatile LAS int*)(F.lds + AUX_OFF + 1024), F.tid); __syncthreads();
            pg8::EpiSwiglu E{(unsigned char*)(F.ws + WS_ACT), PIN(F, I_EB1) + (size_t)layer * NE * 2048, (LAS float*)(F.lds + AUX_OFF)};
#if MK_XP >= 20
            if (_rep + 1 < _n) { int one_ = 1; asm volatile("" : "+s"(one_)); pg8::gemm_phase<pg8::EpiSwiglu, pg8::MoeSched, true, true, MK_XP - 20>(F.lds, S, E, F.wave, one_ != 0, MK_STAG_M1); } else
#endif
            pg8::gemm_phase<pg8::EpiSwiglu, pg8::MoeSched, true, true>(F.lds, S, E, F.wave, MK_XP == 1 && _rep + 1 < _n, MK_STAG_M1);
            PE(pb + LP_MOE1)
        }
        if (EN(13) && IN(pb + LP_MOE2)) { PB(pb + LP_MOE2)
            Frame F = phase_frame(F0);
            moe_tables(F, layer);
            pg8::MoeSched S{(const char*)(F.ws + WS_ACT), (const char*)(F.ws + WS_WE2) + (size_t)layer * NE * 1024 * 1024, (size_t)1024 * 1024, nullptr,
                            (const volatile LAS int*)(F.MISC + MW_CUMBLK), (const volatile LAS int*)(F.MISC + MW_CNT), 2, F.G, F.bx, 1024, (const volatile LAS int*)(F.lds + AUX_OFF + 1024)};
            S.build_list((volatile LAS int*)(F.lds + AUX_OFF + 1024), F.tid); __syncthreads();
            pg8::EpiBias E{(unsigned char*)(F.ws + WS_YM), PIN(F, I_EB2) + (size_t)layer * NE * 1024, (LAS float*)(F.lds + AUX_OFF)};
            pg8::gemm_phase<pg8::EpiBias, pg8::MoeSched, true, true>(F.lds, S, E, F.wave, MK_XP == 1 && _rep + 1 < _n, MK_STAG_M2);
            PE(pb + LP_MOE2)
        }
    }
    if (EN(14) && IN(PH_FINAL)) { PB(PH_FINAL) Frame F = phase_frame(F0); rowpass<2>(F, NLAYER - 1, _rep + 1 == _n); PE(PH_FINAL) }
#undef IN
#undef SEAM
}

static bool host_phase_nonempty(int ph) {
    if (ph < PH_L0 || ph >= PH_FINAL) return true;
    const int layer = (ph - PH_L0) / PH_PER_LAYER, lp = (ph - PH_L0) % PH_PER_LAYER, kind = layer % 3;
    if (lp == LP_MIX2) return kind != 1;
    if (lp == LP_MIX3) return kind == 2;
    return true;
}
extern "C" void kernel_launch(void* const* d_in, const int* in_sizes, int n_in, void* d_out, int out_size, void* d_ws, size_t ws_size, hipStream_t stream) {
    static int grid = 0;
    if (grid == 0) {
        if (n_in != 36 || in_sizes[0] != ML * D || out_size != ML * D || ws_size < WS_END) {
            fprintf(stderr, "kernel_launch: built for 36 inputs, x/out of %d floats, >= %zu bytes of workspace; got n_in %d in0 %d out %d ws %zu; nothing launched\n", ML * D, (size_t)WS_END, n_in, n_in > 0 ? in_sizes[0] : -1, out_size, ws_size);
            grid = -1; return; }
        int dev = 0, cus = 0, per_cu = 0;
        if (hipGetDevice(&dev) != hipSuccess || hipDeviceGetAttribute(&cus, hipDeviceAttributeMultiprocessorCount, dev) != hipSuccess) { fprintf(stderr, "kernel_launch: device query failed\n"); grid = -1; return; }
        if (hipFuncSetAttribute((const void*)mk_fwd, hipFuncAttributeMaxDynamicSharedMemorySize, LDS_BYTES) != hipSuccess) { fprintf(stderr, "kernel_launch: hipFuncSetAttribute(%d B LDS) failed\n", LDS_BYTES); grid = -1; return; }
        if (hipOccupancyMaxActiveBlocksPerMultiprocessor(&per_cu, (const void*)mk_fwd, NTHREADS, LDS_BYTES) != hipSuccess || per_cu < 1)
            fprintf(stderr, "kernel_launch: note: occupancy query reports %d workgroups per CU\n", per_cu);
        (void)hipGetLastError();
        grid = cus;
    }
    if (grid < 0) return;
    if (hipMemsetAsync((char*)d_ws + WS_CTL, 0, CTL_ZERO_BYTES, stream) != hipSuccess) { fprintf(stderr, "kernel_launch: memset failed\n"); return; }
    Args a{};
    for (int i = 0; i < 36; ++i) a.in[i] = (const float*)d_in[i];
    a.out = (float*)d_out; a.ws = (unsigned char*)d_ws;
#if MK_MULTI || MK_DBG
    for (int ph = 0; ph < PH_COUNT; ++ph) {
        if (!host_phase_nonempty(ph)) continue;
        a.ph_lo = ph; a.ph_hi = ph + 1;
        hipLaunchKernelGGL(mk_fwd, dim3(grid), dim3(NTHREADS), LDS_BYTES, stream, a);
#if MK_DBG
        dbg_after_phase(ph, a, stream);
#endif
    }
#if MK_DBG
    dbg_report(a, stream);
#endif
#else
    a.ph_lo = 0; a.ph_hi = PH_COUNT;
    hipLaunchKernelGGL(mk_fwd, dim3(grid), dim3(NTHREADS), LDS_BYTES, stream, a);
#endif
    const hipError_t le = hipPeekAtLastError();
    if (le != hipSuccess) fprintf(stderr, "kernel_launch: launch failed: %s\n", hipGetErrorName(le));
}
```

```cpp
#include <hip/hip_runtime.h>
#include <cstdio>
#include <cstdint>
#include <cmath>

#ifndef MK_MULTI
#define MK_MULTI 0
#endif
#ifndef MK_REPEAT
#define MK_REPEAT -1
#endif
#ifndef MK_NREP
#define MK_NREP 1
#endif
#ifndef MK_XP
#define MK_XP 0
#endif
#ifndef MK_MOEMAP
#define MK_MOEMAP 0
#endif
#ifndef MK_DBG
#define MK_DBG 0
#endif

constexpr int D = 1024, NB = 8, SEQ = 8192, CL = 256, ML = NB * SEQ, MC = NB * CL, MT = ML + MC;
constexpr int NLAYER = 4, NE = 32, TOPK = 4, SKV = SEQ + CL;
constexpr int MOE_MAXBLK = (MT * TOPK) / 256 + NE;
constexpr float EPS = 1e-6f;
constexpr int FH = 64, FEMB = 33, NFFT = 16384;

constexpr size_t MiB = 1u << 20;
constexpr size_t WS_CTL = 0, CTL_ZERO_BYTES = 1 * MiB;
constexpr size_t WS_MOD = 1 * MiB;
constexpr size_t WS_A3 = 2 * MiB;
constexpr size_t WS_A3C = 4 * MiB;
constexpr size_t WS_RC = 4 * MiB + 512 * 1024;
constexpr size_t WS_FCT = 5 * MiB;
constexpr size_t WS_WATT = 8 * MiB;
constexpr size_t WS_WGM = 14 * MiB;
constexpr size_t WS_WHY = 18 * MiB;
constexpr size_t WS_WOUT = 24 * MiB;
constexpr size_t WS_RW3 = 32 * MiB;
constexpr size_t WS_TE = 40 * MiB;
constexpr size_t WS_TR = 42 * MiB;
constexpr size_t WS_TG = 44 * MiB;
constexpr size_t WS_SS = 46 * MiB;
constexpr size_t WS_ROWTOK = 52 * MiB;
constexpr size_t WS_KF = 64 * MiB;
constexpr size_t WS_WE1 = 192 * MiB;
constexpr size_t WS_WE2 = 704 * MiB;
constexpr size_t WS_H = 960 * MiB;
constexpr size_t WS_P = 1092 * MiB;
constexpr size_t WS_Y = 1488 * MiB;
constexpr size_t WS_QB = 1620 * MiB;
constexpr size_t WS_K8_OFF = 72 * MiB;
constexpr size_t WS_KVB = 1752 * MiB;
constexpr size_t WS_X0 = 1818 * MiB;
constexpr size_t WS_VG = 1950 * MiB;
constexpr size_t WS_VT = 2082 * MiB;
constexpr size_t WS_VTC = 2338 * MiB;
constexpr size_t WS_ACT = 2346 * MiB;
constexpr size_t WS_YM = 2890 * MiB;
constexpr size_t WS_CT = 3434 * MiB;
constexpr size_t WS_CTC = 3690 * MiB;
constexpr size_t WS_H8 = 3698 * MiB;
constexpr size_t WS_XB = 3764 * MiB;
constexpr size_t WS_END = 3896 * MiB;
constexpr int CW_BAR = 4096;
constexpr int CW_CNT = 16384;
constexpr int CW_DBG = 32768;

constexpr int RING_BYTES = 131072;
constexpr int AUX_OFF = RING_BYTES;
constexpr int AUX_BYTES = 16384;
constexpr int MISC_OFF = AUX_OFF + AUX_BYTES;
constexpr int MISC_BYTES = 4096;
constexpr int LDS_BYTES = MISC_OFF + MISC_BYTES;

#define GAS __attribute__((address_space(1)))
#define LAS __attribute__((address_space(3)))
typedef unsigned short bf16;
typedef unsigned v4u __attribute__((ext_vector_type(4)));
typedef unsigned v2u __attribute__((ext_vector_type(2)));
typedef float f32x4 __attribute__((ext_vector_type(4)));
typedef float f32x2 __attribute__((ext_vector_type(2)));
typedef float f32x16 __attribute__((ext_vector_type(16)));
typedef short bf16x8 __attribute__((ext_vector_type(8)));
typedef short s16x4 __attribute__((ext_vector_type(4)));
typedef int i32x4 __attribute__((ext_vector_type(4)));
typedef GAS unsigned gu32;
#define RLX_AGENT __ATOMIC_RELAXED, __HIP_MEMORY_SCOPE_AGENT
#define LDS_WAIT() asm volatile("s_waitcnt lgkmcnt(0)" ::: "memory")
#define VM_WAIT() asm volatile("s_waitcnt vmcnt(0)" ::: "memory")
__device__ __forceinline__ int opaque_tid(int wave) { int l; asm volatile("v_mbcnt_lo_u32_b32 %0, -1, 0\n\tv_mbcnt_hi_u32_b32 %0, -1, %0" : "=v"(l)); return (wave << 6) | l; }
__device__ __forceinline__ unsigned f2bf(float f) { unsigned u = __builtin_bit_cast(unsigned, f); return (u + 0x7fffu + ((u >> 16) & 1u)) >> 16; }
__device__ __forceinline__ unsigned pk2(float lo, float hi) { return f2bf(lo) | (f2bf(hi) << 16); }
__device__ __forceinline__ float bf2f(unsigned short b) { return __builtin_bit_cast(float, ((unsigned)b) << 16); }
__device__ __forceinline__ float bflo(unsigned w) { return __builtin_bit_cast(float, w << 16); }
__device__ __forceinline__ float bfhi(unsigned w) { return __builtin_bit_cast(float, w & 0xffff0000u); }
__device__ __forceinline__ f32x4 bf4_f32(v2u w) { return (f32x4){__uint_as_float(w.x << 16), __uint_as_float(w.x & 0xffff0000u), __uint_as_float(w.y << 16), __uint_as_float(w.y & 0xffff0000u)}; }
__device__ __forceinline__ unsigned cvt_pk_bf16(float lo, float hi) { unsigned r; asm volatile("v_cvt_pk_bf16_f32 %0, %1, %2" : "=v"(r) : "v"(lo), "v"(hi)); return r; }
__device__ __forceinline__ float shx(float v, int mask, int lane) { return __int_as_float(__builtin_amdgcn_ds_bpermute((lane ^ mask) << 2, __float_as_int(v))); }
__device__ __forceinline__ float wave_sum(float v, int lane) {
#pragma unroll
    for (int o = 1; o < 64; o <<= 1) v += shx(v, o, lane);
    return v;
}

#define XB_TMO      128
#define XB_XCNT(j)  (256  + 64 * (j))
#define XB_XSUB(j)  (1280 + 64 * (j))
#define XB_XGEN(j)  (2304 + 64 * (j))
#define XB_TOP      3328
#define XB_TOPGEN   3392
#define XCD_BAR_WORDS 3456
#define XB_SPIN_CAP (1u << 22)
__device__ __forceinline__ unsigned xb_ld(unsigned* p)              { return __hip_atomic_load(p, __ATOMIC_RELAXED, __HIP_MEMORY_SCOPE_AGENT); }
__device__ __forceinline__ unsigned xb_add(unsigned* p, unsigned v) { return __hip_atomic_fetch_add(p, v, __ATOMIC_RELAXED, __HIP_MEMORY_SCOPE_AGENT); }
__device__ __forceinline__ unsigned xb_xcc_id() { return (unsigned)__builtin_amdgcn_s_getreg((3 << 11) | 20) & 0xFu; }
#define XB_SPIN(cond, bar) do { unsigned _sp = 0; while (cond) { __builtin_amdgcn_s_sleep(1); \
    if ((++_sp & 255u) == 0u) { if (xb_ld(&(bar)[XB_TMO])) break; if (_sp > XB_SPIN_CAP) { atomicAdd(&(bar)[XB_TMO], 1u); break; } } } } while (0)
struct XcdBarrier { unsigned* bar; unsigned x; volatile LAS unsigned* st; int w; };
__device__ __forceinline__ bool xb_thread0(int w) { return opaque_tid(w) == 0; }
__device__ __forceinline__ XcdBarrier xcd_barrier_post(unsigned* bar, volatile LAS unsigned* st, int w) {
    XcdBarrier b; b.bar = bar; b.x = xb_xcc_id(); b.st = st; b.w = w;
    if (xb_thread0(w)) (void)xb_add(&bar[XB_XCNT(b.x)], 1u);
    return b;
}
__device__ __forceinline__ void xcd_barrier_complete(unsigned* bar, unsigned x, unsigned& nloc, unsigned& nx) {
    const unsigned G = gridDim.x * gridDim.y * gridDim.z;
    unsigned sum, cnt, mine, sp = 0u;
    for (;;) {
        sum = 0u; cnt = 0u; mine = 0u;
#pragma unroll
        for (unsigned j = 0; j < 16; ++j) { const unsigned c = xb_ld(&bar[XB_XCNT(j)]); sum += c; cnt += (c > 0u) ? 1u : 0u; mine = (j == x) ? c : mine; }
        if (sum == G) break;
        __builtin_amdgcn_s_sleep(1);
        if ((++sp & 255u) == 0u) { if (xb_ld(&bar[XB_TMO])) break; if (sp > XB_SPIN_CAP) { atomicAdd(&bar[XB_TMO], 1u); break; } }
    }
    nloc = mine > 0u ? mine : 1u; nx = cnt > 0u ? cnt : 1u;
}
__device__ __forceinline__ void xcd_barrier(const XcdBarrier& b) {
    asm volatile("s_waitcnt vmcnt(0)" ::: "memory");
    __syncthreads();
    if (xb_thread0(b.w)) {
        unsigned* bar = b.bar;
        __builtin_amdgcn_s_waitcnt(0);
        unsigned nloc = b.st[0], nx = b.st[1];
        if (nloc == 0u) { xcd_barrier_complete(bar, b.x, nloc, nx); b.st[0] = nloc; b.st[1] = nx; }
        const unsigned old = xb_add(&bar[XB_XSUB(b.x)], 1u);
        const unsigned gen = old / nloc;
        if (old + 1u == (gen + 1u) * nloc) {
            __builtin_amdgcn_fence(__ATOMIC_RELEASE, "agent");
            asm volatile("s_waitcnt vmcnt(0)" ::: "memory");
            const unsigned og = xb_add(&bar[XB_TOP], 1u);
            const unsigned tg = og / nx;
            if (og + 1u == (tg + 1u) * nx) xb_add(&bar[XB_TOPGEN], 1u);
            else XB_SPIN(xb_ld(&bar[XB_TOPGEN]) == tg, bar);
            __builtin_amdgcn_fence(__ATOMIC_ACQUIRE, "agent");
            xb_add(&bar[XB_XGEN(b.x)], 1u);
            asm volatile("s_waitcnt vmcnt(0)" ::: "memory");
        } else {
            XB_SPIN(xb_ld(&bar[XB_XGEN(b.x)]) == gen, bar);
            __builtin_amdgcn_fence(__ATOMIC_ACQUIRE, "agent");
            asm volatile("s_waitcnt vmcnt(0)" ::: "memory");
        }
    }
    __syncthreads();
}

namespace pg8 {
constexpr int BM = 256, BK = 64, HALF = 128, HTB = HALF * BK * 2, STAGE_BYTES = 8 * HTB, NXCD = 8, WGM = 8;
constexpr int GK = 1024;
__device__ __forceinline__ int lds_byte(int r, int c) { const int st = (r >> 4) * 2 + (c >> 5), rr = r & 15, cc = c & 31, ob = rr * 64 + cc * 2; return st * 1024 + (ob ^ (((ob >> 9) & 1) << 5)); }
__device__ __forceinline__ void stage_rc(int b, int& R, int& C) { const int st = b / 1024, sb = b % 1024, swz = sb ^ (((sb >> 9) & 1) << 5); R = (st >> 1) * 16 + swz / 64; C = (st & 1) * 32 + (swz % 64) / 2; }
__device__ __forceinline__ int perm32(int rho) { const int n = rho >> 4, i = rho & 15; return 8 * (i >> 2) + 4 * n + (i & 3); }
struct Unit { int pm, pn, e; };

template <bool IDG> struct DenseSchedT {
    const char* A; const char* Bt; int nM, nN, nwg, G, c, kb;
    __device__ __forceinline__ void init(const void* A_, const void* Bt_, int M, int N, int G_, int c_, int kb_ = GK * 2) { A = (const char*)A_; Bt = (const char*)Bt_; nM = M / BM; nN = N / BM; nwg = nM * nN; G = G_; c = c_; kb = kb_; }
    __device__ __forceinline__ bool next(int i, Unit& u) const {
        const long L = (long)i * G + c; if (L >= nwg) return false;
        int wgid = (int)L; { const int q = nwg / NXCD, r = nwg % NXCD, xcd = wgid % NXCD, off = wgid / NXCD; wgid = (xcd < r ? xcd * (q + 1) : r * (q + 1) + (xcd - r) * q) + off; }
        const int nig = WGM * nN, gid = wgid / nig, fm = gid * WGM, gsz = (nM - fm) < WGM ? (nM - fm) : WGM;
        u.pm = fm + ((wgid % nig) % gsz); u.pn = (wgid % nig) / gsz; u.e = 0; return true;
    }
    __device__ __forceinline__ const char* a_ptr(const Unit& u) const { return IDG ? A : A + (size_t)u.pm * (size_t)(BM * kb); }
    __device__ __forceinline__ const char* b_ptr(const Unit& u) const { return Bt + (size_t)u.pn * (size_t)(BM * kb); }
    __device__ __forceinline__ void a_offs(const Unit& u, const int (&R)[2], const int (&C)[2], unsigned (&voff)[2][2]) const {
#pragma unroll
        for (int h = 0; h < 2; ++h)
#pragma unroll
            for (int i = 0; i < 2; ++i) voff[h][i] = (unsigned)(u.pm * BM + h * HALF + R[i]) * (unsigned)kb + (unsigned)C[i] * 2u;
    }
    __device__ __forceinline__ void a_raw(const Unit&, const int (&)[2], int (&)[2][2]) const {}
    __device__ __forceinline__ void a_fin(const Unit& u, const int (&R)[2], const int (&C)[2], const int (&)[2][2], unsigned (&voff)[2][2]) const { a_offs(u, R, C, voff); }
};
typedef DenseSchedT<false> DenseSched;
struct MoeSched {
    const char* A; const char* Bt; size_t b_estride; const int* rowtok; const volatile LAS int* cumblk; const volatile LAS int* cnt; int ncol_log2, G, c, kb; const volatile LAS int* ulist;
    __device__ __forceinline__ bool next(int i, Unit& u) const {
        const int v = ulist[i & 63]; if (v < 0) return false;
        u.pm = v >> 8; u.e = (v >> 3) & 31; u.pn = v & 7; return true;
    }
    __device__ __forceinline__ void build_list(volatile LAS int* dst, int tid) const {
        if (tid < 64) { Unit u; dst[tid] = search(tid, u) ? ((u.pm << 8) | (u.e << 3) | u.pn) : -1; }
    }
    __device__ __forceinline__ bool search(int i, Unit& u) const {
        int gb, pn; const int ncol = 1 << ncol_log2;
        if (G == 256 && MK_MOEMAP == 0) { const int xcd = c & 7, j = c >> 3, rpb = 256 >> ncol_log2; gb = i * rpb + xcd + 8 * (j >> ncol_log2); pn = j & (ncol - 1); }
        else { const long L = (long)i * G + c; gb = (int)(L >> ncol_log2); pn = (int)(L & (ncol - 1)); }
        const int tot = cumblk[NE]; if (gb >= tot) return false;
        int e = 0;
#pragma unroll 1
        for (int s = 16; s >= 1; s >>= 1) { if (cumblk[e + s] <= gb) e += s; }
        u.pm = gb; u.pn = pn; u.e = e; return true;
    }
    __device__ __forceinline__ const char* a_ptr(const Unit&) const { return A; }
    __device__ __forceinline__ const char* b_ptr(const Unit& u) const { return Bt + (size_t)u.e * b_estride + (size_t)u.pn * (size_t)(BM * kb); }
    __device__ __forceinline__ void a_raw(const Unit& u, const int (&R)[2], int (&raw)[2][2]) const {
        if (!rowtok) return;
        const int rb = u.pm - cumblk[u.e]; const int* rt = rowtok + (size_t)u.e * MT;
#pragma unroll
        for (int h = 0; h < 2; ++h)
#pragma unroll
            for (int i = 0; i < 2; ++i) { const int* ptr = rt + (rb * 256 + h * HALF + R[i]);
                asm volatile("global_load_dword %0, %1, off" : "=v"(raw[h][i]) : "v"(ptr) : "memory"); }
    }
    __device__ __forceinline__ void a_fin(const Unit& u, const int (&R)[2], const int (&C)[2], const int (&raw_)[2][2], unsigned (&voff)[2][2]) const {
        int raw[2][2] = {{raw_[0][0], raw_[0][1]}, {raw_[1][0], raw_[1][1]}};
        asm volatile("" : "+v"(raw[0][0]), "+v"(raw[0][1]), "+v"(raw[1][0]), "+v"(raw[1][1]));
        const int rb = u.pm - cumblk[u.e], n = cnt[u.e];
#pragma unroll
        for (int h = 0; h < 2; ++h)
#pragma unroll
            for (int i = 0; i < 2; ++i) { const int rank = rb * 256 + h * HALF + R[i]; const int tok = rowtok ? (rank < n ? raw[h][i] : 0) : u.pm * BM + h * HALF + R[i];
                voff[h][i] = (unsigned)tok * (unsigned)kb + (unsigned)C[i] * 2u; }
    }
    __device__ __forceinline__ void a_offs(const Unit& u, const int (&R)[2], const int (&C)[2], unsigned (&voff)[2][2]) const { int raw[2][2] = {{0, 0}, {0, 0}}; a_raw(u, R, raw); asm volatile("s_waitcnt vmcnt(0)" : "+v"(raw[0][0]), "+v"(raw[0][1]), "+v"(raw[1][0]), "+v"(raw[1][1]) :: "memory"); a_fin(u, R, C, raw, voff); }
};

typedef int v8i __attribute__((ext_vector_type(8)));
__device__ __forceinline__ v8i cat8(bf16x8 lo, bf16x8 hi) { const v4u a = __builtin_bit_cast(v4u, lo), b = __builtin_bit_cast(v4u, hi); return (v8i){(int)a.x, (int)a.y, (int)a.z, (int)a.w, (int)b.x, (int)b.y, (int)b.z, (int)b.w}; }
template <class Epi, class Sched, bool GATHER, bool FP8 = false, int XG = 0>
__device__ __forceinline__ void gemm_phase(LAS unsigned char* lds, const Sched& S, const Epi& E, int wave_id, bool skip_epi = false, unsigned stagger_ticks = 0u) {
    if (stagger_ticks && ((blockIdx.x >> 3) & 1u)) { const unsigned long long t0 = __builtin_amdgcn_s_memrealtime(); while (__builtin_amdgcn_s_memrealtime() - t0 < (unsigned long long)stagger_ticks) __builtin_amdgcn_s_sleep(8); }
    const int tid = opaque_tid(wave_id), wid = __builtin_amdgcn_readfirstlane(tid >> 6), lane = tid & 63, wr = wid >> 2, wc = wid & 3, fr = lane & 15, fq = lane >> 4;
    constexpr int KB = FP8 ? GK : GK * 2, nt = KB / (BK * 2);
    unsigned voffA[2][2], voffB[2]; int Rr[2], Cc[2];
#pragma unroll
    for (int i = 0; i < 2; ++i) { int R, C; stage_rc(tid * 16 + i * 8192, R, C); Rr[i] = R; Cc[i] = C; const int Rb = Epi::PERM ? ((R & ~31) + perm32(R & 31)) : R;
        voffA[0][i] = (unsigned)(R * KB + C * 2); voffA[1][i] = (unsigned)((R + HALF) * KB + C * 2); voffB[i] = (unsigned)(Rb * KB + C * 2); }
    constexpr size_t kstep = (size_t)(BK * 2);
    constexpr size_t hstep = (size_t)HALF * KB;
    const unsigned ldsw = (unsigned)wid * 1024u;
    const int aoff = lds_byte(wr * 64 + fr, fq * 8), boff = lds_byte(wc * 32 + fr, fq * 8);
    LAS unsigned char* abase = lds + aoff; LAS unsigned char* bbase = lds + 4 * HTB + boff; asm volatile("" : "+v"(abase), "+v"(bbase));
#define PG8_SA(b, h) (((b) * 2 + (h)) * HTB)
#define PG8_SB(b, h) ((4 + (b) * 2 + (h)) * HTB)
#define PG8_STAGE(bufoff, gbase, voff) do { if (XG == 3) break; _Pragma("unroll") for (int _i = 0; _i < 2; ++_i) \
        __builtin_amdgcn_global_load_lds((const unsigned*)((const char*)(gbase) + (voff)[_i]), (LAS unsigned*)(lds + (bufoff) + ldsw + _i * 8192), 16, 0, 0); } while (0)
#define PG8_STAGE_A(bufoff, gbase, h) PG8_STAGE(bufoff, gbase, voffA[h])
#define PG8_RDA(off) (*(const LAS v4u*)(abase + (off)))
#define PG8_RDB(off) (*(const LAS v4u*)(bbase + (off)))
#define PG8_LDA(dst, b, h) do { if (XG == 2) break; _Pragma("unroll") for (int m = 0; m < 4; ++m) { const v4u _l = PG8_RDA(PG8_SA(b, h) + m * 2048), _h = PG8_RDA(PG8_SA(b, h) + m * 2048 + 1024); \
        if constexpr (FP8) dst##8[m] = (v8i){(int)_l.x, (int)_l.y, (int)_l.z, (int)_l.w, (int)_h.x, (int)_h.y, (int)_h.z, (int)_h.w}; \
        else { dst[m][0] = __builtin_bit_cast(bf16x8, _l); dst[m][1] = __builtin_bit_cast(bf16x8, _h); } } } while (0)
#define PG8_LDB(dst, b, h) do { if (XG == 2) break; _Pragma("unroll") for (int n = 0; n < 2; ++n) { const v4u _l = PG8_RDB(PG8_SA(b, h) + n * 2048), _h = PG8_RDB(PG8_SA(b, h) + n * 2048 + 1024); \
        if constexpr (FP8) dst##8[n] = (v8i){(int)_l.x, (int)_l.y, (int)_l.z, (int)_l.w, (int)_h.x, (int)_h.y, (int)_h.z, (int)_h.w}; \
        else { dst[n][0] = __builtin_bit_cast(bf16x8, _l); dst[n][1] = __builtin_bit_cast(bf16x8, _h); } } } while (0)
#define PG8_MMA(ai, bj, At, Bt) do { if (XG == 1) break; __builtin_amdgcn_s_setprio(1); _Pragma("unroll") for (int m = 0; m < 4; ++m) _Pragma("unroll") for (int n = 0; n < 2; ++n) { \
        if constexpr (FP8) acc[ai][bj][m][n] = __builtin_amdgcn_mfma_scale_f32_16x16x128_f8f6f4(Bt##8[n], At##8[m], acc[ai][bj][m][n], 0, 0, 0, 0x7A7A7A7A, 0, 0x7F7F7F7F); \
        else { _Pragma("unroll") for (int k = 0; k < 2; ++k) acc[ai][bj][m][n] = __builtin_amdgcn_mfma_f32_16x16x32_bf16(Bt[n][k], At[m][k], acc[ai][bj][m][n], 0, 0, 0); } } \
        __builtin_amdgcn_s_setprio(0); } while (0)
#define PG8_WAIT_V(n) asm volatile("s_waitcnt vmcnt(" #n ")" ::: "memory")
#define PG8_WAIT_L(n) asm volatile("s_waitcnt lgkmcnt(" #n ")" ::: "memory")
#define PG8_BAR __builtin_amdgcn_s_barrier()
#define PG8_SCHED __builtin_amdgcn_sched_barrier(0)
    Unit cur, nxt; int ui = 0;
    if (!S.next(0, cur)) return;
    f32x4 acc[2][2][4][2];
#pragma unroll
    for (int a = 0; a < 2; ++a)
#pragma unroll
        for (int b = 0; b < 2; ++b)
#pragma unroll
            for (int m = 0; m < 4; ++m)
#pragma unroll
                for (int n = 0; n < 2; ++n) acc[a][b][m][n] = (f32x4){0.f, 0.f, 0.f, 0.f};
    bf16x8 At[4][2], B0[2][2], B1[2][2]; v8i At8[4], B08[2], B18[2];
    if constexpr (XG == 2) { _Pragma("unroll") for (int m = 0; m < 4; ++m) { asm volatile("" : "=v"(At8[m])); } _Pragma("unroll") for (int n = 0; n < 2; ++n) { asm volatile("" : "=v"(B08[n])); asm volatile("" : "=v"(B18[n])); } }
    const char* cA = S.a_ptr(cur); const char* cB = S.b_ptr(cur);
    if constexpr (GATHER) S.a_offs(cur, Rr, Cc, voffA);
    PG8_STAGE(PG8_SB(0, 0), cB, voffB); PG8_STAGE(PG8_SB(0, 1), cB + hstep, voffB); PG8_STAGE_A(PG8_SA(0, 0), cA, 0); PG8_STAGE_A(PG8_SA(0, 1), cA, 1);
    if (wr == 1) PG8_BAR;
    PG8_WAIT_V(2); PG8_BAR;
    PG8_STAGE(PG8_SB(1, 0), cB + kstep, voffB); PG8_STAGE_A(PG8_SA(1, 0), cA + kstep, 0); PG8_STAGE(PG8_SB(1, 1), cB + hstep + kstep, voffB);
    PG8_WAIT_V(6); PG8_BAR;
    for (;;) {
        const bool has_next = S.next(ui + 1, nxt);
        const char* nA = has_next ? S.a_ptr(nxt) : cA; const char* nB = has_next ? S.b_ptr(nxt) : cB;
        int rawN[2][2] = {{0, 0}, {0, 0}};
        if constexpr (GATHER) { if (has_next) S.a_raw(nxt, Rr, rawN); }
#pragma unroll 1
        for (int t = 0; t < nt; t += 2) {
            const bool last = (t == nt - 2);
            if constexpr (Epi::LDSBIAS) { if (last && wid == 0) E.stage_bias(cur, lane); }
            const char* a1 = cA + (size_t)(t + 1) * kstep;
            const char* a2 = last ? nA : cA + (size_t)(t + 2) * kstep; const char* b2 = last ? nB : cB + (size_t)(t + 2) * kstep;
            const char* a3 = a2 + kstep; const char* b3 = b2 + kstep;
            PG8_LDB(B0, 0, 0); PG8_LDB(B1, 0, 1); PG8_SCHED; PG8_LDA(At, 0, 0); PG8_STAGE_A(PG8_SA(1, 1), a1, 1);
            if constexpr (GATHER) { if (last && has_next) S.a_fin(nxt, Rr, Cc, rawN, voffA); }
            PG8_WAIT_V(8); PG8_WAIT_L(0); PG8_BAR; PG8_MMA(0, 0, At, B0); PG8_MMA(0, 1, At, B1); PG8_BAR; PG8_SCHED;
            PG8_LDA(At, 0, 1); PG8_STAGE(PG8_SB(0, 0), b2, voffB); PG8_STAGE(PG8_SB(0, 1), b2 + hstep, voffB); PG8_STAGE_A(PG8_SA(0, 0), a2, 0);
            PG8_WAIT_V(8); PG8_WAIT_L(0); PG8_BAR; PG8_MMA(1, 0, At, B0); PG8_MMA(1, 1, At, B1); PG8_BAR; PG8_SCHED;
            PG8_LDB(B0, 1, 0); PG8_LDB(B1, 1, 1); PG8_SCHED; PG8_LDA(At, 1, 0); PG8_STAGE_A(PG8_SA(0, 1), a2, 1);
            PG8_WAIT_V(8); PG8_WAIT_L(0); PG8_BAR; PG8_MMA(0, 0, At, B0); PG8_MMA(0, 1, At, B1); PG8_BAR; PG8_SCHED;
            PG8_LDA(At, 1, 1); PG8_STAGE(PG8_SB(1, 0), b3, voffB); PG8_STAGE(PG8_SB(1, 1), b3 + hstep, voffB); PG8_STAGE_A(PG8_SA(1, 0), a3, 0);
            PG8_WAIT_V(8); PG8_WAIT_L(0); PG8_BAR; PG8_MMA(1, 0, At, B0); PG8_MMA(1, 1, At, B1); PG8_BAR; PG8_SCHED;
        }
        if (wr == 0) PG8_BAR;
        if (!skip_epi) E(acc, cur, wr, wc, fr, fq);
        if (!has_next) break;
#pragma unroll
        for (int a = 0; a < 2; ++a)
#pragma unroll
            for (int b = 0; b < 2; ++b)
#pragma unroll
                for (int m = 0; m < 4; ++m)
#pragma unroll
                    for (int n = 0; n < 2; ++n) acc[a][b][m][n] = (f32x4){0.f, 0.f, 0.f, 0.f};
        cur = nxt; cA = nA; cB = nB; ++ui;
        if (wr == 1) PG8_BAR;
    }
    PG8_WAIT_V(0);
    PG8_BAR;
#undef PG8_SA
#undef PG8_SB
#undef PG8_STAGE
#undef PG8_STAGE_A
#undef PG8_LDA
#undef PG8_RDA
#undef PG8_RDB
#undef PG8_LDB
#undef PG8_MMA
#undef PG8_WAIT_V
#undef PG8_WAIT_L
#undef PG8_BAR
#undef PG8_SCHED
}
}
namespace pg8 {
__device__ __forceinline__ f32x2 gelu_pk(f32x2 v) {
    const f32x2 av = __builtin_elementwise_abs(v), d = av * 0.2316418882f + 1.0f;
    f32x2 t; t.x = __builtin_amdgcn_rcpf(d.x); t.y = __builtin_amdgcn_rcpf(d.y);
    f32x2 q = t * 0.5307027145f + (-0.7265760135f); q = q * t + 0.7107068705f; q = q * t + (-0.142248368f); q = q * t + 0.127414796f; q = q * t;
    const f32x2 s = (v * v) * (-0.72134752044f);
    f32x2 e; e.x = __builtin_amdgcn_exp2f(s.x); e.y = __builtin_amdgcn_exp2f(s.y);
    const f32x2 m = v * (q * e), r = v - m;
    f32x2 o; o.x = v.x < 0.f ? m.x : r.x; o.y = v.y < 0.f ? m.y : r.y; return o;
}
struct EpiBf16 {
    static constexpr bool PERM = true, LDSBIAS = false;
    bf16* O; int ldc; float* ss; int ACT;
    __device__ __forceinline__ void operator()(const f32x4 (&acc)[2][2][4][2], const Unit& u, int wr, int wc, int fr, int fq) const {
        const int row0 = u.pm * BM + wr * 64 + fr, col0 = u.pn * BM + wc * 32 + 8 * fq;
#pragma unroll
        for (int ai = 0; ai < 2; ++ai)
#pragma unroll
            for (int m = 0; m < 4; ++m) { const int row = row0 + ai * HALF + m * 16; bf16* rowp = O + (size_t)row * ldc + col0; float sq = 0.f;
#pragma unroll
                for (int bj = 0; bj < 2; ++bj) { f32x4 v0 = acc[ai][bj][m][0], v1 = acc[ai][bj][m][1];
                    if (ACT == 1) { f32x2 a = gelu_pk((f32x2){v0[0], v0[1]}), b = gelu_pk((f32x2){v0[2], v0[3]}), c = gelu_pk((f32x2){v1[0], v1[1]}), d = gelu_pk((f32x2){v1[2], v1[3]});
                        v0 = (f32x4){a.x, a.y, b.x, b.y}; v1 = (f32x4){c.x, c.y, d.x, d.y};
                        sq += (v0[0] * v0[0] + v0[1] * v0[1]) + (v0[2] * v0[2] + v0[3] * v0[3]) + (v1[0] * v1[0] + v1[1] * v1[1]) + (v1[2] * v1[2] + v1[3] * v1[3]); }
                    v4u w; w.x = cvt_pk_bf16(v0[0], v0[1]); w.y = cvt_pk_bf16(v0[2], v0[3]); w.z = cvt_pk_bf16(v1[0], v1[1]); w.w = cvt_pk_bf16(v1[2], v1[3]);
                    *(v4u*)(rowp + bj * HALF) = w; }
                if (ACT == 1) { const int ln = (fq << 4) | fr; sq += shx(sq, 16, ln); sq += shx(sq, 32, ln);
                    if (u.pn >= 4 && fq == 0) ss[(size_t)row * 16 + (u.pn - 4) * 4 + wc] = sq; }
            }
    }
};
struct EpiResid {
    static constexpr bool PERM = false, LDSBIAS = false;
    bf16* xb; const float* modl;
    __device__ __forceinline__ void operator()(const f32x4 (&acc)[2][2][4][2], const Unit& u, int wr, int wc, int fr, int fq) const {
        const bool lat = u.pm < ML / BM; const int bidx = lat ? (u.pm >> 5) : 8;
        bf16* base = xb + (size_t)u.pm * BM * D;
        const float* g = modl + bidx * 6144 + 2 * 1024;
        const int r0 = wr * 64 + fr, col0 = u.pn * BM + wc * 32 + 4 * fq;
        f32x4 gv[2][2];
#pragma unroll
        for (int bj = 0; bj < 2; ++bj)
#pragma unroll
            for (int n = 0; n < 2; ++n) gv[bj][n] = *(const f32x4*)(g + col0 + bj * HALF + n * 16);
        const int odd = fq & 1, colp = col0 - 4 * odd;
#pragma unroll
        for (int ai = 0; ai < 2; ++ai) { v4u bs[2][2][2];
#pragma unroll
            for (int mp = 0; mp < 2; ++mp) { const size_t off = (size_t)(r0 + ai * HALF + (2 * mp + odd) * 16) * D + colp;
#pragma unroll
                for (int bj = 0; bj < 2; ++bj)
#pragma unroll
                    for (int n = 0; n < 2; ++n) bs[mp][bj][n] = *(const v4u*)(base + off + bj * HALF + n * 16); }
#pragma unroll
            for (int mp = 0; mp < 2; ++mp) { const size_t off = (size_t)(r0 + ai * HALF + (2 * mp + odd) * 16) * D + colp;
#pragma unroll
                for (int bj = 0; bj < 2; ++bj)
#pragma unroll
                    for (int n = 0; n < 2; ++n) { const v4u L = bs[mp][bj][n];
                        const auto s0 = __builtin_amdgcn_permlane16_swap(L.x, L.z, false, false), s1 = __builtin_amdgcn_permlane16_swap(L.y, L.w, false, false);
                        const f32x4 va = bf4_f32((v2u){s0[0], s1[0]}) + gv[bj][n] * acc[ai][bj][2 * mp][n], vb = bf4_f32((v2u){s0[1], s1[1]}) + gv[bj][n] * acc[ai][bj][2 * mp + 1][n];
                        const auto t0 = __builtin_amdgcn_permlane16_swap(cvt_pk_bf16(va.x, va.y), cvt_pk_bf16(vb.x, vb.y), false, false), t1 = __builtin_amdgcn_permlane16_swap(cvt_pk_bf16(va.z, va.w), cvt_pk_bf16(vb.z, vb.w), false, false);
                        *(v4u*)(base + off + bj * HALF + n * 16) = (v4u){t0[0], t1[0], t0[1], t1[1]}; } }
            asm volatile("" ::: "memory"); }
    }
};
struct EpiSwiglu {
    static constexpr bool PERM = true, LDSBIAS = true;
    unsigned char* O; const float* b1; LAS float* bl;
    __device__ __forceinline__ void stage_bias(const Unit& u, int lane) const { const float* src = b1 + (size_t)u.e * 2048 + (lane < 32 ? u.pn * HALF + 4 * lane : 1024 + u.pn * HALF + 4 * (lane - 32));
        __builtin_amdgcn_global_load_lds((const unsigned*)src, (LAS unsigned*)bl, 16, 0, 0); }
    __device__ __forceinline__ void operator()(const f32x4 (&acc)[2][2][4][2], const Unit& u, int wr, int wc, int fr, int fq) const {
        const int row0 = u.pm * BM + wr * 64 + fr, cl = wc * 32 + 8 * fq, c0 = u.pn * HALF + cl;
        f32x4 bg[2], bli[2];
#pragma unroll
        for (int n = 0; n < 2; ++n) { bg[n] = *(const LAS f32x4*)(bl + cl + 4 * n); bli[n] = *(const LAS f32x4*)(bl + 128 + cl + 4 * n) + 1.0f; }
#pragma unroll
        for (int ai = 0; ai < 2; ++ai)
#pragma unroll
            for (int mp = 0; mp < 4; mp += 2) { v2u wv[2];
#pragma unroll
              for (int mm = 0; mm < 2; ++mm) { const int m = mp + mm; float o[8];
#pragma unroll
                for (int n = 0; n < 2; ++n)
#pragma unroll
                    for (int j = 0; j < 4; ++j) { const float gl = fminf(acc[ai][0][m][n][j] + bg[n][j], 7.0f), lp = __builtin_amdgcn_fmed3f(acc[ai][1][m][n][j] + bli[n][j], -6.0f, 8.0f);
                        const float sg = __builtin_amdgcn_rcpf(1.0f + __builtin_amdgcn_exp2f(gl * (-1.702f * 1.4426950408889634f)));
                        o[n * 4 + j] = gl * sg * lp; }
                v2u w; w.x = 0; w.y = 0;
                w.x = __builtin_amdgcn_cvt_pk_fp8_f32(o[0], o[1], w.x, false); w.x = __builtin_amdgcn_cvt_pk_fp8_f32(o[2], o[3], w.x, true);
                w.y = __builtin_amdgcn_cvt_pk_fp8_f32(o[4], o[5], w.y, false); w.y = __builtin_amdgcn_cvt_pk_fp8_f32(o[6], o[7], w.y, true);
                wv[mm] = w; }
              const auto sx = __builtin_amdgcn_permlane16_swap(wv[0].x, wv[1].x, false, false), sy = __builtin_amdgcn_permlane16_swap(wv[0].y, wv[1].y, false, false);
              *(v4u*)(O + (size_t)(row0 + ai * HALF + (mp + (fq & 1)) * 16) * D + (c0 - 8 * (fq & 1))) = (v4u){sx[0], sy[0], sx[1], sy[1]}; }
    }
};
struct EpiBias {
    static constexpr bool PERM = true, LDSBIAS = true;
    unsigned char* O; const float* b2; LAS float* bl;
    __device__ __forceinline__ void stage_bias(const Unit& u, int lane) const { __builtin_amdgcn_global_load_lds((const unsigned*)(b2 + (size_t)u.e * 1024 + u.pn * BM + 4 * lane), (LAS unsigned*)bl, 16, 0, 0); }
    __device__ __forceinline__ void operator()(const f32x4 (&acc)[2][2][4][2], const Unit& u, int wr, int wc, int fr, int fq) const {
        const int row0 = u.pm * BM + wr * 64 + fr, cl = wc * 32 + 8 * fq, col0 = u.pn * BM + cl;
#pragma unroll
        for (int bj = 0; bj < 2; ++bj) { const f32x4 bv0 = *(const LAS f32x4*)(bl + cl + bj * HALF), bv1 = *(const LAS f32x4*)(bl + cl + bj * HALF + 4);
#pragma unroll
            for (int ai = 0; ai < 2; ++ai)
#pragma unroll
                for (int mp = 0; mp < 4; mp += 2) { v2u wv[2];
#pragma unroll
                    for (int mm = 0; mm < 2; ++mm) { const int m = mp + mm; const f32x4 v0 = acc[ai][bj][m][0] + bv0, v1 = acc[ai][bj][m][1] + bv1;
                        v2u w; w.x = 0; w.y = 0;
                        w.x = __builtin_amdgcn_cvt_pk_fp8_f32(v0[0], v0[1], w.x, false); w.x = __builtin_amdgcn_cvt_pk_fp8_f32(v0[2], v0[3], w.x, true);
                        w.y = __builtin_amdgcn_cvt_pk_fp8_f32(v1[0], v1[1], w.y, false); w.y = __builtin_amdgcn_cvt_pk_fp8_f32(v1[2], v1[3], w.y, true);
                        wv[mm] = w; }
                    const auto sx = __builtin_amdgcn_permlane16_swap(wv[0].x, wv[1].x, false, false), sy = __builtin_amdgcn_permlane16_swap(wv[0].y, wv[1].y, false, false);
                    *(v4u*)(O + (size_t)(row0 + ai * HALF + (mp + (fq & 1)) * 16) * D + (col0 - 8 * (fq & 1)) + bj * HALF) = (v4u){sx[0], sy[0], sx[1], sy[1]}; }
            asm volatile("" ::: "memory"); }
    }
};
}

namespace att {
constexpr int AD = 128, NW = 8, QBLK = 32, KVBLK = 64;
constexpr float SCALE = 0.088388347648318440f;
constexpr int LDO = 1024;
constexpr int SHM_V = AD * KVBLK, SHM_K = KVBLK * AD, SHM_ATTN = 4 * SHM_V + 4 * SHM_K;
typedef int v8i __attribute__((ext_vector_type(8)));
#define K8SW(key, c) ((key) * 128 + ((((c) ^ (((key) >> 1) & 7))) << 4))
#define V8SW(d, c) ((d) * 64 + ((((c) ^ (((d) >> 2) & 3))) << 4))
#define SBAR() __builtin_amdgcn_sched_barrier(0)
__device__ __forceinline__ int crow(int r, int hi) { return (r & 3) + 8 * (r >> 2) + 4 * hi; }
template <int XV = 0>
__device__ __forceinline__ int exp4(float a0, float a1, float a2, float a3) {
  float t0 = fminf(a0 + 8.0f, 8.0f), t1 = fminf(a1 + 8.0f, 8.0f), t2 = fminf(a2 + 8.0f, 8.0f), t3 = fminf(a3 + 8.0f, 8.0f); int w;
  asm volatile("v_exp_f32 %1, %1\n\tv_exp_f32 %2, %2\n\tv_exp_f32 %3, %3\n\tv_exp_f32 %4, %4\n\t"
               "v_cvt_pk_fp8_f32 %0, %1, %2\n\ts_nop 0\n\tv_cvt_pk_fp8_f32 %0, %3, %4 op_sel:[0,0,1]"
               : "=&v"(w), "+v"(t0), "+v"(t1), "+v"(t2), "+v"(t3));
  return w;
}
template <int PAD>
__device__ __forceinline__ int expc4(float a0, float a1, float a2, float a3) {
  int w; float t0, t1, t2, t3;
  if constexpr (PAD != 0)
    asm volatile("s_nop 5\n\tv_exp_f32_e64 %1, %5 clamp\n\tv_exp_f32_e64 %2, %6 clamp\n\tv_exp_f32_e64 %3, %7 clamp\n\tv_exp_f32_e64 %4, %8 clamp\n\t"
                 "v_cvt_scalef32_pk_fp8_f32 %0, %1, %2, %9\n\ts_nop 0\n\tv_cvt_scalef32_pk_fp8_f32 %0, %3, %4, %9 op_sel:[0,0,0,1]"
                 : "=&v"(w), "=&v"(t0), "=&v"(t1), "=&v"(t2), "=&v"(t3) : "v"(a0), "v"(a1), "v"(a2), "v"(a3), "s"(0x3B800000));
  else
    asm volatile("v_exp_f32_e64 %1, %5 clamp\n\tv_exp_f32_e64 %2, %6 clamp\n\tv_exp_f32_e64 %3, %7 clamp\n\tv_exp_f32_e64 %4, %8 clamp\n\t"
                 "v_cvt_scalef32_pk_fp8_f32 %0, %1, %2, %9\n\ts_nop 0\n\tv_cvt_scalef32_pk_fp8_f32 %0, %3, %4, %9 op_sel:[0,0,0,1]"
                 : "=&v"(w), "=&v"(t0), "=&v"(t1), "=&v"(t2), "=&v"(t3) : "v"(a0), "v"(a1), "v"(a2), "v"(a3), "s"(0x3B800000));
  return w;
}
#define EXC4(P, m, PAD) expc4<PAD>(P[4 * (m)], P[4 * (m) + 1], P[4 * (m) + 2], P[4 * (m) + 3])
typedef int v4i __attribute__((ext_vector_type(4)));
__device__ __forceinline__ void partialSM(const f32x16& p0, float nb, v4i& plo) {
#pragma unroll
  for (int m = 0; m < 4; ++m) plo[m] = exp4(p0[4 * m], p0[4 * m + 1], p0[4 * m + 2], p0[4 * m + 3]);
}
__device__ __forceinline__ void finishSM(const f32x16& p1, float nb, const v4i& plo, v8i& pa) {
  v4i phi;
#pragma unroll
  for (int m = 0; m < 4; ++m) phi[m] = exp4(p1[4 * m], p1[4 * m + 1], p1[4 * m + 2], p1[4 * m + 3]);
  pa = (v8i){plo[0], plo[1], plo[2], plo[3], phi[0], phi[1], phi[2], phi[3]};
}
__device__ __forceinline__ void qkt(f32x16& p0, f32x16& p1, const char* Ks, const v8i* q8, int r32, int hi, const f32x16& NBV) {
  p0 = NBV; p1 = NBV;
#pragma unroll
  for (int s = 0; s < 2; ++s) { const int c0 = 4 * s + 2 * hi;
    const v4u a0 = *reinterpret_cast<const v4u*>(Ks + K8SW(r32, c0)), a1 = *reinterpret_cast<const v4u*>(Ks + K8SW(r32, c0 + 1));
    const v4u b0 = *reinterpret_cast<const v4u*>(Ks + K8SW(32 + r32, c0)), b1 = *reinterpret_cast<const v4u*>(Ks + K8SW(32 + r32, c0 + 1));
    const v8i A0 = (v8i){(int)a0.x, (int)a0.y, (int)a0.z, (int)a0.w, (int)a1.x, (int)a1.y, (int)a1.z, (int)a1.w};
    const v8i A1 = (v8i){(int)b0.x, (int)b0.y, (int)b0.z, (int)b0.w, (int)b1.x, (int)b1.y, (int)b1.z, (int)b1.w};
    p0 = __builtin_amdgcn_mfma_scale_f32_32x32x64_f8f6f4(A0, q8[s], p0, 0, 0, 0, 0x7F7F7F7F, 0, 0x7C7C7C7C);
    p1 = __builtin_amdgcn_mfma_scale_f32_32x32x64_f8f6f4(A1, q8[s], p1, 0, 0, 0, 0x7F7F7F7F, 0, 0x7C7C7C7C); }
}
__device__ __forceinline__ void pv_d0(f32x16* o, f32x16& lacc, const char* Vs, v8i pa, int r32, int hi) {
  { const int one = 0x38383838; const v8i ONES = (v8i){one, one, one, one, one, one, one, one};
    lacc = __builtin_amdgcn_mfma_scale_f32_32x32x64_f8f6f4(pa, ONES, lacc, 0, 0, 0, 0x7F7F7F7F, 0, 0x7F7F7F7F); }
#pragma unroll
  for (int d0 = 0; d0 < 4; ++d0) { const int d = 32 * d0 + r32;
    const v4u b0 = *reinterpret_cast<const v4u*>(Vs + V8SW(d, 2 * hi)), b1 = *reinterpret_cast<const v4u*>(Vs + V8SW(d, 2 * hi + 1));
    const v8i B = (v8i){(int)b0.x, (int)b0.y, (int)b0.z, (int)b0.w, (int)b1.x, (int)b1.y, (int)b1.z, (int)b1.w};
    o[d0] = __builtin_amdgcn_mfma_scale_f32_32x32x64_f8f6f4(pa, B, o[d0], 0, 0, 0, 0x7F7F7F7F, 0, 0x7F7F7F7F); }
}
__device__ __forceinline__ v8i lds32(const char* p0, const char* p1) { const v4u a = *reinterpret_cast<const v4u*>(p0), b = *reinterpret_cast<const v4u*>(p1);
  return (v8i){(int)a.x, (int)a.y, (int)a.z, (int)a.w, (int)b.x, (int)b.y, (int)b.z, (int)b.w}; }
#define MF8(A, B, C, SB) ((XV == 3 || XV == 4 || XV == 5 || XV == 9) ? (C) : __builtin_amdgcn_mfma_scale_f32_32x32x64_f8f6f4(A, B, C, 0, 0, 0, 0x7F7F7F7F, 0, SB))
#define EX4(P, m) exp4<XV>(P[4 * (m)], P[4 * (m) + 1], P[4 * (m) + 2], P[4 * (m) + 3])
template <int XV = 0>
__device__ __forceinline__ void tile_step(f32x16& pN0, f32x16& pN1, const f32x16& pP1, const v4i& ploP, v4i& ploN, f32x16* o, f32x16& lacc,
                                          const char* Ks, const char* Vs, const v8i* q8, int r32, int hi, const f32x16& Z) {
  const int one = 0x38383838; const v8i ONES = (v8i){one, one, one, one, one, one, one, one};
  v4i phi;
  const v8i A00 = lds32(Ks + K8SW(r32, 2 * hi), Ks + K8SW(r32, 2 * hi + 1)), A10 = lds32(Ks + K8SW(32 + r32, 2 * hi), Ks + K8SW(32 + r32, 2 * hi + 1));
  const v8i A01 = lds32(Ks + K8SW(r32, 4 + 2 * hi), Ks + K8SW(r32, 4 + 2 * hi + 1)), A11 = lds32(Ks + K8SW(32 + r32, 4 + 2 * hi), Ks + K8SW(32 + r32, 4 + 2 * hi + 1));
  phi[0] = EXC4(pP1, 0, 0); SBAR();
  pN0 = MF8(A00, q8[0], Z, 0x7C7C7C7C);   SBAR(); const v8i V0 = lds32(Vs + V8SW(r32, 2 * hi), Vs + V8SW(r32, 2 * hi + 1));           phi[1] = EXC4(pP1, 1, 0); SBAR();
  pN0 = MF8(A01, q8[1], pN0, 0x7C7C7C7C); SBAR(); const v8i V1 = lds32(Vs + V8SW(32 + r32, 2 * hi), Vs + V8SW(32 + r32, 2 * hi + 1)); phi[2] = EXC4(pP1, 2, 0); SBAR();
  pN1 = MF8(A10, q8[0], Z, 0x7C7C7C7C);   SBAR(); const v8i V2 = lds32(Vs + V8SW(64 + r32, 2 * hi), Vs + V8SW(64 + r32, 2 * hi + 1)); phi[3] = EXC4(pP1, 3, 0); SBAR();
  pN1 = MF8(A11, q8[1], pN1, 0x7C7C7C7C); SBAR(); const v8i V3 = lds32(Vs + V8SW(96 + r32, 2 * hi), Vs + V8SW(96 + r32, 2 * hi + 1)); SBAR();
  const v8i pa = (v8i){ploP[0], ploP[1], ploP[2], ploP[3], phi[0], phi[1], phi[2], phi[3]};
  lacc = MF8(pa, ONES, lacc, 0x7F7F7F7F); SBAR(); ploN[0] = EXC4(pN0, 0, 1); SBAR();
  o[0] = MF8(pa, V0, o[0], 0x7F7F7F7F);   SBAR(); ploN[1] = EXC4(pN0, 1, 0); SBAR();
  o[1] = MF8(pa, V1, o[1], 0x7F7F7F7F);   SBAR(); ploN[2] = EXC4(pN0, 2, 0); SBAR();
  o[2] = MF8(pa, V2, o[2], 0x7F7F7F7F);   SBAR(); ploN[3] = EXC4(pN0, 3, 0); SBAR();
  o[3] = MF8(pa, V3, o[3], 0x7F7F7F7F);   SBAR();
}
template <int XV = 0>
__device__ __forceinline__ void attn_dense_body(const unsigned char* __restrict__ Q8, const unsigned char* __restrict__ K8, const unsigned char* __restrict__ VT, int vt_ld, bf16* __restrict__ Ob, int seq, char* lds, int wave_id, float nb) {
  const int tid = opaque_tid(wave_id), wid = tid >> 6, lane = tid & 63, r32 = lane & 31, hi = lane >> 5;
  char* V_lds = lds; char* K_lds = lds + 4 * SHM_V;
  f32x16 lacc = {}; f32x16 o[4] = {}; v8i qr[2]; f32x16 NBV;
#pragma unroll
  for (int i = 0; i < 16; ++i) NBV[i] = nb;
  { const unsigned char* Qw = Q8 + (long)(wid * QBLK + r32) * 1024 + hi * 32;
#pragma unroll
    for (int s2 = 0; s2 < 2; ++s2) { const v4u a = *reinterpret_cast<const v4u*>(Qw + 64 * s2), b = *reinterpret_cast<const v4u*>(Qw + 64 * s2 + 16);
      qr[s2] = (v8i){(int)a.x, (int)a.y, (int)a.z, (int)a.w, (int)b.x, (int)b.y, (int)b.z, (int)b.w}; } }
  struct { v4u vs, ks; } sr_[1];
  const int kkey = tid >> 3, kch = tid & 7; const unsigned koff = (unsigned)(kkey * 256 + kch * 16); const int kst = K8SW(kkey, kch);
  const int vd = tid >> 2, vc = tid & 3; const unsigned voff = (unsigned)(vd * vt_ld + vc * 16); const int vst = V8SW(vd, vc);
#define SLOAD(i, k0) do { if (XV >= 7) break; sr_[i].vs = *reinterpret_cast<const v4u*>((const char*)VT + (size_t)(k0) + voff); \
    sr_[i].ks = *reinterpret_cast<const v4u*>((const char*)K8 + (size_t)(k0) * 256 + koff); } while (0)
#define SWRITE(b, i) do { *(v4u*)(V_lds + (b) * SHM_V + vst) = sr_[i].vs; *(v4u*)(K_lds + (b) * SHM_K + kst) = sr_[i].ks; } while (0)
#define SWAIT() asm volatile("s_waitcnt vmcnt(0)" ::: "memory")
#define TBAR() asm volatile("s_waitcnt lgkmcnt(0)\n\ts_barrier" ::: "memory")
  f32x16 pA0, pA1, pB0, pB1; v8i pa; v4i plA, plB; const int NT = seq / KVBLK;
  SLOAD(0, 0); SWAIT(); SWRITE(0, 0); SLOAD(0, KVBLK); TBAR();
  qkt(pA0, pA1, K_lds, qr, r32, hi, NBV); partialSM(pA0, nb, plA);
  SWAIT(); SWRITE(1, 0); SLOAD(0, 2 * KVBLK); TBAR();
#define STEP_IO(t, SW) do { SWAIT(); SWRITE(SW, 0); { const int tn = (t) + 2 < NT ? (t) + 2 : NT - 1; SLOAD(0, tn * KVBLK); } SBAR(); } while (0)
#define STEP_B(t, SK, SV, SW) do { STEP_IO(t, SW); tile_step<XV>(pB0, pB1, pA1, plA, plB, o, lacc, K_lds + (SK) * SHM_K, V_lds + (SV) * SHM_V, qr, r32, hi, NBV); TBAR(); } while (0)
#define STEP_A(t, SK, SV, SW) do { STEP_IO(t, SW); tile_step<XV>(pA0, pA1, pB1, plB, plA, o, lacc, K_lds + (SK) * SHM_K, V_lds + (SV) * SHM_V, qr, r32, hi, NBV); TBAR(); } while (0)
  int j = 1;
  for (; j + 5 < NT; j += 4) { STEP_B(j, 1, 0, 2); STEP_A(j + 1, 2, 1, 3); STEP_B(j + 2, 3, 2, 0); STEP_A(j + 3, 0, 3, 1); }
  STEP_B(j, 1, 0, 2); STEP_A(j + 1, 2, 1, 3);
  SBAR(); qkt(pB0, pB1, K_lds + 3 * SHM_K, qr, r32, hi, NBV);
  finishSM(pA1, nb, plA, pa); SBAR();
  pv_d0(o, lacc, V_lds + 2 * SHM_V, pa, r32, hi); partialSM(pB0, nb, plB);
  finishSM(pB1, nb, plB, pa); SBAR();
  pv_d0(o, lacc, V_lds + 3 * SHM_V, pa, r32, hi);
  { const int ln2 = opaque_tid(wave_id) & 63, r32e = ln2 & 31, hie = ln2 >> 5;
    bf16* Ow = Ob + (long)(wid * QBLK) * LDO;
#pragma unroll
    for (int r = 0; r < 16; ++r) { const int orow = crow(r, hie); const float rl = __builtin_amdgcn_rcpf(lacc[r]);
      for (int d0 = 0; d0 < 4; ++d0) Ow[(long)orow * LDO + d0 * 32 + r32e] = (bf16)f2bf(o[d0][r] * rl); } }
  __syncthreads();
#undef SLOAD
#undef TBAR
#undef STEP_IO
#undef STEP_A
#undef STEP_B
#undef SWRITE
#undef SWAIT
}
#undef K8SW
#undef V8SW
}
constexpr int NWAVES = 8, NTHREADS = 512;
struct Args { const float* in[36]; float* out; unsigned char* ws; int ph_lo, ph_hi; };
enum InIdx { I_X = 0, I_C, I_CTX, I_CCTX, I_ADAW, I_ADAB, I_N1G, I_N2G, I_WOUT, I_RW, I_RB, I_EW1, I_EB1, I_EW2, I_EB2, I_AWIN, I_AQG, I_AKG,
             I_GWIN, I_GVG, I_GWS, I_GBS, I_HWIN, I_HCW, I_HCB, I_FW1, I_FB1, I_FW2, I_FB2, I_FW3, I_FB3, I_FW4, I_FB4, I_FREQ, I_HD, I_FG };
struct Frame {
    LAS unsigned char* lds; volatile LAS unsigned* MISC; gu32* ctl;
    int tid, lane, wave, G, bx;
    float* out; unsigned char* ws;
};
template <class T> __device__ __forceinline__ T* launder(T* p) { unsigned long long v = (unsigned long long)p; asm volatile("" : "+s"(v)); return (T*)(GAS T*)v; }
constexpr int MW_PTRS = 640;
__device__ __forceinline__ const float* pin_load(const Frame& F, int i) {
    const unsigned lo = __builtin_amdgcn_readfirstlane(F.MISC[MW_PTRS + 2 * i]), hi = __builtin_amdgcn_readfirstlane(F.MISC[MW_PTRS + 2 * i + 1]);
    return (const float*)(GAS const float*)(((unsigned long long)hi << 32) | lo);
}
#define PIN(F, i) pin_load(F, i)
__device__ __forceinline__ Frame phase_frame(const Frame& F0) {
    Frame F = F0; F.tid = opaque_tid(F0.wave); F.lane = F.tid & 63; F.wave = F0.wave;
    F.ws = launder(F0.ws); F.out = launder(F0.out); F.ctl = (gu32*)(F.ws + WS_CTL);
    { LAS unsigned char* l = F0.lds; asm volatile("" : "+s"(l)); F.lds = l; F.MISC = (volatile LAS unsigned*)(l + MISC_OFF); }
    return F;
}
constexpr int PH_PRO0 = 0, PH_PRO1 = 1, PH_L0 = 2, PH_PER_LAYER = 9, PH_FINAL = PH_L0 + NLAYER * PH_PER_LAYER, PH_COUNT = PH_FINAL + 1;
enum LPhase { LP_NORM1 = 0, LP_INPROJ, LP_MIX1, LP_MIX2, LP_MIX3, LP_OUTPROJ, LP_NORM2, LP_MOE1, LP_MOE2 };

struct TItem { const float* src; unsigned char* dst; int N; bool fp8; };
__device__ __forceinline__ TItem titem_decode(Frame& F, int it) {
    constexpr int R0 = 128 * 512, R1 = 128 * 256, R2 = 2 * 384, R3 = 512, R4 = 768;
    int r = it; TItem t;
    if (r < R0) { const int mi = r >> 9, q = r & 511, kb = q >> 5, nb = q & 31, n0 = nb * 64;
        const int d0 = n0 < 1024 ? 256 * (n0 >> 7) + (n0 & 127) : 256 * ((n0 - 1024) >> 7) + 128 + (n0 & 127);
        t.src = PIN(F, I_EW1) + (size_t)mi * 1024 * 2048 + (size_t)(kb * 64) * 2048 + n0; t.N = 2048; t.fp8 = true; t.dst = F.ws + WS_WE1 + (size_t)mi * 2048 * 1024 + (size_t)d0 * 1024 + kb * 64; return t; } r -= R0;
    if (r < R1) { const int mi = r >> 8, q = r & 255, kb = q >> 4, nb = q & 15;
        t.src = PIN(F, I_EW2) + (size_t)mi * 1024 * 1024 + (size_t)(kb * 64) * 1024 + nb * 64; t.N = 1024; t.fp8 = true; t.dst = F.ws + WS_WE2 + (size_t)mi * 1024 * 1024 + (size_t)(nb * 64) * 1024 + kb * 64; return t; } r -= R1;
    if (r < R2) { const int mi = r / 384, q = r % 384, kb = q / 24, nb = q % 24;
        t.src = PIN(F, I_AWIN) + (size_t)mi * 1024 * 1536 + (size_t)(kb * 64) * 1536 + nb * 64; t.N = 1536; t.fp8 = true; t.dst = F.ws + WS_WATT + (size_t)mi * 1536 * 1024 + (size_t)(nb * 64) * 1024 + kb * 64; return t; } r -= R2;
    if (r < R3) { const int kb = r >> 5, nb = r & 31;
        t.src = PIN(F, I_GWIN) + (size_t)(kb * 64) * 2048 + nb * 64; t.N = 2048; t.fp8 = false; t.dst = F.ws + WS_WGM + ((size_t)(nb * 64) * 1024 + kb * 64) * 2; return t; } r -= R3;
    if (r < R4) { const int kb = r / 48, nb = r % 48;
        t.src = PIN(F, I_HWIN) + (size_t)(kb * 64) * 3072 + nb * 64; t.N = 3072; t.fp8 = true; t.dst = F.ws + WS_WHY + (size_t)(nb * 64) * 1024 + kb * 64; return t; } r -= R4;
    { const int mi = r >> 8, q = r & 255, kb = q >> 4, nb = q & 15;
        t.src = PIN(F, I_WOUT) + (size_t)mi * 1024 * 1024 + (size_t)(kb * 64) * 1024 + nb * 64; t.N = 1024; t.fp8 = false; t.dst = F.ws + WS_WOUT + ((size_t)mi * 1024 * 1024 + (size_t)(nb * 64) * 1024 + kb * 64) * 2; return t; }
}
__device__ __forceinline__ void titem_load(const TItem& t, float (&v)[64], int lane) {
    const float* src = t.src + lane;
#pragma unroll
    for (int kk = 0; kk < 64; ++kk) v[kk] = src[(size_t)kk * t.N];
}
__device__ __forceinline__ void titem_finish(const TItem& t, const float (&v)[64], LAS float* scr, int lane) {
    constexpr int K = 1024;
#pragma unroll
    for (int kk = 0; kk < 64; ++kk) scr[kk * 65 + lane] = v[kk];
    LDS_WAIT(); asm volatile("" ::: "memory");
    if (!t.fp8) {
        const int c = lane & 7;
#pragma unroll
        for (int j = 0; j < 8; ++j) { const int n = (lane >> 3) + 8 * j; const LAS float* s = scr + (8 * c) * 65 + n;
            v4u o; o.x = pk2(s[0 * 65], s[1 * 65]); o.y = pk2(s[2 * 65], s[3 * 65]); o.z = pk2(s[4 * 65], s[5 * 65]); o.w = pk2(s[6 * 65], s[7 * 65]);
            *(GAS v4u*)(t.dst + ((size_t)n * K + 8 * c) * 2) = o; }
    } else {
        const int c = lane & 3;
#pragma unroll
        for (int j = 0; j < 4; ++j) { const int n = (lane >> 2) + 16 * j; const LAS float* s = scr + (16 * c) * 65 + n; unsigned w[4];
#pragma unroll
            for (int q = 0; q < 4; ++q) { unsigned x = 0; x = __builtin_amdgcn_cvt_pk_fp8_f32(32.0f * s[(4 * q) * 65], 32.0f * s[(4 * q + 1) * 65], x, false);
                x = __builtin_amdgcn_cvt_pk_fp8_f32(32.0f * s[(4 * q + 2) * 65], 32.0f * s[(4 * q + 3) * 65], x, true); w[q] = x; }
            *(GAS v4u*)(t.dst + (size_t)n * K + 16 * c) = (v4u){w[0], w[1], w[2], w[3]}; }
    }
    LDS_WAIT(); asm volatile("" ::: "memory");
}
__device__ __forceinline__ void pro0_transposes(Frame& F) {
    LAS float* scr = (LAS float*)(F.lds + F.wave * 16640);
    const int gw = F.bx * NWAVES + F.wave, NGW = F.G * NWAVES;
    constexpr int NITEMS = 128 * 512 + 128 * 256 + 2 * 384 + 512 + 768 + 4 * 256;
    float va[64], vb[64];
    int it = gw; if (it >= NITEMS) return;
    TItem ta = titem_decode(F, it), tb = ta; titem_load(ta, va, F.lane);
    for (;;) {
        const bool nb_ok = it + NGW < NITEMS; if (nb_ok) { tb = titem_decode(F, it + NGW); titem_load(tb, vb, F.lane); }
        titem_finish(ta, va, scr, F.lane);
        if (!nb_ok) break; it += NGW;
        const bool na_ok = it + NGW < NITEMS; if (na_ok) { ta = titem_decode(F, it + NGW); titem_load(ta, va, F.lane); }
        titem_finish(tb, vb, scr, F.lane);
        if (!na_ok) break; it += NGW;
    }
}
__device__ __forceinline__ void pro0_mod(Frame& F) {
    LAS float* sl = (LAS float*)F.lds;
    LAS float* red = (LAS float*)(F.lds + 65536);
    __syncthreads();
    for (int i = F.tid; i < 9 * 1024; i += NTHREADS) { const int r = i >> 10, k = i & 1023; const float v = r < 8 ? PIN(F, I_C)[r * 1024 + k] : PIN(F, I_CCTX)[k]; sl[i] = v / (1.0f + __expf(-v)); }
    __syncthreads();
    float* MOD = (float*)(F.ws + WS_MOD);
    for (int item = F.bx; item < NLAYER * 96; item += F.G) {
        const int l = item / 96, n0 = (item % 96) * 64;
        const float* W = PIN(F, I_ADAW) + (size_t)l * 1024 * 6144 + n0 + F.lane;
        float acc[9];
#pragma unroll
        for (int r = 0; r < 9; ++r) acc[r] = 0.f;
        const int kb = F.wave * 128;
#pragma unroll 16
        for (int k = 0; k < 128; ++k) { const float wv = W[(size_t)(kb + k) * 6144];
#pragma unroll
            for (int r = 0; r < 9; ++r) acc[r] += sl[r * 1024 + kb + k] * wv; }
#pragma unroll
        for (int r = 0; r < 9; ++r) red[(F.wave * 9 + r) * 64 + F.lane] = acc[r];
        __syncthreads();
        for (int i = F.tid; i < 9 * 64; i += NTHREADS) { const int r = i >> 6, n = i & 63; float s = 0.f;
#pragma unroll
            for (int w = 0; w < 8; ++w) s += red[(w * 9 + r) * 64 + n];
            MOD[((size_t)l * 9 + r) * 6144 + n0 + n] = s + PIN(F, I_ADAB)[l * 6144 + n0 + n]; }
        __syncthreads();
    }
}
__device__ __forceinline__ void pro0_filter_mlp(Frame& F) {
    const int j = F.lane, gw = F.bx * NWAVES + F.wave, NGW = F.G * NWAVES;
    LAS float* W1 = (LAS float*)F.lds; LAS float* W2 = W1 + FEMB * FH; LAS float* W3 = W2 + FH * FH;
    __syncthreads();
    for (int i = F.tid; i < FEMB * FH; i += NTHREADS) W1[i] = PIN(F, I_FW1)[i];
    for (int i = F.tid; i < FH * FH; i += NTHREADS) { W2[i] = PIN(F, I_FW2)[i]; W3[i] = PIN(F, I_FW3)[i]; }
    __syncthreads();
    const float b1 = PIN(F, I_FB1)[j], b2 = PIN(F, I_FB2)[j], b3 = PIN(F, I_FB3)[j], fr = PIN(F, I_FREQ)[j];
    for (int it = gw; it < SEQ + CL; it += NGW) {
        const bool lat = it < SEQ; const int t = lat ? it : it - SEQ; const float L = lat ? (float)SEQ : (float)CL;
        const float tl = (float)t / (L - 1.0f), w = (6.283185307179586f * (float)t) / L;
        float z;
        { const int band = (j - 1) & 15; const float f = 1e-4f + (float)band * ((15.0f - 1e-4f) / 15.0f); const float a = f * w;
          z = (j == 0) ? tl : (j <= 16 ? cosf(a) : -sinf(a)); }
        float s = b1;
#pragma unroll
        for (int i = 0; i < FEMB; ++i) s += __shfl(z, i) * W1[i * FH + j];
        const float a1 = sinf(fr * s);
        s = b2;
#pragma unroll 16
        for (int i = 0; i < FH; ++i) s += __shfl(a1, i) * W2[i * FH + j];
        const float a2 = sinf(fr * s);
        s = b3;
#pragma unroll 16
        for (int i = 0; i < FH; ++i) s += __shfl(a2, i) * W3[i * FH + j];
        const float a3 = sinf(fr * s);
        float* dst = lat ? (float*)(F.ws + WS_A3) + (size_t)t * FH : (float*)(F.ws + WS_A3C) + (size_t)t * FH;
        dst[j] = a3;
    }
    __syncthreads();
}

__device__ __forceinline__ f32x2 cmul(f32x2 a, f32x2 b) { return (f32x2){a.x * b.x - a.y * b.y, a.x * b.y + a.y * b.x}; }
__device__ __forceinline__ f32x2 cconj(f32x2 a) { return (f32x2){a.x, -a.y}; }
#define ZP(n) ((n) + ((n) >> 5))
constexpr int FFT_LDS_BYTES = (NFFT + NFFT / 32) * 8;
__device__ __forceinline__ void bfly_dif(f32x2& a0, f32x2& a1, f32x2& a2, f32x2& a3, f32x2 w) {
    const f32x2 t0 = a0 + a2, t1 = a0 - a2, t2 = a1 + a3, d = a1 - a3, t3 = (f32x2){d.y, -d.x};
    const f32x2 y0 = t0 + t2, y2 = t0 - t2, y1 = t1 + t3, y3 = t1 - t3, w2 = cmul(w, w), w3 = cmul(w2, w);
    a0 = y0; a1 = cmul(y2, w2); a2 = cmul(y1, w); a3 = cmul(y3, w3);
}
__device__ __forceinline__ void bfly_dit(f32x2& a0, f32x2& a1, f32x2& a2, f32x2& a3, f32x2 w) {
    const f32x2 w2 = cmul(w, w), w3 = cmul(w2, w), A1 = cmul(a1, w2), A2 = cmul(a2, w), A3 = cmul(a3, w3);
    const f32x2 u0 = a0 + A1, u1 = a0 - A1, u2 = A2 + A3, u3 = A2 - A3, iu3 = (f32x2){-u3.y, u3.x};
    a0 = u0 + u2; a1 = u1 + iu3; a2 = u0 - u2; a3 = u1 - iu3;
}
template <int LQ, bool INV> __device__ __forceinline__ void fft_r16(LAS f32x2* z, int tid) {
    constexpr int q16 = 1 << LQ; constexpr float inv_lb = 1.0f / (float)(16 * q16);
    constexpr float C1 = 0.92387953251128674f, S1 = 0.38268343236508977f, C2 = 0.70710678118654752f;
    asm volatile("" : "+v"(tid));
#pragma unroll 1
    for (int g = tid; g < NFFT / 16; g += NTHREADS) {
        const int j = g & (q16 - 1), base = ((g >> LQ) << (LQ + 4)) + j;
        f32x2 x[16];
#pragma unroll
        for (int m = 0; m < 16; ++m) x[m] = z[ZP(base + (m << LQ))];
        const float fr = (float)j * inv_lb; const float sn = __builtin_amdgcn_sinf(fr);
        const f32x2 w1 = (f32x2){__builtin_amdgcn_cosf(fr), INV ? sn : -sn};
        const float sg = INV ? 1.0f : -1.0f;
        const f32x2 wa0 = w1, wa1 = cmul(w1, (f32x2){C1, sg * S1}), wa2 = cmul(w1, (f32x2){C2, sg * C2}), wa3 = cmul(w1, (f32x2){S1, sg * C1});
        const f32x2 w2 = cmul(w1, w1), wb = cmul(w2, w2);
        if constexpr (!INV) {
            bfly_dif(x[0], x[4], x[8], x[12], wa0); bfly_dif(x[1], x[5], x[9], x[13], wa1); bfly_dif(x[2], x[6], x[10], x[14], wa2); bfly_dif(x[3], x[7], x[11], x[15], wa3);
#pragma unroll
            for (int a = 0; a < 4; ++a) bfly_dif(x[4 * a], x[4 * a + 1], x[4 * a + 2], x[4 * a + 3], wb);
        } else {
#pragma unroll
            for (int a = 0; a < 4; ++a) bfly_dit(x[4 * a], x[4 * a + 1], x[4 * a + 2], x[4 * a + 3], wb);
            bfly_dit(x[0], x[4], x[8], x[12], wa0); bfly_dit(x[1], x[5], x[9], x[13], wa1); bfly_dit(x[2], x[6], x[10], x[14], wa2); bfly_dit(x[3], x[7], x[11], x[15], wa3);
        }
#pragma unroll
        for (int m = 0; m < 16; ++m) z[ZP(base + (m << LQ))] = x[m];
    }
    __syncthreads();
}
template <bool INV> __device__ __forceinline__ void fft_r4_unit(LAS f32x2* z, int tid) {
    asm volatile("" : "+v"(tid));
#pragma unroll 2
    for (int bf = tid; bf < NFFT / 4; bf += NTHREADS) {
        const int base = 4 * bf; f32x2 a0 = z[ZP(base)], a1 = z[ZP(base + 1)], a2 = z[ZP(base + 2)], a3 = z[ZP(base + 3)];
        if constexpr (!INV) { const f32x2 t0 = a0 + a2, t1 = a0 - a2, t2 = a1 + a3, d = a1 - a3, t3 = (f32x2){d.y, -d.x};
            z[ZP(base)] = t0 + t2; z[ZP(base + 1)] = t0 - t2; z[ZP(base + 2)] = t1 + t3; z[ZP(base + 3)] = t1 - t3; }
        else { const f32x2 u0 = a0 + a1, u1 = a0 - a1, u2 = a2 + a3, u3 = a2 - a3, iu3 = (f32x2){-u3.y, u3.x};
            z[ZP(base)] = u0 + u2; z[ZP(base + 1)] = u1 + iu3; z[ZP(base + 2)] = u0 - u2; z[ZP(base + 3)] = u1 - iu3; }
    }
    __syncthreads();
}
__device__ __forceinline__ void fft16k_dif(LAS f32x2* z, int tid) { fft_r16<10, false>(z, tid); fft_r16<6, false>(z, tid); fft_r16<2, false>(z, tid); fft_r4_unit<false>(z, tid); }
__device__ __forceinline__ void fft16k_dit_inv(LAS f32x2* z, int tid) { fft_r4_unit<true>(z, tid); fft_r16<2, true>(z, tid); fft_r16<6, true>(z, tid); fft_r16<10, true>(z, tid); }
constexpr int KF_LD = 8256;
__device__ __forceinline__ int rev14(int p) { return (int)(__brev((unsigned)p) >> 18); }
__device__ __forceinline__ float hy_delta(int c) { const float mn = -3.0701134573253945f, mx = -15.350567286626973f; return fabsf(mn + (mx - mn) * ((float)c / 1023.0f)); }

__device__ __forceinline__ void pro1_router_split(Frame& F) {
    const float* MOD = (const float*)(F.ws + WS_MOD); unsigned char* RW3 = F.ws + WS_RW3;
    for (int ent = F.bx * NTHREADS + F.tid; ent < NLAYER * 9 * 8 * 8 * 64; ent += F.G * NTHREADS) {
        const int lane = ent & 63, kb = (ent >> 6) & 7, w = (ent >> 9) & 7, lb = ent >> 12, l = lb / 9;
        const int k0 = w * 128 + 16 * kb + 8 * (lane >> 5), e = lane & 31;
        const float* gn = PIN(F, I_N2G) + l * D; const float* sc = MOD + (size_t)lb * 6144 + 4 * 1024; const float* rw = PIN(F, I_RW) + (size_t)l * D * NE;
        unsigned ph[4], pm[4], pl[4];
#pragma unroll
        for (int j2 = 0; j2 < 4; ++j2) { const int k = k0 + 2 * j2; const float v0 = gn[k] * (1.0f + sc[k]) * rw[(size_t)k * NE + e], v1 = gn[k + 1] * (1.0f + sc[k + 1]) * rw[(size_t)(k + 1) * NE + e];
            const unsigned h = cvt_pk_bf16(v0, v1); const float r0 = v0 - __uint_as_float(h << 16), r1 = v1 - __uint_as_float(h & 0xffff0000u);
            const unsigned m = cvt_pk_bf16(r0, r1); const float s0 = r0 - __uint_as_float(m << 16), s1 = r1 - __uint_as_float(m & 0xffff0000u);
            ph[j2] = h; pm[j2] = m; pl[j2] = cvt_pk_bf16(s0, s1); }
        v4u* dst = (v4u*)(RW3 + (size_t)(ent >> 6) * 3 * 1024) + lane;
        dst[0] = (v4u){ph[0], ph[1], ph[2], ph[3]}; dst[64] = (v4u){pm[0], pm[1], pm[2], pm[3]}; dst[128] = (v4u){pl[0], pl[1], pl[2], pl[3]};
    }
}
__device__ __forceinline__ void pro1_filters(Frame& F) {
    if (F.bx < NLAYER * 9) {
        const int lb = F.bx, l = lb / 9, e = F.lane & 31, hf = F.lane >> 5; const float* sh = (const float*)(F.ws + WS_MOD) + (size_t)lb * 6144 + 3 * 1024; const float* rw = PIN(F, I_RW) + (size_t)l * D * NE;
        LAS float* red = (LAS float*)F.lds; const int k0 = F.wave * 128 + hf * 64; float acc = 0.f;
#pragma unroll 8
        for (int k = k0; k < k0 + 64; ++k) acc += sh[k] * rw[(size_t)k * NE + e];
        acc += shx(acc, 32, F.lane); if (F.lane < 32) red[F.wave * 32 + e] = acc;
        __syncthreads();
        if (F.tid < 32) { float s = PIN(F, I_RB)[l * NE + F.tid];
#pragma unroll
            for (int w = 0; w < 8; ++w) s += red[w * 32 + F.tid];
            ((float*)(F.ws + WS_RC))[lb * NE + F.tid] = s; }
    }
    LAS f32x2* z = (LAS f32x2*)F.lds;
    LAS float* wl = (LAS float*)(F.lds + AUX_OFF + 8192);
    const float* a3 = (const float*)(F.ws + WS_A3); const float* a3c = (const float*)(F.ws + WS_A3C);
    f32x2* KF = (f32x2*)(F.ws + WS_KF); float* FCT = (float*)(F.ws + WS_FCT);
    for (int u = F.bx; u < 512; u += F.G) {
        const int ca = 2 * u, cb = 2 * u + 1;
        __syncthreads();
        if (F.tid < 256) { const int which = F.tid >> 6, m = F.tid & 63; const int col = (which & 1 ? cb : ca) + (which >> 1) * 1024; wl[which * 64 + m] = PIN(F, I_FW4)[m * 2048 + col]; }
        if (F.tid < 4) { const int col = (F.tid & 1 ? cb : ca) + (F.tid >> 1) * 1024; wl[256 + F.tid] = PIN(F, I_FB4)[col]; }
        __syncthreads();
        const float da = hy_delta(ca), db = hy_delta(cb);
        const float dska = PIN(F, I_HD)[ca], dskb = PIN(F, I_HD)[cb];
        for (int t = F.tid; t < SEQ; t += NTHREADS) {
            const f32x4* ar = (const f32x4*)(a3 + (size_t)t * FH); float s0 = wl[256], s1 = wl[257], s2 = wl[258], s3 = wl[259];
#pragma unroll 8
            for (int m4 = 0; m4 < 16; ++m4) { const f32x4 a = ar[m4];
#pragma unroll
                for (int i = 0; i < 4; ++i) { const int m = m4 * 4 + i; s0 += a[i] * wl[m]; s1 += a[i] * wl[64 + m]; s2 += a[i] * wl[128 + m]; s3 += a[i] * wl[192 + m]; } }
            const float tl = (float)t / (float)(SEQ - 1); const float wa = __expf(-tl * da), wb = __expf(-tl * db);
            z[ZP(t)] = (f32x2){s0 * wa + (t == 0 ? dska : 0.f), s1 * wb + (t == 0 ? dskb : 0.f)};
            if (t == 0) z[ZP(SEQ)] = (f32x2){0.f, 0.f}; else z[ZP(NFFT - t)] = (f32x2){s2 * wa, s3 * wb};
        }
        for (int i = F.tid; i < 511; i += NTHREADS) {
            const int d = i - 255, t = d < 0 ? -d : d; const int o = d < 0 ? 2 : 0;
            const f32x4* ar = (const f32x4*)(a3c + (size_t)t * FH); float sa = wl[256 + o], sb = wl[257 + o];
            f32x4 av[16];
#pragma unroll
            for (int m4 = 0; m4 < 16; ++m4) av[m4] = ar[m4];
            __builtin_amdgcn_sched_barrier(0);
#pragma unroll
            for (int m4 = 0; m4 < 16; ++m4) {
#pragma unroll
                for (int i2 = 0; i2 < 4; ++i2) { const int m = m4 * 4 + i2; sa += av[m4][i2] * wl[o * 64 + m]; sb += av[m4][i2] * wl[(o + 1) * 64 + m]; }
                if ((m4 & 3) == 3) __builtin_amdgcn_sched_barrier(0); }
            const float tl = (float)t / (float)(CL - 1);
            FCT[(size_t)ca * 512 + d + 256] = sa * __expf(-tl * da) + (d == 0 ? dska : 0.f); FCT[(size_t)cb * 512 + d + 256] = sb * __expf(-tl * db) + (d == 0 ? dskb : 0.f);
        }
        __syncthreads();
        fft16k_dif(z, F.tid);
        for (int k = F.tid; k <= NFFT / 2; k += NTHREADS) {
            const int p = rev14(k), p2 = rev14((NFFT - k) & (NFFT - 1)); const f32x2 a = z[ZP(p)], b = z[ZP(p2)];
            KF[(size_t)ca * KF_LD + k] = (f32x2){0.5f * (a.x + b.x), 0.5f * (a.y - b.y)};
            KF[(size_t)cb * KF_LD + k] = (f32x2){0.5f * (a.y + b.y), -0.5f * (a.x - b.x)};
        }
    }
    __syncthreads();
}

__device__ __forceinline__ void hyena_conv_phase(Frame& F) {
    LAS f32x2* z = (LAS f32x2*)F.lds;
    LAS float* aux = (LAS float*)(F.lds + AUX_OFF + 8192);
    const float* VT = (const float*)(F.ws + WS_VT); const float* VTC = (const float*)(F.ws + WS_VTC); float* CT = (float*)(F.ws + WS_CT); float* CTC = (float*)(F.ws + WS_CTC);
    const f32x2* KF = (const f32x2*)(F.ws + WS_KF); const float* FCT = (const float*)(F.ws + WS_FCT);
    v4u ina[2], inb[2];
#define HC_LOADIN(u_, t_) do { const int b_ = (u_) >> 9, c_ = 2 * ((u_) & 511); const v4u* va_ = (const v4u*)((const bf16*)VT + ((size_t)b_ * 1024 + c_) * SEQ + 16 * (t_)); \
        ina[0] = va_[0]; ina[1] = va_[1]; inb[0] = va_[SEQ / 8]; inb[1] = va_[SEQ / 8 + 1]; } while (0)
    if (F.bx < NB * 512) HC_LOADIN(F.bx, F.tid);
    for (int u = F.bx; u < NB * 512; u += F.G) {
        const int b = u >> 9, cp = u & 511, ca = 2 * cp, cb = ca + 1;
        int tq = F.tid; asm volatile("" : "+v"(tq));
        __syncthreads();
        { const int n0 = 16 * tq;
#pragma unroll
          for (int i = 0; i < 4; ++i) { const unsigned a0 = ina[i >> 1][2 * (i & 1)], a1 = ina[i >> 1][2 * (i & 1) + 1], b0 = inb[i >> 1][2 * (i & 1)], b1 = inb[i >> 1][2 * (i & 1) + 1];
              z[ZP(n0 + 4 * i)] = (f32x2){bflo(a0), bflo(b0)}; z[ZP(n0 + 4 * i + 1)] = (f32x2){bfhi(a0), bfhi(b0)}; z[ZP(n0 + 4 * i + 2)] = (f32x2){bflo(a1), bflo(b1)}; z[ZP(n0 + 4 * i + 3)] = (f32x2){bfhi(a1), bfhi(b1)};
#pragma unroll
              for (int j = 0; j < 4; ++j) z[ZP(SEQ + n0 + 4 * i + j)] = (f32x2){0.f, 0.f}; } }
        f32x4 ka[8], kb[8]; f32x2 kaN, kbN;
        { const f32x4* pa = (const f32x4*)(KF + (size_t)ca * KF_LD + 16 * tq); const f32x4* pb = (const f32x4*)(KF + (size_t)cb * KF_LD + 16 * tq);
#pragma unroll
          for (int i = 0; i < 8; ++i) { ka[i] = pa[i]; kb[i] = pb[i]; }
          kaN = KF[(size_t)ca * KF_LD + NFFT / 2]; kbN = KF[(size_t)cb * KF_LD + NFFT / 2]; }
        { const int h = tq >> 8, t = tq & 255; const float* vc = VTC + ((size_t)b * 1024 + ca + h) * CL;
          aux[h * 256 + t] = vc[t]; aux[512 + h * 512 + t] = FCT[(size_t)(ca + h) * 512 + t]; aux[512 + h * 512 + 256 + t] = FCT[(size_t)(ca + h) * 512 + 256 + t];
          __syncthreads();
          float y = 0.f;
#pragma unroll 8
          for (int s = 0; s < CL; ++s) y += aux[h * 256 + s] * aux[512 + h * 512 + (t - s) + 256];
          CTC[((size_t)b * 1024 + ca + h) * CL + t] = y; }
        fft16k_dif(z, F.tid);
        int tpw = tq; asm volatile("" : "+v"(tpw));
#define HC_PW(k_, Ka_, Kb_) do { const int p = rev14(k_), p2 = rev14((NFFT - (k_)) & (NFFT - 1)); const f32x2 a = z[ZP(p)], b2 = z[ZP(p2)]; \
            const f32x2 Va = (f32x2){0.5f * (a.x + b2.x), 0.5f * (a.y - b2.y)}, Vb = (f32x2){0.5f * (a.y + b2.y), -0.5f * (a.x - b2.x)}; \
            const f32x2 ya = cmul(Va, Ka_), yb = cmul(Vb, Kb_); \
            z[ZP(p)] = (f32x2){ya.x - yb.y, ya.y + yb.x}; z[ZP(p2)] = (f32x2){ya.x + yb.y, -ya.y + yb.x}; } while (0)
#pragma unroll
        for (int i = 0; i < 8; ++i) { const int k = 16 * tpw + 2 * i;
            HC_PW(k, ((f32x2){ka[i].x, ka[i].y}), ((f32x2){kb[i].x, kb[i].y})); HC_PW(k + 1, ((f32x2){ka[i].z, ka[i].w}), ((f32x2){kb[i].z, kb[i].w}));
            asm volatile("" ::: "memory"); }
        if (tpw == 0) HC_PW(NFFT / 2, kaN, kbN);
#undef HC_PW
        __syncthreads();
        if (u + F.G < NB * 512) HC_LOADIN(u + F.G, tq);
        fft16k_dit_inv(z, F.tid);
        { int to = tq; asm volatile("" : "+v"(to)); const float sc = 1.0f / (float)NFFT; const int n0 = 16 * to;
          v4u* oa = (v4u*)((bf16*)CT + ((size_t)b * 1024 + ca) * SEQ + n0);
#pragma unroll
          for (int h2 = 0; h2 < 2; ++h2) { f32x2 w[8];
#pragma unroll
              for (int j = 0; j < 8; ++j) w[j] = z[ZP(n0 + 8 * h2 + j)];
              oa[h2] = (v4u){cvt_pk_bf16(w[0].x * sc, w[1].x * sc), cvt_pk_bf16(w[2].x * sc, w[3].x * sc), cvt_pk_bf16(w[4].x * sc, w[5].x * sc), cvt_pk_bf16(w[6].x * sc, w[7].x * sc)};
              oa[SEQ / 8 + h2] = (v4u){cvt_pk_bf16(w[0].y * sc, w[1].y * sc), cvt_pk_bf16(w[2].y * sc, w[3].y * sc), cvt_pk_bf16(w[4].y * sc, w[5].y * sc), cvt_pk_bf16(w[6].y * sc, w[7].y * sc)}; } }
    }
    __syncthreads();
#undef HC_LOADIN
}
constexpr int MW_CUMBLK = 16, MW_CNT = 64, MW_SELE = 128, MW_SELV = 256, MW_LRANK = 384, MW_LBASE = 512;
__device__ __forceinline__ void moe_tables(Frame& F, int layer) {
    __syncthreads();
    if (F.tid < NE) F.MISC[MW_CNT + F.tid] = __hip_atomic_load(F.ctl + CW_CNT + layer * NE + F.tid, RLX_AGENT);
    __syncthreads();
    if (F.tid == 0) { unsigned c = 0; for (int e = 0; e < NE; ++e) { F.MISC[MW_CUMBLK + e] = c; c += (F.MISC[MW_CNT + e] + 255u) >> 8; } F.MISC[MW_CUMBLK + NE] = c; }
    __syncthreads();
}

template <int MODE> __device__ __forceinline__ void rowpass(Frame& F, int layer, bool real = true, bool h8 = false) {
    const bool combine = (MODE == 0 && layer > 0) || MODE == 2;
    const int nrows = MODE == 2 ? ML : MT;
    const int cl = MODE == 2 ? NLAYER - 1 : layer - 1;
    const bool from_input = (MODE == 0 && layer == 0);
    const float* XLs = PIN(F, I_X); const float* XCs = PIN(F, I_CTX);
    bf16* XB = (bf16*)(F.ws + WS_XB); bf16* XBd = real ? XB : (bf16*)(F.ws + WS_P);
    const float* MOD = (const float*)(F.ws + WS_MOD);
    bf16* H = (bf16*)(F.ws + WS_H); unsigned char* H8 = (unsigned char*)(F.ws + WS_H8); const unsigned char* YM = (const unsigned char*)(F.ws + WS_YM);
    const int* TE = (const int*)(F.ws + WS_TE); const int* TR = (const int*)(F.ws + WS_TR); const float* TG = (const float*)(F.ws + WS_TG);
    const float* gnorm = MODE == 0 ? PIN(F, I_N1G) + layer * D : PIN(F, I_FG);
    if (combine) moe_tables(F, cl);
    f32x4 gn[4];
#pragma unroll
    for (int j = 0; j < 4; ++j) gn[j] = ((const f32x4*)gnorm)[F.lane + 64 * j];
    const int ntiles = nrows / 32;
    i32x4 nte[4], ntr[4]; f32x4 ntg[4];
#define RP_TABLES(tile_) do { const size_t rb_ = (size_t)((tile_) * 32 + F.wave * 4) * 4; \
        _Pragma("unroll") for (int q = 0; q < 4; ++q) { nte[q] = *(const i32x4*)(TE + rb_ + 4 * q); ntr[q] = *(const i32x4*)(TR + rb_ + 4 * q); ntg[q] = *(const f32x4*)(TG + rb_ + 4 * q); } } while (0)
    if (combine && F.bx < ntiles) RP_TABLES(F.bx);
    for (int tile = F.bx; tile < ntiles; tile += F.G) {
        const int rbase = tile * 32 + F.wave * 4; const bool lat = rbase < ML; const int bidx = lat ? (rbase >> 13) : 8;
        const float* g2 = MOD + ((size_t)(combine ? cl : 0) * 9 + bidx) * 6144 + 5 * 1024;
        const float* mb = MOD + ((size_t)layer * 9 + bidx) * 6144;
        int rid[4][4]; float gkk[4][4];
        if (combine) {
#pragma unroll
            for (int q = 0; q < 4; ++q)
#pragma unroll
                for (int k = 0; k < 4; ++k) { rid[q][k] = 256 * (int)F.MISC[MW_CUMBLK + nte[q][k]] + ntr[q][k]; gkk[q][k] = ntg[q][k]; }
            if (tile + F.G < ntiles) RP_TABLES(tile + F.G);
        }
#pragma unroll 1
        for (int pr = 0; pr < 2; ++pr) {
            size_t xo[2]; f32x4 v[2][4]; int rowid[2][4]; float gk[2][4];
#pragma unroll
            for (int u = 0; u < 2; ++u) { const int r = rbase + 2 * pr + u; xo[u] = (size_t)r * D;
                if (combine) {
#pragma unroll
                    for (int k = 0; k < 4; ++k) { rowid[u][k] = pr ? rid[2 + u][k] : rid[u][k]; gk[u][k] = pr ? gkk[2 + u][k] : gkk[u][k]; } }
                if (from_input) { const f32x4* xs = (const f32x4*)(lat ? XLs + xo[u] : XCs + (xo[u] - (size_t)ML * D));
#pragma unroll
                    for (int j = 0; j < 4; ++j) v[u][j] = xs[F.lane + 64 * j]; }
                else { const v2u* xs = (const v2u*)(XB + xo[u]);
#pragma unroll
                    for (int j = 0; j < 4; ++j) v[u][j] = bf4_f32(xs[F.lane + 64 * j]); } }
            if (combine) {
                unsigned w[2][4][4];
#pragma unroll
                for (int u = 0; u < 2; ++u)
#pragma unroll
                    for (int k = 0; k < 4; ++k) { const unsigned* yr = (const unsigned*)(YM + (size_t)rowid[u][k] * D);
#pragma unroll
                        for (int j = 0; j < 4; ++j) w[u][k][j] = yr[F.lane + 64 * j]; }
#pragma unroll
                for (int u = 0; u < 2; ++u) {
#pragma unroll
                    for (int j = 0; j < 4; ++j) { f32x4 a = (f32x4){0.f, 0.f, 0.f, 0.f};
#pragma unroll
                        for (int k = 0; k < 4; ++k) { const f32x2 lo = __builtin_amdgcn_cvt_pk_f32_fp8(w[u][k][j], false), hi2 = __builtin_amdgcn_cvt_pk_f32_fp8(w[u][k][j], true); a += gk[u][k] * (f32x4){lo.x, lo.y, hi2.x, hi2.y}; }
                        v[u][j] += ((const f32x4*)g2)[F.lane + 64 * j] * a; }
                    if (MODE == 0) { v2u* xd = (v2u*)(XBd + xo[u]);
#pragma unroll
                        for (int j = 0; j < 4; ++j) { v2u o; o.x = cvt_pk_bf16(v[u][j].x, v[u][j].y); o.y = cvt_pk_bf16(v[u][j].z, v[u][j].w); xd[F.lane + 64 * j] = o; } } }
            }
            if (from_input) {
#pragma unroll
                for (int u = 0; u < 2; ++u) { v2u* xd = (v2u*)(XBd + xo[u]);
#pragma unroll
                    for (int j = 0; j < 4; ++j) { v2u o; o.x = cvt_pk_bf16(v[u][j].x, v[u][j].y); o.y = cvt_pk_bf16(v[u][j].z, v[u][j].w); xd[F.lane + 64 * j] = o; } } }
#pragma unroll
            for (int u = 0; u < 2; ++u) { const int r = rbase + 2 * pr + u;
                float ss = 0.f;
#pragma unroll
                for (int j = 0; j < 4; ++j) ss += (v[u][j].x * v[u][j].x + v[u][j].y * v[u][j].y) + (v[u][j].z * v[u][j].z + v[u][j].w * v[u][j].w);
                const float rstd = 1.0f / sqrtf(wave_sum(ss, F.lane) * (1.0f / D) + EPS);
                if (MODE == 2) { f32x4* od = (f32x4*)((real ? F.out : (float*)(F.ws + WS_P)) + xo[u]);
#pragma unroll
                    for (int j = 0; j < 4; ++j) od[F.lane + 64 * j] = v[u][j] * rstd * gn[j]; }
                else { v2u* hd = (v2u*)(H + (size_t)r * D); unsigned* hd8 = (unsigned*)(H8 + (size_t)r * D);
#pragma unroll
                    for (int j = 0; j < 4; ++j) { const f32x4 sh = ((const f32x4*)mb)[F.lane + 64 * j], sc = ((const f32x4*)(mb + 1024))[F.lane + 64 * j]; const f32x4 hv = v[u][j] * rstd * gn[j] * (sc + 1.0f) + sh;
                        if (h8) { unsigned o = 0; o = __builtin_amdgcn_cvt_pk_fp8_f32(hv.x, hv.y, o, false); o = __builtin_amdgcn_cvt_pk_fp8_f32(hv.z, hv.w, o, true); hd8[F.lane + 64 * j] = o; }
                        else { v2u o; o.x = cvt_pk_bf16(hv.x, hv.y); o.y = cvt_pk_bf16(hv.z, hv.w); hd[F.lane + 64 * j] = o; } } }
            }
        }
    }
}

typedef float f32x16r __attribute__((ext_vector_type(16)));
__device__ __forceinline__ void router_phase(Frame& F, int layer, bool real = true, int xp = 0) {
    const bool last = layer == NLAYER - 1;
    const int ntiles = (last ? ML : MT) / 32;
    LAS float* PART = (LAS float*)F.lds;
    LAS float* SSQ = PART + 8 * 32 * 33;
    LAS float* LG = SSQ + 8 * 32;
    LAS float* RSTD = LG + 32 * 33;
    LAS unsigned* CW = (LAS unsigned*)(RSTD + 32);
    LAS unsigned* RUN = CW + 64;
    LAS float* AV = (LAS float*)(RUN + 32);
    LAS float* SHV = AV + 1024;
    LAS float* RCV = SHV + 1024;
    LAS bf16* STG = (LAS bf16*)((LAS unsigned char*)(RCV + 32) + F.wave * (32 * 272));
    const bf16* XB = (const bf16*)(F.ws + WS_XB);
    const float* MOD = (const float*)(F.ws + WS_MOD); const float* RC = (const float*)(F.ws + WS_RC);
    unsigned char* H8 = (unsigned char*)(F.ws + WS_H8);
    int* TE = (int*)(F.ws + WS_TE); int* TR = (int*)(F.ws + WS_TR); float* TG = (float*)(F.ws + WS_TG); int* ROWTOK = (int*)(F.ws + WS_ROWTOK);
    const float* gn = PIN(F, I_N2G) + layer * D; const float* rw = PIN(F, I_RW) + (size_t)layer * D * NE;
    const int i = F.lane & 31, hf = F.lane >> 5, lr = F.lane >> 4, lc = F.lane & 15, kw = F.wave * 128;
    const int per = 2048 / F.G;
    const int nmine = (2048 % F.G == 0) ? per + ((2048 + F.bx < ntiles) ? 1 : 0) : 0;
#define RT_TILE(n_) ((2048 % F.G == 0) ? ((n_) < per ? F.bx * per + (n_) : 2048 + F.bx) : F.bx + (n_) * F.G)
    const int ncnt = (2048 % F.G == 0) ? nmine : (F.bx < ntiles ? (ntiles - 1 - F.bx) / F.G + 1 : 0);
    __syncthreads();
    if (F.tid < NE) RUN[F.tid] = 0u;
    bf16x8 bw[8][2];
    v2u rawp[16];
#define RT_LOADX(tile_) do { const int rb_ = (tile_) * 32 + lr; const bf16* xb_ = XB + (size_t)rb_ * D + kw + 4 * lc; \
        _Pragma("unroll") for (int q = 0; q < 16; ++q) rawp[q] = *(const v2u*)(xb_ + (size_t)(4 * (q & 7)) * D + 64 * (q >> 3)); } while (0)
    if (ncnt > 0) RT_LOADX(RT_TILE(0));
    int cur_b = -1;
    for (int n = 0; n < ncnt; ++n) {
        const int tile = RT_TILE(n);
        const int r0 = tile * 32; const bool lat = r0 < ML; const int bidx = lat ? (r0 >> 13) : 8; const int r = r0 + i;
        if (bidx != cur_b) {
            cur_b = bidx; const float* mb = MOD + ((size_t)layer * 9 + bidx) * 6144 + 3 * 1024;
            __syncthreads();
            for (int k = F.tid; k < 1024; k += NTHREADS) { AV[k] = gn[k] * (1.0f + mb[1024 + k]); SHV[k] = mb[k]; }
            if (F.tid < NE) RCV[F.tid] = RC[((size_t)layer * 9 + bidx) * NE + F.tid];
            __syncthreads();
            { const v4u* src = (const v4u*)(F.ws + WS_RW3 + ((size_t)(layer * 9 + bidx) * 8 + F.wave) * 8 * 3 * 1024) + F.lane;
#pragma unroll
              for (int kb = 0; kb < 8; ++kb)
#pragma unroll
                  for (int t = 0; t < 2; ++t) bw[kb][t] = __builtin_bit_cast(bf16x8, src[(kb * 3 + t) * 64]); }
        }
        { float s8[8];
#pragma unroll
          for (int q = 0; q < 8; ++q) { const f32x4 a = bf4_f32(rawp[q]), b = bf4_f32(rawp[q + 8]); s8[q] = ((a.x * a.x + a.y * a.y) + (a.z * a.z + a.w * a.w)) + ((b.x * b.x + b.y * b.y) + (b.z * b.z + b.w * b.w)); }
#pragma unroll
          for (int q = 0; q < 8; ++q) { float v = s8[q]; v += shx(v, 1, F.lane); v += shx(v, 2, F.lane); v += shx(v, 4, F.lane); v += shx(v, 8, F.lane); if (lc == 0) SSQ[F.wave * 32 + 4 * q + lr] = v; } }
        __syncthreads();
        const f32x4 av0 = ((const LAS f32x4*)(AV + kw))[lc], av1 = ((const LAS f32x4*)(AV + kw))[lc + 16];
        { const f32x4 sh0 = ((const LAS f32x4*)(SHV + kw))[lc], sh1 = ((const LAS f32x4*)(SHV + kw))[lc + 16];
          unsigned char* hb = H8 + (size_t)(r0 + lr) * D + kw + 4 * lc;
#pragma unroll
          for (int q = 0; q < 8; ++q) { float qs = 0.f;
#pragma unroll
              for (int w = 0; w < 8; ++w) qs += SSQ[w * 32 + 4 * q + lr];
              const float rs = 1.0f / sqrtf(qs * (1.0f / D) + EPS);
#pragma unroll
              for (int hq = 0; hq < 2; ++hq) { const f32x4 h = bf4_f32(rawp[q + 8 * hq]) * (rs * (hq ? av1 : av0)) + (hq ? sh1 : sh0); unsigned w = 0;
                  w = __builtin_amdgcn_cvt_pk_fp8_f32(h.x, h.y, w, false); w = __builtin_amdgcn_cvt_pk_fp8_f32(h.z, h.w, w, true);
                  *(unsigned*)(hb + (size_t)(4 * q) * D + 64 * hq) = w; } } }
        f32x16r acc = {};
        asm volatile("s_waitcnt lgkmcnt(0)" ::: "memory");
#pragma unroll
        for (int q = 0; q < 16; ++q) *(LAS v2u*)(STG + (4 * (q & 7) + lr) * 136 + 4 * lc + 64 * (q >> 3)) = rawp[q];
        asm volatile("s_waitcnt lgkmcnt(0)" ::: "memory");
        if (n + 1 < ncnt) RT_LOADX(RT_TILE(n + 1));
#pragma unroll
        for (int kb = 0; kb < 8; ++kb) { const bf16x8 a = *(const LAS bf16x8*)(STG + i * 136 + 16 * kb + 8 * hf);
#pragma unroll
            for (int t = 0; t < 2; ++t) acc = __builtin_amdgcn_mfma_f32_32x32x16_bf16(a, bw[kb][t], acc, 0, 0, 0); }
#pragma unroll
        for (int rg = 0; rg < 16; ++rg) PART[(F.wave * 32 + ((rg & 3) + 8 * (rg >> 2) + 4 * hf)) * 33 + i] = acc[rg];
        __syncthreads();
        { const int tk = F.tid >> 4, e0 = (F.tid & 15) * 2; float q = 0.f, s0 = 0.f, s1 = 0.f;
#pragma unroll
          for (int w = 0; w < 8; ++w) { q += SSQ[w * 32 + tk]; s0 += PART[(w * 32 + tk) * 33 + e0]; s1 += PART[(w * 32 + tk) * 33 + e0 + 1]; }
          const float rstd = 1.0f / sqrtf(q * (1.0f / D) + EPS);
          LG[tk * 33 + e0] = rstd * s0 + RCV[e0]; LG[tk * 33 + e0 + 1] = rstd * s1 + RCV[e0 + 1]; }
        __syncthreads();
        { const int tk = F.tid >> 4, e0 = (F.tid & 15) * 2; const LAS float* lg = LG + tk * 33; const float l0 = lg[e0], l1 = lg[e0 + 1]; int rk0 = 0, rk1 = 0;
#pragma unroll 8
          for (int j = 0; j < NE; ++j) { const float o = lg[j]; rk0 += (o > l0 || (o == l0 && j < e0)) ? 1 : 0; rk1 += (o > l1 || (o == l1 && j < e0 + 1)) ? 1 : 0; }
          if (rk0 < 4) { F.MISC[MW_SELE + tk * 4 + rk0] = (unsigned)e0; F.MISC[MW_SELV + tk * 4 + rk0] = __float_as_uint(l0); }
          if (rk1 < 4) { F.MISC[MW_SELE + tk * 4 + rk1] = (unsigned)(e0 + 1); F.MISC[MW_SELV + tk * 4 + rk1] = __float_as_uint(l1); } }
        __syncthreads();
        int my = 0, lrk = 0;
        if (F.wave < 2) { const int a = F.tid; my = (int)F.MISC[MW_SELE + a];
            { const float vk = __uint_as_float(F.MISC[MW_SELV + a]), v0 = __uint_as_float(F.MISC[MW_SELV + (a & ~3)]);
              const float ex = __expf(vk - v0); float sm = ex; sm += shx(sm, 1, F.lane); sm += shx(sm, 2, F.lane);
              const size_t idx = ((size_t)r0 + (a >> 2)) * 4 + (a & 3); TG[idx] = ex / sm; TE[idx] = my; }
            unsigned cm = 0;
#pragma unroll 2
            for (int e = 0; e < NE; ++e) { const unsigned long long m = __ballot(my == e); const unsigned pc = (unsigned)__popcll(m);
                if (my == e) lrk = (int)__builtin_amdgcn_mbcnt_hi((unsigned)(m >> 32), __builtin_amdgcn_mbcnt_lo((unsigned)m, 0u)); if (F.lane == e) cm = pc; }
            if (F.lane < NE) CW[F.wave * 32 + F.lane] = cm; }
        __syncthreads();
        if (F.wave < 2) { const int a = F.tid; const int brank = (int)RUN[my] + lrk + (F.wave == 1 ? (int)CW[my] : 0); TR[((size_t)r0 + (a >> 2)) * 4 + (a & 3)] = brank; }
        __syncthreads();
        if (F.tid < NE) RUN[F.tid] += CW[F.tid] + CW[32 + F.tid];
    }
    VM_WAIT(); __syncthreads();
    if (F.tid < NE) { const unsigned cnt = RUN[F.tid]; unsigned base = 0;
        if (cnt) base = __hip_atomic_fetch_add(F.ctl + CW_CNT + (real ? layer : NLAYER) * NE + F.tid, cnt, RLX_AGENT);
        F.MISC[MW_LBASE + F.tid] = base; }
    __syncthreads();
    if (real) for (int n = 0; n < ncnt; ++n) { const int r0 = RT_TILE(n) * 32;
        if (F.tid < 128) { const size_t idx = ((size_t)r0 + (F.tid >> 2)) * 4 + (F.tid & 3); const int e = TE[idx]; const int rank = TR[idx] + (int)F.MISC[MW_LBASE + e]; TR[idx] = rank; ROWTOK[(size_t)e * MT + rank] = r0 + (F.tid >> 2); } }
    __syncthreads();
#undef RT_LOADX
#undef RT_TILE
}

__device__ __forceinline__ void normrope16(float (&x)[16], const float* gain, bool lat, int prow, int pcol, const LAS f32x2* T, int L, float oscale, int lane) {
    float ss = 0.f;
#pragma unroll
    for (int i = 0; i < 16; ++i) ss += x[i] * x[i];
    ss += shx(ss, 1, lane); ss += shx(ss, 2, lane); ss += shx(ss, 4, lane);
    const float rstd = 1.0f / sqrtf(ss * (1.0f / 128.0f) + EPS);
    const int o = (L & 7) * 16;
#pragma unroll
    for (int i = 0; i < 16; ++i) x[i] = x[i] * rstd * gain[o + i];
    float p[16];
#pragma unroll
    for (int i = 0; i < 16; ++i) p[i] = shx(x[i], 2, lane);
    if (lat) {
        const int pos = (L & 4) ? pcol : prow; const float sgn = (L & 2) ? 1.0f : -1.0f; const LAS f32x2* t = T + pos * 32 + (L & 1) * 16;
#pragma unroll
        for (int i = 0; i < 16; ++i) { const f32x2 cs = t[i]; x[i] = x[i] * cs.x + sgn * p[i] * cs.y; }
    }
#pragma unroll
    for (int i = 0; i < 16; ++i) x[i] *= oscale;
}
__device__ __forceinline__ void qkprep_phase(Frame& F, int j) {
    LAS f32x2* T = (LAS f32x2*)F.lds;
    __syncthreads();
    for (int i = F.tid; i < 128 * 32; i += NTHREADS) { const int pos = i >> 5, f = i & 31; const float inv = powf(10000.0f, -(float)f / 32.0f); const float ang = (float)pos * inv; float s, c; sincosf(ang, &s, &c); T[i] = (f32x2){c, s}; }
    __syncthreads();
    const bf16* P = (const bf16*)(F.ws + WS_P); unsigned char* Q8 = (unsigned char*)(F.ws + WS_QB); unsigned char* K8 = (unsigned char*)(F.ws + WS_QB + WS_K8_OFF); unsigned char* VT8 = (unsigned char*)(F.ws + WS_KVB);
    const float* qg = PIN(F, I_AQG) + j * 128; const float* kg = PIN(F, I_AKG) + j * 128;
    if (F.bx == 0 && F.tid == 0) { float qm = 0.f, km = 0.f; for (int i = 0; i < 128; ++i) { qm = fmaxf(qm, fabsf(qg[i])); km = fmaxf(km, fabsf(kg[i])); }
        const float sig = att::SCALE * 1.4426950408889634f * 11.3137085f * qm * km;
        ((float*)(F.ws + WS_RC))[2048 + j] = -fminf(-2.0f, 8.0f - 7.0f * sig); }
    const int gw = F.bx * NWAVES + F.wave, NGW = F.G * NWAVES, L = F.lane;
#define QK_UNPACK(x, a, c) do { x[0] = bflo(a.x); x[1] = bfhi(a.x); x[2] = bflo(a.y); x[3] = bfhi(a.y); x[4] = bflo(a.z); x[5] = bfhi(a.z); x[6] = bflo(a.w); x[7] = bfhi(a.w); \
        x[8] = bflo(c.x); x[9] = bfhi(c.x); x[10] = bflo(c.y); x[11] = bfhi(c.y); x[12] = bflo(c.z); x[13] = bfhi(c.z); x[14] = bflo(c.w); x[15] = bfhi(c.w); } while (0)
#define QK_PACK(o, x) do { _Pragma("unroll") for (int w4 = 0; w4 < 4; ++w4) { unsigned w = 0; w = __builtin_amdgcn_cvt_pk_fp8_f32(x[4 * w4], x[4 * w4 + 1], w, false); w = __builtin_amdgcn_cvt_pk_fp8_f32(x[4 * w4 + 2], x[4 * w4 + 3], w, true); o[w4] = w; } } while (0)
    const float qscale = att::SCALE * 1.4426950408889634f * 8.0f;
    int rfirst = gw;
    if (F.G * NWAVES * 32 == ML) {
        v4u nq[4][2], nk[2];
#define QK4_LOAD(it_) do { _Pragma("unroll") for (int k = 0; k < 4; ++k) { const bf16* pr_ = P + (size_t)(gw + (4 * (it_) + k) * NGW) * 1536 + 16 * L; nq[k][0] = *(const v4u*)pr_; nq[k][1] = *(const v4u*)(pr_ + 8); } \
        { const bf16* pk_ = P + (size_t)(gw + (4 * (it_) + (L >> 4)) * NGW) * 1536 + 1024 + 16 * (L & 15); nk[0] = *(const v4u*)pk_; nk[1] = *(const v4u*)(pk_ + 8); } } while (0)
        QK4_LOAD(0);
#pragma unroll 1
        for (int it = 0; it < 8; ++it) {
            v4u q[4][2], kk[2];
#pragma unroll
            for (int k = 0; k < 4; ++k) { q[k][0] = nq[k][0]; q[k][1] = nq[k][1]; }
            kk[0] = nk[0]; kk[1] = nk[1];
            if (it + 1 < 8) QK4_LOAD(it + 1);
#pragma unroll
            for (int k = 0; k < 4; ++k) { const int r = gw + (4 * it + k) * NGW, s = r & (SEQ - 1); float x[16];
                QK_UNPACK(x, q[k][0], q[k][1]);
                normrope16(x, qg, true, s >> 6, s & 63, T, L, qscale, L);
                v4u o; QK_PACK(o, x); *(v4u*)(Q8 + (size_t)r * D + 16 * L) = o; }
            { const int r = gw + (4 * it + (L >> 4)) * NGW, s = r & (SEQ - 1), Lk = L & 15; float x[16];
              QK_UNPACK(x, kk[0], kk[1]);
              normrope16(x, kg, true, s >> 6, s & 63, T, Lk, 1.0f, L);
              v4u o; QK_PACK(o, x); *(v4u*)(K8 + ((size_t)(r >> 13) * SKV + s) * 256 + 16 * Lk) = o; }
        }
#undef QK4_LOAD
        rfirst = gw + 32 * NGW;
    }
    v4u nqa, nqc, nka, nkc;
#define QK_LOAD(r_) do { const bf16* pr_ = P + (size_t)(r_) * 1536; nqa = *(const v4u*)(pr_ + 16 * L); nqc = *(const v4u*)(pr_ + 16 * L + 8); nka = *(const v4u*)(pr_ + 1024 + 16 * (L & 15)); nkc = *(const v4u*)(pr_ + 1024 + 16 * (L & 15) + 8); } while (0)
    if (rfirst < MT) QK_LOAD(rfirst);
    for (int r = rfirst; r < MT; r += NGW) {
        const v4u qa_ = nqa, qc_ = nqc, ka_ = nka, kc_ = nkc;
        if (r + NGW < MT) QK_LOAD(r + NGW);
        const bool lat = r < ML; const int b = lat ? (r >> 13) : ((r - ML) >> 8); const int s = lat ? (r & (SEQ - 1)) : ((r - ML) & (CL - 1));
        const int prow = s >> 6, pcol = s & 63; const size_t kvrow = (size_t)b * SKV + (lat ? s : SEQ + s);
        { float x[16]; QK_UNPACK(x, qa_, qc_);
          normrope16(x, qg, lat, prow, pcol, T, L, qscale, L);
          v4u o; QK_PACK(o, x); *(v4u*)(Q8 + (size_t)r * D + 16 * L) = o; }
        { const int Lk = L & 15; float x[16]; QK_UNPACK(x, ka_, kc_);
          normrope16(x, kg, lat, prow, pcol, T, Lk, 1.0f, L);
          if (L < 16) { v4u o; QK_PACK(o, x); *(v4u*)(K8 + kvrow * 256 + 16 * L) = o; } }
    }
#undef QK_LOAD
#undef QK_UNPACK
#undef QK_PACK
    LAS unsigned char* Tt = F.lds + 32768;
    for (int tile = F.bx; tile < NB * (SKV / 64); tile += F.G) {
        const int b = tile / (SKV / 64), kb = tile % (SKV / 64), ki = F.tid >> 3, seg = F.tid & 7, pos = kb * 64 + ki;
        const size_t r = pos < SEQ ? (size_t)b * SEQ + pos : (size_t)ML + (size_t)b * CL + (pos - SEQ);
        const int k5 = ki & 31, slot = 32 * ((k5 >> 2) & 1) + ((k5 & 3) | ((k5 >> 3) << 2)) + (ki >= 32 ? 16 : 0);
        const v4u* src = (const v4u*)(P + r * 1536 + 1280 + 32 * seg);
        __syncthreads();
#pragma unroll
        for (int q = 0; q < 4; ++q) { const v4u w = src[q]; const unsigned ww[4] = {w.x, w.y, w.z, w.w};
#pragma unroll
            for (int e2 = 0; e2 < 4; ++e2) { const unsigned pk = __builtin_amdgcn_cvt_pk_fp8_f32(bflo(ww[e2]), bfhi(ww[e2]), 0u, false); const int dd = 32 * seg + 8 * q + 2 * e2;
                Tt[dd * 64 + slot] = (unsigned char)(pk & 0xff); Tt[(dd + 1) * 64 + slot] = (unsigned char)((pk >> 8) & 0xff); } }
        __syncthreads();
        { const int rho = F.tid >> 1, half = F.tid & 1; const v4u a = *(const LAS v4u*)(Tt + rho * 64 + 32 * half), c = *(const LAS v4u*)(Tt + rho * 64 + 32 * half + 16);
          unsigned char* dst = VT8 + ((size_t)(b * 2 + (rho >> 7)) * 128 + (rho & 127)) * SKV + kb * 64 + 32 * half;
          *(v4u*)dst = a; *(v4u*)(dst + 16) = c; }
    }
    __syncthreads();
}
template <int XV = 0>
__device__ __forceinline__ void attention_phase(Frame& F, char* lds_generic, bool ctx_queries, int j) {
    const float nb = -((const float*)(F.ws + WS_RC))[2048 + j] - 8.0f;
    const unsigned char* Q8 = (const unsigned char*)(F.ws + WS_QB); const unsigned char* K8 = (const unsigned char*)(F.ws + WS_QB + WS_K8_OFF); const unsigned char* VT8 = (const unsigned char*)(F.ws + WS_KVB); bf16* Y = (bf16*)(F.ws + WS_Y);
    const int nunits = 2048 + (ctx_queries ? 64 : 0);
    for (int u = F.bx; u < nunits; u += F.G) {
        if (u < 2048) { const int b = u >> 8, w = u & 255, h = w & 7, qb = w >> 3; const size_t qo = ((size_t)b * SEQ + (size_t)qb * 256) * D + h * 128;
            att::attn_dense_body<XV>(Q8 + qo, K8 + (size_t)b * SKV * 256 + (h >> 2) * 128, VT8 + (size_t)(b * 2 + (h >> 2)) * 128 * SKV, SKV, Y + qo, SKV, lds_generic, F.wave, nb); }
        else { const int w = u - 2048, b = w >> 3, h = w & 7; const size_t qo = ((size_t)ML + (size_t)b * CL) * D + h * 128;
            att::attn_dense_body<XV>(Q8 + qo, K8 + ((size_t)b * SKV + SEQ) * 256 + (h >> 2) * 128, VT8 + (size_t)(b * 2 + (h >> 2)) * 128 * SKV + SEQ, SKV, Y + qo, CL, lds_generic, F.wave, nb); }
    }
}

__device__ __forceinline__ void gmlp_mix_phase(Frame& F) {
    constexpr int LDA = 136, LDO = 132;
    LAS bf16* As = (LAS bf16*)F.lds;
    LAS bf16* Vt = (LAS bf16*)(F.lds + 128 * LDA * 2);
    LAS float* rs = (LAS float*)(F.lds + 2 * 128 * LDA * 2);
    LAS float* Ot = (LAS float*)(F.lds + 2 * 128 * LDA * 2 + 512);
    const bf16* P = (const bf16*)(F.ws + WS_P); bf16* Y = (bf16*)(F.ws + WS_Y); const float* SS = (const float*)(F.ws + WS_SS);
    const float* ws = PIN(F, I_GWS); const float* bs = PIN(F, I_GBS); const float* vg = PIN(F, I_GVG);
    const int r32 = F.lane & 31, hi = F.lane >> 5;
    constexpr int NU = (MT / 128) * 8;
    struct GIn { f32x4 s; v4u v[4], uu[4]; } ga, gb; int gcur = -1;
#define GM_LOAD(u_, IN) do { const int g_ = (u_) & 7; const size_t row0_ = (size_t)((u_) >> 3) * 128; \
        IN.s = *(const f32x4*)(SS + (row0_ + (F.tid >> 2)) * 16 + (F.tid & 3) * 4);                                       \
        _Pragma("unroll") for (int k = 0; k < 4; ++k) { const int i_ = F.tid + NTHREADS * k, q_ = i_ >> 4, c8_ = (i_ & 15) * 8; const bf16* pp_ = P + (row0_ + q_) * 2048 + g_ * 128 + c8_; \
            IN.v[k] = *(const v4u*)(pp_ + 1024); IN.uu[k] = *(const v4u*)pp_; } } while (0)
#define GM_UNIT(u_, IN) do { \
        const int chunk = (u_) >> 3, g = (u_) & 7; const size_t row0 = (size_t)chunk * 128; \
        __syncthreads(); \
        if (g != gcur) { gcur = g; \
            for (int i = F.tid; i < 128 * 32; i += NTHREADS) { const int p = i >> 5, q4 = (i & 31) * 4; const f32x4 w = *(const f32x4*)(ws + ((size_t)g * 128 + p) * 128 + q4); \
                v2u o; o.x = pk2(w.x, w.y); o.y = pk2(w.z, w.w); *(LAS v2u*)(As + p * LDA + q4) = o; } } \
        { float s = (IN.s.x + IN.s.y) + (IN.s.z + IN.s.w); s += shx(s, 1, F.lane); s += shx(s, 2, F.lane); if ((F.tid & 3) == 0) rs[F.tid >> 2] = 1.0f / sqrtf(s * (1.0f / 1024.0f) + EPS); } \
        __syncthreads(); \
        _Pragma("unroll") for (int k = 0; k < 4; ++k) { const int i = F.tid + NTHREADS * k, q = i >> 4, c8 = (i & 15) * 8; const float rq = rs[q]; const unsigned ww[4] = {IN.v[k].x, IN.v[k].y, IN.v[k].z, IN.v[k].w}; \
            _Pragma("unroll") for (int e2 = 0; e2 < 4; ++e2) { const unsigned pk = cvt_pk_bf16(bflo(ww[e2]) * rq, bfhi(ww[e2]) * rq); Vt[(c8 + 2 * e2) * LDA + q] = (bf16)(pk & 0xffff); Vt[(c8 + 2 * e2 + 1) * LDA + q] = (bf16)(pk >> 16); } } \
        __syncthreads(); \
        const int p0 = (F.wave >> 1) * 32, cbase = (F.wave & 1) * 64; \
        f32x16 acc0 = {}, acc1 = {}; \
        _Pragma("unroll") for (int ks = 0; ks < 8; ++ks) { const int k0 = ks * 16 + hi * 8; \
            const bf16x8 a = *(const LAS bf16x8*)(As + (p0 + r32) * LDA + k0); \
            const bf16x8 b0 = *(const LAS bf16x8*)(Vt + (cbase + r32) * LDA + k0), b1 = *(const LAS bf16x8*)(Vt + (cbase + 32 + r32) * LDA + k0); \
            acc0 = __builtin_amdgcn_mfma_f32_32x32x16_bf16(a, b0, acc0, 0, 0, 0); acc1 = __builtin_amdgcn_mfma_f32_32x32x16_bf16(a, b1, acc1, 0, 0, 0); } \
        _Pragma("unroll") for (int t = 0; t < 2; ++t) { const int cl = cbase + t * 32 + r32; const float gain = vg[g * 128 + cl]; \
            _Pragma("unroll") for (int reg = 0; reg < 16; ++reg) { const int p = p0 + (reg & 3) + 8 * (reg >> 2) + 4 * hi; Ot[p * LDO + cl] = gain * (t == 0 ? acc0[reg] : acc1[reg]) + bs[g * 128 + p]; } } \
        __syncthreads(); \
        _Pragma("unroll") for (int k = 0; k < 4; ++k) { const int i = F.tid + NTHREADS * k, p = i >> 4, c8 = (i & 15) * 8; const v4u uw = IN.uu[k]; \
            const LAS float* o = Ot + p * LDO + c8; const f32x4 m0 = *(const LAS f32x4*)o, m1 = *(const LAS f32x4*)(o + 4); \
            v4u w; w.x = cvt_pk_bf16(bflo(uw.x) * m0.x, bfhi(uw.x) * m0.y); w.y = cvt_pk_bf16(bflo(uw.y) * m0.z, bfhi(uw.y) * m0.w); \
            w.z = cvt_pk_bf16(bflo(uw.z) * m1.x, bfhi(uw.z) * m1.y); w.w = cvt_pk_bf16(bflo(uw.w) * m1.z, bfhi(uw.w) * m1.w); \
            *(v4u*)(Y + (row0 + p) * D + g * 128 + c8) = w; } } while (0)
    int u = F.bx;
    if (u < NU) GM_LOAD(u, ga);
    for (; u < NU; u += 2 * F.G) {
        if (u + F.G < NU) GM_LOAD(u + F.G, gb);
        GM_UNIT(u, ga);
        if (u + F.G >= NU) break;
        if (u + 2 * F.G < NU) GM_LOAD(u + 2 * F.G, ga);
        GM_UNIT(u + F.G, gb);
    }
    __syncthreads();
#undef GM_LOAD
#undef GM_UNIT
}

__device__ __forceinline__ void hyena_prep_phase(Frame& F) {
    LAS float* tl = (LAS float*)F.lds;
    const bf16* P = (const bf16*)(F.ws + WS_P); bf16* X0 = (bf16*)(F.ws + WS_X0); bf16* VG = (bf16*)(F.ws + WS_VG);
    float* VT = (float*)(F.ws + WS_VT); float* VTC = (float*)(F.ws + WS_VTC);
    const float* cw = PIN(F, I_HCW); const float* cb = PIN(F, I_HCB);
    const int tt = F.tid >> 3, cg = F.tid & 7;
    constexpr int NU = (MT / 64) * 16;
    v4u pa[3][3], pb[3][3];
#define HP_LOAD(u_, IN) do { const int tb_ = (u_) >> 4, c0_ = ((u_) & 15) * 64, r0_ = tb_ * 64; const bool lat_ = r0_ < ML; \
        const int s_ = (lat_ ? (r0_ & (SEQ - 1)) : ((r0_ - ML) & (CL - 1))) + tt, L_ = lat_ ? SEQ : CL; const bf16* pr_ = P + (size_t)(r0_ + tt) * 3072 + c0_ + cg * 8; const v4u z0_ = {0u, 0u, 0u, 0u}; \
        _Pragma("unroll") for (int seg = 0; seg < 3; ++seg) { IN[seg][0] = s_ > 0 ? *(const v4u*)(pr_ + seg * 1024 - 3072) : z0_; IN[seg][1] = *(const v4u*)(pr_ + seg * 1024); \
            IN[seg][2] = s_ < L_ - 1 ? *(const v4u*)(pr_ + seg * 1024 + 3072) : z0_; } } while (0)
    LAS float* wl = tl + 64 * 65; int c0w = -1;
#define HP_UNIT(u_, IN) do { \
        const int tb = (u_) >> 4, c0 = ((u_) & 15) * 64; const int r0 = tb * 64; const bool lat = r0 < ML; \
        const int b = lat ? (r0 >> 13) : ((r0 - ML) >> 8), s0 = lat ? (r0 & (SEQ - 1)) : ((r0 - ML) & (CL - 1)); \
        const int r = r0 + tt, c = c0 + cg * 8; \
        if (c0 != c0w) { c0w = c0; __syncthreads(); \
            for (int i = F.tid; i < 768; i += NTHREADS) { const int seg = i >> 8, k = (i >> 6) & 3, ch = i & 63; wl[i] = k < 3 ? cw[k * 3072 + seg * 1024 + c0 + ch] : cb[seg * 1024 + c0 + ch]; } \
            __syncthreads(); } \
        float o[3][8]; \
        _Pragma("unroll") for (int seg = 0; seg < 3; ++seg) { \
            const unsigned pmw[4] = {IN[seg][0].x, IN[seg][0].y, IN[seg][0].z, IN[seg][0].w}, pcw[4] = {IN[seg][1].x, IN[seg][1].y, IN[seg][1].z, IN[seg][1].w}, pnw[4] = {IN[seg][2].x, IN[seg][2].y, IN[seg][2].z, IN[seg][2].w}; \
            _Pragma("unroll") for (int i = 0; i < 8; ++i) { const float xm = (i & 1) ? bfhi(pmw[i >> 1]) : bflo(pmw[i >> 1]), xc = (i & 1) ? bfhi(pcw[i >> 1]) : bflo(pcw[i >> 1]), xn = (i & 1) ? bfhi(pnw[i >> 1]) : bflo(pnw[i >> 1]); \
                const LAS float* wp = wl + seg * 256 + cg * 8 + i; o[seg][i] = xm * wp[0] + xc * wp[64] + xn * wp[128] + wp[192]; } } \
        float vgv[8]; \
        _Pragma("unroll") for (int i = 0; i < 8; ++i) vgv[i] = o[2][i] * o[1][i]; \
        v4u w; w.x = cvt_pk_bf16(o[0][0], o[0][1]); w.y = cvt_pk_bf16(o[0][2], o[0][3]); w.z = cvt_pk_bf16(o[0][4], o[0][5]); w.w = cvt_pk_bf16(o[0][6], o[0][7]); \
        *(v4u*)(X0 + (size_t)r * D + c) = w; \
        __syncthreads(); \
        _Pragma("unroll") for (int i = 0; i < 8; ++i) tl[(cg * 8 + i) * 65 + tt] = vgv[i]; \
        __syncthreads(); \
        { const int cc = F.tid >> 3, ts = (F.tid & 7) * 8; const LAS float* sp = tl + cc * 65 + ts; \
          if (lat) *(v4u*)((bf16*)VT + ((size_t)b * 1024 + c0 + cc) * SEQ + s0 + ts) = (v4u){cvt_pk_bf16(sp[0], sp[1]), cvt_pk_bf16(sp[2], sp[3]), cvt_pk_bf16(sp[4], sp[5]), cvt_pk_bf16(sp[6], sp[7])};        \
          else { float* dst = VTC + ((size_t)b * 1024 + c0 + cc) * CL + s0 + ts; *(f32x4*)dst = (f32x4){sp[0], sp[1], sp[2], sp[3]}; *(f32x4*)(dst + 4) = (f32x4){sp[4], sp[5], sp[6], sp[7]}; } } } while (0)
    int u = F.bx;
    if (u < NU) HP_LOAD(u, pa);
    for (; u < NU; u += 2 * F.G) {
        if (u + F.G < NU) HP_LOAD(u + F.G, pb);
        HP_UNIT(u, pa);
        if (u + F.G >= NU) break;
        if (u + 2 * F.G < NU) HP_LOAD(u + 2 * F.G, pa);
        HP_UNIT(u + F.G, pb);
    }
    __syncthreads();
#undef HP_LOAD
#undef HP_UNIT
}
__device__ __forceinline__ void hyena_post_phase(Frame& F) {
    LAS float* tl = (LAS float*)F.lds;
    const bf16* X0 = (const bf16*)(F.ws + WS_X0); const bf16* VG = (const bf16*)(F.ws + WS_VG); bf16* Y = (bf16*)(F.ws + WS_Y);
    const float* VT = (const float*)(F.ws + WS_CT); const float* VTC = (const float*)(F.ws + WS_CTC); const float* dsk = PIN(F, I_HD);
    const int tt = F.tid >> 3, cg = F.tid & 7;
    constexpr int NU = (MT / 64) * 16;
    struct PIn { f32x4 a, bq; v4u cw, x0; } qa, qb;
#define HQ_LOAD(u_, IN) do { const int tb_ = (u_) >> 4, c0_ = ((u_) & 15) * 64, r0_ = tb_ * 64; const bool lat_ = r0_ < ML; \
        const int b_ = lat_ ? (r0_ >> 13) : ((r0_ - ML) >> 8), s0_ = lat_ ? (r0_ & (SEQ - 1)) : ((r0_ - ML) & (CL - 1)); const int cc_ = F.tid >> 3, ts_ = (F.tid & 7) * 8; \
        if (lat_) IN.cw = *(const v4u*)((const bf16*)VT + ((size_t)b_ * 1024 + c0_ + cc_) * SEQ + s0_ + ts_);        \
        else { const float* src_ = VTC + ((size_t)b_ * 1024 + c0_ + cc_) * CL + s0_ + ts_; IN.a = *(const f32x4*)src_; IN.bq = *(const f32x4*)(src_ + 4); } \
        IN.x0 = *(const v4u*)(X0 + (size_t)(r0_ + tt) * D + c0_ + cg * 8); } while (0)
#define HQ_UNIT(u_, IN) do { \
        const int tb = (u_) >> 4, c0 = ((u_) & 15) * 64; const int r0 = tb * 64; \
        __syncthreads(); \
        { const int cc = F.tid >> 3, ts = (F.tid & 7) * 8; LAS float* dp = tl + cc * 65 + ts; \
          if (r0 < ML) { dp[0] = bflo(IN.cw.x); dp[1] = bfhi(IN.cw.x); dp[2] = bflo(IN.cw.y); dp[3] = bfhi(IN.cw.y); dp[4] = bflo(IN.cw.z); dp[5] = bfhi(IN.cw.z); dp[6] = bflo(IN.cw.w); dp[7] = bfhi(IN.cw.w); } \
          else { dp[0] = IN.a.x; dp[1] = IN.a.y; dp[2] = IN.a.z; dp[3] = IN.a.w; dp[4] = IN.bq.x; dp[5] = IN.bq.y; dp[6] = IN.bq.z; dp[7] = IN.bq.w; } } \
        __syncthreads(); \
        const int r = r0 + tt, c = c0 + cg * 8; \
        const unsigned x0w[4] = {IN.x0.x, IN.x0.y, IN.x0.z, IN.x0.w}; float y[8]; \
        _Pragma("unroll") for (int i = 0; i < 8; ++i) { const float xx = (i & 1) ? bfhi(x0w[i >> 1]) : bflo(x0w[i >> 1]); y[i] = tl[(cg * 8 + i) * 65 + tt] * xx; }        \
        v4u w; w.x = cvt_pk_bf16(y[0], y[1]); w.y = cvt_pk_bf16(y[2], y[3]); w.z = cvt_pk_bf16(y[4], y[5]); w.w = cvt_pk_bf16(y[6], y[7]); \
        *(v4u*)(Y + (size_t)r * D + c) = w; } while (0)
    int u = F.bx;
    if (u < NU) HQ_LOAD(u, qa);
    for (; u < NU; u += 2 * F.G) {
        if (u + F.G < NU) HQ_LOAD(u + F.G, qb);
        HQ_UNIT(u, qa);
        if (u + F.G >= NU) break;
        if (u + 2 * F.G < NU) HQ_LOAD(u + 2 * F.G, qa);
        HQ_UNIT(u + F.G, qb);
    }
    __syncthreads();
#undef HQ_LOAD
#undef HQ_UNIT
}
__device__ __forceinline__ bool phase_nonempty(int ph) {
    if (ph < PH_L0 || ph >= PH_FINAL) return true;
    const int layer = (ph - PH_L0) / PH_PER_LAYER, lp = (ph - PH_L0) % PH_PER_LAYER, kind = layer % 3;
    if (lp == LP_MIX2) return kind != 1;
    if (lp == LP_MIX3) return kind == 2;
    return true;
}
__global__ void __launch_bounds__(NTHREADS, 2) mk_fwd(Args args) {
    extern __shared__ __attribute__((aligned(16))) unsigned char lds[];
    Frame F0;
    F0.lds = (LAS unsigned char*)lds; F0.MISC = (volatile LAS unsigned*)(F0.lds + MISC_OFF);
    F0.tid = threadIdx.x; F0.lane = F0.tid & 63; F0.wave = __builtin_amdgcn_readfirstlane(F0.tid >> 6);
    F0.G = gridDim.x; F0.bx = blockIdx.x; F0.out = args.out; F0.ws = args.ws; F0.ctl = (gu32*)(args.ws + WS_CTL);
    for (int u = F0.tid; u < MISC_BYTES / 4; u += NTHREADS) F0.MISC[u] = 0u;
    __syncthreads();
    if (F0.tid < 36) { const unsigned long long p = (unsigned long long)args.in[F0.tid]; F0.MISC[MW_PTRS + 2 * F0.tid] = (unsigned)p; F0.MISC[MW_PTRS + 2 * F0.tid + 1] = (unsigned)(p >> 32); }
    __syncthreads();
    const int lo = args.ph_lo, hi = args.ph_hi;
    const bool multi = (hi - lo) > 1;
    XcdBarrier bar; bar.bar = (unsigned*)(F0.ctl + CW_BAR); bar.x = 0; bar.st = nullptr; bar.w = F0.wave;
    if (multi) bar = xcd_barrier_post((unsigned*)(F0.ctl + CW_BAR), F0.MISC + 8, F0.wave);
#ifndef PHMASK
#define PHMASK 0xFFFF
#endif
#define EN(b) ((PHMASK >> (b)) & 1)
#ifndef MK_STAG_IN
#define MK_STAG_IN 0u
#define MK_STAG_OUT 0u
#define MK_STAG_M1 0u
#define MK_STAG_M2 0u
#endif
#ifndef KMASK
#define KMASK 7
#endif
#define KEN(b) ((KMASK >> (b)) & 1)
#define IN(k) (lo <= (k) && (k) < hi)
#define SEAM(k) do { if ((k) + 1 < hi) xcd_barrier(bar); } while (0)
#define PB(id) for (int _rep = 0, _n = ((id) == MK_REPEAT ? MK_NREP : 1); _rep < _n; ++_rep) {
#define PE(id) if (_rep + 1 < _n) xcd_barrier(bar); } SEAM(id);

    if (EN(0) && IN(PH_PRO0)) { PB(PH_PRO0) Frame F = phase_frame(F0); pro0_mod(F); __syncthreads(); pro0_transposes(F); pro0_filter_mlp(F); PE(PH_PRO0) }
    if (EN(1) && IN(PH_PRO1)) { PB(PH_PRO1) Frame F = phase_frame(F0); pro1_router_split(F); pro1_filters(F); PE(PH_PRO1) }

#pragma unroll 1
    for (int layer = 0; layer < NLAYER; ++layer) {
        const int kind = layer % 3, jj = layer / 3, pb = PH_L0 + layer * PH_PER_LAYER; const bool last = layer == NLAYER - 1;
        if (EN(2) && IN(pb + LP_NORM1)) { PB(pb + LP_NORM1) Frame F = phase_frame(F0); rowpass<0>(F, layer, _rep + 1 == _n, kind != 1); PE(pb + LP_NORM1) }
        if (EN(3) && IN(pb + LP_INPROJ)) { PB(pb + LP_INPROJ)
            Frame F = phase_frame(F0);
            if (kind != 1) {
                const int N = kind == 0 ? 1536 : 3072;
                pg8::DenseSchedT<true> S; S.init(F.ws + WS_H8, kind == 0 ? F.ws + WS_WATT + (size_t)jj * 1536 * 1024 : F.ws + WS_WHY, MT, N, F.G, F.bx, 1024);
                pg8::EpiBf16 E{(bf16*)(F.ws + WS_P), N, (float*)(F.ws + WS_SS), 0};
                pg8::gemm_phase<pg8::EpiBf16, pg8::DenseSchedT<true>, true, true>(F.lds, S, E, F.wave, false, MK_STAG_IN);
            } else {
                const int N = 2048;
                pg8::DenseSched S; S.init(F.ws + WS_H, F.ws + WS_WGM, MT, N, F.G, F.bx);
                pg8::EpiBf16 E{(bf16*)(F.ws + WS_P), N, (float*)(F.ws + WS_SS), 1};
                pg8::gemm_phase<pg8::EpiBf16, pg8::DenseSched, false>(F.lds, S, E, F.wave, false, MK_STAG_IN);
            }
            PE(pb + LP_INPROJ)
        }
        if (IN(pb + LP_MIX1)) { PB(pb + LP_MIX1)
            Frame F = phase_frame(F0);
            if (EN(4) && kind == 0) qkprep_phase(F, jj); else if (EN(5) && kind == 1) gmlp_mix_phase(F); else if (EN(6)) hyena_prep_phase(F);
            PE(pb + LP_MIX1)
        }
        if (IN(pb + LP_MIX2) && kind != 1) { PB(pb + LP_MIX2)
            Frame F = phase_frame(F0);
            if (EN(7) && kind == 0) {
#if MK_XP >= 10 && MK_XP < 20
                if (_rep + 1 < _n) attention_phase<MK_XP - 10>(F, (char*)lds, !last, jj); else
#endif
                attention_phase<0>(F, (char*)lds, !last, jj); }
            else if (EN(8)) hyena_conv_phase(F);
            PE(pb + LP_MIX2)
        }
        if (EN(9) && IN(pb + LP_MIX3) && kind == 2) { PB(pb + LP_MIX3) Frame F = phase_frame(F0); hyena_post_phase(F); PE(pb + LP_MIX3) }
        if (EN(10) && IN(pb + LP_OUTPROJ)) { PB(pb + LP_OUTPROJ)
            Frame F = phase_frame(F0); const float* modl = (const float*)(F.ws + WS_MOD) + (size_t)layer * 9 * 6144;
            pg8::DenseSched S; S.init(F.ws + WS_Y, F.ws + WS_WOUT + (size_t)layer * 1024 * 1024 * 2, last ? ML : MT, 1024, F.G, F.bx);
            pg8::EpiResid E{(bf16*)(F.ws + WS_XB), modl};
            pg8::gemm_phase<pg8::EpiResid, pg8::DenseSched, false>(F.lds, S, E, F.wave, false, MK_STAG_OUT);
            PE(pb + LP_OUTPROJ)
        }
        if (EN(11) && IN(pb + LP_NORM2)) { PB(pb + LP_NORM2) Frame F = phase_frame(F0); router_phase(F, layer, _rep + 1 == _n, (_rep + 1 < _n) ? MK_XP : 0); PE(pb + LP_NORM2) }
        if (EN(12) && IN(pb + LP_MOE1)) { PB(pb + LP_MOE1)
            Frame F = phase_frame(F0);
            moe_tables(F, layer);
            pg8::MoeSched S{(const char*)(F.ws + WS_H8), (const char*)(F.ws + WS_WE1) + (size_t)layer * NE * 2048 * 1024, (size_t)2048 * 1024, (const int*)(F.ws + WS_ROWTOK),
                            (const volatile LAS int*)(F.MISC + MW_CUMBLK), (const volatile LAS int*)(F.MISC + MW_CNT), 3, F.G, F.bx, 1024, (const volatile LAS int*)(F.lds + AUX_OFF + 1024)};
            S.build_list((volatile LAS int*)(F.lds + AUX_OFF + 1024), F.tid); __syncthreads();
            pg8::EpiSwiglu E{(unsigned char*)(F.ws + WS_ACT), PIN(F, I_EB1) + (size_t)layer * NE * 2048, (LAS float*)(F.lds + AUX_OFF)};
#if MK_XP >= 20
            if (_rep + 1 < _n) { int one_ = 1; asm volatile("" : "+s"(one_)); pg8::gemm_phase<pg8::EpiSwiglu, pg8::MoeSched, true, true, MK_XP - 20>(F.lds, S, E, F.wave, one_ != 0, MK_STAG_M1); } else
#endif
            pg8::gemm_phase<pg8::EpiSwiglu, pg8::MoeSched, true, true>(F.lds, S, E, F.wave, MK_XP == 1 && _rep + 1 < _n, MK_STAG_M1);
            PE(pb + LP_MOE1)
        }
        if (EN(13) && IN(pb + LP_MOE2)) { PB(pb + LP_MOE2)
            Frame F = phase_frame(F0);
            moe_tables(F, layer);
            pg8::MoeSched S{(const char*)(F.ws + WS_ACT), (const char*)(F.ws + WS_WE2) + (size_t)layer * NE * 1024 * 1024, (size_t)1024 * 1024, nullptr,
                            (const volatile LAS int*)(F.MISC + MW_CUMBLK), (const volatile LAS int*)(F.MISC + MW_CNT), 2, F.G, F.bx, 1024, (const volatile LAS int*)(F.lds + AUX_OFF + 1024)};
            S.build_list((volatile LAS int*)(F.lds + AUX_OFF + 1024), F.tid); __syncthreads();
            pg8::EpiBias E{(unsigned char*)(F.ws + WS_YM), PIN(F, I_EB2) + (size_t)layer * NE * 1024, (LAS float*)(F.lds + AUX_OFF)};
            pg8::gemm_phase<pg8::EpiBias, pg8::MoeSched, true, true>(F.lds, S, E, F.wave, MK_XP == 1 && _rep + 1 < _n, MK_STAG_M2);
            PE(pb + LP_MOE2)
        }
    }
    if (EN(14) && IN(PH_FINAL)) { PB(PH_FINAL) Frame F = phase_frame(F0); rowpass<2>(F, NLAYER - 1, _rep + 1 == _n); PE(PH_FINAL) }
#undef IN
#undef SEAM
}

static bool host_phase_nonempty(int ph) {
    if (ph < PH_L0 || ph >= PH_FINAL) return true;
    const int layer = (ph - PH_L0) / PH_PER_LAYER, lp = (ph - PH_L0) % PH_PER_LAYER, kind = layer % 3;
    if (lp == LP_MIX2) return kind != 1;
    if (lp == LP_MIX3) return kind == 2;
    return true;
}
extern "C" void kernel_launch(void* const* d_in, const int* in_sizes, int n_in, void* d_out, int out_size, void* d_ws, size_t ws_size, hipStream_t stream) {
    static int grid = 0;
    if (grid == 0) {
        if (n_in != 36 || in_sizes[0] != ML * D || out_size != ML * D || ws_size < WS_END) {
            fprintf(stderr, "kernel_launch: built for 36 inputs, x/out of %d floats, >= %zu bytes of workspace; got n_in %d in0 %d out %d ws %zu; nothing launched\n", ML * D, (size_t)WS_END, n_in, n_in > 0 ? in_sizes[0] : -1, out_size, ws_size);
            grid = -1; return; }
        int dev = 0, cus = 0, per_cu = 0;
        if (hipGetDevice(&dev) != hipSuccess || hipDeviceGetAttribute(&cus, hipDeviceAttributeMultiprocessorCount, dev) != hipSuccess) { fprintf(stderr, "kernel_launch: device query failed\n"); grid = -1; return; }
        if (hipFuncSetAttribute((const void*)mk_fwd, hipFuncAttributeMaxDynamicSharedMemorySize, LDS_BYTES) != hipSuccess) { fprintf(stderr, "kernel_launch: hipFuncSetAttribute(%d B LDS) failed\n", LDS_BYTES); grid = -1; return; }
        if (hipOccupancyMaxActiveBlocksPerMultiprocessor(&per_cu, (const void*)mk_fwd, NTHREADS, LDS_BYTES) != hipSuccess || per_cu < 1)
            fprintf(stderr, "kernel_launch: note: occupancy query reports %d workgroups per CU\n", per_cu);
        (void)hipGetLastError();
        grid = cus;
    }
    if (grid < 0) return;
    if (hipMemsetAsync((char*)d_ws + WS_CTL, 0, CTL_ZERO_BYTES, stream) != hipSuccess) { fprintf(stderr, "kernel_launch: memset failed\n"); return; }
    Args a{};
    for (int i = 0; i < 36; ++i) a.in[i] = (const float*)d_in[i];
    a.out = (float*)d_out; a.ws = (unsigned char*)d_ws;
#if MK_MULTI || MK_DBG
    for (int ph = 0; ph < PH_COUNT; ++ph) {
        if (!host_phase_nonempty(ph)) continue;
        a.ph_lo = ph; a.ph_hi = ph + 1;
        hipLaunchKernelGGL(mk_fwd, dim3(grid), dim3(NTHREADS), LDS_BYTES, stream, a);
#if MK_DBG
        dbg_after_phase(ph, a, stream);
#endif
    }
#if MK_DBG
    dbg_report(a, stream);
#endif
#else
    a.ph_lo = 0; a.ph_hi = PH_COUNT;
    hipLaunchKernelGGL(mk_fwd, dim3(grid), dim3(NTHREADS), LDS_BYTES, stream, a);
#endif
    const hipError_t le = hipPeekAtLastError();
    if (le != hipSuccess) fprintf(stderr, "kernel_launch: launch failed: %s\n", hipGetErrorName(le));
}
```

```cpp
#include <hip/hip_runtime.h>
#include <cstdio>
#include <cstdint>
#include <cmath>

#ifndef MK_MULTI
#define MK_MULTI 0
#endif
#ifndef MK_REPEAT
#define MK_REPEAT -1
#endif
#ifndef MK_NREP
#define MK_NREP 1
#endif
#ifndef MK_XP
#define MK_XP 0
#endif
#ifndef MK_MOEMAP
#define MK_MOEMAP 0
#endif
#ifndef MK_DBG
#define MK_DBG 0
#endif

constexpr int D = 1024, NB = 8, SEQ = 8192, CL = 256, ML = NB * SEQ, MC = NB * CL, MT = ML + MC;
constexpr int NLAYER = 4, NE = 32, TOPK = 4, SKV = SEQ + CL;
constexpr int MOE_MAXBLK = (MT * TOPK) / 256 + NE;
constexpr float EPS = 1e-6f;
constexpr int FH = 64, FEMB = 33, NFFT = 16384;

constexpr size_t MiB = 1u << 20;
constexpr size_t WS_CTL = 0, CTL_ZERO_BYTES = 1 * MiB;
constexpr size_t WS_MOD = 1 * MiB;
constexpr size_t WS_A3 = 2 * MiB;
constexpr size_t WS_A3C = 4 * MiB;
constexpr size_t WS_RC = 4 * MiB + 512 * 1024;
constexpr size_t WS_FCT = 5 * MiB;
constexpr size_t WS_WATT = 8 * MiB;
constexpr size_t WS_WGM = 14 * MiB;
constexpr size_t WS_WHY = 18 * MiB;
constexpr size_t WS_WOUT = 24 * MiB;
constexpr size_t WS_RW3 = 32 * MiB;
constexpr size_t WS_TE = 40 * MiB;
constexpr size_t WS_TR = 42 * MiB;
constexpr size_t WS_TG = 44 * MiB;
constexpr size_t WS_SS = 46 * MiB;
constexpr size_t WS_ROWTOK = 52 * MiB;
constexpr size_t WS_KF = 64 * MiB;
constexpr size_t WS_WE1 = 192 * MiB;
constexpr size_t WS_WE2 = 704 * MiB;
constexpr size_t WS_H = 960 * MiB;
constexpr size_t WS_P = 1092 * MiB;
constexpr size_t WS_Y = 1488 * MiB;
constexpr size_t WS_QB = 1620 * MiB;
constexpr size_t WS_K8_OFF = 72 * MiB;
constexpr size_t WS_KVB = 1752 * MiB;
constexpr size_t WS_X0 = 1818 * MiB;
constexpr size_t WS_VG = 1950 * MiB;
constexpr size_t WS_VT = 2082 * MiB;
constexpr size_t WS_VTC = 2338 * MiB;
constexpr size_t WS_ACT = 2346 * MiB;
constexpr size_t WS_YM = 2890 * MiB;
constexpr size_t WS_CT = 3434 * MiB;
constexpr size_t WS_CTC = 3690 * MiB;
constexpr size_t WS_H8 = 3698 * MiB;
constexpr size_t WS_XB = 3764 * MiB;
constexpr size_t WS_END = 3896 * MiB;
constexpr int CW_BAR = 4096;
constexpr int CW_CNT = 16384;
constexpr int CW_DBG = 32768;

constexpr int RING_BYTES = 131072;
constexpr int AUX_OFF = RING_BYTES;
constexpr int AUX_BYTES = 16384;
constexpr int MISC_OFF = AUX_OFF + AUX_BYTES;
constexpr int MISC_BYTES = 4096;
constexpr int LDS_BYTES = MISC_OFF + MISC_BYTES;

#define GAS __attribute__((address_space(1)))
#define LAS __attribute__((address_space(3)))
typedef unsigned short bf16;
typedef unsigned v4u __attribute__((ext_vector_type(4)));
typedef unsigned v2u __attribute__((ext_vector_type(2)));
typedef float f32x4 __attribute__((ext_vector_type(4)));
typedef float f32x2 __attribute__((ext_vector_type(2)));
typedef float f32x16 __attribute__((ext_vector_type(16)));
typedef short bf16x8 __attribute__((ext_vector_type(8)));
typedef short s16x4 __attribute__((ext_vector_type(4)));
typedef int i32x4 __attribute__((ext_vector_type(4)));
typedef GAS unsigned gu32;
#define RLX_AGENT __ATOMIC_RELAXED, __HIP_MEMORY_SCOPE_AGENT
#define LDS_WAIT() asm volatile("s_waitcnt lgkmcnt(0)" ::: "memory")
#define VM_WAIT() asm volatile("s_waitcnt vmcnt(0)" ::: "memory")
__device__ __forceinline__ int opaque_tid(int wave) { int l; asm volatile("v_mbcnt_lo_u32_b32 %0, -1, 0\n\tv_mbcnt_hi_u32_b32 %0, -1, %0" : "=v"(l)); return (wave << 6) | l; }
__device__ __forceinline__ unsigned f2bf(float f) { unsigned u = __builtin_bit_cast(unsigned, f); return (u + 0x7fffu + ((u >> 16) & 1u)) >> 16; }
__device__ __forceinline__ unsigned pk2(float lo, float hi) { return f2bf(lo) | (f2bf(hi) << 16); }
__device__ __forceinline__ float bf2f(unsigned short b) { return __builtin_bit_cast(float, ((unsigned)b) << 16); }
__device__ __forceinline__ float bflo(unsigned w) { return __builtin_bit_cast(float, w << 16); }
__device__ __forceinline__ float bfhi(unsigned w) { return __builtin_bit_cast(float, w & 0xffff0000u); }
__device__ __forceinline__ f32x4 bf4_f32(v2u w) { return (f32x4){__uint_as_float(w.x << 16), __uint_as_float(w.x & 0xffff0000u), __uint_as_float(w.y << 16), __uint_as_float(w.y & 0xffff0000u)}; }
__device__ __forceinline__ unsigned cvt_pk_bf16(float lo, float hi) { unsigned r; asm volatile("v_cvt_pk_bf16_f32 %0, %1, %2" : "=v"(r) : "v"(lo), "v"(hi)); return r; }
__device__ __forceinline__ float shx(float v, int mask, int lane) { return __int_as_float(__builtin_amdgcn_ds_bpermute((lane ^ mask) << 2, __float_as_int(v))); }
__device__ __forceinline__ float wave_sum(float v, int lane) {
#pragma unroll
    for (int o = 1; o < 64; o <<= 1) v += shx(v, o, lane);
    return v;
}

#define XB_TMO      128
#define XB_XCNT(j)  (256  + 64 * (j))
#define XB_XSUB(j)  (1280 + 64 * (j))
#define XB_XGEN(j)  (2304 + 64 * (j))
#define XB_TOP      3328
#define XB_TOPGEN   3392
#define XCD_BAR_WORDS 3456
#define XB_SPIN_CAP (1u << 22)
__device__ __forceinline__ unsigned xb_ld(unsigned* p)              { return __hip_atomic_load(p, __ATOMIC_RELAXED, __HIP_MEMORY_SCOPE_AGENT); }
__device__ __forceinline__ unsigned xb_add(unsigned* p, unsigned v) { return __hip_atomic_fetch_add(p, v, __ATOMIC_RELAXED, __HIP_MEMORY_SCOPE_AGENT); }
__device__ __forceinline__ unsigned xb_xcc_id() { return (unsigned)__builtin_amdgcn_s_getreg((3 << 11) | 20) & 0xFu; }
#define XB_SPIN(cond, bar) do { unsigned _sp = 0; while (cond) { __builtin_amdgcn_s_sleep(1); \
    if ((++_sp & 255u) == 0u) { if (xb_ld(&(bar)[XB_TMO])) break; if (_sp > XB_SPIN_CAP) { atomicAdd(&(bar)[XB_TMO], 1u); break; } } } } while (0)
struct XcdBarrier { unsigned* bar; unsigned x; volatile LAS unsigned* st; int w; };
__device__ __forceinline__ bool xb_thread0(int w) { return opaque_tid(w) == 0; }
__device__ __forceinline__ XcdBarrier xcd_barrier_post(unsigned* bar, volatile LAS unsigned* st, int w) {
    XcdBarrier b; b.bar = bar; b.x = xb_xcc_id(); b.st = st; b.w = w;
    if (xb_thread0(w)) (void)xb_add(&bar[XB_XCNT(b.x)], 1u);
    return b;
}
__device__ __forceinline__ void xcd_barrier_complete(unsigned* bar, unsigned x, unsigned& nloc, unsigned& nx) {
    const unsigned G = gridDim.x * gridDim.y * gridDim.z;
    unsigned sum, cnt, mine, sp = 0u;
    for (;;) {
        sum = 0u; cnt = 0u; mine = 0u;
#pragma unroll
        for (unsigned j = 0; j < 16; ++j) { const unsigned c = xb_ld(&bar[XB_XCNT(j)]); sum += c; cnt += (c > 0u) ? 1u : 0u; mine = (j == x) ? c : mine; }
        if (sum == G) break;
        __builtin_amdgcn_s_sleep(1);
        if ((++sp & 255u) == 0u) { if (xb_ld(&bar[XB_TMO])) break; if (sp > XB_SPIN_CAP) { atomicAdd(&bar[XB_TMO], 1u); break; } }
    }
    nloc = mine > 0u ? mine : 1u; nx = cnt > 0u ? cnt : 1u;
}
__device__ __forceinline__ void xcd_barrier(const XcdBarrier& b) {
    asm volatile("s_waitcnt vmcnt(0)" ::: "memory");
    __syncthreads();
    if (xb_thread0(b.w)) {
        unsigned* bar = b.bar;
        __builtin_amdgcn_s_waitcnt(0);
        unsigned nloc = b.st[0], nx = b.st[1];
        if (nloc == 0u) { xcd_barrier_complete(bar, b.x, nloc, nx); b.st[0] = nloc; b.st[1] = nx; }
        const unsigned old = xb_add(&bar[XB_XSUB(b.x)], 1u);
        const unsigned gen = old / nloc;
        if (old + 1u == (gen + 1u) * nloc) {
            __builtin_amdgcn_fence(__ATOMIC_RELEASE, "agent");
            asm volatile("s_waitcnt vmcnt(0)" ::: "memory");
            const unsigned og = xb_add(&bar[XB_TOP], 1u);
            const unsigned tg = og / nx;
            if (og + 1u == (tg + 1u) * nx) xb_add(&bar[XB_TOPGEN], 1u);
            else XB_SPIN(xb_ld(&bar[XB_TOPGEN]) == tg, bar);
            __builtin_amdgcn_fence(__ATOMIC_ACQUIRE, "agent");
            xb_add(&bar[XB_XGEN(b.x)], 1u);
            asm volatile("s_waitcnt vmcnt(0)" ::: "memory");
        } else {
            XB_SPIN(xb_ld(&bar[XB_XGEN(b.x)]) == gen, bar);
            __builtin_amdgcn_fence(__ATOMIC_ACQUIRE, "agent");
            asm volatile("s_waitcnt vmcnt(0)" ::: "memory");
        }
    }
    __syncthreads();
}

namespace pg8 {
constexpr int BM = 256, BK = 64, HALF = 128, HTB = HALF * BK * 2, STAGE_BYTES = 8 * HTB, NXCD = 8, WGM = 8;
constexpr int GK = 1024;
__device__ __forceinline__ int lds_byte(int r, int c) { const int st = (r >> 4) * 2 + (c >> 5), rr = r & 15, cc = c & 31, ob = rr * 64 + cc * 2; return st * 1024 + (ob ^ (((ob >> 9) & 1) << 5)); }
__device__ __forceinline__ void stage_rc(int b, int& R, int& C) { const int st = b / 1024, sb = b % 1024, swz = sb ^ (((sb >> 9) & 1) << 5); R = (st >> 1) * 16 + swz / 64; C = (st & 1) * 32 + (swz % 64) / 2; }
__device__ __forceinline__ int perm32(int rho) { const int n = rho >> 4, i = rho & 15; return 8 * (i >> 2) + 4 * n + (i & 3); }
struct Unit { int pm, pn, e; };

template <bool IDG> struct DenseSchedT {
    const char* A; const char* Bt; int nM, nN, nwg, G, c, kb;
    __device__ __forceinline__ void init(const void* A_, const void* Bt_, int M, int N, int G_, int c_, int kb_ = GK * 2) { A = (const char*)A_; Bt = (const char*)Bt_; nM = M / BM; nN = N / BM; nwg = nM * nN; G = G_; c = c_; kb = kb_; }
    __device__ __forceinline__ bool next(int i, Unit& u) const {
        const long L = (long)i * G + c; if (L >= nwg) return false;
        int wgid = (int)L; { const int q = nwg / NXCD, r = nwg % NXCD, xcd = wgid % NXCD, off = wgid / NXCD; wgid = (xcd < r ? xcd * (q + 1) : r * (q + 1) + (xcd - r) * q) + off; }
        const int nig = WGM * nN, gid = wgid / nig, fm = gid * WGM, gsz = (nM - fm) < WGM ? (nM - fm) : WGM;
        u.pm = fm + ((wgid % nig) % gsz); u.pn = (wgid % nig) / gsz; u.e = 0; return true;
    }
    __device__ __forceinline__ const char* a_ptr(const Unit& u) const { return IDG ? A : A + (size_t)u.pm * (size_t)(BM * kb); }
    __device__ __forceinline__ const char* b_ptr(const Unit& u) const { return Bt + (size_t)u.pn * (size_t)(BM * kb); }
    __device__ __forceinline__ void a_offs(const Unit& u, const int (&R)[2], const int (&C)[2], unsigned (&voff)[2][2]) const {
#pragma unroll
        for (int h = 0; h < 2; ++h)
#pragma unroll
            for (int i = 0; i < 2; ++i) voff[h][i] = (unsigned)(u.pm * BM + h * HALF + R[i]) * (unsigned)kb + (unsigned)C[i] * 2u;
    }
    __device__ __forceinline__ void a_raw(const Unit&, const int (&)[2], int (&)[2][2]) const {}
    __device__ __forceinline__ void a_fin(const Unit& u, const int (&R)[2], const int (&C)[2], const int (&)[2][2], unsigned (&voff)[2][2]) const { a_offs(u, R, C, voff); }
};
typedef DenseSchedT<false> DenseSched;
struct MoeSched {
    const char* A; const char* Bt; size_t b_estride; const int* rowtok; const volatile LAS int* cumblk; const volatile LAS int* cnt; int ncol_log2, G, c, kb; const volatile LAS int* ulist;
    __device__ __forceinline__ bool next(int i, Unit& u) const {
        const int v = ulist[i & 63]; if (v < 0) return false;
        u.pm = v >> 8; u.e = (v >> 3) & 31; u.pn = v & 7; return true;
    }
    __device__ __forceinline__ void build_list(volatile LAS int* dst, int tid) const {
        if (tid < 64) { Unit u; dst[tid] = search(tid, u) ? ((u.pm << 8) | (u.e << 3) | u.pn) : -1; }
    }
    __device__ __forceinline__ bool search(int i, Unit& u) const {
        int gb, pn; const int ncol = 1 << ncol_log2;
        if (G == 256 && MK_MOEMAP == 0) { const int xcd = c & 7, j = c >> 3, rpb = 256 >> ncol_log2; gb = i * rpb + xcd + 8 * (j >> ncol_log2); pn = j & (ncol - 1); }
        else { const long L = (long)i * G + c; gb = (int)(L >> ncol_log2); pn = (int)(L & (ncol - 1)); }
        const int tot = cumblk[NE]; if (gb >= tot) return false;
        int e = 0;
#pragma unroll 1
        for (int s = 16; s >= 1; s >>= 1) { if (cumblk[e + s] <= gb) e += s; }
        u.pm = gb; u.pn = pn; u.e = e; return true;
    }
    __device__ __forceinline__ const char* a_ptr(const Unit&) const { return A; }
    __device__ __forceinline__ const char* b_ptr(const Unit& u) const { return Bt + (size_t)u.e * b_estride + (size_t)u.pn * (size_t)(BM * kb); }
    __device__ __forceinline__ void a_raw(const Unit& u, const int (&R)[2], int (&raw)[2][2]) const {
        if (!rowtok) return;
        const int rb = u.pm - cumblk[u.e]; const int* rt = rowtok + (size_t)u.e * MT;
#pragma unroll
        for (int h = 0; h < 2; ++h)
#pragma unroll
            for (int i = 0; i < 2; ++i) { const int* ptr = rt + (rb * 256 + h * HALF + R[i]);
                asm volatile("global_load_dword %0, %1, off" : "=v"(raw[h][i]) : "v"(ptr) : "memory"); }
    }
    __device__ __forceinline__ void a_fin(const Unit& u, const int (&R)[2], const int (&C)[2], const int (&raw_)[2][2], unsigned (&voff)[2][2]) const {
        int raw[2][2] = {{raw_[0][0], raw_[0][1]}, {raw_[1][0], raw_[1][1]}};
        asm volatile("" : "+v"(raw[0][0]), "+v"(raw[0][1]), "+v"(raw[1][0]), "+v"(raw[1][1]));
        const int rb = u.pm - cumblk[u.e], n = cnt[u.e];
#pragma unroll
        for (int h = 0; h < 2; ++h)
#pragma unroll
            for (int i = 0; i < 2; ++i) { const int rank = rb * 256 + h * HALF + R[i]; const int tok = rowtok ? (rank < n ? raw[h][i] : 0) : u.pm * BM + h * HALF + R[i];
                voff[h][i] = (unsigned)tok * (unsigned)kb + (unsigned)C[i] * 2u; }
    }
    __device__ __forceinline__ void a_offs(const Unit& u, const int (&R)[2], const int (&C)[2], unsigned (&voff)[2][2]) const { int raw[2][2] = {{0, 0}, {0, 0}}; a_raw(u, R, raw); asm volatile("s_waitcnt vmcnt(0)" : "+v"(raw[0][0]), "+v"(raw[0][1]), "+v"(raw[1][0]), "+v"(raw[1][1]) :: "memory"); a_fin(u, R, C, raw, voff); }
};

typedef int v8i __attribute__((ext_vector_type(8)));
__device__ __forceinline__ v8i cat8(bf16x8 lo, bf16x8 hi) { const v4u a = __builtin_bit_cast(v4u, lo), b = __builtin_bit_cast(v4u, hi); return (v8i){(int)a.x, (int)a.y, (int)a.z, (int)a.w, (int)b.x, (int)b.y, (int)b.z, (int)b.w}; }
template <class Epi, class Sched, bool GATHER, bool FP8 = false, int XG = 0>
__device__ __forceinline__ void gemm_phase(LAS unsigned char* lds, const Sched& S, const Epi& E, int wave_id, bool skip_epi = false, unsigned stagger_ticks = 0u) {
    if (stagger_ticks && ((blockIdx.x >> 3) & 1u)) { const unsigned long long t0 = __builtin_amdgcn_s_memrealtime(); while (__builtin_amdgcn_s_memrealtime() - t0 < (unsigned long long)stagger_ticks) __builtin_amdgcn_s_sleep(8); }
    const int tid = opaque_tid(wave_id), wid = __builtin_amdgcn_readfirstlane(tid >> 6), lane = tid & 63, wr = wid >> 2, wc = wid & 3, fr = lane & 15, fq = lane >> 4;
    constexpr int KB = FP8 ? GK : GK * 2, nt = KB / (BK * 2);
    unsigned voffA[2][2], voffB[2]; int Rr[2], Cc[2];
#pragma unroll
    for (int i = 0; i < 2; ++i) { int R, C; stage_rc(tid * 16 + i * 8192, R, C); Rr[i] = R; Cc[i] = C; const int Rb = Epi::PERM ? ((R & ~31) + perm32(R & 31)) : R;
        voffA[0][i] = (unsigned)(R * KB + C * 2); voffA[1][i] = (unsigned)((R + HALF) * KB + C * 2); voffB[i] = (unsigned)(Rb * KB + C * 2); }
    constexpr size_t kstep = (size_t)(BK * 2);
    constexpr size_t hstep = (size_t)HALF * KB;
    const unsigned ldsw = (unsigned)wid * 1024u;
    const int aoff = lds_byte(wr * 64 + fr, fq * 8), boff = lds_byte(wc * 32 + fr, fq * 8);
    LAS unsigned char* abase = lds + aoff; LAS unsigned char* bbase = lds + 4 * HTB + boff; asm volatile("" : "+v"(abase), "+v"(bbase));
#define PG8_SA(b, h) (((b) * 2 + (h)) * HTB)
#define PG8_SB(b, h) ((4 + (b) * 2 + (h)) * HTB)
#define PG8_STAGE(bufoff, gbase, voff) do { if (XG == 3) break; _Pragma("unroll") for (int _i = 0; _i < 2; ++_i) \
        __builtin_amdgcn_global_load_lds((const unsigned*)((const char*)(gbase) + (voff)[_i]), (LAS unsigned*)(lds + (bufoff) + ldsw + _i * 8192), 16, 0, 0); } while (0)
#define PG8_STAGE_A(bufoff, gbase, h) PG8_STAGE(bufoff, gbase, voffA[h])
#define PG8_RDA(off) (*(const LAS v4u*)(abase + (off)))
#define PG8_RDB(off) (*(const LAS v4u*)(bbase + (off)))
#define PG8_LDA(dst, b, h) do { if (XG == 2) break; _Pragma("unroll") for (int m = 0; m < 4; ++m) { const v4u _l = PG8_RDA(PG8_SA(b, h) + m * 2048), _h = PG8_RDA(PG8_SA(b, h) + m * 2048 + 1024); \
        if constexpr (FP8) dst##8[m] = (v8i){(int)_l.x, (int)_l.y, (int)_l.z, (int)_l.w, (int)_h.x, (int)_h.y, (int)_h.z, (int)_h.w}; \
        else { dst[m][0] = __builtin_bit_cast(bf16x8, _l); dst[m][1] = __builtin_bit_cast(bf16x8, _h); } } } while (0)
#define PG8_LDB(dst, b, h) do { if (XG == 2) break; _Pragma("unroll") for (int n = 0; n < 2; ++n) { const v4u _l = PG8_RDB(PG8_SA(b, h) + n * 2048), _h = PG8_RDB(PG8_SA(b, h) + n * 2048 + 1024); \
        if constexpr (FP8) dst##8[n] = (v8i){(int)_l.x, (int)_l.y, (int)_l.z, (int)_l.w, (int)_h.x, (int)_h.y, (int)_h.z, (int)_h.w}; \
        else { dst[n][0] = __builtin_bit_cast(bf16x8, _l); dst[n][1] = __builtin_bit_cast(bf16x8, _h); } } } while (0)
#define PG8_MMA(ai, bj, At, Bt) do { if (XG == 1) break; __builtin_amdgcn_s_setprio(1); _Pragma("unroll") for (int m = 0; m < 4; ++m) _Pragma("unroll") for (int n = 0; n < 2; ++n) { \
        if constexpr (FP8) acc[ai][bj][m][n] = __builtin_amdgcn_mfma_scale_f32_16x16x128_f8f6f4(Bt##8[n], At##8[m], acc[ai][bj][m][n], 0, 0, 0, 0x7A7A7A7A, 0, 0x7F7F7F7F); \
        else { _Pragma("unroll") for (int k = 0; k < 2; ++k) acc[ai][bj][m][n] = __builtin_amdgcn_mfma_f32_16x16x32_bf16(Bt[n][k], At[m][k], acc[ai][bj][m][n], 0, 0, 0); } } \
        __builtin_amdgcn_s_setprio(0); } while (0)
#define PG8_WAIT_V(n) asm volatile("s_waitcnt vmcnt(" #n ")" ::: "memory")
#define PG8_WAIT_L(n) asm volatile("s_waitcnt lgkmcnt(" #n ")" ::: "memory")
#define PG8_BAR __builtin_amdgcn_s_barrier()
#define PG8_SCHED __builtin_amdgcn_sched_barrier(0)
    Unit cur, nxt; int ui = 0;
    if (!S.next(0, cur)) return;
    f32x4 acc[2][2][4][2];
#pragma unroll
    for (int a = 0; a < 2; ++a)
#pragma unroll
        for (int b = 0; b < 2; ++b)
#pragma unroll
            for (int m = 0; m < 4; ++m)
#pragma unroll
                for (int n = 0; n < 2; ++n) acc[a][b][m][n] = (f32x4){0.f, 0.f, 0.f, 0.f};
    bf16x8 At[4][2], B0[2][2], B1[2][2]; v8i At8[4], B08[2], B18[2];
    if constexpr (XG == 2) { _Pragma("unroll") for (int m = 0; m < 4; ++m) { asm volatile("" : "=v"(At8[m])); } _Pragma("unroll") for (int n = 0; n < 2; ++n) { asm volatile("" : "=v"(B08[n])); asm volatile("" : "=v"(B18[n])); } }
    const char* cA = S.a_ptr(cur); const char* cB = S.b_ptr(cur);
    if constexpr (GATHER) S.a_offs(cur, Rr, Cc, voffA);
    PG8_STAGE(PG8_SB(0, 0), cB, voffB); PG8_STAGE(PG8_SB(0, 1), cB + hstep, voffB); PG8_STAGE_A(PG8_SA(0, 0), cA, 0); PG8_STAGE_A(PG8_SA(0, 1), cA, 1);
    if (wr == 1) PG8_BAR;
    PG8_WAIT_V(2); PG8_BAR;
    PG8_STAGE(PG8_SB(1, 0), cB + kstep, voffB); PG8_STAGE_A(PG8_SA(1, 0), cA + kstep, 0); PG8_STAGE(PG8_SB(1, 1), cB + hstep + kstep, voffB);
    PG8_WAIT_V(6); PG8_BAR;
    for (;;) {
        const bool has_next = S.next(ui + 1, nxt);
        const char* nA = has_next ? S.a_ptr(nxt) : cA; const char* nB = has_next ? S.b_ptr(nxt) : cB;
        int rawN[2][2] = {{0, 0}, {0, 0}};
        if constexpr (GATHER) { if (has_next) S.a_raw(nxt, Rr, rawN); }
#pragma unroll 1
        for (int t = 0; t < nt; t += 2) {
            const bool last = (t == nt - 2);
            if constexpr (Epi::LDSBIAS) { if (last && wid == 0) E.stage_bias(cur, lane); }
            const char* a1 = cA + (size_t)(t + 1) * kstep;
            const char* a2 = last ? nA : cA + (size_t)(t + 2) * kstep; const char* b2 = last ? nB : cB + (size_t)(t + 2) * kstep;
            const char* a3 = a2 + kstep; const char* b3 = b2 + kstep;
            PG8_LDB(B0, 0, 0); PG8_LDB(B1, 0, 1); PG8_SCHED; PG8_LDA(At, 0, 0); PG8_STAGE_A(PG8_SA(1, 1), a1, 1);
            if constexpr (GATHER) { if (last && has_next) S.a_fin(nxt, Rr, Cc, rawN, voffA); }
            PG8_WAIT_V(8); PG8_WAIT_L(0); PG8_BAR; PG8_MMA(0, 0, At, B0); PG8_MMA(0, 1, At, B1); PG8_BAR; PG8_SCHED;
            PG8_LDA(At, 0, 1); PG8_STAGE(PG8_SB(0, 0), b2, voffB); PG8_STAGE(PG8_SB(0, 1), b2 + hstep, voffB); PG8_STAGE_A(PG8_SA(0, 0), a2, 0);
            PG8_WAIT_V(8); PG8_WAIT_L(0); PG8_BAR; PG8_MMA(1, 0, At, B0); PG8_MMA(1, 1, At, B1); PG8_BAR; PG8_SCHED;
            PG8_LDB(B0, 1, 0); PG8_LDB(B1, 1, 1); PG8_SCHED; PG8_LDA(At, 1, 0); PG8_STAGE_A(PG8_SA(0, 1), a2, 1);
            PG8_WAIT_V(8); PG8_WAIT_L(0); PG8_BAR; PG8_MMA(0, 0, At, B0); PG8_MMA(0, 1, At, B1); PG8_BAR; PG8_SCHED;
            PG8_LDA(At, 1, 1); PG8_STAGE(PG8_SB(1, 0), b3, voffB); PG8_STAGE(PG8_SB(1, 1), b3 + hstep, voffB); PG8_STAGE_A(PG8_SA(1, 0), a3, 0);
            PG8_WAIT_V(8); PG8_WAIT_L(0); PG8_BAR; PG8_MMA(1, 0, At, B0); PG8_MMA(1, 1, At, B1); PG8_BAR; PG8_SCHED;
        }
        if (wr == 0) PG8_BAR;
        if (!skip_epi) E(acc, cur, wr, wc, fr, fq);
        if (!has_next) break;
#pragma unroll
        for (int a = 0; a < 2; ++a)
#pragma unroll
            for (int b = 0; b < 2; ++b)
#pragma unroll
                for (int m = 0; m < 4; ++m)
#pragma unroll
                    for (int n = 0; n < 2; ++n) acc[a][b][m][n] = (f32x4){0.f, 0.f, 0.f, 0.f};
        cur = nxt; cA = nA; cB = nB; ++ui;
        if (wr == 1) PG8_BAR;
    }
    PG8_WAIT_V(0);
    PG8_BAR;
#undef PG8_SA
#undef PG8_SB
#undef PG8_STAGE
#undef PG8_STAGE_A
#undef PG8_LDA
#undef PG8_RDA
#undef PG8_RDB
#undef PG8_LDB
#undef PG8_MMA
#undef PG8_WAIT_V
#undef PG8_WAIT_L
#undef PG8_BAR
#undef PG8_SCHED
}
}
namespace pg8 {
__device__ __forceinline__ f32x2 gelu_pk(f32x2 v) {
    const f32x2 av = __builtin_elementwise_abs(v), d = av * 0.2316418882f + 1.0f;
    f32x2 t; t.x = __builtin_amdgcn_rcpf(d.x); t.y = __builtin_amdgcn_rcpf(d.y);
    f32x2 q = t * 0.5307027145f + (-0.7265760135f); q = q * t + 0.7107068705f; q = q * t + (-0.142248368f); q = q * t + 0.127414796f; q = q * t;
    const f32x2 s = (v * v) * (-0.72134752044f);
    f32x2 e; e.x = __builtin_amdgcn_exp2f(s.x); e.y = __builtin_amdgcn_exp2f(s.y);
    const f32x2 m = v * (q * e), r = v - m;
    f32x2 o; o.x = v.x < 0.f ? m.x : r.x; o.y = v.y < 0.f ? m.y : r.y; return o;
}
struct EpiBf16 {
    static constexpr bool PERM = true, LDSBIAS = false;
    bf16* O; int ldc; float* ss; int ACT;
    __device__ __forceinline__ void operator()(const f32x4 (&acc)[2][2][4][2], const Unit& u, int wr, int wc, int fr, int fq) const {
        const int row0 = u.pm * BM + wr * 64 + fr, col0 = u.pn * BM + wc * 32 + 8 * fq;
#pragma unroll
        for (int ai = 0; ai < 2; ++ai)
#pragma unroll
            for (int m = 0; m < 4; ++m) { const int row = row0 + ai * HALF + m * 16; bf16* rowp = O + (size_t)row * ldc + col0; float sq = 0.f;
#pragma unroll
                for (int bj = 0; bj < 2; ++bj) { f32x4 v0 = acc[ai][bj][m][0], v1 = acc[ai][bj][m][1];
                    if (ACT == 1) { f32x2 a = gelu_pk((f32x2){v0[0], v0[1]}), b = gelu_pk((f32x2){v0[2], v0[3]}), c = gelu_pk((f32x2){v1[0], v1[1]}), d = gelu_pk((f32x2){v1[2], v1[3]});
                        v0 = (f32x4){a.x, a.y, b.x, b.y}; v1 = (f32x4){c.x, c.y, d.x, d.y};
                        sq += (v0[0] * v0[0] + v0[1] * v0[1]) + (v0[2] * v0[2] + v0[3] * v0[3]) + (v1[0] * v1[0] + v1[1] * v1[1]) + (v1[2] * v1[2] + v1[3] * v1[3]); }
                    v4u w; w.x = cvt_pk_bf16(v0[0], v0[1]); w.y = cvt_pk_bf16(v0[2], v0[3]); w.z = cvt_pk_bf16(v1[0], v1[1]); w.w = cvt_pk_bf16(v1[2], v1[3]);
                    *(v4u*)(rowp + bj * HALF) = w; }
                if (ACT == 1) { const int ln = (fq << 4) | fr; sq += shx(sq, 16, ln); sq += shx(sq, 32, ln);
                    if (u.pn >= 4 && fq == 0) ss[(size_t)row * 16 + (u.pn - 4) * 4 + wc] = sq; }
            }
    }
};
struct EpiResid {
    static constexpr bool PERM = false, LDSBIAS = false;
    bf16* xb; const float* modl;
    __device__ __forceinline__ void operator()(const f32x4 (&acc)[2][2][4][2], const Unit& u, int wr, int wc, int fr, int fq) const {
        const bool lat = u.pm < ML / BM; const int bidx = lat ? (u.pm >> 5) : 8;
        bf16* base = xb + (size_t)u.pm * BM * D;
        const float* g = modl + bidx * 6144 + 2 * 1024;
        const int r0 = wr * 64 + fr, col0 = u.pn * BM + wc * 32 + 4 * fq;
        f32x4 gv[2][2];
#pragma unroll
        for (int bj = 0; bj < 2; ++bj)
#pragma unroll
            for (int n = 0; n < 2; ++n) gv[bj][n] = *(const f32x4*)(g + col0 + bj * HALF + n * 16);
        const int odd = fq & 1, colp = col0 - 4 * odd;
#pragma unroll
        for (int ai = 0; ai < 2; ++ai) { v4u bs[2][2][2];
#pragma unroll
            for (int mp = 0; mp < 2; ++mp) { const size_t off = (size_t)(r0 + ai * HALF + (2 * mp + odd) * 16) * D + colp;
#pragma unroll
                for (int bj = 0; bj < 2; ++bj)
#pragma unroll
                    for (int n = 0; n < 2; ++n) bs[mp][bj][n] = *(const v4u*)(base + off + bj * HALF + n * 16); }
#pragma unroll
            for (int mp = 0; mp < 2; ++mp) { const size_t off = (size_t)(r0 + ai * HALF + (2 * mp + odd) * 16) * D + colp;
#pragma unroll
                for (int bj = 0; bj < 2; ++bj)
#pragma unroll
                    for (int n = 0; n < 2; ++n) { const v4u L = bs[mp][bj][n];
                        const auto s0 = __builtin_amdgcn_permlane16_swap(L.x, L.z, false, false), s1 = __builtin_amdgcn_permlane16_swap(L.y, L.w, false, false);
                        const f32x4 va = bf4_f32((v2u){s0[0], s1[0]}) + gv[bj][n] * acc[ai][bj][2 * mp][n], vb = bf4_f32((v2u){s0[1], s1[1]}) + gv[bj][n] * acc[ai][bj][2 * mp + 1][n];
                        const auto t0 = __builtin_amdgcn_permlane16_swap(cvt_pk_bf16(va.x, va.y), cvt_pk_bf16(vb.x, vb.y), false, false), t1 = __builtin_amdgcn_permlane16_swap(cvt_pk_bf16(va.z, va.w), cvt_pk_bf16(vb.z, vb.w), false, false);
                        *(v4u*)(base + off + bj * HALF + n * 16) = (v4u){t0[0], t1[0], t0[1], t1[1]}; } }
            asm volatile("" ::: "memory"); }
    }
};
struct EpiSwiglu {
    static constexpr bool PERM = true, LDSBIAS = true;
    unsigned char* O; const float* b1; LAS float* bl;
    __device__ __forceinline__ void stage_bias(const Unit& u, int lane) const { const float* src = b1 + (size_t)u.e * 2048 + (lane < 32 ? u.pn * HALF + 4 * lane : 1024 + u.pn * HALF + 4 * (lane - 32));
        __builtin_amdgcn_global_load_lds((const unsigned*)src, (LAS unsigned*)bl, 16, 0, 0); }
    __device__ __forceinline__ void operator()(const f32x4 (&acc)[2][2][4][2], const Unit& u, int wr, int wc, int fr, int fq) const {
        const int row0 = u.pm * BM + wr * 64 + fr, cl = wc * 32 + 8 * fq, c0 = u.pn * HALF + cl;
        f32x4 bg[2], bli[2];
#pragma unroll
        for (int n = 0; n < 2; ++n) { bg[n] = *(const LAS f32x4*)(bl + cl + 4 * n); bli[n] = *(const LAS f32x4*)(bl + 128 + cl + 4 * n) + 1.0f; }
#pragma unroll
        for (int ai = 0; ai < 2; ++ai)
#pragma unroll
            for (int mp = 0; mp < 4; mp += 2) { v2u wv[2];
#pragma unroll
              for (int mm = 0; mm < 2; ++mm) { const int m = mp + mm; float o[8];
#pragma unroll
                for (int n = 0; n < 2; ++n)
#pragma unroll
                    for (int j = 0; j < 4; ++j) { const float gl = fminf(acc[ai][0][m][n][j] + bg[n][j], 7.0f), lp = __builtin_amdgcn_fmed3f(acc[ai][1][m][n][j] + bli[n][j], -6.0f, 8.0f);
                        const float sg = __builtin_amdgcn_rcpf(1.0f + __builtin_amdgcn_exp2f(gl * (-1.702f * 1.4426950408889634f)));
                        o[n * 4 + j] = gl * sg * lp; }
                v2u w; w.x = 0; w.y = 0;
                w.x = __builtin_amdgcn_cvt_pk_fp8_f32(o[0], o[1], w.x, false); w.x = __builtin_amdgcn_cvt_pk_fp8_f32(o[2], o[3], w.x, true);
                w.y = __builtin_amdgcn_cvt_pk_fp8_f32(o[4], o[5], w.y, false); w.y = __builtin_amdgcn_cvt_pk_fp8_f32(o[6], o[7], w.y, true);
                wv[mm] = w; }
              const auto sx = __builtin_amdgcn_permlane16_swap(wv[0].x, wv[1].x, false, false), sy = __builtin_amdgcn_permlane16_swap(wv[0].y, wv[1].y, false, false);
              *(v4u*)(O + (size_t)(row0 + ai * HALF + (mp + (fq & 1)) * 16) * D + (c0 - 8 * (fq & 1))) = (v4u){sx[0], sy[0], sx[1], sy[1]}; }
    }
};
struct EpiBias {
    static constexpr bool PERM = true, LDSBIAS = true;
    unsigned char* O; const float* b2; LAS float* bl;
    __device__ __forceinline__ void stage_bias(const Unit& u, int lane) const { __builtin_amdgcn_global_load_lds((const unsigned*)(b2 + (size_t)u.e * 1024 + u.pn * BM + 4 * lane), (LAS unsigned*)bl, 16, 0, 0); }
    __device__ __forceinline__ void operator()(const f32x4 (&acc)[2][2][4][2], const Unit& u, int wr, int wc, int fr, int fq) const {
        const int row0 = u.pm * BM + wr * 64 + fr, cl = wc * 32 + 8 * fq, col0 = u.pn * BM + cl;
#pragma unroll
        for (int bj = 0; bj < 2; ++bj) { const f32x4 bv0 = *(const LAS f32x4*)(bl + cl + bj * HALF), bv1 = *(const LAS f32x4*)(bl + cl + bj * HALF + 4);
#pragma unroll
            for (int ai = 0; ai < 2; ++ai)
#pragma unroll
                for (int mp = 0; mp < 4; mp += 2) { v2u wv[2];
#pragma unroll
                    for (int mm = 0; mm < 2; ++mm) { const int m = mp + mm; const f32x4 v0 = acc[ai][bj][m][0] + bv0, v1 = acc[ai][bj][m][1] + bv1;
                        v2u w; w.x = 0; w.y = 0;
                        w.x = __builtin_amdgcn_cvt_pk_fp8_f32(v0[0], v0[1], w.x, false); w.x = __builtin_amdgcn_cvt_pk_fp8_f32(v0[2], v0[3], w.x, true);
                        w.y = __builtin_amdgcn_cvt_pk_fp8_f32(v1[0], v1[1], w.y, false); w.y = __builtin_amdgcn_cvt_pk_fp8_f32(v1[2], v1[3], w.y, true);
                        wv[mm] = w; }
                    const auto sx = __builtin_amdgcn_permlane16_swap(wv[0].x, wv[1].x, false, false), sy = __builtin_amdgcn_permlane16_swap(wv[0].y, wv[1].y, false, false);
                    *(v4u*)(O + (size_t)(row0 + ai * HALF + (mp + (fq & 1)) * 16) * D + (col0 - 8 * (fq & 1)) + bj * HALF) = (v4u){sx[0], sy[0], sx[1], sy[1]}; }
            asm volatile("" ::: "memory"); }
    }
};
}

namespace att {
constexpr int AD = 128, NW = 8, QBLK = 32, KVBLK = 64;
constexpr float SCALE = 0.088388347648318440f;
constexpr int LDO = 1024;
constexpr int SHM_V = AD * KVBLK, SHM_K = KVBLK * AD, SHM_ATTN = 4 * SHM_V + 4 * SHM_K;
typedef int v8i __attribute__((ext_vector_type(8)));
#define K8SW(key, c) ((key) * 128 + ((((c) ^ (((key) >> 1) & 7))) << 4))
#define V8SW(d, c) ((d) * 64 + ((((c) ^ (((d) >> 2) & 3))) << 4))
#define SBAR() __builtin_amdgcn_sched_barrier(0)
__device__ __forceinline__ int crow(int r, int hi) { return (r & 3) + 8 * (r >> 2) + 4 * hi; }
template <int XV = 0>
__device__ __forceinline__ int exp4(float a0, float a1, float a2, float a3) {
  float t0 = fminf(a0 + 8.0f, 8.0f), t1 = fminf(a1 + 8.0f, 8.0f), t2 = fminf(a2 + 8.0f, 8.0f), t3 = fminf(a3 + 8.0f, 8.0f); int w;
  asm volatile("v_exp_f32 %1, %1\n\tv_exp_f32 %2, %2\n\tv_exp_f32 %3, %3\n\tv_exp_f32 %4, %4\n\t"
               "v_cvt_pk_fp8_f32 %0, %1, %2\n\ts_nop 0\n\tv_cvt_pk_fp8_f32 %0, %3, %4 op_sel:[0,0,1]"
               : "=&v"(w), "+v"(t0), "+v"(t1), "+v"(t2), "+v"(t3));
  return w;
}
template <int PAD>
__device__ __forceinline__ int expc4(float a0, float a1, float a2, float a3) {
  int w; float t0, t1, t2, t3;
  if constexpr (PAD != 0)
    asm volatile("s_nop 5\n\tv_exp_f32_e64 %1, %5 clamp\n\tv_exp_f32_e64 %2, %6 clamp\n\tv_exp_f32_e64 %3, %7 clamp\n\tv_exp_f32_e64 %4, %8 clamp\n\t"
                 "v_cvt_scalef32_pk_fp8_f32 %0, %1, %2, %9\n\ts_nop 0\n\tv_cvt_scalef32_pk_fp8_f32 %0, %3, %4, %9 op_sel:[0,0,0,1]"
                 : "=&v"(w), "=&v"(t0), "=&v"(t1), "=&v"(t2), "=&v"(t3) : "v"(a0), "v"(a1), "v"(a2), "v"(a3), "s"(0x3B800000));
  else
    asm volatile("v_exp_f32_e64 %1, %5 clamp\n\tv_exp_f32_e64 %2, %6 clamp\n\tv_exp_f32_e64 %3, %7 clamp\n\tv_exp_f32_e64 %4, %8 clamp\n\t"
                 "v_cvt_scalef32_pk_fp8_f32 %0, %1, %2, %9\n\ts_nop 0\n\tv_cvt_scalef32_pk_fp8_f32 %0, %3, %4, %9 op_sel:[0,0,0,1]"
                 : "=&v"(w), "=&v"(t0), "=&v"(t1), "=&v"(t2), "=&v"(t3) : "v"(a0), "v"(a1), "v"(a2), "v"(a3), "s"(0x3B800000));
  return w;
}
#define EXC4(P, m, PAD) expc4<PAD>(P[4 * (m)], P[4 * (m) + 1], P[4 * (m) + 2], P[4 * (m) + 3])
typedef int v4i __attribute__((ext_vector_type(4)));
__device__ __forceinline__ void partialSM(const f32x16& p0, float nb, v4i& plo) {
#pragma unroll
  for (int m = 0; m < 4; ++m) plo[m] = exp4(p0[4 * m], p0[4 * m + 1], p0[4 * m + 2], p0[4 * m + 3]);
}
__device__ __forceinline__ void finishSM(const f32x16& p1, float nb, const v4i& plo, v8i& pa) {
  v4i phi;
#pragma unroll
  for (int m = 0; m < 4; ++m) phi[m] = exp4(p1[4 * m], p1[4 * m + 1], p1[4 * m + 2], p1[4 * m + 3]);
  pa = (v8i){plo[0], plo[1], plo[2], plo[3], phi[0], phi[1], phi[2], phi[3]};
}
__device__ __forceinline__ void qkt(f32x16& p0, f32x16& p1, const char* Ks, const v8i* q8, int r32, int hi, const f32x16& NBV) {
  p0 = NBV; p1 = NBV;
#pragma unroll
  for (int s = 0; s < 2; ++s) { const int c0 = 4 * s + 2 * hi;
    const v4u a0 = *reinterpret_cast<const v4u*>(Ks + K8SW(r32, c0)), a1 = *reinterpret_cast<const v4u*>(Ks + K8SW(r32, c0 + 1));
    const v4u b0 = *reinterpret_cast<const v4u*>(Ks + K8SW(32 + r32, c0)), b1 = *reinterpret_cast<const v4u*>(Ks + K8SW(32 + r32, c0 + 1));
    const v8i A0 = (v8i){(int)a0.x, (int)a0.y, (int)a0.z, (int)a0.w, (int)a1.x, (int)a1.y, (int)a1.z, (int)a1.w};
    const v8i A1 = (v8i){(int)b0.x, (int)b0.y, (int)b0.z, (int)b0.w, (int)b1.x, (int)b1.y, (int)b1.z, (int)b1.w};
    p0 = __builtin_amdgcn_mfma_scale_f32_32x32x64_f8f6f4(A0, q8[s], p0, 0, 0, 0, 0x7F7F7F7F, 0, 0x7C7C7C7C);
    p1 = __builtin_amdgcn_mfma_scale_f32_32x32x64_f8f6f4(A1, q8[s], p1, 0, 0, 0, 0x7F7F7F7F, 0, 0x7C7C7C7C); }
}
__device__ __forceinline__ void pv_d0(f32x16* o, f32x16& lacc, const char* Vs, v8i pa, int r32, int hi) {
  { const int one = 0x38383838; const v8i ONES = (v8i){one, one, one, one, one, one, one, one};
    lacc = __builtin_amdgcn_mfma_scale_f32_32x32x64_f8f6f4(pa, ONES, lacc, 0, 0, 0, 0x7F7F7F7F, 0, 0x7F7F7F7F); }
#pragma unroll
  for (int d0 = 0; d0 < 4; ++d0) { const int d = 32 * d0 + r32;
    const v4u b0 = *reinterpret_cast<const v4u*>(Vs + V8SW(d, 2 * hi)), b1 = *reinterpret_cast<const v4u*>(Vs + V8SW(d, 2 * hi + 1));
    const v8i B = (v8i){(int)b0.x, (int)b0.y, (int)b0.z, (int)b0.w, (int)b1.x, (int)b1.y, (int)b1.z, (int)b1.w};
    o[d0] = __builtin_amdgcn_mfma_scale_f32_32x32x64_f8f6f4(pa, B, o[d0], 0, 0, 0, 0x7F7F7F7F, 0, 0x7F7F7F7F); }
}
__device__ __forceinline__ v8i lds32(const char* p0, const char* p1) { const v4u a = *reinterpret_cast<const v4u*>(p0), b = *reinterpret_cast<const v4u*>(p1);
  return (v8i){(int)a.x, (int)a.y, (int)a.z, (int)a.w, (int)b.x, (int)b.y, (int)b.z, (int)b.w}; }
#define MF8(A, B, C, SB) ((XV == 3 || XV == 4 || XV == 5 || XV == 9) ? (C) : __builtin_amdgcn_mfma_scale_f32_32x32x64_f8f6f4(A, B, C, 0, 0, 0, 0x7F7F7F7F, 0, SB))
#define EX4(P, m) exp4<XV>(P[4 * (m)], P[4 * (m) + 1], P[4 * (m) + 2], P[4 * (m) + 3])
template <int XV = 0>
__device__ __forceinline__ void tile_step(f32x16& pN0, f32x16& pN1, const f32x16& pP1, const v4i& ploP, v4i& ploN, f32x16* o, f32x16& lacc,
                                          const char* Ks, const char* Vs, const v8i* q8, int r32, int hi, const f32x16& Z) {
  const int one = 0x38383838; const v8i ONES = (v8i){one, one, one, one, one, one, one, one};
  v4i phi;
  const v8i A00 = lds32(Ks + K8SW(r32, 2 * hi), Ks + K8SW(r32, 2 * hi + 1)), A10 = lds32(Ks + K8SW(32 + r32, 2 * hi), Ks + K8SW(32 + r32, 2 * hi + 1));
  const v8i A01 = lds32(Ks + K8SW(r32, 4 + 2 * hi), Ks + K8SW(r32, 4 + 2 * hi + 1)), A11 = lds32(Ks + K8SW(32 + r32, 4 + 2 * hi), Ks + K8SW(32 + r32, 4 + 2 * hi + 1));
  phi[0] = EXC4(pP1, 0, 0); SBAR();
  pN0 = MF8(A00, q8[0], Z, 0x7C7C7C7C);   SBAR(); const v8i V0 = lds32(Vs + V8SW(r32, 2 * hi), Vs + V8SW(r32, 2 * hi + 1));           phi[1] = EXC4(pP1, 1, 0); SBAR();
  pN0 = MF8(A01, q8[1], pN0, 0x7C7C7C7C); SBAR(); const v8i V1 = lds32(Vs + V8SW(32 + r32, 2 * hi), Vs + V8SW(32 + r32, 2 * hi + 1)); phi[2] = EXC4(pP1, 2, 0); SBAR();
  pN1 = MF8(A10, q8[0], Z, 0x7C7C7C7C);   SBAR(); const v8i V2 = lds32(Vs + V8SW(64 + r32, 2 * hi), Vs + V8SW(64 + r32, 2 * hi + 1)); phi[3] = EXC4(pP1, 3, 0); SBAR();
  pN1 = MF8(A11, q8[1], pN1, 0x7C7C7C7C); SBAR(); const v8i V3 = lds32(Vs + V8SW(96 + r32, 2 * hi), Vs + V8SW(96 + r32, 2 * hi + 1)); SBAR();
  const v8i pa = (v8i){ploP[0], ploP[1], ploP[2], ploP[3], phi[0], phi[1], phi[2], phi[3]};
  lacc = MF8(pa, ONES, lacc, 0x7F7F7F7F); SBAR(); ploN[0] = EXC4(pN0, 0, 1); SBAR();
  o[0] = MF8(pa, V0, o[0], 0x7F7F7F7F);   SBAR(); ploN[1] = EXC4(pN0, 1, 0); SBAR();
  o[1] = MF8(pa, V1, o[1], 0x7F7F7F7F);   SBAR(); ploN[2] = EXC4(pN0, 2, 0); SBAR();
  o[2] = MF8(pa, V2, o[2], 0x7F7F7F7F);   SBAR(); ploN[3] = EXC4(pN0, 3, 0); SBAR();
  o[3] = MF8(pa, V3, o[3], 0x7F7F7F7F);   SBAR();
}
template <int XV = 0>
__device__ __forceinline__ void attn_dense_body(const unsigned char* __restrict__ Q8, const unsigned char* __restrict__ K8, const unsigned char* __restrict__ VT, int vt_ld, bf16* __restrict__ Ob, int seq, char* lds, int wave_id, float nb) {
  const int tid = opaque_tid(wave_id), wid = tid >> 6, lane = tid & 63, r32 = lane & 31, hi = lane >> 5;
  char* V_lds = lds; char* K_lds = lds + 4 * SHM_V;
  f32x16 lacc = {}; f32x16 o[4] = {}; v8i qr[2]; f32x16 NBV;
#pragma unroll
  for (int i = 0; i < 16; ++i) NBV[i] = nb;
  { const unsigned char* Qw = Q8 + (long)(wid * QBLK + r32) * 1024 + hi * 32;
#pragma unroll
    for (int s2 = 0; s2 < 2; ++s2) { const v4u a = *reinterpret_cast<const v4u*>(Qw + 64 * s2), b = *reinterpret_cast<const v4u*>(Qw + 64 * s2 + 16);
      qr[s2] = (v8i){(int)a.x, (int)a.y, (int)a.z, (int)a.w, (int)b.x, (int)b.y, (int)b.z, (int)b.w}; } }
  struct { v4u vs, ks; } sr_[1];
  const int kkey = tid >> 3, kch = tid & 7; const unsigned koff = (unsigned)(kkey * 256 + kch * 16); const int kst = K8SW(kkey, kch);
  const int vd = tid >> 2, vc = tid & 3; const unsigned voff = (unsigned)(vd * vt_ld + vc * 16); const int vst = V8SW(vd, vc);
#define SLOAD(i, k0) do { if (XV >= 7) break; sr_[i].vs = *reinterpret_cast<const v4u*>((const char*)VT + (size_t)(k0) + voff); \
    sr_[i].ks = *reinterpret_cast<const v4u*>((const char*)K8 + (size_t)(k0) * 256 + koff); } while (0)
#define SWRITE(b, i) do { *(v4u*)(V_lds + (b) * SHM_V + vst) = sr_[i].vs; *(v4u*)(K_lds + (b) * SHM_K + kst) = sr_[i].ks; } while (0)
#define SWAIT() asm volatile("s_waitcnt vmcnt(0)" ::: "memory")
#define TBAR() asm volatile("s_waitcnt lgkmcnt(0)\n\ts_barrier" ::: "memory")
  f32x16 pA0, pA1, pB0, pB1; v8i pa; v4i plA, plB; const int NT = seq / KVBLK;
  SLOAD(0, 0); SWAIT(); SWRITE(0, 0); SLOAD(0, KVBLK); TBAR();
  qkt(pA0, pA1, K_lds, qr, r32, hi, NBV); partialSM(pA0, nb, plA);
  SWAIT(); SWRITE(1, 0); SLOAD(0, 2 * KVBLK); TBAR();
#define STEP_IO(t, SW) do { SWAIT(); SWRITE(SW, 0); { const int tn = (t) + 2 < NT ? (t) + 2 : NT - 1; SLOAD(0, tn * KVBLK); } SBAR(); } while (0)
#define STEP_B(t, SK, SV, SW) do { STEP_IO(t, SW); tile_step<XV>(pB0, pB1, pA1, plA, plB, o, lacc, K_lds + (SK) * SHM_K, V_lds + (SV) * SHM_V, qr, r32, hi, NBV); TBAR(); } while (0)
#define STEP_A(t, SK, SV, SW) do { STEP_IO(t, SW); tile_step<XV>(pA0, pA1, pB1, plB, plA, o, lacc, K_lds + (SK) * SHM_K, V_lds + (SV) * SHM_V, qr, r32, hi, NBV); TBAR(); } while (0)
  int j = 1;
  for (; j + 5 < NT; j += 4) { STEP_B(j, 1, 0, 2); STEP_A(j + 1, 2, 1, 3); STEP_B(j + 2, 3, 2, 0); STEP_A(j + 3, 0, 3, 1); }
  STEP_B(j, 1, 0, 2); STEP_A(j + 1, 2, 1, 3);
  SBAR(); qkt(pB0, pB1, K_lds + 3 * SHM_K, qr, r32, hi, NBV);
  finishSM(pA1, nb, plA, pa); SBAR();
  pv_d0(o, lacc, V_lds + 2 * SHM_V, pa, r32, hi); partialSM(pB0, nb, plB);
  finishSM(pB1, nb, plB, pa); SBAR();
  pv_d0(o, lacc, V_lds + 3 * SHM_V, pa, r32, hi);
  { const int ln2 = opaque_tid(wave_id) & 63, r32e = ln2 & 31, hie = ln2 >> 5;
    bf16* Ow = Ob + (long)(wid * QBLK) * LDO;
#pragma unroll
    for (int r = 0; r < 16; ++r) { const int orow = crow(r, hie); const float rl = __builtin_amdgcn_rcpf(lacc[r]);
      for (int d0 = 0; d0 < 4; ++d0) Ow[(long)orow * LDO + d0 * 32 + r32e] = (bf16)f2bf(o[d0][r] * rl); } }
  __syncthreads();
#undef SLOAD
#undef TBAR
#undef STEP_IO
#undef STEP_A
#undef STEP_B
#undef SWRITE
#undef SWAIT
}
#undef K8SW
#undef V8SW
}
constexpr int NWAVES = 8, NTHREADS = 512;
struct Args { const float* in[36]; float* out; unsigned char* ws; int ph_lo, ph_hi; };
enum InIdx { I_X = 0, I_C, I_CTX, I_CCTX, I_ADAW, I_ADAB, I_N1G, I_N2G, I_WOUT, I_RW, I_RB, I_EW1, I_EB1, I_EW2, I_EB2, I_AWIN, I_AQG, I_AKG,
             I_GWIN, I_GVG, I_GWS, I_GBS, I_HWIN, I_HCW, I_HCB, I_FW1, I_FB1, I_FW2, I_FB2, I_FW3, I_FB3, I_FW4, I_FB4, I_FREQ, I_HD, I_FG };
struct Frame {
    LAS unsigned char* lds; volatile LAS unsigned* MISC; gu32* ctl;
    int tid, lane, wave, G, bx;
    float* out; unsigned char* ws;
};
template <class T> __device__ __forceinline__ T* launder(T* p) { unsigned long long v = (unsigned long long)p; asm volatile("" : "+s"(v)); return (T*)(GAS T*)v; }
constexpr int MW_PTRS = 640;
__device__ __forceinline__ const float* pin_load(const Frame& F, int i) {
    const unsigned lo = __builtin_amdgcn_readfirstlane(F.MISC[MW_PTRS + 2 * i]), hi = __builtin_amdgcn_readfirstlane(F.MISC[MW_PTRS + 2 * i + 1]);
    return (const float*)(GAS const float*)(((unsigned long long)hi << 32) | lo);
}
#define PIN(F, i) pin_load(F, i)
__device__ __forceinline__ Frame phase_frame(const Frame& F0) {
    Frame F = F0; F.tid = opaque_tid(F0.wave); F.lane = F.tid & 63; F.wave = F0.wave;
    F.ws = launder(F0.ws); F.out = launder(F0.out); F.ctl = (gu32*)(F.ws + WS_CTL);
    { LAS unsigned char* l = F0.lds; asm volatile("" : "+s"(l)); F.lds = l; F.MISC = (volatile LAS unsigned*)(l + MISC_OFF); }
    return F;
}
constexpr int PH_PRO0 = 0, PH_PRO1 = 1, PH_L0 = 2, PH_PER_LAYER = 9, PH_FINAL = PH_L0 + NLAYER * PH_PER_LAYER, PH_COUNT = PH_FINAL + 1;
enum LPhase { LP_NORM1 = 0, LP_INPROJ, LP_MIX1, LP_MIX2, LP_MIX3, LP_OUTPROJ, LP_NORM2, LP_MOE1, LP_MOE2 };

struct TItem { const float* src; unsigned char* dst; int N; bool fp8; };
__device__ __forceinline__ TItem titem_decode(Frame& F, int it) {
    constexpr int R0 = 128 * 512, R1 = 128 * 256, R2 = 2 * 384, R3 = 512, R4 = 768;
    int r = it; TItem t;
    if (r < R0) { const int mi = r >> 9, q = r & 511, kb = q >> 5, nb = q & 31, n0 = nb * 64;
        const int d0 = n0 < 1024 ? 256 * (n0 >> 7) + (n0 & 127) : 256 * ((n0 - 1024) >> 7) + 128 + (n0 & 127);
        t.src = PIN(F, I_EW1) + (size_t)mi * 1024 * 2048 + (size_t)(kb * 64) * 2048 + n0; t.N = 2048; t.fp8 = true; t.dst = F.ws + WS_WE1 + (size_t)mi * 2048 * 1024 + (size_t)d0 * 1024 + kb * 64; return t; } r -= R0;
    if (r < R1) { const int mi = r >> 8, q = r & 255, kb = q >> 4, nb = q & 15;
        t.src = PIN(F, I_EW2) + (size_t)mi * 1024 * 1024 + (size_t)(kb * 64) * 1024 + nb * 64; t.N = 1024; t.fp8 = true; t.dst = F.ws + WS_WE2 + (size_t)mi * 1024 * 1024 + (size_t)(nb * 64) * 1024 + kb * 64; return t; } r -= R1;
    if (r < R2) { const int mi = r / 384, q = r % 384, kb = q / 24, nb = q % 24;
        t.src = PIN(F, I_AWIN) + (size_t)mi * 1024 * 1536 + (size_t)(kb * 64) * 1536 + nb * 64; t.N = 1536; t.fp8 = true; t.dst = F.ws + WS_WATT + (size_t)mi * 1536 * 1024 + (size_t)(nb * 64) * 1024 + kb * 64; return t; } r -= R2;
    if (r < R3) { const int kb = r >> 5, nb = r & 31;
        t.src = PIN(F, I_GWIN) + (size_t)(kb * 64) * 2048 + nb * 64; t.N = 2048; t.fp8 = false; t.dst = F.ws + WS_WGM + ((size_t)(nb * 64) * 1024 + kb * 64) * 2; return t; } r -= R3;
    if (r < R4) { const int kb = r / 48, nb = r % 48;
        t.src = PIN(F, I_HWIN) + (size_t)(kb * 64) * 3072 + nb * 64; t.N = 3072; t.fp8 = true; t.dst = F.ws + WS_WHY + (size_t)(nb * 64) * 1024 + kb * 64; return t; } r -= R4;
    { const int mi = r >> 8, q = r & 255, kb = q >> 4, nb = q & 15;
        t.src = PIN(F, I_WOUT) + (size_t)mi * 1024 * 1024 + (size_t)(kb * 64) * 1024 + nb * 64; t.N = 1024; t.fp8 = false; t.dst = F.ws + WS_WOUT + ((size_t)mi * 1024 * 1024 + (size_t)(nb * 64) * 1024 + kb * 64) * 2; return t; }
}
__device__ __forceinline__ void titem_load(const TItem& t, float (&v)[64], int lane) {
    const float* src = t.src + lane;
#pragma unroll
    for (int kk = 0; kk < 64; ++kk) v[kk] = src[(size_t)kk * t.N];
}
__device__ __forceinline__ void titem_finish(const TItem& t, const float (&v)[64], LAS float* scr, int lane) {
    constexpr int K = 1024;
#pragma unroll
    for (int kk = 0; kk < 64; ++kk) scr[kk * 65 + lane] = v[kk];
    LDS_WAIT(); asm volatile("" ::: "memory");
    if (!t.fp8) {
        const int c = lane & 7;
#pragma unroll
        for (int j = 0; j < 8; ++j) { const int n = (lane >> 3) + 8 * j; const LAS float* s = scr + (8 * c) * 65 + n;
            v4u o; o.x = pk2(s[0 * 65], s[1 * 65]); o.y = pk2(s[2 * 65], s[3 * 65]); o.z = pk2(s[4 * 65], s[5 * 65]); o.w = pk2(s[6 * 65], s[7 * 65]);
            *(GAS v4u*)(t.dst + ((size_t)n * K + 8 * c) * 2) = o; }
    } else {
        const int c = lane & 3;
#pragma unroll
        for (int j = 0; j < 4; ++j) { const int n = (lane >> 2) + 16 * j; const LAS float* s = scr + (16 * c) * 65 + n; unsigned w[4];
#pragma unroll
            for (int q = 0; q < 4; ++q) { unsigned x = 0; x = __builtin_amdgcn_cvt_pk_fp8_f32(32.0f * s[(4 * q) * 65], 32.0f * s[(4 * q + 1) * 65], x, false);
                x = __builtin_amdgcn_cvt_pk_fp8_f32(32.0f * s[(4 * q + 2) * 65], 32.0f * s[(4 * q + 3) * 65], x, true); w[q] = x; }
            *(GAS v4u*)(t.dst + (size_t)n * K + 16 * c) = (v4u){w[0], w[1], w[2], w[3]}; }
    }
    LDS_WAIT(); asm volatile("" ::: "memory");
}
__device__ __forceinline__ void pro0_transposes(Frame& F) {
    LAS float* scr = (LAS float*)(F.lds + F.wave * 16640);
    const int gw = F.bx * NWAVES + F.wave, NGW = F.G * NWAVES;
    constexpr int NITEMS = 128 * 512 + 128 * 256 + 2 * 384 + 512 + 768 + 4 * 256;
    float va[64], vb[64];
    int it = gw; if (it >= NITEMS) return;
    TItem ta = titem_decode(F, it), tb = ta; titem_load(ta, va, F.lane);
    for (;;) {
        const bool nb_ok = it + NGW < NITEMS; if (nb_ok) { tb = titem_decode(F, it + NGW); titem_load(tb, vb, F.lane); }
        titem_finish(ta, va, scr, F.lane);
        if (!nb_ok) break; it += NGW;
        const bool na_ok = it + NGW < NITEMS; if (na_ok) { ta = titem_decode(F, it + NGW); titem_load(ta, va, F.lane); }
        titem_finish(tb, vb, scr, F.lane);
        if (!na_ok) break; it += NGW;
    }
}
__device__ __forceinline__ void pro0_mod(Frame& F) {
    LAS float* sl = (LAS float*)F.lds;
    LAS float* red = (LAS float*)(F.lds + 65536);
    __syncthreads();
    for (int i = F.tid; i < 9 * 1024; i += NTHREADS) { const int r = i >> 10, k = i & 1023; const float v = r < 8 ? PIN(F, I_C)[r * 1024 + k] : PIN(F, I_CCTX)[k]; sl[i] = v / (1.0f + __expf(-v)); }
    __syncthreads();
    float* MOD = (float*)(F.ws + WS_MOD);
    for (int item = F.bx; item < NLAYER * 96; item += F.G) {
        const int l = item / 96, n0 = (item % 96) * 64;
        const float* W = PIN(F, I_ADAW) + (size_t)l * 1024 * 6144 + n0 + F.lane;
        float acc[9];
#pragma unroll
        for (int r = 0; r < 9; ++r) acc[r] = 0.f;
        const int kb = F.wave * 128;
#pragma unroll 16
        for (int k = 0; k < 128; ++k) { const float wv = W[(size_t)(kb + k) * 6144];
#pragma unroll
            for (int r = 0; r < 9; ++r) acc[r] += sl[r * 1024 + kb + k] * wv; }
#pragma unroll
        for (int r = 0; r < 9; ++r) red[(F.wave * 9 + r) * 64 + F.lane] = acc[r];
        __syncthreads();
        for (int i = F.tid; i < 9 * 64; i += NTHREADS) { const int r = i >> 6, n = i & 63; float s = 0.f;
#pragma unroll
            for (int w = 0; w < 8; ++w) s += red[(w * 9 + r) * 64 + n];
            MOD[((size_t)l * 9 + r) * 6144 + n0 + n] = s + PIN(F, I_ADAB)[l * 6144 + n0 + n]; }
        __syncthreads();
    }
}
__device__ __forceinline__ void pro0_filter_mlp(Frame& F) {
    const int j = F.lane, gw = F.bx * NWAVES + F.wave, NGW = F.G * NWAVES;
    LAS float* W1 = (LAS float*)F.lds; LAS float* W2 = W1 + FEMB * FH; LAS float* W3 = W2 + FH * FH;
    __syncthreads();
    for (int i = F.tid; i < FEMB * FH; i += NTHREADS) W1[i] = PIN(F, I_FW1)[i];
    for (int i = F.tid; i < FH * FH; i += NTHREADS) { W2[i] = PIN(F, I_FW2)[i]; W3[i] = PIN(F, I_FW3)[i]; }
    __syncthreads();
    const float b1 = PIN(F, I_FB1)[j], b2 = PIN(F, I_FB2)[j], b3 = PIN(F, I_FB3)[j], fr = PIN(F, I_FREQ)[j];
    for (int it = gw; it < SEQ + CL; it += NGW) {
        const bool lat = it < SEQ; const int t = lat ? it : it - SEQ; const float L = lat ? (float)SEQ : (float)CL;
        const float tl = (float)t / (L - 1.0f), w = (6.283185307179586f * (float)t) / L;
        float z;
        { const int band = (j - 1) & 15; const float f = 1e-4f + (float)band * ((15.0f - 1e-4f) / 15.0f); const float a = f * w;
          z = (j == 0) ? tl : (j <= 16 ? cosf(a) : -sinf(a)); }
        float s = b1;
#pragma unroll
        for (int i = 0; i < FEMB; ++i) s += __shfl(z, i) * W1[i * FH + j];
        const float a1 = sinf(fr * s);
        s = b2;
#pragma unroll 16
        for (int i = 0; i < FH; ++i) s += __shfl(a1, i) * W2[i * FH + j];
        const float a2 = sinf(fr * s);
        s = b3;
#pragma unroll 16
        for (int i = 0; i < FH; ++i) s += __shfl(a2, i) * W3[i * FH + j];
        const float a3 = sinf(fr * s);
        float* dst = lat ? (float*)(F.ws + WS_A3) + (size_t)t * FH : (float*)(F.ws + WS_A3C) + (size_t)t * FH;
        dst[j] = a3;
    }
    __syncthreads();
}

__device__ __forceinline__ f32x2 cmul(f32x2 a, f32x2 b) { return (f32x2){a.x * b.x - a.y * b.y, a.x * b.y + a.y * b.x}; }
__device__ __forceinline__ f32x2 cconj(f32x2 a) { return (f32x2){a.x, -a.y}; }
#define ZP(n) ((n) + ((n) >> 5))
constexpr int FFT_LDS_BYTES = (NFFT + NFFT / 32) * 8;
__device__ __forceinline__ void bfly_dif(f32x2& a0, f32x2& a1, f32x2& a2, f32x2& a3, f32x2 w) {
    const f32x2 t0 = a0 + a2, t1 = a0 - a2, t2 = a1 + a3, d = a1 - a3, t3 = (f32x2){d.y, -d.x};
    const f32x2 y0 = t0 + t2, y2 = t0 - t2, y1 = t1 + t3, y3 = t1 - t3, w2 = cmul(w, w), w3 = cmul(w2, w);
    a0 = y0; a1 = cmul(y2, w2); a2 = cmul(y1, w); a3 = cmul(y3, w3);
}
__device__ __forceinline__ void bfly_dit(f32x2& a0, f32x2& a1, f32x2& a2, f32x2& a3, f32x2 w) {
    const f32x2 w2 = cmul(w, w), w3 = cmul(w2, w), A1 = cmul(a1, w2), A2 = cmul(a2, w), A3 = cmul(a3, w3);
    const f32x2 u0 = a0 + A1, u1 = a0 - A1, u2 = A2 + A3, u3 = A2 - A3, iu3 = (f32x2){-u3.y, u3.x};
    a0 = u0 + u2; a1 = u1 + iu3; a2 = u0 - u2; a3 = u1 - iu3;
}
template <int LQ, bool INV> __device__ __forceinline__ void fft_r16(LAS f32x2* z, int tid) {
    constexpr int q16 = 1 << LQ; constexpr float inv_lb = 1.0f / (float)(16 * q16);
    constexpr float C1 = 0.92387953251128674f, S1 = 0.38268343236508977f, C2 = 0.70710678118654752f;
    asm volatile("" : "+v"(tid));
#pragma unroll 1
    for (int g = tid; g < NFFT / 16; g += NTHREADS) {
        const int j = g & (q16 - 1), base = ((g >> LQ) << (LQ + 4)) + j;
        f32x2 x[16];
#pragma unroll
        for (int m = 0; m < 16; ++m) x[m] = z[ZP(base + (m << LQ))];
        const float fr = (float)j * inv_lb; const float sn = __builtin_amdgcn_sinf(fr);
        const f32x2 w1 = (f32x2){__builtin_amdgcn_cosf(fr), INV ? sn : -sn};
        const float sg = INV ? 1.0f : -1.0f;
        const f32x2 wa0 = w1, wa1 = cmul(w1, (f32x2){C1, sg * S1}), wa2 = cmul(w1, (f32x2){C2, sg * C2}), wa3 = cmul(w1, (f32x2){S1, sg * C1});
        const f32x2 w2 = cmul(w1, w1), wb = cmul(w2, w2);
        if constexpr (!INV) {
            bfly_dif(x[0], x[4], x[8], x[12], wa0); bfly_dif(x[1], x[5], x[9], x[13], wa1); bfly_dif(x[2], x[6], x[10], x[14], wa2); bfly_dif(x[3], x[7], x[11], x[15], wa3);
#pragma unroll
            for (int a = 0; a < 4; ++a) bfly_dif(x[4 * a], x[4 * a + 1], x[4 * a + 2], x[4 * a + 3], wb);
        } else {
#pragma unroll
            for (int a = 0; a < 4; ++a) bfly_dit(x[4 * a], x[4 * a + 1], x[4 * a + 2], x[4 * a + 3], wb);
            bfly_dit(x[0], x[4], x[8], x[12], wa0); bfly_dit(x[1], x[5], x[9], x[13], wa1); bfly_dit(x[2], x[6], x[10], x[14], wa2); bfly_dit(x[3], x[7], x[11], x[15], wa3);
        }
#pragma unroll
        for (int m = 0; m < 16; ++m) z[ZP(base + (m << LQ))] = x[m];
    }
    __syncthreads();
}
template <bool INV> __device__ __forceinline__ void fft_r4_unit(LAS f32x2* z, int tid) {
    asm volatile("" : "+v"(tid));
#pragma unroll 2
    for (int bf = tid; bf < NFFT / 4; bf += NTHREADS) {
        const int base = 4 * bf; f32x2 a0 = z[ZP(base)], a1 = z[ZP(base + 1)], a2 = z[ZP(base + 2)], a3 = z[ZP(base + 3)];
        if constexpr (!INV) { const f32x2 t0 = a0 + a2, t1 = a0 - a2, t2 = a1 + a3, d = a1 - a3, t3 = (f32x2){d.y, -d.x};
            z[ZP(base)] = t0 + t2; z[ZP(base + 1)] = t0 - t2; z[ZP(base + 2)] = t1 + t3; z[ZP(base + 3)] = t1 - t3; }
        else { const f32x2 u0 = a0 + a1, u1 = a0 - a1, u2 = a2 + a3, u3 = a2 - a3, iu3 = (f32x2){-u3.y, u3.x};
            z[ZP(base)] = u0 + u2; z[ZP(base + 1)] = u1 + iu3; z[ZP(base + 2)] = u0 - u2; z[ZP(base + 3)] = u1 - iu3; }
    }
    __syncthreads();
}
__device__ __forceinline__ void fft16k_dif(LAS f32x2* z, int tid) { fft_r16<10, false>(z, tid); fft_r16<6, false>(z, tid); fft_r16<2, false>(z, tid); fft_r4_unit<false>(z, tid); }
__device__ __forceinline__ void fft16k_dit_inv(LAS f32x2* z, int tid) { fft_r4_unit<true>(z, tid); fft_r16<2, true>(z, tid); fft_r16<6, true>(z, tid); fft_r16<10, true>(z, tid); }
constexpr int KF_LD = 8256;
__device__ __forceinline__ int rev14(int p) { return (int)(__brev((unsigned)p) >> 18); }
__device__ __forceinline__ float hy_delta(int c) { const float mn = -3.0701134573253945f, mx = -15.350567286626973f; return fabsf(mn + (mx - mn) * ((float)c / 1023.0f)); }

__device__ __forceinline__ void pro1_router_split(Frame& F) {
    const float* MOD = (const float*)(F.ws + WS_MOD); unsigned char* RW3 = F.ws + WS_RW3;
    for (int ent = F.bx * NTHREADS + F.tid; ent < NLAYER * 9 * 8 * 8 * 64; ent += F.G * NTHREADS) {
        const int lane = ent & 63, kb = (ent >> 6) & 7, w = (ent >> 9) & 7, lb = ent >> 12, l = lb / 9;
        const int k0 = w * 128 + 16 * kb + 8 * (lane >> 5), e = lane & 31;
        const float* gn = PIN(F, I_N2G) + l * D; const float* sc = MOD + (size_t)lb * 6144 + 4 * 1024; const float* rw = PIN(F, I_RW) + (size_t)l * D * NE;
        unsigned ph[4], pm[4], pl[4];
#pragma unroll
        for (int j2 = 0; j2 < 4; ++j2) { const int k = k0 + 2 * j2; const float v0 = gn[k] * (1.0f + sc[k]) * rw[(size_t)k * NE + e], v1 = gn[k + 1] * (1.0f + sc[k + 1]) * rw[(size_t)(k + 1) * NE + e];
            const unsigned h = cvt_pk_bf16(v0, v1); const float r0 = v0 - __uint_as_float(h << 16), r1 = v1 - __uint_as_float(h & 0xffff0000u);
            const unsigned m = cvt_pk_bf16(r0, r1); const float s0 = r0 - __uint_as_float(m << 16), s1 = r1 - __uint_as_float(m & 0xffff0000u);
            ph[j2] = h; pm[j2] = m; pl[j2] = cvt_pk_bf16(s0, s1); }
        v4u* dst = (v4u*)(RW3 + (size_t)(ent >> 6) * 3 * 1024) + lane;
        dst[0] = (v4u){ph[0], ph[1], ph[2], ph[3]}; dst[64] = (v4u){pm[0], pm[1], pm[2], pm[3]}; dst[128] = (v4u){pl[0], pl[1], pl[2], pl[3]};
    }
}
__device__ __forceinline__ void pro1_filters(Frame& F) {
    if (F.bx < NLAYER * 9) {
        const int lb = F.bx, l = lb / 9, e = F.lane & 31, hf = F.lane >> 5; const float* sh = (const float*)(F.ws + WS_MOD) + (size_t)lb * 6144 + 3 * 1024; const float* rw = PIN(F, I_RW) + (size_t)l * D * NE;
        LAS float* red = (LAS float*)F.lds; const int k0 = F.wave * 128 + hf * 64; float acc = 0.f;
#pragma unroll 8
        for (int k = k0; k < k0 + 64; ++k) acc += sh[k] * rw[(size_t)k * NE + e];
        acc += shx(acc, 32, F.lane); if (F.lane < 32) red[F.wave * 32 + e] = acc;
        __syncthreads();
        if (F.tid < 32) { float s = PIN(F, I_RB)[l * NE + F.tid];
#pragma unroll
            for (int w = 0; w < 8; ++w) s += red[w * 32 + F.tid];
            ((float*)(F.ws + WS_RC))[lb * NE + F.tid] = s; }
    }
    LAS f32x2* z = (LAS f32x2*)F.lds;
    LAS float* wl = (LAS float*)(F.lds + AUX_OFF + 8192);
    const float* a3 = (const float*)(F.ws + WS_A3); const float* a3c = (const float*)(F.ws + WS_A3C);
    f32x2* KF = (f32x2*)(F.ws + WS_KF); float* FCT = (float*)(F.ws + WS_FCT);
    for (int u = F.bx; u < 512; u += F.G) {
        const int ca = 2 * u, cb = 2 * u + 1;
        __syncthreads();
        if (F.tid < 256) { const int which = F.tid >> 6, m = F.tid & 63; const int col = (which & 1 ? cb : ca) + (which >> 1) * 1024; wl[which * 64 + m] = PIN(F, I_FW4)[m * 2048 + col]; }
        if (F.tid < 4) { const int col = (F.tid & 1 ? cb : ca) + (F.tid >> 1) * 1024; wl[256 + F.tid] = PIN(F, I_FB4)[col]; }
        __syncthreads();
        const float da = hy_delta(ca), db = hy_delta(cb);
        const float dska = PIN(F, I_HD)[ca], dskb = PIN(F, I_HD)[cb];
        for (int t = F.tid; t < SEQ; t += NTHREADS) {
            const f32x4* ar = (const f32x4*)(a3 + (size_t)t * FH); float s0 = wl[256], s1 = wl[257], s2 = wl[258], s3 = wl[259];
#pragma unroll 8
            for (int m4 = 0; m4 < 16; ++m4) { const f32x4 a = ar[m4];
#pragma unroll
                for (int i = 0; i < 4; ++i) { const int m = m4 * 4 + i; s0 += a[i] * wl[m]; s1 += a[i] * wl[64 + m]; s2 += a[i] * wl[128 + m]; s3 += a[i] * wl[192 + m]; } }
            const float tl = (float)t / (float)(SEQ - 1); const float wa = __expf(-tl * da), wb = __expf(-tl * db);
            z[ZP(t)] = (f32x2){s0 * wa + (t == 0 ? dska : 0.f), s1 * wb + (t == 0 ? dskb : 0.f)};
            if (t == 0) z[ZP(SEQ)] = (f32x2){0.f, 0.f}; else z[ZP(NFFT - t)] = (f32x2){s2 * wa, s3 * wb};
        }
        for (int i = F.tid; i < 511; i += NTHREADS) {
            const int d = i - 255, t = d < 0 ? -d : d; const int o = d < 0 ? 2 : 0;
            const f32x4* ar = (const f32x4*)(a3c + (size_t)t * FH); float sa = wl[256 + o], sb = wl[257 + o];
            f32x4 av[16];
#pragma unroll
            for (int m4 = 0; m4 < 16; ++m4) av[m4] = ar[m4];
            __builtin_amdgcn_sched_barrier(0);
#pragma unroll
            for (int m4 = 0; m4 < 16; ++m4) {
#pragma unroll
                for (int i2 = 0; i2 < 4; ++i2) { const int m = m4 * 4 + i2; sa += av[m4][i2] * wl[o * 64 + m]; sb += av[m4][i2] * wl[(o + 1) * 64 + m]; }
                if ((m4 & 3) == 3) __builtin_amdgcn_sched_barrier(0); }
            const float tl = (float)t / (float)(CL - 1);
            FCT[(size_t)ca * 512 + d + 256] = sa * __expf(-tl * da) + (d == 0 ? dska : 0.f); FCT[(size_t)cb * 512 + d + 256] = sb * __expf(-tl * db) + (d == 0 ? dskb : 0.f);
        }
        __syncthreads();
        fft16k_dif(z, F.tid);
        for (int k = F.tid; k <= NFFT / 2; k += NTHREADS) {
            const int p = rev14(k), p2 = rev14((NFFT - k) & (NFFT - 1)); const f32x2 a = z[ZP(p)], b = z[ZP(p2)];
            KF[(size_t)ca * KF_LD + k] = (f32x2){0.5f * (a.x + b.x), 0.5f * (a.y - b.y)};
            KF[(size_t)cb * KF_LD + k] = (f32x2){0.5f * (a.y + b.y), -0.5f * (a.x - b.x)};
        }
    }
    __syncthreads();
}

__device__ __forceinline__ void hyena_conv_phase(Frame& F) {
    LAS f32x2* z = (LAS f32x2*)F.lds;
    LAS float* aux = (LAS float*)(F.lds + AUX_OFF + 8192);
    const float* VT = (const float*)(F.ws + WS_VT); const float* VTC = (const float*)(F.ws + WS_VTC); float* CT = (float*)(F.ws + WS_CT); float* CTC = (float*)(F.ws + WS_CTC);
    const f32x2* KF = (const f32x2*)(F.ws + WS_KF); const float* FCT = (const float*)(F.ws + WS_FCT);
    v4u ina[2], inb[2];
#define HC_LOADIN(u_, t_) do { const int b_ = (u_) >> 9, c_ = 2 * ((u_) & 511); const v4u* va_ = (const v4u*)((const bf16*)VT + ((size_t)b_ * 1024 + c_) * SEQ + 16 * (t_)); \
        ina[0] = va_[0]; ina[1] = va_[1]; inb[0] = va_[SEQ / 8]; inb[1] = va_[SEQ / 8 + 1]; } while (0)
    if (F.bx < NB * 512) HC_LOADIN(F.bx, F.tid);
    for (int u = F.bx; u < NB * 512; u += F.G) {
        const int b = u >> 9, cp = u & 511, ca = 2 * cp, cb = ca + 1;
        int tq = F.tid; asm volatile("" : "+v"(tq));
        __syncthreads();
        { const int n0 = 16 * tq;
#pragma unroll
          for (int i = 0; i < 4; ++i) { const unsigned a0 = ina[i >> 1][2 * (i & 1)], a1 = ina[i >> 1][2 * (i & 1) + 1], b0 = inb[i >> 1][2 * (i & 1)], b1 = inb[i >> 1][2 * (i & 1) + 1];
              z[ZP(n0 + 4 * i)] = (f32x2){bflo(a0), bflo(b0)}; z[ZP(n0 + 4 * i + 1)] = (f32x2){bfhi(a0), bfhi(b0)}; z[ZP(n0 + 4 * i + 2)] = (f32x2){bflo(a1), bflo(b1)}; z[ZP(n0 + 4 * i + 3)] = (f32x2){bfhi(a1), bfhi(b1)};
#pragma unroll
              for (int j = 0; j < 4; ++j) z[ZP(SEQ + n0 + 4 * i + j)] = (f32x2){0.f, 0.f}; } }
        f32x4 ka[8], kb[8]; f32x2 kaN, kbN;
        { const f32x4* pa = (const f32x4*)(KF + (size_t)ca * KF_LD + 16 * tq); const f32x4* pb = (const f32x4*)(KF + (size_t)cb * KF_LD + 16 * tq);
#pragma unroll
          for (int i = 0; i < 8; ++i) { ka[i] = pa[i]; kb[i] = pb[i]; }
          kaN = KF[(size_t)ca * KF_LD + NFFT / 2]; kbN = KF[(size_t)cb * KF_LD + NFFT / 2]; }
        { const int h = tq >> 8, t = tq & 255; const float* vc = VTC + ((size_t)b * 1024 + ca + h) * CL;
          aux[h * 256 + t] = vc[t]; aux[512 + h * 512 + t] = FCT[(size_t)(ca + h) * 512 + t]; aux[512 + h * 512 + 256 + t] = FCT[(size_t)(ca + h) * 512 + 256 + t];
          __syncthreads();
          float y = 0.f;
#pragma unroll 8
          for (int s = 0; s < CL; ++s) y += aux[h * 256 + s] * aux[512 + h * 512 + (t - s) + 256];
          CTC[((size_t)b * 1024 + ca + h) * CL + t] = y; }
        fft16k_dif(z, F.tid);
        int tpw = tq; asm volatile("" : "+v"(tpw));
#define HC_PW(k_, Ka_, Kb_) do { const int p = rev14(k_), p2 = rev14((NFFT - (k_)) & (NFFT - 1)); const f32x2 a = z[ZP(p)], b2 = z[ZP(p2)]; \
            const f32x2 Va = (f32x2){0.5f * (a.x + b2.x), 0.5f * (a.y - b2.y)}, Vb = (f32x2){0.5f * (a.y + b2.y), -0.5f * (a.x - b2.x)}; \
            const f32x2 ya = cmul(Va, Ka_), yb = cmul(Vb, Kb_); \
            z[ZP(p)] = (f32x2){ya.x - yb.y, ya.y + yb.x}; z[ZP(p2)] = (f32x2){ya.x + yb.y, -ya.y + yb.x}; } while (0)
#pragma unroll
        for (int i = 0; i < 8; ++i) { const int k = 16 * tpw + 2 * i;
            HC_PW(k, ((f32x2){ka[i].x, ka[i].y}), ((f32x2){kb[i].x, kb[i].y})); HC_PW(k + 1, ((f32x2){ka[i].z, ka[i].w}), ((f32x2){kb[i].z, kb[i].w}));
            asm volatile("" ::: "memory"); }
        if (tpw == 0) HC_PW(NFFT / 2, kaN, kbN);
#undef HC_PW
        __syncthreads();
        if (u + F.G < NB * 512) HC_LOADIN(u + F.G, tq);
        fft16k_dit_inv(z, F.tid);
        { int to = tq; asm volatile("" : "+v"(to)); const float sc = 1.0f / (float)NFFT; const int n0 = 16 * to;
          v4u* oa = (v4u*)((bf16*)CT + ((size_t)b * 1024 + ca) * SEQ + n0);
#pragma unroll
          for (int h2 = 0; h2 < 2; ++h2) { f32x2 w[8];
#pragma unroll
              for (int j = 0; j < 8; ++j) w[j] = z[ZP(n0 + 8 * h2 + j)];
              oa[h2] = (v4u){cvt_pk_bf16(w[0].x * sc, w[1].x * sc), cvt_pk_bf16(w[2].x * sc, w[3].x * sc), cvt_pk_bf16(w[4].x * sc, w[5].x * sc), cvt_pk_bf16(w[6].x * sc, w[7].x * sc)};
              oa[SEQ / 8 + h2] = (v4u){cvt_pk_bf16(w[0].y * sc, w[1].y * sc), cvt_pk_bf16(w[2].y * sc, w[3].y * sc), cvt_pk_bf16(w[4].y * sc, w[5].y * sc), cvt_pk_bf16(w[6].y * sc, w[7].y * sc)}; } }
    }
    __syncthreads();
#undef HC_LOADIN
}
constexpr int MW_CUMBLK = 16, MW_CNT = 64, MW_SELE = 128, MW_SELV = 256, MW_LRANK = 384, MW_LBASE = 512;
__device__ __forceinline__ void moe_tables(Frame& F, int layer) {
    __syncthreads();
    if (F.tid < NE) F.MISC[MW_CNT + F.tid] = __hip_atomic_load(F.ctl + CW_CNT + layer * NE + F.tid, RLX_AGENT);
    __syncthreads();
    if (F.tid < 64) {
        const unsigned v = F.tid < NE ? (F.MISC[MW_CNT + (F.tid & 31)] + 255u) >> 8 : 0u; unsigned s = v;
#pragma unroll
        for (int d = 1; d < 32; d <<= 1) { const unsigned t = (unsigned)__builtin_amdgcn_ds_bpermute(((F.tid - d) & 63) * 4, (int)s); if ((F.tid & 63) >= d) s += t; }
        if (F.tid < NE) F.MISC[MW_CUMBLK + F.tid] = s - v;
        if (F.tid == NE - 1) F.MISC[MW_CUMBLK + NE] = s; }
    __syncthreads();
}

template <int MODE> __device__ __forceinline__ void rowpass(Frame& F, int layer, bool real = true, bool h8 = false) {
    const bool combine = (MODE == 0 && layer > 0) || MODE == 2;
    const int nrows = MODE == 2 ? ML : MT;
    const int cl = MODE == 2 ? NLAYER - 1 : layer - 1;
    const bool from_input = (MODE == 0 && layer == 0);
    const float* XLs = PIN(F, I_X); const float* XCs = PIN(F, I_CTX);
    bf16* XB = (bf16*)(F.ws + WS_XB); bf16* XBd = real ? XB : (bf16*)(F.ws + WS_P);
    const float* MOD = (const float*)(F.ws + WS_MOD);
    bf16* H = (bf16*)(F.ws + WS_H); unsigned char* H8 = (unsigned char*)(F.ws + WS_H8); const unsigned char* YM = (const unsigned char*)(F.ws + WS_YM);
    const int* TE = (const int*)(F.ws + WS_TE); const int* TR = (const int*)(F.ws + WS_TR); const float* TG = (const float*)(F.ws + WS_TG);
    const float* gnorm = MODE == 0 ? PIN(F, I_N1G) + layer * D : PIN(F, I_FG);
    if (combine) moe_tables(F, cl);
    f32x4 gn[4];
#pragma unroll
    for (int j = 0; j < 4; ++j) gn[j] = ((const f32x4*)gnorm)[F.lane + 64 * j];
    const int ntiles = nrows / 32;
    i32x4 nte[4], ntr[4]; f32x4 ntg[4];
#define RP_TABLES(tile_) do { const size_t rb_ = (size_t)((tile_) * 32 + F.wave * 4) * 4; \
        _Pragma("unroll") for (int q = 0; q < 4; ++q) { nte[q] = *(const i32x4*)(TE + rb_ + 4 * q); ntr[q] = *(const i32x4*)(TR + rb_ + 4 * q); ntg[q] = *(const f32x4*)(TG + rb_ + 4 * q); } } while (0)
    if (combine && F.bx < ntiles) RP_TABLES(F.bx);
    for (int tile = F.bx; tile < ntiles; tile += F.G) {
        const int rbase = tile * 32 + F.wave * 4; const bool lat = rbase < ML; const int bidx = lat ? (rbase >> 13) : 8;
        const float* g2 = MOD + ((size_t)(combine ? cl : 0) * 9 + bidx) * 6144 + 5 * 1024;
        const float* mb = MOD + ((size_t)layer * 9 + bidx) * 6144;
        int rid[4][4]; float gkk[4][4];
        if (combine) {
#pragma unroll
            for (int q = 0; q < 4; ++q)
#pragma unroll
                for (int k = 0; k < 4; ++k) { rid[q][k] = 256 * (int)F.MISC[MW_CUMBLK + nte[q][k]] + ntr[q][k]; gkk[q][k] = ntg[q][k]; }
            if (tile + F.G < ntiles) RP_TABLES(tile + F.G);
        }
#pragma unroll 1
        for (int pr = 0; pr < 2; ++pr) {
            size_t xo[2]; f32x4 v[2][4]; int rowid[2][4]; float gk[2][4];
#pragma unroll
            for (int u = 0; u < 2; ++u) { const int r = rbase + 2 * pr + u; xo[u] = (size_t)r * D;
                if (combine) {
#pragma unroll
                    for (int k = 0; k < 4; ++k) { rowid[u][k] = pr ? rid[2 + u][k] : rid[u][k]; gk[u][k] = pr ? gkk[2 + u][k] : gkk[u][k]; } }
                if (from_input) { const f32x4* xs = (const f32x4*)(lat ? XLs + xo[u] : XCs + (xo[u] - (size_t)ML * D));
#pragma unroll
                    for (int j = 0; j < 4; ++j) v[u][j] = xs[F.lane + 64 * j]; }
                else { const v2u* xs = (const v2u*)(XB + xo[u]);
#pragma unroll
                    for (int j = 0; j < 4; ++j) v[u][j] = bf4_f32(xs[F.lane + 64 * j]); } }
            if (combine) {
                unsigned w[2][4][4];
#pragma unroll
                for (int u = 0; u < 2; ++u)
#pragma unroll
                    for (int k = 0; k < 4; ++k) { const unsigned* yr = (const unsigned*)(YM + (size_t)rowid[u][k] * D);
#pragma unroll
                        for (int j = 0; j < 4; ++j) w[u][k][j] = yr[F.lane + 64 * j]; }
#pragma unroll
                for (int u = 0; u < 2; ++u) {
#pragma unroll
                    for (int j = 0; j < 4; ++j) { f32x4 a = (f32x4){0.f, 0.f, 0.f, 0.f};
#pragma unroll
                        for (int k = 0; k < 4; ++k) { const f32x2 lo = __builtin_amdgcn_cvt_pk_f32_fp8(w[u][k][j], false), hi2 = __builtin_amdgcn_cvt_pk_f32_fp8(w[u][k][j], true); a += gk[u][k] * (f32x4){lo.x, lo.y, hi2.x, hi2.y}; }
                        v[u][j] += ((const f32x4*)g2)[F.lane + 64 * j] * a; }
                    if (MODE == 0) { v2u* xd = (v2u*)(XBd + xo[u]);
#pragma unroll
                        for (int j = 0; j < 4; ++j) { v2u o; o.x = cvt_pk_bf16(v[u][j].x, v[u][j].y); o.y = cvt_pk_bf16(v[u][j].z, v[u][j].w); xd[F.lane + 64 * j] = o; } } }
            }
            if (from_input) {
#pragma unroll
                for (int u = 0; u < 2; ++u) { v2u* xd = (v2u*)(XBd + xo[u]);
#pragma unroll
                    for (int j = 0; j < 4; ++j) { v2u o; o.x = cvt_pk_bf16(v[u][j].x, v[u][j].y); o.y = cvt_pk_bf16(v[u][j].z, v[u][j].w); xd[F.lane + 64 * j] = o; } } }
#pragma unroll
            for (int u = 0; u < 2; ++u) { const int r = rbase + 2 * pr + u;
                float ss = 0.f;
#pragma unroll
                for (int j = 0; j < 4; ++j) ss += (v[u][j].x * v[u][j].x + v[u][j].y * v[u][j].y) + (v[u][j].z * v[u][j].z + v[u][j].w * v[u][j].w);
                const float rstd = 1.0f / sqrtf(wave_sum(ss, F.lane) * (1.0f / D) + EPS);
                if (MODE == 2) { f32x4* od = (f32x4*)((real ? F.out : (float*)(F.ws + WS_P)) + xo[u]);
#pragma unroll
                    for (int j = 0; j < 4; ++j) od[F.lane + 64 * j] = v[u][j] * rstd * gn[j]; }
                else { v2u* hd = (v2u*)(H + (size_t)r * D); unsigned* hd8 = (unsigned*)(H8 + (size_t)r * D);
#pragma unroll
                    for (int j = 0; j < 4; ++j) { const f32x4 sh = ((const f32x4*)mb)[F.lane + 64 * j], sc = ((const f32x4*)(mb + 1024))[F.lane + 64 * j]; const f32x4 hv = v[u][j] * rstd * gn[j] * (sc + 1.0f) + sh;
                        if (h8) { unsigned o = 0; o = __builtin_amdgcn_cvt_pk_fp8_f32(hv.x, hv.y, o, false); o = __builtin_amdgcn_cvt_pk_fp8_f32(hv.z, hv.w, o, true); hd8[F.lane + 64 * j] = o; }
                        else { v2u o; o.x = cvt_pk_bf16(hv.x, hv.y); o.y = cvt_pk_bf16(hv.z, hv.w); hd[F.lane + 64 * j] = o; } } }
            }
        }
    }
}

typedef float f32x16r __attribute__((ext_vector_type(16)));
__device__ __forceinline__ void router_phase(Frame& F, int layer, bool real = true, int xp = 0) {
    const bool last = layer == NLAYER - 1;
    const int ntiles = (last ? ML : MT) / 32;
    LAS float* PART = (LAS float*)F.lds;
    LAS float* SSQ = PART + 8 * 32 * 33;
    LAS float* LG = SSQ + 8 * 32;
    LAS float* RSTD = LG + 32 * 33;
    LAS unsigned* CW = (LAS unsigned*)(RSTD + 32);
    LAS unsigned* RUN = CW + 64;
    LAS float* AV = (LAS float*)(RUN + 32);
    LAS float* SHV = AV + 1024;
    LAS float* RCV = SHV + 1024;
    LAS int* TRL = (LAS int*)((LAS unsigned char*)(RCV + 32) + 8 * (32 * 272));
    LAS bf16* STG = (LAS bf16*)((LAS unsigned char*)(RCV + 32) + F.wave * (32 * 272));
    const bf16* XB = (const bf16*)(F.ws + WS_XB);
    const float* MOD = (const float*)(F.ws + WS_MOD); const float* RC = (const float*)(F.ws + WS_RC);
    unsigned char* H8 = (unsigned char*)(F.ws + WS_H8);
    int* TE = (int*)(F.ws + WS_TE); int* TR = (int*)(F.ws + WS_TR); float* TG = (float*)(F.ws + WS_TG); int* ROWTOK = (int*)(F.ws + WS_ROWTOK);
    const float* gn = PIN(F, I_N2G) + layer * D; const float* rw = PIN(F, I_RW) + (size_t)layer * D * NE;
    const int i = F.lane & 31, hf = F.lane >> 5, lr = F.lane >> 4, lc = F.lane & 15, kw = F.wave * 128;
    const int per = 2048 / F.G;
    const int nmine = (2048 % F.G == 0) ? per + ((2048 + F.bx < ntiles) ? 1 : 0) : 0;
#define RT_TILE(n_) ((2048 % F.G == 0) ? ((n_) < per ? F.bx * per + (n_) : 2048 + F.bx) : F.bx + (n_) * F.G)
    const int ncnt = (2048 % F.G == 0) ? nmine : (F.bx < ntiles ? (ntiles - 1 - F.bx) / F.G + 1 : 0);
    __syncthreads();
    if (F.tid < NE) RUN[F.tid] = 0u;
    bf16x8 bw[8][2];
    v2u rawp[16];
#define RT_LOADX(tile_) do { const int rb_ = (tile_) * 32 + lr; const bf16* xb_ = XB + (size_t)rb_ * D + kw + 4 * lc; \
        _Pragma("unroll") for (int q = 0; q < 16; ++q) rawp[q] = *(const v2u*)(xb_ + (size_t)(4 * (q & 7)) * D + 64 * (q >> 3)); } while (0)
    if (ncnt > 0) RT_LOADX(RT_TILE(0));
    int cur_b = -1;
    for (int n = 0; n < ncnt; ++n) {
        const int tile = RT_TILE(n);
        const int r0 = tile * 32; const bool lat = r0 < ML; const int bidx = lat ? (r0 >> 13) : 8; const int r = r0 + i;
        if (bidx != cur_b) {
            cur_b = bidx; const float* mb = MOD + ((size_t)layer * 9 + bidx) * 6144 + 3 * 1024;
            __syncthreads();
            for (int k = F.tid; k < 1024; k += NTHREADS) { AV[k] = gn[k] * (1.0f + mb[1024 + k]); SHV[k] = mb[k]; }
            if (F.tid < NE) RCV[F.tid] = RC[((size_t)layer * 9 + bidx) * NE + F.tid];
            __syncthreads();
            { const v4u* src = (const v4u*)(F.ws + WS_RW3 + ((size_t)(layer * 9 + bidx) * 8 + F.wave) * 8 * 3 * 1024) + F.lane;
#pragma unroll
              for (int kb = 0; kb < 8; ++kb)
#pragma unroll
                  for (int t = 0; t < 2; ++t) bw[kb][t] = __builtin_bit_cast(bf16x8, src[(kb * 3 + t) * 64]); }
        }
        { float s8[8];
#pragma unroll
          for (int q = 0; q < 8; ++q) { const f32x4 a = bf4_f32(rawp[q]), b = bf4_f32(rawp[q + 8]); s8[q] = ((a.x * a.x + a.y * a.y) + (a.z * a.z + a.w * a.w)) + ((b.x * b.x + b.y * b.y) + (b.z * b.z + b.w * b.w)); }
#pragma unroll
          for (int q = 0; q < 8; ++q) { float v = s8[q]; v += shx(v, 1, F.lane); v += shx(v, 2, F.lane); v += shx(v, 4, F.lane); v += shx(v, 8, F.lane); if (lc == 0) SSQ[F.wave * 32 + 4 * q + lr] = v; } }
        __syncthreads();
        const f32x4 av0 = ((const LAS f32x4*)(AV + kw))[lc], av1 = ((const LAS f32x4*)(AV + kw))[lc + 16];
        { const f32x4 sh0 = ((const LAS f32x4*)(SHV + kw))[lc], sh1 = ((const LAS f32x4*)(SHV + kw))[lc + 16];
          unsigned char* hb = H8 + (size_t)(r0 + lr) * D + kw + 4 * lc;
#pragma unroll
          for (int q = 0; q < 8; ++q) { float qs = 0.f;
#pragma unroll
              for (int w = 0; w < 8; ++w) qs += SSQ[w * 32 + 4 * q + lr];
              const float rs = 1.0f / sqrtf(qs * (1.0f / D) + EPS);
#pragma unroll
              for (int hq = 0; hq < 2; ++hq) { const f32x4 h = bf4_f32(rawp[q + 8 * hq]) * (rs * (hq ? av1 : av0)) + (hq ? sh1 : sh0); unsigned w = 0;
                  w = __builtin_amdgcn_cvt_pk_fp8_f32(h.x, h.y, w, false); w = __builtin_amdgcn_cvt_pk_fp8_f32(h.z, h.w, w, true);
                  *(unsigned*)(hb + (size_t)(4 * q) * D + 64 * hq) = w; } } }
        f32x16r acc = {};
        asm volatile("s_waitcnt lgkmcnt(0)" ::: "memory");
#pragma unroll
        for (int q = 0; q < 16; ++q) *(LAS v2u*)(STG + (4 * (q & 7) + lr) * 136 + 4 * lc + 64 * (q >> 3)) = rawp[q];
        asm volatile("s_waitcnt lgkmcnt(0)" ::: "memory");
        if (n + 1 < ncnt) RT_LOADX(RT_TILE(n + 1));
#pragma unroll
        for (int kb = 0; kb < 8; ++kb) { const bf16x8 a = *(const LAS bf16x8*)(STG + i * 136 + 16 * kb + 8 * hf);
#pragma unroll
            for (int t = 0; t < 2; ++t) acc = __builtin_amdgcn_mfma_f32_32x32x16_bf16(a, bw[kb][t], acc, 0, 0, 0); }
#pragma unroll
        for (int rg = 0; rg < 16; ++rg) PART[(F.wave * 32 + ((rg & 3) + 8 * (rg >> 2) + 4 * hf)) * 33 + i] = acc[rg];
        __syncthreads();
        { const int tk = F.tid >> 4, e0 = (F.tid & 15) * 2; float q = 0.f, s0 = 0.f, s1 = 0.f;
#pragma unroll
          for (int w = 0; w < 8; ++w) { q += SSQ[w * 32 + tk]; s0 += PART[(w * 32 + tk) * 33 + e0]; s1 += PART[(w * 32 + tk) * 33 + e0 + 1]; }
          const float rstd = 1.0f / sqrtf(q * (1.0f / D) + EPS);
          LG[tk * 33 + e0] = rstd * s0 + RCV[e0]; LG[tk * 33 + e0 + 1] = rstd * s1 + RCV[e0 + 1]; }
        __syncthreads();
        { const int tk = F.tid >> 4, e0 = (F.tid & 15) * 2; const LAS float* lg = LG + tk * 33; const float l0 = lg[e0], l1 = lg[e0 + 1]; int rk0 = 0, rk1 = 0;
#pragma unroll 8
          for (int j = 0; j < NE; ++j) { const float o = lg[j]; rk0 += (o > l0 || (o == l0 && j < e0)) ? 1 : 0; rk1 += (o > l1 || (o == l1 && j < e0 + 1)) ? 1 : 0; }
          if (rk0 < 4) { F.MISC[MW_SELE + tk * 4 + rk0] = (unsigned)e0; F.MISC[MW_SELV + tk * 4 + rk0] = __float_as_uint(l0); }
          if (rk1 < 4) { F.MISC[MW_SELE + tk * 4 + rk1] = (unsigned)(e0 + 1); F.MISC[MW_SELV + tk * 4 + rk1] = __float_as_uint(l1); } }
        __syncthreads();
        int my = 0, lrk = 0;
        if (F.wave < 2) { const int a = F.tid; my = (int)F.MISC[MW_SELE + a];
            { const float vk = __uint_as_float(F.MISC[MW_SELV + a]), v0 = __uint_as_float(F.MISC[MW_SELV + (a & ~3)]);
              const float ex = __expf(vk - v0); float sm = ex; sm += shx(sm, 1, F.lane); sm += shx(sm, 2, F.lane);
              const size_t idx = ((size_t)r0 + (a >> 2)) * 4 + (a & 3); TG[idx] = ex / sm; TE[idx] = my; }
            unsigned cm = 0;
#pragma unroll 2
            for (int e = 0; e < NE; ++e) { const unsigned long long m = __ballot(my == e); const unsigned pc = (unsigned)__popcll(m);
                if (my == e) lrk = (int)__builtin_amdgcn_mbcnt_hi((unsigned)(m >> 32), __builtin_amdgcn_mbcnt_lo((unsigned)m, 0u)); if (F.lane == e) cm = pc; }
            if (F.lane < NE) CW[F.wave * 32 + F.lane] = cm; }
        __syncthreads();
        if (F.wave < 2) { const int a = F.tid; const int brank = (int)RUN[my] + lrk + (F.wave == 1 ? (int)CW[my] : 0); TRL[n * 128 + a] = (my << 16) | brank; }
        __syncthreads();
        if (F.tid < NE) RUN[F.tid] += CW[F.tid] + CW[32 + F.tid];
    }
    VM_WAIT(); __syncthreads();
    if (F.tid < NE) { const unsigned cnt = RUN[F.tid]; unsigned base = 0;
        if (cnt) base = __hip_atomic_fetch_add(F.ctl + CW_CNT + (real ? layer : NLAYER) * NE + F.tid, cnt, RLX_AGENT);
        F.MISC[MW_LBASE + F.tid] = base; }
    __syncthreads();
    if (real) for (int n = F.tid >> 7; n < ncnt; n += 4) { const int r0 = RT_TILE(n) * 32, a = F.tid & 127;
        const int v = TRL[n * 128 + a], e = v >> 16, rank = (v & 0xffff) + (int)F.MISC[MW_LBASE + e]; const size_t idx = ((size_t)r0 + (a >> 2)) * 4 + (a & 3);
        TR[idx] = rank; ROWTOK[(size_t)e * MT + rank] = r0 + (a >> 2); }
    __syncthreads();
#undef RT_LOADX
#undef RT_TILE
}

__device__ __forceinline__ void normrope16(float (&x)[16], const float* gain, bool lat, int prow, int pcol, const LAS f32x2* T, int L, float oscale, int lane) {
    float ss = 0.f;
#pragma unroll
    for (int i = 0; i < 16; ++i) ss += x[i] * x[i];
    ss += shx(ss, 1, lane); ss += shx(ss, 2, lane); ss += shx(ss, 4, lane);
    const float rstd = 1.0f / sqrtf(ss * (1.0f / 128.0f) + EPS);
    const int o = (L & 7) * 16;
#pragma unroll
    for (int i = 0; i < 16; ++i) x[i] = x[i] * rstd * gain[o + i];
    float p[16];
#pragma unroll
    for (int i = 0; i < 16; ++i) p[i] = shx(x[i], 2, lane);
    if (lat) {
        const int pos = (L & 4) ? pcol : prow; const float sgn = (L & 2) ? 1.0f : -1.0f; const LAS f32x2* t = T + pos * 32 + (L & 1) * 16;
#pragma unroll
        for (int i = 0; i < 16; ++i) { const f32x2 cs = t[i]; x[i] = x[i] * cs.x + sgn * p[i] * cs.y; }
    }
#pragma unroll
    for (int i = 0; i < 16; ++i) x[i] *= oscale;
}
__device__ __forceinline__ void qkprep_phase(Frame& F, int j) {
    LAS f32x2* T = (LAS f32x2*)F.lds;
    __syncthreads();
    for (int i = F.tid; i < 128 * 32; i += NTHREADS) { const int pos = i >> 5, f = i & 31; const float inv = powf(10000.0f, -(float)f / 32.0f); const float ang = (float)pos * inv; float s, c; sincosf(ang, &s, &c); T[i] = (f32x2){c, s}; }
    __syncthreads();
    const bf16* P = (const bf16*)(F.ws + WS_P); unsigned char* Q8 = (unsigned char*)(F.ws + WS_QB); unsigned char* K8 = (unsigned char*)(F.ws + WS_QB + WS_K8_OFF); unsigned char* VT8 = (unsigned char*)(F.ws + WS_KVB);
    const float* qg = PIN(F, I_AQG) + j * 128; const float* kg = PIN(F, I_AKG) + j * 128;
    if (F.bx == 0 && F.tid == 0) { float qm = 0.f, km = 0.f; for (int i = 0; i < 128; ++i) { qm = fmaxf(qm, fabsf(qg[i])); km = fmaxf(km, fabsf(kg[i])); }
        const float sig = att::SCALE * 1.4426950408889634f * 11.3137085f * qm * km;
        ((float*)(F.ws + WS_RC))[2048 + j] = -fminf(-2.0f, 8.0f - 7.0f * sig); }
    const int gw = F.bx * NWAVES + F.wave, NGW = F.G * NWAVES, L = F.lane;
#define QK_UNPACK(x, a, c) do { x[0] = bflo(a.x); x[1] = bfhi(a.x); x[2] = bflo(a.y); x[3] = bfhi(a.y); x[4] = bflo(a.z); x[5] = bfhi(a.z); x[6] = bflo(a.w); x[7] = bfhi(a.w); \
        x[8] = bflo(c.x); x[9] = bfhi(c.x); x[10] = bflo(c.y); x[11] = bfhi(c.y); x[12] = bflo(c.z); x[13] = bfhi(c.z); x[14] = bflo(c.w); x[15] = bfhi(c.w); } while (0)
#define QK_PACK(o, x) do { _Pragma("unroll") for (int w4 = 0; w4 < 4; ++w4) { unsigned w = 0; w = __builtin_amdgcn_cvt_pk_fp8_f32(x[4 * w4], x[4 * w4 + 1], w, false); w = __builtin_amdgcn_cvt_pk_fp8_f32(x[4 * w4 + 2], x[4 * w4 + 3], w, true); o[w4] = w; } } while (0)
    const float qscale = att::SCALE * 1.4426950408889634f * 8.0f;
    int rfirst = gw;
    if (F.G * NWAVES * 32 == ML) {
        v4u nq[4][2], nk[2];
#define QK4_LOAD(it_) do { _Pragma("unroll") for (int k = 0; k < 4; ++k) { const bf16* pr_ = P + (size_t)(gw + (4 * (it_) + k) * NGW) * 1536 + 16 * L; nq[k][0] = *(const v4u*)pr_; nq[k][1] = *(const v4u*)(pr_ + 8); } \
        { const bf16* pk_ = P + (size_t)(gw + (4 * (it_) + (L >> 4)) * NGW) * 1536 + 1024 + 16 * (L & 15); nk[0] = *(const v4u*)pk_; nk[1] = *(const v4u*)(pk_ + 8); } } while (0)
        QK4_LOAD(0);
#pragma unroll 1
        for (int it = 0; it < 8; ++it) {
            v4u q[4][2], kk[2];
#pragma unroll
            for (int k = 0; k < 4; ++k) { q[k][0] = nq[k][0]; q[k][1] = nq[k][1]; }
            kk[0] = nk[0]; kk[1] = nk[1];
            if (it + 1 < 8) QK4_LOAD(it + 1);
#pragma unroll
            for (int k = 0; k < 4; ++k) { const int r = gw + (4 * it + k) * NGW, s = r & (SEQ - 1); float x[16];
                QK_UNPACK(x, q[k][0], q[k][1]);
                normrope16(x, qg, true, s >> 6, s & 63, T, L, qscale, L);
                v4u o; QK_PACK(o, x); *(v4u*)(Q8 + (size_t)r * D + 16 * L) = o; }
            { const int r = gw + (4 * it + (L >> 4)) * NGW, s = r & (SEQ - 1), Lk = L & 15; float x[16];
              QK_UNPACK(x, kk[0], kk[1]);
              normrope16(x, kg, true, s >> 6, s & 63, T, Lk, 1.0f, L);
              v4u o; QK_PACK(o, x); *(v4u*)(K8 + ((size_t)(r >> 13) * SKV + s) * 256 + 16 * Lk) = o; }
        }
#undef QK4_LOAD
        rfirst = gw + 32 * NGW;
    }
    v4u nqa, nqc, nka, nkc;
#define QK_LOAD(r_) do { const bf16* pr_ = P + (size_t)(r_) * 1536; nqa = *(const v4u*)(pr_ + 16 * L); nqc = *(const v4u*)(pr_ + 16 * L + 8); nka = *(const v4u*)(pr_ + 1024 + 16 * (L & 15)); nkc = *(const v4u*)(pr_ + 1024 + 16 * (L & 15) + 8); } while (0)
    if (rfirst < MT) QK_LOAD(rfirst);
    for (int r = rfirst; r < MT; r += NGW) {
        const v4u qa_ = nqa, qc_ = nqc, ka_ = nka, kc_ = nkc;
        if (r + NGW < MT) QK_LOAD(r + NGW);
        const bool lat = r < ML; const int b = lat ? (r >> 13) : ((r - ML) >> 8); const int s = lat ? (r & (SEQ - 1)) : ((r - ML) & (CL - 1));
        const int prow = s >> 6, pcol = s & 63; const size_t kvrow = (size_t)b * SKV + (lat ? s : SEQ + s);
        { float x[16]; QK_UNPACK(x, qa_, qc_);
          normrope16(x, qg, lat, prow, pcol, T, L, qscale, L);
          v4u o; QK_PACK(o, x); *(v4u*)(Q8 + (size_t)r * D + 16 * L) = o; }
        { const int Lk = L & 15; float x[16]; QK_UNPACK(x, ka_, kc_);
          normrope16(x, kg, lat, prow, pcol, T, Lk, 1.0f, L);
          if (L < 16) { v4u o; QK_PACK(o, x); *(v4u*)(K8 + kvrow * 256 + 16 * L) = o; } }
    }
#undef QK_LOAD
#undef QK_UNPACK
#undef QK_PACK
    LAS unsigned char* Tt = F.lds + 32768;
    for (int tile = F.bx; tile < NB * (SKV / 64); tile += F.G) {
        const int b = tile / (SKV / 64), kb = tile % (SKV / 64), ki = F.tid >> 3, seg = F.tid & 7, pos = kb * 64 + ki;
        const size_t r = pos < SEQ ? (size_t)b * SEQ + pos : (size_t)ML + (size_t)b * CL + (pos - SEQ);
        const int k5 = ki & 31, slot = 32 * ((k5 >> 2) & 1) + ((k5 & 3) | ((k5 >> 3) << 2)) + (ki >= 32 ? 16 : 0);
        const v4u* src = (const v4u*)(P + r * 1536 + 1280 + 32 * seg);
        __syncthreads();
#pragma unroll
        for (int q = 0; q < 4; ++q) { const v4u w = src[q]; const unsigned ww[4] = {w.x, w.y, w.z, w.w};
#pragma unroll
            for (int e2 = 0; e2 < 4; ++e2) { const unsigned pk = __builtin_amdgcn_cvt_pk_fp8_f32(bflo(ww[e2]), bfhi(ww[e2]), 0u, false); const int dd = 32 * seg + 8 * q + 2 * e2;
                Tt[dd * 64 + slot] = (unsigned char)(pk & 0xff); Tt[(dd + 1) * 64 + slot] = (unsigned char)((pk >> 8) & 0xff); } }
        __syncthreads();
        { const int rho = F.tid >> 1, half = F.tid & 1; const v4u a = *(const LAS v4u*)(Tt + rho * 64 + 32 * half), c = *(const LAS v4u*)(Tt + rho * 64 + 32 * half + 16);
          unsigned char* dst = VT8 + ((size_t)(b * 2 + (rho >> 7)) * 128 + (rho & 127)) * SKV + kb * 64 + 32 * half;
          *(v4u*)dst = a; *(v4u*)(dst + 16) = c; }
    }
    __syncthreads();
}
template <int XV = 0>
__device__ __forceinline__ void attention_phase(Frame& F, char* lds_generic, bool ctx_queries, int j) {
    const float nb = -((const float*)(F.ws + WS_RC))[2048 + j] - 8.0f;
    const unsigned char* Q8 = (const unsigned char*)(F.ws + WS_QB); const unsigned char* K8 = (const unsigned char*)(F.ws + WS_QB + WS_K8_OFF); const unsigned char* VT8 = (const unsigned char*)(F.ws + WS_KVB); bf16* Y = (bf16*)(F.ws + WS_Y);
    const int nunits = 2048 + (ctx_queries ? 64 : 0);
    for (int u = F.bx; u < nunits; u += F.G) {
        if (u < 2048) { const int b = u >> 8, w = u & 255, h = w & 7, qb = w >> 3; const size_t qo = ((size_t)b * SEQ + (size_t)qb * 256) * D + h * 128;
            att::attn_dense_body<XV>(Q8 + qo, K8 + (size_t)b * SKV * 256 + (h >> 2) * 128, VT8 + (size_t)(b * 2 + (h >> 2)) * 128 * SKV, SKV, Y + qo, SKV, lds_generic, F.wave, nb); }
        else { const int w = u - 2048, b = w >> 3, h = w & 7; const size_t qo = ((size_t)ML + (size_t)b * CL) * D + h * 128;
            att::attn_dense_body<XV>(Q8 + qo, K8 + ((size_t)b * SKV + SEQ) * 256 + (h >> 2) * 128, VT8 + (size_t)(b * 2 + (h >> 2)) * 128 * SKV + SEQ, SKV, Y + qo, CL, lds_generic, F.wave, nb); }
    }
}

__device__ __forceinline__ void gmlp_mix_phase(Frame& F) {
    constexpr int LDA = 136, LDO = 132;
    LAS bf16* As = (LAS bf16*)F.lds;
    LAS bf16* Vt = (LAS bf16*)(F.lds + 128 * LDA * 2);
    LAS float* rs = (LAS float*)(F.lds + 2 * 128 * LDA * 2);
    LAS float* Ot = (LAS float*)(F.lds + 2 * 128 * LDA * 2 + 512);
    const bf16* P = (const bf16*)(F.ws + WS_P); bf16* Y = (bf16*)(F.ws + WS_Y); const float* SS = (const float*)(F.ws + WS_SS);
    const float* ws = PIN(F, I_GWS); const float* bs = PIN(F, I_GBS); const float* vg = PIN(F, I_GVG);
    const int r32 = F.lane & 31, hi = F.lane >> 5;
    constexpr int NU = (MT / 128) * 8;
    struct GIn { f32x4 s; v4u v[4], uu[4]; } ga, gb; int gcur = -1;
#define GM_LOAD(u_, IN) do { const int g_ = (u_) & 7; const size_t row0_ = (size_t)((u_) >> 3) * 128; \
        IN.s = *(const f32x4*)(SS + (row0_ + (F.tid >> 2)) * 16 + (F.tid & 3) * 4);                                       \
        _Pragma("unroll") for (int k = 0; k < 4; ++k) { const int i_ = F.tid + NTHREADS * k, q_ = i_ >> 4, c8_ = (i_ & 15) * 8; const bf16* pp_ = P + (row0_ + q_) * 2048 + g_ * 128 + c8_; \
            IN.v[k] = *(const v4u*)(pp_ + 1024); IN.uu[k] = *(const v4u*)pp_; } } while (0)
#define GM_UNIT(u_, IN) do { \
        const int chunk = (u_) >> 3, g = (u_) & 7; const size_t row0 = (size_t)chunk * 128; \
        __syncthreads(); \
        if (g != gcur) { gcur = g; \
            for (int i = F.tid; i < 128 * 32; i += NTHREADS) { const int p = i >> 5, q4 = (i & 31) * 4; const f32x4 w = *(const f32x4*)(ws + ((size_t)g * 128 + p) * 128 + q4); \
                v2u o; o.x = pk2(w.x, w.y); o.y = pk2(w.z, w.w); *(LAS v2u*)(As + p * LDA + q4) = o; } } \
        { float s = (IN.s.x + IN.s.y) + (IN.s.z + IN.s.w); s += shx(s, 1, F.lane); s += shx(s, 2, F.lane); if ((F.tid & 3) == 0) rs[F.tid >> 2] = 1.0f / sqrtf(s * (1.0f / 1024.0f) + EPS); } \
        __syncthreads(); \
        _Pragma("unroll") for (int k = 0; k < 4; ++k) { const int i = F.tid + NTHREADS * k, q = i >> 4, c8 = (i & 15) * 8; const float rq = rs[q]; const unsigned ww[4] = {IN.v[k].x, IN.v[k].y, IN.v[k].z, IN.v[k].w}; \
            _Pragma("unroll") for (int e2 = 0; e2 < 4; ++e2) { const unsigned pk = cvt_pk_bf16(bflo(ww[e2]) * rq, bfhi(ww[e2]) * rq); Vt[(c8 + 2 * e2) * LDA + q] = (bf16)(pk & 0xffff); Vt[(c8 + 2 * e2 + 1) * LDA + q] = (bf16)(pk >> 16); } } \
        __syncthreads(); \
        const int p0 = (F.wave >> 1) * 32, cbase = (F.wave & 1) * 64; \
        f32x16 acc0 = {}, acc1 = {}; \
        _Pragma("unroll") for (int ks = 0; ks < 8; ++ks) { const int k0 = ks * 16 + hi * 8; \
            const bf16x8 a = *(const LAS bf16x8*)(As + (p0 + r32) * LDA + k0); \
            const bf16x8 b0 = *(const LAS bf16x8*)(Vt + (cbase + r32) * LDA + k0), b1 = *(const LAS bf16x8*)(Vt + (cbase + 32 + r32) * LDA + k0); \
            acc0 = __builtin_amdgcn_mfma_f32_32x32x16_bf16(a, b0, acc0, 0, 0, 0); acc1 = __builtin_amdgcn_mfma_f32_32x32x16_bf16(a, b1, acc1, 0, 0, 0); } \
        _Pragma("unroll") for (int t = 0; t < 2; ++t) { const int cl = cbase + t * 32 + r32; const float gain = vg[g * 128 + cl]; \
            _Pragma("unroll") for (int reg = 0; reg < 16; ++reg) { const int p = p0 + (reg & 3) + 8 * (reg >> 2) + 4 * hi; Ot[p * LDO + cl] = gain * (t == 0 ? acc0[reg] : acc1[reg]) + bs[g * 128 + p]; } } \
        __syncthreads(); \
        _Pragma("unroll") for (int k = 0; k < 4; ++k) { const int i = F.tid + NTHREADS * k, p = i >> 4, c8 = (i & 15) * 8; const v4u uw = IN.uu[k]; \
            const LAS float* o = Ot + p * LDO + c8; const f32x4 m0 = *(const LAS f32x4*)o, m1 = *(const LAS f32x4*)(o + 4); \
            v4u w; w.x = cvt_pk_bf16(bflo(uw.x) * m0.x, bfhi(uw.x) * m0.y); w.y = cvt_pk_bf16(bflo(uw.y) * m0.z, bfhi(uw.y) * m0.w); \
            w.z = cvt_pk_bf16(bflo(uw.z) * m1.x, bfhi(uw.z) * m1.y); w.w = cvt_pk_bf16(bflo(uw.w) * m1.z, bfhi(uw.w) * m1.w); \
            *(v4u*)(Y + (row0 + p) * D + g * 128 + c8) = w; } } while (0)
    int u = F.bx;
    if (u < NU) GM_LOAD(u, ga);
    for (; u < NU; u += 2 * F.G) {
        if (u + F.G < NU) GM_LOAD(u + F.G, gb);
        GM_UNIT(u, ga);
        if (u + F.G >= NU) break;
        if (u + 2 * F.G < NU) GM_LOAD(u + 2 * F.G, ga);
        GM_UNIT(u + F.G, gb);
    }
    __syncthreads();
#undef GM_LOAD
#undef GM_UNIT
}

__device__ __forceinline__ void hyena_prep_phase(Frame& F) {
    LAS float* tl = (LAS float*)F.lds;
    const bf16* P = (const bf16*)(F.ws + WS_P); bf16* X0 = (bf16*)(F.ws + WS_X0); bf16* VG = (bf16*)(F.ws + WS_VG);
    float* VT = (float*)(F.ws + WS_VT); float* VTC = (float*)(F.ws + WS_VTC);
    const float* cw = PIN(F, I_HCW); const float* cb = PIN(F, I_HCB);
    const int tt = F.tid >> 3, cg = F.tid & 7;
    constexpr int NU = (MT / 64) * 16;
    v4u pa[3][3], pb[3][3];
#define HP_LOAD(u_, IN) do { const int tb_ = (u_) >> 4, c0_ = ((u_) & 15) * 64, r0_ = tb_ * 64; const bool lat_ = r0_ < ML; \
        const int s_ = (lat_ ? (r0_ & (SEQ - 1)) : ((r0_ - ML) & (CL - 1))) + tt, L_ = lat_ ? SEQ : CL; const bf16* pr_ = P + (size_t)(r0_ + tt) * 3072 + c0_ + cg * 8; const v4u z0_ = {0u, 0u, 0u, 0u}; \
        _Pragma("unroll") for (int seg = 0; seg < 3; ++seg) { IN[seg][0] = s_ > 0 ? *(const v4u*)(pr_ + seg * 1024 - 3072) : z0_; IN[seg][1] = *(const v4u*)(pr_ + seg * 1024); \
            IN[seg][2] = s_ < L_ - 1 ? *(const v4u*)(pr_ + seg * 1024 + 3072) : z0_; } } while (0)
    LAS float* wl = tl + 64 * 65; int c0w = -1;
#define HP_UNIT(u_, IN) do { \
        const int tb = (u_) >> 4, c0 = ((u_) & 15) * 64; const int r0 = tb * 64; const bool lat = r0 < ML; \
        const int b = lat ? (r0 >> 13) : ((r0 - ML) >> 8), s0 = lat ? (r0 & (SEQ - 1)) : ((r0 - ML) & (CL - 1)); \
        const int r = r0 + tt, c = c0 + cg * 8; \
        if (c0 != c0w) { c0w = c0; __syncthreads(); \
            for (int i = F.tid; i < 768; i += NTHREADS) { const int seg = i >> 8, k = (i >> 6) & 3, ch = i & 63; wl[i] = k < 3 ? cw[k * 3072 + seg * 1024 + c0 + ch] : cb[seg * 1024 + c0 + ch]; } \
            __syncthreads(); } \
        float o[3][8]; \
        _Pragma("unroll") for (int seg = 0; seg < 3; ++seg) { \
            const unsigned pmw[4] = {IN[seg][0].x, IN[seg][0].y, IN[seg][0].z, IN[seg][0].w}, pcw[4] = {IN[seg][1].x, IN[seg][1].y, IN[seg][1].z, IN[seg][1].w}, pnw[4] = {IN[seg][2].x, IN[seg][2].y, IN[seg][2].z, IN[seg][2].w}; \
            _Pragma("unroll") for (int i = 0; i < 8; ++i) { const float xm = (i & 1) ? bfhi(pmw[i >> 1]) : bflo(pmw[i >> 1]), xc = (i & 1) ? bfhi(pcw[i >> 1]) : bflo(pcw[i >> 1]), xn = (i & 1) ? bfhi(pnw[i >> 1]) : bflo(pnw[i >> 1]); \
                const LAS float* wp = wl + seg * 256 + cg * 8 + i; o[seg][i] = xm * wp[0] + xc * wp[64] + xn * wp[128] + wp[192]; } } \
        float vgv[8]; \
        _Pragma("unroll") for (int i = 0; i < 8; ++i) vgv[i] = o[2][i] * o[1][i]; \
        v4u w; w.x = cvt_pk_bf16(o[0][0], o[0][1]); w.y = cvt_pk_bf16(o[0][2], o[0][3]); w.z = cvt_pk_bf16(o[0][4], o[0][5]); w.w = cvt_pk_bf16(o[0][6], o[0][7]); \
        *(v4u*)(X0 + (size_t)r * D + c) = w; \
        __syncthreads(); \
        _Pragma("unroll") for (int i = 0; i < 8; ++i) tl[(cg * 8 + i) * 65 + tt] = vgv[i]; \
        __syncthreads(); \
        { const int cc = F.tid >> 3, ts = (F.tid & 7) * 8; const LAS float* sp = tl + cc * 65 + ts; \
          if (lat) *(v4u*)((bf16*)VT + ((size_t)b * 1024 + c0 + cc) * SEQ + s0 + ts) = (v4u){cvt_pk_bf16(sp[0], sp[1]), cvt_pk_bf16(sp[2], sp[3]), cvt_pk_bf16(sp[4], sp[5]), cvt_pk_bf16(sp[6], sp[7])};        \
          else { float* dst = VTC + ((size_t)b * 1024 + c0 + cc) * CL + s0 + ts; *(f32x4*)dst = (f32x4){sp[0], sp[1], sp[2], sp[3]}; *(f32x4*)(dst + 4) = (f32x4){sp[4], sp[5], sp[6], sp[7]}; } } } while (0)
    int u = F.bx;
    if (u < NU) HP_LOAD(u, pa);
    for (; u < NU; u += 2 * F.G) {
        if (u + F.G < NU) HP_LOAD(u + F.G, pb);
        HP_UNIT(u, pa);
        if (u + F.G >= NU) break;
        if (u + 2 * F.G < NU) HP_LOAD(u + 2 * F.G, pa);
        HP_UNIT(u + F.G, pb);
    }
    __syncthreads();
#undef HP_LOAD
#undef HP_UNIT
}
__device__ __forceinline__ void hyena_post_phase(Frame& F) {
    LAS float* tl = (LAS float*)F.lds;
    const bf16* X0 = (const bf16*)(F.ws + WS_X0); const bf16* VG = (const bf16*)(F.ws + WS_VG); bf16* Y = (bf16*)(F.ws + WS_Y);
    const float* VT = (const float*)(F.ws + WS_CT); const float* VTC = (const float*)(F.ws + WS_CTC); const float* dsk = PIN(F, I_HD);
    const int tt = F.tid >> 3, cg = F.tid & 7;
    constexpr int NU = (MT / 64) * 16;
    struct PIn { f32x4 a, bq; v4u cw, x0; } qa, qb;
#define HQ_LOAD(u_, IN) do { const int tb_ = (u_) >> 4, c0_ = ((u_) & 15) * 64, r0_ = tb_ * 64; const bool lat_ = r0_ < ML; \
        const int b_ = lat_ ? (r0_ >> 13) : ((r0_ - ML) >> 8), s0_ = lat_ ? (r0_ & (SEQ - 1)) : ((r0_ - ML) & (CL - 1)); const int cc_ = F.tid >> 3, ts_ = (F.tid & 7) * 8; \
        if (lat_) IN.cw = *(const v4u*)((const bf16*)VT + ((size_t)b_ * 1024 + c0_ + cc_) * SEQ + s0_ + ts_);        \
        else { const float* src_ = VTC + ((size_t)b_ * 1024 + c0_ + cc_) * CL + s0_ + ts_; IN.a = *(const f32x4*)src_; IN.bq = *(const f32x4*)(src_ + 4); } \
        IN.x0 = *(const v4u*)(X0 + (size_t)(r0_ + tt) * D + c0_ + cg * 8); } while (0)
#define HQ_UNIT(u_, IN) do { \
        const int tb = (u_) >> 4, c0 = ((u_) & 15) * 64; const int r0 = tb * 64; \
        __syncthreads(); \
        { const int cc = F.tid >> 3, ts = (F.tid & 7) * 8; LAS float* dp = tl + cc * 65 + ts; \
          if (r0 < ML) { dp[0] = bflo(IN.cw.x); dp[1] = bfhi(IN.cw.x); dp[2] = bflo(IN.cw.y); dp[3] = bfhi(IN.cw.y); dp[4] = bflo(IN.cw.z); dp[5] = bfhi(IN.cw.z); dp[6] = bflo(IN.cw.w); dp[7] = bfhi(IN.cw.w); } \
          else { dp[0] = IN.a.x; dp[1] = IN.a.y; dp[2] = IN.a.z; dp[3] = IN.a.w; dp[4] = IN.bq.x; dp[5] = IN.bq.y; dp[6] = IN.bq.z; dp[7] = IN.bq.w; } } \
        __syncthreads(); \
        const int r = r0 + tt, c = c0 + cg * 8; \
        const unsigned x0w[4] = {IN.x0.x, IN.x0.y, IN.x0.z, IN.x0.w}; float y[8]; \
        _Pragma("unroll") for (int i = 0; i < 8; ++i) { const float xx = (i & 1) ? bfhi(x0w[i >> 1]) : bflo(x0w[i >> 1]); y[i] = tl[(cg * 8 + i) * 65 + tt] * xx; }        \
        v4u w; w.x = cvt_pk_bf16(y[0], y[1]); w.y = cvt_pk_bf16(y[2], y[3]); w.z = cvt_pk_bf16(y[4], y[5]); w.w = cvt_pk_bf16(y[6], y[7]); \
        *(v4u*)(Y + (size_t)r * D + c) = w; } while (0)
    int u = F.bx;
    if (u < NU) HQ_LOAD(u, qa);
    for (; u < NU; u += 2 * F.G) {
        if (u + F.G < NU) HQ_LOAD(u + F.G, qb);
        HQ_UNIT(u, qa);
        if (u + F.G >= NU) break;
        if (u + 2 * F.G < NU) HQ_LOAD(u + 2 * F.G, qa);
        HQ_UNIT(u + F.G, qb);
    }
    __syncthreads();
#undef HQ_LOAD
#undef HQ_UNIT
}
__device__ __forceinline__ bool phase_nonempty(int ph) {
    if (ph < PH_L0 || ph >= PH_FINAL) return true;
    const int layer = (ph - PH_L0) / PH_PER_LAYER, lp = (ph - PH_L0) % PH_PER_LAYER, kind = layer % 3;
    if (lp == LP_MIX2) return kind != 1;
    if (lp == LP_MIX3) return kind == 2;
    return true;
}
__global__ void __launch_bounds__(NTHREADS, 2) mk_fwd(Args args) {
    extern __shared__ __attribute__((aligned(16))) unsigned char lds[];
    Frame F0;
    F0.lds = (LAS unsigned char*)lds; F0.MISC = (volatile LAS unsigned*)(F0.lds + MISC_OFF);
    F0.tid = threadIdx.x; F0.lane = F0.tid & 63; F0.wave = __builtin_amdgcn_readfirstlane(F0.tid >> 6);
    F0.G = gridDim.x; F0.bx = blockIdx.x; F0.out = args.out; F0.ws = args.ws; F0.ctl = (gu32*)(args.ws + WS_CTL);
    for (int u = F0.tid; u < MISC_BYTES / 4; u += NTHREADS) F0.MISC[u] = 0u;
    __syncthreads();
    if (F0.tid < 36) { const unsigned long long p = (unsigned long long)args.in[F0.tid]; F0.MISC[MW_PTRS + 2 * F0.tid] = (unsigned)p; F0.MISC[MW_PTRS + 2 * F0.tid + 1] = (unsigned)(p >> 32); }
    __syncthreads();
    const int lo = args.ph_lo, hi = args.ph_hi;
    const bool multi = (hi - lo) > 1;
    XcdBarrier bar; bar.bar = (unsigned*)(F0.ctl + CW_BAR); bar.x = 0; bar.st = nullptr; bar.w = F0.wave;
    if (multi) bar = xcd_barrier_post((unsigned*)(F0.ctl + CW_BAR), F0.MISC + 8, F0.wave);
#ifndef PHMASK
#define PHMASK 0xFFFF
#endif
#define EN(b) ((PHMASK >> (b)) & 1)
#ifndef MK_STAG_IN
#define MK_STAG_IN 0u
#define MK_STAG_OUT 0u
#define MK_STAG_M1 0u
#define MK_STAG_M2 0u
#endif
#ifndef KMASK
#define KMASK 7
#endif
#define KEN(b) ((KMASK >> (b)) & 1)
#define IN(k) (lo <= (k) && (k) < hi)
#define SEAM(k) do { if ((k) + 1 < hi) xcd_barrier(bar); } while (0)
#define PB(id) for (int _rep = 0, _n = ((id) == MK_REPEAT ? MK_NREP : 1); _rep < _n; ++_rep) {
#define PE(id) if (_rep + 1 < _n) xcd_barrier(bar); } SEAM(id);

    if (EN(0) && IN(PH_PRO0)) { PB(PH_PRO0) Frame F = phase_frame(F0); pro0_mod(F); __syncthreads(); pro0_transposes(F); pro0_filter_mlp(F); PE(PH_PRO0) }
    if (EN(1) && IN(PH_PRO1)) { PB(PH_PRO1) Frame F = phase_frame(F0); pro1_router_split(F); pro1_filters(F); PE(PH_PRO1) }

#pragma unroll 1
    for (int layer = 0; layer < NLAYER; ++layer) {
        const int kind = layer % 3, jj = layer / 3, pb = PH_L0 + layer * PH_PER_LAYER; const bool last = layer == NLAYER - 1;
        if (EN(2) && IN(pb + LP_NORM1)) { PB(pb + LP_NORM1) Frame F = phase_frame(F0); rowpass<0>(F, layer, _rep + 1 == _n, kind != 1); PE(pb + LP_NORM1) }
        if (EN(3) && IN(pb + LP_INPROJ)) { PB(pb + LP_INPROJ)
            Frame F = phase_frame(F0);
            if (kind != 1) {
                const int N = kind == 0 ? 1536 : 3072;
                pg8::DenseSchedT<true> S; S.init(F.ws + WS_H8, kind == 0 ? F.ws + WS_WATT + (size_t)jj * 1536 * 1024 : F.ws + WS_WHY, MT, N, F.G, F.bx, 1024);
                pg8::EpiBf16 E{(bf16*)(F.ws + WS_P), N, (float*)(F.ws + WS_SS), 0};
                pg8::gemm_phase<pg8::EpiBf16, pg8::DenseSchedT<true>, true, true>(F.lds, S, E, F.wave, false, MK_STAG_IN);
            } else {
                const int N = 2048;
                pg8::DenseSched S; S.init(F.ws + WS_H, F.ws + WS_WGM, MT, N, F.G, F.bx);
                pg8::EpiBf16 E{(bf16*)(F.ws + WS_P), N, (float*)(F.ws + WS_SS), 1};
                pg8::gemm_phase<pg8::EpiBf16, pg8::DenseSched, false>(F.lds, S, E, F.wave, false, MK_STAG_IN);
            }
            PE(pb + LP_INPROJ)
        }
        if (IN(pb + LP_MIX1)) { PB(pb + LP_MIX1)
            Frame F = phase_frame(F0);
            if (EN(4) && kind == 0) qkprep_phase(F, jj); else if (EN(5) && kind == 1) gmlp_mix_phase(F); else if (EN(6)) hyena_prep_phase(F);
            PE(pb + LP_MIX1)
        }
        if (IN(pb + LP_MIX2) && kind != 1) { PB(pb + LP_MIX2)
            Frame F = phase_frame(F0);
            if (EN(7) && kind == 0) {
#if MK_XP >= 10 && MK_XP < 20
                if (_rep + 1 < _n) attention_phase<MK_XP - 10>(F, (char*)lds, !last, jj); else
#endif
                attention_phase<0>(F, (char*)lds, !last, jj); }
            else if (EN(8)) hyena_conv_phase(F);
            PE(pb + LP_MIX2)
        }
        if (EN(9) && IN(pb + LP_MIX3) && kind == 2) { PB(pb + LP_MIX3) Frame F = phase_frame(F0); hyena_post_phase(F); PE(pb + LP_MIX3) }
        if (EN(10) && IN(pb + LP_OUTPROJ)) { PB(pb + LP_OUTPROJ)
            Frame F = phase_frame(F0); const float* modl = (const float*)(F.ws + WS_MOD) + (size_t)layer * 9 * 6144;
            pg8::DenseSched S; S.init(F.ws + WS_Y, F.ws + WS_WOUT + (size_t)layer * 1024 * 1024 * 2, last ? ML : MT, 1024, F.G, F.bx);
            pg8::EpiResid E{(bf16*)(F.ws + WS_XB), modl};
            pg8::gemm_phase<pg8::EpiResid, pg8::DenseSched, false>(F.lds, S, E, F.wave, false, MK_STAG_OUT);
            PE(pb + LP_OUTPROJ)
        }
        if (EN(11) && IN(pb + LP_NORM2)) { PB(pb + LP_NORM2) Frame F = phase_frame(F0); router_phase(F, layer, _rep + 1 == _n, (_rep + 1 < _n) ? MK_XP : 0); PE(pb + LP_NORM2) }
        if (EN(12) && IN(pb + LP_MOE1)) { PB(pb + LP_MOE1)
            Frame F = phase_frame(F0);
            moe_tables(F, layer);
            pg8::MoeSched S{(const char*)(F.ws + WS_H8), (const char*)(F.ws + WS_WE1) + (size_t)layer * NE * 2048 * 1024, (size_t)2048 * 1024, (const int*)(F.ws + WS_ROWTOK),
                            (const volatile LAS int*)(F.MISC + MW_CUMBLK), (const volatile LAS int*)(F.MISC + MW_CNT), 3, F.G, F.bx, 1024, (const volatile LAS int*)(F.lds + AUX_OFF + 1024)};
            S.build_list((volatile LAS int*)(F.lds + AUX_OFF + 1024), F.tid); __syncthreads();
            pg8::EpiSwiglu E{(unsigned char*)(F.ws + WS_ACT), PIN(F, I_EB1) + (size_t)layer * NE * 2048, (LAS float*)(F.lds + AUX_OFF)};
#if MK_XP >= 20
            if (_rep + 1 < _n) { int one_ = 1; asm volatile("" : "+s"(one_)); pg8::gemm_phase<pg8::EpiSwiglu, pg8::MoeSched, true, true, MK_XP - 20>(F.lds, S, E, F.wave, one_ != 0, MK_STAG_M1); } else
#endif
            pg8::gemm_phase<pg8::EpiSwiglu, pg8::MoeSched, true, true>(F.lds, S, E, F.wave, MK_XP == 1 && _rep + 1 < _n, MK_STAG_M1);
            PE(pb + LP_MOE1)
        }
        if (EN(13) && IN(pb + LP_MOE2)) { PB(pb + LP_MOE2)
            Frame F = phase_frame(F0);
            moe_tables(F, layer);
            pg8::MoeSched S{(const char*)(F.ws + WS_ACT), (const char*)(F.ws + WS_WE2) + (size_t)layer * NE * 1024 * 1024, (size_t)1024 * 1024, nullptr,
                            (const volatile LAS int*)(F.MISC + MW_CUMBLK), (const volatile LAS int*)(F.MISC + MW_CNT), 2, F.G, F.bx, 1024, (const volatile LAS int*)(F.lds + AUX_OFF + 1024)};
            S.build_list((volatile LAS int*)(F.lds + AUX_OFF + 1024), F.tid); __syncthreads();
            pg8::EpiBias E{(unsigned char*)(F.ws + WS_YM), PIN(F, I_EB2) + (size_t)layer * NE * 1024, (LAS float*)(F.lds + AUX_OFF)};
            pg8::gemm_phase<pg8::EpiBias, pg8::MoeSched, true, true>(F.lds, S, E, F.wave, MK_XP == 1 && _rep + 1 < _n, MK_STAG_M2);
            PE(pb + LP_MOE2)
        }
    }
    if (EN(14) && IN(PH_FINAL)) { PB(PH_FINAL) Frame F = phase_frame(F0); rowpass<2>(F, NLAYER - 1, _rep + 1 == _n); PE(PH_FINAL) }
#undef IN
#undef SEAM
}

static bool host_phase_nonempty(int ph) {
    if (ph < PH_L0 || ph >= PH_FINAL) return true;
    const int layer = (ph - PH_L0) / PH_PER_LAYER, lp = (ph - PH_L0) % PH_PER_LAYER, kind = layer % 3;
    if (lp == LP_MIX2) return kind != 1;
    if (lp == LP_MIX3) return kind == 2;
    return true;
}
extern "C" void kernel_launch(void* const* d_in, const int* in_sizes, int n_in, void* d_out, int out_size, void* d_ws, size_t ws_size, hipStream_t stream) {
    static int grid = 0;
    if (grid == 0) {
        if (n_in != 36 || in_sizes[0] != ML * D || out_size != ML * D || ws_size < WS_END) {
            fprintf(stderr, "kernel_launch: built for 36 inputs, x/out of %d floats, >= %zu bytes of workspace; got n_in %d in0 %d out %d ws %zu; nothing launched\n", ML * D, (size_t)WS_END, n_in, n_in > 0 ? in_sizes[0] : -1, out_size, ws_size);
            grid = -1; return; }
        int dev = 0, cus = 0, per_cu = 0;
        if (hipGetDevice(&dev) != hipSuccess || hipDeviceGetAttribute(&cus, hipDeviceAttributeMultiprocessorCount, dev) != hipSuccess) { fprintf(stderr, "kernel_launch: device query failed\n"); grid = -1; return; }
        if (hipFuncSetAttribute((const void*)mk_fwd, hipFuncAttributeMaxDynamicSharedMemorySize, LDS_BYTES) != hipSuccess) { fprintf(stderr, "kernel_launch: hipFuncSetAttribute(%d B LDS) failed\n", LDS_BYTES); grid = -1; return; }
        if (hipOccupancyMaxActiveBlocksPerMultiprocessor(&per_cu, (const void*)mk_fwd, NTHREADS, LDS_BYTES) != hipSuccess || per_cu < 1)
            fprintf(stderr, "kernel_launch: note: occupancy query reports %d workgroups per CU\n", per_cu);
        (void)hipGetLastError();
        grid = cus;
    }
    if (grid < 0) return;
    if (hipMemsetAsync((char*)d_ws + WS_CTL, 0, CTL_ZERO_BYTES, stream) != hipSuccess) { fprintf(stderr, "kernel_launch: memset failed\n"); return; }
    Args a{};
    for (int i = 0; i < 36; ++i) a.in[i] = (const float*)d_in[i];
    a.out = (float*)d_out; a.ws = (unsigned char*)d_ws;
#if MK_MULTI || MK_DBG
    for (int ph = 0; ph < PH_COUNT; ++ph) {
        if (!host_phase_nonempty(ph)) continue;
        a.ph_lo = ph; a.ph_hi = ph + 1;
        hipLaunchKernelGGL(mk_fwd, dim3(grid), dim3(NTHREADS), LDS_BYTES, stream, a);
#if MK_DBG
        dbg_after_phase(ph, a, stream);
#endif
    }
#if MK_DBG
    dbg_report(a, stream);
#endif
#else
    a.ph_lo = 0; a.ph_hi = PH_COUNT;
    hipLaunchKernelGGL(mk_fwd, dim3(grid), dim3(NTHREADS), LDS_BYTES, stream, a);
#endif
    const hipError_t le = hipPeekAtLastError();
    if (le != hipSuccess) fprintf(stderr, "kernel_launch: launch failed: %s\n", hipGetErrorName(le));
}
```

```cpp
#include <hip/hip_runtime.h>
#include <cstdio>
#include <cstdint>
#include <cmath>

#ifndef MK_MULTI
#define MK_MULTI 0
#endif
#ifndef MK_REPEAT
#define MK_REPEAT -1
#endif
#ifndef MK_NREP
#define MK_NREP 1
#endif
#ifndef MK_XP
#define MK_XP 0
#endif
#ifndef MK_MOEMAP
#define MK_MOEMAP 0
#endif
#ifndef MK_DBG
#define MK_DBG 0
#endif

constexpr int D = 1024, NB = 8, SEQ = 8192, CL = 256, ML = NB * SEQ, MC = NB * CL, MT = ML + MC;
constexpr int NLAYER = 4, NE = 32, TOPK = 4, SKV = SEQ + CL;
constexpr int MOE_MAXBLK = (MT * TOPK) / 256 + NE;
constexpr float EPS = 1e-6f;
constexpr int FH = 64, FEMB = 33, NFFT = 16384;

constexpr size_t MiB = 1u << 20;
constexpr size_t WS_CTL = 0, CTL_ZERO_BYTES = 1 * MiB;
constexpr size_t WS_MOD = 1 * MiB;
constexpr size_t WS_A3 = 2 * MiB;
constexpr size_t WS_A3C = 4 * MiB;
constexpr size_t WS_RC = 4 * MiB + 512 * 1024;
constexpr size_t WS_FCT = 5 * MiB;
constexpr size_t WS_WATT = 8 * MiB;
constexpr size_t WS_WGM = 14 * MiB;
constexpr size_t WS_WHY = 18 * MiB;
constexpr size_t WS_WOUT = 24 * MiB;
constexpr size_t WS_RW3 = 32 * MiB;
constexpr size_t WS_TE = 40 * MiB;
constexpr size_t WS_TR = 42 * MiB;
constexpr size_t WS_TG = 44 * MiB;
constexpr size_t WS_SS = 46 * MiB;
constexpr size_t WS_ROWTOK = 52 * MiB;
constexpr size_t WS_KF = 64 * MiB;
constexpr size_t WS_WE1 = 192 * MiB;
constexpr size_t WS_WE2 = 704 * MiB;
constexpr size_t WS_H = 960 * MiB;
constexpr size_t WS_P = 1092 * MiB;
constexpr size_t WS_Y = 1488 * MiB;
constexpr size_t WS_QB = 1620 * MiB;
constexpr size_t WS_K8_OFF = 72 * MiB;
constexpr size_t WS_KVB = 1752 * MiB;
constexpr size_t WS_X0 = 1818 * MiB;
constexpr size_t WS_VG = 1950 * MiB;
constexpr size_t WS_VT = 2082 * MiB;
constexpr size_t WS_VTC = 2338 * MiB;
constexpr size_t WS_ACT = 2346 * MiB;
constexpr size_t WS_YM = 2890 * MiB;
constexpr size_t WS_CT = 3434 * MiB;
constexpr size_t WS_CTC = 3690 * MiB;
constexpr size_t WS_H8 = 3698 * MiB;
constexpr size_t WS_XB = 3764 * MiB;
constexpr size_t WS_END = 3896 * MiB;
constexpr int CW_BAR = 4096;
constexpr int CW_CNT = 16384;
constexpr int CW_DBG = 32768;

constexpr int RING_BYTES = 131072;
constexpr int AUX_OFF = RING_BYTES;
constexpr int AUX_BYTES = 16384;
constexpr int MISC_OFF = AUX_OFF + AUX_BYTES;
constexpr int MISC_BYTES = 4096;
constexpr int LDS_BYTES = MISC_OFF + MISC_BYTES;

#define GAS __attribute__((address_space(1)))
#define LAS __attribute__((address_space(3)))
typedef unsigned short bf16;
typedef unsigned v4u __attribute__((ext_vector_type(4)));
typedef unsigned v2u __attribute__((ext_vector_type(2)));
typedef float f32x4 __attribute__((ext_vector_type(4)));
typedef float f32x2 __attribute__((ext_vector_type(2)));
typedef float f32x16 __attribute__((ext_vector_type(16)));
typedef short bf16x8 __attribute__((ext_vector_type(8)));
typedef short s16x4 __attribute__((ext_vector_type(4)));
typedef int i32x4 __attribute__((ext_vector_type(4)));
typedef GAS unsigned gu32;
#define RLX_AGENT __ATOMIC_RELAXED, __HIP_MEMORY_SCOPE_AGENT
#define LDS_WAIT() asm volatile("s_waitcnt lgkmcnt(0)" ::: "memory")
#define VM_WAIT() asm volatile("s_waitcnt vmcnt(0)" ::: "memory")
__device__ __forceinline__ int opaque_tid(int wave) { int l; asm volatile("v_mbcnt_lo_u32_b32 %0, -1, 0\n\tv_mbcnt_hi_u32_b32 %0, -1, %0" : "=v"(l)); return (wave << 6) | l; }
__device__ __forceinline__ unsigned f2bf(float f) { unsigned u = __builtin_bit_cast(unsigned, f); return (u + 0x7fffu + ((u >> 16) & 1u)) >> 16; }
__device__ __forceinline__ unsigned pk2(float lo, float hi) { return f2bf(lo) | (f2bf(hi) << 16); }
__device__ __forceinline__ float bf2f(unsigned short b) { return __builtin_bit_cast(float, ((unsigned)b) << 16); }
__device__ __forceinline__ float bflo(unsigned w) { return __builtin_bit_cast(float, w << 16); }
__device__ __forceinline__ float bfhi(unsigned w) { return __builtin_bit_cast(float, w & 0xffff0000u); }
__device__ __forceinline__ f32x4 bf4_f32(v2u w) { return (f32x4){__uint_as_float(w.x << 16), __uint_as_float(w.x & 0xffff0000u), __uint_as_float(w.y << 16), __uint_as_float(w.y & 0xffff0000u)}; }
__device__ __forceinline__ unsigned cvt_pk_bf16(float lo, float hi) { unsigned r; asm volatile("v_cvt_pk_bf16_f32 %0, %1, %2" : "=v"(r) : "v"(lo), "v"(hi)); return r; }
__device__ __forceinline__ float shx(float v, int mask, int lane) { return __int_as_float(__builtin_amdgcn_ds_bpermute((lane ^ mask) << 2, __float_as_int(v))); }
__device__ __forceinline__ float wave_sum(float v, int lane) {
#pragma unroll
    for (int o = 1; o < 64; o <<= 1) v += shx(v, o, lane);
    return v;
}

#define XB_TMO      128
#define XB_XCNT(j)  (256  + 64 * (j))
#define XB_XSUB(j)  (1280 + 64 * (j))
#define XB_XGEN(j)  (2304 + 64 * (j))
#define XB_TOP      3328
#define XB_TOPGEN   3392
#define XCD_BAR_WORDS 3456
#define XB_SPIN_CAP (1u << 22)
__device__ __forceinline__ unsigned xb_ld(unsigned* p)              { return __hip_atomic_load(p, __ATOMIC_RELAXED, __HIP_MEMORY_SCOPE_AGENT); }
__device__ __forceinline__ unsigned xb_add(unsigned* p, unsigned v) { return __hip_atomic_fetch_add(p, v, __ATOMIC_RELAXED, __HIP_MEMORY_SCOPE_AGENT); }
__device__ __forceinline__ unsigned xb_xcc_id() { return (unsigned)__builtin_amdgcn_s_getreg((3 << 11) | 20) & 0xFu; }
#define XB_SPIN(cond, bar) do { unsigned _sp = 0; while (cond) { __builtin_amdgcn_s_sleep(1); \
    if ((++_sp & 255u) == 0u) { if (xb_ld(&(bar)[XB_TMO])) break; if (_sp > XB_SPIN_CAP) { atomicAdd(&(bar)[XB_TMO], 1u); break; } } } } while (0)
struct XcdBarrier { unsigned* bar; unsigned x; volatile LAS unsigned* st; int w; };
__device__ __forceinline__ bool xb_thread0(int w) { return opaque_tid(w) == 0; }
__device__ __forceinline__ XcdBarrier xcd_barrier_post(unsigned* bar, volatile LAS unsigned* st, int w) {
    XcdBarrier b; b.bar = bar; b.x = xb_xcc_id(); b.st = st; b.w = w;
    if (xb_thread0(w)) (void)xb_add(&bar[XB_XCNT(b.x)], 1u);
    return b;
}
__device__ __forceinline__ void xcd_barrier_complete(unsigned* bar, unsigned x, unsigned& nloc, unsigned& nx) {
    const unsigned G = gridDim.x * gridDim.y * gridDim.z;
    unsigned sum, cnt, mine, sp = 0u;
    for (;;) {
        sum = 0u; cnt = 0u; mine = 0u;
#pragma unroll
        for (unsigned j = 0; j < 16; ++j) { const unsigned c = xb_ld(&bar[XB_XCNT(j)]); sum += c; cnt += (c > 0u) ? 1u : 0u; mine = (j == x) ? c : mine; }
        if (sum == G) break;
        __builtin_amdgcn_s_sleep(1);
        if ((++sp & 255u) == 0u) { if (xb_ld(&bar[XB_TMO])) break; if (sp > XB_SPIN_CAP) { atomicAdd(&bar[XB_TMO], 1u); break; } }
    }
    nloc = mine > 0u ? mine : 1u; nx = cnt > 0u ? cnt : 1u;
}
__device__ __forceinline__ void xcd_barrier(const XcdBarrier& b) {
    asm volatile("s_waitcnt vmcnt(0)" ::: "memory");
    __syncthreads();
    if (xb_thread0(b.w)) {
        unsigned* bar = b.bar;
        __builtin_amdgcn_s_waitcnt(0);
        unsigned nloc = b.st[0], nx = b.st[1];
        if (nloc == 0u) { xcd_barrier_complete(bar, b.x, nloc, nx); b.st[0] = nloc; b.st[1] = nx; }
        const unsigned old = xb_add(&bar[XB_XSUB(b.x)], 1u);
        const unsigned gen = old / nloc;
        if (old + 1u == (gen + 1u) * nloc) {
            __builtin_amdgcn_fence(__ATOMIC_RELEASE, "agent");
            asm volatile("s_waitcnt vmcnt(0)" ::: "memory");
            const unsigned og = xb_add(&bar[XB_TOP], 1u);
            const unsigned tg = og / nx;
            if (og + 1u == (tg + 1u) * nx) xb_add(&bar[XB_TOPGEN], 1u);
            else XB_SPIN(xb_ld(&bar[XB_TOPGEN]) == tg, bar);
            __builtin_amdgcn_fence(__ATOMIC_ACQUIRE, "agent");
            xb_add(&bar[XB_XGEN(b.x)], 1u);
            asm volatile("s_waitcnt vmcnt(0)" ::: "memory");
        } else {
            XB_SPIN(xb_ld(&bar[XB_XGEN(b.x)]) == gen, bar);
            __builtin_amdgcn_fence(__ATOMIC_ACQUIRE, "agent");
            asm volatile("s_waitcnt vmcnt(0)" ::: "memory");
        }
    }
    __syncthreads();
}

namespace pg8 {
constexpr int BM = 256, BK = 64, HALF = 128, HTB = HALF * BK * 2, STAGE_BYTES = 8 * HTB, NXCD = 8, WGM = 8;
constexpr int GK = 1024;
__device__ __forceinline__ int lds_byte(int r, int c) { const int st = (r >> 4) * 2 + (c >> 5), rr = r & 15, cc = c & 31, ob = rr * 64 + cc * 2; return st * 1024 + (ob ^ (((ob >> 9) & 1) << 5)); }
__device__ __forceinline__ void stage_rc(int b, int& R, int& C) { const int st = b / 1024, sb = b % 1024, swz = sb ^ (((sb >> 9) & 1) << 5); R = (st >> 1) * 16 + swz / 64; C = (st & 1) * 32 + (swz % 64) / 2; }
__device__ __forceinline__ int perm32(int rho) { const int n = rho >> 4, i = rho & 15; return 8 * (i >> 2) + 4 * n + (i & 3); }
struct Unit { int pm, pn, e; };

template <bool IDG> struct DenseSchedT {
    const char* A; const char* Bt; int nM, nN, nwg, G, c, kb;
    __device__ __forceinline__ void init(const void* A_, const void* Bt_, int M, int N, int G_, int c_, int kb_ = GK * 2) { A = (const char*)A_; Bt = (const char*)Bt_; nM = M / BM; nN = N / BM; nwg = nM * nN; G = G_; c = c_; kb = kb_; }
    __device__ __forceinline__ bool next(int i, Unit& u) const {
        const long L = (long)i * G + c; if (L >= nwg) return false;
        int wgid = (int)L; { const int q = nwg / NXCD, r = nwg % NXCD, xcd = wgid % NXCD, off = wgid / NXCD; wgid = (xcd < r ? xcd * (q + 1) : r * (q + 1) + (xcd - r) * q) + off; }
        const int nig = WGM * nN, gid = wgid / nig, fm = gid * WGM, gsz = (nM - fm) < WGM ? (nM - fm) : WGM;
        u.pm = fm + ((wgid % nig) % gsz); u.pn = (wgid % nig) / gsz; u.e = 0; return true;
    }
    __device__ __forceinline__ const char* a_ptr(const Unit& u) const { return IDG ? A : A + (size_t)u.pm * (size_t)(BM * kb); }
    __device__ __forceinline__ const char* b_ptr(const Unit& u) const { return Bt + (size_t)u.pn * (size_t)(BM * kb); }
    __device__ __forceinline__ void a_offs(const Unit& u, const int (&R)[2], const int (&C)[2], unsigned (&voff)[2][2]) const {
#pragma unroll
        for (int h = 0; h < 2; ++h)
#pragma unroll
            for (int i = 0; i < 2; ++i) voff[h][i] = (unsigned)(u.pm * BM + h * HALF + R[i]) * (unsigned)kb + (unsigned)C[i] * 2u;
    }
    __device__ __forceinline__ void a_raw(const Unit&, const int (&)[2], int (&)[2][2]) const {}
    __device__ __forceinline__ void a_fin(const Unit& u, const int (&R)[2], const int (&C)[2], const int (&)[2][2], unsigned (&voff)[2][2]) const { a_offs(u, R, C, voff); }
};
typedef DenseSchedT<false> DenseSched;
struct MoeSched {
    const char* A; const char* Bt; size_t b_estride; const int* rowtok; const volatile LAS int* cumblk; const volatile LAS int* cnt; int ncol_log2, G, c, kb; const volatile LAS int* ulist;
    __device__ __forceinline__ bool next(int i, Unit& u) const {
        const int v = ulist[i & 63]; if (v < 0) return false;
        u.pm = v >> 8; u.e = (v >> 3) & 31; u.pn = v & 7; return true;
    }
    __device__ __forceinline__ void build_list(volatile LAS int* dst, int tid) const {
        if (tid < 64) { Unit u; dst[tid] = search(tid, u) ? ((u.pm << 8) | (u.e << 3) | u.pn) : -1; }
    }
    __device__ __forceinline__ bool search(int i, Unit& u) const {
        int gb, pn; const int ncol = 1 << ncol_log2;
        if (G == 256 && MK_MOEMAP == 0) { const int xcd = c & 7, j = c >> 3, rpb = 256 >> ncol_log2; gb = i * rpb + xcd + 8 * (j >> ncol_log2); pn = j & (ncol - 1); }
        else { const long L = (long)i * G + c; gb = (int)(L >> ncol_log2); pn = (int)(L & (ncol - 1)); }
        const int tot = cumblk[NE]; if (gb >= tot) return false;
        int e = 0;
#pragma unroll 1
        for (int s = 16; s >= 1; s >>= 1) { if (cumblk[e + s] <= gb) e += s; }
        u.pm = gb; u.pn = pn; u.e = e; return true;
    }
    __device__ __forceinline__ const char* a_ptr(const Unit&) const { return A; }
    __device__ __forceinline__ const char* b_ptr(const Unit& u) const { return Bt + (size_t)u.e * b_estride + (size_t)u.pn * (size_t)(BM * kb); }
    __device__ __forceinline__ void a_raw(const Unit& u, const int (&R)[2], int (&raw)[2][2]) const {
        if (!rowtok) return;
        const int rb = u.pm - cumblk[u.e]; const int* rt = rowtok + (size_t)u.e * MT;
#pragma unroll
        for (int h = 0; h < 2; ++h)
#pragma unroll
            for (int i = 0; i < 2; ++i) { const int* ptr = rt + (rb * 256 + h * HALF + R[i]);
                asm volatile("global_load_dword %0, %1, off" : "=v"(raw[h][i]) : "v"(ptr) : "memory"); }
    }
    __device__ __forceinline__ void a_fin(const Unit& u, const int (&R)[2], const int (&C)[2], const int (&raw_)[2][2], unsigned (&voff)[2][2]) const {
        int raw[2][2] = {{raw_[0][0], raw_[0][1]}, {raw_[1][0], raw_[1][1]}};
        asm volatile("" : "+v"(raw[0][0]), "+v"(raw[0][1]), "+v"(raw[1][0]), "+v"(raw[1][1]));
        const int rb = u.pm - cumblk[u.e], n = cnt[u.e];
#pragma unroll
        for (int h = 0; h < 2; ++h)
#pragma unroll
            for (int i = 0; i < 2; ++i) { const int rank = rb * 256 + h * HALF + R[i]; const int tok = rowtok ? (rank < n ? raw[h][i] : 0) : u.pm * BM + h * HALF + R[i];
                voff[h][i] = (unsigned)tok * (unsigned)kb + (unsigned)C[i] * 2u; }
    }
    __device__ __forceinline__ void a_offs(const Unit& u, const int (&R)[2], const int (&C)[2], unsigned (&voff)[2][2]) const { int raw[2][2] = {{0, 0}, {0, 0}}; a_raw(u, R, raw); asm volatile("s_waitcnt vmcnt(0)" : "+v"(raw[0][0]), "+v"(raw[0][1]), "+v"(raw[1][0]), "+v"(raw[1][1]) :: "memory"); a_fin(u, R, C, raw, voff); }
};

typedef int v8i __attribute__((ext_vector_type(8)));
__device__ __forceinline__ v8i cat8(bf16x8 lo, bf16x8 hi) { const v4u a = __builtin_bit_cast(v4u, lo), b = __builtin_bit_cast(v4u, hi); return (v8i){(int)a.x, (int)a.y, (int)a.z, (int)a.w, (int)b.x, (int)b.y, (int)b.z, (int)b.w}; }
template <class Epi, class Sched, bool GATHER, bool FP8 = false, int XG = 0>
__device__ __forceinline__ void gemm_phase(LAS unsigned char* lds, const Sched& S, const Epi& E, int wave_id, bool skip_epi = false, unsigned stagger_ticks = 0u) {
    if (stagger_ticks && ((blockIdx.x >> 3) & 1u)) { const unsigned long long t0 = __builtin_amdgcn_s_memrealtime(); while (__builtin_amdgcn_s_memrealtime() - t0 < (unsigned long long)stagger_ticks) __builtin_amdgcn_s_sleep(8); }
    const int tid = opaque_tid(wave_id), wid = __builtin_amdgcn_readfirstlane(tid >> 6), lane = tid & 63, wr = wid >> 2, wc = wid & 3, fr = lane & 15, fq = lane >> 4;
    constexpr int KB = FP8 ? GK : GK * 2, nt = KB / (BK * 2);
    unsigned voffA[2][2], voffB[2]; int Rr[2], Cc[2];
#pragma unroll
    for (int i = 0; i < 2; ++i) { int R, C; stage_rc(tid * 16 + i * 8192, R, C); Rr[i] = R; Cc[i] = C; const int Rb = Epi::PERM ? ((R & ~31) + perm32(R & 31)) : R;
        voffA[0][i] = (unsigned)(R * KB + C * 2); voffA[1][i] = (unsigned)((R + HALF) * KB + C * 2); voffB[i] = (unsigned)(Rb * KB + C * 2); }
    constexpr size_t kstep = (size_t)(BK * 2);
    constexpr size_t hstep = (size_t)HALF * KB;
    const unsigned ldsw = (unsigned)wid * 1024u;
    const int aoff = lds_byte(wr * 64 + fr, fq * 8), boff = lds_byte(wc * 32 + fr, fq * 8);
    LAS unsigned char* abase = lds + aoff; LAS unsigned char* bbase = lds + 4 * HTB + boff; asm volatile("" : "+v"(abase), "+v"(bbase));
#define PG8_SA(b, h) (((b) * 2 + (h)) * HTB)
#define PG8_SB(b, h) ((4 + (b) * 2 + (h)) * HTB)
#define PG8_STAGE(bufoff, gbase, voff) do { if (XG == 3) break; _Pragma("unroll") for (int _i = 0; _i < 2; ++_i) \
        __builtin_amdgcn_global_load_lds((const unsigned*)((const char*)(gbase) + (voff)[_i]), (LAS unsigned*)(lds + (bufoff) + ldsw + _i * 8192), 16, 0, 0); } while (0)
#define PG8_STAGE_A(bufoff, gbase, h) PG8_STAGE(bufoff, gbase, voffA[h])
#define PG8_RDA(off) (*(const LAS v4u*)(abase + (off)))
#define PG8_RDB(off) (*(const LAS v4u*)(bbase + (off)))
#define PG8_LDA(dst, b, h) do { if (XG == 2) break; _Pragma("unroll") for (int m = 0; m < 4; ++m) { const v4u _l = PG8_RDA(PG8_SA(b, h) + m * 2048), _h = PG8_RDA(PG8_SA(b, h) + m * 2048 + 1024); \
        if constexpr (FP8) dst##8[m] = (v8i){(int)_l.x, (int)_l.y, (int)_l.z, (int)_l.w, (int)_h.x, (int)_h.y, (int)_h.z, (int)_h.w}; \
        else { dst[m][0] = __builtin_bit_cast(bf16x8, _l); dst[m][1] = __builtin_bit_cast(bf16x8, _h); } } } while (0)
#define PG8_LDB(dst, b, h) do { if (XG == 2) break; _Pragma("unroll") for (int n = 0; n < 2; ++n) { const v4u _l = PG8_RDB(PG8_SA(b, h) + n * 2048), _h = PG8_RDB(PG8_SA(b, h) + n * 2048 + 1024); \
        if constexpr (FP8) dst##8[n] = (v8i){(int)_l.x, (int)_l.y, (int)_l.z, (int)_l.w, (int)_h.x, (int)_h.y, (int)_h.z, (int)_h.w}; \
        else { dst[n][0] = __builtin_bit_cast(bf16x8, _l); dst[n][1] = __builtin_bit_cast(bf16x8, _h); } } } while (0)
#define PG8_MMA(ai, bj, At, Bt) do { if (XG == 1) break; __builtin_amdgcn_s_setprio(1); _Pragma("unroll") for (int m = 0; m < 4; ++m) _Pragma("unroll") for (int n = 0; n < 2; ++n) { \
        if constexpr (FP8) acc[ai][bj][m][n] = __builtin_amdgcn_mfma_scale_f32_16x16x128_f8f6f4(Bt##8[n], At##8[m], acc[ai][bj][m][n], 0, 0, 0, 0x7A7A7A7A, 0, 0x7F7F7F7F); \
        else { _Pragma("unroll") for (int k = 0; k < 2; ++k) acc[ai][bj][m][n] = __builtin_amdgcn_mfma_f32_16x16x32_bf16(Bt[n][k], At[m][k], acc[ai][bj][m][n], 0, 0, 0); } } \
        __builtin_amdgcn_s_setprio(0); } while (0)
#define PG8_WAIT_V(n) asm volatile("s_waitcnt vmcnt(" #n ")" ::: "memory")
#define PG8_WAIT_L(n) asm volatile("s_waitcnt lgkmcnt(" #n ")" ::: "memory")
#define PG8_BAR __builtin_amdgcn_s_barrier()
#define PG8_SCHED __builtin_amdgcn_sched_barrier(0)
    Unit cur, nxt; int ui = 0;
    if (!S.next(0, cur)) return;
    f32x4 acc[2][2][4][2];
#pragma unroll
    for (int a = 0; a < 2; ++a)
#pragma unroll
        for (int b = 0; b < 2; ++b)
#pragma unroll
            for (int m = 0; m < 4; ++m)
#pragma unroll
                for (int n = 0; n < 2; ++n) acc[a][b][m][n] = (f32x4){0.f, 0.f, 0.f, 0.f};
    bf16x8 At[4][2], B0[2][2], B1[2][2]; v8i At8[4], B08[2], B18[2];
    if constexpr (XG == 2) { _Pragma("unroll") for (int m = 0; m < 4; ++m) { asm volatile("" : "=v"(At8[m])); } _Pragma("unroll") for (int n = 0; n < 2; ++n) { asm volatile("" : "=v"(B08[n])); asm volatile("" : "=v"(B18[n])); } }
    const char* cA = S.a_ptr(cur); const char* cB = S.b_ptr(cur);
    if constexpr (GATHER) S.a_offs(cur, Rr, Cc, voffA);
    PG8_STAGE(PG8_SB(0, 0), cB, voffB); PG8_STAGE(PG8_SB(0, 1), cB + hstep, voffB); PG8_STAGE_A(PG8_SA(0, 0), cA, 0); PG8_STAGE_A(PG8_SA(0, 1), cA, 1);
    if (wr == 1) PG8_BAR;
    PG8_WAIT_V(2); PG8_BAR;
    PG8_STAGE(PG8_SB(1, 0), cB + kstep, voffB); PG8_STAGE_A(PG8_SA(1, 0), cA + kstep, 0); PG8_STAGE(PG8_SB(1, 1), cB + hstep + kstep, voffB);
    PG8_WAIT_V(6); PG8_BAR;
    for (;;) {
        const bool has_next = S.next(ui + 1, nxt);
        const char* nA = has_next ? S.a_ptr(nxt) : cA; const char* nB = has_next ? S.b_ptr(nxt) : cB;
        int rawN[2][2] = {{0, 0}, {0, 0}};
        if constexpr (GATHER) { if (has_next) S.a_raw(nxt, Rr, rawN); }
#pragma unroll 1
        for (int t = 0; t < nt; t += 2) {
            const bool last = (t == nt - 2);
            if constexpr (Epi::LDSBIAS) { if (last && wid == 0) E.stage_bias(cur, lane); }
            const char* a1 = cA + (size_t)(t + 1) * kstep;
            const char* a2 = last ? nA : cA + (size_t)(t + 2) * kstep; const char* b2 = last ? nB : cB + (size_t)(t + 2) * kstep;
            const char* a3 = a2 + kstep; const char* b3 = b2 + kstep;
            PG8_LDB(B0, 0, 0); PG8_LDB(B1, 0, 1); PG8_SCHED; PG8_LDA(At, 0, 0); PG8_STAGE_A(PG8_SA(1, 1), a1, 1);
            if constexpr (GATHER) { if (last && has_next) S.a_fin(nxt, Rr, Cc, rawN, voffA); }
            PG8_WAIT_V(8); PG8_WAIT_L(0); PG8_BAR; PG8_MMA(0, 0, At, B0); PG8_MMA(0, 1, At, B1); PG8_BAR; PG8_SCHED;
            PG8_LDA(At, 0, 1); PG8_STAGE(PG8_SB(0, 0), b2, voffB); PG8_STAGE(PG8_SB(0, 1), b2 + hstep, voffB); PG8_STAGE_A(PG8_SA(0, 0), a2, 0);
            PG8_WAIT_V(8); PG8_WAIT_L(0); PG8_BAR; PG8_MMA(1, 0, At, B0); PG8_MMA(1, 1, At, B1); PG8_BAR; PG8_SCHED;
            PG8_LDB(B0, 1, 0); PG8_LDB(B1, 1, 1); PG8_SCHED; PG8_LDA(At, 1, 0); PG8_STAGE_A(PG8_SA(0, 1), a2, 1);
            PG8_WAIT_V(8); PG8_WAIT_L(0); PG8_BAR; PG8_MMA(0, 0, At, B0); PG8_MMA(0, 1, At, B1); PG8_BAR; PG8_SCHED;
            PG8_LDA(At, 1, 1); PG8_STAGE(PG8_SB(1, 0), b3, voffB); PG8_STAGE(PG8_SB(1, 1), b3 + hstep, voffB); PG8_STAGE_A(PG8_SA(1, 0), a3, 0);
            PG8_WAIT_V(8); PG8_WAIT_L(0); PG8_BAR; PG8_MMA(1, 0, At, B0); PG8_MMA(1, 1, At, B1); PG8_BAR; PG8_SCHED;
        }
        if (wr == 0) PG8_BAR;
        if (!skip_epi) E(acc, cur, wr, wc, fr, fq);
        if (!has_next) break;
#pragma unroll
        for (int a = 0; a < 2; ++a)
#pragma unroll
            for (int b = 0; b < 2; ++b)
#pragma unroll
                for (int m = 0; m < 4; ++m)
#pragma unroll
                    for (int n = 0; n < 2; ++n) acc[a][b][m][n] = (f32x4){0.f, 0.f, 0.f, 0.f};
        cur = nxt; cA = nA; cB = nB; ++ui;
        if (wr == 1) PG8_BAR;
    }
    PG8_WAIT_V(0);
    PG8_BAR;
#undef PG8_SA
#undef PG8_SB
#undef PG8_STAGE
#undef PG8_STAGE_A
#undef PG8_LDA
#undef PG8_RDA
#undef PG8_RDB
#undef PG8_LDB
#undef PG8_MMA
#undef PG8_WAIT_V
#undef PG8_WAIT_L
#undef PG8_BAR
#undef PG8_SCHED
}
}
namespace pg8 {
__device__ __forceinline__ f32x2 gelu_pk(f32x2 v) {
    const f32x2 av = __builtin_elementwise_abs(v), d = av * 0.2316418882f + 1.0f;
    f32x2 t; t.x = __builtin_amdgcn_rcpf(d.x); t.y = __builtin_amdgcn_rcpf(d.y);
    f32x2 q = t * 0.5307027145f + (-0.7265760135f); q = q * t + 0.7107068705f; q = q * t + (-0.142248368f); q = q * t + 0.127414796f; q = q * t;
    const f32x2 s = (v * v) * (-0.72134752044f);
    f32x2 e; e.x = __builtin_amdgcn_exp2f(s.x); e.y = __builtin_amdgcn_exp2f(s.y);
    const f32x2 m = v * (q * e), r = v - m;
    f32x2 o; o.x = v.x < 0.f ? m.x : r.x; o.y = v.y < 0.f ? m.y : r.y; return o;
}
struct EpiBf16 {
    static constexpr bool PERM = true, LDSBIAS = false;
    bf16* O; int ldc; float* ss; int ACT;
    __device__ __forceinline__ void operator()(const f32x4 (&acc)[2][2][4][2], const Unit& u, int wr, int wc, int fr, int fq) const {
        const int row0 = u.pm * BM + wr * 64 + fr, col0 = u.pn * BM + wc * 32 + 8 * fq;
#pragma unroll
        for (int ai = 0; ai < 2; ++ai)
#pragma unroll
            for (int m = 0; m < 4; ++m) { const int row = row0 + ai * HALF + m * 16; bf16* rowp = O + (size_t)row * ldc + col0; float sq = 0.f;
#pragma unroll
                for (int bj = 0; bj < 2; ++bj) { f32x4 v0 = acc[ai][bj][m][0], v1 = acc[ai][bj][m][1];
                    if (ACT == 1) { f32x2 a = gelu_pk((f32x2){v0[0], v0[1]}), b = gelu_pk((f32x2){v0[2], v0[3]}), c = gelu_pk((f32x2){v1[0], v1[1]}), d = gelu_pk((f32x2){v1[2], v1[3]});
                        v0 = (f32x4){a.x, a.y, b.x, b.y}; v1 = (f32x4){c.x, c.y, d.x, d.y};
                        sq += (v0[0] * v0[0] + v0[1] * v0[1]) + (v0[2] * v0[2] + v0[3] * v0[3]) + (v1[0] * v1[0] + v1[1] * v1[1]) + (v1[2] * v1[2] + v1[3] * v1[3]); }
                    v4u w; w.x = cvt_pk_bf16(v0[0], v0[1]); w.y = cvt_pk_bf16(v0[2], v0[3]); w.z = cvt_pk_bf16(v1[0], v1[1]); w.w = cvt_pk_bf16(v1[2], v1[3]);
                    *(v4u*)(rowp + bj * HALF) = w; }
                if (ACT == 1) { const int ln = (fq << 4) | fr; sq += shx(sq, 16, ln); sq += shx(sq, 32, ln);
                    if (u.pn >= 4 && fq == 0) ss[(size_t)row * 16 + (u.pn - 4) * 4 + wc] = sq; }
            }
    }
};
struct EpiResid {
    static constexpr bool PERM = false, LDSBIAS = false;
    bf16* xb; const float* modl;
    __device__ __forceinline__ void operator()(const f32x4 (&acc)[2][2][4][2], const Unit& u, int wr, int wc, int fr, int fq) const {
        const bool lat = u.pm < ML / BM; const int bidx = lat ? (u.pm >> 5) : 8;
        bf16* base = xb + (size_t)u.pm * BM * D;
        const float* g = modl + bidx * 6144 + 2 * 1024;
        const int r0 = wr * 64 + fr, col0 = u.pn * BM + wc * 32 + 4 * fq;
        f32x4 gv[2][2];
#pragma unroll
        for (int bj = 0; bj < 2; ++bj)
#pragma unroll
            for (int n = 0; n < 2; ++n) gv[bj][n] = *(const f32x4*)(g + col0 + bj * HALF + n * 16);
        const int odd = fq & 1, colp = col0 - 4 * odd;
#pragma unroll
        for (int ai = 0; ai < 2; ++ai) { v4u bs[2][2][2];
#pragma unroll
            for (int mp = 0; mp < 2; ++mp) { const size_t off = (size_t)(r0 + ai * HALF + (2 * mp + odd) * 16) * D + colp;
#pragma unroll
                for (int bj = 0; bj < 2; ++bj)
#pragma unroll
                    for (int n = 0; n < 2; ++n) bs[mp][bj][n] = *(const v4u*)(base + off + bj * HALF + n * 16); }
#pragma unroll
            for (int mp = 0; mp < 2; ++mp) { const size_t off = (size_t)(r0 + ai * HALF + (2 * mp + odd) * 16) * D + colp;
#pragma unroll
                for (int bj = 0; bj < 2; ++bj)
#pragma unroll
                    for (int n = 0; n < 2; ++n) { const v4u L = bs[mp][bj][n];
                        const auto s0 = __builtin_amdgcn_permlane16_swap(L.x, L.z, false, false), s1 = __builtin_amdgcn_permlane16_swap(L.y, L.w, false, false);
                        const f32x4 va = bf4_f32((v2u){s0[0], s1[0]}) + gv[bj][n] * acc[ai][bj][2 * mp][n], vb = bf4_f32((v2u){s0[1], s1[1]}) + gv[bj][n] * acc[ai][bj][2 * mp + 1][n];
                        const auto t0 = __builtin_amdgcn_permlane16_swap(cvt_pk_bf16(va.x, va.y), cvt_pk_bf16(vb.x, vb.y), false, false), t1 = __builtin_amdgcn_permlane16_swap(cvt_pk_bf16(va.z, va.w), cvt_pk_bf16(vb.z, vb.w), false, false);
                        *(v4u*)(base + off + bj * HALF + n * 16) = (v4u){t0[0], t1[0], t0[1], t1[1]}; } }
            asm volatile("" ::: "memory"); }
    }
};
struct EpiSwiglu {
    static constexpr bool PERM = true, LDSBIAS = true;
    unsigned char* O; const float* b1; LAS float* bl;
    __device__ __forceinline__ void stage_bias(const Unit& u, int lane) const { const float* src = b1 + (size_t)u.e * 2048 + (lane < 32 ? u.pn * HALF + 4 * lane : 1024 + u.pn * HALF + 4 * (lane - 32));
        __builtin_amdgcn_global_load_lds((const unsigned*)src, (LAS unsigned*)bl, 16, 0, 0); }
    __device__ __forceinline__ void operator()(const f32x4 (&acc)[2][2][4][2], const Unit& u, int wr, int wc, int fr, int fq) const {
        const int row0 = u.pm * BM + wr * 64 + fr, cl = wc * 32 + 8 * fq, c0 = u.pn * HALF + cl;
        f32x4 bg[2], bli[2];
#pragma unroll
        for (int n = 0; n < 2; ++n) { bg[n] = *(const LAS f32x4*)(bl + cl + 4 * n); bli[n] = *(const LAS f32x4*)(bl + 128 + cl + 4 * n) + 1.0f; }
#pragma unroll
        for (int ai = 0; ai < 2; ++ai)
#pragma unroll
            for (int mp = 0; mp < 4; mp += 2) { v2u wv[2];
#pragma unroll
              for (int mm = 0; mm < 2; ++mm) { const int m = mp + mm; float o[8];
#pragma unroll
                for (int n = 0; n < 2; ++n)
#pragma unroll
                    for (int j = 0; j < 4; ++j) { const float gl = fminf(acc[ai][0][m][n][j] + bg[n][j], 7.0f), lp = __builtin_amdgcn_fmed3f(acc[ai][1][m][n][j] + bli[n][j], -6.0f, 8.0f);
                        const float sg = __builtin_amdgcn_rcpf(1.0f + __builtin_amdgcn_exp2f(gl * (-1.702f * 1.4426950408889634f)));
                        o[n * 4 + j] = gl * sg * lp; }
                v2u w; w.x = 0; w.y = 0;
                w.x = __builtin_amdgcn_cvt_pk_fp8_f32(o[0], o[1], w.x, false); w.x = __builtin_amdgcn_cvt_pk_fp8_f32(o[2], o[3], w.x, true);
                w.y = __builtin_amdgcn_cvt_pk_fp8_f32(o[4], o[5], w.y, false); w.y = __builtin_amdgcn_cvt_pk_fp8_f32(o[6], o[7], w.y, true);
                wv[mm] = w; }
              const auto sx = __builtin_amdgcn_permlane16_swap(wv[0].x, wv[1].x, false, false), sy = __builtin_amdgcn_permlane16_swap(wv[0].y, wv[1].y, false, false);
              *(v4u*)(O + (size_t)(row0 + ai * HALF + (mp + (fq & 1)) * 16) * D + (c0 - 8 * (fq & 1))) = (v4u){sx[0], sy[0], sx[1], sy[1]}; }
    }
};
struct EpiBias {
    static constexpr bool PERM = true, LDSBIAS = true;
    unsigned char* O; const float* b2; LAS float* bl;
    __device__ __forceinline__ void stage_bias(const Unit& u, int lane) const { __builtin_amdgcn_global_load_lds((const unsigned*)(b2 + (size_t)u.e * 1024 + u.pn * BM + 4 * lane), (LAS unsigned*)bl, 16, 0, 0); }
    __device__ __forceinline__ void operator()(const f32x4 (&acc)[2][2][4][2], const Unit& u, int wr, int wc, int fr, int fq) const {
        const int row0 = u.pm * BM + wr * 64 + fr, cl = wc * 32 + 8 * fq, col0 = u.pn * BM + cl;
#pragma unroll
        for (int bj = 0; bj < 2; ++bj) { const f32x4 bv0 = *(const LAS f32x4*)(bl + cl + bj * HALF), bv1 = *(const LAS f32x4*)(bl + cl + bj * HALF + 4);
#pragma unroll
            for (int ai = 0; ai < 2; ++ai)
#pragma unroll
                for (int mp = 0; mp < 4; mp += 2) { v2u wv[2];
#pragma unroll
                    for (int mm = 0; mm < 2; ++mm) { const int m = mp + mm; const f32x4 v0 = acc[ai][bj][m][0] + bv0, v1 = acc[ai][bj][m][1] + bv1;
                        v2u w; w.x = 0; w.y = 0;
                        w.x = __builtin_amdgcn_cvt_pk_fp8_f32(v0[0], v0[1], w.x, false); w.x = __builtin_amdgcn_cvt_pk_fp8_f32(v0[2], v0[3], w.x, true);
                        w.y = __builtin_amdgcn_cvt_pk_fp8_f32(v1[0], v1[1], w.y, false); w.y = __builtin_amdgcn_cvt_pk_fp8_f32(v1[2], v1[3], w.y, true);
                        wv[mm] = w; }
                    const auto sx = __builtin_amdgcn_permlane16_swap(wv[0].x, wv[1].x, false, false), sy = __builtin_amdgcn_permlane16_swap(wv[0].y, wv[1].y, false, false);
                    *(v4u*)(O + (size_t)(row0 + ai * HALF + (mp + (fq & 1)) * 16) * D + (col0 - 8 * (fq & 1)) + bj * HALF) = (v4u){sx[0], sy[0], sx[1], sy[1]}; }
            asm volatile("" ::: "memory"); }
    }
};
}

namespace att {
constexpr int AD = 128, NW = 8, QBLK = 32, KVBLK = 64;
constexpr float SCALE = 0.088388347648318440f;
constexpr int LDO = 1024;
constexpr int SHM_V = AD * KVBLK, SHM_K = KVBLK * AD, SHM_ATTN = 4 * SHM_V + 4 * SHM_K;
typedef int v8i __attribute__((ext_vector_type(8)));
#define K8SW(key, c) ((key) * 128 + ((((c) ^ (((key) >> 1) & 7))) << 4))
#define V8SW(d, c) ((d) * 64 + ((((c) ^ (((d) >> 2) & 3))) << 4))
#define SBAR() __builtin_amdgcn_sched_barrier(0)
__device__ __forceinline__ int crow(int r, int hi) { return (r & 3) + 8 * (r >> 2) + 4 * hi; }
template <int XV = 0>
__device__ __forceinline__ int exp4(float a0, float a1, float a2, float a3) {
  float t0 = fminf(a0 + 8.0f, 8.0f), t1 = fminf(a1 + 8.0f, 8.0f), t2 = fminf(a2 + 8.0f, 8.0f), t3 = fminf(a3 + 8.0f, 8.0f); int w;
  asm volatile("v_exp_f32 %1, %1\n\tv_exp_f32 %2, %2\n\tv_exp_f32 %3, %3\n\tv_exp_f32 %4, %4\n\t"
               "v_cvt_pk_fp8_f32 %0, %1, %2\n\ts_nop 0\n\tv_cvt_pk_fp8_f32 %0, %3, %4 op_sel:[0,0,1]"
               : "=&v"(w), "+v"(t0), "+v"(t1), "+v"(t2), "+v"(t3));
  return w;
}
template <int PAD>
__device__ __forceinline__ int expc4(float a0, float a1, float a2, float a3) {
  int w; float t0, t1, t2, t3;
  if constexpr (PAD != 0)
    asm volatile("s_nop 5\n\tv_exp_f32_e64 %1, %5 clamp\n\tv_exp_f32_e64 %2, %6 clamp\n\tv_exp_f32_e64 %3, %7 clamp\n\tv_exp_f32_e64 %4, %8 clamp\n\t"
                 "v_cvt_scalef32_pk_fp8_f32 %0, %1, %2, %9\n\ts_nop 0\n\tv_cvt_scalef32_pk_fp8_f32 %0, %3, %4, %9 op_sel:[0,0,0,1]"
                 : "=&v"(w), "=&v"(t0), "=&v"(t1), "=&v"(t2), "=&v"(t3) : "v"(a0), "v"(a1), "v"(a2), "v"(a3), "s"(0x3B800000));
  else
    asm volatile("v_exp_f32_e64 %1, %5 clamp\n\tv_exp_f32_e64 %2, %6 clamp\n\tv_exp_f32_e64 %3, %7 clamp\n\tv_exp_f32_e64 %4, %8 clamp\n\t"
                 "v_cvt_scalef32_pk_fp8_f32 %0, %1, %2, %9\n\ts_nop 0\n\tv_cvt_scalef32_pk_fp8_f32 %0, %3, %4, %9 op_sel:[0,0,0,1]"
                 : "=&v"(w), "=&v"(t0), "=&v"(t1), "=&v"(t2), "=&v"(t3) : "v"(a0), "v"(a1), "v"(a2), "v"(a3), "s"(0x3B800000));
  return w;
}
#define EXC4(P, m, PAD) expc4<PAD>(P[4 * (m)], P[4 * (m) + 1], P[4 * (m) + 2], P[4 * (m) + 3])
typedef int v4i __attribute__((ext_vector_type(4)));
__device__ __forceinline__ void partialSM(const f32x16& p0, float nb, v4i& plo) {
#pragma unroll
  for (int m = 0; m < 4; ++m) plo[m] = exp4(p0[4 * m], p0[4 * m + 1], p0[4 * m + 2], p0[4 * m + 3]);
}
__device__ __forceinline__ void finishSM(const f32x16& p1, float nb, const v4i& plo, v8i& pa) {
  v4i phi;
#pragma unroll
  for (int m = 0; m < 4; ++m) phi[m] = exp4(p1[4 * m], p1[4 * m + 1], p1[4 * m + 2], p1[4 * m + 3]);
  pa = (v8i){plo[0], plo[1], plo[2], plo[3], phi[0], phi[1], phi[2], phi[3]};
}
__device__ __forceinline__ void qkt(f32x16& p0, f32x16& p1, const char* Ks, const v8i* q8, int r32, int hi, const f32x16& NBV) {
  p0 = NBV; p1 = NBV;
#pragma unroll
  for (int s = 0; s < 2; ++s) { const int c0 = 4 * s + 2 * hi;
    const v4u a0 = *reinterpret_cast<const v4u*>(Ks + K8SW(r32, c0)), a1 = *reinterpret_cast<const v4u*>(Ks + K8SW(r32, c0 + 1));
    const v4u b0 = *reinterpret_cast<const v4u*>(Ks + K8SW(32 + r32, c0)), b1 = *reinterpret_cast<const v4u*>(Ks + K8SW(32 + r32, c0 + 1));
    const v8i A0 = (v8i){(int)a0.x, (int)a0.y, (int)a0.z, (int)a0.w, (int)a1.x, (int)a1.y, (int)a1.z, (int)a1.w};
    const v8i A1 = (v8i){(int)b0.x, (int)b0.y, (int)b0.z, (int)b0.w, (int)b1.x, (int)b1.y, (int)b1.z, (int)b1.w};
    p0 = __builtin_amdgcn_mfma_scale_f32_32x32x64_f8f6f4(A0, q8[s], p0, 0, 0, 0, 0x7F7F7F7F, 0, 0x7C7C7C7C);
    p1 = __builtin_amdgcn_mfma_scale_f32_32x32x64_f8f6f4(A1, q8[s], p1, 0, 0, 0, 0x7F7F7F7F, 0, 0x7C7C7C7C); }
}
__device__ __forceinline__ void pv_d0(f32x16* o, f32x16& lacc, const char* Vs, v8i pa, int r32, int hi) {
  { const int one = 0x38383838; const v8i ONES = (v8i){one, one, one, one, one, one, one, one};
    lacc = __builtin_amdgcn_mfma_scale_f32_32x32x64_f8f6f4(pa, ONES, lacc, 0, 0, 0, 0x7F7F7F7F, 0, 0x7F7F7F7F); }
#pragma unroll
  for (int d0 = 0; d0 < 4; ++d0) { const int d = 32 * d0 + r32;
    const v4u b0 = *reinterpret_cast<const v4u*>(Vs + V8SW(d, 2 * hi)), b1 = *reinterpret_cast<const v4u*>(Vs + V8SW(d, 2 * hi + 1));
    const v8i B = (v8i){(int)b0.x, (int)b0.y, (int)b0.z, (int)b0.w, (int)b1.x, (int)b1.y, (int)b1.z, (int)b1.w};
    o[d0] = __builtin_amdgcn_mfma_scale_f32_32x32x64_f8f6f4(pa, B, o[d0], 0, 0, 0, 0x7F7F7F7F, 0, 0x7F7F7F7F); }
}
__device__ __forceinline__ v8i lds32(const char* p0, const char* p1) { const v4u a = *reinterpret_cast<const v4u*>(p0), b = *reinterpret_cast<const v4u*>(p1);
  return (v8i){(int)a.x, (int)a.y, (int)a.z, (int)a.w, (int)b.x, (int)b.y, (int)b.z, (int)b.w}; }
#define MF8(A, B, C, SB) ((XV == 3 || XV == 4 || XV == 5 || XV == 9) ? (C) : __builtin_amdgcn_mfma_scale_f32_32x32x64_f8f6f4(A, B, C, 0, 0, 0, 0x7F7F7F7F, 0, SB))
#define EX4(P, m) exp4<XV>(P[4 * (m)], P[4 * (m) + 1], P[4 * (m) + 2], P[4 * (m) + 3])
template <int XV = 0>
__device__ __forceinline__ void tile_step(f32x16& pN0, f32x16& pN1, const f32x16& pP1, const v4i& ploP, v4i& ploN, f32x16* o, f32x16& lacc,
                                          const char* Ks, const char* Vs, const v8i* q8, int r32, int hi, const f32x16& Z) {
  const int one = 0x38383838; const v8i ONES = (v8i){one, one, one, one, one, one, one, one};
  v4i phi;
  const v8i A00 = lds32(Ks + K8SW(r32, 2 * hi), Ks + K8SW(r32, 2 * hi + 1)), A10 = lds32(Ks + K8SW(32 + r32, 2 * hi), Ks + K8SW(32 + r32, 2 * hi + 1));
  const v8i A01 = lds32(Ks + K8SW(r32, 4 + 2 * hi), Ks + K8SW(r32, 4 + 2 * hi + 1)), A11 = lds32(Ks + K8SW(32 + r32, 4 + 2 * hi), Ks + K8SW(32 + r32, 4 + 2 * hi + 1));
  phi[0] = EXC4(pP1, 0, 0); SBAR();
  pN0 = MF8(A00, q8[0], Z, 0x7C7C7C7C);   SBAR(); const v8i V0 = lds32(Vs + V8SW(r32, 2 * hi), Vs + V8SW(r32, 2 * hi + 1));           phi[1] = EXC4(pP1, 1, 0); SBAR();
  pN0 = MF8(A01, q8[1], pN0, 0x7C7C7C7C); SBAR(); const v8i V1 = lds32(Vs + V8SW(32 + r32, 2 * hi), Vs + V8SW(32 + r32, 2 * hi + 1)); phi[2] = EXC4(pP1, 2, 0); SBAR();
  pN1 = MF8(A10, q8[0], Z, 0x7C7C7C7C);   SBAR(); const v8i V2 = lds32(Vs + V8SW(64 + r32, 2 * hi), Vs + V8SW(64 + r32, 2 * hi + 1)); phi[3] = EXC4(pP1, 3, 0); SBAR();
  pN1 = MF8(A11, q8[1], pN1, 0x7C7C7C7C); SBAR(); const v8i V3 = lds32(Vs + V8SW(96 + r32, 2 * hi), Vs + V8SW(96 + r32, 2 * hi + 1)); SBAR();
  const v8i pa = (v8i){ploP[0], ploP[1], ploP[2], ploP[3], phi[0], phi[1], phi[2], phi[3]};
  lacc = MF8(pa, ONES, lacc, 0x7F7F7F7F); SBAR(); ploN[0] = EXC4(pN0, 0, 1); SBAR();
  o[0] = MF8(pa, V0, o[0], 0x7F7F7F7F);   SBAR(); ploN[1] = EXC4(pN0, 1, 0); SBAR();
  o[1] = MF8(pa, V1, o[1], 0x7F7F7F7F);   SBAR(); ploN[2] = EXC4(pN0, 2, 0); SBAR();
  o[2] = MF8(pa, V2, o[2], 0x7F7F7F7F);   SBAR(); ploN[3] = EXC4(pN0, 3, 0); SBAR();
  o[3] = MF8(pa, V3, o[3], 0x7F7F7F7F);   SBAR();
}
template <int XV = 0>
__device__ __forceinline__ void attn_dense_body(const unsigned char* __restrict__ Q8, const unsigned char* __restrict__ K8, const unsigned char* __restrict__ VT, int vt_ld, bf16* __restrict__ Ob, int seq, char* lds, int wave_id, float nb) {
  const int tid = opaque_tid(wave_id), wid = tid >> 6, lane = tid & 63, r32 = lane & 31, hi = lane >> 5;
  char* V_lds = lds; char* K_lds = lds + 4 * SHM_V;
  f32x16 lacc = {}; f32x16 o[4] = {}; v8i qr[2]; f32x16 NBV;
#pragma unroll
  for (int i = 0; i < 16; ++i) NBV[i] = nb;
  { const unsigned char* Qw = Q8 + (long)(wid * QBLK + r32) * 1024 + hi * 32;
#pragma unroll
    for (int s2 = 0; s2 < 2; ++s2) { const v4u a = *reinterpret_cast<const v4u*>(Qw + 64 * s2), b = *reinterpret_cast<const v4u*>(Qw + 64 * s2 + 16);
      qr[s2] = (v8i){(int)a.x, (int)a.y, (int)a.z, (int)a.w, (int)b.x, (int)b.y, (int)b.z, (int)b.w}; } }
  struct { v4u vs, ks; } sr_[1];
  const int kkey = tid >> 3, kch = tid & 7; const unsigned koff = (unsigned)(kkey * 256 + kch * 16); const int kst = K8SW(kkey, kch);
  const int vd = tid >> 2, vc = tid & 3; const unsigned voff = (unsigned)(vd * vt_ld + vc * 16); const int vst = V8SW(vd, vc);
#define SLOAD(i, k0) do { if (XV >= 7) break; sr_[i].vs = *reinterpret_cast<const v4u*>((const char*)VT + (size_t)(k0) + voff); \
    sr_[i].ks = *reinterpret_cast<const v4u*>((const char*)K8 + (size_t)(k0) * 256 + koff); } while (0)
#define SWRITE(b, i) do { *(v4u*)(V_lds + (b) * SHM_V + vst) = sr_[i].vs; *(v4u*)(K_lds + (b) * SHM_K + kst) = sr_[i].ks; } while (0)
#define SWAIT() asm volatile("s_waitcnt vmcnt(0)" ::: "memory")
#define TBAR() asm volatile("s_waitcnt lgkmcnt(0)\n\ts_barrier" ::: "memory")
  f32x16 pA0, pA1, pB0, pB1; v8i pa; v4i plA, plB; const int NT = seq / KVBLK;
  SLOAD(0, 0); SWAIT(); SWRITE(0, 0); SLOAD(0, KVBLK); TBAR();
  qkt(pA0, pA1, K_lds, qr, r32, hi, NBV); partialSM(pA0, nb, plA);
  SWAIT(); SWRITE(1, 0); SLOAD(0, 2 * KVBLK); TBAR();
#define STEP_IO(t, SW) do { SWAIT(); SWRITE(SW, 0); { const int tn = (t) + 2 < NT ? (t) + 2 : NT - 1; SLOAD(0, tn * KVBLK); } SBAR(); } while (0)
#define STEP_B(t, SK, SV, SW) do { STEP_IO(t, SW); tile_step<XV>(pB0, pB1, pA1, plA, plB, o, lacc, K_lds + (SK) * SHM_K, V_lds + (SV) * SHM_V, qr, r32, hi, NBV); TBAR(); } while (0)
#define STEP_A(t, SK, SV, SW) do { STEP_IO(t, SW); tile_step<XV>(pA0, pA1, pB1, plB, plA, o, lacc, K_lds + (SK) * SHM_K, V_lds + (SV) * SHM_V, qr, r32, hi, NBV); TBAR(); } while (0)
  int j = 1;
  for (; j + 5 < NT; j += 4) { STEP_B(j, 1, 0, 2); STEP_A(j + 1, 2, 1, 3); STEP_B(j + 2, 3, 2, 0); STEP_A(j + 3, 0, 3, 1); }
  STEP_B(j, 1, 0, 2); STEP_A(j + 1, 2, 1, 3);
  SBAR(); qkt(pB0, pB1, K_lds + 3 * SHM_K, qr, r32, hi, NBV);
  finishSM(pA1, nb, plA, pa); SBAR();
  pv_d0(o, lacc, V_lds + 2 * SHM_V, pa, r32, hi); partialSM(pB0, nb, plB);
  finishSM(pB1, nb, plB, pa); SBAR();
  pv_d0(o, lacc, V_lds + 3 * SHM_V, pa, r32, hi);
  { const int ln2 = opaque_tid(wave_id) & 63, r32e = ln2 & 31, hie = ln2 >> 5;
    bf16* Ow = Ob + (long)(wid * QBLK) * LDO;
#pragma unroll
    for (int r = 0; r < 16; ++r) { const int orow = crow(r, hie); const float rl = __builtin_amdgcn_rcpf(lacc[r]);
      for (int d0 = 0; d0 < 4; ++d0) Ow[(long)orow * LDO + d0 * 32 + r32e] = (bf16)f2bf(o[d0][r] * rl); } }
  __syncthreads();
#undef SLOAD
#undef TBAR
#undef STEP_IO
#undef STEP_A
#undef STEP_B
#undef SWRITE
#undef SWAIT
}
#undef K8SW
#undef V8SW
}
constexpr int NWAVES = 8, NTHREADS = 512;
struct Args { const float* in[36]; float* out; unsigned char* ws; int ph_lo, ph_hi; };
enum InIdx { I_X = 0, I_C, I_CTX, I_CCTX, I_ADAW, I_ADAB, I_N1G, I_N2G, I_WOUT, I_RW, I_RB, I_EW1, I_EB1, I_EW2, I_EB2, I_AWIN, I_AQG, I_AKG,
             I_GWIN, I_GVG, I_GWS, I_GBS, I_HWIN, I_HCW, I_HCB, I_FW1, I_FB1, I_FW2, I_FB2, I_FW3, I_FB3, I_FW4, I_FB4, I_FREQ, I_HD, I_FG };
struct Frame {
    LAS unsigned char* lds; volatile LAS unsigned* MISC; gu32* ctl;
    int tid, lane, wave, G, bx;
    float* out; unsigned char* ws;
};
template <class T> __device__ __forceinline__ T* launder(T* p) { unsigned long long v = (unsigned long long)p; asm volatile("" : "+s"(v)); return (T*)(GAS T*)v; }
constexpr int MW_PTRS = 640;
__device__ __forceinline__ const float* pin_load(const Frame& F, int i) {
    const unsigned lo = __builtin_amdgcn_readfirstlane(F.MISC[MW_PTRS + 2 * i]), hi = __builtin_amdgcn_readfirstlane(F.MISC[MW_PTRS + 2 * i + 1]);
    return (const float*)(GAS const float*)(((unsigned long long)hi << 32) | lo);
}
#define PIN(F, i) pin_load(F, i)
__device__ __forceinline__ Frame phase_frame(const Frame& F0) {
    Frame F = F0; F.tid = opaque_tid(F0.wave); F.lane = F.tid & 63; F.wave = F0.wave;
    F.ws = launder(F0.ws); F.out = launder(F0.out); F.ctl = (gu32*)(F.ws + WS_CTL);
    { LAS unsigned char* l = F0.lds; asm volatile("" : "+s"(l)); F.lds = l; F.MISC = (volatile LAS unsigned*)(l + MISC_OFF); }
    return F;
}
constexpr int PH_PRO0 = 0, PH_PRO1 = 1, PH_L0 = 2, PH_PER_LAYER = 9, PH_FINAL = PH_L0 + NLAYER * PH_PER_LAYER, PH_COUNT = PH_FINAL + 1;
enum LPhase { LP_NORM1 = 0, LP_INPROJ, LP_MIX1, LP_MIX2, LP_MIX3, LP_OUTPROJ, LP_NORM2, LP_MOE1, LP_MOE2 };

struct TItem { const float* src; unsigned char* dst; int N; bool fp8; };
__device__ __forceinline__ TItem titem_decode(Frame& F, int it) {
    constexpr int R0 = 128 * 512, R1 = 128 * 256, R2 = 2 * 384, R3 = 512, R4 = 768;
    int r = it; TItem t;
    if (r < R0) { const int mi = r >> 9, q = r & 511, kb = q >> 5, nb = q & 31, n0 = nb * 64;
        const int d0 = n0 < 1024 ? 256 * (n0 >> 7) + (n0 & 127) : 256 * ((n0 - 1024) >> 7) + 128 + (n0 & 127);
        t.src = PIN(F, I_EW1) + (size_t)mi * 1024 * 2048 + (size_t)(kb * 64) * 2048 + n0; t.N = 2048; t.fp8 = true; t.dst = F.ws + WS_WE1 + (size_t)mi * 2048 * 1024 + (size_t)d0 * 1024 + kb * 64; return t; } r -= R0;
    if (r < R1) { const int mi = r >> 8, q = r & 255, kb = q >> 4, nb = q & 15;
        t.src = PIN(F, I_EW2) + (size_t)mi * 1024 * 1024 + (size_t)(kb * 64) * 1024 + nb * 64; t.N = 1024; t.fp8 = true; t.dst = F.ws + WS_WE2 + (size_t)mi * 1024 * 1024 + (size_t)(nb * 64) * 1024 + kb * 64; return t; } r -= R1;
    if (r < R2) { const int mi = r / 384, q = r % 384, kb = q / 24, nb = q % 24;
        t.src = PIN(F, I_AWIN) + (size_t)mi * 1024 * 1536 + (size_t)(kb * 64) * 1536 + nb * 64; t.N = 1536; t.fp8 = true; t.dst = F.ws + WS_WATT + (size_t)mi * 1536 * 1024 + (size_t)(nb * 64) * 1024 + kb * 64; return t; } r -= R2;
    if (r < R3) { const int kb = r >> 5, nb = r & 31;
        t.src = PIN(F, I_GWIN) + (size_t)(kb * 64) * 2048 + nb * 64; t.N = 2048; t.fp8 = false; t.dst = F.ws + WS_WGM + ((size_t)(nb * 64) * 1024 + kb * 64) * 2; return t; } r -= R3;
    if (r < R4) { const int kb = r / 48, nb = r % 48;
        t.src = PIN(F, I_HWIN) + (size_t)(kb * 64) * 3072 + nb * 64; t.N = 3072; t.fp8 = true; t.dst = F.ws + WS_WHY + (size_t)(nb * 64) * 1024 + kb * 64; return t; } r -= R4;
    { const int mi = r >> 8, q = r & 255, kb = q >> 4, nb = q & 15;
        t.src = PIN(F, I_WOUT) + (size_t)mi * 1024 * 1024 + (size_t)(kb * 64) * 1024 + nb * 64; t.N = 1024; t.fp8 = false; t.dst = F.ws + WS_WOUT + ((size_t)mi * 1024 * 1024 + (size_t)(nb * 64) * 1024 + kb * 64) * 2; return t; }
}
__device__ __forceinline__ void titem_load(const TItem& t, float (&v)[64], int lane) {
    const float* src = t.src + lane;
#pragma unroll
    for (int kk = 0; kk < 64; ++kk) v[kk] = src[(size_t)kk * t.N];
}
__device__ __forceinline__ void titem_finish(const TItem& t, const float (&v)[64], LAS float* scr, int lane) {
    constexpr int K = 1024;
#pragma unroll
    for (int kk = 0; kk < 64; ++kk) scr[kk * 65 + lane] = v[kk];
    LDS_WAIT(); asm volatile("" ::: "memory");
    if (!t.fp8) {
        const int c = lane & 7;
#pragma unroll
        for (int j = 0; j < 8; ++j) { const int n = (lane >> 3) + 8 * j; const LAS float* s = scr + (8 * c) * 65 + n;
            v4u o; o.x = pk2(s[0 * 65], s[1 * 65]); o.y = pk2(s[2 * 65], s[3 * 65]); o.z = pk2(s[4 * 65], s[5 * 65]); o.w = pk2(s[6 * 65], s[7 * 65]);
            *(GAS v4u*)(t.dst + ((size_t)n * K + 8 * c) * 2) = o; }
    } else {
        const int c = lane & 3;
#pragma unroll
        for (int j = 0; j < 4; ++j) { const int n = (lane >> 2) + 16 * j; const LAS float* s = scr + (16 * c) * 65 + n; unsigned w[4];
#pragma unroll
            for (int q = 0; q < 4; ++q) { unsigned x = 0; x = __builtin_amdgcn_cvt_pk_fp8_f32(32.0f * s[(4 * q) * 65], 32.0f * s[(4 * q + 1) * 65], x, false);
                x = __builtin_amdgcn_cvt_pk_fp8_f32(32.0f * s[(4 * q + 2) * 65], 32.0f * s[(4 * q + 3) * 65], x, true); w[q] = x; }
            *(GAS v4u*)(t.dst + (size_t)n * K + 16 * c) = (v4u){w[0], w[1], w[2], w[3]}; }
    }
    LDS_WAIT(); asm volatile("" ::: "memory");
}
__device__ __forceinline__ void pro0_transposes(Frame& F) {
    LAS float* scr = (LAS float*)(F.lds + F.wave * 16640);
    const int gw = F.bx * NWAVES + F.wave, NGW = F.G * NWAVES;
    constexpr int NITEMS = 128 * 512 + 128 * 256 + 2 * 384 + 512 + 768 + 4 * 256;
    float va[64], vb[64];
    int it = gw; if (it >= NITEMS) return;
    TItem ta = titem_decode(F, it), tb = ta; titem_load(ta, va, F.lane);
    for (;;) {
        const bool nb_ok = it + NGW < NITEMS; if (nb_ok) { tb = titem_decode(F, it + NGW); titem_load(tb, vb, F.lane); }
        titem_finish(ta, va, scr, F.lane);
        if (!nb_ok) break; it += NGW;
        const bool na_ok = it + NGW < NITEMS; if (na_ok) { ta = titem_decode(F, it + NGW); titem_load(ta, va, F.lane); }
        titem_finish(tb, vb, scr, F.lane);
        if (!na_ok) break; it += NGW;
    }
}
__device__ __forceinline__ void pro0_mod(Frame& F) {
    LAS float* sl = (LAS float*)F.lds;
    LAS float* red = (LAS float*)(F.lds + 65536);
    __syncthreads();
    for (int i = F.tid; i < 9 * 1024; i += NTHREADS) { const int r = i >> 10, k = i & 1023; const float v = r < 8 ? PIN(F, I_C)[r * 1024 + k] : PIN(F, I_CCTX)[k]; sl[i] = v / (1.0f + __expf(-v)); }
    __syncthreads();
    float* MOD = (float*)(F.ws + WS_MOD);
    for (int item = F.bx; item < NLAYER * 96; item += F.G) {
        const int l = item / 96, n0 = (item % 96) * 64;
        const float* W = PIN(F, I_ADAW) + (size_t)l * 1024 * 6144 + n0 + F.lane;
        float acc[9];
#pragma unroll
        for (int r = 0; r < 9; ++r) acc[r] = 0.f;
        const int kb = F.wave * 128;
#pragma unroll 16
        for (int k = 0; k < 128; ++k) { const float wv = W[(size_t)(kb + k) * 6144];
#pragma unroll
            for (int r = 0; r < 9; ++r) acc[r] += sl[r * 1024 + kb + k] * wv; }
#pragma unroll
        for (int r = 0; r < 9; ++r) red[(F.wave * 9 + r) * 64 + F.lane] = acc[r];
        __syncthreads();
        for (int i = F.tid; i < 9 * 64; i += NTHREADS) { const int r = i >> 6, n = i & 63; float s = 0.f;
#pragma unroll
            for (int w = 0; w < 8; ++w) s += red[(w * 9 + r) * 64 + n];
            MOD[((size_t)l * 9 + r) * 6144 + n0 + n] = s + PIN(F, I_ADAB)[l * 6144 + n0 + n]; }
        __syncthreads();
    }
}
__device__ __forceinline__ void pro0_filter_mlp(Frame& F) {
    const int j = F.lane, gw = F.bx * NWAVES + F.wave, NGW = F.G * NWAVES;
    LAS float* W1 = (LAS float*)F.lds; LAS float* W2 = W1 + FEMB * FH; LAS float* W3 = W2 + FH * FH;
    __syncthreads();
    for (int i = F.tid; i < FEMB * FH; i += NTHREADS) W1[i] = PIN(F, I_FW1)[i];
    for (int i = F.tid; i < FH * FH; i += NTHREADS) { W2[i] = PIN(F, I_FW2)[i]; W3[i] = PIN(F, I_FW3)[i]; }
    __syncthreads();
    const float b1 = PIN(F, I_FB1)[j], b2 = PIN(F, I_FB2)[j], b3 = PIN(F, I_FB3)[j], fr = PIN(F, I_FREQ)[j];
    for (int it = gw; it < SEQ + CL; it += NGW) {
        const bool lat = it < SEQ; const int t = lat ? it : it - SEQ; const float L = lat ? (float)SEQ : (float)CL;
        const float tl = (float)t / (L - 1.0f), w = (6.283185307179586f * (float)t) / L;
        float z;
        { const int band = (j - 1) & 15; const float f = 1e-4f + (float)band * ((15.0f - 1e-4f) / 15.0f); const float a = f * w;
          z = (j == 0) ? tl : (j <= 16 ? cosf(a) : -sinf(a)); }
        float s = b1;
#pragma unroll
        for (int i = 0; i < FEMB; ++i) s += __shfl(z, i) * W1[i * FH + j];
        const float a1 = sinf(fr * s);
        s = b2;
#pragma unroll 16
        for (int i = 0; i < FH; ++i) s += __shfl(a1, i) * W2[i * FH + j];
        const float a2 = sinf(fr * s);
        s = b3;
#pragma unroll 16
        for (int i = 0; i < FH; ++i) s += __shfl(a2, i) * W3[i * FH + j];
        const float a3 = sinf(fr * s);
        float* dst = lat ? (float*)(F.ws + WS_A3) + (size_t)t * FH : (float*)(F.ws + WS_A3C) + (size_t)t * FH;
        dst[j] = a3;
    }
    __syncthreads();
}

__device__ __forceinline__ f32x2 cmul(f32x2 a, f32x2 b) { return (f32x2){a.x * b.x - a.y * b.y, a.x * b.y + a.y * b.x}; }
__device__ __forceinline__ f32x2 cconj(f32x2 a) { return (f32x2){a.x, -a.y}; }
#define ZP(n) ((n) + ((n) >> 5))
constexpr int FFT_LDS_BYTES = (NFFT + NFFT / 32) * 8;
__device__ __forceinline__ void bfly_dif(f32x2& a0, f32x2& a1, f32x2& a2, f32x2& a3, f32x2 w) {
    const f32x2 t0 = a0 + a2, t1 = a0 - a2, t2 = a1 + a3, d = a1 - a3, t3 = (f32x2){d.y, -d.x};
    const f32x2 y0 = t0 + t2, y2 = t0 - t2, y1 = t1 + t3, y3 = t1 - t3, w2 = cmul(w, w), w3 = cmul(w2, w);
    a0 = y0; a1 = cmul(y2, w2); a2 = cmul(y1, w); a3 = cmul(y3, w3);
}
__device__ __forceinline__ void bfly_dit(f32x2& a0, f32x2& a1, f32x2& a2, f32x2& a3, f32x2 w) {
    const f32x2 w2 = cmul(w, w), w3 = cmul(w2, w), A1 = cmul(a1, w2), A2 = cmul(a2, w), A3 = cmul(a3, w3);
    const f32x2 u0 = a0 + A1, u1 = a0 - A1, u2 = A2 + A3, u3 = A2 - A3, iu3 = (f32x2){-u3.y, u3.x};
    a0 = u0 + u2; a1 = u1 + iu3; a2 = u0 - u2; a3 = u1 - iu3;
}
template <int LQ, bool INV> __device__ __forceinline__ void fft_r16(LAS f32x2* z, int tid) {
    constexpr int q16 = 1 << LQ; constexpr float inv_lb = 1.0f / (float)(16 * q16);
    constexpr float C1 = 0.92387953251128674f, S1 = 0.38268343236508977f, C2 = 0.70710678118654752f;
    asm volatile("" : "+v"(tid));
#pragma unroll 1
    for (int g = tid; g < NFFT / 16; g += NTHREADS) {
        const int j = g & (q16 - 1), base = ((g >> LQ) << (LQ + 4)) + j;
        f32x2 x[16];
#pragma unroll
        for (int m = 0; m < 16; ++m) x[m] = z[ZP(base + (m << LQ))];
        const float fr = (float)j * inv_lb; const float sn = __builtin_amdgcn_sinf(fr);
        const f32x2 w1 = (f32x2){__builtin_amdgcn_cosf(fr), INV ? sn : -sn};
        const float sg = INV ? 1.0f : -1.0f;
        const f32x2 wa0 = w1, wa1 = cmul(w1, (f32x2){C1, sg * S1}), wa2 = cmul(w1, (f32x2){C2, sg * C2}), wa3 = cmul(w1, (f32x2){S1, sg * C1});
        const f32x2 w2 = cmul(w1, w1), wb = cmul(w2, w2);
        if constexpr (!INV) {
            bfly_dif(x[0], x[4], x[8], x[12], wa0); bfly_dif(x[1], x[5], x[9], x[13], wa1); bfly_dif(x[2], x[6], x[10], x[14], wa2); bfly_dif(x[3], x[7], x[11], x[15], wa3);
#pragma unroll
            for (int a = 0; a < 4; ++a) bfly_dif(x[4 * a], x[4 * a + 1], x[4 * a + 2], x[4 * a + 3], wb);
        } else {
#pragma unroll
            for (int a = 0; a < 4; ++a) bfly_dit(x[4 * a], x[4 * a + 1], x[4 * a + 2], x[4 * a + 3], wb);
            bfly_dit(x[0], x[4], x[8], x[12], wa0); bfly_dit(x[1], x[5], x[9], x[13], wa1); bfly_dit(x[2], x[6], x[10], x[14], wa2); bfly_dit(x[3], x[7], x[11], x[15], wa3);
        }
#pragma unroll
        for (int m = 0; m < 16; ++m) z[ZP(base + (m << LQ))] = x[m];
    }
    __syncthreads();
}
template <bool INV> __device__ __forceinline__ void fft_r4_unit(LAS f32x2* z, int tid) {
    asm volatile("" : "+v"(tid));
#pragma unroll 2
    for (int bf = tid; bf < NFFT / 4; bf += NTHREADS) {
        const int base = 4 * bf; f32x2 a0 = z[ZP(base)], a1 = z[ZP(base + 1)], a2 = z[ZP(base + 2)], a3 = z[ZP(base + 3)];
        if constexpr (!INV) { const f32x2 t0 = a0 + a2, t1 = a0 - a2, t2 = a1 + a3, d = a1 - a3, t3 = (f32x2){d.y, -d.x};
            z[ZP(base)] = t0 + t2; z[ZP(base + 1)] = t0 - t2; z[ZP(base + 2)] = t1 + t3; z[ZP(base + 3)] = t1 - t3; }
        else { const f32x2 u0 = a0 + a1, u1 = a0 - a1, u2 = a2 + a3, u3 = a2 - a3, iu3 = (f32x2){-u3.y, u3.x};
            z[ZP(base)] = u0 + u2; z[ZP(base + 1)] = u1 + iu3; z[ZP(base + 2)] = u0 - u2; z[ZP(base + 3)] = u1 - iu3; }
    }
    __syncthreads();
}
__device__ __forceinline__ void fft16k_dif(LAS f32x2* z, int tid) { fft_r16<10, false>(z, tid); fft_r16<6, false>(z, tid); fft_r16<2, false>(z, tid); fft_r4_unit<false>(z, tid); }
__device__ __forceinline__ void fft16k_dit_inv(LAS f32x2* z, int tid) { fft_r4_unit<true>(z, tid); fft_r16<2, true>(z, tid); fft_r16<6, true>(z, tid); fft_r16<10, true>(z, tid); }
constexpr int KF_LD = 8256;
__device__ __forceinline__ int rev14(int p) { return (int)(__brev((unsigned)p) >> 18); }
__device__ __forceinline__ float hy_delta(int c) { const float mn = -3.0701134573253945f, mx = -15.350567286626973f; return fabsf(mn + (mx - mn) * ((float)c / 1023.0f)); }

__device__ __forceinline__ void pro1_router_split(Frame& F) {
    const float* MOD = (const float*)(F.ws + WS_MOD); unsigned char* RW3 = F.ws + WS_RW3;
    for (int ent = F.bx * NTHREADS + F.tid; ent < NLAYER * 9 * 8 * 8 * 64; ent += F.G * NTHREADS) {
        const int lane = ent & 63, kb = (ent >> 6) & 7, w = (ent >> 9) & 7, lb = ent >> 12, l = lb / 9;
        const int k0 = w * 128 + 16 * kb + 8 * (lane >> 5), e = lane & 31;
        const float* gn = PIN(F, I_N2G) + l * D; const float* sc = MOD + (size_t)lb * 6144 + 4 * 1024; const float* rw = PIN(F, I_RW) + (size_t)l * D * NE;
        unsigned ph[4], pm[4], pl[4];
#pragma unroll
        for (int j2 = 0; j2 < 4; ++j2) { const int k = k0 + 2 * j2; const float v0 = gn[k] * (1.0f + sc[k]) * rw[(size_t)k * NE + e], v1 = gn[k + 1] * (1.0f + sc[k + 1]) * rw[(size_t)(k + 1) * NE + e];
            const unsigned h = cvt_pk_bf16(v0, v1); const float r0 = v0 - __uint_as_float(h << 16), r1 = v1 - __uint_as_float(h & 0xffff0000u);
            const unsigned m = cvt_pk_bf16(r0, r1); const float s0 = r0 - __uint_as_float(m << 16), s1 = r1 - __uint_as_float(m & 0xffff0000u);
            ph[j2] = h; pm[j2] = m; pl[j2] = cvt_pk_bf16(s0, s1); }
        v4u* dst = (v4u*)(RW3 + (size_t)(ent >> 6) * 3 * 1024) + lane;
        dst[0] = (v4u){ph[0], ph[1], ph[2], ph[3]}; dst[64] = (v4u){pm[0], pm[1], pm[2], pm[3]}; dst[128] = (v4u){pl[0], pl[1], pl[2], pl[3]};
    }
}
__device__ __forceinline__ void pro1_filters(Frame& F) {
    if (F.bx < NLAYER * 9) {
        const int lb = F.bx, l = lb / 9, e = F.lane & 31, hf = F.lane >> 5; const float* sh = (const float*)(F.ws + WS_MOD) + (size_t)lb * 6144 + 3 * 1024; const float* rw = PIN(F, I_RW) + (size_t)l * D * NE;
        LAS float* red = (LAS float*)F.lds; const int k0 = F.wave * 128 + hf * 64; float acc = 0.f;
#pragma unroll 8
        for (int k = k0; k < k0 + 64; ++k) acc += sh[k] * rw[(size_t)k * NE + e];
        acc += shx(acc, 32, F.lane); if (F.lane < 32) red[F.wave * 32 + e] = acc;
        __syncthreads();
        if (F.tid < 32) { float s = PIN(F, I_RB)[l * NE + F.tid];
#pragma unroll
            for (int w = 0; w < 8; ++w) s += red[w * 32 + F.tid];
            ((float*)(F.ws + WS_RC))[lb * NE + F.tid] = s; }
    }
    LAS f32x2* z = (LAS f32x2*)F.lds;
    LAS float* wl = (LAS float*)(F.lds + AUX_OFF + 8192);
    const float* a3 = (const float*)(F.ws + WS_A3); const float* a3c = (const float*)(F.ws + WS_A3C);
    f32x2* KF = (f32x2*)(F.ws + WS_KF); float* FCT = (float*)(F.ws + WS_FCT);
    for (int u = F.bx; u < 512; u += F.G) {
        const int ca = 2 * u, cb = 2 * u + 1;
        __syncthreads();
        if (F.tid < 256) { const int which = F.tid >> 6, m = F.tid & 63; const int col = (which & 1 ? cb : ca) + (which >> 1) * 1024; wl[which * 64 + m] = PIN(F, I_FW4)[m * 2048 + col]; }
        if (F.tid < 4) { const int col = (F.tid & 1 ? cb : ca) + (F.tid >> 1) * 1024; wl[256 + F.tid] = PIN(F, I_FB4)[col]; }
        __syncthreads();
        const float da = hy_delta(ca), db = hy_delta(cb);
        const float dska = PIN(F, I_HD)[ca], dskb = PIN(F, I_HD)[cb];
        for (int t = F.tid; t < SEQ; t += NTHREADS) {
            const f32x4* ar = (const f32x4*)(a3 + (size_t)t * FH); float s0 = wl[256], s1 = wl[257], s2 = wl[258], s3 = wl[259];
#pragma unroll 8
            for (int m4 = 0; m4 < 16; ++m4) { const f32x4 a = ar[m4];
#pragma unroll
                for (int i = 0; i < 4; ++i) { const int m = m4 * 4 + i; s0 += a[i] * wl[m]; s1 += a[i] * wl[64 + m]; s2 += a[i] * wl[128 + m]; s3 += a[i] * wl[192 + m]; } }
            const float tl = (float)t / (float)(SEQ - 1); const float wa = __expf(-tl * da), wb = __expf(-tl * db);
            z[ZP(t)] = (f32x2){s0 * wa + (t == 0 ? dska : 0.f), s1 * wb + (t == 0 ? dskb : 0.f)};
            if (t == 0) z[ZP(SEQ)] = (f32x2){0.f, 0.f}; else z[ZP(NFFT - t)] = (f32x2){s2 * wa, s3 * wb};
        }
        for (int i = F.tid; i < 511; i += NTHREADS) {
            const int d = i - 255, t = d < 0 ? -d : d; const int o = d < 0 ? 2 : 0;
            const f32x4* ar = (const f32x4*)(a3c + (size_t)t * FH); float sa = wl[256 + o], sb = wl[257 + o];
            f32x4 av[16];
#pragma unroll
            for (int m4 = 0; m4 < 16; ++m4) av[m4] = ar[m4];
            __builtin_amdgcn_sched_barrier(0);
#pragma unroll
            for (int m4 = 0; m4 < 16; ++m4) {
#pragma unroll
                for (int i2 = 0; i2 < 4; ++i2) { const int m = m4 * 4 + i2; sa += av[m4][i2] * wl[o * 64 + m]; sb += av[m4][i2] * wl[(o + 1) * 64 + m]; }
                if ((m4 & 3) == 3) __builtin_amdgcn_sched_barrier(0); }
            const float tl = (float)t / (float)(CL - 1);
            FCT[(size_t)ca * 512 + d + 256] = sa * __expf(-tl * da) + (d == 0 ? dska : 0.f); FCT[(size_t)cb * 512 + d + 256] = sb * __expf(-tl * db) + (d == 0 ? dskb : 0.f);
        }
        __syncthreads();
        fft16k_dif(z, F.tid);
        for (int k = F.tid; k <= NFFT / 2; k += NTHREADS) {
            const int p = rev14(k), p2 = rev14((NFFT - k) & (NFFT - 1)); const f32x2 a = z[ZP(p)], b = z[ZP(p2)];
            KF[(size_t)ca * KF_LD + k] = (f32x2){0.5f * (a.x + b.x), 0.5f * (a.y - b.y)};
            KF[(size_t)cb * KF_LD + k] = (f32x2){0.5f * (a.y + b.y), -0.5f * (a.x - b.x)};
        }
    }
    __syncthreads();
}

__device__ __forceinline__ void hyena_conv_phase(Frame& F) {
    LAS f32x2* z = (LAS f32x2*)F.lds;
    LAS float* aux = (LAS float*)(F.lds + AUX_OFF + 8192);
    const float* VT = (const float*)(F.ws + WS_VT); const float* VTC = (const float*)(F.ws + WS_VTC); float* CT = (float*)(F.ws + WS_CT); float* CTC = (float*)(F.ws + WS_CTC);
    const f32x2* KF = (const f32x2*)(F.ws + WS_KF); const float* FCT = (const float*)(F.ws + WS_FCT);
    v4u ina[2], inb[2];
#define HC_LOADIN(u_, t_) do { const int b_ = (u_) >> 9, c_ = 2 * ((u_) & 511); const v4u* va_ = (const v4u*)((const bf16*)VT + ((size_t)b_ * 1024 + c_) * SEQ + 16 * (t_)); \
        ina[0] = va_[0]; ina[1] = va_[1]; inb[0] = va_[SEQ / 8]; inb[1] = va_[SEQ / 8 + 1]; } while (0)
    if (F.bx < NB * 512) HC_LOADIN(F.bx, F.tid);
    for (int u = F.bx; u < NB * 512; u += F.G) {
        const int b = u >> 9, cp = u & 511, ca = 2 * cp, cb = ca + 1;
        int tq = F.tid; asm volatile("" : "+v"(tq));
        __syncthreads();
        { const int n0 = 16 * tq;
#pragma unroll
          for (int i = 0; i < 4; ++i) { const unsigned a0 = ina[i >> 1][2 * (i & 1)], a1 = ina[i >> 1][2 * (i & 1) + 1], b0 = inb[i >> 1][2 * (i & 1)], b1 = inb[i >> 1][2 * (i & 1) + 1];
              z[ZP(n0 + 4 * i)] = (f32x2){bflo(a0), bflo(b0)}; z[ZP(n0 + 4 * i + 1)] = (f32x2){bfhi(a0), bfhi(b0)}; z[ZP(n0 + 4 * i + 2)] = (f32x2){bflo(a1), bflo(b1)}; z[ZP(n0 + 4 * i + 3)] = (f32x2){bfhi(a1), bfhi(b1)};
#pragma unroll
              for (int j = 0; j < 4; ++j) z[ZP(SEQ + n0 + 4 * i + j)] = (f32x2){0.f, 0.f}; } }
        f32x4 ka[8], kb[8]; f32x2 kaN, kbN;
        { const f32x4* pa = (const f32x4*)(KF + (size_t)ca * KF_LD + 16 * tq); const f32x4* pb = (const f32x4*)(KF + (size_t)cb * KF_LD + 16 * tq);
#pragma unroll
          for (int i = 0; i < 8; ++i) { ka[i] = pa[i]; kb[i] = pb[i]; }
          kaN = KF[(size_t)ca * KF_LD + NFFT / 2]; kbN = KF[(size_t)cb * KF_LD + NFFT / 2]; }
        { const int h = tq >> 8, t = tq & 255;
          const float* vc = VTC + ((size_t)b * 1024 + ca + h) * CL;
          aux[h * 256 + t] = vc[t]; aux[512 + h * 520 + 1 + t] = FCT[(size_t)(ca + h) * 512 + t]; aux[512 + h * 520 + 257 + t] = FCT[(size_t)(ca + h) * 512 + 256 + t];
          __syncthreads();
          if (tq < 256) { const int hh = tq >> 7, pp = tq & 127; const LAS float* vv = aux + hh * 256; const LAS float* kk = aux + 512 + hh * 520 + 256 + 2 * pp;
              float y0 = 0.f, y1 = 0.f, lop = kk[2];
#pragma unroll 8
              for (int q = 0; q < CL / 2; ++q) { const f32x2 v = *(const LAS f32x2*)(vv + 2 * q), kq = *(const LAS f32x2*)(kk - 2 * q);
                  y0 += v.x * kq.y + v.y * kq.x; y1 += v.x * lop + v.y * kq.y; lop = kq.x; }
              *(f32x2*)(CTC + ((size_t)b * 1024 + ca + hh) * CL + 2 * pp) = (f32x2){y0, y1}; } }
        fft16k_dif(z, F.tid);
        int tpw = tq; asm volatile("" : "+v"(tpw));
#define HC_PW(k_, Ka_, Kb_) do { const int p = rev14(k_), p2 = rev14((NFFT - (k_)) & (NFFT - 1)); const f32x2 a = z[ZP(p)], b2 = z[ZP(p2)]; \
            const f32x2 Va = (f32x2){0.5f * (a.x + b2.x), 0.5f * (a.y - b2.y)}, Vb = (f32x2){0.5f * (a.y + b2.y), -0.5f * (a.x - b2.x)}; \
            const f32x2 ya = cmul(Va, Ka_), yb = cmul(Vb, Kb_); \
            z[ZP(p)] = (f32x2){ya.x - yb.y, ya.y + yb.x}; z[ZP(p2)] = (f32x2){ya.x + yb.y, -ya.y + yb.x}; } while (0)
#pragma unroll
        for (int i = 0; i < 8; ++i) { const int k = 16 * tpw + 2 * i;
            HC_PW(k, ((f32x2){ka[i].x, ka[i].y}), ((f32x2){kb[i].x, kb[i].y})); HC_PW(k + 1, ((f32x2){ka[i].z, ka[i].w}), ((f32x2){kb[i].z, kb[i].w}));
            asm volatile("" ::: "memory"); }
        if (tpw == 0) HC_PW(NFFT / 2, kaN, kbN);
#undef HC_PW
        __syncthreads();
        if (u + F.G < NB * 512) HC_LOADIN(u + F.G, tq);
        fft16k_dit_inv(z, F.tid);
        { int to = tq; asm volatile("" : "+v"(to)); const float sc = 1.0f / (float)NFFT; const int n0 = 16 * to;
          v4u* oa = (v4u*)((bf16*)CT + ((size_t)b * 1024 + ca) * SEQ + n0);
#pragma unroll
          for (int h2 = 0; h2 < 2; ++h2) { f32x2 w[8];
#pragma unroll
              for (int j = 0; j < 8; ++j) w[j] = z[ZP(n0 + 8 * h2 + j)];
              oa[h2] = (v4u){cvt_pk_bf16(w[0].x * sc, w[1].x * sc), cvt_pk_bf16(w[2].x * sc, w[3].x * sc), cvt_pk_bf16(w[4].x * sc, w[5].x * sc), cvt_pk_bf16(w[6].x * sc, w[7].x * sc)};
              oa[SEQ / 8 + h2] = (v4u){cvt_pk_bf16(w[0].y * sc, w[1].y * sc), cvt_pk_bf16(w[2].y * sc, w[3].y * sc), cvt_pk_bf16(w[4].y * sc, w[5].y * sc), cvt_pk_bf16(w[6].y * sc, w[7].y * sc)}; } }
    }
    __syncthreads();
#undef HC_LOADIN
}
constexpr int MW_CUMBLK = 16, MW_CNT = 64, MW_SELE = 128, MW_SELV = 256, MW_LRANK = 384, MW_LBASE = 512;
__device__ __forceinline__ void moe_tables(Frame& F, int layer) {
    __syncthreads();
    if (F.tid < NE) F.MISC[MW_CNT + F.tid] = __hip_atomic_load(F.ctl + CW_CNT + layer * NE + F.tid, RLX_AGENT);
    __syncthreads();
    if (F.tid < 64) {
        const unsigned v = F.tid < NE ? (F.MISC[MW_CNT + (F.tid & 31)] + 255u) >> 8 : 0u; unsigned s = v;
#pragma unroll
        for (int d = 1; d < 32; d <<= 1) { const unsigned t = (unsigned)__builtin_amdgcn_ds_bpermute(((F.tid - d) & 63) * 4, (int)s); if ((F.tid & 63) >= d) s += t; }
        if (F.tid < NE) F.MISC[MW_CUMBLK + F.tid] = s - v;
        if (F.tid == NE - 1) F.MISC[MW_CUMBLK + NE] = s; }
    __syncthreads();
}

template <int MODE> __device__ __forceinline__ void rowpass(Frame& F, int layer, bool real = true, bool h8 = false) {
    const bool combine = (MODE == 0 && layer > 0) || MODE == 2;
    const int nrows = MODE == 2 ? ML : MT;
    const int cl = MODE == 2 ? NLAYER - 1 : layer - 1;
    const bool from_input = (MODE == 0 && layer == 0);
    const float* XLs = PIN(F, I_X); const float* XCs = PIN(F, I_CTX);
    bf16* XB = (bf16*)(F.ws + WS_XB); bf16* XBd = real ? XB : (bf16*)(F.ws + WS_P);
    const float* MOD = (const float*)(F.ws + WS_MOD);
    bf16* H = (bf16*)(F.ws + WS_H); unsigned char* H8 = (unsigned char*)(F.ws + WS_H8); const unsigned char* YM = (const unsigned char*)(F.ws + WS_YM);
    const int* TE = (const int*)(F.ws + WS_TE); const int* TR = (const int*)(F.ws + WS_TR); const float* TG = (const float*)(F.ws + WS_TG);
    const float* gnorm = MODE == 0 ? PIN(F, I_N1G) + layer * D : PIN(F, I_FG);
    if (combine) moe_tables(F, cl);
    f32x4 gn[4];
#pragma unroll
    for (int j = 0; j < 4; ++j) gn[j] = ((const f32x4*)gnorm)[F.lane + 64 * j];
    const int ntiles = nrows / 32;
    i32x4 nte[4], ntr[4]; f32x4 ntg[4];
#define RP_TABLES(tile_) do { const size_t rb_ = (size_t)((tile_) * 32 + F.wave * 4) * 4; \
        _Pragma("unroll") for (int q = 0; q < 4; ++q) { nte[q] = *(const i32x4*)(TE + rb_ + 4 * q); ntr[q] = *(const i32x4*)(TR + rb_ + 4 * q); ntg[q] = *(const f32x4*)(TG + rb_ + 4 * q); } } while (0)
    if (combine && F.bx < ntiles) RP_TABLES(F.bx);
    for (int tile = F.bx; tile < ntiles; tile += F.G) {
        const int rbase = tile * 32 + F.wave * 4; const bool lat = rbase < ML; const int bidx = lat ? (rbase >> 13) : 8;
        const float* g2 = MOD + ((size_t)(combine ? cl : 0) * 9 + bidx) * 6144 + 5 * 1024;
        const float* mb = MOD + ((size_t)layer * 9 + bidx) * 6144;
        int rid[4][4]; float gkk[4][4];
        if (combine) {
#pragma unroll
            for (int q = 0; q < 4; ++q)
#pragma unroll
                for (int k = 0; k < 4; ++k) { rid[q][k] = 256 * (int)F.MISC[MW_CUMBLK + nte[q][k]] + ntr[q][k]; gkk[q][k] = ntg[q][k]; }
            if (tile + F.G < ntiles) RP_TABLES(tile + F.G);
        }
#pragma unroll 1
        for (int pr = 0; pr < 2; ++pr) {
            size_t xo[2]; f32x4 v[2][4]; int rowid[2][4]; float gk[2][4];
#pragma unroll
            for (int u = 0; u < 2; ++u) { const int r = rbase + 2 * pr + u; xo[u] = (size_t)r * D;
                if (combine) {
#pragma unroll
                    for (int k = 0; k < 4; ++k) { rowid[u][k] = pr ? rid[2 + u][k] : rid[u][k]; gk[u][k] = pr ? gkk[2 + u][k] : gkk[u][k]; } }
                if (from_input) { const f32x4* xs = (const f32x4*)(lat ? XLs + xo[u] : XCs + (xo[u] - (size_t)ML * D));
#pragma unroll
                    for (int j = 0; j < 4; ++j) v[u][j] = xs[F.lane + 64 * j]; }
                else { const v2u* xs = (const v2u*)(XB + xo[u]);
#pragma unroll
                    for (int j = 0; j < 4; ++j) v[u][j] = bf4_f32(xs[F.lane + 64 * j]); } }
            if (combine) {
                unsigned w[2][4][4];
#pragma unroll
                for (int u = 0; u < 2; ++u)
#pragma unroll
                    for (int k = 0; k < 4; ++k) { const unsigned* yr = (const unsigned*)(YM + (size_t)rowid[u][k] * D);
#pragma unroll
                        for (int j = 0; j < 4; ++j) w[u][k][j] = yr[F.lane + 64 * j]; }
#pragma unroll
                for (int u = 0; u < 2; ++u) {
#pragma unroll
                    for (int j = 0; j < 4; ++j) { f32x4 a = (f32x4){0.f, 0.f, 0.f, 0.f};
#pragma unroll
                        for (int k = 0; k < 4; ++k) { const f32x2 lo = __builtin_amdgcn_cvt_pk_f32_fp8(w[u][k][j], false), hi2 = __builtin_amdgcn_cvt_pk_f32_fp8(w[u][k][j], true); a += gk[u][k] * (f32x4){lo.x, lo.y, hi2.x, hi2.y}; }
                        v[u][j] += ((const f32x4*)g2)[F.lane + 64 * j] * a; }
                    if (MODE == 0) { v2u* xd = (v2u*)(XBd + xo[u]);
#pragma unroll
                        for (int j = 0; j < 4; ++j) { v2u o; o.x = cvt_pk_bf16(v[u][j].x, v[u][j].y); o.y = cvt_pk_bf16(v[u][j].z, v[u][j].w); xd[F.lane + 64 * j] = o; } } }
            }
            if (from_input) {
#pragma unroll
                for (int u = 0; u < 2; ++u) { v2u* xd = (v2u*)(XBd + xo[u]);
#pragma unroll
                    for (int j = 0; j < 4; ++j) { v2u o; o.x = cvt_pk_bf16(v[u][j].x, v[u][j].y); o.y = cvt_pk_bf16(v[u][j].z, v[u][j].w); xd[F.lane + 64 * j] = o; } } }
#pragma unroll
            for (int u = 0; u < 2; ++u) { const int r = rbase + 2 * pr + u;
                float ss = 0.f;
#pragma unroll
                for (int j = 0; j < 4; ++j) ss += (v[u][j].x * v[u][j].x + v[u][j].y * v[u][j].y) + (v[u][j].z * v[u][j].z + v[u][j].w * v[u][j].w);
                const float rstd = 1.0f / sqrtf(wave_sum(ss, F.lane) * (1.0f / D) + EPS);
                if (MODE == 2) { f32x4* od = (f32x4*)((real ? F.out : (float*)(F.ws + WS_P)) + xo[u]);
#pragma unroll
                    for (int j = 0; j < 4; ++j) od[F.lane + 64 * j] = v[u][j] * rstd * gn[j]; }
                else { v2u* hd = (v2u*)(H + (size_t)r * D); unsigned* hd8 = (unsigned*)(H8 + (size_t)r * D);
#pragma unroll
                    for (int j = 0; j < 4; ++j) { const f32x4 sh = ((const f32x4*)mb)[F.lane + 64 * j], sc = ((const f32x4*)(mb + 1024))[F.lane + 64 * j]; const f32x4 hv = v[u][j] * rstd * gn[j] * (sc + 1.0f) + sh;
                        if (h8) { unsigned o = 0; o = __builtin_amdgcn_cvt_pk_fp8_f32(hv.x, hv.y, o, false); o = __builtin_amdgcn_cvt_pk_fp8_f32(hv.z, hv.w, o, true); hd8[F.lane + 64 * j] = o; }
                        else { v2u o; o.x = cvt_pk_bf16(hv.x, hv.y); o.y = cvt_pk_bf16(hv.z, hv.w); hd[F.lane + 64 * j] = o; } } }
            }
        }
    }
}

typedef float f32x16r __attribute__((ext_vector_type(16)));
__device__ __forceinline__ void router_phase(Frame& F, int layer, bool real = true, int xp = 0) {
    const bool last = layer == NLAYER - 1;
    const int ntiles = (last ? ML : MT) / 32;
    LAS float* PART = (LAS float*)F.lds;
    LAS float* SSQ = PART + 8 * 32 * 33;
    LAS float* LG = SSQ + 8 * 32;
    LAS float* RSTD = LG + 32 * 33;
    LAS unsigned* CW = (LAS unsigned*)(RSTD + 32);
    LAS unsigned* RUN = CW + 64;
    LAS float* AV = (LAS float*)(RUN + 32);
    LAS float* SHV = AV + 1024;
    LAS float* RCV = SHV + 1024;
    LAS int* TRL = (LAS int*)((LAS unsigned char*)(RCV + 32) + 8 * (32 * 272));
    LAS bf16* STG = (LAS bf16*)((LAS unsigned char*)(RCV + 32) + F.wave * (32 * 272));
    const bf16* XB = (const bf16*)(F.ws + WS_XB);
    const float* MOD = (const float*)(F.ws + WS_MOD); const float* RC = (const float*)(F.ws + WS_RC);
    unsigned char* H8 = (unsigned char*)(F.ws + WS_H8);
    int* TE = (int*)(F.ws + WS_TE); int* TR = (int*)(F.ws + WS_TR); float* TG = (float*)(F.ws + WS_TG); int* ROWTOK = (int*)(F.ws + WS_ROWTOK);
    const float* gn = PIN(F, I_N2G) + layer * D; const float* rw = PIN(F, I_RW) + (size_t)layer * D * NE;
    const int i = F.lane & 31, hf = F.lane >> 5, lr = F.lane >> 4, lc = F.lane & 15, kw = F.wave * 128;
    const int per = 2048 / F.G;
    const int nmine = (2048 % F.G == 0) ? per + ((2048 + F.bx < ntiles) ? 1 : 0) : 0;
#define RT_TILE(n_) ((2048 % F.G == 0) ? ((n_) < per ? F.bx * per + (n_) : 2048 + F.bx) : F.bx + (n_) * F.G)
    const int ncnt = (2048 % F.G == 0) ? nmine : (F.bx < ntiles ? (ntiles - 1 - F.bx) / F.G + 1 : 0);
    __syncthreads();
    if (F.tid < NE) RUN[F.tid] = 0u;
    bf16x8 bw[8][2];
    v2u rawp[16];
#define RT_LOADX(tile_) do { const int rb_ = (tile_) * 32 + lr; const bf16* xb_ = XB + (size_t)rb_ * D + kw + 4 * lc; \
        _Pragma("unroll") for (int q = 0; q < 16; ++q) rawp[q] = *(const v2u*)(xb_ + (size_t)(4 * (q & 7)) * D + 64 * (q >> 3)); } while (0)
    if (ncnt > 0) RT_LOADX(RT_TILE(0));
    int cur_b = -1;
    for (int n = 0; n < ncnt; ++n) {
        const int tile = RT_TILE(n);
        const int r0 = tile * 32; const bool lat = r0 < ML; const int bidx = lat ? (r0 >> 13) : 8; const int r = r0 + i;
        if (bidx != cur_b) {
            cur_b = bidx; const float* mb = MOD + ((size_t)layer * 9 + bidx) * 6144 + 3 * 1024;
            __syncthreads();
            for (int k = F.tid; k < 1024; k += NTHREADS) { AV[k] = gn[k] * (1.0f + mb[1024 + k]); SHV[k] = mb[k]; }
            if (F.tid < NE) RCV[F.tid] = RC[((size_t)layer * 9 + bidx) * NE + F.tid];
            __syncthreads();
            { const v4u* src = (const v4u*)(F.ws + WS_RW3 + ((size_t)(layer * 9 + bidx) * 8 + F.wave) * 8 * 3 * 1024) + F.lane;
#pragma unroll
              for (int kb = 0; kb < 8; ++kb)
#pragma unroll
                  for (int t = 0; t < 2; ++t) bw[kb][t] = __builtin_bit_cast(bf16x8, src[(kb * 3 + t) * 64]); }
        }
        { float s8[8];
#pragma unroll
          for (int q = 0; q < 8; ++q) { const f32x4 a = bf4_f32(rawp[q]), b = bf4_f32(rawp[q + 8]); s8[q] = ((a.x * a.x + a.y * a.y) + (a.z * a.z + a.w * a.w)) + ((b.x * b.x + b.y * b.y) + (b.z * b.z + b.w * b.w)); }
#pragma unroll
          for (int q = 0; q < 8; ++q) { float v = s8[q]; v += shx(v, 1, F.lane); v += shx(v, 2, F.lane); v += shx(v, 4, F.lane); v += shx(v, 8, F.lane); if (lc == 0) SSQ[F.wave * 32 + 4 * q + lr] = v; } }
        __syncthreads();
        const f32x4 av0 = ((const LAS f32x4*)(AV + kw))[lc], av1 = ((const LAS f32x4*)(AV + kw))[lc + 16];
        { const f32x4 sh0 = ((const LAS f32x4*)(SHV + kw))[lc], sh1 = ((const LAS f32x4*)(SHV + kw))[lc + 16];
          unsigned char* hb = H8 + (size_t)(r0 + lr) * D + kw + 4 * lc;
#pragma unroll
          for (int q = 0; q < 8; ++q) { float qs = 0.f;
#pragma unroll
              for (int w = 0; w < 8; ++w) qs += SSQ[w * 32 + 4 * q + lr];
              const float rs = 1.0f / sqrtf(qs * (1.0f / D) + EPS);
#pragma unroll
              for (int hq = 0; hq < 2; ++hq) { const f32x4 h = bf4_f32(rawp[q + 8 * hq]) * (rs * (hq ? av1 : av0)) + (hq ? sh1 : sh0); unsigned w = 0;
                  w = __builtin_amdgcn_cvt_pk_fp8_f32(h.x, h.y, w, false); w = __builtin_amdgcn_cvt_pk_fp8_f32(h.z, h.w, w, true);
                  *(unsigned*)(hb + (size_t)(4 * q) * D + 64 * hq) = w; } } }
        f32x16r acc = {};
        asm volatile("s_waitcnt lgkmcnt(0)" ::: "memory");
#pragma unroll
        for (int q = 0; q < 16; ++q) *(LAS v2u*)(STG + (4 * (q & 7) + lr) * 136 + 4 * lc + 64 * (q >> 3)) = rawp[q];
        asm volatile("s_waitcnt lgkmcnt(0)" ::: "memory");
        if (n + 1 < ncnt) RT_LOADX(RT_TILE(n + 1));
#pragma unroll
        for (int kb = 0; kb < 8; ++kb) { const bf16x8 a = *(const LAS bf16x8*)(STG + i * 136 + 16 * kb + 8 * hf);
#pragma unroll
            for (int t = 0; t < 2; ++t) acc = __builtin_amdgcn_mfma_f32_32x32x16_bf16(a, bw[kb][t], acc, 0, 0, 0); }
#pragma unroll
        for (int rg = 0; rg < 16; ++rg) PART[(F.wave * 32 + ((rg & 3) + 8 * (rg >> 2) + 4 * hf)) * 33 + i] = acc[rg];
        __syncthreads();
        { const int tk = F.tid >> 4, e0 = (F.tid & 15) * 2; float q = 0.f, s0 = 0.f, s1 = 0.f;
#pragma unroll
          for (int w = 0; w < 8; ++w) { q += SSQ[w * 32 + tk]; s0 += PART[(w * 32 + tk) * 33 + e0]; s1 += PART[(w * 32 + tk) * 33 + e0 + 1]; }
          const float rstd = 1.0f / sqrtf(q * (1.0f / D) + EPS);
          LG[tk * 33 + e0] = rstd * s0 + RCV[e0]; LG[tk * 33 + e0 + 1] = rstd * s1 + RCV[e0 + 1]; }
        __syncthreads();
        { const int tk = F.tid >> 4, e0 = (F.tid & 15) * 2; const LAS float* lg = LG + tk * 33; const float l0 = lg[e0], l1 = lg[e0 + 1]; int rk0 = 0, rk1 = 0;
#pragma unroll 8
          for (int j = 0; j < NE; ++j) { const float o = lg[j]; rk0 += (o > l0 || (o == l0 && j < e0)) ? 1 : 0; rk1 += (o > l1 || (o == l1 && j < e0 + 1)) ? 1 : 0; }
          if (rk0 < 4) { F.MISC[MW_SELE + tk * 4 + rk0] = (unsigned)e0; F.MISC[MW_SELV + tk * 4 + rk0] = __float_as_uint(l0); }
          if (rk1 < 4) { F.MISC[MW_SELE + tk * 4 + rk1] = (unsigned)(e0 + 1); F.MISC[MW_SELV + tk * 4 + rk1] = __float_as_uint(l1); } }
        __syncthreads();
        int my = 0, lrk = 0;
        if (F.wave < 2) { const int a = F.tid; my = (int)F.MISC[MW_SELE + a];
            { const float vk = __uint_as_float(F.MISC[MW_SELV + a]), v0 = __uint_as_float(F.MISC[MW_SELV + (a & ~3)]);
              const float ex = __expf(vk - v0); float sm = ex; sm += shx(sm, 1, F.lane); sm += shx(sm, 2, F.lane);
              const size_t idx = ((size_t)r0 + (a >> 2)) * 4 + (a & 3); TG[idx] = ex / sm; TE[idx] = my; }
            unsigned cm = 0;
#pragma unroll 2
            for (int e = 0; e < NE; ++e) { const unsigned long long m = __ballot(my == e); const unsigned pc = (unsigned)__popcll(m);
                if (my == e) lrk = (int)__builtin_amdgcn_mbcnt_hi((unsigned)(m >> 32), __builtin_amdgcn_mbcnt_lo((unsigned)m, 0u)); if (F.lane == e) cm = pc; }
            if (F.lane < NE) CW[F.wave * 32 + F.lane] = cm; }
        __syncthreads();
        if (F.wave < 2) { const int a = F.tid; const int brank = (int)RUN[my] + lrk + (F.wave == 1 ? (int)CW[my] : 0); TRL[n * 128 + a] = (my << 16) | brank; }
        __syncthreads();
        if (F.tid < NE) RUN[F.tid] += CW[F.tid] + CW[32 + F.tid];
    }
    VM_WAIT(); __syncthreads();
    if (F.tid < NE) { const unsigned cnt = RUN[F.tid]; unsigned base = 0;
        if (cnt) base = __hip_atomic_fetch_add(F.ctl + CW_CNT + (real ? layer : NLAYER) * NE + F.tid, cnt, RLX_AGENT);
        F.MISC[MW_LBASE + F.tid] = base; }
    __syncthreads();
    if (real) for (int n = F.tid >> 7; n < ncnt; n += 4) { const int r0 = RT_TILE(n) * 32, a = F.tid & 127;
        const int v = TRL[n * 128 + a], e = v >> 16, rank = (v & 0xffff) + (int)F.MISC[MW_LBASE + e]; const size_t idx = ((size_t)r0 + (a >> 2)) * 4 + (a & 3);
        TR[idx] = rank; ROWTOK[(size_t)e * MT + rank] = r0 + (a >> 2); }
    __syncthreads();
#undef RT_LOADX
#undef RT_TILE
}

__device__ __forceinline__ void normrope16(float (&x)[16], const float* gain, bool lat, int prow, int pcol, const LAS f32x2* T, int L, float oscale, int lane) {
    float ss = 0.f;
#pragma unroll
    for (int i = 0; i < 16; ++i) ss += x[i] * x[i];
    ss += shx(ss, 1, lane); ss += shx(ss, 2, lane); ss += shx(ss, 4, lane);
    const float rstd = 1.0f / sqrtf(ss * (1.0f / 128.0f) + EPS);
    const int o = (L & 7) * 16;
#pragma unroll
    for (int i = 0; i < 16; ++i) x[i] = x[i] * rstd * gain[o + i];
    float p[16];
#pragma unroll
    for (int i = 0; i < 16; ++i) p[i] = shx(x[i], 2, lane);
    if (lat) {
        const int pos = (L & 4) ? pcol : prow; const float sgn = (L & 2) ? 1.0f : -1.0f; const LAS f32x2* t = T + pos * 32 + (L & 1) * 16;
#pragma unroll
        for (int i = 0; i < 16; ++i) { const f32x2 cs = t[i]; x[i] = x[i] * cs.x + sgn * p[i] * cs.y; }
    }
#pragma unroll
    for (int i = 0; i < 16; ++i) x[i] *= oscale;
}
__device__ __forceinline__ void qkprep_phase(Frame& F, int j) {
    LAS f32x2* T = (LAS f32x2*)F.lds;
    __syncthreads();
    for (int i = F.tid; i < 128 * 32; i += NTHREADS) { const int pos = i >> 5, f = i & 31; const float inv = powf(10000.0f, -(float)f / 32.0f); const float ang = (float)pos * inv; float s, c; sincosf(ang, &s, &c); T[i] = (f32x2){c, s}; }
    __syncthreads();
    const bf16* P = (const bf16*)(F.ws + WS_P); unsigned char* Q8 = (unsigned char*)(F.ws + WS_QB); unsigned char* K8 = (unsigned char*)(F.ws + WS_QB + WS_K8_OFF); unsigned char* VT8 = (unsigned char*)(F.ws + WS_KVB);
    const float* qg = PIN(F, I_AQG) + j * 128; const float* kg = PIN(F, I_AKG) + j * 128;
    if (F.bx == 0 && F.tid == 0) { float qm = 0.f, km = 0.f; for (int i = 0; i < 128; ++i) { qm = fmaxf(qm, fabsf(qg[i])); km = fmaxf(km, fabsf(kg[i])); }
        const float sig = att::SCALE * 1.4426950408889634f * 11.3137085f * qm * km;
        ((float*)(F.ws + WS_RC))[2048 + j] = -fminf(-2.0f, 8.0f - 7.0f * sig); }
    const int gw = F.bx * NWAVES + F.wave, NGW = F.G * NWAVES, L = F.lane;
#define QK_UNPACK(x, a, c) do { x[0] = bflo(a.x); x[1] = bfhi(a.x); x[2] = bflo(a.y); x[3] = bfhi(a.y); x[4] = bflo(a.z); x[5] = bfhi(a.z); x[6] = bflo(a.w); x[7] = bfhi(a.w); \
        x[8] = bflo(c.x); x[9] = bfhi(c.x); x[10] = bflo(c.y); x[11] = bfhi(c.y); x[12] = bflo(c.z); x[13] = bfhi(c.z); x[14] = bflo(c.w); x[15] = bfhi(c.w); } while (0)
#define QK_PACK(o, x) do { _Pragma("unroll") for (int w4 = 0; w4 < 4; ++w4) { unsigned w = 0; w = __builtin_amdgcn_cvt_pk_fp8_f32(x[4 * w4], x[4 * w4 + 1], w, false); w = __builtin_amdgcn_cvt_pk_fp8_f32(x[4 * w4 + 2], x[4 * w4 + 3], w, true); o[w4] = w; } } while (0)
    const float qscale = att::SCALE * 1.4426950408889634f * 8.0f;
    int rfirst = gw;
    if (F.G * NWAVES * 32 == ML) {
        v4u nq[4][2], nk[2];
#define QK4_LOAD(it_) do { _Pragma("unroll") for (int k = 0; k < 4; ++k) { const bf16* pr_ = P + (size_t)(gw + (4 * (it_) + k) * NGW) * 1536 + 16 * L; nq[k][0] = *(const v4u*)pr_; nq[k][1] = *(const v4u*)(pr_ + 8); } \
        { const bf16* pk_ = P + (size_t)(gw + (4 * (it_) + (L >> 4)) * NGW) * 1536 + 1024 + 16 * (L & 15); nk[0] = *(const v4u*)pk_; nk[1] = *(const v4u*)(pk_ + 8); } } while (0)
        QK4_LOAD(0);
#pragma unroll 1
        for (int it = 0; it < 8; ++it) {
            v4u q[4][2], kk[2];
#pragma unroll
            for (int k = 0; k < 4; ++k) { q[k][0] = nq[k][0]; q[k][1] = nq[k][1]; }
            kk[0] = nk[0]; kk[1] = nk[1];
            if (it + 1 < 8) QK4_LOAD(it + 1);
#pragma unroll
            for (int k = 0; k < 4; ++k) { const int r = gw + (4 * it + k) * NGW, s = r & (SEQ - 1); float x[16];
                QK_UNPACK(x, q[k][0], q[k][1]);
                normrope16(x, qg, true, s >> 6, s & 63, T, L, qscale, L);
                v4u o; QK_PACK(o, x); *(v4u*)(Q8 + (size_t)r * D + 16 * L) = o; }
            { const int r = gw + (4 * it + (L >> 4)) * NGW, s = r & (SEQ - 1), Lk = L & 15; float x[16];
              QK_UNPACK(x, kk[0], kk[1]);
              normrope16(x, kg, true, s >> 6, s & 63, T, Lk, 1.0f, L);
              v4u o; QK_PACK(o, x); *(v4u*)(K8 + ((size_t)(r >> 13) * SKV + s) * 256 + 16 * Lk) = o; }
        }
#undef QK4_LOAD
        rfirst = gw + 32 * NGW;
    }
    v4u nqa, nqc, nka, nkc;
#define QK_LOAD(r_) do { const bf16* pr_ = P + (size_t)(r_) * 1536; nqa = *(const v4u*)(pr_ + 16 * L); nqc = *(const v4u*)(pr_ + 16 * L + 8); nka = *(const v4u*)(pr_ + 1024 + 16 * (L & 15)); nkc = *(const v4u*)(pr_ + 1024 + 16 * (L & 15) + 8); } while (0)
    if (rfirst < MT) QK_LOAD(rfirst);
    for (int r = rfirst; r < MT; r += NGW) {
        const v4u qa_ = nqa, qc_ = nqc, ka_ = nka, kc_ = nkc;
        if (r + NGW < MT) QK_LOAD(r + NGW);
        const bool lat = r < ML; const int b = lat ? (r >> 13) : ((r - ML) >> 8); const int s = lat ? (r & (SEQ - 1)) : ((r - ML) & (CL - 1));
        const int prow = s >> 6, pcol = s & 63; const size_t kvrow = (size_t)b * SKV + (lat ? s : SEQ + s);
        { float x[16]; QK_UNPACK(x, qa_, qc_);
          normrope16(x, qg, lat, prow, pcol, T, L, qscale, L);
          v4u o; QK_PACK(o, x); *(v4u*)(Q8 + (size_t)r * D + 16 * L) = o; }
        { const int Lk = L & 15; float x[16]; QK_UNPACK(x, ka_, kc_);
          normrope16(x, kg, lat, prow, pcol, T, Lk, 1.0f, L);
          if (L < 16) { v4u o; QK_PACK(o, x); *(v4u*)(K8 + kvrow * 256 + 16 * L) = o; } }
    }
#undef QK_LOAD
#undef QK_UNPACK
#undef QK_PACK
    LAS unsigned char* Tt = F.lds + 32768;
    for (int tile = F.bx; tile < NB * (SKV / 64); tile += F.G) {
        const int b = tile / (SKV / 64), kb = tile % (SKV / 64), ki = F.tid >> 3, seg = F.tid & 7, pos = kb * 64 + ki;
        const size_t r = pos < SEQ ? (size_t)b * SEQ + pos : (size_t)ML + (size_t)b * CL + (pos - SEQ);
        const int k5 = ki & 31, slot = 32 * ((k5 >> 2) & 1) + ((k5 & 3) | ((k5 >> 3) << 2)) + (ki >= 32 ? 16 : 0);
        const v4u* src = (const v4u*)(P + r * 1536 + 1280 + 32 * seg);
        __syncthreads();
#pragma unroll
        for (int q = 0; q < 4; ++q) { const v4u w = src[q]; const unsigned ww[4] = {w.x, w.y, w.z, w.w};
#pragma unroll
            for (int e2 = 0; e2 < 4; ++e2) { const unsigned pk = __builtin_amdgcn_cvt_pk_fp8_f32(bflo(ww[e2]), bfhi(ww[e2]), 0u, false); const int dd = 32 * seg + 8 * q + 2 * e2;
                Tt[dd * 64 + slot] = (unsigned char)(pk & 0xff); Tt[(dd + 1) * 64 + slot] = (unsigned char)((pk >> 8) & 0xff); } }
        __syncthreads();
        { const int rho = F.tid >> 1, half = F.tid & 1; const v4u a = *(const LAS v4u*)(Tt + rho * 64 + 32 * half), c = *(const LAS v4u*)(Tt + rho * 64 + 32 * half + 16);
          unsigned char* dst = VT8 + ((size_t)(b * 2 + (rho >> 7)) * 128 + (rho & 127)) * SKV + kb * 64 + 32 * half;
          *(v4u*)dst = a; *(v4u*)(dst + 16) = c; }
    }
    __syncthreads();
}
template <int XV = 0>
__device__ __forceinline__ void attention_phase(Frame& F, char* lds_generic, bool ctx_queries, int j) {
    const float nb = -((const float*)(F.ws + WS_RC))[2048 + j] - 8.0f;
    const unsigned char* Q8 = (const unsigned char*)(F.ws + WS_QB); const unsigned char* K8 = (const unsigned char*)(F.ws + WS_QB + WS_K8_OFF); const unsigned char* VT8 = (const unsigned char*)(F.ws + WS_KVB); bf16* Y = (bf16*)(F.ws + WS_Y);
    const int nunits = 2048 + (ctx_queries ? 64 : 0);
    for (int u = F.bx; u < nunits; u += F.G) {
        if (u < 2048) { const int b = u >> 8, w = u & 255, h = w & 7, qb = w >> 3; const size_t qo = ((size_t)b * SEQ + (size_t)qb * 256) * D + h * 128;
            att::attn_dense_body<XV>(Q8 + qo, K8 + (size_t)b * SKV * 256 + (h >> 2) * 128, VT8 + (size_t)(b * 2 + (h >> 2)) * 128 * SKV, SKV, Y + qo, SKV, lds_generic, F.wave, nb); }
        else { const int w = u - 2048, b = w >> 3, h = w & 7; const size_t qo = ((size_t)ML + (size_t)b * CL) * D + h * 128;
            att::attn_dense_body<XV>(Q8 + qo, K8 + ((size_t)b * SKV + SEQ) * 256 + (h >> 2) * 128, VT8 + (size_t)(b * 2 + (h >> 2)) * 128 * SKV + SEQ, SKV, Y + qo, CL, lds_generic, F.wave, nb); }
    }
}

__device__ __forceinline__ void gmlp_mix_phase(Frame& F) {
    constexpr int LDA = 136, LDO = 132;
    LAS bf16* As = (LAS bf16*)F.lds;
    LAS bf16* Vt = (LAS bf16*)(F.lds + 128 * LDA * 2);
    LAS float* rs = (LAS float*)(F.lds + 2 * 128 * LDA * 2);
    LAS float* Ot = (LAS float*)(F.lds + 2 * 128 * LDA * 2 + 512);
    const bf16* P = (const bf16*)(F.ws + WS_P); bf16* Y = (bf16*)(F.ws + WS_Y); const float* SS = (const float*)(F.ws + WS_SS);
    const float* ws = PIN(F, I_GWS); const float* bs = PIN(F, I_GBS); const float* vg = PIN(F, I_GVG);
    const int r32 = F.lane & 31, hi = F.lane >> 5;
    constexpr int NU = (MT / 128) * 8;
    struct GIn { f32x4 s; v4u v[4], uu[4]; } ga, gb; int gcur = -1;
#define GM_LOAD(u_, IN) do { const int g_ = (u_) & 7; const size_t row0_ = (size_t)((u_) >> 3) * 128; \
        IN.s = *(const f32x4*)(SS + (row0_ + (F.tid >> 2)) * 16 + (F.tid & 3) * 4);                                       \
        _Pragma("unroll") for (int k = 0; k < 4; ++k) { const int i_ = F.tid + NTHREADS * k, q_ = i_ >> 4, c8_ = (i_ & 15) * 8; const bf16* pp_ = P + (row0_ + q_) * 2048 + g_ * 128 + c8_; \
            IN.v[k] = *(const v4u*)(pp_ + 1024); IN.uu[k] = *(const v4u*)pp_; } } while (0)
#define GM_UNIT(u_, IN) do { \
        const int chunk = (u_) >> 3, g = (u_) & 7; const size_t row0 = (size_t)chunk * 128; \
        __syncthreads(); \
        if (g != gcur) { gcur = g; \
            for (int i = F.tid; i < 128 * 32; i += NTHREADS) { const int p = i >> 5, q4 = (i & 31) * 4; const f32x4 w = *(const f32x4*)(ws + ((size_t)g * 128 + p) * 128 + q4); \
                v2u o; o.x = pk2(w.x, w.y); o.y = pk2(w.z, w.w); *(LAS v2u*)(As + p * LDA + q4) = o; } } \
        { float s = (IN.s.x + IN.s.y) + (IN.s.z + IN.s.w); s += shx(s, 1, F.lane); s += shx(s, 2, F.lane); if ((F.tid & 3) == 0) rs[F.tid >> 2] = 1.0f / sqrtf(s * (1.0f / 1024.0f) + EPS); } \
        __syncthreads(); \
        _Pragma("unroll") for (int k = 0; k < 4; ++k) { const int i = F.tid + NTHREADS * k, q = i >> 4, c8 = (i & 15) * 8; const float rq = rs[q]; const unsigned ww[4] = {IN.v[k].x, IN.v[k].y, IN.v[k].z, IN.v[k].w}; \
            _Pragma("unroll") for (int e2 = 0; e2 < 4; ++e2) { const unsigned pk = cvt_pk_bf16(bflo(ww[e2]) * rq, bfhi(ww[e2]) * rq); Vt[(c8 + 2 * e2) * LDA + q] = (bf16)(pk & 0xffff); Vt[(c8 + 2 * e2 + 1) * LDA + q] = (bf16)(pk >> 16); } } \
        __syncthreads(); \
        const int p0 = (F.wave >> 1) * 32, cbase = (F.wave & 1) * 64; \
        f32x16 acc0 = {}, acc1 = {}; \
        _Pragma("unroll") for (int ks = 0; ks < 8; ++ks) { const int k0 = ks * 16 + hi * 8; \
            const bf16x8 a = *(const LAS bf16x8*)(As + (p0 + r32) * LDA + k0); \
            const bf16x8 b0 = *(const LAS bf16x8*)(Vt + (cbase + r32) * LDA + k0), b1 = *(const LAS bf16x8*)(Vt + (cbase + 32 + r32) * LDA + k0); \
            acc0 = __builtin_amdgcn_mfma_f32_32x32x16_bf16(a, b0, acc0, 0, 0, 0); acc1 = __builtin_amdgcn_mfma_f32_32x32x16_bf16(a, b1, acc1, 0, 0, 0); } \
        _Pragma("unroll") for (int t = 0; t < 2; ++t) { const int cl = cbase + t * 32 + r32; const float gain = vg[g * 128 + cl]; \
            _Pragma("unroll") for (int reg = 0; reg < 16; ++reg) { const int p = p0 + (reg & 3) + 8 * (reg >> 2) + 4 * hi; Ot[p * LDO + cl] = gain * (t == 0 ? acc0[reg] : acc1[reg]) + bs[g * 128 + p]; } } \
        __syncthreads(); \
        _Pragma("unroll") for (int k = 0; k < 4; ++k) { const int i = F.tid + NTHREADS * k, p = i >> 4, c8 = (i & 15) * 8; const v4u uw = IN.uu[k]; \
            const LAS float* o = Ot + p * LDO + c8; const f32x4 m0 = *(const LAS f32x4*)o, m1 = *(const LAS f32x4*)(o + 4); \
            v4u w; w.x = cvt_pk_bf16(bflo(uw.x) * m0.x, bfhi(uw.x) * m0.y); w.y = cvt_pk_bf16(bflo(uw.y) * m0.z, bfhi(uw.y) * m0.w); \
            w.z = cvt_pk_bf16(bflo(uw.z) * m1.x, bfhi(uw.z) * m1.y); w.w = cvt_pk_bf16(bflo(uw.w) * m1.z, bfhi(uw.w) * m1.w); \
            *(v4u*)(Y + (row0 + p) * D + g * 128 + c8) = w; } } while (0)
    int u = F.bx;
    if (u < NU) GM_LOAD(u, ga);
    for (; u < NU; u += 2 * F.G) {
        if (u + F.G < NU) GM_LOAD(u + F.G, gb);
        GM_UNIT(u, ga);
        if (u + F.G >= NU) break;
        if (u + 2 * F.G < NU) GM_LOAD(u + 2 * F.G, ga);
        GM_UNIT(u + F.G, gb);
    }
    __syncthreads();
#undef GM_LOAD
#undef GM_UNIT
}

__device__ __forceinline__ void hyena_prep_phase(Frame& F) {
    LAS float* tl = (LAS float*)F.lds;
    const bf16* P = (const bf16*)(F.ws + WS_P); bf16* X0 = (bf16*)(F.ws + WS_X0); bf16* VG = (bf16*)(F.ws + WS_VG);
    float* VT = (float*)(F.ws + WS_VT); float* VTC = (float*)(F.ws + WS_VTC);
    const float* cw = PIN(F, I_HCW); const float* cb = PIN(F, I_HCB);
    const int tt = F.tid >> 3, cg = F.tid & 7;
    constexpr int NU = (MT / 64) * 16;
    v4u pa[3][3], pb[3][3];
#define HP_LOAD(u_, IN) do { const int tb_ = (u_) >> 4, c0_ = ((u_) & 15) * 64, r0_ = tb_ * 64; const bool lat_ = r0_ < ML; \
        const int s_ = (lat_ ? (r0_ & (SEQ - 1)) : ((r0_ - ML) & (CL - 1))) + tt, L_ = lat_ ? SEQ : CL; const bf16* pr_ = P + (size_t)(r0_ + tt) * 3072 + c0_ + cg * 8; const v4u z0_ = {0u, 0u, 0u, 0u}; \
        _Pragma("unroll") for (int seg = 0; seg < 3; ++seg) { IN[seg][0] = s_ > 0 ? *(const v4u*)(pr_ + seg * 1024 - 3072) : z0_; IN[seg][1] = *(const v4u*)(pr_ + seg * 1024); \
            IN[seg][2] = s_ < L_ - 1 ? *(const v4u*)(pr_ + seg * 1024 + 3072) : z0_; } } while (0)
    LAS float* wl = tl + 64 * 65; int c0w = -1;
#define HP_UNIT(u_, IN) do { \
        const int tb = (u_) >> 4, c0 = ((u_) & 15) * 64; const int r0 = tb * 64; const bool lat = r0 < ML; \
        const int b = lat ? (r0 >> 13) : ((r0 - ML) >> 8), s0 = lat ? (r0 & (SEQ - 1)) : ((r0 - ML) & (CL - 1)); \
        const int r = r0 + tt, c = c0 + cg * 8; \
        if (c0 != c0w) { c0w = c0; __syncthreads(); \
            for (int i = F.tid; i < 768; i += NTHREADS) { const int seg = i >> 8, k = (i >> 6) & 3, ch = i & 63; wl[i] = k < 3 ? cw[k * 3072 + seg * 1024 + c0 + ch] : cb[seg * 1024 + c0 + ch]; } \
            __syncthreads(); } \
        float o[3][8]; \
        _Pragma("unroll") for (int seg = 0; seg < 3; ++seg) { \
            const unsigned pmw[4] = {IN[seg][0].x, IN[seg][0].y, IN[seg][0].z, IN[seg][0].w}, pcw[4] = {IN[seg][1].x, IN[seg][1].y, IN[seg][1].z, IN[seg][1].w}, pnw[4] = {IN[seg][2].x, IN[seg][2].y, IN[seg][2].z, IN[seg][2].w}; \
            _Pragma("unroll") for (int i = 0; i < 8; ++i) { const float xm = (i & 1) ? bfhi(pmw[i >> 1]) : bflo(pmw[i >> 1]), xc = (i & 1) ? bfhi(pcw[i >> 1]) : bflo(pcw[i >> 1]), xn = (i & 1) ? bfhi(pnw[i >> 1]) : bflo(pnw[i >> 1]); \
                const LAS float* wp = wl + seg * 256 + cg * 8 + i; o[seg][i] = xm * wp[0] + xc * wp[64] + xn * wp[128] + wp[192]; } } \
        float vgv[8]; \
        _Pragma("unroll") for (int i = 0; i < 8; ++i) vgv[i] = o[2][i] * o[1][i]; \
        v4u w; w.x = cvt_pk_bf16(o[0][0], o[0][1]); w.y = cvt_pk_bf16(o[0][2], o[0][3]); w.z = cvt_pk_bf16(o[0][4], o[0][5]); w.w = cvt_pk_bf16(o[0][6], o[0][7]); \
        *(v4u*)(X0 + (size_t)r * D + c) = w; \
        __syncthreads(); \
        _Pragma("unroll") for (int i = 0; i < 8; ++i) tl[(cg * 8 + i) * 65 + tt] = vgv[i]; \
        __syncthreads(); \
        { const int cc = F.tid >> 3, ts = (F.tid & 7) * 8; const LAS float* sp = tl + cc * 65 + ts; \
          if (lat) *(v4u*)((bf16*)VT + ((size_t)b * 1024 + c0 + cc) * SEQ + s0 + ts) = (v4u){cvt_pk_bf16(sp[0], sp[1]), cvt_pk_bf16(sp[2], sp[3]), cvt_pk_bf16(sp[4], sp[5]), cvt_pk_bf16(sp[6], sp[7])};        \
          else { float* dst = VTC + ((size_t)b * 1024 + c0 + cc) * CL + s0 + ts; *(f32x4*)dst = (f32x4){sp[0], sp[1], sp[2], sp[3]}; *(f32x4*)(dst + 4) = (f32x4){sp[4], sp[5], sp[6], sp[7]}; } } } while (0)
    int u = F.bx;
    if (u < NU) HP_LOAD(u, pa);
    for (; u < NU; u += 2 * F.G) {
        if (u + F.G < NU) HP_LOAD(u + F.G, pb);
        HP_UNIT(u, pa);
        if (u + F.G >= NU) break;
        if (u + 2 * F.G < NU) HP_LOAD(u + 2 * F.G, pa);
        HP_UNIT(u + F.G, pb);
    }
    __syncthreads();
#undef HP_LOAD
#undef HP_UNIT
}
__device__ __forceinline__ void hyena_post_phase(Frame& F) {
    LAS float* tl = (LAS float*)F.lds;
    const bf16* X0 = (const bf16*)(F.ws + WS_X0); const bf16* VG = (const bf16*)(F.ws + WS_VG); bf16* Y = (bf16*)(F.ws + WS_Y);
    const float* VT = (const float*)(F.ws + WS_CT); const float* VTC = (const float*)(F.ws + WS_CTC); const float* dsk = PIN(F, I_HD);
    const int tt = F.tid >> 3, cg = F.tid & 7;
    constexpr int NU = (MT / 64) * 16;
    struct PIn { f32x4 a, bq; v4u cw, x0; } qa, qb;
#define HQ_LOAD(u_, IN) do { const int tb_ = (u_) >> 4, c0_ = ((u_) & 15) * 64, r0_ = tb_ * 64; const bool lat_ = r0_ < ML; \
        const int b_ = lat_ ? (r0_ >> 13) : ((r0_ - ML) >> 8), s0_ = lat_ ? (r0_ & (SEQ - 1)) : ((r0_ - ML) & (CL - 1)); const int cc_ = F.tid >> 3, ts_ = (F.tid & 7) * 8; \
        if (lat_) IN.cw = *(const v4u*)((const bf16*)VT + ((size_t)b_ * 1024 + c0_ + cc_) * SEQ + s0_ + ts_);        \
        else { const float* src_ = VTC + ((size_t)b_ * 1024 + c0_ + cc_) * CL + s0_ + ts_; IN.a = *(const f32x4*)src_; IN.bq = *(const f32x4*)(src_ + 4); } \
        IN.x0 = *(const v4u*)(X0 + (size_t)(r0_ + tt) * D + c0_ + cg * 8); } while (0)
#define HQ_UNIT(u_, IN) do { \
        const int tb = (u_) >> 4, c0 = ((u_) & 15) * 64; const int r0 = tb * 64; \
        __syncthreads(); \
        { const int cc = F.tid >> 3, ts = (F.tid & 7) * 8; LAS float* dp = tl + cc * 65 + ts; \
          if (r0 < ML) { dp[0] = bflo(IN.cw.x); dp[1] = bfhi(IN.cw.x); dp[2] = bflo(IN.cw.y); dp[3] = bfhi(IN.cw.y); dp[4] = bflo(IN.cw.z); dp[5] = bfhi(IN.cw.z); dp[6] = bflo(IN.cw.w); dp[7] = bfhi(IN.cw.w); } \
          else { dp[0] = IN.a.x; dp[1] = IN.a.y; dp[2] = IN.a.z; dp[3] = IN.a.w; dp[4] = IN.bq.x; dp[5] = IN.bq.y; dp[6] = IN.bq.z; dp[7] = IN.bq.w; } } \
        __syncthreads(); \
        const int r = r0 + tt, c = c0 + cg * 8; \
        const unsigned x0w[4] = {IN.x0.x, IN.x0.y, IN.x0.z, IN.x0.w}; float y[8]; \
        _Pragma("unroll") for (int i = 0; i < 8; ++i) { const float xx = (i & 1) ? bfhi(x0w[i >> 1]) : bflo(x0w[i >> 1]); y[i] = tl[(cg * 8 + i) * 65 + tt] * xx; }        \
        v4u w; w.x = cvt_pk_bf16(y[0], y[1]); w.y = cvt_pk_bf16(y[2], y[3]); w.z = cvt_pk_bf16(y[4], y[5]); w.w = cvt_pk_bf16(y[6], y[7]); \
        *(v4u*)(Y + (size_t)r * D + c) = w; } while (0)
    int u = F.bx;
    if (u < NU) HQ_LOAD(u, qa);
    for (; u < NU; u += 2 * F.G) {
        if (u + F.G < NU) HQ_LOAD(u + F.G, qb);
        HQ_UNIT(u, qa);
        if (u + F.G >= NU) break;
        if (u + 2 * F.G < NU) HQ_LOAD(u + 2 * F.G, qa);
        HQ_UNIT(u + F.G, qb);
    }
    __syncthreads();
#undef HQ_LOAD
#undef HQ_UNIT
}
__device__ __forceinline__ bool phase_nonempty(int ph) {
    if (ph < PH_L0 || ph >= PH_FINAL) return true;
    const int layer = (ph - PH_L0) / PH_PER_LAYER, lp = (ph - PH_L0) % PH_PER_LAYER, kind = layer % 3;
    if (lp == LP_MIX2) return kind != 1;
    if (lp == LP_MIX3) return kind == 2;
    return true;
}
__global__ void __launch_bounds__(NTHREADS, 2) mk_fwd(Args args) {
    extern __shared__ __attribute__((aligned(16))) unsigned char lds[];
    Frame F0;
    F0.lds = (LAS unsigned char*)lds; F0.MISC = (volatile LAS unsigned*)(F0.lds + MISC_OFF);
    F0.tid = threadIdx.x; F0.lane = F0.tid & 63; F0.wave = __builtin_amdgcn_readfirstlane(F0.tid >> 6);
    F0.G = gridDim.x; F0.bx = blockIdx.x; F0.out = args.out; F0.ws = args.ws; F0.ctl = (gu32*)(args.ws + WS_CTL);
    for (int u = F0.tid; u < MISC_BYTES / 4; u += NTHREADS) F0.MISC[u] = 0u;
    __syncthreads();
    if (F0.tid < 36) { const unsigned long long p = (unsigned long long)args.in[F0.tid]; F0.MISC[MW_PTRS + 2 * F0.tid] = (unsigned)p; F0.MISC[MW_PTRS + 2 * F0.tid + 1] = (unsigned)(p >> 32); }
    __syncthreads();
    const int lo = args.ph_lo, hi = args.ph_hi;
    const bool multi = (hi - lo) > 1;
    XcdBarrier bar; bar.bar = (unsigned*)(F0.ctl + CW_BAR); bar.x = 0; bar.st = nullptr; bar.w = F0.wave;
    if (multi) bar = xcd_barrier_post((unsigned*)(F0.ctl + CW_BAR), F0.MISC + 8, F0.wave);
#ifndef PHMASK
#define PHMASK 0xFFFF
#endif
#define EN(b) ((PHMASK >> (b)) & 1)
#ifndef MK_STAG_IN
#define MK_STAG_IN 0u
#define MK_STAG_OUT 0u
#define MK_STAG_M1 0u
#define MK_STAG_M2 0u
#endif
#ifndef KMASK
#define KMASK 7
#endif
#define KEN(b) ((KMASK >> (b)) & 1)
#define IN(k) (lo <= (k) && (k) < hi)
#define SEAM(k) do { if ((k) + 1 < hi) xcd_barrier(bar); } while (0)
#define PB(id) for (int _rep = 0, _n = ((id) == MK_REPEAT ? MK_NREP : 1); _rep < _n; ++_rep) {
#define PE(id) if (_rep + 1 < _n) xcd_barrier(bar); } SEAM(id);

    if (EN(0) && IN(PH_PRO0)) { PB(PH_PRO0) Frame F = phase_frame(F0); pro0_mod(F); __syncthreads(); pro0_transposes(F); pro0_filter_mlp(F); PE(PH_PRO0) }
    if (EN(1) && IN(PH_PRO1)) { PB(PH_PRO1) Frame F = phase_frame(F0); pro1_router_split(F); pro1_filters(F); PE(PH_PRO1) }

#pragma unroll 1
    for (int layer = 0; layer < NLAYER; ++layer) {
        const int kind = layer % 3, jj = layer / 3, pb = PH_L0 + layer * PH_PER_LAYER; const bool last = layer == NLAYER - 1;
        if (EN(2) && IN(pb + LP_NORM1)) { PB(pb + LP_NORM1) Frame F = phase_frame(F0); rowpass<0>(F, layer, _rep + 1 == _n, kind != 1); PE(pb + LP_NORM1) }
        if (EN(3) && IN(pb + LP_INPROJ)) { PB(pb + LP_INPROJ)
            Frame F = phase_frame(F0);
            if (kind != 1) {
                const int N = kind == 0 ? 1536 : 3072;
                pg8::DenseSchedT<true> S; S.init(F.ws + WS_H8, kind == 0 ? F.ws + WS_WATT + (size_t)jj * 1536 * 1024 : F.ws + WS_WHY, MT, N, F.G, F.bx, 1024);
                pg8::EpiBf16 E{(bf16*)(F.ws + WS_P), N, (float*)(F.ws + WS_SS), 0};
                pg8::gemm_phase<pg8::EpiBf16, pg8::DenseSchedT<true>, true, true>(F.lds, S, E, F.wave, false, MK_STAG_IN);
            } else {
                const int N = 2048;
                pg8::DenseSched S; S.init(F.ws + WS_H, F.ws + WS_WGM, MT, N, F.G, F.bx);
                pg8::EpiBf16 E{(bf16*)(F.ws + WS_P), N, (float*)(F.ws + WS_SS), 1};
                pg8::gemm_phase<pg8::EpiBf16, pg8::DenseSched, false>(F.lds, S, E, F.wave, false, MK_STAG_IN);
            }
            PE(pb + LP_INPROJ)
        }
        if (IN(pb + LP_MIX1)) { PB(pb + LP_MIX1)
            Frame F = phase_frame(F0);
            if (EN(4) && kind == 0) qkprep_phase(F, jj); else if (EN(5) && kind == 1) gmlp_mix_phase(F); else if (EN(6)) hyena_prep_phase(F);
            PE(pb + LP_MIX1)
        }
        if (IN(pb + LP_MIX2) && kind != 1) { PB(pb + LP_MIX2)
            Frame F = phase_frame(F0);
            if (EN(7) && kind == 0) {
#if MK_XP >= 10 && MK_XP < 20
                if (_rep + 1 < _n) attention_phase<MK_XP - 10>(F, (char*)lds, !last, jj); else
#endif
                attention_phase<0>(F, (char*)lds, !last, jj); }
            else if (EN(8)) hyena_conv_phase(F);
            PE(pb + LP_MIX2)
        }
        if (EN(9) && IN(pb + LP_MIX3) && kind == 2) { PB(pb + LP_MIX3) Frame F = phase_frame(F0); hyena_post_phase(F); PE(pb + LP_MIX3) }
        if (EN(10) && IN(pb + LP_OUTPROJ)) { PB(pb + LP_OUTPROJ)
            Frame F = phase_frame(F0); const float* modl = (const float*)(F.ws + WS_MOD) + (size_t)layer * 9 * 6144;
            pg8::DenseSched S; S.init(F.ws + WS_Y, F.ws + WS_WOUT + (size_t)layer * 1024 * 1024 * 2, last ? ML : MT, 1024, F.G, F.bx);
            pg8::EpiResid E{(bf16*)(F.ws + WS_XB), modl};
            pg8::gemm_phase<pg8::EpiResid, pg8::DenseSched, false>(F.lds, S, E, F.wave, false, MK_STAG_OUT);
            PE(pb + LP_OUTPROJ)
        }
        if (EN(11) && IN(pb + LP_NORM2)) { PB(pb + LP_NORM2) Frame F = phase_frame(F0); router_phase(F, layer, _rep + 1 == _n, (_rep + 1 < _n) ? MK_XP : 0); PE(pb + LP_NORM2) }
        if (EN(12) && IN(pb + LP_MOE1)) { PB(pb + LP_MOE1)
            Frame F = phase_frame(F0);
            moe_tables(F, layer);
            pg8::MoeSched S{(const char*)(F.ws + WS_H8), (const char*)(F.ws + WS_WE1) + (size_t)layer * NE * 2048 * 1024, (size_t)2048 * 1024, (const int*)(F.ws + WS_ROWTOK),
                            (const volatile LAS int*)(F.MISC + MW_CUMBLK), (const volatile LAS int*)(F.MISC + MW_CNT), 3, F.G, F.bx, 1024, (const volatile LAS int*)(F.lds + AUX_OFF + 1024)};
            S.build_list((volatile LAS int*)(F.lds + AUX_OFF + 1024), F.tid); __syncthreads();
            pg8::EpiSwiglu E{(unsigned char*)(F.ws + WS_ACT), PIN(F, I_EB1) + (size_t)layer * NE * 2048, (LAS float*)(F.lds + AUX_OFF)};
#if MK_XP >= 20
            if (_rep + 1 < _n) { int one_ = 1; asm volatile("" : "+s"(one_)); pg8::gemm_phase<pg8::EpiSwiglu, pg8::MoeSched, true, true, MK_XP - 20>(F.lds, S, E, F.wave, one_ != 0, MK_STAG_M1); } else
#endif
            pg8::gemm_phase<pg8::EpiSwiglu, pg8::MoeSched, true, true>(F.lds, S, E, F.wave, MK_XP == 1 && _rep + 1 < _n, MK_STAG_M1);
            PE(pb + LP_MOE1)
        }
        if (EN(13) && IN(pb + LP_MOE2)) { PB(pb + LP_MOE2)
            Frame F = phase_frame(F0);
            moe_tables(F, layer);
            pg8::MoeSched S{(const char*)(F.ws + WS_ACT), (const char*)(F.ws + WS_WE2) + (size_t)layer * NE * 1024 * 1024, (size_t)1024 * 1024, nullptr,
                            (const volatile LAS int*)(F.MISC + MW_CUMBLK), (const volatile LAS int*)(F.MISC + MW_CNT), 2, F.G, F.bx, 1024, (const volatile LAS int*)(F.lds + AUX_OFF + 1024)};
            S.build_list((volatile LAS int*)(F.lds + AUX_OFF + 1024), F.tid); __syncthreads();
            pg8::EpiBias E{(unsigned char*)(F.ws + WS_YM), PIN(F, I_EB2) + (size_t)layer * NE * 1024, (LAS float*)(F.lds + AUX_OFF)};
            pg8::gemm_phase<pg8::EpiBias, pg8::MoeSched, true, true>(F.lds, S, E, F.wave, MK_XP == 1 && _rep + 1 < _n, MK_STAG_M2);
            PE(pb + LP_MOE2)
        }
    }
    if (EN(14) && IN(PH_FINAL)) { PB(PH_FINAL) Frame F = phase_frame(F0); rowpass<2>(F, NLAYER - 1, _rep + 1 == _n); PE(PH_FINAL) }
#undef IN
#undef SEAM
}

static bool host_phase_nonempty(int ph) {
    if (ph < PH_L0 || ph >= PH_FINAL) return true;
    const int layer = (ph - PH_L0) / PH_PER_LAYER, lp = (ph - PH_L0) % PH_PER_LAYER, kind = layer % 3;
    if (lp == LP_MIX2) return kind != 1;
    if (lp == LP_MIX3) return kind == 2;
    return true;
}
extern "C" void kernel_launch(void* const* d_in, const int* in_sizes, int n_in, void* d_out, int out_size, void* d_ws, size_t ws_size, hipStream_t stream) {
    static int grid = 0;
    if (grid == 0) {
        if (n_in != 36 || in_sizes[0] != ML * D || out_size != ML * D || ws_size < WS_END) {
            fprintf(stderr, "kernel_launch: built for 36 inputs, x/out of %d floats, >= %zu bytes of workspace; got n_in %d in0 %d out %d ws %zu; nothing launched\n", ML * D, (size_t)WS_END, n_in, n_in > 0 ? in_sizes[0] : -1, out_size, ws_size);
            grid = -1; return; }
        int dev = 0, cus = 0, per_cu = 0;
        if (hipGetDevice(&dev) != hipSuccess || hipDeviceGetAttribute(&cus, hipDeviceAttributeMultiprocessorCount, dev) != hipSuccess) { fprintf(stderr, "kernel_launch: device query failed\n"); grid = -1; return; }
        if (hipFuncSetAttribute((const void*)mk_fwd, hipFuncAttributeMaxDynamicSharedMemorySize, LDS_BYTES) != hipSuccess) { fprintf(stderr, "kernel_launch: hipFuncSetAttribute(%d B LDS) failed\n", LDS_BYTES); grid = -1; return; }
        if (hipOccupancyMaxActiveBlocksPerMultiprocessor(&per_cu, (const void*)mk_fwd, NTHREADS, LDS_BYTES) != hipSuccess || per_cu < 1)
            fprintf(stderr, "kernel_launch: note: occupancy query reports %d workgroups per CU\n", per_cu);
        (void)hipGetLastError();
        grid = cus;
    }
    if (grid < 0) return;
    if (hipMemsetAsync((char*)d_ws + WS_CTL, 0, CTL_ZERO_BYTES, stream) != hipSuccess) { fprintf(stderr, "kernel_launch: memset failed\n"); return; }
    Args a{};
    for (int i = 0; i < 36; ++i) a.in[i] = (const float*)d_in[i];
    a.out = (float*)d_out; a.ws = (unsigned char*)d_ws;
#if MK_MULTI || MK_DBG
    for (int ph = 0; ph < PH_COUNT; ++ph) {
        if (!host_phase_nonempty(ph)) continue;
        a.ph_lo = ph; a.ph_hi = ph + 1;
        hipLaunchKernelGGL(mk_fwd, dim3(grid), dim3(NTHREADS), LDS_BYTES, stream, a);
#if MK_DBG
        dbg_after_phase(ph, a, stream);
#endif
    }
#if MK_DBG
    dbg_report(a, stream);
#endif
#else
    a.ph_lo = 0; a.ph_hi = PH_COUNT;
    hipLaunchKernelGGL(mk_fwd, dim3(grid), dim3(NTHREADS), LDS_BYTES, stream, a);
#endif
    const hipError_t le = hipPeekAtLastError();
    if (le != hipSuccess) fprintf(stderr, "kernel_launch: launch failed: %s\n", hipGetErrorName(le));
}
```

```cpp
#include <hip/hip_runtime.h>
#include <cstdio>
#include <cstdint>
#include <cmath>

#ifndef MK_MULTI
#define MK_MULTI 0
#endif
#ifndef MK_REPEAT
#define MK_REPEAT -1
#endif
#ifndef MK_NREP
#define MK_NREP 1
#endif
#ifndef MK_XP
#define MK_XP 0
#endif
#ifndef MK_MOEMAP
#define MK_MOEMAP 0
#endif
#ifndef MK_DBG
#define MK_DBG 0
#endif

constexpr int D = 1024, NB = 8, SEQ = 8192, CL = 256, ML = NB * SEQ, MC = NB * CL, MT = ML + MC;
constexpr int NLAYER = 4, NE = 32, TOPK = 4, SKV = SEQ + CL;
constexpr int MOE_MAXBLK = (MT * TOPK) / 256 + NE;
constexpr float EPS = 1e-6f;
constexpr int FH = 64, FEMB = 33, NFFT = 16384;

constexpr size_t MiB = 1u << 20;
constexpr size_t WS_CTL = 0, CTL_ZERO_BYTES = 1 * MiB;
constexpr size_t WS_MOD = 1 * MiB;
constexpr size_t WS_A3 = 2 * MiB;
constexpr size_t WS_A3C = 4 * MiB;
constexpr size_t WS_RC = 4 * MiB + 512 * 1024;
constexpr size_t WS_FCT = 5 * MiB;
constexpr size_t WS_WATT = 8 * MiB;
constexpr size_t WS_WGM = 14 * MiB;
constexpr size_t WS_WHY = 18 * MiB;
constexpr size_t WS_WOUT = 24 * MiB;
constexpr size_t WS_RW3 = 32 * MiB;
constexpr size_t WS_TE = 40 * MiB;
constexpr size_t WS_TR = 42 * MiB;
constexpr size_t WS_TG = 44 * MiB;
constexpr size_t WS_SS = 46 * MiB;
constexpr size_t WS_ROWTOK = 52 * MiB;
constexpr size_t WS_KF = 64 * MiB;
constexpr size_t WS_WE1 = 192 * MiB;
constexpr size_t WS_WE2 = 704 * MiB;
constexpr size_t WS_H = 960 * MiB;
constexpr size_t WS_P = 1092 * MiB;
constexpr size_t WS_Y = 1488 * MiB;
constexpr size_t WS_QB = 1620 * MiB;
constexpr size_t WS_K8_OFF = 72 * MiB;
constexpr size_t WS_KVB = 1752 * MiB;
constexpr size_t WS_X0 = 1818 * MiB;
constexpr size_t WS_VG = 1950 * MiB;
constexpr size_t WS_VT = 2082 * MiB;
constexpr size_t WS_VTC = 2338 * MiB;
constexpr size_t WS_ACT = 2346 * MiB;
constexpr size_t WS_YM = 2890 * MiB;
constexpr size_t WS_CT = 3434 * MiB;
constexpr size_t WS_CTC = 3690 * MiB;
constexpr size_t WS_H8 = 3698 * MiB;
constexpr size_t WS_XB = 3764 * MiB;
constexpr size_t WS_END = 3896 * MiB;
constexpr int CW_BAR = 4096;
constexpr int CW_CNT = 16384;
constexpr int CW_DBG = 32768;

constexpr int RING_BYTES = 131072;
constexpr int AUX_OFF = RING_BYTES;
constexpr int AUX_BYTES = 16384;
constexpr int MISC_OFF = AUX_OFF + AUX_BYTES;
constexpr int MISC_BYTES = 4096;
constexpr int LDS_BYTES = MISC_OFF + MISC_BYTES;

#define GAS __attribute__((address_space(1)))
#define LAS __attribute__((address_space(3)))
typedef unsigned short bf16;
typedef unsigned v4u __attribute__((ext_vector_type(4)));
typedef unsigned v2u __attribute__((ext_vector_type(2)));
typedef float f32x4 __attribute__((ext_vector_type(4)));
typedef float f32x2 __attribute__((ext_vector_type(2)));
typedef float f32x16 __attribute__((ext_vector_type(16)));
typedef short bf16x8 __attribute__((ext_vector_type(8)));
typedef short s16x4 __attribute__((ext_vector_type(4)));
typedef int i32x4 __attribute__((ext_vector_type(4)));
typedef GAS unsigned gu32;
#define RLX_AGENT __ATOMIC_RELAXED, __HIP_MEMORY_SCOPE_AGENT
#define LDS_WAIT() asm volatile("s_waitcnt lgkmcnt(0)" ::: "memory")
#define VM_WAIT() asm volatile("s_waitcnt vmcnt(0)" ::: "memory")
__device__ __forceinline__ int opaque_tid(int wave) { int l; asm volatile("v_mbcnt_lo_u32_b32 %0, -1, 0\n\tv_mbcnt_hi_u32_b32 %0, -1, %0" : "=v"(l)); return (wave << 6) | l; }
__device__ __forceinline__ unsigned f2bf(float f) { unsigned u = __builtin_bit_cast(unsigned, f); return (u + 0x7fffu + ((u >> 16) & 1u)) >> 16; }
__device__ __forceinline__ unsigned pk2(float lo, float hi) { return f2bf(lo) | (f2bf(hi) << 16); }
__device__ __forceinline__ float bf2f(unsigned short b) { return __builtin_bit_cast(float, ((unsigned)b) << 16); }
__device__ __forceinline__ float bflo(unsigned w) { return __builtin_bit_cast(float, w << 16); }
__device__ __forceinline__ float bfhi(unsigned w) { return __builtin_bit_cast(float, w & 0xffff0000u); }
__device__ __forceinline__ f32x4 bf4_f32(v2u w) { return (f32x4){__uint_as_float(w.x << 16), __uint_as_float(w.x & 0xffff0000u), __uint_as_float(w.y << 16), __uint_as_float(w.y & 0xffff0000u)}; }
__device__ __forceinline__ unsigned cvt_pk_bf16(float lo, float hi) { unsigned r; asm volatile("v_cvt_pk_bf16_f32 %0, %1, %2" : "=v"(r) : "v"(lo), "v"(hi)); return r; }
__device__ __forceinline__ float shx(float v, int mask, int lane) { return __int_as_float(__builtin_amdgcn_ds_bpermute((lane ^ mask) << 2, __float_as_int(v))); }
__device__ __forceinline__ float wave_sum(float v, int lane) {
#pragma unroll
    for (int o = 1; o < 64; o <<= 1) v += shx(v, o, lane);
    return v;
}

#define XB_TMO      128
#define XB_XCNT(j)  (256  + 64 * (j))
#define XB_XSUB(j)  (1280 + 64 * (j))
#define XB_XGEN(j)  (2304 + 64 * (j))
#define XB_TOP      3328
#define XB_TOPGEN   3392
#define XCD_BAR_WORDS 3456
#define XB_SPIN_CAP (1u << 22)
__device__ __forceinline__ unsigned xb_ld(unsigned* p)              { return __hip_atomic_load(p, __ATOMIC_RELAXED, __HIP_MEMORY_SCOPE_AGENT); }
__device__ __forceinline__ unsigned xb_add(unsigned* p, unsigned v) { return __hip_atomic_fetch_add(p, v, __ATOMIC_RELAXED, __HIP_MEMORY_SCOPE_AGENT); }
__device__ __forceinline__ unsigned xb_xcc_id() { return (unsigned)__builtin_amdgcn_s_getreg((3 << 11) | 20) & 0xFu; }
#define XB_SPIN(cond, bar) do { unsigned _sp = 0; while (cond) { __builtin_amdgcn_s_sleep(1); \
    if ((++_sp & 255u) == 0u) { if (xb_ld(&(bar)[XB_TMO])) break; if (_sp > XB_SPIN_CAP) { atomicAdd(&(bar)[XB_TMO], 1u); break; } } } } while (0)
struct XcdBarrier { unsigned* bar; unsigned x; volatile LAS unsigned* st; int w; };
__device__ __forceinline__ bool xb_thread0(int w) { return opaque_tid(w) == 0; }
__device__ __forceinline__ XcdBarrier xcd_barrier_post(unsigned* bar, volatile LAS unsigned* st, int w) {
    XcdBarrier b; b.bar = bar; b.x = xb_xcc_id(); b.st = st; b.w = w;
    if (xb_thread0(w)) (void)xb_add(&bar[XB_XCNT(b.x)], 1u);
    return b;
}
__device__ __forceinline__ void xcd_barrier_complete(unsigned* bar, unsigned x, unsigned& nloc, unsigned& nx) {
    const unsigned G = gridDim.x * gridDim.y * gridDim.z;
    unsigned sum, cnt, mine, sp = 0u;
    for (;;) {
        sum = 0u; cnt = 0u; mine = 0u;
#pragma unroll
        for (unsigned j = 0; j < 16; ++j) { const unsigned c = xb_ld(&bar[XB_XCNT(j)]); sum += c; cnt += (c > 0u) ? 1u : 0u; mine = (j == x) ? c : mine; }
        if (sum == G) break;
        __builtin_amdgcn_s_sleep(1);
        if ((++sp & 255u) == 0u) { if (xb_ld(&bar[XB_TMO])) break; if (sp > XB_SPIN_CAP) { atomicAdd(&bar[XB_TMO], 1u); break; } }
    }
    nloc = mine > 0u ? mine : 1u; nx = cnt > 0u ? cnt : 1u;
}
__device__ __forceinline__ void xcd_barrier(const XcdBarrier& b) {
    asm volatile("s_waitcnt vmcnt(0)" ::: "memory");
    __syncthreads();
    if (xb_thread0(b.w)) {
        unsigned* bar = b.bar;
        __builtin_amdgcn_s_waitcnt(0);
        unsigned nloc = b.st[0], nx = b.st[1];
        if (nloc == 0u) { xcd_barrier_complete(bar, b.x, nloc, nx); b.st[0] = nloc; b.st[1] = nx; }
        const unsigned old = xb_add(&bar[XB_XSUB(b.x)], 1u);
        const unsigned gen = old / nloc;
        if (old + 1u == (gen + 1u) * nloc) {
            __builtin_amdgcn_fence(__ATOMIC_RELEASE, "agent");
            asm volatile("s_waitcnt vmcnt(0)" ::: "memory");
            const unsigned og = xb_add(&bar[XB_TOP], 1u);
            const unsigned tg = og / nx;
            if (og + 1u == (tg + 1u) * nx) xb_add(&bar[XB_TOPGEN], 1u);
            else XB_SPIN(xb_ld(&bar[XB_TOPGEN]) == tg, bar);
            __builtin_amdgcn_fence(__ATOMIC_ACQUIRE, "agent");
            xb_add(&bar[XB_XGEN(b.x)], 1u);
            asm volatile("s_waitcnt vmcnt(0)" ::: "memory");
        } else {
            XB_SPIN(xb_ld(&bar[XB_XGEN(b.x)]) == gen, bar);
            __builtin_amdgcn_fence(__ATOMIC_ACQUIRE, "agent");
            asm volatile("s_waitcnt vmcnt(0)" ::: "memory");
        }
    }
    __syncthreads();
}

namespace pg8 {
constexpr int BM = 256, BK = 64, HALF = 128, HTB = HALF * BK * 2, STAGE_BYTES = 8 * HTB, NXCD = 8, WGM = 8;
constexpr int GK = 1024;
__device__ __forceinline__ int lds_byte(int r, int c) { const int st = (r >> 4) * 2 + (c >> 5), rr = r & 15, cc = c & 31, ob = rr * 64 + cc * 2; return st * 1024 + (ob ^ (((ob >> 9) & 1) << 5)); }
__device__ __forceinline__ void stage_rc(int b, int& R, int& C) { const int st = b / 1024, sb = b % 1024, swz = sb ^ (((sb >> 9) & 1) << 5); R = (st >> 1) * 16 + swz / 64; C = (st & 1) * 32 + (swz % 64) / 2; }
__device__ __forceinline__ int perm32(int rho) { const int n = rho >> 4, i = rho & 15; return 8 * (i >> 2) + 4 * n + (i & 3); }
struct Unit { int pm, pn, e; };

template <bool IDG> struct DenseSchedT {
    const char* A; const char* Bt; int nM, nN, nwg, G, c, kb;
    __device__ __forceinline__ void init(const void* A_, const void* Bt_, int M, int N, int G_, int c_, int kb_ = GK * 2) { A = (const char*)A_; Bt = (const char*)Bt_; nM = M / BM; nN = N / BM; nwg = nM * nN; G = G_; c = c_; kb = kb_; }
    __device__ __forceinline__ bool next(int i, Unit& u) const {
        const long L = (long)i * G + c; if (L >= nwg) return false;
        int wgid = (int)L; { const int q = nwg / NXCD, r = nwg % NXCD, xcd = wgid % NXCD, off = wgid / NXCD; wgid = (xcd < r ? xcd * (q + 1) : r * (q + 1) + (xcd - r) * q) + off; }
        const int nig = WGM * nN, gid = wgid / nig, fm = gid * WGM, gsz = (nM - fm) < WGM ? (nM - fm) : WGM;
        u.pm = fm + ((wgid % nig) % gsz); u.pn = (wgid % nig) / gsz; u.e = 0; return true;
    }
    __device__ __forceinline__ const char* a_ptr(const Unit& u) const { return IDG ? A : A + (size_t)u.pm * (size_t)(BM * kb); }
    __device__ __forceinline__ const char* b_ptr(const Unit& u) const { return Bt + (size_t)u.pn * (size_t)(BM * kb); }
    __device__ __forceinline__ void a_offs(const Unit& u, const int (&R)[2], const int (&C)[2], unsigned (&voff)[2][2]) const {
#pragma unroll
        for (int h = 0; h < 2; ++h)
#pragma unroll
            for (int i = 0; i < 2; ++i) voff[h][i] = (unsigned)(u.pm * BM + h * HALF + R[i]) * (unsigned)kb + (unsigned)C[i] * 2u;
    }
    __device__ __forceinline__ void a_raw(const Unit&, const int (&)[2], int (&)[2][2]) const {}
    __device__ __forceinline__ void a_fin(const Unit& u, const int (&R)[2], const int (&C)[2], const int (&)[2][2], unsigned (&voff)[2][2]) const { a_offs(u, R, C, voff); }
};
typedef DenseSchedT<false> DenseSched;
struct MoeSched {
    const char* A; const char* Bt; size_t b_estride; const int* rowtok; const volatile LAS int* cumblk; const volatile LAS int* cnt; int ncol_log2, G, c, kb; const volatile LAS int* ulist;
    __device__ __forceinline__ bool next(int i, Unit& u) const {
        const int v = ulist[i & 63]; if (v < 0) return false;
        u.pm = v >> 8; u.e = (v >> 3) & 31; u.pn = v & 7; return true;
    }
    __device__ __forceinline__ void build_list(volatile LAS int* dst, int tid) const {
        if (tid < 64) { Unit u; dst[tid] = search(tid, u) ? ((u.pm << 8) | (u.e << 3) | u.pn) : -1; }
    }
    __device__ __forceinline__ bool search(int i, Unit& u) const {
        int gb, pn; const int ncol = 1 << ncol_log2;
        if (G == 256 && MK_MOEMAP == 0) { const int xcd = c & 7, j = c >> 3, rpb = 256 >> ncol_log2; gb = i * rpb + xcd + 8 * (j >> ncol_log2); pn = j & (ncol - 1); }
        else { const long L = (long)i * G + c; gb = (int)(L >> ncol_log2); pn = (int)(L & (ncol - 1)); }
        const int tot = cumblk[NE]; if (gb >= tot) return false;
        int e = 0;
#pragma unroll 1
        for (int s = 16; s >= 1; s >>= 1) { if (cumblk[e + s] <= gb) e += s; }
        u.pm = gb; u.pn = pn; u.e = e; return true;
    }
    __device__ __forceinline__ const char* a_ptr(const Unit&) const { return A; }
    __device__ __forceinline__ const char* b_ptr(const Unit& u) const { return Bt + (size_t)u.e * b_estride + (size_t)u.pn * (size_t)(BM * kb); }
    __device__ __forceinline__ void a_raw(const Unit& u, const int (&R)[2], int (&raw)[2][2]) const {
        if (!rowtok) return;
        const int rb = u.pm - cumblk[u.e]; const int* rt = rowtok + (size_t)u.e * MT;
#pragma unroll
        for (int h = 0; h < 2; ++h)
#pragma unroll
            for (int i = 0; i < 2; ++i) { const int* ptr = rt + (rb * 256 + h * HALF + R[i]);
                asm volatile("global_load_dword %0, %1, off" : "=v"(raw[h][i]) : "v"(ptr) : "memory"); }
    }
    __device__ __forceinline__ void a_fin(const Unit& u, const int (&R)[2], const int (&C)[2], const int (&raw_)[2][2], unsigned (&voff)[2][2]) const {
        int raw[2][2] = {{raw_[0][0], raw_[0][1]}, {raw_[1][0], raw_[1][1]}};
        asm volatile("" : "+v"(raw[0][0]), "+v"(raw[0][1]), "+v"(raw[1][0]), "+v"(raw[1][1]));
        const int rb = u.pm - cumblk[u.e], n = cnt[u.e];
#pragma unroll
        for (int h = 0; h < 2; ++h)
#pragma unroll
            for (int i = 0; i < 2; ++i) { const int rank = rb * 256 + h * HALF + R[i]; const int tok = rowtok ? (rank < n ? raw[h][i] : 0) : u.pm * BM + h * HALF + R[i];
                voff[h][i] = (unsigned)tok * (unsigned)kb + (unsigned)C[i] * 2u; }
    }
    __device__ __forceinline__ void a_offs(const Unit& u, const int (&R)[2], const int (&C)[2], unsigned (&voff)[2][2]) const { int raw[2][2] = {{0, 0}, {0, 0}}; a_raw(u, R, raw); asm volatile("s_waitcnt vmcnt(0)" : "+v"(raw[0][0]), "+v"(raw[0][1]), "+v"(raw[1][0]), "+v"(raw[1][1]) :: "memory"); a_fin(u, R, C, raw, voff); }
};

typedef int v8i __attribute__((ext_vector_type(8)));
__device__ __forceinline__ v8i cat8(bf16x8 lo, bf16x8 hi) { const v4u a = __builtin_bit_cast(v4u, lo), b = __builtin_bit_cast(v4u, hi); return (v8i){(int)a.x, (int)a.y, (int)a.z, (int)a.w, (int)b.x, (int)b.y, (int)b.z, (int)b.w}; }
template <class Epi, class Sched, bool GATHER, bool FP8 = false, int XG = 0>
__device__ __forceinline__ void gemm_phase(LAS unsigned char* lds, const Sched& S, const Epi& E, int wave_id, bool skip_epi = false, unsigned stagger_ticks = 0u) {
    if (stagger_ticks && ((blockIdx.x >> 3) & 1u)) { const unsigned long long t0 = __builtin_amdgcn_s_memrealtime(); while (__builtin_amdgcn_s_memrealtime() - t0 < (unsigned long long)stagger_ticks) __builtin_amdgcn_s_sleep(8); }
    const int tid = opaque_tid(wave_id), wid = __builtin_amdgcn_readfirstlane(tid >> 6), lane = tid & 63, wr = wid >> 2, wc = wid & 3, fr = lane & 15, fq = lane >> 4;
    constexpr int KB = FP8 ? GK : GK * 2, nt = KB / (BK * 2);
    unsigned voffA[2][2], voffB[2]; int Rr[2], Cc[2];
#pragma unroll
    for (int i = 0; i < 2; ++i) { int R, C; stage_rc(tid * 16 + i * 8192, R, C); Rr[i] = R; Cc[i] = C; const int Rb = Epi::PERM ? ((R & ~31) + perm32(R & 31)) : R;
        voffA[0][i] = (unsigned)(R * KB + C * 2); voffA[1][i] = (unsigned)((R + HALF) * KB + C * 2); voffB[i] = (unsigned)(Rb * KB + C * 2); }
    constexpr size_t kstep = (size_t)(BK * 2);
    constexpr size_t hstep = (size_t)HALF * KB;
    const unsigned ldsw = (unsigned)wid * 1024u;
    const int aoff = lds_byte(wr * 64 + fr, fq * 8), boff = lds_byte(wc * 32 + fr, fq * 8);
    LAS unsigned char* abase = lds + aoff; LAS unsigned char* bbase = lds + 4 * HTB + boff; asm volatile("" : "+v"(abase), "+v"(bbase));
#define PG8_SA(b, h) (((b) * 2 + (h)) * HTB)
#define PG8_SB(b, h) ((4 + (b) * 2 + (h)) * HTB)
#define PG8_STAGE(bufoff, gbase, voff) do { if (XG == 3) break; _Pragma("unroll") for (int _i = 0; _i < 2; ++_i) \
        __builtin_amdgcn_global_load_lds((const unsigned*)((const char*)(gbase) + (voff)[_i]), (LAS unsigned*)(lds + (bufoff) + ldsw + _i * 8192), 16, 0, 0); } while (0)
#define PG8_STAGE_A(bufoff, gbase, h) PG8_STAGE(bufoff, gbase, voffA[h])
#define PG8_RDA(off) (*(const LAS v4u*)(abase + (off)))
#define PG8_RDB(off) (*(const LAS v4u*)(bbase + (off)))
#define PG8_LDA(dst, b, h) do { if (XG == 2) break; _Pragma("unroll") for (int m = 0; m < 4; ++m) { const v4u _l = PG8_RDA(PG8_SA(b, h) + m * 2048), _h = PG8_RDA(PG8_SA(b, h) + m * 2048 + 1024); \
        if constexpr (FP8) dst##8[m] = (v8i){(int)_l.x, (int)_l.y, (int)_l.z, (int)_l.w, (int)_h.x, (int)_h.y, (int)_h.z, (int)_h.w}; \
        else { dst[m][0] = __builtin_bit_cast(bf16x8, _l); dst[m][1] = __builtin_bit_cast(bf16x8, _h); } } } while (0)
#define PG8_LDB(dst, b, h) do { if (XG == 2) break; _Pragma("unroll") for (int n = 0; n < 2; ++n) { const v4u _l = PG8_RDB(PG8_SA(b, h) + n * 2048), _h = PG8_RDB(PG8_SA(b, h) + n * 2048 + 1024); \
        if constexpr (FP8) dst##8[n] = (v8i){(int)_l.x, (int)_l.y, (int)_l.z, (int)_l.w, (int)_h.x, (int)_h.y, (int)_h.z, (int)_h.w}; \
        else { dst[n][0] = __builtin_bit_cast(bf16x8, _l); dst[n][1] = __builtin_bit_cast(bf16x8, _h); } } } while (0)
#define PG8_MMA(ai, bj, At, Bt) do { if (XG == 1) break; __builtin_amdgcn_s_setprio(1); _Pragma("unroll") for (int m = 0; m < 4; ++m) _Pragma("unroll") for (int n = 0; n < 2; ++n) { \
        if constexpr (FP8) acc[ai][bj][m][n] = __builtin_amdgcn_mfma_scale_f32_16x16x128_f8f6f4(Bt##8[n], At##8[m], acc[ai][bj][m][n], 0, 0, 0, 0x7A7A7A7A, 0, 0x7F7F7F7F); \
        else { _Pragma("unroll") for (int k = 0; k < 2; ++k) acc[ai][bj][m][n] = __builtin_amdgcn_mfma_f32_16x16x32_bf16(Bt[n][k], At[m][k], acc[ai][bj][m][n], 0, 0, 0); } } \
        __builtin_amdgcn_s_setprio(0); } while (0)
#define PG8_WAIT_V(n) asm volatile("s_waitcnt vmcnt(" #n ")" ::: "memory")
#define PG8_WAIT_L(n) asm volatile("s_waitcnt lgkmcnt(" #n ")" ::: "memory")
#define PG8_BAR __builtin_amdgcn_s_barrier()
#define PG8_SCHED __builtin_amdgcn_sched_barrier(0)
    Unit cur, nxt; int ui = 0;
    if (!S.next(0, cur)) return;
    f32x4 acc[2][2][4][2];
#pragma unroll
    for (int a = 0; a < 2; ++a)
#pragma unroll
        for (int b = 0; b < 2; ++b)
#pragma unroll
            for (int m = 0; m < 4; ++m)
#pragma unroll
                for (int n = 0; n < 2; ++n) acc[a][b][m][n] = (f32x4){0.f, 0.f, 0.f, 0.f};
    bf16x8 At[4][2], B0[2][2], B1[2][2]; v8i At8[4], B08[2], B18[2];
    if constexpr (XG == 2) { _Pragma("unroll") for (int m = 0; m < 4; ++m) { asm volatile("" : "=v"(At8[m])); } _Pragma("unroll") for (int n = 0; n < 2; ++n) { asm volatile("" : "=v"(B08[n])); asm volatile("" : "=v"(B18[n])); } }
    const char* cA = S.a_ptr(cur); const char* cB = S.b_ptr(cur);
    if constexpr (GATHER) S.a_offs(cur, Rr, Cc, voffA);
    PG8_STAGE(PG8_SB(0, 0), cB, voffB); PG8_STAGE(PG8_SB(0, 1), cB + hstep, voffB); PG8_STAGE_A(PG8_SA(0, 0), cA, 0); PG8_STAGE_A(PG8_SA(0, 1), cA, 1);
    if (wr == 1) PG8_BAR;
    PG8_WAIT_V(2); PG8_BAR;
    PG8_STAGE(PG8_SB(1, 0), cB + kstep, voffB); PG8_STAGE_A(PG8_SA(1, 0), cA + kstep, 0); PG8_STAGE(PG8_SB(1, 1), cB + hstep + kstep, voffB);
    PG8_WAIT_V(6); PG8_BAR;
    for (;;) {
        const bool has_next = S.next(ui + 1, nxt);
        const char* nA = has_next ? S.a_ptr(nxt) : cA; const char* nB = has_next ? S.b_ptr(nxt) : cB;
        int rawN[2][2] = {{0, 0}, {0, 0}};
        if constexpr (GATHER) { if (has_next) S.a_raw(nxt, Rr, rawN); }
#pragma unroll 1
        for (int t = 0; t < nt; t += 2) {
            const bool last = (t == nt - 2);
            if constexpr (Epi::LDSBIAS) { if (last && wid == 0) E.stage_bias(cur, lane); }
            const char* a1 = cA + (size_t)(t + 1) * kstep;
            const char* a2 = last ? nA : cA + (size_t)(t + 2) * kstep; const char* b2 = last ? nB : cB + (size_t)(t + 2) * kstep;
            const char* a3 = a2 + kstep; const char* b3 = b2 + kstep;
            PG8_LDB(B0, 0, 0); PG8_LDB(B1, 0, 1); PG8_SCHED; PG8_LDA(At, 0, 0); PG8_STAGE_A(PG8_SA(1, 1), a1, 1);
            if constexpr (GATHER) { if (last && has_next) S.a_fin(nxt, Rr, Cc, rawN, voffA); }
            PG8_WAIT_V(8); PG8_WAIT_L(0); PG8_BAR; PG8_MMA(0, 0, At, B0); PG8_MMA(0, 1, At, B1); PG8_BAR; PG8_SCHED;
            PG8_LDA(At, 0, 1); PG8_STAGE(PG8_SB(0, 0), b2, voffB); PG8_STAGE(PG8_SB(0, 1), b2 + hstep, voffB); PG8_STAGE_A(PG8_SA(0, 0), a2, 0);
            PG8_WAIT_V(8); PG8_WAIT_L(0); PG8_BAR; PG8_MMA(1, 0, At, B0); PG8_MMA(1, 1, At, B1); PG8_BAR; PG8_SCHED;
            PG8_LDB(B0, 1, 0); PG8_LDB(B1, 1, 1); PG8_SCHED; PG8_LDA(At, 1, 0); PG8_STAGE_A(PG8_SA(0, 1), a2, 1);
            PG8_WAIT_V(8); PG8_WAIT_L(0); PG8_BAR; PG8_MMA(0, 0, At, B0); PG8_MMA(0, 1, At, B1); PG8_BAR; PG8_SCHED;
            PG8_LDA(At, 1, 1); PG8_STAGE(PG8_SB(1, 0), b3, voffB); PG8_STAGE(PG8_SB(1, 1), b3 + hstep, voffB); PG8_STAGE_A(PG8_SA(1, 0), a3, 0);
            PG8_WAIT_V(8); PG8_WAIT_L(0); PG8_BAR; PG8_MMA(1, 0, At, B0); PG8_MMA(1, 1, At, B1); PG8_BAR; PG8_SCHED;
        }
        if (wr == 0) PG8_BAR;
        if (!skip_epi) E(acc, cur, wr, wc, fr, fq);
        if (!has_next) break;
#pragma unroll
        for (int a = 0; a < 2; ++a)
#pragma unroll
            for (int b = 0; b < 2; ++b)
#pragma unroll
                for (int m = 0; m < 4; ++m)
#pragma unroll
                    for (int n = 0; n < 2; ++n) acc[a][b][m][n] = (f32x4){0.f, 0.f, 0.f, 0.f};
        cur = nxt; cA = nA; cB = nB; ++ui;
        if (wr == 1) PG8_BAR;
    }
    PG8_WAIT_V(0);
    PG8_BAR;
#undef PG8_SA
#undef PG8_SB
#undef PG8_STAGE
#undef PG8_STAGE_A
#undef PG8_LDA
#undef PG8_RDA
#undef PG8_RDB
#undef PG8_LDB
#undef PG8_MMA
#undef PG8_WAIT_V
#undef PG8_WAIT_L
#undef PG8_BAR
#undef PG8_SCHED
}
}
namespace pg8 {
__device__ __forceinline__ f32x2 gelu_pk(f32x2 v) {
    const f32x2 av = __builtin_elementwise_abs(v), d = av * 0.2316418882f + 1.0f;
    f32x2 t; t.x = __builtin_amdgcn_rcpf(d.x); t.y = __builtin_amdgcn_rcpf(d.y);
    f32x2 q = t * 0.5307027145f + (-0.7265760135f); q = q * t + 0.7107068705f; q = q * t + (-0.142248368f); q = q * t + 0.127414796f; q = q * t;
    const f32x2 s = (v * v) * (-0.72134752044f);
    f32x2 e; e.x = __builtin_amdgcn_exp2f(s.x); e.y = __builtin_amdgcn_exp2f(s.y);
    const f32x2 m = v * (q * e), r = v - m;
    f32x2 o; o.x = v.x < 0.f ? m.x : r.x; o.y = v.y < 0.f ? m.y : r.y; return o;
}
struct EpiBf16 {
    static constexpr bool PERM = true, LDSBIAS = false;
    bf16* O; int ldc; float* ss; int ACT;
    __device__ __forceinline__ void operator()(const f32x4 (&acc)[2][2][4][2], const Unit& u, int wr, int wc, int fr, int fq) const {
        const int row0 = u.pm * BM + wr * 64 + fr, col0 = u.pn * BM + wc * 32 + 8 * fq;
#pragma unroll
        for (int ai = 0; ai < 2; ++ai)
#pragma unroll
            for (int m = 0; m < 4; ++m) { const int row = row0 + ai * HALF + m * 16; bf16* rowp = O + (size_t)row * ldc + col0; float sq = 0.f;
#pragma unroll
                for (int bj = 0; bj < 2; ++bj) { f32x4 v0 = acc[ai][bj][m][0], v1 = acc[ai][bj][m][1];
                    if (ACT == 1) { f32x2 a = gelu_pk((f32x2){v0[0], v0[1]}), b = gelu_pk((f32x2){v0[2], v0[3]}), c = gelu_pk((f32x2){v1[0], v1[1]}), d = gelu_pk((f32x2){v1[2], v1[3]});
                        v0 = (f32x4){a.x, a.y, b.x, b.y}; v1 = (f32x4){c.x, c.y, d.x, d.y};
                        sq += (v0[0] * v0[0] + v0[1] * v0[1]) + (v0[2] * v0[2] + v0[3] * v0[3]) + (v1[0] * v1[0] + v1[1] * v1[1]) + (v1[2] * v1[2] + v1[3] * v1[3]); }
                    v4u w; w.x = cvt_pk_bf16(v0[0], v0[1]); w.y = cvt_pk_bf16(v0[2], v0[3]); w.z = cvt_pk_bf16(v1[0], v1[1]); w.w = cvt_pk_bf16(v1[2], v1[3]);
                    *(v4u*)(rowp + bj * HALF) = w; }
                if (ACT == 1) { const int ln = (fq << 4) | fr; sq += shx(sq, 16, ln); sq += shx(sq, 32, ln);
                    if (u.pn >= 4 && fq == 0) ss[(size_t)row * 16 + (u.pn - 4) * 4 + wc] = sq; }
            }
    }
};
struct EpiResid {
    static constexpr bool PERM = false, LDSBIAS = false;
    bf16* xb; const float* modl;
    __device__ __forceinline__ void operator()(const f32x4 (&acc)[2][2][4][2], const Unit& u, int wr, int wc, int fr, int fq) const {
        const bool lat = u.pm < ML / BM; const int bidx = lat ? (u.pm >> 5) : 8;
        bf16* base = xb + (size_t)u.pm * BM * D;
        const float* g = modl + bidx * 6144 + 2 * 1024;
        const int r0 = wr * 64 + fr, col0 = u.pn * BM + wc * 32 + 4 * fq;
        f32x4 gv[2][2];
#pragma unroll
        for (int bj = 0; bj < 2; ++bj)
#pragma unroll
            for (int n = 0; n < 2; ++n) gv[bj][n] = *(const f32x4*)(g + col0 + bj * HALF + n * 16);
        const int odd = fq & 1, colp = col0 - 4 * odd;
#pragma unroll
        for (int ai = 0; ai < 2; ++ai) { v4u bs[2][2][2];
#pragma unroll
            for (int mp = 0; mp < 2; ++mp) { const size_t off = (size_t)(r0 + ai * HALF + (2 * mp + odd) * 16) * D + colp;
#pragma unroll
                for (int bj = 0; bj < 2; ++bj)
#pragma unroll
                    for (int n = 0; n < 2; ++n) bs[mp][bj][n] = *(const v4u*)(base + off + bj * HALF + n * 16); }
#pragma unroll
            for (int mp = 0; mp < 2; ++mp) { const size_t off = (size_t)(r0 + ai * HALF + (2 * mp + odd) * 16) * D + colp;
#pragma unroll
                for (int bj = 0; bj < 2; ++bj)
#pragma unroll
                    for (int n = 0; n < 2; ++n) { const v4u L = bs[mp][bj][n];
                        const auto s0 = __builtin_amdgcn_permlane16_swap(L.x, L.z, false, false), s1 = __builtin_amdgcn_permlane16_swap(L.y, L.w, false, false);
                        const f32x4 va = bf4_f32((v2u){s0[0], s1[0]}) + gv[bj][n] * acc[ai][bj][2 * mp][n], vb = bf4_f32((v2u){s0[1], s1[1]}) + gv[bj][n] * acc[ai][bj][2 * mp + 1][n];
                        const auto t0 = __builtin_amdgcn_permlane16_swap(cvt_pk_bf16(va.x, va.y), cvt_pk_bf16(vb.x, vb.y), false, false), t1 = __builtin_amdgcn_permlane16_swap(cvt_pk_bf16(va.z, va.w), cvt_pk_bf16(vb.z, vb.w), false, false);
                        *(v4u*)(base + off + bj * HALF + n * 16) = (v4u){t0[0], t1[0], t0[1], t1[1]}; } }
            asm volatile("" ::: "memory"); }
    }
};
struct EpiSwiglu {
    static constexpr bool PERM = true, LDSBIAS = true;
    unsigned char* O; const float* b1; LAS float* bl;
    __device__ __forceinline__ void stage_bias(const Unit& u, int lane) const { const float* src = b1 + (size_t)u.e * 2048 + (lane < 32 ? u.pn * HALF + 4 * lane : 1024 + u.pn * HALF + 4 * (lane - 32));
        __builtin_amdgcn_global_load_lds((const unsigned*)src, (LAS unsigned*)bl, 16, 0, 0); }
    __device__ __forceinline__ void operator()(const f32x4 (&acc)[2][2][4][2], const Unit& u, int wr, int wc, int fr, int fq) const {
        const int row0 = u.pm * BM + wr * 64 + fr, cl = wc * 32 + 8 * fq, c0 = u.pn * HALF + cl;
        f32x4 bg[2], bli[2];
#pragma unroll
        for (int n = 0; n < 2; ++n) { bg[n] = *(const LAS f32x4*)(bl + cl + 4 * n); bli[n] = *(const LAS f32x4*)(bl + 128 + cl + 4 * n) + 1.0f; }
#pragma unroll
        for (int ai = 0; ai < 2; ++ai)
#pragma unroll
            for (int mp = 0; mp < 4; mp += 2) { v2u wv[2];
#pragma unroll
              for (int mm = 0; mm < 2; ++mm) { const int m = mp + mm; float o[8];
#pragma unroll
                for (int n = 0; n < 2; ++n)
#pragma unroll
                    for (int j = 0; j < 4; ++j) { const float gl = fminf(acc[ai][0][m][n][j] + bg[n][j], 7.0f), lp = __builtin_amdgcn_fmed3f(acc[ai][1][m][n][j] + bli[n][j], -6.0f, 8.0f);
                        const float sg = __builtin_amdgcn_rcpf(1.0f + __builtin_amdgcn_exp2f(gl * (-1.702f * 1.4426950408889634f)));
                        o[n * 4 + j] = gl * sg * lp; }
                v2u w; w.x = 0; w.y = 0;
                w.x = __builtin_amdgcn_cvt_pk_fp8_f32(o[0], o[1], w.x, false); w.x = __builtin_amdgcn_cvt_pk_fp8_f32(o[2], o[3], w.x, true);
                w.y = __builtin_amdgcn_cvt_pk_fp8_f32(o[4], o[5], w.y, false); w.y = __builtin_amdgcn_cvt_pk_fp8_f32(o[6], o[7], w.y, true);
                wv[mm] = w; }
              const auto sx = __builtin_amdgcn_permlane16_swap(wv[0].x, wv[1].x, false, false), sy = __builtin_amdgcn_permlane16_swap(wv[0].y, wv[1].y, false, false);
              *(v4u*)(O + (size_t)(row0 + ai * HALF + (mp + (fq & 1)) * 16) * D + (c0 - 8 * (fq & 1))) = (v4u){sx[0], sy[0], sx[1], sy[1]}; }
    }
};
struct EpiBias {
    static constexpr bool PERM = true, LDSBIAS = true;
    unsigned char* O; const float* b2; LAS float* bl;
    __device__ __forceinline__ void stage_bias(const Unit& u, int lane) const { __builtin_amdgcn_global_load_lds((const unsigned*)(b2 + (size_t)u.e * 1024 + u.pn * BM + 4 * lane), (LAS unsigned*)bl, 16, 0, 0); }
    __device__ __forceinline__ void operator()(const f32x4 (&acc)[2][2][4][2], const Unit& u, int wr, int wc, int fr, int fq) const {
        const int row0 = u.pm * BM + wr * 64 + fr, cl = wc * 32 + 8 * fq, col0 = u.pn * BM + cl;
#pragma unroll
        for (int bj = 0; bj < 2; ++bj) { const f32x4 bv0 = *(const LAS f32x4*)(bl + cl + bj * HALF), bv1 = *(const LAS f32x4*)(bl + cl + bj * HALF + 4);
#pragma unroll
            for (int ai = 0; ai < 2; ++ai)
#pragma unroll
                for (int mp = 0; mp < 4; mp += 2) { v2u wv[2];
#pragma unroll
                    for (int mm = 0; mm < 2; ++mm) { const int m = mp + mm; const f32x4 v0 = acc[ai][bj][m][0] + bv0, v1 = acc[ai][bj][m][1] + bv1;
                        v2u w; w.x = 0; w.y = 0;
                        w.x = __builtin_amdgcn_cvt_pk_fp8_f32(v0[0], v0[1], w.x, false); w.x = __builtin_amdgcn_cvt_pk_fp8_f32(v0[2], v0[3], w.x, true);
                        w.y = __builtin_amdgcn_cvt_pk_fp8_f32(v1[0], v1[1], w.y, false); w.y = __builtin_amdgcn_cvt_pk_fp8_f32(v1[2], v1[3], w.y, true);
                        wv[mm] = w; }
                    const auto sx = __builtin_amdgcn_permlane16_swap(wv[0].x, wv[1].x, false, false), sy = __builtin_amdgcn_permlane16_swap(wv[0].y, wv[1].y, false, false);
                    *(v4u*)(O + (size_t)(row0 + ai * HALF + (mp + (fq & 1)) * 16) * D + (col0 - 8 * (fq & 1)) + bj * HALF) = (v4u){sx[0], sy[0], sx[1], sy[1]}; }
            asm volatile("" ::: "memory"); }
    }
};
}

namespace att {
constexpr int AD = 128, NW = 8, QBLK = 32, KVBLK = 64;
constexpr float SCALE = 0.088388347648318440f;
constexpr int LDO = 1024;
constexpr int SHM_V = AD * KVBLK, SHM_K = KVBLK * AD, SHM_ATTN = 4 * SHM_V + 4 * SHM_K;
typedef int v8i __attribute__((ext_vector_type(8)));
#define K8SW(key, c) ((key) * 128 + ((((c) ^ (((key) >> 1) & 7))) << 4))
#define V8SW(d, c) ((d) * 64 + ((((c) ^ (((d) >> 2) & 3))) << 4))
#define SBAR() __builtin_amdgcn_sched_barrier(0)
__device__ __forceinline__ int crow(int r, int hi) { return (r & 3) + 8 * (r >> 2) + 4 * hi; }
template <int XV = 0>
__device__ __forceinline__ int exp4(float a0, float a1, float a2, float a3) {
  float t0 = fminf(a0 + 8.0f, 8.0f), t1 = fminf(a1 + 8.0f, 8.0f), t2 = fminf(a2 + 8.0f, 8.0f), t3 = fminf(a3 + 8.0f, 8.0f); int w;
  asm volatile("v_exp_f32 %1, %1\n\tv_exp_f32 %2, %2\n\tv_exp_f32 %3, %3\n\tv_exp_f32 %4, %4\n\t"
               "v_cvt_pk_fp8_f32 %0, %1, %2\n\ts_nop 0\n\tv_cvt_pk_fp8_f32 %0, %3, %4 op_sel:[0,0,1]"
               : "=&v"(w), "+v"(t0), "+v"(t1), "+v"(t2), "+v"(t3));
  return w;
}
template <int PAD>
__device__ __forceinline__ int expc4(float a0, float a1, float a2, float a3) {
  int w; float t0, t1, t2, t3;
  if constexpr (PAD != 0)
    asm volatile("s_nop 5\n\tv_exp_f32_e64 %1, %5 clamp\n\tv_exp_f32_e64 %2, %6 clamp\n\tv_exp_f32_e64 %3, %7 clamp\n\tv_exp_f32_e64 %4, %8 clamp\n\t"
                 "v_cvt_scalef32_pk_fp8_f32 %0, %1, %2, %9\n\ts_nop 0\n\tv_cvt_scalef32_pk_fp8_f32 %0, %3, %4, %9 op_sel:[0,0,0,1]"
                 : "=&v"(w), "=&v"(t0), "=&v"(t1), "=&v"(t2), "=&v"(t3) : "v"(a0), "v"(a1), "v"(a2), "v"(a3), "s"(0x3B800000));
  else
    asm volatile("v_exp_f32_e64 %1, %5 clamp\n\tv_exp_f32_e64 %2, %6 clamp\n\tv_exp_f32_e64 %3, %7 clamp\n\tv_exp_f32_e64 %4, %8 clamp\n\t"
                 "v_cvt_scalef32_pk_fp8_f32 %0, %1, %2, %9\n\ts_nop 0\n\tv_cvt_scalef32_pk_fp8_f32 %0, %3, %4, %9 op_sel:[0,0,0,1]"
                 : "=&v"(w), "=&v"(t0), "=&v"(t1), "=&v"(t2), "=&v"(t3) : "v"(a0), "v"(a1), "v"(a2), "v"(a3), "s"(0x3B800000));
  return w;
}
#define EXC4(P, m, PAD) expc4<PAD>(P[4 * (m)], P[4 * (m) + 1], P[4 * (m) + 2], P[4 * (m) + 3])
typedef int v4i __attribute__((ext_vector_type(4)));
__device__ __forceinline__ void partialSM(const f32x16& p0, float nb, v4i& plo) {
#pragma unroll
  for (int m = 0; m < 4; ++m) plo[m] = exp4(p0[4 * m], p0[4 * m + 1], p0[4 * m + 2], p0[4 * m + 3]);
}
__device__ __forceinline__ void finishSM(const f32x16& p1, float nb, const v4i& plo, v8i& pa) {
  v4i phi;
#pragma unroll
  for (int m = 0; m < 4; ++m) phi[m] = exp4(p1[4 * m], p1[4 * m + 1], p1[4 * m + 2], p1[4 * m + 3]);
  pa = (v8i){plo[0], plo[1], plo[2], plo[3], phi[0], phi[1], phi[2], phi[3]};
}
__device__ __forceinline__ void qkt(f32x16& p0, f32x16& p1, const char* Ks, const v8i* q8, int r32, int hi, const f32x16& NBV) {
  p0 = NBV; p1 = NBV;
#pragma unroll
  for (int s = 0; s < 2; ++s) { const int c0 = 4 * s + 2 * hi;
    const v4u a0 = *reinterpret_cast<const v4u*>(Ks + K8SW(r32, c0)), a1 = *reinterpret_cast<const v4u*>(Ks + K8SW(r32, c0 + 1));
    const v4u b0 = *reinterpret_cast<const v4u*>(Ks + K8SW(32 + r32, c0)), b1 = *reinterpret_cast<const v4u*>(Ks + K8SW(32 + r32, c0 + 1));
    const v8i A0 = (v8i){(int)a0.x, (int)a0.y, (int)a0.z, (int)a0.w, (int)a1.x, (int)a1.y, (int)a1.z, (int)a1.w};
    const v8i A1 = (v8i){(int)b0.x, (int)b0.y, (int)b0.z, (int)b0.w, (int)b1.x, (int)b1.y, (int)b1.z, (int)b1.w};
    p0 = __builtin_amdgcn_mfma_scale_f32_32x32x64_f8f6f4(A0, q8[s], p0, 0, 0, 0, 0x7F7F7F7F, 0, 0x7C7C7C7C);
    p1 = __builtin_amdgcn_mfma_scale_f32_32x32x64_f8f6f4(A1, q8[s], p1, 0, 0, 0, 0x7F7F7F7F, 0, 0x7C7C7C7C); }
}
__device__ __forceinline__ void pv_d0(f32x16* o, f32x16& lacc, const char* Vs, v8i pa, int r32, int hi) {
  { const int one = 0x38383838; const v8i ONES = (v8i){one, one, one, one, one, one, one, one};
    lacc = __builtin_amdgcn_mfma_scale_f32_32x32x64_f8f6f4(pa, ONES, lacc, 0, 0, 0, 0x7F7F7F7F, 0, 0x7F7F7F7F); }
#pragma unroll
  for (int d0 = 0; d0 < 4; ++d0) { const int d = 32 * d0 + r32;
    const v4u b0 = *reinterpret_cast<const v4u*>(Vs + V8SW(d, 2 * hi)), b1 = *reinterpret_cast<const v4u*>(Vs + V8SW(d, 2 * hi + 1));
    const v8i B = (v8i){(int)b0.x, (int)b0.y, (int)b0.z, (int)b0.w, (int)b1.x, (int)b1.y, (int)b1.z, (int)b1.w};
    o[d0] = __builtin_amdgcn_mfma_scale_f32_32x32x64_f8f6f4(pa, B, o[d0], 0, 0, 0, 0x7F7F7F7F, 0, 0x7F7F7F7F); }
}
__device__ __forceinline__ v8i lds32(const char* p0, const char* p1) { const v4u a = *reinterpret_cast<const v4u*>(p0), b = *reinterpret_cast<const v4u*>(p1);
  return (v8i){(int)a.x, (int)a.y, (int)a.z, (int)a.w, (int)b.x, (int)b.y, (int)b.z, (int)b.w}; }
#define MF8(A, B, C, SB) ((XV == 3 || XV == 4 || XV == 5 || XV == 9) ? (C) : __builtin_amdgcn_mfma_scale_f32_32x32x64_f8f6f4(A, B, C, 0, 0, 0, 0x7F7F7F7F, 0, SB))
#define EX4(P, m) exp4<XV>(P[4 * (m)], P[4 * (m) + 1], P[4 * (m) + 2], P[4 * (m) + 3])
template <int XV = 0>
__device__ __forceinline__ void tile_step(f32x16& pN0, f32x16& pN1, const f32x16& pP1, const v4i& ploP, v4i& ploN, f32x16* o, f32x16& lacc,
                                          const char* Ks, const char* Vs, const v8i* q8, int r32, int hi, const f32x16& Z) {
  const int one = 0x38383838; const v8i ONES = (v8i){one, one, one, one, one, one, one, one};
  v4i phi;
  const v8i A00 = lds32(Ks + K8SW(r32, 2 * hi), Ks + K8SW(r32, 2 * hi + 1)), A10 = lds32(Ks + K8SW(32 + r32, 2 * hi), Ks + K8SW(32 + r32, 2 * hi + 1));
  const v8i A01 = lds32(Ks + K8SW(r32, 4 + 2 * hi), Ks + K8SW(r32, 4 + 2 * hi + 1)), A11 = lds32(Ks + K8SW(32 + r32, 4 + 2 * hi), Ks + K8SW(32 + r32, 4 + 2 * hi + 1));
  phi[0] = EXC4(pP1, 0, 0); SBAR();
  pN0 = MF8(A00, q8[0], Z, 0x7C7C7C7C);   SBAR(); const v8i V0 = lds32(Vs + V8SW(r32, 2 * hi), Vs + V8SW(r32, 2 * hi + 1));           phi[1] = EXC4(pP1, 1, 0); SBAR();
  pN0 = MF8(A01, q8[1], pN0, 0x7C7C7C7C); SBAR(); const v8i V1 = lds32(Vs + V8SW(32 + r32, 2 * hi), Vs + V8SW(32 + r32, 2 * hi + 1)); phi[2] = EXC4(pP1, 2, 0); SBAR();
  pN1 = MF8(A10, q8[0], Z, 0x7C7C7C7C);   SBAR(); const v8i V2 = lds32(Vs + V8SW(64 + r32, 2 * hi), Vs + V8SW(64 + r32, 2 * hi + 1)); phi[3] = EXC4(pP1, 3, 0); SBAR();
  pN1 = MF8(A11, q8[1], pN1, 0x7C7C7C7C); SBAR(); const v8i V3 = lds32(Vs + V8SW(96 + r32, 2 * hi), Vs + V8SW(96 + r32, 2 * hi + 1)); SBAR();
  const v8i pa = (v8i){ploP[0], ploP[1], ploP[2], ploP[3], phi[0], phi[1], phi[2], phi[3]};
  lacc = MF8(pa, ONES, lacc, 0x7F7F7F7F); SBAR(); ploN[0] = EXC4(pN0, 0, 1); SBAR();
  o[0] = MF8(pa, V0, o[0], 0x7F7F7F7F);   SBAR(); ploN[1] = EXC4(pN0, 1, 0); SBAR();
  o[1] = MF8(pa, V1, o[1], 0x7F7F7F7F);   SBAR(); ploN[2] = EXC4(pN0, 2, 0); SBAR();
  o[2] = MF8(pa, V2, o[2], 0x7F7F7F7F);   SBAR(); ploN[3] = EXC4(pN0, 3, 0); SBAR();
  o[3] = MF8(pa, V3, o[3], 0x7F7F7F7F);   SBAR();
}
template <int XV = 0>
__device__ __forceinline__ void attn_dense_body(const unsigned char* __restrict__ Q8, const unsigned char* __restrict__ K8, const unsigned char* __restrict__ VT, int vt_ld, bf16* __restrict__ Ob, int seq, char* lds, int wave_id, float nb) {
  const int tid = opaque_tid(wave_id), wid = tid >> 6, lane = tid & 63, r32 = lane & 31, hi = lane >> 5;
  char* V_lds = lds; char* K_lds = lds + 4 * SHM_V;
  f32x16 lacc = {}; f32x16 o[4] = {}; v8i qr[2]; f32x16 NBV;
#pragma unroll
  for (int i = 0; i < 16; ++i) NBV[i] = nb;
  { const unsigned char* Qw = Q8 + (long)(wid * QBLK + r32) * 1024 + hi * 32;
#pragma unroll
    for (int s2 = 0; s2 < 2; ++s2) { const v4u a = *reinterpret_cast<const v4u*>(Qw + 64 * s2), b = *reinterpret_cast<const v4u*>(Qw + 64 * s2 + 16);
      qr[s2] = (v8i){(int)a.x, (int)a.y, (int)a.z, (int)a.w, (int)b.x, (int)b.y, (int)b.z, (int)b.w}; } }
  struct { v4u vs, ks; } sr_[1];
  const int kkey = tid >> 3, kch = tid & 7; const unsigned koff = (unsigned)(kkey * 256 + kch * 16); const int kst = K8SW(kkey, kch);
  const int vd = tid >> 2, vc = tid & 3; const unsigned voff = (unsigned)(vd * vt_ld + vc * 16); const int vst = V8SW(vd, vc);
#define SLOAD(i, k0) do { if (XV >= 7) break; sr_[i].vs = *reinterpret_cast<const v4u*>((const char*)VT + (size_t)(k0) + voff); \
    sr_[i].ks = *reinterpret_cast<const v4u*>((const char*)K8 + (size_t)(k0) * 256 + koff); } while (0)
#define SWRITE(b, i) do { *(v4u*)(V_lds + (b) * SHM_V + vst) = sr_[i].vs; *(v4u*)(K_lds + (b) * SHM_K + kst) = sr_[i].ks; } while (0)
#define SWAIT() asm volatile("s_waitcnt vmcnt(0)" ::: "memory")
#define TBAR() asm volatile("s_waitcnt lgkmcnt(0)\n\ts_barrier" ::: "memory")
  f32x16 pA0, pA1, pB0, pB1; v8i pa; v4i plA, plB; const int NT = seq / KVBLK;
  SLOAD(0, 0); SWAIT(); SWRITE(0, 0); SLOAD(0, KVBLK); TBAR();
  qkt(pA0, pA1, K_lds, qr, r32, hi, NBV); partialSM(pA0, nb, plA);
  SWAIT(); SWRITE(1, 0); SLOAD(0, 2 * KVBLK); TBAR();
#define STEP_IO(t, SW) do { SWAIT(); SWRITE(SW, 0); { const int tn = (t) + 2 < NT ? (t) + 2 : NT - 1; SLOAD(0, tn * KVBLK); } SBAR(); } while (0)
#define STEP_B(t, SK, SV, SW) do { STEP_IO(t, SW); tile_step<XV>(pB0, pB1, pA1, plA, plB, o, lacc, K_lds + (SK) * SHM_K, V_lds + (SV) * SHM_V, qr, r32, hi, NBV); TBAR(); } while (0)
#define STEP_A(t, SK, SV, SW) do { STEP_IO(t, SW); tile_step<XV>(pA0, pA1, pB1, plB, plA, o, lacc, K_lds + (SK) * SHM_K, V_lds + (SV) * SHM_V, qr, r32, hi, NBV); TBAR(); } while (0)
  int j = 1;
  for (; j + 5 < NT; j += 4) { STEP_B(j, 1, 0, 2); STEP_A(j + 1, 2, 1, 3); STEP_B(j + 2, 3, 2, 0); STEP_A(j + 3, 0, 3, 1); }
  STEP_B(j, 1, 0, 2); STEP_A(j + 1, 2, 1, 3);
  SBAR(); qkt(pB0, pB1, K_lds + 3 * SHM_K, qr, r32, hi, NBV);
  finishSM(pA1, nb, plA, pa); SBAR();
  pv_d0(o, lacc, V_lds + 2 * SHM_V, pa, r32, hi); partialSM(pB0, nb, plB);
  finishSM(pB1, nb, plB, pa); SBAR();
  pv_d0(o, lacc, V_lds + 3 * SHM_V, pa, r32, hi);
  { const int ln2 = opaque_tid(wave_id) & 63, r32e = ln2 & 31, hie = ln2 >> 5;
    bf16* Ow = Ob + (long)(wid * QBLK) * LDO;
#pragma unroll
    for (int r = 0; r < 16; ++r) { const int orow = crow(r, hie); const float rl = __builtin_amdgcn_rcpf(lacc[r]);
      for (int d0 = 0; d0 < 4; ++d0) Ow[(long)orow * LDO + d0 * 32 + r32e] = (bf16)f2bf(o[d0][r] * rl); } }
  __syncthreads();
#undef SLOAD
#undef TBAR
#undef STEP_IO
#undef STEP_A
#undef STEP_B
#undef SWRITE
#undef SWAIT
}
#undef K8SW
#undef V8SW
}
constexpr int NWAVES = 8, NTHREADS = 512;
struct Args { const float* in[36]; float* out; unsigned char* ws; int ph_lo, ph_hi; };
enum InIdx { I_X = 0, I_C, I_CTX, I_CCTX, I_ADAW, I_ADAB, I_N1G, I_N2G, I_WOUT, I_RW, I_RB, I_EW1, I_EB1, I_EW2, I_EB2, I_AWIN, I_AQG, I_AKG,
             I_GWIN, I_GVG, I_GWS, I_GBS, I_HWIN, I_HCW, I_HCB, I_FW1, I_FB1, I_FW2, I_FB2, I_FW3, I_FB3, I_FW4, I_FB4, I_FREQ, I_HD, I_FG };
struct Frame {
    LAS unsigned char* lds; volatile LAS unsigned* MISC; gu32* ctl;
    int tid, lane, wave, G, bx;
    float* out; unsigned char* ws;
};
template <class T> __device__ __forceinline__ T* launder(T* p) { unsigned long long v = (unsigned long long)p; asm volatile("" : "+s"(v)); return (T*)(GAS T*)v; }
constexpr int MW_PTRS = 640;
__device__ __forceinline__ const float* pin_load(const Frame& F, int i) {
    const unsigned lo = __builtin_amdgcn_readfirstlane(F.MISC[MW_PTRS + 2 * i]), hi = __builtin_amdgcn_readfirstlane(F.MISC[MW_PTRS + 2 * i + 1]);
    return (const float*)(GAS const float*)(((unsigned long long)hi << 32) | lo);
}
#define PIN(F, i) pin_load(F, i)
__device__ __forceinline__ Frame phase_frame(const Frame& F0) {
    Frame F = F0; F.tid = opaque_tid(F0.wave); F.lane = F.tid & 63; F.wave = F0.wave;
    F.ws = launder(F0.ws); F.out = launder(F0.out); F.ctl = (gu32*)(F.ws + WS_CTL);
    { LAS unsigned char* l = F0.lds; asm volatile("" : "+s"(l)); F.lds = l; F.MISC = (volatile LAS unsigned*)(l + MISC_OFF); }
    return F;
}
constexpr int PH_PRO0 = 0, PH_PRO1 = 1, PH_L0 = 2, PH_PER_LAYER = 9, PH_FINAL = PH_L0 + NLAYER * PH_PER_LAYER, PH_COUNT = PH_FINAL + 1;
enum LPhase { LP_NORM1 = 0, LP_INPROJ, LP_MIX1, LP_MIX2, LP_MIX3, LP_OUTPROJ, LP_NORM2, LP_MOE1, LP_MOE2 };

struct TItem { const float* src; unsigned char* dst; int N; bool fp8; };
__device__ __forceinline__ TItem titem_decode(Frame& F, int it) {
    constexpr int R0 = 128 * 512, R1 = 128 * 256, R2 = 2 * 384, R3 = 512, R4 = 768;
    int r = it; TItem t;
    if (r < R0) { const int mi = r >> 9, q = r & 511, kb = q >> 5, nb = q & 31, n0 = nb * 64;
        const int d0 = n0 < 1024 ? 256 * (n0 >> 7) + (n0 & 127) : 256 * ((n0 - 1024) >> 7) + 128 + (n0 & 127);
        t.src = PIN(F, I_EW1) + (size_t)mi * 1024 * 2048 + (size_t)(kb * 64) * 2048 + n0; t.N = 2048; t.fp8 = true; t.dst = F.ws + WS_WE1 + (size_t)mi * 2048 * 1024 + (size_t)d0 * 1024 + kb * 64; return t; } r -= R0;
    if (r < R1) { const int mi = r >> 8, q = r & 255, kb = q >> 4, nb = q & 15;
        t.src = PIN(F, I_EW2) + (size_t)mi * 1024 * 1024 + (size_t)(kb * 64) * 1024 + nb * 64; t.N = 1024; t.fp8 = true; t.dst = F.ws + WS_WE2 + (size_t)mi * 1024 * 1024 + (size_t)(nb * 64) * 1024 + kb * 64; return t; } r -= R1;
    if (r < R2) { const int mi = r / 384, q = r % 384, kb = q / 24, nb = q % 24;
        t.src = PIN(F, I_AWIN) + (size_t)mi * 1024 * 1536 + (size_t)(kb * 64) * 1536 + nb * 64; t.N = 1536; t.fp8 = true; t.dst = F.ws + WS_WATT + (size_t)mi * 1536 * 1024 + (size_t)(nb * 64) * 1024 + kb * 64; return t; } r -= R2;
    if (r < R3) { const int kb = r >> 5, nb = r & 31;
        t.src = PIN(F, I_GWIN) + (size_t)(kb * 64) * 2048 + nb * 64; t.N = 2048; t.fp8 = false; t.dst = F.ws + WS_WGM + ((size_t)(nb * 64) * 1024 + kb * 64) * 2; return t; } r -= R3;
    if (r < R4) { const int kb = r / 48, nb = r % 48;
        t.src = PIN(F, I_HWIN) + (size_t)(kb * 64) * 3072 + nb * 64; t.N = 3072; t.fp8 = true; t.dst = F.ws + WS_WHY + (size_t)(nb * 64) * 1024 + kb * 64; return t; } r -= R4;
    { const int mi = r >> 8, q = r & 255, kb = q >> 4, nb = q & 15;
        t.src = PIN(F, I_WOUT) + (size_t)mi * 1024 * 1024 + (size_t)(kb * 64) * 1024 + nb * 64; t.N = 1024; t.fp8 = false; t.dst = F.ws + WS_WOUT + ((size_t)mi * 1024 * 1024 + (size_t)(nb * 64) * 1024 + kb * 64) * 2; return t; }
}
__device__ __forceinline__ void titem_load(const TItem& t, float (&v)[64], int lane) {
    const float* src = t.src + lane;
#pragma unroll
    for (int kk = 0; kk < 64; ++kk) v[kk] = src[(size_t)kk * t.N];
}
__device__ __forceinline__ void titem_finish(const TItem& t, const float (&v)[64], LAS float* scr, int lane) {
    constexpr int K = 1024;
#pragma unroll
    for (int kk = 0; kk < 64; ++kk) scr[kk * 65 + lane] = v[kk];
    LDS_WAIT(); asm volatile("" ::: "memory");
    if (!t.fp8) {
        const int c = lane & 7;
#pragma unroll
        for (int j = 0; j < 8; ++j) { const int n = (lane >> 3) + 8 * j; const LAS float* s = scr + (8 * c) * 65 + n;
            v4u o; o.x = pk2(s[0 * 65], s[1 * 65]); o.y = pk2(s[2 * 65], s[3 * 65]); o.z = pk2(s[4 * 65], s[5 * 65]); o.w = pk2(s[6 * 65], s[7 * 65]);
            *(GAS v4u*)(t.dst + ((size_t)n * K + 8 * c) * 2) = o; }
    } else {
        const int c = lane & 3;
#pragma unroll
        for (int j = 0; j < 4; ++j) { const int n = (lane >> 2) + 16 * j; const LAS float* s = scr + (16 * c) * 65 + n; unsigned w[4];
#pragma unroll
            for (int q = 0; q < 4; ++q) { unsigned x = 0; x = __builtin_amdgcn_cvt_pk_fp8_f32(32.0f * s[(4 * q) * 65], 32.0f * s[(4 * q + 1) * 65], x, false);
                x = __builtin_amdgcn_cvt_pk_fp8_f32(32.0f * s[(4 * q + 2) * 65], 32.0f * s[(4 * q + 3) * 65], x, true); w[q] = x; }
            *(GAS v4u*)(t.dst + (size_t)n * K + 16 * c) = (v4u){w[0], w[1], w[2], w[3]}; }
    }
    LDS_WAIT(); asm volatile("" ::: "memory");
}
__device__ __forceinline__ void pro0_transposes(Frame& F) {
    LAS float* scr = (LAS float*)(F.lds + F.wave * 16640);
    const int gw = F.bx * NWAVES + F.wave, NGW = F.G * NWAVES;
    constexpr int NITEMS = 128 * 512 + 128 * 256 + 2 * 384 + 512 + 768 + 4 * 256;
    float va[64], vb[64];
    int it = gw; if (it >= NITEMS) return;
    TItem ta = titem_decode(F, it), tb = ta; titem_load(ta, va, F.lane);
    for (;;) {
        const bool nb_ok = it + NGW < NITEMS; if (nb_ok) { tb = titem_decode(F, it + NGW); titem_load(tb, vb, F.lane); }
        titem_finish(ta, va, scr, F.lane);
        if (!nb_ok) break; it += NGW;
        const bool na_ok = it + NGW < NITEMS; if (na_ok) { ta = titem_decode(F, it + NGW); titem_load(ta, va, F.lane); }
        titem_finish(tb, vb, scr, F.lane);
        if (!na_ok) break; it += NGW;
    }
}
__device__ __forceinline__ void pro0_mod(Frame& F) {
    LAS float* sl = (LAS float*)F.lds;
    LAS float* red = (LAS float*)(F.lds + 65536);
    __syncthreads();
    for (int i = F.tid; i < 9 * 1024; i += NTHREADS) { const int r = i >> 10, k = i & 1023; const float v = r < 8 ? PIN(F, I_C)[r * 1024 + k] : PIN(F, I_CCTX)[k]; sl[i] = v / (1.0f + __expf(-v)); }
    __syncthreads();
    float* MOD = (float*)(F.ws + WS_MOD);
    for (int item = F.bx; item < NLAYER * 96; item += F.G) {
        const int l = item / 96, n0 = (item % 96) * 64;
        const float* W = PIN(F, I_ADAW) + (size_t)l * 1024 * 6144 + n0 + F.lane;
        float acc[9];
#pragma unroll
        for (int r = 0; r < 9; ++r) acc[r] = 0.f;
        const int kb = F.wave * 128;
#pragma unroll 16
        for (int k = 0; k < 128; ++k) { const float wv = W[(size_t)(kb + k) * 6144];
#pragma unroll
            for (int r = 0; r < 9; ++r) acc[r] += sl[r * 1024 + kb + k] * wv; }
#pragma unroll
        for (int r = 0; r < 9; ++r) red[(F.wave * 9 + r) * 64 + F.lane] = acc[r];
        __syncthreads();
        for (int i = F.tid; i < 9 * 64; i += NTHREADS) { const int r = i >> 6, n = i & 63; float s = 0.f;
#pragma unroll
            for (int w = 0; w < 8; ++w) s += red[(w * 9 + r) * 64 + n];
            MOD[((size_t)l * 9 + r) * 6144 + n0 + n] = s + PIN(F, I_ADAB)[l * 6144 + n0 + n]; }
        __syncthreads();
    }
}
__device__ __forceinline__ void pro0_filter_mlp(Frame& F) {
    const int j = F.lane, gw = F.bx * NWAVES + F.wave, NGW = F.G * NWAVES;
    LAS float* W1 = (LAS float*)F.lds; LAS float* W2 = W1 + FEMB * FH; LAS float* W3 = W2 + FH * FH;
    __syncthreads();
    for (int i = F.tid; i < FEMB * FH; i += NTHREADS) W1[i] = PIN(F, I_FW1)[i];
    for (int i = F.tid; i < FH * FH; i += NTHREADS) { W2[i] = PIN(F, I_FW2)[i]; W3[i] = PIN(F, I_FW3)[i]; }
    __syncthreads();
    const float b1 = PIN(F, I_FB1)[j], b2 = PIN(F, I_FB2)[j], b3 = PIN(F, I_FB3)[j], fr = PIN(F, I_FREQ)[j];
    for (int it = gw; it < SEQ + CL; it += NGW) {
        const bool lat = it < SEQ; const int t = lat ? it : it - SEQ; const float L = lat ? (float)SEQ : (float)CL;
        const float tl = (float)t / (L - 1.0f), w = (6.283185307179586f * (float)t) / L;
        float z;
        { const int band = (j - 1) & 15; const float f = 1e-4f + (float)band * ((15.0f - 1e-4f) / 15.0f); const float a = f * w;
          z = (j == 0) ? tl : (j <= 16 ? cosf(a) : -sinf(a)); }
        float s = b1;
#pragma unroll
        for (int i = 0; i < FEMB; ++i) s += __shfl(z, i) * W1[i * FH + j];
        const float a1 = sinf(fr * s);
        s = b2;
#pragma unroll 16
        for (int i = 0; i < FH; ++i) s += __shfl(a1, i) * W2[i * FH + j];
        const float a2 = sinf(fr * s);
        s = b3;
#pragma unroll 16
        for (int i = 0; i < FH; ++i) s += __shfl(a2, i) * W3[i * FH + j];
        const float a3 = sinf(fr * s);
        float* dst = lat ? (float*)(F.ws + WS_A3) + (size_t)t * FH : (float*)(F.ws + WS_A3C) + (size_t)t * FH;
        dst[j] = a3;
    }
    __syncthreads();
}

__device__ __forceinline__ f32x2 cmul(f32x2 a, f32x2 b) { return (f32x2){a.x * b.x - a.y * b.y, a.x * b.y + a.y * b.x}; }
__device__ __forceinline__ f32x2 cconj(f32x2 a) { return (f32x2){a.x, -a.y}; }
#define ZP(n) ((n) + ((n) >> 5))
constexpr int FFT_LDS_BYTES = (NFFT + NFFT / 32) * 8;
__device__ __forceinline__ void bfly_dif(f32x2& a0, f32x2& a1, f32x2& a2, f32x2& a3, f32x2 w) {
    const f32x2 t0 = a0 + a2, t1 = a0 - a2, t2 = a1 + a3, d = a1 - a3, t3 = (f32x2){d.y, -d.x};
    const f32x2 y0 = t0 + t2, y2 = t0 - t2, y1 = t1 + t3, y3 = t1 - t3, w2 = cmul(w, w), w3 = cmul(w2, w);
    a0 = y0; a1 = cmul(y2, w2); a2 = cmul(y1, w); a3 = cmul(y3, w3);
}
__device__ __forceinline__ void bfly_dit(f32x2& a0, f32x2& a1, f32x2& a2, f32x2& a3, f32x2 w) {
    const f32x2 w2 = cmul(w, w), w3 = cmul(w2, w), A1 = cmul(a1, w2), A2 = cmul(a2, w), A3 = cmul(a3, w3);
    const f32x2 u0 = a0 + A1, u1 = a0 - A1, u2 = A2 + A3, u3 = A2 - A3, iu3 = (f32x2){-u3.y, u3.x};
    a0 = u0 + u2; a1 = u1 + iu3; a2 = u0 - u2; a3 = u1 - iu3;
}
template <int LQ, bool INV> __device__ __forceinline__ void fft_r16(LAS f32x2* z, int tid) {
    constexpr int q16 = 1 << LQ; constexpr float inv_lb = 1.0f / (float)(16 * q16);
    constexpr float C1 = 0.92387953251128674f, S1 = 0.38268343236508977f, C2 = 0.70710678118654752f;
    asm volatile("" : "+v"(tid));
#pragma unroll 1
    for (int g = tid; g < NFFT / 16; g += NTHREADS) {
        const int j = g & (q16 - 1), base = ((g >> LQ) << (LQ + 4)) + j;
        f32x2 x[16];
#pragma unroll
        for (int m = 0; m < 16; ++m) x[m] = z[ZP(base + (m << LQ))];
        const float fr = (float)j * inv_lb; const float sn = __builtin_amdgcn_sinf(fr);
        const f32x2 w1 = (f32x2){__builtin_amdgcn_cosf(fr), INV ? sn : -sn};
        const float sg = INV ? 1.0f : -1.0f;
        const f32x2 wa0 = w1, wa1 = cmul(w1, (f32x2){C1, sg * S1}), wa2 = cmul(w1, (f32x2){C2, sg * C2}), wa3 = cmul(w1, (f32x2){S1, sg * C1});
        const f32x2 w2 = cmul(w1, w1), wb = cmul(w2, w2);
        if constexpr (!INV) {
            bfly_dif(x[0], x[4], x[8], x[12], wa0); bfly_dif(x[1], x[5], x[9], x[13], wa1); bfly_dif(x[2], x[6], x[10], x[14], wa2); bfly_dif(x[3], x[7], x[11], x[15], wa3);
#pragma unroll
            for (int a = 0; a < 4; ++a) bfly_dif(x[4 * a], x[4 * a + 1], x[4 * a + 2], x[4 * a + 3], wb);
        } else {
#pragma unroll
            for (int a = 0; a < 4; ++a) bfly_dit(x[4 * a], x[4 * a + 1], x[4 * a + 2], x[4 * a + 3], wb);
            bfly_dit(x[0], x[4], x[8], x[12], wa0); bfly_dit(x[1], x[5], x[9], x[13], wa1); bfly_dit(x[2], x[6], x[10], x[14], wa2); bfly_dit(x[3], x[7], x[11], x[15], wa3);
        }
#pragma unroll
        for (int m = 0; m < 16; ++m) z[ZP(base + (m << LQ))] = x[m];
    }
    __syncthreads();
}
template <bool INV> __device__ __forceinline__ void fft_r4_unit(LAS f32x2* z, int tid) {
    asm volatile("" : "+v"(tid));
#pragma unroll 2
    for (int bf = tid; bf < NFFT / 4; bf += NTHREADS) {
        const int base = 4 * bf; f32x2 a0 = z[ZP(base)], a1 = z[ZP(base + 1)], a2 = z[ZP(base + 2)], a3 = z[ZP(base + 3)];
        if constexpr (!INV) { const f32x2 t0 = a0 + a2, t1 = a0 - a2, t2 = a1 + a3, d = a1 - a3, t3 = (f32x2){d.y, -d.x};
            z[ZP(base)] = t0 + t2; z[ZP(base + 1)] = t0 - t2; z[ZP(base + 2)] = t1 + t3; z[ZP(base + 3)] = t1 - t3; }
        else { const f32x2 u0 = a0 + a1, u1 = a0 - a1, u2 = a2 + a3, u3 = a2 - a3, iu3 = (f32x2){-u3.y, u3.x};
            z[ZP(base)] = u0 + u2; z[ZP(base + 1)] = u1 + iu3; z[ZP(base + 2)] = u0 - u2; z[ZP(base + 3)] = u1 - iu3; }
    }
    __syncthreads();
}
__device__ __forceinline__ void fft16k_dif(LAS f32x2* z, int tid) { fft_r16<10, false>(z, tid); fft_r16<6, false>(z, tid); fft_r16<2, false>(z, tid); fft_r4_unit<false>(z, tid); }
__device__ __forceinline__ void fft16k_dit_inv(LAS f32x2* z, int tid) { fft_r4_unit<true>(z, tid); fft_r16<2, true>(z, tid); fft_r16<6, true>(z, tid); fft_r16<10, true>(z, tid); }
constexpr int KF_LD = 8256;
__device__ __forceinline__ int rev14(int p) { return (int)(__brev((unsigned)p) >> 18); }
__device__ __forceinline__ float hy_delta(int c) { const float mn = -3.0701134573253945f, mx = -15.350567286626973f; return fabsf(mn + (mx - mn) * ((float)c / 1023.0f)); }

__device__ __forceinline__ void pro1_router_split(Frame& F) {
    const float* MOD = (const float*)(F.ws + WS_MOD); unsigned char* RW3 = F.ws + WS_RW3;
    for (int ent = F.bx * NTHREADS + F.tid; ent < NLAYER * 9 * 8 * 8 * 64; ent += F.G * NTHREADS) {
        const int lane = ent & 63, kb = (ent >> 6) & 7, w = (ent >> 9) & 7, lb = ent >> 12, l = lb / 9;
        const int k0 = w * 128 + 16 * kb + 8 * (lane >> 5), e = lane & 31;
        const float* gn = PIN(F, I_N2G) + l * D; const float* sc = MOD + (size_t)lb * 6144 + 4 * 1024; const float* rw = PIN(F, I_RW) + (size_t)l * D * NE;
        unsigned ph[4], pm[4], pl[4];
#pragma unroll
        for (int j2 = 0; j2 < 4; ++j2) { const int k = k0 + 2 * j2; const float v0 = gn[k] * (1.0f + sc[k]) * rw[(size_t)k * NE + e], v1 = gn[k + 1] * (1.0f + sc[k + 1]) * rw[(size_t)(k + 1) * NE + e];
            const unsigned h = cvt_pk_bf16(v0, v1); const float r0 = v0 - __uint_as_float(h << 16), r1 = v1 - __uint_as_float(h & 0xffff0000u);
            const unsigned m = cvt_pk_bf16(r0, r1); const float s0 = r0 - __uint_as_float(m << 16), s1 = r1 - __uint_as_float(m & 0xffff0000u);
            ph[j2] = h; pm[j2] = m; pl[j2] = cvt_pk_bf16(s0, s1); }
        v4u* dst = (v4u*)(RW3 + (size_t)(ent >> 6) * 3 * 1024) + lane;
        dst[0] = (v4u){ph[0], ph[1], ph[2], ph[3]}; dst[64] = (v4u){pm[0], pm[1], pm[2], pm[3]}; dst[128] = (v4u){pl[0], pl[1], pl[2], pl[3]};
    }
}
__device__ __forceinline__ void pro1_filters(Frame& F) {
    if (F.bx < NLAYER * 9) {
        const int lb = F.bx, l = lb / 9, e = F.lane & 31, hf = F.lane >> 5; const float* sh = (const float*)(F.ws + WS_MOD) + (size_t)lb * 6144 + 3 * 1024; const float* rw = PIN(F, I_RW) + (size_t)l * D * NE;
        LAS float* red = (LAS float*)F.lds; const int k0 = F.wave * 128 + hf * 64; float acc = 0.f;
#pragma unroll 8
        for (int k = k0; k < k0 + 64; ++k) acc += sh[k] * rw[(size_t)k * NE + e];
        acc += shx(acc, 32, F.lane); if (F.lane < 32) red[F.wave * 32 + e] = acc;
        __syncthreads();
        if (F.tid < 32) { float s = PIN(F, I_RB)[l * NE + F.tid];
#pragma unroll
            for (int w = 0; w < 8; ++w) s += red[w * 32 + F.tid];
            ((float*)(F.ws + WS_RC))[lb * NE + F.tid] = s; }
    }
    LAS f32x2* z = (LAS f32x2*)F.lds;
    LAS float* wl = (LAS float*)(F.lds + AUX_OFF + 8192);
    const float* a3 = (const float*)(F.ws + WS_A3); const float* a3c = (const float*)(F.ws + WS_A3C);
    f32x2* KF = (f32x2*)(F.ws + WS_KF); float* FCT = (float*)(F.ws + WS_FCT);
    for (int u = F.bx; u < 512; u += F.G) {
        const int ca = 2 * u, cb = 2 * u + 1;
        __syncthreads();
        if (F.tid < 256) { const int which = F.tid >> 6, m = F.tid & 63; const int col = (which & 1 ? cb : ca) + (which >> 1) * 1024; wl[which * 64 + m] = PIN(F, I_FW4)[m * 2048 + col]; }
        if (F.tid < 4) { const int col = (F.tid & 1 ? cb : ca) + (F.tid >> 1) * 1024; wl[256 + F.tid] = PIN(F, I_FB4)[col]; }
        __syncthreads();
        const float da = hy_delta(ca), db = hy_delta(cb);
        const float dska = PIN(F, I_HD)[ca], dskb = PIN(F, I_HD)[cb];
        for (int t = F.tid; t < SEQ; t += NTHREADS) {
            const f32x4* ar = (const f32x4*)(a3 + (size_t)t * FH); float s0 = wl[256], s1 = wl[257], s2 = wl[258], s3 = wl[259];
#pragma unroll 8
            for (int m4 = 0; m4 < 16; ++m4) { const f32x4 a = ar[m4];
                const f32x4 w0 = *(const LAS f32x4*)(wl + 4 * m4), w1 = *(const LAS f32x4*)(wl + 64 + 4 * m4), w2 = *(const LAS f32x4*)(wl + 128 + 4 * m4), w3 = *(const LAS f32x4*)(wl + 192 + 4 * m4);
                s0 += (a.x * w0.x + a.y * w0.y) + (a.z * w0.z + a.w * w0.w); s1 += (a.x * w1.x + a.y * w1.y) + (a.z * w1.z + a.w * w1.w);
                s2 += (a.x * w2.x + a.y * w2.y) + (a.z * w2.z + a.w * w2.w); s3 += (a.x * w3.x + a.y * w3.y) + (a.z * w3.z + a.w * w3.w); }
            const float tl = (float)t / (float)(SEQ - 1); const float wa = __expf(-tl * da), wb = __expf(-tl * db);
            z[ZP(t)] = (f32x2){s0 * wa + (t == 0 ? dska : 0.f), s1 * wb + (t == 0 ? dskb : 0.f)};
            if (t == 0) z[ZP(SEQ)] = (f32x2){0.f, 0.f}; else z[ZP(NFFT - t)] = (f32x2){s2 * wa, s3 * wb};
        }
        for (int i = F.tid; i < 511; i += NTHREADS) {
            const int d = i - 255, t = d < 0 ? -d : d; const int o = d < 0 ? 2 : 0;
            const f32x4* ar = (const f32x4*)(a3c + (size_t)t * FH); float sa = wl[256 + o], sb = wl[257 + o];
            f32x4 av[16];
#pragma unroll
            for (int m4 = 0; m4 < 16; ++m4) av[m4] = ar[m4];
            __builtin_amdgcn_sched_barrier(0);
#pragma unroll
            for (int m4 = 0; m4 < 16; ++m4) {
#pragma unroll
                for (int i2 = 0; i2 < 4; ++i2) { const int m = m4 * 4 + i2; sa += av[m4][i2] * wl[o * 64 + m]; sb += av[m4][i2] * wl[(o + 1) * 64 + m]; }
                if ((m4 & 3) == 3) __builtin_amdgcn_sched_barrier(0); }
            const float tl = (float)t / (float)(CL - 1);
            FCT[(size_t)ca * 512 + d + 256] = sa * __expf(-tl * da) + (d == 0 ? dska : 0.f); FCT[(size_t)cb * 512 + d + 256] = sb * __expf(-tl * db) + (d == 0 ? dskb : 0.f);
        }
        __syncthreads();
        fft16k_dif(z, F.tid);
        for (int k = F.tid; k <= NFFT / 2; k += NTHREADS) {
            const int p = rev14(k), p2 = rev14((NFFT - k) & (NFFT - 1)); const f32x2 a = z[ZP(p)], b = z[ZP(p2)];
            KF[(size_t)ca * KF_LD + k] = (f32x2){0.5f * (a.x + b.x), 0.5f * (a.y - b.y)};
            KF[(size_t)cb * KF_LD + k] = (f32x2){0.5f * (a.y + b.y), -0.5f * (a.x - b.x)};
        }
    }
    __syncthreads();
}

__device__ __forceinline__ void hyena_conv_phase(Frame& F) {
    LAS f32x2* z = (LAS f32x2*)F.lds;
    LAS float* aux = (LAS float*)(F.lds + AUX_OFF + 8192);
    const float* VT = (const float*)(F.ws + WS_VT); const float* VTC = (const float*)(F.ws + WS_VTC); float* CT = (float*)(F.ws + WS_CT); float* CTC = (float*)(F.ws + WS_CTC);
    const f32x2* KF = (const f32x2*)(F.ws + WS_KF); const float* FCT = (const float*)(F.ws + WS_FCT);
    v4u ina[2], inb[2];
#define HC_LOADIN(u_, t_) do { const int b_ = (u_) >> 9, c_ = 2 * ((u_) & 511); const v4u* va_ = (const v4u*)((const bf16*)VT + ((size_t)b_ * 1024 + c_) * SEQ + 16 * (t_)); \
        ina[0] = va_[0]; ina[1] = va_[1]; inb[0] = va_[SEQ / 8]; inb[1] = va_[SEQ / 8 + 1]; } while (0)
    if (F.bx < NB * 512) HC_LOADIN(F.bx, F.tid);
    for (int u = F.bx; u < NB * 512; u += F.G) {
        const int b = u >> 9, cp = u & 511, ca = 2 * cp, cb = ca + 1;
        int tq = F.tid; asm volatile("" : "+v"(tq));
        __syncthreads();
        { const int n0 = 16 * tq;
#pragma unroll
          for (int i = 0; i < 4; ++i) { const unsigned a0 = ina[i >> 1][2 * (i & 1)], a1 = ina[i >> 1][2 * (i & 1) + 1], b0 = inb[i >> 1][2 * (i & 1)], b1 = inb[i >> 1][2 * (i & 1) + 1];
              z[ZP(n0 + 4 * i)] = (f32x2){bflo(a0), bflo(b0)}; z[ZP(n0 + 4 * i + 1)] = (f32x2){bfhi(a0), bfhi(b0)}; z[ZP(n0 + 4 * i + 2)] = (f32x2){bflo(a1), bflo(b1)}; z[ZP(n0 + 4 * i + 3)] = (f32x2){bfhi(a1), bfhi(b1)};
#pragma unroll
              for (int j = 0; j < 4; ++j) z[ZP(SEQ + n0 + 4 * i + j)] = (f32x2){0.f, 0.f}; } }
        f32x4 ka[8], kb[8]; f32x2 kaN, kbN;
        { const f32x4* pa = (const f32x4*)(KF + (size_t)ca * KF_LD + 16 * tq); const f32x4* pb = (const f32x4*)(KF + (size_t)cb * KF_LD + 16 * tq);
#pragma unroll
          for (int i = 0; i < 8; ++i) { ka[i] = pa[i]; kb[i] = pb[i]; }
          kaN = KF[(size_t)ca * KF_LD + NFFT / 2]; kbN = KF[(size_t)cb * KF_LD + NFFT / 2]; }
        { const int h = tq >> 8, t = tq & 255;
          const float* vc = VTC + ((size_t)b * 1024 + ca + h) * CL;
          aux[h * 256 + t] = vc[t]; aux[512 + h * 520 + 1 + t] = FCT[(size_t)(ca + h) * 512 + t]; aux[512 + h * 520 + 257 + t] = FCT[(size_t)(ca + h) * 512 + 256 + t];
          __syncthreads();
          if (tq < 256) { const int hh = tq >> 7, pp = tq & 127; const LAS float* vv = aux + hh * 256; const LAS float* kk = aux + 512 + hh * 520 + 256 + 2 * pp;
              float y0 = 0.f, y1 = 0.f, lop = kk[2];
#pragma unroll 8
              for (int q = 0; q < CL / 2; ++q) { const f32x2 v = *(const LAS f32x2*)(vv + 2 * q), kq = *(const LAS f32x2*)(kk - 2 * q);
                  y0 += v.x * kq.y + v.y * kq.x; y1 += v.x * lop + v.y * kq.y; lop = kq.x; }
              *(f32x2*)(CTC + ((size_t)b * 1024 + ca + hh) * CL + 2 * pp) = (f32x2){y0, y1}; } }
        fft16k_dif(z, F.tid);
        int tpw = tq; asm volatile("" : "+v"(tpw));
#define HC_PW(k_, Ka_, Kb_) do { const int p = rev14(k_), p2 = rev14((NFFT - (k_)) & (NFFT - 1)); const f32x2 a = z[ZP(p)], b2 = z[ZP(p2)]; \
            const f32x2 Va = (f32x2){0.5f * (a.x + b2.x), 0.5f * (a.y - b2.y)}, Vb = (f32x2){0.5f * (a.y + b2.y), -0.5f * (a.x - b2.x)}; \
            const f32x2 ya = cmul(Va, Ka_), yb = cmul(Vb, Kb_); \
            z[ZP(p)] = (f32x2){ya.x - yb.y, ya.y + yb.x}; z[ZP(p2)] = (f32x2){ya.x + yb.y, -ya.y + yb.x}; } while (0)
#pragma unroll
        for (int i = 0; i < 8; ++i) { const int k = 16 * tpw + 2 * i;
            HC_PW(k, ((f32x2){ka[i].x, ka[i].y}), ((f32x2){kb[i].x, kb[i].y})); HC_PW(k + 1, ((f32x2){ka[i].z, ka[i].w}), ((f32x2){kb[i].z, kb[i].w}));
            asm volatile("" ::: "memory"); }
        if (tpw == 0) HC_PW(NFFT / 2, kaN, kbN);
#undef HC_PW
        __syncthreads();
        if (u + F.G < NB * 512) HC_LOADIN(u + F.G, tq);
        fft16k_dit_inv(z, F.tid);
        { int to = tq; asm volatile("" : "+v"(to)); const float sc = 1.0f / (float)NFFT; const int n0 = 16 * to;
          v4u* oa = (v4u*)((bf16*)CT + ((size_t)b * 1024 + ca) * SEQ + n0);
#pragma unroll
          for (int h2 = 0; h2 < 2; ++h2) { f32x2 w[8];
#pragma unroll
              for (int j = 0; j < 8; ++j) w[j] = z[ZP(n0 + 8 * h2 + j)];
              oa[h2] = (v4u){cvt_pk_bf16(w[0].x * sc, w[1].x * sc), cvt_pk_bf16(w[2].x * sc, w[3].x * sc), cvt_pk_bf16(w[4].x * sc, w[5].x * sc), cvt_pk_bf16(w[6].x * sc, w[7].x * sc)};
              oa[SEQ / 8 + h2] = (v4u){cvt_pk_bf16(w[0].y * sc, w[1].y * sc), cvt_pk_bf16(w[2].y * sc, w[3].y * sc), cvt_pk_bf16(w[4].y * sc, w[5].y * sc), cvt_pk_bf16(w[6].y * sc, w[7].y * sc)}; } }
    }
    __syncthreads();
#undef HC_LOADIN
}
constexpr int MW_CUMBLK = 16, MW_CNT = 64, MW_SELE = 128, MW_SELV = 256, MW_LRANK = 384, MW_LBASE = 512;
__device__ __forceinline__ void moe_tables(Frame& F, int layer) {
    __syncthreads();
    if (F.tid < NE) F.MISC[MW_CNT + F.tid] = __hip_atomic_load(F.ctl + CW_CNT + layer * NE + F.tid, RLX_AGENT);
    __syncthreads();
    if (F.tid < 64) {
        const unsigned v = F.tid < NE ? (F.MISC[MW_CNT + (F.tid & 31)] + 255u) >> 8 : 0u; unsigned s = v;
#pragma unroll
        for (int d = 1; d < 32; d <<= 1) { const unsigned t = (unsigned)__builtin_amdgcn_ds_bpermute(((F.tid - d) & 63) * 4, (int)s); if ((F.tid & 63) >= d) s += t; }
        if (F.tid < NE) F.MISC[MW_CUMBLK + F.tid] = s - v;
        if (F.tid == NE - 1) F.MISC[MW_CUMBLK + NE] = s; }
    __syncthreads();
}

template <int MODE> __device__ __forceinline__ void rowpass(Frame& F, int layer, bool real = true, bool h8 = false) {
    const bool combine = (MODE == 0 && layer > 0) || MODE == 2;
    const int nrows = MODE == 2 ? ML : MT;
    const int cl = MODE == 2 ? NLAYER - 1 : layer - 1;
    const bool from_input = (MODE == 0 && layer == 0);
    const float* XLs = PIN(F, I_X); const float* XCs = PIN(F, I_CTX);
    bf16* XB = (bf16*)(F.ws + WS_XB); bf16* XBd = real ? XB : (bf16*)(F.ws + WS_P);
    const float* MOD = (const float*)(F.ws + WS_MOD);
    bf16* H = (bf16*)(F.ws + WS_H); unsigned char* H8 = (unsigned char*)(F.ws + WS_H8); const unsigned char* YM = (const unsigned char*)(F.ws + WS_YM);
    const int* TE = (const int*)(F.ws + WS_TE); const int* TR = (const int*)(F.ws + WS_TR); const float* TG = (const float*)(F.ws + WS_TG);
    const float* gnorm = MODE == 0 ? PIN(F, I_N1G) + layer * D : PIN(F, I_FG);
    if (combine) moe_tables(F, cl);
    f32x4 gn[4];
#pragma unroll
    for (int j = 0; j < 4; ++j) gn[j] = ((const f32x4*)gnorm)[F.lane + 64 * j];
    const int ntiles = nrows / 32;
    i32x4 nte[4], ntr[4]; f32x4 ntg[4];
#define RP_TABLES(tile_) do { const size_t rb_ = (size_t)((tile_) * 32 + F.wave * 4) * 4; \
        _Pragma("unroll") for (int q = 0; q < 4; ++q) { nte[q] = *(const i32x4*)(TE + rb_ + 4 * q); ntr[q] = *(const i32x4*)(TR + rb_ + 4 * q); ntg[q] = *(const f32x4*)(TG + rb_ + 4 * q); } } while (0)
    if (combine && F.bx < ntiles) RP_TABLES(F.bx);
    for (int tile = F.bx; tile < ntiles; tile += F.G) {
        const int rbase = tile * 32 + F.wave * 4; const bool lat = rbase < ML; const int bidx = lat ? (rbase >> 13) : 8;
        const float* g2 = MOD + ((size_t)(combine ? cl : 0) * 9 + bidx) * 6144 + 5 * 1024;
        const float* mb = MOD + ((size_t)layer * 9 + bidx) * 6144;
        int rid[4][4]; float gkk[4][4];
        if (combine) {
#pragma unroll
            for (int q = 0; q < 4; ++q)
#pragma unroll
                for (int k = 0; k < 4; ++k) { rid[q][k] = 256 * (int)F.MISC[MW_CUMBLK + nte[q][k]] + ntr[q][k]; gkk[q][k] = ntg[q][k]; }
            if (tile + F.G < ntiles) RP_TABLES(tile + F.G);
        }
#pragma unroll 1
        for (int pr = 0; pr < 2; ++pr) {
            size_t xo[2]; f32x4 v[2][4]; int rowid[2][4]; float gk[2][4];
#pragma unroll
            for (int u = 0; u < 2; ++u) { const int r = rbase + 2 * pr + u; xo[u] = (size_t)r * D;
                if (combine) {
#pragma unroll
                    for (int k = 0; k < 4; ++k) { rowid[u][k] = pr ? rid[2 + u][k] : rid[u][k]; gk[u][k] = pr ? gkk[2 + u][k] : gkk[u][k]; } }
                if (from_input) { const f32x4* xs = (const f32x4*)(lat ? XLs + xo[u] : XCs + (xo[u] - (size_t)ML * D));
#pragma unroll
                    for (int j = 0; j < 4; ++j) v[u][j] = xs[F.lane + 64 * j]; }
                else { const v2u* xs = (const v2u*)(XB + xo[u]);
#pragma unroll
                    for (int j = 0; j < 4; ++j) v[u][j] = bf4_f32(xs[F.lane + 64 * j]); } }
            if (combine) {
                unsigned w[2][4][4];
#pragma unroll
                for (int u = 0; u < 2; ++u)
#pragma unroll
                    for (int k = 0; k < 4; ++k) { const unsigned* yr = (const unsigned*)(YM + (size_t)rowid[u][k] * D);
#pragma unroll
                        for (int j = 0; j < 4; ++j) w[u][k][j] = yr[F.lane + 64 * j]; }
#pragma unroll
                for (int u = 0; u < 2; ++u) {
#pragma unroll
                    for (int j = 0; j < 4; ++j) { f32x4 a = (f32x4){0.f, 0.f, 0.f, 0.f};
#pragma unroll
                        for (int k = 0; k < 4; ++k) { const f32x2 lo = __builtin_amdgcn_cvt_pk_f32_fp8(w[u][k][j], false), hi2 = __builtin_amdgcn_cvt_pk_f32_fp8(w[u][k][j], true); a += gk[u][k] * (f32x4){lo.x, lo.y, hi2.x, hi2.y}; }
                        v[u][j] += ((const f32x4*)g2)[F.lane + 64 * j] * a; }
                    if (MODE == 0) { v2u* xd = (v2u*)(XBd + xo[u]);
#pragma unroll
                        for (int j = 0; j < 4; ++j) { v2u o; o.x = cvt_pk_bf16(v[u][j].x, v[u][j].y); o.y = cvt_pk_bf16(v[u][j].z, v[u][j].w); xd[F.lane + 64 * j] = o; } } }
            }
            if (from_input) {
#pragma unroll
                for (int u = 0; u < 2; ++u) { v2u* xd = (v2u*)(XBd + xo[u]);
#pragma unroll
                    for (int j = 0; j < 4; ++j) { v2u o; o.x = cvt_pk_bf16(v[u][j].x, v[u][j].y); o.y = cvt_pk_bf16(v[u][j].z, v[u][j].w); xd[F.lane + 64 * j] = o; } } }
#pragma unroll
            for (int u = 0; u < 2; ++u) { const int r = rbase + 2 * pr + u;
                float ss = 0.f;
#pragma unroll
                for (int j = 0; j < 4; ++j) ss += (v[u][j].x * v[u][j].x + v[u][j].y * v[u][j].y) + (v[u][j].z * v[u][j].z + v[u][j].w * v[u][j].w);
                const float rstd = 1.0f / sqrtf(wave_sum(ss, F.lane) * (1.0f / D) + EPS);
                if (MODE == 2) { f32x4* od = (f32x4*)((real ? F.out : (float*)(F.ws + WS_P)) + xo[u]);
#pragma unroll
                    for (int j = 0; j < 4; ++j) od[F.lane + 64 * j] = v[u][j] * rstd * gn[j]; }
                else { v2u* hd = (v2u*)(H + (size_t)r * D); unsigned* hd8 = (unsigned*)(H8 + (size_t)r * D);
#pragma unroll
                    for (int j = 0; j < 4; ++j) { const f32x4 sh = ((const f32x4*)mb)[F.lane + 64 * j], sc = ((const f32x4*)(mb + 1024))[F.lane + 64 * j]; const f32x4 hv = v[u][j] * rstd * gn[j] * (sc + 1.0f) + sh;
                        if (h8) { unsigned o = 0; o = __builtin_amdgcn_cvt_pk_fp8_f32(hv.x, hv.y, o, false); o = __builtin_amdgcn_cvt_pk_fp8_f32(hv.z, hv.w, o, true); hd8[F.lane + 64 * j] = o; }
                        else { v2u o; o.x = cvt_pk_bf16(hv.x, hv.y); o.y = cvt_pk_bf16(hv.z, hv.w); hd[F.lane + 64 * j] = o; } } }
            }
        }
    }
}

typedef float f32x16r __attribute__((ext_vector_type(16)));
__device__ __forceinline__ void router_phase(Frame& F, int layer, bool real = true, int xp = 0) {
    const bool last = layer == NLAYER - 1;
    const int ntiles = (last ? ML : MT) / 32;
    LAS float* PART = (LAS float*)F.lds;
    LAS float* SSQ = PART + 8 * 32 * 33;
    LAS float* LG = SSQ + 8 * 32;
    LAS float* RSTD = LG + 32 * 33;
    LAS unsigned* CW = (LAS unsigned*)(RSTD + 32);
    LAS unsigned* RUN = CW + 64;
    LAS float* AV = (LAS float*)(RUN + 32);
    LAS float* SHV = AV + 1024;
    LAS float* RCV = SHV + 1024;
    LAS int* TRL = (LAS int*)((LAS unsigned char*)(RCV + 32) + 8 * (32 * 272));
    LAS bf16* STG = (LAS bf16*)((LAS unsigned char*)(RCV + 32) + F.wave * (32 * 272));
    const bf16* XB = (const bf16*)(F.ws + WS_XB);
    const float* MOD = (const float*)(F.ws + WS_MOD); const float* RC = (const float*)(F.ws + WS_RC);
    unsigned char* H8 = (unsigned char*)(F.ws + WS_H8);
    int* TE = (int*)(F.ws + WS_TE); int* TR = (int*)(F.ws + WS_TR); float* TG = (float*)(F.ws + WS_TG); int* ROWTOK = (int*)(F.ws + WS_ROWTOK);
    const float* gn = PIN(F, I_N2G) + layer * D; const float* rw = PIN(F, I_RW) + (size_t)layer * D * NE;
    const int i = F.lane & 31, hf = F.lane >> 5, lr = F.lane >> 4, lc = F.lane & 15, kw = F.wave * 128;
    const int per = 2048 / F.G;
    const int nmine = (2048 % F.G == 0) ? per + ((2048 + F.bx < ntiles) ? 1 : 0) : 0;
#define RT_TILE(n_) ((2048 % F.G == 0) ? ((n_) < per ? F.bx * per + (n_) : 2048 + F.bx) : F.bx + (n_) * F.G)
    const int ncnt = (2048 % F.G == 0) ? nmine : (F.bx < ntiles ? (ntiles - 1 - F.bx) / F.G + 1 : 0);
    __syncthreads();
    if (F.tid < NE) RUN[F.tid] = 0u;
    bf16x8 bw[8][2];
    v2u rawp[16];
#define RT_LOADX(tile_) do { const int rb_ = (tile_) * 32 + lr; const bf16* xb_ = XB + (size_t)rb_ * D + kw + 4 * lc; \
        _Pragma("unroll") for (int q = 0; q < 16; ++q) rawp[q] = *(const v2u*)(xb_ + (size_t)(4 * (q & 7)) * D + 64 * (q >> 3)); } while (0)
    if (ncnt > 0) RT_LOADX(RT_TILE(0));
    int cur_b = -1;
    for (int n = 0; n < ncnt; ++n) {
        const int tile = RT_TILE(n);
        const int r0 = tile * 32; const bool lat = r0 < ML; const int bidx = lat ? (r0 >> 13) : 8; const int r = r0 + i;
        if (bidx != cur_b) {
            cur_b = bidx; const float* mb = MOD + ((size_t)layer * 9 + bidx) * 6144 + 3 * 1024;
            __syncthreads();
            for (int k = F.tid; k < 1024; k += NTHREADS) { AV[k] = gn[k] * (1.0f + mb[1024 + k]); SHV[k] = mb[k]; }
            if (F.tid < NE) RCV[F.tid] = RC[((size_t)layer * 9 + bidx) * NE + F.tid];
            __syncthreads();
            { const v4u* src = (const v4u*)(F.ws + WS_RW3 + ((size_t)(layer * 9 + bidx) * 8 + F.wave) * 8 * 3 * 1024) + F.lane;
#pragma unroll
              for (int kb = 0; kb < 8; ++kb)
#pragma unroll
                  for (int t = 0; t < 2; ++t) bw[kb][t] = __builtin_bit_cast(bf16x8, src[(kb * 3 + t) * 64]); }
        }
        { float s8[8];
#pragma unroll
          for (int q = 0; q < 8; ++q) { const f32x4 a = bf4_f32(rawp[q]), b = bf4_f32(rawp[q + 8]); s8[q] = ((a.x * a.x + a.y * a.y) + (a.z * a.z + a.w * a.w)) + ((b.x * b.x + b.y * b.y) + (b.z * b.z + b.w * b.w)); }
#pragma unroll
          for (int q = 0; q < 8; ++q) { float v = s8[q]; v += shx(v, 1, F.lane); v += shx(v, 2, F.lane); v += shx(v, 4, F.lane); v += shx(v, 8, F.lane); if (lc == 0) SSQ[F.wave * 32 + 4 * q + lr] = v; } }
        __syncthreads();
        const f32x4 av0 = ((const LAS f32x4*)(AV + kw))[lc], av1 = ((const LAS f32x4*)(AV + kw))[lc + 16];
        { const f32x4 sh0 = ((const LAS f32x4*)(SHV + kw))[lc], sh1 = ((const LAS f32x4*)(SHV + kw))[lc + 16];
          unsigned char* hb = H8 + (size_t)(r0 + lr) * D + kw + 4 * lc;
#pragma unroll
          for (int q = 0; q < 8; ++q) { float qs = 0.f;
#pragma unroll
              for (int w = 0; w < 8; ++w) qs += SSQ[w * 32 + 4 * q + lr];
              const float rs = 1.0f / sqrtf(qs * (1.0f / D) + EPS);
#pragma unroll
              for (int hq = 0; hq < 2; ++hq) { const f32x4 h = bf4_f32(rawp[q + 8 * hq]) * (rs * (hq ? av1 : av0)) + (hq ? sh1 : sh0); unsigned w = 0;
                  w = __builtin_amdgcn_cvt_pk_fp8_f32(h.x, h.y, w, false); w = __builtin_amdgcn_cvt_pk_fp8_f32(h.z, h.w, w, true);
                  *(unsigned*)(hb + (size_t)(4 * q) * D + 64 * hq) = w; } } }
        f32x16r acc = {};
        asm volatile("s_waitcnt lgkmcnt(0)" ::: "memory");
#pragma unroll
        for (int q = 0; q < 16; ++q) *(LAS v2u*)(STG + (4 * (q & 7) + lr) * 136 + 4 * lc + 64 * (q >> 3)) = rawp[q];
        asm volatile("s_waitcnt lgkmcnt(0)" ::: "memory");
        if (n + 1 < ncnt) RT_LOADX(RT_TILE(n + 1));
#pragma unroll
        for (int kb = 0; kb < 8; ++kb) { const bf16x8 a = *(const LAS bf16x8*)(STG + i * 136 + 16 * kb + 8 * hf);
#pragma unroll
            for (int t = 0; t < 2; ++t) acc = __builtin_amdgcn_mfma_f32_32x32x16_bf16(a, bw[kb][t], acc, 0, 0, 0); }
#pragma unroll
        for (int rg = 0; rg < 16; ++rg) PART[(F.wave * 32 + ((rg & 3) + 8 * (rg >> 2) + 4 * hf)) * 33 + i] = acc[rg];
        __syncthreads();
        { const int tk = F.tid >> 4, e0 = (F.tid & 15) * 2; float q = 0.f, s0 = 0.f, s1 = 0.f;
#pragma unroll
          for (int w = 0; w < 8; ++w) { q += SSQ[w * 32 + tk]; s0 += PART[(w * 32 + tk) * 33 + e0]; s1 += PART[(w * 32 + tk) * 33 + e0 + 1]; }
          const float rstd = 1.0f / sqrtf(q * (1.0f / D) + EPS);
          LG[tk * 33 + e0] = rstd * s0 + RCV[e0]; LG[tk * 33 + e0 + 1] = rstd * s1 + RCV[e0 + 1]; }
        __syncthreads();
        { const int tk = F.tid >> 4, e0 = (F.tid & 15) * 2; const LAS float* lg = LG + tk * 33; const float l0 = lg[e0], l1 = lg[e0 + 1]; int rk0 = 0, rk1 = 0;
#pragma unroll 8
          for (int j = 0; j < NE; ++j) { const float o = lg[j]; rk0 += (o > l0 || (o == l0 && j < e0)) ? 1 : 0; rk1 += (o > l1 || (o == l1 && j < e0 + 1)) ? 1 : 0; }
          if (rk0 < 4) { F.MISC[MW_SELE + tk * 4 + rk0] = (unsigned)e0; F.MISC[MW_SELV + tk * 4 + rk0] = __float_as_uint(l0); }
          if (rk1 < 4) { F.MISC[MW_SELE + tk * 4 + rk1] = (unsigned)(e0 + 1); F.MISC[MW_SELV + tk * 4 + rk1] = __float_as_uint(l1); } }
        __syncthreads();
        int my = 0, lrk = 0;
        if (F.wave < 2) { const int a = F.tid; my = (int)F.MISC[MW_SELE + a];
            { const float vk = __uint_as_float(F.MISC[MW_SELV + a]), v0 = __uint_as_float(F.MISC[MW_SELV + (a & ~3)]);
              const float ex = __expf(vk - v0); float sm = ex; sm += shx(sm, 1, F.lane); sm += shx(sm, 2, F.lane);
              const size_t idx = ((size_t)r0 + (a >> 2)) * 4 + (a & 3); TG[idx] = ex / sm; TE[idx] = my; }
            unsigned cm = 0;
#pragma unroll 2
            for (int e = 0; e < NE; ++e) { const unsigned long long m = __ballot(my == e); const unsigned pc = (unsigned)__popcll(m);
                if (my == e) lrk = (int)__builtin_amdgcn_mbcnt_hi((unsigned)(m >> 32), __builtin_amdgcn_mbcnt_lo((unsigned)m, 0u)); if (F.lane == e) cm = pc; }
            if (F.lane < NE) CW[F.wave * 32 + F.lane] = cm; }
        __syncthreads();
        if (F.wave < 2) { const int a = F.tid; const int brank = (int)RUN[my] + lrk + (F.wave == 1 ? (int)CW[my] : 0); TRL[n * 128 + a] = (my << 16) | brank; }
        __syncthreads();
        if (F.tid < NE) RUN[F.tid] += CW[F.tid] + CW[32 + F.tid];
    }
    VM_WAIT(); __syncthreads();
    if (F.tid < NE) { const unsigned cnt = RUN[F.tid]; unsigned base = 0;
        if (cnt) base = __hip_atomic_fetch_add(F.ctl + CW_CNT + (real ? layer : NLAYER) * NE + F.tid, cnt, RLX_AGENT);
        F.MISC[MW_LBASE + F.tid] = base; }
    __syncthreads();
    if (real) for (int n = F.tid >> 7; n < ncnt; n += 4) { const int r0 = RT_TILE(n) * 32, a = F.tid & 127;
        const int v = TRL[n * 128 + a], e = v >> 16, rank = (v & 0xffff) + (int)F.MISC[MW_LBASE + e]; const size_t idx = ((size_t)r0 + (a >> 2)) * 4 + (a & 3);
        TR[idx] = rank; ROWTOK[(size_t)e * MT + rank] = r0 + (a >> 2); }
    __syncthreads();
#undef RT_LOADX
#undef RT_TILE
}

__device__ __forceinline__ void normrope16(float (&x)[16], const float* gain, bool lat, int prow, int pcol, const LAS f32x2* T, int L, float oscale, int lane) {
    float ss = 0.f;
#pragma unroll
    for (int i = 0; i < 16; ++i) ss += x[i] * x[i];
    ss += shx(ss, 1, lane); ss += shx(ss, 2, lane); ss += shx(ss, 4, lane);
    const float rstd = 1.0f / sqrtf(ss * (1.0f / 128.0f) + EPS);
    const int o = (L & 7) * 16;
#pragma unroll
    for (int i = 0; i < 16; ++i) x[i] = x[i] * rstd * gain[o + i];
    float p[16];
#pragma unroll
    for (int i = 0; i < 16; ++i) p[i] = shx(x[i], 2, lane);
    if (lat) {
        const int pos = (L & 4) ? pcol : prow; const float sgn = (L & 2) ? 1.0f : -1.0f; const LAS f32x2* t = T + pos * 32 + (L & 1) * 16;
#pragma unroll
        for (int i = 0; i < 16; ++i) { const f32x2 cs = t[i]; x[i] = x[i] * cs.x + sgn * p[i] * cs.y; }
    }
#pragma unroll
    for (int i = 0; i < 16; ++i) x[i] *= oscale;
}
__device__ __forceinline__ void qkprep_phase(Frame& F, int j) {
    LAS f32x2* T = (LAS f32x2*)F.lds;
    __syncthreads();
    for (int i = F.tid; i < 128 * 32; i += NTHREADS) { const int pos = i >> 5, f = i & 31; const float inv = powf(10000.0f, -(float)f / 32.0f); const float ang = (float)pos * inv; float s, c; sincosf(ang, &s, &c); T[i] = (f32x2){c, s}; }
    __syncthreads();
    const bf16* P = (const bf16*)(F.ws + WS_P); unsigned char* Q8 = (unsigned char*)(F.ws + WS_QB); unsigned char* K8 = (unsigned char*)(F.ws + WS_QB + WS_K8_OFF); unsigned char* VT8 = (unsigned char*)(F.ws + WS_KVB);
    const float* qg = PIN(F, I_AQG) + j * 128; const float* kg = PIN(F, I_AKG) + j * 128;
    if (F.bx == 0 && F.tid == 0) { float qm = 0.f, km = 0.f; for (int i = 0; i < 128; ++i) { qm = fmaxf(qm, fabsf(qg[i])); km = fmaxf(km, fabsf(kg[i])); }
        const float sig = att::SCALE * 1.4426950408889634f * 11.3137085f * qm * km;
        ((float*)(F.ws + WS_RC))[2048 + j] = -fminf(-2.0f, 8.0f - 7.0f * sig); }
    const int gw = F.bx * NWAVES + F.wave, NGW = F.G * NWAVES, L = F.lane;
#define QK_UNPACK(x, a, c) do { x[0] = bflo(a.x); x[1] = bfhi(a.x); x[2] = bflo(a.y); x[3] = bfhi(a.y); x[4] = bflo(a.z); x[5] = bfhi(a.z); x[6] = bflo(a.w); x[7] = bfhi(a.w); \
        x[8] = bflo(c.x); x[9] = bfhi(c.x); x[10] = bflo(c.y); x[11] = bfhi(c.y); x[12] = bflo(c.z); x[13] = bfhi(c.z); x[14] = bflo(c.w); x[15] = bfhi(c.w); } while (0)
#define QK_PACK(o, x) do { _Pragma("unroll") for (int w4 = 0; w4 < 4; ++w4) { unsigned w = 0; w = __builtin_amdgcn_cvt_pk_fp8_f32(x[4 * w4], x[4 * w4 + 1], w, false); w = __builtin_amdgcn_cvt_pk_fp8_f32(x[4 * w4 + 2], x[4 * w4 + 3], w, true); o[w4] = w; } } while (0)
    const float qscale = att::SCALE * 1.4426950408889634f * 8.0f;
    int rfirst = gw;
    if (F.G * NWAVES * 32 == ML) {
        v4u nq[4][2], nk[2];
#define QK4_LOAD(it_) do { _Pragma("unroll") for (int k = 0; k < 4; ++k) { const bf16* pr_ = P + (size_t)(gw + (4 * (it_) + k) * NGW) * 1536 + 16 * L; nq[k][0] = *(const v4u*)pr_; nq[k][1] = *(const v4u*)(pr_ + 8); } \
        { const bf16* pk_ = P + (size_t)(gw + (4 * (it_) + (L >> 4)) * NGW) * 1536 + 1024 + 16 * (L & 15); nk[0] = *(const v4u*)pk_; nk[1] = *(const v4u*)(pk_ + 8); } } while (0)
        QK4_LOAD(0);
#pragma unroll 1
        for (int it = 0; it < 8; ++it) {
            v4u q[4][2], kk[2];
#pragma unroll
            for (int k = 0; k < 4; ++k) { q[k][0] = nq[k][0]; q[k][1] = nq[k][1]; }
            kk[0] = nk[0]; kk[1] = nk[1];
            if (it + 1 < 8) QK4_LOAD(it + 1);
#pragma unroll
            for (int k = 0; k < 4; ++k) { const int r = gw + (4 * it + k) * NGW, s = r & (SEQ - 1); float x[16];
                QK_UNPACK(x, q[k][0], q[k][1]);
                normrope16(x, qg, true, s >> 6, s & 63, T, L, qscale, L);
                v4u o; QK_PACK(o, x); *(v4u*)(Q8 + (size_t)r * D + 16 * L) = o; }
            { const int r = gw + (4 * it + (L >> 4)) * NGW, s = r & (SEQ - 1), Lk = L & 15; float x[16];
              QK_UNPACK(x, kk[0], kk[1]);
              normrope16(x, kg, true, s >> 6, s & 63, T, Lk, 1.0f, L);
              v4u o; QK_PACK(o, x); *(v4u*)(K8 + ((size_t)(r >> 13) * SKV + s) * 256 + 16 * Lk) = o; }
        }
#undef QK4_LOAD
        rfirst = gw + 32 * NGW;
    }
    v4u nqa, nqc, nka, nkc;
#define QK_LOAD(r_) do { const bf16* pr_ = P + (size_t)(r_) * 1536; nqa = *(const v4u*)(pr_ + 16 * L); nqc = *(const v4u*)(pr_ + 16 * L + 8); nka = *(const v4u*)(pr_ + 1024 + 16 * (L & 15)); nkc = *(const v4u*)(pr_ + 1024 + 16 * (L & 15) + 8); } while (0)
    if (rfirst < MT) QK_LOAD(rfirst);
    for (int r = rfirst; r < MT; r += NGW) {
        const v4u qa_ = nqa, qc_ = nqc, ka_ = nka, kc_ = nkc;
        if (r + NGW < MT) QK_LOAD(r + NGW);
        const bool lat = r < ML; const int b = lat ? (r >> 13) : ((r - ML) >> 8); const int s = lat ? (r & (SEQ - 1)) : ((r - ML) & (CL - 1));
        const int prow = s >> 6, pcol = s & 63; const size_t kvrow = (size_t)b * SKV + (lat ? s : SEQ + s);
        { float x[16]; QK_UNPACK(x, qa_, qc_);
          normrope16(x, qg, lat, prow, pcol, T, L, qscale, L);
          v4u o; QK_PACK(o, x); *(v4u*)(Q8 + (size_t)r * D + 16 * L) = o; }
        { const int Lk = L & 15; float x[16]; QK_UNPACK(x, ka_, kc_);
          normrope16(x, kg, lat, prow, pcol, T, Lk, 1.0f, L);
          if (L < 16) { v4u o; QK_PACK(o, x); *(v4u*)(K8 + kvrow * 256 + 16 * L) = o; } }
    }
#undef QK_LOAD
#undef QK_UNPACK
#undef QK_PACK
    LAS unsigned char* Tt = F.lds + 32768;
    for (int tile = F.bx; tile < NB * (SKV / 64); tile += F.G) {
        const int b = tile / (SKV / 64), kb = tile % (SKV / 64), ki = F.tid >> 3, seg = F.tid & 7, pos = kb * 64 + ki;
        const size_t r = pos < SEQ ? (size_t)b * SEQ + pos : (size_t)ML + (size_t)b * CL + (pos - SEQ);
        const int k5 = ki & 31, slot = 32 * ((k5 >> 2) & 1) + ((k5 & 3) | ((k5 >> 3) << 2)) + (ki >= 32 ? 16 : 0);
        const v4u* src = (const v4u*)(P + r * 1536 + 1280 + 32 * seg);
        __syncthreads();
#pragma unroll
        for (int q = 0; q < 4; ++q) { const v4u w = src[q]; const unsigned ww[4] = {w.x, w.y, w.z, w.w};
#pragma unroll
            for (int e2 = 0; e2 < 4; ++e2) { const unsigned pk = __builtin_amdgcn_cvt_pk_fp8_f32(bflo(ww[e2]), bfhi(ww[e2]), 0u, false); const int dd = 32 * seg + 8 * q + 2 * e2;
                Tt[dd * 64 + slot] = (unsigned char)(pk & 0xff); Tt[(dd + 1) * 64 + slot] = (unsigned char)((pk >> 8) & 0xff); } }
        __syncthreads();
        { const int rho = F.tid >> 1, half = F.tid & 1; const v4u a = *(const LAS v4u*)(Tt + rho * 64 + 32 * half), c = *(const LAS v4u*)(Tt + rho * 64 + 32 * half + 16);
          unsigned char* dst = VT8 + ((size_t)(b * 2 + (rho >> 7)) * 128 + (rho & 127)) * SKV + kb * 64 + 32 * half;
          *(v4u*)dst = a; *(v4u*)(dst + 16) = c; }
    }
    __syncthreads();
}
template <int XV = 0>
__device__ __forceinline__ void attention_phase(Frame& F, char* lds_generic, bool ctx_queries, int j) {
    const float nb = -((const float*)(F.ws + WS_RC))[2048 + j] - 8.0f;
    const unsigned char* Q8 = (const unsigned char*)(F.ws + WS_QB); const unsigned char* K8 = (const unsigned char*)(F.ws + WS_QB + WS_K8_OFF); const unsigned char* VT8 = (const unsigned char*)(F.ws + WS_KVB); bf16* Y = (bf16*)(F.ws + WS_Y);
    const int nunits = 2048 + (ctx_queries ? 64 : 0);
    for (int u = F.bx; u < nunits; u += F.G) {
        if (u < 2048) { const int b = u >> 8, w = u & 255, h = w & 7, qb = w >> 3; const size_t qo = ((size_t)b * SEQ + (size_t)qb * 256) * D + h * 128;
            att::attn_dense_body<XV>(Q8 + qo, K8 + (size_t)b * SKV * 256 + (h >> 2) * 128, VT8 + (size_t)(b * 2 + (h >> 2)) * 128 * SKV, SKV, Y + qo, SKV, lds_generic, F.wave, nb); }
        else { const int w = u - 2048, b = w >> 3, h = w & 7; const size_t qo = ((size_t)ML + (size_t)b * CL) * D + h * 128;
            att::attn_dense_body<XV>(Q8 + qo, K8 + ((size_t)b * SKV + SEQ) * 256 + (h >> 2) * 128, VT8 + (size_t)(b * 2 + (h >> 2)) * 128 * SKV + SEQ, SKV, Y + qo, CL, lds_generic, F.wave, nb); }
    }
}

__device__ __forceinline__ void gmlp_mix_phase(Frame& F) {
    constexpr int LDA = 136, LDO = 132;
    LAS bf16* As = (LAS bf16*)F.lds;
    LAS bf16* Vt = (LAS bf16*)(F.lds + 128 * LDA * 2);
    LAS float* rs = (LAS float*)(F.lds + 2 * 128 * LDA * 2);
    LAS float* Ot = (LAS float*)(F.lds + 2 * 128 * LDA * 2 + 512);
    const bf16* P = (const bf16*)(F.ws + WS_P); bf16* Y = (bf16*)(F.ws + WS_Y); const float* SS = (const float*)(F.ws + WS_SS);
    const float* ws = PIN(F, I_GWS); const float* bs = PIN(F, I_GBS); const float* vg = PIN(F, I_GVG);
    const int r32 = F.lane & 31, hi = F.lane >> 5;
    constexpr int NU = (MT / 128) * 8;
    struct GIn { f32x4 s; v4u v[4], uu[4]; } ga, gb; int gcur = -1;
#define GM_LOAD(u_, IN) do { const int g_ = (u_) & 7; const size_t row0_ = (size_t)((u_) >> 3) * 128; \
        IN.s = *(const f32x4*)(SS + (row0_ + (F.tid >> 2)) * 16 + (F.tid & 3) * 4);                                       \
        _Pragma("unroll") for (int k = 0; k < 4; ++k) { const int i_ = F.tid + NTHREADS * k, q_ = i_ >> 4, c8_ = (i_ & 15) * 8; const bf16* pp_ = P + (row0_ + q_) * 2048 + g_ * 128 + c8_; \
            IN.v[k] = *(const v4u*)(pp_ + 1024); IN.uu[k] = *(const v4u*)pp_; } } while (0)
#define GM_UNIT(u_, IN) do { \
        const int chunk = (u_) >> 3, g = (u_) & 7; const size_t row0 = (size_t)chunk * 128; \
        __syncthreads(); \
        if (g != gcur) { gcur = g; \
            for (int i = F.tid; i < 128 * 32; i += NTHREADS) { const int p = i >> 5, q4 = (i & 31) * 4; const f32x4 w = *(const f32x4*)(ws + ((size_t)g * 128 + p) * 128 + q4); \
                v2u o; o.x = pk2(w.x, w.y); o.y = pk2(w.z, w.w); *(LAS v2u*)(As + p * LDA + q4) = o; } } \
        { float s = (IN.s.x + IN.s.y) + (IN.s.z + IN.s.w); s += shx(s, 1, F.lane); s += shx(s, 2, F.lane); if ((F.tid & 3) == 0) rs[F.tid >> 2] = 1.0f / sqrtf(s * (1.0f / 1024.0f) + EPS); } \
        __syncthreads(); \
        _Pragma("unroll") for (int k = 0; k < 4; ++k) { const int i = F.tid + NTHREADS * k, q = i >> 4, c8 = (i & 15) * 8; const float rq = rs[q]; const unsigned ww[4] = {IN.v[k].x, IN.v[k].y, IN.v[k].z, IN.v[k].w}; \
            _Pragma("unroll") for (int e2 = 0; e2 < 4; ++e2) { const unsigned pk = cvt_pk_bf16(bflo(ww[e2]) * rq, bfhi(ww[e2]) * rq); Vt[(c8 + 2 * e2) * LDA + q] = (bf16)(pk & 0xffff); Vt[(c8 + 2 * e2 + 1) * LDA + q] = (bf16)(pk >> 16); } } \
        __syncthreads(); \
        const int p0 = (F.wave >> 1) * 32, cbase = (F.wave & 1) * 64; \
        f32x16 acc0 = {}, acc1 = {}; \
        _Pragma("unroll") for (int ks = 0; ks < 8; ++ks) { const int k0 = ks * 16 + hi * 8; \
            const bf16x8 a = *(const LAS bf16x8*)(As + (p0 + r32) * LDA + k0); \
            const bf16x8 b0 = *(const LAS bf16x8*)(Vt + (cbase + r32) * LDA + k0), b1 = *(const LAS bf16x8*)(Vt + (cbase + 32 + r32) * LDA + k0); \
            acc0 = __builtin_amdgcn_mfma_f32_32x32x16_bf16(a, b0, acc0, 0, 0, 0); acc1 = __builtin_amdgcn_mfma_f32_32x32x16_bf16(a, b1, acc1, 0, 0, 0); } \
        _Pragma("unroll") for (int t = 0; t < 2; ++t) { const int cl = cbase + t * 32 + r32; const float gain = vg[g * 128 + cl]; \
            _Pragma("unroll") for (int reg = 0; reg < 16; ++reg) { const int p = p0 + (reg & 3) + 8 * (reg >> 2) + 4 * hi; Ot[p * LDO + cl] = gain * (t == 0 ? acc0[reg] : acc1[reg]) + bs[g * 128 + p]; } } \
        __syncthreads(); \
        _Pragma("unroll") for (int k = 0; k < 4; ++k) { const int i = F.tid + NTHREADS * k, p = i >> 4, c8 = (i & 15) * 8; const v4u uw = IN.uu[k]; \
            const LAS float* o = Ot + p * LDO + c8; const f32x4 m0 = *(const LAS f32x4*)o, m1 = *(const LAS f32x4*)(o + 4); \
            v4u w; w.x = cvt_pk_bf16(bflo(uw.x) * m0.x, bfhi(uw.x) * m0.y); w.y = cvt_pk_bf16(bflo(uw.y) * m0.z, bfhi(uw.y) * m0.w); \
            w.z = cvt_pk_bf16(bflo(uw.z) * m1.x, bfhi(uw.z) * m1.y); w.w = cvt_pk_bf16(bflo(uw.w) * m1.z, bfhi(uw.w) * m1.w); \
            *(v4u*)(Y + (row0 + p) * D + g * 128 + c8) = w; } } while (0)
    int u = F.bx;
    if (u < NU) GM_LOAD(u, ga);
    for (; u < NU; u += 2 * F.G) {
        if (u + F.G < NU) GM_LOAD(u + F.G, gb);
        GM_UNIT(u, ga);
        if (u + F.G >= NU) break;
        if (u + 2 * F.G < NU) GM_LOAD(u + 2 * F.G, ga);
        GM_UNIT(u + F.G, gb);
    }
    __syncthreads();
#undef GM_LOAD
#undef GM_UNIT
}

__device__ __forceinline__ void hyena_prep_phase(Frame& F) {
    LAS float* tl = (LAS float*)F.lds;
    const bf16* P = (const bf16*)(F.ws + WS_P); bf16* X0 = (bf16*)(F.ws + WS_X0); bf16* VG = (bf16*)(F.ws + WS_VG);
    float* VT = (float*)(F.ws + WS_VT); float* VTC = (float*)(F.ws + WS_VTC);
    const float* cw = PIN(F, I_HCW); const float* cb = PIN(F, I_HCB);
    const int tt = F.tid >> 3, cg = F.tid & 7;
    constexpr int NU = (MT / 64) * 16;
    v4u pa[3][3], pb[3][3];
#define HP_LOAD(u_, IN) do { const int tb_ = (u_) >> 4, c0_ = ((u_) & 15) * 64, r0_ = tb_ * 64; const bool lat_ = r0_ < ML; \
        const int s_ = (lat_ ? (r0_ & (SEQ - 1)) : ((r0_ - ML) & (CL - 1))) + tt, L_ = lat_ ? SEQ : CL; const bf16* pr_ = P + (size_t)(r0_ + tt) * 3072 + c0_ + cg * 8; const v4u z0_ = {0u, 0u, 0u, 0u}; \
        _Pragma("unroll") for (int seg = 0; seg < 3; ++seg) { IN[seg][0] = s_ > 0 ? *(const v4u*)(pr_ + seg * 1024 - 3072) : z0_; IN[seg][1] = *(const v4u*)(pr_ + seg * 1024); \
            IN[seg][2] = s_ < L_ - 1 ? *(const v4u*)(pr_ + seg * 1024 + 3072) : z0_; } } while (0)
    LAS float* wl = tl + 64 * 65; int c0w = -1;
#define HP_UNIT(u_, IN) do { \
        const int tb = (u_) >> 4, c0 = ((u_) & 15) * 64; const int r0 = tb * 64; const bool lat = r0 < ML; \
        const int b = lat ? (r0 >> 13) : ((r0 - ML) >> 8), s0 = lat ? (r0 & (SEQ - 1)) : ((r0 - ML) & (CL - 1)); \
        const int r = r0 + tt, c = c0 + cg * 8; \
        if (c0 != c0w) { c0w = c0; __syncthreads(); \
            for (int i = F.tid; i < 768; i += NTHREADS) { const int seg = i >> 8, k = (i >> 6) & 3, ch = i & 63; wl[i] = k < 3 ? cw[k * 3072 + seg * 1024 + c0 + ch] : cb[seg * 1024 + c0 + ch]; } \
            __syncthreads(); } \
        float o[3][8]; \
        _Pragma("unroll") for (int seg = 0; seg < 3; ++seg) { \
            const unsigned pmw[4] = {IN[seg][0].x, IN[seg][0].y, IN[seg][0].z, IN[seg][0].w}, pcw[4] = {IN[seg][1].x, IN[seg][1].y, IN[seg][1].z, IN[seg][1].w}, pnw[4] = {IN[seg][2].x, IN[seg][2].y, IN[seg][2].z, IN[seg][2].w}; \
            _Pragma("unroll") for (int i = 0; i < 8; ++i) { const float xm = (i & 1) ? bfhi(pmw[i >> 1]) : bflo(pmw[i >> 1]), xc = (i & 1) ? bfhi(pcw[i >> 1]) : bflo(pcw[i >> 1]), xn = (i & 1) ? bfhi(pnw[i >> 1]) : bflo(pnw[i >> 1]); \
                const LAS float* wp = wl + seg * 256 + cg * 8 + i; o[seg][i] = xm * wp[0] + xc * wp[64] + xn * wp[128] + wp[192]; } } \
        float vgv[8]; \
        _Pragma("unroll") for (int i = 0; i < 8; ++i) vgv[i] = o[2][i] * o[1][i]; \
        v4u w; w.x = cvt_pk_bf16(o[0][0], o[0][1]); w.y = cvt_pk_bf16(o[0][2], o[0][3]); w.z = cvt_pk_bf16(o[0][4], o[0][5]); w.w = cvt_pk_bf16(o[0][6], o[0][7]); \
        *(v4u*)(X0 + (size_t)r * D + c) = w; \
        __syncthreads(); \
        _Pragma("unroll") for (int i = 0; i < 8; ++i) tl[(cg * 8 + i) * 65 + tt] = vgv[i]; \
        __syncthreads(); \
        { const int cc = F.tid >> 3, ts = (F.tid & 7) * 8; const LAS float* sp = tl + cc * 65 + ts; \
          if (lat) *(v4u*)((bf16*)VT + ((size_t)b * 1024 + c0 + cc) * SEQ + s0 + ts) = (v4u){cvt_pk_bf16(sp[0], sp[1]), cvt_pk_bf16(sp[2], sp[3]), cvt_pk_bf16(sp[4], sp[5]), cvt_pk_bf16(sp[6], sp[7])};        \
          else { float* dst = VTC + ((size_t)b * 1024 + c0 + cc) * CL + s0 + ts; *(f32x4*)dst = (f32x4){sp[0], sp[1], sp[2], sp[3]}; *(f32x4*)(dst + 4) = (f32x4){sp[4], sp[5], sp[6], sp[7]}; } } } while (0)
    int u = F.bx;
    if (u < NU) HP_LOAD(u, pa);
    for (; u < NU; u += 2 * F.G) {
        if (u + F.G < NU) HP_LOAD(u + F.G, pb);
        HP_UNIT(u, pa);
        if (u + F.G >= NU) break;
        if (u + 2 * F.G < NU) HP_LOAD(u + 2 * F.G, pa);
        HP_UNIT(u + F.G, pb);
    }
    __syncthreads();
#undef HP_LOAD
#undef HP_UNIT
}
__device__ __forceinline__ void hyena_post_phase(Frame& F) {
    LAS float* tl = (LAS float*)F.lds;
    const bf16* X0 = (const bf16*)(F.ws + WS_X0); const bf16* VG = (const bf16*)(F.ws + WS_VG); bf16* Y = (bf16*)(F.ws + WS_Y);
    const float* VT = (const float*)(F.ws + WS_CT); const float* VTC = (const float*)(F.ws + WS_CTC); const float* dsk = PIN(F, I_HD);
    const int tt = F.tid >> 3, cg = F.tid & 7;
    constexpr int NU = (MT / 64) * 16;
    struct PIn { f32x4 a, bq; v4u cw, x0; } qa, qb;
#define HQ_LOAD(u_, IN) do { const int tb_ = (u_) >> 4, c0_ = ((u_) & 15) * 64, r0_ = tb_ * 64; const bool lat_ = r0_ < ML; \
        const int b_ = lat_ ? (r0_ >> 13) : ((r0_ - ML) >> 8), s0_ = lat_ ? (r0_ & (SEQ - 1)) : ((r0_ - ML) & (CL - 1)); const int cc_ = F.tid >> 3, ts_ = (F.tid & 7) * 8; \
        if (lat_) IN.cw = *(const v4u*)((const bf16*)VT + ((size_t)b_ * 1024 + c0_ + cc_) * SEQ + s0_ + ts_);        \
        else { const float* src_ = VTC + ((size_t)b_ * 1024 + c0_ + cc_) * CL + s0_ + ts_; IN.a = *(const f32x4*)src_; IN.bq = *(const f32x4*)(src_ + 4); } \
        IN.x0 = *(const v4u*)(X0 + (size_t)(r0_ + tt) * D + c0_ + cg * 8); } while (0)
#define HQ_UNIT(u_, IN) do { \
        const int tb = (u_) >> 4, c0 = ((u_) & 15) * 64; const int r0 = tb * 64; \
        __syncthreads(); \
        { const int cc = F.tid >> 3, ts = (F.tid & 7) * 8; LAS float* dp = tl + cc * 65 + ts; \
          if (r0 < ML) { dp[0] = bflo(IN.cw.x); dp[1] = bfhi(IN.cw.x); dp[2] = bflo(IN.cw.y); dp[3] = bfhi(IN.cw.y); dp[4] = bflo(IN.cw.z); dp[5] = bfhi(IN.cw.z); dp[6] = bflo(IN.cw.w); dp[7] = bfhi(IN.cw.w); } \
          else { dp[0] = IN.a.x; dp[1] = IN.a.y; dp[2] = IN.a.z; dp[3] = IN.a.w; dp[4] = IN.bq.x; dp[5] = IN.bq.y; dp[6] = IN.bq.z; dp[7] = IN.bq.w; } } \
        __syncthreads(); \
        const int r = r0 + tt, c = c0 + cg * 8; \
        const unsigned x0w[4] = {IN.x0.x, IN.x0.y, IN.x0.z, IN.x0.w}; float y[8]; \
        _Pragma("unroll") for (int i = 0; i < 8; ++i) { const float xx = (i & 1) ? bfhi(x0w[i >> 1]) : bflo(x0w[i >> 1]); y[i] = tl[(cg * 8 + i) * 65 + tt] * xx; }        \
        v4u w; w.x = cvt_pk_bf16(y[0], y[1]); w.y = cvt_pk_bf16(y[2], y[3]); w.z = cvt_pk_bf16(y[4], y[5]); w.w = cvt_pk_bf16(y[6], y[7]); \
        *(v4u*)(Y + (size_t)r * D + c) = w; } while (0)
    int u = F.bx;
    if (u < NU) HQ_LOAD(u, qa);
    for (; u < NU; u += 2 * F.G) {
        if (u + F.G < NU) HQ_LOAD(u + F.G, qb);
        HQ_UNIT(u, qa);
        if (u + F.G >= NU) break;
        if (u + 2 * F.G < NU) HQ_LOAD(u + 2 * F.G, qa);
        HQ_UNIT(u + F.G, qb);
    }
    __syncthreads();
#undef HQ_LOAD
#undef HQ_UNIT
}
__device__ __forceinline__ bool phase_nonempty(int ph) {
    if (ph < PH_L0 || ph >= PH_FINAL) return true;
    const int layer = (ph - PH_L0) / PH_PER_LAYER, lp = (ph - PH_L0) % PH_PER_LAYER, kind = layer % 3;
    if (lp == LP_MIX2) return kind != 1;
    if (lp == LP_MIX3) return kind == 2;
    return true;
}
__global__ void __launch_bounds__(NTHREADS, 2) mk_fwd(Args args) {
    extern __shared__ __attribute__((aligned(16))) unsigned char lds[];
    Frame F0;
    F0.lds = (LAS unsigned char*)lds; F0.MISC = (volatile LAS unsigned*)(F0.lds + MISC_OFF);
    F0.tid = threadIdx.x; F0.lane = F0.tid & 63; F0.wave = __builtin_amdgcn_readfirstlane(F0.tid >> 6);
    F0.G = gridDim.x; F0.bx = blockIdx.x; F0.out = args.out; F0.ws = args.ws; F0.ctl = (gu32*)(args.ws + WS_CTL);
    for (int u = F0.tid; u < MISC_BYTES / 4; u += NTHREADS) F0.MISC[u] = 0u;
    __syncthreads();
    if (F0.tid < 36) { const unsigned long long p = (unsigned long long)args.in[F0.tid]; F0.MISC[MW_PTRS + 2 * F0.tid] = (unsigned)p; F0.MISC[MW_PTRS + 2 * F0.tid + 1] = (unsigned)(p >> 32); }
    __syncthreads();
    const int lo = args.ph_lo, hi = args.ph_hi;
    const bool multi = (hi - lo) > 1;
    XcdBarrier bar; bar.bar = (unsigned*)(F0.ctl + CW_BAR); bar.x = 0; bar.st = nullptr; bar.w = F0.wave;
    if (multi) bar = xcd_barrier_post((unsigned*)(F0.ctl + CW_BAR), F0.MISC + 8, F0.wave);
#ifndef PHMASK
#define PHMASK 0xFFFF
#endif
#define EN(b) ((PHMASK >> (b)) & 1)
#ifndef MK_STAG_IN
#define MK_STAG_IN 0u
#define MK_STAG_OUT 0u
#define MK_STAG_M1 0u
#define MK_STAG_M2 0u
#endif
#ifndef KMASK
#define KMASK 7
#endif
#define KEN(b) ((KMASK >> (b)) & 1)
#define IN(k) (lo <= (k) && (k) < hi)
#define SEAM(k) do { if ((k) + 1 < hi) xcd_barrier(bar); } while (0)
#define PB(id) for (int _rep = 0, _n = ((id) == MK_REPEAT ? MK_NREP : 1); _rep < _n; ++_rep) {
#define PE(id) if (_rep + 1 < _n) xcd_barrier(bar); } SEAM(id);

    if (EN(0) && IN(PH_PRO0)) { PB(PH_PRO0) Frame F = phase_frame(F0); pro0_mod(F); __syncthreads(); pro0_transposes(F); pro0_filter_mlp(F); PE(PH_PRO0) }
    if (EN(1) && IN(PH_PRO1)) { PB(PH_PRO1) Frame F = phase_frame(F0); pro1_router_split(F); pro1_filters(F); PE(PH_PRO1) }

#pragma unroll 1
    for (int layer = 0; layer < NLAYER; ++layer) {
        const int kind = layer % 3, jj = layer / 3, pb = PH_L0 + layer * PH_PER_LAYER; const bool last = layer == NLAYER - 1;
        if (EN(2) && IN(pb + LP_NORM1)) { PB(pb + LP_NORM1) Frame F = phase_frame(F0); rowpass<0>(F, layer, _rep + 1 == _n, kind != 1); PE(pb + LP_NORM1) }
        if (EN(3) && IN(pb + LP_INPROJ)) { PB(pb + LP_INPROJ)
            Frame F = phase_frame(F0);
            if (kind != 1) {
                const int N = kind == 0 ? 1536 : 3072;
                pg8::DenseSchedT<true> S; S.init(F.ws + WS_H8, kind == 0 ? F.ws + WS_WATT + (size_t)jj * 1536 * 1024 : F.ws + WS_WHY, MT, N, F.G, F.bx, 1024);
                pg8::EpiBf16 E{(bf16*)(F.ws + WS_P), N, (float*)(F.ws + WS_SS), 0};
                pg8::gemm_phase<pg8::EpiBf16, pg8::DenseSchedT<true>, true, true>(F.lds, S, E, F.wave, false, MK_STAG_IN);
            } else {
                const int N = 2048;
                pg8::DenseSched S; S.init(F.ws + WS_H, F.ws + WS_WGM, MT, N, F.G, F.bx);
                pg8::EpiBf16 E{(bf16*)(F.ws + WS_P), N, (float*)(F.ws + WS_SS), 1};
                pg8::gemm_phase<pg8::EpiBf16, pg8::DenseSched, false>(F.lds, S, E, F.wave, false, MK_STAG_IN);
            }
            PE(pb + LP_INPROJ)
        }
        if (IN(pb + LP_MIX1)) { PB(pb + LP_MIX1)
            Frame F = phase_frame(F0);
            if (EN(4) && kind == 0) qkprep_phase(F, jj); else if (EN(5) && kind == 1) gmlp_mix_phase(F); else if (EN(6)) hyena_prep_phase(F);
            PE(pb + LP_MIX1)
        }
        if (IN(pb + LP_MIX2) && kind != 1) { PB(pb + LP_MIX2)
            Frame F = phase_frame(F0);
            if (EN(7) && kind == 0) {
#if MK_XP >= 10 && MK_XP < 20
                if (_rep + 1 < _n) attention_phase<MK_XP - 10>(F, (char*)lds, !last, jj); else
#endif
                attention_phase<0>(F, (char*)lds, !last, jj); }
            else if (EN(8)) hyena_conv_phase(F);
            PE(pb + LP_MIX2)
        }
        if (EN(9) && IN(pb + LP_MIX3) && kind == 2) { PB(pb + LP_MIX3) Frame F = phase_frame(F0); hyena_post_phase(F); PE(pb + LP_MIX3) }
        if (EN(10) && IN(pb + LP_OUTPROJ)) { PB(pb + LP_OUTPROJ)
            Frame F = phase_frame(F0); const float* modl = (const float*)(F.ws + WS_MOD) + (size_t)layer * 9 * 6144;
            pg8::DenseSched S; S.init(F.ws + WS_Y, F.ws + WS_WOUT + (size_t)layer * 1024 * 1024 * 2, last ? ML : MT, 1024, F.G, F.bx);
            pg8::EpiResid E{(bf16*)(F.ws + WS_XB), modl};
            pg8::gemm_phase<pg8::EpiResid, pg8::DenseSched, false>(F.lds, S, E, F.wave, false, MK_STAG_OUT);
            PE(pb + LP_OUTPROJ)
        }
        if (EN(11) && IN(pb + LP_NORM2)) { PB(pb + LP_NORM2) Frame F = phase_frame(F0); router_phase(F, layer, _rep + 1 == _n, (_rep + 1 < _n) ? MK_XP : 0); PE(pb + LP_NORM2) }
        if (EN(12) && IN(pb + LP_MOE1)) { PB(pb + LP_MOE1)
            Frame F = phase_frame(F0);
            moe_tables(F, layer);
            pg8::MoeSched S{(const char*)(F.ws + WS_H8), (const char*)(F.ws + WS_WE1) + (size_t)layer * NE * 2048 * 1024, (size_t)2048 * 1024, (const int*)(F.ws + WS_ROWTOK),
                            (const volatile LAS int*)(F.MISC + MW_CUMBLK), (const volatile LAS int*)(F.MISC + MW_CNT), 3, F.G, F.bx, 1024, (const volatile LAS int*)(F.lds + AUX_OFF + 1024)};
            S.build_list((volatile LAS int*)(F.lds + AUX_OFF + 1024), F.tid); __syncthreads();
            pg8::EpiSwiglu E{(unsigned char*)(F.ws + WS_ACT), PIN(F, I_EB1) + (size_t)layer * NE * 2048, (LAS float*)(F.lds + AUX_OFF)};
#if MK_XP >= 20
            if (_rep + 1 < _n) { int one_ = 1; asm volatile("" : "+s"(one_)); pg8::gemm_phase<pg8::EpiSwiglu, pg8::MoeSched, true, true, MK_XP - 20>(F.lds, S, E, F.wave, one_ != 0, MK_STAG_M1); } else
#endif
            pg8::gemm_phase<pg8::EpiSwiglu, pg8::MoeSched, true, true>(F.lds, S, E, F.wave, MK_XP == 1 && _rep + 1 < _n, MK_STAG_M1);
            PE(pb + LP_MOE1)
        }
        if (EN(13) && IN(pb + LP_MOE2)) { PB(pb + LP_MOE2)
            Frame F = phase_frame(F0);
            moe_tables(F, layer);
            pg8::MoeSched S{(const char*)(F.ws + WS_ACT), (const char*)(F.ws + WS_WE2) + (size_t)layer * NE * 1024 * 1024, (size_t)1024 * 1024, nullptr,
                            (const volatile LAS int*)(F.MISC + MW_CUMBLK), (const volatile LAS int*)(F.MISC + MW_CNT), 2, F.G, F.bx, 1024, (const volatile LAS int*)(F.lds + AUX_OFF + 1024)};
            S.build_list((volatile LAS int*)(F.lds + AUX_OFF + 1024), F.tid); __syncthreads();
            pg8::EpiBias E{(unsigned char*)(F.ws + WS_YM), PIN(F, I_EB2) + (size_t)layer * NE * 1024, (LAS float*)(F.lds + AUX_OFF)};
            pg8::gemm_phase<pg8::EpiBias, pg8::MoeSched, true, true>(F.lds, S, E, F.wave, MK_XP == 1 && _rep + 1 < _n, MK_STAG_M2);
            PE(pb + LP_MOE2)
        }
    }
    if (EN(14) && IN(PH_FINAL)) { PB(PH_FINAL) Frame F = phase_frame(F0); rowpass<2>(F, NLAYER - 1, _rep + 1 == _n); PE(PH_FINAL) }
#undef IN
#undef SEAM
}

static bool host_phase_nonempty(int ph) {
    if (ph < PH_L0 || ph >= PH_FINAL) return true;
    const int layer = (ph - PH_L0) / PH_PER_LAYER, lp = (ph - PH_L0) % PH_PER_LAYER, kind = layer % 3;
    if (lp == LP_MIX2) return kind != 1;
    if (lp == LP_MIX3) return kind == 2;
    return true;
}
extern "C" void kernel_launch(void* const* d_in, const int* in_sizes, int n_in, void* d_out, int out_size, void* d_ws, size_t ws_size, hipStream_t stream) {
    static int grid = 0;
    if (grid == 0) {
        if (n_in != 36 || in_sizes[0] != ML * D || out_size != ML * D || ws_size < WS_END) {
            fprintf(stderr, "kernel_launch: built for 36 inputs, x/out of %d floats, >= %zu bytes of workspace; got n_in %d in0 %d out %d ws %zu; nothing launched\n", ML * D, (size_t)WS_END, n_in, n_in > 0 ? in_sizes[0] : -1, out_size, ws_size);
            grid = -1; return; }
        int dev = 0, cus = 0, per_cu = 0;
        if (hipGetDevice(&dev) != hipSuccess || hipDeviceGetAttribute(&cus, hipDeviceAttributeMultiprocessorCount, dev) != hipSuccess) { fprintf(stderr, "kernel_launch: device query failed\n"); grid = -1; return; }
        if (hipFuncSetAttribute((const void*)mk_fwd, hipFuncAttributeMaxDynamicSharedMemorySize, LDS_BYTES) != hipSuccess) { fprintf(stderr, "kernel_launch: hipFuncSetAttribute(%d B LDS) failed\n", LDS_BYTES); grid = -1; return; }
        if (hipOccupancyMaxActiveBlocksPerMultiprocessor(&per_cu, (const void*)mk_fwd, NTHREADS, LDS_BYTES) != hipSuccess || per_cu < 1)
            fprintf(stderr, "kernel_launch: note: occupancy query reports %d workgroups per CU\n", per_cu);
        (void)hipGetLastError();
        grid = cus;
    }
    if (grid < 0) return;
    if (hipMemsetAsync((char*)d_ws + WS_CTL, 0, CTL_ZERO_BYTES, stream) != hipSuccess) { fprintf(stderr, "kernel_launch: memset failed\n"); return; }
    Args a{};
    for (int i = 0; i < 36; ++i) a.in[i] = (const float*)d_in[i];
    a.out = (float*)d_out; a.ws = (unsigned char*)d_ws;
#if MK_MULTI || MK_DBG
    for (int ph = 0; ph < PH_COUNT; ++ph) {
        if (!host_phase_nonempty(ph)) continue;
        a.ph_lo = ph; a.ph_hi = ph + 1;
        hipLaunchKernelGGL(mk_fwd, dim3(grid), dim3(NTHREADS), LDS_BYTES, stream, a);
#if MK_DBG
        dbg_after_phase(ph, a, stream);
#endif
    }
#if MK_DBG
    dbg_report(a, stream);
#endif
#else
    a.ph_lo = 0; a.ph_hi = PH_COUNT;
    hipLaunchKernelGGL(mk_fwd, dim3(grid), dim3(NTHREADS), LDS_BYTES, stream, a);
#endif
    const hipError_t le = hipPeekAtLastError();
    if (le != hipSuccess) fprintf(stderr, "kernel_launch: launch failed: %s\n", hipGetErrorName(le));
}
```

```cpp
#include <hip/hip_runtime.h>
#include <cstdio>
#include <cstdint>
#include <cmath>

#ifndef MK_MULTI
#define MK_MULTI 0
#endif
#ifndef MK_REPEAT
#define MK_REPEAT -1
#endif
#ifndef MK_NREP
#define MK_NREP 1
#endif
#ifndef MK_XP
#define MK_XP 0
#endif
#ifndef MK_MOEMAP
#define MK_MOEMAP 0
#endif
#ifndef MK_DBG
#define MK_DBG 0
#endif

constexpr int D = 1024, NB = 8, SEQ = 8192, CL = 256, ML = NB * SEQ, MC = NB * CL, MT = ML + MC;
constexpr int NLAYER = 4, NE = 32, TOPK = 4, SKV = SEQ + CL;
constexpr int MOE_MAXBLK = (MT * TOPK) / 256 + NE;
constexpr float EPS = 1e-6f;
constexpr int FH = 64, FEMB = 33, NFFT = 16384;

constexpr size_t MiB = 1u << 20;
constexpr size_t WS_CTL = 0, CTL_ZERO_BYTES = 1 * MiB;
constexpr size_t WS_MOD = 1 * MiB;
constexpr size_t WS_A3 = 2 * MiB;
constexpr size_t WS_A3C = 4 * MiB;
constexpr size_t WS_RC = 4 * MiB + 512 * 1024;
constexpr size_t WS_FCT = 5 * MiB;
constexpr size_t WS_WATT = 8 * MiB;
constexpr size_t WS_WGM = 14 * MiB;
constexpr size_t WS_WHY = 18 * MiB;
constexpr size_t WS_WOUT = 24 * MiB;
constexpr size_t WS_RW3 = 32 * MiB;
constexpr size_t WS_TE = 40 * MiB;
constexpr size_t WS_TR = 42 * MiB;
constexpr size_t WS_TG = 44 * MiB;
constexpr size_t WS_SS = 46 * MiB;
constexpr size_t WS_ROWTOK = 52 * MiB;
constexpr size_t WS_KF = 64 * MiB;
constexpr size_t WS_WE1 = 192 * MiB;
constexpr size_t WS_WE2 = 704 * MiB;
constexpr size_t WS_H = 960 * MiB;
constexpr size_t WS_P = 1092 * MiB;
constexpr size_t WS_Y = 1488 * MiB;
constexpr size_t WS_QB = 1620 * MiB;
constexpr size_t WS_K8_OFF = 72 * MiB;
constexpr size_t WS_KVB = 1752 * MiB;
constexpr size_t WS_X0 = 1818 * MiB;
constexpr size_t WS_VG = 1950 * MiB;
constexpr size_t WS_VT = 2082 * MiB;
constexpr size_t WS_VTC = 2338 * MiB;
constexpr size_t WS_ACT = 2346 * MiB;
constexpr size_t WS_YM = 2890 * MiB;
constexpr size_t WS_CT = 3434 * MiB;
constexpr size_t WS_CTC = 3690 * MiB;
constexpr size_t WS_H8 = 3698 * MiB;
constexpr size_t WS_XB = 3764 * MiB;
constexpr size_t WS_END = 3896 * MiB;
constexpr int CW_BAR = 4096;
constexpr int CW_CNT = 16384;
constexpr int CW_DBG = 32768;

constexpr int RING_BYTES = 131072;
constexpr int AUX_OFF = RING_BYTES;
constexpr int AUX_BYTES = 16384;
constexpr int MISC_OFF = AUX_OFF + AUX_BYTES;
constexpr int MISC_BYTES = 4096;
constexpr int LDS_BYTES = MISC_OFF + MISC_BYTES;

#define GAS __attribute__((address_space(1)))
#define LAS __attribute__((address_space(3)))
typedef unsigned short bf16;
typedef unsigned v4u __attribute__((ext_vector_type(4)));
typedef unsigned v2u __attribute__((ext_vector_type(2)));
typedef float f32x4 __attribute__((ext_vector_type(4)));
typedef float f32x2 __attribute__((ext_vector_type(2)));
typedef float f32x16 __attribute__((ext_vector_type(16)));
typedef short bf16x8 __attribute__((ext_vector_type(8)));
typedef short s16x4 __attribute__((ext_vector_type(4)));
typedef int i32x4 __attribute__((ext_vector_type(4)));
typedef GAS unsigned gu32;
#define RLX_AGENT __ATOMIC_RELAXED, __HIP_MEMORY_SCOPE_AGENT
#define LDS_WAIT() asm volatile("s_waitcnt lgkmcnt(0)" ::: "memory")
#define VM_WAIT() asm volatile("s_waitcnt vmcnt(0)" ::: "memory")
__device__ __forceinline__ int opaque_tid(int wave) { int l; asm volatile("v_mbcnt_lo_u32_b32 %0, -1, 0\n\tv_mbcnt_hi_u32_b32 %0, -1, %0" : "=v"(l)); return (wave << 6) | l; }
__device__ __forceinline__ unsigned f2bf(float f) { unsigned u = __builtin_bit_cast(unsigned, f); return (u + 0x7fffu + ((u >> 16) & 1u)) >> 16; }
__device__ __forceinline__ unsigned pk2(float lo, float hi) { return f2bf(lo) | (f2bf(hi) << 16); }
__device__ __forceinline__ float bf2f(unsigned short b) { return __builtin_bit_cast(float, ((unsigned)b) << 16); }
__device__ __forceinline__ float bflo(unsigned w) { return __builtin_bit_cast(float, w << 16); }
__device__ __forceinline__ float bfhi(unsigned w) { return __builtin_bit_cast(float, w & 0xffff0000u); }
__device__ __forceinline__ f32x4 bf4_f32(v2u w) { return (f32x4){__uint_as_float(w.x << 16), __uint_as_float(w.x & 0xffff0000u), __uint_as_float(w.y << 16), __uint_as_float(w.y & 0xffff0000u)}; }
__device__ __forceinline__ unsigned cvt_pk_bf16(float lo, float hi) { unsigned r; asm volatile("v_cvt_pk_bf16_f32 %0, %1, %2" : "=v"(r) : "v"(lo), "v"(hi)); return r; }
__device__ __forceinline__ float shx(float v, int mask, int lane) { return __int_as_float(__builtin_amdgcn_ds_bpermute((lane ^ mask) << 2, __float_as_int(v))); }
__device__ __forceinline__ float wave_sum(float v, int lane) {
#pragma unroll
    for (int o = 1; o < 64; o <<= 1) v += shx(v, o, lane);
    return v;
}

#define XB_TMO      128
#define XB_XCNT(j)  (256  + 64 * (j))
#define XB_XSUB(j)  (1280 + 64 * (j))
#define XB_XGEN(j)  (2304 + 64 * (j))
#define XB_TOP      3328
#define XB_TOPGEN   3392
#define XCD_BAR_WORDS 3456
#define XB_SPIN_CAP (1u << 22)
__device__ __forceinline__ unsigned xb_ld(unsigned* p)              { return __hip_atomic_load(p, __ATOMIC_RELAXED, __HIP_MEMORY_SCOPE_AGENT); }
__device__ __forceinline__ unsigned xb_add(unsigned* p, unsigned v) { return __hip_atomic_fetch_add(p, v, __ATOMIC_RELAXED, __HIP_MEMORY_SCOPE_AGENT); }
__device__ __forceinline__ unsigned xb_xcc_id() { return (unsigned)__builtin_amdgcn_s_getreg((3 << 11) | 20) & 0xFu; }
#define XB_SPIN(cond, bar) do { unsigned _sp = 0; while (cond) { __builtin_amdgcn_s_sleep(1); \
    if ((++_sp & 255u) == 0u) { if (xb_ld(&(bar)[XB_TMO])) break; if (_sp > XB_SPIN_CAP) { atomicAdd(&(bar)[XB_TMO], 1u); break; } } } } while (0)
struct XcdBarrier { unsigned* bar; unsigned x; volatile LAS unsigned* st; int w; };
__device__ __forceinline__ bool xb_thread0(int w) { return opaque_tid(w) == 0; }
__device__ __forceinline__ XcdBarrier xcd_barrier_post(unsigned* bar, volatile LAS unsigned* st, int w) {
    XcdBarrier b; b.bar = bar; b.x = xb_xcc_id(); b.st = st; b.w = w;
    if (xb_thread0(w)) (void)xb_add(&bar[XB_XCNT(b.x)], 1u);
    return b;
}
__device__ __forceinline__ void xcd_barrier_complete(unsigned* bar, unsigned x, unsigned& nloc, unsigned& nx) {
    const unsigned G = gridDim.x * gridDim.y * gridDim.z;
    unsigned sum, cnt, mine, sp = 0u;
    for (;;) {
        sum = 0u; cnt = 0u; mine = 0u;
#pragma unroll
        for (unsigned j = 0; j < 16; ++j) { const unsigned c = xb_ld(&bar[XB_XCNT(j)]); sum += c; cnt += (c > 0u) ? 1u : 0u; mine = (j == x) ? c : mine; }
        if (sum == G) break;
        __builtin_amdgcn_s_sleep(1);
        if ((++sp & 255u) == 0u) { if (xb_ld(&bar[XB_TMO])) break; if (sp > XB_SPIN_CAP) { atomicAdd(&bar[XB_TMO], 1u); break; } }
    }
    nloc = mine > 0u ? mine : 1u; nx = cnt > 0u ? cnt : 1u;
}
__device__ __forceinline__ void xcd_barrier(const XcdBarrier& b) {
    asm volatile("s_waitcnt vmcnt(0)" ::: "memory");
    __syncthreads();
    if (xb_thread0(b.w)) {
        unsigned* bar = b.bar;
        __builtin_amdgcn_s_waitcnt(0);
        unsigned nloc = b.st[0], nx = b.st[1];
        if (nloc == 0u) { xcd_barrier_complete(bar, b.x, nloc, nx); b.st[0] = nloc; b.st[1] = nx; }
        const unsigned old = xb_add(&bar[XB_XSUB(b.x)], 1u);
        const unsigned gen = old / nloc;
        if (old + 1u == (gen + 1u) * nloc) {
            __builtin_amdgcn_fence(__ATOMIC_RELEASE, "agent");
            asm volatile("s_waitcnt vmcnt(0)" ::: "memory");
            const unsigned og = xb_add(&bar[XB_TOP], 1u);
            const unsigned tg = og / nx;
            if (og + 1u == (tg + 1u) * nx) xb_add(&bar[XB_TOPGEN], 1u);
            else XB_SPIN(xb_ld(&bar[XB_TOPGEN]) == tg, bar);
            __builtin_amdgcn_fence(__ATOMIC_ACQUIRE, "agent");
            xb_add(&bar[XB_XGEN(b.x)], 1u);
            asm volatile("s_waitcnt vmcnt(0)" ::: "memory");
        } else {
            XB_SPIN(xb_ld(&bar[XB_XGEN(b.x)]) == gen, bar);
            __builtin_amdgcn_fence(__ATOMIC_ACQUIRE, "agent");
            asm volatile("s_waitcnt vmcnt(0)" ::: "memory");
        }
    }
    __syncthreads();
}

namespace pg8 {
constexpr int BM = 256, BK = 64, HALF = 128, HTB = HALF * BK * 2, STAGE_BYTES = 8 * HTB, NXCD = 8, WGM = 8;
constexpr int GK = 1024;
__device__ __forceinline__ int lds_byte(int r, int c) { const int st = (r >> 4) * 2 + (c >> 5), rr = r & 15, cc = c & 31, ob = rr * 64 + cc * 2; return st * 1024 + (ob ^ (((ob >> 9) & 1) << 5)); }
__device__ __forceinline__ void stage_rc(int b, int& R, int& C) { const int st = b / 1024, sb = b % 1024, swz = sb ^ (((sb >> 9) & 1) << 5); R = (st >> 1) * 16 + swz / 64; C = (st & 1) * 32 + (swz % 64) / 2; }
__device__ __forceinline__ int perm32(int rho) { const int n = rho >> 4, i = rho & 15; return 8 * (i >> 2) + 4 * n + (i & 3); }
struct Unit { int pm, pn, e; };

template <bool IDG> struct DenseSchedT {
    const char* A; const char* Bt; int nM, nN, nwg, G, c, kb;
    __device__ __forceinline__ void init(const void* A_, const void* Bt_, int M, int N, int G_, int c_, int kb_ = GK * 2) { A = (const char*)A_; Bt = (const char*)Bt_; nM = M / BM; nN = N / BM; nwg = nM * nN; G = G_; c = c_; kb = kb_; }
    __device__ __forceinline__ bool next(int i, Unit& u) const {
        const long L = (long)i * G + c; if (L >= nwg) return false;
        int wgid = (int)L; { const int q = nwg / NXCD, r = nwg % NXCD, xcd = wgid % NXCD, off = wgid / NXCD; wgid = (xcd < r ? xcd * (q + 1) : r * (q + 1) + (xcd - r) * q) + off; }
        const int nig = WGM * nN, gid = wgid / nig, fm = gid * WGM, gsz = (nM - fm) < WGM ? (nM - fm) : WGM;
        u.pm = fm + ((wgid % nig) % gsz); u.pn = (wgid % nig) / gsz; u.e = 0; return true;
    }
    __device__ __forceinline__ const char* a_ptr(const Unit& u) const { return IDG ? A : A + (size_t)u.pm * (size_t)(BM * kb); }
    __device__ __forceinline__ const char* b_ptr(const Unit& u) const { return Bt + (size_t)u.pn * (size_t)(BM * kb); }
    __device__ __forceinline__ void a_offs(const Unit& u, const int (&R)[2], const int (&C)[2], unsigned (&voff)[2][2]) const {
#pragma unroll
        for (int h = 0; h < 2; ++h)
#pragma unroll
            for (int i = 0; i < 2; ++i) voff[h][i] = (unsigned)(u.pm * BM + h * HALF + R[i]) * (unsigned)kb + (unsigned)C[i] * 2u;
    }
    __device__ __forceinline__ void a_raw(const Unit&, const int (&)[2], int (&)[2][2]) const {}
    __device__ __forceinline__ void a_fin(const Unit& u, const int (&R)[2], const int (&C)[2], const int (&)[2][2], unsigned (&voff)[2][2]) const { a_offs(u, R, C, voff); }
};
typedef DenseSchedT<false> DenseSched;
struct MoeSched {
    const char* A; const char* Bt; size_t b_estride; const int* rowtok; const volatile LAS int* cumblk; const volatile LAS int* cnt; int ncol_log2, G, c, kb; const volatile LAS int* ulist;
    __device__ __forceinline__ bool next(int i, Unit& u) const {
        const int v = ulist[i & 63]; if (v < 0) return false;
        u.pm = v >> 8; u.e = (v >> 3) & 31; u.pn = v & 7; return true;
    }
    __device__ __forceinline__ void build_list(volatile LAS int* dst, int tid) const {
        if (tid < 64) { Unit u; dst[tid] = search(tid, u) ? ((u.pm << 8) | (u.e << 3) | u.pn) : -1; }
    }
    __device__ __forceinline__ bool search(int i, Unit& u) const {
        int gb, pn; const int ncol = 1 << ncol_log2;
        if (G == 256 && MK_MOEMAP == 0) { const int xcd = c & 7, j = c >> 3, rpb = 256 >> ncol_log2; gb = i * rpb + xcd + 8 * (j >> ncol_log2); pn = j & (ncol - 1); }
        else { const long L = (long)i * G + c; gb = (int)(L >> ncol_log2); pn = (int)(L & (ncol - 1)); }
        const int tot = cumblk[NE]; if (gb >= tot) return false;
        int e = 0;
#pragma unroll 1
        for (int s = 16; s >= 1; s >>= 1) { if (cumblk[e + s] <= gb) e += s; }
        u.pm = gb; u.pn = pn; u.e = e; return true;
    }
    __device__ __forceinline__ const char* a_ptr(const Unit&) const { return A; }
    __device__ __forceinline__ const char* b_ptr(const Unit& u) const { return Bt + (size_t)u.e * b_estride + (size_t)u.pn * (size_t)(BM * kb); }
    __device__ __forceinline__ void a_raw(const Unit& u, const int (&R)[2], int (&raw)[2][2]) const {
        if (!rowtok) return;
        const int rb = u.pm - cumblk[u.e]; const int* rt = rowtok + (size_t)u.e * MT;
#pragma unroll
        for (int h = 0; h < 2; ++h)
#pragma unroll
            for (int i = 0; i < 2; ++i) { const int* ptr = rt + (rb * 256 + h * HALF + R[i]);
                asm volatile("global_load_dword %0, %1, off" : "=v"(raw[h][i]) : "v"(ptr) : "memory"); }
    }
    __device__ __forceinline__ void a_fin(const Unit& u, const int (&R)[2], const int (&C)[2], const int (&raw_)[2][2], unsigned (&voff)[2][2]) const {
        int raw[2][2] = {{raw_[0][0], raw_[0][1]}, {raw_[1][0], raw_[1][1]}};
        asm volatile("" : "+v"(raw[0][0]), "+v"(raw[0][1]), "+v"(raw[1][0]), "+v"(raw[1][1]));
        const int rb = u.pm - cumblk[u.e], n = cnt[u.e];
#pragma unroll
        for (int h = 0; h < 2; ++h)
#pragma unroll
            for (int i = 0; i < 2; ++i) { const int rank = rb * 256 + h * HALF + R[i]; const int tok = rowtok ? (rank < n ? raw[h][i] : 0) : u.pm * BM + h * HALF + R[i];
                voff[h][i] = (unsigned)tok * (unsigned)kb + (unsigned)C[i] * 2u; }
    }
    __device__ __forceinline__ void a_offs(const Unit& u, const int (&R)[2], const int (&C)[2], unsigned (&voff)[2][2]) const { int raw[2][2] = {{0, 0}, {0, 0}}; a_raw(u, R, raw); asm volatile("s_waitcnt vmcnt(0)" : "+v"(raw[0][0]), "+v"(raw[0][1]), "+v"(raw[1][0]), "+v"(raw[1][1]) :: "memory"); a_fin(u, R, C, raw, voff); }
};

typedef int v8i __attribute__((ext_vector_type(8)));
__device__ __forceinline__ v8i cat8(bf16x8 lo, bf16x8 hi) { const v4u a = __builtin_bit_cast(v4u, lo), b = __builtin_bit_cast(v4u, hi); return (v8i){(int)a.x, (int)a.y, (int)a.z, (int)a.w, (int)b.x, (int)b.y, (int)b.z, (int)b.w}; }
template <class Epi, class Sched, bool GATHER, bool FP8 = false, int XG = 0>
__device__ __forceinline__ void gemm_phase(LAS unsigned char* lds, const Sched& S, const Epi& E, int wave_id, bool skip_epi = false, unsigned stagger_ticks = 0u) {
    if (stagger_ticks && ((blockIdx.x >> 3) & 1u)) { const unsigned long long t0 = __builtin_amdgcn_s_memrealtime(); while (__builtin_amdgcn_s_memrealtime() - t0 < (unsigned long long)stagger_ticks) __builtin_amdgcn_s_sleep(8); }
    const int tid = opaque_tid(wave_id), wid = __builtin_amdgcn_readfirstlane(tid >> 6), lane = tid & 63, wr = wid >> 2, wc = wid & 3, fr = lane & 15, fq = lane >> 4;
    constexpr int KB = FP8 ? GK : GK * 2, nt = KB / (BK * 2);
    unsigned voffA[2][2], voffB[2]; int Rr[2], Cc[2];
#pragma unroll
    for (int i = 0; i < 2; ++i) { int R, C; stage_rc(tid * 16 + i * 8192, R, C); Rr[i] = R; Cc[i] = C; const int Rb = Epi::PERM ? ((R & ~31) + perm32(R & 31)) : R;
        voffA[0][i] = (unsigned)(R * KB + C * 2); voffA[1][i] = (unsigned)((R + HALF) * KB + C * 2); voffB[i] = (unsigned)(Rb * KB + C * 2); }
    constexpr size_t kstep = (size_t)(BK * 2);
    constexpr size_t hstep = (size_t)HALF * KB;
    const unsigned ldsw = (unsigned)wid * 1024u;
    const int aoff = lds_byte(wr * 64 + fr, fq * 8), boff = lds_byte(wc * 32 + fr, fq * 8);
    LAS unsigned char* abase = lds + aoff; LAS unsigned char* bbase = lds + 4 * HTB + boff; asm volatile("" : "+v"(abase), "+v"(bbase));
#define PG8_SA(b, h) (((b) * 2 + (h)) * HTB)
#define PG8_SB(b, h) ((4 + (b) * 2 + (h)) * HTB)
#define PG8_STAGE(bufoff, gbase, voff) do { if (XG == 3) break; _Pragma("unroll") for (int _i = 0; _i < 2; ++_i) \
        __builtin_amdgcn_global_load_lds((const unsigned*)((const char*)(gbase) + (voff)[_i]), (LAS unsigned*)(lds + (bufoff) + ldsw + _i * 8192), 16, 0, 0); } while (0)
#define PG8_STAGE_A(bufoff, gbase, h) PG8_STAGE(bufoff, gbase, voffA[h])
#define PG8_RDA(off) (*(const LAS v4u*)(abase + (off)))
#define PG8_RDB(off) (*(const LAS v4u*)(bbase + (off)))
#define PG8_LDA(dst, b, h) do { if (XG == 2) break; _Pragma("unroll") for (int m = 0; m < 4; ++m) { const v4u _l = PG8_RDA(PG8_SA(b, h) + m * 2048), _h = PG8_RDA(PG8_SA(b, h) + m * 2048 + 1024); \
        if constexpr (FP8) dst##8[m] = (v8i){(int)_l.x, (int)_l.y, (int)_l.z, (int)_l.w, (int)_h.x, (int)_h.y, (int)_h.z, (int)_h.w}; \
        else { dst[m][0] = __builtin_bit_cast(bf16x8, _l); dst[m][1] = __builtin_bit_cast(bf16x8, _h); } } } while (0)
#define PG8_LDB(dst, b, h) do { if (XG == 2) break; _Pragma("unroll") for (int n = 0; n < 2; ++n) { const v4u _l = PG8_RDB(PG8_SA(b, h) + n * 2048), _h = PG8_RDB(PG8_SA(b, h) + n * 2048 + 1024); \
        if constexpr (FP8) dst##8[n] = (v8i){(int)_l.x, (int)_l.y, (int)_l.z, (int)_l.w, (int)_h.x, (int)_h.y, (int)_h.z, (int)_h.w}; \
        else { dst[n][0] = __builtin_bit_cast(bf16x8, _l); dst[n][1] = __builtin_bit_cast(bf16x8, _h); } } } while (0)
#define PG8_MMA(ai, bj, At, Bt) do { if (XG == 1) break; __builtin_amdgcn_s_setprio(1); _Pragma("unroll") for (int m = 0; m < 4; ++m) _Pragma("unroll") for (int n = 0; n < 2; ++n) { \
        if constexpr (FP8) acc[ai][bj][m][n] = __builtin_amdgcn_mfma_scale_f32_16x16x128_f8f6f4(Bt##8[n], At##8[m], acc[ai][bj][m][n], 0, 0, 0, 0x7A7A7A7A, 0, 0x7F7F7F7F); \
        else { _Pragma("unroll") for (int k = 0; k < 2; ++k) acc[ai][bj][m][n] = __builtin_amdgcn_mfma_f32_16x16x32_bf16(Bt[n][k], At[m][k], acc[ai][bj][m][n], 0, 0, 0); } } \
        __builtin_amdgcn_s_setprio(0); } while (0)
#define PG8_WAIT_V(n) asm volatile("s_waitcnt vmcnt(" #n ")" ::: "memory")
#define PG8_WAIT_L(n) asm volatile("s_waitcnt lgkmcnt(" #n ")" ::: "memory")
#define PG8_BAR __builtin_amdgcn_s_barrier()
#define PG8_SCHED __builtin_amdgcn_sched_barrier(0)
    Unit cur, nxt; int ui = 0;
    if (!S.next(0, cur)) return;
    f32x4 acc[2][2][4][2];
#pragma unroll
    for (int a = 0; a < 2; ++a)
#pragma unroll
        for (int b = 0; b < 2; ++b)
#pragma unroll
            for (int m = 0; m < 4; ++m)
#pragma unroll
                for (int n = 0; n < 2; ++n) acc[a][b][m][n] = (f32x4){0.f, 0.f, 0.f, 0.f};
    bf16x8 At[4][2], B0[2][2], B1[2][2]; v8i At8[4], B08[2], B18[2];
    if constexpr (XG == 2) { _Pragma("unroll") for (int m = 0; m < 4; ++m) { asm volatile("" : "=v"(At8[m])); } _Pragma("unroll") for (int n = 0; n < 2; ++n) { asm volatile("" : "=v"(B08[n])); asm volatile("" : "=v"(B18[n])); } }
    const char* cA = S.a_ptr(cur); const char* cB = S.b_ptr(cur);
    if constexpr (GATHER) S.a_offs(cur, Rr, Cc, voffA);
    PG8_STAGE(PG8_SB(0, 0), cB, voffB); PG8_STAGE(PG8_SB(0, 1), cB + hstep, voffB); PG8_STAGE_A(PG8_SA(0, 0), cA, 0); PG8_STAGE_A(PG8_SA(0, 1), cA, 1);
    if (wr == 1) PG8_BAR;
    PG8_WAIT_V(2); PG8_BAR;
    PG8_STAGE(PG8_SB(1, 0), cB + kstep, voffB); PG8_STAGE_A(PG8_SA(1, 0), cA + kstep, 0); PG8_STAGE(PG8_SB(1, 1), cB + hstep + kstep, voffB);
    PG8_WAIT_V(6); PG8_BAR;
    for (;;) {
        const bool has_next = S.next(ui + 1, nxt);
        const char* nA = has_next ? S.a_ptr(nxt) : cA; const char* nB = has_next ? S.b_ptr(nxt) : cB;
        int rawN[2][2] = {{0, 0}, {0, 0}};
        if constexpr (GATHER) { if (has_next) S.a_raw(nxt, Rr, rawN); }
#pragma unroll 1
        for (int t = 0; t < nt; t += 2) {
            const bool last = (t == nt - 2);
            if constexpr (Epi::LDSBIAS) { if (last && wid == 0) E.stage_bias(cur, lane); }
            const char* a1 = cA + (size_t)(t + 1) * kstep;
            const char* a2 = last ? nA : cA + (size_t)(t + 2) * kstep; const char* b2 = last ? nB : cB + (size_t)(t + 2) * kstep;
            const char* a3 = a2 + kstep; const char* b3 = b2 + kstep;
            PG8_LDB(B0, 0, 0); PG8_LDB(B1, 0, 1); PG8_SCHED; PG8_LDA(At, 0, 0); PG8_STAGE_A(PG8_SA(1, 1), a1, 1);
            if constexpr (GATHER) { if (last && has_next) S.a_fin(nxt, Rr, Cc, rawN, voffA); }
            PG8_WAIT_V(8); PG8_WAIT_L(0); PG8_BAR; PG8_MMA(0, 0, At, B0); PG8_MMA(0, 1, At, B1); PG8_BAR; PG8_SCHED;
            PG8_LDA(At, 0, 1); PG8_STAGE(PG8_SB(0, 0), b2, voffB); PG8_STAGE(PG8_SB(0, 1), b2 + hstep, voffB); PG8_STAGE_A(PG8_SA(0, 0), a2, 0);
            PG8_WAIT_V(8); PG8_WAIT_L(0); PG8_BAR; PG8_MMA(1, 0, At, B0); PG8_MMA(1, 1, At, B1); PG8_BAR; PG8_SCHED;
            PG8_LDB(B0, 1, 0); PG8_LDB(B1, 1, 1); PG8_SCHED; PG8_LDA(At, 1, 0); PG8_STAGE_A(PG8_SA(0, 1), a2, 1);
            PG8_WAIT_V(8); PG8_WAIT_L(0); PG8_BAR; PG8_MMA(0, 0, At, B0); PG8_MMA(0, 1, At, B1); PG8_BAR; PG8_SCHED;
            PG8_LDA(At, 1, 1); PG8_STAGE(PG8_SB(1, 0), b3, voffB); PG8_STAGE(PG8_SB(1, 1), b3 + hstep, voffB); PG8_STAGE_A(PG8_SA(1, 0), a3, 0);
            PG8_WAIT_V(8); PG8_WAIT_L(0); PG8_BAR; PG8_MMA(1, 0, At, B0); PG8_MMA(1, 1, At, B1); PG8_BAR; PG8_SCHED;
        }
        if (wr == 0) PG8_BAR;
        if (!skip_epi) E(acc, cur, wr, wc, fr, fq);
        if (!has_next) break;
#pragma unroll
        for (int a = 0; a < 2; ++a)
#pragma unroll
            for (int b = 0; b < 2; ++b)
#pragma unroll
                for (int m = 0; m < 4; ++m)
#pragma unroll
                    for (int n = 0; n < 2; ++n) acc[a][b][m][n] = (f32x4){0.f, 0.f, 0.f, 0.f};
        cur = nxt; cA = nA; cB = nB; ++ui;
        if (wr == 1) PG8_BAR;
    }
    PG8_WAIT_V(0);
    PG8_BAR;
#undef PG8_SA
#undef PG8_SB
#undef PG8_STAGE
#undef PG8_STAGE_A
#undef PG8_LDA
#undef PG8_RDA
#undef PG8_RDB
#undef PG8_LDB
#undef PG8_MMA
#undef PG8_WAIT_V
#undef PG8_WAIT_L
#undef PG8_BAR
#undef PG8_SCHED
}
}
namespace pg8 {
__device__ __forceinline__ f32x2 gelu_pk(f32x2 v) {
    const f32x2 av = __builtin_elementwise_abs(v), d = av * 0.2316418882f + 1.0f;
    f32x2 t; t.x = __builtin_amdgcn_rcpf(d.x); t.y = __builtin_amdgcn_rcpf(d.y);
    f32x2 q = t * 0.5307027145f + (-0.7265760135f); q = q * t + 0.7107068705f; q = q * t + (-0.142248368f); q = q * t + 0.127414796f; q = q * t;
    const f32x2 s = (v * v) * (-0.72134752044f);
    f32x2 e; e.x = __builtin_amdgcn_exp2f(s.x); e.y = __builtin_amdgcn_exp2f(s.y);
    const f32x2 m = v * (q * e), r = v - m;
    f32x2 o; o.x = v.x < 0.f ? m.x : r.x; o.y = v.y < 0.f ? m.y : r.y; return o;
}
struct EpiBf16 {
    static constexpr bool PERM = true, LDSBIAS = false;
    bf16* O; int ldc; float* ss; int ACT;
    __device__ __forceinline__ void operator()(const f32x4 (&acc)[2][2][4][2], const Unit& u, int wr, int wc, int fr, int fq) const {
        const int row0 = u.pm * BM + wr * 64 + fr, col0 = u.pn * BM + wc * 32 + 8 * fq;
#pragma unroll
        for (int ai = 0; ai < 2; ++ai)
#pragma unroll
            for (int m = 0; m < 4; ++m) { const int row = row0 + ai * HALF + m * 16; bf16* rowp = O + (size_t)row * ldc + col0; float sq = 0.f;
#pragma unroll
                for (int bj = 0; bj < 2; ++bj) { f32x4 v0 = acc[ai][bj][m][0], v1 = acc[ai][bj][m][1];
                    if (ACT == 1) { f32x2 a = gelu_pk((f32x2){v0[0], v0[1]}), b = gelu_pk((f32x2){v0[2], v0[3]}), c = gelu_pk((f32x2){v1[0], v1[1]}), d = gelu_pk((f32x2){v1[2], v1[3]});
                        v0 = (f32x4){a.x, a.y, b.x, b.y}; v1 = (f32x4){c.x, c.y, d.x, d.y};
                        sq += (v0[0] * v0[0] + v0[1] * v0[1]) + (v0[2] * v0[2] + v0[3] * v0[3]) + (v1[0] * v1[0] + v1[1] * v1[1]) + (v1[2] * v1[2] + v1[3] * v1[3]); }
                    v4u w; w.x = cvt_pk_bf16(v0[0], v0[1]); w.y = cvt_pk_bf16(v0[2], v0[3]); w.z = cvt_pk_bf16(v1[0], v1[1]); w.w = cvt_pk_bf16(v1[2], v1[3]);
                    *(v4u*)(rowp + bj * HALF) = w; }
                if (ACT == 1) { const int ln = (fq << 4) | fr; sq += shx(sq, 16, ln); sq += shx(sq, 32, ln);
                    if (u.pn >= 4 && fq == 0) ss[(size_t)row * 16 + (u.pn - 4) * 4 + wc] = sq; }
            }
    }
};
struct EpiResid {
    static constexpr bool PERM = false, LDSBIAS = false;
    bf16* xb; const float* modl;
    __device__ __forceinline__ void operator()(const f32x4 (&acc)[2][2][4][2], const Unit& u, int wr, int wc, int fr, int fq) const {
        const bool lat = u.pm < ML / BM; const int bidx = lat ? (u.pm >> 5) : 8;
        bf16* base = xb + (size_t)u.pm * BM * D;
        const float* g = modl + bidx * 6144 + 2 * 1024;
        const int r0 = wr * 64 + fr, col0 = u.pn * BM + wc * 32 + 4 * fq;
        f32x4 gv[2][2];
#pragma unroll
        for (int bj = 0; bj < 2; ++bj)
#pragma unroll
            for (int n = 0; n < 2; ++n) gv[bj][n] = *(const f32x4*)(g + col0 + bj * HALF + n * 16);
        const int odd = fq & 1, colp = col0 - 4 * odd;
#pragma unroll
        for (int ai = 0; ai < 2; ++ai) { v4u bs[2][2][2];
#pragma unroll
            for (int mp = 0; mp < 2; ++mp) { const size_t off = (size_t)(r0 + ai * HALF + (2 * mp + odd) * 16) * D + colp;
#pragma unroll
                for (int bj = 0; bj < 2; ++bj)
#pragma unroll
                    for (int n = 0; n < 2; ++n) bs[mp][bj][n] = *(const v4u*)(base + off + bj * HALF + n * 16); }
#pragma unroll
            for (int mp = 0; mp < 2; ++mp) { const size_t off = (size_t)(r0 + ai * HALF + (2 * mp + odd) * 16) * D + colp;
#pragma unroll
                for (int bj = 0; bj < 2; ++bj)
#pragma unroll
                    for (int n = 0; n < 2; ++n) { const v4u L = bs[mp][bj][n];
                        const auto s0 = __builtin_amdgcn_permlane16_swap(L.x, L.z, false, false), s1 = __builtin_amdgcn_permlane16_swap(L.y, L.w, false, false);
                        const f32x4 va = bf4_f32((v2u){s0[0], s1[0]}) + gv[bj][n] * acc[ai][bj][2 * mp][n], vb = bf4_f32((v2u){s0[1], s1[1]}) + gv[bj][n] * acc[ai][bj][2 * mp + 1][n];
                        const auto t0 = __builtin_amdgcn_permlane16_swap(cvt_pk_bf16(va.x, va.y), cvt_pk_bf16(vb.x, vb.y), false, false), t1 = __builtin_amdgcn_permlane16_swap(cvt_pk_bf16(va.z, va.w), cvt_pk_bf16(vb.z, vb.w), false, false);
                        *(v4u*)(base + off + bj * HALF + n * 16) = (v4u){t0[0], t1[0], t0[1], t1[1]}; } }
            asm volatile("" ::: "memory"); }
    }
};
struct EpiSwiglu {
    static constexpr bool PERM = true, LDSBIAS = true;
    unsigned char* O; const float* b1; LAS float* bl;
    __device__ __forceinline__ void stage_bias(const Unit& u, int lane) const { const float* src = b1 + (size_t)u.e * 2048 + (lane < 32 ? u.pn * HALF + 4 * lane : 1024 + u.pn * HALF + 4 * (lane - 32));
        __builtin_amdgcn_global_load_lds((const unsigned*)src, (LAS unsigned*)bl, 16, 0, 0); }
    __device__ __forceinline__ void operator()(const f32x4 (&acc)[2][2][4][2], const Unit& u, int wr, int wc, int fr, int fq) const {
        const int row0 = u.pm * BM + wr * 64 + fr, cl = wc * 32 + 8 * fq, c0 = u.pn * HALF + cl;
        f32x4 bg[2], bli[2];
#pragma unroll
        for (int n = 0; n < 2; ++n) { bg[n] = *(const LAS f32x4*)(bl + cl + 4 * n); bli[n] = *(const LAS f32x4*)(bl + 128 + cl + 4 * n) + 1.0f; }
#pragma unroll
        for (int ai = 0; ai < 2; ++ai)
#pragma unroll
            for (int mp = 0; mp < 4; mp += 2) { v2u wv[2];
#pragma unroll
              for (int mm = 0; mm < 2; ++mm) { const int m = mp + mm; float o[8];
#pragma unroll
                for (int n = 0; n < 2; ++n)
#pragma unroll
                    for (int j = 0; j < 4; ++j) { const float gl = fminf(acc[ai][0][m][n][j] + bg[n][j], 7.0f), lp = __builtin_amdgcn_fmed3f(acc[ai][1][m][n][j] + bli[n][j], -6.0f, 8.0f);
                        const float sg = __builtin_amdgcn_rcpf(1.0f + __builtin_amdgcn_exp2f(gl * (-1.702f * 1.4426950408889634f)));
                        o[n * 4 + j] = gl * sg * lp; }
                v2u w; w.x = 0; w.y = 0;
                w.x = __builtin_amdgcn_cvt_pk_fp8_f32(o[0], o[1], w.x, false); w.x = __builtin_amdgcn_cvt_pk_fp8_f32(o[2], o[3], w.x, true);
                w.y = __builtin_amdgcn_cvt_pk_fp8_f32(o[4], o[5], w.y, false); w.y = __builtin_amdgcn_cvt_pk_fp8_f32(o[6], o[7], w.y, true);
                wv[mm] = w; }
              const auto sx = __builtin_amdgcn_permlane16_swap(wv[0].x, wv[1].x, false, false), sy = __builtin_amdgcn_permlane16_swap(wv[0].y, wv[1].y, false, false);
              *(v4u*)(O + (size_t)(row0 + ai * HALF + (mp + (fq & 1)) * 16) * D + (c0 - 8 * (fq & 1))) = (v4u){sx[0], sy[0], sx[1], sy[1]}; }
    }
};
struct EpiBias {
    static constexpr bool PERM = true, LDSBIAS = true;
    unsigned char* O; const float* b2; LAS float* bl;
    __device__ __forceinline__ void stage_bias(const Unit& u, int lane) const { __builtin_amdgcn_global_load_lds((const unsigned*)(b2 + (size_t)u.e * 1024 + u.pn * BM + 4 * lane), (LAS unsigned*)bl, 16, 0, 0); }
    __device__ __forceinline__ void operator()(const f32x4 (&acc)[2][2][4][2], const Unit& u, int wr, int wc, int fr, int fq) const {
        const int row0 = u.pm * BM + wr * 64 + fr, cl = wc * 32 + 8 * fq, col0 = u.pn * BM + cl;
#pragma unroll
        for (int bj = 0; bj < 2; ++bj) { const f32x4 bv0 = *(const LAS f32x4*)(bl + cl + bj * HALF), bv1 = *(const LAS f32x4*)(bl + cl + bj * HALF + 4);
#pragma unroll
            for (int ai = 0; ai < 2; ++ai)
#pragma unroll
                for (int mp = 0; mp < 4; mp += 2) { v2u wv[2];
#pragma unroll
                    for (int mm = 0; mm < 2; ++mm) { const int m = mp + mm; const f32x4 v0 = acc[ai][bj][m][0] + bv0, v1 = acc[ai][bj][m][1] + bv1;
                        v2u w; w.x = 0; w.y = 0;
                        w.x = __builtin_amdgcn_cvt_pk_fp8_f32(v0[0], v0[1], w.x, false); w.x = __builtin_amdgcn_cvt_pk_fp8_f32(v0[2], v0[3], w.x, true);
                        w.y = __builtin_amdgcn_cvt_pk_fp8_f32(v1[0], v1[1], w.y, false); w.y = __builtin_amdgcn_cvt_pk_fp8_f32(v1[2], v1[3], w.y, true);
                        wv[mm] = w; }
                    const auto sx = __builtin_amdgcn_permlane16_swap(wv[0].x, wv[1].x, false, false), sy = __builtin_amdgcn_permlane16_swap(wv[0].y, wv[1].y, false, false);
                    *(v4u*)(O + (size_t)(row0 + ai * HALF + (mp + (fq & 1)) * 16) * D + (col0 - 8 * (fq & 1)) + bj * HALF) = (v4u){sx[0], sy[0], sx[1], sy[1]}; }
            asm volatile("" ::: "memory"); }
    }
};
}

namespace att {
constexpr int AD = 128, NW = 8, QBLK = 32, KVBLK = 64;
constexpr float SCALE = 0.088388347648318440f;
constexpr int LDO = 1024;
constexpr int SHM_V = AD * KVBLK, SHM_K = KVBLK * AD, SHM_ATTN = 4 * SHM_V + 4 * SHM_K;
typedef int v8i __attribute__((ext_vector_type(8)));
#define K8SW(key, c) ((key) * 128 + ((((c) ^ (((key) >> 1) & 7))) << 4))
#define V8SW(d, c) ((d) * 64 + ((((c) ^ (((d) >> 2) & 3))) << 4))
#define SBAR() __builtin_amdgcn_sched_barrier(0)
__device__ __forceinline__ int crow(int r, int hi) { return (r & 3) + 8 * (r >> 2) + 4 * hi; }
template <int XV = 0>
__device__ __forceinline__ int exp4(float a0, float a1, float a2, float a3) {
  float t0 = fminf(a0 + 8.0f, 8.0f), t1 = fminf(a1 + 8.0f, 8.0f), t2 = fminf(a2 + 8.0f, 8.0f), t3 = fminf(a3 + 8.0f, 8.0f); int w;
  asm volatile("v_exp_f32 %1, %1\n\tv_exp_f32 %2, %2\n\tv_exp_f32 %3, %3\n\tv_exp_f32 %4, %4\n\t"
               "v_cvt_pk_fp8_f32 %0, %1, %2\n\ts_nop 0\n\tv_cvt_pk_fp8_f32 %0, %3, %4 op_sel:[0,0,1]"
               : "=&v"(w), "+v"(t0), "+v"(t1), "+v"(t2), "+v"(t3));
  return w;
}
template <int PAD>
__device__ __forceinline__ int expc4(float a0, float a1, float a2, float a3) {
  int w; float t0, t1, t2, t3;
  if constexpr (PAD != 0)
    asm volatile("s_nop 5\n\tv_exp_f32_e64 %1, %5 clamp\n\tv_exp_f32_e64 %2, %6 clamp\n\tv_exp_f32_e64 %3, %7 clamp\n\tv_exp_f32_e64 %4, %8 clamp\n\t"
                 "v_cvt_scalef32_pk_fp8_f32 %0, %1, %2, %9\n\ts_nop 0\n\tv_cvt_scalef32_pk_fp8_f32 %0, %3, %4, %9 op_sel:[0,0,0,1]"
                 : "=&v"(w), "=&v"(t0), "=&v"(t1), "=&v"(t2), "=&v"(t3) : "v"(a0), "v"(a1), "v"(a2), "v"(a3), "s"(0x3B800000));
  else
    asm volatile("v_exp_f32_e64 %1, %5 clamp\n\tv_exp_f32_e64 %2, %6 clamp\n\tv_exp_f32_e64 %3, %7 clamp\n\tv_exp_f32_e64 %4, %8 clamp\n\t"
                 "v_cvt_scalef32_pk_fp8_f32 %0, %1, %2, %9\n\ts_nop 0\n\tv_cvt_scalef32_pk_fp8_f32 %0, %3, %4, %9 op_sel:[0,0,0,1]"
                 : "=&v"(w), "=&v"(t0), "=&v"(t1), "=&v"(t2), "=&v"(t3) : "v"(a0), "v"(a1), "v"(a2), "v"(a3), "s"(0x3B800000));
  return w;
}
#define EXC4(P, m, PAD) expc4<PAD>(P[4 * (m)], P[4 * (m) + 1], P[4 * (m) + 2], P[4 * (m) + 3])
typedef int v4i __attribute__((ext_vector_type(4)));
__device__ __forceinline__ void partialSM(const f32x16& p0, float nb, v4i& plo) {
#pragma unroll
  for (int m = 0; m < 4; ++m) plo[m] = exp4(p0[4 * m], p0[4 * m + 1], p0[4 * m + 2], p0[4 * m + 3]);
}
__device__ __forceinline__ void finishSM(const f32x16& p1, float nb, const v4i& plo, v8i& pa) {
  v4i phi;
#pragma unroll
  for (int m = 0; m < 4; ++m) phi[m] = exp4(p1[4 * m], p1[4 * m + 1], p1[4 * m + 2], p1[4 * m + 3]);
  pa = (v8i){plo[0], plo[1], plo[2], plo[3], phi[0], phi[1], phi[2], phi[3]};
}
__device__ __forceinline__ void qkt(f32x16& p0, f32x16& p1, const char* Ks, const v8i* q8, int r32, int hi, const f32x16& NBV) {
  p0 = NBV; p1 = NBV;
#pragma unroll
  for (int s = 0; s < 2; ++s) { const int c0 = 4 * s + 2 * hi;
    const v4u a0 = *reinterpret_cast<const v4u*>(Ks + K8SW(r32, c0)), a1 = *reinterpret_cast<const v4u*>(Ks + K8SW(r32, c0 + 1));
    const v4u b0 = *reinterpret_cast<const v4u*>(Ks + K8SW(32 + r32, c0)), b1 = *reinterpret_cast<const v4u*>(Ks + K8SW(32 + r32, c0 + 1));
    const v8i A0 = (v8i){(int)a0.x, (int)a0.y, (int)a0.z, (int)a0.w, (int)a1.x, (int)a1.y, (int)a1.z, (int)a1.w};
    const v8i A1 = (v8i){(int)b0.x, (int)b0.y, (int)b0.z, (int)b0.w, (int)b1.x, (int)b1.y, (int)b1.z, (int)b1.w};
    p0 = __builtin_amdgcn_mfma_scale_f32_32x32x64_f8f6f4(A0, q8[s], p0, 0, 0, 0, 0x7F7F7F7F, 0, 0x7C7C7C7C);
    p1 = __builtin_amdgcn_mfma_scale_f32_32x32x64_f8f6f4(A1, q8[s], p1, 0, 0, 0, 0x7F7F7F7F, 0, 0x7C7C7C7C); }
}
__device__ __forceinline__ void pv_d0(f32x16* o, f32x16& lacc, const char* Vs, v8i pa, int r32, int hi) {
  { const int one = 0x38383838; const v8i ONES = (v8i){one, one, one, one, one, one, one, one};
    lacc = __builtin_amdgcn_mfma_scale_f32_32x32x64_f8f6f4(pa, ONES, lacc, 0, 0, 0, 0x7F7F7F7F, 0, 0x7F7F7F7F); }
#pragma unroll
  for (int d0 = 0; d0 < 4; ++d0) { const int d = 32 * d0 + r32;
    const v4u b0 = *reinterpret_cast<const v4u*>(Vs + V8SW(d, 2 * hi)), b1 = *reinterpret_cast<const v4u*>(Vs + V8SW(d, 2 * hi + 1));
    const v8i B = (v8i){(int)b0.x, (int)b0.y, (int)b0.z, (int)b0.w, (int)b1.x, (int)b1.y, (int)b1.z, (int)b1.w};
    o[d0] = __builtin_amdgcn_mfma_scale_f32_32x32x64_f8f6f4(pa, B, o[d0], 0, 0, 0, 0x7F7F7F7F, 0, 0x7F7F7F7F); }
}
__device__ __forceinline__ v8i lds32(const char* p0, const char* p1) { const v4u a = *reinterpret_cast<const v4u*>(p0), b = *reinterpret_cast<const v4u*>(p1);
  return (v8i){(int)a.x, (int)a.y, (int)a.z, (int)a.w, (int)b.x, (int)b.y, (int)b.z, (int)b.w}; }
#define MF8(A, B, C, SB) ((XV == 3 || XV == 4 || XV == 5 || XV == 9) ? (C) : __builtin_amdgcn_mfma_scale_f32_32x32x64_f8f6f4(A, B, C, 0, 0, 0, 0x7F7F7F7F, 0, SB))
#define EX4(P, m) exp4<XV>(P[4 * (m)], P[4 * (m) + 1], P[4 * (m) + 2], P[4 * (m) + 3])
template <int XV = 0>
__device__ __forceinline__ void tile_step(f32x16& pN0, f32x16& pN1, const f32x16& pP1, const v4i& ploP, v4i& ploN, f32x16* o, f32x16& lacc,
                                          const char* Ks, const char* Vs, const v8i* q8, int r32, int hi, const f32x16& Z) {
  const int one = 0x38383838; const v8i ONES = (v8i){one, one, one, one, one, one, one, one};
  v4i phi;
  const v8i A00 = lds32(Ks + K8SW(r32, 2 * hi), Ks + K8SW(r32, 2 * hi + 1)), A10 = lds32(Ks + K8SW(32 + r32, 2 * hi), Ks + K8SW(32 + r32, 2 * hi + 1));
  const v8i A01 = lds32(Ks + K8SW(r32, 4 + 2 * hi), Ks + K8SW(r32, 4 + 2 * hi + 1)), A11 = lds32(Ks + K8SW(32 + r32, 4 + 2 * hi), Ks + K8SW(32 + r32, 4 + 2 * hi + 1));
  phi[0] = EXC4(pP1, 0, 0); SBAR();
  pN0 = MF8(A00, q8[0], Z, 0x7C7C7C7C);   SBAR(); const v8i V0 = lds32(Vs + V8SW(r32, 2 * hi), Vs + V8SW(r32, 2 * hi + 1));           phi[1] = EXC4(pP1, 1, 0); SBAR();
  pN0 = MF8(A01, q8[1], pN0, 0x7C7C7C7C); SBAR(); const v8i V1 = lds32(Vs + V8SW(32 + r32, 2 * hi), Vs + V8SW(32 + r32, 2 * hi + 1)); phi[2] = EXC4(pP1, 2, 0); SBAR();
  pN1 = MF8(A10, q8[0], Z, 0x7C7C7C7C);   SBAR(); const v8i V2 = lds32(Vs + V8SW(64 + r32, 2 * hi), Vs + V8SW(64 + r32, 2 * hi + 1)); phi[3] = EXC4(pP1, 3, 0); SBAR();
  pN1 = MF8(A11, q8[1], pN1, 0x7C7C7C7C); SBAR(); const v8i V3 = lds32(Vs + V8SW(96 + r32, 2 * hi), Vs + V8SW(96 + r32, 2 * hi + 1)); SBAR();
  const v8i pa = (v8i){ploP[0], ploP[1], ploP[2], ploP[3], phi[0], phi[1], phi[2], phi[3]};
  lacc = MF8(pa, ONES, lacc, 0x7F7F7F7F); SBAR(); ploN[0] = EXC4(pN0, 0, 1); SBAR();
  o[0] = MF8(pa, V0, o[0], 0x7F7F7F7F);   SBAR(); ploN[1] = EXC4(pN0, 1, 0); SBAR();
  o[1] = MF8(pa, V1, o[1], 0x7F7F7F7F);   SBAR(); ploN[2] = EXC4(pN0, 2, 0); SBAR();
  o[2] = MF8(pa, V2, o[2], 0x7F7F7F7F);   SBAR(); ploN[3] = EXC4(pN0, 3, 0); SBAR();
  o[3] = MF8(pa, V3, o[3], 0x7F7F7F7F);   SBAR();
}
template <int XV = 0>
__device__ __forceinline__ void attn_dense_body(const unsigned char* __restrict__ Q8, const unsigned char* __restrict__ K8, const unsigned char* __restrict__ VT, int vt_ld, bf16* __restrict__ Ob, int seq, char* lds, int wave_id, float nb) {
  const int tid = opaque_tid(wave_id), wid = tid >> 6, lane = tid & 63, r32 = lane & 31, hi = lane >> 5;
  char* V_lds = lds; char* K_lds = lds + 4 * SHM_V;
  f32x16 lacc = {}; f32x16 o[4] = {}; v8i qr[2]; f32x16 NBV;
#pragma unroll
  for (int i = 0; i < 16; ++i) NBV[i] = nb;
  { const unsigned char* Qw = Q8 + (long)(wid * QBLK + r32) * 1024 + hi * 32;
#pragma unroll
    for (int s2 = 0; s2 < 2; ++s2) { const v4u a = *reinterpret_cast<const v4u*>(Qw + 64 * s2), b = *reinterpret_cast<const v4u*>(Qw + 64 * s2 + 16);
      qr[s2] = (v8i){(int)a.x, (int)a.y, (int)a.z, (int)a.w, (int)b.x, (int)b.y, (int)b.z, (int)b.w}; } }
  struct { v4u vs, ks; } sr_[1];
  const int kkey = tid >> 3, kch = tid & 7; const unsigned koff = (unsigned)(kkey * 256 + kch * 16); const int kst = K8SW(kkey, kch);
  const int vd = tid >> 2, vc = tid & 3; const unsigned voff = (unsigned)(vd * vt_ld + vc * 16); const int vst = V8SW(vd, vc);
#define SLOAD(i, k0) do { if (XV >= 7) break; sr_[i].vs = *reinterpret_cast<const v4u*>((const char*)VT + (size_t)(k0) + voff); \
    sr_[i].ks = *reinterpret_cast<const v4u*>((const char*)K8 + (size_t)(k0) * 256 + koff); } while (0)
#define SWRITE(b, i) do { *(v4u*)(V_lds + (b) * SHM_V + vst) = sr_[i].vs; *(v4u*)(K_lds + (b) * SHM_K + kst) = sr_[i].ks; } while (0)
#define SWAIT() asm volatile("s_waitcnt vmcnt(0)" ::: "memory")
#define TBAR() asm volatile("s_waitcnt lgkmcnt(0)\n\ts_barrier" ::: "memory")
  f32x16 pA0, pA1, pB0, pB1; v8i pa; v4i plA, plB; const int NT = seq / KVBLK;
  SLOAD(0, 0); SWAIT(); SWRITE(0, 0); SLOAD(0, KVBLK); TBAR();
  qkt(pA0, pA1, K_lds, qr, r32, hi, NBV); partialSM(pA0, nb, plA);
  SWAIT(); SWRITE(1, 0); SLOAD(0, 2 * KVBLK); TBAR();
#define STEP_IO(t, SW) do { SWAIT(); SWRITE(SW, 0); { const int tn = (t) + 2 < NT ? (t) + 2 : NT - 1; SLOAD(0, tn * KVBLK); } SBAR(); } while (0)
#define STEP_B(t, SK, SV, SW) do { STEP_IO(t, SW); tile_step<XV>(pB0, pB1, pA1, plA, plB, o, lacc, K_lds + (SK) * SHM_K, V_lds + (SV) * SHM_V, qr, r32, hi, NBV); TBAR(); } while (0)
#define STEP_A(t, SK, SV, SW) do { STEP_IO(t, SW); tile_step<XV>(pA0, pA1, pB1, plB, plA, o, lacc, K_lds + (SK) * SHM_K, V_lds + (SV) * SHM_V, qr, r32, hi, NBV); TBAR(); } while (0)
  int j = 1;
  for (; j + 5 < NT; j += 4) { STEP_B(j, 1, 0, 2); STEP_A(j + 1, 2, 1, 3); STEP_B(j + 2, 3, 2, 0); STEP_A(j + 3, 0, 3, 1); }
  STEP_B(j, 1, 0, 2); STEP_A(j + 1, 2, 1, 3);
  SBAR(); qkt(pB0, pB1, K_lds + 3 * SHM_K, qr, r32, hi, NBV);
  finishSM(pA1, nb, plA, pa); SBAR();
  pv_d0(o, lacc, V_lds + 2 * SHM_V, pa, r32, hi); partialSM(pB0, nb, plB);
  finishSM(pB1, nb, plB, pa); SBAR();
  pv_d0(o, lacc, V_lds + 3 * SHM_V, pa, r32, hi);
  { const int ln2 = opaque_tid(wave_id) & 63, r32e = ln2 & 31, hie = ln2 >> 5;
    bf16* Ow = Ob + (long)(wid * QBLK) * LDO;
#pragma unroll
    for (int r = 0; r < 16; ++r) { const int orow = crow(r, hie); const float rl = __builtin_amdgcn_rcpf(lacc[r]);
      for (int d0 = 0; d0 < 4; ++d0) Ow[(long)orow * LDO + d0 * 32 + r32e] = (bf16)f2bf(o[d0][r] * rl); } }
  __syncthreads();
#undef SLOAD
#undef TBAR
#undef STEP_IO
#undef STEP_A
#undef STEP_B
#undef SWRITE
#undef SWAIT
}
#undef K8SW
#undef V8SW
}
constexpr int NWAVES = 8, NTHREADS = 512;
struct Args { const float* in[36]; float* out; unsigned char* ws; int ph_lo, ph_hi; };
enum InIdx { I_X = 0, I_C, I_CTX, I_CCTX, I_ADAW, I_ADAB, I_N1G, I_N2G, I_WOUT, I_RW, I_RB, I_EW1, I_EB1, I_EW2, I_EB2, I_AWIN, I_AQG, I_AKG,
             I_GWIN, I_GVG, I_GWS, I_GBS, I_HWIN, I_HCW, I_HCB, I_FW1, I_FB1, I_FW2, I_FB2, I_FW3, I_FB3, I_FW4, I_FB4, I_FREQ, I_HD, I_FG };
struct Frame {
    LAS unsigned char* lds; volatile LAS unsigned* MISC; gu32* ctl;
    int tid, lane, wave, G, bx;
    float* out; unsigned char* ws;
};
template <class T> __device__ __forceinline__ T* launder(T* p) { unsigned long long v = (unsigned long long)p; asm volatile("" : "+s"(v)); return (T*)(GAS T*)v; }
constexpr int MW_PTRS = 640;
__device__ __forceinline__ const float* pin_load(const Frame& F, int i) {
    const unsigned lo = __builtin_amdgcn_readfirstlane(F.MISC[MW_PTRS + 2 * i]), hi = __builtin_amdgcn_readfirstlane(F.MISC[MW_PTRS + 2 * i + 1]);
    return (const float*)(GAS const float*)(((unsigned long long)hi << 32) | lo);
}
#define PIN(F, i) pin_load(F, i)
__device__ __forceinline__ Frame phase_frame(const Frame& F0) {
    Frame F = F0; F.tid = opaque_tid(F0.wave); F.lane = F.tid & 63; F.wave = F0.wave;
    F.ws = launder(F0.ws); F.out = launder(F0.out); F.ctl = (gu32*)(F.ws + WS_CTL);
    { LAS unsigned char* l = F0.lds; asm volatile("" : "+s"(l)); F.lds = l; F.MISC = (volatile LAS unsigned*)(l + MISC_OFF); }
    return F;
}
constexpr int PH_PRO0 = 0, PH_PRO1 = 1, PH_L0 = 2, PH_PER_LAYER = 9, PH_FINAL = PH_L0 + NLAYER * PH_PER_LAYER, PH_COUNT = PH_FINAL + 1;
enum LPhase { LP_NORM1 = 0, LP_INPROJ, LP_MIX1, LP_MIX2, LP_MIX3, LP_OUTPROJ, LP_NORM2, LP_MOE1, LP_MOE2 };

struct TItem { const float* src; unsigned char* dst; int N; bool fp8; };
__device__ __forceinline__ TItem titem_decode(Frame& F, int it) {
    constexpr int R0 = 128 * 512, R1 = 128 * 256, R2 = 2 * 384, R3 = 512, R4 = 768;
    int r = it; TItem t;
    if (r < R0) { const int mi = r >> 9, q = r & 511, kb = q >> 5, nb = q & 31, n0 = nb * 64;
        const int d0 = n0 < 1024 ? 256 * (n0 >> 7) + (n0 & 127) : 256 * ((n0 - 1024) >> 7) + 128 + (n0 & 127);
        t.src = PIN(F, I_EW1) + (size_t)mi * 1024 * 2048 + (size_t)(kb * 64) * 2048 + n0; t.N = 2048; t.fp8 = true; t.dst = F.ws + WS_WE1 + (size_t)mi * 2048 * 1024 + (size_t)d0 * 1024 + kb * 64; return t; } r -= R0;
    if (r < R1) { const int mi = r >> 8, q = r & 255, kb = q >> 4, nb = q & 15;
        t.src = PIN(F, I_EW2) + (size_t)mi * 1024 * 1024 + (size_t)(kb * 64) * 1024 + nb * 64; t.N = 1024; t.fp8 = true; t.dst = F.ws + WS_WE2 + (size_t)mi * 1024 * 1024 + (size_t)(nb * 64) * 1024 + kb * 64; return t; } r -= R1;
    if (r < R2) { const int mi = r / 384, q = r % 384, kb = q / 24, nb = q % 24;
        t.src = PIN(F, I_AWIN) + (size_t)mi * 1024 * 1536 + (size_t)(kb * 64) * 1536 + nb * 64; t.N = 1536; t.fp8 = true; t.dst = F.ws + WS_WATT + (size_t)mi * 1536 * 1024 + (size_t)(nb * 64) * 1024 + kb * 64; return t; } r -= R2;
    if (r < R3) { const int kb = r >> 5, nb = r & 31;
        t.src = PIN(F, I_GWIN) + (size_t)(kb * 64) * 2048 + nb * 64; t.N = 2048; t.fp8 = false; t.dst = F.ws + WS_WGM + ((size_t)(nb * 64) * 1024 + kb * 64) * 2; return t; } r -= R3;
    if (r < R4) { const int kb = r / 48, nb = r % 48;
        t.src = PIN(F, I_HWIN) + (size_t)(kb * 64) * 3072 + nb * 64; t.N = 3072; t.fp8 = true; t.dst = F.ws + WS_WHY + (size_t)(nb * 64) * 1024 + kb * 64; return t; } r -= R4;
    { const int mi = r >> 8, q = r & 255, kb = q >> 4, nb = q & 15;
        t.src = PIN(F, I_WOUT) + (size_t)mi * 1024 * 1024 + (size_t)(kb * 64) * 1024 + nb * 64; t.N = 1024; t.fp8 = false; t.dst = F.ws + WS_WOUT + ((size_t)mi * 1024 * 1024 + (size_t)(nb * 64) * 1024 + kb * 64) * 2; return t; }
}
__device__ __forceinline__ void titem_load(const TItem& t, float (&v)[64], int lane) {
    const float* src = t.src + lane;
#pragma unroll
    for (int kk = 0; kk < 64; ++kk) v[kk] = src[(size_t)kk * t.N];
}
__device__ __forceinline__ void titem_finish(const TItem& t, const float (&v)[64], LAS float* scr, int lane) {
    constexpr int K = 1024;
#pragma unroll
    for (int kk = 0; kk < 64; ++kk) scr[kk * 65 + lane] = v[kk];
    LDS_WAIT(); asm volatile("" ::: "memory");
    if (!t.fp8) {
        const int c = lane & 7;
#pragma unroll
        for (int j = 0; j < 8; ++j) { const int n = (lane >> 3) + 8 * j; const LAS float* s = scr + (8 * c) * 65 + n;
            v4u o; o.x = pk2(s[0 * 65], s[1 * 65]); o.y = pk2(s[2 * 65], s[3 * 65]); o.z = pk2(s[4 * 65], s[5 * 65]); o.w = pk2(s[6 * 65], s[7 * 65]);
            *(GAS v4u*)(t.dst + ((size_t)n * K + 8 * c) * 2) = o; }
    } else {
        const int c = lane & 3;
#pragma unroll
        for (int j = 0; j < 4; ++j) { const int n = (lane >> 2) + 16 * j; const LAS float* s = scr + (16 * c) * 65 + n; unsigned w[4];
#pragma unroll
            for (int q = 0; q < 4; ++q) { unsigned x = 0; x = __builtin_amdgcn_cvt_pk_fp8_f32(32.0f * s[(4 * q) * 65], 32.0f * s[(4 * q + 1) * 65], x, false);
                x = __builtin_amdgcn_cvt_pk_fp8_f32(32.0f * s[(4 * q + 2) * 65], 32.0f * s[(4 * q + 3) * 65], x, true); w[q] = x; }
            *(GAS v4u*)(t.dst + (size_t)n * K + 16 * c) = (v4u){w[0], w[1], w[2], w[3]}; }
    }
    LDS_WAIT(); asm volatile("" ::: "memory");
}
__device__ __forceinline__ void pro0_transposes(Frame& F) {
    LAS float* scr = (LAS float*)(F.lds + F.wave * 16640);
    const int gw = F.bx * NWAVES + F.wave, NGW = F.G * NWAVES;
    constexpr int NITEMS = 128 * 512 + 128 * 256 + 2 * 384 + 512 + 768 + 4 * 256;
    float va[64], vb[64];
    int it = gw; if (it >= NITEMS) return;
    TItem ta = titem_decode(F, it), tb = ta; titem_load(ta, va, F.lane);
    for (;;) {
        const bool nb_ok = it + NGW < NITEMS; if (nb_ok) { tb = titem_decode(F, it + NGW); titem_load(tb, vb, F.lane); }
        titem_finish(ta, va, scr, F.lane);
        if (!nb_ok) break; it += NGW;
        const bool na_ok = it + NGW < NITEMS; if (na_ok) { ta = titem_decode(F, it + NGW); titem_load(ta, va, F.lane); }
        titem_finish(tb, vb, scr, F.lane);
        if (!na_ok) break; it += NGW;
    }
}
__device__ __forceinline__ void pro0_mod(Frame& F) {
    LAS float* sl = (LAS float*)F.lds;
    LAS float* red = (LAS float*)(F.lds + 65536);
    __syncthreads();
    for (int i = F.tid; i < 9 * 1024; i += NTHREADS) { const int r = i >> 10, k = i & 1023; const float v = r < 8 ? PIN(F, I_C)[r * 1024 + k] : PIN(F, I_CCTX)[k]; sl[i] = v / (1.0f + __expf(-v)); }
    __syncthreads();
    float* MOD = (float*)(F.ws + WS_MOD);
    for (int item = F.bx; item < NLAYER * 96; item += F.G) {
        const int l = item / 96, n0 = (item % 96) * 64;
        const float* W = PIN(F, I_ADAW) + (size_t)l * 1024 * 6144 + n0 + F.lane;
        float acc[9];
#pragma unroll
        for (int r = 0; r < 9; ++r) acc[r] = 0.f;
        const int kb = F.wave * 128;
#pragma unroll 16
        for (int k = 0; k < 128; ++k) { const float wv = W[(size_t)(kb + k) * 6144];
#pragma unroll
            for (int r = 0; r < 9; ++r) acc[r] += sl[r * 1024 + kb + k] * wv; }
#pragma unroll
        for (int r = 0; r < 9; ++r) red[(F.wave * 9 + r) * 64 + F.lane] = acc[r];
        __syncthreads();
        for (int i = F.tid; i < 9 * 64; i += NTHREADS) { const int r = i >> 6, n = i & 63; float s = 0.f;
#pragma unroll
            for (int w = 0; w < 8; ++w) s += red[(w * 9 + r) * 64 + n];
            MOD[((size_t)l * 9 + r) * 6144 + n0 + n] = s + PIN(F, I_ADAB)[l * 6144 + n0 + n]; }
        __syncthreads();
    }
}
__device__ __forceinline__ void pro0_filter_mlp(Frame& F) {
    const int j = F.lane, gw = F.bx * NWAVES + F.wave, NGW = F.G * NWAVES;
    LAS float* W1 = (LAS float*)F.lds; LAS float* W2 = W1 + FEMB * FH; LAS float* W3 = W2 + FH * FH;
    __syncthreads();
    for (int i = F.tid; i < FEMB * FH; i += NTHREADS) W1[i] = PIN(F, I_FW1)[i];
    for (int i = F.tid; i < FH * FH; i += NTHREADS) { W2[i] = PIN(F, I_FW2)[i]; W3[i] = PIN(F, I_FW3)[i]; }
    __syncthreads();
    const float b1 = PIN(F, I_FB1)[j], b2 = PIN(F, I_FB2)[j], b3 = PIN(F, I_FB3)[j], fr = PIN(F, I_FREQ)[j];
    for (int it = gw; it < SEQ + CL; it += NGW) {
        const bool lat = it < SEQ; const int t = lat ? it : it - SEQ; const float L = lat ? (float)SEQ : (float)CL;
        const float tl = (float)t / (L - 1.0f), w = (6.283185307179586f * (float)t) / L;
        float z;
        { const int band = (j - 1) & 15; const float f = 1e-4f + (float)band * ((15.0f - 1e-4f) / 15.0f); const float a = f * w;
          z = (j == 0) ? tl : (j <= 16 ? cosf(a) : -sinf(a)); }
        float s = b1;
#pragma unroll
        for (int i = 0; i < FEMB; ++i) s += __shfl(z, i) * W1[i * FH + j];
        const float a1 = sinf(fr * s);
        s = b2;
#pragma unroll 16
        for (int i = 0; i < FH; ++i) s += __shfl(a1, i) * W2[i * FH + j];
        const float a2 = sinf(fr * s);
        s = b3;
#pragma unroll 16
        for (int i = 0; i < FH; ++i) s += __shfl(a2, i) * W3[i * FH + j];
        const float a3 = sinf(fr * s);
        float* dst = lat ? (float*)(F.ws + WS_A3) + (size_t)t * FH : (float*)(F.ws + WS_A3C) + (size_t)t * FH;
        dst[j] = a3;
    }
    __syncthreads();
}

__device__ __forceinline__ f32x2 cmul(f32x2 a, f32x2 b) { return (f32x2){a.x * b.x - a.y * b.y, a.x * b.y + a.y * b.x}; }
__device__ __forceinline__ f32x2 cconj(f32x2 a) { return (f32x2){a.x, -a.y}; }
#define ZP(n) ((n) + ((n) >> 5))
constexpr int FFT_LDS_BYTES = (NFFT + NFFT / 32) * 8;
__device__ __forceinline__ void bfly_dif(f32x2& a0, f32x2& a1, f32x2& a2, f32x2& a3, f32x2 w) {
    const f32x2 t0 = a0 + a2, t1 = a0 - a2, t2 = a1 + a3, d = a1 - a3, t3 = (f32x2){d.y, -d.x};
    const f32x2 y0 = t0 + t2, y2 = t0 - t2, y1 = t1 + t3, y3 = t1 - t3, w2 = cmul(w, w), w3 = cmul(w2, w);
    a0 = y0; a1 = cmul(y2, w2); a2 = cmul(y1, w); a3 = cmul(y3, w3);
}
__device__ __forceinline__ void bfly_dit(f32x2& a0, f32x2& a1, f32x2& a2, f32x2& a3, f32x2 w) {
    const f32x2 w2 = cmul(w, w), w3 = cmul(w2, w), A1 = cmul(a1, w2), A2 = cmul(a2, w), A3 = cmul(a3, w3);
    const f32x2 u0 = a0 + A1, u1 = a0 - A1, u2 = A2 + A3, u3 = A2 - A3, iu3 = (f32x2){-u3.y, u3.x};
    a0 = u0 + u2; a1 = u1 + iu3; a2 = u0 - u2; a3 = u1 - iu3;
}
template <int LQ, bool INV> __device__ __forceinline__ void fft_r16(LAS f32x2* z, int tid) {
    constexpr int q16 = 1 << LQ; constexpr float inv_lb = 1.0f / (float)(16 * q16);
    constexpr float C1 = 0.92387953251128674f, S1 = 0.38268343236508977f, C2 = 0.70710678118654752f;
    asm volatile("" : "+v"(tid));
#pragma unroll 1
    for (int g = tid; g < NFFT / 16; g += NTHREADS) {
        const int j = g & (q16 - 1), base = ((g >> LQ) << (LQ + 4)) + j;
        f32x2 x[16];
#pragma unroll
        for (int m = 0; m < 16; ++m) x[m] = z[ZP(base + (m << LQ))];
        const float fr = (float)j * inv_lb; const float sn = __builtin_amdgcn_sinf(fr);
        const f32x2 w1 = (f32x2){__builtin_amdgcn_cosf(fr), INV ? sn : -sn};
        const float sg = INV ? 1.0f : -1.0f;
        const f32x2 wa0 = w1, wa1 = cmul(w1, (f32x2){C1, sg * S1}), wa2 = cmul(w1, (f32x2){C2, sg * C2}), wa3 = cmul(w1, (f32x2){S1, sg * C1});
        const f32x2 w2 = cmul(w1, w1), wb = cmul(w2, w2);
        if constexpr (!INV) {
            bfly_dif(x[0], x[4], x[8], x[12], wa0); bfly_dif(x[1], x[5], x[9], x[13], wa1); bfly_dif(x[2], x[6], x[10], x[14], wa2); bfly_dif(x[3], x[7], x[11], x[15], wa3);
#pragma unroll
            for (int a = 0; a < 4; ++a) bfly_dif(x[4 * a], x[4 * a + 1], x[4 * a + 2], x[4 * a + 3], wb);
        } else {
#pragma unroll
            for (int a = 0; a < 4; ++a) bfly_dit(x[4 * a], x[4 * a + 1], x[4 * a + 2], x[4 * a + 3], wb);
            bfly_dit(x[0], x[4], x[8], x[12], wa0); bfly_dit(x[1], x[5], x[9], x[13], wa1); bfly_dit(x[2], x[6], x[10], x[14], wa2); bfly_dit(x[3], x[7], x[11], x[15], wa3);
        }
#pragma unroll
        for (int m = 0; m < 16; ++m) z[ZP(base + (m << LQ))] = x[m];
    }
    __syncthreads();
}
template <bool INV> __device__ __forceinline__ void fft_r4_unit(LAS f32x2* z, int tid) {
    asm volatile("" : "+v"(tid));
#pragma unroll 2
    for (int bf = tid; bf < NFFT / 4; bf += NTHREADS) {
        const int base = 4 * bf; f32x2 a0 = z[ZP(base)], a1 = z[ZP(base + 1)], a2 = z[ZP(base + 2)], a3 = z[ZP(base + 3)];
        if constexpr (!INV) { const f32x2 t0 = a0 + a2, t1 = a0 - a2, t2 = a1 + a3, d = a1 - a3, t3 = (f32x2){d.y, -d.x};
            z[ZP(base)] = t0 + t2; z[ZP(base + 1)] = t0 - t2; z[ZP(base + 2)] = t1 + t3; z[ZP(base + 3)] = t1 - t3; }
        else { const f32x2 u0 = a0 + a1, u1 = a0 - a1, u2 = a2 + a3, u3 = a2 - a3, iu3 = (f32x2){-u3.y, u3.x};
            z[ZP(base)] = u0 + u2; z[ZP(base + 1)] = u1 + iu3; z[ZP(base + 2)] = u0 - u2; z[ZP(base + 3)] = u1 - iu3; }
    }
    __syncthreads();
}
__device__ __forceinline__ void fft16k_dif(LAS f32x2* z, int tid) { fft_r16<10, false>(z, tid); fft_r16<6, false>(z, tid); fft_r16<2, false>(z, tid); fft_r4_unit<false>(z, tid); }
__device__ __forceinline__ void fft16k_dit_inv(LAS f32x2* z, int tid) { fft_r4_unit<true>(z, tid); fft_r16<2, true>(z, tid); fft_r16<6, true>(z, tid); fft_r16<10, true>(z, tid); }
constexpr int KF_LD = 8256;
__device__ __forceinline__ int rev14(int p) { return (int)(__brev((unsigned)p) >> 18); }
__device__ __forceinline__ float hy_delta(int c) { const float mn = -3.0701134573253945f, mx = -15.350567286626973f; return fabsf(mn + (mx - mn) * ((float)c / 1023.0f)); }

__device__ __forceinline__ void pro1_router_split(Frame& F) {
    const float* MOD = (const float*)(F.ws + WS_MOD); unsigned char* RW3 = F.ws + WS_RW3;
    for (int ent = F.bx * NTHREADS + F.tid; ent < NLAYER * 9 * 8 * 8 * 64; ent += F.G * NTHREADS) {
        const int lane = ent & 63, kb = (ent >> 6) & 7, w = (ent >> 9) & 7, lb = ent >> 12, l = lb / 9;
        const int k0 = w * 128 + 16 * kb + 8 * (lane >> 5), e = lane & 31;
        const float* gn = PIN(F, I_N2G) + l * D; const float* sc = MOD + (size_t)lb * 6144 + 4 * 1024; const float* rw = PIN(F, I_RW) + (size_t)l * D * NE;
        unsigned ph[4], pm[4], pl[4];
#pragma unroll
        for (int j2 = 0; j2 < 4; ++j2) { const int k = k0 + 2 * j2; const float v0 = gn[k] * (1.0f + sc[k]) * rw[(size_t)k * NE + e], v1 = gn[k + 1] * (1.0f + sc[k + 1]) * rw[(size_t)(k + 1) * NE + e];
            const unsigned h = cvt_pk_bf16(v0, v1); const float r0 = v0 - __uint_as_float(h << 16), r1 = v1 - __uint_as_float(h & 0xffff0000u);
            const unsigned m = cvt_pk_bf16(r0, r1); const float s0 = r0 - __uint_as_float(m << 16), s1 = r1 - __uint_as_float(m & 0xffff0000u);
            ph[j2] = h; pm[j2] = m; pl[j2] = cvt_pk_bf16(s0, s1); }
        v4u* dst = (v4u*)(RW3 + (size_t)(ent >> 6) * 3 * 1024) + lane;
        dst[0] = (v4u){ph[0], ph[1], ph[2], ph[3]}; dst[64] = (v4u){pm[0], pm[1], pm[2], pm[3]}; dst[128] = (v4u){pl[0], pl[1], pl[2], pl[3]};
    }
}
__device__ __forceinline__ void pro1_filters(Frame& F) {
    if (F.bx < NLAYER * 9) {
        const int lb = F.bx, l = lb / 9, e = F.lane & 31, hf = F.lane >> 5; const float* sh = (const float*)(F.ws + WS_MOD) + (size_t)lb * 6144 + 3 * 1024; const float* rw = PIN(F, I_RW) + (size_t)l * D * NE;
        LAS float* red = (LAS float*)F.lds; const int k0 = F.wave * 128 + hf * 64; float acc = 0.f;
#pragma unroll 8
        for (int k = k0; k < k0 + 64; ++k) acc += sh[k] * rw[(size_t)k * NE + e];
        acc += shx(acc, 32, F.lane); if (F.lane < 32) red[F.wave * 32 + e] = acc;
        __syncthreads();
        if (F.tid < 32) { float s = PIN(F, I_RB)[l * NE + F.tid];
#pragma unroll
            for (int w = 0; w < 8; ++w) s += red[w * 32 + F.tid];
            ((float*)(F.ws + WS_RC))[lb * NE + F.tid] = s; }
    }
    LAS f32x2* z = (LAS f32x2*)F.lds;
    LAS float* wl = (LAS float*)(F.lds + AUX_OFF + 8192);
    const float* a3 = (const float*)(F.ws + WS_A3); const float* a3c = (const float*)(F.ws + WS_A3C);
    f32x2* KF = (f32x2*)(F.ws + WS_KF); float* FCT = (float*)(F.ws + WS_FCT);
    for (int u = F.bx; u < 512; u += F.G) {
        const int ca = 2 * u, cb = 2 * u + 1;
        __syncthreads();
        if (F.tid < 256) { const int which = F.tid >> 6, m = F.tid & 63; const int col = (which & 1 ? cb : ca) + (which >> 1) * 1024; wl[which * 64 + m] = PIN(F, I_FW4)[m * 2048 + col]; }
        if (F.tid < 4) { const int col = (F.tid & 1 ? cb : ca) + (F.tid >> 1) * 1024; wl[256 + F.tid] = PIN(F, I_FB4)[col]; }
        __syncthreads();
        const float da = hy_delta(ca), db = hy_delta(cb);
        const float dska = PIN(F, I_HD)[ca], dskb = PIN(F, I_HD)[cb];
        for (int t = F.tid; t < SEQ; t += NTHREADS) {
            const f32x4* ar = (const f32x4*)(a3 + (size_t)t * FH); float s0 = wl[256], s1 = wl[257], s2 = wl[258], s3 = wl[259];
#pragma unroll 8
            for (int m4 = 0; m4 < 16; ++m4) { const f32x4 a = ar[m4];
                const f32x4 w0 = *(const LAS f32x4*)(wl + 4 * m4), w1 = *(const LAS f32x4*)(wl + 64 + 4 * m4), w2 = *(const LAS f32x4*)(wl + 128 + 4 * m4), w3 = *(const LAS f32x4*)(wl + 192 + 4 * m4);
                s0 += (a.x * w0.x + a.y * w0.y) + (a.z * w0.z + a.w * w0.w); s1 += (a.x * w1.x + a.y * w1.y) + (a.z * w1.z + a.w * w1.w);
                s2 += (a.x * w2.x + a.y * w2.y) + (a.z * w2.z + a.w * w2.w); s3 += (a.x * w3.x + a.y * w3.y) + (a.z * w3.z + a.w * w3.w); }
            const float tl = (float)t / (float)(SEQ - 1); const float wa = __expf(-tl * da), wb = __expf(-tl * db);
            z[ZP(t)] = (f32x2){s0 * wa + (t == 0 ? dska : 0.f), s1 * wb + (t == 0 ? dskb : 0.f)};
            if (t == 0) z[ZP(SEQ)] = (f32x2){0.f, 0.f}; else z[ZP(NFFT - t)] = (f32x2){s2 * wa, s3 * wb};
        }
        for (int i = F.tid; i < 511; i += NTHREADS) {
            const int d = i - 255, t = d < 0 ? -d : d; const int o = d < 0 ? 2 : 0;
            const f32x4* ar = (const f32x4*)(a3c + (size_t)t * FH); float sa = wl[256 + o], sb = wl[257 + o];
            f32x4 av[16];
#pragma unroll
            for (int m4 = 0; m4 < 16; ++m4) av[m4] = ar[m4];
            __builtin_amdgcn_sched_barrier(0);
#pragma unroll
            for (int m4 = 0; m4 < 16; ++m4) {
#pragma unroll
                for (int i2 = 0; i2 < 4; ++i2) { const int m = m4 * 4 + i2; sa += av[m4][i2] * wl[o * 64 + m]; sb += av[m4][i2] * wl[(o + 1) * 64 + m]; }
                if ((m4 & 3) == 3) __builtin_amdgcn_sched_barrier(0); }
            const float tl = (float)t / (float)(CL - 1);
            FCT[(size_t)ca * 512 + d + 256] = sa * __expf(-tl * da) + (d == 0 ? dska : 0.f); FCT[(size_t)cb * 512 + d + 256] = sb * __expf(-tl * db) + (d == 0 ? dskb : 0.f);
        }
        __syncthreads();
        fft16k_dif(z, F.tid);
        for (int k = F.tid; k <= NFFT / 2; k += NTHREADS) {
            const int p = rev14(k), p2 = rev14((NFFT - k) & (NFFT - 1)); const f32x2 a = z[ZP(p)], b = z[ZP(p2)];
            KF[(size_t)ca * KF_LD + k] = (f32x2){0.5f * (a.x + b.x), 0.5f * (a.y - b.y)};
            KF[(size_t)cb * KF_LD + k] = (f32x2){0.5f * (a.y + b.y), -0.5f * (a.x - b.x)};
        }
    }
    __syncthreads();
}

__device__ __forceinline__ void hyena_conv_phase(Frame& F) {
    LAS f32x2* z = (LAS f32x2*)F.lds;
    LAS float* aux = (LAS float*)(F.lds + AUX_OFF + 8192);
    const float* VT = (const float*)(F.ws + WS_VT); const float* VTC = (const float*)(F.ws + WS_VTC); float* CT = (float*)(F.ws + WS_CT); float* CTC = (float*)(F.ws + WS_CTC);
    const f32x2* KF = (const f32x2*)(F.ws + WS_KF); const float* FCT = (const float*)(F.ws + WS_FCT);
    v4u ina[2], inb[2];
#define HC_LOADIN(u_, t_) do { const int b_ = (u_) >> 9, c_ = 2 * ((u_) & 511); const v4u* va_ = (const v4u*)((const bf16*)VT + ((size_t)b_ * 1024 + c_) * SEQ + 16 * (t_)); \
        ina[0] = va_[0]; ina[1] = va_[1]; inb[0] = va_[SEQ / 8]; inb[1] = va_[SEQ / 8 + 1]; } while (0)
    if (F.bx < NB * 512) HC_LOADIN(F.bx, F.tid);
    for (int u = F.bx; u < NB * 512; u += F.G) {
        const int b = u >> 9, cp = u & 511, ca = 2 * cp, cb = ca + 1;
        int tq = F.tid; asm volatile("" : "+v"(tq));
        __syncthreads();
        { const int n0 = 16 * tq;
#pragma unroll
          for (int i = 0; i < 4; ++i) { const unsigned a0 = ina[i >> 1][2 * (i & 1)], a1 = ina[i >> 1][2 * (i & 1) + 1], b0 = inb[i >> 1][2 * (i & 1)], b1 = inb[i >> 1][2 * (i & 1) + 1];
              z[ZP(n0 + 4 * i)] = (f32x2){bflo(a0), bflo(b0)}; z[ZP(n0 + 4 * i + 1)] = (f32x2){bfhi(a0), bfhi(b0)}; z[ZP(n0 + 4 * i + 2)] = (f32x2){bflo(a1), bflo(b1)}; z[ZP(n0 + 4 * i + 3)] = (f32x2){bfhi(a1), bfhi(b1)};
#pragma unroll
              for (int j = 0; j < 4; ++j) z[ZP(SEQ + n0 + 4 * i + j)] = (f32x2){0.f, 0.f}; } }
        f32x4 ka[8], kb[8]; f32x2 kaN, kbN;
        { const f32x4* pa = (const f32x4*)(KF + (size_t)ca * KF_LD + 16 * tq); const f32x4* pb = (const f32x4*)(KF + (size_t)cb * KF_LD + 16 * tq);
#pragma unroll
          for (int i = 0; i < 8; ++i) { ka[i] = pa[i]; kb[i] = pb[i]; }
          kaN = KF[(size_t)ca * KF_LD + NFFT / 2]; kbN = KF[(size_t)cb * KF_LD + NFFT / 2]; }
        { const int h = tq >> 8, t = tq & 255;
          const float* vc = VTC + ((size_t)b * 1024 + ca + h) * CL;
          aux[h * 256 + t] = vc[t]; aux[512 + h * 520 + 1 + t] = FCT[(size_t)(ca + h) * 512 + t]; aux[512 + h * 520 + 257 + t] = FCT[(size_t)(ca + h) * 512 + 256 + t];
          __syncthreads();
          if (tq < 256) { const int hh = tq >> 7, pp = tq & 127; const LAS float* vv = aux + hh * 256; const LAS float* kk = aux + 512 + hh * 520 + 256 + 2 * pp;
              float y0 = 0.f, y1 = 0.f, lop = kk[2];
#pragma unroll 8
              for (int q = 0; q < CL / 2; ++q) { const f32x2 v = *(const LAS f32x2*)(vv + 2 * q), kq = *(const LAS f32x2*)(kk - 2 * q);
                  y0 += v.x * kq.y + v.y * kq.x; y1 += v.x * lop + v.y * kq.y; lop = kq.x; }
              *(f32x2*)(CTC + ((size_t)b * 1024 + ca + hh) * CL + 2 * pp) = (f32x2){y0, y1}; } }
        fft16k_dif(z, F.tid);
        int tpw = tq; asm volatile("" : "+v"(tpw));
#define HC_PW(k_, Ka_, Kb_) do { const int p = rev14(k_), p2 = rev14((NFFT - (k_)) & (NFFT - 1)); const f32x2 a = z[ZP(p)], b2 = z[ZP(p2)]; \
            const f32x2 Va = (f32x2){0.5f * (a.x + b2.x), 0.5f * (a.y - b2.y)}, Vb = (f32x2){0.5f * (a.y + b2.y), -0.5f * (a.x - b2.x)}; \
            const f32x2 ya = cmul(Va, Ka_), yb = cmul(Vb, Kb_); \
            z[ZP(p)] = (f32x2){ya.x - yb.y, ya.y + yb.x}; z[ZP(p2)] = (f32x2){ya.x + yb.y, -ya.y + yb.x}; } while (0)
#pragma unroll
        for (int i = 0; i < 8; ++i) { const int k = 16 * tpw + 2 * i;
            HC_PW(k, ((f32x2){ka[i].x, ka[i].y}), ((f32x2){kb[i].x, kb[i].y})); HC_PW(k + 1, ((f32x2){ka[i].z, ka[i].w}), ((f32x2){kb[i].z, kb[i].w}));
            asm volatile("" ::: "memory"); }
        if (tpw == 0) HC_PW(NFFT / 2, kaN, kbN);
#undef HC_PW
        __syncthreads();
        if (u + F.G < NB * 512) HC_LOADIN(u + F.G, tq);
        fft16k_dit_inv(z, F.tid);
        { int to = tq; asm volatile("" : "+v"(to)); const float sc = 1.0f / (float)NFFT; const int n0 = 16 * to;
          v4u* oa = (v4u*)((bf16*)CT + ((size_t)b * 1024 + ca) * SEQ + n0);
#pragma unroll
          for (int h2 = 0; h2 < 2; ++h2) { f32x2 w[8];
#pragma unroll
              for (int j = 0; j < 8; ++j) w[j] = z[ZP(n0 + 8 * h2 + j)];
              oa[h2] = (v4u){cvt_pk_bf16(w[0].x * sc, w[1].x * sc), cvt_pk_bf16(w[2].x * sc, w[3].x * sc), cvt_pk_bf16(w[4].x * sc, w[5].x * sc), cvt_pk_bf16(w[6].x * sc, w[7].x * sc)};
              oa[SEQ / 8 + h2] = (v4u){cvt_pk_bf16(w[0].y * sc, w[1].y * sc), cvt_pk_bf16(w[2].y * sc, w[3].y * sc), cvt_pk_bf16(w[4].y * sc, w[5].y * sc), cvt_pk_bf16(w[6].y * sc, w[7].y * sc)}; } }
    }
    __syncthreads();
#undef HC_LOADIN
}
constexpr int MW_CUMBLK = 16, MW_CNT = 64, MW_SELE = 128, MW_SELV = 256, MW_LRANK = 384, MW_LBASE = 512;
__device__ __forceinline__ void moe_tables(Frame& F, int layer) {
    __syncthreads();
    if (F.tid < NE) F.MISC[MW_CNT + F.tid] = __hip_atomic_load(F.ctl + CW_CNT + layer * NE + F.tid, RLX_AGENT);
    __syncthreads();
    if (F.tid < 64) {
        const unsigned v = F.tid < NE ? (F.MISC[MW_CNT + (F.tid & 31)] + 255u) >> 8 : 0u; unsigned s = v;
#pragma unroll
        for (int d = 1; d < 32; d <<= 1) { const unsigned t = (unsigned)__builtin_amdgcn_ds_bpermute(((F.tid - d) & 63) * 4, (int)s); if ((F.tid & 63) >= d) s += t; }
        if (F.tid < NE) F.MISC[MW_CUMBLK + F.tid] = s - v;
        if (F.tid == NE - 1) F.MISC[MW_CUMBLK + NE] = s; }
    __syncthreads();
}

template <int MODE> __device__ __forceinline__ void rowpass(Frame& F, int layer, bool real = true, bool h8 = false) {
    const bool combine = (MODE == 0 && layer > 0) || MODE == 2;
    const int nrows = MODE == 2 ? ML : MT;
    const int cl = MODE == 2 ? NLAYER - 1 : layer - 1;
    const bool from_input = (MODE == 0 && layer == 0);
    const float* XLs = PIN(F, I_X); const float* XCs = PIN(F, I_CTX);
    bf16* XB = (bf16*)(F.ws + WS_XB); bf16* XBd = real ? XB : (bf16*)(F.ws + WS_P);
    const float* MOD = (const float*)(F.ws + WS_MOD);
    bf16* H = (bf16*)(F.ws + WS_H); unsigned char* H8 = (unsigned char*)(F.ws + WS_H8); const unsigned char* YM = (const unsigned char*)(F.ws + WS_YM);
    const int* TE = (const int*)(F.ws + WS_TE); const int* TR = (const int*)(F.ws + WS_TR); const float* TG = (const float*)(F.ws + WS_TG);
    const float* gnorm = MODE == 0 ? PIN(F, I_N1G) + layer * D : PIN(F, I_FG);
    if (combine) moe_tables(F, cl);
    f32x4 gn[4];
#pragma unroll
    for (int j = 0; j < 4; ++j) gn[j] = ((const f32x4*)gnorm)[F.lane + 64 * j];
    const int ntiles = nrows / 32;
    i32x4 nte[4], ntr[4]; f32x4 ntg[4];
#define RP_TABLES(tile_) do { const size_t rb_ = (size_t)((tile_) * 32 + F.wave * 4) * 4; \
        _Pragma("unroll") for (int q = 0; q < 4; ++q) { nte[q] = *(const i32x4*)(TE + rb_ + 4 * q); ntr[q] = *(const i32x4*)(TR + rb_ + 4 * q); ntg[q] = *(const f32x4*)(TG + rb_ + 4 * q); } } while (0)
    if (combine && F.bx < ntiles) RP_TABLES(F.bx);
    for (int tile = F.bx; tile < ntiles; tile += F.G) {
        const int rbase = tile * 32 + F.wave * 4; const bool lat = rbase < ML; const int bidx = lat ? (rbase >> 13) : 8;
        const float* g2 = MOD + ((size_t)(combine ? cl : 0) * 9 + bidx) * 6144 + 5 * 1024;
        const float* mb = MOD + ((size_t)layer * 9 + bidx) * 6144;
        int rid[4][4]; float gkk[4][4];
        if (combine) {
#pragma unroll
            for (int q = 0; q < 4; ++q)
#pragma unroll
                for (int k = 0; k < 4; ++k) { rid[q][k] = 256 * (int)F.MISC[MW_CUMBLK + nte[q][k]] + ntr[q][k]; gkk[q][k] = ntg[q][k]; }
            if (tile + F.G < ntiles) RP_TABLES(tile + F.G);
        }
#pragma unroll 1
        for (int pr = 0; pr < 2; ++pr) {
            size_t xo[2]; f32x4 v[2][4]; int rowid[2][4]; float gk[2][4];
#pragma unroll
            for (int u = 0; u < 2; ++u) { const int r = rbase + 2 * pr + u; xo[u] = (size_t)r * D;
                if (combine) {
#pragma unroll
                    for (int k = 0; k < 4; ++k) { rowid[u][k] = pr ? rid[2 + u][k] : rid[u][k]; gk[u][k] = pr ? gkk[2 + u][k] : gkk[u][k]; } }
                if (from_input) { const f32x4* xs = (const f32x4*)(lat ? XLs + xo[u] : XCs + (xo[u] - (size_t)ML * D));
#pragma unroll
                    for (int j = 0; j < 4; ++j) v[u][j] = xs[F.lane + 64 * j]; }
                else { const v2u* xs = (const v2u*)(XB + xo[u]);
#pragma unroll
                    for (int j = 0; j < 4; ++j) v[u][j] = bf4_f32(xs[F.lane + 64 * j]); } }
            if (combine) {
                unsigned w[2][4][4];
#pragma unroll
                for (int u = 0; u < 2; ++u)
#pragma unroll
                    for (int k = 0; k < 4; ++k) { const unsigned* yr = (const unsigned*)(YM + (size_t)rowid[u][k] * D);
#pragma unroll
                        for (int j = 0; j < 4; ++j) w[u][k][j] = yr[F.lane + 64 * j]; }
#pragma unroll
                for (int u = 0; u < 2; ++u) {
#pragma unroll
                    for (int j = 0; j < 4; ++j) { f32x4 a = (f32x4){0.f, 0.f, 0.f, 0.f};
#pragma unroll
                        for (int k = 0; k < 4; ++k) { const f32x2 lo = __builtin_amdgcn_cvt_pk_f32_fp8(w[u][k][j], false), hi2 = __builtin_amdgcn_cvt_pk_f32_fp8(w[u][k][j], true); a += gk[u][k] * (f32x4){lo.x, lo.y, hi2.x, hi2.y}; }
                        v[u][j] += ((const f32x4*)g2)[F.lane + 64 * j] * a; }
                    if (MODE == 0) { v2u* xd = (v2u*)(XBd + xo[u]);
#pragma unroll
                        for (int j = 0; j < 4; ++j) { v2u o; o.x = cvt_pk_bf16(v[u][j].x, v[u][j].y); o.y = cvt_pk_bf16(v[u][j].z, v[u][j].w); xd[F.lane + 64 * j] = o; } } }
            }
            if (from_input) {
#pragma unroll
                for (int u = 0; u < 2; ++u) { v2u* xd = (v2u*)(XBd + xo[u]);
#pragma unroll
                    for (int j = 0; j < 4; ++j) { v2u o; o.x = cvt_pk_bf16(v[u][j].x, v[u][j].y); o.y = cvt_pk_bf16(v[u][j].z, v[u][j].w); xd[F.lane + 64 * j] = o; } } }
#pragma unroll
            for (int u = 0; u < 2; ++u) { const int r = rbase + 2 * pr + u;
                float ss = 0.f;
#pragma unroll
                for (int j = 0; j < 4; ++j) ss += (v[u][j].x * v[u][j].x + v[u][j].y * v[u][j].y) + (v[u][j].z * v[u][j].z + v[u][j].w * v[u][j].w);
                const float rstd = 1.0f / sqrtf(wave_sum(ss, F.lane) * (1.0f / D) + EPS);
                if (MODE == 2) { f32x4* od = (f32x4*)((real ? F.out : (float*)(F.ws + WS_P)) + xo[u]);
#pragma unroll
                    for (int j = 0; j < 4; ++j) od[F.lane + 64 * j] = v[u][j] * rstd * gn[j]; }
                else { v2u* hd = (v2u*)(H + (size_t)r * D); unsigned* hd8 = (unsigned*)(H8 + (size_t)r * D);
#pragma unroll
                    for (int j = 0; j < 4; ++j) { const f32x4 sh = ((const f32x4*)mb)[F.lane + 64 * j], sc = ((const f32x4*)(mb + 1024))[F.lane + 64 * j]; const f32x4 hv = v[u][j] * rstd * gn[j] * (sc + 1.0f) + sh;
                        if (h8) { unsigned o = 0; o = __builtin_amdgcn_cvt_pk_fp8_f32(hv.x, hv.y, o, false); o = __builtin_amdgcn_cvt_pk_fp8_f32(hv.z, hv.w, o, true); hd8[F.lane + 64 * j] = o; }
                        else { v2u o; o.x = cvt_pk_bf16(hv.x, hv.y); o.y = cvt_pk_bf16(hv.z, hv.w); hd[F.lane + 64 * j] = o; } } }
            }
        }
    }
}

typedef float f32x16r __attribute__((ext_vector_type(16)));
__device__ __forceinline__ void router_phase(Frame& F, int layer, bool real = true, int xp = 0) {
    const bool last = layer == NLAYER - 1;
    const int ntiles = (last ? ML : MT) / 32;
    LAS float* PART = (LAS float*)F.lds;
    LAS float* SSQ = PART + 8 * 32 * 33;
    LAS float* LG = SSQ + 8 * 32;
    LAS float* RSTD = LG + 32 * 33;
    LAS unsigned* CW = (LAS unsigned*)(RSTD + 32);
    LAS unsigned* RUN = CW + 64;
    LAS float* AV = (LAS float*)(RUN + 32);
    LAS float* SHV = AV + 1024;
    LAS float* RCV = SHV + 1024;
    LAS int* TRL = (LAS int*)((LAS unsigned char*)(RCV + 32) + 8 * (32 * 272));
    LAS bf16* STG = (LAS bf16*)((LAS unsigned char*)(RCV + 32) + F.wave * (32 * 272));
    const bf16* XB = (const bf16*)(F.ws + WS_XB);
    const float* MOD = (const float*)(F.ws + WS_MOD); const float* RC = (const float*)(F.ws + WS_RC);
    unsigned char* H8 = (unsigned char*)(F.ws + WS_H8);
    int* TE = (int*)(F.ws + WS_TE); int* TR = (int*)(F.ws + WS_TR); float* TG = (float*)(F.ws + WS_TG); int* ROWTOK = (int*)(F.ws + WS_ROWTOK);
    const float* gn = PIN(F, I_N2G) + layer * D; const float* rw = PIN(F, I_RW) + (size_t)layer * D * NE;
    const int i = F.lane & 31, hf = F.lane >> 5, lr = F.lane >> 4, lc = F.lane & 15, kw = F.wave * 128;
    const int per = 2048 / F.G;
    const int nmine = (2048 % F.G == 0) ? per + ((2048 + F.bx < ntiles) ? 1 : 0) : 0;
#define RT_TILE(n_) ((2048 % F.G == 0) ? ((n_) < per ? F.bx * per + (n_) : 2048 + F.bx) : F.bx + (n_) * F.G)
    const int ncnt = (2048 % F.G == 0) ? nmine : (F.bx < ntiles ? (ntiles - 1 - F.bx) / F.G + 1 : 0);
    __syncthreads();
    if (F.tid < NE) RUN[F.tid] = 0u;
    bf16x8 bw[8][2];
    v2u rawp[16];
#define RT_LOADX(tile_) do { const int rb_ = (tile_) * 32 + lr; const bf16* xb_ = XB + (size_t)rb_ * D + kw + 4 * lc; \
        _Pragma("unroll") for (int q = 0; q < 16; ++q) rawp[q] = *(const v2u*)(xb_ + (size_t)(4 * (q & 7)) * D + 64 * (q >> 3)); } while (0)
    if (ncnt > 0) RT_LOADX(RT_TILE(0));
    int cur_b = -1;
    for (int n = 0; n < ncnt; ++n) {
        const int tile = RT_TILE(n);
        const int r0 = tile * 32; const bool lat = r0 < ML; const int bidx = lat ? (r0 >> 13) : 8; const int r = r0 + i;
        if (bidx != cur_b) {
            cur_b = bidx; const float* mb = MOD + ((size_t)layer * 9 + bidx) * 6144 + 3 * 1024;
            __syncthreads();
            for (int k = F.tid; k < 1024; k += NTHREADS) { AV[k] = gn[k] * (1.0f + mb[1024 + k]); SHV[k] = mb[k]; }
            if (F.tid < NE) RCV[F.tid] = RC[((size_t)layer * 9 + bidx) * NE + F.tid];
            __syncthreads();
            { const v4u* src = (const v4u*)(F.ws + WS_RW3 + ((size_t)(layer * 9 + bidx) * 8 + F.wave) * 8 * 3 * 1024) + F.lane;
#pragma unroll
              for (int kb = 0; kb < 8; ++kb)
#pragma unroll
                  for (int t = 0; t < 2; ++t) bw[kb][t] = __builtin_bit_cast(bf16x8, src[(kb * 3 + t) * 64]); }
        }
        { float s8[8];
#pragma unroll
          for (int q = 0; q < 8; ++q) { const f32x4 a = bf4_f32(rawp[q]), b = bf4_f32(rawp[q + 8]); s8[q] = ((a.x * a.x + a.y * a.y) + (a.z * a.z + a.w * a.w)) + ((b.x * b.x + b.y * b.y) + (b.z * b.z + b.w * b.w)); }
#pragma unroll
          for (int q = 0; q < 8; ++q) { float v = s8[q]; v += shx(v, 1, F.lane); v += shx(v, 2, F.lane); v += shx(v, 4, F.lane); v += shx(v, 8, F.lane); if (lc == 0) SSQ[F.wave * 32 + 4 * q + lr] = v; } }
        __syncthreads();
        const f32x4 av0 = ((const LAS f32x4*)(AV + kw))[lc], av1 = ((const LAS f32x4*)(AV + kw))[lc + 16];
        { const f32x4 sh0 = ((const LAS f32x4*)(SHV + kw))[lc], sh1 = ((const LAS f32x4*)(SHV + kw))[lc + 16];
          unsigned char* hb = H8 + (size_t)(r0 + lr) * D + kw + 4 * lc;
#pragma unroll
          for (int q = 0; q < 8; ++q) { float qs = 0.f;
#pragma unroll
              for (int w = 0; w < 8; ++w) qs += SSQ[w * 32 + 4 * q + lr];
              const float rs = 1.0f / sqrtf(qs * (1.0f / D) + EPS);
#pragma unroll
              for (int hq = 0; hq < 2; ++hq) { const f32x4 h = bf4_f32(rawp[q + 8 * hq]) * (rs * (hq ? av1 : av0)) + (hq ? sh1 : sh0); unsigned w = 0;
                  w = __builtin_amdgcn_cvt_pk_fp8_f32(h.x, h.y, w, false); w = __builtin_amdgcn_cvt_pk_fp8_f32(h.z, h.w, w, true);
                  *(unsigned*)(hb + (size_t)(4 * q) * D + 64 * hq) = w; } } }
        f32x16r acc = {};
        asm volatile("s_waitcnt lgkmcnt(0)" ::: "memory");
#pragma unroll
        for (int q = 0; q < 16; ++q) *(LAS v2u*)(STG + (4 * (q & 7) + lr) * 136 + 4 * lc + 64 * (q >> 3)) = rawp[q];
        asm volatile("s_waitcnt lgkmcnt(0)" ::: "memory");
        if (n + 1 < ncnt) RT_LOADX(RT_TILE(n + 1));
#pragma unroll
        for (int kb = 0; kb < 8; ++kb) { const bf16x8 a = *(const LAS bf16x8*)(STG + i * 136 + 16 * kb + 8 * hf);
#pragma unroll
            for (int t = 0; t < 2; ++t) acc = __builtin_amdgcn_mfma_f32_32x32x16_bf16(a, bw[kb][t], acc, 0, 0, 0); }
#pragma unroll
        for (int rg = 0; rg < 16; ++rg) PART[(F.wave * 32 + ((rg & 3) + 8 * (rg >> 2) + 4 * hf)) * 33 + i] = acc[rg];
        __syncthreads();
        { const int tk = F.tid >> 4, e0 = (F.tid & 15) * 2; float q = 0.f, s0 = 0.f, s1 = 0.f;
#pragma unroll
          for (int w = 0; w < 8; ++w) { q += SSQ[w * 32 + tk]; s0 += PART[(w * 32 + tk) * 33 + e0]; s1 += PART[(w * 32 + tk) * 33 + e0 + 1]; }
          const float rstd = 1.0f / sqrtf(q * (1.0f / D) + EPS);
          LG[tk * 33 + e0] = rstd * s0 + RCV[e0]; LG[tk * 33 + e0 + 1] = rstd * s1 + RCV[e0 + 1]; }
        asm volatile("s_waitcnt lgkmcnt(0)" ::: "memory");
        { const int tk = F.tid >> 4, e0 = (F.tid & 15) * 2; const LAS float* lg = LG + tk * 33; const float l0 = lg[e0], l1 = lg[e0 + 1]; int rk0 = 0, rk1 = 0;
#pragma unroll 8
          for (int j = 0; j < NE; ++j) { const float o = lg[j]; rk0 += (o > l0 || (o == l0 && j < e0)) ? 1 : 0; rk1 += (o > l1 || (o == l1 && j < e0 + 1)) ? 1 : 0; }
          if (rk0 < 4) { F.MISC[MW_SELE + tk * 4 + rk0] = (unsigned)e0; F.MISC[MW_SELV + tk * 4 + rk0] = __float_as_uint(l0); }
          if (rk1 < 4) { F.MISC[MW_SELE + tk * 4 + rk1] = (unsigned)(e0 + 1); F.MISC[MW_SELV + tk * 4 + rk1] = __float_as_uint(l1); } }
        __syncthreads();
        int my = 0, lrk = 0;
        if (F.wave < 2) { const int a = F.tid; my = (int)F.MISC[MW_SELE + a];
            { const float vk = __uint_as_float(F.MISC[MW_SELV + a]), v0 = __uint_as_float(F.MISC[MW_SELV + (a & ~3)]);
              const float ex = __expf(vk - v0); float sm = ex; sm += shx(sm, 1, F.lane); sm += shx(sm, 2, F.lane);
              const size_t idx = ((size_t)r0 + (a >> 2)) * 4 + (a & 3); TG[idx] = ex / sm; TE[idx] = my; }
            unsigned cm = 0;
#pragma unroll 2
            for (int e = 0; e < NE; ++e) { const unsigned long long m = __ballot(my == e); const unsigned pc = (unsigned)__popcll(m);
                if (my == e) lrk = (int)__builtin_amdgcn_mbcnt_hi((unsigned)(m >> 32), __builtin_amdgcn_mbcnt_lo((unsigned)m, 0u)); if (F.lane == e) cm = pc; }
            if (F.lane < NE) CW[F.wave * 32 + F.lane] = cm; }
        __syncthreads();
        if (F.wave < 2) { const int a = F.tid; const int brank = (int)RUN[my] + lrk + (F.wave == 1 ? (int)CW[my] : 0); TRL[n * 128 + a] = (my << 16) | brank; }
        __syncthreads();
        if (F.tid < NE) RUN[F.tid] += CW[F.tid] + CW[32 + F.tid];
    }
    VM_WAIT(); __syncthreads();
    if (F.tid < NE) { const unsigned cnt = RUN[F.tid]; unsigned base = 0;
        if (cnt) base = __hip_atomic_fetch_add(F.ctl + CW_CNT + (real ? layer : NLAYER) * NE + F.tid, cnt, RLX_AGENT);
        F.MISC[MW_LBASE + F.tid] = base; }
    __syncthreads();
    if (real) for (int n = F.tid >> 7; n < ncnt; n += 4) { const int r0 = RT_TILE(n) * 32, a = F.tid & 127;
        const int v = TRL[n * 128 + a], e = v >> 16, rank = (v & 0xffff) + (int)F.MISC[MW_LBASE + e]; const size_t idx = ((size_t)r0 + (a >> 2)) * 4 + (a & 3);
        TR[idx] = rank; ROWTOK[(size_t)e * MT + rank] = r0 + (a >> 2); }
    __syncthreads();
#undef RT_LOADX
#undef RT_TILE
}

__device__ __forceinline__ void normrope16(float (&x)[16], const float* gain, bool lat, int prow, int pcol, const LAS f32x2* T, int L, float oscale, int lane) {
    float ss = 0.f;
#pragma unroll
    for (int i = 0; i < 16; ++i) ss += x[i] * x[i];
    ss += shx(ss, 1, lane); ss += shx(ss, 2, lane); ss += shx(ss, 4, lane);
    const float rstd = 1.0f / sqrtf(ss * (1.0f / 128.0f) + EPS);
    const int o = (L & 7) * 16;
#pragma unroll
    for (int i = 0; i < 16; ++i) x[i] = x[i] * rstd * gain[o + i];
    float p[16];
#pragma unroll
    for (int i = 0; i < 16; ++i) p[i] = shx(x[i], 2, lane);
    if (lat) {
        const int pos = (L & 4) ? pcol : prow; const float sgn = (L & 2) ? 1.0f : -1.0f; const LAS f32x2* t = T + pos * 32 + (L & 1) * 16;
#pragma unroll
        for (int i = 0; i < 16; ++i) { const f32x2 cs = t[i]; x[i] = x[i] * cs.x + sgn * p[i] * cs.y; }
    }
#pragma unroll
    for (int i = 0; i < 16; ++i) x[i] *= oscale;
}
__device__ __forceinline__ void qkprep_phase(Frame& F, int j) {
    LAS f32x2* T = (LAS f32x2*)F.lds;
    __syncthreads();
    for (int i = F.tid; i < 128 * 32; i += NTHREADS) { const int pos = i >> 5, f = i & 31; const float inv = powf(10000.0f, -(float)f / 32.0f); const float ang = (float)pos * inv; float s, c; sincosf(ang, &s, &c); T[i] = (f32x2){c, s}; }
    __syncthreads();
    const bf16* P = (const bf16*)(F.ws + WS_P); unsigned char* Q8 = (unsigned char*)(F.ws + WS_QB); unsigned char* K8 = (unsigned char*)(F.ws + WS_QB + WS_K8_OFF); unsigned char* VT8 = (unsigned char*)(F.ws + WS_KVB);
    const float* qg = PIN(F, I_AQG) + j * 128; const float* kg = PIN(F, I_AKG) + j * 128;
    if (F.bx == 0 && F.tid == 0) { float qm = 0.f, km = 0.f; for (int i = 0; i < 128; ++i) { qm = fmaxf(qm, fabsf(qg[i])); km = fmaxf(km, fabsf(kg[i])); }
        const float sig = att::SCALE * 1.4426950408889634f * 11.3137085f * qm * km;
        ((float*)(F.ws + WS_RC))[2048 + j] = -fminf(-2.0f, 8.0f - 7.0f * sig); }
    const int gw = F.bx * NWAVES + F.wave, NGW = F.G * NWAVES, L = F.lane;
#define QK_UNPACK(x, a, c) do { x[0] = bflo(a.x); x[1] = bfhi(a.x); x[2] = bflo(a.y); x[3] = bfhi(a.y); x[4] = bflo(a.z); x[5] = bfhi(a.z); x[6] = bflo(a.w); x[7] = bfhi(a.w); \
        x[8] = bflo(c.x); x[9] = bfhi(c.x); x[10] = bflo(c.y); x[11] = bfhi(c.y); x[12] = bflo(c.z); x[13] = bfhi(c.z); x[14] = bflo(c.w); x[15] = bfhi(c.w); } while (0)
#define QK_PACK(o, x) do { _Pragma("unroll") for (int w4 = 0; w4 < 4; ++w4) { unsigned w = 0; w = __builtin_amdgcn_cvt_pk_fp8_f32(x[4 * w4], x[4 * w4 + 1], w, false); w = __builtin_amdgcn_cvt_pk_fp8_f32(x[4 * w4 + 2], x[4 * w4 + 3], w, true); o[w4] = w; } } while (0)
    const float qscale = att::SCALE * 1.4426950408889634f * 8.0f;
    int rfirst = gw;
    if (F.G * NWAVES * 32 == ML) {
        v4u nq[4][2], nk[2];
#define QK4_LOAD(it_) do { _Pragma("unroll") for (int k = 0; k < 4; ++k) { const bf16* pr_ = P + (size_t)(gw + (4 * (it_) + k) * NGW) * 1536 + 16 * L; nq[k][0] = *(const v4u*)pr_; nq[k][1] = *(const v4u*)(pr_ + 8); } \
        { const bf16* pk_ = P + (size_t)(gw + (4 * (it_) + (L >> 4)) * NGW) * 1536 + 1024 + 16 * (L & 15); nk[0] = *(const v4u*)pk_; nk[1] = *(const v4u*)(pk_ + 8); } } while (0)
        QK4_LOAD(0);
#pragma unroll 1
        for (int it = 0; it < 8; ++it) {
            v4u q[4][2], kk[2];
#pragma unroll
            for (int k = 0; k < 4; ++k) { q[k][0] = nq[k][0]; q[k][1] = nq[k][1]; }
            kk[0] = nk[0]; kk[1] = nk[1];
            if (it + 1 < 8) QK4_LOAD(it + 1);
#pragma unroll
            for (int k = 0; k < 4; ++k) { const int r = gw + (4 * it + k) * NGW, s = r & (SEQ - 1); float x[16];
                QK_UNPACK(x, q[k][0], q[k][1]);
                normrope16(x, qg, true, s >> 6, s & 63, T, L, qscale, L);
                v4u o; QK_PACK(o, x); *(v4u*)(Q8 + (size_t)r * D + 16 * L) = o; }
            { const int r = gw + (4 * it + (L >> 4)) * NGW, s = r & (SEQ - 1), Lk = L & 15; float x[16];
              QK_UNPACK(x, kk[0], kk[1]);
              normrope16(x, kg, true, s >> 6, s & 63, T, Lk, 1.0f, L);
              v4u o; QK_PACK(o, x); *(v4u*)(K8 + ((size_t)(r >> 13) * SKV + s) * 256 + 16 * Lk) = o; }
        }
#undef QK4_LOAD
        rfirst = gw + 32 * NGW;
    }
    v4u nqa, nqc, nka, nkc;
#define QK_LOAD(r_) do { const bf16* pr_ = P + (size_t)(r_) * 1536; nqa = *(const v4u*)(pr_ + 16 * L); nqc = *(const v4u*)(pr_ + 16 * L + 8); nka = *(const v4u*)(pr_ + 1024 + 16 * (L & 15)); nkc = *(const v4u*)(pr_ + 1024 + 16 * (L & 15) + 8); } while (0)
    if (rfirst < MT) QK_LOAD(rfirst);
    for (int r = rfirst; r < MT; r += NGW) {
        const v4u qa_ = nqa, qc_ = nqc, ka_ = nka, kc_ = nkc;
        if (r + NGW < MT) QK_LOAD(r + NGW);
        const bool lat = r < ML; const int b = lat ? (r >> 13) : ((r - ML) >> 8); const int s = lat ? (r & (SEQ - 1)) : ((r - ML) & (CL - 1));
        const int prow = s >> 6, pcol = s & 63; const size_t kvrow = (size_t)b * SKV + (lat ? s : SEQ + s);
        { float x[16]; QK_UNPACK(x, qa_, qc_);
          normrope16(x, qg, lat, prow, pcol, T, L, qscale, L);
          v4u o; QK_PACK(o, x); *(v4u*)(Q8 + (size_t)r * D + 16 * L) = o; }
        { const int Lk = L & 15; float x[16]; QK_UNPACK(x, ka_, kc_);
          normrope16(x, kg, lat, prow, pcol, T, Lk, 1.0f, L);
          if (L < 16) { v4u o; QK_PACK(o, x); *(v4u*)(K8 + kvrow * 256 + 16 * L) = o; } }
    }
#undef QK_LOAD
#undef QK_UNPACK
#undef QK_PACK
    LAS unsigned char* Tt = F.lds + 32768;
    v4u nv[4];
#define VT_LOAD(tile_) do { const int b_ = (tile_) / (SKV / 64), kb_ = (tile_) % (SKV / 64), pos_ = kb_ * 64 + (F.tid >> 3); \
        const size_t r_ = pos_ < SEQ ? (size_t)b_ * SEQ + pos_ : (size_t)ML + (size_t)b_ * CL + (pos_ - SEQ); const v4u* src_ = (const v4u*)(P + r_ * 1536 + 1280 + 32 * (F.tid & 7)); \
        _Pragma("unroll") for (int q = 0; q < 4; ++q) nv[q] = src_[q]; } while (0)
    if (F.bx < NB * (SKV / 64)) VT_LOAD(F.bx);
    for (int tile = F.bx; tile < NB * (SKV / 64); tile += F.G) {
        const int b = tile / (SKV / 64), kb = tile % (SKV / 64), ki = F.tid >> 3, seg = F.tid & 7;
        const int k5 = ki & 31, slot = 32 * ((k5 >> 2) & 1) + ((k5 & 3) | ((k5 >> 3) << 2)) + (ki >= 32 ? 16 : 0);
        v4u cv[4];
#pragma unroll
        for (int q = 0; q < 4; ++q) cv[q] = nv[q];
        if (tile + F.G < NB * (SKV / 64)) VT_LOAD(tile + F.G);
        __syncthreads();
#pragma unroll
        for (int q = 0; q < 4; ++q) { const v4u w = cv[q]; const unsigned ww[4] = {w.x, w.y, w.z, w.w};
#pragma unroll
            for (int e2 = 0; e2 < 4; ++e2) { const unsigned pk = __builtin_amdgcn_cvt_pk_fp8_f32(bflo(ww[e2]), bfhi(ww[e2]), 0u, false); const int dd = 32 * seg + 8 * q + 2 * e2;
                Tt[dd * 64 + slot] = (unsigned char)(pk & 0xff); Tt[(dd + 1) * 64 + slot] = (unsigned char)((pk >> 8) & 0xff); } }
        __syncthreads();
        { const int rho = F.tid >> 1, half = F.tid & 1; const v4u a = *(const LAS v4u*)(Tt + rho * 64 + 32 * half), c = *(const LAS v4u*)(Tt + rho * 64 + 32 * half + 16);
          unsigned char* dst = VT8 + ((size_t)(b * 2 + (rho >> 7)) * 128 + (rho & 127)) * SKV + kb * 64 + 32 * half;
          *(v4u*)dst = a; *(v4u*)(dst + 16) = c; }
    }
#undef VT_LOAD
    __syncthreads();
}
template <int XV = 0>
__device__ __forceinline__ void attention_phase(Frame& F, char* lds_generic, bool ctx_queries, int j) {
    const float nb = -((const float*)(F.ws + WS_RC))[2048 + j] - 8.0f;
    const unsigned char* Q8 = (const unsigned char*)(F.ws + WS_QB); const unsigned char* K8 = (const unsigned char*)(F.ws + WS_QB + WS_K8_OFF); const unsigned char* VT8 = (const unsigned char*)(F.ws + WS_KVB); bf16* Y = (bf16*)(F.ws + WS_Y);
    const int nunits = 2048 + (ctx_queries ? 64 : 0);
    for (int u = F.bx; u < nunits; u += F.G) {
        if (u < 2048) { const int b = u >> 8, w = u & 255, h = w & 7, qb = w >> 3; const size_t qo = ((size_t)b * SEQ + (size_t)qb * 256) * D + h * 128;
            att::attn_dense_body<XV>(Q8 + qo, K8 + (size_t)b * SKV * 256 + (h >> 2) * 128, VT8 + (size_t)(b * 2 + (h >> 2)) * 128 * SKV, SKV, Y + qo, SKV, lds_generic, F.wave, nb); }
        else { const int w = u - 2048, b = w >> 3, h = w & 7; const size_t qo = ((size_t)ML + (size_t)b * CL) * D + h * 128;
            att::attn_dense_body<XV>(Q8 + qo, K8 + ((size_t)b * SKV + SEQ) * 256 + (h >> 2) * 128, VT8 + (size_t)(b * 2 + (h >> 2)) * 128 * SKV + SEQ, SKV, Y + qo, CL, lds_generic, F.wave, nb); }
    }
}

__device__ __forceinline__ void gmlp_mix_phase(Frame& F) {
    constexpr int LDA = 136, LDO = 132;
    LAS bf16* As = (LAS bf16*)F.lds;
    LAS bf16* Vt = (LAS bf16*)(F.lds + 128 * LDA * 2);
    LAS float* rs = (LAS float*)(F.lds + 2 * 128 * LDA * 2);
    LAS float* Ot = (LAS float*)(F.lds + 2 * 128 * LDA * 2 + 512);
    const bf16* P = (const bf16*)(F.ws + WS_P); bf16* Y = (bf16*)(F.ws + WS_Y); const float* SS = (const float*)(F.ws + WS_SS);
    const float* ws = PIN(F, I_GWS); const float* bs = PIN(F, I_GBS); const float* vg = PIN(F, I_GVG);
    const int r32 = F.lane & 31, hi = F.lane >> 5;
    constexpr int NU = (MT / 128) * 8;
    struct GIn { f32x4 s; v4u v[4], uu[4]; } ga, gb; int gcur = -1;
#define GM_LOAD(u_, IN) do { const int g_ = (u_) & 7; const size_t row0_ = (size_t)((u_) >> 3) * 128; \
        IN.s = *(const f32x4*)(SS + (row0_ + (F.tid >> 2)) * 16 + (F.tid & 3) * 4);                                       \
        _Pragma("unroll") for (int k = 0; k < 4; ++k) { const int i_ = F.tid + NTHREADS * k, q_ = i_ >> 4, c8_ = (i_ & 15) * 8; const bf16* pp_ = P + (row0_ + q_) * 2048 + g_ * 128 + c8_; \
            IN.v[k] = *(const v4u*)(pp_ + 1024); IN.uu[k] = *(const v4u*)pp_; } } while (0)
#define GM_UNIT(u_, IN) do { \
        const int chunk = (u_) >> 3, g = (u_) & 7; const size_t row0 = (size_t)chunk * 128; \
        __syncthreads(); \
        if (g != gcur) { gcur = g; \
            for (int i = F.tid; i < 128 * 32; i += NTHREADS) { const int p = i >> 5, q4 = (i & 31) * 4; const f32x4 w = *(const f32x4*)(ws + ((size_t)g * 128 + p) * 128 + q4); \
                v2u o; o.x = pk2(w.x, w.y); o.y = pk2(w.z, w.w); *(LAS v2u*)(As + p * LDA + q4) = o; } } \
        { float s = (IN.s.x + IN.s.y) + (IN.s.z + IN.s.w); s += shx(s, 1, F.lane); s += shx(s, 2, F.lane); if ((F.tid & 3) == 0) rs[F.tid >> 2] = 1.0f / sqrtf(s * (1.0f / 1024.0f) + EPS); } \
        __syncthreads(); \
        _Pragma("unroll") for (int k = 0; k < 4; ++k) { const int i = F.tid + NTHREADS * k, q = i >> 4, c8 = (i & 15) * 8; const float rq = rs[q]; const unsigned ww[4] = {IN.v[k].x, IN.v[k].y, IN.v[k].z, IN.v[k].w}; \
            _Pragma("unroll") for (int e2 = 0; e2 < 4; ++e2) { const unsigned pk = cvt_pk_bf16(bflo(ww[e2]) * rq, bfhi(ww[e2]) * rq); Vt[(c8 + 2 * e2) * LDA + q] = (bf16)(pk & 0xffff); Vt[(c8 + 2 * e2 + 1) * LDA + q] = (bf16)(pk >> 16); } } \
        __syncthreads(); \
        const int p0 = (F.wave >> 1) * 32, cbase = (F.wave & 1) * 64; \
        f32x16 acc0 = {}, acc1 = {}; \
        _Pragma("unroll") for (int ks = 0; ks < 8; ++ks) { const int k0 = ks * 16 + hi * 8; \
            const bf16x8 a = *(const LAS bf16x8*)(As + (p0 + r32) * LDA + k0); \
            const bf16x8 b0 = *(const LAS bf16x8*)(Vt + (cbase + r32) * LDA + k0), b1 = *(const LAS bf16x8*)(Vt + (cbase + 32 + r32) * LDA + k0); \
            acc0 = __builtin_amdgcn_mfma_f32_32x32x16_bf16(a, b0, acc0, 0, 0, 0); acc1 = __builtin_amdgcn_mfma_f32_32x32x16_bf16(a, b1, acc1, 0, 0, 0); } \
        _Pragma("unroll") for (int t = 0; t < 2; ++t) { const int cl = cbase + t * 32 + r32; const float gain = vg[g * 128 + cl]; \
            _Pragma("unroll") for (int reg = 0; reg < 16; ++reg) { const int p = p0 + (reg & 3) + 8 * (reg >> 2) + 4 * hi; Ot[p * LDO + cl] = gain * (t == 0 ? acc0[reg] : acc1[reg]) + bs[g * 128 + p]; } } \
        __syncthreads(); \
        _Pragma("unroll") for (int k = 0; k < 4; ++k) { const int i = F.tid + NTHREADS * k, p = i >> 4, c8 = (i & 15) * 8; const v4u uw = IN.uu[k]; \
            const LAS float* o = Ot + p * LDO + c8; const f32x4 m0 = *(const LAS f32x4*)o, m1 = *(const LAS f32x4*)(o + 4); \
            v4u w; w.x = cvt_pk_bf16(bflo(uw.x) * m0.x, bfhi(uw.x) * m0.y); w.y = cvt_pk_bf16(bflo(uw.y) * m0.z, bfhi(uw.y) * m0.w); \
            w.z = cvt_pk_bf16(bflo(uw.z) * m1.x, bfhi(uw.z) * m1.y); w.w = cvt_pk_bf16(bflo(uw.w) * m1.z, bfhi(uw.w) * m1.w); \
            *(v4u*)(Y + (row0 + p) * D + g * 128 + c8) = w; } } while (0)
    int u = F.bx;
    if (u < NU) GM_LOAD(u, ga);
    for (; u < NU; u += 2 * F.G) {
        if (u + F.G < NU) GM_LOAD(u + F.G, gb);
        GM_UNIT(u, ga);
        if (u + F.G >= NU) break;
        if (u + 2 * F.G < NU) GM_LOAD(u + 2 * F.G, ga);
        GM_UNIT(u + F.G, gb);
    }
    __syncthreads();
#undef GM_LOAD
#undef GM_UNIT
}

__device__ __forceinline__ void hyena_prep_phase(Frame& F) {
    LAS float* tl = (LAS float*)F.lds;
    const bf16* P = (const bf16*)(F.ws + WS_P); bf16* X0 = (bf16*)(F.ws + WS_X0); bf16* VG = (bf16*)(F.ws + WS_VG);
    float* VT = (float*)(F.ws + WS_VT); float* VTC = (float*)(F.ws + WS_VTC);
    const float* cw = PIN(F, I_HCW); const float* cb = PIN(F, I_HCB);
    const int tt = F.tid >> 3, cg = F.tid & 7;
    constexpr int NU = (MT / 64) * 16;
    v4u pa[3][3], pb[3][3];
#define HP_LOAD(u_, IN) do { const int tb_ = (u_) >> 4, c0_ = ((u_) & 15) * 64, r0_ = tb_ * 64; const bool lat_ = r0_ < ML; \
        const int s_ = (lat_ ? (r0_ & (SEQ - 1)) : ((r0_ - ML) & (CL - 1))) + tt, L_ = lat_ ? SEQ : CL; const bf16* pr_ = P + (size_t)(r0_ + tt) * 3072 + c0_ + cg * 8; const v4u z0_ = {0u, 0u, 0u, 0u}; \
        _Pragma("unroll") for (int seg = 0; seg < 3; ++seg) { IN[seg][0] = s_ > 0 ? *(const v4u*)(pr_ + seg * 1024 - 3072) : z0_; IN[seg][1] = *(const v4u*)(pr_ + seg * 1024); \
            IN[seg][2] = s_ < L_ - 1 ? *(const v4u*)(pr_ + seg * 1024 + 3072) : z0_; } } while (0)
    LAS float* wl = tl + 64 * 65; int c0w = -1;
#define HP_UNIT(u_, IN) do { \
        const int tb = (u_) >> 4, c0 = ((u_) & 15) * 64; const int r0 = tb * 64; const bool lat = r0 < ML; \
        const int b = lat ? (r0 >> 13) : ((r0 - ML) >> 8), s0 = lat ? (r0 & (SEQ - 1)) : ((r0 - ML) & (CL - 1)); \
        const int r = r0 + tt, c = c0 + cg * 8; \
        if (c0 != c0w) { c0w = c0; __syncthreads(); \
            for (int i = F.tid; i < 768; i += NTHREADS) { const int seg = i >> 8, k = (i >> 6) & 3, ch = i & 63; wl[i] = k < 3 ? cw[k * 3072 + seg * 1024 + c0 + ch] : cb[seg * 1024 + c0 + ch]; } \
            __syncthreads(); } \
        float o[3][8]; \
        _Pragma("unroll") for (int seg = 0; seg < 3; ++seg) { \
            const unsigned pmw[4] = {IN[seg][0].x, IN[seg][0].y, IN[seg][0].z, IN[seg][0].w}, pcw[4] = {IN[seg][1].x, IN[seg][1].y, IN[seg][1].z, IN[seg][1].w}, pnw[4] = {IN[seg][2].x, IN[seg][2].y, IN[seg][2].z, IN[seg][2].w}; \
            _Pragma("unroll") for (int i = 0; i < 8; ++i) { const float xm = (i & 1) ? bfhi(pmw[i >> 1]) : bflo(pmw[i >> 1]), xc = (i & 1) ? bfhi(pcw[i >> 1]) : bflo(pcw[i >> 1]), xn = (i & 1) ? bfhi(pnw[i >> 1]) : bflo(pnw[i >> 1]); \
                const LAS float* wp = wl + seg * 256 + cg * 8 + i; o[seg][i] = xm * wp[0] + xc * wp[64] + xn * wp[128] + wp[192]; } } \
        float vgv[8]; \
        _Pragma("unroll") for (int i = 0; i < 8; ++i) vgv[i] = o[2][i] * o[1][i]; \
        v4u w; w.x = cvt_pk_bf16(o[0][0], o[0][1]); w.y = cvt_pk_bf16(o[0][2], o[0][3]); w.z = cvt_pk_bf16(o[0][4], o[0][5]); w.w = cvt_pk_bf16(o[0][6], o[0][7]); \
        *(v4u*)(X0 + (size_t)r * D + c) = w; \
        __syncthreads(); \
        _Pragma("unroll") for (int i = 0; i < 8; ++i) tl[(cg * 8 + i) * 65 + tt] = vgv[i]; \
        __syncthreads(); \
        { const int cc = F.tid >> 3, ts = (F.tid & 7) * 8; const LAS float* sp = tl + cc * 65 + ts; \
          if (lat) *(v4u*)((bf16*)VT + ((size_t)b * 1024 + c0 + cc) * SEQ + s0 + ts) = (v4u){cvt_pk_bf16(sp[0], sp[1]), cvt_pk_bf16(sp[2], sp[3]), cvt_pk_bf16(sp[4], sp[5]), cvt_pk_bf16(sp[6], sp[7])};        \
          else { float* dst = VTC + ((size_t)b * 1024 + c0 + cc) * CL + s0 + ts; *(f32x4*)dst = (f32x4){sp[0], sp[1], sp[2], sp[3]}; *(f32x4*)(dst + 4) = (f32x4){sp[4], sp[5], sp[6], sp[7]}; } } } while (0)
    int u = F.bx;
    if (u < NU) HP_LOAD(u, pa);
    for (; u < NU; u += 2 * F.G) {
        if (u + F.G < NU) HP_LOAD(u + F.G, pb);
        HP_UNIT(u, pa);
        if (u + F.G >= NU) break;
        if (u + 2 * F.G < NU) HP_LOAD(u + 2 * F.G, pa);
        HP_UNIT(u + F.G, pb);
    }
    __syncthreads();
#undef HP_LOAD
#undef HP_UNIT
}
__device__ __forceinline__ void hyena_post_phase(Frame& F) {
    LAS float* tl = (LAS float*)F.lds;
    const bf16* X0 = (const bf16*)(F.ws + WS_X0); const bf16* VG = (const bf16*)(F.ws + WS_VG); bf16* Y = (bf16*)(F.ws + WS_Y);
    const float* VT = (const float*)(F.ws + WS_CT); const float* VTC = (const float*)(F.ws + WS_CTC); const float* dsk = PIN(F, I_HD);
    const int tt = F.tid >> 3, cg = F.tid & 7;
    constexpr int NU = (MT / 64) * 16;
    struct PIn { f32x4 a, bq; v4u cw, x0; } qa, qb;
#define HQ_LOAD(u_, IN) do { const int tb_ = (u_) >> 4, c0_ = ((u_) & 15) * 64, r0_ = tb_ * 64; const bool lat_ = r0_ < ML; \
        const int b_ = lat_ ? (r0_ >> 13) : ((r0_ - ML) >> 8), s0_ = lat_ ? (r0_ & (SEQ - 1)) : ((r0_ - ML) & (CL - 1)); const int cc_ = F.tid >> 3, ts_ = (F.tid & 7) * 8; \
        if (lat_) IN.cw = *(const v4u*)((const bf16*)VT + ((size_t)b_ * 1024 + c0_ + cc_) * SEQ + s0_ + ts_);        \
        else { const float* src_ = VTC + ((size_t)b_ * 1024 + c0_ + cc_) * CL + s0_ + ts_; IN.a = *(const f32x4*)src_; IN.bq = *(const f32x4*)(src_ + 4); } \
        IN.x0 = *(const v4u*)(X0 + (size_t)(r0_ + tt) * D + c0_ + cg * 8); } while (0)
#define HQ_UNIT(u_, IN) do { \
        const int tb = (u_) >> 4, c0 = ((u_) & 15) * 64; const int r0 = tb * 64; \
        __syncthreads(); \
        { const int cc = F.tid >> 3, ts = (F.tid & 7) * 8; LAS float* dp = tl + cc * 65 + ts; \
          if (r0 < ML) { dp[0] = bflo(IN.cw.x); dp[1] = bfhi(IN.cw.x); dp[2] = bflo(IN.cw.y); dp[3] = bfhi(IN.cw.y); dp[4] = bflo(IN.cw.z); dp[5] = bfhi(IN.cw.z); dp[6] = bflo(IN.cw.w); dp[7] = bfhi(IN.cw.w); } \
          else { dp[0] = IN.a.x; dp[1] = IN.a.y; dp[2] = IN.a.z; dp[3] = IN.a.w; dp[4] = IN.bq.x; dp[5] = IN.bq.y; dp[6] = IN.bq.z; dp[7] = IN.bq.w; } } \
        __syncthreads(); \
        const int r = r0 + tt, c = c0 + cg * 8; \
        const unsigned x0w[4] = {IN.x0.x, IN.x0.y, IN.x0.z, IN.x0.w}; float y[8]; \
        _Pragma("unroll") for (int i = 0; i < 8; ++i) { const float xx = (i & 1) ? bfhi(x0w[i >> 1]) : bflo(x0w[i >> 1]); y[i] = tl[(cg * 8 + i) * 65 + tt] * xx; }        \
        v4u w; w.x = cvt_pk_bf16(y[0], y[1]); w.y = cvt_pk_bf16(y[2], y[3]); w.z = cvt_pk_bf16(y[4], y[5]); w.w = cvt_pk_bf16(y[6], y[7]); \
        *(v4u*)(Y + (size_t)r * D + c) = w; } while (0)
    int u = F.bx;
    if (u < NU) HQ_LOAD(u, qa);
    for (; u < NU; u += 2 * F.G) {
        if (u + F.G < NU) HQ_LOAD(u + F.G, qb);
        HQ_UNIT(u, qa);
        if (u + F.G >= NU) break;
        if (u + 2 * F.G < NU) HQ_LOAD(u + 2 * F.G, qa);
        HQ_UNIT(u + F.G, qb);
    }
    __syncthreads();
#undef HQ_LOAD
#undef HQ_UNIT
}
__device__ __forceinline__ bool phase_nonempty(int ph) {
    if (ph < PH_L0 || ph >= PH_FINAL) return true;
    const int layer = (ph - PH_L0) / PH_PER_LAYER, lp = (ph - PH_L0) % PH_PER_LAYER, kind = layer % 3;
    if (lp == LP_MIX2) return kind != 1;
    if (lp == LP_MIX3) return kind == 2;
    return true;
}
__global__ void __launch_bounds__(NTHREADS, 2) mk_fwd(Args args) {
    extern __shared__ __attribute__((aligned(16))) unsigned char lds[];
    Frame F0;
    F0.lds = (LAS unsigned char*)lds; F0.MISC = (volatile LAS unsigned*)(F0.lds + MISC_OFF);
    F0.tid = threadIdx.x; F0.lane = F0.tid & 63; F0.wave = __builtin_amdgcn_readfirstlane(F0.tid >> 6);
    F0.G = gridDim.x; F0.bx = blockIdx.x; F0.out = args.out; F0.ws = args.ws; F0.ctl = (gu32*)(args.ws + WS_CTL);
    for (int u = F0.tid; u < MISC_BYTES / 4; u += NTHREADS) F0.MISC[u] = 0u;
    __syncthreads();
    if (F0.tid < 36) { const unsigned long long p = (unsigned long long)args.in[F0.tid]; F0.MISC[MW_PTRS + 2 * F0.tid] = (unsigned)p; F0.MISC[MW_PTRS + 2 * F0.tid + 1] = (unsigned)(p >> 32); }
    __syncthreads();
    const int lo = args.ph_lo, hi = args.ph_hi;
    const bool multi = (hi - lo) > 1;
    XcdBarrier bar; bar.bar = (unsigned*)(F0.ctl + CW_BAR); bar.x = 0; bar.st = nullptr; bar.w = F0.wave;
    if (multi) bar = xcd_barrier_post((unsigned*)(F0.ctl + CW_BAR), F0.MISC + 8, F0.wave);
#ifndef PHMASK
#define PHMASK 0xFFFF
#endif
#define EN(b) ((PHMASK >> (b)) & 1)
#ifndef MK_STAG_IN
#define MK_STAG_IN 0u
#define MK_STAG_OUT 0u
#define MK_STAG_M1 0u
#define MK_STAG_M2 0u
#endif
#ifndef KMASK
#define KMASK 7
#endif
#define KEN(b) ((KMASK >> (b)) & 1)
#define IN(k) (lo <= (k) && (k) < hi)
#define SEAM(k) do { if ((k) + 1 < hi) xcd_barrier(bar); } while (0)
#define PB(id) for (int _rep = 0, _n = ((id) == MK_REPEAT ? MK_NREP : 1); _rep < _n; ++_rep) {
#define PE(id) if (_rep + 1 < _n) xcd_barrier(bar); } SEAM(id);

    if (EN(0) && IN(PH_PRO0)) { PB(PH_PRO0) Frame F = phase_frame(F0); pro0_mod(F); __syncthreads(); pro0_transposes(F); pro0_filter_mlp(F); PE(PH_PRO0) }
    if (EN(1) && IN(PH_PRO1)) { PB(PH_PRO1) Frame F = phase_frame(F0); pro1_router_split(F); pro1_filters(F); PE(PH_PRO1) }

#pragma unroll 1
    for (int layer = 0; layer < NLAYER; ++layer) {
        const int kind = layer % 3, jj = layer / 3, pb = PH_L0 + layer * PH_PER_LAYER; const bool last = layer == NLAYER - 1;
        if (EN(2) && IN(pb + LP_NORM1)) { PB(pb + LP_NORM1) Frame F = phase_frame(F0); rowpass<0>(F, layer, _rep + 1 == _n, kind != 1); PE(pb + LP_NORM1) }
        if (EN(3) && IN(pb + LP_INPROJ)) { PB(pb + LP_INPROJ)
            Frame F = phase_frame(F0);
            if (kind != 1) {
                const int N = kind == 0 ? 1536 : 3072;
                pg8::DenseSchedT<true> S; S.init(F.ws + WS_H8, kind == 0 ? F.ws + WS_WATT + (size_t)jj * 1536 * 1024 : F.ws + WS_WHY, MT, N, F.G, F.bx, 1024);
                pg8::EpiBf16 E{(bf16*)(F.ws + WS_P), N, (float*)(F.ws + WS_SS), 0};
                pg8::gemm_phase<pg8::EpiBf16, pg8::DenseSchedT<true>, true, true>(F.lds, S, E, F.wave, false, MK_STAG_IN);
            } else {
                const int N = 2048;
                pg8::DenseSched S; S.init(F.ws + WS_H, F.ws + WS_WGM, MT, N, F.G, F.bx);
                pg8::EpiBf16 E{(bf16*)(F.ws + WS_P), N, (float*)(F.ws + WS_SS), 1};
                pg8::gemm_phase<pg8::EpiBf16, pg8::DenseSched, false>(F.lds, S, E, F.wave, false, MK_STAG_IN);
            }
            PE(pb + LP_INPROJ)
        }
        if (IN(pb + LP_MIX1)) { PB(pb + LP_MIX1)
            Frame F = phase_frame(F0);
            if (EN(4) && kind == 0) qkprep_phase(F, jj); else if (EN(5) && kind == 1) gmlp_mix_phase(F); else if (EN(6)) hyena_prep_phase(F);
            PE(pb + LP_MIX1)
        }
        if (IN(pb + LP_MIX2) && kind != 1) { PB(pb + LP_MIX2)
            Frame F = phase_frame(F0);
            if (EN(7) && kind == 0) {
#if MK_XP >= 10 && MK_XP < 20
                if (_rep + 1 < _n) attention_phase<MK_XP - 10>(F, (char*)lds, !last, jj); else
#endif
                attention_phase<0>(F, (char*)lds, !last, jj); }
            else if (EN(8)) hyena_conv_phase(F);
            PE(pb + LP_MIX2)
        }
        if (EN(9) && IN(pb + LP_MIX3) && kind == 2) { PB(pb + LP_MIX3) Frame F = phase_frame(F0); hyena_post_phase(F); PE(pb + LP_MIX3) }
        if (EN(10) && IN(pb + LP_OUTPROJ)) { PB(pb + LP_OUTPROJ)
            Frame F = phase_frame(F0); const float* modl = (const float*)(F.ws + WS_MOD) + (size_t)layer * 9 * 6144;
            pg8::DenseSched S; S.init(F.ws + WS_Y, F.ws + WS_WOUT + (size_t)layer * 1024 * 1024 * 2, last ? ML : MT, 1024, F.G, F.bx);
            pg8::EpiResid E{(bf16*)(F.ws + WS_XB), modl};
            pg8::gemm_phase<pg8::EpiResid, pg8::DenseSched, false>(F.lds, S, E, F.wave, false, MK_STAG_OUT);
            PE(pb + LP_OUTPROJ)
        }
        if (EN(11) && IN(pb + LP_NORM2)) { PB(pb + LP_NORM2) Frame F = phase_frame(F0); router_phase(F, layer, _rep + 1 == _n, (_rep + 1 < _n) ? MK_XP : 0); PE(pb + LP_NORM2) }
        if (EN(12) && IN(pb + LP_MOE1)) { PB(pb + LP_MOE1)
            Frame F = phase_frame(F0);
            moe_tables(F, layer);
            pg8::MoeSched S{(const char*)(F.ws + WS_H8), (const char*)(F.ws + WS_WE1) + (size_t)layer * NE * 2048 * 1024, (size_t)2048 * 1024, (const int*)(F.ws + WS_ROWTOK),
                            (const volatile LAS int*)(F.MISC + MW_CUMBLK), (const volatile LAS int*)(F.MISC + MW_CNT), 3, F.G, F.bx, 1024, (const volatile LAS int*)(F.lds + AUX_OFF + 1024)};
            S.build_list((volatile LAS int*)(F.lds + AUX_OFF + 1024), F.tid); __syncthreads();
            pg8::EpiSwiglu E{(unsigned char*)(F.ws + WS_ACT), PIN(F, I_EB1) + (size_t)layer * NE * 2048, (LAS float*)(F.lds + AUX_OFF)};
#if MK_XP >= 20
            if (_rep + 1 < _n) { int one_ = 1; asm volatile("" : "+s"(one_)); pg8::gemm_phase<pg8::EpiSwiglu, pg8::MoeSched, true, true, MK_XP - 20>(F.lds, S, E, F.wave, one_ != 0, MK_STAG_M1); } else
#endif
            pg8::gemm_phase<pg8::EpiSwiglu, pg8::MoeSched, true, true>(F.lds, S, E, F.wave, MK_XP == 1 && _rep + 1 < _n, MK_STAG_M1);
            PE(pb + LP_MOE1)
        }
        if (EN(13) && IN(pb + LP_MOE2)) { PB(pb + LP_MOE2)
            Frame F = phase_frame(F0);
            moe_tables(F, layer);
            pg8::MoeSched S{(const char*)(F.ws + WS_ACT), (const char*)(F.ws + WS_WE2) + (size_t)layer * NE * 1024 * 1024, (size_t)1024 * 1024, nullptr,
                            (const volatile LAS int*)(F.MISC + MW_CUMBLK), (const volatile LAS int*)(F.MISC + MW_CNT), 2, F.G, F.bx, 1024, (const volatile LAS int*)(F.lds + AUX_OFF + 1024)};
            S.build_list((volatile LAS int*)(F.lds + AUX_OFF + 1024), F.tid); __syncthreads();
            pg8::EpiBias E{(unsigned char*)(F.ws + WS_YM), PIN(F, I_EB2) + (size_t)layer * NE * 1024, (LAS float*)(F.lds + AUX_OFF)};
            pg8::gemm_phase<pg8::EpiBias, pg8::MoeSched, true, true>(F.lds, S, E, F.wave, MK_XP == 1 && _rep + 1 < _n, MK_STAG_M2);
            PE(pb + LP_MOE2)
        }
    }
    if (EN(14) && IN(PH_FINAL)) { PB(PH_FINAL) Frame F = phase_frame(F0); rowpass<2>(F, NLAYER - 1, _rep + 1 == _n); PE(PH_FINAL) }
#undef IN
#undef SEAM
}

static bool host_phase_nonempty(int ph) {
    if (ph < PH_L0 || ph >= PH_FINAL) return true;
    const int layer = (ph - PH_L0) / PH_PER_LAYER, lp = (ph - PH_L0) % PH_PER_LAYER, kind = layer % 3;
    if (lp == LP_MIX2) return kind != 1;
    if (lp == LP_MIX3) return kind == 2;
    return true;
}
extern "C" void kernel_launch(void* const* d_in, const int* in_sizes, int n_in, void* d_out, int out_size, void* d_ws, size_t ws_size, hipStream_t stream) {
    static int grid = 0;
    if (grid == 0) {
        if (n_in != 36 || in_sizes[0] != ML * D || out_size != ML * D || ws_size < WS_END) {
            fprintf(stderr, "kernel_launch: built for 36 inputs, x/out of %d floats, >= %zu bytes of workspace; got n_in %d in0 %d out %d ws %zu; nothing launched\n", ML * D, (size_t)WS_END, n_in, n_in > 0 ? in_sizes[0] : -1, out_size, ws_size);
            grid = -1; return; }
        int dev = 0, cus = 0, per_cu = 0;
        if (hipGetDevice(&dev) != hipSuccess || hipDeviceGetAttribute(&cus, hipDeviceAttributeMultiprocessorCount, dev) != hipSuccess) { fprintf(stderr, "kernel_launch: device query failed\n"); grid = -1; return; }
        if (hipFuncSetAttribute((const void*)mk_fwd, hipFuncAttributeMaxDynamicSharedMemorySize, LDS_BYTES) != hipSuccess) { fprintf(stderr, "kernel_launch: hipFuncSetAttribute(%d B LDS) failed\n", LDS_BYTES); grid = -1; return; }
        if (hipOccupancyMaxActiveBlocksPerMultiprocessor(&per_cu, (const void*)mk_fwd, NTHREADS, LDS_BYTES) != hipSuccess || per_cu < 1)
            fprintf(stderr, "kernel_launch: note: occupancy query reports %d workgroups per CU\n", per_cu);
        (void)hipGetLastError();
        grid = cus;
    }
    if (grid < 0) return;
    if (hipMemsetAsync((char*)d_ws + WS_CTL, 0, CTL_ZERO_BYTES, stream) != hipSuccess) { fprintf(stderr, "kernel_launch: memset failed\n"); return; }
    Args a{};
    for (int i = 0; i < 36; ++i) a.in[i] = (const float*)d_in[i];
    a.out = (float*)d_out; a.ws = (unsigned char*)d_ws;
#if MK_MULTI || MK_DBG
    for (int ph = 0; ph < PH_COUNT; ++ph) {
        if (!host_phase_nonempty(ph)) continue;
        a.ph_lo = ph; a.ph_hi = ph + 1;
        hipLaunchKernelGGL(mk_fwd, dim3(grid), dim3(NTHREADS), LDS_BYTES, stream, a);
#if MK_DBG
        dbg_after_phase(ph, a, stream);
#endif
    }
#if MK_DBG
    dbg_report(a, stream);
#endif
#else
    a.ph_lo = 0; a.ph_hi = PH_COUNT;
    hipLaunchKernelGGL(mk_fwd, dim3(grid), dim3(NTHREADS), LDS_BYTES, stream, a);
#endif
    const hipError_t le = hipPeekAtLastError();
    if (le != hipSuccess) fprintf(stderr, "kernel_launch: launch failed: %s\n", hipGetErrorName(le));
}
```

```cpp
#include <hip/hip_runtime.h>
#include <cstdio>
#include <cstdint>
#include <cmath>

#ifndef MK_MULTI
#define MK_MULTI 0
#endif
#ifndef MK_REPEAT
#define MK_REPEAT -1
#endif
#ifndef MK_NREP
#define MK_NREP 1
#endif
#ifndef MK_XP
#define MK_XP 0
#endif
#ifndef MK_MOEMAP
#define MK_MOEMAP 0
#endif
#ifndef MK_DBG
#define MK_DBG 0
#endif

constexpr int D = 1024, NB = 8, SEQ = 8192, CL = 256, ML = NB * SEQ, MC = NB * CL, MT = ML + MC;
constexpr int NLAYER = 4, NE = 32, TOPK = 4, SKV = SEQ + CL;
constexpr int MOE_MAXBLK = (MT * TOPK) / 256 + NE;
constexpr float EPS = 1e-6f;
constexpr int FH = 64, FEMB = 33, NFFT = 16384;

constexpr size_t MiB = 1u << 20;
constexpr size_t WS_CTL = 0, CTL_ZERO_BYTES = 1 * MiB;
constexpr size_t WS_MOD = 1 * MiB;
constexpr size_t WS_A3 = 2 * MiB;
constexpr size_t WS_A3C = 4 * MiB;
constexpr size_t WS_RC = 4 * MiB + 512 * 1024;
constexpr size_t WS_FCT = 5 * MiB;
constexpr size_t WS_WATT = 8 * MiB;
constexpr size_t WS_WGM = 14 * MiB;
constexpr size_t WS_WHY = 18 * MiB;
constexpr size_t WS_WOUT = 24 * MiB;
constexpr size_t WS_RW3 = 32 * MiB;
constexpr size_t WS_TE = 40 * MiB;
constexpr size_t WS_TR = 42 * MiB;
constexpr size_t WS_TG = 44 * MiB;
constexpr size_t WS_SS = 46 * MiB;
constexpr size_t WS_ROWTOK = 52 * MiB;
constexpr size_t WS_KF = 64 * MiB;
constexpr size_t WS_WE1 = 192 * MiB;
constexpr size_t WS_WE2 = 704 * MiB;
constexpr size_t WS_H = 960 * MiB;
constexpr size_t WS_P = 1092 * MiB;
constexpr size_t WS_Y = 1488 * MiB;
constexpr size_t WS_QB = 1620 * MiB;
constexpr size_t WS_K8_OFF = 72 * MiB;
constexpr size_t WS_KVB = 1752 * MiB;
constexpr size_t WS_X0 = 1818 * MiB;
constexpr size_t WS_VG = 1950 * MiB;
constexpr size_t WS_VT = 2082 * MiB;
constexpr size_t WS_VTC = 2338 * MiB;
constexpr size_t WS_ACT = 2346 * MiB;
constexpr size_t WS_YM = 2890 * MiB;
constexpr size_t WS_CT = 3434 * MiB;
constexpr size_t WS_CTC = 3690 * MiB;
constexpr size_t WS_H8 = 3698 * MiB;
constexpr size_t WS_XB = 3764 * MiB;
constexpr size_t WS_END = 3896 * MiB;
constexpr int CW_BAR = 4096;
constexpr int CW_CNT = 16384;
constexpr int CW_DBG = 32768;

constexpr int RING_BYTES = 131072;
constexpr int AUX_OFF = RING_BYTES;
constexpr int AUX_BYTES = 16384;
constexpr int MISC_OFF = AUX_OFF + AUX_BYTES;
constexpr int MISC_BYTES = 4096;
constexpr int LDS_BYTES = MISC_OFF + MISC_BYTES;

#define GAS __attribute__((address_space(1)))
#define LAS __attribute__((address_space(3)))
typedef unsigned short bf16;
typedef unsigned v4u __attribute__((ext_vector_type(4)));
typedef unsigned v2u __attribute__((ext_vector_type(2)));
typedef float f32x4 __attribute__((ext_vector_type(4)));
typedef float f32x2 __attribute__((ext_vector_type(2)));
typedef float f32x16 __attribute__((ext_vector_type(16)));
typedef short bf16x8 __attribute__((ext_vector_type(8)));
typedef short s16x4 __attribute__((ext_vector_type(4)));
typedef int i32x4 __attribute__((ext_vector_type(4)));
typedef GAS unsigned gu32;
#define RLX_AGENT __ATOMIC_RELAXED, __HIP_MEMORY_SCOPE_AGENT
#define LDS_WAIT() asm volatile("s_waitcnt lgkmcnt(0)" ::: "memory")
#define VM_WAIT() asm volatile("s_waitcnt vmcnt(0)" ::: "memory")
__device__ __forceinline__ int opaque_tid(int wave) { int l; asm volatile("v_mbcnt_lo_u32_b32 %0, -1, 0\n\tv_mbcnt_hi_u32_b32 %0, -1, %0" : "=v"(l)); return (wave << 6) | l; }
__device__ __forceinline__ unsigned f2bf(float f) { unsigned u = __builtin_bit_cast(unsigned, f); return (u + 0x7fffu + ((u >> 16) & 1u)) >> 16; }
__device__ __forceinline__ unsigned pk2(float lo, float hi) { return f2bf(lo) | (f2bf(hi) << 16); }
__device__ __forceinline__ float bf2f(unsigned short b) { return __builtin_bit_cast(float, ((unsigned)b) << 16); }
__device__ __forceinline__ float bflo(unsigned w) { return __builtin_bit_cast(float, w << 16); }
__device__ __forceinline__ float bfhi(unsigned w) { return __builtin_bit_cast(float, w & 0xffff0000u); }
__device__ __forceinline__ f32x4 bf4_f32(v2u w) { return (f32x4){__uint_as_float(w.x << 16), __uint_as_float(w.x & 0xffff0000u), __uint_as_float(w.y << 16), __uint_as_float(w.y & 0xffff0000u)}; }
__device__ __forceinline__ unsigned cvt_pk_bf16(float lo, float hi) { unsigned r; asm volatile("v_cvt_pk_bf16_f32 %0, %1, %2" : "=v"(r) : "v"(lo), "v"(hi)); return r; }
__device__ __forceinline__ float shx(float v, int mask, int lane) { return __int_as_float(__builtin_amdgcn_ds_bpermute((lane ^ mask) << 2, __float_as_int(v))); }
__device__ __forceinline__ float wave_sum(float v, int lane) {
#pragma unroll
    for (int o = 1; o < 64; o <<= 1) v += shx(v, o, lane);
    return v;
}

#define XB_TMO      128
#define XB_XCNT(j)  (256  + 64 * (j))
#define XB_XSUB(j)  (1280 + 64 * (j))
#define XB_XGEN(j)  (2304 + 64 * (j))
#define XB_TOP      3328
#define XB_TOPGEN   3392
#define XCD_BAR_WORDS 3456
#define XB_SPIN_CAP (1u << 22)
__device__ __forceinline__ unsigned xb_ld(unsigned* p)              { return __hip_atomic_load(p, __ATOMIC_RELAXED, __HIP_MEMORY_SCOPE_AGENT); }
__device__ __forceinline__ unsigned xb_add(unsigned* p, unsigned v) { return __hip_atomic_fetch_add(p, v, __ATOMIC_RELAXED, __HIP_MEMORY_SCOPE_AGENT); }
__device__ __forceinline__ unsigned xb_xcc_id() { return (unsigned)__builtin_amdgcn_s_getreg((3 << 11) | 20) & 0xFu; }
#define XB_SPIN(cond, bar) do { unsigned _sp = 0; while (cond) { __builtin_amdgcn_s_sleep(1); \
    if ((++_sp & 255u) == 0u) { if (xb_ld(&(bar)[XB_TMO])) break; if (_sp > XB_SPIN_CAP) { atomicAdd(&(bar)[XB_TMO], 1u); break; } } } } while (0)
struct XcdBarrier { unsigned* bar; unsigned x; volatile LAS unsigned* st; int w; };
__device__ __forceinline__ bool xb_thread0(int w) { return opaque_tid(w) == 0; }
__device__ __forceinline__ XcdBarrier xcd_barrier_post(unsigned* bar, volatile LAS unsigned* st, int w) {
    XcdBarrier b; b.bar = bar; b.x = xb_xcc_id(); b.st = st; b.w = w;
    if (xb_thread0(w)) (void)xb_add(&bar[XB_XCNT(b.x)], 1u);
    return b;
}
__device__ __forceinline__ void xcd_barrier_complete(unsigned* bar, unsigned x, unsigned& nloc, unsigned& nx) {
    const unsigned G = gridDim.x * gridDim.y * gridDim.z;
    unsigned sum, cnt, mine, sp = 0u;
    for (;;) {
        sum = 0u; cnt = 0u; mine = 0u;
#pragma unroll
        for (unsigned j = 0; j < 16; ++j) { const unsigned c = xb_ld(&bar[XB_XCNT(j)]); sum += c; cnt += (c > 0u) ? 1u : 0u; mine = (j == x) ? c : mine; }
        if (sum == G) break;
        __builtin_amdgcn_s_sleep(1);
        if ((++sp & 255u) == 0u) { if (xb_ld(&bar[XB_TMO])) break; if (sp > XB_SPIN_CAP) { atomicAdd(&bar[XB_TMO], 1u); break; } }
    }
    nloc = mine > 0u ? mine : 1u; nx = cnt > 0u ? cnt : 1u;
}
__device__ __forceinline__ void xcd_barrier(const XcdBarrier& b) {
    asm volatile("s_waitcnt vmcnt(0)" ::: "memory");
    __syncthreads();
    if (xb_thread0(b.w)) {
        unsigned* bar = b.bar;
        __builtin_amdgcn_s_waitcnt(0);
        unsigned nloc = b.st[0], nx = b.st[1];
        if (nloc == 0u) { xcd_barrier_complete(bar, b.x, nloc, nx); b.st[0] = nloc; b.st[1] = nx; }
        const unsigned old = xb_add(&bar[XB_XSUB(b.x)], 1u);
        const unsigned gen = old / nloc;
        if (old + 1u == (gen + 1u) * nloc) {
            __builtin_amdgcn_fence(__ATOMIC_RELEASE, "agent");
            asm volatile("s_waitcnt vmcnt(0)" ::: "memory");
            const unsigned og = xb_add(&bar[XB_TOP], 1u);
            const unsigned tg = og / nx;
            if (og + 1u == (tg + 1u) * nx) xb_add(&bar[XB_TOPGEN], 1u);
            else XB_SPIN(xb_ld(&bar[XB_TOPGEN]) == tg, bar);
            __builtin_amdgcn_fence(__ATOMIC_ACQUIRE, "agent");
            xb_add(&bar[XB_XGEN(b.x)], 1u);
            asm volatile("s_waitcnt vmcnt(0)" ::: "memory");
        } else {
            XB_SPIN(xb_ld(&bar[XB_XGEN(b.x)]) == gen, bar);
            __builtin_amdgcn_fence(__ATOMIC_ACQUIRE, "agent");
            asm volatile("s_waitcnt vmcnt(0)" ::: "memory");
        }
    }
    __syncthreads();
}

namespace pg8 {
constexpr int BM = 256, BK = 64, HALF = 128, HTB = HALF * BK * 2, STAGE_BYTES = 8 * HTB, NXCD = 8, WGM = 8;
constexpr int GK = 1024;
__device__ __forceinline__ int lds_byte(int r, int c) { const int st = (r >> 4) * 2 + (c >> 5), rr = r & 15, cc = c & 31, ob = rr * 64 + cc * 2; return st * 1024 + (ob ^ (((ob >> 9) & 1) << 5)); }
__device__ __forceinline__ void stage_rc(int b, int& R, int& C) { const int st = b / 1024, sb = b % 1024, swz = sb ^ (((sb >> 9) & 1) << 5); R = (st >> 1) * 16 + swz / 64; C = (st & 1) * 32 + (swz % 64) / 2; }
__device__ __forceinline__ int perm32(int rho) { const int n = rho >> 4, i = rho & 15; return 8 * (i >> 2) + 4 * n + (i & 3); }
struct Unit { int pm, pn, e; };

template <bool IDG> struct DenseSchedT {
    const char* A; const char* Bt; int nM, nN, nwg, G, c, kb;
    __device__ __forceinline__ void init(const void* A_, const void* Bt_, int M, int N, int G_, int c_, int kb_ = GK * 2) { A = (const char*)A_; Bt = (const char*)Bt_; nM = M / BM; nN = N / BM; nwg = nM * nN; G = G_; c = c_; kb = kb_; }
    __device__ __forceinline__ bool next(int i, Unit& u) const {
        const long L = (long)i * G + c; if (L >= nwg) return false;
        int wgid = (int)L; { const int q = nwg / NXCD, r = nwg % NXCD, xcd = wgid % NXCD, off = wgid / NXCD; wgid = (xcd < r ? xcd * (q + 1) : r * (q + 1) + (xcd - r) * q) + off; }
        const int nig = WGM * nN, gid = wgid / nig, fm = gid * WGM, gsz = (nM - fm) < WGM ? (nM - fm) : WGM;
        u.pm = fm + ((wgid % nig) % gsz); u.pn = (wgid % nig) / gsz; u.e = 0; return true;
    }
    __device__ __forceinline__ const char* a_ptr(const Unit& u) const { return IDG ? A : A + (size_t)u.pm * (size_t)(BM * kb); }
    __device__ __forceinline__ const char* b_ptr(const Unit& u) const { return Bt + (size_t)u.pn * (size_t)(BM * kb); }
    __device__ __forceinline__ void a_offs(const Unit& u, const int (&R)[2], const int (&C)[2], unsigned (&voff)[2][2]) const {
#pragma unroll
        for (int h = 0; h < 2; ++h)
#pragma unroll
            for (int i = 0; i < 2; ++i) voff[h][i] = (unsigned)(u.pm * BM + h * HALF + R[i]) * (unsigned)kb + (unsigned)C[i] * 2u;
    }
    __device__ __forceinline__ void a_raw(const Unit&, const int (&)[2], int (&)[2][2]) const {}
    __device__ __forceinline__ void a_fin(const Unit& u, const int (&R)[2], const int (&C)[2], const int (&)[2][2], unsigned (&voff)[2][2]) const { a_offs(u, R, C, voff); }
};
typedef DenseSchedT<false> DenseSched;
struct MoeSched {
    const char* A; const char* Bt; size_t b_estride; const int* rowtok; const volatile LAS int* cumblk; const volatile LAS int* cnt; int ncol_log2, G, c, kb; const volatile LAS int* ulist;
    __device__ __forceinline__ bool next(int i, Unit& u) const {
        const int v = ulist[i & 63]; if (v < 0) return false;
        u.pm = v >> 8; u.e = (v >> 3) & 31; u.pn = v & 7; return true;
    }
    __device__ __forceinline__ void build_list(volatile LAS int* dst, int tid) const {
        if (tid < 64) { Unit u; dst[tid] = search(tid, u) ? ((u.pm << 8) | (u.e << 3) | u.pn) : -1; }
    }
    __device__ __forceinline__ bool search(int i, Unit& u) const {
        int gb, pn; const int ncol = 1 << ncol_log2;
        if (G == 256 && MK_MOEMAP == 0) { const int xcd = c & 7, j = c >> 3, rpb = 256 >> ncol_log2; gb = i * rpb + xcd + 8 * (j >> ncol_log2); pn = j & (ncol - 1); }
        else { const long L = (long)i * G + c; gb = (int)(L >> ncol_log2); pn = (int)(L & (ncol - 1)); }
        const int tot = cumblk[NE]; if (gb >= tot) return false;
        int e = 0;
#pragma unroll 1
        for (int s = 16; s >= 1; s >>= 1) { if (cumblk[e + s] <= gb) e += s; }
        u.pm = gb; u.pn = pn; u.e = e; return true;
    }
    __device__ __forceinline__ const char* a_ptr(const Unit&) const { return A; }
    __device__ __forceinline__ const char* b_ptr(const Unit& u) const { return Bt + (size_t)u.e * b_estride + (size_t)u.pn * (size_t)(BM * kb); }
    __device__ __forceinline__ void a_raw(const Unit& u, const int (&R)[2], int (&raw)[2][2]) const {
        if (!rowtok) return;
        const int rb = u.pm - cumblk[u.e]; const int* rt = rowtok + (size_t)u.e * MT;
#pragma unroll
        for (int h = 0; h < 2; ++h)
#pragma unroll
            for (int i = 0; i < 2; ++i) { const int* ptr = rt + (rb * 256 + h * HALF + R[i]);
                asm volatile("global_load_dword %0, %1, off" : "=v"(raw[h][i]) : "v"(ptr) : "memory"); }
    }
    __device__ __forceinline__ void a_fin(const Unit& u, const int (&R)[2], const int (&C)[2], const int (&raw_)[2][2], unsigned (&voff)[2][2]) const {
        int raw[2][2] = {{raw_[0][0], raw_[0][1]}, {raw_[1][0], raw_[1][1]}};
        asm volatile("" : "+v"(raw[0][0]), "+v"(raw[0][1]), "+v"(raw[1][0]), "+v"(raw[1][1]));
        const int rb = u.pm - cumblk[u.e], n = cnt[u.e];
#pragma unroll
        for (int h = 0; h < 2; ++h)
#pragma unroll
            for (int i = 0; i < 2; ++i) { const int rank = rb * 256 + h * HALF + R[i]; const int tok = rowtok ? (rank < n ? raw[h][i] : 0) : u.pm * BM + h * HALF + R[i];
                voff[h][i] = (unsigned)tok * (unsigned)kb + (unsigned)C[i] * 2u; }
    }
    __device__ __forceinline__ void a_offs(const Unit& u, const int (&R)[2], const int (&C)[2], unsigned (&voff)[2][2]) const { int raw[2][2] = {{0, 0}, {0, 0}}; a_raw(u, R, raw); asm volatile("s_waitcnt vmcnt(0)" : "+v"(raw[0][0]), "+v"(raw[0][1]), "+v"(raw[1][0]), "+v"(raw[1][1]) :: "memory"); a_fin(u, R, C, raw, voff); }
};

typedef int v8i __attribute__((ext_vector_type(8)));
__device__ __forceinline__ v8i cat8(bf16x8 lo, bf16x8 hi) { const v4u a = __builtin_bit_cast(v4u, lo), b = __builtin_bit_cast(v4u, hi); return (v8i){(int)a.x, (int)a.y, (int)a.z, (int)a.w, (int)b.x, (int)b.y, (int)b.z, (int)b.w}; }
template <class Epi, class Sched, bool GATHER, bool FP8 = false, int XG = 0>
__device__ __forceinline__ void gemm_phase(LAS unsigned char* lds, const Sched& S, const Epi& E, int wave_id, bool skip_epi = false, unsigned stagger_ticks = 0u) {
    if (stagger_ticks && ((blockIdx.x >> 3) & 1u)) { const unsigned long long t0 = __builtin_amdgcn_s_memrealtime(); while (__builtin_amdgcn_s_memrealtime() - t0 < (unsigned long long)stagger_ticks) __builtin_amdgcn_s_sleep(8); }
    const int tid = opaque_tid(wave_id), wid = __builtin_amdgcn_readfirstlane(tid >> 6), lane = tid & 63, wr = wid >> 2, wc = wid & 3, fr = lane & 15, fq = lane >> 4;
    constexpr int KB = FP8 ? GK : GK * 2, nt = KB / (BK * 2);
    unsigned voffA[2][2], voffB[2]; int Rr[2], Cc[2];
#pragma unroll
    for (int i = 0; i < 2; ++i) { int R, C; stage_rc(tid * 16 + i * 8192, R, C); Rr[i] = R; Cc[i] = C; const int Rb = Epi::PERM ? ((R & ~31) + perm32(R & 31)) : R;
        voffA[0][i] = (unsigned)(R * KB + C * 2); voffA[1][i] = (unsigned)((R + HALF) * KB + C * 2); voffB[i] = (unsigned)(Rb * KB + C * 2); }
    constexpr size_t kstep = (size_t)(BK * 2);
    constexpr size_t hstep = (size_t)HALF * KB;
    const unsigned ldsw = (unsigned)wid * 1024u;
    const int aoff = lds_byte(wr * 64 + fr, fq * 8), boff = lds_byte(wc * 32 + fr, fq * 8);
    LAS unsigned char* abase = lds + aoff; LAS unsigned char* bbase = lds + 4 * HTB + boff; asm volatile("" : "+v"(abase), "+v"(bbase));
#define PG8_SA(b, h) (((b) * 2 + (h)) * HTB)
#define PG8_SB(b, h) ((4 + (b) * 2 + (h)) * HTB)
#define PG8_STAGE(bufoff, gbase, voff) do { if (XG == 3) break; _Pragma("unroll") for (int _i = 0; _i < 2; ++_i) \
        __builtin_amdgcn_global_load_lds((const unsigned*)((const char*)(gbase) + (voff)[_i]), (LAS unsigned*)(lds + (bufoff) + ldsw + _i * 8192), 16, 0, 0); } while (0)
#define PG8_STAGE_A(bufoff, gbase, h) PG8_STAGE(bufoff, gbase, voffA[h])
#define PG8_RDA(off) (*(const LAS v4u*)(abase + (off)))
#define PG8_RDB(off) (*(const LAS v4u*)(bbase + (off)))
#define PG8_LDA(dst, b, h) do { if (XG == 2) break; _Pragma("unroll") for (int m = 0; m < 4; ++m) { const v4u _l = PG8_RDA(PG8_SA(b, h) + m * 2048), _h = PG8_RDA(PG8_SA(b, h) + m * 2048 + 1024); \
        if constexpr (FP8) dst##8[m] = (v8i){(int)_l.x, (int)_l.y, (int)_l.z, (int)_l.w, (int)_h.x, (int)_h.y, (int)_h.z, (int)_h.w}; \
        else { dst[m][0] = __builtin_bit_cast(bf16x8, _l); dst[m][1] = __builtin_bit_cast(bf16x8, _h); } } } while (0)
#define PG8_LDB(dst, b, h) do { if (XG == 2) break; _Pragma("unroll") for (int n = 0; n < 2; ++n) { const v4u _l = PG8_RDB(PG8_SA(b, h) + n * 2048), _h = PG8_RDB(PG8_SA(b, h) + n * 2048 + 1024); \
        if constexpr (FP8) dst##8[n] = (v8i){(int)_l.x, (int)_l.y, (int)_l.z, (int)_l.w, (int)_h.x, (int)_h.y, (int)_h.z, (int)_h.w}; \
        else { dst[n][0] = __builtin_bit_cast(bf16x8, _l); dst[n][1] = __builtin_bit_cast(bf16x8, _h); } } } while (0)
#define PG8_MMA(ai, bj, At, Bt) do { if (XG == 1) break; __builtin_amdgcn_s_setprio(1); _Pragma("unroll") for (int m = 0; m < 4; ++m) _Pragma("unroll") for (int n = 0; n < 2; ++n) { \
        if constexpr (FP8) acc[ai][bj][m][n] = __builtin_amdgcn_mfma_scale_f32_16x16x128_f8f6f4(Bt##8[n], At##8[m], acc[ai][bj][m][n], 0, 0, 0, 0x7A7A7A7A, 0, 0x7F7F7F7F); \
        else { _Pragma("unroll") for (int k = 0; k < 2; ++k) acc[ai][bj][m][n] = __builtin_amdgcn_mfma_f32_16x16x32_bf16(Bt[n][k], At[m][k], acc[ai][bj][m][n], 0, 0, 0); } } \
        __builtin_amdgcn_s_setprio(0); } while (0)
#define PG8_WAIT_V(n) asm volatile("s_waitcnt vmcnt(" #n ")" ::: "memory")
#define PG8_WAIT_L(n) asm volatile("s_waitcnt lgkmcnt(" #n ")" ::: "memory")
#define PG8_BAR __builtin_amdgcn_s_barrier()
#define PG8_SCHED __builtin_amdgcn_sched_barrier(0)
    Unit cur, nxt; int ui = 0;
    if (!S.next(0, cur)) return;
    f32x4 acc[2][2][4][2];
#pragma unroll
    for (int a = 0; a < 2; ++a)
#pragma unroll
        for (int b = 0; b < 2; ++b)
#pragma unroll
            for (int m = 0; m < 4; ++m)
#pragma unroll
                for (int n = 0; n < 2; ++n) acc[a][b][m][n] = (f32x4){0.f, 0.f, 0.f, 0.f};
    bf16x8 At[4][2], B0[2][2], B1[2][2]; v8i At8[4], B08[2], B18[2];
    if constexpr (XG == 2) { _Pragma("unroll") for (int m = 0; m < 4; ++m) { asm volatile("" : "=v"(At8[m])); } _Pragma("unroll") for (int n = 0; n < 2; ++n) { asm volatile("" : "=v"(B08[n])); asm volatile("" : "=v"(B18[n])); } }
    const char* cA = S.a_ptr(cur); const char* cB = S.b_ptr(cur);
    if constexpr (GATHER) S.a_offs(cur, Rr, Cc, voffA);
    PG8_STAGE(PG8_SB(0, 0), cB, voffB); PG8_STAGE(PG8_SB(0, 1), cB + hstep, voffB); PG8_STAGE_A(PG8_SA(0, 0), cA, 0); PG8_STAGE_A(PG8_SA(0, 1), cA, 1);
    if (wr == 1) PG8_BAR;
    PG8_WAIT_V(2); PG8_BAR;
    PG8_STAGE(PG8_SB(1, 0), cB + kstep, voffB); PG8_STAGE_A(PG8_SA(1, 0), cA + kstep, 0); PG8_STAGE(PG8_SB(1, 1), cB + hstep + kstep, voffB);
    PG8_WAIT_V(6); PG8_BAR;
    for (;;) {
        const bool has_next = S.next(ui + 1, nxt);
        const char* nA = has_next ? S.a_ptr(nxt) : cA; const char* nB = has_next ? S.b_ptr(nxt) : cB;
        int rawN[2][2] = {{0, 0}, {0, 0}};
        if constexpr (GATHER) { if (has_next) S.a_raw(nxt, Rr, rawN); }
#pragma unroll 1
        for (int t = 0; t < nt; t += 2) {
            const bool last = (t == nt - 2);
            if constexpr (Epi::LDSBIAS) { if (last && wid == 0) E.stage_bias(cur, lane); }
            const char* a1 = cA + (size_t)(t + 1) * kstep;
            const char* a2 = last ? nA : cA + (size_t)(t + 2) * kstep; const char* b2 = last ? nB : cB + (size_t)(t + 2) * kstep;
            const char* a3 = a2 + kstep; const char* b3 = b2 + kstep;
            PG8_LDB(B0, 0, 0); PG8_LDB(B1, 0, 1); PG8_SCHED; PG8_LDA(At, 0, 0); PG8_STAGE_A(PG8_SA(1, 1), a1, 1);
            if constexpr (GATHER) { if (last && has_next) S.a_fin(nxt, Rr, Cc, rawN, voffA); }
            PG8_WAIT_V(8); PG8_WAIT_L(0); PG8_BAR; PG8_MMA(0, 0, At, B0); PG8_MMA(0, 1, At, B1); PG8_BAR; PG8_SCHED;
            PG8_LDA(At, 0, 1); PG8_STAGE(PG8_SB(0, 0), b2, voffB); PG8_STAGE(PG8_SB(0, 1), b2 + hstep, voffB); PG8_STAGE_A(PG8_SA(0, 0), a2, 0);
            PG8_WAIT_V(8); PG8_WAIT_L(0); PG8_BAR; PG8_MMA(1, 0, At, B0); PG8_MMA(1, 1, At, B1); PG8_BAR; PG8_SCHED;
            PG8_LDB(B0, 1, 0); PG8_LDB(B1, 1, 1); PG8_SCHED; PG8_LDA(At, 1, 0); PG8_STAGE_A(PG8_SA(0, 1), a2, 1);
            PG8_WAIT_V(8); PG8_WAIT_L(0); PG8_BAR; PG8_MMA(0, 0, At, B0); PG8_MMA(0, 1, At, B1); PG8_BAR; PG8_SCHED;
            PG8_LDA(At, 1, 1); PG8_STAGE(PG8_SB(1, 0), b3, voffB); PG8_STAGE(PG8_SB(1, 1), b3 + hstep, voffB); PG8_STAGE_A(PG8_SA(1, 0), a3, 0);
            PG8_WAIT_V(8); PG8_WAIT_L(0); PG8_BAR; PG8_MMA(1, 0, At, B0); PG8_MMA(1, 1, At, B1); PG8_BAR; PG8_SCHED;
        }
        if (wr == 0) PG8_BAR;
        if (!skip_epi) E(acc, cur, wr, wc, fr, fq);
        if (!has_next) break;
#pragma unroll
        for (int a = 0; a < 2; ++a)
#pragma unroll
            for (int b = 0; b < 2; ++b)
#pragma unroll
                for (int m = 0; m < 4; ++m)
#pragma unroll
                    for (int n = 0; n < 2; ++n) acc[a][b][m][n] = (f32x4){0.f, 0.f, 0.f, 0.f};
        cur = nxt; cA = nA; cB = nB; ++ui;
        if (wr == 1) PG8_BAR;
    }
    PG8_WAIT_V(0);
    PG8_BAR;
#undef PG8_SA
#undef PG8_SB
#undef PG8_STAGE
#undef PG8_STAGE_A
#undef PG8_LDA
#undef PG8_RDA
#undef PG8_RDB
#undef PG8_LDB
#undef PG8_MMA
#undef PG8_WAIT_V
#undef PG8_WAIT_L
#undef PG8_BAR
#undef PG8_SCHED
}
}
namespace pg8 {
__device__ __forceinline__ f32x2 gelu_pk(f32x2 v) {
    const f32x2 av = __builtin_elementwise_abs(v), d = av * 0.2316418882f + 1.0f;
    f32x2 t; t.x = __builtin_amdgcn_rcpf(d.x); t.y = __builtin_amdgcn_rcpf(d.y);
    f32x2 q = t * 0.5307027145f + (-0.7265760135f); q = q * t + 0.7107068705f; q = q * t + (-0.142248368f); q = q * t + 0.127414796f; q = q * t;
    const f32x2 s = (v * v) * (-0.72134752044f);
    f32x2 e; e.x = __builtin_amdgcn_exp2f(s.x); e.y = __builtin_amdgcn_exp2f(s.y);
    const f32x2 m = v * (q * e), r = v - m;
    f32x2 o; o.x = v.x < 0.f ? m.x : r.x; o.y = v.y < 0.f ? m.y : r.y; return o;
}
struct EpiBf16 {
    static constexpr bool PERM = true, LDSBIAS = false;
    bf16* O; int ldc; float* ss; int ACT;
    __device__ __forceinline__ void operator()(const f32x4 (&acc)[2][2][4][2], const Unit& u, int wr, int wc, int fr, int fq) const {
        const int row0 = u.pm * BM + wr * 64 + fr, col0 = u.pn * BM + wc * 32 + 8 * fq;
#pragma unroll
        for (int ai = 0; ai < 2; ++ai)
#pragma unroll
            for (int m = 0; m < 4; ++m) { const int row = row0 + ai * HALF + m * 16; bf16* rowp = O + (size_t)row * ldc + col0; float sq = 0.f;
#pragma unroll
                for (int bj = 0; bj < 2; ++bj) { f32x4 v0 = acc[ai][bj][m][0], v1 = acc[ai][bj][m][1];
                    if (ACT == 1) { f32x2 a = gelu_pk((f32x2){v0[0], v0[1]}), b = gelu_pk((f32x2){v0[2], v0[3]}), c = gelu_pk((f32x2){v1[0], v1[1]}), d = gelu_pk((f32x2){v1[2], v1[3]});
                        v0 = (f32x4){a.x, a.y, b.x, b.y}; v1 = (f32x4){c.x, c.y, d.x, d.y};
                        sq += (v0[0] * v0[0] + v0[1] * v0[1]) + (v0[2] * v0[2] + v0[3] * v0[3]) + (v1[0] * v1[0] + v1[1] * v1[1]) + (v1[2] * v1[2] + v1[3] * v1[3]); }
                    v4u w; w.x = cvt_pk_bf16(v0[0], v0[1]); w.y = cvt_pk_bf16(v0[2], v0[3]); w.z = cvt_pk_bf16(v1[0], v1[1]); w.w = cvt_pk_bf16(v1[2], v1[3]);
                    *(v4u*)(rowp + bj * HALF) = w; }
                if (ACT == 1) { const int ln = (fq << 4) | fr; sq += shx(sq, 16, ln); sq += shx(sq, 32, ln);
                    if (u.pn >= 4 && fq == 0) ss[(size_t)row * 16 + (u.pn - 4) * 4 + wc] = sq; }
            }
    }
};
struct EpiResid {
    static constexpr bool PERM = false, LDSBIAS = false;
    bf16* xb; const float* modl;
    __device__ __forceinline__ void operator()(const f32x4 (&acc)[2][2][4][2], const Unit& u, int wr, int wc, int fr, int fq) const {
        const bool lat = u.pm < ML / BM; const int bidx = lat ? (u.pm >> 5) : 8;
        bf16* base = xb + (size_t)u.pm * BM * D;
        const float* g = modl + bidx * 6144 + 2 * 1024;
        const int r0 = wr * 64 + fr, col0 = u.pn * BM + wc * 32 + 4 * fq;
        f32x4 gv[2][2];
#pragma unroll
        for (int bj = 0; bj < 2; ++bj)
#pragma unroll
            for (int n = 0; n < 2; ++n) gv[bj][n] = *(const f32x4*)(g + col0 + bj * HALF + n * 16);
        const int odd = fq & 1, colp = col0 - 4 * odd;
#pragma unroll
        for (int ai = 0; ai < 2; ++ai) { v4u bs[2][2][2];
#pragma unroll
            for (int mp = 0; mp < 2; ++mp) { const size_t off = (size_t)(r0 + ai * HALF + (2 * mp + odd) * 16) * D + colp;
#pragma unroll
                for (int bj = 0; bj < 2; ++bj)
#pragma unroll
                    for (int n = 0; n < 2; ++n) bs[mp][bj][n] = *(const v4u*)(base + off + bj * HALF + n * 16); }
#pragma unroll
            for (int mp = 0; mp < 2; ++mp) { const size_t off = (size_t)(r0 + ai * HALF + (2 * mp + odd) * 16) * D + colp;
#pragma unroll
                for (int bj = 0; bj < 2; ++bj)
#pragma unroll
                    for (int n = 0; n < 2; ++n) { const v4u L = bs[mp][bj][n];
                        const auto s0 = __builtin_amdgcn_permlane16_swap(L.x, L.z, false, false), s1 = __builtin_amdgcn_permlane16_swap(L.y, L.w, false, false);
                        const f32x4 va = bf4_f32((v2u){s0[0], s1[0]}) + gv[bj][n] * acc[ai][bj][2 * mp][n], vb = bf4_f32((v2u){s0[1], s1[1]}) + gv[bj][n] * acc[ai][bj][2 * mp + 1][n];
                        const auto t0 = __builtin_amdgcn_permlane16_swap(cvt_pk_bf16(va.x, va.y), cvt_pk_bf16(vb.x, vb.y), false, false), t1 = __builtin_amdgcn_permlane16_swap(cvt_pk_bf16(va.z, va.w), cvt_pk_bf16(vb.z, vb.w), false, false);
                        *(v4u*)(base + off + bj * HALF + n * 16) = (v4u){t0[0], t1[0], t0[1], t1[1]}; } }
            asm volatile("" ::: "memory"); }
    }
};
struct EpiSwiglu {
    static constexpr bool PERM = true, LDSBIAS = true;
    unsigned char* O; const float* b1; LAS float* bl;
    __device__ __forceinline__ void stage_bias(const Unit& u, int lane) const { const float* src = b1 + (size_t)u.e * 2048 + (lane < 32 ? u.pn * HALF + 4 * lane : 1024 + u.pn * HALF + 4 * (lane - 32));
        __builtin_amdgcn_global_load_lds((const unsigned*)src, (LAS unsigned*)bl, 16, 0, 0); }
    __device__ __forceinline__ void operator()(const f32x4 (&acc)[2][2][4][2], const Unit& u, int wr, int wc, int fr, int fq) const {
        const int row0 = u.pm * BM + wr * 64 + fr, cl = wc * 32 + 8 * fq, c0 = u.pn * HALF + cl;
        f32x4 bg[2], bli[2];
#pragma unroll
        for (int n = 0; n < 2; ++n) { bg[n] = *(const LAS f32x4*)(bl + cl + 4 * n); bli[n] = *(const LAS f32x4*)(bl + 128 + cl + 4 * n) + 1.0f; }
#pragma unroll
        for (int ai = 0; ai < 2; ++ai)
#pragma unroll
            for (int mp = 0; mp < 4; mp += 2) { v2u wv[2];
#pragma unroll
              for (int mm = 0; mm < 2; ++mm) { const int m = mp + mm; float o[8];
#pragma unroll
                for (int n = 0; n < 2; ++n)
#pragma unroll
                    for (int j = 0; j < 4; ++j) { const float gl = fminf(acc[ai][0][m][n][j] + bg[n][j], 7.0f), lp = __builtin_amdgcn_fmed3f(acc[ai][1][m][n][j] + bli[n][j], -6.0f, 8.0f);
                        const float sg = __builtin_amdgcn_rcpf(1.0f + __builtin_amdgcn_exp2f(gl * (-1.702f * 1.4426950408889634f)));
                        o[n * 4 + j] = gl * sg * lp; }
                v2u w; w.x = 0; w.y = 0;
                w.x = __builtin_amdgcn_cvt_pk_fp8_f32(o[0], o[1], w.x, false); w.x = __builtin_amdgcn_cvt_pk_fp8_f32(o[2], o[3], w.x, true);
                w.y = __builtin_amdgcn_cvt_pk_fp8_f32(o[4], o[5], w.y, false); w.y = __builtin_amdgcn_cvt_pk_fp8_f32(o[6], o[7], w.y, true);
                wv[mm] = w; }
              const auto sx = __builtin_amdgcn_permlane16_swap(wv[0].x, wv[1].x, false, false), sy = __builtin_amdgcn_permlane16_swap(wv[0].y, wv[1].y, false, false);
              *(v4u*)(O + (size_t)(row0 + ai * HALF + (mp + (fq & 1)) * 16) * D + (c0 - 8 * (fq & 1))) = (v4u){sx[0], sy[0], sx[1], sy[1]}; }
    }
};
struct EpiBias {
    static constexpr bool PERM = true, LDSBIAS = true;
    unsigned char* O; const float* b2; LAS float* bl;
    __device__ __forceinline__ void stage_bias(const Unit& u, int lane) const { __builtin_amdgcn_global_load_lds((const unsigned*)(b2 + (size_t)u.e * 1024 + u.pn * BM + 4 * lane), (LAS unsigned*)bl, 16, 0, 0); }
    __device__ __forceinline__ void operator()(const f32x4 (&acc)[2][2][4][2], const Unit& u, int wr, int wc, int fr, int fq) const {
        const int row0 = u.pm * BM + wr * 64 + fr, cl = wc * 32 + 8 * fq, col0 = u.pn * BM + cl;
#pragma unroll
        for (int bj = 0; bj < 2; ++bj) { const f32x4 bv0 = *(const LAS f32x4*)(bl + cl + bj * HALF), bv1 = *(const LAS f32x4*)(bl + cl + bj * HALF + 4);
#pragma unroll
            for (int ai = 0; ai < 2; ++ai)
#pragma unroll
                for (int mp = 0; mp < 4; mp += 2) { v2u wv[2];
#pragma unroll
                    for (int mm = 0; mm < 2; ++mm) { const int m = mp + mm; const f32x4 v0 = acc[ai][bj][m][0] + bv0, v1 = acc[ai][bj][m][1] + bv1;
                        v2u w; w.x = 0; w.y = 0;
                        w.x = __builtin_amdgcn_cvt_pk_fp8_f32(v0[0], v0[1], w.x, false); w.x = __builtin_amdgcn_cvt_pk_fp8_f32(v0[2], v0[3], w.x, true);
                        w.y = __builtin_amdgcn_cvt_pk_fp8_f32(v1[0], v1[1], w.y, false); w.y = __builtin_amdgcn_cvt_pk_fp8_f32(v1[2], v1[3], w.y, true);
                        wv[mm] = w; }
                    const auto sx = __builtin_amdgcn_permlane16_swap(wv[0].x, wv[1].x, false, false), sy = __builtin_amdgcn_permlane16_swap(wv[0].y, wv[1].y, false, false);
                    *(v4u*)(O + (size_t)(row0 + ai * HALF + (mp + (fq & 1)) * 16) * D + (col0 - 8 * (fq & 1)) + bj * HALF) = (v4u){sx[0], sy[0], sx[1], sy[1]}; }
            asm volatile("" ::: "memory"); }
    }
};
}

namespace att {
constexpr int AD = 128, NW = 8, QBLK = 32, KVBLK = 64;
constexpr float SCALE = 0.088388347648318440f;
constexpr int LDO = 1024;
constexpr int SHM_V = AD * KVBLK, SHM_K = KVBLK * AD, SHM_ATTN = 4 * SHM_V + 4 * SHM_K;
typedef int v8i __attribute__((ext_vector_type(8)));
#define K8SW(key, c) ((key) * 128 + ((((c) ^ (((key) >> 1) & 7))) << 4))
#define V8SW(d, c) ((d) * 64 + ((((c) ^ (((d) >> 2) & 3))) << 4))
#define SBAR() __builtin_amdgcn_sched_barrier(0)
__device__ __forceinline__ int crow(int r, int hi) { return (r & 3) + 8 * (r >> 2) + 4 * hi; }
template <int XV = 0>
__device__ __forceinline__ int exp4(float a0, float a1, float a2, float a3) {
  float t0 = fminf(a0 + 8.0f, 8.0f), t1 = fminf(a1 + 8.0f, 8.0f), t2 = fminf(a2 + 8.0f, 8.0f), t3 = fminf(a3 + 8.0f, 8.0f); int w;
  asm volatile("v_exp_f32 %1, %1\n\tv_exp_f32 %2, %2\n\tv_exp_f32 %3, %3\n\tv_exp_f32 %4, %4\n\t"
               "v_cvt_pk_fp8_f32 %0, %1, %2\n\ts_nop 0\n\tv_cvt_pk_fp8_f32 %0, %3, %4 op_sel:[0,0,1]"
               : "=&v"(w), "+v"(t0), "+v"(t1), "+v"(t2), "+v"(t3));
  return w;
}
template <int PAD>
__device__ __forceinline__ int expc4(float a0, float a1, float a2, float a3) {
  int w; float t0, t1, t2, t3;
  if constexpr (PAD != 0)
    asm volatile("s_nop 5\n\tv_exp_f32_e64 %1, %5 clamp\n\tv_exp_f32_e64 %2, %6 clamp\n\tv_exp_f32_e64 %3, %7 clamp\n\tv_exp_f32_e64 %4, %8 clamp\n\t"
                 "v_cvt_scalef32_pk_fp8_f32 %0, %1, %2, %9\n\ts_nop 0\n\tv_cvt_scalef32_pk_fp8_f32 %0, %3, %4, %9 op_sel:[0,0,0,1]"
                 : "=&v"(w), "=&v"(t0), "=&v"(t1), "=&v"(t2), "=&v"(t3) : "v"(a0), "v"(a1), "v"(a2), "v"(a3), "s"(0x3B800000));
  else
    asm volatile("v_exp_f32_e64 %1, %5 clamp\n\tv_exp_f32_e64 %2, %6 clamp\n\tv_exp_f32_e64 %3, %7 clamp\n\tv_exp_f32_e64 %4, %8 clamp\n\t"
                 "v_cvt_scalef32_pk_fp8_f32 %0, %1, %2, %9\n\ts_nop 0\n\tv_cvt_scalef32_pk_fp8_f32 %0, %3, %4, %9 op_sel:[0,0,0,1]"
                 : "=&v"(w), "=&v"(t0), "=&v"(t1), "=&v"(t2), "=&v"(t3) : "v"(a0), "v"(a1), "v"(a2), "v"(a3), "s"(0x3B800000));
  return w;
}
#define EXC4(P, m, PAD) expc4<PAD>(P[4 * (m)], P[4 * (m) + 1], P[4 * (m) + 2], P[4 * (m) + 3])
typedef int v4i __attribute__((ext_vector_type(4)));
__device__ __forceinline__ void partialSM(const f32x16& p0, float nb, v4i& plo) {
#pragma unroll
  for (int m = 0; m < 4; ++m) plo[m] = exp4(p0[4 * m], p0[4 * m + 1], p0[4 * m + 2], p0[4 * m + 3]);
}
__device__ __forceinline__ void finishSM(const f32x16& p1, float nb, const v4i& plo, v8i& pa) {
  v4i phi;
#pragma unroll
  for (int m = 0; m < 4; ++m) phi[m] = exp4(p1[4 * m], p1[4 * m + 1], p1[4 * m + 2], p1[4 * m + 3]);
  pa = (v8i){plo[0], plo[1], plo[2], plo[3], phi[0], phi[1], phi[2], phi[3]};
}
__device__ __forceinline__ void qkt(f32x16& p0, f32x16& p1, const char* Ks, const v8i* q8, int r32, int hi, const f32x16& NBV) {
  p0 = NBV; p1 = NBV;
#pragma unroll
  for (int s = 0; s < 2; ++s) { const int c0 = 4 * s + 2 * hi;
    const v4u a0 = *reinterpret_cast<const v4u*>(Ks + K8SW(r32, c0)), a1 = *reinterpret_cast<const v4u*>(Ks + K8SW(r32, c0 + 1));
    const v4u b0 = *reinterpret_cast<const v4u*>(Ks + K8SW(32 + r32, c0)), b1 = *reinterpret_cast<const v4u*>(Ks + K8SW(32 + r32, c0 + 1));
    const v8i A0 = (v8i){(int)a0.x, (int)a0.y, (int)a0.z, (int)a0.w, (int)a1.x, (int)a1.y, (int)a1.z, (int)a1.w};
    const v8i A1 = (v8i){(int)b0.x, (int)b0.y, (int)b0.z, (int)b0.w, (int)b1.x, (int)b1.y, (int)b1.z, (int)b1.w};
    p0 = __builtin_amdgcn_mfma_scale_f32_32x32x64_f8f6f4(A0, q8[s], p0, 0, 0, 0, 0x7F7F7F7F, 0, 0x7C7C7C7C);
    p1 = __builtin_amdgcn_mfma_scale_f32_32x32x64_f8f6f4(A1, q8[s], p1, 0, 0, 0, 0x7F7F7F7F, 0, 0x7C7C7C7C); }
}
__device__ __forceinline__ void pv_d0(f32x16* o, f32x16& lacc, const char* Vs, v8i pa, int r32, int hi) {
  { const int one = 0x38383838; const v8i ONES = (v8i){one, one, one, one, one, one, one, one};
    lacc = __builtin_amdgcn_mfma_scale_f32_32x32x64_f8f6f4(pa, ONES, lacc, 0, 0, 0, 0x7F7F7F7F, 0, 0x7F7F7F7F); }
#pragma unroll
  for (int d0 = 0; d0 < 4; ++d0) { const int d = 32 * d0 + r32;
    const v4u b0 = *reinterpret_cast<const v4u*>(Vs + V8SW(d, 2 * hi)), b1 = *reinterpret_cast<const v4u*>(Vs + V8SW(d, 2 * hi + 1));
    const v8i B = (v8i){(int)b0.x, (int)b0.y, (int)b0.z, (int)b0.w, (int)b1.x, (int)b1.y, (int)b1.z, (int)b1.w};
    o[d0] = __builtin_amdgcn_mfma_scale_f32_32x32x64_f8f6f4(pa, B, o[d0], 0, 0, 0, 0x7F7F7F7F, 0, 0x7F7F7F7F); }
}
__device__ __forceinline__ v8i lds32(const char* p0, const char* p1) { const v4u a = *reinterpret_cast<const v4u*>(p0), b = *reinterpret_cast<const v4u*>(p1);
  return (v8i){(int)a.x, (int)a.y, (int)a.z, (int)a.w, (int)b.x, (int)b.y, (int)b.z, (int)b.w}; }
#define MF8(A, B, C, SB) ((XV == 3 || XV == 4 || XV == 5 || XV == 9) ? (C) : __builtin_amdgcn_mfma_scale_f32_32x32x64_f8f6f4(A, B, C, 0, 0, 0, 0x7F7F7F7F, 0, SB))
#define EX4(P, m) exp4<XV>(P[4 * (m)], P[4 * (m) + 1], P[4 * (m) + 2], P[4 * (m) + 3])
template <int XV = 0>
__device__ __forceinline__ void tile_step(f32x16& pN0, f32x16& pN1, const f32x16& pP1, const v4i& ploP, v4i& ploN, f32x16* o, f32x16& lacc,
                                          const char* Ks, const char* Vs, const v8i* q8, int r32, int hi, const f32x16& Z) {
  const int one = 0x38383838; const v8i ONES = (v8i){one, one, one, one, one, one, one, one};
  v4i phi;
  const v8i A00 = lds32(Ks + K8SW(r32, 2 * hi), Ks + K8SW(r32, 2 * hi + 1)), A10 = lds32(Ks + K8SW(32 + r32, 2 * hi), Ks + K8SW(32 + r32, 2 * hi + 1));
  const v8i A01 = lds32(Ks + K8SW(r32, 4 + 2 * hi), Ks + K8SW(r32, 4 + 2 * hi + 1)), A11 = lds32(Ks + K8SW(32 + r32, 4 + 2 * hi), Ks + K8SW(32 + r32, 4 + 2 * hi + 1));
  phi[0] = EXC4(pP1, 0, 0); SBAR();
  pN0 = MF8(A00, q8[0], Z, 0x7C7C7C7C);   SBAR(); const v8i V0 = lds32(Vs + V8SW(r32, 2 * hi), Vs + V8SW(r32, 2 * hi + 1));           phi[1] = EXC4(pP1, 1, 0); SBAR();
  pN0 = MF8(A01, q8[1], pN0, 0x7C7C7C7C); SBAR(); const v8i V1 = lds32(Vs + V8SW(32 + r32, 2 * hi), Vs + V8SW(32 + r32, 2 * hi + 1)); phi[2] = EXC4(pP1, 2, 0); SBAR();
  pN1 = MF8(A10, q8[0], Z, 0x7C7C7C7C);   SBAR(); const v8i V2 = lds32(Vs + V8SW(64 + r32, 2 * hi), Vs + V8SW(64 + r32, 2 * hi + 1)); phi[3] = EXC4(pP1, 3, 0); SBAR();
  pN1 = MF8(A11, q8[1], pN1, 0x7C7C7C7C); SBAR(); const v8i V3 = lds32(Vs + V8SW(96 + r32, 2 * hi), Vs + V8SW(96 + r32, 2 * hi + 1)); SBAR();
  const v8i pa = (v8i){ploP[0], ploP[1], ploP[2], ploP[3], phi[0], phi[1], phi[2], phi[3]};
  lacc = MF8(pa, ONES, lacc, 0x7F7F7F7F); SBAR(); ploN[0] = EXC4(pN0, 0, 1); SBAR();
  o[0] = MF8(pa, V0, o[0], 0x7F7F7F7F);   SBAR(); ploN[1] = EXC4(pN0, 1, 0); SBAR();
  o[1] = MF8(pa, V1, o[1], 0x7F7F7F7F);   SBAR(); ploN[2] = EXC4(pN0, 2, 0); SBAR();
  o[2] = MF8(pa, V2, o[2], 0x7F7F7F7F);   SBAR(); ploN[3] = EXC4(pN0, 3, 0); SBAR();
  o[3] = MF8(pa, V3, o[3], 0x7F7F7F7F);   SBAR();
}
template <int XV = 0>
__device__ __forceinline__ void attn_dense_body(const unsigned char* __restrict__ Q8, const unsigned char* __restrict__ K8, const unsigned char* __restrict__ VT, int vt_ld, bf16* __restrict__ Ob, int seq, char* lds, int wave_id, float nb) {
  const int tid = opaque_tid(wave_id), wid = tid >> 6, lane = tid & 63, r32 = lane & 31, hi = lane >> 5;
  char* V_lds = lds; char* K_lds = lds + 4 * SHM_V;
  f32x16 lacc = {}; f32x16 o[4] = {}; v8i qr[2]; f32x16 NBV;
#pragma unroll
  for (int i = 0; i < 16; ++i) NBV[i] = nb;
  { const unsigned char* Qw = Q8 + (long)(wid * QBLK + r32) * 1024 + hi * 32;
#pragma unroll
    for (int s2 = 0; s2 < 2; ++s2) { const v4u a = *reinterpret_cast<const v4u*>(Qw + 64 * s2), b = *reinterpret_cast<const v4u*>(Qw + 64 * s2 + 16);
      qr[s2] = (v8i){(int)a.x, (int)a.y, (int)a.z, (int)a.w, (int)b.x, (int)b.y, (int)b.z, (int)b.w}; } }
  struct { v4u vs, ks; } sr_[1];
  const int kkey = tid >> 3, kch = tid & 7; const unsigned koff = (unsigned)(kkey * 256 + kch * 16); const int kst = K8SW(kkey, kch);
  const int vd = tid >> 2, vc = tid & 3; const unsigned voff = (unsigned)(vd * vt_ld + vc * 16); const int vst = V8SW(vd, vc);
#define SLOAD(i, k0) do { if (XV >= 7) break; sr_[i].vs = *reinterpret_cast<const v4u*>((const char*)VT + (size_t)(k0) + voff); \
    sr_[i].ks = *reinterpret_cast<const v4u*>((const char*)K8 + (size_t)(k0) * 256 + koff); } while (0)
#define SWRITE(b, i) do { *(v4u*)(V_lds + (b) * SHM_V + vst) = sr_[i].vs; *(v4u*)(K_lds + (b) * SHM_K + kst) = sr_[i].ks; } while (0)
#define SWAIT() asm volatile("s_waitcnt vmcnt(0)" ::: "memory")
#define TBAR() asm volatile("s_waitcnt lgkmcnt(0)\n\ts_barrier" ::: "memory")
  f32x16 pA0, pA1, pB0, pB1; v8i pa; v4i plA, plB; const int NT = seq / KVBLK;
  SLOAD(0, 0); SWAIT(); SWRITE(0, 0); SLOAD(0, KVBLK); TBAR();
  qkt(pA0, pA1, K_lds, qr, r32, hi, NBV); partialSM(pA0, nb, plA);
  SWAIT(); SWRITE(1, 0); SLOAD(0, 2 * KVBLK); TBAR();
#define STEP_IO(t, SW) do { SWAIT(); SWRITE(SW, 0); { const int tn = (t) + 2 < NT ? (t) + 2 : NT - 1; SLOAD(0, tn * KVBLK); } SBAR(); } while (0)
#define STEP_B(t, SK, SV, SW) do { STEP_IO(t, SW); tile_step<XV>(pB0, pB1, pA1, plA, plB, o, lacc, K_lds + (SK) * SHM_K, V_lds + (SV) * SHM_V, qr, r32, hi, NBV); TBAR(); } while (0)
#define STEP_A(t, SK, SV, SW) do { STEP_IO(t, SW); tile_step<XV>(pA0, pA1, pB1, plB, plA, o, lacc, K_lds + (SK) * SHM_K, V_lds + (SV) * SHM_V, qr, r32, hi, NBV); TBAR(); } while (0)
  int j = 1;
  for (; j + 5 < NT; j += 4) { STEP_B(j, 1, 0, 2); STEP_A(j + 1, 2, 1, 3); STEP_B(j + 2, 3, 2, 0); STEP_A(j + 3, 0, 3, 1); }
  STEP_B(j, 1, 0, 2); STEP_A(j + 1, 2, 1, 3);
  SBAR(); qkt(pB0, pB1, K_lds + 3 * SHM_K, qr, r32, hi, NBV);
  finishSM(pA1, nb, plA, pa); SBAR();
  pv_d0(o, lacc, V_lds + 2 * SHM_V, pa, r32, hi); partialSM(pB0, nb, plB);
  finishSM(pB1, nb, plB, pa); SBAR();
  pv_d0(o, lacc, V_lds + 3 * SHM_V, pa, r32, hi);
  { const int ln2 = opaque_tid(wave_id) & 63, r32e = ln2 & 31, hie = ln2 >> 5;
    bf16* Ow = Ob + (long)(wid * QBLK) * LDO;
#pragma unroll
    for (int r = 0; r < 16; ++r) { const int orow = crow(r, hie); const float rl = __builtin_amdgcn_rcpf(lacc[r]);
      for (int d0 = 0; d0 < 4; ++d0) Ow[(long)orow * LDO + d0 * 32 + r32e] = (bf16)f2bf(o[d0][r] * rl); } }
  __syncthreads();
#undef SLOAD
#undef TBAR
#undef STEP_IO
#undef STEP_A
#undef STEP_B
#undef SWRITE
#undef SWAIT
}
#undef K8SW
#undef V8SW
}
constexpr int NWAVES = 8, NTHREADS = 512;
struct Args { const float* in[36]; float* out; unsigned char* ws; int ph_lo, ph_hi; };
enum InIdx { I_X = 0, I_C, I_CTX, I_CCTX, I_ADAW, I_ADAB, I_N1G, I_N2G, I_WOUT, I_RW, I_RB, I_EW1, I_EB1, I_EW2, I_EB2, I_AWIN, I_AQG, I_AKG,
             I_GWIN, I_GVG, I_GWS, I_GBS, I_HWIN, I_HCW, I_HCB, I_FW1, I_FB1, I_FW2, I_FB2, I_FW3, I_FB3, I_FW4, I_FB4, I_FREQ, I_HD, I_FG };
struct Frame {
    LAS unsigned char* lds; volatile LAS unsigned* MISC; gu32* ctl;
    int tid, lane, wave, G, bx;
    float* out; unsigned char* ws;
};
template <class T> __device__ __forceinline__ T* launder(T* p) { unsigned long long v = (unsigned long long)p; asm volatile("" : "+s"(v)); return (T*)(GAS T*)v; }
constexpr int MW_PTRS = 640;
__device__ __forceinline__ const float* pin_load(const Frame& F, int i) {
    const unsigned lo = __builtin_amdgcn_readfirstlane(F.MISC[MW_PTRS + 2 * i]), hi = __builtin_amdgcn_readfirstlane(F.MISC[MW_PTRS + 2 * i + 1]);
    return (const float*)(GAS const float*)(((unsigned long long)hi << 32) | lo);
}
#define PIN(F, i) pin_load(F, i)
__device__ __forceinline__ Frame phase_frame(const Frame& F0) {
    Frame F = F0; F.tid = opaque_tid(F0.wave); F.lane = F.tid & 63; F.wave = F0.wave;
    F.ws = launder(F0.ws); F.out = launder(F0.out); F.ctl = (gu32*)(F.ws + WS_CTL);
    { LAS unsigned char* l = F0.lds; asm volatile("" : "+s"(l)); F.lds = l; F.MISC = (volatile LAS unsigned*)(l + MISC_OFF); }
    return F;
}
constexpr int PH_PRO0 = 0, PH_PRO1 = 1, PH_L0 = 2, PH_PER_LAYER = 9, PH_FINAL = PH_L0 + NLAYER * PH_PER_LAYER, PH_COUNT = PH_FINAL + 1;
enum LPhase { LP_NORM1 = 0, LP_INPROJ, LP_MIX1, LP_MIX2, LP_MIX3, LP_OUTPROJ, LP_NORM2, LP_MOE1, LP_MOE2 };

struct TItem { const float* src; unsigned char* dst; int N; bool fp8; };
__device__ __forceinline__ TItem titem_decode(Frame& F, int it) {
    constexpr int R0 = 128 * 512, R1 = 128 * 256, R2 = 2 * 384, R3 = 512, R4 = 768;
    int r = it; TItem t;
    if (r < R0) { const int mi = r >> 9, q = r & 511, kb = q >> 5, nb = q & 31, n0 = nb * 64;
        const int d0 = n0 < 1024 ? 256 * (n0 >> 7) + (n0 & 127) : 256 * ((n0 - 1024) >> 7) + 128 + (n0 & 127);
        t.src = PIN(F, I_EW1) + (size_t)mi * 1024 * 2048 + (size_t)(kb * 64) * 2048 + n0; t.N = 2048; t.fp8 = true; t.dst = F.ws + WS_WE1 + (size_t)mi * 2048 * 1024 + (size_t)d0 * 1024 + kb * 64; return t; } r -= R0;
    if (r < R1) { const int mi = r >> 8, q = r & 255, kb = q >> 4, nb = q & 15;
        t.src = PIN(F, I_EW2) + (size_t)mi * 1024 * 1024 + (size_t)(kb * 64) * 1024 + nb * 64; t.N = 1024; t.fp8 = true; t.dst = F.ws + WS_WE2 + (size_t)mi * 1024 * 1024 + (size_t)(nb * 64) * 1024 + kb * 64; return t; } r -= R1;
    if (r < R2) { const int mi = r / 384, q = r % 384, kb = q / 24, nb = q % 24;
        t.src = PIN(F, I_AWIN) + (size_t)mi * 1024 * 1536 + (size_t)(kb * 64) * 1536 + nb * 64; t.N = 1536; t.fp8 = true; t.dst = F.ws + WS_WATT + (size_t)mi * 1536 * 1024 + (size_t)(nb * 64) * 1024 + kb * 64; return t; } r -= R2;
    if (r < R3) { const int kb = r >> 5, nb = r & 31;
        t.src = PIN(F, I_GWIN) + (size_t)(kb * 64) * 2048 + nb * 64; t.N = 2048; t.fp8 = false; t.dst = F.ws + WS_WGM + ((size_t)(nb * 64) * 1024 + kb * 64) * 2; return t; } r -= R3;
    if (r < R4) { const int kb = r / 48, nb = r % 48;
        t.src = PIN(F, I_HWIN) + (size_t)(kb * 64) * 3072 + nb * 64; t.N = 3072; t.fp8 = true; t.dst = F.ws + WS_WHY + (size_t)(nb * 64) * 1024 + kb * 64; return t; } r -= R4;
    { const int mi = r >> 8, q = r & 255, kb = q >> 4, nb = q & 15;
        t.src = PIN(F, I_WOUT) + (size_t)mi * 1024 * 1024 + (size_t)(kb * 64) * 1024 + nb * 64; t.N = 1024; t.fp8 = false; t.dst = F.ws + WS_WOUT + ((size_t)mi * 1024 * 1024 + (size_t)(nb * 64) * 1024 + kb * 64) * 2; return t; }
}
__device__ __forceinline__ void titem_load(const TItem& t, float (&v)[64], int lane) {
    const float* src = t.src + lane;
#pragma unroll
    for (int kk = 0; kk < 64; ++kk) v[kk] = src[(size_t)kk * t.N];
}
__device__ __forceinline__ void titem_finish(const TItem& t, const float (&v)[64], LAS float* scr, int lane) {
    constexpr int K = 1024;
#pragma unroll
    for (int kk = 0; kk < 64; ++kk) scr[kk * 65 + lane] = v[kk];
    LDS_WAIT(); asm volatile("" ::: "memory");
    if (!t.fp8) {
        const int c = lane & 7;
#pragma unroll
        for (int j = 0; j < 8; ++j) { const int n = (lane >> 3) + 8 * j; const LAS float* s = scr + (8 * c) * 65 + n;
            v4u o; o.x = pk2(s[0 * 65], s[1 * 65]); o.y = pk2(s[2 * 65], s[3 * 65]); o.z = pk2(s[4 * 65], s[5 * 65]); o.w = pk2(s[6 * 65], s[7 * 65]);
            *(GAS v4u*)(t.dst + ((size_t)n * K + 8 * c) * 2) = o; }
    } else {
        const int c = lane & 3;
#pragma unroll
        for (int j = 0; j < 4; ++j) { const int n = (lane >> 2) + 16 * j; const LAS float* s = scr + (16 * c) * 65 + n; unsigned w[4];
#pragma unroll
            for (int q = 0; q < 4; ++q) { unsigned x = 0; x = __builtin_amdgcn_cvt_pk_fp8_f32(32.0f * s[(4 * q) * 65], 32.0f * s[(4 * q + 1) * 65], x, false);
                x = __builtin_amdgcn_cvt_pk_fp8_f32(32.0f * s[(4 * q + 2) * 65], 32.0f * s[(4 * q + 3) * 65], x, true); w[q] = x; }
            *(GAS v4u*)(t.dst + (size_t)n * K + 16 * c) = (v4u){w[0], w[1], w[2], w[3]}; }
    }
    LDS_WAIT(); asm volatile("" ::: "memory");
}
__device__ __forceinline__ void pro0_transposes(Frame& F) {
    LAS float* scr = (LAS float*)(F.lds + F.wave * 16640);
    const int gw = F.bx * NWAVES + F.wave, NGW = F.G * NWAVES;
    constexpr int NITEMS = 128 * 512 + 128 * 256 + 2 * 384 + 512 + 768 + 4 * 256;
    float va[64], vb[64];
    int it = gw; if (it >= NITEMS) return;
    TItem ta = titem_decode(F, it), tb = ta; titem_load(ta, va, F.lane);
    for (;;) {
        const bool nb_ok = it + NGW < NITEMS; if (nb_ok) { tb = titem_decode(F, it + NGW); titem_load(tb, vb, F.lane); }
        titem_finish(ta, va, scr, F.lane);
        if (!nb_ok) break; it += NGW;
        const bool na_ok = it + NGW < NITEMS; if (na_ok) { ta = titem_decode(F, it + NGW); titem_load(ta, va, F.lane); }
        titem_finish(tb, vb, scr, F.lane);
        if (!na_ok) break; it += NGW;
    }
}
__device__ __forceinline__ void pro0_mod(Frame& F) {
    LAS float* sl = (LAS float*)F.lds;
    LAS float* red = (LAS float*)(F.lds + 65536);
    __syncthreads();
    for (int i = F.tid; i < 9 * 1024; i += NTHREADS) { const int r = i >> 10, k = i & 1023; const float v = r < 8 ? PIN(F, I_C)[r * 1024 + k] : PIN(F, I_CCTX)[k]; sl[i] = v / (1.0f + __expf(-v)); }
    __syncthreads();
    float* MOD = (float*)(F.ws + WS_MOD);
    for (int item = F.bx; item < NLAYER * 96; item += F.G) {
        const int l = item / 96, n0 = (item % 96) * 64;
        const float* W = PIN(F, I_ADAW) + (size_t)l * 1024 * 6144 + n0 + F.lane;
        float acc[9];
#pragma unroll
        for (int r = 0; r < 9; ++r) acc[r] = 0.f;
        const int kb = F.wave * 128;
#pragma unroll 16
        for (int k = 0; k < 128; ++k) { const float wv = W[(size_t)(kb + k) * 6144];
#pragma unroll
            for (int r = 0; r < 9; ++r) acc[r] += sl[r * 1024 + kb + k] * wv; }
#pragma unroll
        for (int r = 0; r < 9; ++r) red[(F.wave * 9 + r) * 64 + F.lane] = acc[r];
        __syncthreads();
        for (int i = F.tid; i < 9 * 64; i += NTHREADS) { const int r = i >> 6, n = i & 63; float s = 0.f;
#pragma unroll
            for (int w = 0; w < 8; ++w) s += red[(w * 9 + r) * 64 + n];
            MOD[((size_t)l * 9 + r) * 6144 + n0 + n] = s + PIN(F, I_ADAB)[l * 6144 + n0 + n]; }
        __syncthreads();
    }
}
__device__ __forceinline__ void pro0_filter_mlp(Frame& F) {
    const int j = F.lane, gw = F.bx * NWAVES + F.wave, NGW = F.G * NWAVES;
    LAS float* W1 = (LAS float*)F.lds; LAS float* W2 = W1 + FEMB * FH; LAS float* W3 = W2 + FH * FH;
    __syncthreads();
    for (int i = F.tid; i < FEMB * FH; i += NTHREADS) W1[i] = PIN(F, I_FW1)[i];
    for (int i = F.tid; i < FH * FH; i += NTHREADS) { W2[i] = PIN(F, I_FW2)[i]; W3[i] = PIN(F, I_FW3)[i]; }
    __syncthreads();
    const float b1 = PIN(F, I_FB1)[j], b2 = PIN(F, I_FB2)[j], b3 = PIN(F, I_FB3)[j], fr = PIN(F, I_FREQ)[j];
    for (int it = gw; it < SEQ + CL; it += NGW) {
        const bool lat = it < SEQ; const int t = lat ? it : it - SEQ; const float L = lat ? (float)SEQ : (float)CL;
        const float tl = (float)t / (L - 1.0f), w = (6.283185307179586f * (float)t) / L;
        float z;
        { const int band = (j - 1) & 15; const float f = 1e-4f + (float)band * ((15.0f - 1e-4f) / 15.0f); const float a = f * w;
          z = (j == 0) ? tl : (j <= 16 ? cosf(a) : -sinf(a)); }
        float s = b1;
#pragma unroll
        for (int i = 0; i < FEMB; ++i) s += __shfl(z, i) * W1[i * FH + j];
        const float a1 = sinf(fr * s);
        s = b2;
#pragma unroll 16
        for (int i = 0; i < FH; ++i) s += __shfl(a1, i) * W2[i * FH + j];
        const float a2 = sinf(fr * s);
        s = b3;
#pragma unroll 16
        for (int i = 0; i < FH; ++i) s += __shfl(a2, i) * W3[i * FH + j];
        const float a3 = sinf(fr * s);
        float* dst = lat ? (float*)(F.ws + WS_A3) + (size_t)t * FH : (float*)(F.ws + WS_A3C) + (size_t)t * FH;
        dst[j] = a3;
    }
    __syncthreads();
}

__device__ __forceinline__ f32x2 cmul(f32x2 a, f32x2 b) { return (f32x2){a.x * b.x - a.y * b.y, a.x * b.y + a.y * b.x}; }
__device__ __forceinline__ f32x2 cconj(f32x2 a) { return (f32x2){a.x, -a.y}; }
#define ZP(n) ((n) + ((n) >> 5))
constexpr int FFT_LDS_BYTES = (NFFT + NFFT / 32) * 8;
__device__ __forceinline__ void bfly_dif(f32x2& a0, f32x2& a1, f32x2& a2, f32x2& a3, f32x2 w) {
    const f32x2 t0 = a0 + a2, t1 = a0 - a2, t2 = a1 + a3, d = a1 - a3, t3 = (f32x2){d.y, -d.x};
    const f32x2 y0 = t0 + t2, y2 = t0 - t2, y1 = t1 + t3, y3 = t1 - t3, w2 = cmul(w, w), w3 = cmul(w2, w);
    a0 = y0; a1 = cmul(y2, w2); a2 = cmul(y1, w); a3 = cmul(y3, w3);
}
__device__ __forceinline__ void bfly_dit(f32x2& a0, f32x2& a1, f32x2& a2, f32x2& a3, f32x2 w) {
    const f32x2 w2 = cmul(w, w), w3 = cmul(w2, w), A1 = cmul(a1, w2), A2 = cmul(a2, w), A3 = cmul(a3, w3);
    const f32x2 u0 = a0 + A1, u1 = a0 - A1, u2 = A2 + A3, u3 = A2 - A3, iu3 = (f32x2){-u3.y, u3.x};
    a0 = u0 + u2; a1 = u1 + iu3; a2 = u0 - u2; a3 = u1 - iu3;
}
template <int LQ, bool INV> __device__ __forceinline__ void fft_r16(LAS f32x2* z, int tid) {
    constexpr int q16 = 1 << LQ; constexpr float inv_lb = 1.0f / (float)(16 * q16);
    constexpr float C1 = 0.92387953251128674f, S1 = 0.38268343236508977f, C2 = 0.70710678118654752f;
    asm volatile("" : "+v"(tid));
#pragma unroll 1
    for (int g = tid; g < NFFT / 16; g += NTHREADS) {
        const int j = g & (q16 - 1), base = ((g >> LQ) << (LQ + 4)) + j;
        f32x2 x[16];
#pragma unroll
        for (int m = 0; m < 16; ++m) x[m] = z[ZP(base + (m << LQ))];
        const float fr = (float)j * inv_lb; const float sn = __builtin_amdgcn_sinf(fr);
        const f32x2 w1 = (f32x2){__builtin_amdgcn_cosf(fr), INV ? sn : -sn};
        const float sg = INV ? 1.0f : -1.0f;
        const f32x2 wa0 = w1, wa1 = cmul(w1, (f32x2){C1, sg * S1}), wa2 = cmul(w1, (f32x2){C2, sg * C2}), wa3 = cmul(w1, (f32x2){S1, sg * C1});
        const f32x2 w2 = cmul(w1, w1), wb = cmul(w2, w2);
        if constexpr (!INV) {
            bfly_dif(x[0], x[4], x[8], x[12], wa0); bfly_dif(x[1], x[5], x[9], x[13], wa1); bfly_dif(x[2], x[6], x[10], x[14], wa2); bfly_dif(x[3], x[7], x[11], x[15], wa3);
#pragma unroll
            for (int a = 0; a < 4; ++a) bfly_dif(x[4 * a], x[4 * a + 1], x[4 * a + 2], x[4 * a + 3], wb);
        } else {
#pragma unroll
            for (int a = 0; a < 4; ++a) bfly_dit(x[4 * a], x[4 * a + 1], x[4 * a + 2], x[4 * a + 3], wb);
            bfly_dit(x[0], x[4], x[8], x[12], wa0); bfly_dit(x[1], x[5], x[9], x[13], wa1); bfly_dit(x[2], x[6], x[10], x[14], wa2); bfly_dit(x[3], x[7], x[11], x[15], wa3);
        }
#pragma unroll
        for (int m = 0; m < 16; ++m) z[ZP(base + (m << LQ))] = x[m];
    }
    __syncthreads();
}
template <bool INV> __device__ __forceinline__ void fft_r4_unit(LAS f32x2* z, int tid) {
    asm volatile("" : "+v"(tid));
#pragma unroll 2
    for (int bf = tid; bf < NFFT / 4; bf += NTHREADS) {
        const int base = 4 * bf; f32x2 a0 = z[ZP(base)], a1 = z[ZP(base + 1)], a2 = z[ZP(base + 2)], a3 = z[ZP(base + 3)];
        if constexpr (!INV) { const f32x2 t0 = a0 + a2, t1 = a0 - a2, t2 = a1 + a3, d = a1 - a3, t3 = (f32x2){d.y, -d.x};
            z[ZP(base)] = t0 + t2; z[ZP(base + 1)] = t0 - t2; z[ZP(base + 2)] = t1 + t3; z[ZP(base + 3)] = t1 - t3; }
        else { const f32x2 u0 = a0 + a1, u1 = a0 - a1, u2 = a2 + a3, u3 = a2 - a3, iu3 = (f32x2){-u3.y, u3.x};
            z[ZP(base)] = u0 + u2; z[ZP(base + 1)] = u1 + iu3; z[ZP(base + 2)] = u0 - u2; z[ZP(base + 3)] = u1 - iu3; }
    }
    __syncthreads();
}
__device__ __forceinline__ void fft16k_dif(LAS f32x2* z, int tid) { fft_r16<10, false>(z, tid); fft_r16<6, false>(z, tid); fft_r16<2, false>(z, tid); fft_r4_unit<false>(z, tid); }
__device__ __forceinline__ void fft16k_dit_inv(LAS f32x2* z, int tid) { fft_r4_unit<true>(z, tid); fft_r16<2, true>(z, tid); fft_r16<6, true>(z, tid); fft_r16<10, true>(z, tid); }
constexpr int KF_LD = 8256;
__device__ __forceinline__ int rev14(int p) { return (int)(__brev((unsigned)p) >> 18); }
__device__ __forceinline__ float hy_delta(int c) { const float mn = -3.0701134573253945f, mx = -15.350567286626973f; return fabsf(mn + (mx - mn) * ((float)c / 1023.0f)); }

__device__ __forceinline__ void pro1_router_split(Frame& F) {
    const float* MOD = (const float*)(F.ws + WS_MOD); unsigned char* RW3 = F.ws + WS_RW3;
    for (int ent = F.bx * NTHREADS + F.tid; ent < NLAYER * 9 * 8 * 8 * 64; ent += F.G * NTHREADS) {
        const int lane = ent & 63, kb = (ent >> 6) & 7, w = (ent >> 9) & 7, lb = ent >> 12, l = lb / 9;
        const int k0 = w * 128 + 16 * kb + 8 * (lane >> 5), e = lane & 31;
        const float* gn = PIN(F, I_N2G) + l * D; const float* sc = MOD + (size_t)lb * 6144 + 4 * 1024; const float* rw = PIN(F, I_RW) + (size_t)l * D * NE;
        unsigned ph[4], pm[4], pl[4];
#pragma unroll
        for (int j2 = 0; j2 < 4; ++j2) { const int k = k0 + 2 * j2; const float v0 = gn[k] * (1.0f + sc[k]) * rw[(size_t)k * NE + e], v1 = gn[k + 1] * (1.0f + sc[k + 1]) * rw[(size_t)(k + 1) * NE + e];
            const unsigned h = cvt_pk_bf16(v0, v1); const float r0 = v0 - __uint_as_float(h << 16), r1 = v1 - __uint_as_float(h & 0xffff0000u);
            const unsigned m = cvt_pk_bf16(r0, r1); const float s0 = r0 - __uint_as_float(m << 16), s1 = r1 - __uint_as_float(m & 0xffff0000u);
            ph[j2] = h; pm[j2] = m; pl[j2] = cvt_pk_bf16(s0, s1); }
        v4u* dst = (v4u*)(RW3 + (size_t)(ent >> 6) * 3 * 1024) + lane;
        dst[0] = (v4u){ph[0], ph[1], ph[2], ph[3]}; dst[64] = (v4u){pm[0], pm[1], pm[2], pm[3]}; dst[128] = (v4u){pl[0], pl[1], pl[2], pl[3]};
    }
}
__device__ __forceinline__ void pro1_filters(Frame& F) {
    if (F.bx < NLAYER * 9) {
        const int lb = F.bx, l = lb / 9, e = F.lane & 31, hf = F.lane >> 5; const float* sh = (const float*)(F.ws + WS_MOD) + (size_t)lb * 6144 + 3 * 1024; const float* rw = PIN(F, I_RW) + (size_t)l * D * NE;
        LAS float* red = (LAS float*)F.lds; const int k0 = F.wave * 128 + hf * 64; float acc = 0.f;
#pragma unroll 8
        for (int k = k0; k < k0 + 64; ++k) acc += sh[k] * rw[(size_t)k * NE + e];
        acc += shx(acc, 32, F.lane); if (F.lane < 32) red[F.wave * 32 + e] = acc;
        __syncthreads();
        if (F.tid < 32) { float s = PIN(F, I_RB)[l * NE + F.tid];
#pragma unroll
            for (int w = 0; w < 8; ++w) s += red[w * 32 + F.tid];
            ((float*)(F.ws + WS_RC))[lb * NE + F.tid] = s; }
    }
    LAS f32x2* z = (LAS f32x2*)F.lds;
    LAS float* wl = (LAS float*)(F.lds + AUX_OFF + 8192);
    const float* a3 = (const float*)(F.ws + WS_A3); const float* a3c = (const float*)(F.ws + WS_A3C);
    f32x2* KF = (f32x2*)(F.ws + WS_KF); float* FCT = (float*)(F.ws + WS_FCT);
    for (int u = F.bx; u < 512; u += F.G) {
        const int ca = 2 * u, cb = 2 * u + 1;
        __syncthreads();
        if (F.tid < 256) { const int which = F.tid >> 6, m = F.tid & 63; const int col = (which & 1 ? cb : ca) + (which >> 1) * 1024; wl[which * 64 + m] = PIN(F, I_FW4)[m * 2048 + col]; }
        if (F.tid < 4) { const int col = (F.tid & 1 ? cb : ca) + (F.tid >> 1) * 1024; wl[256 + F.tid] = PIN(F, I_FB4)[col]; }
        __syncthreads();
        const float da = hy_delta(ca), db = hy_delta(cb);
        const float dska = PIN(F, I_HD)[ca], dskb = PIN(F, I_HD)[cb];
        for (int t = F.tid; t < SEQ; t += NTHREADS) {
            const f32x4* ar = (const f32x4*)(a3 + (size_t)t * FH); float s0 = wl[256], s1 = wl[257], s2 = wl[258], s3 = wl[259];
#pragma unroll 8
            for (int m4 = 0; m4 < 16; ++m4) { const f32x4 a = ar[m4];
                const f32x4 w0 = *(const LAS f32x4*)(wl + 4 * m4), w1 = *(const LAS f32x4*)(wl + 64 + 4 * m4), w2 = *(const LAS f32x4*)(wl + 128 + 4 * m4), w3 = *(const LAS f32x4*)(wl + 192 + 4 * m4);
                s0 += (a.x * w0.x + a.y * w0.y) + (a.z * w0.z + a.w * w0.w); s1 += (a.x * w1.x + a.y * w1.y) + (a.z * w1.z + a.w * w1.w);
                s2 += (a.x * w2.x + a.y * w2.y) + (a.z * w2.z + a.w * w2.w); s3 += (a.x * w3.x + a.y * w3.y) + (a.z * w3.z + a.w * w3.w); }
            const float tl = (float)t / (float)(SEQ - 1); const float wa = __expf(-tl * da), wb = __expf(-tl * db);
            z[ZP(t)] = (f32x2){s0 * wa + (t == 0 ? dska : 0.f), s1 * wb + (t == 0 ? dskb : 0.f)};
            if (t == 0) z[ZP(SEQ)] = (f32x2){0.f, 0.f}; else z[ZP(NFFT - t)] = (f32x2){s2 * wa, s3 * wb};
        }
        for (int i = F.tid; i < 511; i += NTHREADS) {
            const int d = i - 255, t = d < 0 ? -d : d; const int o = d < 0 ? 2 : 0;
            const f32x4* ar = (const f32x4*)(a3c + (size_t)t * FH); float sa = wl[256 + o], sb = wl[257 + o];
            f32x4 av[16];
#pragma unroll
            for (int m4 = 0; m4 < 16; ++m4) av[m4] = ar[m4];
            __builtin_amdgcn_sched_barrier(0);
#pragma unroll
            for (int m4 = 0; m4 < 16; ++m4) {
#pragma unroll
                for (int i2 = 0; i2 < 4; ++i2) { const int m = m4 * 4 + i2; sa += av[m4][i2] * wl[o * 64 + m]; sb += av[m4][i2] * wl[(o + 1) * 64 + m]; }
                if ((m4 & 3) == 3) __builtin_amdgcn_sched_barrier(0); }
            const float tl = (float)t / (float)(CL - 1);
            FCT[(size_t)ca * 512 + d + 256] = sa * __expf(-tl * da) + (d == 0 ? dska : 0.f); FCT[(size_t)cb * 512 + d + 256] = sb * __expf(-tl * db) + (d == 0 ? dskb : 0.f);
        }
        __syncthreads();
        fft16k_dif(z, F.tid);
        for (int k = F.tid; k <= NFFT / 2; k += NTHREADS) {
            const int p = rev14(k), p2 = rev14((NFFT - k) & (NFFT - 1)); const f32x2 a = z[ZP(p)], b = z[ZP(p2)];
            KF[(size_t)ca * KF_LD + k] = (f32x2){0.5f * (a.x + b.x), 0.5f * (a.y - b.y)};
            KF[(size_t)cb * KF_LD + k] = (f32x2){0.5f * (a.y + b.y), -0.5f * (a.x - b.x)};
        }
    }
    __syncthreads();
}

__device__ __forceinline__ void hyena_conv_phase(Frame& F) {
    LAS f32x2* z = (LAS f32x2*)F.lds;
    LAS float* aux = (LAS float*)(F.lds + AUX_OFF + 8192);
    const float* VT = (const float*)(F.ws + WS_VT); const float* VTC = (const float*)(F.ws + WS_VTC); float* CT = (float*)(F.ws + WS_CT); float* CTC = (float*)(F.ws + WS_CTC);
    const f32x2* KF = (const f32x2*)(F.ws + WS_KF); const float* FCT = (const float*)(F.ws + WS_FCT);
    v4u ina[2], inb[2];
#define HC_LOADIN(u_, t_) do { const int b_ = (u_) >> 9, c_ = 2 * ((u_) & 511); const v4u* va_ = (const v4u*)((const bf16*)VT + ((size_t)b_ * 1024 + c_) * SEQ + 16 * (t_)); \
        ina[0] = va_[0]; ina[1] = va_[1]; inb[0] = va_[SEQ / 8]; inb[1] = va_[SEQ / 8 + 1]; } while (0)
    if (F.bx < NB * 512) HC_LOADIN(F.bx, F.tid);
    for (int u = F.bx; u < NB * 512; u += F.G) {
        const int b = u >> 9, cp = u & 511, ca = 2 * cp, cb = ca + 1;
        int tq = F.tid; asm volatile("" : "+v"(tq));
        __syncthreads();
        { const int n0 = 16 * tq;
#pragma unroll
          for (int i = 0; i < 4; ++i) { const unsigned a0 = ina[i >> 1][2 * (i & 1)], a1 = ina[i >> 1][2 * (i & 1) + 1], b0 = inb[i >> 1][2 * (i & 1)], b1 = inb[i >> 1][2 * (i & 1) + 1];
              z[ZP(n0 + 4 * i)] = (f32x2){bflo(a0), bflo(b0)}; z[ZP(n0 + 4 * i + 1)] = (f32x2){bfhi(a0), bfhi(b0)}; z[ZP(n0 + 4 * i + 2)] = (f32x2){bflo(a1), bflo(b1)}; z[ZP(n0 + 4 * i + 3)] = (f32x2){bfhi(a1), bfhi(b1)};
#pragma unroll
              for (int j = 0; j < 4; ++j) z[ZP(SEQ + n0 + 4 * i + j)] = (f32x2){0.f, 0.f}; } }
        f32x4 ka[8], kb[8]; f32x2 kaN, kbN;
        { const f32x4* pa = (const f32x4*)(KF + (size_t)ca * KF_LD + 16 * tq); const f32x4* pb = (const f32x4*)(KF + (size_t)cb * KF_LD + 16 * tq);
#pragma unroll
          for (int i = 0; i < 8; ++i) { ka[i] = pa[i]; kb[i] = pb[i]; }
          kaN = KF[(size_t)ca * KF_LD + NFFT / 2]; kbN = KF[(size_t)cb * KF_LD + NFFT / 2]; }
        { const int h = tq >> 8, t = tq & 255;
          const float* vc = VTC + ((size_t)b * 1024 + ca + h) * CL;
          aux[h * 256 + t] = vc[t]; aux[512 + h * 520 + 1 + t] = FCT[(size_t)(ca + h) * 512 + t]; aux[512 + h * 520 + 257 + t] = FCT[(size_t)(ca + h) * 512 + 256 + t];
          __syncthreads();
          if (tq < 256) { const int hh = tq >> 7, pp = tq & 127; const LAS float* vv = aux + hh * 256; const LAS float* kk = aux + 512 + hh * 520 + 256 + 2 * pp;
              float y0 = 0.f, y1 = 0.f, lop = kk[2];
#pragma unroll 8
              for (int q = 0; q < CL / 2; ++q) { const f32x2 v = *(const LAS f32x2*)(vv + 2 * q), kq = *(const LAS f32x2*)(kk - 2 * q);
                  y0 += v.x * kq.y + v.y * kq.x; y1 += v.x * lop + v.y * kq.y; lop = kq.x; }
              *(f32x2*)(CTC + ((size_t)b * 1024 + ca + hh) * CL + 2 * pp) = (f32x2){y0, y1}; } }
        fft16k_dif(z, F.tid);
        int tpw = tq; asm volatile("" : "+v"(tpw));
#define HC_PW(k_, Ka_, Kb_) do { const int p = rev14(k_), p2 = rev14((NFFT - (k_)) & (NFFT - 1)); const f32x2 a = z[ZP(p)], b2 = z[ZP(p2)]; \
            const f32x2 Va = (f32x2){0.5f * (a.x + b2.x), 0.5f * (a.y - b2.y)}, Vb = (f32x2){0.5f * (a.y + b2.y), -0.5f * (a.x - b2.x)}; \
            const f32x2 ya = cmul(Va, Ka_), yb = cmul(Vb, Kb_); \
            z[ZP(p)] = (f32x2){ya.x - yb.y, ya.y + yb.x}; z[ZP(p2)] = (f32x2){ya.x + yb.y, -ya.y + yb.x}; } while (0)
#pragma unroll
        for (int i = 0; i < 8; ++i) { const int k = 16 * tpw + 2 * i;
            HC_PW(k, ((f32x2){ka[i].x, ka[i].y}), ((f32x2){kb[i].x, kb[i].y})); HC_PW(k + 1, ((f32x2){ka[i].z, ka[i].w}), ((f32x2){kb[i].z, kb[i].w}));
            asm volatile("" ::: "memory"); }
        if (tpw == 0) HC_PW(NFFT / 2, kaN, kbN);
#undef HC_PW
        __syncthreads();
        if (u + F.G < NB * 512) HC_LOADIN(u + F.G, tq);
        fft16k_dit_inv(z, F.tid);
        { int to = tq; asm volatile("" : "+v"(to)); const float sc = 1.0f / (float)NFFT; const int n0 = 16 * to;
          v4u* oa = (v4u*)((bf16*)CT + ((size_t)b * 1024 + ca) * SEQ + n0);
#pragma unroll
          for (int h2 = 0; h2 < 2; ++h2) { f32x2 w[8];
#pragma unroll
              for (int j = 0; j < 8; ++j) w[j] = z[ZP(n0 + 8 * h2 + j)];
              oa[h2] = (v4u){cvt_pk_bf16(w[0].x * sc, w[1].x * sc), cvt_pk_bf16(w[2].x * sc, w[3].x * sc), cvt_pk_bf16(w[4].x * sc, w[5].x * sc), cvt_pk_bf16(w[6].x * sc, w[7].x * sc)};
              oa[SEQ / 8 + h2] = (v4u){cvt_pk_bf16(w[0].y * sc, w[1].y * sc), cvt_pk_bf16(w[2].y * sc, w[3].y * sc), cvt_pk_bf16(w[4].y * sc, w[5].y * sc), cvt_pk_bf16(w[6].y * sc, w[7].y * sc)}; } }
    }
    __syncthreads();
#undef HC_LOADIN
}
constexpr int MW_CUMBLK = 16, MW_CNT = 64, MW_SELE = 128, MW_SELV = 256, MW_LRANK = 384, MW_LBASE = 512;
__device__ __forceinline__ void moe_tables(Frame& F, int layer) {
    __syncthreads();
    if (F.tid < NE) F.MISC[MW_CNT + F.tid] = __hip_atomic_load(F.ctl + CW_CNT + layer * NE + F.tid, RLX_AGENT);
    __syncthreads();
    if (F.tid < 64) {
        const unsigned v = F.tid < NE ? (F.MISC[MW_CNT + (F.tid & 31)] + 255u) >> 8 : 0u; unsigned s = v;
#pragma unroll
        for (int d = 1; d < 32; d <<= 1) { const unsigned t = (unsigned)__builtin_amdgcn_ds_bpermute(((F.tid - d) & 63) * 4, (int)s); if ((F.tid & 63) >= d) s += t; }
        if (F.tid < NE) F.MISC[MW_CUMBLK + F.tid] = s - v;
        if (F.tid == NE - 1) F.MISC[MW_CUMBLK + NE] = s; }
    __syncthreads();
}

template <int MODE> __device__ __forceinline__ void rowpass(Frame& F, int layer, bool real = true, bool h8 = false) {
    const bool combine = (MODE == 0 && layer > 0) || MODE == 2;
    const int nrows = MODE == 2 ? ML : MT;
    const int cl = MODE == 2 ? NLAYER - 1 : layer - 1;
    const bool from_input = (MODE == 0 && layer == 0);
    const float* XLs = PIN(F, I_X); const float* XCs = PIN(F, I_CTX);
    bf16* XB = (bf16*)(F.ws + WS_XB); bf16* XBd = real ? XB : (bf16*)(F.ws + WS_P);
    const float* MOD = (const float*)(F.ws + WS_MOD);
    bf16* H = (bf16*)(F.ws + WS_H); unsigned char* H8 = (unsigned char*)(F.ws + WS_H8); const unsigned char* YM = (const unsigned char*)(F.ws + WS_YM);
    const int* TE = (const int*)(F.ws + WS_TE); const int* TR = (const int*)(F.ws + WS_TR); const float* TG = (const float*)(F.ws + WS_TG);
    const float* gnorm = MODE == 0 ? PIN(F, I_N1G) + layer * D : PIN(F, I_FG);
    if (combine) moe_tables(F, cl);
    f32x4 gn[4];
#pragma unroll
    for (int j = 0; j < 4; ++j) gn[j] = ((const f32x4*)gnorm)[F.lane + 64 * j];
    const int ntiles = nrows / 32;
    i32x4 nte[4], ntr[4]; f32x4 ntg[4];
#define RP_TABLES(tile_) do { const size_t rb_ = (size_t)((tile_) * 32 + F.wave * 4) * 4; \
        _Pragma("unroll") for (int q = 0; q < 4; ++q) { nte[q] = *(const i32x4*)(TE + rb_ + 4 * q); ntr[q] = *(const i32x4*)(TR + rb_ + 4 * q); ntg[q] = *(const f32x4*)(TG + rb_ + 4 * q); } } while (0)
    if (combine && F.bx < ntiles) RP_TABLES(F.bx);
    for (int tile = F.bx; tile < ntiles; tile += F.G) {
        const int rbase = tile * 32 + F.wave * 4; const bool lat = rbase < ML; const int bidx = lat ? (rbase >> 13) : 8;
        const float* g2 = MOD + ((size_t)(combine ? cl : 0) * 9 + bidx) * 6144 + 5 * 1024;
        const float* mb = MOD + ((size_t)layer * 9 + bidx) * 6144;
        int rid[4][4]; float gkk[4][4];
        if (combine) {
#pragma unroll
            for (int q = 0; q < 4; ++q)
#pragma unroll
                for (int k = 0; k < 4; ++k) { rid[q][k] = 256 * (int)F.MISC[MW_CUMBLK + nte[q][k]] + ntr[q][k]; gkk[q][k] = ntg[q][k]; }
            if (tile + F.G < ntiles) RP_TABLES(tile + F.G);
        }
#pragma unroll 1
        for (int pr = 0; pr < 2; ++pr) {
            size_t xo[2]; f32x4 v[2][4]; int rowid[2][4]; float gk[2][4];
#pragma unroll
            for (int u = 0; u < 2; ++u) { const int r = rbase + 2 * pr + u; xo[u] = (size_t)r * D;
                if (combine) {
#pragma unroll
                    for (int k = 0; k < 4; ++k) { rowid[u][k] = pr ? rid[2 + u][k] : rid[u][k]; gk[u][k] = pr ? gkk[2 + u][k] : gkk[u][k]; } }
                if (from_input) { const f32x4* xs = (const f32x4*)(lat ? XLs + xo[u] : XCs + (xo[u] - (size_t)ML * D));
#pragma unroll
                    for (int j = 0; j < 4; ++j) v[u][j] = xs[F.lane + 64 * j]; }
                else { const v2u* xs = (const v2u*)(XB + xo[u]);
#pragma unroll
                    for (int j = 0; j < 4; ++j) v[u][j] = bf4_f32(xs[F.lane + 64 * j]); } }
            if (combine) {
                unsigned w[2][4][4];
#pragma unroll
                for (int u = 0; u < 2; ++u)
#pragma unroll
                    for (int k = 0; k < 4; ++k) { const unsigned* yr = (const unsigned*)(YM + (size_t)rowid[u][k] * D);
#pragma unroll
                        for (int j = 0; j < 4; ++j) w[u][k][j] = yr[F.lane + 64 * j]; }
#pragma unroll
                for (int u = 0; u < 2; ++u) {
#pragma unroll
                    for (int j = 0; j < 4; ++j) { f32x4 a = (f32x4){0.f, 0.f, 0.f, 0.f};
#pragma unroll
                        for (int k = 0; k < 4; ++k) { const f32x2 lo = __builtin_amdgcn_cvt_pk_f32_fp8(w[u][k][j], false), hi2 = __builtin_amdgcn_cvt_pk_f32_fp8(w[u][k][j], true); a += gk[u][k] * (f32x4){lo.x, lo.y, hi2.x, hi2.y}; }
                        v[u][j] += ((const f32x4*)g2)[F.lane + 64 * j] * a; }
                    if (MODE == 0) { v2u* xd = (v2u*)(XBd + xo[u]);
#pragma unroll
                        for (int j = 0; j < 4; ++j) { v2u o; o.x = cvt_pk_bf16(v[u][j].x, v[u][j].y); o.y = cvt_pk_bf16(v[u][j].z, v[u][j].w); xd[F.lane + 64 * j] = o; } } }
            }
            if (from_input) {
#pragma unroll
                for (int u = 0; u < 2; ++u) { v2u* xd = (v2u*)(XBd + xo[u]);
#pragma unroll
                    for (int j = 0; j < 4; ++j) { v2u o; o.x = cvt_pk_bf16(v[u][j].x, v[u][j].y); o.y = cvt_pk_bf16(v[u][j].z, v[u][j].w); xd[F.lane + 64 * j] = o; } } }
#pragma unroll
            for (int u = 0; u < 2; ++u) { const int r = rbase + 2 * pr + u;
                float ss = 0.f;
#pragma unroll
                for (int j = 0; j < 4; ++j) ss += (v[u][j].x * v[u][j].x + v[u][j].y * v[u][j].y) + (v[u][j].z * v[u][j].z + v[u][j].w * v[u][j].w);
                const float rstd = 1.0f / sqrtf(wave_sum(ss, F.lane) * (1.0f / D) + EPS);
                if (MODE == 2) { f32x4* od = (f32x4*)((real ? F.out : (float*)(F.ws + WS_P)) + xo[u]);
#pragma unroll
                    for (int j = 0; j < 4; ++j) od[F.lane + 64 * j] = v[u][j] * rstd * gn[j]; }
                else { v2u* hd = (v2u*)(H + (size_t)r * D); unsigned* hd8 = (unsigned*)(H8 + (size_t)r * D);
#pragma unroll
                    for (int j = 0; j < 4; ++j) { const f32x4 sh = ((const f32x4*)mb)[F.lane + 64 * j], sc = ((const f32x4*)(mb + 1024))[F.lane + 64 * j]; const f32x4 hv = v[u][j] * rstd * gn[j] * (sc + 1.0f) + sh;
                        if (h8) { unsigned o = 0; o = __builtin_amdgcn_cvt_pk_fp8_f32(hv.x, hv.y, o, false); o = __builtin_amdgcn_cvt_pk_fp8_f32(hv.z, hv.w, o, true); hd8[F.lane + 64 * j] = o; }
                        else { v2u o; o.x = cvt_pk_bf16(hv.x, hv.y); o.y = cvt_pk_bf16(hv.z, hv.w); hd[F.lane + 64 * j] = o; } } }
            }
        }
    }
}

typedef float f32x16r __attribute__((ext_vector_type(16)));
__device__ __forceinline__ void router_phase(Frame& F, int layer, bool real = true, int xp = 0) {
    const bool last = layer == NLAYER - 1;
    const int ntiles = (last ? ML : MT) / 32;
    LAS float* PART = (LAS float*)F.lds;
    LAS float* SSQ = PART + 8 * 32 * 33;
    LAS float* LG = SSQ + 8 * 32;
    LAS float* RSTD = LG + 32 * 33;
    LAS unsigned* CW = (LAS unsigned*)(RSTD + 32);
    LAS unsigned* RUN = CW + 64;
    LAS float* AV = (LAS float*)(RUN + 32);
    LAS float* SHV = AV + 1024;
    LAS float* RCV = SHV + 1024;
    LAS int* TRL = (LAS int*)((LAS unsigned char*)(RCV + 32) + 8 * (32 * 272));
    LAS bf16* STG = (LAS bf16*)((LAS unsigned char*)(RCV + 32) + F.wave * (32 * 272));
    const bf16* XB = (const bf16*)(F.ws + WS_XB);
    const float* MOD = (const float*)(F.ws + WS_MOD); const float* RC = (const float*)(F.ws + WS_RC);
    unsigned char* H8 = (unsigned char*)(F.ws + WS_H8);
    int* TE = (int*)(F.ws + WS_TE); int* TR = (int*)(F.ws + WS_TR); float* TG = (float*)(F.ws + WS_TG); int* ROWTOK = (int*)(F.ws + WS_ROWTOK);
    const float* gn = PIN(F, I_N2G) + layer * D; const float* rw = PIN(F, I_RW) + (size_t)layer * D * NE;
    const int i = F.lane & 31, hf = F.lane >> 5, lr = F.lane >> 4, lc = F.lane & 15, kw = F.wave * 128;
    const int per = 2048 / F.G;
    const int nmine = (2048 % F.G == 0) ? per + ((2048 + F.bx < ntiles) ? 1 : 0) : 0;
#define RT_TILE(n_) ((2048 % F.G == 0) ? ((n_) < per ? F.bx * per + (n_) : 2048 + F.bx) : F.bx + (n_) * F.G)
    const int ncnt = (2048 % F.G == 0) ? nmine : (F.bx < ntiles ? (ntiles - 1 - F.bx) / F.G + 1 : 0);
    __syncthreads();
    if (F.tid < NE) RUN[F.tid] = 0u;
    bf16x8 bw[8][2];
    v2u rawp[16];
#define RT_LOADX(tile_) do { const int rb_ = (tile_) * 32 + lr; const bf16* xb_ = XB + (size_t)rb_ * D + kw + 4 * lc; \
        _Pragma("unroll") for (int q = 0; q < 16; ++q) rawp[q] = *(const v2u*)(xb_ + (size_t)(4 * (q & 7)) * D + 64 * (q >> 3)); } while (0)
    if (ncnt > 0) RT_LOADX(RT_TILE(0));
    int cur_b = -1;
    for (int n = 0; n < ncnt; ++n) {
        const int tile = RT_TILE(n);
        const int r0 = tile * 32; const bool lat = r0 < ML; const int bidx = lat ? (r0 >> 13) : 8; const int r = r0 + i;
        if (bidx != cur_b) {
            cur_b = bidx; const float* mb = MOD + ((size_t)layer * 9 + bidx) * 6144 + 3 * 1024;
            __syncthreads();
            for (int k = F.tid; k < 1024; k += NTHREADS) { AV[k] = gn[k] * (1.0f + mb[1024 + k]); SHV[k] = mb[k]; }
            if (F.tid < NE) RCV[F.tid] = RC[((size_t)layer * 9 + bidx) * NE + F.tid];
            __syncthreads();
            { const v4u* src = (const v4u*)(F.ws + WS_RW3 + ((size_t)(layer * 9 + bidx) * 8 + F.wave) * 8 * 3 * 1024) + F.lane;
#pragma unroll
              for (int kb = 0; kb < 8; ++kb)
#pragma unroll
                  for (int t = 0; t < 2; ++t) bw[kb][t] = __builtin_bit_cast(bf16x8, src[(kb * 3 + t) * 64]); }
        }
        { float s8[8];
#pragma unroll
          for (int q = 0; q < 8; ++q) { const f32x4 a = bf4_f32(rawp[q]), b = bf4_f32(rawp[q + 8]); s8[q] = ((a.x * a.x + a.y * a.y) + (a.z * a.z + a.w * a.w)) + ((b.x * b.x + b.y * b.y) + (b.z * b.z + b.w * b.w)); }
#pragma unroll
          for (int q = 0; q < 8; ++q) { float v = s8[q]; v += shx(v, 1, F.lane); v += shx(v, 2, F.lane); v += shx(v, 4, F.lane); v += shx(v, 8, F.lane); if (lc == 0) SSQ[F.wave * 32 + 4 * q + lr] = v; } }
        __syncthreads();
        const f32x4 av0 = ((const LAS f32x4*)(AV + kw))[lc], av1 = ((const LAS f32x4*)(AV + kw))[lc + 16];
        { const f32x4 sh0 = ((const LAS f32x4*)(SHV + kw))[lc], sh1 = ((const LAS f32x4*)(SHV + kw))[lc + 16];
          unsigned char* hb = H8 + (size_t)(r0 + lr) * D + kw + 4 * lc;
#pragma unroll
          for (int q = 0; q < 8; ++q) { float qs = 0.f;
#pragma unroll
              for (int w = 0; w < 8; ++w) qs += SSQ[w * 32 + 4 * q + lr];
              const float rs = 1.0f / sqrtf(qs * (1.0f / D) + EPS);
#pragma unroll
              for (int hq = 0; hq < 2; ++hq) { const f32x4 h = bf4_f32(rawp[q + 8 * hq]) * (rs * (hq ? av1 : av0)) + (hq ? sh1 : sh0); unsigned w = 0;
                  w = __builtin_amdgcn_cvt_pk_fp8_f32(h.x, h.y, w, false); w = __builtin_amdgcn_cvt_pk_fp8_f32(h.z, h.w, w, true);
                  *(unsigned*)(hb + (size_t)(4 * q) * D + 64 * hq) = w; } } }
        f32x16r acc = {};
        asm volatile("s_waitcnt lgkmcnt(0)" ::: "memory");
#pragma unroll
        for (int q = 0; q < 16; ++q) *(LAS v2u*)(STG + (4 * (q & 7) + lr) * 136 + 4 * lc + 64 * (q >> 3)) = rawp[q];
        asm volatile("s_waitcnt lgkmcnt(0)" ::: "memory");
        if (n + 1 < ncnt) RT_LOADX(RT_TILE(n + 1));
#pragma unroll
        for (int kb = 0; kb < 8; ++kb) { const bf16x8 a = *(const LAS bf16x8*)(STG + i * 136 + 16 * kb + 8 * hf);
#pragma unroll
            for (int t = 0; t < 2; ++t) acc = __builtin_amdgcn_mfma_f32_32x32x16_bf16(a, bw[kb][t], acc, 0, 0, 0); }
#pragma unroll
        for (int rg = 0; rg < 16; ++rg) PART[(F.wave * 32 + ((rg & 3) + 8 * (rg >> 2) + 4 * hf)) * 33 + i] = acc[rg];
        __syncthreads();
        { const int tk = F.tid >> 4, e0 = (F.tid & 15) * 2; float q = 0.f, s0 = 0.f, s1 = 0.f;
#pragma unroll
          for (int w = 0; w < 8; ++w) { q += SSQ[w * 32 + tk]; s0 += PART[(w * 32 + tk) * 33 + e0]; s1 += PART[(w * 32 + tk) * 33 + e0 + 1]; }
          const float rstd = 1.0f / sqrtf(q * (1.0f / D) + EPS);
          LG[tk * 33 + e0] = rstd * s0 + RCV[e0]; LG[tk * 33 + e0 + 1] = rstd * s1 + RCV[e0 + 1]; }
        asm volatile("s_waitcnt lgkmcnt(0)" ::: "memory");
        { const int tk = F.tid >> 4, e0 = (F.tid & 15) * 2; const LAS float* lg = LG + tk * 33; const float l0 = lg[e0], l1 = lg[e0 + 1]; int rk0 = 0, rk1 = 0;
#pragma unroll 8
          for (int j = 0; j < NE; ++j) { const float o = lg[j]; rk0 += (o > l0 || (o == l0 && j < e0)) ? 1 : 0; rk1 += (o > l1 || (o == l1 && j < e0 + 1)) ? 1 : 0; }
          if (rk0 < 4) { F.MISC[MW_SELE + tk * 4 + rk0] = (unsigned)e0; F.MISC[MW_SELV + tk * 4 + rk0] = __float_as_uint(l0); }
          if (rk1 < 4) { F.MISC[MW_SELE + tk * 4 + rk1] = (unsigned)(e0 + 1); F.MISC[MW_SELV + tk * 4 + rk1] = __float_as_uint(l1); } }
        __syncthreads();
        int my = 0, lrk = 0;
        if (F.wave < 2) { const int a = F.tid; my = (int)F.MISC[MW_SELE + a];
            { const float vk = __uint_as_float(F.MISC[MW_SELV + a]), v0 = __uint_as_float(F.MISC[MW_SELV + (a & ~3)]);
              const float ex = __expf(vk - v0); float sm = ex; sm += shx(sm, 1, F.lane); sm += shx(sm, 2, F.lane);
              const size_t idx = ((size_t)r0 + (a >> 2)) * 4 + (a & 3); TG[idx] = ex / sm; TE[idx] = my; }
            unsigned cm = 0;
#pragma unroll 2
            for (int e = 0; e < NE; ++e) { const unsigned long long m = __ballot(my == e); const unsigned pc = (unsigned)__popcll(m);
                if (my == e) lrk = (int)__builtin_amdgcn_mbcnt_hi((unsigned)(m >> 32), __builtin_amdgcn_mbcnt_lo((unsigned)m, 0u)); if (F.lane == e) cm = pc; }
            if (F.lane < NE) CW[F.wave * 32 + F.lane] = cm; }
        __syncthreads();
        if (F.wave < 2) { const int a = F.tid; const int brank = (int)RUN[my] + lrk + (F.wave == 1 ? (int)CW[my] : 0); TRL[n * 128 + a] = (my << 16) | brank; }
        __syncthreads();
        if (F.tid < NE) RUN[F.tid] += CW[F.tid] + CW[32 + F.tid];
    }
    VM_WAIT(); __syncthreads();
    if (F.tid < NE) { const unsigned cnt = RUN[F.tid]; unsigned base = 0;
        if (cnt) base = __hip_atomic_fetch_add(F.ctl + CW_CNT + (real ? layer : NLAYER) * NE + F.tid, cnt, RLX_AGENT);
        F.MISC[MW_LBASE + F.tid] = base; }
    __syncthreads();
    if (real) for (int n = F.tid >> 7; n < ncnt; n += 4) { const int r0 = RT_TILE(n) * 32, a = F.tid & 127;
        const int v = TRL[n * 128 + a], e = v >> 16, rank = (v & 0xffff) + (int)F.MISC[MW_LBASE + e]; const size_t idx = ((size_t)r0 + (a >> 2)) * 4 + (a & 3);
        TR[idx] = rank; ROWTOK[(size_t)e * MT + rank] = r0 + (a >> 2); }
    __syncthreads();
#undef RT_LOADX
#undef RT_TILE
}

__device__ __forceinline__ void normrope16(float (&x)[16], const float* gain, bool lat, int prow, int pcol, const LAS f32x2* T, int L, float oscale, int lane) {
    float ss = 0.f;
#pragma unroll
    for (int i = 0; i < 16; ++i) ss += x[i] * x[i];
    ss += shx(ss, 1, lane); ss += shx(ss, 2, lane); ss += shx(ss, 4, lane);
    const float rstd = 1.0f / sqrtf(ss * (1.0f / 128.0f) + EPS);
    const int o = (L & 7) * 16;
#pragma unroll
    for (int i = 0; i < 16; ++i) x[i] = x[i] * rstd * gain[o + i];
    float p[16];
#pragma unroll
    for (int i = 0; i < 16; ++i) p[i] = shx(x[i], 2, lane);
    if (lat) {
        const int pos = (L & 4) ? pcol : prow; const float sgn = (L & 2) ? 1.0f : -1.0f; const LAS f32x2* t = T + pos * 32 + (L & 1) * 16;
#pragma unroll
        for (int i = 0; i < 16; ++i) { const f32x2 cs = t[i]; x[i] = x[i] * cs.x + sgn * p[i] * cs.y; }
    }
#pragma unroll
    for (int i = 0; i < 16; ++i) x[i] *= oscale;
}
__device__ __forceinline__ void qkprep_phase(Frame& F, int j) {
    LAS f32x2* T = (LAS f32x2*)F.lds;
    __syncthreads();
    for (int i = F.tid; i < 128 * 32; i += NTHREADS) { const int pos = i >> 5, f = i & 31; const float inv = powf(10000.0f, -(float)f / 32.0f); const float ang = (float)pos * inv; float s, c; sincosf(ang, &s, &c); T[i] = (f32x2){c, s}; }
    __syncthreads();
    const bf16* P = (const bf16*)(F.ws + WS_P); unsigned char* Q8 = (unsigned char*)(F.ws + WS_QB); unsigned char* K8 = (unsigned char*)(F.ws + WS_QB + WS_K8_OFF); unsigned char* VT8 = (unsigned char*)(F.ws + WS_KVB);
    const float* qg = PIN(F, I_AQG) + j * 128; const float* kg = PIN(F, I_AKG) + j * 128;
    if (F.bx == 0 && F.tid == 0) { float qm = 0.f, km = 0.f; for (int i = 0; i < 128; ++i) { qm = fmaxf(qm, fabsf(qg[i])); km = fmaxf(km, fabsf(kg[i])); }
        const float sig = att::SCALE * 1.4426950408889634f * 11.3137085f * qm * km;
        ((float*)(F.ws + WS_RC))[2048 + j] = -fminf(-2.0f, 8.0f - 7.0f * sig); }
    const int gw = F.bx * NWAVES + F.wave, NGW = F.G * NWAVES, L = F.lane;
#define QK_UNPACK(x, a, c) do { x[0] = bflo(a.x); x[1] = bfhi(a.x); x[2] = bflo(a.y); x[3] = bfhi(a.y); x[4] = bflo(a.z); x[5] = bfhi(a.z); x[6] = bflo(a.w); x[7] = bfhi(a.w); \
        x[8] = bflo(c.x); x[9] = bfhi(c.x); x[10] = bflo(c.y); x[11] = bfhi(c.y); x[12] = bflo(c.z); x[13] = bfhi(c.z); x[14] = bflo(c.w); x[15] = bfhi(c.w); } while (0)
#define QK_PACK(o, x) do { _Pragma("unroll") for (int w4 = 0; w4 < 4; ++w4) { unsigned w = 0; w = __builtin_amdgcn_cvt_pk_fp8_f32(x[4 * w4], x[4 * w4 + 1], w, false); w = __builtin_amdgcn_cvt_pk_fp8_f32(x[4 * w4 + 2], x[4 * w4 + 3], w, true); o[w4] = w; } } while (0)
    const float qscale = att::SCALE * 1.4426950408889634f * 8.0f;
    int rfirst = gw;
    if (F.G * NWAVES * 32 == ML) {
        v4u nq[4][2], nk[2];
#define QK4_LOAD(it_) do { _Pragma("unroll") for (int k = 0; k < 4; ++k) { const bf16* pr_ = P + (size_t)(gw + (4 * (it_) + k) * NGW) * 1536 + 16 * L; nq[k][0] = *(const v4u*)pr_; nq[k][1] = *(const v4u*)(pr_ + 8); } \
        { const bf16* pk_ = P + (size_t)(gw + (4 * (it_) + (L >> 4)) * NGW) * 1536 + 1024 + 16 * (L & 15); nk[0] = *(const v4u*)pk_; nk[1] = *(const v4u*)(pk_ + 8); } } while (0)
        QK4_LOAD(0);
#pragma unroll 1
        for (int it = 0; it < 8; ++it) {
            v4u q[4][2], kk[2];
#pragma unroll
            for (int k = 0; k < 4; ++k) { q[k][0] = nq[k][0]; q[k][1] = nq[k][1]; }
            kk[0] = nk[0]; kk[1] = nk[1];
            if (it + 1 < 8) QK4_LOAD(it + 1);
#pragma unroll
            for (int k = 0; k < 4; ++k) { const int r = gw + (4 * it + k) * NGW, s = r & (SEQ - 1); float x[16];
                QK_UNPACK(x, q[k][0], q[k][1]);
                normrope16(x, qg, true, s >> 6, s & 63, T, L, qscale, L);
                v4u o; QK_PACK(o, x); *(v4u*)(Q8 + (size_t)r * D + 16 * L) = o; }
            { const int r = gw + (4 * it + (L >> 4)) * NGW, s = r & (SEQ - 1), Lk = L & 15; float x[16];
              QK_UNPACK(x, kk[0], kk[1]);
              normrope16(x, kg, true, s >> 6, s & 63, T, Lk, 1.0f, L);
              v4u o; QK_PACK(o, x); *(v4u*)(K8 + ((size_t)(r >> 13) * SKV + s) * 256 + 16 * Lk) = o; }
        }
#undef QK4_LOAD
        rfirst = gw + 32 * NGW;
    }
    v4u nqa, nqc, nka, nkc;
#define QK_LOAD(r_) do { const bf16* pr_ = P + (size_t)(r_) * 1536; nqa = *(const v4u*)(pr_ + 16 * L); nqc = *(const v4u*)(pr_ + 16 * L + 8); nka = *(const v4u*)(pr_ + 1024 + 16 * (L & 15)); nkc = *(const v4u*)(pr_ + 1024 + 16 * (L & 15) + 8); } while (0)
    if (rfirst < MT) QK_LOAD(rfirst);
    for (int r = rfirst; r < MT; r += NGW) {
        const v4u qa_ = nqa, qc_ = nqc, ka_ = nka, kc_ = nkc;
        if (r + NGW < MT) QK_LOAD(r + NGW);
        const bool lat = r < ML; const int b = lat ? (r >> 13) : ((r - ML) >> 8); const int s = lat ? (r & (SEQ - 1)) : ((r - ML) & (CL - 1));
        const int prow = s >> 6, pcol = s & 63; const size_t kvrow = (size_t)b * SKV + (lat ? s : SEQ + s);
        { float x[16]; QK_UNPACK(x, qa_, qc_);
          normrope16(x, qg, lat, prow, pcol, T, L, qscale, L);
          v4u o; QK_PACK(o, x); *(v4u*)(Q8 + (size_t)r * D + 16 * L) = o; }
        { const int Lk = L & 15; float x[16]; QK_UNPACK(x, ka_, kc_);
          normrope16(x, kg, lat, prow, pcol, T, Lk, 1.0f, L);
          if (L < 16) { v4u o; QK_PACK(o, x); *(v4u*)(K8 + kvrow * 256 + 16 * L) = o; } }
    }
#undef QK_LOAD
#undef QK_UNPACK
#undef QK_PACK
    LAS unsigned char* Tt = F.lds + 32768;
    v4u nv[4];
#define VT_LOAD(tile_) do { const int b_ = (tile_) / (SKV / 64), kb_ = (tile_) % (SKV / 64), pos_ = kb_ * 64 + (F.tid >> 3); \
        const size_t r_ = pos_ < SEQ ? (size_t)b_ * SEQ + pos_ : (size_t)ML + (size_t)b_ * CL + (pos_ - SEQ); const v4u* src_ = (const v4u*)(P + r_ * 1536 + 1280 + 32 * (F.tid & 7)); \
        _Pragma("unroll") for (int q = 0; q < 4; ++q) nv[q] = src_[q]; } while (0)
    if (F.bx < NB * (SKV / 64)) VT_LOAD(F.bx);
    for (int tile = F.bx; tile < NB * (SKV / 64); tile += F.G) {
        const int b = tile / (SKV / 64), kb = tile % (SKV / 64), ki = F.tid >> 3, seg = F.tid & 7;
        const int k5 = ki & 31, slot = 32 * ((k5 >> 2) & 1) + ((k5 & 3) | ((k5 >> 3) << 2)) + (ki >= 32 ? 16 : 0);
        v4u cv[4];
#pragma unroll
        for (int q = 0; q < 4; ++q) cv[q] = nv[q];
        if (tile + F.G < NB * (SKV / 64)) VT_LOAD(tile + F.G);
        __syncthreads();
#pragma unroll
        for (int q = 0; q < 4; ++q) { const v4u w = cv[q]; const unsigned ww[4] = {w.x, w.y, w.z, w.w};
#pragma unroll
            for (int e2 = 0; e2 < 4; ++e2) { const unsigned pk = __builtin_amdgcn_cvt_pk_fp8_f32(bflo(ww[e2]), bfhi(ww[e2]), 0u, false); const int dd = 32 * seg + 8 * q + 2 * e2;
                Tt[dd * 64 + slot] = (unsigned char)(pk & 0xff); Tt[(dd + 1) * 64 + slot] = (unsigned char)((pk >> 8) & 0xff); } }
        __syncthreads();
        { const int rho = F.tid >> 1, half = F.tid & 1; const v4u a = *(const LAS v4u*)(Tt + rho * 64 + 32 * half), c = *(const LAS v4u*)(Tt + rho * 64 + 32 * half + 16);
          unsigned char* dst = VT8 + ((size_t)(b * 2 + (rho >> 7)) * 128 + (rho & 127)) * SKV + kb * 64 + 32 * half;
          *(v4u*)dst = a; *(v4u*)(dst + 16) = c; }
    }
#undef VT_LOAD
    __syncthreads();
}
template <int XV = 0>
__device__ __forceinline__ void attention_phase(Frame& F, char* lds_generic, bool ctx_queries, int j) {
    const float nb = -((const float*)(F.ws + WS_RC))[2048 + j] - 8.0f;
    const unsigned char* Q8 = (const unsigned char*)(F.ws + WS_QB); const unsigned char* K8 = (const unsigned char*)(F.ws + WS_QB + WS_K8_OFF); const unsigned char* VT8 = (const unsigned char*)(F.ws + WS_KVB); bf16* Y = (bf16*)(F.ws + WS_Y);
    const int nunits = 2048 + (ctx_queries ? 64 : 0);
    for (int u = F.bx; u < nunits; u += F.G) {
        if (u < 2048) { const int b = u >> 8, w = u & 255, h = w & 7, qb = w >> 3; const size_t qo = ((size_t)b * SEQ + (size_t)qb * 256) * D + h * 128;
            att::attn_dense_body<XV>(Q8 + qo, K8 + (size_t)b * SKV * 256 + (h >> 2) * 128, VT8 + (size_t)(b * 2 + (h >> 2)) * 128 * SKV, SKV, Y + qo, SKV, lds_generic, F.wave, nb); }
        else { const int w = u - 2048, b = w >> 3, h = w & 7; const size_t qo = ((size_t)ML + (size_t)b * CL) * D + h * 128;
            att::attn_dense_body<XV>(Q8 + qo, K8 + ((size_t)b * SKV + SEQ) * 256 + (h >> 2) * 128, VT8 + (size_t)(b * 2 + (h >> 2)) * 128 * SKV + SEQ, SKV, Y + qo, CL, lds_generic, F.wave, nb); }
    }
}

__device__ __forceinline__ void gmlp_mix_phase(Frame& F) {
    constexpr int LDA = 136, LDO = 132;
    LAS bf16* As = (LAS bf16*)F.lds;
    LAS bf16* Vt = (LAS bf16*)(F.lds + 128 * LDA * 2);
    LAS float* rs = (LAS float*)(F.lds + 2 * 128 * LDA * 2);
    LAS float* Ot = (LAS float*)(F.lds + 2 * 128 * LDA * 2 + 512);
    const bf16* P = (const bf16*)(F.ws + WS_P); bf16* Y = (bf16*)(F.ws + WS_Y); const float* SS = (const float*)(F.ws + WS_SS);
    const float* ws = PIN(F, I_GWS); const float* bs = PIN(F, I_GBS); const float* vg = PIN(F, I_GVG);
    const int r32 = F.lane & 31, hi = F.lane >> 5;
    constexpr int NU = (MT / 128) * 8;
    struct GIn { f32x4 s; v4u v[4], uu[4]; } ga, gb; int gcur = -1;
#define GM_LOAD(u_, IN) do { const int g_ = (u_) & 7; const size_t row0_ = (size_t)((u_) >> 3) * 128; \
        IN.s = *(const f32x4*)(SS + (row0_ + (F.tid >> 2)) * 16 + (F.tid & 3) * 4);                                       \
        _Pragma("unroll") for (int k = 0; k < 4; ++k) { const int i_ = F.tid + NTHREADS * k, q_ = i_ >> 4, c8_ = (i_ & 15) * 8; const bf16* pp_ = P + (row0_ + q_) * 2048 + g_ * 128 + c8_; \
            IN.v[k] = *(const v4u*)(pp_ + 1024); IN.uu[k] = *(const v4u*)pp_; } } while (0)
#define GM_UNIT(u_, IN) do { \
        const int chunk = (u_) >> 3, g = (u_) & 7; const size_t row0 = (size_t)chunk * 128; \
        __syncthreads(); \
        if (g != gcur) { gcur = g; \
            for (int i = F.tid; i < 128 * 32; i += NTHREADS) { const int p = i >> 5, q4 = (i & 31) * 4; const f32x4 w = *(const f32x4*)(ws + ((size_t)g * 128 + p) * 128 + q4); \
                v2u o; o.x = pk2(w.x, w.y); o.y = pk2(w.z, w.w); *(LAS v2u*)(As + p * LDA + q4) = o; } } \
        { float s = (IN.s.x + IN.s.y) + (IN.s.z + IN.s.w); s += shx(s, 1, F.lane); s += shx(s, 2, F.lane); if ((F.tid & 3) == 0) rs[F.tid >> 2] = 1.0f / sqrtf(s * (1.0f / 1024.0f) + EPS); } \
        __syncthreads(); \
        _Pragma("unroll") for (int k = 0; k < 4; ++k) { const int i = F.tid + NTHREADS * k, q = i >> 4, c8 = (i & 15) * 8; const float rq = rs[q]; const unsigned ww[4] = {IN.v[k].x, IN.v[k].y, IN.v[k].z, IN.v[k].w}; \
            _Pragma("unroll") for (int e2 = 0; e2 < 4; ++e2) { const unsigned pk = cvt_pk_bf16(bflo(ww[e2]) * rq, bfhi(ww[e2]) * rq); Vt[(c8 + 2 * e2) * LDA + q] = (bf16)(pk & 0xffff); Vt[(c8 + 2 * e2 + 1) * LDA + q] = (bf16)(pk >> 16); } } \
        __syncthreads(); \
        const int p0 = (F.wave >> 1) * 32, cbase = (F.wave & 1) * 64; \
        f32x16 acc0 = {}, acc1 = {}; \
        _Pragma("unroll") for (int ks = 0; ks < 8; ++ks) { const int k0 = ks * 16 + hi * 8; \
            const bf16x8 a = *(const LAS bf16x8*)(As + (p0 + r32) * LDA + k0); \
            const bf16x8 b0 = *(const LAS bf16x8*)(Vt + (cbase + r32) * LDA + k0), b1 = *(const LAS bf16x8*)(Vt + (cbase + 32 + r32) * LDA + k0); \
            acc0 = __builtin_amdgcn_mfma_f32_32x32x16_bf16(a, b0, acc0, 0, 0, 0); acc1 = __builtin_amdgcn_mfma_f32_32x32x16_bf16(a, b1, acc1, 0, 0, 0); } \
        _Pragma("unroll") for (int t = 0; t < 2; ++t) { const int cl = cbase + t * 32 + r32; const float gain = vg[g * 128 + cl]; \
            _Pragma("unroll") for (int reg = 0; reg < 16; ++reg) { const int p = p0 + (reg & 3) + 8 * (reg >> 2) + 4 * hi; Ot[p * LDO + cl] = gain * (t == 0 ? acc0[reg] : acc1[reg]) + bs[g * 128 + p]; } } \
        __syncthreads(); \
        _Pragma("unroll") for (int k = 0; k < 4; ++k) { const int i = F.tid + NTHREADS * k, p = i >> 4, c8 = (i & 15) * 8; const v4u uw = IN.uu[k]; \
            const LAS float* o = Ot + p * LDO + c8; const f32x4 m0 = *(const LAS f32x4*)o, m1 = *(const LAS f32x4*)(o + 4); \
            v4u w; w.x = cvt_pk_bf16(bflo(uw.x) * m0.x, bfhi(uw.x) * m0.y); w.y = cvt_pk_bf16(bflo(uw.y) * m0.z, bfhi(uw.y) * m0.w); \
            w.z = cvt_pk_bf16(bflo(uw.z) * m1.x, bfhi(uw.z) * m1.y); w.w = cvt_pk_bf16(bflo(uw.w) * m1.z, bfhi(uw.w) * m1.w); \
            *(v4u*)(Y + (row0 + p) * D + g * 128 + c8) = w; } } while (0)
    int u = F.bx;
    if (u < NU) GM_LOAD(u, ga);
    for (; u < NU; u += 2 * F.G) {
        if (u + F.G < NU) GM_LOAD(u + F.G, gb);
        GM_UNIT(u, ga);
        if (u + F.G >= NU) break;
        if (u + 2 * F.G < NU) GM_LOAD(u + 2 * F.G, ga);
        GM_UNIT(u + F.G, gb);
    }
    __syncthreads();
#undef GM_LOAD
#undef GM_UNIT
}

__device__ __forceinline__ void hyena_prep_phase(Frame& F) {
    LAS float* tl = (LAS float*)F.lds;
    const bf16* P = (const bf16*)(F.ws + WS_P); bf16* X0 = (bf16*)(F.ws + WS_X0); bf16* VG = (bf16*)(F.ws + WS_VG);
    float* VT = (float*)(F.ws + WS_VT); float* VTC = (float*)(F.ws + WS_VTC);
    const float* cw = PIN(F, I_HCW); const float* cb = PIN(F, I_HCB);
    const int tt = F.tid >> 3, cg = F.tid & 7;
    constexpr int NU = (MT / 64) * 16;
    v4u pa[3][3], pb[3][3];
#define HP_LOAD(u_, IN) do { const int tb_ = (u_) >> 4, c0_ = ((u_) & 15) * 64, r0_ = tb_ * 64; const bool lat_ = r0_ < ML; \
        const int s_ = (lat_ ? (r0_ & (SEQ - 1)) : ((r0_ - ML) & (CL - 1))) + tt, L_ = lat_ ? SEQ : CL; const bf16* pr_ = P + (size_t)(r0_ + tt) * 3072 + c0_ + cg * 8; const v4u z0_ = {0u, 0u, 0u, 0u}; \
        _Pragma("unroll") for (int seg = 0; seg < 3; ++seg) { IN[seg][0] = s_ > 0 ? *(const v4u*)(pr_ + seg * 1024 - 3072) : z0_; IN[seg][1] = *(const v4u*)(pr_ + seg * 1024); \
            IN[seg][2] = s_ < L_ - 1 ? *(const v4u*)(pr_ + seg * 1024 + 3072) : z0_; } } while (0)
    LAS float* wl = tl + 64 * 65; int c0w = -1;
#define HP_UNIT(u_, IN) do { \
        const int tb = (u_) >> 4, c0 = ((u_) & 15) * 64; const int r0 = tb * 64; const bool lat = r0 < ML; \
        const int b = lat ? (r0 >> 13) : ((r0 - ML) >> 8), s0 = lat ? (r0 & (SEQ - 1)) : ((r0 - ML) & (CL - 1)); \
        const int r = r0 + tt, c = c0 + cg * 8; \
        if (c0 != c0w) { c0w = c0; __syncthreads(); \
            for (int i = F.tid; i < 768; i += NTHREADS) { const int seg = i >> 8, k = (i >> 6) & 3, ch = i & 63; wl[i] = k < 3 ? cw[k * 3072 + seg * 1024 + c0 + ch] : cb[seg * 1024 + c0 + ch]; } \
            __syncthreads(); } \
        float o[3][8]; \
        _Pragma("unroll") for (int seg = 0; seg < 3; ++seg) { \
            const unsigned pmw[4] = {IN[seg][0].x, IN[seg][0].y, IN[seg][0].z, IN[seg][0].w}, pcw[4] = {IN[seg][1].x, IN[seg][1].y, IN[seg][1].z, IN[seg][1].w}, pnw[4] = {IN[seg][2].x, IN[seg][2].y, IN[seg][2].z, IN[seg][2].w}; \
            _Pragma("unroll") for (int i = 0; i < 8; ++i) { const float xm = (i & 1) ? bfhi(pmw[i >> 1]) : bflo(pmw[i >> 1]), xc = (i & 1) ? bfhi(pcw[i >> 1]) : bflo(pcw[i >> 1]), xn = (i & 1) ? bfhi(pnw[i >> 1]) : bflo(pnw[i >> 1]); \
                const LAS float* wp = wl + seg * 256 + cg * 8 + i; o[seg][i] = xm * wp[0] + xc * wp[64] + xn * wp[128] + wp[192]; } } \
        float vgv[8]; \
        _Pragma("unroll") for (int i = 0; i < 8; ++i) vgv[i] = o[2][i] * o[1][i]; \
        v4u w; w.x = cvt_pk_bf16(o[0][0], o[0][1]); w.y = cvt_pk_bf16(o[0][2], o[0][3]); w.z = cvt_pk_bf16(o[0][4], o[0][5]); w.w = cvt_pk_bf16(o[0][6], o[0][7]); \
        *(v4u*)(X0 + (size_t)r * D + c) = w; \
        __syncthreads(); \
        _Pragma("unroll") for (int i = 0; i < 8; ++i) tl[(cg * 8 + i) * 65 + tt] = vgv[i]; \
        __syncthreads(); \
        { const int cc = F.tid >> 3, ts = (F.tid & 7) * 8; const LAS float* sp = tl + cc * 65 + ts; \
          if (lat) *(v4u*)((bf16*)VT + ((size_t)b * 1024 + c0 + cc) * SEQ + s0 + ts) = (v4u){cvt_pk_bf16(sp[0], sp[1]), cvt_pk_bf16(sp[2], sp[3]), cvt_pk_bf16(sp[4], sp[5]), cvt_pk_bf16(sp[6], sp[7])};        \
          else { float* dst = VTC + ((size_t)b * 1024 + c0 + cc) * CL + s0 + ts; *(f32x4*)dst = (f32x4){sp[0], sp[1], sp[2], sp[3]}; *(f32x4*)(dst + 4) = (f32x4){sp[4], sp[5], sp[6], sp[7]}; } } } while (0)
    int u = F.bx;
    if (u < NU) HP_LOAD(u, pa);
    for (; u < NU; u += 2 * F.G) {
        if (u + F.G < NU) HP_LOAD(u + F.G, pb);
        HP_UNIT(u, pa);
        if (u + F.G >= NU) break;
        if (u + 2 * F.G < NU) HP_LOAD(u + 2 * F.G, pa);
        HP_UNIT(u + F.G, pb);
    }
    __syncthreads();
#undef HP_LOAD
#undef HP_UNIT
}
__device__ __forceinline__ void hyena_post_phase(Frame& F) {
    LAS float* tl = (LAS float*)F.lds;
    const bf16* X0 = (const bf16*)(F.ws + WS_X0); const bf16* VG = (const bf16*)(F.ws + WS_VG); bf16* Y = (bf16*)(F.ws + WS_Y);
    const float* VT = (const float*)(F.ws + WS_CT); const float* VTC = (const float*)(F.ws + WS_CTC); const float* dsk = PIN(F, I_HD);
    const int tt = F.tid >> 3, cg = F.tid & 7;
    constexpr int NU = (MT / 64) * 16;
    struct PIn { f32x4 a, bq; v4u cw, x0; } qa, qb;
#define HQ_LOAD(u_, IN) do { const int tb_ = (u_) >> 4, c0_ = ((u_) & 15) * 64, r0_ = tb_ * 64; const bool lat_ = r0_ < ML; \
        const int b_ = lat_ ? (r0_ >> 13) : ((r0_ - ML) >> 8), s0_ = lat_ ? (r0_ & (SEQ - 1)) : ((r0_ - ML) & (CL - 1)); const int cc_ = F.tid >> 3, ts_ = (F.tid & 7) * 8; \
        if (lat_) IN.cw = *(const v4u*)((const bf16*)VT + ((size_t)b_ * 1024 + c0_ + cc_) * SEQ + s0_ + ts_);        \
        else { const float* src_ = VTC + ((size_t)b_ * 1024 + c0_ + cc_) * CL + s0_ + ts_; IN.a = *(const f32x4*)src_; IN.bq = *(const f32x4*)(src_ + 4); } \
        IN.x0 = *(const v4u*)(X0 + (size_t)(r0_ + tt) * D + c0_ + cg * 8); } while (0)
#define HQ_UNIT(u_, IN) do { \
        const int tb = (u_) >> 4, c0 = ((u_) & 15) * 64; const int r0 = tb * 64; \
        __syncthreads(); \
        { const int cc = F.tid >> 3, ts = (F.tid & 7) * 8; LAS float* dp = tl + cc * 65 + ts; \
          if (r0 < ML) { dp[0] = bflo(IN.cw.x); dp[1] = bfhi(IN.cw.x); dp[2] = bflo(IN.cw.y); dp[3] = bfhi(IN.cw.y); dp[4] = bflo(IN.cw.z); dp[5] = bfhi(IN.cw.z); dp[6] = bflo(IN.cw.w); dp[7] = bfhi(IN.cw.w); } \
          else { dp[0] = IN.a.x; dp[1] = IN.a.y; dp[2] = IN.a.z; dp[3] = IN.a.w; dp[4] = IN.bq.x; dp[5] = IN.bq.y; dp[6] = IN.bq.z; dp[7] = IN.bq.w; } } \
        __syncthreads(); \
        const int r = r0 + tt, c = c0 + cg * 8; \
        const unsigned x0w[4] = {IN.x0.x, IN.x0.y, IN.x0.z, IN.x0.w}; float y[8]; \
        _Pragma("unroll") for (int i = 0; i < 8; ++i) { const float xx = (i & 1) ? bfhi(x0w[i >> 1]) : bflo(x0w[i >> 1]); y[i] = tl[(cg * 8 + i) * 65 + tt] * xx; }        \
        v4u w; w.x = cvt_pk_bf16(y[0], y[1]); w.y = cvt_pk_bf16(y[2], y[3]); w.z = cvt_pk_bf16(y[4], y[5]); w.w = cvt_pk_bf16(y[6], y[7]); \
        *(v4u*)(Y + (size_t)r * D + c) = w; } while (0)
    int u = F.bx;
    if (u < NU) HQ_LOAD(u, qa);
    for (; u < NU; u += 2 * F.G) {
        if (u + F.G < NU) HQ_LOAD(u + F.G, qb);
        HQ_UNIT(u, qa);
        if (u + F.G >= NU) break;
        if (u + 2 * F.G < NU) HQ_LOAD(u + 2 * F.G, qa);
        HQ_UNIT(u + F.G, qb);
    }
    __syncthreads();
#undef HQ_LOAD
#undef HQ_UNIT
}
__device__ __forceinline__ bool phase_nonempty(int ph) {
    if (ph < PH_L0 || ph >= PH_FINAL) return true;
    const int layer = (ph - PH_L0) / PH_PER_LAYER, lp = (ph - PH_L0) % PH_PER_LAYER, kind = layer % 3;
    if (lp == LP_MIX2) return kind != 1;
    if (lp == LP_MIX3) return kind == 2;
    return true;
}
__global__ void __launch_bounds__(NTHREADS, 2) mk_fwd(Args args) {
    extern __shared__ __attribute__((aligned(16))) unsigned char lds[];
    Frame F0;
    F0.lds = (LAS unsigned char*)lds; F0.MISC = (volatile LAS unsigned*)(F0.lds + MISC_OFF);
    F0.tid = threadIdx.x; F0.lane = F0.tid & 63; F0.wave = __builtin_amdgcn_readfirstlane(F0.tid >> 6);
    F0.G = gridDim.x; F0.bx = blockIdx.x; F0.out = args.out; F0.ws = args.ws; F0.ctl = (gu32*)(args.ws + WS_CTL);
    for (int u = F0.tid; u < MISC_BYTES / 4; u += NTHREADS) F0.MISC[u] = 0u;
    __syncthreads();
    if (F0.tid < 36) { const unsigned long long p = (unsigned long long)args.in[F0.tid]; F0.MISC[MW_PTRS + 2 * F0.tid] = (unsigned)p; F0.MISC[MW_PTRS + 2 * F0.tid + 1] = (unsigned)(p >> 32); }
    __syncthreads();
    const int lo = args.ph_lo, hi = args.ph_hi;
    const bool multi = (hi - lo) > 1;
    XcdBarrier bar; bar.bar = (unsigned*)(F0.ctl + CW_BAR); bar.x = 0; bar.st = nullptr; bar.w = F0.wave;
    if (multi) bar = xcd_barrier_post((unsigned*)(F0.ctl + CW_BAR), F0.MISC + 8, F0.wave);
#ifndef PHMASK
#define PHMASK 0xFFFF
#endif
#define EN(b) ((PHMASK >> (b)) & 1)
#ifndef MK_STAG_IN
#define MK_STAG_IN 0u
#define MK_STAG_OUT 0u
#define MK_STAG_M1 0u
#define MK_STAG_M2 0u
#endif
#ifndef KMASK
#define KMASK 7
#endif
#define KEN(b) ((KMASK >> (b)) & 1)
#define IN(k) (lo <= (k) && (k) < hi)
#define SEAM(k) do { if ((k) + 1 < hi) xcd_barrier(bar); } while (0)
#define PB(id) for (int _rep = 0, _n = ((id) == MK_REPEAT ? MK_NREP : 1); _rep < _n; ++_rep) {
#define PE(id) if (_rep + 1 < _n) xcd_barrier(bar); } SEAM(id);

    if (EN(0) && IN(PH_PRO0)) { PB(PH_PRO0) Frame F = phase_frame(F0); pro0_mod(F); __syncthreads(); pro0_transposes(F); pro0_filter_mlp(F); PE(PH_PRO0) }

#pragma unroll 1
    for (int layer = 0; layer < NLAYER; ++layer) {
        const int kind = layer % 3, jj = layer / 3, pb = PH_L0 + layer * PH_PER_LAYER; const bool last = layer == NLAYER - 1;
        if (EN(2) && IN(pb + LP_NORM1)) { PB(pb + LP_NORM1) Frame F = phase_frame(F0);
            if (EN(1) && layer == 0) { pro1_router_split(F); pro1_filters(F); }
            rowpass<0>(F, layer, _rep + 1 == _n, kind != 1); PE(pb + LP_NORM1) }
        if (EN(3) && IN(pb + LP_INPROJ)) { PB(pb + LP_INPROJ)
            Frame F = phase_frame(F0);
            if (kind != 1) {
                const int N = kind == 0 ? 1536 : 3072;
                pg8::DenseSchedT<true> S; S.init(F.ws + WS_H8, kind == 0 ? F.ws + WS_WATT + (size_t)jj * 1536 * 1024 : F.ws + WS_WHY, MT, N, F.G, F.bx, 1024);
                pg8::EpiBf16 E{(bf16*)(F.ws + WS_P), N, (float*)(F.ws + WS_SS), 0};
                pg8::gemm_phase<pg8::EpiBf16, pg8::DenseSchedT<true>, true, true>(F.lds, S, E, F.wave, false, MK_STAG_IN);
            } else {
                const int N = 2048;
                pg8::DenseSched S; S.init(F.ws + WS_H, F.ws + WS_WGM, MT, N, F.G, F.bx);
                pg8::EpiBf16 E{(bf16*)(F.ws + WS_P), N, (float*)(F.ws + WS_SS), 1};
                pg8::gemm_phase<pg8::EpiBf16, pg8::DenseSched, false>(F.lds, S, E, F.wave, false, MK_STAG_IN);
            }
            PE(pb + LP_INPROJ)
        }
        if (IN(pb + LP_MIX1)) { PB(pb + LP_MIX1)
            Frame F = phase_frame(F0);
            if (EN(4) && kind == 0) qkprep_phase(F, jj); else if (EN(5) && kind == 1) gmlp_mix_phase(F); else if (EN(6)) hyena_prep_phase(F);
            PE(pb + LP_MIX1)
        }
        if (IN(pb + LP_MIX2) && kind != 1) { PB(pb + LP_MIX2)
            Frame F = phase_frame(F0);
            if (EN(7) && kind == 0) {
#if MK_XP >= 10 && MK_XP < 20
                if (_rep + 1 < _n) attention_phase<MK_XP - 10>(F, (char*)lds, !last, jj); else
#endif
                attention_phase<0>(F, (char*)lds, !last, jj); }
            else if (EN(8)) hyena_conv_phase(F);
            PE(pb + LP_MIX2)
        }
        if (EN(9) && IN(pb + LP_MIX3) && kind == 2) { PB(pb + LP_MIX3) Frame F = phase_frame(F0); hyena_post_phase(F); PE(pb + LP_MIX3) }
        if (EN(10) && IN(pb + LP_OUTPROJ)) { PB(pb + LP_OUTPROJ)
            Frame F = phase_frame(F0); const float* modl = (const float*)(F.ws + WS_MOD) + (size_t)layer * 9 * 6144;
            pg8::DenseSched S; S.init(F.ws + WS_Y, F.ws + WS_WOUT + (size_t)layer * 1024 * 1024 * 2, last ? ML : MT, 1024, F.G, F.bx);
            pg8::EpiResid E{(bf16*)(F.ws + WS_XB), modl};
            pg8::gemm_phase<pg8::EpiResid, pg8::DenseSched, false>(F.lds, S, E, F.wave, false, MK_STAG_OUT);
            PE(pb + LP_OUTPROJ)
        }
        if (EN(11) && IN(pb + LP_NORM2)) { PB(pb + LP_NORM2) Frame F = phase_frame(F0); router_phase(F, layer, _rep + 1 == _n, (_rep + 1 < _n) ? MK_XP : 0); PE(pb + LP_NORM2) }
        if (EN(12) && IN(pb + LP_MOE1)) { PB(pb + LP_MOE1)
            Frame F = phase_frame(F0);
            moe_tables(F, layer);
            pg8::MoeSched S{(const char*)(F.ws + WS_H8), (const char*)(F.ws + WS_WE1) + (size_t)layer * NE * 2048 * 1024, (size_t)2048 * 1024, (const int*)(F.ws + WS_ROWTOK),
                            (const volatile LAS int*)(F.MISC + MW_CUMBLK), (const volatile LAS int*)(F.MISC + MW_CNT), 3, F.G, F.bx, 1024, (const volatile LAS int*)(F.lds + AUX_OFF + 1024)};
            S.build_list((volatile LAS int*)(F.lds + AUX_OFF + 1024), F.tid); __syncthreads();
            pg8::EpiSwiglu E{(unsigned char*)(F.ws + WS_ACT), PIN(F, I_EB1) + (size_t)layer * NE * 2048, (LAS float*)(F.lds + AUX_OFF)};
#if MK_XP >= 20
            if (_rep + 1 < _n) { int one_ = 1; asm volatile("" : "+s"(one_)); pg8::gemm_phase<pg8::EpiSwiglu, pg8::MoeSched, true, true, MK_XP - 20>(F.lds, S, E, F.wave, one_ != 0, MK_STAG_M1); } else
#endif
            pg8::gemm_phase<pg8::EpiSwiglu, pg8::MoeSched, true, true>(F.lds, S, E, F.wave, MK_XP == 1 && _rep + 1 < _n, MK_STAG_M1);
            PE(pb + LP_MOE1)
        }
        if (EN(13) && IN(pb + LP_MOE2)) { PB(pb + LP_MOE2)
            Frame F = phase_frame(F0);
            moe_tables(F, layer);
            pg8::MoeSched S{(const char*)(F.ws + WS_ACT), (const char*)(F.ws + WS_WE2) + (size_t)layer * NE * 1024 * 1024, (size_t)1024 * 1024, nullptr,
                            (const volatile LAS int*)(F.MISC + MW_CUMBLK), (const volatile LAS int*)(F.MISC + MW_CNT), 2, F.G, F.bx, 1024, (const volatile LAS int*)(F.lds + AUX_OFF + 1024)};
            S.build_list((volatile LAS int*)(F.lds + AUX_OFF + 1024), F.tid); __syncthreads();
            pg8::EpiBias E{(unsigned char*)(F.ws + WS_YM), PIN(F, I_EB2) + (size_t)layer * NE * 1024, (LAS float*)(F.lds + AUX_OFF)};
            pg8::gemm_phase<pg8::EpiBias, pg8::MoeSched, true, true>(F.lds, S, E, F.wave, MK_XP == 1 && _rep + 1 < _n, MK_STAG_M2);
            PE(pb + LP_MOE2)
        }
    }
    if (EN(14) && IN(PH_FINAL)) { PB(PH_FINAL) Frame F = phase_frame(F0); rowpass<2>(F, NLAYER - 1, _rep + 1 == _n); PE(PH_FINAL) }
#undef IN
#undef SEAM
}

static bool host_phase_nonempty(int ph) {
    if (ph < PH_L0 || ph >= PH_FINAL) return true;
    const int layer = (ph - PH_L0) / PH_PER_LAYER, lp = (ph - PH_L0) % PH_PER_LAYER, kind = layer % 3;
    if (lp == LP_MIX2) return kind != 1;
    if (lp == LP_MIX3) return kind == 2;
    return true;
}
extern "C" void kernel_launch(void* const* d_in, const int* in_sizes, int n_in, void* d_out, int out_size, void* d_ws, size_t ws_size, hipStream_t stream) {
    static int grid = 0;
    if (grid == 0) {
        if (n_in != 36 || in_sizes[0] != ML * D || out_size != ML * D || ws_size < WS_END) {
            fprintf(stderr, "kernel_launch: built for 36 inputs, x/out of %d floats, >= %zu bytes of workspace; got n_in %d in0 %d out %d ws %zu; nothing launched\n", ML * D, (size_t)WS_END, n_in, n_in > 0 ? in_sizes[0] : -1, out_size, ws_size);
            grid = -1; return; }
        int dev = 0, cus = 0, per_cu = 0;
        if (hipGetDevice(&dev) != hipSuccess || hipDeviceGetAttribute(&cus, hipDeviceAttributeMultiprocessorCount, dev) != hipSuccess) { fprintf(stderr, "kernel_launch: device query failed\n"); grid = -1; return; }
        if (hipFuncSetAttribute((const void*)mk_fwd, hipFuncAttributeMaxDynamicSharedMemorySize, LDS_BYTES) != hipSuccess) { fprintf(stderr, "kernel_launch: hipFuncSetAttribute(%d B LDS) failed\n", LDS_BYTES); grid = -1; return; }
        if (hipOccupancyMaxActiveBlocksPerMultiprocessor(&per_cu, (const void*)mk_fwd, NTHREADS, LDS_BYTES) != hipSuccess || per_cu < 1)
            fprintf(stderr, "kernel_launch: note: occupancy query reports %d workgroups per CU\n", per_cu);
        (void)hipGetLastError();
        grid = cus;
    }
    if (grid < 0) return;
    if (hipMemsetAsync((char*)d_ws + WS_CTL, 0, CTL_ZERO_BYTES, stream) != hipSuccess) { fprintf(stderr, "kernel_launch: memset failed\n"); return; }
    Args a{};
    for (int i = 0; i < 36; ++i) a.in[i] = (const float*)d_in[i];
    a.out = (float*)d_out; a.ws = (unsigned char*)d_ws;
#if MK_MULTI || MK_DBG
    for (int ph = 0; ph < PH_COUNT; ++ph) {
        if (!host_phase_nonempty(ph)) continue;
        a.ph_lo = ph; a.ph_hi = ph + 1;
        hipLaunchKernelGGL(mk_fwd, dim3(grid), dim3(NTHREADS), LDS_BYTES, stream, a);
#if MK_DBG
        dbg_after_phase(ph, a, stream);
#endif
    }
#if MK_DBG
    dbg_report(a, stream);
#endif
#else
    a.ph_lo = 0; a.ph_hi = PH_COUNT;
    hipLaunchKernelGGL(mk_fwd, dim3(grid), dim3(NTHREADS), LDS_BYTES, stream, a);
#endif
    const hipError_t le = hipPeekAtLastError();
    if (le != hipSuccess) fprintf(stderr, "kernel_launch: launch failed: %s\n", hipGetErrorName(le));
}
```
